# Optimizing an MI355X kernel written in HIP

```python
import jax, jax.numpy as jnp
from jax import lax
import numpy as np

D_MODEL = 1024
BATCH = 8
SEQ = 8192
DEPTH = 1

N_META = 16
EPS = 1e-6

SB_HEADS = 8
SB_HEAD_DIM = D_MODEL // 16
SB_WIDTH = SB_HEADS * SB_HEAD_DIM
SB_BLOCK = 128

GLA_HEADS = 4
GLA_DV = D_MODEL // 8
GLA_DK = GLA_DV // 2
GLA_WIDTH = GLA_HEADS * GLA_DV
GLA_KW = GLA_HEADS * GLA_DK
GLA_GATE_RANK = 16
GLA_TAU = 16.0
GLA_CHUNK = 64

MIX_WIDTH = SB_WIDTH + GLA_WIDTH
IN_SPLITS = [SB_WIDTH, SB_WIDTH, SB_WIDTH, GLA_KW, GLA_KW, GLA_WIDTH, GLA_WIDTH, GLA_GATE_RANK]
IN_COLS = sum(IN_SPLITS)

PEER_HEADS = 8
PEER_NKEYS = 128
PEER_TOPK = 16
PEER_QDIM = 128
PEER_HALF = PEER_QDIM // 2
N_EXPERTS = PEER_NKEYS * PEER_NKEYS
PEER_BLOCK = 256

kernel_name = "hymba_sb_gla_peer_block"


def rmsnorm(x, g):
    xf = x.astype(jnp.float32)
    y = xf * lax.rsqrt(jnp.mean(xf * xf, axis=-1, keepdims=True) + EPS)
    return (y * g.astype(jnp.float32)).astype(x.dtype)


def split_heads(t, n):
    b, l, _ = t.shape
    return t.reshape(b, l, n, -1).transpose(0, 2, 1, 3)


def merge_heads(t):
    b, h, l, d = t.shape
    return t.transpose(0, 2, 1, 3).reshape(b, l, h * d)


def sb_query_block(q_blk, q_pos, k, v):
    L = k.shape[2]
    z = jnp.einsum('bhqd,bhkd->bhqk', q_blk, k).astype(jnp.float32) * (SB_HEAD_DIM ** -0.5)
    mask = jnp.arange(L)[None, :] < q_pos[:, None]
    log_1m = jnp.where(mask, jax.nn.log_sigmoid(-z), 0.0)
    between = lax.cumsum(log_1m, axis=3, reverse=True) - log_1m
    a = jnp.where(mask, jnp.exp(jax.nn.log_sigmoid(z) + between), 0.0)
    return jnp.einsum('bhqk,bhkd->bhqd', a, v.astype(jnp.float32)).astype(v.dtype)


def stick_breaking_attention(q, k, v):
    b, h, L, d = q.shape
    n_real = L - N_META
    o_meta = sb_query_block(q[:, :, :N_META], jnp.arange(N_META), k, v)
    starts = N_META + jnp.arange(n_real // SB_BLOCK) * SB_BLOCK

    def body(start):
        qb = lax.dynamic_slice_in_dim(q, start, SB_BLOCK, axis=2)
        return sb_query_block(qb, start + jnp.arange(SB_BLOCK), k, v)

    o_real = lax.map(body, starts)
    o_real = jnp.moveaxis(o_real, 0, 2).reshape(b, h, n_real, d)
    return jnp.concatenate([o_meta, o_real], axis=2)


def gla_chunk(state, xs):
    q, k, v, lg = xs
    C = q.shape[2]
    bcum = jnp.cumsum(lg, axis=2)
    o_inter = jnp.einsum('bhtd,bhde->bhte', q * jnp.exp(bcum), state)
    causal = (jnp.arange(C)[:, None] >= jnp.arange(C)[None, :])[:, :, None]
    diff = bcum[:, :, :, None, :] - bcum[:, :, None, :, :]
    decay = jnp.where(causal, jnp.exp(jnp.where(causal, diff, 0.0)), 0.0)
    attn = jnp.einsum('bhtd,bhsd,bhtsd->bhts', q, k, decay)
    o = o_inter + jnp.einsum('bhts,bhse->bhte', attn, v)
    b_last = bcum[:, :, -1:, :]
    new_state = jnp.exp(b_last[:, :, 0, :])[..., None] * state + \
        jnp.einsum('bhsd,bhse->bhde', k * jnp.exp(b_last - bcum), v)
    return new_state, o


def gated_linear_attention(q, k, v, lg):
    out_dtype = v.dtype
    q, k, v, lg = (t.astype(jnp.float32) for t in (q, k, v, lg))
    b, h, L, dk = q.shape
    dv = v.shape[-1]
    n_real = L - N_META
    n_chunks = n_real // GLA_CHUNK
    state0 = jnp.zeros((b, h, dk, dv), jnp.float32)
    state, o_meta = gla_chunk(state0, (q[:, :, :N_META], k[:, :, :N_META], v[:, :, :N_META], lg[:, :, :N_META]))

    def to_chunks(t):
        return jnp.moveaxis(t[:, :, N_META:].reshape(b, h, n_chunks, GLA_CHUNK, t.shape[-1]), 2, 0)

    _, o_real = lax.scan(gla_chunk, state, (to_chunks(q), to_chunks(k), to_chunks(v), to_chunks(lg)))
    o_real = jnp.moveaxis(o_real, 0, 2).reshape(b, h, n_real, dv)
    return jnp.concatenate([o_meta, o_real], axis=2).astype(out_dtype)


def hybrid_mixer(hn, w_in, w_gate_up, b_gate_up, sb_norm_g, gla_norm_g, w_out):
    proj = hn @ w_in
    offsets = list(np.cumsum(IN_SPLITS)[:-1])
    sbq, sbk, sbv, gq, gk, gv, gr, glr = jnp.split(proj, offsets, axis=-1)
    sb_o = stick_breaking_attention(split_heads(sbq, SB_HEADS), split_heads(sbk, SB_HEADS),
                                    split_heads(sbv, SB_HEADS))
    sb_o = merge_heads(rmsnorm(sb_o, sb_norm_g.reshape(SB_HEADS, 1, SB_HEAD_DIM)))
    lg = jax.nn.log_sigmoid((glr @ w_gate_up + b_gate_up).astype(jnp.float32)) / GLA_TAU
    gla_o = gated_linear_attention(split_heads(gq, GLA_HEADS) * (GLA_DK ** -0.5),
                                   split_heads(gk, GLA_HEADS), split_heads(gv, GLA_HEADS),
                                   split_heads(lg, GLA_HEADS))
    gla_o = merge_heads(rmsnorm(gla_o, gla_norm_g.reshape(GLA_HEADS, 1, GLA_DV))) * jax.nn.silu(gr)
    return jnp.concatenate([sb_o, gla_o], axis=-1) @ w_out


def peer_ffn(hn, w_peer_q, sub_keys1, sub_keys2, expert_u, expert_v):
    b, L, d = hn.shape
    t = hn.reshape(b * L, d)
    T = t.shape[0]
    q = (t @ w_peer_q).reshape(T, PEER_HEADS, 2, PEER_HALF)
    s1 = jnp.einsum('thd,hkd->thk', q[:, :, 0], sub_keys1).astype(jnp.float32)
    s2 = jnp.einsum('thd,hkd->thk', q[:, :, 1], sub_keys2).astype(jnp.float32)
    v1, i1 = lax.top_k(s1, PEER_TOPK)
    v2, i2 = lax.top_k(s2, PEER_TOPK)
    cand = (v1[..., :, None] + v2[..., None, :]).reshape(T, PEER_HEADS, PEER_TOPK * PEER_TOPK)
    cidx = (i1[..., :, None] * PEER_NKEYS + i2[..., None, :]).reshape(T, PEER_HEADS, PEER_TOPK * PEER_TOPK)
    sc, pos = lax.top_k(cand, PEER_TOPK)
    eidx = jnp.take_along_axis(cidx, pos, axis=-1).reshape(T, PEER_HEADS * PEER_TOPK)
    gates = jax.nn.softmax(sc, axis=-1).reshape(T, PEER_HEADS * PEER_TOPK).astype(hn.dtype)
    n_blocks = -(-T // PEER_BLOCK)
    pad = n_blocks * PEER_BLOCK - T
    tb = jnp.pad(t, ((0, pad), (0, 0))).reshape(n_blocks, PEER_BLOCK, d)
    eb = jnp.pad(eidx, ((0, pad), (0, 0))).reshape(n_blocks, PEER_BLOCK, -1)
    gb = jnp.pad(gates, ((0, pad), (0, 0))).reshape(n_blocks, PEER_BLOCK, -1)

    def block(args):
        xt, e, g = args
        act = jax.nn.gelu(jnp.einsum('nkd,nd->nk', expert_u[e], xt), approximate=False)
        return jnp.einsum('nk,nkd->nd', g * act, expert_v[e])

    y = lax.map(block, (tb, eb, gb)).reshape(n_blocks * PEER_BLOCK, d)[:T]
    return y.reshape(b, L, d)


def setup_inputs(seed: int = 0) -> dict:
    key = jax.random.key(seed)
    ks = jax.random.split(key, 20)
    n = jax.random.normal
    f = jnp.float32
    return {
        "x": n(ks[0], (BATCH, SEQ, D_MODEL), f),
        "meta_tokens": n(ks[1], (N_META, D_MODEL), f),
        "norm1_g": 1.0 + 0.02 * n(ks[2], (DEPTH, D_MODEL), f),
        "w_in": n(ks[3], (DEPTH, D_MODEL, IN_COLS), f) * D_MODEL ** -0.5,
        "w_gate_up": n(ks[4], (DEPTH, GLA_GATE_RANK, GLA_KW), f) * GLA_GATE_RANK ** -0.5,
        "b_gate_up": 0.1 * n(ks[5], (DEPTH, GLA_KW), f),
        "sb_norm_g": 1.0 + 0.02 * n(ks[6], (DEPTH, SB_WIDTH), f),
        "gla_norm_g": 1.0 + 0.02 * n(ks[7], (DEPTH, GLA_WIDTH), f),
        "w_out": n(ks[8], (DEPTH, MIX_WIDTH, D_MODEL), f) * MIX_WIDTH ** -0.5,
        "norm2_g": 1.0 + 0.02 * n(ks[9], (DEPTH, D_MODEL), f),
        "w_peer_q": n(ks[10], (DEPTH, D_MODEL, PEER_HEADS * PEER_QDIM), f) * D_MODEL ** -0.5,
        "sub_keys1": n(ks[11], (DEPTH, PEER_HEADS, PEER_NKEYS, PEER_HALF), f) * PEER_HALF ** -0.5,
        "sub_keys2": n(ks[12], (DEPTH, PEER_HEADS, PEER_NKEYS, PEER_HALF), f) * PEER_HALF ** -0.5,
        "expert_u": n(ks[13], (DEPTH, N_EXPERTS, D_MODEL), f) * D_MODEL ** -0.5,
        "expert_v": n(ks[14], (DEPTH, N_EXPERTS, D_MODEL), f) * PEER_HEADS ** -0.5,
        "norm_f_g": 1.0 + 0.02 * n(ks[15], (D_MODEL,), f),
    }


def reference(x, meta_tokens, norm1_g, w_in, w_gate_up, b_gate_up, sb_norm_g, gla_norm_g, w_out,
              norm2_g, w_peer_q, sub_keys1, sub_keys2, expert_u, expert_v, norm_f_g):
    b = x.shape[0]
    meta = jnp.broadcast_to(meta_tokens.astype(x.dtype)[None], (b, N_META, x.shape[-1]))
    h = jnp.concatenate([meta, x], axis=1)
    for l in range(DEPTH):
        h = h + hybrid_mixer(rmsnorm(h, norm1_g[l]), w_in[l], w_gate_up[l], b_gate_up[l],
                             sb_norm_g[l], gla_norm_g[l], w_out[l])
        h = h + peer_ffn(rmsnorm(h, norm2_g[l]), w_peer_q[l], sub_keys1[l], sub_keys2[l],
                         expert_u[l], expert_v[l])
    return rmsnorm(h, norm_f_g)[:, N_META:]
```

```cpp
#include <hip/hip_runtime.h>
#include <stdint.h>
#include <stddef.h>

typedef unsigned short bf16_t;
typedef short bf16x8 __attribute__((ext_vector_type(8)));
typedef float f32x16 __attribute__((ext_vector_type(16)));
typedef float f32x4 __attribute__((ext_vector_type(4)));
typedef float f32x2 __attribute__((ext_vector_type(2)));
typedef unsigned u32x4 __attribute__((ext_vector_type(4)));
typedef unsigned u32x2 __attribute__((ext_vector_type(2)));
typedef __bf16 bf16x2_t __attribute__((ext_vector_type(2)));

#define DI __device__ __forceinline__
#define MFMA32(a, b, c) __builtin_amdgcn_mfma_f32_32x32x16_bf16((a), (b), (c), 0, 0, 0)

constexpr int D = 1024, NB = 8, SEQ = 8192, NMETA = 16;
constexpr int TREAL = NB * SEQ;
constexpr int MROWS = TREAL + 128;
constexpr int NIN = 3088, NINP = 3200;
constexpr int SBH = 8, SBD = 64;
constexpr int GH = 4, GDK = 64, GDV = 128;
constexpr int KIDX = SEQ + 32;
constexpr int GU = SEQ + 64;
constexpr int NEXP = 16384;
constexpr float EPS = 1e-6f;

constexpr size_t MiB = 1u << 20;
constexpr size_t WS_WIN = 1 * MiB;
constexpr size_t WS_WOUT = 8 * MiB;
constexpr size_t WS_WPQ = 10 * MiB;
constexpr size_t WS_EU = 16 * MiB;
constexpr size_t WS_EV = 48 * MiB;
constexpr size_t WS_A1 = 80 * MiB;
constexpr size_t WS_QSB = 210 * MiB;
constexpr size_t WS_KSB = 274 * MiB;
constexpr size_t WS_VTSB = 339 * MiB;
constexpr size_t WS_GQ = 404 * MiB;
constexpr size_t WS_GK = 437 * MiB;
constexpr size_t WS_H1 = 210 * MiB;
constexpr size_t WS_GV = 470 * MiB;
constexpr size_t WS_GR = 535 * MiB;
constexpr size_t WS_GLR = 599 * MiB;
constexpr size_t WS_LG = 604 * MiB;
constexpr size_t WS_MIX = 669 * MiB;
constexpr size_t WS_EIDX = 797 * MiB;
constexpr size_t WS_GATE = 829 * MiB;
constexpr size_t WS_END = 861 * MiB;

DI unsigned f2bf(float f) { unsigned u = __float_as_uint(f); return (u + 0x7fffu + ((u >> 16) & 1u)) >> 16; }
DI float bf2f(unsigned b) { return __uint_as_float(b << 16); }
DI unsigned pk2(float lo, float hi) { f32x2 v = {lo, hi}; return __builtin_bit_cast(unsigned, __builtin_convertvector(v, bf16x2_t)); }
DI float bflo(unsigned u) { return __uint_as_float(u << 16); }
DI float bfhi(unsigned u) { return __uint_as_float(u & 0xffff0000u); }
DI int crow(int reg, int h) { return (reg & 3) + 8 * (reg >> 2) + 4 * h; }
DI float wave_sum(float v) {
#pragma unroll
  for (int o = 32; o >= 1; o >>= 1) v += __shfl_xor(v, o);
  return v;
}
DI float dot2bf(unsigned a, unsigned b, float acc) { return __builtin_amdgcn_fdot2_f32_bf16(__builtin_bit_cast(bf16x2_t, a), __builtin_bit_cast(bf16x2_t, b), acc, false); }
DI float softplus(float z) { return fmaxf(z, 0.f) + __logf(1.f + __expf(-fabsf(z))); }

__global__ void k_transpose_w(const float* __restrict__ W, const float* __restrict__ gain, bf16_t* __restrict__ WT, int K, int N, int Npad) {
  __shared__ float t[32][33];
  const int n0 = blockIdx.x * 32, k0 = blockIdx.y * 32, tx = threadIdx.x, ty = threadIdx.y;
  for (int r = ty; r < 32; r += 8) {
    const int k = k0 + r, n = n0 + tx;
    float v = 0.f;
    if (n < N) { v = W[(size_t)k * N + n]; if (gain) v *= gain[k]; }
    t[r][tx] = v;
  }
  __syncthreads();
  for (int r = ty; r < 32; r += 8) {
    const int n = n0 + r, k = k0 + tx;
    WT[(size_t)n * K + k] = (bf16_t)f2bf(t[tx][r]);
  }
}
__global__ void k_convert(const float* __restrict__ src, bf16_t* __restrict__ dst, size_t n8) {
  size_t i = (size_t)blockIdx.x * blockDim.x + threadIdx.x;
  const size_t stride = (size_t)gridDim.x * blockDim.x;
  for (; i < n8; i += stride) {
    const f32x4 a = ((const f32x4*)src)[2 * i], b = ((const f32x4*)src)[2 * i + 1];
    u32x4 o; o.x = pk2(a.x, a.y); o.y = pk2(a.z, a.w); o.z = pk2(b.x, b.y); o.w = pk2(b.z, b.w);
    ((u32x4*)dst)[i] = o;
  }
}
__global__ void k_zero_pads(bf16_t* KSB, bf16_t* VTSB, bf16_t* GQ, bf16_t* GK, bf16_t* GV) {
  const int tid = blockIdx.x * blockDim.x + threadIdx.x, nth = gridDim.x * blockDim.x;
  for (int i = tid; i < 64 * 16 * 64; i += nth) { const int bh = i / 1024, r = i % 1024; KSB[(size_t)bh * KIDX * 64 + r] = 0; }
  for (int i = tid; i < 64 * 64 * 16; i += nth) { const int row = i / 16, c = i % 16; VTSB[(size_t)row * KIDX + c] = 0; }
  for (int i = tid; i < 32 * 48 * 64; i += nth) { const int bh = i / 3072, r = i % 3072; GQ[(size_t)bh * GU * 64 + r] = 0; GK[(size_t)bh * GU * 64 + r] = 0; }
  for (int i = tid; i < 32 * 48 * 128; i += nth) { const int bh = i / 6144, r = i % 6144; GV[(size_t)bh * GU * 128 + r] = 0; }
}

template <int MODE>
__global__ __launch_bounds__(256) void k_norm_rows(const float* __restrict__ src, const float* __restrict__ meta, bf16_t* __restrict__ dst, int nrows) {
  const int row = blockIdx.x * 4 + (threadIdx.x >> 6), lane = threadIdx.x & 63;
  if (row >= nrows) return;
  const float* p = nullptr;
  if (MODE == 0) { if (row < TREAL) p = src + (size_t)row * D; else if (row < TREAL + NMETA) p = meta + (size_t)(row - TREAL) * D; }
  else p = src + (size_t)row * D;
  f32x4 v[4];
  float ss = 0.f;
#pragma unroll
  for (int j = 0; j < 4; ++j) {
    v[j] = p ? *(const f32x4*)(p + j * 256 + lane * 4) : (f32x4){0.f, 0.f, 0.f, 0.f};
    ss += v[j].x * v[j].x + v[j].y * v[j].y + v[j].z * v[j].z + v[j].w * v[j].w;
  }
  ss = wave_sum(ss);
  const float r = rsqrtf(ss * (1.0f / D) + EPS);
#pragma unroll
  for (int j = 0; j < 4; ++j) {
    f32x4 gg = {1.f, 1.f, 1.f, 1.f};
    if (MODE == 1) gg = *(const f32x4*)(meta + j * 256 + lane * 4);
    u32x2 o; o.x = pk2(v[j].x * r * gg.x, v[j].y * r * gg.y); o.y = pk2(v[j].z * r * gg.z, v[j].w * r * gg.w);
    *(u32x2*)(dst + (size_t)row * D + j * 256 + lane * 4) = o;
  }
}

constexpr int GBK = 32, GLDS_ROW = 40;
struct GemmLds { bf16_t a[2][128 * GLDS_ROW]; bf16_t b[2][128 * GLDS_ROW]; };

template <bool SWAP>
DI void gemm_tile(const bf16_t* __restrict__ A, const bf16_t* __restrict__ Bt, int K, int m0, int n0, GemmLds& L, f32x16 (&acc)[2][2]) {
  const int tid = threadIdx.x, lane = tid & 63, wave = tid >> 6, wm = wave >> 1, wn = wave & 1;
  const int r = lane & 31, h = lane >> 5;
#pragma unroll
  for (int i = 0; i < 2; ++i)
#pragma unroll
    for (int j = 0; j < 2; ++j)
#pragma unroll
      for (int e = 0; e < 16; ++e) acc[i][j][e] = 0.f;
  const int prow0 = tid >> 2, pc = tid & 3;
  const bf16_t* ga0 = A + (size_t)(m0 + prow0) * K + pc * 8;
  const bf16_t* ga1 = A + (size_t)(m0 + prow0 + 64) * K + pc * 8;
  const bf16_t* gb0 = Bt + (size_t)(n0 + prow0) * K + pc * 8;
  const bf16_t* gb1 = Bt + (size_t)(n0 + prow0 + 64) * K + pc * 8;
  const int lw0 = prow0 * GLDS_ROW + pc * 8, lw1 = (prow0 + 64) * GLDS_ROW + pc * 8;
  u32x4 ra0, ra1, rb0, rb1;
  ra0 = *(const u32x4*)ga0; ra1 = *(const u32x4*)ga1; rb0 = *(const u32x4*)gb0; rb1 = *(const u32x4*)gb1;
  *(u32x4*)&L.a[0][lw0] = ra0; *(u32x4*)&L.a[0][lw1] = ra1; *(u32x4*)&L.b[0][lw0] = rb0; *(u32x4*)&L.b[0][lw1] = rb1;
  __syncthreads();
  const int nk = K / GBK;
  for (int kt = 0; kt < nk; ++kt) {
    const int cur = kt & 1;
    if (kt + 1 < nk) {
      const int ko = (kt + 1) * GBK;
      ra0 = *(const u32x4*)(ga0 + ko); ra1 = *(const u32x4*)(ga1 + ko); rb0 = *(const u32x4*)(gb0 + ko); rb1 = *(const u32x4*)(gb1 + ko);
    }
#pragma unroll
    for (int ks = 0; ks < 2; ++ks) {
      bf16x8 af[2], bfr[2];
#pragma unroll
      for (int i = 0; i < 2; ++i) af[i] = *(const bf16x8*)&L.a[cur][(wm * 64 + i * 32 + r) * GLDS_ROW + ks * 16 + h * 8];
#pragma unroll
      for (int j = 0; j < 2; ++j) bfr[j] = *(const bf16x8*)&L.b[cur][(wn * 64 + j * 32 + r) * GLDS_ROW + ks * 16 + h * 8];
#pragma unroll
      for (int i = 0; i < 2; ++i)
#pragma unroll
        for (int j = 0; j < 2; ++j) {
          if (SWAP) acc[i][j] = MFMA32(bfr[j], af[i], acc[i][j]);
          else acc[i][j] = MFMA32(af[i], bfr[j], acc[i][j]);
        }
    }
    if (kt + 1 < nk) {
      const int nx = cur ^ 1;
      *(u32x4*)&L.a[nx][lw0] = ra0; *(u32x4*)&L.a[nx][lw1] = ra1; *(u32x4*)&L.b[nx][lw0] = rb0; *(u32x4*)&L.b[nx][lw1] = rb1;
    }
    __syncthreads();
  }
}

struct InProjOut { bf16_t *QSB, *KSB, *VTSB, *GQ, *GK, *GV, *GR; float* GLR; };

DI void inproj_store_row4(const InProjOut& O, int m, int n, float v0, float v1, float v2, float v3) {
  const bool real = m < TREAL;
  const int mm = m - TREAL;
  if (!real && mm >= NMETA) return;
  const int b = m >> 13, i = m & 8191;
  u32x2 pk; pk.x = pk2(v0, v1); pk.y = pk2(v2, v3);
  if (n < 512) {
    if (!real) return;
    const int hd = n >> 6, d = n & 63;
    *(u32x2*)(O.QSB + ((size_t)(b * SBH + hd) * SEQ + i) * 64 + d) = pk;
  } else if (n < 1024) {
    const int f = n - 512, hd = f >> 6, d = f & 63;
    if (real) *(u32x2*)(O.KSB + ((size_t)(b * SBH + hd) * KIDX + 32 + i) * 64 + d) = pk;
    else for (int bb = 0; bb < NB; ++bb) *(u32x2*)(O.KSB + ((size_t)(bb * SBH + hd) * KIDX + 16 + mm) * 64 + d) = pk;
  } else if (n < 1536) {
  } else if (n < 1792) {
    const int f = n - 1536, hd = f >> 6, d = f & 63;
    if (real) *(u32x2*)(O.GQ + ((size_t)(b * GH + hd) * GU + 64 + i) * 64 + d) = pk;
    else for (int bb = 0; bb < NB; ++bb) *(u32x2*)(O.GQ + ((size_t)(bb * GH + hd) * GU + 48 + mm) * 64 + d) = pk;
  } else if (n < 2048) {
    const int f = n - 1792, hd = f >> 6, d = f & 63;
    if (real) *(u32x2*)(O.GK + ((size_t)(b * GH + hd) * GU + 64 + i) * 64 + d) = pk;
    else for (int bb = 0; bb < NB; ++bb) *(u32x2*)(O.GK + ((size_t)(bb * GH + hd) * GU + 48 + mm) * 64 + d) = pk;
  } else if (n < 2560) {
    const int f = n - 2048, hd = f >> 7, e = f & 127;
    if (real) *(u32x2*)(O.GV + ((size_t)(b * GH + hd) * GU + 64 + i) * 128 + e) = pk;
    else for (int bb = 0; bb < NB; ++bb) *(u32x2*)(O.GV + ((size_t)(bb * GH + hd) * GU + 48 + mm) * 128 + e) = pk;
  } else if (n < 3072) {
    if (!real) return;
    *(u32x2*)(O.GR + (size_t)m * 512 + (n - 2560)) = pk;
  } else if (n < 3088) {
    const int f = n - 3072;
    const f32x4 v = {v0, v1, v2, v3};
    if (real) *(f32x4*)(O.GLR + ((size_t)b * GU + 64 + i) * 16 + f) = v;
    else for (int bb = 0; bb < NB; ++bb) *(f32x4*)(O.GLR + ((size_t)bb * GU + 48 + mm) * 16 + f) = v;
  }
}

__global__ __launch_bounds__(256) void k_gemm_inproj(const bf16_t* __restrict__ A1, const bf16_t* __restrict__ WinT, InProjOut O) {
  __shared__ GemmLds L;
  const int nt = blockIdx.x % 25, mt = blockIdx.x / 25;
  const int m0 = mt * 128, n0 = nt * 128;
  const int lane = threadIdx.x & 63, wave = threadIdx.x >> 6, wm = wave >> 1, wn = wave & 1, r = lane & 31, h = lane >> 5;
  f32x16 acc[2][2];
  const bool vtile = (nt >= 8 && nt < 12);
  if (vtile) {
    gemm_tile<false>(A1, WinT, D, m0, n0, L, acc);
#pragma unroll
    for (int i = 0; i < 2; ++i)
#pragma unroll
      for (int j = 0; j < 2; ++j) {
        const int n = n0 + wn * 64 + j * 32 + r, f = n - 1024, hd = f >> 6, d = f & 63;
#pragma unroll
        for (int g = 0; g < 4; ++g) {
          const int m = m0 + wm * 64 + i * 32 + 8 * g + 4 * h;
          u32x2 pk; pk.x = pk2(acc[i][j][4 * g], acc[i][j][4 * g + 1]); pk.y = pk2(acc[i][j][4 * g + 2], acc[i][j][4 * g + 3]);
          if (m < TREAL) {
            const int b = m >> 13, ii = m & 8191;
            *(u32x2*)(O.VTSB + ((size_t)(b * SBH + hd) * 64 + d) * KIDX + 32 + ii) = pk;
          } else {
            const int mm = m - TREAL;
            if (mm < NMETA) for (int bb = 0; bb < NB; ++bb) *(u32x2*)(O.VTSB + ((size_t)(bb * SBH + hd) * 64 + d) * KIDX + 16 + mm) = pk;
          }
        }
      }
  } else {
    gemm_tile<true>(A1, WinT, D, m0, n0, L, acc);
#pragma unroll
    for (int i = 0; i < 2; ++i)
#pragma unroll
      for (int j = 0; j < 2; ++j) {
        const int m = m0 + wm * 64 + i * 32 + r;
#pragma unroll
        for (int g = 0; g < 4; ++g) {
          const int n = n0 + wn * 64 + j * 32 + 8 * g + 4 * h;
          inproj_store_row4(O, m, n, acc[i][j][4 * g], acc[i][j][4 * g + 1], acc[i][j][4 * g + 2], acc[i][j][4 * g + 3]);
        }
      }
  }
}

__global__ __launch_bounds__(256) void k_gemm_out(const bf16_t* __restrict__ MIX, const bf16_t* __restrict__ WoutT, const float* __restrict__ x, float* __restrict__ H1) {
  __shared__ GemmLds L;
  const int nt = blockIdx.x % 8, mt = blockIdx.x / 8;
  const int m0 = mt * 128, n0 = nt * 128;
  const int lane = threadIdx.x & 63, wave = threadIdx.x >> 6, wm = wave >> 1, wn = wave & 1, r = lane & 31, h = lane >> 5;
  f32x16 acc[2][2];
  gemm_tile<false>(MIX, WoutT, D, m0, n0, L, acc);
#pragma unroll
  for (int i = 0; i < 2; ++i)
#pragma unroll
    for (int j = 0; j < 2; ++j) {
      const int n = n0 + wn * 64 + j * 32 + r;
#pragma unroll
      for (int e = 0; e < 16; ++e) {
        const int m = m0 + wm * 64 + i * 32 + crow(e, h);
        const size_t idx = (size_t)m * D + n;
        H1[idx] = x[idx] + acc[i][j][e];
      }
    }
}

__global__ __launch_bounds__(256) void k_gemm_pq(const bf16_t* __restrict__ A2, const bf16_t* __restrict__ WpqT, bf16_t* __restrict__ QP) {
  __shared__ GemmLds L;
  const int nt = blockIdx.x % 8, mt = blockIdx.x / 8;
  const int m0 = mt * 128, n0 = nt * 128;
  const int lane = threadIdx.x & 63, wave = threadIdx.x >> 6, wm = wave >> 1, wn = wave & 1, r = lane & 31, h = lane >> 5;
  f32x16 acc[2][2];
  gemm_tile<true>(A2, WpqT, D, m0, n0, L, acc);
#pragma unroll
  for (int i = 0; i < 2; ++i)
#pragma unroll
    for (int j = 0; j < 2; ++j) {
      const int m = m0 + wm * 64 + i * 32 + r;
#pragma unroll
      for (int g = 0; g < 4; ++g) {
        const int n = n0 + wn * 64 + j * 32 + 8 * g + 4 * h;
        u32x2 pk; pk.x = pk2(acc[i][j][4 * g], acc[i][j][4 * g + 1]); pk.y = pk2(acc[i][j][4 * g + 2], acc[i][j][4 * g + 3]);
        *(u32x2*)(QP + (size_t)m * D + n) = pk;
      }
    }
}

constexpr float SB_THR = -90.f;
__global__ __launch_bounds__(256) void k_sb_attn(const bf16_t* __restrict__ QSB, const bf16_t* __restrict__ KSB, const bf16_t* __restrict__ VTSB,
                                                 const float* __restrict__ sb_g, bf16_t* __restrict__ MIX) {
  const int lane = threadIdx.x & 63, wave = threadIdx.x >> 6, r = lane & 31, h = lane >> 5;
  const int bh = blockIdx.x >> 6, qb = blockIdx.x & 63;
  const int b = bh >> 3, hd = bh & 7;
  const int i0 = qb * 128 + wave * 32;
  const bf16_t* Qb = QSB + ((size_t)bh * SEQ + i0) * 64;
  const bf16_t* Kb = KSB + (size_t)bh * KIDX * 64;
  const bf16_t* Vb = VTSB + (size_t)bh * 64 * KIDX;
  bf16x8 qf[4];
#pragma unroll
  for (int ks = 0; ks < 4; ++ks) qf[ks] = *(const bf16x8*)(Qb + r * 64 + ks * 16 + h * 8);
  f32x16 o[2];
#pragma unroll
  for (int e = 0; e < 16; ++e) { o[0][e] = 0.f; o[1][e] = 0.f; }
  float R = 0.f;
  const int qidx = 32 + i0 + r;
  for (int c = (i0 >> 5) + 1; c >= 0; --c) {
    const int k0 = 32 * c;
    bf16x8 kf[4];
#pragma unroll
    for (int ks = 0; ks < 4; ++ks) kf[ks] = *(const bf16x8*)(Kb + (size_t)(k0 + r) * 64 + ks * 16 + h * 8);
    bf16x8 vf[2][2];
#pragma unroll
    for (int mt = 0; mt < 2; ++mt)
#pragma unroll
      for (int s2 = 0; s2 < 2; ++s2) {
        const bf16_t* vp = Vb + (size_t)(mt * 32 + r) * KIDX + k0 + 16 * s2 + 4 * h;
        const u32x2 lo = *(const u32x2*)vp, hi = *(const u32x2*)(vp + 8);
        u32x4 t; t.x = lo.x; t.y = lo.y; t.z = hi.x; t.w = hi.y;
        vf[mt][s2] = __builtin_bit_cast(bf16x8, t);
      }
    f32x16 s;
#pragma unroll
    for (int e = 0; e < 16; ++e) s[e] = 0.f;
#pragma unroll
    for (int ks = 0; ks < 4; ++ks) s = MFMA32(kf[ks], qf[ks], s);
    float l1m[16], lb[16];
    bool valid[16];
#pragma unroll
    for (int e = 0; e < 16; ++e) {
      const int kidx = k0 + crow(e, h);
      valid[e] = (kidx < qidx) && (kidx >= 16);
      const float z = s[e] * 0.125f;
      const float sp = softplus(z);
      l1m[e] = valid[e] ? -sp : 0.f;
      lb[e] = z - sp;
    }
    float sfx[16], G[4], PG[4];
#pragma unroll
    for (int g = 0; g < 4; ++g) {
      sfx[4 * g + 3] = 0.f;
      sfx[4 * g + 2] = l1m[4 * g + 3];
      sfx[4 * g + 1] = sfx[4 * g + 2] + l1m[4 * g + 2];
      sfx[4 * g + 0] = sfx[4 * g + 1] + l1m[4 * g + 1];
      G[g] = sfx[4 * g + 0] + l1m[4 * g + 0];
      PG[g] = __shfl_xor(G[g], 32);
    }
    float HS[4];
    HS[3] = 0.f;
    HS[2] = G[3] + PG[3];
    HS[1] = HS[2] + G[2] + PG[2];
    HS[0] = HS[1] + G[1] + PG[1];
    const float total = HS[0] + G[0] + PG[0];
    float a[16];
#pragma unroll
    for (int e = 0; e < 16; ++e) {
      const int g = e >> 2;
      const float between = sfx[e] + (h == 0 ? PG[g] : 0.f) + HS[g] + R;
      a[e] = valid[e] ? __expf(lb[e] + between) : 0.f;
    }
    R += total;
#pragma unroll
    for (int s2 = 0; s2 < 2; ++s2) {
      u32x4 p;
      p.x = pk2(a[8 * s2 + 0], a[8 * s2 + 1]); p.y = pk2(a[8 * s2 + 2], a[8 * s2 + 3]);
      p.z = pk2(a[8 * s2 + 4], a[8 * s2 + 5]); p.w = pk2(a[8 * s2 + 6], a[8 * s2 + 7]);
      const bf16x8 pf = __builtin_bit_cast(bf16x8, p);
      o[0] = MFMA32(vf[0][s2], pf, o[0]);
      o[1] = MFMA32(vf[1][s2], pf, o[1]);
    }
    if (__all(R < SB_THR)) break;
  }
  float ss = 0.f;
#pragma unroll
  for (int e = 0; e < 16; ++e) ss += o[0][e] * o[0][e] + o[1][e] * o[1][e];
  ss += __shfl_xor(ss, 32);
  const float sc = rsqrtf(ss * (1.0f / 64.0f) + EPS);
  bf16_t* outp = MIX + (size_t)(b * SEQ + i0 + r) * D + hd * 64;
#pragma unroll
  for (int mt = 0; mt < 2; ++mt)
#pragma unroll
    for (int g = 0; g < 4; ++g) {
      const int d = mt * 32 + 8 * g + 4 * h;
      const f32x4 gg = *(const f32x4*)(sb_g + hd * 64 + d);
      u32x2 pk;
      pk.x = pk2(o[mt][4 * g] * sc * gg.x, o[mt][4 * g + 1] * sc * gg.y);
      pk.y = pk2(o[mt][4 * g + 2] * sc * gg.z, o[mt][4 * g + 3] * sc * gg.w);
      *(u32x2*)(outp + d) = pk;
    }
}

__global__ __launch_bounds__(256) void k_lg(const float* __restrict__ GLR, const float* __restrict__ wg, const float* __restrict__ bg, float* __restrict__ LG) {
  const int c = threadIdx.x;
  const int bu = blockIdx.x;
  const int b = bu / GU, u = bu % GU;
  float val = 0.f;
  if (u >= 48) {
    float acc = bg[c];
    const float* g = GLR + (size_t)bu * 16;
#pragma unroll
    for (int k = 0; k < 16; ++k) acc += g[k] * wg[k * 256 + c];
    val = -softplus(-acc) * (1.0f / 16.0f);
  }
  const int hd = c >> 6, d = c & 63;
  LG[((size_t)(b * GH + hd) * GU + u) * 64 + d] = val;
}

__global__ __launch_bounds__(256) void k_gla_v1(const bf16_t* __restrict__ GQ, const bf16_t* __restrict__ GK, const bf16_t* __restrict__ GV,
                                                const float* __restrict__ LG, float* __restrict__ GO) {
  __shared__ float qs[64][68], ks[64][68], bc[64][68], at[64][68], vs[64][36], Ss[64][36];
  const int tid = threadIdx.x;
  const int bh = blockIdx.x >> 2, es = blockIdx.x & 3, b = bh >> 2, hd = bh & 3;
  const bf16_t* gq = GQ + (size_t)bh * GU * 64;
  const bf16_t* gk = GK + (size_t)bh * GU * 64;
  const bf16_t* gv = GV + (size_t)bh * GU * 128 + es * 32;
  const float* lg = LG + (size_t)bh * GU * 64;
  const int sd = tid >> 2, eg = tid & 3;
  float S[8];
#pragma unroll
  for (int j = 0; j < 8; ++j) S[j] = 0.f;
  for (int c = 0; c < 129; ++c) {
    const int u0 = c * 64;
#pragma unroll 2
    for (int idx = tid; idx < 4096; idx += 256) {
      const int t = idx >> 6, d = idx & 63;
      qs[t][d] = bf2f(gq[(size_t)(u0 + t) * 64 + d]);
      ks[t][d] = bf2f(gk[(size_t)(u0 + t) * 64 + d]);
      bc[t][d] = lg[(size_t)(u0 + t) * 64 + d];
    }
    for (int idx = tid; idx < 2048; idx += 256) {
      const int t = idx >> 5, e = idx & 31;
      vs[t][e] = bf2f(gv[(size_t)(u0 + t) * 128 + e]);
    }
#pragma unroll
    for (int j = 0; j < 8; ++j) Ss[sd][eg * 8 + j] = S[j];
    __syncthreads();
    if (tid < 64) { float run = 0.f;
#pragma unroll 4
      for (int t = 0; t < 64; ++t) { run += bc[t][tid]; bc[t][tid] = run; } }
    __syncthreads();
#pragma unroll 2
    for (int idx = tid; idx < 4096; idx += 256) {
      const int t = idx >> 6, d = idx & 63;
      const float bv = bc[t][d];
      qs[t][d] *= __expf(bv) * 0.125f;
      ks[t][d] *= __expf(-bv);
    }
    __syncthreads();
    {
      const int ti = tid >> 4, si = tid & 15;
      float acc[4][4];
#pragma unroll
      for (int a = 0; a < 4; ++a)
#pragma unroll
        for (int bb = 0; bb < 4; ++bb) acc[a][bb] = 0.f;
#pragma unroll 1
      for (int d = 0; d < 64; d += 4) {
        f32x4 q4[4], k4[4];
#pragma unroll
        for (int a = 0; a < 4; ++a) q4[a] = *(const f32x4*)&qs[ti + 16 * a][d];
#pragma unroll
        for (int bb = 0; bb < 4; ++bb) k4[bb] = *(const f32x4*)&ks[si + 16 * bb][d];
#pragma unroll
        for (int a = 0; a < 4; ++a)
#pragma unroll
          for (int bb = 0; bb < 4; ++bb)
            acc[a][bb] += q4[a].x * k4[bb].x + q4[a].y * k4[bb].y + q4[a].z * k4[bb].z + q4[a].w * k4[bb].w;
      }
#pragma unroll
      for (int a = 0; a < 4; ++a)
#pragma unroll
        for (int bb = 0; bb < 4; ++bb) {
          const int t = ti + 16 * a, s = si + 16 * bb;
          at[t][s] = (s <= t) ? acc[a][bb] : 0.f;
        }
    }
    __syncthreads();
    {
      const int t = sd;
      float o[8];
#pragma unroll
      for (int j = 0; j < 8; ++j) o[j] = 0.f;
#pragma unroll 2
      for (int d = 0; d < 64; ++d) {
        const float qv = qs[t][d];
        const f32x4 s0 = *(const f32x4*)&Ss[d][eg * 8], s1 = *(const f32x4*)&Ss[d][eg * 8 + 4];
        o[0] += qv * s0.x; o[1] += qv * s0.y; o[2] += qv * s0.z; o[3] += qv * s0.w;
        o[4] += qv * s1.x; o[5] += qv * s1.y; o[6] += qv * s1.z; o[7] += qv * s1.w;
      }
#pragma unroll 2
      for (int s = 0; s < 64; ++s) {
        const float av = at[t][s];
        const f32x4 v0 = *(const f32x4*)&vs[s][eg * 8], v1 = *(const f32x4*)&vs[s][eg * 8 + 4];
        o[0] += av * v0.x; o[1] += av * v0.y; o[2] += av * v0.z; o[3] += av * v0.w;
        o[4] += av * v1.x; o[5] += av * v1.y; o[6] += av * v1.z; o[7] += av * v1.w;
      }
      if (c >= 1) {
        float* op = GO + ((size_t)(b * SEQ + (c - 1) * 64 + t)) * 512 + hd * 128 + es * 32 + eg * 8;
        *(f32x4*)op = (f32x4){o[0], o[1], o[2], o[3]};
        *(f32x4*)(op + 4) = (f32x4){o[4], o[5], o[6], o[7]};
      }
    }
    {
      float n[8];
#pragma unroll
      for (int j = 0; j < 8; ++j) n[j] = S[j];
#pragma unroll 2
      for (int s = 0; s < 64; ++s) {
        const float kv = ks[s][sd];
        const f32x4 v0 = *(const f32x4*)&vs[s][eg * 8], v1 = *(const f32x4*)&vs[s][eg * 8 + 4];
        n[0] += kv * v0.x; n[1] += kv * v0.y; n[2] += kv * v0.z; n[3] += kv * v0.w;
        n[4] += kv * v1.x; n[5] += kv * v1.y; n[6] += kv * v1.z; n[7] += kv * v1.w;
      }
      const float dec = __expf(bc[63][sd]);
#pragma unroll
      for (int j = 0; j < 8; ++j) S[j] = dec * n[j];
    }
    __syncthreads();
  }
}

__global__ __launch_bounds__(256) void k_gla_norm(const float* __restrict__ GO, const bf16_t* __restrict__ GR, const float* __restrict__ gla_g, bf16_t* __restrict__ MIX) {
  const int m = blockIdx.x, hd = threadIdx.x >> 6, lane = threadIdx.x & 63;
  const f32x2 v = *(const f32x2*)(GO + (size_t)m * 512 + hd * 128 + lane * 2);
  float ss = wave_sum(v.x * v.x + v.y * v.y);
  const float sc = rsqrtf(ss * (1.0f / 128.0f) + EPS);
  const unsigned g2 = *(const unsigned*)(GR + (size_t)m * 512 + hd * 128 + lane * 2);
  const float g0 = bflo(g2), g1 = bfhi(g2);
  const f32x2 gn = *(const f32x2*)(gla_g + hd * 128 + lane * 2);
  const float s0 = g0 / (1.f + __expf(-g0)), s1 = g1 / (1.f + __expf(-g1));
  *(unsigned*)(MIX + (size_t)m * D + 512 + hd * 128 + lane * 2) = pk2(v.x * sc * gn.x * s0, v.y * sc * gn.y * s1);
}

DI bool better(float v1, int i1, float v2, int i2) { return (v1 > v2) || (v1 == v2 && i1 < i2); }
DI void wave_argmax(float& v, int& i) {
#pragma unroll
  for (int o = 32; o >= 1; o >>= 1) {
    const float ov = __shfl_xor(v, o);
    const int oi = __shfl_xor(i, o);
    if (better(ov, oi, v, i)) { v = ov; i = oi; }
  }
}
constexpr int RT_TOK_PER_BLOCK = 256;
__global__ __launch_bounds__(256) void k_route_v1(const bf16_t* __restrict__ QP, const float* __restrict__ sk1, const float* __restrict__ sk2,
                                                  int* __restrict__ EIDX, float* __restrict__ GATE) {
  __shared__ float K1[128][68], K2[128][68];
  __shared__ float qsh[4][128];
  const int hd = blockIdx.x & 7, tg = blockIdx.x >> 3;
  const int tid = threadIdx.x, lane = tid & 63, wave = tid >> 6;
  for (int idx = tid; idx < 128 * 64; idx += 256) {
    const int k = idx >> 6, d = idx & 63;
    K1[k][d] = sk1[((size_t)hd * 128 + k) * 64 + d];
    K2[k][d] = sk2[((size_t)hd * 128 + k) * 64 + d];
  }
  __syncthreads();
  const float NEG = -3.0e38f;
  for (int it = 0; it < RT_TOK_PER_BLOCK / 4; ++it) {
    const int m = tg * RT_TOK_PER_BLOCK + it * 4 + wave;
    {
      const unsigned q2 = *(const unsigned*)(QP + (size_t)m * D + hd * 128 + lane * 2);
      qsh[wave][lane * 2] = bflo(q2); qsh[wave][lane * 2 + 1] = bfhi(q2);
    }
    __builtin_amdgcn_wave_barrier();
    float s1a = 0.f, s1b = 0.f, s2a = 0.f, s2b = 0.f;
#pragma unroll 4
    for (int d = 0; d < 64; d += 4) {
      const f32x4 q1 = *(const f32x4*)&qsh[wave][d], q2 = *(const f32x4*)&qsh[wave][64 + d];
      const f32x4 a = *(const f32x4*)&K1[lane][d], bb = *(const f32x4*)&K1[lane + 64][d];
      const f32x4 c = *(const f32x4*)&K2[lane][d], dd = *(const f32x4*)&K2[lane + 64][d];
      s1a += q1.x * a.x + q1.y * a.y + q1.z * a.z + q1.w * a.w;
      s1b += q1.x * bb.x + q1.y * bb.y + q1.z * bb.z + q1.w * bb.w;
      s2a += q2.x * c.x + q2.y * c.y + q2.z * c.z + q2.w * c.w;
      s2b += q2.x * dd.x + q2.y * dd.y + q2.z * dd.z + q2.w * dd.w;
    }
    __builtin_amdgcn_wave_barrier();
    float tv1 = 0.f, tv2 = 0.f; int ti1 = 0, ti2 = 0;
    for (int rr = 0; rr < 16; ++rr) {
      float v; int i;
      if (better(s1a, lane, s1b, lane + 64)) { v = s1a; i = lane; } else { v = s1b; i = lane + 64; }
      wave_argmax(v, i);
      if (lane == rr) { tv1 = v; ti1 = i; }
      if (i == lane) s1a = NEG;
      if (i == lane + 64) s1b = NEG;
      if (better(s2a, lane, s2b, lane + 64)) { v = s2a; i = lane; } else { v = s2b; i = lane + 64; }
      wave_argmax(v, i);
      if (lane == rr) { tv2 = v; ti2 = i; }
      if (i == lane) s2a = NEG;
      if (i == lane + 64) s2b = NEG;
    }
    const int ca = lane >> 2;
    const float va = __shfl(tv1, ca); const int ia = __shfl(ti1, ca);
    float cv[4]; int ce[4];
#pragma unroll
    for (int j = 0; j < 4; ++j) {
      const int cb = (lane & 3) * 4 + j;
      cv[j] = va + __shfl(tv2, cb);
      ce[j] = ia * 128 + __shfl(ti2, cb);
    }
    float fsc = 0.f; int fe = 0;
    for (int rr = 0; rr < 16; ++rr) {
      float v = cv[0]; int p = lane * 4;
#pragma unroll
      for (int j = 1; j < 4; ++j) if (better(cv[j], lane * 4 + j, v, p)) { v = cv[j]; p = lane * 4 + j; }
      wave_argmax(v, p);
      const int src = p >> 2, jj = p & 3;
      int e = (jj == 0) ? ce[0] : (jj == 1) ? ce[1] : (jj == 2) ? ce[2] : ce[3];
      e = __shfl(e, src);
      if (lane == rr) { fsc = v; fe = e; }
      if (lane == src) {
        if (jj == 0) cv[0] = NEG; else if (jj == 1) cv[1] = NEG; else if (jj == 2) cv[2] = NEG; else cv[3] = NEG;
      }
    }
    const float mx = __shfl(fsc, 0);
    float ex = (lane < 16) ? __expf(fsc - mx) : 0.f;
    const float sum = wave_sum(ex);
    if (lane < 16) {
      EIDX[(size_t)m * 128 + hd * 16 + lane] = fe;
      GATE[(size_t)m * 128 + hd * 16 + lane] = ex / sum;
    }
  }
}

__global__ __launch_bounds__(256) void k_peer_v1(const bf16_t* __restrict__ A2, const bf16_t* __restrict__ EU, const bf16_t* __restrict__ EV,
                                                 const int* __restrict__ EIDX, const float* __restrict__ GATE, const float* __restrict__ H1,
                                                 const float* __restrict__ gf, float* __restrict__ out) {
  __shared__ float cs[4][128];
  __shared__ int es[4][128];
  const int lane = threadIdx.x & 63, wave = threadIdx.x >> 6;
  const int m = blockIdx.x * 4 + wave;
  const int g = lane >> 3, sub = lane & 7;
  u32x4 xf[16];
#pragma unroll
  for (int j = 0; j < 16; ++j) xf[j] = *(const u32x4*)(A2 + (size_t)m * D + (j * 8 + sub) * 8);
  for (int bt = 0; bt < 16; ++bt) {
    const int k = bt * 8 + g;
    const int e = EIDX[(size_t)m * 128 + k];
    const bf16_t* up = EU + (size_t)e * D + sub * 8;
    float acc = 0.f;
#pragma unroll
    for (int j = 0; j < 16; ++j) {
      const u32x4 u = *(const u32x4*)(up + j * 64);
      acc = dot2bf(u.x, xf[j].x, acc); acc = dot2bf(u.y, xf[j].y, acc); acc = dot2bf(u.z, xf[j].z, acc); acc = dot2bf(u.w, xf[j].w, acc);
    }
    acc += __shfl_xor(acc, 1); acc += __shfl_xor(acc, 2); acc += __shfl_xor(acc, 4);
    if (sub == 0) {
      const float act = 0.5f * acc * (1.f + erff(acc * 0.70710678118654752f));
      cs[wave][k] = GATE[(size_t)m * 128 + k] * act;
      es[wave][k] = e;
    }
  }
  __builtin_amdgcn_wave_barrier();
  __syncthreads();
  float y[16];
#pragma unroll
  for (int j = 0; j < 16; ++j) y[j] = 0.f;
#pragma unroll 4
  for (int k = 0; k < 128; ++k) {
    const float c = cs[wave][k];
    const bf16_t* vp = EV + (size_t)es[wave][k] * D + lane * 8;
    const u32x4 v0 = *(const u32x4*)vp, v1 = *(const u32x4*)(vp + 512);
    y[0] += c * bflo(v0.x); y[1] += c * bfhi(v0.x); y[2] += c * bflo(v0.y); y[3] += c * bfhi(v0.y);
    y[4] += c * bflo(v0.z); y[5] += c * bfhi(v0.z); y[6] += c * bflo(v0.w); y[7] += c * bfhi(v0.w);
    y[8] += c * bflo(v1.x); y[9] += c * bfhi(v1.x); y[10] += c * bflo(v1.y); y[11] += c * bfhi(v1.y);
    y[12] += c * bflo(v1.z); y[13] += c * bfhi(v1.z); y[14] += c * bflo(v1.w); y[15] += c * bfhi(v1.w);
  }
  const float* hp = H1 + (size_t)m * D + lane * 8;
  float ss = 0.f;
#pragma unroll
  for (int q = 0; q < 4; ++q) {
    const f32x4 hv = *(const f32x4*)(hp + (q >> 1) * 512 + (q & 1) * 4);
    y[q * 4 + 0] += hv.x; y[q * 4 + 1] += hv.y; y[q * 4 + 2] += hv.z; y[q * 4 + 3] += hv.w;
  }
#pragma unroll
  for (int j = 0; j < 16; ++j) ss += y[j] * y[j];
  ss = wave_sum(ss);
  const float sc = rsqrtf(ss * (1.0f / D) + EPS);
  float* op = out + (size_t)m * D + lane * 8;
#pragma unroll
  for (int q = 0; q < 4; ++q) {
    const int off = (q >> 1) * 512 + (q & 1) * 4;
    const f32x4 gg = *(const f32x4*)(gf + lane * 8 + off);
    *(f32x4*)(op + off) = (f32x4){y[q * 4 + 0] * sc * gg.x, y[q * 4 + 1] * sc * gg.y, y[q * 4 + 2] * sc * gg.z, y[q * 4 + 3] * sc * gg.w};
  }
}

extern "C" void kernel_launch(void* const* d_in, const int* in_sizes, int n_in, void* d_out, int out_size, void* d_ws, size_t ws_size, hipStream_t stream) {
  const float* x = (const float*)d_in[0];
  const float* meta = (const float*)d_in[1];
  const float* norm1_g = (const float*)d_in[2];
  const float* w_in = (const float*)d_in[3];
  const float* w_gate_up = (const float*)d_in[4];
  const float* b_gate_up = (const float*)d_in[5];
  const float* sb_norm_g = (const float*)d_in[6];
  const float* gla_norm_g = (const float*)d_in[7];
  const float* w_out = (const float*)d_in[8];
  const float* norm2_g = (const float*)d_in[9];
  const float* w_peer_q = (const float*)d_in[10];
  const float* sub_keys1 = (const float*)d_in[11];
  const float* sub_keys2 = (const float*)d_in[12];
  const float* expert_u = (const float*)d_in[13];
  const float* expert_v = (const float*)d_in[14];
  const float* norm_f_g = (const float*)d_in[15];
  float* out = (float*)d_out;
  char* ws = (char*)d_ws;
  bf16_t* WinT = (bf16_t*)(ws + WS_WIN);
  bf16_t* WoutT = (bf16_t*)(ws + WS_WOUT);
  bf16_t* WpqT = (bf16_t*)(ws + WS_WPQ);
  bf16_t* EU = (bf16_t*)(ws + WS_EU);
  bf16_t* EV = (bf16_t*)(ws + WS_EV);
  bf16_t* A1 = (bf16_t*)(ws + WS_A1);
  float* GO = (float*)(ws + WS_A1);
  bf16_t* A2 = (bf16_t*)(ws + WS_A1);
  InProjOut O;
  O.QSB = (bf16_t*)(ws + WS_QSB); O.KSB = (bf16_t*)(ws + WS_KSB); O.VTSB = (bf16_t*)(ws + WS_VTSB);
  O.GQ = (bf16_t*)(ws + WS_GQ); O.GK = (bf16_t*)(ws + WS_GK); O.GV = (bf16_t*)(ws + WS_GV); O.GR = (bf16_t*)(ws + WS_GR);
  O.GLR = (float*)(ws + WS_GLR);
  float* H1 = (float*)(ws + WS_H1);
  float* LG = (float*)(ws + WS_LG);
  bf16_t* MIX = (bf16_t*)(ws + WS_MIX);
  bf16_t* QP = (bf16_t*)(ws + WS_MIX);
  int* EIDX = (int*)(ws + WS_EIDX);
  float* GATE = (float*)(ws + WS_GATE);

  k_transpose_w<<<dim3(NINP / 32, D / 32), dim3(32, 8), 0, stream>>>(w_in, norm1_g, WinT, D, NIN, NINP);
  k_transpose_w<<<dim3(D / 32, D / 32), dim3(32, 8), 0, stream>>>(w_out, nullptr, WoutT, D, D, D);
  k_transpose_w<<<dim3(D / 32, D / 32), dim3(32, 8), 0, stream>>>(w_peer_q, nullptr, WpqT, D, D, D);
  k_convert<<<2048, 256, 0, stream>>>(expert_u, EU, (size_t)NEXP * D / 8);
  k_convert<<<2048, 256, 0, stream>>>(expert_v, EV, (size_t)NEXP * D / 8);
  k_zero_pads<<<256, 256, 0, stream>>>(O.KSB, O.VTSB, O.GQ, O.GK, O.GV);
  k_norm_rows<0><<<MROWS / 4, 256, 0, stream>>>(x, meta, A1, MROWS);
  k_gemm_inproj<<<(MROWS / 128) * 25, 256, 0, stream>>>(A1, WinT, O);
  k_sb_attn<<<64 * 64, 256, 0, stream>>>(O.QSB, O.KSB, O.VTSB, sb_norm_g, MIX);
  k_lg<<<NB * GU, 256, 0, stream>>>(O.GLR, w_gate_up, b_gate_up, LG);
  k_gla_v1<<<128, 256, 0, stream>>>(O.GQ, O.GK, O.GV, LG, GO);
  k_gla_norm<<<TREAL, 256, 0, stream>>>(GO, O.GR, gla_norm_g, MIX);
  k_gemm_out<<<(TREAL / 128) * 8, 256, 0, stream>>>(MIX, WoutT, x, H1);
  k_norm_rows<1><<<TREAL / 4, 256, 0, stream>>>(H1, norm2_g, A2, TREAL);
  k_gemm_pq<<<(TREAL / 128) * 8, 256, 0, stream>>>(A2, WpqT, QP);
  k_route_v1<<<8 * (TREAL / RT_TOK_PER_BLOCK), 256, 0, stream>>>(QP, sub_keys1, sub_keys2, EIDX, GATE);
  k_peer_v1<<<TREAL / 4, 256, 0, stream>>>(A2, EU, EV, EIDX, GATE, H1, norm_f_g, out);
}
```

```cpp
#include <hip/hip_runtime.h>
#include <stdint.h>
#include <stddef.h>

typedef unsigned short bf16_t;
typedef short bf16x8 __attribute__((ext_vector_type(8)));
typedef float f32x16 __attribute__((ext_vector_type(16)));
typedef float f32x4 __attribute__((ext_vector_type(4)));
typedef float f32x2 __attribute__((ext_vector_type(2)));
typedef unsigned u32x4 __attribute__((ext_vector_type(4)));
typedef unsigned u32x2 __attribute__((ext_vector_type(2)));
typedef __bf16 bf16x2_t __attribute__((ext_vector_type(2)));

#define DI __device__ __forceinline__
#define MFMA32(a, b, c) __builtin_amdgcn_mfma_f32_32x32x16_bf16((a), (b), (c), 0, 0, 0)

constexpr int D = 1024, NB = 8, SEQ = 8192, NMETA = 16;
constexpr int TREAL = NB * SEQ;
constexpr int MROWS = TREAL + 128;
constexpr int NIN = 3088, NINP = 3200;
constexpr int SBH = 8, SBD = 64;
constexpr int GH = 4, GDK = 64, GDV = 128;
constexpr int KIDX = SEQ + 32;
constexpr int GU = SEQ + 64;
constexpr int NEXP = 16384;
constexpr float EPS = 1e-6f;

constexpr size_t MiB = 1u << 20;
constexpr size_t WS_WIN = 1 * MiB;
constexpr size_t WS_WOUT = 8 * MiB;
constexpr size_t WS_WPQ = 10 * MiB;
constexpr size_t WS_EU = 16 * MiB;
constexpr size_t WS_EV = 48 * MiB;
constexpr size_t WS_A1 = 80 * MiB;
constexpr size_t WS_QSB = 210 * MiB;
constexpr size_t WS_KSB = 274 * MiB;
constexpr size_t WS_VTSB = 339 * MiB;
constexpr size_t WS_GQ = 404 * MiB;
constexpr size_t WS_GK = 437 * MiB;
constexpr size_t WS_H1 = 210 * MiB;
constexpr size_t WS_GV = 470 * MiB;
constexpr size_t WS_GR = 535 * MiB;
constexpr size_t WS_GLR = 599 * MiB;
constexpr size_t WS_LG = 604 * MiB;
constexpr size_t WS_MIX = 669 * MiB;
constexpr size_t WS_EIDX = 797 * MiB;
constexpr size_t WS_GATE = 829 * MiB;
constexpr size_t WS_END = 861 * MiB;

DI unsigned f2bf(float f) { unsigned u = __float_as_uint(f); return (u + 0x7fffu + ((u >> 16) & 1u)) >> 16; }
DI float bf2f(unsigned b) { return __uint_as_float(b << 16); }
DI unsigned pk2(float lo, float hi) { f32x2 v = {lo, hi}; return __builtin_bit_cast(unsigned, __builtin_convertvector(v, bf16x2_t)); }
DI float bflo(unsigned u) { return __uint_as_float(u << 16); }
DI float bfhi(unsigned u) { return __uint_as_float(u & 0xffff0000u); }
DI int crow(int reg, int h) { return (reg & 3) + 8 * (reg >> 2) + 4 * h; }
DI float wave_sum(float v) {
#pragma unroll
  for (int o = 32; o >= 1; o >>= 1) v += __shfl_xor(v, o);
  return v;
}
DI float dot2bf(unsigned a, unsigned b, float acc) { return __builtin_amdgcn_fdot2_f32_bf16(__builtin_bit_cast(bf16x2_t, a), __builtin_bit_cast(bf16x2_t, b), acc, false); }
DI float softplus(float z) { return fmaxf(z, 0.f) + __logf(1.f + __expf(-fabsf(z))); }

DI void ph_transpose_w(int bx, int by, char* smem, const float* __restrict__ W, const float* __restrict__ gain, bf16_t* __restrict__ WT, int K, int N) {
  float (*t)[33] = (float (*)[33])smem;
  const int n0 = bx * 32, k0 = by * 32, tx = threadIdx.x & 31, ty = threadIdx.x >> 5;
  for (int r = ty; r < 32; r += 8) {
    const int k = k0 + r, n = n0 + tx;
    float v = 0.f;
    if (n < N) { v = W[(size_t)k * N + n]; if (gain) v *= gain[k]; }
    t[r][tx] = v;
  }
  __syncthreads();
  for (int r = ty; r < 32; r += 8) {
    const int n = n0 + r, k = k0 + tx;
    WT[(size_t)n * K + k] = (bf16_t)f2bf(t[tx][r]);
  }
  __syncthreads();
}
DI void ph_convert(const float* __restrict__ src, bf16_t* __restrict__ dst, size_t n8) {
  size_t i = (size_t)blockIdx.x * blockDim.x + threadIdx.x;
  const size_t stride = (size_t)gridDim.x * blockDim.x;
  for (; i < n8; i += stride) {
    const f32x4 a = ((const f32x4*)src)[2 * i], b = ((const f32x4*)src)[2 * i + 1];
    u32x4 o; o.x = pk2(a.x, a.y); o.y = pk2(a.z, a.w); o.z = pk2(b.x, b.y); o.w = pk2(b.z, b.w);
    ((u32x4*)dst)[i] = o;
  }
}
DI void ph_zero_pads(bf16_t* KSB, bf16_t* VTSB, bf16_t* GQ, bf16_t* GK, bf16_t* GV) {
  const int tid = blockIdx.x * blockDim.x + threadIdx.x, nth = gridDim.x * blockDim.x;
  for (int i = tid; i < 64 * 16 * 64; i += nth) { const int bh = i / 1024, r = i % 1024; KSB[(size_t)bh * KIDX * 64 + r] = 0; }
  for (int i = tid; i < 64 * 64 * 16; i += nth) { const int row = i / 16, c = i % 16; VTSB[(size_t)row * KIDX + c] = 0; }
  for (int i = tid; i < 32 * 48 * 64; i += nth) { const int bh = i / 3072, r = i % 3072; GQ[(size_t)bh * GU * 64 + r] = 0; GK[(size_t)bh * GU * 64 + r] = 0; }
  for (int i = tid; i < 32 * 48 * 128; i += nth) { const int bh = i / 6144, r = i % 6144; GV[(size_t)bh * GU * 128 + r] = 0; }
}

template <int MODE>
DI void ph_norm_rows(int vb, const float* __restrict__ src, const float* __restrict__ meta, bf16_t* __restrict__ dst) {
  const int row = vb * 4 + (threadIdx.x >> 6), lane = threadIdx.x & 63;
  const float* p = nullptr;
  if (MODE == 0) { if (row < TREAL) p = src + (size_t)row * D; else if (row < TREAL + NMETA) p = meta + (size_t)(row - TREAL) * D; }
  else p = src + (size_t)row * D;
  f32x4 v[4];
  float ss = 0.f;
#pragma unroll
  for (int j = 0; j < 4; ++j) {
    v[j] = p ? *(const f32x4*)(p + j * 256 + lane * 4) : (f32x4){0.f, 0.f, 0.f, 0.f};
    ss += v[j].x * v[j].x + v[j].y * v[j].y + v[j].z * v[j].z + v[j].w * v[j].w;
  }
  ss = wave_sum(ss);
  const float r = rsqrtf(ss * (1.0f / D) + EPS);
#pragma unroll
  for (int j = 0; j < 4; ++j) {
    f32x4 gg = {1.f, 1.f, 1.f, 1.f};
    if (MODE == 1) gg = *(const f32x4*)(meta + j * 256 + lane * 4);
    u32x2 o; o.x = pk2(v[j].x * r * gg.x, v[j].y * r * gg.y); o.y = pk2(v[j].z * r * gg.z, v[j].w * r * gg.w);
    *(u32x2*)(dst + (size_t)row * D + j * 256 + lane * 4) = o;
  }
}

constexpr int GBK = 32, GLDS_ROW = 40;
struct GemmLds { bf16_t a[2][128 * GLDS_ROW]; bf16_t b[2][128 * GLDS_ROW]; };

template <bool SWAP>
DI void gemm_tile(const bf16_t* __restrict__ A, const bf16_t* __restrict__ Bt, int K, int m0, int n0, GemmLds& L, f32x16 (&acc)[2][2]) {
  const int tid = threadIdx.x, lane = tid & 63, wave = tid >> 6, wm = wave >> 1, wn = wave & 1;
  const int r = lane & 31, h = lane >> 5;
#pragma unroll
  for (int i = 0; i < 2; ++i)
#pragma unroll
    for (int j = 0; j < 2; ++j)
#pragma unroll
      for (int e = 0; e < 16; ++e) acc[i][j][e] = 0.f;
  const int prow0 = tid >> 2, pc = tid & 3;
  const bf16_t* ga0 = A + (size_t)(m0 + prow0) * K + pc * 8;
  const bf16_t* ga1 = A + (size_t)(m0 + prow0 + 64) * K + pc * 8;
  const bf16_t* gb0 = Bt + (size_t)(n0 + prow0) * K + pc * 8;
  const bf16_t* gb1 = Bt + (size_t)(n0 + prow0 + 64) * K + pc * 8;
  const int lw0 = prow0 * GLDS_ROW + pc * 8, lw1 = (prow0 + 64) * GLDS_ROW + pc * 8;
  u32x4 ra0, ra1, rb0, rb1;
  ra0 = *(const u32x4*)ga0; ra1 = *(const u32x4*)ga1; rb0 = *(const u32x4*)gb0; rb1 = *(const u32x4*)gb1;
  *(u32x4*)&L.a[0][lw0] = ra0; *(u32x4*)&L.a[0][lw1] = ra1; *(u32x4*)&L.b[0][lw0] = rb0; *(u32x4*)&L.b[0][lw1] = rb1;
  __syncthreads();
  const int nk = K / GBK;
  for (int kt = 0; kt < nk; ++kt) {
    const int cur = kt & 1;
    if (kt + 1 < nk) {
      const int ko = (kt + 1) * GBK;
      ra0 = *(const u32x4*)(ga0 + ko); ra1 = *(const u32x4*)(ga1 + ko); rb0 = *(const u32x4*)(gb0 + ko); rb1 = *(const u32x4*)(gb1 + ko);
    }
#pragma unroll
    for (int ks = 0; ks < 2; ++ks) {
      bf16x8 af[2], bfr[2];
#pragma unroll
      for (int i = 0; i < 2; ++i) af[i] = *(const bf16x8*)&L.a[cur][(wm * 64 + i * 32 + r) * GLDS_ROW + ks * 16 + h * 8];
#pragma unroll
      for (int j = 0; j < 2; ++j) bfr[j] = *(const bf16x8*)&L.b[cur][(wn * 64 + j * 32 + r) * GLDS_ROW + ks * 16 + h * 8];
#pragma unroll
      for (int i = 0; i < 2; ++i)
#pragma unroll
        for (int j = 0; j < 2; ++j) {
          if (SWAP) acc[i][j] = MFMA32(bfr[j], af[i], acc[i][j]);
          else acc[i][j] = MFMA32(af[i], bfr[j], acc[i][j]);
        }
    }
    if (kt + 1 < nk) {
      const int nx = cur ^ 1;
      *(u32x4*)&L.a[nx][lw0] = ra0; *(u32x4*)&L.a[nx][lw1] = ra1; *(u32x4*)&L.b[nx][lw0] = rb0; *(u32x4*)&L.b[nx][lw1] = rb1;
    }
    __syncthreads();
  }
}

struct InProjOut { bf16_t *QSB, *KSB, *VTSB, *GQ, *GK, *GV, *GR; float* GLR; };

DI void inproj_store_row4(const InProjOut& O, int m, int n, float v0, float v1, float v2, float v3) {
  const bool real = m < TREAL;
  const int mm = m - TREAL;
  if (!real && mm >= NMETA) return;
  const int b = m >> 13, i = m & 8191;
  u32x2 pk; pk.x = pk2(v0, v1); pk.y = pk2(v2, v3);
  if (n < 512) {
    if (!real) return;
    const int hd = n >> 6, d = n & 63;
    *(u32x2*)(O.QSB + ((size_t)(b * SBH + hd) * SEQ + i) * 64 + d) = pk;
  } else if (n < 1024) {
    const int f = n - 512, hd = f >> 6, d = f & 63;
    if (real) *(u32x2*)(O.KSB + ((size_t)(b * SBH + hd) * KIDX + 32 + i) * 64 + d) = pk;
    else for (int bb = 0; bb < NB; ++bb) *(u32x2*)(O.KSB + ((size_t)(bb * SBH + hd) * KIDX + 16 + mm) * 64 + d) = pk;
  } else if (n < 1536) {
  } else if (n < 1792) {
    const int f = n - 1536, hd = f >> 6, d = f & 63;
    if (real) *(u32x2*)(O.GQ + ((size_t)(b * GH + hd) * GU + 64 + i) * 64 + d) = pk;
    else for (int bb = 0; bb < NB; ++bb) *(u32x2*)(O.GQ + ((size_t)(bb * GH + hd) * GU + 48 + mm) * 64 + d) = pk;
  } else if (n < 2048) {
    const int f = n - 1792, hd = f >> 6, d = f & 63;
    if (real) *(u32x2*)(O.GK + ((size_t)(b * GH + hd) * GU + 64 + i) * 64 + d) = pk;
    else for (int bb = 0; bb < NB; ++bb) *(u32x2*)(O.GK + ((size_t)(bb * GH + hd) * GU + 48 + mm) * 64 + d) = pk;
  } else if (n < 2560) {
    const int f = n - 2048, hd = f >> 7, e = f & 127;
    if (real) *(u32x2*)(O.GV + ((size_t)(b * GH + hd) * GU + 64 + i) * 128 + e) = pk;
    else for (int bb = 0; bb < NB; ++bb) *(u32x2*)(O.GV + ((size_t)(bb * GH + hd) * GU + 48 + mm) * 128 + e) = pk;
  } else if (n < 3072) {
    if (!real) return;
    *(u32x2*)(O.GR + (size_t)m * 512 + (n - 2560)) = pk;
  } else if (n < 3088) {
    const int f = n - 3072;
    const f32x4 v = {v0, v1, v2, v3};
    if (real) *(f32x4*)(O.GLR + ((size_t)b * GU + 64 + i) * 16 + f) = v;
    else for (int bb = 0; bb < NB; ++bb) *(f32x4*)(O.GLR + ((size_t)bb * GU + 48 + mm) * 16 + f) = v;
  }
}

DI void ph_gemm_inproj(int vb, char* smem, const bf16_t* __restrict__ A1, const bf16_t* __restrict__ WinT, const InProjOut& O) {
  GemmLds& L = *(GemmLds*)smem;
  const int nt = vb % 25, mt = vb / 25;
  const int m0 = mt * 128, n0 = nt * 128;
  const int lane = threadIdx.x & 63, wave = threadIdx.x >> 6, wm = wave >> 1, wn = wave & 1, r = lane & 31, h = lane >> 5;
  f32x16 acc[2][2];
  const bool vtile = (nt >= 8 && nt < 12);
  if (vtile) {
    gemm_tile<false>(A1, WinT, D, m0, n0, L, acc);
#pragma unroll
    for (int i = 0; i < 2; ++i)
#pragma unroll
      for (int j = 0; j < 2; ++j) {
        const int n = n0 + wn * 64 + j * 32 + r, f = n - 1024, hd = f >> 6, d = f & 63;
#pragma unroll
        for (int g = 0; g < 4; ++g) {
          const int m = m0 + wm * 64 + i * 32 + 8 * g + 4 * h;
          u32x2 pk; pk.x = pk2(acc[i][j][4 * g], acc[i][j][4 * g + 1]); pk.y = pk2(acc[i][j][4 * g + 2], acc[i][j][4 * g + 3]);
          if (m < TREAL) {
            const int b = m >> 13, ii = m & 8191;
            *(u32x2*)(O.VTSB + ((size_t)(b * SBH + hd) * 64 + d) * KIDX + 32 + ii) = pk;
          } else {
            const int mm = m - TREAL;
            if (mm < NMETA) for (int bb = 0; bb < NB; ++bb) *(u32x2*)(O.VTSB + ((size_t)(bb * SBH + hd) * 64 + d) * KIDX + 16 + mm) = pk;
          }
        }
      }
  } else {
    gemm_tile<true>(A1, WinT, D, m0, n0, L, acc);
#pragma unroll
    for (int i = 0; i < 2; ++i)
#pragma unroll
      for (int j = 0; j < 2; ++j) {
        const int m = m0 + wm * 64 + i * 32 + r;
#pragma unroll
        for (int g = 0; g < 4; ++g) {
          const int n = n0 + wn * 64 + j * 32 + 8 * g + 4 * h;
          inproj_store_row4(O, m, n, acc[i][j][4 * g], acc[i][j][4 * g + 1], acc[i][j][4 * g + 2], acc[i][j][4 * g + 3]);
        }
      }
  }
}

DI void ph_gemm_out(int vb, char* smem, const bf16_t* __restrict__ MIX, const bf16_t* __restrict__ WoutT, const float* __restrict__ x, float* __restrict__ H1) {
  GemmLds& L = *(GemmLds*)smem;
  const int nt = vb % 8, mt = vb / 8;
  const int m0 = mt * 128, n0 = nt * 128;
  const int lane = threadIdx.x & 63, wave = threadIdx.x >> 6, wm = wave >> 1, wn = wave & 1, r = lane & 31, h = lane >> 5;
  f32x16 acc[2][2];
  gemm_tile<false>(MIX, WoutT, D, m0, n0, L, acc);
#pragma unroll
  for (int i = 0; i < 2; ++i)
#pragma unroll
    for (int j = 0; j < 2; ++j) {
      const int n = n0 + wn * 64 + j * 32 + r;
#pragma unroll
      for (int e = 0; e < 16; ++e) {
        const int m = m0 + wm * 64 + i * 32 + crow(e, h);
        const size_t idx = (size_t)m * D + n;
        H1[idx] = x[idx] + acc[i][j][e];
      }
    }
}

DI void ph_gemm_pq(int vb, char* smem, const bf16_t* __restrict__ A2, const bf16_t* __restrict__ WpqT, bf16_t* __restrict__ QP) {
  GemmLds& L = *(GemmLds*)smem;
  const int nt = vb % 8, mt = vb / 8;
  const int m0 = mt * 128, n0 = nt * 128;
  const int lane = threadIdx.x & 63, wave = threadIdx.x >> 6, wm = wave >> 1, wn = wave & 1, r = lane & 31, h = lane >> 5;
  f32x16 acc[2][2];
  gemm_tile<true>(A2, WpqT, D, m0, n0, L, acc);
#pragma unroll
  for (int i = 0; i < 2; ++i)
#pragma unroll
    for (int j = 0; j < 2; ++j) {
      const int m = m0 + wm * 64 + i * 32 + r;
#pragma unroll
      for (int g = 0; g < 4; ++g) {
        const int n = n0 + wn * 64 + j * 32 + 8 * g + 4 * h;
        u32x2 pk; pk.x = pk2(acc[i][j][4 * g], acc[i][j][4 * g + 1]); pk.y = pk2(acc[i][j][4 * g + 2], acc[i][j][4 * g + 3]);
        *(u32x2*)(QP + (size_t)m * D + n) = pk;
      }
    }
}

constexpr float SB_THR = -90.f;
DI void ph_sb_attn(int vb, const bf16_t* __restrict__ QSB, const bf16_t* __restrict__ KSB, const bf16_t* __restrict__ VTSB,
                                                 const float* __restrict__ sb_g, bf16_t* __restrict__ MIX) {
  const int lane = threadIdx.x & 63, wave = threadIdx.x >> 6, r = lane & 31, h = lane >> 5;
  const int bh = vb >> 6, qb = vb & 63;
  const int b = bh >> 3, hd = bh & 7;
  const int i0 = qb * 128 + wave * 32;
  const bf16_t* Qb = QSB + ((size_t)bh * SEQ + i0) * 64;
  const bf16_t* Kb = KSB + (size_t)bh * KIDX * 64;
  const bf16_t* Vb = VTSB + (size_t)bh * 64 * KIDX;
  bf16x8 qf[4];
#pragma unroll
  for (int ks = 0; ks < 4; ++ks) qf[ks] = *(const bf16x8*)(Qb + r * 64 + ks * 16 + h * 8);
  f32x16 o[2];
#pragma unroll
  for (int e = 0; e < 16; ++e) { o[0][e] = 0.f; o[1][e] = 0.f; }
  float R = 0.f;
  const int qidx = 32 + i0 + r;
  for (int c = (i0 >> 5) + 1; c >= 0; --c) {
    const int k0 = 32 * c;
    bf16x8 kf[4];
#pragma unroll
    for (int ks = 0; ks < 4; ++ks) kf[ks] = *(const bf16x8*)(Kb + (size_t)(k0 + r) * 64 + ks * 16 + h * 8);
    bf16x8 vf[2][2];
#pragma unroll
    for (int mt = 0; mt < 2; ++mt)
#pragma unroll
      for (int s2 = 0; s2 < 2; ++s2) {
        const bf16_t* vp = Vb + (size_t)(mt * 32 + r) * KIDX + k0 + 16 * s2 + 4 * h;
        const u32x2 lo = *(const u32x2*)vp, hi = *(const u32x2*)(vp + 8);
        u32x4 t; t.x = lo.x; t.y = lo.y; t.z = hi.x; t.w = hi.y;
        vf[mt][s2] = __builtin_bit_cast(bf16x8, t);
      }
    f32x16 s;
#pragma unroll
    for (int e = 0; e < 16; ++e) s[e] = 0.f;
#pragma unroll
    for (int ks = 0; ks < 4; ++ks) s = MFMA32(kf[ks], qf[ks], s);
    float l1m[16], lb[16];
    bool valid[16];
#pragma unroll
    for (int e = 0; e < 16; ++e) {
      const int kidx = k0 + crow(e, h);
      valid[e] = (kidx < qidx) && (kidx >= 16);
      const float z = s[e] * 0.125f;
      const float sp = softplus(z);
      l1m[e] = valid[e] ? -sp : 0.f;
      lb[e] = z - sp;
    }
    float sfx[16], G[4], PG[4];
#pragma unroll
    for (int g = 0; g < 4; ++g) {
      sfx[4 * g + 3] = 0.f;
      sfx[4 * g + 2] = l1m[4 * g + 3];
      sfx[4 * g + 1] = sfx[4 * g + 2] + l1m[4 * g + 2];
      sfx[4 * g + 0] = sfx[4 * g + 1] + l1m[4 * g + 1];
      G[g] = sfx[4 * g + 0] + l1m[4 * g + 0];
      PG[g] = __shfl_xor(G[g], 32);
    }
    float HS[4];
    HS[3] = 0.f;
    HS[2] = G[3] + PG[3];
    HS[1] = HS[2] + G[2] + PG[2];
    HS[0] = HS[1] + G[1] + PG[1];
    const float total = HS[0] + G[0] + PG[0];
    float a[16];
#pragma unroll
    for (int e = 0; e < 16; ++e) {
      const int g = e >> 2;
      const float between = sfx[e] + (h == 0 ? PG[g] : 0.f) + HS[g] + R;
      a[e] = valid[e] ? __expf(lb[e] + between) : 0.f;
    }
    R += total;
#pragma unroll
    for (int s2 = 0; s2 < 2; ++s2) {
      u32x4 p;
      p.x = pk2(a[8 * s2 + 0], a[8 * s2 + 1]); p.y = pk2(a[8 * s2 + 2], a[8 * s2 + 3]);
      p.z = pk2(a[8 * s2 + 4], a[8 * s2 + 5]); p.w = pk2(a[8 * s2 + 6], a[8 * s2 + 7]);
      const bf16x8 pf = __builtin_bit_cast(bf16x8, p);
      o[0] = MFMA32(vf[0][s2], pf, o[0]);
      o[1] = MFMA32(vf[1][s2], pf, o[1]);
    }
    if (__all(R < SB_THR)) break;
  }
  float ss = 0.f;
#pragma unroll
  for (int e = 0; e < 16; ++e) ss += o[0][e] * o[0][e] + o[1][e] * o[1][e];
  ss += __shfl_xor(ss, 32);
  const float sc = rsqrtf(ss * (1.0f / 64.0f) + EPS);
  bf16_t* outp = MIX + (size_t)(b * SEQ + i0 + r) * D + hd * 64;
#pragma unroll
  for (int mt = 0; mt < 2; ++mt)
#pragma unroll
    for (int g = 0; g < 4; ++g) {
      const int d = mt * 32 + 8 * g + 4 * h;
      const f32x4 gg = *(const f32x4*)(sb_g + hd * 64 + d);
      u32x2 pk;
      pk.x = pk2(o[mt][4 * g] * sc * gg.x, o[mt][4 * g + 1] * sc * gg.y);
      pk.y = pk2(o[mt][4 * g + 2] * sc * gg.z, o[mt][4 * g + 3] * sc * gg.w);
      *(u32x2*)(outp + d) = pk;
    }
}

DI void ph_lg(int bu, const float* __restrict__ GLR, const float* __restrict__ wg, const float* __restrict__ bg, float* __restrict__ LG) {
  const int c = threadIdx.x;
  const int b = bu / GU, u = bu % GU;
  float val = 0.f;
  if (u >= 48) {
    float acc = bg[c];
    const float* g = GLR + (size_t)bu * 16;
#pragma unroll
    for (int k = 0; k < 16; ++k) acc += g[k] * wg[k * 256 + c];
    val = -softplus(-acc) * (1.0f / 16.0f);
  }
  const int hd = c >> 6, d = c & 63;
  LG[((size_t)(b * GH + hd) * GU + u) * 64 + d] = val;
}

DI void ph_gla_v1(int vb, char* smem, const bf16_t* __restrict__ GQ, const bf16_t* __restrict__ GK, const bf16_t* __restrict__ GV,
                                                const float* __restrict__ LG, float* __restrict__ GO) {
  float (*qs)[68] = (float (*)[68])smem;
  float (*ks)[68] = (float (*)[68])(smem + 17408);
  float (*bc)[68] = (float (*)[68])(smem + 2 * 17408);
  float (*at)[68] = bc;
  float (*vs)[36] = (float (*)[36])(smem + 3 * 17408);
  float (*Ss)[36] = (float (*)[36])(smem + 3 * 17408 + 9216);
  float* decs = (float*)(smem + 3 * 17408 + 2 * 9216);
  const int tid = threadIdx.x;
  const int bh = vb >> 2, es = vb & 3, b = bh >> 2, hd = bh & 3;
  const bf16_t* gq = GQ + (size_t)bh * GU * 64;
  const bf16_t* gk = GK + (size_t)bh * GU * 64;
  const bf16_t* gv = GV + (size_t)bh * GU * 128 + es * 32;
  const float* lg = LG + (size_t)bh * GU * 64;
  const int sd = tid >> 2, eg = tid & 3;
  float S[8];
#pragma unroll
  for (int j = 0; j < 8; ++j) S[j] = 0.f;
  for (int c = 0; c < 129; ++c) {
    const int u0 = c * 64;
#pragma unroll 2
    for (int idx = tid; idx < 4096; idx += 256) {
      const int t = idx >> 6, d = idx & 63;
      qs[t][d] = bf2f(gq[(size_t)(u0 + t) * 64 + d]);
      ks[t][d] = bf2f(gk[(size_t)(u0 + t) * 64 + d]);
      bc[t][d] = lg[(size_t)(u0 + t) * 64 + d];
    }
    for (int idx = tid; idx < 2048; idx += 256) {
      const int t = idx >> 5, e = idx & 31;
      vs[t][e] = bf2f(gv[(size_t)(u0 + t) * 128 + e]);
    }
#pragma unroll
    for (int j = 0; j < 8; ++j) Ss[sd][eg * 8 + j] = S[j];
    __syncthreads();
    if (tid < 64) { float run = 0.f;
#pragma unroll 4
      for (int t = 0; t < 64; ++t) { run += bc[t][tid]; bc[t][tid] = run; } }
    __syncthreads();
#pragma unroll 2
    for (int idx = tid; idx < 4096; idx += 256) {
      const int t = idx >> 6, d = idx & 63;
      const float bv = bc[t][d];
      qs[t][d] *= __expf(bv) * 0.125f;
      ks[t][d] *= __expf(-bv);
    }
    if (tid < 64) decs[tid] = __expf(bc[63][tid]);
    __syncthreads();
    {
      const int ti = tid >> 4, si = tid & 15;
      float acc[4][4];
#pragma unroll
      for (int a = 0; a < 4; ++a)
#pragma unroll
        for (int bb = 0; bb < 4; ++bb) acc[a][bb] = 0.f;
#pragma unroll 1
      for (int d = 0; d < 64; d += 4) {
        f32x4 q4[4], k4[4];
#pragma unroll
        for (int a = 0; a < 4; ++a) q4[a] = *(const f32x4*)&qs[ti + 16 * a][d];
#pragma unroll
        for (int bb = 0; bb < 4; ++bb) k4[bb] = *(const f32x4*)&ks[si + 16 * bb][d];
#pragma unroll
        for (int a = 0; a < 4; ++a)
#pragma unroll
          for (int bb = 0; bb < 4; ++bb)
            acc[a][bb] += q4[a].x * k4[bb].x + q4[a].y * k4[bb].y + q4[a].z * k4[bb].z + q4[a].w * k4[bb].w;
      }
#pragma unroll
      for (int a = 0; a < 4; ++a)
#pragma unroll
        for (int bb = 0; bb < 4; ++bb) {
          const int t = ti + 16 * a, s = si + 16 * bb;
          at[t][s] = (s <= t) ? acc[a][bb] : 0.f;
        }
    }
    __syncthreads();
    {
      const int t = sd;
      float o[8];
#pragma unroll
      for (int j = 0; j < 8; ++j) o[j] = 0.f;
#pragma unroll 2
      for (int d = 0; d < 64; ++d) {
        const float qv = qs[t][d];
        const f32x4 s0 = *(const f32x4*)&Ss[d][eg * 8], s1 = *(const f32x4*)&Ss[d][eg * 8 + 4];
        o[0] += qv * s0.x; o[1] += qv * s0.y; o[2] += qv * s0.z; o[3] += qv * s0.w;
        o[4] += qv * s1.x; o[5] += qv * s1.y; o[6] += qv * s1.z; o[7] += qv * s1.w;
      }
#pragma unroll 2
      for (int s = 0; s < 64; ++s) {
        const float av = at[t][s];
        const f32x4 v0 = *(const f32x4*)&vs[s][eg * 8], v1 = *(const f32x4*)&vs[s][eg * 8 + 4];
        o[0] += av * v0.x; o[1] += av * v0.y; o[2] += av * v0.z; o[3] += av * v0.w;
        o[4] += av * v1.x; o[5] += av * v1.y; o[6] += av * v1.z; o[7] += av * v1.w;
      }
      if (c >= 1) {
        float* op = GO + ((size_t)(b * SEQ + (c - 1) * 64 + t)) * 512 + hd * 128 + es * 32 + eg * 8;
        *(f32x4*)op = (f32x4){o[0], o[1], o[2], o[3]};
        *(f32x4*)(op + 4) = (f32x4){o[4], o[5], o[6], o[7]};
      }
    }
    {
      float n[8];
#pragma unroll
      for (int j = 0; j < 8; ++j) n[j] = S[j];
#pragma unroll 2
      for (int s = 0; s < 64; ++s) {
        const float kv = ks[s][sd];
        const f32x4 v0 = *(const f32x4*)&vs[s][eg * 8], v1 = *(const f32x4*)&vs[s][eg * 8 + 4];
        n[0] += kv * v0.x; n[1] += kv * v0.y; n[2] += kv * v0.z; n[3] += kv * v0.w;
        n[4] += kv * v1.x; n[5] += kv * v1.y; n[6] += kv * v1.z; n[7] += kv * v1.w;
      }
      const float dec = decs[sd];
#pragma unroll
      for (int j = 0; j < 8; ++j) S[j] = dec * n[j];
    }
    __syncthreads();
  }
}

DI void ph_gla_norm(int m, const float* __restrict__ GO, const bf16_t* __restrict__ GR, const float* __restrict__ gla_g, bf16_t* __restrict__ MIX) {
  const int hd = threadIdx.x >> 6, lane = threadIdx.x & 63;
  const f32x2 v = *(const f32x2*)(GO + (size_t)m * 512 + hd * 128 + lane * 2);
  float ss = wave_sum(v.x * v.x + v.y * v.y);
  const float sc = rsqrtf(ss * (1.0f / 128.0f) + EPS);
  const unsigned g2 = *(const unsigned*)(GR + (size_t)m * 512 + hd * 128 + lane * 2);
  const float g0 = bflo(g2), g1 = bfhi(g2);
  const f32x2 gn = *(const f32x2*)(gla_g + hd * 128 + lane * 2);
  const float s0 = g0 / (1.f + __expf(-g0)), s1 = g1 / (1.f + __expf(-g1));
  *(unsigned*)(MIX + (size_t)m * D + 512 + hd * 128 + lane * 2) = pk2(v.x * sc * gn.x * s0, v.y * sc * gn.y * s1);
}

DI bool better(float v1, int i1, float v2, int i2) { return (v1 > v2) || (v1 == v2 && i1 < i2); }
DI void wave_argmax(float& v, int& i) {
#pragma unroll
  for (int o = 32; o >= 1; o >>= 1) {
    const float ov = __shfl_xor(v, o);
    const int oi = __shfl_xor(i, o);
    if (better(ov, oi, v, i)) { v = ov; i = oi; }
  }
}
constexpr int RT_TOK_PER_BLOCK = 256;
DI void ph_route_v1(int vb, char* smem, const bf16_t* __restrict__ QP, const float* __restrict__ sk1, const float* __restrict__ sk2,
                                                  int* __restrict__ EIDX, float* __restrict__ GATE) {
  float (*K1)[68] = (float (*)[68])smem;
  float (*K2)[68] = (float (*)[68])(smem + 34816);
  float (*qsh)[128] = (float (*)[128])(smem + 2 * 34816);
  const int hd = vb & 7, tg = vb >> 3;
  const int tid = threadIdx.x, lane = tid & 63, wave = tid >> 6;
  for (int idx = tid; idx < 128 * 64; idx += 256) {
    const int k = idx >> 6, d = idx & 63;
    K1[k][d] = sk1[((size_t)hd * 128 + k) * 64 + d];
    K2[k][d] = sk2[((size_t)hd * 128 + k) * 64 + d];
  }
  __syncthreads();
  const float NEG = -3.0e38f;
  for (int it = 0; it < RT_TOK_PER_BLOCK / 4; ++it) {
    const int m = tg * RT_TOK_PER_BLOCK + it * 4 + wave;
    {
      const unsigned q2 = *(const unsigned*)(QP + (size_t)m * D + hd * 128 + lane * 2);
      qsh[wave][lane * 2] = bflo(q2); qsh[wave][lane * 2 + 1] = bfhi(q2);
    }
    __builtin_amdgcn_wave_barrier();
    float s1a = 0.f, s1b = 0.f, s2a = 0.f, s2b = 0.f;
#pragma unroll 4
    for (int d = 0; d < 64; d += 4) {
      const f32x4 q1 = *(const f32x4*)&qsh[wave][d], q2 = *(const f32x4*)&qsh[wave][64 + d];
      const f32x4 a = *(const f32x4*)&K1[lane][d], bb = *(const f32x4*)&K1[lane + 64][d];
      const f32x4 c = *(const f32x4*)&K2[lane][d], dd = *(const f32x4*)&K2[lane + 64][d];
      s1a += q1.x * a.x + q1.y * a.y + q1.z * a.z + q1.w * a.w;
      s1b += q1.x * bb.x + q1.y * bb.y + q1.z * bb.z + q1.w * bb.w;
      s2a += q2.x * c.x + q2.y * c.y + q2.z * c.z + q2.w * c.w;
      s2b += q2.x * dd.x + q2.y * dd.y + q2.z * dd.z + q2.w * dd.w;
    }
    __builtin_amdgcn_wave_barrier();
    float tv1 = 0.f, tv2 = 0.f; int ti1 = 0, ti2 = 0;
    for (int rr = 0; rr < 16; ++rr) {
      float v; int i;
      if (better(s1a, lane, s1b, lane + 64)) { v = s1a; i = lane; } else { v = s1b; i = lane + 64; }
      wave_argmax(v, i);
      if (lane == rr) { tv1 = v; ti1 = i; }
      if (i == lane) s1a = NEG;
      if (i == lane + 64) s1b = NEG;
      if (better(s2a, lane, s2b, lane + 64)) { v = s2a; i = lane; } else { v = s2b; i = lane + 64; }
      wave_argmax(v, i);
      if (lane == rr) { tv2 = v; ti2 = i; }
      if (i == lane) s2a = NEG;
      if (i == lane + 64) s2b = NEG;
    }
    const int ca = lane >> 2;
    const float va = __shfl(tv1, ca); const int ia = __shfl(ti1, ca);
    float cv[4]; int ce[4];
#pragma unroll
    for (int j = 0; j < 4; ++j) {
      const int cb = (lane & 3) * 4 + j;
      cv[j] = va + __shfl(tv2, cb);
      ce[j] = ia * 128 + __shfl(ti2, cb);
    }
    float fsc = 0.f; int fe = 0;
    for (int rr = 0; rr < 16; ++rr) {
      float v = cv[0]; int p = lane * 4;
#pragma unroll
      for (int j = 1; j < 4; ++j) if (better(cv[j], lane * 4 + j, v, p)) { v = cv[j]; p = lane * 4 + j; }
      wave_argmax(v, p);
      const int src = p >> 2, jj = p & 3;
      int e = (jj == 0) ? ce[0] : (jj == 1) ? ce[1] : (jj == 2) ? ce[2] : ce[3];
      e = __shfl(e, src);
      if (lane == rr) { fsc = v; fe = e; }
      if (lane == src) {
        if (jj == 0) cv[0] = NEG; else if (jj == 1) cv[1] = NEG; else if (jj == 2) cv[2] = NEG; else cv[3] = NEG;
      }
    }
    const float mx = __shfl(fsc, 0);
    float ex = (lane < 16) ? __expf(fsc - mx) : 0.f;
    const float sum = wave_sum(ex);
    if (lane < 16) {
      EIDX[(size_t)m * 128 + hd * 16 + lane] = fe;
      GATE[(size_t)m * 128 + hd * 16 + lane] = ex / sum;
    }
  }
  __syncthreads();
}

DI void ph_peer_v1(int vb, char* smem, const bf16_t* __restrict__ A2, const bf16_t* __restrict__ EU, const bf16_t* __restrict__ EV,
                                                 const int* __restrict__ EIDX, const float* __restrict__ GATE, const float* __restrict__ H1,
                                                 const float* __restrict__ gf, float* __restrict__ out) {
  float (*cs)[128] = (float (*)[128])smem;
  int (*es)[128] = (int (*)[128])(smem + 2048);
  const int lane = threadIdx.x & 63, wave = threadIdx.x >> 6;
  const int m = vb * 4 + wave;
  const int g = lane >> 3, sub = lane & 7;
  u32x4 xf[16];
#pragma unroll
  for (int j = 0; j < 16; ++j) xf[j] = *(const u32x4*)(A2 + (size_t)m * D + (j * 8 + sub) * 8);
  for (int bt = 0; bt < 16; ++bt) {
    const int k = bt * 8 + g;
    const int e = EIDX[(size_t)m * 128 + k];
    const bf16_t* up = EU + (size_t)e * D + sub * 8;
    float acc = 0.f;
#pragma unroll
    for (int j = 0; j < 16; ++j) {
      const u32x4 u = *(const u32x4*)(up + j * 64);
      acc = dot2bf(u.x, xf[j].x, acc); acc = dot2bf(u.y, xf[j].y, acc); acc = dot2bf(u.z, xf[j].z, acc); acc = dot2bf(u.w, xf[j].w, acc);
    }
    acc += __shfl_xor(acc, 1); acc += __shfl_xor(acc, 2); acc += __shfl_xor(acc, 4);
    if (sub == 0) {
      const float act = 0.5f * acc * (1.f + erff(acc * 0.70710678118654752f));
      cs[wave][k] = GATE[(size_t)m * 128 + k] * act;
      es[wave][k] = e;
    }
  }
  __builtin_amdgcn_wave_barrier();
  __syncthreads();
  float y[16];
#pragma unroll
  for (int j = 0; j < 16; ++j) y[j] = 0.f;
#pragma unroll 4
  for (int k = 0; k < 128; ++k) {
    const float c = cs[wave][k];
    const bf16_t* vp = EV + (size_t)es[wave][k] * D + lane * 8;
    const u32x4 v0 = *(const u32x4*)vp, v1 = *(const u32x4*)(vp + 512);
    y[0] += c * bflo(v0.x); y[1] += c * bfhi(v0.x); y[2] += c * bflo(v0.y); y[3] += c * bfhi(v0.y);
    y[4] += c * bflo(v0.z); y[5] += c * bfhi(v0.z); y[6] += c * bflo(v0.w); y[7] += c * bfhi(v0.w);
    y[8] += c * bflo(v1.x); y[9] += c * bfhi(v1.x); y[10] += c * bflo(v1.y); y[11] += c * bfhi(v1.y);
    y[12] += c * bflo(v1.z); y[13] += c * bfhi(v1.z); y[14] += c * bflo(v1.w); y[15] += c * bfhi(v1.w);
  }
  const float* hp = H1 + (size_t)m * D + lane * 8;
  float ss = 0.f;
#pragma unroll
  for (int q = 0; q < 4; ++q) {
    const f32x4 hv = *(const f32x4*)(hp + (q >> 1) * 512 + (q & 1) * 4);
    y[q * 4 + 0] += hv.x; y[q * 4 + 1] += hv.y; y[q * 4 + 2] += hv.z; y[q * 4 + 3] += hv.w;
  }
#pragma unroll
  for (int j = 0; j < 16; ++j) ss += y[j] * y[j];
  ss = wave_sum(ss);
  const float sc = rsqrtf(ss * (1.0f / D) + EPS);
  float* op = out + (size_t)m * D + lane * 8;
#pragma unroll
  for (int q = 0; q < 4; ++q) {
    const int off = (q >> 1) * 512 + (q & 1) * 4;
    const f32x4 gg = *(const f32x4*)(gf + lane * 8 + off);
    *(f32x4*)(op + off) = (f32x4){y[q * 4 + 0] * sc * gg.x, y[q * 4 + 1] * sc * gg.y, y[q * 4 + 2] * sc * gg.z, y[q * 4 + 3] * sc * gg.w};
  }
}


#define XB_TMO      128
#define XB_XCNT(j)  (256  + 64 * (j))
#define XB_XSUB(j)  (1280 + 64 * (j))
#define XB_XGEN(j)  (2304 + 64 * (j))
#define XB_TOP      3328
#define XB_TOPGEN   3392
#define XCD_BAR_WORDS 3456
#define XB_SPIN_CAP (1u << 20)
#define LAS __attribute__((address_space(3)))
DI unsigned xb_ld(unsigned* p)              { return __hip_atomic_load(p, __ATOMIC_RELAXED, __HIP_MEMORY_SCOPE_AGENT); }
DI unsigned xb_add(unsigned* p, unsigned v) { return __hip_atomic_fetch_add(p, v, __ATOMIC_RELAXED, __HIP_MEMORY_SCOPE_AGENT); }
DI unsigned xb_xcc_id() { return (unsigned)__builtin_amdgcn_s_getreg((3 << 11) | 20) & 0xFu; }
#define XB_SPIN(cond, bar) do { unsigned _sp = 0; while (cond) { __builtin_amdgcn_s_sleep(1); \
    if ((++_sp & 255u) == 0u) { if (xb_ld(&(bar)[XB_TMO])) break; if (_sp > XB_SPIN_CAP) { atomicAdd(&(bar)[XB_TMO], 1u); break; } } } } while (0)
struct XcdBarrier { unsigned* bar; unsigned x; volatile unsigned* st; };
DI XcdBarrier xcd_barrier_post(unsigned* bar, volatile unsigned* st) {
  XcdBarrier b; b.bar = bar; b.x = xb_xcc_id(); b.st = st;
  if (threadIdx.x == 0) (void)xb_add(&bar[XB_XCNT(b.x)], 1u);
  return b;
}
DI void xcd_barrier_complete(unsigned* bar, unsigned x, unsigned& nloc, unsigned& nx) {
  const unsigned G = gridDim.x;
  unsigned sum, cnt, mine, sp = 0u;
  for (;;) {
    sum = 0u; cnt = 0u; mine = 0u;
#pragma unroll
    for (unsigned j = 0; j < 16; ++j) { const unsigned c = xb_ld(&bar[XB_XCNT(j)]); sum += c; cnt += (c > 0u) ? 1u : 0u; mine = (j == x) ? c : mine; }
    if (sum == G) break;
    __builtin_amdgcn_s_sleep(1);
    if ((++sp & 255u) == 0u) { if (xb_ld(&bar[XB_TMO])) break; if (sp > XB_SPIN_CAP) { atomicAdd(&bar[XB_TMO], 1u); break; } }
  }
  nloc = mine > 0u ? mine : 1u; nx = cnt > 0u ? cnt : 1u;
}
DI void xcd_barrier(const XcdBarrier& b) {
  asm volatile("s_waitcnt vmcnt(0)" ::: "memory");
  __syncthreads();
  if (threadIdx.x == 0) {
    unsigned* bar = b.bar;
    __builtin_amdgcn_s_waitcnt(0);
    unsigned nloc = b.st[0], nx = b.st[1];
    if (nloc == 0u) { xcd_barrier_complete(bar, b.x, nloc, nx); b.st[0] = nloc; b.st[1] = nx; }
    const unsigned old = xb_add(&bar[XB_XSUB(b.x)], 1u);
    const unsigned gen = old / nloc;
    if (old + 1u == (gen + 1u) * nloc) {
      __builtin_amdgcn_fence(__ATOMIC_RELEASE, "agent");
      asm volatile("s_waitcnt vmcnt(0)" ::: "memory");
      const unsigned og = xb_add(&bar[XB_TOP], 1u);
      const unsigned tg = og / nx;
      if (og + 1u == (tg + 1u) * nx) xb_add(&bar[XB_TOPGEN], 1u);
      else XB_SPIN(xb_ld(&bar[XB_TOPGEN]) == tg, bar);
      __builtin_amdgcn_fence(__ATOMIC_ACQUIRE, "agent");
      xb_add(&bar[XB_XGEN(b.x)], 1u);
      asm volatile("s_waitcnt vmcnt(0)" ::: "memory");
    } else {
      XB_SPIN(xb_ld(&bar[XB_XGEN(b.x)]) == gen, bar);
      __builtin_amdgcn_fence(__ATOMIC_ACQUIRE, "agent");
      asm volatile("s_waitcnt vmcnt(0)" ::: "memory");
    }
  }
  __syncthreads();
}

struct Params {
  const float *x, *meta, *norm1_g, *w_in, *wg, *bg, *sb_g, *gla_g, *w_out, *norm2_g, *w_pq, *sk1, *sk2, *eu, *ev, *gf;
  float* out; char* ws;
};
constexpr int SMEM_BYTES = 73728;
constexpr size_t WS_BAR = 0;

__global__ void __launch_bounds__(256, 2) k_fused(Params p) {
  extern __shared__ __attribute__((aligned(16))) char smem_dyn[];
  char* smem = smem_dyn;
  __shared__ unsigned xb_words[4];
  if (threadIdx.x < 4) xb_words[threadIdx.x] = 0u;
  __syncthreads();
  const XcdBarrier bar = xcd_barrier_post((unsigned*)(p.ws + WS_BAR), xb_words);
  const int G = gridDim.x, bid = blockIdx.x;
  char* ws = p.ws;
  bf16_t* WinT = (bf16_t*)(ws + WS_WIN);
  bf16_t* WoutT = (bf16_t*)(ws + WS_WOUT);
  bf16_t* WpqT = (bf16_t*)(ws + WS_WPQ);
  bf16_t* EU = (bf16_t*)(ws + WS_EU);
  bf16_t* EV = (bf16_t*)(ws + WS_EV);
  bf16_t* A1 = (bf16_t*)(ws + WS_A1);
  float* GO = (float*)(ws + WS_A1);
  bf16_t* A2 = (bf16_t*)(ws + WS_A1);
  InProjOut O;
  O.QSB = (bf16_t*)(ws + WS_QSB); O.KSB = (bf16_t*)(ws + WS_KSB); O.VTSB = (bf16_t*)(ws + WS_VTSB);
  O.GQ = (bf16_t*)(ws + WS_GQ); O.GK = (bf16_t*)(ws + WS_GK); O.GV = (bf16_t*)(ws + WS_GV); O.GR = (bf16_t*)(ws + WS_GR);
  O.GLR = (float*)(ws + WS_GLR);
  float* H1 = (float*)(ws + WS_H1);
  float* LG = (float*)(ws + WS_LG);
  bf16_t* MIX = (bf16_t*)(ws + WS_MIX);
  bf16_t* QP = (bf16_t*)(ws + WS_MIX);
  int* EIDX = (int*)(ws + WS_EIDX);
  float* GATE = (float*)(ws + WS_GATE);

  for (int vb = bid; vb < 3200 + 1024 + 1024; vb += G) {
    if (vb < 3200) ph_transpose_w(vb % 100, vb / 100, smem, p.w_in, p.norm1_g, WinT, D, NIN);
    else if (vb < 4224) { const int t = vb - 3200; ph_transpose_w(t % 32, t / 32, smem, p.w_out, nullptr, WoutT, D, D); }
    else { const int t = vb - 4224; ph_transpose_w(t % 32, t / 32, smem, p.w_pq, nullptr, WpqT, D, D); }
  }
  ph_convert(p.eu, EU, (size_t)NEXP * D / 8);
  ph_convert(p.ev, EV, (size_t)NEXP * D / 8);
  ph_zero_pads(O.KSB, O.VTSB, O.GQ, O.GK, O.GV);
  for (int vb = bid; vb < MROWS / 4; vb += G) ph_norm_rows<0>(vb, p.x, p.meta, A1);
  xcd_barrier(bar);
  for (int vb = bid; vb < (MROWS / 128) * 25; vb += G) ph_gemm_inproj(vb, smem, A1, WinT, O);
  xcd_barrier(bar);
  for (int vb = bid; vb < NB * GU; vb += G) ph_lg(vb, O.GLR, p.wg, p.bg, LG);
  for (int vb = bid; vb < 64 * 64; vb += G) ph_sb_attn(vb, O.QSB, O.KSB, O.VTSB, p.sb_g, MIX);
  xcd_barrier(bar);
  for (int vb = bid; vb < 128; vb += G) ph_gla_v1(vb, smem, O.GQ, O.GK, O.GV, LG, GO);
  xcd_barrier(bar);
  for (int vb = bid; vb < TREAL; vb += G) ph_gla_norm(vb, GO, O.GR, p.gla_g, MIX);
  xcd_barrier(bar);
  for (int vb = bid; vb < (TREAL / 128) * 8; vb += G) ph_gemm_out(vb, smem, MIX, WoutT, p.x, H1);
  xcd_barrier(bar);
  for (int vb = bid; vb < TREAL / 4; vb += G) ph_norm_rows<1>(vb, H1, p.norm2_g, A2);
  xcd_barrier(bar);
  for (int vb = bid; vb < (TREAL / 128) * 8; vb += G) ph_gemm_pq(vb, smem, A2, WpqT, QP);
  xcd_barrier(bar);
  for (int vb = bid; vb < 8 * (TREAL / RT_TOK_PER_BLOCK); vb += G) ph_route_v1(vb, smem, QP, p.sk1, p.sk2, EIDX, GATE);
  xcd_barrier(bar);
  for (int vb = bid; vb < TREAL / 4; vb += G) ph_peer_v1(vb, smem, A2, EU, EV, EIDX, GATE, H1, p.gf, p.out);
}

extern "C" void kernel_launch(void* const* d_in, const int* in_sizes, int n_in, void* d_out, int out_size, void* d_ws, size_t ws_size, hipStream_t stream) {
  static int grid = 0;
  if (grid == 0) {
    int dev = 0, cus = 0, per_cu = 0;
    hipGetDevice(&dev);
    hipDeviceGetAttribute(&cus, hipDeviceAttributeMultiprocessorCount, dev);
    hipFuncSetAttribute((const void*)k_fused, hipFuncAttributeMaxDynamicSharedMemorySize, SMEM_BYTES);
    hipOccupancyMaxActiveBlocksPerMultiprocessor(&per_cu, (const void*)k_fused, 256, SMEM_BYTES);
    if (per_cu > 2) per_cu = 2;
    if (per_cu < 1) per_cu = 1;
    grid = cus * per_cu;
  }
  hipMemsetAsync((char*)d_ws + WS_BAR, 0, XCD_BAR_WORDS * 4, stream);
  Params p{};
  p.x = (const float*)d_in[0]; p.meta = (const float*)d_in[1]; p.norm1_g = (const float*)d_in[2]; p.w_in = (const float*)d_in[3];
  p.wg = (const float*)d_in[4]; p.bg = (const float*)d_in[5]; p.sb_g = (const float*)d_in[6]; p.gla_g = (const float*)d_in[7];
  p.w_out = (const float*)d_in[8]; p.norm2_g = (const float*)d_in[9]; p.w_pq = (const float*)d_in[10]; p.sk1 = (const float*)d_in[11];
  p.sk2 = (const float*)d_in[12]; p.eu = (const float*)d_in[13]; p.ev = (const float*)d_in[14]; p.gf = (const float*)d_in[15];
  p.out = (float*)d_out; p.ws = (char*)d_ws;
  void* args[] = {&p};
  hipLaunchCooperativeKernel((const void*)k_fused, dim3(grid), dim3(256), args, SMEM_BYTES, stream);
}
```

```cpp
#include <hip/hip_runtime.h>
#include <stdint.h>
#include <stddef.h>

typedef unsigned short bf16_t;
typedef short bf16x8 __attribute__((ext_vector_type(8)));
typedef float f32x16 __attribute__((ext_vector_type(16)));
typedef float f32x4 __attribute__((ext_vector_type(4)));
typedef float f32x2 __attribute__((ext_vector_type(2)));
typedef unsigned u32x4 __attribute__((ext_vector_type(4)));
typedef unsigned u32x2 __attribute__((ext_vector_type(2)));
typedef __bf16 bf16x2_t __attribute__((ext_vector_type(2)));

#define DI __device__ __forceinline__
#define MFMA32(a, b, c) __builtin_amdgcn_mfma_f32_32x32x16_bf16((a), (b), (c), 0, 0, 0)

constexpr int D = 1024, NB = 8, SEQ = 8192, NMETA = 16;
constexpr int TREAL = NB * SEQ;
constexpr int MROWS = TREAL + 128;
constexpr int NIN = 3088, NINP = 3200;
constexpr int SBH = 8, SBD = 64;
constexpr int GH = 4, GDK = 64, GDV = 128;
constexpr int KIDX = SEQ + 32;
constexpr int GU = SEQ + 64;
constexpr int NEXP = 16384;
constexpr float EPS = 1e-6f;

constexpr size_t MiB = 1u << 20;
constexpr size_t WS_WIN = 1 * MiB;
constexpr size_t WS_WOUT = 8 * MiB;
constexpr size_t WS_WPQ = 10 * MiB;
constexpr size_t WS_SK1 = 12 * MiB;
constexpr size_t WS_SK2 = 13 * MiB;
constexpr size_t WS_EU = 16 * MiB;
constexpr size_t WS_EV = 48 * MiB;
constexpr size_t WS_A1 = 80 * MiB;
constexpr size_t WS_QSB = 210 * MiB;
constexpr size_t WS_KSB = 274 * MiB;
constexpr size_t WS_VTSB = 339 * MiB;
constexpr size_t WS_GQ = 404 * MiB;
constexpr size_t WS_GK = 437 * MiB;
constexpr size_t WS_H1 = 210 * MiB;
constexpr size_t WS_GV = 470 * MiB;
constexpr size_t WS_GR = 535 * MiB;
constexpr size_t WS_GLR = 599 * MiB;
constexpr size_t WS_LG = 604 * MiB;
constexpr size_t WS_MIX = 669 * MiB;
constexpr size_t WS_EIDX = 797 * MiB;
constexpr size_t WS_GATE = 829 * MiB;
constexpr size_t WS_END = 861 * MiB;

DI unsigned f2bf(float f) { unsigned u = __float_as_uint(f); return (u + 0x7fffu + ((u >> 16) & 1u)) >> 16; }
DI float bf2f(unsigned b) { return __uint_as_float(b << 16); }
DI unsigned pk2(float lo, float hi) { f32x2 v = {lo, hi}; return __builtin_bit_cast(unsigned, __builtin_convertvector(v, bf16x2_t)); }
DI float bflo(unsigned u) { return __uint_as_float(u << 16); }
DI float bfhi(unsigned u) { return __uint_as_float(u & 0xffff0000u); }
DI int crow(int reg, int h) { return (reg & 3) + 8 * (reg >> 2) + 4 * h; }
DI float wave_sum(float v) {
#pragma unroll
  for (int o = 32; o >= 1; o >>= 1) v += __shfl_xor(v, o);
  return v;
}
DI float dot2bf(unsigned a, unsigned b, float acc) { return __builtin_amdgcn_fdot2_f32_bf16(__builtin_bit_cast(bf16x2_t, a), __builtin_bit_cast(bf16x2_t, b), acc, false); }
DI float softplus(float z) { return fmaxf(z, 0.f) + __logf(1.f + __expf(-fabsf(z))); }

DI void ph_transpose_w(int bx, int by, char* smem, const float* __restrict__ W, const float* __restrict__ gain, bf16_t* __restrict__ WT, int K, int N) {
  float (*t)[33] = (float (*)[33])smem;
  const int n0 = bx * 32, k0 = by * 32, tx = threadIdx.x & 31, ty = threadIdx.x >> 5;
  for (int r = ty; r < 32; r += 8) {
    const int k = k0 + r, n = n0 + tx;
    float v = 0.f;
    if (n < N) { v = W[(size_t)k * N + n]; if (gain) v *= gain[k]; }
    t[r][tx] = v;
  }
  __syncthreads();
  for (int r = ty; r < 32; r += 8) {
    const int n = n0 + r, k = k0 + tx;
    WT[(size_t)n * K + k] = (bf16_t)f2bf(t[tx][r]);
  }
  __syncthreads();
}
DI void ph_convert(const float* __restrict__ src, bf16_t* __restrict__ dst, size_t n8) {
  size_t i = (size_t)blockIdx.x * blockDim.x + threadIdx.x;
  const size_t stride = (size_t)gridDim.x * blockDim.x;
  for (; i < n8; i += stride) {
    const f32x4 a = ((const f32x4*)src)[2 * i], b = ((const f32x4*)src)[2 * i + 1];
    u32x4 o; o.x = pk2(a.x, a.y); o.y = pk2(a.z, a.w); o.z = pk2(b.x, b.y); o.w = pk2(b.z, b.w);
    ((u32x4*)dst)[i] = o;
  }
}
DI void ph_zero_pads(bf16_t* KSB, bf16_t* VTSB, bf16_t* GQ, bf16_t* GK, bf16_t* GV) {
  const int tid = blockIdx.x * blockDim.x + threadIdx.x, nth = gridDim.x * blockDim.x;
  for (int i = tid; i < 64 * 16 * 64; i += nth) { const int bh = i / 1024, r = i % 1024; KSB[(size_t)bh * KIDX * 64 + r] = 0; }
  for (int i = tid; i < 64 * 64 * 16; i += nth) { const int row = i / 16, c = i % 16; VTSB[(size_t)row * KIDX + c] = 0; }
  for (int i = tid; i < 32 * 48 * 64; i += nth) { const int bh = i / 3072, r = i % 3072; GQ[(size_t)bh * GU * 64 + r] = 0; GK[(size_t)bh * GU * 64 + r] = 0; }
  for (int i = tid; i < 32 * 48 * 128; i += nth) { const int bh = i / 6144, r = i % 6144; GV[(size_t)bh * GU * 128 + r] = 0; }
}

template <int MODE>
DI void ph_norm_rows(int vb, const float* __restrict__ src, const float* __restrict__ meta, bf16_t* __restrict__ dst) {
  const int row = vb * 4 + (threadIdx.x >> 6), lane = threadIdx.x & 63;
  const float* p = nullptr;
  if (MODE == 0) { if (row < TREAL) p = src + (size_t)row * D; else if (row < TREAL + NMETA) p = meta + (size_t)(row - TREAL) * D; }
  else p = src + (size_t)row * D;
  f32x4 v[4];
  float ss = 0.f;
#pragma unroll
  for (int j = 0; j < 4; ++j) {
    v[j] = p ? *(const f32x4*)(p + j * 256 + lane * 4) : (f32x4){0.f, 0.f, 0.f, 0.f};
    ss += v[j].x * v[j].x + v[j].y * v[j].y + v[j].z * v[j].z + v[j].w * v[j].w;
  }
  ss = wave_sum(ss);
  const float r = rsqrtf(ss * (1.0f / D) + EPS);
#pragma unroll
  for (int j = 0; j < 4; ++j) {
    f32x4 gg = {1.f, 1.f, 1.f, 1.f};
    if (MODE == 1) gg = *(const f32x4*)(meta + j * 256 + lane * 4);
    u32x2 o; o.x = pk2(v[j].x * r * gg.x, v[j].y * r * gg.y); o.y = pk2(v[j].z * r * gg.z, v[j].w * r * gg.w);
    *(u32x2*)(dst + (size_t)row * D + j * 256 + lane * 4) = o;
  }
}

constexpr int GBK = 32, GLDS_ROW = 40;
struct GemmLds { bf16_t a[2][128 * GLDS_ROW]; bf16_t b[2][128 * GLDS_ROW]; };

template <bool SWAP>
DI void gemm_tile(const bf16_t* __restrict__ A, const bf16_t* __restrict__ Bt, int K, int m0, int n0, GemmLds& L, f32x16 (&acc)[2][2]) {
  const int tid = threadIdx.x, lane = tid & 63, wave = tid >> 6, wm = wave >> 1, wn = wave & 1;
  const int r = lane & 31, h = lane >> 5;
#pragma unroll
  for (int i = 0; i < 2; ++i)
#pragma unroll
    for (int j = 0; j < 2; ++j)
#pragma unroll
      for (int e = 0; e < 16; ++e) acc[i][j][e] = 0.f;
  const int prow0 = tid >> 2, pc = tid & 3;
  const bf16_t* ga0 = A + (size_t)(m0 + prow0) * K + pc * 8;
  const bf16_t* ga1 = A + (size_t)(m0 + prow0 + 64) * K + pc * 8;
  const bf16_t* gb0 = Bt + (size_t)(n0 + prow0) * K + pc * 8;
  const bf16_t* gb1 = Bt + (size_t)(n0 + prow0 + 64) * K + pc * 8;
  const int lw0 = prow0 * GLDS_ROW + pc * 8, lw1 = (prow0 + 64) * GLDS_ROW + pc * 8;
  u32x4 ra0, ra1, rb0, rb1;
  ra0 = *(const u32x4*)ga0; ra1 = *(const u32x4*)ga1; rb0 = *(const u32x4*)gb0; rb1 = *(const u32x4*)gb1;
  *(u32x4*)&L.a[0][lw0] = ra0; *(u32x4*)&L.a[0][lw1] = ra1; *(u32x4*)&L.b[0][lw0] = rb0; *(u32x4*)&L.b[0][lw1] = rb1;
  __syncthreads();
  const int nk = K / GBK;
  for (int kt = 0; kt < nk; ++kt) {
    const int cur = kt & 1;
    if (kt + 1 < nk) {
      const int ko = (kt + 1) * GBK;
      ra0 = *(const u32x4*)(ga0 + ko); ra1 = *(const u32x4*)(ga1 + ko); rb0 = *(const u32x4*)(gb0 + ko); rb1 = *(const u32x4*)(gb1 + ko);
    }
#pragma unroll
    for (int ks = 0; ks < 2; ++ks) {
      bf16x8 af[2], bfr[2];
#pragma unroll
      for (int i = 0; i < 2; ++i) af[i] = *(const bf16x8*)&L.a[cur][(wm * 64 + i * 32 + r) * GLDS_ROW + ks * 16 + h * 8];
#pragma unroll
      for (int j = 0; j < 2; ++j) bfr[j] = *(const bf16x8*)&L.b[cur][(wn * 64 + j * 32 + r) * GLDS_ROW + ks * 16 + h * 8];
#pragma unroll
      for (int i = 0; i < 2; ++i)
#pragma unroll
        for (int j = 0; j < 2; ++j) {
          if (SWAP) acc[i][j] = MFMA32(bfr[j], af[i], acc[i][j]);
          else acc[i][j] = MFMA32(af[i], bfr[j], acc[i][j]);
        }
    }
    if (kt + 1 < nk) {
      const int nx = cur ^ 1;
      *(u32x4*)&L.a[nx][lw0] = ra0; *(u32x4*)&L.a[nx][lw1] = ra1; *(u32x4*)&L.b[nx][lw0] = rb0; *(u32x4*)&L.b[nx][lw1] = rb1;
    }
    __syncthreads();
  }
}

struct InProjOut { bf16_t *QSB, *KSB, *VTSB, *GQ, *GK, *GV, *GR; float* GLR; };

DI void inproj_store_row4(const InProjOut& O, int m, int n, float v0, float v1, float v2, float v3) {
  const bool real = m < TREAL;
  const int mm = m - TREAL;
  if (!real && mm >= NMETA) return;
  const int b = m >> 13, i = m & 8191;
  u32x2 pk; pk.x = pk2(v0, v1); pk.y = pk2(v2, v3);
  if (n < 512) {
    if (!real) return;
    const int hd = n >> 6, d = n & 63;
    *(u32x2*)(O.QSB + ((size_t)(b * SBH + hd) * SEQ + i) * 64 + d) = pk;
  } else if (n < 1024) {
    const int f = n - 512, hd = f >> 6, d = f & 63;
    if (real) *(u32x2*)(O.KSB + ((size_t)(b * SBH + hd) * KIDX + 32 + i) * 64 + d) = pk;
    else for (int bb = 0; bb < NB; ++bb) *(u32x2*)(O.KSB + ((size_t)(bb * SBH + hd) * KIDX + 16 + mm) * 64 + d) = pk;
  } else if (n < 1536) {
  } else if (n < 1792) {
    const int f = n - 1536, hd = f >> 6, d = f & 63;
    if (real) *(u32x2*)(O.GQ + ((size_t)(b * GH + hd) * GU + 64 + i) * 64 + d) = pk;
    else for (int bb = 0; bb < NB; ++bb) *(u32x2*)(O.GQ + ((size_t)(bb * GH + hd) * GU + 48 + mm) * 64 + d) = pk;
  } else if (n < 2048) {
    const int f = n - 1792, hd = f >> 6, d = f & 63;
    if (real) *(u32x2*)(O.GK + ((size_t)(b * GH + hd) * GU + 64 + i) * 64 + d) = pk;
    else for (int bb = 0; bb < NB; ++bb) *(u32x2*)(O.GK + ((size_t)(bb * GH + hd) * GU + 48 + mm) * 64 + d) = pk;
  } else if (n < 2560) {
    const int f = n - 2048, hd = f >> 7, e = f & 127;
    if (real) *(u32x2*)(O.GV + ((size_t)(b * GH + hd) * GU + 64 + i) * 128 + e) = pk;
    else for (int bb = 0; bb < NB; ++bb) *(u32x2*)(O.GV + ((size_t)(bb * GH + hd) * GU + 48 + mm) * 128 + e) = pk;
  } else if (n < 3072) {
    if (!real) return;
    *(u32x2*)(O.GR + (size_t)m * 512 + (n - 2560)) = pk;
  } else if (n < 3088) {
    const int f = n - 3072;
    const f32x4 v = {v0, v1, v2, v3};
    if (real) *(f32x4*)(O.GLR + ((size_t)b * GU + 64 + i) * 16 + f) = v;
    else for (int bb = 0; bb < NB; ++bb) *(f32x4*)(O.GLR + ((size_t)bb * GU + 48 + mm) * 16 + f) = v;
  }
}

DI void ph_gemm_inproj(int vb, char* smem, const bf16_t* __restrict__ A1, const bf16_t* __restrict__ WinT, const InProjOut& O) {
  GemmLds& L = *(GemmLds*)smem;
  const int nt = vb % 25, mt = vb / 25;
  const int m0 = mt * 128, n0 = nt * 128;
  const int lane = threadIdx.x & 63, wave = threadIdx.x >> 6, wm = wave >> 1, wn = wave & 1, r = lane & 31, h = lane >> 5;
  f32x16 acc[2][2];
  const bool vtile = (nt >= 8 && nt < 12);
  if (vtile) {
    gemm_tile<false>(A1, WinT, D, m0, n0, L, acc);
#pragma unroll
    for (int i = 0; i < 2; ++i)
#pragma unroll
      for (int j = 0; j < 2; ++j) {
        const int n = n0 + wn * 64 + j * 32 + r, f = n - 1024, hd = f >> 6, d = f & 63;
#pragma unroll
        for (int g = 0; g < 4; ++g) {
          const int m = m0 + wm * 64 + i * 32 + 8 * g + 4 * h;
          u32x2 pk; pk.x = pk2(acc[i][j][4 * g], acc[i][j][4 * g + 1]); pk.y = pk2(acc[i][j][4 * g + 2], acc[i][j][4 * g + 3]);
          if (m < TREAL) {
            const int b = m >> 13, ii = m & 8191;
            *(u32x2*)(O.VTSB + ((size_t)(b * SBH + hd) * 64 + d) * KIDX + 32 + ii) = pk;
          } else {
            const int mm = m - TREAL;
            if (mm < NMETA) for (int bb = 0; bb < NB; ++bb) *(u32x2*)(O.VTSB + ((size_t)(bb * SBH + hd) * 64 + d) * KIDX + 16 + mm) = pk;
          }
        }
      }
  } else {
    gemm_tile<true>(A1, WinT, D, m0, n0, L, acc);
#pragma unroll
    for (int i = 0; i < 2; ++i)
#pragma unroll
      for (int j = 0; j < 2; ++j) {
        const int m = m0 + wm * 64 + i * 32 + r;
#pragma unroll
        for (int g = 0; g < 4; ++g) {
          const int n = n0 + wn * 64 + j * 32 + 8 * g + 4 * h;
          inproj_store_row4(O, m, n, acc[i][j][4 * g], acc[i][j][4 * g + 1], acc[i][j][4 * g + 2], acc[i][j][4 * g + 3]);
        }
      }
  }
}

DI void ph_gemm_out(int vb, char* smem, const bf16_t* __restrict__ MIX, const bf16_t* __restrict__ WoutT, const float* __restrict__ x, float* __restrict__ H1) {
  GemmLds& L = *(GemmLds*)smem;
  const int nt = vb % 8, mt = vb / 8;
  const int m0 = mt * 128, n0 = nt * 128;
  const int lane = threadIdx.x & 63, wave = threadIdx.x >> 6, wm = wave >> 1, wn = wave & 1, r = lane & 31, h = lane >> 5;
  f32x16 acc[2][2];
  gemm_tile<false>(MIX, WoutT, D, m0, n0, L, acc);
#pragma unroll
  for (int i = 0; i < 2; ++i)
#pragma unroll
    for (int j = 0; j < 2; ++j) {
      const int n = n0 + wn * 64 + j * 32 + r;
#pragma unroll
      for (int e = 0; e < 16; ++e) {
        const int m = m0 + wm * 64 + i * 32 + crow(e, h);
        const size_t idx = (size_t)m * D + n;
        H1[idx] = x[idx] + acc[i][j][e];
      }
    }
}

DI void ph_gemm_pq(int vb, char* smem, const bf16_t* __restrict__ A2, const bf16_t* __restrict__ WpqT, bf16_t* __restrict__ QP) {
  GemmLds& L = *(GemmLds*)smem;
  const int nt = vb % 8, mt = vb / 8;
  const int m0 = mt * 128, n0 = nt * 128;
  const int lane = threadIdx.x & 63, wave = threadIdx.x >> 6, wm = wave >> 1, wn = wave & 1, r = lane & 31, h = lane >> 5;
  f32x16 acc[2][2];
  gemm_tile<true>(A2, WpqT, D, m0, n0, L, acc);
#pragma unroll
  for (int i = 0; i < 2; ++i)
#pragma unroll
    for (int j = 0; j < 2; ++j) {
      const int m = m0 + wm * 64 + i * 32 + r;
#pragma unroll
      for (int g = 0; g < 4; ++g) {
        const int n = n0 + wn * 64 + j * 32 + 8 * g + 4 * h;
        u32x2 pk; pk.x = pk2(acc[i][j][4 * g], acc[i][j][4 * g + 1]); pk.y = pk2(acc[i][j][4 * g + 2], acc[i][j][4 * g + 3]);
        *(u32x2*)(QP + (size_t)m * D + n) = pk;
      }
    }
}

constexpr float SB_THR = -90.f;
DI void ph_sb_attn(int vb, const bf16_t* __restrict__ QSB, const bf16_t* __restrict__ KSB, const bf16_t* __restrict__ VTSB,
                                                 const float* __restrict__ sb_g, bf16_t* __restrict__ MIX) {
  const int lane = threadIdx.x & 63, wave = threadIdx.x >> 6, r = lane & 31, h = lane >> 5;
  const int bh = vb >> 6, qb = vb & 63;
  const int b = bh >> 3, hd = bh & 7;
  const int i0 = qb * 128 + wave * 32;
  const bf16_t* Qb = QSB + ((size_t)bh * SEQ + i0) * 64;
  const bf16_t* Kb = KSB + (size_t)bh * KIDX * 64;
  const bf16_t* Vb = VTSB + (size_t)bh * 64 * KIDX;
  bf16x8 qf[4];
#pragma unroll
  for (int ks = 0; ks < 4; ++ks) qf[ks] = *(const bf16x8*)(Qb + r * 64 + ks * 16 + h * 8);
  f32x16 o[2];
#pragma unroll
  for (int e = 0; e < 16; ++e) { o[0][e] = 0.f; o[1][e] = 0.f; }
  float R = 0.f;
  const int qidx = 32 + i0 + r;
  for (int c = (i0 >> 5) + 1; c >= 0; --c) {
    const int k0 = 32 * c;
    bf16x8 kf[4];
#pragma unroll
    for (int ks = 0; ks < 4; ++ks) kf[ks] = *(const bf16x8*)(Kb + (size_t)(k0 + r) * 64 + ks * 16 + h * 8);
    bf16x8 vf[2][2];
#pragma unroll
    for (int mt = 0; mt < 2; ++mt)
#pragma unroll
      for (int s2 = 0; s2 < 2; ++s2) {
        const bf16_t* vp = Vb + (size_t)(mt * 32 + r) * KIDX + k0 + 16 * s2 + 4 * h;
        const u32x2 lo = *(const u32x2*)vp, hi = *(const u32x2*)(vp + 8);
        u32x4 t; t.x = lo.x; t.y = lo.y; t.z = hi.x; t.w = hi.y;
        vf[mt][s2] = __builtin_bit_cast(bf16x8, t);
      }
    f32x16 s;
#pragma unroll
    for (int e = 0; e < 16; ++e) s[e] = 0.f;
#pragma unroll
    for (int ks = 0; ks < 4; ++ks) s = MFMA32(kf[ks], qf[ks], s);
    float l1m[16], lb[16];
    bool valid[16];
#pragma unroll
    for (int e = 0; e < 16; ++e) {
      const int kidx = k0 + crow(e, h);
      valid[e] = (kidx < qidx) && (kidx >= 16);
      const float z = s[e] * 0.125f;
      const float sp = softplus(z);
      l1m[e] = valid[e] ? -sp : 0.f;
      lb[e] = z - sp;
    }
    float sfx[16], G[4], PG[4];
#pragma unroll
    for (int g = 0; g < 4; ++g) {
      sfx[4 * g + 3] = 0.f;
      sfx[4 * g + 2] = l1m[4 * g + 3];
      sfx[4 * g + 1] = sfx[4 * g + 2] + l1m[4 * g + 2];
      sfx[4 * g + 0] = sfx[4 * g + 1] + l1m[4 * g + 1];
      G[g] = sfx[4 * g + 0] + l1m[4 * g + 0];
      PG[g] = __shfl_xor(G[g], 32);
    }
    float HS[4];
    HS[3] = 0.f;
    HS[2] = G[3] + PG[3];
    HS[1] = HS[2] + G[2] + PG[2];
    HS[0] = HS[1] + G[1] + PG[1];
    const float total = HS[0] + G[0] + PG[0];
    float a[16];
#pragma unroll
    for (int e = 0; e < 16; ++e) {
      const int g = e >> 2;
      const float between = sfx[e] + (h == 0 ? PG[g] : 0.f) + HS[g] + R;
      a[e] = valid[e] ? __expf(lb[e] + between) : 0.f;
    }
    R += total;
#pragma unroll
    for (int s2 = 0; s2 < 2; ++s2) {
      u32x4 p;
      p.x = pk2(a[8 * s2 + 0], a[8 * s2 + 1]); p.y = pk2(a[8 * s2 + 2], a[8 * s2 + 3]);
      p.z = pk2(a[8 * s2 + 4], a[8 * s2 + 5]); p.w = pk2(a[8 * s2 + 6], a[8 * s2 + 7]);
      const bf16x8 pf = __builtin_bit_cast(bf16x8, p);
      o[0] = MFMA32(vf[0][s2], pf, o[0]);
      o[1] = MFMA32(vf[1][s2], pf, o[1]);
    }
    if (__all(R < SB_THR)) break;
  }
  float ss = 0.f;
#pragma unroll
  for (int e = 0; e < 16; ++e) ss += o[0][e] * o[0][e] + o[1][e] * o[1][e];
  ss += __shfl_xor(ss, 32);
  const float sc = rsqrtf(ss * (1.0f / 64.0f) + EPS);
  bf16_t* outp = MIX + (size_t)(b * SEQ + i0 + r) * D + hd * 64;
#pragma unroll
  for (int mt = 0; mt < 2; ++mt)
#pragma unroll
    for (int g = 0; g < 4; ++g) {
      const int d = mt * 32 + 8 * g + 4 * h;
      const f32x4 gg = *(const f32x4*)(sb_g + hd * 64 + d);
      u32x2 pk;
      pk.x = pk2(o[mt][4 * g] * sc * gg.x, o[mt][4 * g + 1] * sc * gg.y);
      pk.y = pk2(o[mt][4 * g + 2] * sc * gg.z, o[mt][4 * g + 3] * sc * gg.w);
      *(u32x2*)(outp + d) = pk;
    }
}

DI void ph_lg(int bu, const float* __restrict__ GLR, const float* __restrict__ wg, const float* __restrict__ bg, float* __restrict__ LG) {
  const int c = threadIdx.x;
  const int b = bu / GU, u = bu % GU;
  float val = 0.f;
  if (u >= 48) {
    float acc = bg[c];
    const float* g = GLR + (size_t)bu * 16;
#pragma unroll
    for (int k = 0; k < 16; ++k) acc += g[k] * wg[k * 256 + c];
    val = -softplus(-acc) * (1.0f / 16.0f);
  }
  const int hd = c >> 6, d = c & 63;
  LG[((size_t)(b * GH + hd) * GU + u) * 64 + d] = val;
}

DI void ph_gla_v1(int vb, char* smem, const bf16_t* __restrict__ GQ, const bf16_t* __restrict__ GK, const bf16_t* __restrict__ GV,
                                                const float* __restrict__ LG, float* __restrict__ GO) {
  float (*qs)[68] = (float (*)[68])smem;
  float (*ks)[68] = (float (*)[68])(smem + 17408);
  float (*bc)[68] = (float (*)[68])(smem + 2 * 17408);
  float (*at)[68] = bc;
  float (*vs)[36] = (float (*)[36])(smem + 3 * 17408);
  float (*Ss)[36] = (float (*)[36])(smem + 3 * 17408 + 9216);
  float* decs = (float*)(smem + 3 * 17408 + 2 * 9216);
  const int tid = threadIdx.x;
  const int bh = vb >> 2, es = vb & 3, b = bh >> 2, hd = bh & 3;
  const bf16_t* gq = GQ + (size_t)bh * GU * 64;
  const bf16_t* gk = GK + (size_t)bh * GU * 64;
  const bf16_t* gv = GV + (size_t)bh * GU * 128 + es * 32;
  const float* lg = LG + (size_t)bh * GU * 64;
  const int sd = tid >> 2, eg = tid & 3;
  float S[8];
#pragma unroll
  for (int j = 0; j < 8; ++j) S[j] = 0.f;
  for (int c = 0; c < 129; ++c) {
    const int u0 = c * 64;
#pragma unroll 2
    for (int idx = tid; idx < 4096; idx += 256) {
      const int t = idx >> 6, d = idx & 63;
      qs[t][d] = bf2f(gq[(size_t)(u0 + t) * 64 + d]);
      ks[t][d] = bf2f(gk[(size_t)(u0 + t) * 64 + d]);
      bc[t][d] = lg[(size_t)(u0 + t) * 64 + d];
    }
    for (int idx = tid; idx < 2048; idx += 256) {
      const int t = idx >> 5, e = idx & 31;
      vs[t][e] = bf2f(gv[(size_t)(u0 + t) * 128 + e]);
    }
#pragma unroll
    for (int j = 0; j < 8; ++j) Ss[sd][eg * 8 + j] = S[j];
    __syncthreads();
    if (tid < 64) { float run = 0.f;
#pragma unroll 4
      for (int t = 0; t < 64; ++t) { run += bc[t][tid]; bc[t][tid] = run; } }
    __syncthreads();
#pragma unroll 2
    for (int idx = tid; idx < 4096; idx += 256) {
      const int t = idx >> 6, d = idx & 63;
      const float bv = bc[t][d];
      qs[t][d] *= __expf(bv) * 0.125f;
      ks[t][d] *= __expf(-bv);
    }
    if (tid < 64) decs[tid] = __expf(bc[63][tid]);
    __syncthreads();
    {
      const int ti = tid >> 4, si = tid & 15;
      float acc[4][4];
#pragma unroll
      for (int a = 0; a < 4; ++a)
#pragma unroll
        for (int bb = 0; bb < 4; ++bb) acc[a][bb] = 0.f;
#pragma unroll 1
      for (int d = 0; d < 64; d += 4) {
        f32x4 q4[4], k4[4];
#pragma unroll
        for (int a = 0; a < 4; ++a) q4[a] = *(const f32x4*)&qs[ti + 16 * a][d];
#pragma unroll
        for (int bb = 0; bb < 4; ++bb) k4[bb] = *(const f32x4*)&ks[si + 16 * bb][d];
#pragma unroll
        for (int a = 0; a < 4; ++a)
#pragma unroll
          for (int bb = 0; bb < 4; ++bb)
            acc[a][bb] += q4[a].x * k4[bb].x + q4[a].y * k4[bb].y + q4[a].z * k4[bb].z + q4[a].w * k4[bb].w;
      }
#pragma unroll
      for (int a = 0; a < 4; ++a)
#pragma unroll
        for (int bb = 0; bb < 4; ++bb) {
          const int t = ti + 16 * a, s = si + 16 * bb;
          at[t][s] = (s <= t) ? acc[a][bb] : 0.f;
        }
    }
    __syncthreads();
    {
      const int t = sd;
      float o[8];
#pragma unroll
      for (int j = 0; j < 8; ++j) o[j] = 0.f;
#pragma unroll 2
      for (int d = 0; d < 64; ++d) {
        const float qv = qs[t][d];
        const f32x4 s0 = *(const f32x4*)&Ss[d][eg * 8], s1 = *(const f32x4*)&Ss[d][eg * 8 + 4];
        o[0] += qv * s0.x; o[1] += qv * s0.y; o[2] += qv * s0.z; o[3] += qv * s0.w;
        o[4] += qv * s1.x; o[5] += qv * s1.y; o[6] += qv * s1.z; o[7] += qv * s1.w;
      }
#pragma unroll 2
      for (int s = 0; s < 64; ++s) {
        const float av = at[t][s];
        const f32x4 v0 = *(const f32x4*)&vs[s][eg * 8], v1 = *(const f32x4*)&vs[s][eg * 8 + 4];
        o[0] += av * v0.x; o[1] += av * v0.y; o[2] += av * v0.z; o[3] += av * v0.w;
        o[4] += av * v1.x; o[5] += av * v1.y; o[6] += av * v1.z; o[7] += av * v1.w;
      }
      if (c >= 1) {
        float* op = GO + ((size_t)(b * SEQ + (c - 1) * 64 + t)) * 512 + hd * 128 + es * 32 + eg * 8;
        *(f32x4*)op = (f32x4){o[0], o[1], o[2], o[3]};
        *(f32x4*)(op + 4) = (f32x4){o[4], o[5], o[6], o[7]};
      }
    }
    {
      float n[8];
#pragma unroll
      for (int j = 0; j < 8; ++j) n[j] = S[j];
#pragma unroll 2
      for (int s = 0; s < 64; ++s) {
        const float kv = ks[s][sd];
        const f32x4 v0 = *(const f32x4*)&vs[s][eg * 8], v1 = *(const f32x4*)&vs[s][eg * 8 + 4];
        n[0] += kv * v0.x; n[1] += kv * v0.y; n[2] += kv * v0.z; n[3] += kv * v0.w;
        n[4] += kv * v1.x; n[5] += kv * v1.y; n[6] += kv * v1.z; n[7] += kv * v1.w;
      }
      const float dec = decs[sd];
#pragma unroll
      for (int j = 0; j < 8; ++j) S[j] = dec * n[j];
    }
    __syncthreads();
  }
}

DI void ph_gla_norm(int m, const float* __restrict__ GO, const bf16_t* __restrict__ GR, const float* __restrict__ gla_g, bf16_t* __restrict__ MIX) {
  const int hd = threadIdx.x >> 6, lane = threadIdx.x & 63;
  const f32x2 v = *(const f32x2*)(GO + (size_t)m * 512 + hd * 128 + lane * 2);
  float ss = wave_sum(v.x * v.x + v.y * v.y);
  const float sc = rsqrtf(ss * (1.0f / 128.0f) + EPS);
  const unsigned g2 = *(const unsigned*)(GR + (size_t)m * 512 + hd * 128 + lane * 2);
  const float g0 = bflo(g2), g1 = bfhi(g2);
  const f32x2 gn = *(const f32x2*)(gla_g + hd * 128 + lane * 2);
  const float s0 = g0 / (1.f + __expf(-g0)), s1 = g1 / (1.f + __expf(-g1));
  *(unsigned*)(MIX + (size_t)m * D + 512 + hd * 128 + lane * 2) = pk2(v.x * sc * gn.x * s0, v.y * sc * gn.y * s1);
}

DI bool better(float v1, int i1, float v2, int i2) { return (v1 > v2) || (v1 == v2 && i1 < i2); }
DI void wave_argmax(float& v, int& i) {
#pragma unroll
  for (int o = 32; o >= 1; o >>= 1) {
    const float ov = __shfl_xor(v, o);
    const int oi = __shfl_xor(i, o);
    if (better(ov, oi, v, i)) { v = ov; i = oi; }
  }
}
constexpr int RT_TOK_PER_BLOCK = 256;
DI void ph_route_v1(int vb, char* smem, const bf16_t* __restrict__ QP, const float* __restrict__ sk1, const float* __restrict__ sk2,
                                                  int* __restrict__ EIDX, float* __restrict__ GATE) {
  float (*K1)[68] = (float (*)[68])smem;
  float (*K2)[68] = (float (*)[68])(smem + 34816);
  float (*qsh)[128] = (float (*)[128])(smem + 2 * 34816);
  const int hd = vb & 7, tg = vb >> 3;
  const int tid = threadIdx.x, lane = tid & 63, wave = tid >> 6;
  for (int idx = tid; idx < 128 * 64; idx += 256) {
    const int k = idx >> 6, d = idx & 63;
    K1[k][d] = sk1[((size_t)hd * 128 + k) * 64 + d];
    K2[k][d] = sk2[((size_t)hd * 128 + k) * 64 + d];
  }
  __syncthreads();
  const float NEG = -3.0e38f;
  for (int it = 0; it < RT_TOK_PER_BLOCK / 4; ++it) {
    const int m = tg * RT_TOK_PER_BLOCK + it * 4 + wave;
    {
      const unsigned q2 = *(const unsigned*)(QP + (size_t)m * D + hd * 128 + lane * 2);
      qsh[wave][lane * 2] = bflo(q2); qsh[wave][lane * 2 + 1] = bfhi(q2);
    }
    __builtin_amdgcn_wave_barrier();
    float s1a = 0.f, s1b = 0.f, s2a = 0.f, s2b = 0.f;
#pragma unroll 4
    for (int d = 0; d < 64; d += 4) {
      const f32x4 q1 = *(const f32x4*)&qsh[wave][d], q2 = *(const f32x4*)&qsh[wave][64 + d];
      const f32x4 a = *(const f32x4*)&K1[lane][d], bb = *(const f32x4*)&K1[lane + 64][d];
      const f32x4 c = *(const f32x4*)&K2[lane][d], dd = *(const f32x4*)&K2[lane + 64][d];
      s1a += q1.x * a.x + q1.y * a.y + q1.z * a.z + q1.w * a.w;
      s1b += q1.x * bb.x + q1.y * bb.y + q1.z * bb.z + q1.w * bb.w;
      s2a += q2.x * c.x + q2.y * c.y + q2.z * c.z + q2.w * c.w;
      s2b += q2.x * dd.x + q2.y * dd.y + q2.z * dd.z + q2.w * dd.w;
    }
    __builtin_amdgcn_wave_barrier();
    float tv1 = 0.f, tv2 = 0.f; int ti1 = 0, ti2 = 0;
    for (int rr = 0; rr < 16; ++rr) {
      float v; int i;
      if (better(s1a, lane, s1b, lane + 64)) { v = s1a; i = lane; } else { v = s1b; i = lane + 64; }
      wave_argmax(v, i);
      if (lane == rr) { tv1 = v; ti1 = i; }
      if (i == lane) s1a = NEG;
      if (i == lane + 64) s1b = NEG;
      if (better(s2a, lane, s2b, lane + 64)) { v = s2a; i = lane; } else { v = s2b; i = lane + 64; }
      wave_argmax(v, i);
      if (lane == rr) { tv2 = v; ti2 = i; }
      if (i == lane) s2a = NEG;
      if (i == lane + 64) s2b = NEG;
    }
    const int ca = lane >> 2;
    const float va = __shfl(tv1, ca); const int ia = __shfl(ti1, ca);
    float cv[4]; int ce[4];
#pragma unroll
    for (int j = 0; j < 4; ++j) {
      const int cb = (lane & 3) * 4 + j;
      cv[j] = va + __shfl(tv2, cb);
      ce[j] = ia * 128 + __shfl(ti2, cb);
    }
    float fsc = 0.f; int fe = 0;
    for (int rr = 0; rr < 16; ++rr) {
      float v = cv[0]; int p = lane * 4;
#pragma unroll
      for (int j = 1; j < 4; ++j) if (better(cv[j], lane * 4 + j, v, p)) { v = cv[j]; p = lane * 4 + j; }
      wave_argmax(v, p);
      const int src = p >> 2, jj = p & 3;
      int e = (jj == 0) ? ce[0] : (jj == 1) ? ce[1] : (jj == 2) ? ce[2] : ce[3];
      e = __shfl(e, src);
      if (lane == rr) { fsc = v; fe = e; }
      if (lane == src) {
        if (jj == 0) cv[0] = NEG; else if (jj == 1) cv[1] = NEG; else if (jj == 2) cv[2] = NEG; else cv[3] = NEG;
      }
    }
    const float mx = __shfl(fsc, 0);
    float ex = (lane < 16) ? __expf(fsc - mx) : 0.f;
    const float sum = wave_sum(ex);
    if (lane < 16) {
      EIDX[(size_t)m * 128 + hd * 16 + lane] = fe;
      GATE[(size_t)m * 128 + hd * 16 + lane] = ex / sum;
    }
  }
  __syncthreads();
}


DI void ce_desc(float& a, float& b) {
  float hi, lo;
  asm("v_max_f32 %0, %1, %2" : "=v"(hi) : "v"(a), "v"(b));
  asm("v_min_f32 %0, %1, %2" : "=v"(lo) : "v"(a), "v"(b));
  a = hi; b = lo;
}
DI float vmaxf(float a, float b) { float hi; asm("v_max_f32 %0, %1, %2" : "=v"(hi) : "v"(a), "v"(b)); return hi; }
template <int N> DI void bitonic_sort_desc(float (&v)[N]) {
#pragma unroll
  for (int k = 2; k <= N; k <<= 1) {
#pragma unroll
    for (int j = k >> 1; j > 0; j >>= 1) {
#pragma unroll
      for (int i = 0; i < N; ++i) {
        const int l = i ^ j;
        if (l > i) { if ((i & k) == 0) ce_desc(v[i], v[l]); else ce_desc(v[l], v[i]); }
      }
    }
  }
}
DI void bitonic_merge16_desc(float (&v)[16]) {
#pragma unroll
  for (int j = 8; j > 0; j >>= 1) {
#pragma unroll
    for (int i = 0; i < 16; ++i) { const int l = i ^ j; if (l > i) ce_desc(v[i], v[l]); }
  }
}
template <int NBV> DI void merge_prune16(float (&a)[16], const float (&b)[16]) {
#pragma unroll
  for (int i = 16 - NBV; i < 16; ++i) a[i] = vmaxf(a[i], b[15 - i]);
  bitonic_merge16_desc(a);
}
DI float selh(int hh, float a, float b) { asm volatile("" : "+v"(a), "+v"(b)); return hh == 0 ? a : b; }
DI float pack_idx(float v, unsigned idx, unsigned mask) { return __uint_as_float((__float_as_uint(v) & ~mask) | idx); }

DI void ph_route_v2(int vb, char* smem, const bf16_t* __restrict__ QP, const bf16_t* __restrict__ SK1b, const bf16_t* __restrict__ SK2b,
                    int* __restrict__ EIDX, float* __restrict__ GATE) {
  const int lane = threadIdx.x & 63, wave = threadIdx.x >> 6, r = lane & 31, hh = lane >> 5;
  const int hd = vb & 7, tile = vb >> 3;
  const int m = tile * 128 + wave * 32 + r;
  float loc[2][16];
#pragma unroll
  for (int L = 0; L < 2; ++L) {
    const bf16_t* qp = QP + (size_t)m * D + hd * 128 + L * 64 + hh * 8;
    const bf16_t* kb = (L == 0 ? SK1b : SK2b) + (size_t)(hd * 128 + r) * 64 + hh * 8;
    bf16x8 qf[4];
#pragma unroll
    for (int ks = 0; ks < 4; ++ks) qf[ks] = *(const bf16x8*)(qp + ks * 16);
    float grp[4][16];
#pragma unroll
    for (int mt = 0; mt < 4; ++mt) {
      f32x16 acc;
#pragma unroll
      for (int e = 0; e < 16; ++e) acc[e] = 0.f;
#pragma unroll
      for (int ks = 0; ks < 4; ++ks) {
        const bf16x8 kf = *(const bf16x8*)(kb + (size_t)mt * 32 * 64 + ks * 16);
        acc = MFMA32(kf, qf[ks], acc);
      }
#pragma unroll
      for (int e = 0; e < 16; ++e) grp[mt][e] = pack_idx(acc[e], (unsigned)(mt * 32 + crow(e, hh)), 127u);
      bitonic_sort_desc<16>(grp[mt]);
    }
    merge_prune16<16>(grp[0], grp[1]);
    merge_prune16<16>(grp[2], grp[3]);
    merge_prune16<16>(grp[0], grp[2]);
#pragma unroll
    for (int i = 0; i < 16; ++i) loc[L][i] = grp[0][i];
  }
  float fin[16], oth[16];
#pragma unroll
  for (int i = 0; i < 16; ++i) {
    const float send = selh(hh, loc[1][i], loc[0][i]);
    oth[i] = __shfl_xor(send, 32);
    fin[i] = selh(hh, loc[0][i], loc[1][i]);
  }
  merge_prune16<16>(fin, oth);
  float v1[16], v2[16];
#pragma unroll
  for (int i = 0; i < 16; ++i) {
    const float o = __shfl_xor(fin[i], 32);
    v1[i] = selh(hh, fin[i], o);
    v2[i] = selh(hh, o, fin[i]);
  }
  unsigned* ib = (unsigned*)smem + (size_t)threadIdx.x * 8;
#pragma unroll
  for (int q = 0; q < 4; ++q) {
    unsigned w1 = 0, w2 = 0;
#pragma unroll
    for (int j = 0; j < 4; ++j) {
      w1 |= (__float_as_uint(v1[4 * q + j]) & 127u) << (8 * j);
      w2 |= (__float_as_uint(v2[4 * q + j]) & 127u) << (8 * j);
    }
    ib[q] = w1; ib[4 + q] = w2;
  }
  float R[16], Bv[16];
#pragma unroll
  for (int j = 0; j < 16; ++j) R[j] = pack_idx(v1[0] + v2[j], (unsigned)j, 255u);
#define ROUTE_ROW(I, CNT) { _Pragma("unroll") for (int j = 0; j < 16; ++j) Bv[j] = (j < CNT) ? pack_idx(v1[I] + v2[j < CNT ? j : 0], (unsigned)(I * 16 + j), 255u) : 0.f; \
    merge_prune16<CNT>(R, Bv); }
  ROUTE_ROW(1, 8) ROUTE_ROW(2, 5) ROUTE_ROW(3, 4) ROUTE_ROW(4, 3) ROUTE_ROW(5, 2) ROUTE_ROW(6, 2) ROUTE_ROW(7, 2)
#undef ROUTE_ROW
#pragma unroll
  for (int j = 0; j < 16; ++j) Bv[j] = (j < 8) ? pack_idx(v1[8 + (j < 8 ? j : 0)] + v2[0], (unsigned)((8 + j) * 16), 255u) : 0.f;
  merge_prune16<8>(R, Bv);
  float ex[16], sum = 0.f;
#pragma unroll
  for (int i = 0; i < 16; ++i) { ex[i] = __expf(R[i] - R[0]); sum += ex[i]; }
  const float inv = 1.f / sum;
  const unsigned char* ibb = (const unsigned char*)ib;
  int eo[8]; float go[8];
#pragma unroll
  for (int w = 0; w < 8; ++w) {
    const float rv = selh(hh, R[w], R[8 + w]);
    const float ev = selh(hh, ex[w], ex[8 + w]);
    const unsigned pos = __float_as_uint(rv) & 255u;
    const unsigned i1 = ibb[pos >> 4], i2 = ibb[16 + (pos & 15u)];
    eo[w] = (int)(i1 * 128u + i2);
    go[w] = ev * inv;
  }
  int* ep = EIDX + (size_t)m * 128 + hd * 16 + hh * 8;
  float* gp = GATE + (size_t)m * 128 + hd * 16 + hh * 8;
  *(int4*)ep = make_int4(eo[0], eo[1], eo[2], eo[3]);
  *(int4*)(ep + 4) = make_int4(eo[4], eo[5], eo[6], eo[7]);
  *(f32x4*)gp = (f32x4){go[0], go[1], go[2], go[3]};
  *(f32x4*)(gp + 4) = (f32x4){go[4], go[5], go[6], go[7]};
}

DI void ph_peer_v1(int vb, char* smem, const bf16_t* __restrict__ A2, const bf16_t* __restrict__ EU, const bf16_t* __restrict__ EV,
                                                 const int* __restrict__ EIDX, const float* __restrict__ GATE, const float* __restrict__ H1,
                                                 const float* __restrict__ gf, float* __restrict__ out) {
  float (*cs)[128] = (float (*)[128])smem;
  int (*es)[128] = (int (*)[128])(smem + 2048);
  const int lane = threadIdx.x & 63, wave = threadIdx.x >> 6;
  const int m = vb * 4 + wave;
  const int g = lane >> 3, sub = lane & 7;
  u32x4 xf[16];
#pragma unroll
  for (int j = 0; j < 16; ++j) xf[j] = *(const u32x4*)(A2 + (size_t)m * D + (j * 8 + sub) * 8);
  for (int bt = 0; bt < 16; ++bt) {
    const int k = bt * 8 + g;
    const int e = EIDX[(size_t)m * 128 + k];
    const bf16_t* up = EU + (size_t)e * D + sub * 8;
    float acc = 0.f;
#pragma unroll
    for (int j = 0; j < 16; ++j) {
      const u32x4 u = *(const u32x4*)(up + j * 64);
      acc = dot2bf(u.x, xf[j].x, acc); acc = dot2bf(u.y, xf[j].y, acc); acc = dot2bf(u.z, xf[j].z, acc); acc = dot2bf(u.w, xf[j].w, acc);
    }
    acc += __shfl_xor(acc, 1); acc += __shfl_xor(acc, 2); acc += __shfl_xor(acc, 4);
    if (sub == 0) {
      const float act = 0.5f * acc * (1.f + erff(acc * 0.70710678118654752f));
      cs[wave][k] = GATE[(size_t)m * 128 + k] * act;
      es[wave][k] = e;
    }
  }
  __builtin_amdgcn_wave_barrier();
  __syncthreads();
  float y[16];
#pragma unroll
  for (int j = 0; j < 16; ++j) y[j] = 0.f;
#pragma unroll 4
  for (int k = 0; k < 128; ++k) {
    const float c = cs[wave][k];
    const bf16_t* vp = EV + (size_t)es[wave][k] * D + lane * 8;
    const u32x4 v0 = *(const u32x4*)vp, v1 = *(const u32x4*)(vp + 512);
    y[0] += c * bflo(v0.x); y[1] += c * bfhi(v0.x); y[2] += c * bflo(v0.y); y[3] += c * bfhi(v0.y);
    y[4] += c * bflo(v0.z); y[5] += c * bfhi(v0.z); y[6] += c * bflo(v0.w); y[7] += c * bfhi(v0.w);
    y[8] += c * bflo(v1.x); y[9] += c * bfhi(v1.x); y[10] += c * bflo(v1.y); y[11] += c * bfhi(v1.y);
    y[12] += c * bflo(v1.z); y[13] += c * bfhi(v1.z); y[14] += c * bflo(v1.w); y[15] += c * bfhi(v1.w);
  }
  const float* hp = H1 + (size_t)m * D + lane * 8;
  float ss = 0.f;
#pragma unroll
  for (int q = 0; q < 4; ++q) {
    const f32x4 hv = *(const f32x4*)(hp + (q >> 1) * 512 + (q & 1) * 4);
    y[q * 4 + 0] += hv.x; y[q * 4 + 1] += hv.y; y[q * 4 + 2] += hv.z; y[q * 4 + 3] += hv.w;
  }
#pragma unroll
  for (int j = 0; j < 16; ++j) ss += y[j] * y[j];
  ss = wave_sum(ss);
  const float sc = rsqrtf(ss * (1.0f / D) + EPS);
  float* op = out + (size_t)m * D + lane * 8;
#pragma unroll
  for (int q = 0; q < 4; ++q) {
    const int off = (q >> 1) * 512 + (q & 1) * 4;
    const f32x4 gg = *(const f32x4*)(gf + lane * 8 + off);
    *(f32x4*)(op + off) = (f32x4){y[q * 4 + 0] * sc * gg.x, y[q * 4 + 1] * sc * gg.y, y[q * 4 + 2] * sc * gg.z, y[q * 4 + 3] * sc * gg.w};
  }
}


#define XB_TMO      128
#define XB_XCNT(j)  (256  + 64 * (j))
#define XB_XSUB(j)  (1280 + 64 * (j))
#define XB_XGEN(j)  (2304 + 64 * (j))
#define XB_TOP      3328
#define XB_TOPGEN   3392
#define XCD_BAR_WORDS 3456
#define XB_SPIN_CAP (1u << 20)
#define LAS __attribute__((address_space(3)))
DI unsigned xb_ld(unsigned* p)              { return __hip_atomic_load(p, __ATOMIC_RELAXED, __HIP_MEMORY_SCOPE_AGENT); }
DI unsigned xb_add(unsigned* p, unsigned v) { return __hip_atomic_fetch_add(p, v, __ATOMIC_RELAXED, __HIP_MEMORY_SCOPE_AGENT); }
DI unsigned xb_xcc_id() { return (unsigned)__builtin_amdgcn_s_getreg((3 << 11) | 20) & 0xFu; }
#define XB_SPIN(cond, bar) do { unsigned _sp = 0; while (cond) { __builtin_amdgcn_s_sleep(1); \
    if ((++_sp & 255u) == 0u) { if (xb_ld(&(bar)[XB_TMO])) break; if (_sp > XB_SPIN_CAP) { atomicAdd(&(bar)[XB_TMO], 1u); break; } } } } while (0)
struct XcdBarrier { unsigned* bar; unsigned x; volatile unsigned* st; };
DI XcdBarrier xcd_barrier_post(unsigned* bar, volatile unsigned* st) {
  XcdBarrier b; b.bar = bar; b.x = xb_xcc_id(); b.st = st;
  if (threadIdx.x == 0) (void)xb_add(&bar[XB_XCNT(b.x)], 1u);
  return b;
}
DI void xcd_barrier_complete(unsigned* bar, unsigned x, unsigned& nloc, unsigned& nx) {
  const unsigned G = gridDim.x;
  unsigned sum, cnt, mine, sp = 0u;
  for (;;) {
    sum = 0u; cnt = 0u; mine = 0u;
#pragma unroll
    for (unsigned j = 0; j < 16; ++j) { const unsigned c = xb_ld(&bar[XB_XCNT(j)]); sum += c; cnt += (c > 0u) ? 1u : 0u; mine = (j == x) ? c : mine; }
    if (sum == G) break;
    __builtin_amdgcn_s_sleep(1);
    if ((++sp & 255u) == 0u) { if (xb_ld(&bar[XB_TMO])) break; if (sp > XB_SPIN_CAP) { atomicAdd(&bar[XB_TMO], 1u); break; } }
  }
  nloc = mine > 0u ? mine : 1u; nx = cnt > 0u ? cnt : 1u;
}
DI void xcd_barrier(const XcdBarrier& b) {
  asm volatile("s_waitcnt vmcnt(0)" ::: "memory");
  __syncthreads();
  if (threadIdx.x == 0) {
    unsigned* bar = b.bar;
    __builtin_amdgcn_s_waitcnt(0);
    unsigned nloc = b.st[0], nx = b.st[1];
    if (nloc == 0u) { xcd_barrier_complete(bar, b.x, nloc, nx); b.st[0] = nloc; b.st[1] = nx; }
    const unsigned old = xb_add(&bar[XB_XSUB(b.x)], 1u);
    const unsigned gen = old / nloc;
    if (old + 1u == (gen + 1u) * nloc) {
      __builtin_amdgcn_fence(__ATOMIC_RELEASE, "agent");
      asm volatile("s_waitcnt vmcnt(0)" ::: "memory");
      const unsigned og = xb_add(&bar[XB_TOP], 1u);
      const unsigned tg = og / nx;
      if (og + 1u == (tg + 1u) * nx) xb_add(&bar[XB_TOPGEN], 1u);
      else XB_SPIN(xb_ld(&bar[XB_TOPGEN]) == tg, bar);
      __builtin_amdgcn_fence(__ATOMIC_ACQUIRE, "agent");
      xb_add(&bar[XB_XGEN(b.x)], 1u);
      asm volatile("s_waitcnt vmcnt(0)" ::: "memory");
    } else {
      XB_SPIN(xb_ld(&bar[XB_XGEN(b.x)]) == gen, bar);
      __builtin_amdgcn_fence(__ATOMIC_ACQUIRE, "agent");
      asm volatile("s_waitcnt vmcnt(0)" ::: "memory");
    }
  }
  __syncthreads();
}

struct Params {
  const float *x, *meta, *norm1_g, *w_in, *wg, *bg, *sb_g, *gla_g, *w_out, *norm2_g, *w_pq, *sk1, *sk2, *eu, *ev, *gf;
  float* out; char* ws;
};
constexpr int SMEM_BYTES = 73728;
constexpr size_t WS_BAR = 0;

__global__ void __launch_bounds__(256, 2) k_fused(Params p) {
  extern __shared__ __attribute__((aligned(16))) char smem_dyn[];
  char* smem = smem_dyn;
  __shared__ unsigned xb_words[4];
  if (threadIdx.x < 4) xb_words[threadIdx.x] = 0u;
  __syncthreads();
  const XcdBarrier bar = xcd_barrier_post((unsigned*)(p.ws + WS_BAR), xb_words);
  const int G = gridDim.x, bid = blockIdx.x;
  char* ws = p.ws;
  bf16_t* WinT = (bf16_t*)(ws + WS_WIN);
  bf16_t* WoutT = (bf16_t*)(ws + WS_WOUT);
  bf16_t* WpqT = (bf16_t*)(ws + WS_WPQ);
  bf16_t* EU = (bf16_t*)(ws + WS_EU);
  bf16_t* EV = (bf16_t*)(ws + WS_EV);
  bf16_t* SK1b = (bf16_t*)(ws + WS_SK1);
  bf16_t* SK2b = (bf16_t*)(ws + WS_SK2);
  bf16_t* A1 = (bf16_t*)(ws + WS_A1);
  float* GO = (float*)(ws + WS_A1);
  bf16_t* A2 = (bf16_t*)(ws + WS_A1);
  InProjOut O;
  O.QSB = (bf16_t*)(ws + WS_QSB); O.KSB = (bf16_t*)(ws + WS_KSB); O.VTSB = (bf16_t*)(ws + WS_VTSB);
  O.GQ = (bf16_t*)(ws + WS_GQ); O.GK = (bf16_t*)(ws + WS_GK); O.GV = (bf16_t*)(ws + WS_GV); O.GR = (bf16_t*)(ws + WS_GR);
  O.GLR = (float*)(ws + WS_GLR);
  float* H1 = (float*)(ws + WS_H1);
  float* LG = (float*)(ws + WS_LG);
  bf16_t* MIX = (bf16_t*)(ws + WS_MIX);
  bf16_t* QP = (bf16_t*)(ws + WS_MIX);
  int* EIDX = (int*)(ws + WS_EIDX);
  float* GATE = (float*)(ws + WS_GATE);

  for (int vb = bid; vb < 3200 + 1024 + 1024; vb += G) {
    if (vb < 3200) ph_transpose_w(vb % 100, vb / 100, smem, p.w_in, p.norm1_g, WinT, D, NIN);
    else if (vb < 4224) { const int t = vb - 3200; ph_transpose_w(t % 32, t / 32, smem, p.w_out, nullptr, WoutT, D, D); }
    else { const int t = vb - 4224; ph_transpose_w(t % 32, t / 32, smem, p.w_pq, nullptr, WpqT, D, D); }
  }
  ph_convert(p.eu, EU, (size_t)NEXP * D / 8);
  ph_convert(p.ev, EV, (size_t)NEXP * D / 8);
  ph_convert(p.sk1, SK1b, (size_t)8 * 128 * 64 / 8);
  ph_convert(p.sk2, SK2b, (size_t)8 * 128 * 64 / 8);
  ph_zero_pads(O.KSB, O.VTSB, O.GQ, O.GK, O.GV);
  for (int vb = bid; vb < MROWS / 4; vb += G) ph_norm_rows<0>(vb, p.x, p.meta, A1);
  xcd_barrier(bar);
  for (int vb = bid; vb < (MROWS / 128) * 25; vb += G) ph_gemm_inproj(vb, smem, A1, WinT, O);
  xcd_barrier(bar);
  for (int vb = bid; vb < NB * GU; vb += G) ph_lg(vb, O.GLR, p.wg, p.bg, LG);
  for (int vb = bid; vb < 64 * 64; vb += G) ph_sb_attn(vb, O.QSB, O.KSB, O.VTSB, p.sb_g, MIX);
  xcd_barrier(bar);
  for (int vb = bid; vb < 128; vb += G) ph_gla_v1(vb, smem, O.GQ, O.GK, O.GV, LG, GO);
  xcd_barrier(bar);
  for (int vb = bid; vb < TREAL; vb += G) ph_gla_norm(vb, GO, O.GR, p.gla_g, MIX);
  xcd_barrier(bar);
  for (int vb = bid; vb < (TREAL / 128) * 8; vb += G) ph_gemm_out(vb, smem, MIX, WoutT, p.x, H1);
  xcd_barrier(bar);
  for (int vb = bid; vb < TREAL / 4; vb += G) ph_norm_rows<1>(vb, H1, p.norm2_g, A2);
  xcd_barrier(bar);
  for (int vb = bid; vb < (TREAL / 128) * 8; vb += G) ph_gemm_pq(vb, smem, A2, WpqT, QP);
  xcd_barrier(bar);
  for (int vb = bid; vb < 8 * (TREAL / 128); vb += G) ph_route_v2(vb, smem, QP, SK1b, SK2b, EIDX, GATE);
  xcd_barrier(bar);
  for (int vb = bid; vb < TREAL / 4; vb += G) ph_peer_v1(vb, smem, A2, EU, EV, EIDX, GATE, H1, p.gf, p.out);
}

extern "C" void kernel_launch(void* const* d_in, const int* in_sizes, int n_in, void* d_out, int out_size, void* d_ws, size_t ws_size, hipStream_t stream) {
  static int grid = 0;
  if (grid == 0) {
    int dev = 0, cus = 0, per_cu = 0;
    hipGetDevice(&dev);
    hipDeviceGetAttribute(&cus, hipDeviceAttributeMultiprocessorCount, dev);
    hipFuncSetAttribute((const void*)k_fused, hipFuncAttributeMaxDynamicSharedMemorySize, SMEM_BYTES);
    hipOccupancyMaxActiveBlocksPerMultiprocessor(&per_cu, (const void*)k_fused, 256, SMEM_BYTES);
    if (per_cu > 2) per_cu = 2;
    if (per_cu < 1) per_cu = 1;
    grid = cus * per_cu;
  }
  hipMemsetAsync((char*)d_ws + WS_BAR, 0, XCD_BAR_WORDS * 4, stream);
  Params p{};
  p.x = (const float*)d_in[0]; p.meta = (const float*)d_in[1]; p.norm1_g = (const float*)d_in[2]; p.w_in = (const float*)d_in[3];
  p.wg = (const float*)d_in[4]; p.bg = (const float*)d_in[5]; p.sb_g = (const float*)d_in[6]; p.gla_g = (const float*)d_in[7];
  p.w_out = (const float*)d_in[8]; p.norm2_g = (const float*)d_in[9]; p.w_pq = (const float*)d_in[10]; p.sk1 = (const float*)d_in[11];
  p.sk2 = (const float*)d_in[12]; p.eu = (const float*)d_in[13]; p.ev = (const float*)d_in[14]; p.gf = (const float*)d_in[15];
  p.out = (float*)d_out; p.ws = (char*)d_ws;
  void* args[] = {&p};
  hipLaunchCooperativeKernel((const void*)k_fused, dim3(grid), dim3(256), args, SMEM_BYTES, stream);
}
```

```cpp
#include <hip/hip_runtime.h>
#include <stdint.h>
#include <stddef.h>

typedef unsigned short bf16_t;
typedef short bf16x8 __attribute__((ext_vector_type(8)));
typedef float f32x16 __attribute__((ext_vector_type(16)));
typedef float f32x4 __attribute__((ext_vector_type(4)));
typedef float f32x2 __attribute__((ext_vector_type(2)));
typedef unsigned u32x4 __attribute__((ext_vector_type(4)));
typedef unsigned u32x2 __attribute__((ext_vector_type(2)));
typedef __bf16 bf16x2_t __attribute__((ext_vector_type(2)));

#define DI __device__ __forceinline__
__device__ __forceinline__ int fresh_tid() { int t = (int)threadIdx.x; asm volatile("" : "+v"(t)); return t; }
#define TID tid256_
#define MFMA32(a, b, c) __builtin_amdgcn_mfma_f32_32x32x16_bf16((a), (b), (c), 0, 0, 0)

constexpr int D = 1024, NB = 8, SEQ = 8192, NMETA = 16;
constexpr int TREAL = NB * SEQ;
constexpr int MROWS = TREAL + 128;
constexpr int NIN = 3088, NINP = 3328;
constexpr int SBH = 8, SBD = 64;
constexpr int GH = 4, GDK = 64, GDV = 128;
constexpr int KIDX = SEQ + 32;
constexpr int GU = SEQ + 64;
constexpr int NEXP = 16384;
constexpr float EPS = 1e-6f;

constexpr size_t MiB = 1u << 20;
constexpr size_t WS_WIN = 1 * MiB;
constexpr size_t WS_WOUT = 8 * MiB;
constexpr size_t WS_WPQ = 10 * MiB;
constexpr size_t WS_SK1 = 12 * MiB;
constexpr size_t WS_SK2 = 13 * MiB;
constexpr size_t WS_EU = 16 * MiB;
constexpr size_t WS_EV = 48 * MiB;
constexpr size_t WS_A1 = 80 * MiB;
constexpr size_t WS_QSB = 210 * MiB;
constexpr size_t WS_KSB = 274 * MiB;
constexpr size_t WS_VTSB = 339 * MiB;
constexpr size_t WS_GQ = 404 * MiB;
constexpr size_t WS_GK = 437 * MiB;
constexpr size_t WS_H1 = 210 * MiB;
constexpr size_t WS_GV = 470 * MiB;
constexpr size_t WS_GR = 535 * MiB;
constexpr size_t WS_GLR = 599 * MiB;
constexpr size_t WS_LG = 604 * MiB;
constexpr size_t WS_MIX = 669 * MiB;
constexpr size_t WS_EIDX = 797 * MiB;
constexpr size_t WS_GATE = 829 * MiB;
constexpr size_t WS_PP = 470 * MiB;
constexpr size_t WS_STREAM = 726 * MiB;
constexpr size_t WS_XRANK = 16384;
constexpr size_t WS_VSB = 861 * MiB;
constexpr size_t WS_END = 926 * MiB;

DI unsigned f2bf(float f) { unsigned u = __float_as_uint(f); return (u + 0x7fffu + ((u >> 16) & 1u)) >> 16; }
DI float bf2f(unsigned b) { return __uint_as_float(b << 16); }
DI unsigned pk2(float lo, float hi) { f32x2 v = {lo, hi}; return __builtin_bit_cast(unsigned, __builtin_convertvector(v, bf16x2_t)); }
DI float bflo(unsigned u) { return __uint_as_float(u << 16); }
DI float bfhi(unsigned u) { return __uint_as_float(u & 0xffff0000u); }
DI int crow(int reg, int h) { return (reg & 3) + 8 * (reg >> 2) + 4 * h; }
DI float wave_sum(float v) {
#pragma unroll
  for (int o = 32; o >= 1; o >>= 1) v += __shfl_xor(v, o);
  return v;
}
DI float dot2bf(unsigned a, unsigned b, float acc) { return __builtin_amdgcn_fdot2_f32_bf16(__builtin_bit_cast(bf16x2_t, a), __builtin_bit_cast(bf16x2_t, b), acc, false); }
DI float softplus(float z) { return fmaxf(z, 0.f) + __logf(1.f + __expf(-fabsf(z))); }

DI void ph_transpose_w(int bx, int by, char* smem, const float* __restrict__ W, const float* __restrict__ gain, bf16_t* __restrict__ WT, int K, int N) {
  const int tid256_ = fresh_tid() & 255;
  float (*t)[33] = (float (*)[33])smem;
  const int n0 = bx * 32, k0 = by * 32, tx = TID & 31, ty = TID >> 5;
  for (int r = ty; r < 32; r += 8) {
    const int k = k0 + r, n = n0 + tx;
    float v = 0.f;
    if (n < N) { v = W[(size_t)k * N + n]; if (gain) v *= gain[k]; }
    t[r][tx] = v;
  }
  __syncthreads();
  for (int r = ty; r < 32; r += 8) {
    const int n = n0 + r, k = k0 + tx;
    WT[(size_t)n * K + k] = (bf16_t)f2bf(t[tx][r]);
  }
  __syncthreads();
}
DI void ph_convert(const float* __restrict__ src, bf16_t* __restrict__ dst, size_t n8) {
  size_t i = (size_t)blockIdx.x * blockDim.x + threadIdx.x;
  const size_t stride = (size_t)gridDim.x * blockDim.x;
  for (; i < n8; i += stride) {
    const f32x4 a = ((const f32x4*)src)[2 * i], b = ((const f32x4*)src)[2 * i + 1];
    u32x4 o; o.x = pk2(a.x, a.y); o.y = pk2(a.z, a.w); o.z = pk2(b.x, b.y); o.w = pk2(b.z, b.w);
    ((u32x4*)dst)[i] = o;
  }
}
DI void ph_zero_pads(bf16_t* KSB, bf16_t* VTSB, bf16_t* GQ, bf16_t* GK, bf16_t* GV) {
  const int tid = blockIdx.x * blockDim.x + threadIdx.x, nth = gridDim.x * blockDim.x;
  for (int i = tid; i < 64 * 16 * 64; i += nth) { const int bh = i / 1024, r = i % 1024; KSB[(size_t)bh * KIDX * 64 + r] = 0; }
  for (int i = tid; i < 64 * 16 * 64; i += nth) { const int bh = i / 1024, r = i % 1024; VTSB[(size_t)bh * KIDX * 64 + r] = 0; }
  for (int i = tid; i < 32 * 48 * 64; i += nth) { const int bh = i / 3072, r = i % 3072; GQ[(size_t)bh * GU * 64 + r] = 0; GK[(size_t)bh * GU * 64 + r] = 0; }
  for (int i = tid; i < 32 * 48 * 128; i += nth) { const int bh = i / 6144, r = i % 6144; GV[(size_t)bh * GU * 128 + r] = 0; }
}

template <int MODE>
DI void ph_norm_rows(int vb, const float* __restrict__ src, const float* __restrict__ meta, bf16_t* __restrict__ dst) {
  const int tid256_ = fresh_tid() & 255;
  const int row = vb * 4 + (TID >> 6), lane = TID & 63;
  const float* p = nullptr;
  p = src + (size_t)row * D;
  f32x4 v[4];
  float ss = 0.f;
#pragma unroll
  for (int j = 0; j < 4; ++j) {
    v[j] = p ? *(const f32x4*)(p + j * 256 + lane * 4) : (f32x4){0.f, 0.f, 0.f, 0.f};
    ss += v[j].x * v[j].x + v[j].y * v[j].y + v[j].z * v[j].z + v[j].w * v[j].w;
  }
  ss = wave_sum(ss);
  const float r = rsqrtf(ss * (1.0f / D) + EPS);
#pragma unroll
  for (int j = 0; j < 4; ++j) {
    f32x4 gg = {1.f, 1.f, 1.f, 1.f};
    if (MODE == 1) gg = *(const f32x4*)(meta + j * 256 + lane * 4);
    u32x2 o; o.x = pk2(v[j].x * r * gg.x, v[j].y * r * gg.y); o.y = pk2(v[j].z * r * gg.z, v[j].w * r * gg.w);
    *(u32x2*)(dst + (size_t)row * D + j * 256 + lane * 4) = o;
  }
}

namespace pg8 {
#define PG8_LAS __attribute__((address_space(3)))
typedef unsigned short bf16_t;
typedef short bf16x8 __attribute__((ext_vector_type(8)));
typedef float f32x4 __attribute__((ext_vector_type(4)));
typedef unsigned u32x4 __attribute__((ext_vector_type(4)));
constexpr int BM = 256, BK = 64, HALF = 128, HTB = HALF * BK * 2  , STAGE_BYTES = 8 * HTB, NXCD = 8, WGM = 8;

__host__ __device__ __forceinline__ int lds_byte(int r, int c) { const int st = (r >> 4) * 2 + (c >> 5), rr = r & 15, cc = c & 31, ob = rr * 64 + cc * 2; return st * 1024 + (ob ^ (((ob >> 9) & 1) << 5)); }
__host__ __device__ __forceinline__ void stage_rc(int b, int& R, int& C) { const int st = b / 1024, sb = b % 1024, swz = sb ^ (((sb >> 9) & 1) << 5); R = (st >> 1) * 16 + swz / 64; C = (st & 1) * 32 + (swz % 64) / 2; }
__host__ __device__ __forceinline__ int perm32(int rho) { const int n = rho >> 4, i = rho & 15; return 8 * (i >> 2) + 4 * n + (i & 3); }

struct Unit { int pm, pn; };
struct Gemm { const bf16_t* A; const bf16_t* Bt; int M, N, K; };

struct StaticOrder {
    int nM, nN, nwg, G, c;
    __host__ __device__ void init(int M, int N, int G_, int c_) { nM = M / BM; nN = N / BM; nwg = nM * nN; G = G_; c = c_; }
    __host__ __device__ bool next(int i, Unit& u) const {
        const long L = (long)i * G + c; if (L >= nwg) return false;
        int wgid = (int)L; { const int q = nwg / NXCD, r = nwg % NXCD, xcd = wgid % NXCD, off = wgid / NXCD; wgid = (xcd < r ? xcd * (q + 1) : r * (q + 1) + (xcd - r) * q) + off; }
        const int nig = WGM * nN, gid = wgid / nig, fm = gid * WGM, gsz = (nM - fm) < WGM ? (nM - fm) : WGM;
        u.pm = fm + ((wgid % nig) % gsz); u.pn = (wgid % nig) / gsz; return true;
    }
    __device__ __forceinline__ void a_ready(const Unit&) const {}
    __device__ __forceinline__ void done(const Unit&) const {}
};

template <class Epi, class Sched, bool ALIGN_EPI = false, bool SP2 = false>
__device__ __forceinline__ void gemm_phase(PG8_LAS unsigned char* lds, const Gemm g, const Sched& S, const Epi& E) {
    const int tid = fresh_tid(), wid = __builtin_amdgcn_readfirstlane(tid >> 6), lane = tid & 63, wr = wid >> 2, wc = wid & 3, fr = lane & 15, fq = lane >> 4;
    const int K = g.K, nt = K / BK;
    unsigned voffA[2], voffB[2];
#pragma unroll
    for (int i = 0; i < 2; ++i) { int R, C; stage_rc(tid * 16 + i * 8192, R, C); const int Rb = Epi::PERM ? ((R & ~31) + perm32(R & 31)) : R;
        voffA[i] = (unsigned)(R * K + C) * 2u; voffB[i] = (unsigned)(Rb * K + C) * 2u; }
    const size_t kstep = (size_t)(BK * 2);
    const size_t hstep = (size_t)HALF * K * 2;
    const size_t tstep = 2 * hstep;
    const unsigned ldsw = (unsigned)wid * 1024u;
    const int aoff = lds_byte(wr * 64 + fr, fq * 8), boff = lds_byte(wc * 32 + fr, fq * 8);
#define PG8_SA(b, h) (((b) * 2 + (h)) * HTB)
#define PG8_SB(b, h) ((4 + (b) * 2 + (h)) * HTB)
#define PG8_STAGE(bufoff, gbase, voff) do { _Pragma("unroll") for (int _i = 0; _i < 2; ++_i) \
        __builtin_amdgcn_global_load_lds((const unsigned*)((const char*)(gbase) + (voff)[_i]), (PG8_LAS unsigned*)(lds + (bufoff) + ldsw + _i * 8192), 16, 0, 0); } while (0)
#define PG8_LDA(dst, b, h) do { _Pragma("unroll") for (int m = 0; m < 4; ++m) _Pragma("unroll") for (int k = 0; k < 2; ++k) dst[m][k] = *(const PG8_LAS bf16x8*)(lds + PG8_SA(b, h) + aoff + m * 2048 + k * 1024); } while (0)
#define PG8_LDB(dst, b, h) do { _Pragma("unroll") for (int n = 0; n < 2; ++n) _Pragma("unroll") for (int k = 0; k < 2; ++k) dst[n][k] = *(const PG8_LAS bf16x8*)(lds + PG8_SB(b, h) + boff + n * 2048 + k * 1024); } while (0)
#define PG8_MMA(ai, bj, At, Bt) do { __builtin_amdgcn_s_setprio(1); _Pragma("unroll") for (int m = 0; m < 4; ++m) _Pragma("unroll") for (int n = 0; n < 2; ++n) _Pragma("unroll") for (int k = 0; k < 2; ++k) \
        acc[ai][bj][m][n] = __builtin_amdgcn_mfma_f32_16x16x32_bf16(Bt[n][k], At[m][k], acc[ai][bj][m][n], 0, 0, 0); __builtin_amdgcn_s_setprio(0); } while (0)
#define PG8_WAIT_V(n) asm volatile("s_waitcnt vmcnt(" #n ")" ::: "memory")
#define PG8_WAIT_L(n) asm volatile("s_waitcnt lgkmcnt(" #n ")" ::: "memory")
#define PG8_BAR __builtin_amdgcn_s_barrier()
#define PG8_SCHED __builtin_amdgcn_sched_barrier(0)
    Unit cur, nxt; int ui = 0;
    if (!S.next(0, cur)) return;
    f32x4 acc[2][2][4][2];
#pragma unroll
    for (int a = 0; a < 2; ++a)
#pragma unroll
        for (int b = 0; b < 2; ++b)
#pragma unroll
            for (int m = 0; m < 4; ++m)
#pragma unroll
                for (int n = 0; n < 2; ++n) acc[a][b][m][n] = (f32x4){0.f, 0.f, 0.f, 0.f};
    bf16x8 At[4][2], B0[2][2], B1[2][2];
    const char* cA = (const char*)g.A + (size_t)cur.pm * tstep; const char* cB = (const char*)g.Bt + (size_t)cur.pn * tstep;
    S.a_ready(cur);
    if constexpr (SP2) {
        PG8_STAGE(PG8_SB(0, 0), cB, voffB); PG8_STAGE(PG8_SB(0, 1), cB + hstep, voffB); PG8_STAGE(PG8_SA(0, 0), cA, voffA); PG8_STAGE(PG8_SA(0, 1), cA + hstep, voffA);
        if (wr == 1) PG8_BAR;
        PG8_WAIT_V(2); PG8_BAR;
        PG8_STAGE(PG8_SB(1, 0), cB + kstep, voffB); PG8_STAGE(PG8_SA(1, 0), cA + kstep, voffA); PG8_STAGE(PG8_SB(1, 1), cB + hstep + kstep, voffB);
        PG8_WAIT_V(6); PG8_BAR;
    } else {
        PG8_STAGE(PG8_SB(0, 0), cB, voffB); PG8_STAGE(PG8_SA(0, 0), cA, voffA); PG8_STAGE(PG8_SB(0, 1), cB + hstep, voffB); PG8_STAGE(PG8_SA(0, 1), cA + hstep, voffA);
        if (wr == 1) PG8_BAR;
        PG8_WAIT_V(4); PG8_BAR;
        PG8_STAGE(PG8_SB(1, 0), cB + kstep, voffB); PG8_STAGE(PG8_SA(1, 0), cA + kstep, voffA); PG8_STAGE(PG8_SB(1, 1), cB + hstep + kstep, voffB);
        PG8_WAIT_V(6); PG8_BAR;
    }
    for (;;) {
        const bool has_next = S.next(ui + 1, nxt);
        const char* nA = has_next ? (const char*)g.A + (size_t)nxt.pm * tstep : cA; const char* nB = has_next ? (const char*)g.Bt + (size_t)nxt.pn * tstep : cB;
        for (int t = 0; t < nt; t += 2) {
            const bool last = (t == nt - 2);
            const char* a1 = cA + (size_t)(t + 1) * kstep;
            const char* a2 = last ? nA : cA + (size_t)(t + 2) * kstep; const char* b2 = last ? nB : cB + (size_t)(t + 2) * kstep;
            const char* a3 = a2 + kstep; const char* b3 = b2 + kstep;
            if (last && has_next) S.a_ready(nxt);
            if constexpr (SP2) {
            PG8_LDB(B0, 0, 0); PG8_LDB(B1, 0, 1); PG8_SCHED; PG8_LDA(At, 0, 0); PG8_STAGE(PG8_SA(1, 1), a1 + hstep, voffA);
            PG8_WAIT_V(8); PG8_WAIT_L(0); PG8_BAR; PG8_MMA(0, 0, At, B0); PG8_MMA(0, 1, At, B1); PG8_BAR; PG8_SCHED;
            PG8_LDA(At, 0, 1); PG8_STAGE(PG8_SB(0, 0), b2, voffB); PG8_STAGE(PG8_SB(0, 1), b2 + hstep, voffB); PG8_STAGE(PG8_SA(0, 0), a2, voffA);
            PG8_WAIT_V(8); PG8_WAIT_L(0); PG8_BAR; PG8_MMA(1, 0, At, B0); PG8_MMA(1, 1, At, B1); PG8_BAR; PG8_SCHED;
            PG8_LDB(B0, 1, 0); PG8_LDB(B1, 1, 1); PG8_SCHED; PG8_LDA(At, 1, 0); PG8_STAGE(PG8_SA(0, 1), a2 + hstep, voffA);
            PG8_WAIT_V(8); PG8_WAIT_L(0); PG8_BAR; PG8_MMA(0, 0, At, B0); PG8_MMA(0, 1, At, B1); PG8_BAR; PG8_SCHED;
            PG8_LDA(At, 1, 1); PG8_STAGE(PG8_SB(1, 0), b3, voffB); PG8_STAGE(PG8_SB(1, 1), b3 + hstep, voffB); PG8_STAGE(PG8_SA(1, 0), a3, voffA);
            PG8_WAIT_V(8); PG8_WAIT_L(0); PG8_BAR; PG8_MMA(1, 0, At, B0); PG8_MMA(1, 1, At, B1); PG8_BAR; PG8_SCHED;
            } else {
            PG8_LDB(B0, 0, 0); PG8_SCHED; PG8_LDA(At, 0, 0); PG8_STAGE(PG8_SA(1, 1), a1 + hstep, voffA);
            PG8_WAIT_L(8); PG8_BAR; PG8_WAIT_L(0); PG8_MMA(0, 0, At, B0); PG8_BAR; PG8_SCHED;
            PG8_LDB(B1, 0, 1); PG8_STAGE(PG8_SB(0, 0), b2, voffB);
            PG8_BAR; PG8_WAIT_L(0); PG8_MMA(0, 1, At, B1); PG8_BAR;
            PG8_LDA(At, 0, 1); PG8_STAGE(PG8_SA(0, 0), a2, voffA);
            PG8_BAR; PG8_WAIT_L(0); PG8_MMA(1, 0, At, B0); PG8_BAR; PG8_SCHED;
            PG8_STAGE(PG8_SB(0, 1), b2 + hstep, voffB);
            PG8_WAIT_V(6); PG8_BAR; PG8_MMA(1, 1, At, B1); PG8_BAR;
            PG8_LDB(B0, 1, 0); PG8_SCHED; PG8_LDA(At, 1, 0); PG8_STAGE(PG8_SA(0, 1), a2 + hstep, voffA);
            PG8_WAIT_L(8); PG8_BAR; PG8_WAIT_L(0); PG8_MMA(0, 0, At, B0); PG8_BAR; PG8_SCHED;
            PG8_LDB(B1, 1, 1); PG8_STAGE(PG8_SB(1, 0), b3, voffB);
            PG8_BAR; PG8_WAIT_L(0); PG8_MMA(0, 1, At, B1); PG8_BAR;
            PG8_LDA(At, 1, 1); PG8_STAGE(PG8_SA(1, 0), a3, voffA);
            PG8_BAR; PG8_WAIT_L(0); PG8_MMA(1, 0, At, B0); PG8_BAR; PG8_SCHED;
            PG8_STAGE(PG8_SB(1, 1), b3 + hstep, voffB);
            PG8_WAIT_V(6); PG8_BAR; PG8_MMA(1, 1, At, B1); PG8_BAR;
            }
        }
        if constexpr (ALIGN_EPI) { if (wr == 0) PG8_BAR; }
        if constexpr (!Epi::AFTER_DRAIN) { E(acc, cur, wr, wc, fr, fq); S.done(cur); }
        if (!has_next) break;
#pragma unroll
        for (int a = 0; a < 2; ++a)
#pragma unroll
            for (int b = 0; b < 2; ++b)
#pragma unroll
                for (int m = 0; m < 4; ++m)
#pragma unroll
                    for (int n = 0; n < 2; ++n) acc[a][b][m][n] = (f32x4){0.f, 0.f, 0.f, 0.f};
        cur = nxt; cA = nA; cB = nB; ++ui;
        if constexpr (ALIGN_EPI) { if (wr == 1) PG8_BAR; }
    }
    PG8_WAIT_V(0);
    if constexpr (!ALIGN_EPI) { if (wr == 0) PG8_BAR; }
    PG8_BAR;
    if constexpr (Epi::AFTER_DRAIN) { E.fused(acc, cur, wr, wc, fr, fq, lds, wid, lane); S.done(cur); }
#undef PG8_SA
#undef PG8_SB
#undef PG8_STAGE
#undef PG8_LDA
#undef PG8_LDB
#undef PG8_MMA
#undef PG8_WAIT_V
#undef PG8_WAIT_L
#undef PG8_BAR
#undef PG8_SCHED
}
}

struct InProjOut { bf16_t *QSB, *KSB, *VSB, *VTSB, *GQ, *GK, *GV, *GR; float* GLR; };

struct EpiInProj {
  static constexpr bool PERM = true, AFTER_DRAIN = false;
  InProjOut O;
  DI void operator()(const pg8::f32x4 (&acc)[2][2][4][2], const pg8::Unit& u, int wr, int wc, int fr, int fq) const {
    const int pn = u.pn;
#pragma unroll
    for (int ai = 0; ai < 2; ++ai)
#pragma unroll
      for (int m = 0; m < 4; ++m) {
        const int row = u.pm * 256 + ai * 128 + wr * 64 + m * 16 + fr;
        const int b = row >> 13, i = row & 8191;
#pragma unroll
        for (int bj = 0; bj < 2; ++bj) {
          const int col = pn * 256 + bj * 128 + wc * 32 + 8 * fq;
          const pg8::f32x4 v0 = acc[ai][bj][m][0], v1 = acc[ai][bj][m][1];
          if (pn < 12) {
            u32x4 w; w.x = pk2(v0[0], v0[1]); w.y = pk2(v0[2], v0[3]); w.z = pk2(v1[0], v1[1]); w.w = pk2(v1[2], v1[3]);
            bf16_t* dst;
            if (pn < 2)       { const int c = col;        dst = O.QSB + ((size_t)(b * SBH + (c >> 6)) * SEQ + i) * 64 + (c & 63); }
            else if (pn < 4)  { const int c = col - 512;  dst = O.KSB + ((size_t)(b * SBH + (c >> 6)) * KIDX + 32 + i) * 64 + (c & 63); }
            else if (pn < 6)  { const int c = col - 1024; dst = O.VSB + ((size_t)(b * SBH + (c >> 6)) * KIDX + 32 + i) * 64 + (c & 63); }
            else if (pn == 6) { const int c = col - 1536; dst = O.GQ + ((size_t)(b * GH + (c >> 6)) * GU + 64 + i) * 64 + (c & 63); }
            else if (pn == 7) { const int c = col - 1792; dst = O.GK + ((size_t)(b * GH + (c >> 6)) * GU + 64 + i) * 64 + (c & 63); }
            else if (pn < 10) { const int c = col - 2048; dst = O.GV + ((size_t)(b * GH + (c >> 7)) * GU + 64 + i) * 128 + (c & 127); }
            else              { const int c = col - 2560; dst = O.GR + (size_t)row * 512 + c; }
            *(u32x4*)dst = w;
          } else if (col < NIN) {
            float* dst = O.GLR + ((size_t)b * GU + 64 + i) * 16 + (col - 3072);
            *(f32x4*)dst = (f32x4){v0[0], v0[1], v0[2], v0[3]};
            *(f32x4*)(dst + 4) = (f32x4){v1[0], v1[1], v1[2], v1[3]};
          }
        }
      }
  }
};
struct EpiOut {
  static constexpr bool PERM = false, AFTER_DRAIN = false;
  const float* x; float* H1;
  DI void operator()(const pg8::f32x4 (&acc)[2][2][4][2], const pg8::Unit& u, int wr, int wc, int fr, int fq) const {
#pragma unroll
    for (int ai = 0; ai < 2; ++ai)
#pragma unroll
      for (int m = 0; m < 4; ++m) {
        const size_t rowoff = (size_t)(u.pm * 256 + ai * 128 + wr * 64 + m * 16 + fr) * D;
#pragma unroll
        for (int bj = 0; bj < 2; ++bj)
#pragma unroll
          for (int n = 0; n < 2; ++n) {
            const size_t idx = rowoff + u.pn * 256 + bj * 128 + wc * 32 + 16 * n + 4 * fq;
            const f32x4 xv = *(const f32x4*)(x + idx);
            const pg8::f32x4 a = acc[ai][bj][m][n];
            *(f32x4*)(H1 + idx) = (f32x4){xv.x + a[0], xv.y + a[1], xv.z + a[2], xv.w + a[3]};
          }
      }
  }
};
struct EpiPQ {
  static constexpr bool PERM = true, AFTER_DRAIN = false;
  bf16_t* QP;
  DI void operator()(const pg8::f32x4 (&acc)[2][2][4][2], const pg8::Unit& u, int wr, int wc, int fr, int fq) const {
#pragma unroll
    for (int ai = 0; ai < 2; ++ai)
#pragma unroll
      for (int m = 0; m < 4; ++m) {
        const size_t rowoff = (size_t)(u.pm * 256 + ai * 128 + wr * 64 + m * 16 + fr) * D;
#pragma unroll
        for (int bj = 0; bj < 2; ++bj) {
          const pg8::f32x4 v0 = acc[ai][bj][m][0], v1 = acc[ai][bj][m][1];
          u32x4 w; w.x = pk2(v0[0], v0[1]); w.y = pk2(v0[2], v0[3]); w.z = pk2(v1[0], v1[1]); w.w = pk2(v1[2], v1[3]);
          *(u32x4*)(QP + rowoff + u.pn * 256 + bj * 128 + wc * 32 + 8 * fq) = w;
        }
      }
  }
};

DI void ph_meta(int blk, char* smem, const float* __restrict__ meta, const float* __restrict__ g1, const float* __restrict__ w_in, const InProjOut& O) {
  float (*xmT)[16] = (float (*)[16])smem;
  const int tid = fresh_tid(), lane = tid & 63, wave = tid >> 6;
  for (int rr = 0; rr < 2; ++rr) {
    const int mm = wave * 2 + rr;
    float v[16]; float ss = 0.f;
#pragma unroll
    for (int j = 0; j < 16; ++j) { v[j] = meta[(size_t)mm * D + j * 64 + lane]; ss += v[j] * v[j]; }
    ss = wave_sum(ss);
    const float r = rsqrtf(ss * (1.0f / D) + EPS);
#pragma unroll
    for (int j = 0; j < 16; ++j) xmT[j * 64 + lane][mm] = v[j] * r * g1[j * 64 + lane];
  }
  __syncthreads();
  const int n = blk * 512 + tid;
  if (n < NIN) {
    float acc[16];
#pragma unroll
    for (int j = 0; j < 16; ++j) acc[j] = 0.f;
#pragma unroll 4
    for (int k = 0; k < D; ++k) {
      const float w = w_in[(size_t)k * NIN + n];
      const f32x4 a = *(const f32x4*)&xmT[k][0], b4 = *(const f32x4*)&xmT[k][4], c4 = *(const f32x4*)&xmT[k][8], d4 = *(const f32x4*)&xmT[k][12];
      acc[0] += a.x * w; acc[1] += a.y * w; acc[2] += a.z * w; acc[3] += a.w * w;
      acc[4] += b4.x * w; acc[5] += b4.y * w; acc[6] += b4.z * w; acc[7] += b4.w * w;
      acc[8] += c4.x * w; acc[9] += c4.y * w; acc[10] += c4.z * w; acc[11] += c4.w * w;
      acc[12] += d4.x * w; acc[13] += d4.y * w; acc[14] += d4.z * w; acc[15] += d4.w * w;
    }
#pragma unroll
    for (int mm = 0; mm < 16; ++mm) {
      const float val = acc[mm];
      const bf16_t hv = (bf16_t)f2bf(val);
      for (int bb = 0; bb < NB; ++bb) {
        if (n < 512) {}
        else if (n < 1024) { const int c = n - 512;  O.KSB[((size_t)(bb * SBH + (c >> 6)) * KIDX + 16 + mm) * 64 + (c & 63)] = hv; }
        else if (n < 1536) { const int c = n - 1024; O.VSB[((size_t)(bb * SBH + (c >> 6)) * KIDX + 16 + mm) * 64 + (c & 63)] = hv; }
        else if (n < 1792) { const int c = n - 1536; O.GQ[((size_t)(bb * GH + (c >> 6)) * GU + 48 + mm) * 64 + (c & 63)] = hv; }
        else if (n < 2048) { const int c = n - 1792; O.GK[((size_t)(bb * GH + (c >> 6)) * GU + 48 + mm) * 64 + (c & 63)] = hv; }
        else if (n < 2560) { const int c = n - 2048; O.GV[((size_t)(bb * GH + (c >> 7)) * GU + 48 + mm) * 128 + (c & 127)] = hv; }
        else if (n < 3072) {}
        else { O.GLR[((size_t)bb * GU + 48 + mm) * 16 + (n - 3072)] = val; }
      }
    }
  }
  __syncthreads();
}

DI void ph_vtrans(int vb, char* smem, const bf16_t* __restrict__ VSB, bf16_t* __restrict__ VTSB) {
  const int tid256_ = fresh_tid() & 255;
  bf16_t (*t)[66] = (bf16_t (*)[66])smem;
  const int tid = TID;
  const int bh = vb / 257, it = vb % 257, idx0 = it * 32;
  {
    const int row = tid >> 3, c8 = tid & 7;
    const u32x4 v = *(const u32x4*)(VSB + ((size_t)bh * KIDX + idx0 + row) * 64 + c8 * 8);
    unsigned* tp = (unsigned*)&t[row][c8 * 8];
    tp[0] = v.x; tp[1] = v.y; tp[2] = v.z; tp[3] = v.w;
  }
  __syncthreads();
  {
    const int d = tid >> 2, i4 = tid & 3;
    unsigned w[4];
#pragma unroll
    for (int j = 0; j < 4; ++j) w[j] = (unsigned)t[i4 * 8 + 2 * j][d] | ((unsigned)t[i4 * 8 + 2 * j + 1][d] << 16);
    *(u32x4*)(VTSB + ((size_t)bh * 64 + d) * KIDX + idx0 + i4 * 8) = (u32x4){w[0], w[1], w[2], w[3]};
  }
  __syncthreads();
}

constexpr float SB_THR = -90.f;
DI void ph_sb_attn(int vb, const bf16_t* __restrict__ QSB, const bf16_t* __restrict__ KSB, const bf16_t* __restrict__ VTSB,
                                                 const float* __restrict__ sb_g, bf16_t* __restrict__ MIX) {
  const int tid256_ = fresh_tid() & 255;
  const int lane = TID & 63, wave = TID >> 6, r = lane & 31, h = lane >> 5;
  const int bh = vb >> 6, qb = vb & 63;
  const int b = bh >> 3, hd = bh & 7;
  const int i0 = qb * 128 + wave * 32;
  const bf16_t* Qb = QSB + ((size_t)bh * SEQ + i0) * 64;
  const bf16_t* Kb = KSB + (size_t)bh * KIDX * 64;
  const bf16_t* Vb = VTSB + (size_t)bh * 64 * KIDX;
  bf16x8 qf[4];
#pragma unroll
  for (int ks = 0; ks < 4; ++ks) qf[ks] = *(const bf16x8*)(Qb + r * 64 + ks * 16 + h * 8);
  f32x16 o[2];
#pragma unroll
  for (int e = 0; e < 16; ++e) { o[0][e] = 0.f; o[1][e] = 0.f; }
  float R = 0.f;
  const int qidx = 32 + i0 + r;
  for (int c = (i0 >> 5) + 1; c >= 0; --c) {
    const int k0 = 32 * c;
    bf16x8 kf[4];
#pragma unroll
    for (int ks = 0; ks < 4; ++ks) kf[ks] = *(const bf16x8*)(Kb + (size_t)(k0 + r) * 64 + ks * 16 + h * 8);
    bf16x8 vf[2][2];
#pragma unroll
    for (int mt = 0; mt < 2; ++mt)
#pragma unroll
      for (int s2 = 0; s2 < 2; ++s2) {
        const bf16_t* vp = Vb + (size_t)(mt * 32 + r) * KIDX + k0 + 16 * s2 + 4 * h;
        const u32x2 lo = *(const u32x2*)vp, hi = *(const u32x2*)(vp + 8);
        u32x4 t; t.x = lo.x; t.y = lo.y; t.z = hi.x; t.w = hi.y;
        vf[mt][s2] = __builtin_bit_cast(bf16x8, t);
      }
    f32x16 s;
#pragma unroll
    for (int e = 0; e < 16; ++e) s[e] = 0.f;
#pragma unroll
    for (int ks = 0; ks < 4; ++ks) s = MFMA32(kf[ks], qf[ks], s);
    float l1m[16], lb[16];
    bool valid[16];
#pragma unroll
    for (int e = 0; e < 16; ++e) {
      const int kidx = k0 + crow(e, h);
      valid[e] = (kidx < qidx) && (kidx >= 16);
      const float z = s[e] * 0.125f;
      const float sp = softplus(z);
      l1m[e] = valid[e] ? -sp : 0.f;
      lb[e] = z - sp;
    }
    float sfx[16], G[4], PG[4];
#pragma unroll
    for (int g = 0; g < 4; ++g) {
      sfx[4 * g + 3] = 0.f;
      sfx[4 * g + 2] = l1m[4 * g + 3];
      sfx[4 * g + 1] = sfx[4 * g + 2] + l1m[4 * g + 2];
      sfx[4 * g + 0] = sfx[4 * g + 1] + l1m[4 * g + 1];
      G[g] = sfx[4 * g + 0] + l1m[4 * g + 0];
      PG[g] = __shfl_xor(G[g], 32);
    }
    float HS[4];
    HS[3] = 0.f;
    HS[2] = G[3] + PG[3];
    HS[1] = HS[2] + G[2] + PG[2];
    HS[0] = HS[1] + G[1] + PG[1];
    const float total = HS[0] + G[0] + PG[0];
    float a[16];
#pragma unroll
    for (int e = 0; e < 16; ++e) {
      const int g = e >> 2;
      const float between = sfx[e] + (h == 0 ? PG[g] : 0.f) + HS[g] + R;
      a[e] = valid[e] ? __expf(lb[e] + between) : 0.f;
    }
    R += total;
#pragma unroll
    for (int s2 = 0; s2 < 2; ++s2) {
      u32x4 p;
      p.x = pk2(a[8 * s2 + 0], a[8 * s2 + 1]); p.y = pk2(a[8 * s2 + 2], a[8 * s2 + 3]);
      p.z = pk2(a[8 * s2 + 4], a[8 * s2 + 5]); p.w = pk2(a[8 * s2 + 6], a[8 * s2 + 7]);
      const bf16x8 pf = __builtin_bit_cast(bf16x8, p);
      o[0] = MFMA32(vf[0][s2], pf, o[0]);
      o[1] = MFMA32(vf[1][s2], pf, o[1]);
    }
    if (__all(R < SB_THR)) break;
  }
  float ss = 0.f;
#pragma unroll
  for (int e = 0; e < 16; ++e) ss += o[0][e] * o[0][e] + o[1][e] * o[1][e];
  ss += __shfl_xor(ss, 32);
  const float sc = rsqrtf(ss * (1.0f / 64.0f) + EPS);
  bf16_t* outp = MIX + (size_t)(b * SEQ + i0 + r) * D + hd * 64;
#pragma unroll
  for (int mt = 0; mt < 2; ++mt)
#pragma unroll
    for (int g = 0; g < 4; ++g) {
      const int d = mt * 32 + 8 * g + 4 * h;
      const f32x4 gg = *(const f32x4*)(sb_g + hd * 64 + d);
      u32x2 pk;
      pk.x = pk2(o[mt][4 * g] * sc * gg.x, o[mt][4 * g + 1] * sc * gg.y);
      pk.y = pk2(o[mt][4 * g + 2] * sc * gg.z, o[mt][4 * g + 3] * sc * gg.w);
      *(u32x2*)(outp + d) = pk;
    }
}

DI void ph_lg(int bu, const float* __restrict__ GLR, const float* __restrict__ wg, const float* __restrict__ bg, float* __restrict__ LG) {
  const int tid256_ = fresh_tid() & 255;
  const int c = TID;
  const int b = bu / GU, u = bu % GU;
  float val = 0.f;
  if (u >= 48) {
    float acc = bg[c];
    const float* g = GLR + (size_t)bu * 16;
#pragma unroll
    for (int k = 0; k < 16; ++k) acc += g[k] * wg[k * 256 + c];
    val = -softplus(-acc) * (1.0f / 16.0f);
  }
  const int hd = c >> 6, d = c & 63;
  LG[((size_t)(b * GH + hd) * GU + u) * 64 + d] = val;
}

DI void ph_gla_v1(int vb, char* smem, const bf16_t* __restrict__ GQ, const bf16_t* __restrict__ GK, const bf16_t* __restrict__ GV,
                                                const float* __restrict__ LG, float* __restrict__ GO) {
  const int tid256_ = fresh_tid() & 255;
  float (*qs)[68] = (float (*)[68])smem;
  float (*ks)[68] = (float (*)[68])(smem + 17408);
  float (*bc)[68] = (float (*)[68])(smem + 2 * 17408);
  float (*at)[68] = bc;
  float (*vs)[36] = (float (*)[36])(smem + 3 * 17408);
  float (*Ss)[36] = (float (*)[36])(smem + 3 * 17408 + 9216);
  float* decs = (float*)(smem + 3 * 17408 + 2 * 9216);
  const int tid = TID;
  const int bh = vb >> 2, es = vb & 3, b = bh >> 2, hd = bh & 3;
  const bf16_t* gq = GQ + (size_t)bh * GU * 64;
  const bf16_t* gk = GK + (size_t)bh * GU * 64;
  const bf16_t* gv = GV + (size_t)bh * GU * 128 + es * 32;
  const float* lg = LG + (size_t)bh * GU * 64;
  const int sd = tid >> 2, eg = tid & 3;
  float S[8];
#pragma unroll
  for (int j = 0; j < 8; ++j) S[j] = 0.f;
  for (int c = 0; c < 129; ++c) {
    const int u0 = c * 64;
#pragma unroll 2
    for (int idx = tid; idx < 4096; idx += 256) {
      const int t = idx >> 6, d = idx & 63;
      qs[t][d] = bf2f(gq[(size_t)(u0 + t) * 64 + d]);
      ks[t][d] = bf2f(gk[(size_t)(u0 + t) * 64 + d]);
      bc[t][d] = lg[(size_t)(u0 + t) * 64 + d];
    }
    for (int idx = tid; idx < 2048; idx += 256) {
      const int t = idx >> 5, e = idx & 31;
      vs[t][e] = bf2f(gv[(size_t)(u0 + t) * 128 + e]);
    }
#pragma unroll
    for (int j = 0; j < 8; ++j) Ss[sd][eg * 8 + j] = S[j];
    __syncthreads();
    if (tid < 64) { float run = 0.f;
#pragma unroll 4
      for (int t = 0; t < 64; ++t) { run += bc[t][tid]; bc[t][tid] = run; } }
    __syncthreads();
#pragma unroll 2
    for (int idx = tid; idx < 4096; idx += 256) {
      const int t = idx >> 6, d = idx & 63;
      const float bv = bc[t][d];
      qs[t][d] *= __expf(bv) * 0.125f;
      ks[t][d] *= __expf(-bv);
    }
    if (tid < 64) decs[tid] = __expf(bc[63][tid]);
    __syncthreads();
    {
      const int ti = tid >> 4, si = tid & 15;
      float acc[4][4];
#pragma unroll
      for (int a = 0; a < 4; ++a)
#pragma unroll
        for (int bb = 0; bb < 4; ++bb) acc[a][bb] = 0.f;
#pragma unroll 1
      for (int d = 0; d < 64; d += 4) {
        f32x4 q4[4], k4[4];
#pragma unroll
        for (int a = 0; a < 4; ++a) q4[a] = *(const f32x4*)&qs[ti + 16 * a][d];
#pragma unroll
        for (int bb = 0; bb < 4; ++bb) k4[bb] = *(const f32x4*)&ks[si + 16 * bb][d];
#pragma unroll
        for (int a = 0; a < 4; ++a)
#pragma unroll
          for (int bb = 0; bb < 4; ++bb)
            acc[a][bb] += q4[a].x * k4[bb].x + q4[a].y * k4[bb].y + q4[a].z * k4[bb].z + q4[a].w * k4[bb].w;
      }
#pragma unroll
      for (int a = 0; a < 4; ++a)
#pragma unroll
        for (int bb = 0; bb < 4; ++bb) {
          const int t = ti + 16 * a, s = si + 16 * bb;
          at[t][s] = (s <= t) ? acc[a][bb] : 0.f;
        }
    }
    __syncthreads();
    {
      const int t = sd;
      float o[8];
#pragma unroll
      for (int j = 0; j < 8; ++j) o[j] = 0.f;
#pragma unroll 2
      for (int d = 0; d < 64; ++d) {
        const float qv = qs[t][d];
        const f32x4 s0 = *(const f32x4*)&Ss[d][eg * 8], s1 = *(const f32x4*)&Ss[d][eg * 8 + 4];
        o[0] += qv * s0.x; o[1] += qv * s0.y; o[2] += qv * s0.z; o[3] += qv * s0.w;
        o[4] += qv * s1.x; o[5] += qv * s1.y; o[6] += qv * s1.z; o[7] += qv * s1.w;
      }
#pragma unroll 2
      for (int s = 0; s < 64; ++s) {
        const float av = at[t][s];
        const f32x4 v0 = *(const f32x4*)&vs[s][eg * 8], v1 = *(const f32x4*)&vs[s][eg * 8 + 4];
        o[0] += av * v0.x; o[1] += av * v0.y; o[2] += av * v0.z; o[3] += av * v0.w;
        o[4] += av * v1.x; o[5] += av * v1.y; o[6] += av * v1.z; o[7] += av * v1.w;
      }
      if (c >= 1) {
        float* op = GO + ((size_t)(b * SEQ + (c - 1) * 64 + t)) * 512 + hd * 128 + es * 32 + eg * 8;
        *(f32x4*)op = (f32x4){o[0], o[1], o[2], o[3]};
        *(f32x4*)(op + 4) = (f32x4){o[4], o[5], o[6], o[7]};
      }
    }
    {
      float n[8];
#pragma unroll
      for (int j = 0; j < 8; ++j) n[j] = S[j];
#pragma unroll 2
      for (int s = 0; s < 64; ++s) {
        const float kv = ks[s][sd];
        const f32x4 v0 = *(const f32x4*)&vs[s][eg * 8], v1 = *(const f32x4*)&vs[s][eg * 8 + 4];
        n[0] += kv * v0.x; n[1] += kv * v0.y; n[2] += kv * v0.z; n[3] += kv * v0.w;
        n[4] += kv * v1.x; n[5] += kv * v1.y; n[6] += kv * v1.z; n[7] += kv * v1.w;
      }
      const float dec = decs[sd];
#pragma unroll
      for (int j = 0; j < 8; ++j) S[j] = dec * n[j];
    }
    __syncthreads();
  }
}

DI void ph_gla_norm(int m, const float* __restrict__ GO, const bf16_t* __restrict__ GR, const float* __restrict__ gla_g, bf16_t* __restrict__ MIX) {
  const int tid256_ = fresh_tid() & 255;
  const int hd = TID >> 6, lane = TID & 63;
  const f32x2 v = *(const f32x2*)(GO + (size_t)m * 512 + hd * 128 + lane * 2);
  float ss = wave_sum(v.x * v.x + v.y * v.y);
  const float sc = rsqrtf(ss * (1.0f / 128.0f) + EPS);
  const unsigned g2 = *(const unsigned*)(GR + (size_t)m * 512 + hd * 128 + lane * 2);
  const float g0 = bflo(g2), g1 = bfhi(g2);
  const f32x2 gn = *(const f32x2*)(gla_g + hd * 128 + lane * 2);
  const float s0 = g0 / (1.f + __expf(-g0)), s1 = g1 / (1.f + __expf(-g1));
  *(unsigned*)(MIX + (size_t)m * D + 512 + hd * 128 + lane * 2) = pk2(v.x * sc * gn.x * s0, v.y * sc * gn.y * s1);
}

DI bool better(float v1, int i1, float v2, int i2) { return (v1 > v2) || (v1 == v2 && i1 < i2); }
DI void wave_argmax(float& v, int& i) {
#pragma unroll
  for (int o = 32; o >= 1; o >>= 1) {
    const float ov = __shfl_xor(v, o);
    const int oi = __shfl_xor(i, o);
    if (better(ov, oi, v, i)) { v = ov; i = oi; }
  }
}
constexpr int RT_TOK_PER_BLOCK = 256;
DI void ph_route_v1(int vb, char* smem, const bf16_t* __restrict__ QP, const float* __restrict__ sk1, const float* __restrict__ sk2,
                                                  int* __restrict__ EIDX, float* __restrict__ GATE) {
  const int tid256_ = fresh_tid() & 255;
  float (*K1)[68] = (float (*)[68])smem;
  float (*K2)[68] = (float (*)[68])(smem + 34816);
  float (*qsh)[128] = (float (*)[128])(smem + 2 * 34816);
  const int hd = vb & 7, tg = vb >> 3;
  const int tid = TID, lane = tid & 63, wave = tid >> 6;
  for (int idx = tid; idx < 128 * 64; idx += 256) {
    const int k = idx >> 6, d = idx & 63;
    K1[k][d] = sk1[((size_t)hd * 128 + k) * 64 + d];
    K2[k][d] = sk2[((size_t)hd * 128 + k) * 64 + d];
  }
  __syncthreads();
  const float NEG = -3.0e38f;
  for (int it = 0; it < RT_TOK_PER_BLOCK / 4; ++it) {
    const int m = tg * RT_TOK_PER_BLOCK + it * 4 + wave;
    {
      const unsigned q2 = *(const unsigned*)(QP + (size_t)m * D + hd * 128 + lane * 2);
      qsh[wave][lane * 2] = bflo(q2); qsh[wave][lane * 2 + 1] = bfhi(q2);
    }
    __builtin_amdgcn_wave_barrier();
    float s1a = 0.f, s1b = 0.f, s2a = 0.f, s2b = 0.f;
#pragma unroll 4
    for (int d = 0; d < 64; d += 4) {
      const f32x4 q1 = *(const f32x4*)&qsh[wave][d], q2 = *(const f32x4*)&qsh[wave][64 + d];
      const f32x4 a = *(const f32x4*)&K1[lane][d], bb = *(const f32x4*)&K1[lane + 64][d];
      const f32x4 c = *(const f32x4*)&K2[lane][d], dd = *(const f32x4*)&K2[lane + 64][d];
      s1a += q1.x * a.x + q1.y * a.y + q1.z * a.z + q1.w * a.w;
      s1b += q1.x * bb.x + q1.y * bb.y + q1.z * bb.z + q1.w * bb.w;
      s2a += q2.x * c.x + q2.y * c.y + q2.z * c.z + q2.w * c.w;
      s2b += q2.x * dd.x + q2.y * dd.y + q2.z * dd.z + q2.w * dd.w;
    }
    __builtin_amdgcn_wave_barrier();
    float tv1 = 0.f, tv2 = 0.f; int ti1 = 0, ti2 = 0;
    for (int rr = 0; rr < 16; ++rr) {
      float v; int i;
      if (better(s1a, lane, s1b, lane + 64)) { v = s1a; i = lane; } else { v = s1b; i = lane + 64; }
      wave_argmax(v, i);
      if (lane == rr) { tv1 = v; ti1 = i; }
      if (i == lane) s1a = NEG;
      if (i == lane + 64) s1b = NEG;
      if (better(s2a, lane, s2b, lane + 64)) { v = s2a; i = lane; } else { v = s2b; i = lane + 64; }
      wave_argmax(v, i);
      if (lane == rr) { tv2 = v; ti2 = i; }
      if (i == lane) s2a = NEG;
      if (i == lane + 64) s2b = NEG;
    }
    const int ca = lane >> 2;
    const float va = __shfl(tv1, ca); const int ia = __shfl(ti1, ca);
    float cv[4]; int ce[4];
#pragma unroll
    for (int j = 0; j < 4; ++j) {
      const int cb = (lane & 3) * 4 + j;
      cv[j] = va + __shfl(tv2, cb);
      ce[j] = ia * 128 + __shfl(ti2, cb);
    }
    float fsc = 0.f; int fe = 0;
    for (int rr = 0; rr < 16; ++rr) {
      float v = cv[0]; int p = lane * 4;
#pragma unroll
      for (int j = 1; j < 4; ++j) if (better(cv[j], lane * 4 + j, v, p)) { v = cv[j]; p = lane * 4 + j; }
      wave_argmax(v, p);
      const int src = p >> 2, jj = p & 3;
      int e = (jj == 0) ? ce[0] : (jj == 1) ? ce[1] : (jj == 2) ? ce[2] : ce[3];
      e = __shfl(e, src);
      if (lane == rr) { fsc = v; fe = e; }
      if (lane == src) {
        if (jj == 0) cv[0] = NEG; else if (jj == 1) cv[1] = NEG; else if (jj == 2) cv[2] = NEG; else cv[3] = NEG;
      }
    }
    const float mx = __shfl(fsc, 0);
    float ex = (lane < 16) ? __expf(fsc - mx) : 0.f;
    const float sum = wave_sum(ex);
    if (lane < 16) {
      EIDX[(size_t)m * 128 + hd * 16 + lane] = fe;
      GATE[(size_t)m * 128 + hd * 16 + lane] = ex / sum;
    }
  }
  __syncthreads();
}


#define MFMA16(a, b, c) __builtin_amdgcn_mfma_f32_16x16x32_bf16((a), (b), (c), 0, 0, 0)
constexpr int GLDS = 72;
struct GlaLds {
  bf16_t Qt[64 * GLDS];
  bf16_t Kt[64 * GLDS];
  bf16_t KT[64 * GLDS];
  bf16_t P[64 * GLDS];
  float dec[64];
  float tot[8][64];
  float ssq[8][64];
};
constexpr size_t WS_SLOC = 926 * MiB;
constexpr size_t WS_DTOT = 942 * MiB;
constexpr size_t WS_GVT = 604 * MiB;

struct GlaPtrs { const bf16_t *GQ, *GK, *GVT, *GR; const float *GLR, *wg, *bg, *gla_g; float *SLOC, *DTOT; bf16_t* MIX; };

template <int PASS>
DI void gla_item(int bh, int sc, char* smem, const GlaPtrs& G) {
  GlaLds& L = *(GlaLds*)smem;
  const int tid = fresh_tid(), lane = tid & 63, w = __builtin_amdgcn_readfirstlane(tid >> 6), c16 = lane & 15, q = lane >> 4;
  const int b = bh >> 2, hd = bh & 3;
  const int cbeg = sc == 0 ? 0 : 8 * sc + 1, cend = 8 * sc + 9;
  float wgr[16];
#pragma unroll
  for (int k = 0; k < 16; ++k) wgr[k] = G.wg[k * 256 + hd * 64 + lane];
  const float bgv = G.bg[hd * 64 + lane];
  f32x4 X[4];
#pragma unroll
  for (int i = 0; i < 4; ++i) X[i] = (f32x4){0.f, 0.f, 0.f, 0.f};
  if (PASS == 1) {
    for (int j = 0; j < sc; ++j) {
      const float* dt = G.DTOT + (size_t)(bh * 16 + j) * 64;
      const float* sl = G.SLOC + ((size_t)(bh * 16 + j) * 8 + w) * 16 * 64 + lane;
#pragma unroll
      for (int i = 0; i < 4; ++i) {
        const f32x4 d4 = *(const f32x4*)(dt + 16 * i + 4 * q);
        X[i][0] = d4.x * X[i][0] + sl[(4 * i + 0) * 64]; X[i][1] = d4.y * X[i][1] + sl[(4 * i + 1) * 64];
        X[i][2] = d4.z * X[i][2] + sl[(4 * i + 2) * 64]; X[i][3] = d4.w * X[i][3] + sl[(4 * i + 3) * 64];
      }
    }
  }
  f32x4 gain = {1.f, 1.f, 1.f, 1.f};
  if (PASS == 1) gain = *(const f32x4*)(G.gla_g + hd * 128 + 16 * w + 4 * q);
  float blsum = 0.f;
  const bf16_t* gq = G.GQ + (size_t)bh * GU * 64 + lane;
  const bf16_t* gk = G.GK + (size_t)bh * GU * 64 + lane;
  const bf16_t* gvt = G.GVT + ((size_t)bh * 128 + 16 * w + c16) * GU + 8 * q;
  for (int c = cbeg; c < cend; ++c) {
    const int u0 = 64 * c;
    float cs[8];
    {
      float run = 0.f;
#pragma unroll
      for (int i = 0; i < 8; ++i) {
        const int u = u0 + 8 * w + i;
        float lgv = 0.f;
        if (u >= 48) {
          const f32x4* gp = (const f32x4*)(G.GLR + ((size_t)b * GU + u) * 16);
          const f32x4 g0 = gp[0], g1 = gp[1], g2 = gp[2], g3 = gp[3];
          float a = bgv;
          a += g0.x * wgr[0] + g0.y * wgr[1] + g0.z * wgr[2] + g0.w * wgr[3];
          a += g1.x * wgr[4] + g1.y * wgr[5] + g1.z * wgr[6] + g1.w * wgr[7];
          a += g2.x * wgr[8] + g2.y * wgr[9] + g2.z * wgr[10] + g2.w * wgr[11];
          a += g3.x * wgr[12] + g3.y * wgr[13] + g3.z * wgr[14] + g3.w * wgr[15];
          lgv = -softplus(-a) * (1.0f / 16.0f);
        }
        run += lgv; cs[i] = run;
      }
      L.tot[w][lane] = run;
    }
    bf16x8 vfr[2];
    vfr[0] = *(const bf16x8*)(gvt + u0);
    vfr[1] = *(const bf16x8*)(gvt + u0 + 32);
    unsigned short kraw[8], qraw[8];
#pragma unroll
    for (int i = 0; i < 8; ++i) {
      kraw[i] = gk[(size_t)(u0 + 8 * w + i) * 64];
      if (PASS == 1) qraw[i] = gq[(size_t)(u0 + 8 * w + i) * 64];
    }
    __syncthreads();
    {
      float offset = 0.f, total = 0.f;
#pragma unroll
      for (int s2 = 0; s2 < 8; ++s2) { const float tv = L.tot[s2][lane]; total += tv; if (s2 < w) offset += tv; }
      blsum += total;
      if (w == 0) L.dec[lane] = __expf(total);
      float kt[8];
#pragma unroll
      for (int i = 0; i < 8; ++i) {
        const float bc = offset + cs[i];
        kt[i] = bf2f(kraw[i]) * __expf(-bc);
        if (PASS == 1) {
          L.Qt[(8 * w + i) * GLDS + lane] = (bf16_t)f2bf(bf2f(qraw[i]) * __expf(bc) * 0.125f);
          L.Kt[(8 * w + i) * GLDS + lane] = (bf16_t)f2bf(kt[i]);
        }
      }
      u32x4 kp; kp.x = pk2(kt[0], kt[1]); kp.y = pk2(kt[2], kt[3]); kp.z = pk2(kt[4], kt[5]); kp.w = pk2(kt[6], kt[7]);
      *(u32x4*)&L.KT[lane * GLDS + 8 * w] = kp;
    }
    __syncthreads();
    f32x4 OT[4];
    if (PASS == 1) {
      const int is = w >> 1;
#pragma unroll
      for (int z = 0; z < 2; ++z) {
        const int it = 2 * (w & 1) + z;
        f32x4 pa = {0.f, 0.f, 0.f, 0.f};
        if (is <= it) {
#pragma unroll
          for (int kk = 0; kk < 2; ++kk) {
            const bf16x8 ka = *(const bf16x8*)&L.Kt[(16 * is + c16) * GLDS + 32 * kk + 8 * q];
            const bf16x8 qb = *(const bf16x8*)&L.Qt[(16 * it + c16) * GLDS + 32 * kk + 8 * q];
            pa = MFMA16(ka, qb, pa);
          }
          if (is == it) {
#pragma unroll
            for (int r = 0; r < 4; ++r) if (4 * q + r > c16) pa[r] = 0.f;
          }
        }
        u32x2 pw; pw.x = pk2(pa[0], pa[1]); pw.y = pk2(pa[2], pa[3]);
        *(u32x2*)&L.P[(16 * it + c16) * GLDS + 16 * is + 4 * q] = pw;
      }
#pragma unroll
      for (int n = 0; n < 4; ++n) OT[n] = (f32x4){0.f, 0.f, 0.f, 0.f};
#pragma unroll
      for (int kk = 0; kk < 2; ++kk) {
        u32x4 xp; xp.x = pk2(X[2 * kk][0], X[2 * kk][1]); xp.y = pk2(X[2 * kk][2], X[2 * kk][3]);
        xp.z = pk2(X[2 * kk + 1][0], X[2 * kk + 1][1]); xp.w = pk2(X[2 * kk + 1][2], X[2 * kk + 1][3]);
        const bf16x8 xa = __builtin_bit_cast(bf16x8, xp);
#pragma unroll
        for (int n = 0; n < 4; ++n) {
          const u32x2 lo = *(const u32x2*)&L.Qt[(16 * n + c16) * GLDS + 32 * kk + 4 * q];
          const u32x2 hi = *(const u32x2*)&L.Qt[(16 * n + c16) * GLDS + 32 * kk + 16 + 4 * q];
          u32x4 qq; qq.x = lo.x; qq.y = lo.y; qq.z = hi.x; qq.w = hi.y;
          OT[n] = MFMA16(xa, __builtin_bit_cast(bf16x8, qq), OT[n]);
        }
      }
      __syncthreads();
#pragma unroll
      for (int kk = 0; kk < 2; ++kk)
#pragma unroll
        for (int n = 0; n < 4; ++n) {
          const bf16x8 pb = *(const bf16x8*)&L.P[(16 * n + c16) * GLDS + 32 * kk + 8 * q];
          OT[n] = MFMA16(vfr[kk], pb, OT[n]);
        }
    }
#pragma unroll
    for (int i = 0; i < 4; ++i) {
#pragma unroll
      for (int kk = 0; kk < 2; ++kk) {
        const bf16x8 ka = *(const bf16x8*)&L.KT[(16 * i + c16) * GLDS + 32 * kk + 8 * q];
        X[i] = MFMA16(ka, vfr[kk], X[i]);
      }
      const f32x4 d4 = *(const f32x4*)&L.dec[16 * i + 4 * q];
      X[i][0] *= d4.x; X[i][1] *= d4.y; X[i][2] *= d4.z; X[i][3] *= d4.w;
    }
    if (PASS == 1) {
      if (c >= 1) {
        float ss[4];
#pragma unroll
        for (int n = 0; n < 4; ++n) {
          float v = OT[n][0] * OT[n][0] + OT[n][1] * OT[n][1] + OT[n][2] * OT[n][2] + OT[n][3] * OT[n][3];
          v += __shfl_xor(v, 16); v += __shfl_xor(v, 32);
          ss[n] = v;
        }
        if (q == 0) {
#pragma unroll
          for (int n = 0; n < 4; ++n) L.ssq[w][16 * n + c16] = ss[n];
        }
        __syncthreads();
#pragma unroll
        for (int n = 0; n < 4; ++n) {
          float tot = 0.f;
#pragma unroll
          for (int w2 = 0; w2 < 8; ++w2) tot += L.ssq[w2][16 * n + c16];
          const float scl = rsqrtf(tot * (1.0f / 128.0f) + EPS);
          const size_t m = (size_t)b * SEQ + 64 * (c - 1) + 16 * n + c16;
          const u32x2 g2 = *(const u32x2*)(G.GR + m * 512 + hd * 128 + 16 * w + 4 * q);
          const float r0 = bflo(g2.x), r1 = bfhi(g2.x), r2 = bflo(g2.y), r3 = bfhi(g2.y);
          const float o0 = OT[n][0] * scl * gain.x * (r0 / (1.f + __expf(-r0)));
          const float o1 = OT[n][1] * scl * gain.y * (r1 / (1.f + __expf(-r1)));
          const float o2 = OT[n][2] * scl * gain.z * (r2 / (1.f + __expf(-r2)));
          const float o3 = OT[n][3] * scl * gain.w * (r3 / (1.f + __expf(-r3)));
          u32x2 ow; ow.x = pk2(o0, o1); ow.y = pk2(o2, o3);
          *(u32x2*)(G.MIX + m * D + 512 + hd * 128 + 16 * w + 4 * q) = ow;
        }
      }
    }
    __syncthreads();
  }
  if (PASS == 0) {
    float* sl = G.SLOC + ((size_t)(bh * 16 + sc) * 8 + w) * 16 * 64 + lane;
#pragma unroll
    for (int i = 0; i < 4; ++i)
#pragma unroll
      for (int r = 0; r < 4; ++r) sl[(4 * i + r) * 64] = X[i][r];
    if (w == 0) G.DTOT[(size_t)(bh * 16 + sc) * 64 + lane] = __expf(blsum);
  }
}

DI void ph_gvtrans(int vb, char* smem, const bf16_t* __restrict__ GV, bf16_t* __restrict__ GVT) {
  const int tid256_ = fresh_tid() & 255;
  bf16_t (*t)[66] = (bf16_t (*)[66])smem;
  const int tid = TID;
  const int eh = vb & 1, rest = vb >> 1, bh = rest / 258, ut = rest % 258, u0 = ut * 32;
  {
    const int row = tid >> 3, c8 = tid & 7;
    const u32x4 v = *(const u32x4*)(GV + ((size_t)bh * GU + u0 + row) * 128 + eh * 64 + c8 * 8);
    unsigned* tp = (unsigned*)&t[row][c8 * 8];
    tp[0] = v.x; tp[1] = v.y; tp[2] = v.z; tp[3] = v.w;
  }
  __syncthreads();
  {
    const int d = tid >> 2, i4 = tid & 3;
    unsigned wv[4];
#pragma unroll
    for (int j = 0; j < 4; ++j) wv[j] = (unsigned)t[i4 * 8 + 2 * j][d] | ((unsigned)t[i4 * 8 + 2 * j + 1][d] << 16);
    *(u32x4*)(GVT + ((size_t)bh * 128 + eh * 64 + d) * GU + u0 + i4 * 8) = (u32x4){wv[0], wv[1], wv[2], wv[3]};
  }
  __syncthreads();
}

DI void ce_desc(float& a, float& b) {
  float hi, lo;
  asm("v_max_f32 %0, %1, %2" : "=v"(hi) : "v"(a), "v"(b));
  asm("v_min_f32 %0, %1, %2" : "=v"(lo) : "v"(a), "v"(b));
  a = hi; b = lo;
}
DI float vmaxf(float a, float b) { float hi; asm("v_max_f32 %0, %1, %2" : "=v"(hi) : "v"(a), "v"(b)); return hi; }
template <int N> DI void bitonic_sort_desc(float (&v)[N]) {
#pragma unroll
  for (int k = 2; k <= N; k <<= 1) {
#pragma unroll
    for (int j = k >> 1; j > 0; j >>= 1) {
#pragma unroll
      for (int i = 0; i < N; ++i) {
        const int l = i ^ j;
        if (l > i) { if ((i & k) == 0) ce_desc(v[i], v[l]); else ce_desc(v[l], v[i]); }
      }
    }
  }
}
DI void bitonic_merge16_desc(float (&v)[16]) {
#pragma unroll
  for (int j = 8; j > 0; j >>= 1) {
#pragma unroll
    for (int i = 0; i < 16; ++i) { const int l = i ^ j; if (l > i) ce_desc(v[i], v[l]); }
  }
}
template <int NBV> DI void merge_prune16(float (&a)[16], const float (&b)[16]) {
#pragma unroll
  for (int i = 16 - NBV; i < 16; ++i) a[i] = vmaxf(a[i], b[15 - i]);
  bitonic_merge16_desc(a);
}
DI float selh(int hh, float a, float b) { asm volatile("" : "+v"(a), "+v"(b)); return hh == 0 ? a : b; }
DI float pack_idx(float v, unsigned idx, unsigned mask) { return __uint_as_float((__float_as_uint(v) & ~mask) | idx); }

DI void ph_route_v2(int vb, char* smem, const bf16_t* __restrict__ QP, const bf16_t* __restrict__ SK1b, const bf16_t* __restrict__ SK2b,
                    unsigned short* __restrict__ EIDX, float* __restrict__ GATE) {
  const int tid256_ = fresh_tid() & 255;
  const int lane = TID & 63, wave = TID >> 6, r = lane & 31, hh = lane >> 5;
  const int hd = vb & 7, tile = vb >> 3;
  const int m = tile * 128 + wave * 32 + r;
  float loc[2][16];
#pragma unroll
  for (int L = 0; L < 2; ++L) {
    const bf16_t* qp = QP + (size_t)m * D + hd * 128 + L * 64 + hh * 8;
    const bf16_t* kb = (L == 0 ? SK1b : SK2b) + (size_t)(hd * 128 + r) * 64 + hh * 8;
    bf16x8 qf[4];
#pragma unroll
    for (int ks = 0; ks < 4; ++ks) qf[ks] = *(const bf16x8*)(qp + ks * 16);
    float grp[4][16];
#pragma unroll
    for (int mt = 0; mt < 4; ++mt) {
      f32x16 acc;
#pragma unroll
      for (int e = 0; e < 16; ++e) acc[e] = 0.f;
#pragma unroll
      for (int ks = 0; ks < 4; ++ks) {
        const bf16x8 kf = *(const bf16x8*)(kb + (size_t)mt * 32 * 64 + ks * 16);
        acc = MFMA32(kf, qf[ks], acc);
      }
#pragma unroll
      for (int e = 0; e < 16; ++e) grp[mt][e] = pack_idx(acc[e], (unsigned)(mt * 32 + crow(e, hh)), 127u);
      bitonic_sort_desc<16>(grp[mt]);
    }
    merge_prune16<16>(grp[0], grp[1]);
    merge_prune16<16>(grp[2], grp[3]);
    merge_prune16<16>(grp[0], grp[2]);
#pragma unroll
    for (int i = 0; i < 16; ++i) loc[L][i] = grp[0][i];
  }
  float fin[16], oth[16];
#pragma unroll
  for (int i = 0; i < 16; ++i) {
    const float send = selh(hh, loc[1][i], loc[0][i]);
    oth[i] = __shfl_xor(send, 32);
    fin[i] = selh(hh, loc[0][i], loc[1][i]);
  }
  merge_prune16<16>(fin, oth);
  float v1[16], v2[16];
#pragma unroll
  for (int i = 0; i < 16; ++i) {
    const float o = __shfl_xor(fin[i], 32);
    v1[i] = selh(hh, fin[i], o);
    v2[i] = selh(hh, o, fin[i]);
  }
  unsigned* ib = (unsigned*)smem + (size_t)TID * 8;
#pragma unroll
  for (int q = 0; q < 4; ++q) {
    unsigned w1 = 0, w2 = 0;
#pragma unroll
    for (int j = 0; j < 4; ++j) {
      w1 |= (__float_as_uint(v1[4 * q + j]) & 127u) << (8 * j);
      w2 |= (__float_as_uint(v2[4 * q + j]) & 127u) << (8 * j);
    }
    ib[q] = w1; ib[4 + q] = w2;
  }
  float R[16], Bv[16];
#pragma unroll
  for (int j = 0; j < 16; ++j) R[j] = pack_idx(v1[0] + v2[j], (unsigned)j, 255u);
#define ROUTE_ROW(I, CNT) { _Pragma("unroll") for (int j = 0; j < 16; ++j) Bv[j] = (j < CNT) ? pack_idx(v1[I] + v2[j < CNT ? j : 0], (unsigned)(I * 16 + j), 255u) : 0.f; \
    merge_prune16<CNT>(R, Bv); }
  ROUTE_ROW(1, 8) ROUTE_ROW(2, 5) ROUTE_ROW(3, 4) ROUTE_ROW(4, 3) ROUTE_ROW(5, 2) ROUTE_ROW(6, 2) ROUTE_ROW(7, 2)
#undef ROUTE_ROW
#pragma unroll
  for (int j = 0; j < 16; ++j) Bv[j] = (j < 8) ? pack_idx(v1[8 + (j < 8 ? j : 0)] + v2[0], (unsigned)((8 + j) * 16), 255u) : 0.f;
  merge_prune16<8>(R, Bv);
  float ex[16], sum = 0.f;
#pragma unroll
  for (int i = 0; i < 16; ++i) { ex[i] = __expf(R[i] - R[0]); sum += ex[i]; }
  const float inv = 1.f / sum;
  const unsigned char* ibb = (const unsigned char*)ib;
  int eo[8]; float go[8];
#pragma unroll
  for (int w = 0; w < 8; ++w) {
    const float rv = selh(hh, R[w], R[8 + w]);
    const float ev = selh(hh, ex[w], ex[8 + w]);
    const unsigned pos = __float_as_uint(rv) & 255u;
    const unsigned i1 = ibb[pos >> 4], i2 = ibb[16 + (pos & 15u)];
    eo[w] = (int)(i1 * 128u + i2);
    go[w] = ev * inv;
  }
  unsigned short* ep = EIDX + (size_t)m * 128 + hd * 16 + hh * 8;
  float* gp = GATE + (size_t)m * 128 + hd * 16 + hh * 8;
  *(u32x4*)ep = (u32x4){(unsigned)eo[0] | ((unsigned)eo[1] << 16), (unsigned)eo[2] | ((unsigned)eo[3] << 16), (unsigned)eo[4] | ((unsigned)eo[5] << 16), (unsigned)eo[6] | ((unsigned)eo[7] << 16)};
  *(f32x4*)gp = (f32x4){go[0], go[1], go[2], go[3]};
  *(f32x4*)(gp + 4) = (f32x4){go[4], go[5], go[6], go[7]};
}

DI void ph_peer_v1(int vb, char* smem, const bf16_t* __restrict__ A2, const bf16_t* __restrict__ EU, const bf16_t* __restrict__ EV,
                                                 const int* __restrict__ EIDX, const float* __restrict__ GATE, const float* __restrict__ H1,
                                                 const float* __restrict__ gf, float* __restrict__ out) {
  const int tid256_ = fresh_tid() & 255;
  float (*cs)[128] = (float (*)[128])smem;
  int (*es)[128] = (int (*)[128])(smem + 2048);
  const int lane = TID & 63, wave = TID >> 6;
  const int m = vb * 4 + wave;
  const int g = lane >> 3, sub = lane & 7;
  u32x4 xf[16];
#pragma unroll
  for (int j = 0; j < 16; ++j) xf[j] = *(const u32x4*)(A2 + (size_t)m * D + (j * 8 + sub) * 8);
  for (int bt = 0; bt < 16; ++bt) {
    const int k = bt * 8 + g;
    const int e = EIDX[(size_t)m * 128 + k];
    const bf16_t* up = EU + (size_t)e * D + sub * 8;
    float acc = 0.f;
#pragma unroll
    for (int j = 0; j < 16; ++j) {
      const u32x4 u = *(const u32x4*)(up + j * 64);
      acc = dot2bf(u.x, xf[j].x, acc); acc = dot2bf(u.y, xf[j].y, acc); acc = dot2bf(u.z, xf[j].z, acc); acc = dot2bf(u.w, xf[j].w, acc);
    }
    acc += __shfl_xor(acc, 1); acc += __shfl_xor(acc, 2); acc += __shfl_xor(acc, 4);
    if (sub == 0) {
      const float act = 0.5f * acc * (1.f + erff(acc * 0.70710678118654752f));
      cs[wave][k] = GATE[(size_t)m * 128 + k] * act;
      es[wave][k] = e;
    }
  }
  __builtin_amdgcn_wave_barrier();
  __syncthreads();
  float y[16];
#pragma unroll
  for (int j = 0; j < 16; ++j) y[j] = 0.f;
#pragma unroll 4
  for (int k = 0; k < 128; ++k) {
    const float c = cs[wave][k];
    const bf16_t* vp = EV + (size_t)es[wave][k] * D + lane * 8;
    const u32x4 v0 = *(const u32x4*)vp, v1 = *(const u32x4*)(vp + 512);
    y[0] += c * bflo(v0.x); y[1] += c * bfhi(v0.x); y[2] += c * bflo(v0.y); y[3] += c * bfhi(v0.y);
    y[4] += c * bflo(v0.z); y[5] += c * bfhi(v0.z); y[6] += c * bflo(v0.w); y[7] += c * bfhi(v0.w);
    y[8] += c * bflo(v1.x); y[9] += c * bfhi(v1.x); y[10] += c * bflo(v1.y); y[11] += c * bfhi(v1.y);
    y[12] += c * bflo(v1.z); y[13] += c * bfhi(v1.z); y[14] += c * bflo(v1.w); y[15] += c * bfhi(v1.w);
  }
  const float* hp = H1 + (size_t)m * D + lane * 8;
  float ss = 0.f;
#pragma unroll
  for (int q = 0; q < 4; ++q) {
    const f32x4 hv = *(const f32x4*)(hp + (q >> 1) * 512 + (q & 1) * 4);
    y[q * 4 + 0] += hv.x; y[q * 4 + 1] += hv.y; y[q * 4 + 2] += hv.z; y[q * 4 + 3] += hv.w;
  }
#pragma unroll
  for (int j = 0; j < 16; ++j) ss += y[j] * y[j];
  ss = wave_sum(ss);
  const float sc = rsqrtf(ss * (1.0f / D) + EPS);
  float* op = out + (size_t)m * D + lane * 8;
#pragma unroll
  for (int q = 0; q < 4; ++q) {
    const int off = (q >> 1) * 512 + (q & 1) * 4;
    const f32x4 gg = *(const f32x4*)(gf + lane * 8 + off);
    *(f32x4*)(op + off) = (f32x4){y[q * 4 + 0] * sc * gg.x, y[q * 4 + 1] * sc * gg.y, y[q * 4 + 2] * sc * gg.z, y[q * 4 + 3] * sc * gg.w};
  }
}


DI void ph_convert_eu(const float* __restrict__ src, bf16_t* __restrict__ EUs) {
  size_t i = (size_t)blockIdx.x * blockDim.x + threadIdx.x;
  const size_t stride = (size_t)gridDim.x * blockDim.x;
  for (; i < (size_t)NEXP * 128; i += stride) {
    const int e = (int)(i >> 7), pz = (int)(i & 127);
    const f32x4 a = ((const f32x4*)src)[2 * i], b = ((const f32x4*)src)[2 * i + 1];
    u32x4 o; o.x = pk2(a.x, a.y); o.y = pk2(a.z, a.w); o.z = pk2(b.x, b.y); o.w = pk2(b.z, b.w);
    *(u32x4*)(EUs + ((size_t)(pz >> 3) * NEXP + e) * 64 + (pz & 7) * 8) = o;
  }
}
DI void ph_convert_ev(int vb, char* smem, const float* __restrict__ src, bf16_t* __restrict__ EVc) {
  const int tid256_ = fresh_tid() & 255;
  bf16_t (*t)[1028] = (bf16_t (*)[1028])smem;
  const int e0 = vb * 32;
  for (int r = 0; r < 32; ++r) {
    const f32x4 a = *(const f32x4*)(src + (size_t)(e0 + r) * D + TID * 4);
    u32x2 o; o.x = pk2(a.x, a.y); o.y = pk2(a.z, a.w);
    *(u32x2*)&t[r][TID * 4] = o;
  }
  __syncthreads();
  const int r = TID & 31, cs = TID >> 5;
  for (int c0 = 0; c0 < 256; c0 += 8) {
    const int cg = c0 + cs;
    const u32x2 v = *(const u32x2*)&t[r][cg * 4];
    *(u32x2*)(EVc + ((size_t)cg * NEXP + e0 + r) * 4) = v;
  }
  __syncthreads();
}

DI float dpp_sum8(float v) {
  v += __shfl_xor(v, 1); v += __shfl_xor(v, 2); v += __shfl_xor(v, 4);
  return v;
}
DI void ph_peer_u(int xi, int nx, int wv, int nwv, const bf16_t* __restrict__ A2, const bf16_t* __restrict__ EUs,
                  const unsigned short* __restrict__ EIDX, bf16_t* __restrict__ PP) {
  const int lane = fresh_tid() & 63, g = lane >> 3, sub = lane & 7;
  for (int s = xi; s < 16; s += nx) {
    const bf16_t* tab = EUs + (size_t)s * NEXP * 64 + sub * 8;
    bf16_t* pp = PP + (size_t)s * TREAL * 128;
    for (int t = wv; t < TREAL; t += nwv) {
      const unsigned idxpair = __builtin_nontemporal_load((const unsigned*)(EIDX + (size_t)t * 128) + lane);
      const u32x4 xs = *(const u32x4*)(A2 + (size_t)t * D + s * 64 + sub * 8);
      u32x4 u[16];
#pragma unroll
      for (int j = 0; j < 16; ++j) {
        const unsigned w = (unsigned)__shfl((int)idxpair, (lane & ~7) + (j >> 1));
        const unsigned e = (j & 1) ? (w >> 16) : (w & 0xffffu);
        u[j] = *(const u32x4*)(tab + (size_t)e * 64);
      }
      float res0 = 0.f, res1 = 0.f;
#pragma unroll
      for (int j = 0; j < 16; ++j) {
        float acc = 0.f;
        acc = dot2bf(u[j].x, xs.x, acc); acc = dot2bf(u[j].y, xs.y, acc); acc = dot2bf(u[j].z, xs.z, acc); acc = dot2bf(u[j].w, xs.w, acc);
        acc = dpp_sum8(acc);
        if (sub == (j >> 1)) { if (j & 1) res1 = acc; else res0 = acc; }
      }
      __builtin_nontemporal_store(pk2(res0, res1), (unsigned*)(pp + (size_t)t * 128) + lane);
    }
  }
}
DI void ph_peer_c(const bf16_t* __restrict__ PP, const unsigned short* __restrict__ EIDX, const float* __restrict__ GATE, unsigned* __restrict__ STREAM) {
  size_t i = (size_t)blockIdx.x * blockDim.x + threadIdx.x;
  const size_t stride = (size_t)gridDim.x * blockDim.x, n = (size_t)TREAL * 128;
  for (; i < n; i += stride) {
    float a = 0.f;
#pragma unroll
    for (int s = 0; s < 16; ++s) a += bf2f(PP[(size_t)s * n + i]);
    const float act = 0.5f * a * (1.f + erff(a * 0.70710678118654752f));
    const float c = GATE[i] * act;
    const size_t t = i >> 7; const unsigned k = (unsigned)(i & 127);
    STREAM[(((t >> 6) * 32 + (k >> 2)) * 64 + (t & 63)) * 4 + (k & 3)] = (unsigned)EIDX[i] | (f2bf(c) << 16);
  }
}
DI void ph_peer_v(char* smem, const unsigned* __restrict__ STREAM, const bf16_t* __restrict__ EVc, float* __restrict__ YT) {
  const int tid = fresh_tid(), lane = tid & 63, wave = tid >> 6;
  u32x2* tabl = (u32x2*)smem;
  for (int cg = blockIdx.x; cg < 256; cg += gridDim.x) {
    const u32x4* src = (const u32x4*)(EVc + (size_t)cg * NEXP * 4);
#pragma unroll 4
    for (int i = tid; i < NEXP * 8 / 16; i += 512) ((u32x4*)smem)[i] = src[i];
    __syncthreads();
    for (int it = wave; it < TREAL / 64; it += 8) {
      const int t = it * 64 + lane;
      const u32x4* sp = (const u32x4*)(STREAM + (size_t)it * 8192) + lane;
      float y0 = 0.f, y1 = 0.f, y2 = 0.f, y3 = 0.f;
#pragma unroll 4
      for (int q = 0; q < 32; ++q) {
        const u32x4 w4 = sp[q * 64];
#pragma unroll
        for (int z = 0; z < 4; ++z) {
          const unsigned w = z == 0 ? w4.x : z == 1 ? w4.y : z == 2 ? w4.z : w4.w;
          const float c = bfhi(w);
          const u32x2 v = tabl[w & 0xffffu];
          y0 += c * bflo(v.x); y1 += c * bfhi(v.x); y2 += c * bflo(v.y); y3 += c * bfhi(v.y);
        }
      }
      *(f32x4*)(YT + ((size_t)cg * TREAL + t) * 4) = (f32x4){y0, y1, y2, y3};
    }
    __syncthreads();
  }
}
DI void ph_final(int wv4, const float* __restrict__ H1, const float* __restrict__ YT, const float* __restrict__ gf, float* __restrict__ out) {
  const int lane = fresh_tid() & 63;
  const int t0 = wv4 * 4;
  f32x4 y[4][4];
#pragma unroll
  for (int j = 0; j < 4; ++j) {
    const f32x4* yp = (const f32x4*)(YT + ((size_t)(lane + 64 * j) * TREAL + t0) * 4);
#pragma unroll
    for (int q = 0; q < 4; ++q) y[j][q] = yp[q];
  }
#pragma unroll
  for (int q = 0; q < 4; ++q) {
    const size_t rowoff = (size_t)(t0 + q) * D;
    float ss = 0.f;
#pragma unroll
    for (int j = 0; j < 4; ++j) {
      const f32x4 hv = *(const f32x4*)(H1 + rowoff + (lane + 64 * j) * 4);
      y[j][q].x += hv.x; y[j][q].y += hv.y; y[j][q].z += hv.z; y[j][q].w += hv.w;
      ss += y[j][q].x * y[j][q].x + y[j][q].y * y[j][q].y + y[j][q].z * y[j][q].z + y[j][q].w * y[j][q].w;
    }
    ss = wave_sum(ss);
    const float sc = rsqrtf(ss * (1.0f / D) + EPS);
#pragma unroll
    for (int j = 0; j < 4; ++j) {
      const f32x4 gg = *(const f32x4*)(gf + (lane + 64 * j) * 4);
      *(f32x4*)(out + rowoff + (lane + 64 * j) * 4) = (f32x4){y[j][q].x * sc * gg.x, y[j][q].y * sc * gg.y, y[j][q].z * sc * gg.z, y[j][q].w * sc * gg.w};
    }
  }
}

#define XB_TMO      128
#define XB_XCNT(j)  (256  + 64 * (j))
#define XB_XSUB(j)  (1280 + 64 * (j))
#define XB_XGEN(j)  (2304 + 64 * (j))
#define XB_TOP      3328
#define XB_TOPGEN   3392
#define XCD_BAR_WORDS 3456
#define XB_SPIN_CAP (1u << 20)
#define LAS __attribute__((address_space(3)))
DI unsigned xb_ld(unsigned* p)              { return __hip_atomic_load(p, __ATOMIC_RELAXED, __HIP_MEMORY_SCOPE_AGENT); }
DI unsigned xb_add(unsigned* p, unsigned v) { return __hip_atomic_fetch_add(p, v, __ATOMIC_RELAXED, __HIP_MEMORY_SCOPE_AGENT); }
DI unsigned xb_xcc_id() { return (unsigned)__builtin_amdgcn_s_getreg((3 << 11) | 20) & 0xFu; }
#define XB_SPIN(cond, bar) do { unsigned _sp = 0; while (cond) { __builtin_amdgcn_s_sleep(1); \
    if ((++_sp & 255u) == 0u) { if (xb_ld(&(bar)[XB_TMO])) break; if (_sp > XB_SPIN_CAP) { atomicAdd(&(bar)[XB_TMO], 1u); break; } } } } while (0)
struct XcdBarrier { unsigned* bar; unsigned x; volatile unsigned* st; };
DI XcdBarrier xcd_barrier_post(unsigned* bar, volatile unsigned* st) {
  XcdBarrier b; b.bar = bar; b.x = xb_xcc_id(); b.st = st;
  if (threadIdx.x == 0) (void)xb_add(&bar[XB_XCNT(b.x)], 1u);
  return b;
}
DI void xcd_barrier_complete(unsigned* bar, unsigned x, unsigned& nloc, unsigned& nx) {
  const unsigned G = gridDim.x;
  unsigned sum, cnt, mine, sp = 0u;
  for (;;) {
    sum = 0u; cnt = 0u; mine = 0u;
#pragma unroll
    for (unsigned j = 0; j < 16; ++j) { const unsigned c = xb_ld(&bar[XB_XCNT(j)]); sum += c; cnt += (c > 0u) ? 1u : 0u; mine = (j == x) ? c : mine; }
    if (sum == G) break;
    __builtin_amdgcn_s_sleep(1);
    if ((++sp & 255u) == 0u) { if (xb_ld(&bar[XB_TMO])) break; if (sp > XB_SPIN_CAP) { atomicAdd(&bar[XB_TMO], 1u); break; } }
  }
  nloc = mine > 0u ? mine : 1u; nx = cnt > 0u ? cnt : 1u;
}
DI void xcd_barrier(const XcdBarrier& b) {
  asm volatile("s_waitcnt vmcnt(0)" ::: "memory");
  __syncthreads();
  if (threadIdx.x == 0) {
    unsigned* bar = b.bar;
    __builtin_amdgcn_s_waitcnt(0);
    unsigned nloc = b.st[0], nx = b.st[1];
    if (nloc == 0u) { xcd_barrier_complete(bar, b.x, nloc, nx); b.st[0] = nloc; b.st[1] = nx; }
    const unsigned old = xb_add(&bar[XB_XSUB(b.x)], 1u);
    const unsigned gen = old / nloc;
    if (old + 1u == (gen + 1u) * nloc) {
      __builtin_amdgcn_fence(__ATOMIC_RELEASE, "agent");
      asm volatile("s_waitcnt vmcnt(0)" ::: "memory");
      const unsigned og = xb_add(&bar[XB_TOP], 1u);
      const unsigned tg = og / nx;
      if (og + 1u == (tg + 1u) * nx) xb_add(&bar[XB_TOPGEN], 1u);
      else XB_SPIN(xb_ld(&bar[XB_TOPGEN]) == tg, bar);
      __builtin_amdgcn_fence(__ATOMIC_ACQUIRE, "agent");
      xb_add(&bar[XB_XGEN(b.x)], 1u);
      asm volatile("s_waitcnt vmcnt(0)" ::: "memory");
    } else {
      XB_SPIN(xb_ld(&bar[XB_XGEN(b.x)]) == gen, bar);
      __builtin_amdgcn_fence(__ATOMIC_ACQUIRE, "agent");
      asm volatile("s_waitcnt vmcnt(0)" ::: "memory");
    }
  }
  __syncthreads();
}

struct Params {
  const float *x, *meta, *norm1_g, *w_in, *wg, *bg, *sb_g, *gla_g, *w_out, *norm2_g, *w_pq, *sk1, *sk2, *eu, *ev, *gf;
  float* out; char* ws;
};
constexpr int HALF_SMEM = 73728;
constexpr int SMEM_BYTES = 2 * HALF_SMEM;
constexpr size_t WS_BAR = 0;

__global__ void __launch_bounds__(512, 2) k_fused(Params p) {
  extern __shared__ __attribute__((aligned(16))) char smem_dyn[];
  const int half = __builtin_amdgcn_readfirstlane((int)(threadIdx.x >> 8));
  char* smem = smem_dyn + half * HALF_SMEM;
  __shared__ unsigned xb_words[4];
  if (threadIdx.x < 4) xb_words[threadIdx.x] = 0u;
  __syncthreads();
  const XcdBarrier bar = xcd_barrier_post((unsigned*)(p.ws + WS_BAR), xb_words);
  if (threadIdx.x == 0) xb_words[2] = xb_add((unsigned*)(p.ws + WS_XRANK) + bar.x, 1u);
  const int G = 2 * gridDim.x, bid = 2 * blockIdx.x + half;
  char* ws = p.ws;
  bf16_t* WinT = (bf16_t*)(ws + WS_WIN);
  bf16_t* WoutT = (bf16_t*)(ws + WS_WOUT);
  bf16_t* WpqT = (bf16_t*)(ws + WS_WPQ);
  bf16_t* EU = (bf16_t*)(ws + WS_EU);
  bf16_t* EV = (bf16_t*)(ws + WS_EV);
  bf16_t* SK1b = (bf16_t*)(ws + WS_SK1);
  bf16_t* SK2b = (bf16_t*)(ws + WS_SK2);
  bf16_t* A1 = (bf16_t*)(ws + WS_A1);
  float* GO = (float*)(ws + WS_A1);
  bf16_t* A2 = (bf16_t*)(ws + WS_A1);
  InProjOut O;
  O.QSB = (bf16_t*)(ws + WS_QSB); O.KSB = (bf16_t*)(ws + WS_KSB); O.VTSB = (bf16_t*)(ws + WS_VTSB); O.VSB = (bf16_t*)(ws + WS_VSB);
  O.GQ = (bf16_t*)(ws + WS_GQ); O.GK = (bf16_t*)(ws + WS_GK); O.GV = (bf16_t*)(ws + WS_GV); O.GR = (bf16_t*)(ws + WS_GR);
  O.GLR = (float*)(ws + WS_GLR);
  float* H1 = (float*)(ws + WS_H1);
  bf16_t* GVT = (bf16_t*)(ws + WS_GVT);
  GlaPtrs GP;
  GP.GQ = O.GQ; GP.GK = O.GK; GP.GVT = GVT; GP.GR = O.GR; GP.GLR = O.GLR; GP.wg = p.wg; GP.bg = p.bg; GP.gla_g = p.gla_g;
  GP.SLOC = (float*)(ws + WS_SLOC); GP.DTOT = (float*)(ws + WS_DTOT); GP.MIX = (bf16_t*)(ws + WS_MIX);
  bf16_t* MIX = (bf16_t*)(ws + WS_MIX);
  bf16_t* QP = (bf16_t*)(ws + WS_MIX);
  unsigned short* EIDX = (unsigned short*)(ws + WS_EIDX);
  bf16_t* PP = (bf16_t*)(ws + WS_PP);
  float* YT = (float*)(ws + WS_PP);
  unsigned* STREAM = (unsigned*)(ws + WS_STREAM);
  float* GATE = (float*)(ws + WS_GATE);

  for (int vb = bid; vb < 3328 + 1024 + 1024; vb += G) {
    if (vb < 3328) ph_transpose_w(vb % 104, vb / 104, smem, p.w_in, p.norm1_g, WinT, D, NIN);
    else if (vb < 4352) { const int t = vb - 3328; ph_transpose_w(t % 32, t / 32, smem, p.w_out, nullptr, WoutT, D, D); }
    else { const int t = vb - 4352; ph_transpose_w(t % 32, t / 32, smem, p.w_pq, nullptr, WpqT, D, D); }
  }
  ph_convert_eu(p.eu, EU);
  for (int vb = bid; vb < NEXP / 32; vb += G) ph_convert_ev(vb, smem, p.ev, EV);
  ph_convert(p.sk1, SK1b, (size_t)8 * 128 * 64 / 8);
  ph_convert(p.sk2, SK2b, (size_t)8 * 128 * 64 / 8);
  ph_zero_pads(O.KSB, O.VSB, O.GQ, O.GK, O.GV);
  for (int vb = bid; vb < TREAL / 4; vb += G) ph_norm_rows<0>(vb, p.x, p.meta, A1);
  __syncthreads();
  if (blockIdx.x < 7) ph_meta(blockIdx.x, smem_dyn, p.meta, p.norm1_g, p.w_in, O);
  xcd_barrier(bar);
  {
    pg8::Gemm g{A1, WinT, TREAL, NINP, D}; pg8::StaticOrder S; S.init(TREAL, NINP, (int)gridDim.x, (int)blockIdx.x);
    EpiInProj E{O};
    pg8::gemm_phase<EpiInProj, pg8::StaticOrder, true, true>((PG8_LAS unsigned char*)smem_dyn, g, S, E);
  }
  xcd_barrier(bar);
  for (int vb = bid; vb < 64 * 257; vb += G) ph_vtrans(vb, smem, O.VSB, O.VTSB);
  for (int vb = bid; vb < 32 * 258 * 2; vb += G) ph_gvtrans(vb, smem, O.GV, GVT);
  xcd_barrier(bar);
  for (int it = blockIdx.x; it < 32 * 15; it += gridDim.x) gla_item<0>(it / 15, it % 15, smem_dyn, GP);
  for (int vb = bid; vb < 64 * 64; vb += G) ph_sb_attn(vb, O.QSB, O.KSB, O.VTSB, p.sb_g, MIX);
  xcd_barrier(bar);
  for (int it = blockIdx.x; it < 32 * 16; it += gridDim.x) gla_item<1>(it >> 4, it & 15, smem_dyn, GP);
  xcd_barrier(bar);
  {
    pg8::Gemm g{MIX, WoutT, TREAL, D, D}; pg8::StaticOrder S; S.init(TREAL, D, (int)gridDim.x, (int)blockIdx.x);
    EpiOut E{p.x, H1};
    pg8::gemm_phase<EpiOut, pg8::StaticOrder, true, true>((PG8_LAS unsigned char*)smem_dyn, g, S, E);
  }
  xcd_barrier(bar);
  for (int vb = bid; vb < TREAL / 4; vb += G) ph_norm_rows<1>(vb, H1, p.norm2_g, A2);
  xcd_barrier(bar);
  {
    pg8::Gemm g{A2, WpqT, TREAL, D, D}; pg8::StaticOrder S; S.init(TREAL, D, (int)gridDim.x, (int)blockIdx.x);
    EpiPQ E{QP};
    pg8::gemm_phase<EpiPQ, pg8::StaticOrder, true, true>((PG8_LAS unsigned char*)smem_dyn, g, S, E);
  }
  xcd_barrier(bar);
  for (int vb = bid; vb < 8 * (TREAL / 128); vb += G) ph_route_v2(vb, smem, QP, SK1b, SK2b, EIDX, GATE);
  xcd_barrier(bar);
  {
    __shared__ int xinfo[4];
    if (threadIdx.x == 0) {
      unsigned* barw = (unsigned*)(p.ws + WS_BAR);
      unsigned cnt = 0, ord = 0, mine = 1;
      for (unsigned j = 0; j < 16; ++j) { const unsigned c = xb_ld(&barw[XB_XCNT(j)]); if (c > 0) { if (j < bar.x) ++ord; ++cnt; } if (j == bar.x) mine = c; }
      xinfo[0] = (int)ord; xinfo[1] = (int)cnt; xinfo[2] = (int)xb_words[2]; xinfo[3] = (int)mine;
    }
    __syncthreads();
    const int xi = xinfo[0], nx = xinfo[1], rank = xinfo[2], nloc = xinfo[3];
    const int wave = __builtin_amdgcn_readfirstlane((int)(threadIdx.x >> 6));
    ph_peer_u(xi, nx, rank * 8 + wave, nloc * 8, A2, EU, EIDX, PP);
  }
  xcd_barrier(bar);
  ph_peer_c(PP, EIDX, GATE, STREAM);
  xcd_barrier(bar);
  ph_peer_v(smem_dyn, STREAM, EV, YT);
  xcd_barrier(bar);
  {
    const int wave = __builtin_amdgcn_readfirstlane((int)(threadIdx.x >> 6));
    for (int wv4 = blockIdx.x * 8 + wave; wv4 < TREAL / 4; wv4 += gridDim.x * 8) ph_final(wv4, H1, YT, p.gf, p.out);
  }
}

extern "C" void kernel_launch(void* const* d_in, const int* in_sizes, int n_in, void* d_out, int out_size, void* d_ws, size_t ws_size, hipStream_t stream) {
  static int grid = 0;
  if (grid == 0) {
    int dev = 0, cus = 0, per_cu = 0;
    hipGetDevice(&dev);
    hipDeviceGetAttribute(&cus, hipDeviceAttributeMultiprocessorCount, dev);
    hipFuncSetAttribute((const void*)k_fused, hipFuncAttributeMaxDynamicSharedMemorySize, SMEM_BYTES);
    hipOccupancyMaxActiveBlocksPerMultiprocessor(&per_cu, (const void*)k_fused, 512, SMEM_BYTES);
    if (per_cu > 1) per_cu = 1;
    if (per_cu < 1) per_cu = 1;
    grid = cus * per_cu;
  }
  hipMemsetAsync((char*)d_ws + WS_BAR, 0, 32768, stream);
  Params p{};
  p.x = (const float*)d_in[0]; p.meta = (const float*)d_in[1]; p.norm1_g = (const float*)d_in[2]; p.w_in = (const float*)d_in[3];
  p.wg = (const float*)d_in[4]; p.bg = (const float*)d_in[5]; p.sb_g = (const float*)d_in[6]; p.gla_g = (const float*)d_in[7];
  p.w_out = (const float*)d_in[8]; p.norm2_g = (const float*)d_in[9]; p.w_pq = (const float*)d_in[10]; p.sk1 = (const float*)d_in[11];
  p.sk2 = (const float*)d_in[12]; p.eu = (const float*)d_in[13]; p.ev = (const float*)d_in[14]; p.gf = (const float*)d_in[15];
  p.out = (float*)d_out; p.ws = (char*)d_ws;
  void* args[] = {&p};
  hipLaunchCooperativeKernel((const void*)k_fused, dim3(grid), dim3(512), args, SMEM_BYTES, stream);
}
```

```cpp
#include <hip/hip_runtime.h>
#include <stdint.h>
#include <stddef.h>

typedef unsigned short bf16_t;
typedef short bf16x8 __attribute__((ext_vector_type(8)));
typedef float f32x16 __attribute__((ext_vector_type(16)));
typedef float f32x4 __attribute__((ext_vector_type(4)));
typedef float f32x2 __attribute__((ext_vector_type(2)));
typedef unsigned u32x4 __attribute__((ext_vector_type(4)));
typedef unsigned u32x2 __attribute__((ext_vector_type(2)));
typedef __bf16 bf16x2_t __attribute__((ext_vector_type(2)));

#define DI __device__ __forceinline__
__device__ __forceinline__ int fresh_tid() { int t = (int)threadIdx.x; asm volatile("" : "+v"(t)); return t; }
#define TID tid256_
#define MFMA32(a, b, c) __builtin_amdgcn_mfma_f32_32x32x16_bf16((a), (b), (c), 0, 0, 0)

constexpr int D = 1024, NB = 8, SEQ = 8192, NMETA = 16;
constexpr int TREAL = NB * SEQ;
constexpr int MROWS = TREAL + 128;
constexpr int NIN = 3088, NINP = 3328;
constexpr int SBH = 8, SBD = 64;
constexpr int GH = 4, GDK = 64, GDV = 128;
constexpr int KIDX = SEQ + 32;
constexpr int GU = SEQ + 64;
constexpr int NEXP = 16384;
constexpr float EPS = 1e-6f;

constexpr size_t MiB = 1u << 20;
constexpr size_t WS_WIN = 1 * MiB;
constexpr size_t WS_WOUT = 8 * MiB;
constexpr size_t WS_WPQ = 10 * MiB;
constexpr size_t WS_SK1 = 12 * MiB;
constexpr size_t WS_SK2 = 13 * MiB;
constexpr size_t WS_EU = 16 * MiB;
constexpr size_t WS_EV = 48 * MiB;
constexpr size_t WS_A1 = 80 * MiB;
constexpr size_t WS_QSB = 210 * MiB;
constexpr size_t WS_KSB = 274 * MiB;
constexpr size_t WS_VTSB = 339 * MiB;
constexpr size_t WS_GQ = 404 * MiB;
constexpr size_t WS_GK = 437 * MiB;
constexpr size_t WS_H1 = 210 * MiB;
constexpr size_t WS_GV = 470 * MiB;
constexpr size_t WS_GR = 535 * MiB;
constexpr size_t WS_GLR = 599 * MiB;
constexpr size_t WS_LG = 604 * MiB;
constexpr size_t WS_MIX = 669 * MiB;
constexpr size_t WS_EIDX = 797 * MiB;
constexpr size_t WS_GATE = 829 * MiB;
constexpr size_t WS_PP = 470 * MiB;
constexpr size_t WS_STREAM = 726 * MiB;
constexpr size_t WS_XRANK = 16384;
constexpr size_t WS_VSB = 861 * MiB;
constexpr size_t WS_END = 926 * MiB;

DI unsigned f2bf(float f) { unsigned u = __float_as_uint(f); return (u + 0x7fffu + ((u >> 16) & 1u)) >> 16; }
DI float bf2f(unsigned b) { return __uint_as_float(b << 16); }
DI unsigned pk2(float lo, float hi) { f32x2 v = {lo, hi}; return __builtin_bit_cast(unsigned, __builtin_convertvector(v, bf16x2_t)); }
DI float bflo(unsigned u) { return __uint_as_float(u << 16); }
DI float bfhi(unsigned u) { return __uint_as_float(u & 0xffff0000u); }
DI int crow(int reg, int h) { return (reg & 3) + 8 * (reg >> 2) + 4 * h; }
DI float wave_sum(float v) {
#pragma unroll
  for (int o = 32; o >= 1; o >>= 1) v += __shfl_xor(v, o);
  return v;
}
DI float dot2bf(unsigned a, unsigned b, float acc) { return __builtin_amdgcn_fdot2_f32_bf16(__builtin_bit_cast(bf16x2_t, a), __builtin_bit_cast(bf16x2_t, b), acc, false); }
DI float softplus(float z) { return fmaxf(z, 0.f) + __logf(1.f + __expf(-fabsf(z))); }

DI void ph_transpose_w(int bx, int by, char* smem, const float* __restrict__ W, const float* __restrict__ gain, bf16_t* __restrict__ WT, int K, int N) {
  const int tid256_ = fresh_tid() & 255;
  float (*t)[33] = (float (*)[33])smem;
  const int n0 = bx * 32, k0 = by * 32, tx = TID & 31, ty = TID >> 5;
  for (int r = ty; r < 32; r += 8) {
    const int k = k0 + r, n = n0 + tx;
    float v = 0.f;
    if (n < N) { v = W[(size_t)k * N + n]; if (gain) v *= gain[k]; }
    t[r][tx] = v;
  }
  __syncthreads();
  for (int r = ty; r < 32; r += 8) {
    const int n = n0 + r, k = k0 + tx;
    WT[(size_t)n * K + k] = (bf16_t)f2bf(t[tx][r]);
  }
  __syncthreads();
}
DI void ph_convert(const float* __restrict__ src, bf16_t* __restrict__ dst, size_t n8) {
  size_t i = (size_t)blockIdx.x * blockDim.x + threadIdx.x;
  const size_t stride = (size_t)gridDim.x * blockDim.x;
  for (; i < n8; i += stride) {
    const f32x4 a = ((const f32x4*)src)[2 * i], b = ((const f32x4*)src)[2 * i + 1];
    u32x4 o; o.x = pk2(a.x, a.y); o.y = pk2(a.z, a.w); o.z = pk2(b.x, b.y); o.w = pk2(b.z, b.w);
    ((u32x4*)dst)[i] = o;
  }
}
DI void ph_zero_pads(bf16_t* KSB, bf16_t* VTSB, bf16_t* GQ, bf16_t* GK, bf16_t* GV) {
  const int tid = blockIdx.x * blockDim.x + threadIdx.x, nth = gridDim.x * blockDim.x;
  for (int i = tid; i < 64 * 16 * 64; i += nth) { const int bh = i / 1024, r = i % 1024; KSB[(size_t)bh * KIDX * 64 + r] = 0; }
  for (int i = tid; i < 64 * 16 * 64; i += nth) { const int bh = i / 1024, r = i % 1024; VTSB[(size_t)bh * KIDX * 64 + r] = 0; }
  for (int i = tid; i < 32 * 48 * 64; i += nth) { const int bh = i / 3072, r = i % 3072; GQ[(size_t)bh * GU * 64 + r] = 0; GK[(size_t)bh * GU * 64 + r] = 0; }
  for (int i = tid; i < 32 * 48 * 128; i += nth) { const int bh = i / 6144, r = i % 6144; GV[(size_t)bh * GU * 128 + r] = 0; }
}

template <int MODE>
DI void ph_norm_rows(int vb, const float* __restrict__ src, const float* __restrict__ meta, bf16_t* __restrict__ dst) {
  const int tid256_ = fresh_tid() & 255;
  const int row0 = vb * 16 + (TID >> 6) * 4, lane = TID & 63;
  f32x4 v[4][4];
#pragma unroll
  for (int rr = 0; rr < 4; ++rr)
#pragma unroll
    for (int j = 0; j < 4; ++j) v[rr][j] = *(const f32x4*)(src + (size_t)(row0 + rr) * D + j * 256 + lane * 4);
  f32x4 gg[4];
#pragma unroll
  for (int j = 0; j < 4; ++j) { gg[j] = (f32x4){1.f, 1.f, 1.f, 1.f}; if (MODE == 1) gg[j] = *(const f32x4*)(meta + j * 256 + lane * 4); }
#pragma unroll
  for (int rr = 0; rr < 4; ++rr) {
    float ss = 0.f;
#pragma unroll
    for (int j = 0; j < 4; ++j) ss += v[rr][j].x * v[rr][j].x + v[rr][j].y * v[rr][j].y + v[rr][j].z * v[rr][j].z + v[rr][j].w * v[rr][j].w;
    ss = wave_sum(ss);
    const float r = rsqrtf(ss * (1.0f / D) + EPS);
#pragma unroll
    for (int j = 0; j < 4; ++j) {
      u32x2 o; o.x = pk2(v[rr][j].x * r * gg[j].x, v[rr][j].y * r * gg[j].y); o.y = pk2(v[rr][j].z * r * gg[j].z, v[rr][j].w * r * gg[j].w);
      *(u32x2*)(dst + (size_t)(row0 + rr) * D + j * 256 + lane * 4) = o;
    }
  }
}

namespace pg8 {
#define PG8_LAS __attribute__((address_space(3)))
typedef unsigned short bf16_t;
typedef short bf16x8 __attribute__((ext_vector_type(8)));
typedef float f32x4 __attribute__((ext_vector_type(4)));
typedef unsigned u32x4 __attribute__((ext_vector_type(4)));
constexpr int BM = 256, BK = 64, HALF = 128, HTB = HALF * BK * 2  , STAGE_BYTES = 8 * HTB, NXCD = 8, WGM = 8;

__host__ __device__ __forceinline__ int lds_byte(int r, int c) { const int st = (r >> 4) * 2 + (c >> 5), rr = r & 15, cc = c & 31, ob = rr * 64 + cc * 2; return st * 1024 + (ob ^ (((ob >> 9) & 1) << 5)); }
__host__ __device__ __forceinline__ void stage_rc(int b, int& R, int& C) { const int st = b / 1024, sb = b % 1024, swz = sb ^ (((sb >> 9) & 1) << 5); R = (st >> 1) * 16 + swz / 64; C = (st & 1) * 32 + (swz % 64) / 2; }
__host__ __device__ __forceinline__ int perm32(int rho) { const int n = rho >> 4, i = rho & 15; return 8 * (i >> 2) + 4 * n + (i & 3); }

struct Unit { int pm, pn; };
struct Gemm { const bf16_t* A; const bf16_t* Bt; int M, N, K; };

struct StaticOrder {
    int nM, nN, nwg, G, c;
    __host__ __device__ void init(int M, int N, int G_, int c_) { nM = M / BM; nN = N / BM; nwg = nM * nN; G = G_; c = c_; }
    __host__ __device__ bool next(int i, Unit& u) const {
        const long L = (long)i * G + c; if (L >= nwg) return false;
        int wgid = (int)L; { const int q = nwg / NXCD, r = nwg % NXCD, xcd = wgid % NXCD, off = wgid / NXCD; wgid = (xcd < r ? xcd * (q + 1) : r * (q + 1) + (xcd - r) * q) + off; }
        const int nig = WGM * nN, gid = wgid / nig, fm = gid * WGM, gsz = (nM - fm) < WGM ? (nM - fm) : WGM;
        u.pm = fm + ((wgid % nig) % gsz); u.pn = (wgid % nig) / gsz; return true;
    }
    __device__ __forceinline__ void a_ready(const Unit&) const {}
    __device__ __forceinline__ void done(const Unit&) const {}
};

template <class Epi, class Sched, bool ALIGN_EPI = false, bool SP2 = false>
__device__ __forceinline__ void gemm_phase(PG8_LAS unsigned char* lds, const Gemm g, const Sched& S, const Epi& E) {
    const int tid = fresh_tid(), wid = __builtin_amdgcn_readfirstlane(tid >> 6), lane = tid & 63, wr = wid >> 2, wc = wid & 3, fr = lane & 15, fq = lane >> 4;
    const int K = g.K, nt = K / BK;
    unsigned voffA[2], voffB[2];
#pragma unroll
    for (int i = 0; i < 2; ++i) { int R, C; stage_rc(tid * 16 + i * 8192, R, C); const int Rb = Epi::PERM ? ((R & ~31) + perm32(R & 31)) : R;
        voffA[i] = (unsigned)(R * K + C) * 2u; voffB[i] = (unsigned)(Rb * K + C) * 2u; }
    const size_t kstep = (size_t)(BK * 2);
    const size_t hstep = (size_t)HALF * K * 2;
    const size_t tstep = 2 * hstep;
    const unsigned ldsw = (unsigned)wid * 1024u;
    const int aoff = lds_byte(wr * 64 + fr, fq * 8), boff = lds_byte(wc * 32 + fr, fq * 8);
#define PG8_SA(b, h) (((b) * 2 + (h)) * HTB)
#define PG8_SB(b, h) ((4 + (b) * 2 + (h)) * HTB)
#define PG8_STAGE(bufoff, gbase, voff) do { _Pragma("unroll") for (int _i = 0; _i < 2; ++_i) \
        __builtin_amdgcn_global_load_lds((const unsigned*)((const char*)(gbase) + (voff)[_i]), (PG8_LAS unsigned*)(lds + (bufoff) + ldsw + _i * 8192), 16, 0, 0); } while (0)
#define PG8_LDA(dst, b, h) do { _Pragma("unroll") for (int m = 0; m < 4; ++m) _Pragma("unroll") for (int k = 0; k < 2; ++k) dst[m][k] = *(const PG8_LAS bf16x8*)(lds + PG8_SA(b, h) + aoff + m * 2048 + k * 1024); } while (0)
#define PG8_LDB(dst, b, h) do { _Pragma("unroll") for (int n = 0; n < 2; ++n) _Pragma("unroll") for (int k = 0; k < 2; ++k) dst[n][k] = *(const PG8_LAS bf16x8*)(lds + PG8_SB(b, h) + boff + n * 2048 + k * 1024); } while (0)
#define PG8_MMA(ai, bj, At, Bt) do { __builtin_amdgcn_s_setprio(1); _Pragma("unroll") for (int m = 0; m < 4; ++m) _Pragma("unroll") for (int n = 0; n < 2; ++n) _Pragma("unroll") for (int k = 0; k < 2; ++k) \
        acc[ai][bj][m][n] = __builtin_amdgcn_mfma_f32_16x16x32_bf16(Bt[n][k], At[m][k], acc[ai][bj][m][n], 0, 0, 0); __builtin_amdgcn_s_setprio(0); } while (0)
#define PG8_WAIT_V(n) asm volatile("s_waitcnt vmcnt(" #n ")" ::: "memory")
#define PG8_WAIT_L(n) asm volatile("s_waitcnt lgkmcnt(" #n ")" ::: "memory")
#define PG8_BAR __builtin_amdgcn_s_barrier()
#define PG8_SCHED __builtin_amdgcn_sched_barrier(0)
    Unit cur, nxt; int ui = 0;
    if (!S.next(0, cur)) return;
    f32x4 acc[2][2][4][2];
#pragma unroll
    for (int a = 0; a < 2; ++a)
#pragma unroll
        for (int b = 0; b < 2; ++b)
#pragma unroll
            for (int m = 0; m < 4; ++m)
#pragma unroll
                for (int n = 0; n < 2; ++n) acc[a][b][m][n] = (f32x4){0.f, 0.f, 0.f, 0.f};
    bf16x8 At[4][2], B0[2][2], B1[2][2];
    const char* cA = (const char*)g.A + (size_t)cur.pm * tstep; const char* cB = (const char*)g.Bt + (size_t)cur.pn * tstep;
    S.a_ready(cur);
    if constexpr (SP2) {
        PG8_STAGE(PG8_SB(0, 0), cB, voffB); PG8_STAGE(PG8_SB(0, 1), cB + hstep, voffB); PG8_STAGE(PG8_SA(0, 0), cA, voffA); PG8_STAGE(PG8_SA(0, 1), cA + hstep, voffA);
        if (wr == 1) PG8_BAR;
        PG8_WAIT_V(2); PG8_BAR;
        PG8_STAGE(PG8_SB(1, 0), cB + kstep, voffB); PG8_STAGE(PG8_SA(1, 0), cA + kstep, voffA); PG8_STAGE(PG8_SB(1, 1), cB + hstep + kstep, voffB);
        PG8_WAIT_V(6); PG8_BAR;
    } else {
        PG8_STAGE(PG8_SB(0, 0), cB, voffB); PG8_STAGE(PG8_SA(0, 0), cA, voffA); PG8_STAGE(PG8_SB(0, 1), cB + hstep, voffB); PG8_STAGE(PG8_SA(0, 1), cA + hstep, voffA);
        if (wr == 1) PG8_BAR;
        PG8_WAIT_V(4); PG8_BAR;
        PG8_STAGE(PG8_SB(1, 0), cB + kstep, voffB); PG8_STAGE(PG8_SA(1, 0), cA + kstep, voffA); PG8_STAGE(PG8_SB(1, 1), cB + hstep + kstep, voffB);
        PG8_WAIT_V(6); PG8_BAR;
    }
    for (;;) {
        const bool has_next = S.next(ui + 1, nxt);
        const char* nA = has_next ? (const char*)g.A + (size_t)nxt.pm * tstep : cA; const char* nB = has_next ? (const char*)g.Bt + (size_t)nxt.pn * tstep : cB;
        for (int t = 0; t < nt; t += 2) {
            const bool last = (t == nt - 2);
            const char* a1 = cA + (size_t)(t + 1) * kstep;
            const char* a2 = last ? nA : cA + (size_t)(t + 2) * kstep; const char* b2 = last ? nB : cB + (size_t)(t + 2) * kstep;
            const char* a3 = a2 + kstep; const char* b3 = b2 + kstep;
            if (last && has_next) S.a_ready(nxt);
            if constexpr (SP2) {
            PG8_LDB(B0, 0, 0); PG8_LDB(B1, 0, 1); PG8_SCHED; PG8_LDA(At, 0, 0); PG8_STAGE(PG8_SA(1, 1), a1 + hstep, voffA);
            PG8_WAIT_V(8); PG8_WAIT_L(0); PG8_BAR; PG8_MMA(0, 0, At, B0); PG8_MMA(0, 1, At, B1); PG8_BAR; PG8_SCHED;
            PG8_LDA(At, 0, 1); PG8_STAGE(PG8_SB(0, 0), b2, voffB); PG8_STAGE(PG8_SB(0, 1), b2 + hstep, voffB); PG8_STAGE(PG8_SA(0, 0), a2, voffA);
            PG8_WAIT_V(8); PG8_WAIT_L(0); PG8_BAR; PG8_MMA(1, 0, At, B0); PG8_MMA(1, 1, At, B1); PG8_BAR; PG8_SCHED;
            PG8_LDB(B0, 1, 0); PG8_LDB(B1, 1, 1); PG8_SCHED; PG8_LDA(At, 1, 0); PG8_STAGE(PG8_SA(0, 1), a2 + hstep, voffA);
            PG8_WAIT_V(8); PG8_WAIT_L(0); PG8_BAR; PG8_MMA(0, 0, At, B0); PG8_MMA(0, 1, At, B1); PG8_BAR; PG8_SCHED;
            PG8_LDA(At, 1, 1); PG8_STAGE(PG8_SB(1, 0), b3, voffB); PG8_STAGE(PG8_SB(1, 1), b3 + hstep, voffB); PG8_STAGE(PG8_SA(1, 0), a3, voffA);
            PG8_WAIT_V(8); PG8_WAIT_L(0); PG8_BAR; PG8_MMA(1, 0, At, B0); PG8_MMA(1, 1, At, B1); PG8_BAR; PG8_SCHED;
            } else {
            PG8_LDB(B0, 0, 0); PG8_SCHED; PG8_LDA(At, 0, 0); PG8_STAGE(PG8_SA(1, 1), a1 + hstep, voffA);
            PG8_WAIT_L(8); PG8_BAR; PG8_WAIT_L(0); PG8_MMA(0, 0, At, B0); PG8_BAR; PG8_SCHED;
            PG8_LDB(B1, 0, 1); PG8_STAGE(PG8_SB(0, 0), b2, voffB);
            PG8_BAR; PG8_WAIT_L(0); PG8_MMA(0, 1, At, B1); PG8_BAR;
            PG8_LDA(At, 0, 1); PG8_STAGE(PG8_SA(0, 0), a2, voffA);
            PG8_BAR; PG8_WAIT_L(0); PG8_MMA(1, 0, At, B0); PG8_BAR; PG8_SCHED;
            PG8_STAGE(PG8_SB(0, 1), b2 + hstep, voffB);
            PG8_WAIT_V(6); PG8_BAR; PG8_MMA(1, 1, At, B1); PG8_BAR;
            PG8_LDB(B0, 1, 0); PG8_SCHED; PG8_LDA(At, 1, 0); PG8_STAGE(PG8_SA(0, 1), a2 + hstep, voffA);
            PG8_WAIT_L(8); PG8_BAR; PG8_WAIT_L(0); PG8_MMA(0, 0, At, B0); PG8_BAR; PG8_SCHED;
            PG8_LDB(B1, 1, 1); PG8_STAGE(PG8_SB(1, 0), b3, voffB);
            PG8_BAR; PG8_WAIT_L(0); PG8_MMA(0, 1, At, B1); PG8_BAR;
            PG8_LDA(At, 1, 1); PG8_STAGE(PG8_SA(1, 0), a3, voffA);
            PG8_BAR; PG8_WAIT_L(0); PG8_MMA(1, 0, At, B0); PG8_BAR; PG8_SCHED;
            PG8_STAGE(PG8_SB(1, 1), b3 + hstep, voffB);
            PG8_WAIT_V(6); PG8_BAR; PG8_MMA(1, 1, At, B1); PG8_BAR;
            }
        }
        if constexpr (ALIGN_EPI) { if (wr == 0) PG8_BAR; }
        if constexpr (!Epi::AFTER_DRAIN) { E(acc, cur, wr, wc, fr, fq); S.done(cur); }
        if (!has_next) break;
#pragma unroll
        for (int a = 0; a < 2; ++a)
#pragma unroll
            for (int b = 0; b < 2; ++b)
#pragma unroll
                for (int m = 0; m < 4; ++m)
#pragma unroll
                    for (int n = 0; n < 2; ++n) acc[a][b][m][n] = (f32x4){0.f, 0.f, 0.f, 0.f};
        cur = nxt; cA = nA; cB = nB; ++ui;
        if constexpr (ALIGN_EPI) { if (wr == 1) PG8_BAR; }
    }
    PG8_WAIT_V(0);
    if constexpr (!ALIGN_EPI) { if (wr == 0) PG8_BAR; }
    PG8_BAR;
    if constexpr (Epi::AFTER_DRAIN) { E.fused(acc, cur, wr, wc, fr, fq, lds, wid, lane); S.done(cur); }
#undef PG8_SA
#undef PG8_SB
#undef PG8_STAGE
#undef PG8_LDA
#undef PG8_LDB
#undef PG8_MMA
#undef PG8_WAIT_V
#undef PG8_WAIT_L
#undef PG8_BAR
#undef PG8_SCHED
}
}

struct InProjOut { bf16_t *QSB, *KSB, *VSB, *VTSB, *GQ, *GK, *GV, *GR; float* GLR; };

struct EpiInProj {
  static constexpr bool PERM = true, AFTER_DRAIN = false;
  InProjOut O;
  DI void operator()(const pg8::f32x4 (&acc)[2][2][4][2], const pg8::Unit& u, int wr, int wc, int fr, int fq) const {
    const int pn = u.pn;
#pragma unroll
    for (int ai = 0; ai < 2; ++ai)
#pragma unroll
      for (int m = 0; m < 4; ++m) {
        const int row = u.pm * 256 + ai * 128 + wr * 64 + m * 16 + fr;
        const int b = row >> 13, i = row & 8191;
#pragma unroll
        for (int bj = 0; bj < 2; ++bj) {
          const int col = pn * 256 + bj * 128 + wc * 32 + 8 * fq;
          const pg8::f32x4 v0 = acc[ai][bj][m][0], v1 = acc[ai][bj][m][1];
          if (pn < 12) {
            u32x4 w; w.x = pk2(v0[0], v0[1]); w.y = pk2(v0[2], v0[3]); w.z = pk2(v1[0], v1[1]); w.w = pk2(v1[2], v1[3]);
            bf16_t* dst;
            if (pn < 2)       { const int c = col;        dst = O.QSB + ((size_t)(b * SBH + (c >> 6)) * SEQ + i) * 64 + (c & 63); }
            else if (pn < 4)  { const int c = col - 512;  dst = O.KSB + ((size_t)(b * SBH + (c >> 6)) * KIDX + 32 + i) * 64 + (c & 63); }
            else if (pn < 6)  { const int c = col - 1024; dst = O.VSB + ((size_t)(b * SBH + (c >> 6)) * KIDX + 32 + i) * 64 + (c & 63); }
            else if (pn == 6) { const int c = col - 1536; dst = O.GQ + ((size_t)(b * GH + (c >> 6)) * GU + 64 + i) * 64 + (c & 63); }
            else if (pn == 7) { const int c = col - 1792; dst = O.GK + ((size_t)(b * GH + (c >> 6)) * GU + 64 + i) * 64 + (c & 63); }
            else if (pn < 10) { const int c = col - 2048; dst = O.GV + ((size_t)(b * GH + (c >> 7)) * GU + 64 + i) * 128 + (c & 127); }
            else              { const int c = col - 2560; dst = O.GR + (size_t)row * 512 + c; }
            *(u32x4*)dst = w;
          } else if (col < NIN) {
            float* dst = O.GLR + ((size_t)b * GU + 64 + i) * 16 + (col - 3072);
            *(f32x4*)dst = (f32x4){v0[0], v0[1], v0[2], v0[3]};
            *(f32x4*)(dst + 4) = (f32x4){v1[0], v1[1], v1[2], v1[3]};
          }
        }
      }
  }
};
struct EpiOut {
  static constexpr bool PERM = false, AFTER_DRAIN = false;
  const float* x; float* H1;
  DI void operator()(const pg8::f32x4 (&acc)[2][2][4][2], const pg8::Unit& u, int wr, int wc, int fr, int fq) const {
#pragma unroll
    for (int ai = 0; ai < 2; ++ai)
#pragma unroll
      for (int m = 0; m < 4; ++m) {
        const size_t rowoff = (size_t)(u.pm * 256 + ai * 128 + wr * 64 + m * 16 + fr) * D;
#pragma unroll
        for (int bj = 0; bj < 2; ++bj)
#pragma unroll
          for (int n = 0; n < 2; ++n) {
            const size_t idx = rowoff + u.pn * 256 + bj * 128 + wc * 32 + 16 * n + 4 * fq;
            const f32x4 xv = *(const f32x4*)(x + idx);
            const pg8::f32x4 a = acc[ai][bj][m][n];
            *(f32x4*)(H1 + idx) = (f32x4){xv.x + a[0], xv.y + a[1], xv.z + a[2], xv.w + a[3]};
          }
      }
  }
};
struct EpiPQ {
  static constexpr bool PERM = true, AFTER_DRAIN = false;
  bf16_t* QP;
  DI void operator()(const pg8::f32x4 (&acc)[2][2][4][2], const pg8::Unit& u, int wr, int wc, int fr, int fq) const {
#pragma unroll
    for (int ai = 0; ai < 2; ++ai)
#pragma unroll
      for (int m = 0; m < 4; ++m) {
        const size_t rowoff = (size_t)(u.pm * 256 + ai * 128 + wr * 64 + m * 16 + fr) * D;
#pragma unroll
        for (int bj = 0; bj < 2; ++bj) {
          const pg8::f32x4 v0 = acc[ai][bj][m][0], v1 = acc[ai][bj][m][1];
          u32x4 w; w.x = pk2(v0[0], v0[1]); w.y = pk2(v0[2], v0[3]); w.z = pk2(v1[0], v1[1]); w.w = pk2(v1[2], v1[3]);
          *(u32x4*)(QP + rowoff + u.pn * 256 + bj * 128 + wc * 32 + 8 * fq) = w;
        }
      }
  }
};

DI void ph_meta(int blk, char* smem, const float* __restrict__ meta, const float* __restrict__ g1, const float* __restrict__ w_in, const InProjOut& O) {
  float (*xmT)[16] = (float (*)[16])smem;
  const int tid = fresh_tid(), lane = tid & 63, wave = tid >> 6;
  for (int rr = 0; rr < 2; ++rr) {
    const int mm = wave * 2 + rr;
    float v[16]; float ss = 0.f;
#pragma unroll
    for (int j = 0; j < 16; ++j) { v[j] = meta[(size_t)mm * D + j * 64 + lane]; ss += v[j] * v[j]; }
    ss = wave_sum(ss);
    const float r = rsqrtf(ss * (1.0f / D) + EPS);
#pragma unroll
    for (int j = 0; j < 16; ++j) xmT[j * 64 + lane][mm] = v[j] * r * g1[j * 64 + lane];
  }
  __syncthreads();
  const int n = blk * 512 + tid;
  if (n < NIN) {
    float acc[16];
#pragma unroll
    for (int j = 0; j < 16; ++j) acc[j] = 0.f;
#pragma unroll 4
    for (int k = 0; k < D; ++k) {
      const float w = w_in[(size_t)k * NIN + n];
      const f32x4 a = *(const f32x4*)&xmT[k][0], b4 = *(const f32x4*)&xmT[k][4], c4 = *(const f32x4*)&xmT[k][8], d4 = *(const f32x4*)&xmT[k][12];
      acc[0] += a.x * w; acc[1] += a.y * w; acc[2] += a.z * w; acc[3] += a.w * w;
      acc[4] += b4.x * w; acc[5] += b4.y * w; acc[6] += b4.z * w; acc[7] += b4.w * w;
      acc[8] += c4.x * w; acc[9] += c4.y * w; acc[10] += c4.z * w; acc[11] += c4.w * w;
      acc[12] += d4.x * w; acc[13] += d4.y * w; acc[14] += d4.z * w; acc[15] += d4.w * w;
    }
#pragma unroll
    for (int mm = 0; mm < 16; ++mm) {
      const float val = acc[mm];
      const bf16_t hv = (bf16_t)f2bf(val);
      for (int bb = 0; bb < NB; ++bb) {
        if (n < 512) {}
        else if (n < 1024) { const int c = n - 512;  O.KSB[((size_t)(bb * SBH + (c >> 6)) * KIDX + 16 + mm) * 64 + (c & 63)] = hv; }
        else if (n < 1536) { const int c = n - 1024; O.VSB[((size_t)(bb * SBH + (c >> 6)) * KIDX + 16 + mm) * 64 + (c & 63)] = hv; }
        else if (n < 1792) { const int c = n - 1536; O.GQ[((size_t)(bb * GH + (c >> 6)) * GU + 48 + mm) * 64 + (c & 63)] = hv; }
        else if (n < 2048) { const int c = n - 1792; O.GK[((size_t)(bb * GH + (c >> 6)) * GU + 48 + mm) * 64 + (c & 63)] = hv; }
        else if (n < 2560) { const int c = n - 2048; O.GV[((size_t)(bb * GH + (c >> 7)) * GU + 48 + mm) * 128 + (c & 127)] = hv; }
        else if (n < 3072) {}
        else { O.GLR[((size_t)bb * GU + 48 + mm) * 16 + (n - 3072)] = val; }
      }
    }
  }
  __syncthreads();
}

DI void ph_vtrans(int vb, char* smem, const bf16_t* __restrict__ VSB, bf16_t* __restrict__ VTSB) {
  const int tid256_ = fresh_tid() & 255;
  bf16_t (*t)[66] = (bf16_t (*)[66])smem;
  const int tid = TID;
  const int bh = vb / 257, it = vb % 257, idx0 = it * 32;
  {
    const int row = tid >> 3, c8 = tid & 7;
    const u32x4 v = *(const u32x4*)(VSB + ((size_t)bh * KIDX + idx0 + row) * 64 + c8 * 8);
    unsigned* tp = (unsigned*)&t[row][c8 * 8];
    tp[0] = v.x; tp[1] = v.y; tp[2] = v.z; tp[3] = v.w;
  }
  __syncthreads();
  {
    const int d = tid >> 2, i4 = tid & 3;
    unsigned w[4];
#pragma unroll
    for (int j = 0; j < 4; ++j) w[j] = (unsigned)t[i4 * 8 + 2 * j][d] | ((unsigned)t[i4 * 8 + 2 * j + 1][d] << 16);
    *(u32x4*)(VTSB + ((size_t)bh * 64 + d) * KIDX + idx0 + i4 * 8) = (u32x4){w[0], w[1], w[2], w[3]};
  }
  __syncthreads();
}

constexpr float SB_THR = -90.f;
DI void ph_sb_attn(int vb, const bf16_t* __restrict__ QSB, const bf16_t* __restrict__ KSB, const bf16_t* __restrict__ VTSB,
                                                 const float* __restrict__ sb_g, bf16_t* __restrict__ MIX) {
  const int tid256_ = fresh_tid() & 255;
  const int lane = TID & 63, wave = TID >> 6, r = lane & 31, h = lane >> 5;
  const int bh = vb >> 6, qb = vb & 63;
  const int b = bh >> 3, hd = bh & 7;
  const int i0 = qb * 128 + wave * 32;
  const bf16_t* Qb = QSB + ((size_t)bh * SEQ + i0) * 64;
  const bf16_t* Kb = KSB + (size_t)bh * KIDX * 64;
  const bf16_t* Vb = VTSB + (size_t)bh * 64 * KIDX;
  bf16x8 qf[4];
#pragma unroll
  for (int ks = 0; ks < 4; ++ks) qf[ks] = *(const bf16x8*)(Qb + r * 64 + ks * 16 + h * 8);
  f32x16 o[2];
#pragma unroll
  for (int e = 0; e < 16; ++e) { o[0][e] = 0.f; o[1][e] = 0.f; }
  float R = 0.f;
  const int qidx = 32 + i0 + r;
  for (int c = (i0 >> 5) + 1; c >= 0; --c) {
    const int k0 = 32 * c;
    bf16x8 kf[4];
#pragma unroll
    for (int ks = 0; ks < 4; ++ks) kf[ks] = *(const bf16x8*)(Kb + (size_t)(k0 + r) * 64 + ks * 16 + h * 8);
    bf16x8 vf[2][2];
#pragma unroll
    for (int mt = 0; mt < 2; ++mt)
#pragma unroll
      for (int s2 = 0; s2 < 2; ++s2) {
        const bf16_t* vp = Vb + (size_t)(mt * 32 + r) * KIDX + k0 + 16 * s2 + 4 * h;
        const u32x2 lo = *(const u32x2*)vp, hi = *(const u32x2*)(vp + 8);
        u32x4 t; t.x = lo.x; t.y = lo.y; t.z = hi.x; t.w = hi.y;
        vf[mt][s2] = __builtin_bit_cast(bf16x8, t);
      }
    f32x16 s;
#pragma unroll
    for (int e = 0; e < 16; ++e) s[e] = 0.f;
#pragma unroll
    for (int ks = 0; ks < 4; ++ks) s = MFMA32(kf[ks], qf[ks], s);
    float l1m[16], lb[16];
    bool valid[16];
#pragma unroll
    for (int e = 0; e < 16; ++e) {
      const int kidx = k0 + crow(e, h);
      valid[e] = (kidx < qidx) && (kidx >= 16);
      const float z = s[e] * 0.125f;
      const float sp = softplus(z);
      l1m[e] = valid[e] ? -sp : 0.f;
      lb[e] = z - sp;
    }
    float sfx[16], G[4], PG[4];
#pragma unroll
    for (int g = 0; g < 4; ++g) {
      sfx[4 * g + 3] = 0.f;
      sfx[4 * g + 2] = l1m[4 * g + 3];
      sfx[4 * g + 1] = sfx[4 * g + 2] + l1m[4 * g + 2];
      sfx[4 * g + 0] = sfx[4 * g + 1] + l1m[4 * g + 1];
      G[g] = sfx[4 * g + 0] + l1m[4 * g + 0];
      PG[g] = __shfl_xor(G[g], 32);
    }
    float HS[4];
    HS[3] = 0.f;
    HS[2] = G[3] + PG[3];
    HS[1] = HS[2] + G[2] + PG[2];
    HS[0] = HS[1] + G[1] + PG[1];
    const float total = HS[0] + G[0] + PG[0];
    float a[16];
#pragma unroll
    for (int e = 0; e < 16; ++e) {
      const int g = e >> 2;
      const float between = sfx[e] + (h == 0 ? PG[g] : 0.f) + HS[g] + R;
      a[e] = valid[e] ? __expf(lb[e] + between) : 0.f;
    }
    R += total;
#pragma unroll
    for (int s2 = 0; s2 < 2; ++s2) {
      u32x4 p;
      p.x = pk2(a[8 * s2 + 0], a[8 * s2 + 1]); p.y = pk2(a[8 * s2 + 2], a[8 * s2 + 3]);
      p.z = pk2(a[8 * s2 + 4], a[8 * s2 + 5]); p.w = pk2(a[8 * s2 + 6], a[8 * s2 + 7]);
      const bf16x8 pf = __builtin_bit_cast(bf16x8, p);
      o[0] = MFMA32(vf[0][s2], pf, o[0]);
      o[1] = MFMA32(vf[1][s2], pf, o[1]);
    }
    if (__all(R < SB_THR)) break;
  }
  float ss = 0.f;
#pragma unroll
  for (int e = 0; e < 16; ++e) ss += o[0][e] * o[0][e] + o[1][e] * o[1][e];
  ss += __shfl_xor(ss, 32);
  const float sc = rsqrtf(ss * (1.0f / 64.0f) + EPS);
  bf16_t* outp = MIX + (size_t)(b * SEQ + i0 + r) * D + hd * 64;
#pragma unroll
  for (int mt = 0; mt < 2; ++mt)
#pragma unroll
    for (int g = 0; g < 4; ++g) {
      const int d = mt * 32 + 8 * g + 4 * h;
      const f32x4 gg = *(const f32x4*)(sb_g + hd * 64 + d);
      u32x2 pk;
      pk.x = pk2(o[mt][4 * g] * sc * gg.x, o[mt][4 * g + 1] * sc * gg.y);
      pk.y = pk2(o[mt][4 * g + 2] * sc * gg.z, o[mt][4 * g + 3] * sc * gg.w);
      *(u32x2*)(outp + d) = pk;
    }
}

DI void ph_lg(int bu, const float* __restrict__ GLR, const float* __restrict__ wg, const float* __restrict__ bg, float* __restrict__ LG) {
  const int tid256_ = fresh_tid() & 255;
  const int c = TID;
  const int b = bu / GU, u = bu % GU;
  float val = 0.f;
  if (u >= 48) {
    float acc = bg[c];
    const float* g = GLR + (size_t)bu * 16;
#pragma unroll
    for (int k = 0; k < 16; ++k) acc += g[k] * wg[k * 256 + c];
    val = -softplus(-acc) * (1.0f / 16.0f);
  }
  const int hd = c >> 6, d = c & 63;
  LG[((size_t)(b * GH + hd) * GU + u) * 64 + d] = val;
}

DI void ph_gla_v1(int vb, char* smem, const bf16_t* __restrict__ GQ, const bf16_t* __restrict__ GK, const bf16_t* __restrict__ GV,
                                                const float* __restrict__ LG, float* __restrict__ GO) {
  const int tid256_ = fresh_tid() & 255;
  float (*qs)[68] = (float (*)[68])smem;
  float (*ks)[68] = (float (*)[68])(smem + 17408);
  float (*bc)[68] = (float (*)[68])(smem + 2 * 17408);
  float (*at)[68] = bc;
  float (*vs)[36] = (float (*)[36])(smem + 3 * 17408);
  float (*Ss)[36] = (float (*)[36])(smem + 3 * 17408 + 9216);
  float* decs = (float*)(smem + 3 * 17408 + 2 * 9216);
  const int tid = TID;
  const int bh = vb >> 2, es = vb & 3, b = bh >> 2, hd = bh & 3;
  const bf16_t* gq = GQ + (size_t)bh * GU * 64;
  const bf16_t* gk = GK + (size_t)bh * GU * 64;
  const bf16_t* gv = GV + (size_t)bh * GU * 128 + es * 32;
  const float* lg = LG + (size_t)bh * GU * 64;
  const int sd = tid >> 2, eg = tid & 3;
  float S[8];
#pragma unroll
  for (int j = 0; j < 8; ++j) S[j] = 0.f;
  for (int c = 0; c < 129; ++c) {
    const int u0 = c * 64;
#pragma unroll 2
    for (int idx = tid; idx < 4096; idx += 256) {
      const int t = idx >> 6, d = idx & 63;
      qs[t][d] = bf2f(gq[(size_t)(u0 + t) * 64 + d]);
      ks[t][d] = bf2f(gk[(size_t)(u0 + t) * 64 + d]);
      bc[t][d] = lg[(size_t)(u0 + t) * 64 + d];
    }
    for (int idx = tid; idx < 2048; idx += 256) {
      const int t = idx >> 5, e = idx & 31;
      vs[t][e] = bf2f(gv[(size_t)(u0 + t) * 128 + e]);
    }
#pragma unroll
    for (int j = 0; j < 8; ++j) Ss[sd][eg * 8 + j] = S[j];
    __syncthreads();
    if (tid < 64) { float run = 0.f;
#pragma unroll 4
      for (int t = 0; t < 64; ++t) { run += bc[t][tid]; bc[t][tid] = run; } }
    __syncthreads();
#pragma unroll 2
    for (int idx = tid; idx < 4096; idx += 256) {
      const int t = idx >> 6, d = idx & 63;
      const float bv = bc[t][d];
      qs[t][d] *= __expf(bv) * 0.125f;
      ks[t][d] *= __expf(-bv);
    }
    if (tid < 64) decs[tid] = __expf(bc[63][tid]);
    __syncthreads();
    {
      const int ti = tid >> 4, si = tid & 15;
      float acc[4][4];
#pragma unroll
      for (int a = 0; a < 4; ++a)
#pragma unroll
        for (int bb = 0; bb < 4; ++bb) acc[a][bb] = 0.f;
#pragma unroll 1
      for (int d = 0; d < 64; d += 4) {
        f32x4 q4[4], k4[4];
#pragma unroll
        for (int a = 0; a < 4; ++a) q4[a] = *(const f32x4*)&qs[ti + 16 * a][d];
#pragma unroll
        for (int bb = 0; bb < 4; ++bb) k4[bb] = *(const f32x4*)&ks[si + 16 * bb][d];
#pragma unroll
        for (int a = 0; a < 4; ++a)
#pragma unroll
          for (int bb = 0; bb < 4; ++bb)
            acc[a][bb] += q4[a].x * k4[bb].x + q4[a].y * k4[bb].y + q4[a].z * k4[bb].z + q4[a].w * k4[bb].w;
      }
#pragma unroll
      for (int a = 0; a < 4; ++a)
#pragma unroll
        for (int bb = 0; bb < 4; ++bb) {
          const int t = ti + 16 * a, s = si + 16 * bb;
          at[t][s] = (s <= t) ? acc[a][bb] : 0.f;
        }
    }
    __syncthreads();
    {
      const int t = sd;
      float o[8];
#pragma unroll
      for (int j = 0; j < 8; ++j) o[j] = 0.f;
#pragma unroll 2
      for (int d = 0; d < 64; ++d) {
        const float qv = qs[t][d];
        const f32x4 s0 = *(const f32x4*)&Ss[d][eg * 8], s1 = *(const f32x4*)&Ss[d][eg * 8 + 4];
        o[0] += qv * s0.x; o[1] += qv * s0.y; o[2] += qv * s0.z; o[3] += qv * s0.w;
        o[4] += qv * s1.x; o[5] += qv * s1.y; o[6] += qv * s1.z; o[7] += qv * s1.w;
      }
#pragma unroll 2
      for (int s = 0; s < 64; ++s) {
        const float av = at[t][s];
        const f32x4 v0 = *(const f32x4*)&vs[s][eg * 8], v1 = *(const f32x4*)&vs[s][eg * 8 + 4];
        o[0] += av * v0.x; o[1] += av * v0.y; o[2] += av * v0.z; o[3] += av * v0.w;
        o[4] += av * v1.x; o[5] += av * v1.y; o[6] += av * v1.z; o[7] += av * v1.w;
      }
      if (c >= 1) {
        float* op = GO + ((size_t)(b * SEQ + (c - 1) * 64 + t)) * 512 + hd * 128 + es * 32 + eg * 8;
        *(f32x4*)op = (f32x4){o[0], o[1], o[2], o[3]};
        *(f32x4*)(op + 4) = (f32x4){o[4], o[5], o[6], o[7]};
      }
    }
    {
      float n[8];
#pragma unroll
      for (int j = 0; j < 8; ++j) n[j] = S[j];
#pragma unroll 2
      for (int s = 0; s < 64; ++s) {
        const float kv = ks[s][sd];
        const f32x4 v0 = *(const f32x4*)&vs[s][eg * 8], v1 = *(const f32x4*)&vs[s][eg * 8 + 4];
        n[0] += kv * v0.x; n[1] += kv * v0.y; n[2] += kv * v0.z; n[3] += kv * v0.w;
        n[4] += kv * v1.x; n[5] += kv * v1.y; n[6] += kv * v1.z; n[7] += kv * v1.w;
      }
      const float dec = decs[sd];
#pragma unroll
      for (int j = 0; j < 8; ++j) S[j] = dec * n[j];
    }
    __syncthreads();
  }
}

DI void ph_gla_norm(int m, const float* __restrict__ GO, const bf16_t* __restrict__ GR, const float* __restrict__ gla_g, bf16_t* __restrict__ MIX) {
  const int tid256_ = fresh_tid() & 255;
  const int hd = TID >> 6, lane = TID & 63;
  const f32x2 v = *(const f32x2*)(GO + (size_t)m * 512 + hd * 128 + lane * 2);
  float ss = wave_sum(v.x * v.x + v.y * v.y);
  const float sc = rsqrtf(ss * (1.0f / 128.0f) + EPS);
  const unsigned g2 = *(const unsigned*)(GR + (size_t)m * 512 + hd * 128 + lane * 2);
  const float g0 = bflo(g2), g1 = bfhi(g2);
  const f32x2 gn = *(const f32x2*)(gla_g + hd * 128 + lane * 2);
  const float s0 = g0 / (1.f + __expf(-g0)), s1 = g1 / (1.f + __expf(-g1));
  *(unsigned*)(MIX + (size_t)m * D + 512 + hd * 128 + lane * 2) = pk2(v.x * sc * gn.x * s0, v.y * sc * gn.y * s1);
}

DI bool better(float v1, int i1, float v2, int i2) { return (v1 > v2) || (v1 == v2 && i1 < i2); }
DI void wave_argmax(float& v, int& i) {
#pragma unroll
  for (int o = 32; o >= 1; o >>= 1) {
    const float ov = __shfl_xor(v, o);
    const int oi = __shfl_xor(i, o);
    if (better(ov, oi, v, i)) { v = ov; i = oi; }
  }
}
constexpr int RT_TOK_PER_BLOCK = 256;
DI void ph_route_v1(int vb, char* smem, const bf16_t* __restrict__ QP, const float* __restrict__ sk1, const float* __restrict__ sk2,
                                                  int* __restrict__ EIDX, float* __restrict__ GATE) {
  const int tid256_ = fresh_tid() & 255;
  float (*K1)[68] = (float (*)[68])smem;
  float (*K2)[68] = (float (*)[68])(smem + 34816);
  float (*qsh)[128] = (float (*)[128])(smem + 2 * 34816);
  const int hd = vb & 7, tg = vb >> 3;
  const int tid = TID, lane = tid & 63, wave = tid >> 6;
  for (int idx = tid; idx < 128 * 64; idx += 256) {
    const int k = idx >> 6, d = idx & 63;
    K1[k][d] = sk1[((size_t)hd * 128 + k) * 64 + d];
    K2[k][d] = sk2[((size_t)hd * 128 + k) * 64 + d];
  }
  __syncthreads();
  const float NEG = -3.0e38f;
  for (int it = 0; it < RT_TOK_PER_BLOCK / 4; ++it) {
    const int m = tg * RT_TOK_PER_BLOCK + it * 4 + wave;
    {
      const unsigned q2 = *(const unsigned*)(QP + (size_t)m * D + hd * 128 + lane * 2);
      qsh[wave][lane * 2] = bflo(q2); qsh[wave][lane * 2 + 1] = bfhi(q2);
    }
    __builtin_amdgcn_wave_barrier();
    float s1a = 0.f, s1b = 0.f, s2a = 0.f, s2b = 0.f;
#pragma unroll 4
    for (int d = 0; d < 64; d += 4) {
      const f32x4 q1 = *(const f32x4*)&qsh[wave][d], q2 = *(const f32x4*)&qsh[wave][64 + d];
      const f32x4 a = *(const f32x4*)&K1[lane][d], bb = *(const f32x4*)&K1[lane + 64][d];
      const f32x4 c = *(const f32x4*)&K2[lane][d], dd = *(const f32x4*)&K2[lane + 64][d];
      s1a += q1.x * a.x + q1.y * a.y + q1.z * a.z + q1.w * a.w;
      s1b += q1.x * bb.x + q1.y * bb.y + q1.z * bb.z + q1.w * bb.w;
      s2a += q2.x * c.x + q2.y * c.y + q2.z * c.z + q2.w * c.w;
      s2b += q2.x * dd.x + q2.y * dd.y + q2.z * dd.z + q2.w * dd.w;
    }
    __builtin_amdgcn_wave_barrier();
    float tv1 = 0.f, tv2 = 0.f; int ti1 = 0, ti2 = 0;
    for (int rr = 0; rr < 16; ++rr) {
      float v; int i;
      if (better(s1a, lane, s1b, lane + 64)) { v = s1a; i = lane; } else { v = s1b; i = lane + 64; }
      wave_argmax(v, i);
      if (lane == rr) { tv1 = v; ti1 = i; }
      if (i == lane) s1a = NEG;
      if (i == lane + 64) s1b = NEG;
      if (better(s2a, lane, s2b, lane + 64)) { v = s2a; i = lane; } else { v = s2b; i = lane + 64; }
      wave_argmax(v, i);
      if (lane == rr) { tv2 = v; ti2 = i; }
      if (i == lane) s2a = NEG;
      if (i == lane + 64) s2b = NEG;
    }
    const int ca = lane >> 2;
    const float va = __shfl(tv1, ca); const int ia = __shfl(ti1, ca);
    float cv[4]; int ce[4];
#pragma unroll
    for (int j = 0; j < 4; ++j) {
      const int cb = (lane & 3) * 4 + j;
      cv[j] = va + __shfl(tv2, cb);
      ce[j] = ia * 128 + __shfl(ti2, cb);
    }
    float fsc = 0.f; int fe = 0;
    for (int rr = 0; rr < 16; ++rr) {
      float v = cv[0]; int p = lane * 4;
#pragma unroll
      for (int j = 1; j < 4; ++j) if (better(cv[j], lane * 4 + j, v, p)) { v = cv[j]; p = lane * 4 + j; }
      wave_argmax(v, p);
      const int src = p >> 2, jj = p & 3;
      int e = (jj == 0) ? ce[0] : (jj == 1) ? ce[1] : (jj == 2) ? ce[2] : ce[3];
      e = __shfl(e, src);
      if (lane == rr) { fsc = v; fe = e; }
      if (lane == src) {
        if (jj == 0) cv[0] = NEG; else if (jj == 1) cv[1] = NEG; else if (jj == 2) cv[2] = NEG; else cv[3] = NEG;
      }
    }
    const float mx = __shfl(fsc, 0);
    float ex = (lane < 16) ? __expf(fsc - mx) : 0.f;
    const float sum = wave_sum(ex);
    if (lane < 16) {
      EIDX[(size_t)m * 128 + hd * 16 + lane] = fe;
      GATE[(size_t)m * 128 + hd * 16 + lane] = ex / sum;
    }
  }
  __syncthreads();
}


#define MFMA16(a, b, c) __builtin_amdgcn_mfma_f32_16x16x32_bf16((a), (b), (c), 0, 0, 0)
constexpr int GLDS = 72;
struct GlaLds {
  bf16_t Qt[64 * GLDS];
  bf16_t Kt[64 * GLDS];
  bf16_t KT[64 * GLDS];
  bf16_t P[64 * GLDS];
  float dec[64];
  float tot[8][64];
  float ssq[8][64];
};
constexpr size_t WS_SLOC = 926 * MiB;
constexpr size_t WS_DTOT = 942 * MiB;
constexpr size_t WS_GVT = 604 * MiB;

struct GlaPtrs { const bf16_t *GQ, *GK, *GVT, *GR; const float *GLR, *wg, *bg, *gla_g; float *SLOC, *DTOT; bf16_t* MIX; };

template <int PASS>
DI void gla_item(int bh, int sc, char* smem, const GlaPtrs& G) {
  GlaLds& L = *(GlaLds*)smem;
  const int tid = fresh_tid(), lane = tid & 63, w = __builtin_amdgcn_readfirstlane(tid >> 6), c16 = lane & 15, q = lane >> 4;
  const int b = bh >> 2, hd = bh & 3;
  const int cbeg = sc == 0 ? 0 : 8 * sc + 1, cend = 8 * sc + 9;
  float wgr[16];
#pragma unroll
  for (int k = 0; k < 16; ++k) wgr[k] = G.wg[k * 256 + hd * 64 + lane];
  const float bgv = G.bg[hd * 64 + lane];
  f32x4 X[4];
#pragma unroll
  for (int i = 0; i < 4; ++i) X[i] = (f32x4){0.f, 0.f, 0.f, 0.f};
  if (PASS == 1) {
    for (int j = 0; j < sc; ++j) {
      const float* dt = G.DTOT + (size_t)(bh * 16 + j) * 64;
      const float* sl = G.SLOC + ((size_t)(bh * 16 + j) * 8 + w) * 16 * 64 + lane;
#pragma unroll
      for (int i = 0; i < 4; ++i) {
        const f32x4 d4 = *(const f32x4*)(dt + 16 * i + 4 * q);
        X[i][0] = d4.x * X[i][0] + sl[(4 * i + 0) * 64]; X[i][1] = d4.y * X[i][1] + sl[(4 * i + 1) * 64];
        X[i][2] = d4.z * X[i][2] + sl[(4 * i + 2) * 64]; X[i][3] = d4.w * X[i][3] + sl[(4 * i + 3) * 64];
      }
    }
  }
  f32x4 gain = {1.f, 1.f, 1.f, 1.f};
  if (PASS == 1) gain = *(const f32x4*)(G.gla_g + hd * 128 + 16 * w + 4 * q);
  float blsum = 0.f;
  const bf16_t* gq = G.GQ + (size_t)bh * GU * 64 + lane;
  const bf16_t* gk = G.GK + (size_t)bh * GU * 64 + lane;
  const bf16_t* gvt = G.GVT + ((size_t)bh * 128 + 16 * w + c16) * GU + 8 * q;
  for (int c = cbeg; c < cend; ++c) {
    const int u0 = 64 * c;
    float cs[8];
    {
      float run = 0.f;
#pragma unroll
      for (int i = 0; i < 8; ++i) {
        const int u = u0 + 8 * w + i;
        float lgv = 0.f;
        if (u >= 48) {
          const f32x4* gp = (const f32x4*)(G.GLR + ((size_t)b * GU + u) * 16);
          const f32x4 g0 = gp[0], g1 = gp[1], g2 = gp[2], g3 = gp[3];
          float a = bgv;
          a += g0.x * wgr[0] + g0.y * wgr[1] + g0.z * wgr[2] + g0.w * wgr[3];
          a += g1.x * wgr[4] + g1.y * wgr[5] + g1.z * wgr[6] + g1.w * wgr[7];
          a += g2.x * wgr[8] + g2.y * wgr[9] + g2.z * wgr[10] + g2.w * wgr[11];
          a += g3.x * wgr[12] + g3.y * wgr[13] + g3.z * wgr[14] + g3.w * wgr[15];
          lgv = -softplus(-a) * (1.0f / 16.0f);
        }
        run += lgv; cs[i] = run;
      }
      L.tot[w][lane] = run;
    }
    bf16x8 vfr[2];
    vfr[0] = *(const bf16x8*)(gvt + u0);
    vfr[1] = *(const bf16x8*)(gvt + u0 + 32);
    unsigned short kraw[8], qraw[8];
#pragma unroll
    for (int i = 0; i < 8; ++i) {
      kraw[i] = gk[(size_t)(u0 + 8 * w + i) * 64];
      if (PASS == 1) qraw[i] = gq[(size_t)(u0 + 8 * w + i) * 64];
    }
    __syncthreads();
    {
      float offset = 0.f, total = 0.f;
#pragma unroll
      for (int s2 = 0; s2 < 8; ++s2) { const float tv = L.tot[s2][lane]; total += tv; if (s2 < w) offset += tv; }
      blsum += total;
      if (w == 0) L.dec[lane] = __expf(total);
      float kt[8];
#pragma unroll
      for (int i = 0; i < 8; ++i) {
        const float bc = offset + cs[i];
        kt[i] = bf2f(kraw[i]) * __expf(-bc);
        if (PASS == 1) {
          L.Qt[(8 * w + i) * GLDS + lane] = (bf16_t)f2bf(bf2f(qraw[i]) * __expf(bc) * 0.125f);
          L.Kt[(8 * w + i) * GLDS + lane] = (bf16_t)f2bf(kt[i]);
        }
      }
      u32x4 kp; kp.x = pk2(kt[0], kt[1]); kp.y = pk2(kt[2], kt[3]); kp.z = pk2(kt[4], kt[5]); kp.w = pk2(kt[6], kt[7]);
      *(u32x4*)&L.KT[lane * GLDS + 8 * w] = kp;
    }
    __syncthreads();
    f32x4 OT[4];
    if (PASS == 1) {
      const int is = w >> 1;
#pragma unroll
      for (int z = 0; z < 2; ++z) {
        const int it = 2 * (w & 1) + z;
        f32x4 pa = {0.f, 0.f, 0.f, 0.f};
        if (is <= it) {
#pragma unroll
          for (int kk = 0; kk < 2; ++kk) {
            const bf16x8 ka = *(const bf16x8*)&L.Kt[(16 * is + c16) * GLDS + 32 * kk + 8 * q];
            const bf16x8 qb = *(const bf16x8*)&L.Qt[(16 * it + c16) * GLDS + 32 * kk + 8 * q];
            pa = MFMA16(ka, qb, pa);
          }
          if (is == it) {
#pragma unroll
            for (int r = 0; r < 4; ++r) if (4 * q + r > c16) pa[r] = 0.f;
          }
        }
        u32x2 pw; pw.x = pk2(pa[0], pa[1]); pw.y = pk2(pa[2], pa[3]);
        *(u32x2*)&L.P[(16 * it + c16) * GLDS + 16 * is + 4 * q] = pw;
      }
#pragma unroll
      for (int n = 0; n < 4; ++n) OT[n] = (f32x4){0.f, 0.f, 0.f, 0.f};
#pragma unroll
      for (int kk = 0; kk < 2; ++kk) {
        u32x4 xp; xp.x = pk2(X[2 * kk][0], X[2 * kk][1]); xp.y = pk2(X[2 * kk][2], X[2 * kk][3]);
        xp.z = pk2(X[2 * kk + 1][0], X[2 * kk + 1][1]); xp.w = pk2(X[2 * kk + 1][2], X[2 * kk + 1][3]);
        const bf16x8 xa = __builtin_bit_cast(bf16x8, xp);
#pragma unroll
        for (int n = 0; n < 4; ++n) {
          const u32x2 lo = *(const u32x2*)&L.Qt[(16 * n + c16) * GLDS + 32 * kk + 4 * q];
          const u32x2 hi = *(const u32x2*)&L.Qt[(16 * n + c16) * GLDS + 32 * kk + 16 + 4 * q];
          u32x4 qq; qq.x = lo.x; qq.y = lo.y; qq.z = hi.x; qq.w = hi.y;
          OT[n] = MFMA16(xa, __builtin_bit_cast(bf16x8, qq), OT[n]);
        }
      }
      __syncthreads();
#pragma unroll
      for (int kk = 0; kk < 2; ++kk)
#pragma unroll
        for (int n = 0; n < 4; ++n) {
          const bf16x8 pb = *(const bf16x8*)&L.P[(16 * n + c16) * GLDS + 32 * kk + 8 * q];
          OT[n] = MFMA16(vfr[kk], pb, OT[n]);
        }
    }
#pragma unroll
    for (int i = 0; i < 4; ++i) {
#pragma unroll
      for (int kk = 0; kk < 2; ++kk) {
        const bf16x8 ka = *(const bf16x8*)&L.KT[(16 * i + c16) * GLDS + 32 * kk + 8 * q];
        X[i] = MFMA16(ka, vfr[kk], X[i]);
      }
      const f32x4 d4 = *(const f32x4*)&L.dec[16 * i + 4 * q];
      X[i][0] *= d4.x; X[i][1] *= d4.y; X[i][2] *= d4.z; X[i][3] *= d4.w;
    }
    if (PASS == 1) {
      if (c >= 1) {
        float ss[4];
#pragma unroll
        for (int n = 0; n < 4; ++n) {
          float v = OT[n][0] * OT[n][0] + OT[n][1] * OT[n][1] + OT[n][2] * OT[n][2] + OT[n][3] * OT[n][3];
          v += __shfl_xor(v, 16); v += __shfl_xor(v, 32);
          ss[n] = v;
        }
        if (q == 0) {
#pragma unroll
          for (int n = 0; n < 4; ++n) L.ssq[w][16 * n + c16] = ss[n];
        }
        __syncthreads();
#pragma unroll
        for (int n = 0; n < 4; ++n) {
          float tot = 0.f;
#pragma unroll
          for (int w2 = 0; w2 < 8; ++w2) tot += L.ssq[w2][16 * n + c16];
          const float scl = rsqrtf(tot * (1.0f / 128.0f) + EPS);
          const size_t m = (size_t)b * SEQ + 64 * (c - 1) + 16 * n + c16;
          const u32x2 g2 = *(const u32x2*)(G.GR + m * 512 + hd * 128 + 16 * w + 4 * q);
          const float r0 = bflo(g2.x), r1 = bfhi(g2.x), r2 = bflo(g2.y), r3 = bfhi(g2.y);
          const float o0 = OT[n][0] * scl * gain.x * (r0 / (1.f + __expf(-r0)));
          const float o1 = OT[n][1] * scl * gain.y * (r1 / (1.f + __expf(-r1)));
          const float o2 = OT[n][2] * scl * gain.z * (r2 / (1.f + __expf(-r2)));
          const float o3 = OT[n][3] * scl * gain.w * (r3 / (1.f + __expf(-r3)));
          u32x2 ow; ow.x = pk2(o0, o1); ow.y = pk2(o2, o3);
          *(u32x2*)(G.MIX + m * D + 512 + hd * 128 + 16 * w + 4 * q) = ow;
        }
      }
    }
    __syncthreads();
  }
  if (PASS == 0) {
    float* sl = G.SLOC + ((size_t)(bh * 16 + sc) * 8 + w) * 16 * 64 + lane;
#pragma unroll
    for (int i = 0; i < 4; ++i)
#pragma unroll
      for (int r = 0; r < 4; ++r) sl[(4 * i + r) * 64] = X[i][r];
    if (w == 0) G.DTOT[(size_t)(bh * 16 + sc) * 64 + lane] = __expf(blsum);
  }
}

DI void ph_gvtrans(int vb, char* smem, const bf16_t* __restrict__ GV, bf16_t* __restrict__ GVT) {
  const int tid256_ = fresh_tid() & 255;
  bf16_t (*t)[66] = (bf16_t (*)[66])smem;
  const int tid = TID;
  const int eh = vb & 1, rest = vb >> 1, bh = rest / 258, ut = rest % 258, u0 = ut * 32;
  {
    const int row = tid >> 3, c8 = tid & 7;
    const u32x4 v = *(const u32x4*)(GV + ((size_t)bh * GU + u0 + row) * 128 + eh * 64 + c8 * 8);
    unsigned* tp = (unsigned*)&t[row][c8 * 8];
    tp[0] = v.x; tp[1] = v.y; tp[2] = v.z; tp[3] = v.w;
  }
  __syncthreads();
  {
    const int d = tid >> 2, i4 = tid & 3;
    unsigned wv[4];
#pragma unroll
    for (int j = 0; j < 4; ++j) wv[j] = (unsigned)t[i4 * 8 + 2 * j][d] | ((unsigned)t[i4 * 8 + 2 * j + 1][d] << 16);
    *(u32x4*)(GVT + ((size_t)bh * 128 + eh * 64 + d) * GU + u0 + i4 * 8) = (u32x4){wv[0], wv[1], wv[2], wv[3]};
  }
  __syncthreads();
}

DI void ce_desc(float& a, float& b) {
  float hi, lo;
  asm("v_max_f32 %0, %1, %2" : "=v"(hi) : "v"(a), "v"(b));
  asm("v_min_f32 %0, %1, %2" : "=v"(lo) : "v"(a), "v"(b));
  a = hi; b = lo;
}
DI float vmaxf(float a, float b) { float hi; asm("v_max_f32 %0, %1, %2" : "=v"(hi) : "v"(a), "v"(b)); return hi; }
template <int N> DI void bitonic_sort_desc(float (&v)[N]) {
#pragma unroll
  for (int k = 2; k <= N; k <<= 1) {
#pragma unroll
    for (int j = k >> 1; j > 0; j >>= 1) {
#pragma unroll
      for (int i = 0; i < N; ++i) {
        const int l = i ^ j;
        if (l > i) { if ((i & k) == 0) ce_desc(v[i], v[l]); else ce_desc(v[l], v[i]); }
      }
    }
  }
}
DI void bitonic_merge16_desc(float (&v)[16]) {
#pragma unroll
  for (int j = 8; j > 0; j >>= 1) {
#pragma unroll
    for (int i = 0; i < 16; ++i) { const int l = i ^ j; if (l > i) ce_desc(v[i], v[l]); }
  }
}
template <int NBV> DI void merge_prune16(float (&a)[16], const float (&b)[16]) {
#pragma unroll
  for (int i = 16 - NBV; i < 16; ++i) a[i] = vmaxf(a[i], b[15 - i]);
  bitonic_merge16_desc(a);
}
DI float selh(int hh, float a, float b) { asm volatile("" : "+v"(a), "+v"(b)); return hh == 0 ? a : b; }
DI float pack_idx(float v, unsigned idx, unsigned mask) { return __uint_as_float((__float_as_uint(v) & ~mask) | idx); }

DI void ph_route_v2(int vb, char* smem, const bf16_t* __restrict__ QP, const bf16_t* __restrict__ SK1b, const bf16_t* __restrict__ SK2b,
                    unsigned short* __restrict__ EIDX, float* __restrict__ GATE) {
  const int tid256_ = fresh_tid() & 255;
  const int lane = TID & 63, wave = TID >> 6, r = lane & 31, hh = lane >> 5;
  const int hd = vb & 7, tile = vb >> 3;
  const int m = tile * 128 + wave * 32 + r;
  float loc[2][16];
#pragma unroll
  for (int L = 0; L < 2; ++L) {
    const bf16_t* qp = QP + (size_t)m * D + hd * 128 + L * 64 + hh * 8;
    const bf16_t* kb = (L == 0 ? SK1b : SK2b) + (size_t)(hd * 128 + r) * 64 + hh * 8;
    bf16x8 qf[4];
#pragma unroll
    for (int ks = 0; ks < 4; ++ks) qf[ks] = *(const bf16x8*)(qp + ks * 16);
    float grp[4][16];
#pragma unroll
    for (int mt = 0; mt < 4; ++mt) {
      f32x16 acc;
#pragma unroll
      for (int e = 0; e < 16; ++e) acc[e] = 0.f;
#pragma unroll
      for (int ks = 0; ks < 4; ++ks) {
        const bf16x8 kf = *(const bf16x8*)(kb + (size_t)mt * 32 * 64 + ks * 16);
        acc = MFMA32(kf, qf[ks], acc);
      }
#pragma unroll
      for (int e = 0; e < 16; ++e) grp[mt][e] = pack_idx(acc[e], (unsigned)(mt * 32 + crow(e, hh)), 127u);
      bitonic_sort_desc<16>(grp[mt]);
    }
    merge_prune16<16>(grp[0], grp[1]);
    merge_prune16<16>(grp[2], grp[3]);
    merge_prune16<16>(grp[0], grp[2]);
#pragma unroll
    for (int i = 0; i < 16; ++i) loc[L][i] = grp[0][i];
  }
  float fin[16], oth[16];
#pragma unroll
  for (int i = 0; i < 16; ++i) {
    const float send = selh(hh, loc[1][i], loc[0][i]);
    oth[i] = __shfl_xor(send, 32);
    fin[i] = selh(hh, loc[0][i], loc[1][i]);
  }
  merge_prune16<16>(fin, oth);
  float v1[16], v2[16];
#pragma unroll
  for (int i = 0; i < 16; ++i) {
    const float o = __shfl_xor(fin[i], 32);
    v1[i] = selh(hh, fin[i], o);
    v2[i] = selh(hh, o, fin[i]);
  }
  unsigned* ib = (unsigned*)smem + (size_t)TID * 8;
#pragma unroll
  for (int q = 0; q < 4; ++q) {
    unsigned w1 = 0, w2 = 0;
#pragma unroll
    for (int j = 0; j < 4; ++j) {
      w1 |= (__float_as_uint(v1[4 * q + j]) & 127u) << (8 * j);
      w2 |= (__float_as_uint(v2[4 * q + j]) & 127u) << (8 * j);
    }
    ib[q] = w1; ib[4 + q] = w2;
  }
  float R[16], Bv[16];
#pragma unroll
  for (int j = 0; j < 16; ++j) R[j] = pack_idx(v1[0] + v2[j], (unsigned)j, 255u);
#define ROUTE_ROW(I, CNT) { _Pragma("unroll") for (int j = 0; j < 16; ++j) Bv[j] = (j < CNT) ? pack_idx(v1[I] + v2[j < CNT ? j : 0], (unsigned)(I * 16 + j), 255u) : 0.f; \
    merge_prune16<CNT>(R, Bv); }
  ROUTE_ROW(1, 8) ROUTE_ROW(2, 5) ROUTE_ROW(3, 4) ROUTE_ROW(4, 3) ROUTE_ROW(5, 2) ROUTE_ROW(6, 2) ROUTE_ROW(7, 2)
#undef ROUTE_ROW
#pragma unroll
  for (int j = 0; j < 16; ++j) Bv[j] = (j < 8) ? pack_idx(v1[8 + (j < 8 ? j : 0)] + v2[0], (unsigned)((8 + j) * 16), 255u) : 0.f;
  merge_prune16<8>(R, Bv);
  float ex[16], sum = 0.f;
#pragma unroll
  for (int i = 0; i < 16; ++i) { ex[i] = __expf(R[i] - R[0]); sum += ex[i]; }
  const float inv = 1.f / sum;
  const unsigned char* ibb = (const unsigned char*)ib;
  int eo[8]; float go[8];
#pragma unroll
  for (int w = 0; w < 8; ++w) {
    const float rv = selh(hh, R[w], R[8 + w]);
    const float ev = selh(hh, ex[w], ex[8 + w]);
    const unsigned pos = __float_as_uint(rv) & 255u;
    const unsigned i1 = ibb[pos >> 4], i2 = ibb[16 + (pos & 15u)];
    eo[w] = (int)(i1 * 128u + i2);
    go[w] = ev * inv;
  }
  unsigned short* ep = EIDX + (size_t)m * 128 + hd * 16 + hh * 8;
  float* gp = GATE + (size_t)m * 128 + hd * 16 + hh * 8;
  *(u32x4*)ep = (u32x4){(unsigned)eo[0] | ((unsigned)eo[1] << 16), (unsigned)eo[2] | ((unsigned)eo[3] << 16), (unsigned)eo[4] | ((unsigned)eo[5] << 16), (unsigned)eo[6] | ((unsigned)eo[7] << 16)};
  *(f32x4*)gp = (f32x4){go[0], go[1], go[2], go[3]};
  *(f32x4*)(gp + 4) = (f32x4){go[4], go[5], go[6], go[7]};
}

DI void ph_peer_v1(int vb, char* smem, const bf16_t* __restrict__ A2, const bf16_t* __restrict__ EU, const bf16_t* __restrict__ EV,
                                                 const int* __restrict__ EIDX, const float* __restrict__ GATE, const float* __restrict__ H1,
                                                 const float* __restrict__ gf, float* __restrict__ out) {
  const int tid256_ = fresh_tid() & 255;
  float (*cs)[128] = (float (*)[128])smem;
  int (*es)[128] = (int (*)[128])(smem + 2048);
  const int lane = TID & 63, wave = TID >> 6;
  const int m = vb * 4 + wave;
  const int g = lane >> 3, sub = lane & 7;
  u32x4 xf[16];
#pragma unroll
  for (int j = 0; j < 16; ++j) xf[j] = *(const u32x4*)(A2 + (size_t)m * D + (j * 8 + sub) * 8);
  for (int bt = 0; bt < 16; ++bt) {
    const int k = bt * 8 + g;
    const int e = EIDX[(size_t)m * 128 + k];
    const bf16_t* up = EU + (size_t)e * D + sub * 8;
    float acc = 0.f;
#pragma unroll
    for (int j = 0; j < 16; ++j) {
      const u32x4 u = *(const u32x4*)(up + j * 64);
      acc = dot2bf(u.x, xf[j].x, acc); acc = dot2bf(u.y, xf[j].y, acc); acc = dot2bf(u.z, xf[j].z, acc); acc = dot2bf(u.w, xf[j].w, acc);
    }
    acc += __shfl_xor(acc, 1); acc += __shfl_xor(acc, 2); acc += __shfl_xor(acc, 4);
    if (sub == 0) {
      const float act = 0.5f * acc * (1.f + erff(acc * 0.70710678118654752f));
      cs[wave][k] = GATE[(size_t)m * 128 + k] * act;
      es[wave][k] = e;
    }
  }
  __builtin_amdgcn_wave_barrier();
  __syncthreads();
  float y[16];
#pragma unroll
  for (int j = 0; j < 16; ++j) y[j] = 0.f;
#pragma unroll 4
  for (int k = 0; k < 128; ++k) {
    const float c = cs[wave][k];
    const bf16_t* vp = EV + (size_t)es[wave][k] * D + lane * 8;
    const u32x4 v0 = *(const u32x4*)vp, v1 = *(const u32x4*)(vp + 512);
    y[0] += c * bflo(v0.x); y[1] += c * bfhi(v0.x); y[2] += c * bflo(v0.y); y[3] += c * bfhi(v0.y);
    y[4] += c * bflo(v0.z); y[5] += c * bfhi(v0.z); y[6] += c * bflo(v0.w); y[7] += c * bfhi(v0.w);
    y[8] += c * bflo(v1.x); y[9] += c * bfhi(v1.x); y[10] += c * bflo(v1.y); y[11] += c * bfhi(v1.y);
    y[12] += c * bflo(v1.z); y[13] += c * bfhi(v1.z); y[14] += c * bflo(v1.w); y[15] += c * bfhi(v1.w);
  }
  const float* hp = H1 + (size_t)m * D + lane * 8;
  float ss = 0.f;
#pragma unroll
  for (int q = 0; q < 4; ++q) {
    const f32x4 hv = *(const f32x4*)(hp + (q >> 1) * 512 + (q & 1) * 4);
    y[q * 4 + 0] += hv.x; y[q * 4 + 1] += hv.y; y[q * 4 + 2] += hv.z; y[q * 4 + 3] += hv.w;
  }
#pragma unroll
  for (int j = 0; j < 16; ++j) ss += y[j] * y[j];
  ss = wave_sum(ss);
  const float sc = rsqrtf(ss * (1.0f / D) + EPS);
  float* op = out + (size_t)m * D + lane * 8;
#pragma unroll
  for (int q = 0; q < 4; ++q) {
    const int off = (q >> 1) * 512 + (q & 1) * 4;
    const f32x4 gg = *(const f32x4*)(gf + lane * 8 + off);
    *(f32x4*)(op + off) = (f32x4){y[q * 4 + 0] * sc * gg.x, y[q * 4 + 1] * sc * gg.y, y[q * 4 + 2] * sc * gg.z, y[q * 4 + 3] * sc * gg.w};
  }
}


DI void ph_convert_eu(const float* __restrict__ src, bf16_t* __restrict__ EUs) {
  size_t i = (size_t)blockIdx.x * blockDim.x + threadIdx.x;
  const size_t stride = (size_t)gridDim.x * blockDim.x;
  for (; i < (size_t)NEXP * 128; i += stride) {
    const int e = (int)(i >> 7), pz = (int)(i & 127);
    const f32x4 a = ((const f32x4*)src)[2 * i], b = ((const f32x4*)src)[2 * i + 1];
    u32x4 o; o.x = pk2(a.x, a.y); o.y = pk2(a.z, a.w); o.z = pk2(b.x, b.y); o.w = pk2(b.z, b.w);
    *(u32x4*)(EUs + ((size_t)(pz >> 3) * NEXP + e) * 64 + (pz & 7) * 8) = o;
  }
}
DI void ph_convert_ev(int vb, char* smem, const float* __restrict__ src, bf16_t* __restrict__ EVc) {
  const int tid256_ = fresh_tid() & 255;
  bf16_t (*t)[1028] = (bf16_t (*)[1028])smem;
  const int e0 = vb * 32;
  for (int r = 0; r < 32; ++r) {
    const f32x4 a = *(const f32x4*)(src + (size_t)(e0 + r) * D + TID * 4);
    u32x2 o; o.x = pk2(a.x, a.y); o.y = pk2(a.z, a.w);
    *(u32x2*)&t[r][TID * 4] = o;
  }
  __syncthreads();
  const int r = TID & 31, cs = TID >> 5;
  for (int c0 = 0; c0 < 256; c0 += 8) {
    const int cg = c0 + cs;
    const u32x2 v = *(const u32x2*)&t[r][cg * 4];
    *(u32x2*)(EVc + ((size_t)cg * NEXP + e0 + r) * 4) = v;
  }
  __syncthreads();
}

DI float dpp_f(float v, const int ctrl_sel) {
  int r;
  if (ctrl_sel == 0) r = __builtin_amdgcn_update_dpp(0, __builtin_bit_cast(int, v), 0xB1, 0xF, 0xF, true);
  else if (ctrl_sel == 1) r = __builtin_amdgcn_update_dpp(0, __builtin_bit_cast(int, v), 0x4E, 0xF, 0xF, true);
  else r = __builtin_amdgcn_update_dpp(0, __builtin_bit_cast(int, v), 0x141, 0xF, 0xF, true);
  return __builtin_bit_cast(float, r);
}
DI float dpp_sum8(float v) {
  v += dpp_f(v, 0); v += dpp_f(v, 1); v += dpp_f(v, 2);
  return v;
}
DI void ph_peer_u(int xi, int nx, int wv, int nwv, const bf16_t* __restrict__ A2, const bf16_t* __restrict__ EUs,
                  const unsigned short* __restrict__ EIDX, bf16_t* __restrict__ PP) {
  const int lane = fresh_tid() & 63, g = lane >> 3, sub = lane & 7;
  for (int s = xi; s < 16; s += nx) {
    const bf16_t* tab = EUs + (size_t)s * NEXP * 64 + sub * 8;
    bf16_t* pp = PP + (size_t)s * TREAL * 128;
    for (int t = wv; t < TREAL; t += nwv) {
      const unsigned idxpair = __builtin_nontemporal_load((const unsigned*)(EIDX + (size_t)t * 128) + lane);
      const u32x4 xs = *(const u32x4*)(A2 + (size_t)t * D + s * 64 + sub * 8);
      u32x4 u[16];
#pragma unroll
      for (int j = 0; j < 16; ++j) {
        const unsigned w = (unsigned)__shfl((int)idxpair, (lane & ~7) + (j >> 1));
        const unsigned e = (j & 1) ? (w >> 16) : (w & 0xffffu);
        u[j] = *(const u32x4*)(tab + (size_t)e * 64);
      }
      float res0 = 0.f, res1 = 0.f;
#pragma unroll
      for (int j = 0; j < 16; ++j) {
        float acc = 0.f;
        acc = dot2bf(u[j].x, xs.x, acc); acc = dot2bf(u[j].y, xs.y, acc); acc = dot2bf(u[j].z, xs.z, acc); acc = dot2bf(u[j].w, xs.w, acc);
        acc = dpp_sum8(acc);
        if (sub == (j >> 1)) { if (j & 1) res1 = acc; else res0 = acc; }
      }
      __builtin_nontemporal_store(pk2(res0, res1), (unsigned*)(pp + (size_t)t * 128) + lane);
    }
  }
}
DI void ph_peer_c(const bf16_t* __restrict__ PP, const unsigned short* __restrict__ EIDX, const float* __restrict__ GATE, unsigned* __restrict__ STREAM) {
  size_t i = (size_t)blockIdx.x * blockDim.x + threadIdx.x;
  const size_t stride = (size_t)gridDim.x * blockDim.x, n = (size_t)TREAL * 128;
  for (; i < n; i += stride) {
    float a = 0.f;
#pragma unroll
    for (int s = 0; s < 16; ++s) a += bf2f(PP[(size_t)s * n + i]);
    const float act = 0.5f * a * (1.f + erff(a * 0.70710678118654752f));
    const float c = GATE[i] * act;
    const size_t t = i >> 7; const unsigned k = (unsigned)(i & 127);
    STREAM[(((t >> 6) * 32 + (k >> 2)) * 64 + (t & 63)) * 4 + (k & 3)] = (unsigned)EIDX[i] | (f2bf(c) << 16);
  }
}
DI void ph_peer_v(char* smem, const unsigned* __restrict__ STREAM, const bf16_t* __restrict__ EVc, float* __restrict__ YT) {
  const int tid = fresh_tid(), lane = tid & 63, wave = tid >> 6;
  u32x2* tabl = (u32x2*)smem;
  for (int cg = blockIdx.x; cg < 256; cg += gridDim.x) {
    const u32x4* src = (const u32x4*)(EVc + (size_t)cg * NEXP * 4);
#pragma unroll 4
    for (int i = tid; i < NEXP * 8 / 16; i += 512) ((u32x4*)smem)[i] = src[i];
    __syncthreads();
    for (int it = wave; it < TREAL / 64; it += 8) {
      const int t = it * 64 + lane;
      const u32x4* sp = (const u32x4*)(STREAM + (size_t)it * 8192) + lane;
      float y0 = 0.f, y1 = 0.f, y2 = 0.f, y3 = 0.f;
#pragma unroll 4
      for (int q = 0; q < 32; ++q) {
        const u32x4 w4 = sp[q * 64];
#pragma unroll
        for (int z = 0; z < 4; ++z) {
          const unsigned w = z == 0 ? w4.x : z == 1 ? w4.y : z == 2 ? w4.z : w4.w;
          const float c = bfhi(w);
          const u32x2 v = tabl[w & 0xffffu];
          y0 += c * bflo(v.x); y1 += c * bfhi(v.x); y2 += c * bflo(v.y); y3 += c * bfhi(v.y);
        }
      }
      *(f32x4*)(YT + ((size_t)cg * TREAL + t) * 4) = (f32x4){y0, y1, y2, y3};
    }
    __syncthreads();
  }
}
DI void ph_final(int wv4, const float* __restrict__ H1, const float* __restrict__ YT, const float* __restrict__ gf, float* __restrict__ out) {
  const int lane = fresh_tid() & 63;
  const int t0 = wv4 * 4;
  f32x4 y[4][4];
#pragma unroll
  for (int j = 0; j < 4; ++j) {
    const f32x4* yp = (const f32x4*)(YT + ((size_t)(lane + 64 * j) * TREAL + t0) * 4);
#pragma unroll
    for (int q = 0; q < 4; ++q) y[j][q] = yp[q];
  }
#pragma unroll
  for (int q = 0; q < 4; ++q) {
    const size_t rowoff = (size_t)(t0 + q) * D;
    float ss = 0.f;
#pragma unroll
    for (int j = 0; j < 4; ++j) {
      const f32x4 hv = *(const f32x4*)(H1 + rowoff + (lane + 64 * j) * 4);
      y[j][q].x += hv.x; y[j][q].y += hv.y; y[j][q].z += hv.z; y[j][q].w += hv.w;
      ss += y[j][q].x * y[j][q].x + y[j][q].y * y[j][q].y + y[j][q].z * y[j][q].z + y[j][q].w * y[j][q].w;
    }
    ss = wave_sum(ss);
    const float sc = rsqrtf(ss * (1.0f / D) + EPS);
#pragma unroll
    for (int j = 0; j < 4; ++j) {
      const f32x4 gg = *(const f32x4*)(gf + (lane + 64 * j) * 4);
      *(f32x4*)(out + rowoff + (lane + 64 * j) * 4) = (f32x4){y[j][q].x * sc * gg.x, y[j][q].y * sc * gg.y, y[j][q].z * sc * gg.z, y[j][q].w * sc * gg.w};
    }
  }
}


typedef unsigned char u8_t;
constexpr size_t WS_SCU = 14 * MiB;
constexpr size_t WS_SCV = 14 * MiB + 65536;
DI float wave_max(float v) {
#pragma unroll
  for (int o = 32; o >= 1; o >>= 1) v = fmaxf(v, __shfl_xor(v, o));
  return v;
}
DI u32x4 quant_row16(const float* __restrict__ rowp, int lane, float& sc) {
  const f32x4* rp = (const f32x4*)(rowp + lane * 16);
  const f32x4 a = rp[0], b = rp[1], c = rp[2], d = rp[3];
  float m = fmaxf(fmaxf(fmaxf(fabsf(a.x), fabsf(a.y)), fmaxf(fabsf(a.z), fabsf(a.w))), fmaxf(fmaxf(fabsf(b.x), fabsf(b.y)), fmaxf(fabsf(b.z), fabsf(b.w))));
  m = fmaxf(m, fmaxf(fmaxf(fmaxf(fabsf(c.x), fabsf(c.y)), fmaxf(fabsf(c.z), fabsf(c.w))), fmaxf(fmaxf(fabsf(d.x), fabsf(d.y)), fmaxf(fabsf(d.z), fabsf(d.w)))));
  m = wave_max(m);
  sc = m > 0.f ? m * (1.0f / 448.0f) : 1.0f;
  const float inv = 1.0f / sc;
  u32x4 o; unsigned w;
  w = 0; w = __builtin_amdgcn_cvt_pk_fp8_f32(a.x * inv, a.y * inv, w, false); w = __builtin_amdgcn_cvt_pk_fp8_f32(a.z * inv, a.w * inv, w, true); o.x = w;
  w = 0; w = __builtin_amdgcn_cvt_pk_fp8_f32(b.x * inv, b.y * inv, w, false); w = __builtin_amdgcn_cvt_pk_fp8_f32(b.z * inv, b.w * inv, w, true); o.y = w;
  w = 0; w = __builtin_amdgcn_cvt_pk_fp8_f32(c.x * inv, c.y * inv, w, false); w = __builtin_amdgcn_cvt_pk_fp8_f32(c.z * inv, c.w * inv, w, true); o.z = w;
  w = 0; w = __builtin_amdgcn_cvt_pk_fp8_f32(d.x * inv, d.y * inv, w, false); w = __builtin_amdgcn_cvt_pk_fp8_f32(d.z * inv, d.w * inv, w, true); o.w = w;
  return o;
}
DI void ph_convert_eu8(const float* __restrict__ src, u8_t* __restrict__ EU8s, float* __restrict__ scaleU) {
  const int tid = fresh_tid(), lane = tid & 63, wave = tid >> 6;
  for (int e = (blockIdx.x * 8 + wave) * 2; e < NEXP; e += gridDim.x * 16) {
    float sc0, sc1 = 1.f;
    const bool two = e + 1 < NEXP;
    const u32x4 o0 = quant_row16(src + (size_t)e * D, lane, sc0);
    u32x4 o1 = o0;
    if (two) o1 = quant_row16(src + (size_t)(e + 1) * D, lane, sc1);
    *(u32x4*)(EU8s + ((size_t)(lane >> 3) * NEXP + e) * 128 + (lane & 7) * 16) = o0;
    if (two) *(u32x4*)(EU8s + ((size_t)(lane >> 3) * NEXP + e + 1) * 128 + (lane & 7) * 16) = o1;
    if (lane == 0) { scaleU[e] = sc0; if (two) scaleU[e + 1] = sc1; }
  }
}
DI void ph_convert_ev8(int vb, char* smem, const float* __restrict__ src, u8_t* __restrict__ EV8c, float* __restrict__ scaleV) {
  const int tid256_ = fresh_tid() & 255;
  u8_t (*t)[1040] = (u8_t (*)[1040])smem;
  const int lane = TID & 63, wave = TID >> 6, e0 = vb * 32;
  for (int rr = 0; rr < 8; ++rr) {
    const int r = wave * 8 + rr;
    float sc;
    const u32x4 o = quant_row16(src + (size_t)(e0 + r) * D, lane, sc);
    *(u32x4*)&t[r][lane * 16] = o;
    if (lane == 0) scaleV[e0 + r] = sc;
  }
  __syncthreads();
  const int r = TID & 31, cs = TID >> 5;
  for (int c0 = 0; c0 < 128; c0 += 8) {
    const int cg = c0 + cs;
    const u32x2 v = *(const u32x2*)&t[r][cg * 8];
    *(u32x2*)(EV8c + ((size_t)cg * NEXP + e0 + r) * 8) = v;
  }
  __syncthreads();
}
DI float dot4_fp8(unsigned w, float x0, float x1, float x2, float x3, float acc) {
  const f32x2 lo = __builtin_amdgcn_cvt_pk_f32_fp8(w, false), hi = __builtin_amdgcn_cvt_pk_f32_fp8(w, true);
  acc += lo.x * x0; acc += lo.y * x1; acc += hi.x * x2; acc += hi.y * x3;
  return acc;
}
struct PeerUHalf { u32x4 u[8]; };
template <int HF> DI void peer_u8_issue(PeerUHalf& H, unsigned idxpair, int lane, const u8_t* __restrict__ tab) {
#pragma unroll
  for (int jj = 0; jj < 8; ++jj) {
    const int j = 8 * HF + jj;
    const unsigned w = (unsigned)__shfl((int)idxpair, (lane & ~7) + (j >> 1));
    const unsigned e = (j & 1) ? (w >> 16) : (w & 0xffffu);
    H.u[jj] = *(const u32x4*)(tab + (size_t)e * 128);
  }
}
template <int HF> DI void peer_u8_compute(const PeerUHalf& H, const u32x4 xa, const u32x4 xb, int sub, float& res0, float& res1) {
  const float x0 = bflo(xa.x), x1 = bfhi(xa.x), x2 = bflo(xa.y), x3 = bfhi(xa.y), x4 = bflo(xa.z), x5 = bfhi(xa.z), x6 = bflo(xa.w), x7 = bfhi(xa.w);
  const float x8 = bflo(xb.x), x9 = bfhi(xb.x), x10 = bflo(xb.y), x11 = bfhi(xb.y), x12 = bflo(xb.z), x13 = bfhi(xb.z), x14 = bflo(xb.w), x15 = bfhi(xb.w);
#pragma unroll
  for (int jj = 0; jj < 8; ++jj) {
    const int j = 8 * HF + jj;
    float acc = 0.f;
    acc = dot4_fp8(H.u[jj].x, x0, x1, x2, x3, acc); acc = dot4_fp8(H.u[jj].y, x4, x5, x6, x7, acc);
    acc = dot4_fp8(H.u[jj].z, x8, x9, x10, x11, acc); acc = dot4_fp8(H.u[jj].w, x12, x13, x14, x15, acc);
    acc = dpp_sum8(acc);
    if (sub == (j >> 1)) { if (j & 1) res1 = acc; else res0 = acc; }
  }
}
DI unsigned peer_u8_idx(const unsigned short* __restrict__ EIDX, int t, int lane) {
  return t < TREAL ? __builtin_nontemporal_load((const unsigned*)(EIDX + (size_t)t * 128) + lane) : 0u;
}
DI void ph_peer_u8(int xi, int nx, int wv, int nwv, const bf16_t* __restrict__ A2, const u8_t* __restrict__ EU8s,
                   const unsigned short* __restrict__ EIDX, bf16_t* __restrict__ PP) {
  const int lane = fresh_tid() & 63, sub = lane & 7;
  const int ntok = (TREAL - wv + nwv - 1) / nwv;
#define PU_TOK(i) (wv + ((i) < ntok ? (i) : ntok - 1) * nwv)
#define PU_IDX(t) __builtin_nontemporal_load((const unsigned*)(EIDX + (size_t)(t) * 128) + lane)
#define PU_LDX(xa_, xb_, t) { xa_ = *(const u32x4*)(xbase + (size_t)(t) * D); xb_ = *(const u32x4*)(xbase + (size_t)(t) * D + 8); }
#define PU_STORE(t, r0, r1) __builtin_nontemporal_store(pk2(r0, r1), (unsigned*)(pp + (size_t)(t) * 128) + lane)
  for (int s = xi; s < 8; s += nx) {
    const u8_t* tab = EU8s + (size_t)s * NEXP * 128 + sub * 16;
    const bf16_t* xbase = A2 + s * 128 + sub * 16;
    bf16_t* pp = PP + (size_t)s * TREAL * 128;
    PeerUHalf HA, HB, HC;
    int ta = PU_TOK(0), tb = PU_TOK(1), tc = PU_TOK(2);
    unsigned ia = PU_IDX(ta), ib = PU_IDX(tb), ic = PU_IDX(tc);
    u32x4 xaa, xab; PU_LDX(xaa, xab, ta);
    peer_u8_issue<0>(HA, ia, lane, tab);
    peer_u8_issue<1>(HB, ia, lane, tab);
    for (int i = 0; i < ntok; i += 3) {
      const int td = PU_TOK(i + 3), te = PU_TOK(i + 4), tf = PU_TOK(i + 5);
      u32x4 xba, xbb, xca, xcb, xda, xdb;
      float r0, r1;
      peer_u8_issue<0>(HC, ib, lane, tab); PU_LDX(xba, xbb, tb); const unsigned id = PU_IDX(td);
      r0 = 0.f; r1 = 0.f;
      peer_u8_compute<0>(HA, xaa, xab, sub, r0, r1);
      peer_u8_issue<1>(HA, ib, lane, tab);
      peer_u8_compute<1>(HB, xaa, xab, sub, r0, r1);
      PU_STORE(ta, r0, r1);
      peer_u8_issue<0>(HB, ic, lane, tab); PU_LDX(xca, xcb, tc); const unsigned ie = PU_IDX(te);
      r0 = 0.f; r1 = 0.f;
      peer_u8_compute<0>(HC, xba, xbb, sub, r0, r1);
      peer_u8_issue<1>(HC, ic, lane, tab);
      peer_u8_compute<1>(HA, xba, xbb, sub, r0, r1);
      PU_STORE(tb, r0, r1);
      peer_u8_issue<0>(HA, id, lane, tab); PU_LDX(xda, xdb, td); const unsigned if_ = PU_IDX(tf);
      r0 = 0.f; r1 = 0.f;
      peer_u8_compute<0>(HB, xca, xcb, sub, r0, r1);
      peer_u8_issue<1>(HB, id, lane, tab);
      peer_u8_compute<1>(HC, xca, xcb, sub, r0, r1);
      PU_STORE(tc, r0, r1);
      ta = td; tb = te; tc = tf; ib = ie; ic = if_; xaa = xda; xab = xdb;
    }
  }
#undef PU_TOK
#undef PU_IDX
#undef PU_LDX
#undef PU_STORE
}
DI void ph_peer_c8(const bf16_t* __restrict__ PP, const unsigned short* __restrict__ EIDX, const float* __restrict__ GATE,
                   const float* __restrict__ scaleU, const float* __restrict__ scaleV, unsigned* __restrict__ STREAM) {
  size_t i = (size_t)blockIdx.x * blockDim.x + threadIdx.x;
  const size_t stride = (size_t)gridDim.x * blockDim.x, n = (size_t)TREAL * 128;
  for (; i < n; i += stride) {
    float a = 0.f;
#pragma unroll
    for (int s = 0; s < 8; ++s) a += bf2f(PP[(size_t)s * n + i]);
    const unsigned e = EIDX[i];
    a *= scaleU[e];
    const float act = 0.5f * a * (1.f + erff(a * 0.70710678118654752f));
    const float c = GATE[i] * act * scaleV[e];
    const size_t t = i >> 7; const unsigned k = (unsigned)(i & 127);
    STREAM[(((t >> 6) * 32 + (k >> 2)) * 64 + (t & 63)) * 4 + (k & 3)] = e | (f2bf(c) << 16);
  }
}
struct PVW { u32x4 a, b; };
struct PVT { u32x2 v[8]; };
DI void pv_loadw(PVW& W, const unsigned* __restrict__ STREAM, int it, int g, int lane) {
  const u32x4* sp = (const u32x4*)(STREAM + (size_t)it * 8192) + lane;
  W.a = sp[(2 * g) * 64]; W.b = sp[(2 * g + 1) * 64];
}
DI void pv_readt(PVT& T, const PVW& W, const u32x2* tabl) {
  T.v[0] = tabl[W.a.x & 0xffffu]; T.v[1] = tabl[W.a.y & 0xffffu]; T.v[2] = tabl[W.a.z & 0xffffu]; T.v[3] = tabl[W.a.w & 0xffffu];
  T.v[4] = tabl[W.b.x & 0xffffu]; T.v[5] = tabl[W.b.y & 0xffffu]; T.v[6] = tabl[W.b.z & 0xffffu]; T.v[7] = tabl[W.b.w & 0xffffu];
}
DI void pv_fma1(unsigned w, const u32x2 v, f32x2 (&y)[4]) {
  const float c = bfhi(w);
  const f32x2 cc = {c, c};
  y[0] = __builtin_elementwise_fma(__builtin_amdgcn_cvt_pk_f32_fp8(v.x, false), cc, y[0]);
  y[1] = __builtin_elementwise_fma(__builtin_amdgcn_cvt_pk_f32_fp8(v.x, true), cc, y[1]);
  y[2] = __builtin_elementwise_fma(__builtin_amdgcn_cvt_pk_f32_fp8(v.y, false), cc, y[2]);
  y[3] = __builtin_elementwise_fma(__builtin_amdgcn_cvt_pk_f32_fp8(v.y, true), cc, y[3]);
}
DI void pv_fma(const PVW& W, const PVT& T, f32x2 (&y)[4]) {
  pv_fma1(W.a.x, T.v[0], y); pv_fma1(W.a.y, T.v[1], y); pv_fma1(W.a.z, T.v[2], y); pv_fma1(W.a.w, T.v[3], y);
  pv_fma1(W.b.x, T.v[4], y); pv_fma1(W.b.y, T.v[5], y); pv_fma1(W.b.z, T.v[6], y); pv_fma1(W.b.w, T.v[7], y);
}
DI void ph_peer_v8(char* smem, const unsigned* __restrict__ STREAM, const u8_t* __restrict__ EV8c, float* __restrict__ YT) {
  const int tid = fresh_tid(), lane = tid & 63, wave = tid >> 6;
  const u32x2* tabl = (const u32x2*)smem;
  for (int unit = blockIdx.x; unit < 256; unit += gridDim.x) {
    const int cg = unit & 127, th = unit >> 7;
    const u32x4* src = (const u32x4*)(EV8c + (size_t)cg * NEXP * 8);
#pragma unroll 4
    for (int i = tid; i < NEXP * 8 / 16; i += 512) ((u32x4*)smem)[i] = src[i];
    __syncthreads();
    const int it_end = th * 512 + 512;
    int it = th * 512 + wave;
    PVW W0, W1, W2, W3; PVT T0, T1;
    pv_loadw(W0, STREAM, it, 0, lane); pv_loadw(W1, STREAM, it, 1, lane);
    pv_readt(T0, W0, tabl);
    for (; it < it_end; it += 8) {
      const int itn = (it + 8 < it_end) ? it + 8 : it;
      f32x2 y[4];
#pragma unroll
      for (int z = 0; z < 4; ++z) y[z] = (f32x2){0.f, 0.f};
#define PV_STEP(g, Wld, Wrd, Trd, Wc, Tc) \
      pv_loadw(Wld, STREAM, ((g) + 2 < 16) ? it : itn, ((g) + 2) & 15, lane); \
      pv_readt(Trd, Wrd, tabl); \
      pv_fma(Wc, Tc, y); \
      asm volatile("" ::: "memory");
      PV_STEP(0, W2, W1, T1, W0, T0)  PV_STEP(1, W3, W2, T0, W1, T1)  PV_STEP(2, W0, W3, T1, W2, T0)  PV_STEP(3, W1, W0, T0, W3, T1)
      PV_STEP(4, W2, W1, T1, W0, T0)  PV_STEP(5, W3, W2, T0, W1, T1)  PV_STEP(6, W0, W3, T1, W2, T0)  PV_STEP(7, W1, W0, T0, W3, T1)
      PV_STEP(8, W2, W1, T1, W0, T0)  PV_STEP(9, W3, W2, T0, W1, T1)  PV_STEP(10, W0, W3, T1, W2, T0) PV_STEP(11, W1, W0, T0, W3, T1)
      PV_STEP(12, W2, W1, T1, W0, T0) PV_STEP(13, W3, W2, T0, W1, T1) PV_STEP(14, W0, W3, T1, W2, T0) PV_STEP(15, W1, W0, T0, W3, T1)
#undef PV_STEP
      const int t = it * 64 + lane;
      float* yo = YT + ((size_t)cg * TREAL + t) * 8;
      *(f32x4*)yo = (f32x4){y[0].x, y[0].y, y[1].x, y[1].y};
      *(f32x4*)(yo + 4) = (f32x4){y[2].x, y[2].y, y[3].x, y[3].y};
    }
    __syncthreads();
  }
}
DI void ph_final8(int wv2, const float* __restrict__ H1, const float* __restrict__ YT, const float* __restrict__ gf, float* __restrict__ out) {
  const int lane = fresh_tid() & 63;
  const int t0 = wv2 * 2;
  f32x4 y[2][2][2];
#pragma unroll
  for (int j = 0; j < 2; ++j) {
    const f32x4* yp = (const f32x4*)(YT + ((size_t)(lane + 64 * j) * TREAL + t0) * 8);
    y[j][0][0] = yp[0]; y[j][0][1] = yp[1]; y[j][1][0] = yp[2]; y[j][1][1] = yp[3];
  }
#pragma unroll
  for (int q = 0; q < 2; ++q) {
    const size_t rowoff = (size_t)(t0 + q) * D;
    float ss = 0.f;
#pragma unroll
    for (int j = 0; j < 2; ++j)
#pragma unroll
      for (int hf = 0; hf < 2; ++hf) {
        const f32x4 hv = *(const f32x4*)(H1 + rowoff + (lane + 64 * j) * 8 + hf * 4);
        f32x4& yy = y[j][q][hf];
        yy.x += hv.x; yy.y += hv.y; yy.z += hv.z; yy.w += hv.w;
        ss += yy.x * yy.x + yy.y * yy.y + yy.z * yy.z + yy.w * yy.w;
      }
    ss = wave_sum(ss);
    const float sc = rsqrtf(ss * (1.0f / D) + EPS);
#pragma unroll
    for (int j = 0; j < 2; ++j)
#pragma unroll
      for (int hf = 0; hf < 2; ++hf) {
        const f32x4 gg = *(const f32x4*)(gf + (lane + 64 * j) * 8 + hf * 4);
        const f32x4 yy = y[j][q][hf];
        *(f32x4*)(out + rowoff + (lane + 64 * j) * 8 + hf * 4) = (f32x4){yy.x * sc * gg.x, yy.y * sc * gg.y, yy.z * sc * gg.z, yy.w * sc * gg.w};
      }
  }
}


DI void ph_final_lds(int unit, char* smem, const float* __restrict__ H1, const float* __restrict__ YT, const float* __restrict__ gf, float* __restrict__ out) {
  float (*h2)[1028] = (float (*)[1028])smem;
  const int tid = fresh_tid(), lane = tid & 63, wave = tid >> 6;
  const int t0 = unit * 32;
#pragma unroll
  for (int rr = 0; rr < 4; ++rr) {
    const int r = wave * 4 + rr;
    const float* hp = H1 + (size_t)(t0 + r) * D;
#pragma unroll
    for (int j = 0; j < 4; ++j) *(f32x4*)&h2[r][j * 256 + lane * 4] = *(const f32x4*)(hp + j * 256 + lane * 4);
  }
  __syncthreads();
  {
    const int tok = lane >> 1, hf = lane & 1;
#pragma unroll 4
    for (int cg = wave; cg < 128; cg += 8) {
      const f32x4 yv = *(const f32x4*)(YT + ((size_t)cg * TREAL + t0) * 8 + lane * 4);
      f32x4* hp = (f32x4*)&h2[tok][cg * 8 + hf * 4];
      f32x4 hv = *hp; hv.x += yv.x; hv.y += yv.y; hv.z += yv.z; hv.w += yv.w; *hp = hv;
    }
  }
  __syncthreads();
#pragma unroll
  for (int rr = 0; rr < 4; ++rr) {
    const int r = wave * 4 + rr;
    f32x4 v[4]; float ss = 0.f;
#pragma unroll
    for (int j = 0; j < 4; ++j) { v[j] = *(const f32x4*)&h2[r][j * 256 + lane * 4]; ss += v[j].x * v[j].x + v[j].y * v[j].y + v[j].z * v[j].z + v[j].w * v[j].w; }
    ss = wave_sum(ss);
    const float sc = rsqrtf(ss * (1.0f / D) + EPS);
    float* op = out + (size_t)(t0 + r) * D;
#pragma unroll
    for (int j = 0; j < 4; ++j) {
      const f32x4 gg = *(const f32x4*)(gf + j * 256 + lane * 4);
      *(f32x4*)(op + j * 256 + lane * 4) = (f32x4){v[j].x * sc * gg.x, v[j].y * sc * gg.y, v[j].z * sc * gg.z, v[j].w * sc * gg.w};
    }
  }
  __syncthreads();
}

#define XB_TMO      128
#define XB_XCNT(j)  (256  + 64 * (j))
#define XB_XSUB(j)  (1280 + 64 * (j))
#define XB_XGEN(j)  (2304 + 64 * (j))
#define XB_TOP      3328
#define XB_TOPGEN   3392
#define XCD_BAR_WORDS 3456
#define XB_SPIN_CAP (1u << 20)
#define LAS __attribute__((address_space(3)))
DI unsigned xb_ld(unsigned* p)              { return __hip_atomic_load(p, __ATOMIC_RELAXED, __HIP_MEMORY_SCOPE_AGENT); }
DI unsigned xb_add(unsigned* p, unsigned v) { return __hip_atomic_fetch_add(p, v, __ATOMIC_RELAXED, __HIP_MEMORY_SCOPE_AGENT); }
DI unsigned xb_xcc_id() { return (unsigned)__builtin_amdgcn_s_getreg((3 << 11) | 20) & 0xFu; }
#define XB_SPIN(cond, bar) do { unsigned _sp = 0; while (cond) { __builtin_amdgcn_s_sleep(1); \
    if ((++_sp & 255u) == 0u) { if (xb_ld(&(bar)[XB_TMO])) break; if (_sp > XB_SPIN_CAP) { atomicAdd(&(bar)[XB_TMO], 1u); break; } } } } while (0)
struct XcdBarrier { unsigned* bar; unsigned x; volatile unsigned* st; };
DI XcdBarrier xcd_barrier_post(unsigned* bar, volatile unsigned* st) {
  XcdBarrier b; b.bar = bar; b.x = xb_xcc_id(); b.st = st;
  if (threadIdx.x == 0) (void)xb_add(&bar[XB_XCNT(b.x)], 1u);
  return b;
}
DI void xcd_barrier_complete(unsigned* bar, unsigned x, unsigned& nloc, unsigned& nx) {
  const unsigned G = gridDim.x;
  unsigned sum, cnt, mine, sp = 0u;
  for (;;) {
    sum = 0u; cnt = 0u; mine = 0u;
#pragma unroll
    for (unsigned j = 0; j < 16; ++j) { const unsigned c = xb_ld(&bar[XB_XCNT(j)]); sum += c; cnt += (c > 0u) ? 1u : 0u; mine = (j == x) ? c : mine; }
    if (sum == G) break;
    __builtin_amdgcn_s_sleep(1);
    if ((++sp & 255u) == 0u) { if (xb_ld(&bar[XB_TMO])) break; if (sp > XB_SPIN_CAP) { atomicAdd(&bar[XB_TMO], 1u); break; } }
  }
  nloc = mine > 0u ? mine : 1u; nx = cnt > 0u ? cnt : 1u;
}
DI void xcd_barrier(const XcdBarrier& b) {
  asm volatile("s_waitcnt vmcnt(0)" ::: "memory");
  __syncthreads();
  if (threadIdx.x == 0) {
    unsigned* bar = b.bar;
    __builtin_amdgcn_s_waitcnt(0);
    unsigned nloc = b.st[0], nx = b.st[1];
    if (nloc == 0u) { xcd_barrier_complete(bar, b.x, nloc, nx); b.st[0] = nloc; b.st[1] = nx; }
    const unsigned old = xb_add(&bar[XB_XSUB(b.x)], 1u);
    const unsigned gen = old / nloc;
    if (old + 1u == (gen + 1u) * nloc) {
      __builtin_amdgcn_fence(__ATOMIC_RELEASE, "agent");
      asm volatile("s_waitcnt vmcnt(0)" ::: "memory");
      const unsigned og = xb_add(&bar[XB_TOP], 1u);
      const unsigned tg = og / nx;
      if (og + 1u == (tg + 1u) * nx) xb_add(&bar[XB_TOPGEN], 1u);
      else XB_SPIN(xb_ld(&bar[XB_TOPGEN]) == tg, bar);
      __builtin_amdgcn_fence(__ATOMIC_ACQUIRE, "agent");
      xb_add(&bar[XB_XGEN(b.x)], 1u);
      asm volatile("s_waitcnt vmcnt(0)" ::: "memory");
    } else {
      XB_SPIN(xb_ld(&bar[XB_XGEN(b.x)]) == gen, bar);
      __builtin_amdgcn_fence(__ATOMIC_ACQUIRE, "agent");
      asm volatile("s_waitcnt vmcnt(0)" ::: "memory");
    }
  }
  __syncthreads();
}

struct Params {
  const float *x, *meta, *norm1_g, *w_in, *wg, *bg, *sb_g, *gla_g, *w_out, *norm2_g, *w_pq, *sk1, *sk2, *eu, *ev, *gf;
  float* out; char* ws;
};
constexpr int HALF_SMEM = 73728;
constexpr int SMEM_BYTES = 2 * HALF_SMEM;
constexpr size_t WS_BAR = 0;

__global__ void __launch_bounds__(512, 2) k_fused(Params p) {
  extern __shared__ __attribute__((aligned(16))) char smem_dyn[];
  const int half = __builtin_amdgcn_readfirstlane((int)(threadIdx.x >> 8));
  char* smem = smem_dyn + half * HALF_SMEM;
  __shared__ unsigned xb_words[4];
  if (threadIdx.x < 4) xb_words[threadIdx.x] = 0u;
  __syncthreads();
  const XcdBarrier bar = xcd_barrier_post((unsigned*)(p.ws + WS_BAR), xb_words);
  if (threadIdx.x == 0) xb_words[2] = xb_add((unsigned*)(p.ws + WS_XRANK) + bar.x, 1u);
  const int G = 2 * gridDim.x, bid = 2 * blockIdx.x + half;
  char* ws = p.ws;
  bf16_t* WinT = (bf16_t*)(ws + WS_WIN);
  bf16_t* WoutT = (bf16_t*)(ws + WS_WOUT);
  bf16_t* WpqT = (bf16_t*)(ws + WS_WPQ);
  bf16_t* EU = (bf16_t*)(ws + WS_EU);
  bf16_t* EV = (bf16_t*)(ws + WS_EV);
  bf16_t* SK1b = (bf16_t*)(ws + WS_SK1);
  bf16_t* SK2b = (bf16_t*)(ws + WS_SK2);
  bf16_t* A1 = (bf16_t*)(ws + WS_A1);
  float* GO = (float*)(ws + WS_A1);
  bf16_t* A2 = (bf16_t*)(ws + WS_A1);
  InProjOut O;
  O.QSB = (bf16_t*)(ws + WS_QSB); O.KSB = (bf16_t*)(ws + WS_KSB); O.VTSB = (bf16_t*)(ws + WS_VTSB); O.VSB = (bf16_t*)(ws + WS_VSB);
  O.GQ = (bf16_t*)(ws + WS_GQ); O.GK = (bf16_t*)(ws + WS_GK); O.GV = (bf16_t*)(ws + WS_GV); O.GR = (bf16_t*)(ws + WS_GR);
  O.GLR = (float*)(ws + WS_GLR);
  float* H1 = (float*)(ws + WS_H1);
  bf16_t* GVT = (bf16_t*)(ws + WS_GVT);
  GlaPtrs GP;
  GP.GQ = O.GQ; GP.GK = O.GK; GP.GVT = GVT; GP.GR = O.GR; GP.GLR = O.GLR; GP.wg = p.wg; GP.bg = p.bg; GP.gla_g = p.gla_g;
  GP.SLOC = (float*)(ws + WS_SLOC); GP.DTOT = (float*)(ws + WS_DTOT); GP.MIX = (bf16_t*)(ws + WS_MIX);
  bf16_t* MIX = (bf16_t*)(ws + WS_MIX);
  bf16_t* QP = (bf16_t*)(ws + WS_MIX);
  unsigned short* EIDX = (unsigned short*)(ws + WS_EIDX);
  bf16_t* PP = (bf16_t*)(ws + WS_PP);
  float* YT = (float*)(ws + WS_PP);
  unsigned* STREAM = (unsigned*)(ws + WS_STREAM);
  float* GATE = (float*)(ws + WS_GATE);

  for (int vb = bid; vb < 3328 + 1024 + 1024; vb += G) {
    if (vb < 3328) ph_transpose_w(vb % 104, vb / 104, smem, p.w_in, p.norm1_g, WinT, D, NIN);
    else if (vb < 4352) { const int t = vb - 3328; ph_transpose_w(t % 32, t / 32, smem, p.w_out, nullptr, WoutT, D, D); }
    else { const int t = vb - 4352; ph_transpose_w(t % 32, t / 32, smem, p.w_pq, nullptr, WpqT, D, D); }
  }
  ph_convert_eu8(p.eu, (u8_t*)EU, (float*)(ws + WS_SCU));
  for (int vb = bid; vb < NEXP / 32; vb += G) ph_convert_ev8(vb, smem, p.ev, (u8_t*)EV, (float*)(ws + WS_SCV));
  ph_convert(p.sk1, SK1b, (size_t)8 * 128 * 64 / 8);
  ph_convert(p.sk2, SK2b, (size_t)8 * 128 * 64 / 8);
  ph_zero_pads(O.KSB, O.VSB, O.GQ, O.GK, O.GV);
  for (int vb = bid; vb < TREAL / 16; vb += G) ph_norm_rows<0>(vb, p.x, p.meta, A1);
  __syncthreads();
  if (blockIdx.x < 7) ph_meta(blockIdx.x, smem_dyn, p.meta, p.norm1_g, p.w_in, O);
  xcd_barrier(bar);
  {
    pg8::Gemm g{A1, WinT, TREAL, NINP, D}; pg8::StaticOrder S; S.init(TREAL, NINP, (int)gridDim.x, (int)blockIdx.x);
    EpiInProj E{O};
    pg8::gemm_phase<EpiInProj, pg8::StaticOrder, true, true>((PG8_LAS unsigned char*)smem_dyn, g, S, E);
  }
  xcd_barrier(bar);
  for (int vb = bid; vb < 64 * 257; vb += G) ph_vtrans(vb, smem, O.VSB, O.VTSB);
  for (int vb = bid; vb < 32 * 258 * 2; vb += G) ph_gvtrans(vb, smem, O.GV, GVT);
  xcd_barrier(bar);
  for (int it = blockIdx.x; it < 32 * 15; it += gridDim.x) gla_item<0>(it / 15, it % 15, smem_dyn, GP);
  for (int vb = bid; vb < 64 * 64; vb += G) ph_sb_attn(vb, O.QSB, O.KSB, O.VTSB, p.sb_g, MIX);
  xcd_barrier(bar);
  for (int it = blockIdx.x; it < 32 * 16; it += gridDim.x) gla_item<1>(it >> 4, it & 15, smem_dyn, GP);
  xcd_barrier(bar);
  {
    pg8::Gemm g{MIX, WoutT, TREAL, D, D}; pg8::StaticOrder S; S.init(TREAL, D, (int)gridDim.x, (int)blockIdx.x);
    EpiOut E{p.x, H1};
    pg8::gemm_phase<EpiOut, pg8::StaticOrder, true, true>((PG8_LAS unsigned char*)smem_dyn, g, S, E);
  }
  xcd_barrier(bar);
  for (int vb = bid; vb < TREAL / 16; vb += G) ph_norm_rows<1>(vb, H1, p.norm2_g, A2);
  xcd_barrier(bar);
  {
    pg8::Gemm g{A2, WpqT, TREAL, D, D}; pg8::StaticOrder S; S.init(TREAL, D, (int)gridDim.x, (int)blockIdx.x);
    EpiPQ E{QP};
    pg8::gemm_phase<EpiPQ, pg8::StaticOrder, true, true>((PG8_LAS unsigned char*)smem_dyn, g, S, E);
  }
  xcd_barrier(bar);
  for (int vb = bid; vb < 8 * (TREAL / 128); vb += G) ph_route_v2(vb, smem, QP, SK1b, SK2b, EIDX, GATE);
  xcd_barrier(bar);
  {
    __shared__ int xinfo[4];
    if (threadIdx.x == 0) {
      unsigned* barw = (unsigned*)(p.ws + WS_BAR);
      unsigned cnt = 0, ord = 0, mine = 1;
      for (unsigned j = 0; j < 16; ++j) { const unsigned c = xb_ld(&barw[XB_XCNT(j)]); if (c > 0) { if (j < bar.x) ++ord; ++cnt; } if (j == bar.x) mine = c; }
      xinfo[0] = (int)ord; xinfo[1] = (int)cnt; xinfo[2] = (int)xb_words[2]; xinfo[3] = (int)mine;
    }
    __syncthreads();
    const int xi = xinfo[0], nx = xinfo[1], rank = xinfo[2], nloc = xinfo[3];
    const int wave = __builtin_amdgcn_readfirstlane((int)(threadIdx.x >> 6));
    ph_peer_u8(xi, nx, rank * 8 + wave, nloc * 8, A2, (const u8_t*)EU, EIDX, PP);
  }
  xcd_barrier(bar);
  ph_peer_c8(PP, EIDX, GATE, (const float*)(ws + WS_SCU), (const float*)(ws + WS_SCV), STREAM);
  xcd_barrier(bar);
  ph_peer_v8(smem_dyn, STREAM, (const u8_t*)EV, YT);
  xcd_barrier(bar);
  for (int unit = blockIdx.x; unit < TREAL / 32; unit += gridDim.x) ph_final_lds(unit, smem_dyn, H1, YT, p.gf, p.out);
}

extern "C" void kernel_launch(void* const* d_in, const int* in_sizes, int n_in, void* d_out, int out_size, void* d_ws, size_t ws_size, hipStream_t stream) {
  static int grid = 0;
  if (grid == 0) {
    int dev = 0, cus = 0, per_cu = 0;
    hipGetDevice(&dev);
    hipDeviceGetAttribute(&cus, hipDeviceAttributeMultiprocessorCount, dev);
    hipFuncSetAttribute((const void*)k_fused, hipFuncAttributeMaxDynamicSharedMemorySize, SMEM_BYTES);
    hipOccupancyMaxActiveBlocksPerMultiprocessor(&per_cu, (const void*)k_fused, 512, SMEM_BYTES);
    if (per_cu > 1) per_cu = 1;
    if (per_cu < 1) per_cu = 1;
    grid = cus * per_cu;
  }
  hipMemsetAsync((char*)d_ws + WS_BAR, 0, 32768, stream);
  Params p{};
  p.x = (const float*)d_in[0]; p.meta = (const float*)d_in[1]; p.norm1_g = (const float*)d_in[2]; p.w_in = (const float*)d_in[3];
  p.wg = (const float*)d_in[4]; p.bg = (const float*)d_in[5]; p.sb_g = (const float*)d_in[6]; p.gla_g = (const float*)d_in[7];
  p.w_out = (const float*)d_in[8]; p.norm2_g = (const float*)d_in[9]; p.w_pq = (const float*)d_in[10]; p.sk1 = (const float*)d_in[11];
  p.sk2 = (const float*)d_in[12]; p.eu = (const float*)d_in[13]; p.ev = (const float*)d_in[14]; p.gf = (const float*)d_in[15];
  p.out = (float*)d_out; p.ws = (char*)d_ws;
  void* args[] = {&p};
  hipLaunchCooperativeKernel((const void*)k_fused, dim3(grid), dim3(512), args, SMEM_BYTES, stream);
}
```

```cpp
#include <hip/hip_runtime.h>
#include <stdint.h>
#include <stddef.h>

typedef unsigned short bf16_t;
typedef short bf16x8 __attribute__((ext_vector_type(8)));
typedef float f32x16 __attribute__((ext_vector_type(16)));
typedef float f32x4 __attribute__((ext_vector_type(4)));
typedef float f32x2 __attribute__((ext_vector_type(2)));
typedef unsigned u32x4 __attribute__((ext_vector_type(4)));
typedef unsigned u32x2 __attribute__((ext_vector_type(2)));
typedef __bf16 bf16x2_t __attribute__((ext_vector_type(2)));

#define DI __device__ __forceinline__
__device__ __forceinline__ int fresh_tid() { int t = (int)threadIdx.x; asm volatile("" : "+v"(t)); return t; }
#define TID tid256_
#define MFMA32(a, b, c) __builtin_amdgcn_mfma_f32_32x32x16_bf16((a), (b), (c), 0, 0, 0)

constexpr int D = 1024, NB = 8, SEQ = 8192, NMETA = 16;
constexpr int TREAL = NB * SEQ;
constexpr int MROWS = TREAL + 128;
constexpr int NIN = 3088, NINP = 3328;
constexpr int SBH = 8, SBD = 64;
constexpr int GH = 4, GDK = 64, GDV = 128;
constexpr int KIDX = SEQ + 32;
constexpr int GU = SEQ + 64;
constexpr int NEXP = 16384;
constexpr float EPS = 1e-6f;

constexpr size_t MiB = 1u << 20;
constexpr size_t WS_WIN = 1 * MiB;
constexpr size_t WS_WOUT = 8 * MiB;
constexpr size_t WS_WPQ = 10 * MiB;
constexpr size_t WS_SK1 = 12 * MiB;
constexpr size_t WS_SK2 = 13 * MiB;
constexpr size_t WS_EU = 16 * MiB;
constexpr size_t WS_EV = 48 * MiB;
constexpr size_t WS_A1 = 80 * MiB;
constexpr size_t WS_QSB = 210 * MiB;
constexpr size_t WS_KSB = 274 * MiB;
constexpr size_t WS_VTSB = 339 * MiB;
constexpr size_t WS_GQ = 404 * MiB;
constexpr size_t WS_GK = 437 * MiB;
constexpr size_t WS_H1 = 210 * MiB;
constexpr size_t WS_GV = 470 * MiB;
constexpr size_t WS_GR = 535 * MiB;
constexpr size_t WS_GLR = 599 * MiB;
constexpr size_t WS_LG = 604 * MiB;
constexpr size_t WS_MIX = 669 * MiB;
constexpr size_t WS_EIDX = 797 * MiB;
constexpr size_t WS_GATE = 829 * MiB;
constexpr size_t WS_PP = 470 * MiB;
constexpr size_t WS_STREAM = 726 * MiB;
constexpr size_t WS_XRANK = 16384;
constexpr size_t WS_VSB = 861 * MiB;
constexpr size_t WS_END = 926 * MiB;

DI unsigned f2bf(float f) { unsigned u = __float_as_uint(f); return (u + 0x7fffu + ((u >> 16) & 1u)) >> 16; }
DI float bf2f(unsigned b) { return __uint_as_float(b << 16); }
DI unsigned pk2(float lo, float hi) { f32x2 v = {lo, hi}; return __builtin_bit_cast(unsigned, __builtin_convertvector(v, bf16x2_t)); }
DI float bflo(unsigned u) { return __uint_as_float(u << 16); }
DI float bfhi(unsigned u) { return __uint_as_float(u & 0xffff0000u); }
DI int crow(int reg, int h) { return (reg & 3) + 8 * (reg >> 2) + 4 * h; }
DI float wave_sum(float v) {
#pragma unroll
  for (int o = 32; o >= 1; o >>= 1) v += __shfl_xor(v, o);
  return v;
}
DI float dot2bf(unsigned a, unsigned b, float acc) { return __builtin_amdgcn_fdot2_f32_bf16(__builtin_bit_cast(bf16x2_t, a), __builtin_bit_cast(bf16x2_t, b), acc, false); }
DI float softplus(float z) { return fmaxf(z, 0.f) + __logf(1.f + __expf(-fabsf(z))); }

DI void ph_transpose_w(int bx, int by, char* smem, const float* __restrict__ W, const float* __restrict__ gain, bf16_t* __restrict__ WT, int K, int N) {
  const int tid256_ = fresh_tid() & 255;
  float (*t)[33] = (float (*)[33])smem;
  const int n0 = bx * 32, k0 = by * 32, tx = TID & 31, ty = TID >> 5;
  for (int r = ty; r < 32; r += 8) {
    const int k = k0 + r, n = n0 + tx;
    float v = 0.f;
    if (n < N) { v = W[(size_t)k * N + n]; if (gain) v *= gain[k]; }
    t[r][tx] = v;
  }
  __syncthreads();
  for (int r = ty; r < 32; r += 8) {
    const int n = n0 + r, k = k0 + tx;
    WT[(size_t)n * K + k] = (bf16_t)f2bf(t[tx][r]);
  }
  __syncthreads();
}
DI void ph_convert(const float* __restrict__ src, bf16_t* __restrict__ dst, size_t n8) {
  size_t i = (size_t)blockIdx.x * blockDim.x + threadIdx.x;
  const size_t stride = (size_t)gridDim.x * blockDim.x;
  for (; i < n8; i += stride) {
    const f32x4 a = ((const f32x4*)src)[2 * i], b = ((const f32x4*)src)[2 * i + 1];
    u32x4 o; o.x = pk2(a.x, a.y); o.y = pk2(a.z, a.w); o.z = pk2(b.x, b.y); o.w = pk2(b.z, b.w);
    ((u32x4*)dst)[i] = o;
  }
}
DI void ph_zero_pads(bf16_t* KSB, bf16_t* VTSB, bf16_t* GQ, bf16_t* GK, bf16_t* GV) {
  const int tid = blockIdx.x * blockDim.x + threadIdx.x, nth = gridDim.x * blockDim.x;
  for (int i = tid; i < 64 * 16 * 64; i += nth) { const int bh = i / 1024, r = i % 1024; KSB[(size_t)bh * KIDX * 64 + r] = 0; }
  for (int i = tid; i < 64 * 16 * 64; i += nth) { const int bh = i / 1024, r = i % 1024; VTSB[(size_t)bh * KIDX * 64 + r] = 0; }
  for (int i = tid; i < 32 * 48 * 64; i += nth) { const int bh = i / 3072, r = i % 3072; GQ[(size_t)bh * GU * 64 + r] = 0; GK[(size_t)bh * GU * 64 + r] = 0; }
  for (int i = tid; i < 32 * 48 * 128; i += nth) { const int bh = i / 6144, r = i % 6144; GV[(size_t)bh * GU * 128 + r] = 0; }
}

template <int MODE>
DI void ph_norm_rows(int vb, const float* __restrict__ src, const float* __restrict__ meta, bf16_t* __restrict__ dst) {
  const int tid256_ = fresh_tid() & 255;
  const int row0 = vb * 16 + (TID >> 6) * 4, lane = TID & 63;
  f32x4 v[4][4];
#pragma unroll
  for (int rr = 0; rr < 4; ++rr)
#pragma unroll
    for (int j = 0; j < 4; ++j) v[rr][j] = *(const f32x4*)(src + (size_t)(row0 + rr) * D + j * 256 + lane * 4);
  f32x4 gg[4];
#pragma unroll
  for (int j = 0; j < 4; ++j) { gg[j] = (f32x4){1.f, 1.f, 1.f, 1.f}; if (MODE == 1) gg[j] = *(const f32x4*)(meta + j * 256 + lane * 4); }
#pragma unroll
  for (int rr = 0; rr < 4; ++rr) {
    float ss = 0.f;
#pragma unroll
    for (int j = 0; j < 4; ++j) ss += v[rr][j].x * v[rr][j].x + v[rr][j].y * v[rr][j].y + v[rr][j].z * v[rr][j].z + v[rr][j].w * v[rr][j].w;
    ss = wave_sum(ss);
    const float r = rsqrtf(ss * (1.0f / D) + EPS);
#pragma unroll
    for (int j = 0; j < 4; ++j) {
      u32x2 o; o.x = pk2(v[rr][j].x * r * gg[j].x, v[rr][j].y * r * gg[j].y); o.y = pk2(v[rr][j].z * r * gg[j].z, v[rr][j].w * r * gg[j].w);
      *(u32x2*)(dst + (size_t)(row0 + rr) * D + j * 256 + lane * 4) = o;
    }
  }
}

namespace pg8 {
#define PG8_LAS __attribute__((address_space(3)))
typedef unsigned short bf16_t;
typedef short bf16x8 __attribute__((ext_vector_type(8)));
typedef float f32x4 __attribute__((ext_vector_type(4)));
typedef unsigned u32x4 __attribute__((ext_vector_type(4)));
constexpr int BM = 256, BK = 64, HALF = 128, HTB = HALF * BK * 2  , STAGE_BYTES = 8 * HTB, NXCD = 8, WGM = 8;

__host__ __device__ __forceinline__ int lds_byte(int r, int c) { const int st = (r >> 4) * 2 + (c >> 5), rr = r & 15, cc = c & 31, ob = rr * 64 + cc * 2; return st * 1024 + (ob ^ (((ob >> 9) & 1) << 5)); }
__host__ __device__ __forceinline__ void stage_rc(int b, int& R, int& C) { const int st = b / 1024, sb = b % 1024, swz = sb ^ (((sb >> 9) & 1) << 5); R = (st >> 1) * 16 + swz / 64; C = (st & 1) * 32 + (swz % 64) / 2; }
__host__ __device__ __forceinline__ int perm32(int rho) { const int n = rho >> 4, i = rho & 15; return 8 * (i >> 2) + 4 * n + (i & 3); }

struct Unit { int pm, pn; };
struct Gemm { const bf16_t* A; const bf16_t* Bt; int M, N, K; };

struct StaticOrder {
    int nM, nN, nwg, G, c;
    __host__ __device__ void init(int M, int N, int G_, int c_) { nM = M / BM; nN = N / BM; nwg = nM * nN; G = G_; c = c_; }
    __host__ __device__ bool next(int i, Unit& u) const {
        const long L = (long)i * G + c; if (L >= nwg) return false;
        int wgid = (int)L; { const int q = nwg / NXCD, r = nwg % NXCD, xcd = wgid % NXCD, off = wgid / NXCD; wgid = (xcd < r ? xcd * (q + 1) : r * (q + 1) + (xcd - r) * q) + off; }
        const int nig = WGM * nN, gid = wgid / nig, fm = gid * WGM, gsz = (nM - fm) < WGM ? (nM - fm) : WGM;
        u.pm = fm + ((wgid % nig) % gsz); u.pn = (wgid % nig) / gsz; return true;
    }
    __device__ __forceinline__ void a_ready(const Unit&) const {}
    __device__ __forceinline__ void done(const Unit&) const {}
};

template <class Epi, class Sched, bool ALIGN_EPI = false, bool SP2 = false>
__device__ __forceinline__ void gemm_phase(PG8_LAS unsigned char* lds, const Gemm g, const Sched& S, const Epi& E) {
    const int tid = fresh_tid(), wid = __builtin_amdgcn_readfirstlane(tid >> 6), lane = tid & 63, wr = wid >> 2, wc = wid & 3, fr = lane & 15, fq = lane >> 4;
    const int K = g.K, nt = K / BK;
    unsigned voffA[2], voffB[2];
#pragma unroll
    for (int i = 0; i < 2; ++i) { int R, C; stage_rc(tid * 16 + i * 8192, R, C); const int Rb = Epi::PERM ? ((R & ~31) + perm32(R & 31)) : R;
        voffA[i] = (unsigned)(R * K + C) * 2u; voffB[i] = (unsigned)(Rb * K + C) * 2u; }
    const size_t kstep = (size_t)(BK * 2);
    const size_t hstep = (size_t)HALF * K * 2;
    const size_t tstep = 2 * hstep;
    const unsigned ldsw = (unsigned)wid * 1024u;
    const int aoff = lds_byte(wr * 64 + fr, fq * 8), boff = lds_byte(wc * 32 + fr, fq * 8);
#define PG8_SA(b, h) (((b) * 2 + (h)) * HTB)
#define PG8_SB(b, h) ((4 + (b) * 2 + (h)) * HTB)
#define PG8_STAGE(bufoff, gbase, voff) do { _Pragma("unroll") for (int _i = 0; _i < 2; ++_i) \
        __builtin_amdgcn_global_load_lds((const unsigned*)((const char*)(gbase) + (voff)[_i]), (PG8_LAS unsigned*)(lds + (bufoff) + ldsw + _i * 8192), 16, 0, 0); } while (0)
#define PG8_LDA(dst, b, h) do { _Pragma("unroll") for (int m = 0; m < 4; ++m) _Pragma("unroll") for (int k = 0; k < 2; ++k) dst[m][k] = *(const PG8_LAS bf16x8*)(lds + PG8_SA(b, h) + aoff + m * 2048 + k * 1024); } while (0)
#define PG8_LDB(dst, b, h) do { _Pragma("unroll") for (int n = 0; n < 2; ++n) _Pragma("unroll") for (int k = 0; k < 2; ++k) dst[n][k] = *(const PG8_LAS bf16x8*)(lds + PG8_SB(b, h) + boff + n * 2048 + k * 1024); } while (0)
#define PG8_MMA(ai, bj, At, Bt) do { __builtin_amdgcn_s_setprio(1); _Pragma("unroll") for (int m = 0; m < 4; ++m) _Pragma("unroll") for (int n = 0; n < 2; ++n) _Pragma("unroll") for (int k = 0; k < 2; ++k) \
        acc[ai][bj][m][n] = __builtin_amdgcn_mfma_f32_16x16x32_bf16(Bt[n][k], At[m][k], acc[ai][bj][m][n], 0, 0, 0); __builtin_amdgcn_s_setprio(0); } while (0)
#define PG8_WAIT_V(n) asm volatile("s_waitcnt vmcnt(" #n ")" ::: "memory")
#define PG8_WAIT_L(n) asm volatile("s_waitcnt lgkmcnt(" #n ")" ::: "memory")
#define PG8_BAR __builtin_amdgcn_s_barrier()
#define PG8_SCHED __builtin_amdgcn_sched_barrier(0)
    Unit cur, nxt; int ui = 0;
    if (!S.next(0, cur)) return;
    f32x4 acc[2][2][4][2];
#pragma unroll
    for (int a = 0; a < 2; ++a)
#pragma unroll
        for (int b = 0; b < 2; ++b)
#pragma unroll
            for (int m = 0; m < 4; ++m)
#pragma unroll
                for (int n = 0; n < 2; ++n) acc[a][b][m][n] = (f32x4){0.f, 0.f, 0.f, 0.f};
    bf16x8 At[4][2], B0[2][2], B1[2][2];
    const char* cA = (const char*)g.A + (size_t)cur.pm * tstep; const char* cB = (const char*)g.Bt + (size_t)cur.pn * tstep;
    S.a_ready(cur);
    if constexpr (SP2) {
        PG8_STAGE(PG8_SB(0, 0), cB, voffB); PG8_STAGE(PG8_SB(0, 1), cB + hstep, voffB); PG8_STAGE(PG8_SA(0, 0), cA, voffA); PG8_STAGE(PG8_SA(0, 1), cA + hstep, voffA);
        if (wr == 1) PG8_BAR;
        PG8_WAIT_V(2); PG8_BAR;
        PG8_STAGE(PG8_SB(1, 0), cB + kstep, voffB); PG8_STAGE(PG8_SA(1, 0), cA + kstep, voffA); PG8_STAGE(PG8_SB(1, 1), cB + hstep + kstep, voffB);
        PG8_WAIT_V(6); PG8_BAR;
    } else {
        PG8_STAGE(PG8_SB(0, 0), cB, voffB); PG8_STAGE(PG8_SA(0, 0), cA, voffA); PG8_STAGE(PG8_SB(0, 1), cB + hstep, voffB); PG8_STAGE(PG8_SA(0, 1), cA + hstep, voffA);
        if (wr == 1) PG8_BAR;
        PG8_WAIT_V(4); PG8_BAR;
        PG8_STAGE(PG8_SB(1, 0), cB + kstep, voffB); PG8_STAGE(PG8_SA(1, 0), cA + kstep, voffA); PG8_STAGE(PG8_SB(1, 1), cB + hstep + kstep, voffB);
        PG8_WAIT_V(6); PG8_BAR;
    }
    for (;;) {
        const bool has_next = S.next(ui + 1, nxt);
        const char* nA = has_next ? (const char*)g.A + (size_t)nxt.pm * tstep : cA; const char* nB = has_next ? (const char*)g.Bt + (size_t)nxt.pn * tstep : cB;
        for (int t = 0; t < nt; t += 2) {
            const bool last = (t == nt - 2);
            const char* a1 = cA + (size_t)(t + 1) * kstep;
            const char* a2 = last ? nA : cA + (size_t)(t + 2) * kstep; const char* b2 = last ? nB : cB + (size_t)(t + 2) * kstep;
            const char* a3 = a2 + kstep; const char* b3 = b2 + kstep;
            if (last && has_next) S.a_ready(nxt);
            if constexpr (SP2) {
            PG8_LDB(B0, 0, 0); PG8_LDB(B1, 0, 1); PG8_SCHED; PG8_LDA(At, 0, 0); PG8_STAGE(PG8_SA(1, 1), a1 + hstep, voffA);
            PG8_WAIT_V(8); PG8_WAIT_L(0); PG8_BAR; PG8_MMA(0, 0, At, B0); PG8_MMA(0, 1, At, B1); PG8_BAR; PG8_SCHED;
            PG8_LDA(At, 0, 1); PG8_STAGE(PG8_SB(0, 0), b2, voffB); PG8_STAGE(PG8_SB(0, 1), b2 + hstep, voffB); PG8_STAGE(PG8_SA(0, 0), a2, voffA);
            PG8_WAIT_V(8); PG8_WAIT_L(0); PG8_BAR; PG8_MMA(1, 0, At, B0); PG8_MMA(1, 1, At, B1); PG8_BAR; PG8_SCHED;
            PG8_LDB(B0, 1, 0); PG8_LDB(B1, 1, 1); PG8_SCHED; PG8_LDA(At, 1, 0); PG8_STAGE(PG8_SA(0, 1), a2 + hstep, voffA);
            PG8_WAIT_V(8); PG8_WAIT_L(0); PG8_BAR; PG8_MMA(0, 0, At, B0); PG8_MMA(0, 1, At, B1); PG8_BAR; PG8_SCHED;
            PG8_LDA(At, 1, 1); PG8_STAGE(PG8_SB(1, 0), b3, voffB); PG8_STAGE(PG8_SB(1, 1), b3 + hstep, voffB); PG8_STAGE(PG8_SA(1, 0), a3, voffA);
            PG8_WAIT_V(8); PG8_WAIT_L(0); PG8_BAR; PG8_MMA(1, 0, At, B0); PG8_MMA(1, 1, At, B1); PG8_BAR; PG8_SCHED;
            } else {
            PG8_LDB(B0, 0, 0); PG8_SCHED; PG8_LDA(At, 0, 0); PG8_STAGE(PG8_SA(1, 1), a1 + hstep, voffA);
            PG8_WAIT_L(8); PG8_BAR; PG8_WAIT_L(0); PG8_MMA(0, 0, At, B0); PG8_BAR; PG8_SCHED;
            PG8_LDB(B1, 0, 1); PG8_STAGE(PG8_SB(0, 0), b2, voffB);
            PG8_BAR; PG8_WAIT_L(0); PG8_MMA(0, 1, At, B1); PG8_BAR;
            PG8_LDA(At, 0, 1); PG8_STAGE(PG8_SA(0, 0), a2, voffA);
            PG8_BAR; PG8_WAIT_L(0); PG8_MMA(1, 0, At, B0); PG8_BAR; PG8_SCHED;
            PG8_STAGE(PG8_SB(0, 1), b2 + hstep, voffB);
            PG8_WAIT_V(6); PG8_BAR; PG8_MMA(1, 1, At, B1); PG8_BAR;
            PG8_LDB(B0, 1, 0); PG8_SCHED; PG8_LDA(At, 1, 0); PG8_STAGE(PG8_SA(0, 1), a2 + hstep, voffA);
            PG8_WAIT_L(8); PG8_BAR; PG8_WAIT_L(0); PG8_MMA(0, 0, At, B0); PG8_BAR; PG8_SCHED;
            PG8_LDB(B1, 1, 1); PG8_STAGE(PG8_SB(1, 0), b3, voffB);
            PG8_BAR; PG8_WAIT_L(0); PG8_MMA(0, 1, At, B1); PG8_BAR;
            PG8_LDA(At, 1, 1); PG8_STAGE(PG8_SA(1, 0), a3, voffA);
            PG8_BAR; PG8_WAIT_L(0); PG8_MMA(1, 0, At, B0); PG8_BAR; PG8_SCHED;
            PG8_STAGE(PG8_SB(1, 1), b3 + hstep, voffB);
            PG8_WAIT_V(6); PG8_BAR; PG8_MMA(1, 1, At, B1); PG8_BAR;
            }
        }
        if constexpr (ALIGN_EPI) { if (wr == 0) PG8_BAR; }
        if constexpr (!Epi::AFTER_DRAIN) { E(acc, cur, wr, wc, fr, fq); S.done(cur); }
        if (!has_next) break;
#pragma unroll
        for (int a = 0; a < 2; ++a)
#pragma unroll
            for (int b = 0; b < 2; ++b)
#pragma unroll
                for (int m = 0; m < 4; ++m)
#pragma unroll
                    for (int n = 0; n < 2; ++n) acc[a][b][m][n] = (f32x4){0.f, 0.f, 0.f, 0.f};
        cur = nxt; cA = nA; cB = nB; ++ui;
        if constexpr (ALIGN_EPI) { if (wr == 1) PG8_BAR; }
    }
    PG8_WAIT_V(0);
    if constexpr (!ALIGN_EPI) { if (wr == 0) PG8_BAR; }
    PG8_BAR;
    if constexpr (Epi::AFTER_DRAIN) { E.fused(acc, cur, wr, wc, fr, fq, lds, wid, lane); S.done(cur); }
#undef PG8_SA
#undef PG8_SB
#undef PG8_STAGE
#undef PG8_LDA
#undef PG8_LDB
#undef PG8_MMA
#undef PG8_WAIT_V
#undef PG8_WAIT_L
#undef PG8_BAR
#undef PG8_SCHED
}
}

struct InProjOut { bf16_t *QSB, *KSB, *VSB, *VTSB, *GQ, *GK, *GV, *GR; float* GLR; };

struct EpiInProj {
  static constexpr bool PERM = true, AFTER_DRAIN = false;
  InProjOut O;
  DI void operator()(const pg8::f32x4 (&acc)[2][2][4][2], const pg8::Unit& u, int wr, int wc, int fr, int fq) const {
    const int pn = u.pn;
#pragma unroll
    for (int ai = 0; ai < 2; ++ai)
#pragma unroll
      for (int m = 0; m < 4; ++m) {
        const int row = u.pm * 256 + ai * 128 + wr * 64 + m * 16 + fr;
        const int b = row >> 13, i = row & 8191;
#pragma unroll
        for (int bj = 0; bj < 2; ++bj) {
          const int col = pn * 256 + bj * 128 + wc * 32 + 8 * fq;
          const pg8::f32x4 v0 = acc[ai][bj][m][0], v1 = acc[ai][bj][m][1];
          if (pn < 12) {
            u32x4 w; w.x = pk2(v0[0], v0[1]); w.y = pk2(v0[2], v0[3]); w.z = pk2(v1[0], v1[1]); w.w = pk2(v1[2], v1[3]);
            bf16_t* dst;
            if (pn < 2)       { const int c = col;        dst = O.QSB + ((size_t)(b * SBH + (c >> 6)) * SEQ + i) * 64 + (c & 63); }
            else if (pn < 4)  { const int c = col - 512;  dst = O.KSB + ((size_t)(b * SBH + (c >> 6)) * KIDX + 32 + i) * 64 + (c & 63); }
            else if (pn < 6)  { const int c = col - 1024; dst = O.VSB + ((size_t)(b * SBH + (c >> 6)) * KIDX + 32 + i) * 64 + (c & 63); }
            else if (pn == 6) { const int c = col - 1536; dst = O.GQ + ((size_t)(b * GH + (c >> 6)) * GU + 64 + i) * 64 + (c & 63); }
            else if (pn == 7) { const int c = col - 1792; dst = O.GK + ((size_t)(b * GH + (c >> 6)) * GU + 64 + i) * 64 + (c & 63); }
            else if (pn < 10) { const int c = col - 2048; dst = O.GV + ((size_t)(b * GH + (c >> 7)) * GU + 64 + i) * 128 + (c & 127); }
            else              { const int c = col - 2560; dst = O.GR + (size_t)row * 512 + c; }
            *(u32x4*)dst = w;
          } else if (col < NIN) {
            float* dst = O.GLR + ((size_t)b * GU + 64 + i) * 16 + (col - 3072);
            *(f32x4*)dst = (f32x4){v0[0], v0[1], v0[2], v0[3]};
            *(f32x4*)(dst + 4) = (f32x4){v1[0], v1[1], v1[2], v1[3]};
          }
        }
      }
  }
};
struct EpiOut {
  static constexpr bool PERM = false, AFTER_DRAIN = false;
  const float* x; float* H1;
  DI void operator()(const pg8::f32x4 (&acc)[2][2][4][2], const pg8::Unit& u, int wr, int wc, int fr, int fq) const {
#pragma unroll
    for (int ai = 0; ai < 2; ++ai)
#pragma unroll
      for (int m = 0; m < 4; ++m) {
        const size_t rowoff = (size_t)(u.pm * 256 + ai * 128 + wr * 64 + m * 16 + fr) * D;
#pragma unroll
        for (int bj = 0; bj < 2; ++bj)
#pragma unroll
          for (int n = 0; n < 2; ++n) {
            const size_t idx = rowoff + u.pn * 256 + bj * 128 + wc * 32 + 16 * n + 4 * fq;
            const f32x4 xv = *(const f32x4*)(x + idx);
            const pg8::f32x4 a = acc[ai][bj][m][n];
            *(f32x4*)(H1 + idx) = (f32x4){xv.x + a[0], xv.y + a[1], xv.z + a[2], xv.w + a[3]};
          }
      }
  }
};
struct EpiPQ {
  static constexpr bool PERM = true, AFTER_DRAIN = false;
  bf16_t* QP;
  DI void operator()(const pg8::f32x4 (&acc)[2][2][4][2], const pg8::Unit& u, int wr, int wc, int fr, int fq) const {
#pragma unroll
    for (int ai = 0; ai < 2; ++ai)
#pragma unroll
      for (int m = 0; m < 4; ++m) {
        const size_t rowoff = (size_t)(u.pm * 256 + ai * 128 + wr * 64 + m * 16 + fr) * D;
#pragma unroll
        for (int bj = 0; bj < 2; ++bj) {
          const pg8::f32x4 v0 = acc[ai][bj][m][0], v1 = acc[ai][bj][m][1];
          u32x4 w; w.x = pk2(v0[0], v0[1]); w.y = pk2(v0[2], v0[3]); w.z = pk2(v1[0], v1[1]); w.w = pk2(v1[2], v1[3]);
          *(u32x4*)(QP + rowoff + u.pn * 256 + bj * 128 + wc * 32 + 8 * fq) = w;
        }
      }
  }
};

DI void ph_meta(int blk, char* smem, const float* __restrict__ meta, const float* __restrict__ g1, const float* __restrict__ w_in, const InProjOut& O) {
  float (*xmT)[16] = (float (*)[16])smem;
  float (*red)[256] = (float (*)[256])(smem + 65536);
  const int tid = fresh_tid(), lane = tid & 63, wave = tid >> 6;
  for (int rr = 0; rr < 2; ++rr) {
    const int mm = wave * 2 + rr;
    float v[16]; float ss = 0.f;
#pragma unroll
    for (int j = 0; j < 16; ++j) { v[j] = meta[(size_t)mm * D + j * 64 + lane]; ss += v[j] * v[j]; }
    ss = wave_sum(ss);
    const float r = rsqrtf(ss * (1.0f / D) + EPS);
#pragma unroll
    for (int j = 0; j < 16; ++j) xmT[j * 64 + lane][mm] = v[j] * r * g1[j * 64 + lane];
  }
  __syncthreads();
  {
    const int c = tid & 15, ks = tid >> 4, n = blk * 16 + c;
    float acc[16];
#pragma unroll
    for (int j = 0; j < 16; ++j) acc[j] = 0.f;
#pragma unroll 8
    for (int kk = 0; kk < 32; ++kk) {
      const int k = ks * 32 + kk;
      const float w = w_in[(size_t)k * NIN + n];
      const f32x4 a = *(const f32x4*)&xmT[k][0], b4 = *(const f32x4*)&xmT[k][4], c4 = *(const f32x4*)&xmT[k][8], d4 = *(const f32x4*)&xmT[k][12];
      acc[0] += a.x * w; acc[1] += a.y * w; acc[2] += a.z * w; acc[3] += a.w * w;
      acc[4] += b4.x * w; acc[5] += b4.y * w; acc[6] += b4.z * w; acc[7] += b4.w * w;
      acc[8] += c4.x * w; acc[9] += c4.y * w; acc[10] += c4.z * w; acc[11] += c4.w * w;
      acc[12] += d4.x * w; acc[13] += d4.y * w; acc[14] += d4.z * w; acc[15] += d4.w * w;
    }
#pragma unroll
    for (int mm = 0; mm < 16; ++mm) red[ks][c * 16 + mm] = acc[mm];
  }
  __syncthreads();
  if (tid < 256) {
    const int c = tid >> 4, mm = tid & 15, n = blk * 16 + c;
    float val = 0.f;
#pragma unroll 8
    for (int ks = 0; ks < 32; ++ks) val += red[ks][tid];
    const bf16_t hv = (bf16_t)f2bf(val);
    for (int bb = 0; bb < NB; ++bb) {
      if (n < 512) {}
      else if (n < 1024) { const int cc = n - 512;  O.KSB[((size_t)(bb * SBH + (cc >> 6)) * KIDX + 16 + mm) * 64 + (cc & 63)] = hv; }
      else if (n < 1536) { const int cc = n - 1024; O.VSB[((size_t)(bb * SBH + (cc >> 6)) * KIDX + 16 + mm) * 64 + (cc & 63)] = hv; }
      else if (n < 1792) { const int cc = n - 1536; O.GQ[((size_t)(bb * GH + (cc >> 6)) * GU + 48 + mm) * 64 + (cc & 63)] = hv; }
      else if (n < 2048) { const int cc = n - 1792; O.GK[((size_t)(bb * GH + (cc >> 6)) * GU + 48 + mm) * 64 + (cc & 63)] = hv; }
      else if (n < 2560) { const int cc = n - 2048; O.GV[((size_t)(bb * GH + (cc >> 7)) * GU + 48 + mm) * 128 + (cc & 127)] = hv; }
      else if (n < 3072) {}
      else { O.GLR[((size_t)bb * GU + 48 + mm) * 16 + (n - 3072)] = val; }
    }
  }
  __syncthreads();
}

DI void ph_vtrans(int vb, char* smem, const bf16_t* __restrict__ VSB, bf16_t* __restrict__ VTSB) {
  const int tid256_ = fresh_tid() & 255;
  bf16_t (*t)[66] = (bf16_t (*)[66])smem;
  const int tid = TID;
  const int bh = vb / 257, it = vb % 257, idx0 = it * 32;
  {
    const int row = tid >> 3, c8 = tid & 7;
    const u32x4 v = *(const u32x4*)(VSB + ((size_t)bh * KIDX + idx0 + row) * 64 + c8 * 8);
    unsigned* tp = (unsigned*)&t[row][c8 * 8];
    tp[0] = v.x; tp[1] = v.y; tp[2] = v.z; tp[3] = v.w;
  }
  __syncthreads();
  {
    const int d = tid >> 2, i4 = tid & 3;
    unsigned w[4];
#pragma unroll
    for (int j = 0; j < 4; ++j) w[j] = (unsigned)t[i4 * 8 + 2 * j][d] | ((unsigned)t[i4 * 8 + 2 * j + 1][d] << 16);
    *(u32x4*)(VTSB + ((size_t)bh * 64 + d) * KIDX + idx0 + i4 * 8) = (u32x4){w[0], w[1], w[2], w[3]};
  }
  __syncthreads();
}

constexpr float SB_THR = -90.f;
DI void ph_sb_attn(int vb, const bf16_t* __restrict__ QSB, const bf16_t* __restrict__ KSB, const bf16_t* __restrict__ VTSB,
                                                 const float* __restrict__ sb_g, bf16_t* __restrict__ MIX) {
  const int tid256_ = fresh_tid() & 255;
  const int lane = TID & 63, wave = TID >> 6, r = lane & 31, h = lane >> 5;
  const int bh = vb >> 6, qb = vb & 63;
  const int b = bh >> 3, hd = bh & 7;
  const int i0 = qb * 128 + wave * 32;
  const bf16_t* Qb = QSB + ((size_t)bh * SEQ + i0) * 64;
  const bf16_t* Kb = KSB + (size_t)bh * KIDX * 64;
  const bf16_t* Vb = VTSB + (size_t)bh * 64 * KIDX;
  bf16x8 qf[4];
#pragma unroll
  for (int ks = 0; ks < 4; ++ks) qf[ks] = *(const bf16x8*)(Qb + r * 64 + ks * 16 + h * 8);
  f32x16 o[2];
#pragma unroll
  for (int e = 0; e < 16; ++e) { o[0][e] = 0.f; o[1][e] = 0.f; }
  float R = 0.f;
  const int qidx = 32 + i0 + r;
  for (int c = (i0 >> 5) + 1; c >= 0; --c) {
    const int k0 = 32 * c;
    bf16x8 kf[4];
#pragma unroll
    for (int ks = 0; ks < 4; ++ks) kf[ks] = *(const bf16x8*)(Kb + (size_t)(k0 + r) * 64 + ks * 16 + h * 8);
    bf16x8 vf[2][2];
#pragma unroll
    for (int mt = 0; mt < 2; ++mt)
#pragma unroll
      for (int s2 = 0; s2 < 2; ++s2) {
        const bf16_t* vp = Vb + (size_t)(mt * 32 + r) * KIDX + k0 + 16 * s2 + 4 * h;
        const u32x2 lo = *(const u32x2*)vp, hi = *(const u32x2*)(vp + 8);
        u32x4 t; t.x = lo.x; t.y = lo.y; t.z = hi.x; t.w = hi.y;
        vf[mt][s2] = __builtin_bit_cast(bf16x8, t);
      }
    f32x16 s;
#pragma unroll
    for (int e = 0; e < 16; ++e) s[e] = 0.f;
#pragma unroll
    for (int ks = 0; ks < 4; ++ks) s = MFMA32(kf[ks], qf[ks], s);
    float l1m[16], lb[16];
    bool valid[16];
#pragma unroll
    for (int e = 0; e < 16; ++e) {
      const int kidx = k0 + crow(e, h);
      valid[e] = (kidx < qidx) && (kidx >= 16);
      const float z = s[e] * 0.125f;
      const float sp = softplus(z);
      l1m[e] = valid[e] ? -sp : 0.f;
      lb[e] = z - sp;
    }
    float sfx[16], G[4], PG[4];
#pragma unroll
    for (int g = 0; g < 4; ++g) {
      sfx[4 * g + 3] = 0.f;
      sfx[4 * g + 2] = l1m[4 * g + 3];
      sfx[4 * g + 1] = sfx[4 * g + 2] + l1m[4 * g + 2];
      sfx[4 * g + 0] = sfx[4 * g + 1] + l1m[4 * g + 1];
      G[g] = sfx[4 * g + 0] + l1m[4 * g + 0];
      PG[g] = __shfl_xor(G[g], 32);
    }
    float HS[4];
    HS[3] = 0.f;
    HS[2] = G[3] + PG[3];
    HS[1] = HS[2] + G[2] + PG[2];
    HS[0] = HS[1] + G[1] + PG[1];
    const float total = HS[0] + G[0] + PG[0];
    float a[16];
#pragma unroll
    for (int e = 0; e < 16; ++e) {
      const int g = e >> 2;
      const float between = sfx[e] + (h == 0 ? PG[g] : 0.f) + HS[g] + R;
      a[e] = valid[e] ? __expf(lb[e] + between) : 0.f;
    }
    R += total;
#pragma unroll
    for (int s2 = 0; s2 < 2; ++s2) {
      u32x4 p;
      p.x = pk2(a[8 * s2 + 0], a[8 * s2 + 1]); p.y = pk2(a[8 * s2 + 2], a[8 * s2 + 3]);
      p.z = pk2(a[8 * s2 + 4], a[8 * s2 + 5]); p.w = pk2(a[8 * s2 + 6], a[8 * s2 + 7]);
      const bf16x8 pf = __builtin_bit_cast(bf16x8, p);
      o[0] = MFMA32(vf[0][s2], pf, o[0]);
      o[1] = MFMA32(vf[1][s2], pf, o[1]);
    }
    if (__all(R < SB_THR)) break;
  }
  float ss = 0.f;
#pragma unroll
  for (int e = 0; e < 16; ++e) ss += o[0][e] * o[0][e] + o[1][e] * o[1][e];
  ss += __shfl_xor(ss, 32);
  const float sc = rsqrtf(ss * (1.0f / 64.0f) + EPS);
  bf16_t* outp = MIX + (size_t)(b * SEQ + i0 + r) * D + hd * 64;
#pragma unroll
  for (int mt = 0; mt < 2; ++mt)
#pragma unroll
    for (int g = 0; g < 4; ++g) {
      const int d = mt * 32 + 8 * g + 4 * h;
      const f32x4 gg = *(const f32x4*)(sb_g + hd * 64 + d);
      u32x2 pk;
      pk.x = pk2(o[mt][4 * g] * sc * gg.x, o[mt][4 * g + 1] * sc * gg.y);
      pk.y = pk2(o[mt][4 * g + 2] * sc * gg.z, o[mt][4 * g + 3] * sc * gg.w);
      *(u32x2*)(outp + d) = pk;
    }
}

DI void ph_lg(int bu, const float* __restrict__ GLR, const float* __restrict__ wg, const float* __restrict__ bg, float* __restrict__ LG) {
  const int tid256_ = fresh_tid() & 255;
  const int c = TID;
  const int b = bu / GU, u = bu % GU;
  float val = 0.f;
  if (u >= 48) {
    float acc = bg[c];
    const float* g = GLR + (size_t)bu * 16;
#pragma unroll
    for (int k = 0; k < 16; ++k) acc += g[k] * wg[k * 256 + c];
    val = -softplus(-acc) * (1.0f / 16.0f);
  }
  const int hd = c >> 6, d = c & 63;
  LG[((size_t)(b * GH + hd) * GU + u) * 64 + d] = val;
}

DI void ph_gla_v1(int vb, char* smem, const bf16_t* __restrict__ GQ, const bf16_t* __restrict__ GK, const bf16_t* __restrict__ GV,
                                                const float* __restrict__ LG, float* __restrict__ GO) {
  const int tid256_ = fresh_tid() & 255;
  float (*qs)[68] = (float (*)[68])smem;
  float (*ks)[68] = (float (*)[68])(smem + 17408);
  float (*bc)[68] = (float (*)[68])(smem + 2 * 17408);
  float (*at)[68] = bc;
  float (*vs)[36] = (float (*)[36])(smem + 3 * 17408);
  float (*Ss)[36] = (float (*)[36])(smem + 3 * 17408 + 9216);
  float* decs = (float*)(smem + 3 * 17408 + 2 * 9216);
  const int tid = TID;
  const int bh = vb >> 2, es = vb & 3, b = bh >> 2, hd = bh & 3;
  const bf16_t* gq = GQ + (size_t)bh * GU * 64;
  const bf16_t* gk = GK + (size_t)bh * GU * 64;
  const bf16_t* gv = GV + (size_t)bh * GU * 128 + es * 32;
  const float* lg = LG + (size_t)bh * GU * 64;
  const int sd = tid >> 2, eg = tid & 3;
  float S[8];
#pragma unroll
  for (int j = 0; j < 8; ++j) S[j] = 0.f;
  for (int c = 0; c < 129; ++c) {
    const int u0 = c * 64;
#pragma unroll 2
    for (int idx = tid; idx < 4096; idx += 256) {
      const int t = idx >> 6, d = idx & 63;
      qs[t][d] = bf2f(gq[(size_t)(u0 + t) * 64 + d]);
      ks[t][d] = bf2f(gk[(size_t)(u0 + t) * 64 + d]);
      bc[t][d] = lg[(size_t)(u0 + t) * 64 + d];
    }
    for (int idx = tid; idx < 2048; idx += 256) {
      const int t = idx >> 5, e = idx & 31;
      vs[t][e] = bf2f(gv[(size_t)(u0 + t) * 128 + e]);
    }
#pragma unroll
    for (int j = 0; j < 8; ++j) Ss[sd][eg * 8 + j] = S[j];
    __syncthreads();
    if (tid < 64) { float run = 0.f;
#pragma unroll 4
      for (int t = 0; t < 64; ++t) { run += bc[t][tid]; bc[t][tid] = run; } }
    __syncthreads();
#pragma unroll 2
    for (int idx = tid; idx < 4096; idx += 256) {
      const int t = idx >> 6, d = idx & 63;
      const float bv = bc[t][d];
      qs[t][d] *= __expf(bv) * 0.125f;
      ks[t][d] *= __expf(-bv);
    }
    if (tid < 64) decs[tid] = __expf(bc[63][tid]);
    __syncthreads();
    {
      const int ti = tid >> 4, si = tid & 15;
      float acc[4][4];
#pragma unroll
      for (int a = 0; a < 4; ++a)
#pragma unroll
        for (int bb = 0; bb < 4; ++bb) acc[a][bb] = 0.f;
#pragma unroll 1
      for (int d = 0; d < 64; d += 4) {
        f32x4 q4[4], k4[4];
#pragma unroll
        for (int a = 0; a < 4; ++a) q4[a] = *(const f32x4*)&qs[ti + 16 * a][d];
#pragma unroll
        for (int bb = 0; bb < 4; ++bb) k4[bb] = *(const f32x4*)&ks[si + 16 * bb][d];
#pragma unroll
        for (int a = 0; a < 4; ++a)
#pragma unroll
          for (int bb = 0; bb < 4; ++bb)
            acc[a][bb] += q4[a].x * k4[bb].x + q4[a].y * k4[bb].y + q4[a].z * k4[bb].z + q4[a].w * k4[bb].w;
      }
#pragma unroll
      for (int a = 0; a < 4; ++a)
#pragma unroll
        for (int bb = 0; bb < 4; ++bb) {
          const int t = ti + 16 * a, s = si + 16 * bb;
          at[t][s] = (s <= t) ? acc[a][bb] : 0.f;
        }
    }
    __syncthreads();
    {
      const int t = sd;
      float o[8];
#pragma unroll
      for (int j = 0; j < 8; ++j) o[j] = 0.f;
#pragma unroll 2
      for (int d = 0; d < 64; ++d) {
        const float qv = qs[t][d];
        const f32x4 s0 = *(const f32x4*)&Ss[d][eg * 8], s1 = *(const f32x4*)&Ss[d][eg * 8 + 4];
        o[0] += qv * s0.x; o[1] += qv * s0.y; o[2] += qv * s0.z; o[3] += qv * s0.w;
        o[4] += qv * s1.x; o[5] += qv * s1.y; o[6] += qv * s1.z; o[7] += qv * s1.w;
      }
#pragma unroll 2
      for (int s = 0; s < 64; ++s) {
        const float av = at[t][s];
        const f32x4 v0 = *(const f32x4*)&vs[s][eg * 8], v1 = *(const f32x4*)&vs[s][eg * 8 + 4];
        o[0] += av * v0.x; o[1] += av * v0.y; o[2] += av * v0.z; o[3] += av * v0.w;
        o[4] += av * v1.x; o[5] += av * v1.y; o[6] += av * v1.z; o[7] += av * v1.w;
      }
      if (c >= 1) {
        float* op = GO + ((size_t)(b * SEQ + (c - 1) * 64 + t)) * 512 + hd * 128 + es * 32 + eg * 8;
        *(f32x4*)op = (f32x4){o[0], o[1], o[2], o[3]};
        *(f32x4*)(op + 4) = (f32x4){o[4], o[5], o[6], o[7]};
      }
    }
    {
      float n[8];
#pragma unroll
      for (int j = 0; j < 8; ++j) n[j] = S[j];
#pragma unroll 2
      for (int s = 0; s < 64; ++s) {
        const float kv = ks[s][sd];
        const f32x4 v0 = *(const f32x4*)&vs[s][eg * 8], v1 = *(const f32x4*)&vs[s][eg * 8 + 4];
        n[0] += kv * v0.x; n[1] += kv * v0.y; n[2] += kv * v0.z; n[3] += kv * v0.w;
        n[4] += kv * v1.x; n[5] += kv * v1.y; n[6] += kv * v1.z; n[7] += kv * v1.w;
      }
      const float dec = decs[sd];
#pragma unroll
      for (int j = 0; j < 8; ++j) S[j] = dec * n[j];
    }
    __syncthreads();
  }
}

DI void ph_gla_norm(int m, const float* __restrict__ GO, const bf16_t* __restrict__ GR, const float* __restrict__ gla_g, bf16_t* __restrict__ MIX) {
  const int tid256_ = fresh_tid() & 255;
  const int hd = TID >> 6, lane = TID & 63;
  const f32x2 v = *(const f32x2*)(GO + (size_t)m * 512 + hd * 128 + lane * 2);
  float ss = wave_sum(v.x * v.x + v.y * v.y);
  const float sc = rsqrtf(ss * (1.0f / 128.0f) + EPS);
  const unsigned g2 = *(const unsigned*)(GR + (size_t)m * 512 + hd * 128 + lane * 2);
  const float g0 = bflo(g2), g1 = bfhi(g2);
  const f32x2 gn = *(const f32x2*)(gla_g + hd * 128 + lane * 2);
  const float s0 = g0 / (1.f + __expf(-g0)), s1 = g1 / (1.f + __expf(-g1));
  *(unsigned*)(MIX + (size_t)m * D + 512 + hd * 128 + lane * 2) = pk2(v.x * sc * gn.x * s0, v.y * sc * gn.y * s1);
}

DI bool better(float v1, int i1, float v2, int i2) { return (v1 > v2) || (v1 == v2 && i1 < i2); }
DI void wave_argmax(float& v, int& i) {
#pragma unroll
  for (int o = 32; o >= 1; o >>= 1) {
    const float ov = __shfl_xor(v, o);
    const int oi = __shfl_xor(i, o);
    if (better(ov, oi, v, i)) { v = ov; i = oi; }
  }
}
constexpr int RT_TOK_PER_BLOCK = 256;
DI void ph_route_v1(int vb, char* smem, const bf16_t* __restrict__ QP, const float* __restrict__ sk1, const float* __restrict__ sk2,
                                                  int* __restrict__ EIDX, float* __restrict__ GATE) {
  const int tid256_ = fresh_tid() & 255;
  float (*K1)[68] = (float (*)[68])smem;
  float (*K2)[68] = (float (*)[68])(smem + 34816);
  float (*qsh)[128] = (float (*)[128])(smem + 2 * 34816);
  const int hd = vb & 7, tg = vb >> 3;
  const int tid = TID, lane = tid & 63, wave = tid >> 6;
  for (int idx = tid; idx < 128 * 64; idx += 256) {
    const int k = idx >> 6, d = idx & 63;
    K1[k][d] = sk1[((size_t)hd * 128 + k) * 64 + d];
    K2[k][d] = sk2[((size_t)hd * 128 + k) * 64 + d];
  }
  __syncthreads();
  const float NEG = -3.0e38f;
  for (int it = 0; it < RT_TOK_PER_BLOCK / 4; ++it) {
    const int m = tg * RT_TOK_PER_BLOCK + it * 4 + wave;
    {
      const unsigned q2 = *(const unsigned*)(QP + (size_t)m * D + hd * 128 + lane * 2);
      qsh[wave][lane * 2] = bflo(q2); qsh[wave][lane * 2 + 1] = bfhi(q2);
    }
    __builtin_amdgcn_wave_barrier();
    float s1a = 0.f, s1b = 0.f, s2a = 0.f, s2b = 0.f;
#pragma unroll 4
    for (int d = 0; d < 64; d += 4) {
      const f32x4 q1 = *(const f32x4*)&qsh[wave][d], q2 = *(const f32x4*)&qsh[wave][64 + d];
      const f32x4 a = *(const f32x4*)&K1[lane][d], bb = *(const f32x4*)&K1[lane + 64][d];
      const f32x4 c = *(const f32x4*)&K2[lane][d], dd = *(const f32x4*)&K2[lane + 64][d];
      s1a += q1.x * a.x + q1.y * a.y + q1.z * a.z + q1.w * a.w;
      s1b += q1.x * bb.x + q1.y * bb.y + q1.z * bb.z + q1.w * bb.w;
      s2a += q2.x * c.x + q2.y * c.y + q2.z * c.z + q2.w * c.w;
      s2b += q2.x * dd.x + q2.y * dd.y + q2.z * dd.z + q2.w * dd.w;
    }
    __builtin_amdgcn_wave_barrier();
    float tv1 = 0.f, tv2 = 0.f; int ti1 = 0, ti2 = 0;
    for (int rr = 0; rr < 16; ++rr) {
      float v; int i;
      if (better(s1a, lane, s1b, lane + 64)) { v = s1a; i = lane; } else { v = s1b; i = lane + 64; }
      wave_argmax(v, i);
      if (lane == rr) { tv1 = v; ti1 = i; }
      if (i == lane) s1a = NEG;
      if (i == lane + 64) s1b = NEG;
      if (better(s2a, lane, s2b, lane + 64)) { v = s2a; i = lane; } else { v = s2b; i = lane + 64; }
      wave_argmax(v, i);
      if (lane == rr) { tv2 = v; ti2 = i; }
      if (i == lane) s2a = NEG;
      if (i == lane + 64) s2b = NEG;
    }
    const int ca = lane >> 2;
    const float va = __shfl(tv1, ca); const int ia = __shfl(ti1, ca);
    float cv[4]; int ce[4];
#pragma unroll
    for (int j = 0; j < 4; ++j) {
      const int cb = (lane & 3) * 4 + j;
      cv[j] = va + __shfl(tv2, cb);
      ce[j] = ia * 128 + __shfl(ti2, cb);
    }
    float fsc = 0.f; int fe = 0;
    for (int rr = 0; rr < 16; ++rr) {
      float v = cv[0]; int p = lane * 4;
#pragma unroll
      for (int j = 1; j < 4; ++j) if (better(cv[j], lane * 4 + j, v, p)) { v = cv[j]; p = lane * 4 + j; }
      wave_argmax(v, p);
      const int src = p >> 2, jj = p & 3;
      int e = (jj == 0) ? ce[0] : (jj == 1) ? ce[1] : (jj == 2) ? ce[2] : ce[3];
      e = __shfl(e, src);
      if (lane == rr) { fsc = v; fe = e; }
      if (lane == src) {
        if (jj == 0) cv[0] = NEG; else if (jj == 1) cv[1] = NEG; else if (jj == 2) cv[2] = NEG; else cv[3] = NEG;
      }
    }
    const float mx = __shfl(fsc, 0);
    float ex = (lane < 16) ? __expf(fsc - mx) : 0.f;
    const float sum = wave_sum(ex);
    if (lane < 16) {
      EIDX[(size_t)m * 128 + hd * 16 + lane] = fe;
      GATE[(size_t)m * 128 + hd * 16 + lane] = ex / sum;
    }
  }
  __syncthreads();
}


#define MFMA16(a, b, c) __builtin_amdgcn_mfma_f32_16x16x32_bf16((a), (b), (c), 0, 0, 0)
constexpr int GLDS = 72;
struct GlaLds {
  bf16_t Qt[64 * GLDS];
  bf16_t Kt[64 * GLDS];
  bf16_t KT[64 * GLDS];
  bf16_t P[64 * GLDS];
  float dec[64];
  float tot[8][64];
  float ssq[8][64];
};
constexpr size_t WS_SLOC = 926 * MiB;
constexpr size_t WS_DTOT = 942 * MiB;
constexpr size_t WS_GVT = 604 * MiB;

struct GlaPtrs { const bf16_t *GQ, *GK, *GVT, *GR; const float *GLR, *wg, *bg, *gla_g; float *SLOC, *DTOT; bf16_t* MIX; };

template <int PASS>
DI void gla_item(int bh, int sc, char* smem, const GlaPtrs& G) {
  GlaLds& L = *(GlaLds*)smem;
  const int tid = fresh_tid(), lane = tid & 63, w = __builtin_amdgcn_readfirstlane(tid >> 6), c16 = lane & 15, q = lane >> 4;
  const int b = bh >> 2, hd = bh & 3;
  const int cbeg = sc == 0 ? 0 : 8 * sc + 1, cend = 8 * sc + 9;
  float wgr[16];
#pragma unroll
  for (int k = 0; k < 16; ++k) wgr[k] = G.wg[k * 256 + hd * 64 + lane];
  const float bgv = G.bg[hd * 64 + lane];
  f32x4 X[4];
#pragma unroll
  for (int i = 0; i < 4; ++i) X[i] = (f32x4){0.f, 0.f, 0.f, 0.f};
  if (PASS == 1) {
    for (int j = 0; j < sc; ++j) {
      const float* dt = G.DTOT + (size_t)(bh * 16 + j) * 64;
      const float* sl = G.SLOC + ((size_t)(bh * 16 + j) * 8 + w) * 16 * 64 + lane;
#pragma unroll
      for (int i = 0; i < 4; ++i) {
        const f32x4 d4 = *(const f32x4*)(dt + 16 * i + 4 * q);
        X[i][0] = d4.x * X[i][0] + sl[(4 * i + 0) * 64]; X[i][1] = d4.y * X[i][1] + sl[(4 * i + 1) * 64];
        X[i][2] = d4.z * X[i][2] + sl[(4 * i + 2) * 64]; X[i][3] = d4.w * X[i][3] + sl[(4 * i + 3) * 64];
      }
    }
  }
  f32x4 gain = {1.f, 1.f, 1.f, 1.f};
  if (PASS == 1) gain = *(const f32x4*)(G.gla_g + hd * 128 + 16 * w + 4 * q);
  float blsum = 0.f;
  const bf16_t* gq = G.GQ + (size_t)bh * GU * 64 + lane;
  const bf16_t* gk = G.GK + (size_t)bh * GU * 64 + lane;
  const bf16_t* gvt = G.GVT + ((size_t)bh * 128 + 16 * w + c16) * GU + 8 * q;
  for (int c = cbeg; c < cend; ++c) {
    const int u0 = 64 * c;
    float cs[8];
    {
      float run = 0.f;
#pragma unroll
      for (int i = 0; i < 8; ++i) {
        const int u = u0 + 8 * w + i;
        float lgv = 0.f;
        if (u >= 48) {
          const f32x4* gp = (const f32x4*)(G.GLR + ((size_t)b * GU + u) * 16);
          const f32x4 g0 = gp[0], g1 = gp[1], g2 = gp[2], g3 = gp[3];
          float a = bgv;
          a += g0.x * wgr[0] + g0.y * wgr[1] + g0.z * wgr[2] + g0.w * wgr[3];
          a += g1.x * wgr[4] + g1.y * wgr[5] + g1.z * wgr[6] + g1.w * wgr[7];
          a += g2.x * wgr[8] + g2.y * wgr[9] + g2.z * wgr[10] + g2.w * wgr[11];
          a += g3.x * wgr[12] + g3.y * wgr[13] + g3.z * wgr[14] + g3.w * wgr[15];
          lgv = -softplus(-a) * (1.0f / 16.0f);
        }
        run += lgv; cs[i] = run;
      }
      L.tot[w][lane] = run;
    }
    bf16x8 vfr[2];
    vfr[0] = *(const bf16x8*)(gvt + u0);
    vfr[1] = *(const bf16x8*)(gvt + u0 + 32);
    unsigned short kraw[8], qraw[8];
#pragma unroll
    for (int i = 0; i < 8; ++i) {
      kraw[i] = gk[(size_t)(u0 + 8 * w + i) * 64];
      if (PASS == 1) qraw[i] = gq[(size_t)(u0 + 8 * w + i) * 64];
    }
    __syncthreads();
    {
      float offset = 0.f, total = 0.f;
#pragma unroll
      for (int s2 = 0; s2 < 8; ++s2) { const float tv = L.tot[s2][lane]; total += tv; if (s2 < w) offset += tv; }
      blsum += total;
      if (w == 0) L.dec[lane] = __expf(total);
      float kt[8];
#pragma unroll
      for (int i = 0; i < 8; ++i) {
        const float bc = offset + cs[i];
        kt[i] = bf2f(kraw[i]) * __expf(-bc);
        if (PASS == 1) {
          L.Qt[(8 * w + i) * GLDS + lane] = (bf16_t)f2bf(bf2f(qraw[i]) * __expf(bc) * 0.125f);
          L.Kt[(8 * w + i) * GLDS + lane] = (bf16_t)f2bf(kt[i]);
        }
      }
      u32x4 kp; kp.x = pk2(kt[0], kt[1]); kp.y = pk2(kt[2], kt[3]); kp.z = pk2(kt[4], kt[5]); kp.w = pk2(kt[6], kt[7]);
      *(u32x4*)&L.KT[lane * GLDS + 8 * w] = kp;
    }
    __syncthreads();
    f32x4 OT[4];
    if (PASS == 1) {
      const int is = w >> 1;
#pragma unroll
      for (int z = 0; z < 2; ++z) {
        const int it = 2 * (w & 1) + z;
        f32x4 pa = {0.f, 0.f, 0.f, 0.f};
        if (is <= it) {
#pragma unroll
          for (int kk = 0; kk < 2; ++kk) {
            const bf16x8 ka = *(const bf16x8*)&L.Kt[(16 * is + c16) * GLDS + 32 * kk + 8 * q];
            const bf16x8 qb = *(const bf16x8*)&L.Qt[(16 * it + c16) * GLDS + 32 * kk + 8 * q];
            pa = MFMA16(ka, qb, pa);
          }
          if (is == it) {
#pragma unroll
            for (int r = 0; r < 4; ++r) if (4 * q + r > c16) pa[r] = 0.f;
          }
        }
        u32x2 pw; pw.x = pk2(pa[0], pa[1]); pw.y = pk2(pa[2], pa[3]);
        *(u32x2*)&L.P[(16 * it + c16) * GLDS + 16 * is + 4 * q] = pw;
      }
#pragma unroll
      for (int n = 0; n < 4; ++n) OT[n] = (f32x4){0.f, 0.f, 0.f, 0.f};
#pragma unroll
      for (int kk = 0; kk < 2; ++kk) {
        u32x4 xp; xp.x = pk2(X[2 * kk][0], X[2 * kk][1]); xp.y = pk2(X[2 * kk][2], X[2 * kk][3]);
        xp.z = pk2(X[2 * kk + 1][0], X[2 * kk + 1][1]); xp.w = pk2(X[2 * kk + 1][2], X[2 * kk + 1][3]);
        const bf16x8 xa = __builtin_bit_cast(bf16x8, xp);
#pragma unroll
        for (int n = 0; n < 4; ++n) {
          const u32x2 lo = *(const u32x2*)&L.Qt[(16 * n + c16) * GLDS + 32 * kk + 4 * q];
          const u32x2 hi = *(const u32x2*)&L.Qt[(16 * n + c16) * GLDS + 32 * kk + 16 + 4 * q];
          u32x4 qq; qq.x = lo.x; qq.y = lo.y; qq.z = hi.x; qq.w = hi.y;
          OT[n] = MFMA16(xa, __builtin_bit_cast(bf16x8, qq), OT[n]);
        }
      }
      __syncthreads();
#pragma unroll
      for (int kk = 0; kk < 2; ++kk)
#pragma unroll
        for (int n = 0; n < 4; ++n) {
          const bf16x8 pb = *(const bf16x8*)&L.P[(16 * n + c16) * GLDS + 32 * kk + 8 * q];
          OT[n] = MFMA16(vfr[kk], pb, OT[n]);
        }
    }
#pragma unroll
    for (int i = 0; i < 4; ++i) {
#pragma unroll
      for (int kk = 0; kk < 2; ++kk) {
        const bf16x8 ka = *(const bf16x8*)&L.KT[(16 * i + c16) * GLDS + 32 * kk + 8 * q];
        X[i] = MFMA16(ka, vfr[kk], X[i]);
      }
      const f32x4 d4 = *(const f32x4*)&L.dec[16 * i + 4 * q];
      X[i][0] *= d4.x; X[i][1] *= d4.y; X[i][2] *= d4.z; X[i][3] *= d4.w;
    }
    if (PASS == 1) {
      if (c >= 1) {
        float ss[4];
#pragma unroll
        for (int n = 0; n < 4; ++n) {
          float v = OT[n][0] * OT[n][0] + OT[n][1] * OT[n][1] + OT[n][2] * OT[n][2] + OT[n][3] * OT[n][3];
          v += __shfl_xor(v, 16); v += __shfl_xor(v, 32);
          ss[n] = v;
        }
        if (q == 0) {
#pragma unroll
          for (int n = 0; n < 4; ++n) L.ssq[w][16 * n + c16] = ss[n];
        }
        __syncthreads();
#pragma unroll
        for (int n = 0; n < 4; ++n) {
          float tot = 0.f;
#pragma unroll
          for (int w2 = 0; w2 < 8; ++w2) tot += L.ssq[w2][16 * n + c16];
          const float scl = rsqrtf(tot * (1.0f / 128.0f) + EPS);
          const size_t m = (size_t)b * SEQ + 64 * (c - 1) + 16 * n + c16;
          const u32x2 g2 = *(const u32x2*)(G.GR + m * 512 + hd * 128 + 16 * w + 4 * q);
          const float r0 = bflo(g2.x), r1 = bfhi(g2.x), r2 = bflo(g2.y), r3 = bfhi(g2.y);
          const float o0 = OT[n][0] * scl * gain.x * (r0 / (1.f + __expf(-r0)));
          const float o1 = OT[n][1] * scl * gain.y * (r1 / (1.f + __expf(-r1)));
          const float o2 = OT[n][2] * scl * gain.z * (r2 / (1.f + __expf(-r2)));
          const float o3 = OT[n][3] * scl * gain.w * (r3 / (1.f + __expf(-r3)));
          u32x2 ow; ow.x = pk2(o0, o1); ow.y = pk2(o2, o3);
          *(u32x2*)(G.MIX + m * D + 512 + hd * 128 + 16 * w + 4 * q) = ow;
        }
      }
    }
    __syncthreads();
  }
  if (PASS == 0) {
    float* sl = G.SLOC + ((size_t)(bh * 16 + sc) * 8 + w) * 16 * 64 + lane;
#pragma unroll
    for (int i = 0; i < 4; ++i)
#pragma unroll
      for (int r = 0; r < 4; ++r) sl[(4 * i + r) * 64] = X[i][r];
    if (w == 0) G.DTOT[(size_t)(bh * 16 + sc) * 64 + lane] = __expf(blsum);
  }
}

DI void ph_gvtrans(int vb, char* smem, const bf16_t* __restrict__ GV, bf16_t* __restrict__ GVT) {
  const int tid256_ = fresh_tid() & 255;
  bf16_t (*t)[66] = (bf16_t (*)[66])smem;
  const int tid = TID;
  const int eh = vb & 1, rest = vb >> 1, bh = rest / 258, ut = rest % 258, u0 = ut * 32;
  {
    const int row = tid >> 3, c8 = tid & 7;
    const u32x4 v = *(const u32x4*)(GV + ((size_t)bh * GU + u0 + row) * 128 + eh * 64 + c8 * 8);
    unsigned* tp = (unsigned*)&t[row][c8 * 8];
    tp[0] = v.x; tp[1] = v.y; tp[2] = v.z; tp[3] = v.w;
  }
  __syncthreads();
  {
    const int d = tid >> 2, i4 = tid & 3;
    unsigned wv[4];
#pragma unroll
    for (int j = 0; j < 4; ++j) wv[j] = (unsigned)t[i4 * 8 + 2 * j][d] | ((unsigned)t[i4 * 8 + 2 * j + 1][d] << 16);
    *(u32x4*)(GVT + ((size_t)bh * 128 + eh * 64 + d) * GU + u0 + i4 * 8) = (u32x4){wv[0], wv[1], wv[2], wv[3]};
  }
  __syncthreads();
}

DI void ce_desc(float& a, float& b) {
  float hi, lo;
  asm("v_max_f32 %0, %1, %2" : "=v"(hi) : "v"(a), "v"(b));
  asm("v_min_f32 %0, %1, %2" : "=v"(lo) : "v"(a), "v"(b));
  a = hi; b = lo;
}
DI float vmaxf(float a, float b) { float hi; asm("v_max_f32 %0, %1, %2" : "=v"(hi) : "v"(a), "v"(b)); return hi; }
template <int N> DI void bitonic_sort_desc(float (&v)[N]) {
#pragma unroll
  for (int k = 2; k <= N; k <<= 1) {
#pragma unroll
    for (int j = k >> 1; j > 0; j >>= 1) {
#pragma unroll
      for (int i = 0; i < N; ++i) {
        const int l = i ^ j;
        if (l > i) { if ((i & k) == 0) ce_desc(v[i], v[l]); else ce_desc(v[l], v[i]); }
      }
    }
  }
}
DI void bitonic_merge16_desc(float (&v)[16]) {
#pragma unroll
  for (int j = 8; j > 0; j >>= 1) {
#pragma unroll
    for (int i = 0; i < 16; ++i) { const int l = i ^ j; if (l > i) ce_desc(v[i], v[l]); }
  }
}
template <int NBV> DI void merge_prune16(float (&a)[16], const float (&b)[16]) {
#pragma unroll
  for (int i = 16 - NBV; i < 16; ++i) a[i] = vmaxf(a[i], b[15 - i]);
  bitonic_merge16_desc(a);
}
DI float selh(int hh, float a, float b) { asm volatile("" : "+v"(a), "+v"(b)); return hh == 0 ? a : b; }
DI float pack_idx(float v, unsigned idx, unsigned mask) { return __uint_as_float((__float_as_uint(v) & ~mask) | idx); }

DI void ph_route_v2(int vb, char* smem, const bf16_t* __restrict__ QP, const bf16_t* __restrict__ SK1b, const bf16_t* __restrict__ SK2b,
                    unsigned short* __restrict__ EIDX, float* __restrict__ GATE) {
  const int tid256_ = fresh_tid() & 255;
  const int lane = TID & 63, wave = TID >> 6, r = lane & 31, hh = lane >> 5;
  const int hd = vb & 7, tile = vb >> 3;
  const int m = tile * 128 + wave * 32 + r;
  float loc[2][16];
#pragma unroll
  for (int L = 0; L < 2; ++L) {
    const bf16_t* qp = QP + (size_t)m * D + hd * 128 + L * 64 + hh * 8;
    const bf16_t* kb = (L == 0 ? SK1b : SK2b) + (size_t)(hd * 128 + r) * 64 + hh * 8;
    bf16x8 qf[4];
#pragma unroll
    for (int ks = 0; ks < 4; ++ks) qf[ks] = *(const bf16x8*)(qp + ks * 16);
    float grp[4][16];
#pragma unroll
    for (int mt = 0; mt < 4; ++mt) {
      f32x16 acc;
#pragma unroll
      for (int e = 0; e < 16; ++e) acc[e] = 0.f;
#pragma unroll
      for (int ks = 0; ks < 4; ++ks) {
        const bf16x8 kf = *(const bf16x8*)(kb + (size_t)mt * 32 * 64 + ks * 16);
        acc = MFMA32(kf, qf[ks], acc);
      }
#pragma unroll
      for (int e = 0; e < 16; ++e) grp[mt][e] = pack_idx(acc[e], (unsigned)(mt * 32 + crow(e, hh)), 127u);
      bitonic_sort_desc<16>(grp[mt]);
    }
    merge_prune16<16>(grp[0], grp[1]);
    merge_prune16<16>(grp[2], grp[3]);
    merge_prune16<16>(grp[0], grp[2]);
#pragma unroll
    for (int i = 0; i < 16; ++i) loc[L][i] = grp[0][i];
  }
  float fin[16], oth[16];
#pragma unroll
  for (int i = 0; i < 16; ++i) {
    const float send = selh(hh, loc[1][i], loc[0][i]);
    oth[i] = __shfl_xor(send, 32);
    fin[i] = selh(hh, loc[0][i], loc[1][i]);
  }
  merge_prune16<16>(fin, oth);
  float v1[16], v2[16];
#pragma unroll
  for (int i = 0; i < 16; ++i) {
    const float o = __shfl_xor(fin[i], 32);
    v1[i] = selh(hh, fin[i], o);
    v2[i] = selh(hh, o, fin[i]);
  }
  unsigned* ib = (unsigned*)smem + (size_t)TID * 8;
#pragma unroll
  for (int q = 0; q < 4; ++q) {
    unsigned w1 = 0, w2 = 0;
#pragma unroll
    for (int j = 0; j < 4; ++j) {
      w1 |= (__float_as_uint(v1[4 * q + j]) & 127u) << (8 * j);
      w2 |= (__float_as_uint(v2[4 * q + j]) & 127u) << (8 * j);
    }
    ib[q] = w1; ib[4 + q] = w2;
  }
  float R[16], Bv[16];
#pragma unroll
  for (int j = 0; j < 16; ++j) R[j] = pack_idx(v1[0] + v2[j], (unsigned)j, 255u);
#define ROUTE_ROW(I, CNT) { _Pragma("unroll") for (int j = 0; j < 16; ++j) Bv[j] = (j < CNT) ? pack_idx(v1[I] + v2[j < CNT ? j : 0], (unsigned)(I * 16 + j), 255u) : 0.f; \
    merge_prune16<CNT>(R, Bv); }
  ROUTE_ROW(1, 8) ROUTE_ROW(2, 5) ROUTE_ROW(3, 4) ROUTE_ROW(4, 3) ROUTE_ROW(5, 2) ROUTE_ROW(6, 2) ROUTE_ROW(7, 2)
#undef ROUTE_ROW
#pragma unroll
  for (int j = 0; j < 16; ++j) Bv[j] = (j < 8) ? pack_idx(v1[8 + (j < 8 ? j : 0)] + v2[0], (unsigned)((8 + j) * 16), 255u) : 0.f;
  merge_prune16<8>(R, Bv);
  float ex[16], sum = 0.f;
#pragma unroll
  for (int i = 0; i < 16; ++i) { ex[i] = __expf(R[i] - R[0]); sum += ex[i]; }
  const float inv = 1.f / sum;
  const unsigned char* ibb = (const unsigned char*)ib;
  int eo[8]; float go[8];
#pragma unroll
  for (int w = 0; w < 8; ++w) {
    const float rv = selh(hh, R[w], R[8 + w]);
    const float ev = selh(hh, ex[w], ex[8 + w]);
    const unsigned pos = __float_as_uint(rv) & 255u;
    const unsigned i1 = ibb[pos >> 4], i2 = ibb[16 + (pos & 15u)];
    eo[w] = (int)(i1 * 128u + i2);
    go[w] = ev * inv;
  }
  unsigned short* ep = EIDX + (size_t)m * 128 + hd * 16 + hh * 8;
  float* gp = GATE + (size_t)m * 128 + hd * 16 + hh * 8;
  *(u32x4*)ep = (u32x4){(unsigned)eo[0] | ((unsigned)eo[1] << 16), (unsigned)eo[2] | ((unsigned)eo[3] << 16), (unsigned)eo[4] | ((unsigned)eo[5] << 16), (unsigned)eo[6] | ((unsigned)eo[7] << 16)};
  *(f32x4*)gp = (f32x4){go[0], go[1], go[2], go[3]};
  *(f32x4*)(gp + 4) = (f32x4){go[4], go[5], go[6], go[7]};
}

DI void ph_peer_v1(int vb, char* smem, const bf16_t* __restrict__ A2, const bf16_t* __restrict__ EU, const bf16_t* __restrict__ EV,
                                                 const int* __restrict__ EIDX, const float* __restrict__ GATE, const float* __restrict__ H1,
                                                 const float* __restrict__ gf, float* __restrict__ out) {
  const int tid256_ = fresh_tid() & 255;
  float (*cs)[128] = (float (*)[128])smem;
  int (*es)[128] = (int (*)[128])(smem + 2048);
  const int lane = TID & 63, wave = TID >> 6;
  const int m = vb * 4 + wave;
  const int g = lane >> 3, sub = lane & 7;
  u32x4 xf[16];
#pragma unroll
  for (int j = 0; j < 16; ++j) xf[j] = *(const u32x4*)(A2 + (size_t)m * D + (j * 8 + sub) * 8);
  for (int bt = 0; bt < 16; ++bt) {
    const int k = bt * 8 + g;
    const int e = EIDX[(size_t)m * 128 + k];
    const bf16_t* up = EU + (size_t)e * D + sub * 8;
    float acc = 0.f;
#pragma unroll
    for (int j = 0; j < 16; ++j) {
      const u32x4 u = *(const u32x4*)(up + j * 64);
      acc = dot2bf(u.x, xf[j].x, acc); acc = dot2bf(u.y, xf[j].y, acc); acc = dot2bf(u.z, xf[j].z, acc); acc = dot2bf(u.w, xf[j].w, acc);
    }
    acc += __shfl_xor(acc, 1); acc += __shfl_xor(acc, 2); acc += __shfl_xor(acc, 4);
    if (sub == 0) {
      const float act = 0.5f * acc * (1.f + erff(acc * 0.70710678118654752f));
      cs[wave][k] = GATE[(size_t)m * 128 + k] * act;
      es[wave][k] = e;
    }
  }
  __builtin_amdgcn_wave_barrier();
  __syncthreads();
  float y[16];
#pragma unroll
  for (int j = 0; j < 16; ++j) y[j] = 0.f;
#pragma unroll 4
  for (int k = 0; k < 128; ++k) {
    const float c = cs[wave][k];
    const bf16_t* vp = EV + (size_t)es[wave][k] * D + lane * 8;
    const u32x4 v0 = *(const u32x4*)vp, v1 = *(const u32x4*)(vp + 512);
    y[0] += c * bflo(v0.x); y[1] += c * bfhi(v0.x); y[2] += c * bflo(v0.y); y[3] += c * bfhi(v0.y);
    y[4] += c * bflo(v0.z); y[5] += c * bfhi(v0.z); y[6] += c * bflo(v0.w); y[7] += c * bfhi(v0.w);
    y[8] += c * bflo(v1.x); y[9] += c * bfhi(v1.x); y[10] += c * bflo(v1.y); y[11] += c * bfhi(v1.y);
    y[12] += c * bflo(v1.z); y[13] += c * bfhi(v1.z); y[14] += c * bflo(v1.w); y[15] += c * bfhi(v1.w);
  }
  const float* hp = H1 + (size_t)m * D + lane * 8;
  float ss = 0.f;
#pragma unroll
  for (int q = 0; q < 4; ++q) {
    const f32x4 hv = *(const f32x4*)(hp + (q >> 1) * 512 + (q & 1) * 4);
    y[q * 4 + 0] += hv.x; y[q * 4 + 1] += hv.y; y[q * 4 + 2] += hv.z; y[q * 4 + 3] += hv.w;
  }
#pragma unroll
  for (int j = 0; j < 16; ++j) ss += y[j] * y[j];
  ss = wave_sum(ss);
  const float sc = rsqrtf(ss * (1.0f / D) + EPS);
  float* op = out + (size_t)m * D + lane * 8;
#pragma unroll
  for (int q = 0; q < 4; ++q) {
    const int off = (q >> 1) * 512 + (q & 1) * 4;
    const f32x4 gg = *(const f32x4*)(gf + lane * 8 + off);
    *(f32x4*)(op + off) = (f32x4){y[q * 4 + 0] * sc * gg.x, y[q * 4 + 1] * sc * gg.y, y[q * 4 + 2] * sc * gg.z, y[q * 4 + 3] * sc * gg.w};
  }
}


DI void ph_convert_eu(const float* __restrict__ src, bf16_t* __restrict__ EUs) {
  size_t i = (size_t)blockIdx.x * blockDim.x + threadIdx.x;
  const size_t stride = (size_t)gridDim.x * blockDim.x;
  for (; i < (size_t)NEXP * 128; i += stride) {
    const int e = (int)(i >> 7), pz = (int)(i & 127);
    const f32x4 a = ((const f32x4*)src)[2 * i], b = ((const f32x4*)src)[2 * i + 1];
    u32x4 o; o.x = pk2(a.x, a.y); o.y = pk2(a.z, a.w); o.z = pk2(b.x, b.y); o.w = pk2(b.z, b.w);
    *(u32x4*)(EUs + ((size_t)(pz >> 3) * NEXP + e) * 64 + (pz & 7) * 8) = o;
  }
}
DI void ph_convert_ev(int vb, char* smem, const float* __restrict__ src, bf16_t* __restrict__ EVc) {
  const int tid256_ = fresh_tid() & 255;
  bf16_t (*t)[1028] = (bf16_t (*)[1028])smem;
  const int e0 = vb * 32;
  for (int r = 0; r < 32; ++r) {
    const f32x4 a = *(const f32x4*)(src + (size_t)(e0 + r) * D + TID * 4);
    u32x2 o; o.x = pk2(a.x, a.y); o.y = pk2(a.z, a.w);
    *(u32x2*)&t[r][TID * 4] = o;
  }
  __syncthreads();
  const int r = TID & 31, cs = TID >> 5;
  for (int c0 = 0; c0 < 256; c0 += 8) {
    const int cg = c0 + cs;
    const u32x2 v = *(const u32x2*)&t[r][cg * 4];
    *(u32x2*)(EVc + ((size_t)cg * NEXP + e0 + r) * 4) = v;
  }
  __syncthreads();
}

DI float dpp_f(float v, const int ctrl_sel) {
  int r;
  if (ctrl_sel == 0) r = __builtin_amdgcn_update_dpp(0, __builtin_bit_cast(int, v), 0xB1, 0xF, 0xF, true);
  else if (ctrl_sel == 1) r = __builtin_amdgcn_update_dpp(0, __builtin_bit_cast(int, v), 0x4E, 0xF, 0xF, true);
  else r = __builtin_amdgcn_update_dpp(0, __builtin_bit_cast(int, v), 0x141, 0xF, 0xF, true);
  return __builtin_bit_cast(float, r);
}
DI float dpp_sum8(float v) {
  v += dpp_f(v, 0); v += dpp_f(v, 1); v += dpp_f(v, 2);
  return v;
}
DI void ph_peer_u(int xi, int nx, int wv, int nwv, const bf16_t* __restrict__ A2, const bf16_t* __restrict__ EUs,
                  const unsigned short* __restrict__ EIDX, bf16_t* __restrict__ PP) {
  const int lane = fresh_tid() & 63, g = lane >> 3, sub = lane & 7;
  for (int s = xi; s < 16; s += nx) {
    const bf16_t* tab = EUs + (size_t)s * NEXP * 64 + sub * 8;
    bf16_t* pp = PP + (size_t)s * TREAL * 128;
    for (int t = wv; t < TREAL; t += nwv) {
      const unsigned idxpair = __builtin_nontemporal_load((const unsigned*)(EIDX + (size_t)t * 128) + lane);
      const u32x4 xs = *(const u32x4*)(A2 + (size_t)t * D + s * 64 + sub * 8);
      u32x4 u[16];
#pragma unroll
      for (int j = 0; j < 16; ++j) {
        const unsigned w = (unsigned)__shfl((int)idxpair, (lane & ~7) + (j >> 1));
        const unsigned e = (j & 1) ? (w >> 16) : (w & 0xffffu);
        u[j] = *(const u32x4*)(tab + (size_t)e * 64);
      }
      float res0 = 0.f, res1 = 0.f;
#pragma unroll
      for (int j = 0; j < 16; ++j) {
        float acc = 0.f;
        acc = dot2bf(u[j].x, xs.x, acc); acc = dot2bf(u[j].y, xs.y, acc); acc = dot2bf(u[j].z, xs.z, acc); acc = dot2bf(u[j].w, xs.w, acc);
        acc = dpp_sum8(acc);
        if (sub == (j >> 1)) { if (j & 1) res1 = acc; else res0 = acc; }
      }
      __builtin_nontemporal_store(pk2(res0, res1), (unsigned*)(pp + (size_t)t * 128) + lane);
    }
  }
}
DI void ph_peer_c(const bf16_t* __restrict__ PP, const unsigned short* __restrict__ EIDX, const float* __restrict__ GATE, unsigned* __restrict__ STREAM) {
  size_t i = (size_t)blockIdx.x * blockDim.x + threadIdx.x;
  const size_t stride = (size_t)gridDim.x * blockDim.x, n = (size_t)TREAL * 128;
  for (; i < n; i += stride) {
    float a = 0.f;
#pragma unroll
    for (int s = 0; s < 16; ++s) a += bf2f(PP[(size_t)s * n + i]);
    const float act = 0.5f * a * (1.f + erff(a * 0.70710678118654752f));
    const float c = GATE[i] * act;
    const size_t t = i >> 7; const unsigned k = (unsigned)(i & 127);
    STREAM[(((t >> 6) * 32 + (k >> 2)) * 64 + (t & 63)) * 4 + (k & 3)] = (unsigned)EIDX[i] | (f2bf(c) << 16);
  }
}
DI void ph_peer_v(char* smem, const unsigned* __restrict__ STREAM, const bf16_t* __restrict__ EVc, float* __restrict__ YT) {
  const int tid = fresh_tid(), lane = tid & 63, wave = tid >> 6;
  u32x2* tabl = (u32x2*)smem;
  for (int cg = blockIdx.x; cg < 256; cg += gridDim.x) {
    const u32x4* src = (const u32x4*)(EVc + (size_t)cg * NEXP * 4);
#pragma unroll 4
    for (int i = tid; i < NEXP * 8 / 16; i += 512) ((u32x4*)smem)[i] = src[i];
    __syncthreads();
    for (int it = wave; it < TREAL / 64; it += 8) {
      const int t = it * 64 + lane;
      const u32x4* sp = (const u32x4*)(STREAM + (size_t)it * 8192) + lane;
      float y0 = 0.f, y1 = 0.f, y2 = 0.f, y3 = 0.f;
#pragma unroll 4
      for (int q = 0; q < 32; ++q) {
        const u32x4 w4 = sp[q * 64];
#pragma unroll
        for (int z = 0; z < 4; ++z) {
          const unsigned w = z == 0 ? w4.x : z == 1 ? w4.y : z == 2 ? w4.z : w4.w;
          const float c = bfhi(w);
          const u32x2 v = tabl[w & 0xffffu];
          y0 += c * bflo(v.x); y1 += c * bfhi(v.x); y2 += c * bflo(v.y); y3 += c * bfhi(v.y);
        }
      }
      *(f32x4*)(YT + ((size_t)cg * TREAL + t) * 4) = (f32x4){y0, y1, y2, y3};
    }
    __syncthreads();
  }
}
DI void ph_final(int wv4, const float* __restrict__ H1, const float* __restrict__ YT, const float* __restrict__ gf, float* __restrict__ out) {
  const int lane = fresh_tid() & 63;
  const int t0 = wv4 * 4;
  f32x4 y[4][4];
#pragma unroll
  for (int j = 0; j < 4; ++j) {
    const f32x4* yp = (const f32x4*)(YT + ((size_t)(lane + 64 * j) * TREAL + t0) * 4);
#pragma unroll
    for (int q = 0; q < 4; ++q) y[j][q] = yp[q];
  }
#pragma unroll
  for (int q = 0; q < 4; ++q) {
    const size_t rowoff = (size_t)(t0 + q) * D;
    float ss = 0.f;
#pragma unroll
    for (int j = 0; j < 4; ++j) {
      const f32x4 hv = *(const f32x4*)(H1 + rowoff + (lane + 64 * j) * 4);
      y[j][q].x += hv.x; y[j][q].y += hv.y; y[j][q].z += hv.z; y[j][q].w += hv.w;
      ss += y[j][q].x * y[j][q].x + y[j][q].y * y[j][q].y + y[j][q].z * y[j][q].z + y[j][q].w * y[j][q].w;
    }
    ss = wave_sum(ss);
    const float sc = rsqrtf(ss * (1.0f / D) + EPS);
#pragma unroll
    for (int j = 0; j < 4; ++j) {
      const f32x4 gg = *(const f32x4*)(gf + (lane + 64 * j) * 4);
      *(f32x4*)(out + rowoff + (lane + 64 * j) * 4) = (f32x4){y[j][q].x * sc * gg.x, y[j][q].y * sc * gg.y, y[j][q].z * sc * gg.z, y[j][q].w * sc * gg.w};
    }
  }
}


typedef unsigned char u8_t;
constexpr size_t WS_SCU = 14 * MiB;
constexpr size_t WS_SCV = 14 * MiB + 65536;
DI float wave_max(float v) {
#pragma unroll
  for (int o = 32; o >= 1; o >>= 1) v = fmaxf(v, __shfl_xor(v, o));
  return v;
}
DI u32x4 quant_row16(const float* __restrict__ rowp, int lane, float& sc) {
  const f32x4* rp = (const f32x4*)(rowp + lane * 16);
  const f32x4 a = rp[0], b = rp[1], c = rp[2], d = rp[3];
  float m = fmaxf(fmaxf(fmaxf(fabsf(a.x), fabsf(a.y)), fmaxf(fabsf(a.z), fabsf(a.w))), fmaxf(fmaxf(fabsf(b.x), fabsf(b.y)), fmaxf(fabsf(b.z), fabsf(b.w))));
  m = fmaxf(m, fmaxf(fmaxf(fmaxf(fabsf(c.x), fabsf(c.y)), fmaxf(fabsf(c.z), fabsf(c.w))), fmaxf(fmaxf(fabsf(d.x), fabsf(d.y)), fmaxf(fabsf(d.z), fabsf(d.w)))));
  m = wave_max(m);
  sc = m > 0.f ? m * (1.0f / 448.0f) : 1.0f;
  const float inv = 1.0f / sc;
  u32x4 o; unsigned w;
  w = 0; w = __builtin_amdgcn_cvt_pk_fp8_f32(a.x * inv, a.y * inv, w, false); w = __builtin_amdgcn_cvt_pk_fp8_f32(a.z * inv, a.w * inv, w, true); o.x = w;
  w = 0; w = __builtin_amdgcn_cvt_pk_fp8_f32(b.x * inv, b.y * inv, w, false); w = __builtin_amdgcn_cvt_pk_fp8_f32(b.z * inv, b.w * inv, w, true); o.y = w;
  w = 0; w = __builtin_amdgcn_cvt_pk_fp8_f32(c.x * inv, c.y * inv, w, false); w = __builtin_amdgcn_cvt_pk_fp8_f32(c.z * inv, c.w * inv, w, true); o.z = w;
  w = 0; w = __builtin_amdgcn_cvt_pk_fp8_f32(d.x * inv, d.y * inv, w, false); w = __builtin_amdgcn_cvt_pk_fp8_f32(d.z * inv, d.w * inv, w, true); o.w = w;
  return o;
}
DI void ph_convert_eu8(const float* __restrict__ src, u8_t* __restrict__ EU8s, float* __restrict__ scaleU) {
  const int tid = fresh_tid(), lane = tid & 63, wave = tid >> 6;
  for (int e = (blockIdx.x * 8 + wave) * 2; e < NEXP; e += gridDim.x * 16) {
    float sc0, sc1 = 1.f;
    const bool two = e + 1 < NEXP;
    const u32x4 o0 = quant_row16(src + (size_t)e * D, lane, sc0);
    u32x4 o1 = o0;
    if (two) o1 = quant_row16(src + (size_t)(e + 1) * D, lane, sc1);
    *(u32x4*)(EU8s + ((size_t)(lane >> 3) * NEXP + e) * 128 + (lane & 7) * 16) = o0;
    if (two) *(u32x4*)(EU8s + ((size_t)(lane >> 3) * NEXP + e + 1) * 128 + (lane & 7) * 16) = o1;
    if (lane == 0) { scaleU[e] = sc0; if (two) scaleU[e + 1] = sc1; }
  }
}
DI void ph_convert_ev8(int vb, char* smem, const float* __restrict__ src, u8_t* __restrict__ EV8c, float* __restrict__ scaleV) {
  const int tid256_ = fresh_tid() & 255;
  u8_t (*t)[1040] = (u8_t (*)[1040])smem;
  const int lane = TID & 63, wave = TID >> 6, e0 = vb * 32;
  for (int rr = 0; rr < 8; ++rr) {
    const int r = wave * 8 + rr;
    float sc;
    const u32x4 o = quant_row16(src + (size_t)(e0 + r) * D, lane, sc);
    *(u32x4*)&t[r][lane * 16] = o;
    if (lane == 0) scaleV[e0 + r] = sc;
  }
  __syncthreads();
  const int r = TID & 31, cs = TID >> 5;
  for (int c0 = 0; c0 < 128; c0 += 8) {
    const int cg = c0 + cs;
    const u32x2 v = *(const u32x2*)&t[r][cg * 8];
    *(u32x2*)(EV8c + ((size_t)cg * NEXP + e0 + r) * 8) = v;
  }
  __syncthreads();
}
DI float dot4_fp8(unsigned w, float x0, float x1, float x2, float x3, float acc) {
  const f32x2 lo = __builtin_amdgcn_cvt_pk_f32_fp8(w, false), hi = __builtin_amdgcn_cvt_pk_f32_fp8(w, true);
  acc += lo.x * x0; acc += lo.y * x1; acc += hi.x * x2; acc += hi.y * x3;
  return acc;
}
struct PeerUHalf { u32x4 u[8]; };
template <int HF> DI void peer_u8_issue(PeerUHalf& H, unsigned idxpair, int lane, const u8_t* __restrict__ tab) {
#pragma unroll
  for (int jj = 0; jj < 8; ++jj) {
    const int j = 8 * HF + jj;
    const unsigned w = (unsigned)__shfl((int)idxpair, (lane & ~7) + (j >> 1));
    const unsigned e = (j & 1) ? (w >> 16) : (w & 0xffffu);
    H.u[jj] = *(const u32x4*)(tab + (size_t)e * 128);
  }
}
template <int HF> DI void peer_u8_compute(const PeerUHalf& H, const u32x4 xa, const u32x4 xb, int sub, float& res0, float& res1) {
  const float x0 = bflo(xa.x), x1 = bfhi(xa.x), x2 = bflo(xa.y), x3 = bfhi(xa.y), x4 = bflo(xa.z), x5 = bfhi(xa.z), x6 = bflo(xa.w), x7 = bfhi(xa.w);
  const float x8 = bflo(xb.x), x9 = bfhi(xb.x), x10 = bflo(xb.y), x11 = bfhi(xb.y), x12 = bflo(xb.z), x13 = bfhi(xb.z), x14 = bflo(xb.w), x15 = bfhi(xb.w);
#pragma unroll
  for (int jj = 0; jj < 8; ++jj) {
    const int j = 8 * HF + jj;
    float acc = 0.f;
    acc = dot4_fp8(H.u[jj].x, x0, x1, x2, x3, acc); acc = dot4_fp8(H.u[jj].y, x4, x5, x6, x7, acc);
    acc = dot4_fp8(H.u[jj].z, x8, x9, x10, x11, acc); acc = dot4_fp8(H.u[jj].w, x12, x13, x14, x15, acc);
    acc = dpp_sum8(acc);
    if (sub == (j >> 1)) { if (j & 1) res1 = acc; else res0 = acc; }
  }
}
DI unsigned peer_u8_idx(const unsigned short* __restrict__ EIDX, int t, int lane) {
  return t < TREAL ? __builtin_nontemporal_load((const unsigned*)(EIDX + (size_t)t * 128) + lane) : 0u;
}
DI void ph_peer_u8(int xi, int nx, int wv, int nwv, const bf16_t* __restrict__ A2, const u8_t* __restrict__ EU8s,
                   const unsigned short* __restrict__ EIDX, bf16_t* __restrict__ PP) {
  const int lane = fresh_tid() & 63, sub = lane & 7;
  const int ntok = (TREAL - wv + nwv - 1) / nwv;
#define PU_TOK(i) (wv + ((i) < ntok ? (i) : ntok - 1) * nwv)
#define PU_IDX(t) __builtin_nontemporal_load((const unsigned*)(EIDX + (size_t)(t) * 128) + lane)
#define PU_LDX(xa_, xb_, t) { xa_ = *(const u32x4*)(xbase + (size_t)(t) * D); xb_ = *(const u32x4*)(xbase + (size_t)(t) * D + 8); }
#define PU_STORE(t, r0, r1) __builtin_nontemporal_store(pk2(r0, r1), (unsigned*)(pp + (size_t)(t) * 128) + lane)
  for (int s = xi; s < 8; s += nx) {
    const u8_t* tab = EU8s + (size_t)s * NEXP * 128 + sub * 16;
    const bf16_t* xbase = A2 + s * 128 + sub * 16;
    bf16_t* pp = PP + (size_t)s * TREAL * 128;
    PeerUHalf HA, HB, HC;
    int ta = PU_TOK(0), tb = PU_TOK(1), tc = PU_TOK(2);
    unsigned ia = PU_IDX(ta), ib = PU_IDX(tb), ic = PU_IDX(tc);
    u32x4 xaa, xab; PU_LDX(xaa, xab, ta);
    peer_u8_issue<0>(HA, ia, lane, tab);
    peer_u8_issue<1>(HB, ia, lane, tab);
    for (int i = 0; i < ntok; i += 3) {
      const int td = PU_TOK(i + 3), te = PU_TOK(i + 4), tf = PU_TOK(i + 5);
      u32x4 xba, xbb, xca, xcb, xda, xdb;
      float r0, r1;
      peer_u8_issue<0>(HC, ib, lane, tab); PU_LDX(xba, xbb, tb); const unsigned id = PU_IDX(td);
      r0 = 0.f; r1 = 0.f;
      peer_u8_compute<0>(HA, xaa, xab, sub, r0, r1);
      peer_u8_issue<1>(HA, ib, lane, tab);
      peer_u8_compute<1>(HB, xaa, xab, sub, r0, r1);
      PU_STORE(ta, r0, r1);
      peer_u8_issue<0>(HB, ic, lane, tab); PU_LDX(xca, xcb, tc); const unsigned ie = PU_IDX(te);
      r0 = 0.f; r1 = 0.f;
      peer_u8_compute<0>(HC, xba, xbb, sub, r0, r1);
      peer_u8_issue<1>(HC, ic, lane, tab);
      peer_u8_compute<1>(HA, xba, xbb, sub, r0, r1);
      PU_STORE(tb, r0, r1);
      peer_u8_issue<0>(HA, id, lane, tab); PU_LDX(xda, xdb, td); const unsigned if_ = PU_IDX(tf);
      r0 = 0.f; r1 = 0.f;
      peer_u8_compute<0>(HB, xca, xcb, sub, r0, r1);
      peer_u8_issue<1>(HB, id, lane, tab);
      peer_u8_compute<1>(HC, xca, xcb, sub, r0, r1);
      PU_STORE(tc, r0, r1);
      ta = td; tb = te; tc = tf; ib = ie; ic = if_; xaa = xda; xab = xdb;
    }
  }
#undef PU_TOK
#undef PU_IDX
#undef PU_LDX
#undef PU_STORE
}
DI void ph_peer_c8(const bf16_t* __restrict__ PP, const unsigned short* __restrict__ EIDX, const float* __restrict__ GATE,
                   const float* __restrict__ scaleU, const float* __restrict__ scaleV, unsigned* __restrict__ STREAM) {
  size_t i = (size_t)blockIdx.x * blockDim.x + threadIdx.x;
  const size_t stride = (size_t)gridDim.x * blockDim.x, n = (size_t)TREAL * 128;
  for (; i < n; i += stride) {
    float a = 0.f;
#pragma unroll
    for (int s = 0; s < 8; ++s) a += bf2f(PP[(size_t)s * n + i]);
    const unsigned e = EIDX[i];
    a *= scaleU[e];
    const float act = 0.5f * a * (1.f + erff(a * 0.70710678118654752f));
    const float c = GATE[i] * act * scaleV[e];
    const size_t t = i >> 7; const unsigned k = (unsigned)(i & 127);
    STREAM[(((t >> 6) * 32 + (k >> 2)) * 64 + (t & 63)) * 4 + (k & 3)] = e | (f2bf(c) << 16);
  }
}
struct PVW { u32x4 a, b; };
struct PVT { u32x2 v[8]; };
DI void pv_loadw(PVW& W, const unsigned* __restrict__ STREAM, int it, int g, int lane) {
  const u32x4* sp = (const u32x4*)(STREAM + (size_t)it * 8192) + lane;
  W.a = sp[(2 * g) * 64]; W.b = sp[(2 * g + 1) * 64];
}
DI void pv_readt(PVT& T, const PVW& W, const u32x2* tabl) {
  T.v[0] = tabl[W.a.x & 0xffffu]; T.v[1] = tabl[W.a.y & 0xffffu]; T.v[2] = tabl[W.a.z & 0xffffu]; T.v[3] = tabl[W.a.w & 0xffffu];
  T.v[4] = tabl[W.b.x & 0xffffu]; T.v[5] = tabl[W.b.y & 0xffffu]; T.v[6] = tabl[W.b.z & 0xffffu]; T.v[7] = tabl[W.b.w & 0xffffu];
}
DI void pv_fma1(unsigned w, const u32x2 v, f32x2 (&y)[4]) {
  const float c = bfhi(w);
  const f32x2 cc = {c, c};
  y[0] = __builtin_elementwise_fma(__builtin_amdgcn_cvt_pk_f32_fp8(v.x, false), cc, y[0]);
  y[1] = __builtin_elementwise_fma(__builtin_amdgcn_cvt_pk_f32_fp8(v.x, true), cc, y[1]);
  y[2] = __builtin_elementwise_fma(__builtin_amdgcn_cvt_pk_f32_fp8(v.y, false), cc, y[2]);
  y[3] = __builtin_elementwise_fma(__builtin_amdgcn_cvt_pk_f32_fp8(v.y, true), cc, y[3]);
}
DI void pv_fma(const PVW& W, const PVT& T, f32x2 (&y)[4]) {
  pv_fma1(W.a.x, T.v[0], y); pv_fma1(W.a.y, T.v[1], y); pv_fma1(W.a.z, T.v[2], y); pv_fma1(W.a.w, T.v[3], y);
  pv_fma1(W.b.x, T.v[4], y); pv_fma1(W.b.y, T.v[5], y); pv_fma1(W.b.z, T.v[6], y); pv_fma1(W.b.w, T.v[7], y);
}
DI void ph_peer_v8(char* smem, const unsigned* __restrict__ STREAM, const u8_t* __restrict__ EV8c, float* __restrict__ YT) {
  const int tid = fresh_tid(), lane = tid & 63, wave = tid >> 6;
  const u32x2* tabl = (const u32x2*)smem;
  for (int unit = blockIdx.x; unit < 256; unit += gridDim.x) {
    const int cg = unit & 127, th = unit >> 7;
    const u32x4* src = (const u32x4*)(EV8c + (size_t)cg * NEXP * 8);
#pragma unroll 4
    for (int i = tid; i < NEXP * 8 / 16; i += 512) ((u32x4*)smem)[i] = src[i];
    __syncthreads();
    const int it_end = th * 512 + 512;
    int it = th * 512 + wave;
    PVW W0, W1, W2, W3; PVT T0, T1;
    pv_loadw(W0, STREAM, it, 0, lane); pv_loadw(W1, STREAM, it, 1, lane);
    pv_readt(T0, W0, tabl);
    for (; it < it_end; it += 8) {
      const int itn = (it + 8 < it_end) ? it + 8 : it;
      f32x2 y[4];
#pragma unroll
      for (int z = 0; z < 4; ++z) y[z] = (f32x2){0.f, 0.f};
#define PV_STEP(g, Wld, Wrd, Trd, Wc, Tc) \
      pv_loadw(Wld, STREAM, ((g) + 2 < 16) ? it : itn, ((g) + 2) & 15, lane); \
      pv_readt(Trd, Wrd, tabl); \
      pv_fma(Wc, Tc, y); \
      asm volatile("" ::: "memory");
      PV_STEP(0, W2, W1, T1, W0, T0)  PV_STEP(1, W3, W2, T0, W1, T1)  PV_STEP(2, W0, W3, T1, W2, T0)  PV_STEP(3, W1, W0, T0, W3, T1)
      PV_STEP(4, W2, W1, T1, W0, T0)  PV_STEP(5, W3, W2, T0, W1, T1)  PV_STEP(6, W0, W3, T1, W2, T0)  PV_STEP(7, W1, W0, T0, W3, T1)
      PV_STEP(8, W2, W1, T1, W0, T0)  PV_STEP(9, W3, W2, T0, W1, T1)  PV_STEP(10, W0, W3, T1, W2, T0) PV_STEP(11, W1, W0, T0, W3, T1)
      PV_STEP(12, W2, W1, T1, W0, T0) PV_STEP(13, W3, W2, T0, W1, T1) PV_STEP(14, W0, W3, T1, W2, T0) PV_STEP(15, W1, W0, T0, W3, T1)
#undef PV_STEP
      const int t = it * 64 + lane;
      float* yo = YT + ((size_t)cg * TREAL + t) * 8;
      *(f32x4*)yo = (f32x4){y[0].x, y[0].y, y[1].x, y[1].y};
      *(f32x4*)(yo + 4) = (f32x4){y[2].x, y[2].y, y[3].x, y[3].y};
    }
    __syncthreads();
  }
}
DI void ph_final8(int wv2, const float* __restrict__ H1, const float* __restrict__ YT, const float* __restrict__ gf, float* __restrict__ out) {
  const int lane = fresh_tid() & 63;
  const int t0 = wv2 * 2;
  f32x4 y[2][2][2];
#pragma unroll
  for (int j = 0; j < 2; ++j) {
    const f32x4* yp = (const f32x4*)(YT + ((size_t)(lane + 64 * j) * TREAL + t0) * 8);
    y[j][0][0] = yp[0]; y[j][0][1] = yp[1]; y[j][1][0] = yp[2]; y[j][1][1] = yp[3];
  }
#pragma unroll
  for (int q = 0; q < 2; ++q) {
    const size_t rowoff = (size_t)(t0 + q) * D;
    float ss = 0.f;
#pragma unroll
    for (int j = 0; j < 2; ++j)
#pragma unroll
      for (int hf = 0; hf < 2; ++hf) {
        const f32x4 hv = *(const f32x4*)(H1 + rowoff + (lane + 64 * j) * 8 + hf * 4);
        f32x4& yy = y[j][q][hf];
        yy.x += hv.x; yy.y += hv.y; yy.z += hv.z; yy.w += hv.w;
        ss += yy.x * yy.x + yy.y * yy.y + yy.z * yy.z + yy.w * yy.w;
      }
    ss = wave_sum(ss);
    const float sc = rsqrtf(ss * (1.0f / D) + EPS);
#pragma unroll
    for (int j = 0; j < 2; ++j)
#pragma unroll
      for (int hf = 0; hf < 2; ++hf) {
        const f32x4 gg = *(const f32x4*)(gf + (lane + 64 * j) * 8 + hf * 4);
        const f32x4 yy = y[j][q][hf];
        *(f32x4*)(out + rowoff + (lane + 64 * j) * 8 + hf * 4) = (f32x4){yy.x * sc * gg.x, yy.y * sc * gg.y, yy.z * sc * gg.z, yy.w * sc * gg.w};
      }
  }
}


DI void ph_final_lds(int unit, char* smem, const float* __restrict__ H1, const float* __restrict__ YT, const float* __restrict__ gf, float* __restrict__ out) {
  float (*h2)[1028] = (float (*)[1028])smem;
  const int tid = fresh_tid(), lane = tid & 63, wave = tid >> 6;
  const int t0 = unit * 32;
#pragma unroll
  for (int rr = 0; rr < 4; ++rr) {
    const int r = wave * 4 + rr;
    const float* hp = H1 + (size_t)(t0 + r) * D;
#pragma unroll
    for (int j = 0; j < 4; ++j) *(f32x4*)&h2[r][j * 256 + lane * 4] = *(const f32x4*)(hp + j * 256 + lane * 4);
  }
  __syncthreads();
  {
    const int tok = lane >> 1, hf = lane & 1;
#pragma unroll 4
    for (int cg = wave; cg < 128; cg += 8) {
      const f32x4 yv = *(const f32x4*)(YT + ((size_t)cg * TREAL + t0) * 8 + lane * 4);
      f32x4* hp = (f32x4*)&h2[tok][cg * 8 + hf * 4];
      f32x4 hv = *hp; hv.x += yv.x; hv.y += yv.y; hv.z += yv.z; hv.w += yv.w; *hp = hv;
    }
  }
  __syncthreads();
#pragma unroll
  for (int rr = 0; rr < 4; ++rr) {
    const int r = wave * 4 + rr;
    f32x4 v[4]; float ss = 0.f;
#pragma unroll
    for (int j = 0; j < 4; ++j) { v[j] = *(const f32x4*)&h2[r][j * 256 + lane * 4]; ss += v[j].x * v[j].x + v[j].y * v[j].y + v[j].z * v[j].z + v[j].w * v[j].w; }
    ss = wave_sum(ss);
    const float sc = rsqrtf(ss * (1.0f / D) + EPS);
    float* op = out + (size_t)(t0 + r) * D;
#pragma unroll
    for (int j = 0; j < 4; ++j) {
      const f32x4 gg = *(const f32x4*)(gf + j * 256 + lane * 4);
      *(f32x4*)(op + j * 256 + lane * 4) = (f32x4){v[j].x * sc * gg.x, v[j].y * sc * gg.y, v[j].z * sc * gg.z, v[j].w * sc * gg.w};
    }
  }
  __syncthreads();
}


typedef int i32x4 __attribute__((ext_vector_type(4)));
constexpr size_t WS_XQ = 861 * MiB;
constexpr size_t WS_XS = 943 * MiB;
DI unsigned pack_i8x4(float a, float b, float c, float d) {
  const int ia = __float2int_rn(a), ib = __float2int_rn(b), ic = __float2int_rn(c), id = __float2int_rn(d);
  return ((unsigned)ia & 255u) | (((unsigned)ib & 255u) << 8) | (((unsigned)ic & 255u) << 16) | ((unsigned)id << 24);
}
DI u32x4 quant_row16_i8(const float* __restrict__ rowp, int lane, float& sc) {
  const f32x4* rp = (const f32x4*)(rowp + lane * 16);
  const f32x4 a = rp[0], b = rp[1], c = rp[2], d = rp[3];
  float m = fmaxf(fmaxf(fmaxf(fabsf(a.x), fabsf(a.y)), fmaxf(fabsf(a.z), fabsf(a.w))), fmaxf(fmaxf(fabsf(b.x), fabsf(b.y)), fmaxf(fabsf(b.z), fabsf(b.w))));
  m = fmaxf(m, fmaxf(fmaxf(fmaxf(fabsf(c.x), fabsf(c.y)), fmaxf(fabsf(c.z), fabsf(c.w))), fmaxf(fmaxf(fabsf(d.x), fabsf(d.y)), fmaxf(fabsf(d.z), fabsf(d.w)))));
  m = wave_max(m);
  sc = m > 0.f ? m * (1.0f / 127.0f) : 1.0f;
  const float inv = 1.0f / sc;
  u32x4 o;
  o.x = pack_i8x4(a.x * inv, a.y * inv, a.z * inv, a.w * inv); o.y = pack_i8x4(b.x * inv, b.y * inv, b.z * inv, b.w * inv);
  o.z = pack_i8x4(c.x * inv, c.y * inv, c.z * inv, c.w * inv); o.w = pack_i8x4(d.x * inv, d.y * inv, d.z * inv, d.w * inv);
  return o;
}
DI void ph_convert_eu_i8(const float* __restrict__ src, u8_t* __restrict__ EUq, float* __restrict__ scaleU) {
  const int tid = fresh_tid(), lane = tid & 63, wave = tid >> 6;
  for (int e = (blockIdx.x * 8 + wave) * 2; e < NEXP; e += gridDim.x * 16) {
    float sc0, sc1 = 1.f;
    const bool two = e + 1 < NEXP;
    const u32x4 o0 = quant_row16_i8(src + (size_t)e * D, lane, sc0);
    u32x4 o1 = o0;
    if (two) o1 = quant_row16_i8(src + (size_t)(e + 1) * D, lane, sc1);
    *(u32x4*)(EUq + ((size_t)(lane >> 3) * NEXP + e) * 128 + (lane & 7) * 16) = o0;
    if (two) *(u32x4*)(EUq + ((size_t)(lane >> 3) * NEXP + e + 1) * 128 + (lane & 7) * 16) = o1;
    if (lane == 0) { scaleU[e] = sc0; if (two) scaleU[e + 1] = sc1; }
  }
}
DI void ph_norm2_rows(int vb, const float* __restrict__ src, const float* __restrict__ gain, bf16_t* __restrict__ dst, u8_t* __restrict__ XQ, float* __restrict__ XS) {
  const int tid256_ = fresh_tid() & 255;
  const int row0 = vb * 16 + (TID >> 6) * 4, lane = TID & 63;
  f32x4 v[4][4];
#pragma unroll
  for (int rr = 0; rr < 4; ++rr)
#pragma unroll
    for (int j = 0; j < 4; ++j) v[rr][j] = *(const f32x4*)(src + (size_t)(row0 + rr) * D + j * 256 + lane * 4);
  f32x4 gg[4];
#pragma unroll
  for (int j = 0; j < 4; ++j) gg[j] = *(const f32x4*)(gain + j * 256 + lane * 4);
#pragma unroll
  for (int rr = 0; rr < 4; ++rr) {
    float ss = 0.f;
#pragma unroll
    for (int j = 0; j < 4; ++j) ss += v[rr][j].x * v[rr][j].x + v[rr][j].y * v[rr][j].y + v[rr][j].z * v[rr][j].z + v[rr][j].w * v[rr][j].w;
    ss = wave_sum(ss);
    const float r = rsqrtf(ss * (1.0f / D) + EPS);
#pragma unroll
    for (int j = 0; j < 4; ++j) {
      const float a0 = v[rr][j].x * r * gg[j].x, a1 = v[rr][j].y * r * gg[j].y, a2 = v[rr][j].z * r * gg[j].z, a3 = v[rr][j].w * r * gg[j].w;
      u32x2 o; o.x = pk2(a0, a1); o.y = pk2(a2, a3);
      *(u32x2*)(dst + (size_t)(row0 + rr) * D + j * 256 + lane * 4) = o;
      float m = fmaxf(fmaxf(fabsf(a0), fabsf(a1)), fmaxf(fabsf(a2), fabsf(a3)));
#pragma unroll
      for (int sh = 16; sh >= 1; sh >>= 1) m = fmaxf(m, __shfl_xor(m, sh));
      const float sc = m > 0.f ? m * (1.0f / 127.0f) : 1.0f;
      const float inv = 1.0f / sc;
      *(unsigned*)(XQ + (size_t)(row0 + rr) * D + j * 256 + lane * 4) = pack_i8x4(a0 * inv, a1 * inv, a2 * inv, a3 * inv);
      if ((lane & 31) == 0) XS[(size_t)(row0 + rr) * 8 + 2 * j + (lane >> 5)] = sc;
    }
  }
}

DI int dpp_i(int v, const int sel) {
  if (sel == 0) return __builtin_amdgcn_update_dpp(0, v, 0xB1, 0xF, 0xF, true);
  if (sel == 1) return __builtin_amdgcn_update_dpp(0, v, 0x4E, 0xF, 0xF, true);
  return __builtin_amdgcn_update_dpp(0, v, 0x141, 0xF, 0xF, true);
}
DI int dpp_isum8(int v) { v += dpp_i(v, 0); v += dpp_i(v, 1); v += dpp_i(v, 2); return v; }
template <int HF> DI void peer_ud4_issue(PeerUHalf& H, unsigned idxpair, int lane, const u8_t* __restrict__ tab) {
#pragma unroll
  for (int jj = 0; jj < 8; ++jj) {
    const int j = 8 * HF + jj;
    const unsigned w = (unsigned)__shfl((int)idxpair, (lane & ~7) + (j >> 1));
    const unsigned e = (j & 1) ? (w >> 16) : (w & 0xffffu);
    H.u[jj] = *(const u32x4*)(tab + (size_t)e * 128);
  }
}
template <int HF> DI void peer_ud4_compute(const PeerUHalf& H, const u32x4 xq, int sub, int& res0, int& res1) {
#pragma unroll
  for (int jj = 0; jj < 8; ++jj) {
    const int j = 8 * HF + jj;
    int acc = 0;
    acc = __builtin_amdgcn_sdot4((int)H.u[jj].x, (int)xq.x, acc, false); acc = __builtin_amdgcn_sdot4((int)H.u[jj].y, (int)xq.y, acc, false);
    acc = __builtin_amdgcn_sdot4((int)H.u[jj].z, (int)xq.z, acc, false); acc = __builtin_amdgcn_sdot4((int)H.u[jj].w, (int)xq.w, acc, false);
    acc = dpp_isum8(acc);
    if (sub == (j >> 1)) { if (j & 1) res1 = acc; else res0 = acc; }
  }
}
DI void ph_peer_u_d4(int xi, int nx, int wv, int nwv, const u8_t* __restrict__ XQ, const float* __restrict__ XS, const u8_t* __restrict__ EUq,
                     const unsigned short* __restrict__ EIDX, bf16_t* __restrict__ PP) {
  const int lane = fresh_tid() & 63, sub = lane & 7;
  const int ntok = (TREAL - wv + nwv - 1) / nwv;
#define PU_TOK(i) (wv + ((i) < ntok ? (i) : ntok - 1) * nwv)
#define PU_IDX(t) __builtin_nontemporal_load((const unsigned*)(EIDX + (size_t)(t) * 128) + lane)
#define PU_LDX(xq_, xs_, t) { xq_ = *(const u32x4*)(xbase + (size_t)(t) * D); xs_ = XS[(size_t)(t) * 8 + s]; }
#define PU_STORE(t, r0, r1, xs_) __builtin_nontemporal_store(pk2((float)(r0) * (xs_), (float)(r1) * (xs_)), (unsigned*)(pp + (size_t)(t) * 128) + lane)
  for (int s = xi; s < 8; s += nx) {
    const u8_t* tab = EUq + (size_t)s * NEXP * 128 + sub * 16;
    const u8_t* xbase = XQ + s * 128 + sub * 16;
    bf16_t* pp = PP + (size_t)s * TREAL * 128;
    PeerUHalf HA, HB, HC;
    int ta = PU_TOK(0), tb = PU_TOK(1), tc = PU_TOK(2);
    unsigned ia = PU_IDX(ta), ib = PU_IDX(tb), ic = PU_IDX(tc);
    u32x4 xqa; float xsa; PU_LDX(xqa, xsa, ta);
    peer_ud4_issue<0>(HA, ia, lane, tab);
    peer_ud4_issue<1>(HB, ia, lane, tab);
    for (int i = 0; i < ntok; i += 3) {
      const int td = PU_TOK(i + 3), te = PU_TOK(i + 4), tf = PU_TOK(i + 5);
      u32x4 xqb, xqc, xqd; float xsb, xsc, xsd;
      int r0, r1;
      peer_ud4_issue<0>(HC, ib, lane, tab); PU_LDX(xqb, xsb, tb); const unsigned id = PU_IDX(td);
      r0 = 0; r1 = 0;
      peer_ud4_compute<0>(HA, xqa, sub, r0, r1);
      peer_ud4_issue<1>(HA, ib, lane, tab);
      peer_ud4_compute<1>(HB, xqa, sub, r0, r1);
      PU_STORE(ta, r0, r1, xsa);
      peer_ud4_issue<0>(HB, ic, lane, tab); PU_LDX(xqc, xsc, tc); const unsigned ie = PU_IDX(te);
      r0 = 0; r1 = 0;
      peer_ud4_compute<0>(HC, xqb, sub, r0, r1);
      peer_ud4_issue<1>(HC, ic, lane, tab);
      peer_ud4_compute<1>(HA, xqb, sub, r0, r1);
      PU_STORE(tb, r0, r1, xsb);
      peer_ud4_issue<0>(HA, id, lane, tab); PU_LDX(xqd, xsd, td); const unsigned if_ = PU_IDX(tf);
      r0 = 0; r1 = 0;
      peer_ud4_compute<0>(HB, xqc, sub, r0, r1);
      peer_ud4_issue<1>(HB, id, lane, tab);
      peer_ud4_compute<1>(HC, xqc, sub, r0, r1);
      PU_STORE(tc, r0, r1, xsc);
      ta = td; tb = te; tc = tf; ib = ie; ic = if_; xqa = xqd; xsa = xsd;
    }
  }
#undef PU_TOK
#undef PU_IDX
#undef PU_LDX
#undef PU_STORE
}

struct PUI { i32x4 a[8]; };
struct PUE { int e[8]; };
DI void pui_idx(PUE& E, const unsigned short* __restrict__ EIDX, int t, int c16) {
#pragma unroll
  for (int tau = 0; tau < 8; ++tau) E.e[tau] = EIDX[(size_t)t * 128 + 16 * tau + c16];
}
template <int HF> DI void pui_issue(PUI& H, const PUE& E, const u8_t* __restrict__ tab) {
#pragma unroll
  for (int tt = 0; tt < 4; ++tt) {
    const u8_t* pz = tab + (size_t)E.e[4 * HF + tt] * 128;
    H.a[2 * tt] = *(const i32x4*)pz; H.a[2 * tt + 1] = *(const i32x4*)(pz + 64);
  }
}
DI i32x4 pui_compute(const PUI& H, const i32x4 xb0, const i32x4 xb1, int c16) {
  i32x4 out = {0, 0, 0, 0};
#pragma unroll
  for (int tt = 0; tt < 4; ++tt) {
    i32x4 acc = {0, 0, 0, 0};
    acc = __builtin_amdgcn_mfma_i32_16x16x64_i8(H.a[2 * tt], xb0, acc, 0, 0, 0);
    acc = __builtin_amdgcn_mfma_i32_16x16x64_i8(H.a[2 * tt + 1], xb1, acc, 0, 0, 0);
    if ((c16 & 3) == tt) out = acc;
  }
  return out;
}
DI void ph_peer_u_i8(int xi, int nx, int wv, int nwv, const u8_t* __restrict__ XQ, const float* __restrict__ XS, const u8_t* __restrict__ EUq,
                     const unsigned short* __restrict__ EIDX, bf16_t* __restrict__ PP) {
  const int lane = fresh_tid() & 63, c16 = lane & 15, q = lane >> 4;
  const int ntok = (TREAL - wv + nwv - 1) / nwv;
#define PU_TOK(i) (wv + ((i) < ntok ? (i) : ntok - 1) * nwv)
#define PU_LDX(x0_, x1_, xs_, t) { x0_ = *(const i32x4*)(xbase + (size_t)(t) * D); x1_ = *(const i32x4*)(xbase + (size_t)(t) * D + 64); xs_ = XS[(size_t)(t) * 8 + s]; }
#define PU_STORE(t, o0, o1, xs_) { const i32x4 sel = (c16 & 4) ? (o1) : (o0); \
    if (c16 < 8) { u32x2 w_; w_.x = pk2((float)sel.x * (xs_), (float)sel.y * (xs_)); w_.y = pk2((float)sel.z * (xs_), (float)sel.w * (xs_)); \
      __builtin_nontemporal_store(w_, (u32x2*)(pp + (size_t)(t) * 128 + 16 * c16 + 4 * q)); } }
  for (int s = xi; s < 8; s += nx) {
    const u8_t* tab = EUq + (size_t)s * NEXP * 128 + q * 16;
    const u8_t* xbase = XQ + s * 128 + q * 16;
    bf16_t* pp = PP + (size_t)s * TREAL * 128;
    PUI HA, HB, HC;
    PUE Ea, Eb, Ec, Ed;
    int ta = PU_TOK(0), tb = PU_TOK(1), tc = PU_TOK(2);
    pui_idx(Ea, EIDX, ta, c16); pui_idx(Eb, EIDX, tb, c16); pui_idx(Ec, EIDX, tc, c16);
    i32x4 xa0, xa1; float xsa; PU_LDX(xa0, xa1, xsa, ta);
    pui_issue<0>(HA, Ea, tab);
    pui_issue<1>(HB, Ea, tab);
    for (int i = 0; i < ntok; i += 3) {
      const int td = PU_TOK(i + 3), te = PU_TOK(i + 4), tf = PU_TOK(i + 5);
      i32x4 xb0, xb1, xc0, xc1, xd0, xd1; float xsb, xsc, xsd;
      i32x4 o0, o1;
      pui_issue<0>(HC, Eb, tab); PU_LDX(xb0, xb1, xsb, tb); pui_idx(Ed, EIDX, td, c16);
      o0 = pui_compute(HA, xa0, xa1, c16);
      pui_issue<1>(HA, Eb, tab);
      o1 = pui_compute(HB, xa0, xa1, c16);
      PU_STORE(ta, o0, o1, xsa);
      pui_issue<0>(HB, Ec, tab); PU_LDX(xc0, xc1, xsc, tc); pui_idx(Eb, EIDX, te, c16);
      o0 = pui_compute(HC, xb0, xb1, c16);
      pui_issue<1>(HC, Ec, tab);
      o1 = pui_compute(HA, xb0, xb1, c16);
      PU_STORE(tb, o0, o1, xsb);
      pui_issue<0>(HA, Ed, tab); PU_LDX(xd0, xd1, xsd, td); pui_idx(Ec, EIDX, tf, c16);
      o0 = pui_compute(HB, xc0, xc1, c16);
      pui_issue<1>(HB, Ed, tab);
      o1 = pui_compute(HC, xc0, xc1, c16);
      PU_STORE(tc, o0, o1, xsc);
      ta = td; tb = te; tc = tf; xa0 = xd0; xa1 = xd1; xsa = xsd;
    }
  }
#undef PU_TOK
#undef PU_LDX
#undef PU_STORE
}

#define XB_TMO      128
#define XB_XCNT(j)  (256  + 64 * (j))
#define XB_XSUB(j)  (1280 + 64 * (j))
#define XB_XGEN(j)  (2304 + 64 * (j))
#define XB_TOP      3328
#define XB_TOPGEN   3392
#define XCD_BAR_WORDS 3456
#define XB_SPIN_CAP (1u << 20)
#define LAS __attribute__((address_space(3)))
DI unsigned xb_ld(unsigned* p)              { return __hip_atomic_load(p, __ATOMIC_RELAXED, __HIP_MEMORY_SCOPE_AGENT); }
DI unsigned xb_add(unsigned* p, unsigned v) { return __hip_atomic_fetch_add(p, v, __ATOMIC_RELAXED, __HIP_MEMORY_SCOPE_AGENT); }
DI unsigned xb_xcc_id() { return (unsigned)__builtin_amdgcn_s_getreg((3 << 11) | 20) & 0xFu; }
#define XB_SPIN(cond, bar) do { unsigned _sp = 0; while (cond) { __builtin_amdgcn_s_sleep(1); \
    if ((++_sp & 255u) == 0u) { if (xb_ld(&(bar)[XB_TMO])) break; if (_sp > XB_SPIN_CAP) { atomicAdd(&(bar)[XB_TMO], 1u); break; } } } } while (0)
struct XcdBarrier { unsigned* bar; unsigned x; volatile unsigned* st; };
DI XcdBarrier xcd_barrier_post(unsigned* bar, volatile unsigned* st) {
  XcdBarrier b; b.bar = bar; b.x = xb_xcc_id(); b.st = st;
  if (threadIdx.x == 0) (void)xb_add(&bar[XB_XCNT(b.x)], 1u);
  return b;
}
DI void xcd_barrier_complete(unsigned* bar, unsigned x, unsigned& nloc, unsigned& nx) {
  const unsigned G = gridDim.x;
  unsigned sum, cnt, mine, sp = 0u;
  for (;;) {
    sum = 0u; cnt = 0u; mine = 0u;
#pragma unroll
    for (unsigned j = 0; j < 16; ++j) { const unsigned c = xb_ld(&bar[XB_XCNT(j)]); sum += c; cnt += (c > 0u) ? 1u : 0u; mine = (j == x) ? c : mine; }
    if (sum == G) break;
    __builtin_amdgcn_s_sleep(1);
    if ((++sp & 255u) == 0u) { if (xb_ld(&bar[XB_TMO])) break; if (sp > XB_SPIN_CAP) { atomicAdd(&bar[XB_TMO], 1u); break; } }
  }
  nloc = mine > 0u ? mine : 1u; nx = cnt > 0u ? cnt : 1u;
}
DI void xcd_barrier(const XcdBarrier& b) {
  asm volatile("s_waitcnt vmcnt(0)" ::: "memory");
  __syncthreads();
  if (threadIdx.x == 0) {
    unsigned* bar = b.bar;
    __builtin_amdgcn_s_waitcnt(0);
    unsigned nloc = b.st[0], nx = b.st[1];
    if (nloc == 0u) { xcd_barrier_complete(bar, b.x, nloc, nx); b.st[0] = nloc; b.st[1] = nx; }
    const unsigned old = xb_add(&bar[XB_XSUB(b.x)], 1u);
    const unsigned gen = old / nloc;
    if (old + 1u == (gen + 1u) * nloc) {
      __builtin_amdgcn_fence(__ATOMIC_RELEASE, "agent");
      asm volatile("s_waitcnt vmcnt(0)" ::: "memory");
      const unsigned og = xb_add(&bar[XB_TOP], 1u);
      const unsigned tg = og / nx;
      if (og + 1u == (tg + 1u) * nx) xb_add(&bar[XB_TOPGEN], 1u);
      else XB_SPIN(xb_ld(&bar[XB_TOPGEN]) == tg, bar);
      __builtin_amdgcn_fence(__ATOMIC_ACQUIRE, "agent");
      xb_add(&bar[XB_XGEN(b.x)], 1u);
      asm volatile("s_waitcnt vmcnt(0)" ::: "memory");
    } else {
      XB_SPIN(xb_ld(&bar[XB_XGEN(b.x)]) == gen, bar);
      __builtin_amdgcn_fence(__ATOMIC_ACQUIRE, "agent");
      asm volatile("s_waitcnt vmcnt(0)" ::: "memory");
    }
  }
  __syncthreads();
}

struct Params {
  const float *x, *meta, *norm1_g, *w_in, *wg, *bg, *sb_g, *gla_g, *w_out, *norm2_g, *w_pq, *sk1, *sk2, *eu, *ev, *gf;
  float* out; char* ws;
};
constexpr int HALF_SMEM = 73728;
constexpr int SMEM_BYTES = 2 * HALF_SMEM;
constexpr size_t WS_BAR = 0;

__global__ void __launch_bounds__(512, 2) k_fused(Params p) {
  extern __shared__ __attribute__((aligned(16))) char smem_dyn[];
  const int half = __builtin_amdgcn_readfirstlane((int)(threadIdx.x >> 8));
  char* smem = smem_dyn + half * HALF_SMEM;
  __shared__ unsigned xb_words[4];
  if (threadIdx.x < 4) xb_words[threadIdx.x] = 0u;
  __syncthreads();
  const XcdBarrier bar = xcd_barrier_post((unsigned*)(p.ws + WS_BAR), xb_words);
  if (threadIdx.x == 0) xb_words[2] = xb_add((unsigned*)(p.ws + WS_XRANK) + bar.x, 1u);
  const int G = 2 * gridDim.x, bid = 2 * blockIdx.x + half;
  char* ws = p.ws;
  bf16_t* WinT = (bf16_t*)(ws + WS_WIN);
  bf16_t* WoutT = (bf16_t*)(ws + WS_WOUT);
  bf16_t* WpqT = (bf16_t*)(ws + WS_WPQ);
  bf16_t* EU = (bf16_t*)(ws + WS_EU);
  bf16_t* EV = (bf16_t*)(ws + WS_EV);
  bf16_t* SK1b = (bf16_t*)(ws + WS_SK1);
  bf16_t* SK2b = (bf16_t*)(ws + WS_SK2);
  bf16_t* A1 = (bf16_t*)(ws + WS_A1);
  float* GO = (float*)(ws + WS_A1);
  bf16_t* A2 = (bf16_t*)(ws + WS_A1);
  InProjOut O;
  O.QSB = (bf16_t*)(ws + WS_QSB); O.KSB = (bf16_t*)(ws + WS_KSB); O.VTSB = (bf16_t*)(ws + WS_VTSB); O.VSB = (bf16_t*)(ws + WS_VSB);
  O.GQ = (bf16_t*)(ws + WS_GQ); O.GK = (bf16_t*)(ws + WS_GK); O.GV = (bf16_t*)(ws + WS_GV); O.GR = (bf16_t*)(ws + WS_GR);
  O.GLR = (float*)(ws + WS_GLR);
  float* H1 = (float*)(ws + WS_H1);
  bf16_t* GVT = (bf16_t*)(ws + WS_GVT);
  GlaPtrs GP;
  GP.GQ = O.GQ; GP.GK = O.GK; GP.GVT = GVT; GP.GR = O.GR; GP.GLR = O.GLR; GP.wg = p.wg; GP.bg = p.bg; GP.gla_g = p.gla_g;
  GP.SLOC = (float*)(ws + WS_SLOC); GP.DTOT = (float*)(ws + WS_DTOT); GP.MIX = (bf16_t*)(ws + WS_MIX);
  bf16_t* MIX = (bf16_t*)(ws + WS_MIX);
  bf16_t* QP = (bf16_t*)(ws + WS_MIX);
  unsigned short* EIDX = (unsigned short*)(ws + WS_EIDX);
  bf16_t* PP = (bf16_t*)(ws + WS_PP);
  float* YT = (float*)(ws + WS_PP);
  unsigned* STREAM = (unsigned*)(ws + WS_STREAM);
  float* GATE = (float*)(ws + WS_GATE);

  for (int vb = bid; vb < 3328 + 1024 + 1024; vb += G) {
    if (vb < 3328) ph_transpose_w(vb % 104, vb / 104, smem, p.w_in, p.norm1_g, WinT, D, NIN);
    else if (vb < 4352) { const int t = vb - 3328; ph_transpose_w(t % 32, t / 32, smem, p.w_out, nullptr, WoutT, D, D); }
    else { const int t = vb - 4352; ph_transpose_w(t % 32, t / 32, smem, p.w_pq, nullptr, WpqT, D, D); }
  }
  ph_convert_eu_i8(p.eu, (u8_t*)EU, (float*)(ws + WS_SCU));
  for (int vb = bid; vb < NEXP / 32; vb += G) ph_convert_ev8(vb, smem, p.ev, (u8_t*)EV, (float*)(ws + WS_SCV));
  ph_convert(p.sk1, SK1b, (size_t)8 * 128 * 64 / 8);
  ph_convert(p.sk2, SK2b, (size_t)8 * 128 * 64 / 8);
  ph_zero_pads(O.KSB, O.VSB, O.GQ, O.GK, O.GV);
  for (int vb = bid; vb < TREAL / 16; vb += G) ph_norm_rows<0>(vb, p.x, p.meta, A1);
  __syncthreads();
  for (int mb = blockIdx.x; mb < NIN / 16; mb += gridDim.x) ph_meta(mb, smem_dyn, p.meta, p.norm1_g, p.w_in, O);
  xcd_barrier(bar);
  {
    pg8::Gemm g{A1, WinT, TREAL, NINP, D}; pg8::StaticOrder S; S.init(TREAL, NINP, (int)gridDim.x, (int)blockIdx.x);
    EpiInProj E{O};
    pg8::gemm_phase<EpiInProj, pg8::StaticOrder, true, true>((PG8_LAS unsigned char*)smem_dyn, g, S, E);
  }
  xcd_barrier(bar);
  for (int vb = bid; vb < 64 * 257; vb += G) ph_vtrans(vb, smem, O.VSB, O.VTSB);
  for (int vb = bid; vb < 32 * 258 * 2; vb += G) ph_gvtrans(vb, smem, O.GV, GVT);
  xcd_barrier(bar);
  for (int it = blockIdx.x; it < 32 * 15; it += gridDim.x) gla_item<0>(it / 15, it % 15, smem_dyn, GP);
  for (int vb = bid; vb < 64 * 64; vb += G) ph_sb_attn(vb, O.QSB, O.KSB, O.VTSB, p.sb_g, MIX);
  xcd_barrier(bar);
  for (int it = blockIdx.x; it < 32 * 16; it += gridDim.x) gla_item<1>(it >> 4, it & 15, smem_dyn, GP);
  xcd_barrier(bar);
  {
    pg8::Gemm g{MIX, WoutT, TREAL, D, D}; pg8::StaticOrder S; S.init(TREAL, D, (int)gridDim.x, (int)blockIdx.x);
    EpiOut E{p.x, H1};
    pg8::gemm_phase<EpiOut, pg8::StaticOrder, true, true>((PG8_LAS unsigned char*)smem_dyn, g, S, E);
  }
  xcd_barrier(bar);
  for (int vb = bid; vb < TREAL / 16; vb += G) ph_norm2_rows(vb, H1, p.norm2_g, A2, (u8_t*)(ws + WS_XQ), (float*)(ws + WS_XS));
  xcd_barrier(bar);
  {
    pg8::Gemm g{A2, WpqT, TREAL, D, D}; pg8::StaticOrder S; S.init(TREAL, D, (int)gridDim.x, (int)blockIdx.x);
    EpiPQ E{QP};
    pg8::gemm_phase<EpiPQ, pg8::StaticOrder, true, true>((PG8_LAS unsigned char*)smem_dyn, g, S, E);
  }
  xcd_barrier(bar);
  for (int vb = bid; vb < 8 * (TREAL / 128); vb += G) ph_route_v2(vb, smem, QP, SK1b, SK2b, EIDX, GATE);
  xcd_barrier(bar);
  {
    __shared__ int xinfo[4];
    if (threadIdx.x == 0) {
      unsigned* barw = (unsigned*)(p.ws + WS_BAR);
      unsigned cnt = 0, ord = 0, mine = 1;
      for (unsigned j = 0; j < 16; ++j) { const unsigned c = xb_ld(&barw[XB_XCNT(j)]); if (c > 0) { if (j < bar.x) ++ord; ++cnt; } if (j == bar.x) mine = c; }
      xinfo[0] = (int)ord; xinfo[1] = (int)cnt; xinfo[2] = (int)xb_words[2]; xinfo[3] = (int)mine;
    }
    __syncthreads();
    const int xi = xinfo[0], nx = xinfo[1], rank = xinfo[2], nloc = xinfo[3];
    const int wave = __builtin_amdgcn_readfirstlane((int)(threadIdx.x >> 6));
    ph_peer_u_d4(xi, nx, rank * 8 + wave, nloc * 8, (const u8_t*)(ws + WS_XQ), (const float*)(ws + WS_XS), (const u8_t*)EU, EIDX, PP);
  }
  xcd_barrier(bar);
  ph_peer_c8(PP, EIDX, GATE, (const float*)(ws + WS_SCU), (const float*)(ws + WS_SCV), STREAM);
  xcd_barrier(bar);
  ph_peer_v8(smem_dyn, STREAM, (const u8_t*)EV, YT);
  xcd_barrier(bar);
  for (int unit = blockIdx.x; unit < TREAL / 32; unit += gridDim.x) ph_final_lds(unit, smem_dyn, H1, YT, p.gf, p.out);
}

extern "C" void kernel_launch(void* const* d_in, const int* in_sizes, int n_in, void* d_out, int out_size, void* d_ws, size_t ws_size, hipStream_t stream) {
  static int grid = 0;
  if (grid == 0) {
    int dev = 0, cus = 0, per_cu = 0;
    hipGetDevice(&dev);
    hipDeviceGetAttribute(&cus, hipDeviceAttributeMultiprocessorCount, dev);
    hipFuncSetAttribute((const void*)k_fused, hipFuncAttributeMaxDynamicSharedMemorySize, SMEM_BYTES);
    hipOccupancyMaxActiveBlocksPerMultiprocessor(&per_cu, (const void*)k_fused, 512, SMEM_BYTES);
    if (per_cu > 1) per_cu = 1;
    if (per_cu < 1) per_cu = 1;
    grid = cus * per_cu;
  }
  hipMemsetAsync((char*)d_ws + WS_BAR, 0, 32768, stream);
  Params p{};
  p.x = (const float*)d_in[0]; p.meta = (const float*)d_in[1]; p.norm1_g = (const float*)d_in[2]; p.w_in = (const float*)d_in[3];
  p.wg = (const float*)d_in[4]; p.bg = (const float*)d_in[5]; p.sb_g = (const float*)d_in[6]; p.gla_g = (const float*)d_in[7];
  p.w_out = (const float*)d_in[8]; p.norm2_g = (const float*)d_in[9]; p.w_pq = (const float*)d_in[10]; p.sk1 = (const float*)d_in[11];
  p.sk2 = (const float*)d_in[12]; p.eu = (const float*)d_in[13]; p.ev = (const float*)d_in[14]; p.gf = (const float*)d_in[15];
  p.out = (float*)d_out; p.ws = (char*)d_ws;
  void* args[] = {&p};
  hipLaunchCooperativeKernel((const void*)k_fused, dim3(grid), dim3(512), args, SMEM_BYTES, stream);
}
```

```cpp
#include <hip/hip_runtime.h>
#include <stdint.h>
#include <stddef.h>

typedef unsigned short bf16_t;
typedef short bf16x8 __attribute__((ext_vector_type(8)));
typedef float f32x16 __attribute__((ext_vector_type(16)));
typedef float f32x4 __attribute__((ext_vector_type(4)));
typedef float f32x2 __attribute__((ext_vector_type(2)));
typedef unsigned u32x4 __attribute__((ext_vector_type(4)));
typedef unsigned u32x2 __attribute__((ext_vector_type(2)));
typedef __bf16 bf16x2_t __attribute__((ext_vector_type(2)));

#define DI __device__ __forceinline__
__device__ __forceinline__ int fresh_tid() { int t = (int)threadIdx.x; asm volatile("" : "+v"(t)); return t; }
#define TID tid256_
#define MFMA32(a, b, c) __builtin_amdgcn_mfma_f32_32x32x16_bf16((a), (b), (c), 0, 0, 0)

constexpr int D = 1024, NB = 8, SEQ = 8192, NMETA = 16;
constexpr int TREAL = NB * SEQ;
constexpr int MROWS = TREAL + 128;
constexpr int NIN = 3088, NINP = 3328;
constexpr int SBH = 8, SBD = 64;
constexpr int GH = 4, GDK = 64, GDV = 128;
constexpr int KIDX = SEQ + 32;
constexpr int GU = SEQ + 64;
constexpr int NEXP = 16384;
constexpr float EPS = 1e-6f;

constexpr size_t MiB = 1u << 20;
constexpr size_t WS_WIN = 1 * MiB;
constexpr size_t WS_WOUT = 8 * MiB;
constexpr size_t WS_WPQ = 10 * MiB;
constexpr size_t WS_SK1 = 12 * MiB;
constexpr size_t WS_SK2 = 13 * MiB;
constexpr size_t WS_EU = 16 * MiB;
constexpr size_t WS_EV = 48 * MiB;
constexpr size_t WS_A1 = 80 * MiB;
constexpr size_t WS_QSB = 210 * MiB;
constexpr size_t WS_KSB = 274 * MiB;
constexpr size_t WS_VTSB = 339 * MiB;
constexpr size_t WS_GQ = 404 * MiB;
constexpr size_t WS_GK = 437 * MiB;
constexpr size_t WS_H1 = 210 * MiB;
constexpr size_t WS_GV = 470 * MiB;
constexpr size_t WS_GR = 535 * MiB;
constexpr size_t WS_GLR = 599 * MiB;
constexpr size_t WS_LG = 604 * MiB;
constexpr size_t WS_MIX = 669 * MiB;
constexpr size_t WS_EIDX = 797 * MiB;
constexpr size_t WS_GATE = 829 * MiB;
constexpr size_t WS_PP = 470 * MiB;
constexpr size_t WS_STREAM = 726 * MiB;
constexpr size_t WS_XRANK = 16384;
constexpr size_t WS_VSB = 861 * MiB;
constexpr size_t WS_END = 926 * MiB;

DI unsigned f2bf(float f) { unsigned u = __float_as_uint(f); return (u + 0x7fffu + ((u >> 16) & 1u)) >> 16; }
DI float bf2f(unsigned b) { return __uint_as_float(b << 16); }
DI unsigned pk2(float lo, float hi) { f32x2 v = {lo, hi}; return __builtin_bit_cast(unsigned, __builtin_convertvector(v, bf16x2_t)); }
DI float bflo(unsigned u) { return __uint_as_float(u << 16); }
DI float bfhi(unsigned u) { return __uint_as_float(u & 0xffff0000u); }
DI int crow(int reg, int h) { return (reg & 3) + 8 * (reg >> 2) + 4 * h; }
DI float wave_sum(float v) {
#pragma unroll
  for (int o = 32; o >= 1; o >>= 1) v += __shfl_xor(v, o);
  return v;
}
DI float dot2bf(unsigned a, unsigned b, float acc) { return __builtin_amdgcn_fdot2_f32_bf16(__builtin_bit_cast(bf16x2_t, a), __builtin_bit_cast(bf16x2_t, b), acc, false); }
DI float softplus(float z) { return fmaxf(z, 0.f) + __logf(1.f + __expf(-fabsf(z))); }

DI void ph_transpose_w(int bx, int by, char* smem, const float* __restrict__ W, const float* __restrict__ gain, bf16_t* __restrict__ WT, int K, int N) {
  const int tid256_ = fresh_tid() & 255;
  float (*t)[33] = (float (*)[33])smem;
  const int n0 = bx * 32, k0 = by * 32, tx = TID & 31, ty = TID >> 5;
  for (int r = ty; r < 32; r += 8) {
    const int k = k0 + r, n = n0 + tx;
    float v = 0.f;
    if (n < N) { v = W[(size_t)k * N + n]; if (gain) v *= gain[k]; }
    t[r][tx] = v;
  }
  __syncthreads();
  for (int r = ty; r < 32; r += 8) {
    const int n = n0 + r, k = k0 + tx;
    WT[(size_t)n * K + k] = (bf16_t)f2bf(t[tx][r]);
  }
  __syncthreads();
}
DI void ph_convert(const float* __restrict__ src, bf16_t* __restrict__ dst, size_t n8) {
  size_t i = (size_t)blockIdx.x * blockDim.x + threadIdx.x;
  const size_t stride = (size_t)gridDim.x * blockDim.x;
  for (; i < n8; i += stride) {
    const f32x4 a = ((const f32x4*)src)[2 * i], b = ((const f32x4*)src)[2 * i + 1];
    u32x4 o; o.x = pk2(a.x, a.y); o.y = pk2(a.z, a.w); o.z = pk2(b.x, b.y); o.w = pk2(b.z, b.w);
    ((u32x4*)dst)[i] = o;
  }
}
DI void ph_zero_pads(bf16_t* KSB, bf16_t* VTSB, bf16_t* GQ, bf16_t* GK, bf16_t* GV) {
  const int tid = blockIdx.x * blockDim.x + threadIdx.x, nth = gridDim.x * blockDim.x;
  for (int i = tid; i < 64 * 16 * 64; i += nth) { const int bh = i / 1024, r = i % 1024; KSB[(size_t)bh * KIDX * 64 + r] = 0; }
  for (int i = tid; i < 64 * 16 * 64; i += nth) { const int bh = i / 1024, r = i % 1024; VTSB[(size_t)bh * KIDX * 64 + r] = 0; }
  for (int i = tid; i < 32 * 48 * 64; i += nth) { const int bh = i / 3072, r = i % 3072; GQ[(size_t)bh * GU * 64 + r] = 0; GK[(size_t)bh * GU * 64 + r] = 0; }
  for (int i = tid; i < 32 * 48 * 128; i += nth) { const int bh = i / 6144, r = i % 6144; GV[(size_t)bh * GU * 128 + r] = 0; }
}

template <int MODE>
DI void ph_norm_rows(int vb, const float* __restrict__ src, const float* __restrict__ meta, bf16_t* __restrict__ dst) {
  const int tid256_ = fresh_tid() & 255;
  const int row0 = vb * 16 + (TID >> 6) * 4, lane = TID & 63;
  f32x4 v[4][4];
#pragma unroll
  for (int rr = 0; rr < 4; ++rr)
#pragma unroll
    for (int j = 0; j < 4; ++j) v[rr][j] = *(const f32x4*)(src + (size_t)(row0 + rr) * D + j * 256 + lane * 4);
  f32x4 gg[4];
#pragma unroll
  for (int j = 0; j < 4; ++j) { gg[j] = (f32x4){1.f, 1.f, 1.f, 1.f}; if (MODE == 1) gg[j] = *(const f32x4*)(meta + j * 256 + lane * 4); }
#pragma unroll
  for (int rr = 0; rr < 4; ++rr) {
    float ss = 0.f;
#pragma unroll
    for (int j = 0; j < 4; ++j) ss += v[rr][j].x * v[rr][j].x + v[rr][j].y * v[rr][j].y + v[rr][j].z * v[rr][j].z + v[rr][j].w * v[rr][j].w;
    ss = wave_sum(ss);
    const float r = rsqrtf(ss * (1.0f / D) + EPS);
#pragma unroll
    for (int j = 0; j < 4; ++j) {
      u32x2 o; o.x = pk2(v[rr][j].x * r * gg[j].x, v[rr][j].y * r * gg[j].y); o.y = pk2(v[rr][j].z * r * gg[j].z, v[rr][j].w * r * gg[j].w);
      *(u32x2*)(dst + (size_t)(row0 + rr) * D + j * 256 + lane * 4) = o;
    }
  }
}

namespace pg8 {
#define PG8_LAS __attribute__((address_space(3)))
typedef unsigned short bf16_t;
typedef short bf16x8 __attribute__((ext_vector_type(8)));
typedef float f32x4 __attribute__((ext_vector_type(4)));
typedef unsigned u32x4 __attribute__((ext_vector_type(4)));
constexpr int BM = 256, BK = 64, HALF = 128, HTB = HALF * BK * 2  , STAGE_BYTES = 8 * HTB, NXCD = 8, WGM = 8;

__host__ __device__ __forceinline__ int lds_byte(int r, int c) { const int st = (r >> 4) * 2 + (c >> 5), rr = r & 15, cc = c & 31, ob = rr * 64 + cc * 2; return st * 1024 + (ob ^ (((ob >> 9) & 1) << 5)); }
__host__ __device__ __forceinline__ void stage_rc(int b, int& R, int& C) { const int st = b / 1024, sb = b % 1024, swz = sb ^ (((sb >> 9) & 1) << 5); R = (st >> 1) * 16 + swz / 64; C = (st & 1) * 32 + (swz % 64) / 2; }
__host__ __device__ __forceinline__ int perm32(int rho) { const int n = rho >> 4, i = rho & 15; return 8 * (i >> 2) + 4 * n + (i & 3); }

struct Unit { int pm, pn; };
struct Gemm { const bf16_t* A; const bf16_t* Bt; int M, N, K; };

struct StaticOrder {
    int nM, nN, nwg, G, c;
    __host__ __device__ void init(int M, int N, int G_, int c_) { nM = M / BM; nN = N / BM; nwg = nM * nN; G = G_; c = c_; }
    __host__ __device__ bool next(int i, Unit& u) const {
        const long L = (long)i * G + c; if (L >= nwg) return false;
        int wgid = (int)L; { const int q = nwg / NXCD, r = nwg % NXCD, xcd = wgid % NXCD, off = wgid / NXCD; wgid = (xcd < r ? xcd * (q + 1) : r * (q + 1) + (xcd - r) * q) + off; }
        const int nig = WGM * nN, gid = wgid / nig, fm = gid * WGM, gsz = (nM - fm) < WGM ? (nM - fm) : WGM;
        u.pm = fm + ((wgid % nig) % gsz); u.pn = (wgid % nig) / gsz; return true;
    }
    __device__ __forceinline__ void a_ready(const Unit&) const {}
    __device__ __forceinline__ void done(const Unit&) const {}
};

template <class Epi, class Sched, bool ALIGN_EPI = false, bool SP2 = false>
__device__ __forceinline__ void gemm_phase(PG8_LAS unsigned char* lds, const Gemm g, const Sched& S, const Epi& E) {
    const int tid = fresh_tid(), wid = __builtin_amdgcn_readfirstlane(tid >> 6), lane = tid & 63, wr = wid >> 2, wc = wid & 3, fr = lane & 15, fq = lane >> 4;
    const int K = g.K, nt = K / BK;
    unsigned voffA[2], voffB[2];
#pragma unroll
    for (int i = 0; i < 2; ++i) { int R, C; stage_rc(tid * 16 + i * 8192, R, C); const int Rb = Epi::PERM ? ((R & ~31) + perm32(R & 31)) : R;
        voffA[i] = (unsigned)(R * K + C) * 2u; voffB[i] = (unsigned)(Rb * K + C) * 2u; }
    const size_t kstep = (size_t)(BK * 2);
    const size_t hstep = (size_t)HALF * K * 2;
    const size_t tstep = 2 * hstep;
    const unsigned ldsw = (unsigned)wid * 1024u;
    const int aoff = lds_byte(wr * 64 + fr, fq * 8), boff = lds_byte(wc * 32 + fr, fq * 8);
#define PG8_SA(b, h) (((b) * 2 + (h)) * HTB)
#define PG8_SB(b, h) ((4 + (b) * 2 + (h)) * HTB)
#define PG8_STAGE(bufoff, gbase, voff) do { _Pragma("unroll") for (int _i = 0; _i < 2; ++_i) \
        __builtin_amdgcn_global_load_lds((const unsigned*)((const char*)(gbase) + (voff)[_i]), (PG8_LAS unsigned*)(lds + (bufoff) + ldsw + _i * 8192), 16, 0, 0); } while (0)
#define PG8_LDA(dst, b, h) do { _Pragma("unroll") for (int m = 0; m < 4; ++m) _Pragma("unroll") for (int k = 0; k < 2; ++k) dst[m][k] = *(const PG8_LAS bf16x8*)(lds + PG8_SA(b, h) + aoff + m * 2048 + k * 1024); } while (0)
#define PG8_LDB(dst, b, h) do { _Pragma("unroll") for (int n = 0; n < 2; ++n) _Pragma("unroll") for (int k = 0; k < 2; ++k) dst[n][k] = *(const PG8_LAS bf16x8*)(lds + PG8_SB(b, h) + boff + n * 2048 + k * 1024); } while (0)
#define PG8_MMA(ai, bj, At, Bt) do { __builtin_amdgcn_s_setprio(1); _Pragma("unroll") for (int m = 0; m < 4; ++m) _Pragma("unroll") for (int n = 0; n < 2; ++n) _Pragma("unroll") for (int k = 0; k < 2; ++k) \
        acc[ai][bj][m][n] = __builtin_amdgcn_mfma_f32_16x16x32_bf16(Bt[n][k], At[m][k], acc[ai][bj][m][n], 0, 0, 0); __builtin_amdgcn_s_setprio(0); } while (0)
#define PG8_WAIT_V(n) asm volatile("s_waitcnt vmcnt(" #n ")" ::: "memory")
#define PG8_WAIT_L(n) asm volatile("s_waitcnt lgkmcnt(" #n ")" ::: "memory")
#define PG8_BAR __builtin_amdgcn_s_barrier()
#define PG8_SCHED __builtin_amdgcn_sched_barrier(0)
    Unit cur, nxt; int ui = 0;
    if (!S.next(0, cur)) return;
    f32x4 acc[2][2][4][2];
#pragma unroll
    for (int a = 0; a < 2; ++a)
#pragma unroll
        for (int b = 0; b < 2; ++b)
#pragma unroll
            for (int m = 0; m < 4; ++m)
#pragma unroll
                for (int n = 0; n < 2; ++n) acc[a][b][m][n] = (f32x4){0.f, 0.f, 0.f, 0.f};
    bf16x8 At[4][2], B0[2][2], B1[2][2];
    const char* cA = (const char*)g.A + (size_t)cur.pm * tstep; const char* cB = (const char*)g.Bt + (size_t)cur.pn * tstep;
    S.a_ready(cur);
    if constexpr (SP2) {
        PG8_STAGE(PG8_SB(0, 0), cB, voffB); PG8_STAGE(PG8_SB(0, 1), cB + hstep, voffB); PG8_STAGE(PG8_SA(0, 0), cA, voffA); PG8_STAGE(PG8_SA(0, 1), cA + hstep, voffA);
        if (wr == 1) PG8_BAR;
        PG8_WAIT_V(2); PG8_BAR;
        PG8_STAGE(PG8_SB(1, 0), cB + kstep, voffB); PG8_STAGE(PG8_SA(1, 0), cA + kstep, voffA); PG8_STAGE(PG8_SB(1, 1), cB + hstep + kstep, voffB);
        PG8_WAIT_V(6); PG8_BAR;
    } else {
        PG8_STAGE(PG8_SB(0, 0), cB, voffB); PG8_STAGE(PG8_SA(0, 0), cA, voffA); PG8_STAGE(PG8_SB(0, 1), cB + hstep, voffB); PG8_STAGE(PG8_SA(0, 1), cA + hstep, voffA);
        if (wr == 1) PG8_BAR;
        PG8_WAIT_V(4); PG8_BAR;
        PG8_STAGE(PG8_SB(1, 0), cB + kstep, voffB); PG8_STAGE(PG8_SA(1, 0), cA + kstep, voffA); PG8_STAGE(PG8_SB(1, 1), cB + hstep + kstep, voffB);
        PG8_WAIT_V(6); PG8_BAR;
    }
    for (;;) {
        const bool has_next = S.next(ui + 1, nxt);
        const char* nA = has_next ? (const char*)g.A + (size_t)nxt.pm * tstep : cA; const char* nB = has_next ? (const char*)g.Bt + (size_t)nxt.pn * tstep : cB;
        for (int t = 0; t < nt; t += 2) {
            const bool last = (t == nt - 2);
            const char* a1 = cA + (size_t)(t + 1) * kstep;
            const char* a2 = last ? nA : cA + (size_t)(t + 2) * kstep; const char* b2 = last ? nB : cB + (size_t)(t + 2) * kstep;
            const char* a3 = a2 + kstep; const char* b3 = b2 + kstep;
            if (last && has_next) S.a_ready(nxt);
            if constexpr (SP2) {
            PG8_LDB(B0, 0, 0); PG8_LDB(B1, 0, 1); PG8_SCHED; PG8_LDA(At, 0, 0); PG8_STAGE(PG8_SA(1, 1), a1 + hstep, voffA);
            PG8_WAIT_V(8); PG8_WAIT_L(0); PG8_BAR; PG8_MMA(0, 0, At, B0); PG8_MMA(0, 1, At, B1); PG8_BAR; PG8_SCHED;
            PG8_LDA(At, 0, 1); PG8_STAGE(PG8_SB(0, 0), b2, voffB); PG8_STAGE(PG8_SB(0, 1), b2 + hstep, voffB); PG8_STAGE(PG8_SA(0, 0), a2, voffA);
            PG8_WAIT_V(8); PG8_WAIT_L(0); PG8_BAR; PG8_MMA(1, 0, At, B0); PG8_MMA(1, 1, At, B1); PG8_BAR; PG8_SCHED;
            PG8_LDB(B0, 1, 0); PG8_LDB(B1, 1, 1); PG8_SCHED; PG8_LDA(At, 1, 0); PG8_STAGE(PG8_SA(0, 1), a2 + hstep, voffA);
            PG8_WAIT_V(8); PG8_WAIT_L(0); PG8_BAR; PG8_MMA(0, 0, At, B0); PG8_MMA(0, 1, At, B1); PG8_BAR; PG8_SCHED;
            PG8_LDA(At, 1, 1); PG8_STAGE(PG8_SB(1, 0), b3, voffB); PG8_STAGE(PG8_SB(1, 1), b3 + hstep, voffB); PG8_STAGE(PG8_SA(1, 0), a3, voffA);
            PG8_WAIT_V(8); PG8_WAIT_L(0); PG8_BAR; PG8_MMA(1, 0, At, B0); PG8_MMA(1, 1, At, B1); PG8_BAR; PG8_SCHED;
            } else {
            PG8_LDB(B0, 0, 0); PG8_SCHED; PG8_LDA(At, 0, 0); PG8_STAGE(PG8_SA(1, 1), a1 + hstep, voffA);
            PG8_WAIT_L(8); PG8_BAR; PG8_WAIT_L(0); PG8_MMA(0, 0, At, B0); PG8_BAR; PG8_SCHED;
            PG8_LDB(B1, 0, 1); PG8_STAGE(PG8_SB(0, 0), b2, voffB);
            PG8_BAR; PG8_WAIT_L(0); PG8_MMA(0, 1, At, B1); PG8_BAR;
            PG8_LDA(At, 0, 1); PG8_STAGE(PG8_SA(0, 0), a2, voffA);
            PG8_BAR; PG8_WAIT_L(0); PG8_MMA(1, 0, At, B0); PG8_BAR; PG8_SCHED;
            PG8_STAGE(PG8_SB(0, 1), b2 + hstep, voffB);
            PG8_WAIT_V(6); PG8_BAR; PG8_MMA(1, 1, At, B1); PG8_BAR;
            PG8_LDB(B0, 1, 0); PG8_SCHED; PG8_LDA(At, 1, 0); PG8_STAGE(PG8_SA(0, 1), a2 + hstep, voffA);
            PG8_WAIT_L(8); PG8_BAR; PG8_WAIT_L(0); PG8_MMA(0, 0, At, B0); PG8_BAR; PG8_SCHED;
            PG8_LDB(B1, 1, 1); PG8_STAGE(PG8_SB(1, 0), b3, voffB);
            PG8_BAR; PG8_WAIT_L(0); PG8_MMA(0, 1, At, B1); PG8_BAR;
            PG8_LDA(At, 1, 1); PG8_STAGE(PG8_SA(1, 0), a3, voffA);
            PG8_BAR; PG8_WAIT_L(0); PG8_MMA(1, 0, At, B0); PG8_BAR; PG8_SCHED;
            PG8_STAGE(PG8_SB(1, 1), b3 + hstep, voffB);
            PG8_WAIT_V(6); PG8_BAR; PG8_MMA(1, 1, At, B1); PG8_BAR;
            }
        }
        if constexpr (ALIGN_EPI) { if (wr == 0) PG8_BAR; }
        if constexpr (!Epi::AFTER_DRAIN) { E(acc, cur, wr, wc, fr, fq); S.done(cur); }
        if (!has_next) break;
#pragma unroll
        for (int a = 0; a < 2; ++a)
#pragma unroll
            for (int b = 0; b < 2; ++b)
#pragma unroll
                for (int m = 0; m < 4; ++m)
#pragma unroll
                    for (int n = 0; n < 2; ++n) acc[a][b][m][n] = (f32x4){0.f, 0.f, 0.f, 0.f};
        cur = nxt; cA = nA; cB = nB; ++ui;
        if constexpr (ALIGN_EPI) { if (wr == 1) PG8_BAR; }
    }
    PG8_WAIT_V(0);
    if constexpr (!ALIGN_EPI) { if (wr == 0) PG8_BAR; }
    PG8_BAR;
    if constexpr (Epi::AFTER_DRAIN) { E.fused(acc, cur, wr, wc, fr, fq, lds, wid, lane); S.done(cur); }
#undef PG8_SA
#undef PG8_SB
#undef PG8_STAGE
#undef PG8_LDA
#undef PG8_LDB
#undef PG8_MMA
#undef PG8_WAIT_V
#undef PG8_WAIT_L
#undef PG8_BAR
#undef PG8_SCHED
}
}

struct InProjOut { bf16_t *QSB, *KSB, *VSB, *VTSB, *GQ, *GK, *GV, *GR; float* GLR; };

struct EpiInProj {
  static constexpr bool PERM = true, AFTER_DRAIN = false;
  InProjOut O;
  DI void operator()(const pg8::f32x4 (&acc)[2][2][4][2], const pg8::Unit& u, int wr, int wc, int fr, int fq) const {
    const int pn = u.pn;
#pragma unroll
    for (int ai = 0; ai < 2; ++ai)
#pragma unroll
      for (int m = 0; m < 4; ++m) {
        const int row = u.pm * 256 + ai * 128 + wr * 64 + m * 16 + fr;
        const int b = row >> 13, i = row & 8191;
#pragma unroll
        for (int bj = 0; bj < 2; ++bj) {
          const int col = pn * 256 + bj * 128 + wc * 32 + 8 * fq;
          const pg8::f32x4 v0 = acc[ai][bj][m][0], v1 = acc[ai][bj][m][1];
          if (pn < 12) {
            u32x4 w; w.x = pk2(v0[0], v0[1]); w.y = pk2(v0[2], v0[3]); w.z = pk2(v1[0], v1[1]); w.w = pk2(v1[2], v1[3]);
            bf16_t* dst;
            if (pn < 2)       { const int c = col;        dst = O.QSB + ((size_t)(b * SBH + (c >> 6)) * SEQ + i) * 64 + (c & 63); }
            else if (pn < 4)  { const int c = col - 512;  dst = O.KSB + ((size_t)(b * SBH + (c >> 6)) * KIDX + 32 + i) * 64 + (c & 63); }
            else if (pn < 6)  { const int c = col - 1024; dst = O.VSB + ((size_t)(b * SBH + (c >> 6)) * KIDX + 32 + i) * 64 + (c & 63); }
            else if (pn == 6) { const int c = col - 1536; dst = O.GQ + ((size_t)(b * GH + (c >> 6)) * GU + 64 + i) * 64 + (c & 63); }
            else if (pn == 7) { const int c = col - 1792; dst = O.GK + ((size_t)(b * GH + (c >> 6)) * GU + 64 + i) * 64 + (c & 63); }
            else if (pn < 10) { const int c = col - 2048; dst = O.GV + ((size_t)(b * GH + (c >> 7)) * GU + 64 + i) * 128 + (c & 127); }
            else              { const int c = col - 2560; dst = O.GR + (size_t)row * 512 + c; }
            *(u32x4*)dst = w;
          } else if (col < NIN) {
            float* dst = O.GLR + ((size_t)b * GU + 64 + i) * 16 + (col - 3072);
            *(f32x4*)dst = (f32x4){v0[0], v0[1], v0[2], v0[3]};
            *(f32x4*)(dst + 4) = (f32x4){v1[0], v1[1], v1[2], v1[3]};
          }
        }
      }
  }
};
struct EpiOut {
  static constexpr bool PERM = true, AFTER_DRAIN = false;
  const float* x; bf16_t* H1;
  DI void operator()(const pg8::f32x4 (&acc)[2][2][4][2], const pg8::Unit& u, int wr, int wc, int fr, int fq) const {
#pragma unroll
    for (int ai = 0; ai < 2; ++ai)
#pragma unroll
      for (int m = 0; m < 4; ++m) {
        const size_t rowoff = (size_t)(u.pm * 256 + ai * 128 + wr * 64 + m * 16 + fr) * D;
#pragma unroll
        for (int bj = 0; bj < 2; ++bj) {
          const size_t idx = rowoff + u.pn * 256 + bj * 128 + wc * 32 + 8 * fq;
          const f32x4 x0 = *(const f32x4*)(x + idx), x1 = *(const f32x4*)(x + idx + 4);
          const pg8::f32x4 v0 = acc[ai][bj][m][0], v1 = acc[ai][bj][m][1];
          u32x4 w; w.x = pk2(x0.x + v0[0], x0.y + v0[1]); w.y = pk2(x0.z + v0[2], x0.w + v0[3]); w.z = pk2(x1.x + v1[0], x1.y + v1[1]); w.w = pk2(x1.z + v1[2], x1.w + v1[3]);
          *(u32x4*)(H1 + idx) = w;
        }
      }
  }
};
struct EpiPQ {
  static constexpr bool PERM = true, AFTER_DRAIN = false;
  bf16_t* QP; const float* R2;
  DI void operator()(const pg8::f32x4 (&acc)[2][2][4][2], const pg8::Unit& u, int wr, int wc, int fr, int fq) const {
#pragma unroll
    for (int ai = 0; ai < 2; ++ai)
#pragma unroll
      for (int m = 0; m < 4; ++m) {
        const int row = u.pm * 256 + ai * 128 + wr * 64 + m * 16 + fr;
        const float r = R2[row];
        const size_t rowoff = (size_t)row * D;
#pragma unroll
        for (int bj = 0; bj < 2; ++bj) {
          const pg8::f32x4 v0 = acc[ai][bj][m][0], v1 = acc[ai][bj][m][1];
          u32x4 w; w.x = pk2(v0[0] * r, v0[1] * r); w.y = pk2(v0[2] * r, v0[3] * r); w.z = pk2(v1[0] * r, v1[1] * r); w.w = pk2(v1[2] * r, v1[3] * r);
          *(u32x4*)(QP + rowoff + u.pn * 256 + bj * 128 + wc * 32 + 8 * fq) = w;
        }
      }
  }
};

DI void ph_meta(int blk, char* smem, const float* __restrict__ meta, const float* __restrict__ g1, const float* __restrict__ w_in, const InProjOut& O) {
  float (*xmT)[16] = (float (*)[16])smem;
  float (*red)[256] = (float (*)[256])(smem + 65536);
  const int tid = fresh_tid(), lane = tid & 63, wave = tid >> 6;
  for (int rr = 0; rr < 2; ++rr) {
    const int mm = wave * 2 + rr;
    float v[16]; float ss = 0.f;
#pragma unroll
    for (int j = 0; j < 16; ++j) { v[j] = meta[(size_t)mm * D + j * 64 + lane]; ss += v[j] * v[j]; }
    ss = wave_sum(ss);
    const float r = rsqrtf(ss * (1.0f / D) + EPS);
#pragma unroll
    for (int j = 0; j < 16; ++j) xmT[j * 64 + lane][mm] = v[j] * r * g1[j * 64 + lane];
  }
  __syncthreads();
  {
    const int c = tid & 15, ks = tid >> 4, n = blk * 16 + c;
    float acc[16];
#pragma unroll
    for (int j = 0; j < 16; ++j) acc[j] = 0.f;
#pragma unroll 8
    for (int kk = 0; kk < 32; ++kk) {
      const int k = ks * 32 + kk;
      const float w = w_in[(size_t)k * NIN + n];
      const f32x4 a = *(const f32x4*)&xmT[k][0], b4 = *(const f32x4*)&xmT[k][4], c4 = *(const f32x4*)&xmT[k][8], d4 = *(const f32x4*)&xmT[k][12];
      acc[0] += a.x * w; acc[1] += a.y * w; acc[2] += a.z * w; acc[3] += a.w * w;
      acc[4] += b4.x * w; acc[5] += b4.y * w; acc[6] += b4.z * w; acc[7] += b4.w * w;
      acc[8] += c4.x * w; acc[9] += c4.y * w; acc[10] += c4.z * w; acc[11] += c4.w * w;
      acc[12] += d4.x * w; acc[13] += d4.y * w; acc[14] += d4.z * w; acc[15] += d4.w * w;
    }
#pragma unroll
    for (int mm = 0; mm < 16; ++mm) red[ks][c * 16 + mm] = acc[mm];
  }
  __syncthreads();
  if (tid < 256) {
    const int c = tid >> 4, mm = tid & 15, n = blk * 16 + c;
    float val = 0.f;
#pragma unroll 8
    for (int ks = 0; ks < 32; ++ks) val += red[ks][tid];
    const bf16_t hv = (bf16_t)f2bf(val);
    for (int bb = 0; bb < NB; ++bb) {
      if (n < 512) {}
      else if (n < 1024) { const int cc = n - 512;  O.KSB[((size_t)(bb * SBH + (cc >> 6)) * KIDX + 16 + mm) * 64 + (cc & 63)] = hv; }
      else if (n < 1536) { const int cc = n - 1024; O.VSB[((size_t)(bb * SBH + (cc >> 6)) * KIDX + 16 + mm) * 64 + (cc & 63)] = hv; }
      else if (n < 1792) { const int cc = n - 1536; O.GQ[((size_t)(bb * GH + (cc >> 6)) * GU + 48 + mm) * 64 + (cc & 63)] = hv; }
      else if (n < 2048) { const int cc = n - 1792; O.GK[((size_t)(bb * GH + (cc >> 6)) * GU + 48 + mm) * 64 + (cc & 63)] = hv; }
      else if (n < 2560) { const int cc = n - 2048; O.GV[((size_t)(bb * GH + (cc >> 7)) * GU + 48 + mm) * 128 + (cc & 127)] = hv; }
      else if (n < 3072) {}
      else { O.GLR[((size_t)bb * GU + 48 + mm) * 16 + (n - 3072)] = val; }
    }
  }
  __syncthreads();
}

DI void ph_vtrans(int vb, char* smem, const bf16_t* __restrict__ VSB, bf16_t* __restrict__ VTSB) {
  const int tid256_ = fresh_tid() & 255;
  bf16_t (*t)[66] = (bf16_t (*)[66])smem;
  const int tid = TID;
  const int bh = vb / 257, it = vb % 257, idx0 = it * 32;
  {
    const int row = tid >> 3, c8 = tid & 7;
    const u32x4 v = *(const u32x4*)(VSB + ((size_t)bh * KIDX + idx0 + row) * 64 + c8 * 8);
    unsigned* tp = (unsigned*)&t[row][c8 * 8];
    tp[0] = v.x; tp[1] = v.y; tp[2] = v.z; tp[3] = v.w;
  }
  __syncthreads();
  {
    const int d = tid >> 2, i4 = tid & 3;
    unsigned w[4];
#pragma unroll
    for (int j = 0; j < 4; ++j) w[j] = (unsigned)t[i4 * 8 + 2 * j][d] | ((unsigned)t[i4 * 8 + 2 * j + 1][d] << 16);
    *(u32x4*)(VTSB + ((size_t)bh * 64 + d) * KIDX + idx0 + i4 * 8) = (u32x4){w[0], w[1], w[2], w[3]};
  }
  __syncthreads();
}

constexpr float SB_THR = -90.f;
DI void ph_sb_attn(int vb, const bf16_t* __restrict__ QSB, const bf16_t* __restrict__ KSB, const bf16_t* __restrict__ VTSB,
                                                 const float* __restrict__ sb_g, bf16_t* __restrict__ MIX) {
  const int tid256_ = fresh_tid() & 255;
  const int lane = TID & 63, wave = TID >> 6, r = lane & 31, h = lane >> 5;
  const int bh = vb >> 6, qb = vb & 63;
  const int b = bh >> 3, hd = bh & 7;
  const int i0 = qb * 128 + wave * 32;
  const bf16_t* Qb = QSB + ((size_t)bh * SEQ + i0) * 64;
  const bf16_t* Kb = KSB + (size_t)bh * KIDX * 64;
  const bf16_t* Vb = VTSB + (size_t)bh * 64 * KIDX;
  bf16x8 qf[4];
#pragma unroll
  for (int ks = 0; ks < 4; ++ks) qf[ks] = *(const bf16x8*)(Qb + r * 64 + ks * 16 + h * 8);
  f32x16 o[2];
#pragma unroll
  for (int e = 0; e < 16; ++e) { o[0][e] = 0.f; o[1][e] = 0.f; }
  float R = 0.f;
  const int qidx = 32 + i0 + r;
  for (int c = (i0 >> 5) + 1; c >= 0; --c) {
    const int k0 = 32 * c;
    bf16x8 kf[4];
#pragma unroll
    for (int ks = 0; ks < 4; ++ks) kf[ks] = *(const bf16x8*)(Kb + (size_t)(k0 + r) * 64 + ks * 16 + h * 8);
    bf16x8 vf[2][2];
#pragma unroll
    for (int mt = 0; mt < 2; ++mt)
#pragma unroll
      for (int s2 = 0; s2 < 2; ++s2) {
        const bf16_t* vp = Vb + (size_t)(mt * 32 + r) * KIDX + k0 + 16 * s2 + 4 * h;
        const u32x2 lo = *(const u32x2*)vp, hi = *(const u32x2*)(vp + 8);
        u32x4 t; t.x = lo.x; t.y = lo.y; t.z = hi.x; t.w = hi.y;
        vf[mt][s2] = __builtin_bit_cast(bf16x8, t);
      }
    f32x16 s;
#pragma unroll
    for (int e = 0; e < 16; ++e) s[e] = 0.f;
#pragma unroll
    for (int ks = 0; ks < 4; ++ks) s = MFMA32(kf[ks], qf[ks], s);
    float l1m[16], lb[16];
    bool valid[16];
#pragma unroll
    for (int e = 0; e < 16; ++e) {
      const int kidx = k0 + crow(e, h);
      valid[e] = (kidx < qidx) && (kidx >= 16);
      const float z = s[e] * 0.125f;
      const float sp = softplus(z);
      l1m[e] = valid[e] ? -sp : 0.f;
      lb[e] = z - sp;
    }
    float sfx[16], G[4], PG[4];
#pragma unroll
    for (int g = 0; g < 4; ++g) {
      sfx[4 * g + 3] = 0.f;
      sfx[4 * g + 2] = l1m[4 * g + 3];
      sfx[4 * g + 1] = sfx[4 * g + 2] + l1m[4 * g + 2];
      sfx[4 * g + 0] = sfx[4 * g + 1] + l1m[4 * g + 1];
      G[g] = sfx[4 * g + 0] + l1m[4 * g + 0];
      PG[g] = __shfl_xor(G[g], 32);
    }
    float HS[4];
    HS[3] = 0.f;
    HS[2] = G[3] + PG[3];
    HS[1] = HS[2] + G[2] + PG[2];
    HS[0] = HS[1] + G[1] + PG[1];
    const float total = HS[0] + G[0] + PG[0];
    float a[16];
#pragma unroll
    for (int e = 0; e < 16; ++e) {
      const int g = e >> 2;
      const float between = sfx[e] + (h == 0 ? PG[g] : 0.f) + HS[g] + R;
      a[e] = valid[e] ? __expf(lb[e] + between) : 0.f;
    }
    R += total;
#pragma unroll
    for (int s2 = 0; s2 < 2; ++s2) {
      u32x4 p;
      p.x = pk2(a[8 * s2 + 0], a[8 * s2 + 1]); p.y = pk2(a[8 * s2 + 2], a[8 * s2 + 3]);
      p.z = pk2(a[8 * s2 + 4], a[8 * s2 + 5]); p.w = pk2(a[8 * s2 + 6], a[8 * s2 + 7]);
      const bf16x8 pf = __builtin_bit_cast(bf16x8, p);
      o[0] = MFMA32(vf[0][s2], pf, o[0]);
      o[1] = MFMA32(vf[1][s2], pf, o[1]);
    }
    if (__all(R < SB_THR)) break;
  }
  float ss = 0.f;
#pragma unroll
  for (int e = 0; e < 16; ++e) ss += o[0][e] * o[0][e] + o[1][e] * o[1][e];
  ss += __shfl_xor(ss, 32);
  const float sc = rsqrtf(ss * (1.0f / 64.0f) + EPS);
  bf16_t* outp = MIX + (size_t)(b * SEQ + i0 + r) * D + hd * 64;
#pragma unroll
  for (int mt = 0; mt < 2; ++mt)
#pragma unroll
    for (int g = 0; g < 4; ++g) {
      const int d = mt * 32 + 8 * g + 4 * h;
      const f32x4 gg = *(const f32x4*)(sb_g + hd * 64 + d);
      u32x2 pk;
      pk.x = pk2(o[mt][4 * g] * sc * gg.x, o[mt][4 * g + 1] * sc * gg.y);
      pk.y = pk2(o[mt][4 * g + 2] * sc * gg.z, o[mt][4 * g + 3] * sc * gg.w);
      *(u32x2*)(outp + d) = pk;
    }
}

DI void ph_lg(int bu, const float* __restrict__ GLR, const float* __restrict__ wg, const float* __restrict__ bg, float* __restrict__ LG) {
  const int tid256_ = fresh_tid() & 255;
  const int c = TID;
  const int b = bu / GU, u = bu % GU;
  float val = 0.f;
  if (u >= 48) {
    float acc = bg[c];
    const float* g = GLR + (size_t)bu * 16;
#pragma unroll
    for (int k = 0; k < 16; ++k) acc += g[k] * wg[k * 256 + c];
    val = -softplus(-acc) * (1.0f / 16.0f);
  }
  const int hd = c >> 6, d = c & 63;
  LG[((size_t)(b * GH + hd) * GU + u) * 64 + d] = val;
}

DI void ph_gla_v1(int vb, char* smem, const bf16_t* __restrict__ GQ, const bf16_t* __restrict__ GK, const bf16_t* __restrict__ GV,
                                                const float* __restrict__ LG, float* __restrict__ GO) {
  const int tid256_ = fresh_tid() & 255;
  float (*qs)[68] = (float (*)[68])smem;
  float (*ks)[68] = (float (*)[68])(smem + 17408);
  float (*bc)[68] = (float (*)[68])(smem + 2 * 17408);
  float (*at)[68] = bc;
  float (*vs)[36] = (float (*)[36])(smem + 3 * 17408);
  float (*Ss)[36] = (float (*)[36])(smem + 3 * 17408 + 9216);
  float* decs = (float*)(smem + 3 * 17408 + 2 * 9216);
  const int tid = TID;
  const int bh = vb >> 2, es = vb & 3, b = bh >> 2, hd = bh & 3;
  const bf16_t* gq = GQ + (size_t)bh * GU * 64;
  const bf16_t* gk = GK + (size_t)bh * GU * 64;
  const bf16_t* gv = GV + (size_t)bh * GU * 128 + es * 32;
  const float* lg = LG + (size_t)bh * GU * 64;
  const int sd = tid >> 2, eg = tid & 3;
  float S[8];
#pragma unroll
  for (int j = 0; j < 8; ++j) S[j] = 0.f;
  for (int c = 0; c < 129; ++c) {
    const int u0 = c * 64;
#pragma unroll 2
    for (int idx = tid; idx < 4096; idx += 256) {
      const int t = idx >> 6, d = idx & 63;
      qs[t][d] = bf2f(gq[(size_t)(u0 + t) * 64 + d]);
      ks[t][d] = bf2f(gk[(size_t)(u0 + t) * 64 + d]);
      bc[t][d] = lg[(size_t)(u0 + t) * 64 + d];
    }
    for (int idx = tid; idx < 2048; idx += 256) {
      const int t = idx >> 5, e = idx & 31;
      vs[t][e] = bf2f(gv[(size_t)(u0 + t) * 128 + e]);
    }
#pragma unroll
    for (int j = 0; j < 8; ++j) Ss[sd][eg * 8 + j] = S[j];
    __syncthreads();
    if (tid < 64) { float run = 0.f;
#pragma unroll 4
      for (int t = 0; t < 64; ++t) { run += bc[t][tid]; bc[t][tid] = run; } }
    __syncthreads();
#pragma unroll 2
    for (int idx = tid; idx < 4096; idx += 256) {
      const int t = idx >> 6, d = idx & 63;
      const float bv = bc[t][d];
      qs[t][d] *= __expf(bv) * 0.125f;
      ks[t][d] *= __expf(-bv);
    }
    if (tid < 64) decs[tid] = __expf(bc[63][tid]);
    __syncthreads();
    {
      const int ti = tid >> 4, si = tid & 15;
      float acc[4][4];
#pragma unroll
      for (int a = 0; a < 4; ++a)
#pragma unroll
        for (int bb = 0; bb < 4; ++bb) acc[a][bb] = 0.f;
#pragma unroll 1
      for (int d = 0; d < 64; d += 4) {
        f32x4 q4[4], k4[4];
#pragma unroll
        for (int a = 0; a < 4; ++a) q4[a] = *(const f32x4*)&qs[ti + 16 * a][d];
#pragma unroll
        for (int bb = 0; bb < 4; ++bb) k4[bb] = *(const f32x4*)&ks[si + 16 * bb][d];
#pragma unroll
        for (int a = 0; a < 4; ++a)
#pragma unroll
          for (int bb = 0; bb < 4; ++bb)
            acc[a][bb] += q4[a].x * k4[bb].x + q4[a].y * k4[bb].y + q4[a].z * k4[bb].z + q4[a].w * k4[bb].w;
      }
#pragma unroll
      for (int a = 0; a < 4; ++a)
#pragma unroll
        for (int bb = 0; bb < 4; ++bb) {
          const int t = ti + 16 * a, s = si + 16 * bb;
          at[t][s] = (s <= t) ? acc[a][bb] : 0.f;
        }
    }
    __syncthreads();
    {
      const int t = sd;
      float o[8];
#pragma unroll
      for (int j = 0; j < 8; ++j) o[j] = 0.f;
#pragma unroll 2
      for (int d = 0; d < 64; ++d) {
        const float qv = qs[t][d];
        const f32x4 s0 = *(const f32x4*)&Ss[d][eg * 8], s1 = *(const f32x4*)&Ss[d][eg * 8 + 4];
        o[0] += qv * s0.x; o[1] += qv * s0.y; o[2] += qv * s0.z; o[3] += qv * s0.w;
        o[4] += qv * s1.x; o[5] += qv * s1.y; o[6] += qv * s1.z; o[7] += qv * s1.w;
      }
#pragma unroll 2
      for (int s = 0; s < 64; ++s) {
        const float av = at[t][s];
        const f32x4 v0 = *(const f32x4*)&vs[s][eg * 8], v1 = *(const f32x4*)&vs[s][eg * 8 + 4];
        o[0] += av * v0.x; o[1] += av * v0.y; o[2] += av * v0.z; o[3] += av * v0.w;
        o[4] += av * v1.x; o[5] += av * v1.y; o[6] += av * v1.z; o[7] += av * v1.w;
      }
      if (c >= 1) {
        float* op = GO + ((size_t)(b * SEQ + (c - 1) * 64 + t)) * 512 + hd * 128 + es * 32 + eg * 8;
        *(f32x4*)op = (f32x4){o[0], o[1], o[2], o[3]};
        *(f32x4*)(op + 4) = (f32x4){o[4], o[5], o[6], o[7]};
      }
    }
    {
      float n[8];
#pragma unroll
      for (int j = 0; j < 8; ++j) n[j] = S[j];
#pragma unroll 2
      for (int s = 0; s < 64; ++s) {
        const float kv = ks[s][sd];
        const f32x4 v0 = *(const f32x4*)&vs[s][eg * 8], v1 = *(const f32x4*)&vs[s][eg * 8 + 4];
        n[0] += kv * v0.x; n[1] += kv * v0.y; n[2] += kv * v0.z; n[3] += kv * v0.w;
        n[4] += kv * v1.x; n[5] += kv * v1.y; n[6] += kv * v1.z; n[7] += kv * v1.w;
      }
      const float dec = decs[sd];
#pragma unroll
      for (int j = 0; j < 8; ++j) S[j] = dec * n[j];
    }
    __syncthreads();
  }
}

DI void ph_gla_norm(int m, const float* __restrict__ GO, const bf16_t* __restrict__ GR, const float* __restrict__ gla_g, bf16_t* __restrict__ MIX) {
  const int tid256_ = fresh_tid() & 255;
  const int hd = TID >> 6, lane = TID & 63;
  const f32x2 v = *(const f32x2*)(GO + (size_t)m * 512 + hd * 128 + lane * 2);
  float ss = wave_sum(v.x * v.x + v.y * v.y);
  const float sc = rsqrtf(ss * (1.0f / 128.0f) + EPS);
  const unsigned g2 = *(const unsigned*)(GR + (size_t)m * 512 + hd * 128 + lane * 2);
  const float g0 = bflo(g2), g1 = bfhi(g2);
  const f32x2 gn = *(const f32x2*)(gla_g + hd * 128 + lane * 2);
  const float s0 = g0 / (1.f + __expf(-g0)), s1 = g1 / (1.f + __expf(-g1));
  *(unsigned*)(MIX + (size_t)m * D + 512 + hd * 128 + lane * 2) = pk2(v.x * sc * gn.x * s0, v.y * sc * gn.y * s1);
}

DI bool better(float v1, int i1, float v2, int i2) { return (v1 > v2) || (v1 == v2 && i1 < i2); }
DI void wave_argmax(float& v, int& i) {
#pragma unroll
  for (int o = 32; o >= 1; o >>= 1) {
    const float ov = __shfl_xor(v, o);
    const int oi = __shfl_xor(i, o);
    if (better(ov, oi, v, i)) { v = ov; i = oi; }
  }
}
constexpr int RT_TOK_PER_BLOCK = 256;
DI void ph_route_v1(int vb, char* smem, const bf16_t* __restrict__ QP, const float* __restrict__ sk1, const float* __restrict__ sk2,
                                                  int* __restrict__ EIDX, float* __restrict__ GATE) {
  const int tid256_ = fresh_tid() & 255;
  float (*K1)[68] = (float (*)[68])smem;
  float (*K2)[68] = (float (*)[68])(smem + 34816);
  float (*qsh)[128] = (float (*)[128])(smem + 2 * 34816);
  const int hd = vb & 7, tg = vb >> 3;
  const int tid = TID, lane = tid & 63, wave = tid >> 6;
  for (int idx = tid; idx < 128 * 64; idx += 256) {
    const int k = idx >> 6, d = idx & 63;
    K1[k][d] = sk1[((size_t)hd * 128 + k) * 64 + d];
    K2[k][d] = sk2[((size_t)hd * 128 + k) * 64 + d];
  }
  __syncthreads();
  const float NEG = -3.0e38f;
  for (int it = 0; it < RT_TOK_PER_BLOCK / 4; ++it) {
    const int m = tg * RT_TOK_PER_BLOCK + it * 4 + wave;
    {
      const unsigned q2 = *(const unsigned*)(QP + (size_t)m * D + hd * 128 + lane * 2);
      qsh[wave][lane * 2] = bflo(q2); qsh[wave][lane * 2 + 1] = bfhi(q2);
    }
    __builtin_amdgcn_wave_barrier();
    float s1a = 0.f, s1b = 0.f, s2a = 0.f, s2b = 0.f;
#pragma unroll 4
    for (int d = 0; d < 64; d += 4) {
      const f32x4 q1 = *(const f32x4*)&qsh[wave][d], q2 = *(const f32x4*)&qsh[wave][64 + d];
      const f32x4 a = *(const f32x4*)&K1[lane][d], bb = *(const f32x4*)&K1[lane + 64][d];
      const f32x4 c = *(const f32x4*)&K2[lane][d], dd = *(const f32x4*)&K2[lane + 64][d];
      s1a += q1.x * a.x + q1.y * a.y + q1.z * a.z + q1.w * a.w;
      s1b += q1.x * bb.x + q1.y * bb.y + q1.z * bb.z + q1.w * bb.w;
      s2a += q2.x * c.x + q2.y * c.y + q2.z * c.z + q2.w * c.w;
      s2b += q2.x * dd.x + q2.y * dd.y + q2.z * dd.z + q2.w * dd.w;
    }
    __builtin_amdgcn_wave_barrier();
    float tv1 = 0.f, tv2 = 0.f; int ti1 = 0, ti2 = 0;
    for (int rr = 0; rr < 16; ++rr) {
      float v; int i;
      if (better(s1a, lane, s1b, lane + 64)) { v = s1a; i = lane; } else { v = s1b; i = lane + 64; }
      wave_argmax(v, i);
      if (lane == rr) { tv1 = v; ti1 = i; }
      if (i == lane) s1a = NEG;
      if (i == lane + 64) s1b = NEG;
      if (better(s2a, lane, s2b, lane + 64)) { v = s2a; i = lane; } else { v = s2b; i = lane + 64; }
      wave_argmax(v, i);
      if (lane == rr) { tv2 = v; ti2 = i; }
      if (i == lane) s2a = NEG;
      if (i == lane + 64) s2b = NEG;
    }
    const int ca = lane >> 2;
    const float va = __shfl(tv1, ca); const int ia = __shfl(ti1, ca);
    float cv[4]; int ce[4];
#pragma unroll
    for (int j = 0; j < 4; ++j) {
      const int cb = (lane & 3) * 4 + j;
      cv[j] = va + __shfl(tv2, cb);
      ce[j] = ia * 128 + __shfl(ti2, cb);
    }
    float fsc = 0.f; int fe = 0;
    for (int rr = 0; rr < 16; ++rr) {
      float v = cv[0]; int p = lane * 4;
#pragma unroll
      for (int j = 1; j < 4; ++j) if (better(cv[j], lane * 4 + j, v, p)) { v = cv[j]; p = lane * 4 + j; }
      wave_argmax(v, p);
      const int src = p >> 2, jj = p & 3;
      int e = (jj == 0) ? ce[0] : (jj == 1) ? ce[1] : (jj == 2) ? ce[2] : ce[3];
      e = __shfl(e, src);
      if (lane == rr) { fsc = v; fe = e; }
      if (lane == src) {
        if (jj == 0) cv[0] = NEG; else if (jj == 1) cv[1] = NEG; else if (jj == 2) cv[2] = NEG; else cv[3] = NEG;
      }
    }
    const float mx = __shfl(fsc, 0);
    float ex = (lane < 16) ? __expf(fsc - mx) : 0.f;
    const float sum = wave_sum(ex);
    if (lane < 16) {
      EIDX[(size_t)m * 128 + hd * 16 + lane] = fe;
      GATE[(size_t)m * 128 + hd * 16 + lane] = ex / sum;
    }
  }
  __syncthreads();
}


#define MFMA16(a, b, c) __builtin_amdgcn_mfma_f32_16x16x32_bf16((a), (b), (c), 0, 0, 0)
constexpr int GLDS = 72;
struct GlaLds {
  bf16_t Qt[64 * GLDS];
  bf16_t Kt[64 * GLDS];
  bf16_t KT[64 * GLDS];
  bf16_t P[64 * GLDS];
  float dec[64];
  float tot[8][64];
  float ssq[8][64];
};
constexpr size_t WS_SLOC = 926 * MiB;
constexpr size_t WS_DTOT = 942 * MiB;
constexpr size_t WS_GVT = 604 * MiB;

struct GlaPtrs { const bf16_t *GQ, *GK, *GVT, *GR; const float *GLR, *wg, *bg, *gla_g; float *SLOC, *DTOT; bf16_t* MIX; };

template <int PASS>
DI void gla_item(int bh, int sc, char* smem, const GlaPtrs& G) {
  GlaLds& L = *(GlaLds*)smem;
  const int tid = fresh_tid(), lane = tid & 63, w = __builtin_amdgcn_readfirstlane(tid >> 6), c16 = lane & 15, q = lane >> 4;
  const int b = bh >> 2, hd = bh & 3;
  const int cbeg = sc == 0 ? 0 : 8 * sc + 1, cend = 8 * sc + 9;
  float wgr[16];
#pragma unroll
  for (int k = 0; k < 16; ++k) wgr[k] = G.wg[k * 256 + hd * 64 + lane];
  const float bgv = G.bg[hd * 64 + lane];
  f32x4 X[4];
#pragma unroll
  for (int i = 0; i < 4; ++i) X[i] = (f32x4){0.f, 0.f, 0.f, 0.f};
  if (PASS == 1) {
    for (int j = 0; j < sc; ++j) {
      const float* dt = G.DTOT + (size_t)(bh * 16 + j) * 64;
      const float* sl = G.SLOC + ((size_t)(bh * 16 + j) * 8 + w) * 16 * 64 + lane;
#pragma unroll
      for (int i = 0; i < 4; ++i) {
        const f32x4 d4 = *(const f32x4*)(dt + 16 * i + 4 * q);
        X[i][0] = d4.x * X[i][0] + sl[(4 * i + 0) * 64]; X[i][1] = d4.y * X[i][1] + sl[(4 * i + 1) * 64];
        X[i][2] = d4.z * X[i][2] + sl[(4 * i + 2) * 64]; X[i][3] = d4.w * X[i][3] + sl[(4 * i + 3) * 64];
      }
    }
  }
  f32x4 gain = {1.f, 1.f, 1.f, 1.f};
  if (PASS == 1) gain = *(const f32x4*)(G.gla_g + hd * 128 + 16 * w + 4 * q);
  float blsum = 0.f;
  const bf16_t* gq = G.GQ + (size_t)bh * GU * 64 + lane;
  const bf16_t* gk = G.GK + (size_t)bh * GU * 64 + lane;
  const bf16_t* gvt = G.GVT + ((size_t)bh * 128 + 16 * w + c16) * GU + 8 * q;
  for (int c = cbeg; c < cend; ++c) {
    const int u0 = 64 * c;
    float cs[8];
    {
      float run = 0.f;
#pragma unroll
      for (int i = 0; i < 8; ++i) {
        const int u = u0 + 8 * w + i;
        float lgv = 0.f;
        if (u >= 48) {
          const f32x4* gp = (const f32x4*)(G.GLR + ((size_t)b * GU + u) * 16);
          const f32x4 g0 = gp[0], g1 = gp[1], g2 = gp[2], g3 = gp[3];
          float a = bgv;
          a += g0.x * wgr[0] + g0.y * wgr[1] + g0.z * wgr[2] + g0.w * wgr[3];
          a += g1.x * wgr[4] + g1.y * wgr[5] + g1.z * wgr[6] + g1.w * wgr[7];
          a += g2.x * wgr[8] + g2.y * wgr[9] + g2.z * wgr[10] + g2.w * wgr[11];
          a += g3.x * wgr[12] + g3.y * wgr[13] + g3.z * wgr[14] + g3.w * wgr[15];
          lgv = -softplus(-a) * (1.0f / 16.0f);
        }
        run += lgv; cs[i] = run;
      }
      L.tot[w][lane] = run;
    }
    bf16x8 vfr[2];
    vfr[0] = *(const bf16x8*)(gvt + u0);
    vfr[1] = *(const bf16x8*)(gvt + u0 + 32);
    unsigned short kraw[8], qraw[8];
#pragma unroll
    for (int i = 0; i < 8; ++i) {
      kraw[i] = gk[(size_t)(u0 + 8 * w + i) * 64];
      if (PASS == 1) qraw[i] = gq[(size_t)(u0 + 8 * w + i) * 64];
    }
    __syncthreads();
    {
      float offset = 0.f, total = 0.f;
#pragma unroll
      for (int s2 = 0; s2 < 8; ++s2) { const float tv = L.tot[s2][lane]; total += tv; if (s2 < w) offset += tv; }
      blsum += total;
      if (w == 0) L.dec[lane] = __expf(total);
      float kt[8];
#pragma unroll
      for (int i = 0; i < 8; ++i) {
        const float bc = offset + cs[i];
        kt[i] = bf2f(kraw[i]) * __expf(-bc);
        if (PASS == 1) {
          L.Qt[(8 * w + i) * GLDS + lane] = (bf16_t)f2bf(bf2f(qraw[i]) * __expf(bc) * 0.125f);
          L.Kt[(8 * w + i) * GLDS + lane] = (bf16_t)f2bf(kt[i]);
        }
      }
      u32x4 kp; kp.x = pk2(kt[0], kt[1]); kp.y = pk2(kt[2], kt[3]); kp.z = pk2(kt[4], kt[5]); kp.w = pk2(kt[6], kt[7]);
      *(u32x4*)&L.KT[lane * GLDS + 8 * w] = kp;
    }
    __syncthreads();
    f32x4 OT[4];
    if (PASS == 1) {
      const int is = w >> 1;
#pragma unroll
      for (int z = 0; z < 2; ++z) {
        const int it = 2 * (w & 1) + z;
        f32x4 pa = {0.f, 0.f, 0.f, 0.f};
        if (is <= it) {
#pragma unroll
          for (int kk = 0; kk < 2; ++kk) {
            const bf16x8 ka = *(const bf16x8*)&L.Kt[(16 * is + c16) * GLDS + 32 * kk + 8 * q];
            const bf16x8 qb = *(const bf16x8*)&L.Qt[(16 * it + c16) * GLDS + 32 * kk + 8 * q];
            pa = MFMA16(ka, qb, pa);
          }
          if (is == it) {
#pragma unroll
            for (int r = 0; r < 4; ++r) if (4 * q + r > c16) pa[r] = 0.f;
          }
        }
        u32x2 pw; pw.x = pk2(pa[0], pa[1]); pw.y = pk2(pa[2], pa[3]);
        *(u32x2*)&L.P[(16 * it + c16) * GLDS + 16 * is + 4 * q] = pw;
      }
#pragma unroll
      for (int n = 0; n < 4; ++n) OT[n] = (f32x4){0.f, 0.f, 0.f, 0.f};
#pragma unroll
      for (int kk = 0; kk < 2; ++kk) {
        u32x4 xp; xp.x = pk2(X[2 * kk][0], X[2 * kk][1]); xp.y = pk2(X[2 * kk][2], X[2 * kk][3]);
        xp.z = pk2(X[2 * kk + 1][0], X[2 * kk + 1][1]); xp.w = pk2(X[2 * kk + 1][2], X[2 * kk + 1][3]);
        const bf16x8 xa = __builtin_bit_cast(bf16x8, xp);
#pragma unroll
        for (int n = 0; n < 4; ++n) {
          const u32x2 lo = *(const u32x2*)&L.Qt[(16 * n + c16) * GLDS + 32 * kk + 4 * q];
          const u32x2 hi = *(const u32x2*)&L.Qt[(16 * n + c16) * GLDS + 32 * kk + 16 + 4 * q];
          u32x4 qq; qq.x = lo.x; qq.y = lo.y; qq.z = hi.x; qq.w = hi.y;
          OT[n] = MFMA16(xa, __builtin_bit_cast(bf16x8, qq), OT[n]);
        }
      }
      __syncthreads();
#pragma unroll
      for (int kk = 0; kk < 2; ++kk)
#pragma unroll
        for (int n = 0; n < 4; ++n) {
          const bf16x8 pb = *(const bf16x8*)&L.P[(16 * n + c16) * GLDS + 32 * kk + 8 * q];
          OT[n] = MFMA16(vfr[kk], pb, OT[n]);
        }
    }
#pragma unroll
    for (int i = 0; i < 4; ++i) {
#pragma unroll
      for (int kk = 0; kk < 2; ++kk) {
        const bf16x8 ka = *(const bf16x8*)&L.KT[(16 * i + c16) * GLDS + 32 * kk + 8 * q];
        X[i] = MFMA16(ka, vfr[kk], X[i]);
      }
      const f32x4 d4 = *(const f32x4*)&L.dec[16 * i + 4 * q];
      X[i][0] *= d4.x; X[i][1] *= d4.y; X[i][2] *= d4.z; X[i][3] *= d4.w;
    }
    if (PASS == 1) {
      if (c >= 1) {
        float ss[4];
#pragma unroll
        for (int n = 0; n < 4; ++n) {
          float v = OT[n][0] * OT[n][0] + OT[n][1] * OT[n][1] + OT[n][2] * OT[n][2] + OT[n][3] * OT[n][3];
          v += __shfl_xor(v, 16); v += __shfl_xor(v, 32);
          ss[n] = v;
        }
        if (q == 0) {
#pragma unroll
          for (int n = 0; n < 4; ++n) L.ssq[w][16 * n + c16] = ss[n];
        }
        __syncthreads();
#pragma unroll
        for (int n = 0; n < 4; ++n) {
          float tot = 0.f;
#pragma unroll
          for (int w2 = 0; w2 < 8; ++w2) tot += L.ssq[w2][16 * n + c16];
          const float scl = rsqrtf(tot * (1.0f / 128.0f) + EPS);
          const size_t m = (size_t)b * SEQ + 64 * (c - 1) + 16 * n + c16;
          const u32x2 g2 = *(const u32x2*)(G.GR + m * 512 + hd * 128 + 16 * w + 4 * q);
          const float r0 = bflo(g2.x), r1 = bfhi(g2.x), r2 = bflo(g2.y), r3 = bfhi(g2.y);
          const float o0 = OT[n][0] * scl * gain.x * (r0 / (1.f + __expf(-r0)));
          const float o1 = OT[n][1] * scl * gain.y * (r1 / (1.f + __expf(-r1)));
          const float o2 = OT[n][2] * scl * gain.z * (r2 / (1.f + __expf(-r2)));
          const float o3 = OT[n][3] * scl * gain.w * (r3 / (1.f + __expf(-r3)));
          u32x2 ow; ow.x = pk2(o0, o1); ow.y = pk2(o2, o3);
          *(u32x2*)(G.MIX + m * D + 512 + hd * 128 + 16 * w + 4 * q) = ow;
        }
      }
    }
    __syncthreads();
  }
  if (PASS == 0) {
    float* sl = G.SLOC + ((size_t)(bh * 16 + sc) * 8 + w) * 16 * 64 + lane;
#pragma unroll
    for (int i = 0; i < 4; ++i)
#pragma unroll
      for (int r = 0; r < 4; ++r) sl[(4 * i + r) * 64] = X[i][r];
    if (w == 0) G.DTOT[(size_t)(bh * 16 + sc) * 64 + lane] = __expf(blsum);
  }
}


constexpr size_t WS_GQT = 80 * MiB;
constexpr size_t WS_GKT = 113 * MiB;
constexpr size_t WS_GKTT = 146 * MiB;
constexpr size_t WS_GDEC = 179 * MiB;
constexpr size_t WS_GBL = 182 * MiB;
struct GlaPrepPtrs { const bf16_t *GQ, *GK; const float *GLR, *wg, *bg; bf16_t *QT, *KT, *KTT; float *DEC, *BL; };
DI void ph_gla_prep(int item, char* smem, const GlaPrepPtrs& G) {
  float (*tot)[64] = (float (*)[64])smem;
  const int tid = fresh_tid(), lane = tid & 63, w = tid >> 6;
  const int bh = item / 129, c = item % 129, b = bh >> 2, hd = bh & 3, u0 = 64 * c;
  float wgr[16];
#pragma unroll
  for (int k = 0; k < 16; ++k) wgr[k] = G.wg[k * 256 + hd * 64 + lane];
  const float bgv = G.bg[hd * 64 + lane];
  float cs[8]; float run = 0.f;
  unsigned short kraw[8], qraw[8];
#pragma unroll
  for (int i = 0; i < 8; ++i) {
    const int u = u0 + 8 * w + i;
    kraw[i] = G.GK[((size_t)bh * GU + u) * 64 + lane];
    qraw[i] = G.GQ[((size_t)bh * GU + u) * 64 + lane];
    float lgv = 0.f;
    if (u >= 48) {
      const f32x4* gp = (const f32x4*)(G.GLR + ((size_t)b * GU + u) * 16);
      const f32x4 g0 = gp[0], g1 = gp[1], g2 = gp[2], g3 = gp[3];
      float a = bgv;
      a += g0.x * wgr[0] + g0.y * wgr[1] + g0.z * wgr[2] + g0.w * wgr[3];
      a += g1.x * wgr[4] + g1.y * wgr[5] + g1.z * wgr[6] + g1.w * wgr[7];
      a += g2.x * wgr[8] + g2.y * wgr[9] + g2.z * wgr[10] + g2.w * wgr[11];
      a += g3.x * wgr[12] + g3.y * wgr[13] + g3.z * wgr[14] + g3.w * wgr[15];
      lgv = -softplus(-a) * (1.0f / 16.0f);
    }
    run += lgv; cs[i] = run;
  }
  tot[w][lane] = run;
  __syncthreads();
  float offset = 0.f, total = 0.f;
#pragma unroll
  for (int s2 = 0; s2 < 8; ++s2) { const float tv = tot[s2][lane]; total += tv; if (s2 < w) offset += tv; }
  const size_t cb = ((size_t)bh * 129 + c) * 4096;
  float kt[8];
#pragma unroll
  for (int i = 0; i < 8; ++i) {
    const float bc = offset + cs[i];
    kt[i] = bf2f(kraw[i]) * __expf(-bc);
    G.QT[cb + (8 * w + i) * 64 + lane] = (bf16_t)f2bf(bf2f(qraw[i]) * __expf(bc) * 0.125f);
    G.KT[cb + (8 * w + i) * 64 + lane] = (bf16_t)f2bf(kt[i]);
  }
  u32x4 kp; kp.x = pk2(kt[0], kt[1]); kp.y = pk2(kt[2], kt[3]); kp.z = pk2(kt[4], kt[5]); kp.w = pk2(kt[6], kt[7]);
  *(u32x4*)(G.KTT + cb + lane * 64 + 8 * w) = kp;
  if (w == 0) { G.DEC[((size_t)bh * 129 + c) * 64 + lane] = __expf(total); G.BL[((size_t)bh * 129 + c) * 64 + lane] = total; }
  __syncthreads();
}

struct GlaBuf { bf16_t Qt[64 * GLDS]; bf16_t Kt[64 * GLDS]; bf16_t KT[64 * GLDS]; };
struct GlaLds3 { GlaBuf B[2]; bf16_t P[64 * GLDS]; float ssq[8][64]; };
struct GlaPtrs3 { const bf16_t *QT, *KT, *KTT, *GVT, *GR; const float *DEC, *BL, *gla_g; float *SLOC, *DTOT; bf16_t* MIX; };

template <int PASS>
DI void gla_item3(int bh, int sc, char* smem, const GlaPtrs3& G) {
  GlaLds3& L = *(GlaLds3*)smem;
  const int tid = fresh_tid(), lane = tid & 63, w = __builtin_amdgcn_readfirstlane(tid >> 6), c16 = lane & 15, q = lane >> 4;
  const int b = bh >> 2, hd = bh & 3;
  const int cbeg = sc == 0 ? 0 : 8 * sc + 1, cend = 8 * sc + 9;
  f32x4 X[4];
#pragma unroll
  for (int i = 0; i < 4; ++i) X[i] = (f32x4){0.f, 0.f, 0.f, 0.f};
  if (PASS == 1) {
#pragma unroll 4
    for (int j = 0; j < sc; ++j) {
      const float* dt = G.DTOT + (size_t)(bh * 16 + j) * 64;
      const float* sl = G.SLOC + ((size_t)(bh * 16 + j) * 8 + w) * 16 * 64 + lane;
#pragma unroll
      for (int i = 0; i < 4; ++i) {
        const f32x4 d4 = *(const f32x4*)(dt + 16 * i + 4 * q);
        X[i][0] = d4.x * X[i][0] + sl[(4 * i + 0) * 64]; X[i][1] = d4.y * X[i][1] + sl[(4 * i + 1) * 64];
        X[i][2] = d4.z * X[i][2] + sl[(4 * i + 2) * 64]; X[i][3] = d4.w * X[i][3] + sl[(4 * i + 3) * 64];
      }
    }
  }
  f32x4 gain = {1.f, 1.f, 1.f, 1.f};
  if (PASS == 1) gain = *(const f32x4*)(G.gla_g + hd * 128 + 16 * w + 4 * q);
  const bf16_t* gvt = G.GVT + ((size_t)bh * 128 + 16 * w + c16) * GU + 8 * q;
  const int srow = tid >> 3, sc8 = tid & 7, soff = srow * GLDS + sc8 * 8;
  const size_t cb0 = (size_t)bh * 129 * 4096 + (size_t)srow * 64 + sc8 * 8;
  u32x4 rq, rk, rkt, rq2, rk2, rkt2; bf16x8 vfr[2], vfn[2], vfn2[2]; f32x4 dec[4], decn[4], decn2[4];
  {
    const size_t cb = cb0 + (size_t)cbeg * 4096;
    rkt = *(const u32x4*)(G.KTT + cb);
    if (PASS == 1) { rq = *(const u32x4*)(G.QT + cb); rk = *(const u32x4*)(G.KT + cb); }
    vfr[0] = *(const bf16x8*)(gvt + 64 * cbeg); vfr[1] = *(const bf16x8*)(gvt + 64 * cbeg + 32);
#pragma unroll
    for (int i = 0; i < 4; ++i) dec[i] = *(const f32x4*)(G.DEC + ((size_t)bh * 129 + cbeg) * 64 + 16 * i + 4 * q);
    *(u32x4*)&L.B[0].KT[soff] = rkt;
    if (PASS == 1) { *(u32x4*)&L.B[0].Qt[soff] = rq; *(u32x4*)&L.B[0].Kt[soff] = rk; }
    const size_t cb1 = cb0 + (size_t)(cbeg + 1) * 4096;
    rkt = *(const u32x4*)(G.KTT + cb1);
    if (PASS == 1) { rq = *(const u32x4*)(G.QT + cb1); rk = *(const u32x4*)(G.KT + cb1); }
    vfn[0] = *(const bf16x8*)(gvt + 64 * (cbeg + 1)); vfn[1] = *(const bf16x8*)(gvt + 64 * (cbeg + 1) + 32);
#pragma unroll
    for (int i = 0; i < 4; ++i) decn[i] = *(const f32x4*)(G.DEC + ((size_t)bh * 129 + cbeg + 1) * 64 + 16 * i + 4 * q);
  }
  __syncthreads();
  for (int c = cbeg; c < cend; ++c) {
    const int cur = (c - cbeg) & 1;
    const GlaBuf& Bc = L.B[cur];
    const bool more = c + 1 < cend, more2 = c + 2 < cend;
    if (more2) {
      const size_t cb = cb0 + (size_t)(c + 2) * 4096;
      rkt2 = *(const u32x4*)(G.KTT + cb);
      if (PASS == 1) { rq2 = *(const u32x4*)(G.QT + cb); rk2 = *(const u32x4*)(G.KT + cb); }
      vfn2[0] = *(const bf16x8*)(gvt + 64 * (c + 2)); vfn2[1] = *(const bf16x8*)(gvt + 64 * (c + 2) + 32);
#pragma unroll
      for (int i = 0; i < 4; ++i) decn2[i] = *(const f32x4*)(G.DEC + ((size_t)bh * 129 + c + 2) * 64 + 16 * i + 4 * q);
    }
    u32x2 grv[4];
    if (PASS == 1 && c >= 1) {
#pragma unroll
      for (int n = 0; n < 4; ++n) grv[n] = *(const u32x2*)(G.GR + ((size_t)b * SEQ + 64 * (c - 1) + 16 * n + c16) * 512 + hd * 128 + 16 * w + 4 * q);
    }
    f32x4 OT[4];
    if (PASS == 1) {
      const int is = w >> 1;
#pragma unroll
      for (int z = 0; z < 2; ++z) {
        const int it = 2 * (w & 1) + z;
        f32x4 pa = {0.f, 0.f, 0.f, 0.f};
        if (is <= it) {
#pragma unroll
          for (int kk = 0; kk < 2; ++kk) {
            const bf16x8 ka = *(const bf16x8*)&Bc.Kt[(16 * is + c16) * GLDS + 32 * kk + 8 * q];
            const bf16x8 qb = *(const bf16x8*)&Bc.Qt[(16 * it + c16) * GLDS + 32 * kk + 8 * q];
            pa = MFMA16(ka, qb, pa);
          }
          if (is == it) {
#pragma unroll
            for (int r = 0; r < 4; ++r) if (4 * q + r > c16) pa[r] = 0.f;
          }
        }
        u32x2 pw; pw.x = pk2(pa[0], pa[1]); pw.y = pk2(pa[2], pa[3]);
        *(u32x2*)&L.P[(16 * it + c16) * GLDS + 16 * is + 4 * q] = pw;
      }
#pragma unroll
      for (int n = 0; n < 4; ++n) OT[n] = (f32x4){0.f, 0.f, 0.f, 0.f};
#pragma unroll
      for (int kk = 0; kk < 2; ++kk) {
        u32x4 xp; xp.x = pk2(X[2 * kk][0], X[2 * kk][1]); xp.y = pk2(X[2 * kk][2], X[2 * kk][3]);
        xp.z = pk2(X[2 * kk + 1][0], X[2 * kk + 1][1]); xp.w = pk2(X[2 * kk + 1][2], X[2 * kk + 1][3]);
        const bf16x8 xa = __builtin_bit_cast(bf16x8, xp);
#pragma unroll
        for (int n = 0; n < 4; ++n) {
          const u32x2 lo = *(const u32x2*)&Bc.Qt[(16 * n + c16) * GLDS + 32 * kk + 4 * q];
          const u32x2 hi = *(const u32x2*)&Bc.Qt[(16 * n + c16) * GLDS + 32 * kk + 16 + 4 * q];
          u32x4 qq; qq.x = lo.x; qq.y = lo.y; qq.z = hi.x; qq.w = hi.y;
          OT[n] = MFMA16(xa, __builtin_bit_cast(bf16x8, qq), OT[n]);
        }
      }
      __syncthreads();
#pragma unroll
      for (int kk = 0; kk < 2; ++kk)
#pragma unroll
        for (int n = 0; n < 4; ++n) {
          const bf16x8 pb = *(const bf16x8*)&L.P[(16 * n + c16) * GLDS + 32 * kk + 8 * q];
          OT[n] = MFMA16(vfr[kk], pb, OT[n]);
        }
    }
#pragma unroll
    for (int i = 0; i < 4; ++i) {
#pragma unroll
      for (int kk = 0; kk < 2; ++kk) {
        const bf16x8 ka = *(const bf16x8*)&Bc.KT[(16 * i + c16) * GLDS + 32 * kk + 8 * q];
        X[i] = MFMA16(ka, vfr[kk], X[i]);
      }
      X[i][0] *= dec[i].x; X[i][1] *= dec[i].y; X[i][2] *= dec[i].z; X[i][3] *= dec[i].w;
    }
    if (PASS == 1 && c >= 1) {
      float ss[4];
#pragma unroll
      for (int n = 0; n < 4; ++n) {
        float v = OT[n][0] * OT[n][0] + OT[n][1] * OT[n][1] + OT[n][2] * OT[n][2] + OT[n][3] * OT[n][3];
        v += __shfl_xor(v, 16); v += __shfl_xor(v, 32);
        ss[n] = v;
      }
      if (q == 0) {
#pragma unroll
        for (int n = 0; n < 4; ++n) L.ssq[w][16 * n + c16] = ss[n];
      }
      __syncthreads();
#pragma unroll
      for (int n = 0; n < 4; ++n) {
        float tot = 0.f;
#pragma unroll
        for (int w2 = 0; w2 < 8; ++w2) tot += L.ssq[w2][16 * n + c16];
        const float scl = rsqrtf(tot * (1.0f / 128.0f) + EPS);
        const size_t m = (size_t)b * SEQ + 64 * (c - 1) + 16 * n + c16;
        const float r0 = bflo(grv[n].x), r1 = bfhi(grv[n].x), r2 = bflo(grv[n].y), r3 = bfhi(grv[n].y);
        const float o0 = OT[n][0] * scl * gain.x * (r0 / (1.f + __expf(-r0)));
        const float o1 = OT[n][1] * scl * gain.y * (r1 / (1.f + __expf(-r1)));
        const float o2 = OT[n][2] * scl * gain.z * (r2 / (1.f + __expf(-r2)));
        const float o3 = OT[n][3] * scl * gain.w * (r3 / (1.f + __expf(-r3)));
        u32x2 ow; ow.x = pk2(o0, o1); ow.y = pk2(o2, o3);
        *(u32x2*)(G.MIX + m * D + 512 + hd * 128 + 16 * w + 4 * q) = ow;
      }
    }
    if (more) {
      GlaBuf& Bn = L.B[cur ^ 1];
      *(u32x4*)&Bn.KT[soff] = rkt;
      if (PASS == 1) { *(u32x4*)&Bn.Qt[soff] = rq; *(u32x4*)&Bn.Kt[soff] = rk; }
      vfr[0] = vfn[0]; vfr[1] = vfn[1];
#pragma unroll
      for (int i = 0; i < 4; ++i) dec[i] = decn[i];
      rkt = rkt2; rq = rq2; rk = rk2; vfn[0] = vfn2[0]; vfn[1] = vfn2[1];
#pragma unroll
      for (int i = 0; i < 4; ++i) decn[i] = decn2[i];
    }
    __syncthreads();
  }
  if (PASS == 0) {
    float* sl = G.SLOC + ((size_t)(bh * 16 + sc) * 8 + w) * 16 * 64 + lane;
#pragma unroll
    for (int i = 0; i < 4; ++i)
#pragma unroll
      for (int r = 0; r < 4; ++r) sl[(4 * i + r) * 64] = X[i][r];
    if (w == 0) {
      float bl = 0.f;
      for (int c = cbeg; c < cend; ++c) bl += G.BL[((size_t)bh * 129 + c) * 64 + lane];
      G.DTOT[(size_t)(bh * 16 + sc) * 64 + lane] = __expf(bl);
    }
  }
}

DI void ph_gvtrans(int vb, char* smem, const bf16_t* __restrict__ GV, bf16_t* __restrict__ GVT) {
  const int tid256_ = fresh_tid() & 255;
  bf16_t (*t)[66] = (bf16_t (*)[66])smem;
  const int tid = TID;
  const int eh = vb & 1, rest = vb >> 1, bh = rest / 258, ut = rest % 258, u0 = ut * 32;
  {
    const int row = tid >> 3, c8 = tid & 7;
    const u32x4 v = *(const u32x4*)(GV + ((size_t)bh * GU + u0 + row) * 128 + eh * 64 + c8 * 8);
    unsigned* tp = (unsigned*)&t[row][c8 * 8];
    tp[0] = v.x; tp[1] = v.y; tp[2] = v.z; tp[3] = v.w;
  }
  __syncthreads();
  {
    const int d = tid >> 2, i4 = tid & 3;
    unsigned wv[4];
#pragma unroll
    for (int j = 0; j < 4; ++j) wv[j] = (unsigned)t[i4 * 8 + 2 * j][d] | ((unsigned)t[i4 * 8 + 2 * j + 1][d] << 16);
    *(u32x4*)(GVT + ((size_t)bh * 128 + eh * 64 + d) * GU + u0 + i4 * 8) = (u32x4){wv[0], wv[1], wv[2], wv[3]};
  }
  __syncthreads();
}

DI void ce_desc(float& a, float& b) {
  float hi, lo;
  asm("v_max_f32 %0, %1, %2" : "=v"(hi) : "v"(a), "v"(b));
  asm("v_min_f32 %0, %1, %2" : "=v"(lo) : "v"(a), "v"(b));
  a = hi; b = lo;
}
DI float vmaxf(float a, float b) { float hi; asm("v_max_f32 %0, %1, %2" : "=v"(hi) : "v"(a), "v"(b)); return hi; }
template <int N> DI void bitonic_sort_desc(float (&v)[N]) {
#pragma unroll
  for (int k = 2; k <= N; k <<= 1) {
#pragma unroll
    for (int j = k >> 1; j > 0; j >>= 1) {
#pragma unroll
      for (int i = 0; i < N; ++i) {
        const int l = i ^ j;
        if (l > i) { if ((i & k) == 0) ce_desc(v[i], v[l]); else ce_desc(v[l], v[i]); }
      }
    }
  }
}
DI void bitonic_merge16_desc(float (&v)[16]) {
#pragma unroll
  for (int j = 8; j > 0; j >>= 1) {
#pragma unroll
    for (int i = 0; i < 16; ++i) { const int l = i ^ j; if (l > i) ce_desc(v[i], v[l]); }
  }
}
template <int NBV> DI void merge_prune16(float (&a)[16], const float (&b)[16]) {
#pragma unroll
  for (int i = 16 - NBV; i < 16; ++i) a[i] = vmaxf(a[i], b[15 - i]);
  bitonic_merge16_desc(a);
}
DI float selh(int hh, float a, float b) { asm volatile("" : "+v"(a), "+v"(b)); return hh == 0 ? a : b; }
DI float pack_idx(float v, unsigned idx, unsigned mask) { return __uint_as_float((__float_as_uint(v) & ~mask) | idx); }

DI void ph_route_v2(int vb, char* smem, const bf16_t* __restrict__ QP, const bf16_t* __restrict__ SK1b, const bf16_t* __restrict__ SK2b,
                    unsigned short* __restrict__ EIDX, float* __restrict__ GATE) {
  const int tid256_ = fresh_tid() & 255;
  const int lane = TID & 63, wave = TID >> 6, r = lane & 31, hh = lane >> 5;
  const int hd = vb & 7, tile = vb >> 3;
  const int m = tile * 128 + wave * 32 + r;
  float loc[2][16];
#pragma unroll
  for (int L = 0; L < 2; ++L) {
    const bf16_t* qp = QP + (size_t)m * D + hd * 128 + L * 64 + hh * 8;
    const bf16_t* kb = (L == 0 ? SK1b : SK2b) + (size_t)(hd * 128 + r) * 64 + hh * 8;
    bf16x8 qf[4];
#pragma unroll
    for (int ks = 0; ks < 4; ++ks) qf[ks] = *(const bf16x8*)(qp + ks * 16);
    float grp[4][16];
#pragma unroll
    for (int mt = 0; mt < 4; ++mt) {
      f32x16 acc;
#pragma unroll
      for (int e = 0; e < 16; ++e) acc[e] = 0.f;
#pragma unroll
      for (int ks = 0; ks < 4; ++ks) {
        const bf16x8 kf = *(const bf16x8*)(kb + (size_t)mt * 32 * 64 + ks * 16);
        acc = MFMA32(kf, qf[ks], acc);
      }
#pragma unroll
      for (int e = 0; e < 16; ++e) grp[mt][e] = pack_idx(acc[e], (unsigned)(mt * 32 + crow(e, hh)), 127u);
      bitonic_sort_desc<16>(grp[mt]);
    }
    merge_prune16<16>(grp[0], grp[1]);
    merge_prune16<16>(grp[2], grp[3]);
    merge_prune16<16>(grp[0], grp[2]);
#pragma unroll
    for (int i = 0; i < 16; ++i) loc[L][i] = grp[0][i];
  }
  float fin[16], oth[16];
#pragma unroll
  for (int i = 0; i < 16; ++i) {
    const float send = selh(hh, loc[1][i], loc[0][i]);
    oth[i] = __shfl_xor(send, 32);
    fin[i] = selh(hh, loc[0][i], loc[1][i]);
  }
  merge_prune16<16>(fin, oth);
  float v1[16], v2[16];
#pragma unroll
  for (int i = 0; i < 16; ++i) {
    const float o = __shfl_xor(fin[i], 32);
    v1[i] = selh(hh, fin[i], o);
    v2[i] = selh(hh, o, fin[i]);
  }
  unsigned* ib = (unsigned*)smem + (size_t)TID * 8;
#pragma unroll
  for (int q = 0; q < 4; ++q) {
    unsigned w1 = 0, w2 = 0;
#pragma unroll
    for (int j = 0; j < 4; ++j) {
      w1 |= (__float_as_uint(v1[4 * q + j]) & 127u) << (8 * j);
      w2 |= (__float_as_uint(v2[4 * q + j]) & 127u) << (8 * j);
    }
    ib[q] = w1; ib[4 + q] = w2;
  }
  float R[16], Bv[16];
#pragma unroll
  for (int j = 0; j < 16; ++j) R[j] = pack_idx(v1[0] + v2[j], (unsigned)j, 255u);
#define ROUTE_ROW(I, CNT) { _Pragma("unroll") for (int j = 0; j < 16; ++j) Bv[j] = (j < CNT) ? pack_idx(v1[I] + v2[j < CNT ? j : 0], (unsigned)(I * 16 + j), 255u) : 0.f; \
    merge_prune16<CNT>(R, Bv); }
  ROUTE_ROW(1, 8) ROUTE_ROW(2, 5) ROUTE_ROW(3, 4) ROUTE_ROW(4, 3) ROUTE_ROW(5, 2) ROUTE_ROW(6, 2) ROUTE_ROW(7, 2)
#undef ROUTE_ROW
#pragma unroll
  for (int j = 0; j < 16; ++j) Bv[j] = (j < 8) ? pack_idx(v1[8 + (j < 8 ? j : 0)] + v2[0], (unsigned)((8 + j) * 16), 255u) : 0.f;
  merge_prune16<8>(R, Bv);
  float ex[16], sum = 0.f;
#pragma unroll
  for (int i = 0; i < 16; ++i) { ex[i] = __expf(R[i] - R[0]); sum += ex[i]; }
  const float inv = 1.f / sum;
  const unsigned char* ibb = (const unsigned char*)ib;
  int eo[8]; float go[8];
#pragma unroll
  for (int w = 0; w < 8; ++w) {
    const float rv = selh(hh, R[w], R[8 + w]);
    const float ev = selh(hh, ex[w], ex[8 + w]);
    const unsigned pos = __float_as_uint(rv) & 255u;
    const unsigned i1 = ibb[pos >> 4], i2 = ibb[16 + (pos & 15u)];
    eo[w] = (int)(i1 * 128u + i2);
    go[w] = ev * inv;
  }
  unsigned short* ep = EIDX + (size_t)m * 128 + hd * 16 + hh * 8;
  float* gp = GATE + (size_t)m * 128 + hd * 16 + hh * 8;
  *(u32x4*)ep = (u32x4){(unsigned)eo[0] | ((unsigned)eo[1] << 16), (unsigned)eo[2] | ((unsigned)eo[3] << 16), (unsigned)eo[4] | ((unsigned)eo[5] << 16), (unsigned)eo[6] | ((unsigned)eo[7] << 16)};
  *(f32x4*)gp = (f32x4){go[0], go[1], go[2], go[3]};
  *(f32x4*)(gp + 4) = (f32x4){go[4], go[5], go[6], go[7]};
}

DI void ph_peer_v1(int vb, char* smem, const bf16_t* __restrict__ A2, const bf16_t* __restrict__ EU, const bf16_t* __restrict__ EV,
                                                 const int* __restrict__ EIDX, const float* __restrict__ GATE, const float* __restrict__ H1,
                                                 const float* __restrict__ gf, float* __restrict__ out) {
  const int tid256_ = fresh_tid() & 255;
  float (*cs)[128] = (float (*)[128])smem;
  int (*es)[128] = (int (*)[128])(smem + 2048);
  const int lane = TID & 63, wave = TID >> 6;
  const int m = vb * 4 + wave;
  const int g = lane >> 3, sub = lane & 7;
  u32x4 xf[16];
#pragma unroll
  for (int j = 0; j < 16; ++j) xf[j] = *(const u32x4*)(A2 + (size_t)m * D + (j * 8 + sub) * 8);
  for (int bt = 0; bt < 16; ++bt) {
    const int k = bt * 8 + g;
    const int e = EIDX[(size_t)m * 128 + k];
    const bf16_t* up = EU + (size_t)e * D + sub * 8;
    float acc = 0.f;
#pragma unroll
    for (int j = 0; j < 16; ++j) {
      const u32x4 u = *(const u32x4*)(up + j * 64);
      acc = dot2bf(u.x, xf[j].x, acc); acc = dot2bf(u.y, xf[j].y, acc); acc = dot2bf(u.z, xf[j].z, acc); acc = dot2bf(u.w, xf[j].w, acc);
    }
    acc += __shfl_xor(acc, 1); acc += __shfl_xor(acc, 2); acc += __shfl_xor(acc, 4);
    if (sub == 0) {
      const float act = 0.5f * acc * (1.f + erff(acc * 0.70710678118654752f));
      cs[wave][k] = GATE[(size_t)m * 128 + k] * act;
      es[wave][k] = e;
    }
  }
  __builtin_amdgcn_wave_barrier();
  __syncthreads();
  float y[16];
#pragma unroll
  for (int j = 0; j < 16; ++j) y[j] = 0.f;
#pragma unroll 4
  for (int k = 0; k < 128; ++k) {
    const float c = cs[wave][k];
    const bf16_t* vp = EV + (size_t)es[wave][k] * D + lane * 8;
    const u32x4 v0 = *(const u32x4*)vp, v1 = *(const u32x4*)(vp + 512);
    y[0] += c * bflo(v0.x); y[1] += c * bfhi(v0.x); y[2] += c * bflo(v0.y); y[3] += c * bfhi(v0.y);
    y[4] += c * bflo(v0.z); y[5] += c * bfhi(v0.z); y[6] += c * bflo(v0.w); y[7] += c * bfhi(v0.w);
    y[8] += c * bflo(v1.x); y[9] += c * bfhi(v1.x); y[10] += c * bflo(v1.y); y[11] += c * bfhi(v1.y);
    y[12] += c * bflo(v1.z); y[13] += c * bfhi(v1.z); y[14] += c * bflo(v1.w); y[15] += c * bfhi(v1.w);
  }
  const float* hp = H1 + (size_t)m * D + lane * 8;
  float ss = 0.f;
#pragma unroll
  for (int q = 0; q < 4; ++q) {
    const f32x4 hv = *(const f32x4*)(hp + (q >> 1) * 512 + (q & 1) * 4);
    y[q * 4 + 0] += hv.x; y[q * 4 + 1] += hv.y; y[q * 4 + 2] += hv.z; y[q * 4 + 3] += hv.w;
  }
#pragma unroll
  for (int j = 0; j < 16; ++j) ss += y[j] * y[j];
  ss = wave_sum(ss);
  const float sc = rsqrtf(ss * (1.0f / D) + EPS);
  float* op = out + (size_t)m * D + lane * 8;
#pragma unroll
  for (int q = 0; q < 4; ++q) {
    const int off = (q >> 1) * 512 + (q & 1) * 4;
    const f32x4 gg = *(const f32x4*)(gf + lane * 8 + off);
    *(f32x4*)(op + off) = (f32x4){y[q * 4 + 0] * sc * gg.x, y[q * 4 + 1] * sc * gg.y, y[q * 4 + 2] * sc * gg.z, y[q * 4 + 3] * sc * gg.w};
  }
}


DI void ph_convert_eu(const float* __restrict__ src, bf16_t* __restrict__ EUs) {
  size_t i = (size_t)blockIdx.x * blockDim.x + threadIdx.x;
  const size_t stride = (size_t)gridDim.x * blockDim.x;
  for (; i < (size_t)NEXP * 128; i += stride) {
    const int e = (int)(i >> 7), pz = (int)(i & 127);
    const f32x4 a = ((const f32x4*)src)[2 * i], b = ((const f32x4*)src)[2 * i + 1];
    u32x4 o; o.x = pk2(a.x, a.y); o.y = pk2(a.z, a.w); o.z = pk2(b.x, b.y); o.w = pk2(b.z, b.w);
    *(u32x4*)(EUs + ((size_t)(pz >> 3) * NEXP + e) * 64 + (pz & 7) * 8) = o;
  }
}
DI void ph_convert_ev(int vb, char* smem, const float* __restrict__ src, bf16_t* __restrict__ EVc) {
  const int tid256_ = fresh_tid() & 255;
  bf16_t (*t)[1028] = (bf16_t (*)[1028])smem;
  const int e0 = vb * 32;
  for (int r = 0; r < 32; ++r) {
    const f32x4 a = *(const f32x4*)(src + (size_t)(e0 + r) * D + TID * 4);
    u32x2 o; o.x = pk2(a.x, a.y); o.y = pk2(a.z, a.w);
    *(u32x2*)&t[r][TID * 4] = o;
  }
  __syncthreads();
  const int r = TID & 31, cs = TID >> 5;
  for (int c0 = 0; c0 < 256; c0 += 8) {
    const int cg = c0 + cs;
    const u32x2 v = *(const u32x2*)&t[r][cg * 4];
    *(u32x2*)(EVc + ((size_t)cg * NEXP + e0 + r) * 4) = v;
  }
  __syncthreads();
}

DI float dpp_f(float v, const int ctrl_sel) {
  int r;
  if (ctrl_sel == 0) r = __builtin_amdgcn_update_dpp(0, __builtin_bit_cast(int, v), 0xB1, 0xF, 0xF, true);
  else if (ctrl_sel == 1) r = __builtin_amdgcn_update_dpp(0, __builtin_bit_cast(int, v), 0x4E, 0xF, 0xF, true);
  else r = __builtin_amdgcn_update_dpp(0, __builtin_bit_cast(int, v), 0x141, 0xF, 0xF, true);
  return __builtin_bit_cast(float, r);
}
DI float dpp_sum8(float v) {
  v += dpp_f(v, 0); v += dpp_f(v, 1); v += dpp_f(v, 2);
  return v;
}
DI void ph_peer_u(int xi, int nx, int wv, int nwv, const bf16_t* __restrict__ A2, const bf16_t* __restrict__ EUs,
                  const unsigned short* __restrict__ EIDX, bf16_t* __restrict__ PP) {
  const int lane = fresh_tid() & 63, g = lane >> 3, sub = lane & 7;
  for (int s = xi; s < 16; s += nx) {
    const bf16_t* tab = EUs + (size_t)s * NEXP * 64 + sub * 8;
    bf16_t* pp = PP + (size_t)s * TREAL * 128;
    for (int t = wv; t < TREAL; t += nwv) {
      const unsigned idxpair = __builtin_nontemporal_load((const unsigned*)(EIDX + (size_t)t * 128) + lane);
      const u32x4 xs = *(const u32x4*)(A2 + (size_t)t * D + s * 64 + sub * 8);
      u32x4 u[16];
#pragma unroll
      for (int j = 0; j < 16; ++j) {
        const unsigned w = (unsigned)__shfl((int)idxpair, (lane & ~7) + (j >> 1));
        const unsigned e = (j & 1) ? (w >> 16) : (w & 0xffffu);
        u[j] = *(const u32x4*)(tab + (size_t)e * 64);
      }
      float res0 = 0.f, res1 = 0.f;
#pragma unroll
      for (int j = 0; j < 16; ++j) {
        float acc = 0.f;
        acc = dot2bf(u[j].x, xs.x, acc); acc = dot2bf(u[j].y, xs.y, acc); acc = dot2bf(u[j].z, xs.z, acc); acc = dot2bf(u[j].w, xs.w, acc);
        acc = dpp_sum8(acc);
        if (sub == (j >> 1)) { if (j & 1) res1 = acc; else res0 = acc; }
      }
      __builtin_nontemporal_store(pk2(res0, res1), (unsigned*)(pp + (size_t)t * 128) + lane);
    }
  }
}
DI void ph_peer_c(const bf16_t* __restrict__ PP, const unsigned short* __restrict__ EIDX, const float* __restrict__ GATE, unsigned* __restrict__ STREAM) {
  size_t i = (size_t)blockIdx.x * blockDim.x + threadIdx.x;
  const size_t stride = (size_t)gridDim.x * blockDim.x, n = (size_t)TREAL * 128;
  for (; i < n; i += stride) {
    float a = 0.f;
#pragma unroll
    for (int s = 0; s < 16; ++s) a += bf2f(PP[(size_t)s * n + i]);
    const float act = 0.5f * a * (1.f + erff(a * 0.70710678118654752f));
    const float c = GATE[i] * act;
    const size_t t = i >> 7; const unsigned k = (unsigned)(i & 127);
    STREAM[(((t >> 6) * 32 + (k >> 2)) * 64 + (t & 63)) * 4 + (k & 3)] = (unsigned)EIDX[i] | (f2bf(c) << 16);
  }
}
DI void ph_peer_v(char* smem, const unsigned* __restrict__ STREAM, const bf16_t* __restrict__ EVc, float* __restrict__ YT) {
  const int tid = fresh_tid(), lane = tid & 63, wave = tid >> 6;
  u32x2* tabl = (u32x2*)smem;
  for (int cg = blockIdx.x; cg < 256; cg += gridDim.x) {
    const u32x4* src = (const u32x4*)(EVc + (size_t)cg * NEXP * 4);
#pragma unroll 4
    for (int i = tid; i < NEXP * 8 / 16; i += 512) ((u32x4*)smem)[i] = src[i];
    __syncthreads();
    for (int it = wave; it < TREAL / 64; it += 8) {
      const int t = it * 64 + lane;
      const u32x4* sp = (const u32x4*)(STREAM + (size_t)it * 8192) + lane;
      float y0 = 0.f, y1 = 0.f, y2 = 0.f, y3 = 0.f;
#pragma unroll 4
      for (int q = 0; q < 32; ++q) {
        const u32x4 w4 = sp[q * 64];
#pragma unroll
        for (int z = 0; z < 4; ++z) {
          const unsigned w = z == 0 ? w4.x : z == 1 ? w4.y : z == 2 ? w4.z : w4.w;
          const float c = bfhi(w);
          const u32x2 v = tabl[w & 0xffffu];
          y0 += c * bflo(v.x); y1 += c * bfhi(v.x); y2 += c * bflo(v.y); y3 += c * bfhi(v.y);
        }
      }
      *(f32x4*)(YT + ((size_t)cg * TREAL + t) * 4) = (f32x4){y0, y1, y2, y3};
    }
    __syncthreads();
  }
}
DI void ph_final(int wv4, const float* __restrict__ H1, const float* __restrict__ YT, const float* __restrict__ gf, float* __restrict__ out) {
  const int lane = fresh_tid() & 63;
  const int t0 = wv4 * 4;
  f32x4 y[4][4];
#pragma unroll
  for (int j = 0; j < 4; ++j) {
    const f32x4* yp = (const f32x4*)(YT + ((size_t)(lane + 64 * j) * TREAL + t0) * 4);
#pragma unroll
    for (int q = 0; q < 4; ++q) y[j][q] = yp[q];
  }
#pragma unroll
  for (int q = 0; q < 4; ++q) {
    const size_t rowoff = (size_t)(t0 + q) * D;
    float ss = 0.f;
#pragma unroll
    for (int j = 0; j < 4; ++j) {
      const f32x4 hv = *(const f32x4*)(H1 + rowoff + (lane + 64 * j) * 4);
      y[j][q].x += hv.x; y[j][q].y += hv.y; y[j][q].z += hv.z; y[j][q].w += hv.w;
      ss += y[j][q].x * y[j][q].x + y[j][q].y * y[j][q].y + y[j][q].z * y[j][q].z + y[j][q].w * y[j][q].w;
    }
    ss = wave_sum(ss);
    const float sc = rsqrtf(ss * (1.0f / D) + EPS);
#pragma unroll
    for (int j = 0; j < 4; ++j) {
      const f32x4 gg = *(const f32x4*)(gf + (lane + 64 * j) * 4);
      *(f32x4*)(out + rowoff + (lane + 64 * j) * 4) = (f32x4){y[j][q].x * sc * gg.x, y[j][q].y * sc * gg.y, y[j][q].z * sc * gg.z, y[j][q].w * sc * gg.w};
    }
  }
}


typedef unsigned char u8_t;
constexpr size_t WS_SCU = 14 * MiB;
constexpr size_t WS_SCV = 14 * MiB + 65536;
DI float wave_max(float v) {
#pragma unroll
  for (int o = 32; o >= 1; o >>= 1) v = fmaxf(v, __shfl_xor(v, o));
  return v;
}
DI u32x4 quant_row16(const float* __restrict__ rowp, int lane, float& sc) {
  const f32x4* rp = (const f32x4*)(rowp + lane * 16);
  const f32x4 a = rp[0], b = rp[1], c = rp[2], d = rp[3];
  float m = fmaxf(fmaxf(fmaxf(fabsf(a.x), fabsf(a.y)), fmaxf(fabsf(a.z), fabsf(a.w))), fmaxf(fmaxf(fabsf(b.x), fabsf(b.y)), fmaxf(fabsf(b.z), fabsf(b.w))));
  m = fmaxf(m, fmaxf(fmaxf(fmaxf(fabsf(c.x), fabsf(c.y)), fmaxf(fabsf(c.z), fabsf(c.w))), fmaxf(fmaxf(fabsf(d.x), fabsf(d.y)), fmaxf(fabsf(d.z), fabsf(d.w)))));
  m = wave_max(m);
  sc = m > 0.f ? m * (1.0f / 448.0f) : 1.0f;
  const float inv = 1.0f / sc;
  u32x4 o; unsigned w;
  w = 0; w = __builtin_amdgcn_cvt_pk_fp8_f32(a.x * inv, a.y * inv, w, false); w = __builtin_amdgcn_cvt_pk_fp8_f32(a.z * inv, a.w * inv, w, true); o.x = w;
  w = 0; w = __builtin_amdgcn_cvt_pk_fp8_f32(b.x * inv, b.y * inv, w, false); w = __builtin_amdgcn_cvt_pk_fp8_f32(b.z * inv, b.w * inv, w, true); o.y = w;
  w = 0; w = __builtin_amdgcn_cvt_pk_fp8_f32(c.x * inv, c.y * inv, w, false); w = __builtin_amdgcn_cvt_pk_fp8_f32(c.z * inv, c.w * inv, w, true); o.z = w;
  w = 0; w = __builtin_amdgcn_cvt_pk_fp8_f32(d.x * inv, d.y * inv, w, false); w = __builtin_amdgcn_cvt_pk_fp8_f32(d.z * inv, d.w * inv, w, true); o.w = w;
  return o;
}
DI void ph_convert_eu8(const float* __restrict__ src, u8_t* __restrict__ EU8s, float* __restrict__ scaleU) {
  const int tid = fresh_tid(), lane = tid & 63, wave = tid >> 6;
  for (int e = (blockIdx.x * 8 + wave) * 2; e < NEXP; e += gridDim.x * 16) {
    float sc0, sc1 = 1.f;
    const bool two = e + 1 < NEXP;
    const u32x4 o0 = quant_row16(src + (size_t)e * D, lane, sc0);
    u32x4 o1 = o0;
    if (two) o1 = quant_row16(src + (size_t)(e + 1) * D, lane, sc1);
    *(u32x4*)(EU8s + ((size_t)(lane >> 3) * NEXP + e) * 128 + (lane & 7) * 16) = o0;
    if (two) *(u32x4*)(EU8s + ((size_t)(lane >> 3) * NEXP + e + 1) * 128 + (lane & 7) * 16) = o1;
    if (lane == 0) { scaleU[e] = sc0; if (two) scaleU[e + 1] = sc1; }
  }
}
DI void ph_convert_ev8(int vb, char* smem, const float* __restrict__ src, u8_t* __restrict__ EV8c, float* __restrict__ scaleV) {
  const int tid256_ = fresh_tid() & 255;
  u8_t (*t)[1040] = (u8_t (*)[1040])smem;
  const int lane = TID & 63, wave = TID >> 6, e0 = vb * 32;
  for (int rr = 0; rr < 8; ++rr) {
    const int r = wave * 8 + rr;
    float sc;
    const u32x4 o = quant_row16(src + (size_t)(e0 + r) * D, lane, sc);
    *(u32x4*)&t[r][lane * 16] = o;
    if (lane == 0) scaleV[e0 + r] = sc;
  }
  __syncthreads();
  const int r = TID & 31, cs = TID >> 5;
  for (int c0 = 0; c0 < 128; c0 += 8) {
    const int cg = c0 + cs;
    const u32x2 v = *(const u32x2*)&t[r][cg * 8];
    *(u32x2*)(EV8c + ((size_t)cg * NEXP + e0 + r) * 8) = v;
  }
  __syncthreads();
}
DI float dot4_fp8(unsigned w, float x0, float x1, float x2, float x3, float acc) {
  const f32x2 lo = __builtin_amdgcn_cvt_pk_f32_fp8(w, false), hi = __builtin_amdgcn_cvt_pk_f32_fp8(w, true);
  acc += lo.x * x0; acc += lo.y * x1; acc += hi.x * x2; acc += hi.y * x3;
  return acc;
}
struct PeerUHalf { u32x4 u[8]; };
template <int HF> DI void peer_u8_issue(PeerUHalf& H, unsigned idxpair, int lane, const u8_t* __restrict__ tab) {
#pragma unroll
  for (int jj = 0; jj < 8; ++jj) {
    const int j = 8 * HF + jj;
    const unsigned w = (unsigned)__shfl((int)idxpair, (lane & ~7) + (j >> 1));
    const unsigned e = (j & 1) ? (w >> 16) : (w & 0xffffu);
    H.u[jj] = *(const u32x4*)(tab + (size_t)e * 128);
  }
}
template <int HF> DI void peer_u8_compute(const PeerUHalf& H, const u32x4 xa, const u32x4 xb, int sub, float& res0, float& res1) {
  const float x0 = bflo(xa.x), x1 = bfhi(xa.x), x2 = bflo(xa.y), x3 = bfhi(xa.y), x4 = bflo(xa.z), x5 = bfhi(xa.z), x6 = bflo(xa.w), x7 = bfhi(xa.w);
  const float x8 = bflo(xb.x), x9 = bfhi(xb.x), x10 = bflo(xb.y), x11 = bfhi(xb.y), x12 = bflo(xb.z), x13 = bfhi(xb.z), x14 = bflo(xb.w), x15 = bfhi(xb.w);
#pragma unroll
  for (int jj = 0; jj < 8; ++jj) {
    const int j = 8 * HF + jj;
    float acc = 0.f;
    acc = dot4_fp8(H.u[jj].x, x0, x1, x2, x3, acc); acc = dot4_fp8(H.u[jj].y, x4, x5, x6, x7, acc);
    acc = dot4_fp8(H.u[jj].z, x8, x9, x10, x11, acc); acc = dot4_fp8(H.u[jj].w, x12, x13, x14, x15, acc);
    acc = dpp_sum8(acc);
    if (sub == (j >> 1)) { if (j & 1) res1 = acc; else res0 = acc; }
  }
}
DI unsigned peer_u8_idx(const unsigned short* __restrict__ EIDX, int t, int lane) {
  return t < TREAL ? __builtin_nontemporal_load((const unsigned*)(EIDX + (size_t)t * 128) + lane) : 0u;
}
DI void ph_peer_u8(int xi, int nx, int wv, int nwv, const bf16_t* __restrict__ A2, const u8_t* __restrict__ EU8s,
                   const unsigned short* __restrict__ EIDX, bf16_t* __restrict__ PP) {
  const int lane = fresh_tid() & 63, sub = lane & 7;
  const int ntok = (TREAL - wv + nwv - 1) / nwv;
#define PU_TOK(i) (wv + ((i) < ntok ? (i) : ntok - 1) * nwv)
#define PU_IDX(t) __builtin_nontemporal_load((const unsigned*)(EIDX + (size_t)(t) * 128) + lane)
#define PU_LDX(xa_, xb_, t) { xa_ = *(const u32x4*)(xbase + (size_t)(t) * D); xb_ = *(const u32x4*)(xbase + (size_t)(t) * D + 8); }
#define PU_STORE(t, r0, r1) __builtin_nontemporal_store(pk2(r0, r1), (unsigned*)(pp + (size_t)(t) * 128) + lane)
  for (int s = xi; s < 8; s += nx) {
    const u8_t* tab = EU8s + (size_t)s * NEXP * 128 + sub * 16;
    const bf16_t* xbase = A2 + s * 128 + sub * 16;
    bf16_t* pp = PP + (size_t)s * TREAL * 128;
    PeerUHalf HA, HB, HC;
    int ta = PU_TOK(0), tb = PU_TOK(1), tc = PU_TOK(2);
    unsigned ia = PU_IDX(ta), ib = PU_IDX(tb), ic = PU_IDX(tc);
    u32x4 xaa, xab; PU_LDX(xaa, xab, ta);
    peer_u8_issue<0>(HA, ia, lane, tab);
    peer_u8_issue<1>(HB, ia, lane, tab);
    for (int i = 0; i < ntok; i += 3) {
      const int td = PU_TOK(i + 3), te = PU_TOK(i + 4), tf = PU_TOK(i + 5);
      u32x4 xba, xbb, xca, xcb, xda, xdb;
      float r0, r1;
      peer_u8_issue<0>(HC, ib, lane, tab); PU_LDX(xba, xbb, tb); const unsigned id = PU_IDX(td);
      r0 = 0.f; r1 = 0.f;
      peer_u8_compute<0>(HA, xaa, xab, sub, r0, r1);
      peer_u8_issue<1>(HA, ib, lane, tab);
      peer_u8_compute<1>(HB, xaa, xab, sub, r0, r1);
      PU_STORE(ta, r0, r1);
      peer_u8_issue<0>(HB, ic, lane, tab); PU_LDX(xca, xcb, tc); const unsigned ie = PU_IDX(te);
      r0 = 0.f; r1 = 0.f;
      peer_u8_compute<0>(HC, xba, xbb, sub, r0, r1);
      peer_u8_issue<1>(HC, ic, lane, tab);
      peer_u8_compute<1>(HA, xba, xbb, sub, r0, r1);
      PU_STORE(tb, r0, r1);
      peer_u8_issue<0>(HA, id, lane, tab); PU_LDX(xda, xdb, td); const unsigned if_ = PU_IDX(tf);
      r0 = 0.f; r1 = 0.f;
      peer_u8_compute<0>(HB, xca, xcb, sub, r0, r1);
      peer_u8_issue<1>(HB, id, lane, tab);
      peer_u8_compute<1>(HC, xca, xcb, sub, r0, r1);
      PU_STORE(tc, r0, r1);
      ta = td; tb = te; tc = tf; ib = ie; ic = if_; xaa = xda; xab = xdb;
    }
  }
#undef PU_TOK
#undef PU_IDX
#undef PU_LDX
#undef PU_STORE
}
DI void ph_peer_c8(const bf16_t* __restrict__ PP, const unsigned short* __restrict__ EIDX, const float* __restrict__ GATE,
                   const float* __restrict__ scaleU, const float* __restrict__ scaleV, unsigned* __restrict__ STREAM) {
  size_t i = (size_t)blockIdx.x * blockDim.x + threadIdx.x;
  const size_t stride = (size_t)gridDim.x * blockDim.x, n = (size_t)TREAL * 128;
  for (; i < n; i += stride) {
    float a = 0.f;
#pragma unroll
    for (int s = 0; s < 8; ++s) a += bf2f(PP[(size_t)s * n + i]);
    const unsigned e = EIDX[i];
    a *= scaleU[e];
    const float act = 0.5f * a * (1.f + erff(a * 0.70710678118654752f));
    const float c = GATE[i] * act * scaleV[e];
    const size_t t = i >> 7; const unsigned k = (unsigned)(i & 127);
    STREAM[(((t >> 6) * 32 + (k >> 2)) * 64 + (t & 63)) * 4 + (k & 3)] = e | (f2bf(c) << 16);
  }
}
struct PVW { u32x4 a, b; };
struct PVT { u32x2 v[8]; };
DI void pv_loadw(PVW& W, const unsigned* __restrict__ STREAM, int it, int g, int lane) {
  const u32x4* sp = (const u32x4*)(STREAM + (size_t)it * 8192) + lane;
  W.a = sp[(2 * g) * 64]; W.b = sp[(2 * g + 1) * 64];
}
DI void pv_readt(PVT& T, const PVW& W, const u32x2* tabl) {
  T.v[0] = tabl[W.a.x & 0xffffu]; T.v[1] = tabl[W.a.y & 0xffffu]; T.v[2] = tabl[W.a.z & 0xffffu]; T.v[3] = tabl[W.a.w & 0xffffu];
  T.v[4] = tabl[W.b.x & 0xffffu]; T.v[5] = tabl[W.b.y & 0xffffu]; T.v[6] = tabl[W.b.z & 0xffffu]; T.v[7] = tabl[W.b.w & 0xffffu];
}
DI void pv_fma1(unsigned w, const u32x2 v, f32x2 (&y)[4]) {
  const float c = bfhi(w);
  const f32x2 cc = {c, c};
  y[0] = __builtin_elementwise_fma(__builtin_amdgcn_cvt_pk_f32_fp8(v.x, false), cc, y[0]);
  y[1] = __builtin_elementwise_fma(__builtin_amdgcn_cvt_pk_f32_fp8(v.x, true), cc, y[1]);
  y[2] = __builtin_elementwise_fma(__builtin_amdgcn_cvt_pk_f32_fp8(v.y, false), cc, y[2]);
  y[3] = __builtin_elementwise_fma(__builtin_amdgcn_cvt_pk_f32_fp8(v.y, true), cc, y[3]);
}
DI void pv_fma(const PVW& W, const PVT& T, f32x2 (&y)[4]) {
  pv_fma1(W.a.x, T.v[0], y); pv_fma1(W.a.y, T.v[1], y); pv_fma1(W.a.z, T.v[2], y); pv_fma1(W.a.w, T.v[3], y);
  pv_fma1(W.b.x, T.v[4], y); pv_fma1(W.b.y, T.v[5], y); pv_fma1(W.b.z, T.v[6], y); pv_fma1(W.b.w, T.v[7], y);
}
DI void ph_peer_v8(char* smem, const unsigned* __restrict__ STREAM, const u8_t* __restrict__ EV8c, bf16_t* __restrict__ YT) {
  const int tid = fresh_tid(), lane = tid & 63, wave = tid >> 6;
  const u32x2* tabl = (const u32x2*)smem;
  for (int unit = blockIdx.x; unit < 256; unit += gridDim.x) {
    const int cg = unit & 127, th = unit >> 7;
    const u32x4* src = (const u32x4*)(EV8c + (size_t)cg * NEXP * 8);
#pragma unroll 4
    for (int i = tid; i < NEXP * 8 / 16; i += 512) ((u32x4*)smem)[i] = src[i];
    __syncthreads();
    const int it_end = th * 512 + 512;
    int it = th * 512 + wave;
    PVW W0, W1, W2, W3; PVT T0, T1;
    pv_loadw(W0, STREAM, it, 0, lane); pv_loadw(W1, STREAM, it, 1, lane);
    pv_readt(T0, W0, tabl);
    for (; it < it_end; it += 8) {
      const int itn = (it + 8 < it_end) ? it + 8 : it;
      f32x2 y[4];
#pragma unroll
      for (int z = 0; z < 4; ++z) y[z] = (f32x2){0.f, 0.f};
#define PV_STEP(g, Wld, Wrd, Trd, Wc, Tc) \
      pv_loadw(Wld, STREAM, ((g) + 2 < 16) ? it : itn, ((g) + 2) & 15, lane); \
      pv_readt(Trd, Wrd, tabl); \
      pv_fma(Wc, Tc, y); \
      asm volatile("" ::: "memory");
      PV_STEP(0, W2, W1, T1, W0, T0)  PV_STEP(1, W3, W2, T0, W1, T1)  PV_STEP(2, W0, W3, T1, W2, T0)  PV_STEP(3, W1, W0, T0, W3, T1)
      PV_STEP(4, W2, W1, T1, W0, T0)  PV_STEP(5, W3, W2, T0, W1, T1)  PV_STEP(6, W0, W3, T1, W2, T0)  PV_STEP(7, W1, W0, T0, W3, T1)
      PV_STEP(8, W2, W1, T1, W0, T0)  PV_STEP(9, W3, W2, T0, W1, T1)  PV_STEP(10, W0, W3, T1, W2, T0) PV_STEP(11, W1, W0, T0, W3, T1)
      PV_STEP(12, W2, W1, T1, W0, T0) PV_STEP(13, W3, W2, T0, W1, T1) PV_STEP(14, W0, W3, T1, W2, T0) PV_STEP(15, W1, W0, T0, W3, T1)
#undef PV_STEP
      const int t = it * 64 + lane;
      u32x4 yw; yw.x = pk2(y[0].x, y[0].y); yw.y = pk2(y[1].x, y[1].y); yw.z = pk2(y[2].x, y[2].y); yw.w = pk2(y[3].x, y[3].y);
      *(u32x4*)(YT + ((size_t)cg * TREAL + t) * 8) = yw;
    }
    __syncthreads();
  }
}
DI void ph_final8(int wv2, const float* __restrict__ H1, const float* __restrict__ YT, const float* __restrict__ gf, float* __restrict__ out) {
  const int lane = fresh_tid() & 63;
  const int t0 = wv2 * 2;
  f32x4 y[2][2][2];
#pragma unroll
  for (int j = 0; j < 2; ++j) {
    const f32x4* yp = (const f32x4*)(YT + ((size_t)(lane + 64 * j) * TREAL + t0) * 8);
    y[j][0][0] = yp[0]; y[j][0][1] = yp[1]; y[j][1][0] = yp[2]; y[j][1][1] = yp[3];
  }
#pragma unroll
  for (int q = 0; q < 2; ++q) {
    const size_t rowoff = (size_t)(t0 + q) * D;
    float ss = 0.f;
#pragma unroll
    for (int j = 0; j < 2; ++j)
#pragma unroll
      for (int hf = 0; hf < 2; ++hf) {
        const f32x4 hv = *(const f32x4*)(H1 + rowoff + (lane + 64 * j) * 8 + hf * 4);
        f32x4& yy = y[j][q][hf];
        yy.x += hv.x; yy.y += hv.y; yy.z += hv.z; yy.w += hv.w;
        ss += yy.x * yy.x + yy.y * yy.y + yy.z * yy.z + yy.w * yy.w;
      }
    ss = wave_sum(ss);
    const float sc = rsqrtf(ss * (1.0f / D) + EPS);
#pragma unroll
    for (int j = 0; j < 2; ++j)
#pragma unroll
      for (int hf = 0; hf < 2; ++hf) {
        const f32x4 gg = *(const f32x4*)(gf + (lane + 64 * j) * 8 + hf * 4);
        const f32x4 yy = y[j][q][hf];
        *(f32x4*)(out + rowoff + (lane + 64 * j) * 8 + hf * 4) = (f32x4){yy.x * sc * gg.x, yy.y * sc * gg.y, yy.z * sc * gg.z, yy.w * sc * gg.w};
      }
  }
}


DI void ph_final_lds(int unit, char* smem, const bf16_t* __restrict__ H1, const bf16_t* __restrict__ YT, const float* __restrict__ gf, float* __restrict__ out) {
  float (*h2)[1028] = (float (*)[1028])smem;
  const int tid = fresh_tid(), lane = tid & 63, wave = tid >> 6;
  const int t0 = unit * 32;
#pragma unroll
  for (int rr = 0; rr < 4; ++rr) {
    const int r = wave * 4 + rr;
    const bf16_t* hp = H1 + (size_t)(t0 + r) * D;
#pragma unroll
    for (int j = 0; j < 2; ++j) {
      const u32x4 hw = *(const u32x4*)(hp + j * 512 + lane * 8);
      *(f32x4*)&h2[r][j * 512 + lane * 8] = (f32x4){bflo(hw.x), bfhi(hw.x), bflo(hw.y), bfhi(hw.y)};
      *(f32x4*)&h2[r][j * 512 + lane * 8 + 4] = (f32x4){bflo(hw.z), bfhi(hw.z), bflo(hw.w), bfhi(hw.w)};
    }
  }
  __syncthreads();
  {
    const int tok = lane & 31;
#pragma unroll 4
    for (int cg = wave * 2 + (lane >> 5); cg < 128; cg += 16) {
      const u32x4 yw = *(const u32x4*)(YT + ((size_t)cg * TREAL + t0 + tok) * 8);
      f32x4* hp = (f32x4*)&h2[tok][cg * 8];
      f32x4 a = hp[0], b4 = hp[1];
      a.x += bflo(yw.x); a.y += bfhi(yw.x); a.z += bflo(yw.y); a.w += bfhi(yw.y);
      b4.x += bflo(yw.z); b4.y += bfhi(yw.z); b4.z += bflo(yw.w); b4.w += bfhi(yw.w);
      hp[0] = a; hp[1] = b4;
    }
  }
  __syncthreads();
#pragma unroll
  for (int rr = 0; rr < 4; ++rr) {
    const int r = wave * 4 + rr;
    f32x4 v[4]; float ss = 0.f;
#pragma unroll
    for (int j = 0; j < 4; ++j) { v[j] = *(const f32x4*)&h2[r][j * 256 + lane * 4]; ss += v[j].x * v[j].x + v[j].y * v[j].y + v[j].z * v[j].z + v[j].w * v[j].w; }
    ss = wave_sum(ss);
    const float sc = rsqrtf(ss * (1.0f / D) + EPS);
    float* op = out + (size_t)(t0 + r) * D;
#pragma unroll
    for (int j = 0; j < 4; ++j) {
      const f32x4 gg = *(const f32x4*)(gf + j * 256 + lane * 4);
      *(f32x4*)(op + j * 256 + lane * 4) = (f32x4){v[j].x * sc * gg.x, v[j].y * sc * gg.y, v[j].z * sc * gg.z, v[j].w * sc * gg.w};
    }
  }
  __syncthreads();
}

typedef int i32x4 __attribute__((ext_vector_type(4)));
constexpr size_t WS_XQ = 861 * MiB;
constexpr size_t WS_XS = 943 * MiB;
DI unsigned pack_i8x4(float a, float b, float c, float d) {
  const int ia = __float2int_rn(a), ib = __float2int_rn(b), ic = __float2int_rn(c), id = __float2int_rn(d);
  return ((unsigned)ia & 255u) | (((unsigned)ib & 255u) << 8) | (((unsigned)ic & 255u) << 16) | ((unsigned)id << 24);
}
DI u32x4 quant_row16_i8(const float* __restrict__ rowp, int lane, float& sc) {
  const f32x4* rp = (const f32x4*)(rowp + lane * 16);
  const f32x4 a = rp[0], b = rp[1], c = rp[2], d = rp[3];
  float m = fmaxf(fmaxf(fmaxf(fabsf(a.x), fabsf(a.y)), fmaxf(fabsf(a.z), fabsf(a.w))), fmaxf(fmaxf(fabsf(b.x), fabsf(b.y)), fmaxf(fabsf(b.z), fabsf(b.w))));
  m = fmaxf(m, fmaxf(fmaxf(fmaxf(fabsf(c.x), fabsf(c.y)), fmaxf(fabsf(c.z), fabsf(c.w))), fmaxf(fmaxf(fabsf(d.x), fabsf(d.y)), fmaxf(fabsf(d.z), fabsf(d.w)))));
  m = wave_max(m);
  sc = m > 0.f ? m * (1.0f / 127.0f) : 1.0f;
  const float inv = 1.0f / sc;
  u32x4 o;
  o.x = pack_i8x4(a.x * inv, a.y * inv, a.z * inv, a.w * inv); o.y = pack_i8x4(b.x * inv, b.y * inv, b.z * inv, b.w * inv);
  o.z = pack_i8x4(c.x * inv, c.y * inv, c.z * inv, c.w * inv); o.w = pack_i8x4(d.x * inv, d.y * inv, d.z * inv, d.w * inv);
  return o;
}
DI void ph_convert_eu_i8(const float* __restrict__ src, u8_t* __restrict__ EUq, float* __restrict__ scaleU) {
  const int tid = fresh_tid(), lane = tid & 63, wave = tid >> 6;
  for (int e = (blockIdx.x * 8 + wave) * 2; e < NEXP; e += gridDim.x * 16) {
    float sc0, sc1 = 1.f;
    const bool two = e + 1 < NEXP;
    const u32x4 o0 = quant_row16_i8(src + (size_t)e * D, lane, sc0);
    u32x4 o1 = o0;
    if (two) o1 = quant_row16_i8(src + (size_t)(e + 1) * D, lane, sc1);
    *(u32x4*)(EUq + ((size_t)(lane >> 3) * NEXP + e) * 128 + (lane & 7) * 16) = o0;
    if (two) *(u32x4*)(EUq + ((size_t)(lane >> 3) * NEXP + e + 1) * 128 + (lane & 7) * 16) = o1;
    if (lane == 0) { scaleU[e] = sc0; if (two) scaleU[e + 1] = sc1; }
  }
}
DI void ph_norm2_rows(int vb, const bf16_t* __restrict__ src, const float* __restrict__ gain, float* __restrict__ R2, u8_t* __restrict__ XQ, float* __restrict__ XS) {
  const int tid256_ = fresh_tid() & 255;
  const int row0 = vb * 16 + (TID >> 6) * 4, lane = TID & 63;
  u32x2 raw[4][4];
#pragma unroll
  for (int rr = 0; rr < 4; ++rr)
#pragma unroll
    for (int j = 0; j < 4; ++j) raw[rr][j] = *(const u32x2*)(src + (size_t)(row0 + rr) * D + j * 256 + lane * 4);
  f32x4 gg[4];
#pragma unroll
  for (int j = 0; j < 4; ++j) gg[j] = *(const f32x4*)(gain + j * 256 + lane * 4);
#pragma unroll
  for (int rr = 0; rr < 4; ++rr) {
    f32x4 v[4]; float ss = 0.f;
#pragma unroll
    for (int j = 0; j < 4; ++j) {
      v[j] = (f32x4){bflo(raw[rr][j].x), bfhi(raw[rr][j].x), bflo(raw[rr][j].y), bfhi(raw[rr][j].y)};
      ss += v[j].x * v[j].x + v[j].y * v[j].y + v[j].z * v[j].z + v[j].w * v[j].w;
    }
    ss = wave_sum(ss);
    const float r = rsqrtf(ss * (1.0f / D) + EPS);
    if (lane == 0) R2[row0 + rr] = r;
#pragma unroll
    for (int j = 0; j < 4; ++j) {
      const float a0 = v[j].x * gg[j].x, a1 = v[j].y * gg[j].y, a2 = v[j].z * gg[j].z, a3 = v[j].w * gg[j].w;
      float m = fmaxf(fmaxf(fabsf(a0), fabsf(a1)), fmaxf(fabsf(a2), fabsf(a3)));
#pragma unroll
      for (int sh = 16; sh >= 1; sh >>= 1) m = fmaxf(m, __shfl_xor(m, sh));
      const float inv = m > 0.f ? 127.0f / m : 0.f;
      *(unsigned*)(XQ + (size_t)(row0 + rr) * D + j * 256 + lane * 4) = pack_i8x4(a0 * inv, a1 * inv, a2 * inv, a3 * inv);
      if ((lane & 31) == 0) XS[(size_t)(row0 + rr) * 8 + 2 * j + (lane >> 5)] = m * r * (1.0f / 127.0f);
    }
  }
}
DI int dpp_i(int v, const int sel) {
  if (sel == 0) return __builtin_amdgcn_update_dpp(0, v, 0xB1, 0xF, 0xF, true);
  if (sel == 1) return __builtin_amdgcn_update_dpp(0, v, 0x4E, 0xF, 0xF, true);
  return __builtin_amdgcn_update_dpp(0, v, 0x141, 0xF, 0xF, true);
}
DI int dpp_isum8(int v) { v += dpp_i(v, 0); v += dpp_i(v, 1); v += dpp_i(v, 2); return v; }
template <int HF> DI void peer_ud4_issue(PeerUHalf& H, unsigned idxpair, int lane, const u8_t* __restrict__ tab) {
#pragma unroll
  for (int jj = 0; jj < 8; ++jj) {
    const int j = 8 * HF + jj;
    const unsigned w = (unsigned)__shfl((int)idxpair, (lane & ~7) + (j >> 1));
    const unsigned e = (j & 1) ? (w >> 16) : (w & 0xffffu);
    H.u[jj] = *(const u32x4*)(tab + (size_t)e * 128);
  }
}
template <int HF> DI void peer_ud4_compute(const PeerUHalf& H, const u32x4 xq, int sub, int& res0, int& res1) {
#pragma unroll
  for (int jj = 0; jj < 8; ++jj) {
    const int j = 8 * HF + jj;
    int acc = 0;
    acc = __builtin_amdgcn_sdot4((int)H.u[jj].x, (int)xq.x, acc, false); acc = __builtin_amdgcn_sdot4((int)H.u[jj].y, (int)xq.y, acc, false);
    acc = __builtin_amdgcn_sdot4((int)H.u[jj].z, (int)xq.z, acc, false); acc = __builtin_amdgcn_sdot4((int)H.u[jj].w, (int)xq.w, acc, false);
    acc = dpp_isum8(acc);
    if (sub == (j >> 1)) { if (j & 1) res1 = acc; else res0 = acc; }
  }
}
DI void ph_peer_u_d4(int xi, int nx, int wv, int nwv, const u8_t* __restrict__ XQ, const float* __restrict__ XS, const u8_t* __restrict__ EUq,
                     const unsigned short* __restrict__ EIDX, bf16_t* __restrict__ PP) {
  const int lane = fresh_tid() & 63, sub = lane & 7;
  const int ntok = (TREAL - wv + nwv - 1) / nwv;
#define PU_TOK(i) (wv + ((i) < ntok ? (i) : ntok - 1) * nwv)
#define PU_IDX(t) __builtin_nontemporal_load((const unsigned*)(EIDX + (size_t)(t) * 128) + lane)
#define PU_LDX(xq_, xs_, t) { xq_ = *(const u32x4*)(xbase + (size_t)(t) * D); xs_ = XS[(size_t)(t) * 8 + s]; }
#define PU_STORE(t, r0, r1, xs_) __builtin_nontemporal_store(pk2((float)(r0) * (xs_), (float)(r1) * (xs_)), (unsigned*)(pp + (size_t)(t) * 128) + lane)
  for (int s = xi; s < 8; s += nx) {
    const u8_t* tab = EUq + (size_t)s * NEXP * 128 + sub * 16;
    const u8_t* xbase = XQ + s * 128 + sub * 16;
    bf16_t* pp = PP + (size_t)s * TREAL * 128;
    PeerUHalf HA, HB, HC;
    int ta = PU_TOK(0), tb = PU_TOK(1), tc = PU_TOK(2);
    unsigned ia = PU_IDX(ta), ib = PU_IDX(tb), ic = PU_IDX(tc);
    u32x4 xqa; float xsa; PU_LDX(xqa, xsa, ta);
    peer_ud4_issue<0>(HA, ia, lane, tab);
    peer_ud4_issue<1>(HB, ia, lane, tab);
    for (int i = 0; i < ntok; i += 3) {
      const int td = PU_TOK(i + 3), te = PU_TOK(i + 4), tf = PU_TOK(i + 5);
      u32x4 xqb, xqc, xqd; float xsb, xsc, xsd;
      int r0, r1;
      peer_ud4_issue<0>(HC, ib, lane, tab); PU_LDX(xqb, xsb, tb); const unsigned id = PU_IDX(td);
      r0 = 0; r1 = 0;
      peer_ud4_compute<0>(HA, xqa, sub, r0, r1);
      peer_ud4_issue<1>(HA, ib, lane, tab);
      peer_ud4_compute<1>(HB, xqa, sub, r0, r1);
      PU_STORE(ta, r0, r1, xsa);
      peer_ud4_issue<0>(HB, ic, lane, tab); PU_LDX(xqc, xsc, tc); const unsigned ie = PU_IDX(te);
      r0 = 0; r1 = 0;
      peer_ud4_compute<0>(HC, xqb, sub, r0, r1);
      peer_ud4_issue<1>(HC, ic, lane, tab);
      peer_ud4_compute<1>(HA, xqb, sub, r0, r1);
      PU_STORE(tb, r0, r1, xsb);
      peer_ud4_issue<0>(HA, id, lane, tab); PU_LDX(xqd, xsd, td); const unsigned if_ = PU_IDX(tf);
      r0 = 0; r1 = 0;
      peer_ud4_compute<0>(HB, xqc, sub, r0, r1);
      peer_ud4_issue<1>(HB, id, lane, tab);
      peer_ud4_compute<1>(HC, xqc, sub, r0, r1);
      PU_STORE(tc, r0, r1, xsc);
      ta = td; tb = te; tc = tf; ib = ie; ic = if_; xqa = xqd; xsa = xsd;
    }
  }
#undef PU_TOK
#undef PU_IDX
#undef PU_LDX
#undef PU_STORE
}

struct PUI { i32x4 a[8]; };
struct PUE { int e[8]; };
DI void pui_idx(PUE& E, const unsigned short* __restrict__ EIDX, int t, int c16) {
#pragma unroll
  for (int tau = 0; tau < 8; ++tau) E.e[tau] = EIDX[(size_t)t * 128 + 16 * tau + c16];
}
template <int HF> DI void pui_issue(PUI& H, const PUE& E, const u8_t* __restrict__ tab) {
#pragma unroll
  for (int tt = 0; tt < 4; ++tt) {
    const u8_t* pz = tab + (size_t)E.e[4 * HF + tt] * 128;
    H.a[2 * tt] = *(const i32x4*)pz; H.a[2 * tt + 1] = *(const i32x4*)(pz + 64);
  }
}
DI i32x4 pui_compute(const PUI& H, const i32x4 xb0, const i32x4 xb1, int c16) {
  i32x4 out = {0, 0, 0, 0};
#pragma unroll
  for (int tt = 0; tt < 4; ++tt) {
    i32x4 acc = {0, 0, 0, 0};
    acc = __builtin_amdgcn_mfma_i32_16x16x64_i8(H.a[2 * tt], xb0, acc, 0, 0, 0);
    acc = __builtin_amdgcn_mfma_i32_16x16x64_i8(H.a[2 * tt + 1], xb1, acc, 0, 0, 0);
    if ((c16 & 3) == tt) out = acc;
  }
  return out;
}
DI void ph_peer_u_i8(int xi, int nx, int wv, int nwv, const u8_t* __restrict__ XQ, const float* __restrict__ XS, const u8_t* __restrict__ EUq,
                     const unsigned short* __restrict__ EIDX, bf16_t* __restrict__ PP) {
  const int lane = fresh_tid() & 63, c16 = lane & 15, q = lane >> 4;
  const int ntok = (TREAL - wv + nwv - 1) / nwv;
#define PU_TOK(i) (wv + ((i) < ntok ? (i) : ntok - 1) * nwv)
#define PU_LDX(x0_, x1_, xs_, t) { x0_ = *(const i32x4*)(xbase + (size_t)(t) * D); x1_ = *(const i32x4*)(xbase + (size_t)(t) * D + 64); xs_ = XS[(size_t)(t) * 8 + s]; }
#define PU_STORE(t, o0, o1, xs_) { const i32x4 sel = (c16 & 4) ? (o1) : (o0); \
    if (c16 < 8) { u32x2 w_; w_.x = pk2((float)sel.x * (xs_), (float)sel.y * (xs_)); w_.y = pk2((float)sel.z * (xs_), (float)sel.w * (xs_)); \
      __builtin_nontemporal_store(w_, (u32x2*)(pp + (size_t)(t) * 128 + 16 * c16 + 4 * q)); } }
  for (int s = xi; s < 8; s += nx) {
    const u8_t* tab = EUq + (size_t)s * NEXP * 128 + q * 16;
    const u8_t* xbase = XQ + s * 128 + q * 16;
    bf16_t* pp = PP + (size_t)s * TREAL * 128;
    PUI HA, HB, HC;
    PUE Ea, Eb, Ec, Ed;
    int ta = PU_TOK(0), tb = PU_TOK(1), tc = PU_TOK(2);
    pui_idx(Ea, EIDX, ta, c16); pui_idx(Eb, EIDX, tb, c16); pui_idx(Ec, EIDX, tc, c16);
    i32x4 xa0, xa1; float xsa; PU_LDX(xa0, xa1, xsa, ta);
    pui_issue<0>(HA, Ea, tab);
    pui_issue<1>(HB, Ea, tab);
    for (int i = 0; i < ntok; i += 3) {
      const int td = PU_TOK(i + 3), te = PU_TOK(i + 4), tf = PU_TOK(i + 5);
      i32x4 xb0, xb1, xc0, xc1, xd0, xd1; float xsb, xsc, xsd;
      i32x4 o0, o1;
      pui_issue<0>(HC, Eb, tab); PU_LDX(xb0, xb1, xsb, tb); pui_idx(Ed, EIDX, td, c16);
      o0 = pui_compute(HA, xa0, xa1, c16);
      pui_issue<1>(HA, Eb, tab);
      o1 = pui_compute(HB, xa0, xa1, c16);
      PU_STORE(ta, o0, o1, xsa);
      pui_issue<0>(HB, Ec, tab); PU_LDX(xc0, xc1, xsc, tc); pui_idx(Eb, EIDX, te, c16);
      o0 = pui_compute(HC, xb0, xb1, c16);
      pui_issue<1>(HC, Ec, tab);
      o1 = pui_compute(HA, xb0, xb1, c16);
      PU_STORE(tb, o0, o1, xsb);
      pui_issue<0>(HA, Ed, tab); PU_LDX(xd0, xd1, xsd, td); pui_idx(Ec, EIDX, tf, c16);
      o0 = pui_compute(HB, xc0, xc1, c16);
      pui_issue<1>(HB, Ed, tab);
      o1 = pui_compute(HC, xc0, xc1, c16);
      PU_STORE(tc, o0, o1, xsc);
      ta = td; tb = te; tc = tf; xa0 = xd0; xa1 = xd1; xsa = xsd;
    }
  }
#undef PU_TOK
#undef PU_LDX
#undef PU_STORE
}

#define XB_TMO      128
#define XB_XCNT(j)  (256  + 64 * (j))
#define XB_XSUB(j)  (1280 + 64 * (j))
#define XB_XGEN(j)  (2304 + 64 * (j))
#define XB_TOP      3328
#define XB_TOPGEN   3392
#define XCD_BAR_WORDS 3456
#define XB_SPIN_CAP (1u << 20)
#define LAS __attribute__((address_space(3)))
DI unsigned xb_ld(unsigned* p)              { return __hip_atomic_load(p, __ATOMIC_RELAXED, __HIP_MEMORY_SCOPE_AGENT); }
DI unsigned xb_add(unsigned* p, unsigned v) { return __hip_atomic_fetch_add(p, v, __ATOMIC_RELAXED, __HIP_MEMORY_SCOPE_AGENT); }
DI unsigned xb_xcc_id() { return (unsigned)__builtin_amdgcn_s_getreg((3 << 11) | 20) & 0xFu; }
#define XB_SPIN(cond, bar) do { unsigned _sp = 0; while (cond) { __builtin_amdgcn_s_sleep(1); \
    if ((++_sp & 255u) == 0u) { if (xb_ld(&(bar)[XB_TMO])) break; if (_sp > XB_SPIN_CAP) { atomicAdd(&(bar)[XB_TMO], 1u); break; } } } } while (0)
struct XcdBarrier { unsigned* bar; unsigned x; volatile unsigned* st; };
DI XcdBarrier xcd_barrier_post(unsigned* bar, volatile unsigned* st) {
  XcdBarrier b; b.bar = bar; b.x = xb_xcc_id(); b.st = st;
  if (threadIdx.x == 0) (void)xb_add(&bar[XB_XCNT(b.x)], 1u);
  return b;
}
DI void xcd_barrier_complete(unsigned* bar, unsigned x, unsigned& nloc, unsigned& nx) {
  const unsigned G = gridDim.x;
  unsigned sum, cnt, mine, sp = 0u;
  for (;;) {
    sum = 0u; cnt = 0u; mine = 0u;
#pragma unroll
    for (unsigned j = 0; j < 16; ++j) { const unsigned c = xb_ld(&bar[XB_XCNT(j)]); sum += c; cnt += (c > 0u) ? 1u : 0u; mine = (j == x) ? c : mine; }
    if (sum == G) break;
    __builtin_amdgcn_s_sleep(1);
    if ((++sp & 255u) == 0u) { if (xb_ld(&bar[XB_TMO])) break; if (sp > XB_SPIN_CAP) { atomicAdd(&bar[XB_TMO], 1u); break; } }
  }
  nloc = mine > 0u ? mine : 1u; nx = cnt > 0u ? cnt : 1u;
}
DI void xcd_barrier(const XcdBarrier& b) {
  asm volatile("s_waitcnt vmcnt(0)" ::: "memory");
  __syncthreads();
  if (threadIdx.x == 0) {
    unsigned* bar = b.bar;
    __builtin_amdgcn_s_waitcnt(0);
    unsigned nloc = b.st[0], nx = b.st[1];
    if (nloc == 0u) { xcd_barrier_complete(bar, b.x, nloc, nx); b.st[0] = nloc; b.st[1] = nx; }
    const unsigned old = xb_add(&bar[XB_XSUB(b.x)], 1u);
    const unsigned gen = old / nloc;
    if (old + 1u == (gen + 1u) * nloc) {
      __builtin_amdgcn_fence(__ATOMIC_RELEASE, "agent");
      asm volatile("s_waitcnt vmcnt(0)" ::: "memory");
      const unsigned og = xb_add(&bar[XB_TOP], 1u);
      const unsigned tg = og / nx;
      if (og + 1u == (tg + 1u) * nx) xb_add(&bar[XB_TOPGEN], 1u);
      else XB_SPIN(xb_ld(&bar[XB_TOPGEN]) == tg, bar);
      __builtin_amdgcn_fence(__ATOMIC_ACQUIRE, "agent");
      xb_add(&bar[XB_XGEN(b.x)], 1u);
      asm volatile("s_waitcnt vmcnt(0)" ::: "memory");
    } else {
      XB_SPIN(xb_ld(&bar[XB_XGEN(b.x)]) == gen, bar);
      __builtin_amdgcn_fence(__ATOMIC_ACQUIRE, "agent");
      asm volatile("s_waitcnt vmcnt(0)" ::: "memory");
    }
  }
  __syncthreads();
}

struct Params {
  const float *x, *meta, *norm1_g, *w_in, *wg, *bg, *sb_g, *gla_g, *w_out, *norm2_g, *w_pq, *sk1, *sk2, *eu, *ev, *gf;
  float* out; char* ws;
};
constexpr int HALF_SMEM = 73728;
constexpr int SMEM_BYTES = 2 * HALF_SMEM;
constexpr size_t WS_BAR = 0;

__global__ void __launch_bounds__(512, 2) k_fused(Params p) {
  extern __shared__ __attribute__((aligned(16))) char smem_dyn[];
  const int half = __builtin_amdgcn_readfirstlane((int)(threadIdx.x >> 8));
  char* smem = smem_dyn + half * HALF_SMEM;
  __shared__ unsigned xb_words[4];
  if (threadIdx.x < 4) xb_words[threadIdx.x] = 0u;
  __syncthreads();
  const XcdBarrier bar = xcd_barrier_post((unsigned*)(p.ws + WS_BAR), xb_words);
  if (threadIdx.x == 0) xb_words[2] = xb_add((unsigned*)(p.ws + WS_XRANK) + bar.x, 1u);
  const int G = 2 * gridDim.x, bid = 2 * blockIdx.x + half;
  char* ws = p.ws;
  bf16_t* WinT = (bf16_t*)(ws + WS_WIN);
  bf16_t* WoutT = (bf16_t*)(ws + WS_WOUT);
  bf16_t* WpqT = (bf16_t*)(ws + WS_WPQ);
  bf16_t* EU = (bf16_t*)(ws + WS_EU);
  bf16_t* EV = (bf16_t*)(ws + WS_EV);
  bf16_t* SK1b = (bf16_t*)(ws + WS_SK1);
  bf16_t* SK2b = (bf16_t*)(ws + WS_SK2);
  bf16_t* A1 = (bf16_t*)(ws + WS_A1);
  float* GO = (float*)(ws + WS_A1);
  bf16_t* A2 = (bf16_t*)(ws + WS_A1);
  InProjOut O;
  O.QSB = (bf16_t*)(ws + WS_QSB); O.KSB = (bf16_t*)(ws + WS_KSB); O.VTSB = (bf16_t*)(ws + WS_VTSB); O.VSB = (bf16_t*)(ws + WS_VSB);
  O.GQ = (bf16_t*)(ws + WS_GQ); O.GK = (bf16_t*)(ws + WS_GK); O.GV = (bf16_t*)(ws + WS_GV); O.GR = (bf16_t*)(ws + WS_GR);
  O.GLR = (float*)(ws + WS_GLR);
  bf16_t* H1 = (bf16_t*)(ws + WS_H1);
  float* R2 = (float*)(ws + WS_XS + 3 * MiB);
  bf16_t* GVT = (bf16_t*)(ws + WS_GVT);
  GlaPtrs GP;
  GP.GQ = O.GQ; GP.GK = O.GK; GP.GVT = GVT; GP.GR = O.GR; GP.GLR = O.GLR; GP.wg = p.wg; GP.bg = p.bg; GP.gla_g = p.gla_g;
  GP.SLOC = (float*)(ws + WS_SLOC); GP.DTOT = (float*)(ws + WS_DTOT); GP.MIX = (bf16_t*)(ws + WS_MIX);
  GlaPrepPtrs GPP; GPP.GQ = O.GQ; GPP.GK = O.GK; GPP.GLR = O.GLR; GPP.wg = p.wg; GPP.bg = p.bg;
  GPP.QT = (bf16_t*)(ws + WS_GQT); GPP.KT = (bf16_t*)(ws + WS_GKT); GPP.KTT = (bf16_t*)(ws + WS_GKTT); GPP.DEC = (float*)(ws + WS_GDEC); GPP.BL = (float*)(ws + WS_GBL);
  GlaPtrs3 GP3; GP3.QT = GPP.QT; GP3.KT = GPP.KT; GP3.KTT = GPP.KTT; GP3.GVT = GVT; GP3.GR = O.GR; GP3.DEC = GPP.DEC; GP3.BL = GPP.BL; GP3.gla_g = p.gla_g;
  GP3.SLOC = GP.SLOC; GP3.DTOT = GP.DTOT; GP3.MIX = GP.MIX;
  bf16_t* MIX = (bf16_t*)(ws + WS_MIX);
  bf16_t* QP = (bf16_t*)(ws + WS_MIX);
  unsigned short* EIDX = (unsigned short*)(ws + WS_EIDX);
  bf16_t* PP = (bf16_t*)(ws + WS_PP);
  bf16_t* YT = (bf16_t*)(ws + WS_PP);
  unsigned* STREAM = (unsigned*)(ws + WS_STREAM);
  float* GATE = (float*)(ws + WS_GATE);

  for (int vb = bid; vb < 3328 + 1024 + 1024; vb += G) {
    if (vb < 3328) ph_transpose_w(vb % 104, vb / 104, smem, p.w_in, p.norm1_g, WinT, D, NIN);
    else if (vb < 4352) { const int t = vb - 3328; ph_transpose_w(t % 32, t / 32, smem, p.w_out, nullptr, WoutT, D, D); }
    else { const int t = vb - 4352; ph_transpose_w(t % 32, t / 32, smem, p.w_pq, p.norm2_g, WpqT, D, D); }
  }
  ph_convert_eu_i8(p.eu, (u8_t*)EU, (float*)(ws + WS_SCU));
  for (int vb = bid; vb < NEXP / 32; vb += G) ph_convert_ev8(vb, smem, p.ev, (u8_t*)EV, (float*)(ws + WS_SCV));
  ph_convert(p.sk1, SK1b, (size_t)8 * 128 * 64 / 8);
  ph_convert(p.sk2, SK2b, (size_t)8 * 128 * 64 / 8);
  ph_zero_pads(O.KSB, O.VSB, O.GQ, O.GK, O.GV);
  for (int vb = bid; vb < TREAL / 16; vb += G) ph_norm_rows<0>(vb, p.x, p.meta, A1);
  __syncthreads();
  for (int mb = blockIdx.x; mb < NIN / 16; mb += gridDim.x) ph_meta(mb, smem_dyn, p.meta, p.norm1_g, p.w_in, O);
  xcd_barrier(bar);
  {
    pg8::Gemm g{A1, WinT, TREAL, NINP, D}; pg8::StaticOrder S; S.init(TREAL, NINP, (int)gridDim.x, (int)blockIdx.x);
    EpiInProj E{O};
    pg8::gemm_phase<EpiInProj, pg8::StaticOrder, true, true>((PG8_LAS unsigned char*)smem_dyn, g, S, E);
  }
  xcd_barrier(bar);
  for (int vb = bid; vb < 64 * 257; vb += G) ph_vtrans(vb, smem, O.VSB, O.VTSB);
  for (int vb = bid; vb < 32 * 258 * 2; vb += G) ph_gvtrans(vb, smem, O.GV, GVT);
  __syncthreads();
  for (int it = blockIdx.x; it < 32 * 129; it += gridDim.x) ph_gla_prep(it, smem_dyn, GPP);
  xcd_barrier(bar);
  for (int it = blockIdx.x; it < 32 * 15; it += gridDim.x) gla_item3<0>(it / 15, it % 15, smem_dyn, GP3);
  for (int vb = bid; vb < 64 * 64; vb += G) ph_sb_attn(vb, O.QSB, O.KSB, O.VTSB, p.sb_g, MIX);
  xcd_barrier(bar);
  for (int it = blockIdx.x; it < 32 * 16; it += gridDim.x) gla_item3<1>(it >> 4, it & 15, smem_dyn, GP3);
  xcd_barrier(bar);
  {
    pg8::Gemm g{MIX, WoutT, TREAL, D, D}; pg8::StaticOrder S; S.init(TREAL, D, (int)gridDim.x, (int)blockIdx.x);
    EpiOut E{p.x, H1};
    pg8::gemm_phase<EpiOut, pg8::StaticOrder, true, true>((PG8_LAS unsigned char*)smem_dyn, g, S, E);
  }
  xcd_barrier(bar);
  for (int vb = bid; vb < TREAL / 16; vb += G) ph_norm2_rows(vb, H1, p.norm2_g, R2, (u8_t*)(ws + WS_XQ), (float*)(ws + WS_XS));
  xcd_barrier(bar);
  {
    pg8::Gemm g{H1, WpqT, TREAL, D, D}; pg8::StaticOrder S; S.init(TREAL, D, (int)gridDim.x, (int)blockIdx.x);
    EpiPQ E{QP, R2};
    pg8::gemm_phase<EpiPQ, pg8::StaticOrder, true, true>((PG8_LAS unsigned char*)smem_dyn, g, S, E);
  }
  xcd_barrier(bar);
  for (int vb = bid; vb < 8 * (TREAL / 128); vb += G) ph_route_v2(vb, smem, QP, SK1b, SK2b, EIDX, GATE);
  xcd_barrier(bar);
  {
    __shared__ int xinfo[4];
    if (threadIdx.x == 0) {
      unsigned* barw = (unsigned*)(p.ws + WS_BAR);
      unsigned cnt = 0, ord = 0, mine = 1;
      for (unsigned j = 0; j < 16; ++j) { const unsigned c = xb_ld(&barw[XB_XCNT(j)]); if (c > 0) { if (j < bar.x) ++ord; ++cnt; } if (j == bar.x) mine = c; }
      xinfo[0] = (int)ord; xinfo[1] = (int)cnt; xinfo[2] = (int)xb_words[2]; xinfo[3] = (int)mine;
    }
    __syncthreads();
    const int xi = xinfo[0], nx = xinfo[1], rank = xinfo[2], nloc = xinfo[3];
    const int wave = __builtin_amdgcn_readfirstlane((int)(threadIdx.x >> 6));
    ph_peer_u_d4(xi, nx, rank * 8 + wave, nloc * 8, (const u8_t*)(ws + WS_XQ), (const float*)(ws + WS_XS), (const u8_t*)EU, EIDX, PP);
  }
  xcd_barrier(bar);
  ph_peer_c8(PP, EIDX, GATE, (const float*)(ws + WS_SCU), (const float*)(ws + WS_SCV), STREAM);
  xcd_barrier(bar);
  ph_peer_v8(smem_dyn, STREAM, (const u8_t*)EV, YT);
  xcd_barrier(bar);
  for (int unit = blockIdx.x; unit < TREAL / 32; unit += gridDim.x) ph_final_lds(unit, smem_dyn, H1, YT, p.gf, p.out);
}

extern "C" void kernel_launch(void* const* d_in, const int* in_sizes, int n_in, void* d_out, int out_size, void* d_ws, size_t ws_size, hipStream_t stream) {
  static int grid = 0;
  if (grid == 0) {
    int dev = 0, cus = 0, per_cu = 0;
    hipGetDevice(&dev);
    hipDeviceGetAttribute(&cus, hipDeviceAttributeMultiprocessorCount, dev);
    hipFuncSetAttribute((const void*)k_fused, hipFuncAttributeMaxDynamicSharedMemorySize, SMEM_BYTES);
    hipOccupancyMaxActiveBlocksPerMultiprocessor(&per_cu, (const void*)k_fused, 512, SMEM_BYTES);
    if (per_cu > 1) per_cu = 1;
    if (per_cu < 1) per_cu = 1;
    grid = cus * per_cu;
  }
  hipMemsetAsync((char*)d_ws + WS_BAR, 0, 32768, stream);
  Params p{};
  p.x = (const float*)d_in[0]; p.meta = (const float*)d_in[1]; p.norm1_g = (const float*)d_in[2]; p.w_in = (const float*)d_in[3];
  p.wg = (const float*)d_in[4]; p.bg = (const float*)d_in[5]; p.sb_g = (const float*)d_in[6]; p.gla_g = (const float*)d_in[7];
  p.w_out = (const float*)d_in[8]; p.norm2_g = (const float*)d_in[9]; p.w_pq = (const float*)d_in[10]; p.sk1 = (const float*)d_in[11];
  p.sk2 = (const float*)d_in[12]; p.eu = (const float*)d_in[13]; p.ev = (const float*)d_in[14]; p.gf = (const float*)d_in[15];
  p.out = (float*)d_out; p.ws = (char*)d_ws;
  void* args[] = {&p};
  hipLaunchCooperativeKernel((const void*)k_fused, dim3(grid), dim3(512), args, SMEM_BYTES, stream);
}
```

```cpp
#include <hip/hip_runtime.h>
#include <stdint.h>
#include <stddef.h>

typedef unsigned short bf16_t;
typedef short bf16x8 __attribute__((ext_vector_type(8)));
typedef float f32x16 __attribute__((ext_vector_type(16)));
typedef float f32x4 __attribute__((ext_vector_type(4)));
typedef float f32x2 __attribute__((ext_vector_type(2)));
typedef unsigned u32x4 __attribute__((ext_vector_type(4)));
typedef unsigned u32x2 __attribute__((ext_vector_type(2)));
typedef __bf16 bf16x2_t __attribute__((ext_vector_type(2)));

#define DI __device__ __forceinline__
__device__ __forceinline__ int fresh_tid() { int t = (int)threadIdx.x; asm volatile("" : "+v"(t)); return t; }
#define TID tid256_
#define MFMA32(a, b, c) __builtin_amdgcn_mfma_f32_32x32x16_bf16((a), (b), (c), 0, 0, 0)

constexpr int D = 1024, NB = 8, SEQ = 8192, NMETA = 16;
constexpr int TREAL = NB * SEQ;
constexpr int MROWS = TREAL + 128;
constexpr int NIN = 3088, NINP = 3328;
constexpr int SBH = 8, SBD = 64;
constexpr int GH = 4, GDK = 64, GDV = 128;
constexpr int KIDX = SEQ + 32;
constexpr int GU = SEQ + 64;
constexpr int NEXP = 16384;
constexpr float EPS = 1e-6f;

constexpr size_t MiB = 1u << 20;
constexpr size_t WS_WIN = 1 * MiB;
constexpr size_t WS_WOUT = 8 * MiB;
constexpr size_t WS_WPQ = 10 * MiB;
constexpr size_t WS_SK1 = 12 * MiB;
constexpr size_t WS_SK2 = 13 * MiB;
constexpr size_t WS_EU = 16 * MiB;
constexpr size_t WS_EV = 48 * MiB;
constexpr size_t WS_A1 = 80 * MiB;
constexpr size_t WS_QSB = 210 * MiB;
constexpr size_t WS_KSB = 274 * MiB;
constexpr size_t WS_VTSB = 339 * MiB;
constexpr size_t WS_GQ = 404 * MiB;
constexpr size_t WS_GK = 437 * MiB;
constexpr size_t WS_H1 = 210 * MiB;
constexpr size_t WS_GV = 470 * MiB;
constexpr size_t WS_GR = 535 * MiB;
constexpr size_t WS_GLR = 599 * MiB;
constexpr size_t WS_LG = 604 * MiB;
constexpr size_t WS_MIX = 669 * MiB;
constexpr size_t WS_EIDX = 797 * MiB;
constexpr size_t WS_GATE = 829 * MiB;
constexpr size_t WS_PP = 470 * MiB;
constexpr size_t WS_STREAM = 726 * MiB;
constexpr size_t WS_XRANK = 16384;
constexpr size_t WS_VSB = 861 * MiB;
constexpr size_t WS_END = 926 * MiB;

DI unsigned f2bf(float f) { unsigned u = __float_as_uint(f); return (u + 0x7fffu + ((u >> 16) & 1u)) >> 16; }
DI float bf2f(unsigned b) { return __uint_as_float(b << 16); }
DI unsigned pk2(float lo, float hi) { f32x2 v = {lo, hi}; return __builtin_bit_cast(unsigned, __builtin_convertvector(v, bf16x2_t)); }
DI float bflo(unsigned u) { return __uint_as_float(u << 16); }
DI float bfhi(unsigned u) { return __uint_as_float(u & 0xffff0000u); }
DI int crow(int reg, int h) { return (reg & 3) + 8 * (reg >> 2) + 4 * h; }
DI float wave_sum(float v) {
#pragma unroll
  for (int o = 32; o >= 1; o >>= 1) v += __shfl_xor(v, o);
  return v;
}
DI float dot2bf(unsigned a, unsigned b, float acc) { return __builtin_amdgcn_fdot2_f32_bf16(__builtin_bit_cast(bf16x2_t, a), __builtin_bit_cast(bf16x2_t, b), acc, false); }
DI float softplus(float z) { return fmaxf(z, 0.f) + __logf(1.f + __expf(-fabsf(z))); }

DI void ph_transpose_w(int bx, int by, char* smem, const float* __restrict__ W, const float* __restrict__ gain, bf16_t* __restrict__ WT, int K, int N) {
  const int tid256_ = fresh_tid() & 255;
  float (*t)[33] = (float (*)[33])smem;
  const int n0 = bx * 32, k0 = by * 32, tx = TID & 31, ty = TID >> 5;
  for (int r = ty; r < 32; r += 8) {
    const int k = k0 + r, n = n0 + tx;
    float v = 0.f;
    if (n < N) { v = W[(size_t)k * N + n]; if (gain) v *= gain[k]; }
    t[r][tx] = v;
  }
  __syncthreads();
  for (int r = ty; r < 32; r += 8) {
    const int n = n0 + r, k = k0 + tx;
    WT[(size_t)n * K + k] = (bf16_t)f2bf(t[tx][r]);
  }
  __syncthreads();
}
DI void ph_convert(const float* __restrict__ src, bf16_t* __restrict__ dst, size_t n8) {
  size_t i = (size_t)blockIdx.x * blockDim.x + threadIdx.x;
  const size_t stride = (size_t)gridDim.x * blockDim.x;
  for (; i < n8; i += stride) {
    const f32x4 a = ((const f32x4*)src)[2 * i], b = ((const f32x4*)src)[2 * i + 1];
    u32x4 o; o.x = pk2(a.x, a.y); o.y = pk2(a.z, a.w); o.z = pk2(b.x, b.y); o.w = pk2(b.z, b.w);
    ((u32x4*)dst)[i] = o;
  }
}
DI void ph_zero_pads(bf16_t* KSB, bf16_t* VTSB, bf16_t* GQ, bf16_t* GK, bf16_t* GVT) {
  const int tid = blockIdx.x * blockDim.x + threadIdx.x, nth = gridDim.x * blockDim.x;
  for (int i = tid; i < 64 * 16 * 64; i += nth) { const int bh = i / 1024, r = i % 1024; KSB[(size_t)bh * KIDX * 64 + r] = 0; }
  for (int i = tid; i < 64 * 64 * 16; i += nth) { const int row = i / 16, c = i % 16; VTSB[(size_t)row * KIDX + c] = 0; }
  for (int i = tid; i < 32 * 48 * 64; i += nth) { const int bh = i / 3072, r = i % 3072; GQ[(size_t)bh * GU * 64 + r] = 0; GK[(size_t)bh * GU * 64 + r] = 0; }
  for (int i = tid; i < 32 * 128 * 48; i += nth) { const int row = i / 48, c = i % 48; GVT[(size_t)row * GU + c] = 0; }
}

template <int MODE>
DI void ph_norm_rows(int vb, const float* __restrict__ src, const float* __restrict__ meta, bf16_t* __restrict__ dst) {
  const int tid256_ = fresh_tid() & 255;
  const int row0 = vb * 16 + (TID >> 6) * 4, lane = TID & 63;
  f32x4 v[4][4];
#pragma unroll
  for (int rr = 0; rr < 4; ++rr)
#pragma unroll
    for (int j = 0; j < 4; ++j) v[rr][j] = *(const f32x4*)(src + (size_t)(row0 + rr) * D + j * 256 + lane * 4);
  f32x4 gg[4];
#pragma unroll
  for (int j = 0; j < 4; ++j) { gg[j] = (f32x4){1.f, 1.f, 1.f, 1.f}; if (MODE == 1) gg[j] = *(const f32x4*)(meta + j * 256 + lane * 4); }
#pragma unroll
  for (int rr = 0; rr < 4; ++rr) {
    float ss = 0.f;
#pragma unroll
    for (int j = 0; j < 4; ++j) ss += v[rr][j].x * v[rr][j].x + v[rr][j].y * v[rr][j].y + v[rr][j].z * v[rr][j].z + v[rr][j].w * v[rr][j].w;
    ss = wave_sum(ss);
    const float r = rsqrtf(ss * (1.0f / D) + EPS);
#pragma unroll
    for (int j = 0; j < 4; ++j) {
      u32x2 o; o.x = pk2(v[rr][j].x * r * gg[j].x, v[rr][j].y * r * gg[j].y); o.y = pk2(v[rr][j].z * r * gg[j].z, v[rr][j].w * r * gg[j].w);
      *(u32x2*)(dst + (size_t)(row0 + rr) * D + j * 256 + lane * 4) = o;
    }
  }
}

namespace pg8 {
#define PG8_LAS __attribute__((address_space(3)))
typedef unsigned short bf16_t;
typedef short bf16x8 __attribute__((ext_vector_type(8)));
typedef float f32x4 __attribute__((ext_vector_type(4)));
typedef unsigned u32x4 __attribute__((ext_vector_type(4)));
constexpr int BM = 256, BK = 64, HALF = 128, HTB = HALF * BK * 2  , STAGE_BYTES = 8 * HTB, NXCD = 8, WGM = 8;

__host__ __device__ __forceinline__ int lds_byte(int r, int c) { const int st = (r >> 4) * 2 + (c >> 5), rr = r & 15, cc = c & 31, ob = rr * 64 + cc * 2; return st * 1024 + (ob ^ (((ob >> 9) & 1) << 5)); }
__host__ __device__ __forceinline__ void stage_rc(int b, int& R, int& C) { const int st = b / 1024, sb = b % 1024, swz = sb ^ (((sb >> 9) & 1) << 5); R = (st >> 1) * 16 + swz / 64; C = (st & 1) * 32 + (swz % 64) / 2; }
__host__ __device__ __forceinline__ int perm32(int rho) { const int n = rho >> 4, i = rho & 15; return 8 * (i >> 2) + 4 * n + (i & 3); }

struct Unit { int pm, pn; };
struct Gemm { const bf16_t* A; const bf16_t* Bt; int M, N, K; };

struct StaticOrder {
    int nM, nN, nwg, G, c;
    __host__ __device__ void init(int M, int N, int G_, int c_) { nM = M / BM; nN = N / BM; nwg = nM * nN; G = G_; c = c_; }
    __host__ __device__ bool next(int i, Unit& u) const {
        const long L = (long)i * G + c; if (L >= nwg) return false;
        int wgid = (int)L; { const int q = nwg / NXCD, r = nwg % NXCD, xcd = wgid % NXCD, off = wgid / NXCD; wgid = (xcd < r ? xcd * (q + 1) : r * (q + 1) + (xcd - r) * q) + off; }
        const int nig = WGM * nN, gid = wgid / nig, fm = gid * WGM, gsz = (nM - fm) < WGM ? (nM - fm) : WGM;
        u.pm = fm + ((wgid % nig) % gsz); u.pn = (wgid % nig) / gsz; return true;
    }
    __device__ __forceinline__ void a_ready(const Unit&) const {}
    __device__ __forceinline__ void done(const Unit&) const {}
};

template <class Epi, class Sched, bool ALIGN_EPI = false, bool SP2 = false>
__device__ __forceinline__ void gemm_phase(PG8_LAS unsigned char* lds, const Gemm g, const Sched& S, const Epi& E) {
    const int tid = fresh_tid(), wid = __builtin_amdgcn_readfirstlane(tid >> 6), lane = tid & 63, wr = wid >> 2, wc = wid & 3, fr = lane & 15, fq = lane >> 4;
    const int K = g.K, nt = K / BK;
    unsigned voffA[2], voffB[2];
#pragma unroll
    for (int i = 0; i < 2; ++i) { int R, C; stage_rc(tid * 16 + i * 8192, R, C); const int Rb = Epi::PERM ? ((R & ~31) + perm32(R & 31)) : R;
        voffA[i] = (unsigned)(R * K + C) * 2u; voffB[i] = (unsigned)(Rb * K + C) * 2u; }
    const size_t kstep = (size_t)(BK * 2);
    const size_t hstep = (size_t)HALF * K * 2;
    const size_t tstep = 2 * hstep;
    const unsigned ldsw = (unsigned)wid * 1024u;
    const int aoff = lds_byte(wr * 64 + fr, fq * 8), boff = lds_byte(wc * 32 + fr, fq * 8);
#define PG8_SA(b, h) (((b) * 2 + (h)) * HTB)
#define PG8_SB(b, h) ((4 + (b) * 2 + (h)) * HTB)
#define PG8_STAGE(bufoff, gbase, voff) do { _Pragma("unroll") for (int _i = 0; _i < 2; ++_i) \
        __builtin_amdgcn_global_load_lds((const unsigned*)((const char*)(gbase) + (voff)[_i]), (PG8_LAS unsigned*)(lds + (bufoff) + ldsw + _i * 8192), 16, 0, 0); } while (0)
#define PG8_LDA(dst, b, h) do { _Pragma("unroll") for (int m = 0; m < 4; ++m) _Pragma("unroll") for (int k = 0; k < 2; ++k) dst[m][k] = *(const PG8_LAS bf16x8*)(lds + PG8_SA(b, h) + aoff + m * 2048 + k * 1024); } while (0)
#define PG8_LDB(dst, b, h) do { _Pragma("unroll") for (int n = 0; n < 2; ++n) _Pragma("unroll") for (int k = 0; k < 2; ++k) dst[n][k] = *(const PG8_LAS bf16x8*)(lds + PG8_SB(b, h) + boff + n * 2048 + k * 1024); } while (0)
#define PG8_MMA(ai, bj, At, Bt) do { __builtin_amdgcn_s_setprio(1); _Pragma("unroll") for (int m = 0; m < 4; ++m) _Pragma("unroll") for (int n = 0; n < 2; ++n) _Pragma("unroll") for (int k = 0; k < 2; ++k) \
        acc[ai][bj][m][n] = __builtin_amdgcn_mfma_f32_16x16x32_bf16(Bt[n][k], At[m][k], acc[ai][bj][m][n], 0, 0, 0); __builtin_amdgcn_s_setprio(0); } while (0)
#define PG8_WAIT_V(n) asm volatile("s_waitcnt vmcnt(" #n ")" ::: "memory")
#define PG8_WAIT_L(n) asm volatile("s_waitcnt lgkmcnt(" #n ")" ::: "memory")
#define PG8_BAR __builtin_amdgcn_s_barrier()
#define PG8_SCHED __builtin_amdgcn_sched_barrier(0)
    Unit cur, nxt; int ui = 0;
    if (!S.next(0, cur)) return;
    f32x4 acc[2][2][4][2];
#pragma unroll
    for (int a = 0; a < 2; ++a)
#pragma unroll
        for (int b = 0; b < 2; ++b)
#pragma unroll
            for (int m = 0; m < 4; ++m)
#pragma unroll
                for (int n = 0; n < 2; ++n) acc[a][b][m][n] = (f32x4){0.f, 0.f, 0.f, 0.f};
    bf16x8 At[4][2], B0[2][2], B1[2][2];
    const char* cA = (const char*)g.A + (size_t)cur.pm * tstep; const char* cB = (const char*)g.Bt + (size_t)cur.pn * tstep;
    S.a_ready(cur);
    if constexpr (SP2) {
        PG8_STAGE(PG8_SB(0, 0), cB, voffB); PG8_STAGE(PG8_SB(0, 1), cB + hstep, voffB); PG8_STAGE(PG8_SA(0, 0), cA, voffA); PG8_STAGE(PG8_SA(0, 1), cA + hstep, voffA);
        if (wr == 1) PG8_BAR;
        PG8_WAIT_V(2); PG8_BAR;
        PG8_STAGE(PG8_SB(1, 0), cB + kstep, voffB); PG8_STAGE(PG8_SA(1, 0), cA + kstep, voffA); PG8_STAGE(PG8_SB(1, 1), cB + hstep + kstep, voffB);
        PG8_WAIT_V(6); PG8_BAR;
    } else {
        PG8_STAGE(PG8_SB(0, 0), cB, voffB); PG8_STAGE(PG8_SA(0, 0), cA, voffA); PG8_STAGE(PG8_SB(0, 1), cB + hstep, voffB); PG8_STAGE(PG8_SA(0, 1), cA + hstep, voffA);
        if (wr == 1) PG8_BAR;
        PG8_WAIT_V(4); PG8_BAR;
        PG8_STAGE(PG8_SB(1, 0), cB + kstep, voffB); PG8_STAGE(PG8_SA(1, 0), cA + kstep, voffA); PG8_STAGE(PG8_SB(1, 1), cB + hstep + kstep, voffB);
        PG8_WAIT_V(6); PG8_BAR;
    }
    for (;;) {
        const bool has_next = S.next(ui + 1, nxt);
        const char* nA = has_next ? (const char*)g.A + (size_t)nxt.pm * tstep : cA; const char* nB = has_next ? (const char*)g.Bt + (size_t)nxt.pn * tstep : cB;
        for (int t = 0; t < nt; t += 2) {
            const bool last = (t == nt - 2);
            const char* a1 = cA + (size_t)(t + 1) * kstep;
            const char* a2 = last ? nA : cA + (size_t)(t + 2) * kstep; const char* b2 = last ? nB : cB + (size_t)(t + 2) * kstep;
            const char* a3 = a2 + kstep; const char* b3 = b2 + kstep;
            if (last && has_next) S.a_ready(nxt);
            if constexpr (SP2) {
            PG8_LDB(B0, 0, 0); PG8_LDB(B1, 0, 1); PG8_SCHED; PG8_LDA(At, 0, 0); PG8_STAGE(PG8_SA(1, 1), a1 + hstep, voffA);
            PG8_WAIT_V(8); PG8_WAIT_L(0); PG8_BAR; PG8_MMA(0, 0, At, B0); PG8_MMA(0, 1, At, B1); PG8_BAR; PG8_SCHED;
            PG8_LDA(At, 0, 1); PG8_STAGE(PG8_SB(0, 0), b2, voffB); PG8_STAGE(PG8_SB(0, 1), b2 + hstep, voffB); PG8_STAGE(PG8_SA(0, 0), a2, voffA);
            PG8_WAIT_V(8); PG8_WAIT_L(0); PG8_BAR; PG8_MMA(1, 0, At, B0); PG8_MMA(1, 1, At, B1); PG8_BAR; PG8_SCHED;
            PG8_LDB(B0, 1, 0); PG8_LDB(B1, 1, 1); PG8_SCHED; PG8_LDA(At, 1, 0); PG8_STAGE(PG8_SA(0, 1), a2 + hstep, voffA);
            PG8_WAIT_V(8); PG8_WAIT_L(0); PG8_BAR; PG8_MMA(0, 0, At, B0); PG8_MMA(0, 1, At, B1); PG8_BAR; PG8_SCHED;
            PG8_LDA(At, 1, 1); PG8_STAGE(PG8_SB(1, 0), b3, voffB); PG8_STAGE(PG8_SB(1, 1), b3 + hstep, voffB); PG8_STAGE(PG8_SA(1, 0), a3, voffA);
            PG8_WAIT_V(8); PG8_WAIT_L(0); PG8_BAR; PG8_MMA(1, 0, At, B0); PG8_MMA(1, 1, At, B1); PG8_BAR; PG8_SCHED;
            } else {
            PG8_LDB(B0, 0, 0); PG8_SCHED; PG8_LDA(At, 0, 0); PG8_STAGE(PG8_SA(1, 1), a1 + hstep, voffA);
            PG8_WAIT_L(8); PG8_BAR; PG8_WAIT_L(0); PG8_MMA(0, 0, At, B0); PG8_BAR; PG8_SCHED;
            PG8_LDB(B1, 0, 1); PG8_STAGE(PG8_SB(0, 0), b2, voffB);
            PG8_BAR; PG8_WAIT_L(0); PG8_MMA(0, 1, At, B1); PG8_BAR;
            PG8_LDA(At, 0, 1); PG8_STAGE(PG8_SA(0, 0), a2, voffA);
            PG8_BAR; PG8_WAIT_L(0); PG8_MMA(1, 0, At, B0); PG8_BAR; PG8_SCHED;
            PG8_STAGE(PG8_SB(0, 1), b2 + hstep, voffB);
            PG8_WAIT_V(6); PG8_BAR; PG8_MMA(1, 1, At, B1); PG8_BAR;
            PG8_LDB(B0, 1, 0); PG8_SCHED; PG8_LDA(At, 1, 0); PG8_STAGE(PG8_SA(0, 1), a2 + hstep, voffA);
            PG8_WAIT_L(8); PG8_BAR; PG8_WAIT_L(0); PG8_MMA(0, 0, At, B0); PG8_BAR; PG8_SCHED;
            PG8_LDB(B1, 1, 1); PG8_STAGE(PG8_SB(1, 0), b3, voffB);
            PG8_BAR; PG8_WAIT_L(0); PG8_MMA(0, 1, At, B1); PG8_BAR;
            PG8_LDA(At, 1, 1); PG8_STAGE(PG8_SA(1, 0), a3, voffA);
            PG8_BAR; PG8_WAIT_L(0); PG8_MMA(1, 0, At, B0); PG8_BAR; PG8_SCHED;
            PG8_STAGE(PG8_SB(1, 1), b3 + hstep, voffB);
            PG8_WAIT_V(6); PG8_BAR; PG8_MMA(1, 1, At, B1); PG8_BAR;
            }
        }
        if constexpr (ALIGN_EPI) { if (wr == 0) PG8_BAR; }
        if constexpr (!Epi::AFTER_DRAIN) { E(acc, cur, wr, wc, fr, fq); S.done(cur); }
        if (!has_next) break;
#pragma unroll
        for (int a = 0; a < 2; ++a)
#pragma unroll
            for (int b = 0; b < 2; ++b)
#pragma unroll
                for (int m = 0; m < 4; ++m)
#pragma unroll
                    for (int n = 0; n < 2; ++n) acc[a][b][m][n] = (f32x4){0.f, 0.f, 0.f, 0.f};
        cur = nxt; cA = nA; cB = nB; ++ui;
        if constexpr (ALIGN_EPI) { if (wr == 1) PG8_BAR; }
    }
    PG8_WAIT_V(0);
    if constexpr (!ALIGN_EPI) { if (wr == 0) PG8_BAR; }
    PG8_BAR;
    if constexpr (Epi::AFTER_DRAIN) { E.fused(acc, cur, wr, wc, fr, fq, lds, wid, lane); S.done(cur); }
#undef PG8_SA
#undef PG8_SB
#undef PG8_STAGE
#undef PG8_LDA
#undef PG8_LDB
#undef PG8_MMA
#undef PG8_WAIT_V
#undef PG8_WAIT_L
#undef PG8_BAR
#undef PG8_SCHED
}
}

struct InProjOut { bf16_t *QSB, *KSB, *VSB, *VTSB, *GQ, *GK, *GV, *GR; float* GLR; };

struct EpiInProj {
  static constexpr bool PERM = true, AFTER_DRAIN = false;
  InProjOut O; bf16_t* GVT; char* stage;
  DI void store_vt(const pg8::f32x4 (&acc)[2][2][4][2], const pg8::Unit& u, int wr, int wc, int fr, int fq) const {
    bf16_t* st = (bf16_t*)(stage + (wr * 4 + wc) * 1280);
    const int lane = fr + 16 * fq;
    const int rc = lane >> 2, r8 = lane & 3;
#pragma unroll
    for (int ai = 0; ai < 2; ++ai)
#pragma unroll
      for (int bj = 0; bj < 2; ++bj)
#pragma unroll
        for (int mp = 0; mp < 2; ++mp)
#pragma unroll
          for (int ch = 0; ch < 2; ++ch) {
            if ((fq >> 1) == ch) {
#pragma unroll
              for (int m2 = 0; m2 < 2; ++m2)
#pragma unroll
                for (int n = 0; n < 2; ++n) {
                  const pg8::f32x4 v = acc[ai][bj][2 * mp + m2][n];
                  const int cl = 8 * (fq & 1) + 4 * n, rl = 16 * m2 + fr;
                  st[(cl + 0) * 40 + rl] = (bf16_t)f2bf(v[0]); st[(cl + 1) * 40 + rl] = (bf16_t)f2bf(v[1]);
                  st[(cl + 2) * 40 + rl] = (bf16_t)f2bf(v[2]); st[(cl + 3) * 40 + rl] = (bf16_t)f2bf(v[3]);
                }
            }
            asm volatile("s_waitcnt lgkmcnt(0)" ::: "memory");
            const u32x4 w = *(const u32x4*)&st[rc * 40 + 8 * r8];
            asm volatile("" ::: "memory");
            const int col = u.pn * 256 + bj * 128 + wc * 32 + 16 * ch + rc;
            const int row = u.pm * 256 + ai * 128 + wr * 64 + 32 * mp + 8 * r8;
            const int b = row >> 13, i = row & 8191;
            bf16_t* dst;
            if (u.pn < 6) { const int c = col - 1024; dst = O.VTSB + ((size_t)(b * SBH + (c >> 6)) * 64 + (c & 63)) * KIDX + 32 + i; }
            else          { const int c = col - 2048; dst = GVT + ((size_t)(b * GH + (c >> 7)) * 128 + (c & 127)) * GU + 64 + i; }
            *(u32x4*)dst = w;
          }
  }
  DI void operator()(const pg8::f32x4 (&acc)[2][2][4][2], const pg8::Unit& u, int wr, int wc, int fr, int fq) const {
    const int pn = u.pn;
    if (pn == 4 || pn == 5 || pn == 8 || pn == 9) { store_vt(acc, u, wr, wc, fr, fq); return; }
#pragma unroll
    for (int ai = 0; ai < 2; ++ai)
#pragma unroll
      for (int m = 0; m < 4; ++m) {
        const int row = u.pm * 256 + ai * 128 + wr * 64 + m * 16 + fr;
        const int b = row >> 13, i = row & 8191;
#pragma unroll
        for (int bj = 0; bj < 2; ++bj) {
          const int col = pn * 256 + bj * 128 + wc * 32 + 8 * fq;
          const pg8::f32x4 v0 = acc[ai][bj][m][0], v1 = acc[ai][bj][m][1];
          if (pn < 12) {
            u32x4 w; w.x = pk2(v0[0], v0[1]); w.y = pk2(v0[2], v0[3]); w.z = pk2(v1[0], v1[1]); w.w = pk2(v1[2], v1[3]);
            bf16_t* dst;
            if (pn < 2)       { const int c = col;        dst = O.QSB + ((size_t)(b * SBH + (c >> 6)) * SEQ + i) * 64 + (c & 63); }
            else if (pn < 4)  { const int c = col - 512;  dst = O.KSB + ((size_t)(b * SBH + (c >> 6)) * KIDX + 32 + i) * 64 + (c & 63); }
            else if (pn == 6) { const int c = col - 1536; dst = O.GQ + ((size_t)(b * GH + (c >> 6)) * GU + 64 + i) * 64 + (c & 63); }
            else if (pn == 7) { const int c = col - 1792; dst = O.GK + ((size_t)(b * GH + (c >> 6)) * GU + 64 + i) * 64 + (c & 63); }
            else              { const int c = col - 2560; dst = O.GR + (size_t)row * 512 + c; }
            *(u32x4*)dst = w;
          } else if (col < NIN) {
            float* dst = O.GLR + ((size_t)b * GU + 64 + i) * 16 + (col - 3072);
            *(f32x4*)dst = (f32x4){v0[0], v0[1], v0[2], v0[3]};
            *(f32x4*)(dst + 4) = (f32x4){v1[0], v1[1], v1[2], v1[3]};
          }
        }
      }
  }
};
struct EpiOut {
  static constexpr bool PERM = true, AFTER_DRAIN = false;
  const float* x; bf16_t* H1;
  DI void operator()(const pg8::f32x4 (&acc)[2][2][4][2], const pg8::Unit& u, int wr, int wc, int fr, int fq) const {
#pragma unroll
    for (int ai = 0; ai < 2; ++ai)
#pragma unroll
      for (int m = 0; m < 4; ++m) {
        const size_t rowoff = (size_t)(u.pm * 256 + ai * 128 + wr * 64 + m * 16 + fr) * D;
#pragma unroll
        for (int bj = 0; bj < 2; ++bj) {
          const size_t idx = rowoff + u.pn * 256 + bj * 128 + wc * 32 + 8 * fq;
          const f32x4 x0 = *(const f32x4*)(x + idx), x1 = *(const f32x4*)(x + idx + 4);
          const pg8::f32x4 v0 = acc[ai][bj][m][0], v1 = acc[ai][bj][m][1];
          u32x4 w; w.x = pk2(x0.x + v0[0], x0.y + v0[1]); w.y = pk2(x0.z + v0[2], x0.w + v0[3]); w.z = pk2(x1.x + v1[0], x1.y + v1[1]); w.w = pk2(x1.z + v1[2], x1.w + v1[3]);
          *(u32x4*)(H1 + idx) = w;
        }
      }
  }
};
struct EpiPQ {
  static constexpr bool PERM = true, AFTER_DRAIN = false;
  bf16_t* QP; const float* R2;
  DI void operator()(const pg8::f32x4 (&acc)[2][2][4][2], const pg8::Unit& u, int wr, int wc, int fr, int fq) const {
#pragma unroll
    for (int ai = 0; ai < 2; ++ai)
#pragma unroll
      for (int m = 0; m < 4; ++m) {
        const int row = u.pm * 256 + ai * 128 + wr * 64 + m * 16 + fr;
        const float r = R2[row];
        const size_t rowoff = (size_t)row * D;
#pragma unroll
        for (int bj = 0; bj < 2; ++bj) {
          const pg8::f32x4 v0 = acc[ai][bj][m][0], v1 = acc[ai][bj][m][1];
          u32x4 w; w.x = pk2(v0[0] * r, v0[1] * r); w.y = pk2(v0[2] * r, v0[3] * r); w.z = pk2(v1[0] * r, v1[1] * r); w.w = pk2(v1[2] * r, v1[3] * r);
          *(u32x4*)(QP + rowoff + u.pn * 256 + bj * 128 + wc * 32 + 8 * fq) = w;
        }
      }
  }
};

DI void ph_meta(int blk, char* smem, const float* __restrict__ meta, const float* __restrict__ g1, const float* __restrict__ w_in, const InProjOut& O) {
  float (*xmT)[16] = (float (*)[16])smem;
  float (*red)[256] = (float (*)[256])(smem + 65536);
  const int tid = fresh_tid(), lane = tid & 63, wave = tid >> 6;
  for (int rr = 0; rr < 2; ++rr) {
    const int mm = wave * 2 + rr;
    float v[16]; float ss = 0.f;
#pragma unroll
    for (int j = 0; j < 16; ++j) { v[j] = meta[(size_t)mm * D + j * 64 + lane]; ss += v[j] * v[j]; }
    ss = wave_sum(ss);
    const float r = rsqrtf(ss * (1.0f / D) + EPS);
#pragma unroll
    for (int j = 0; j < 16; ++j) xmT[j * 64 + lane][mm] = v[j] * r * g1[j * 64 + lane];
  }
  __syncthreads();
  {
    const int c = tid & 15, ks = tid >> 4, n = blk * 16 + c;
    float acc[16];
#pragma unroll
    for (int j = 0; j < 16; ++j) acc[j] = 0.f;
#pragma unroll 8
    for (int kk = 0; kk < 32; ++kk) {
      const int k = ks * 32 + kk;
      const float w = w_in[(size_t)k * NIN + n];
      const f32x4 a = *(const f32x4*)&xmT[k][0], b4 = *(const f32x4*)&xmT[k][4], c4 = *(const f32x4*)&xmT[k][8], d4 = *(const f32x4*)&xmT[k][12];
      acc[0] += a.x * w; acc[1] += a.y * w; acc[2] += a.z * w; acc[3] += a.w * w;
      acc[4] += b4.x * w; acc[5] += b4.y * w; acc[6] += b4.z * w; acc[7] += b4.w * w;
      acc[8] += c4.x * w; acc[9] += c4.y * w; acc[10] += c4.z * w; acc[11] += c4.w * w;
      acc[12] += d4.x * w; acc[13] += d4.y * w; acc[14] += d4.z * w; acc[15] += d4.w * w;
    }
#pragma unroll
    for (int mm = 0; mm < 16; ++mm) red[ks][c * 16 + mm] = acc[mm];
  }
  __syncthreads();
  if (tid < 256) {
    const int c = tid >> 4, mm = tid & 15, n = blk * 16 + c;
    float val = 0.f;
#pragma unroll 8
    for (int ks = 0; ks < 32; ++ks) val += red[ks][tid];
    const bf16_t hv = (bf16_t)f2bf(val);
    for (int bb = 0; bb < NB; ++bb) {
      if (n < 512) {}
      else if (n < 1024) { const int cc = n - 512;  O.KSB[((size_t)(bb * SBH + (cc >> 6)) * KIDX + 16 + mm) * 64 + (cc & 63)] = hv; }
      else if (n < 1536) { const int cc = n - 1024; O.VTSB[((size_t)(bb * SBH + (cc >> 6)) * 64 + (cc & 63)) * KIDX + 16 + mm] = hv; }
      else if (n < 1792) { const int cc = n - 1536; O.GQ[((size_t)(bb * GH + (cc >> 6)) * GU + 48 + mm) * 64 + (cc & 63)] = hv; }
      else if (n < 2048) { const int cc = n - 1792; O.GK[((size_t)(bb * GH + (cc >> 6)) * GU + 48 + mm) * 64 + (cc & 63)] = hv; }
      else if (n < 2560) { const int cc = n - 2048; O.GV[((size_t)(bb * GH + (cc >> 7)) * 128 + (cc & 127)) * GU + 48 + mm] = hv; }
      else if (n < 3072) {}
      else { O.GLR[((size_t)bb * GU + 48 + mm) * 16 + (n - 3072)] = val; }
    }
  }
  __syncthreads();
}

DI void ph_vtrans(int vb, char* smem, const bf16_t* __restrict__ VSB, bf16_t* __restrict__ VTSB) {
  const int tid256_ = fresh_tid() & 255;
  bf16_t (*t)[66] = (bf16_t (*)[66])smem;
  const int tid = TID;
  const int bh = vb / 257, it = vb % 257, idx0 = it * 32;
  {
    const int row = tid >> 3, c8 = tid & 7;
    const u32x4 v = *(const u32x4*)(VSB + ((size_t)bh * KIDX + idx0 + row) * 64 + c8 * 8);
    unsigned* tp = (unsigned*)&t[row][c8 * 8];
    tp[0] = v.x; tp[1] = v.y; tp[2] = v.z; tp[3] = v.w;
  }
  __syncthreads();
  {
    const int d = tid >> 2, i4 = tid & 3;
    unsigned w[4];
#pragma unroll
    for (int j = 0; j < 4; ++j) w[j] = (unsigned)t[i4 * 8 + 2 * j][d] | ((unsigned)t[i4 * 8 + 2 * j + 1][d] << 16);
    *(u32x4*)(VTSB + ((size_t)bh * 64 + d) * KIDX + idx0 + i4 * 8) = (u32x4){w[0], w[1], w[2], w[3]};
  }
  __syncthreads();
}

constexpr float SB_THR = -90.f;
DI void ph_sb_attn(int vb, const bf16_t* __restrict__ QSB, const bf16_t* __restrict__ KSB, const bf16_t* __restrict__ VTSB,
                                                 const float* __restrict__ sb_g, bf16_t* __restrict__ MIX) {
  const int tid256_ = fresh_tid() & 255;
  const int lane = TID & 63, wave = TID >> 6, r = lane & 31, h = lane >> 5;
  const int bh = vb >> 6, qb = vb & 63;
  const int b = bh >> 3, hd = bh & 7;
  const int i0 = qb * 128 + wave * 32;
  const bf16_t* Qb = QSB + ((size_t)bh * SEQ + i0) * 64;
  const bf16_t* Kb = KSB + (size_t)bh * KIDX * 64;
  const bf16_t* Vb = VTSB + (size_t)bh * 64 * KIDX;
  bf16x8 qf[4];
#pragma unroll
  for (int ks = 0; ks < 4; ++ks) qf[ks] = *(const bf16x8*)(Qb + r * 64 + ks * 16 + h * 8);
  f32x16 o[2];
#pragma unroll
  for (int e = 0; e < 16; ++e) { o[0][e] = 0.f; o[1][e] = 0.f; }
  float R = 0.f;
  const int qidx = 32 + i0 + r;
  for (int c = (i0 >> 5) + 1; c >= 0; --c) {
    const int k0 = 32 * c;
    bf16x8 kf[4];
#pragma unroll
    for (int ks = 0; ks < 4; ++ks) kf[ks] = *(const bf16x8*)(Kb + (size_t)(k0 + r) * 64 + ks * 16 + h * 8);
    bf16x8 vf[2][2];
#pragma unroll
    for (int mt = 0; mt < 2; ++mt)
#pragma unroll
      for (int s2 = 0; s2 < 2; ++s2) {
        const bf16_t* vp = Vb + (size_t)(mt * 32 + r) * KIDX + k0 + 16 * s2 + 4 * h;
        const u32x2 lo = *(const u32x2*)vp, hi = *(const u32x2*)(vp + 8);
        u32x4 t; t.x = lo.x; t.y = lo.y; t.z = hi.x; t.w = hi.y;
        vf[mt][s2] = __builtin_bit_cast(bf16x8, t);
      }
    f32x16 s;
#pragma unroll
    for (int e = 0; e < 16; ++e) s[e] = 0.f;
#pragma unroll
    for (int ks = 0; ks < 4; ++ks) s = MFMA32(kf[ks], qf[ks], s);
    float l1m[16], lb[16];
    bool valid[16];
#pragma unroll
    for (int e = 0; e < 16; ++e) {
      const int kidx = k0 + crow(e, h);
      valid[e] = (kidx < qidx) && (kidx >= 16);
      const float z = s[e] * 0.125f;
      const float sp = softplus(z);
      l1m[e] = valid[e] ? -sp : 0.f;
      lb[e] = z - sp;
    }
    float sfx[16], G[4], PG[4];
#pragma unroll
    for (int g = 0; g < 4; ++g) {
      sfx[4 * g + 3] = 0.f;
      sfx[4 * g + 2] = l1m[4 * g + 3];
      sfx[4 * g + 1] = sfx[4 * g + 2] + l1m[4 * g + 2];
      sfx[4 * g + 0] = sfx[4 * g + 1] + l1m[4 * g + 1];
      G[g] = sfx[4 * g + 0] + l1m[4 * g + 0];
      PG[g] = __shfl_xor(G[g], 32);
    }
    float HS[4];
    HS[3] = 0.f;
    HS[2] = G[3] + PG[3];
    HS[1] = HS[2] + G[2] + PG[2];
    HS[0] = HS[1] + G[1] + PG[1];
    const float total = HS[0] + G[0] + PG[0];
    float a[16];
#pragma unroll
    for (int e = 0; e < 16; ++e) {
      const int g = e >> 2;
      const float between = sfx[e] + (h == 0 ? PG[g] : 0.f) + HS[g] + R;
      a[e] = valid[e] ? __expf(lb[e] + between) : 0.f;
    }
    R += total;
#pragma unroll
    for (int s2 = 0; s2 < 2; ++s2) {
      u32x4 p;
      p.x = pk2(a[8 * s2 + 0], a[8 * s2 + 1]); p.y = pk2(a[8 * s2 + 2], a[8 * s2 + 3]);
      p.z = pk2(a[8 * s2 + 4], a[8 * s2 + 5]); p.w = pk2(a[8 * s2 + 6], a[8 * s2 + 7]);
      const bf16x8 pf = __builtin_bit_cast(bf16x8, p);
      o[0] = MFMA32(vf[0][s2], pf, o[0]);
      o[1] = MFMA32(vf[1][s2], pf, o[1]);
    }
    if (__all(R < SB_THR)) break;
  }
  float ss = 0.f;
#pragma unroll
  for (int e = 0; e < 16; ++e) ss += o[0][e] * o[0][e] + o[1][e] * o[1][e];
  ss += __shfl_xor(ss, 32);
  const float sc = rsqrtf(ss * (1.0f / 64.0f) + EPS);
  bf16_t* outp = MIX + (size_t)(b * SEQ + i0 + r) * D + hd * 64;
#pragma unroll
  for (int mt = 0; mt < 2; ++mt)
#pragma unroll
    for (int g = 0; g < 4; ++g) {
      const int d = mt * 32 + 8 * g + 4 * h;
      const f32x4 gg = *(const f32x4*)(sb_g + hd * 64 + d);
      u32x2 pk;
      pk.x = pk2(o[mt][4 * g] * sc * gg.x, o[mt][4 * g + 1] * sc * gg.y);
      pk.y = pk2(o[mt][4 * g + 2] * sc * gg.z, o[mt][4 * g + 3] * sc * gg.w);
      *(u32x2*)(outp + d) = pk;
    }
}

DI void ph_lg(int bu, const float* __restrict__ GLR, const float* __restrict__ wg, const float* __restrict__ bg, float* __restrict__ LG) {
  const int tid256_ = fresh_tid() & 255;
  const int c = TID;
  const int b = bu / GU, u = bu % GU;
  float val = 0.f;
  if (u >= 48) {
    float acc = bg[c];
    const float* g = GLR + (size_t)bu * 16;
#pragma unroll
    for (int k = 0; k < 16; ++k) acc += g[k] * wg[k * 256 + c];
    val = -softplus(-acc) * (1.0f / 16.0f);
  }
  const int hd = c >> 6, d = c & 63;
  LG[((size_t)(b * GH + hd) * GU + u) * 64 + d] = val;
}

DI void ph_gla_v1(int vb, char* smem, const bf16_t* __restrict__ GQ, const bf16_t* __restrict__ GK, const bf16_t* __restrict__ GV,
                                                const float* __restrict__ LG, float* __restrict__ GO) {
  const int tid256_ = fresh_tid() & 255;
  float (*qs)[68] = (float (*)[68])smem;
  float (*ks)[68] = (float (*)[68])(smem + 17408);
  float (*bc)[68] = (float (*)[68])(smem + 2 * 17408);
  float (*at)[68] = bc;
  float (*vs)[36] = (float (*)[36])(smem + 3 * 17408);
  float (*Ss)[36] = (float (*)[36])(smem + 3 * 17408 + 9216);
  float* decs = (float*)(smem + 3 * 17408 + 2 * 9216);
  const int tid = TID;
  const int bh = vb >> 2, es = vb & 3, b = bh >> 2, hd = bh & 3;
  const bf16_t* gq = GQ + (size_t)bh * GU * 64;
  const bf16_t* gk = GK + (size_t)bh * GU * 64;
  const bf16_t* gv = GV + (size_t)bh * GU * 128 + es * 32;
  const float* lg = LG + (size_t)bh * GU * 64;
  const int sd = tid >> 2, eg = tid & 3;
  float S[8];
#pragma unroll
  for (int j = 0; j < 8; ++j) S[j] = 0.f;
  for (int c = 0; c < 129; ++c) {
    const int u0 = c * 64;
#pragma unroll 2
    for (int idx = tid; idx < 4096; idx += 256) {
      const int t = idx >> 6, d = idx & 63;
      qs[t][d] = bf2f(gq[(size_t)(u0 + t) * 64 + d]);
      ks[t][d] = bf2f(gk[(size_t)(u0 + t) * 64 + d]);
      bc[t][d] = lg[(size_t)(u0 + t) * 64 + d];
    }
    for (int idx = tid; idx < 2048; idx += 256) {
      const int t = idx >> 5, e = idx & 31;
      vs[t][e] = bf2f(gv[(size_t)(u0 + t) * 128 + e]);
    }
#pragma unroll
    for (int j = 0; j < 8; ++j) Ss[sd][eg * 8 + j] = S[j];
    __syncthreads();
    if (tid < 64) { float run = 0.f;
#pragma unroll 4
      for (int t = 0; t < 64; ++t) { run += bc[t][tid]; bc[t][tid] = run; } }
    __syncthreads();
#pragma unroll 2
    for (int idx = tid; idx < 4096; idx += 256) {
      const int t = idx >> 6, d = idx & 63;
      const float bv = bc[t][d];
      qs[t][d] *= __expf(bv) * 0.125f;
      ks[t][d] *= __expf(-bv);
    }
    if (tid < 64) decs[tid] = __expf(bc[63][tid]);
    __syncthreads();
    {
      const int ti = tid >> 4, si = tid & 15;
      float acc[4][4];
#pragma unroll
      for (int a = 0; a < 4; ++a)
#pragma unroll
        for (int bb = 0; bb < 4; ++bb) acc[a][bb] = 0.f;
#pragma unroll 1
      for (int d = 0; d < 64; d += 4) {
        f32x4 q4[4], k4[4];
#pragma unroll
        for (int a = 0; a < 4; ++a) q4[a] = *(const f32x4*)&qs[ti + 16 * a][d];
#pragma unroll
        for (int bb = 0; bb < 4; ++bb) k4[bb] = *(const f32x4*)&ks[si + 16 * bb][d];
#pragma unroll
        for (int a = 0; a < 4; ++a)
#pragma unroll
          for (int bb = 0; bb < 4; ++bb)
            acc[a][bb] += q4[a].x * k4[bb].x + q4[a].y * k4[bb].y + q4[a].z * k4[bb].z + q4[a].w * k4[bb].w;
      }
#pragma unroll
      for (int a = 0; a < 4; ++a)
#pragma unroll
        for (int bb = 0; bb < 4; ++bb) {
          const int t = ti + 16 * a, s = si + 16 * bb;
          at[t][s] = (s <= t) ? acc[a][bb] : 0.f;
        }
    }
    __syncthreads();
    {
      const int t = sd;
      float o[8];
#pragma unroll
      for (int j = 0; j < 8; ++j) o[j] = 0.f;
#pragma unroll 2
      for (int d = 0; d < 64; ++d) {
        const float qv = qs[t][d];
        const f32x4 s0 = *(const f32x4*)&Ss[d][eg * 8], s1 = *(const f32x4*)&Ss[d][eg * 8 + 4];
        o[0] += qv * s0.x; o[1] += qv * s0.y; o[2] += qv * s0.z; o[3] += qv * s0.w;
        o[4] += qv * s1.x; o[5] += qv * s1.y; o[6] += qv * s1.z; o[7] += qv * s1.w;
      }
#pragma unroll 2
      for (int s = 0; s < 64; ++s) {
        const float av = at[t][s];
        const f32x4 v0 = *(const f32x4*)&vs[s][eg * 8], v1 = *(const f32x4*)&vs[s][eg * 8 + 4];
        o[0] += av * v0.x; o[1] += av * v0.y; o[2] += av * v0.z; o[3] += av * v0.w;
        o[4] += av * v1.x; o[5] += av * v1.y; o[6] += av * v1.z; o[7] += av * v1.w;
      }
      if (c >= 1) {
        float* op = GO + ((size_t)(b * SEQ + (c - 1) * 64 + t)) * 512 + hd * 128 + es * 32 + eg * 8;
        *(f32x4*)op = (f32x4){o[0], o[1], o[2], o[3]};
        *(f32x4*)(op + 4) = (f32x4){o[4], o[5], o[6], o[7]};
      }
    }
    {
      float n[8];
#pragma unroll
      for (int j = 0; j < 8; ++j) n[j] = S[j];
#pragma unroll 2
      for (int s = 0; s < 64; ++s) {
        const float kv = ks[s][sd];
        const f32x4 v0 = *(const f32x4*)&vs[s][eg * 8], v1 = *(const f32x4*)&vs[s][eg * 8 + 4];
        n[0] += kv * v0.x; n[1] += kv * v0.y; n[2] += kv * v0.z; n[3] += kv * v0.w;
        n[4] += kv * v1.x; n[5] += kv * v1.y; n[6] += kv * v1.z; n[7] += kv * v1.w;
      }
      const float dec = decs[sd];
#pragma unroll
      for (int j = 0; j < 8; ++j) S[j] = dec * n[j];
    }
    __syncthreads();
  }
}

DI void ph_gla_norm(int m, const float* __restrict__ GO, const bf16_t* __restrict__ GR, const float* __restrict__ gla_g, bf16_t* __restrict__ MIX) {
  const int tid256_ = fresh_tid() & 255;
  const int hd = TID >> 6, lane = TID & 63;
  const f32x2 v = *(const f32x2*)(GO + (size_t)m * 512 + hd * 128 + lane * 2);
  float ss = wave_sum(v.x * v.x + v.y * v.y);
  const float sc = rsqrtf(ss * (1.0f / 128.0f) + EPS);
  const unsigned g2 = *(const unsigned*)(GR + (size_t)m * 512 + hd * 128 + lane * 2);
  const float g0 = bflo(g2), g1 = bfhi(g2);
  const f32x2 gn = *(const f32x2*)(gla_g + hd * 128 + lane * 2);
  const float s0 = g0 / (1.f + __expf(-g0)), s1 = g1 / (1.f + __expf(-g1));
  *(unsigned*)(MIX + (size_t)m * D + 512 + hd * 128 + lane * 2) = pk2(v.x * sc * gn.x * s0, v.y * sc * gn.y * s1);
}

DI bool better(float v1, int i1, float v2, int i2) { return (v1 > v2) || (v1 == v2 && i1 < i2); }
DI void wave_argmax(float& v, int& i) {
#pragma unroll
  for (int o = 32; o >= 1; o >>= 1) {
    const float ov = __shfl_xor(v, o);
    const int oi = __shfl_xor(i, o);
    if (better(ov, oi, v, i)) { v = ov; i = oi; }
  }
}
constexpr int RT_TOK_PER_BLOCK = 256;
DI void ph_route_v1(int vb, char* smem, const bf16_t* __restrict__ QP, const float* __restrict__ sk1, const float* __restrict__ sk2,
                                                  int* __restrict__ EIDX, float* __restrict__ GATE) {
  const int tid256_ = fresh_tid() & 255;
  float (*K1)[68] = (float (*)[68])smem;
  float (*K2)[68] = (float (*)[68])(smem + 34816);
  float (*qsh)[128] = (float (*)[128])(smem + 2 * 34816);
  const int hd = vb & 7, tg = vb >> 3;
  const int tid = TID, lane = tid & 63, wave = tid >> 6;
  for (int idx = tid; idx < 128 * 64; idx += 256) {
    const int k = idx >> 6, d = idx & 63;
    K1[k][d] = sk1[((size_t)hd * 128 + k) * 64 + d];
    K2[k][d] = sk2[((size_t)hd * 128 + k) * 64 + d];
  }
  __syncthreads();
  const float NEG = -3.0e38f;
  for (int it = 0; it < RT_TOK_PER_BLOCK / 4; ++it) {
    const int m = tg * RT_TOK_PER_BLOCK + it * 4 + wave;
    {
      const unsigned q2 = *(const unsigned*)(QP + (size_t)m * D + hd * 128 + lane * 2);
      qsh[wave][lane * 2] = bflo(q2); qsh[wave][lane * 2 + 1] = bfhi(q2);
    }
    __builtin_amdgcn_wave_barrier();
    float s1a = 0.f, s1b = 0.f, s2a = 0.f, s2b = 0.f;
#pragma unroll 4
    for (int d = 0; d < 64; d += 4) {
      const f32x4 q1 = *(const f32x4*)&qsh[wave][d], q2 = *(const f32x4*)&qsh[wave][64 + d];
      const f32x4 a = *(const f32x4*)&K1[lane][d], bb = *(const f32x4*)&K1[lane + 64][d];
      const f32x4 c = *(const f32x4*)&K2[lane][d], dd = *(const f32x4*)&K2[lane + 64][d];
      s1a += q1.x * a.x + q1.y * a.y + q1.z * a.z + q1.w * a.w;
      s1b += q1.x * bb.x + q1.y * bb.y + q1.z * bb.z + q1.w * bb.w;
      s2a += q2.x * c.x + q2.y * c.y + q2.z * c.z + q2.w * c.w;
      s2b += q2.x * dd.x + q2.y * dd.y + q2.z * dd.z + q2.w * dd.w;
    }
    __builtin_amdgcn_wave_barrier();
    float tv1 = 0.f, tv2 = 0.f; int ti1 = 0, ti2 = 0;
    for (int rr = 0; rr < 16; ++rr) {
      float v; int i;
      if (better(s1a, lane, s1b, lane + 64)) { v = s1a; i = lane; } else { v = s1b; i = lane + 64; }
      wave_argmax(v, i);
      if (lane == rr) { tv1 = v; ti1 = i; }
      if (i == lane) s1a = NEG;
      if (i == lane + 64) s1b = NEG;
      if (better(s2a, lane, s2b, lane + 64)) { v = s2a; i = lane; } else { v = s2b; i = lane + 64; }
      wave_argmax(v, i);
      if (lane == rr) { tv2 = v; ti2 = i; }
      if (i == lane) s2a = NEG;
      if (i == lane + 64) s2b = NEG;
    }
    const int ca = lane >> 2;
    const float va = __shfl(tv1, ca); const int ia = __shfl(ti1, ca);
    float cv[4]; int ce[4];
#pragma unroll
    for (int j = 0; j < 4; ++j) {
      const int cb = (lane & 3) * 4 + j;
      cv[j] = va + __shfl(tv2, cb);
      ce[j] = ia * 128 + __shfl(ti2, cb);
    }
    float fsc = 0.f; int fe = 0;
    for (int rr = 0; rr < 16; ++rr) {
      float v = cv[0]; int p = lane * 4;
#pragma unroll
      for (int j = 1; j < 4; ++j) if (better(cv[j], lane * 4 + j, v, p)) { v = cv[j]; p = lane * 4 + j; }
      wave_argmax(v, p);
      const int src = p >> 2, jj = p & 3;
      int e = (jj == 0) ? ce[0] : (jj == 1) ? ce[1] : (jj == 2) ? ce[2] : ce[3];
      e = __shfl(e, src);
      if (lane == rr) { fsc = v; fe = e; }
      if (lane == src) {
        if (jj == 0) cv[0] = NEG; else if (jj == 1) cv[1] = NEG; else if (jj == 2) cv[2] = NEG; else cv[3] = NEG;
      }
    }
    const float mx = __shfl(fsc, 0);
    float ex = (lane < 16) ? __expf(fsc - mx) : 0.f;
    const float sum = wave_sum(ex);
    if (lane < 16) {
      EIDX[(size_t)m * 128 + hd * 16 + lane] = fe;
      GATE[(size_t)m * 128 + hd * 16 + lane] = ex / sum;
    }
  }
  __syncthreads();
}


#define MFMA16(a, b, c) __builtin_amdgcn_mfma_f32_16x16x32_bf16((a), (b), (c), 0, 0, 0)
constexpr int GLDS = 72;
struct GlaLds {
  bf16_t Qt[64 * GLDS];
  bf16_t Kt[64 * GLDS];
  bf16_t KT[64 * GLDS];
  bf16_t P[64 * GLDS];
  float dec[64];
  float tot[8][64];
  float ssq[8][64];
};
constexpr size_t WS_SLOC = 926 * MiB;
constexpr size_t WS_DTOT = 942 * MiB;
constexpr size_t WS_GVT = 604 * MiB;

struct GlaPtrs { const bf16_t *GQ, *GK, *GVT, *GR; const float *GLR, *wg, *bg, *gla_g; float *SLOC, *DTOT; bf16_t* MIX; };

template <int PASS>
DI void gla_item(int bh, int sc, char* smem, const GlaPtrs& G) {
  GlaLds& L = *(GlaLds*)smem;
  const int tid = fresh_tid(), lane = tid & 63, w = __builtin_amdgcn_readfirstlane(tid >> 6), c16 = lane & 15, q = lane >> 4;
  const int b = bh >> 2, hd = bh & 3;
  const int cbeg = sc == 0 ? 0 : 8 * sc + 1, cend = 8 * sc + 9;
  float wgr[16];
#pragma unroll
  for (int k = 0; k < 16; ++k) wgr[k] = G.wg[k * 256 + hd * 64 + lane];
  const float bgv = G.bg[hd * 64 + lane];
  f32x4 X[4];
#pragma unroll
  for (int i = 0; i < 4; ++i) X[i] = (f32x4){0.f, 0.f, 0.f, 0.f};
  if (PASS == 1) {
    for (int j = 0; j < sc; ++j) {
      const float* dt = G.DTOT + (size_t)(bh * 16 + j) * 64;
      const float* sl = G.SLOC + ((size_t)(bh * 16 + j) * 8 + w) * 16 * 64 + lane;
#pragma unroll
      for (int i = 0; i < 4; ++i) {
        const f32x4 d4 = *(const f32x4*)(dt + 16 * i + 4 * q);
        X[i][0] = d4.x * X[i][0] + sl[(4 * i + 0) * 64]; X[i][1] = d4.y * X[i][1] + sl[(4 * i + 1) * 64];
        X[i][2] = d4.z * X[i][2] + sl[(4 * i + 2) * 64]; X[i][3] = d4.w * X[i][3] + sl[(4 * i + 3) * 64];
      }
    }
  }
  f32x4 gain = {1.f, 1.f, 1.f, 1.f};
  if (PASS == 1) gain = *(const f32x4*)(G.gla_g + hd * 128 + 16 * w + 4 * q);
  float blsum = 0.f;
  const bf16_t* gq = G.GQ + (size_t)bh * GU * 64 + lane;
  const bf16_t* gk = G.GK + (size_t)bh * GU * 64 + lane;
  const bf16_t* gvt = G.GVT + ((size_t)bh * 128 + 16 * w + c16) * GU + 8 * q;
  for (int c = cbeg; c < cend; ++c) {
    const int u0 = 64 * c;
    float cs[8];
    {
      float run = 0.f;
#pragma unroll
      for (int i = 0; i < 8; ++i) {
        const int u = u0 + 8 * w + i;
        float lgv = 0.f;
        if (u >= 48) {
          const f32x4* gp = (const f32x4*)(G.GLR + ((size_t)b * GU + u) * 16);
          const f32x4 g0 = gp[0], g1 = gp[1], g2 = gp[2], g3 = gp[3];
          float a = bgv;
          a += g0.x * wgr[0] + g0.y * wgr[1] + g0.z * wgr[2] + g0.w * wgr[3];
          a += g1.x * wgr[4] + g1.y * wgr[5] + g1.z * wgr[6] + g1.w * wgr[7];
          a += g2.x * wgr[8] + g2.y * wgr[9] + g2.z * wgr[10] + g2.w * wgr[11];
          a += g3.x * wgr[12] + g3.y * wgr[13] + g3.z * wgr[14] + g3.w * wgr[15];
          lgv = -softplus(-a) * (1.0f / 16.0f);
        }
        run += lgv; cs[i] = run;
      }
      L.tot[w][lane] = run;
    }
    bf16x8 vfr[2];
    vfr[0] = *(const bf16x8*)(gvt + u0);
    vfr[1] = *(const bf16x8*)(gvt + u0 + 32);
    unsigned short kraw[8], qraw[8];
#pragma unroll
    for (int i = 0; i < 8; ++i) {
      kraw[i] = gk[(size_t)(u0 + 8 * w + i) * 64];
      if (PASS == 1) qraw[i] = gq[(size_t)(u0 + 8 * w + i) * 64];
    }
    __syncthreads();
    {
      float offset = 0.f, total = 0.f;
#pragma unroll
      for (int s2 = 0; s2 < 8; ++s2) { const float tv = L.tot[s2][lane]; total += tv; if (s2 < w) offset += tv; }
      blsum += total;
      if (w == 0) L.dec[lane] = __expf(total);
      float kt[8];
#pragma unroll
      for (int i = 0; i < 8; ++i) {
        const float bc = offset + cs[i];
        kt[i] = bf2f(kraw[i]) * __expf(-bc);
        if (PASS == 1) {
          L.Qt[(8 * w + i) * GLDS + lane] = (bf16_t)f2bf(bf2f(qraw[i]) * __expf(bc) * 0.125f);
          L.Kt[(8 * w + i) * GLDS + lane] = (bf16_t)f2bf(kt[i]);
        }
      }
      u32x4 kp; kp.x = pk2(kt[0], kt[1]); kp.y = pk2(kt[2], kt[3]); kp.z = pk2(kt[4], kt[5]); kp.w = pk2(kt[6], kt[7]);
      *(u32x4*)&L.KT[lane * GLDS + 8 * w] = kp;
    }
    __syncthreads();
    f32x4 OT[4];
    if (PASS == 1) {
      const int is = w >> 1;
#pragma unroll
      for (int z = 0; z < 2; ++z) {
        const int it = 2 * (w & 1) + z;
        f32x4 pa = {0.f, 0.f, 0.f, 0.f};
        if (is <= it) {
#pragma unroll
          for (int kk = 0; kk < 2; ++kk) {
            const bf16x8 ka = *(const bf16x8*)&L.Kt[(16 * is + c16) * GLDS + 32 * kk + 8 * q];
            const bf16x8 qb = *(const bf16x8*)&L.Qt[(16 * it + c16) * GLDS + 32 * kk + 8 * q];
            pa = MFMA16(ka, qb, pa);
          }
          if (is == it) {
#pragma unroll
            for (int r = 0; r < 4; ++r) if (4 * q + r > c16) pa[r] = 0.f;
          }
        }
        u32x2 pw; pw.x = pk2(pa[0], pa[1]); pw.y = pk2(pa[2], pa[3]);
        *(u32x2*)&L.P[(16 * it + c16) * GLDS + 16 * is + 4 * q] = pw;
      }
#pragma unroll
      for (int n = 0; n < 4; ++n) OT[n] = (f32x4){0.f, 0.f, 0.f, 0.f};
#pragma unroll
      for (int kk = 0; kk < 2; ++kk) {
        u32x4 xp; xp.x = pk2(X[2 * kk][0], X[2 * kk][1]); xp.y = pk2(X[2 * kk][2], X[2 * kk][3]);
        xp.z = pk2(X[2 * kk + 1][0], X[2 * kk + 1][1]); xp.w = pk2(X[2 * kk + 1][2], X[2 * kk + 1][3]);
        const bf16x8 xa = __builtin_bit_cast(bf16x8, xp);
#pragma unroll
        for (int n = 0; n < 4; ++n) {
          const u32x2 lo = *(const u32x2*)&L.Qt[(16 * n + c16) * GLDS + 32 * kk + 4 * q];
          const u32x2 hi = *(const u32x2*)&L.Qt[(16 * n + c16) * GLDS + 32 * kk + 16 + 4 * q];
          u32x4 qq; qq.x = lo.x; qq.y = lo.y; qq.z = hi.x; qq.w = hi.y;
          OT[n] = MFMA16(xa, __builtin_bit_cast(bf16x8, qq), OT[n]);
        }
      }
      __syncthreads();
#pragma unroll
      for (int kk = 0; kk < 2; ++kk)
#pragma unroll
        for (int n = 0; n < 4; ++n) {
          const bf16x8 pb = *(const bf16x8*)&L.P[(16 * n + c16) * GLDS + 32 * kk + 8 * q];
          OT[n] = MFMA16(vfr[kk], pb, OT[n]);
        }
    }
#pragma unroll
    for (int i = 0; i < 4; ++i) {
#pragma unroll
      for (int kk = 0; kk < 2; ++kk) {
        const bf16x8 ka = *(const bf16x8*)&L.KT[(16 * i + c16) * GLDS + 32 * kk + 8 * q];
        X[i] = MFMA16(ka, vfr[kk], X[i]);
      }
      const f32x4 d4 = *(const f32x4*)&L.dec[16 * i + 4 * q];
      X[i][0] *= d4.x; X[i][1] *= d4.y; X[i][2] *= d4.z; X[i][3] *= d4.w;
    }
    if (PASS == 1) {
      if (c >= 1) {
        float ss[4];
#pragma unroll
        for (int n = 0; n < 4; ++n) {
          float v = OT[n][0] * OT[n][0] + OT[n][1] * OT[n][1] + OT[n][2] * OT[n][2] + OT[n][3] * OT[n][3];
          v += __shfl_xor(v, 16); v += __shfl_xor(v, 32);
          ss[n] = v;
        }
        if (q == 0) {
#pragma unroll
          for (int n = 0; n < 4; ++n) L.ssq[w][16 * n + c16] = ss[n];
        }
        __syncthreads();
#pragma unroll
        for (int n = 0; n < 4; ++n) {
          float tot = 0.f;
#pragma unroll
          for (int w2 = 0; w2 < 8; ++w2) tot += L.ssq[w2][16 * n + c16];
          const float scl = rsqrtf(tot * (1.0f / 128.0f) + EPS);
          const size_t m = (size_t)b * SEQ + 64 * (c - 1) + 16 * n + c16;
          const u32x2 g2 = *(const u32x2*)(G.GR + m * 512 + hd * 128 + 16 * w + 4 * q);
          const float r0 = bflo(g2.x), r1 = bfhi(g2.x), r2 = bflo(g2.y), r3 = bfhi(g2.y);
          const float o0 = OT[n][0] * scl * gain.x * (r0 / (1.f + __expf(-r0)));
          const float o1 = OT[n][1] * scl * gain.y * (r1 / (1.f + __expf(-r1)));
          const float o2 = OT[n][2] * scl * gain.z * (r2 / (1.f + __expf(-r2)));
          const float o3 = OT[n][3] * scl * gain.w * (r3 / (1.f + __expf(-r3)));
          u32x2 ow; ow.x = pk2(o0, o1); ow.y = pk2(o2, o3);
          *(u32x2*)(G.MIX + m * D + 512 + hd * 128 + 16 * w + 4 * q) = ow;
        }
      }
    }
    __syncthreads();
  }
  if (PASS == 0) {
    float* sl = G.SLOC + ((size_t)(bh * 16 + sc) * 8 + w) * 16 * 64 + lane;
#pragma unroll
    for (int i = 0; i < 4; ++i)
#pragma unroll
      for (int r = 0; r < 4; ++r) sl[(4 * i + r) * 64] = X[i][r];
    if (w == 0) G.DTOT[(size_t)(bh * 16 + sc) * 64 + lane] = __expf(blsum);
  }
}


constexpr size_t WS_GQT = 80 * MiB;
constexpr size_t WS_GKT = 113 * MiB;
constexpr size_t WS_GKTT = 146 * MiB;
constexpr size_t WS_GDEC = 179 * MiB;
constexpr size_t WS_GBL = 182 * MiB;
struct GlaPrepPtrs { const bf16_t *GQ, *GK; const float *GLR, *wg, *bg; bf16_t *QT, *KT, *KTT; float *DEC, *BL; };
DI void ph_gla_prep(int item, char* smem, const GlaPrepPtrs& G) {
  float (*tot)[64] = (float (*)[64])smem;
  const int tid = fresh_tid(), lane = tid & 63, w = tid >> 6;
  const int bh = item / 129, c = item % 129, b = bh >> 2, hd = bh & 3, u0 = 64 * c;
  float wgr[16];
#pragma unroll
  for (int k = 0; k < 16; ++k) wgr[k] = G.wg[k * 256 + hd * 64 + lane];
  const float bgv = G.bg[hd * 64 + lane];
  float cs[8]; float run = 0.f;
  unsigned short kraw[8], qraw[8];
#pragma unroll
  for (int i = 0; i < 8; ++i) {
    const int u = u0 + 8 * w + i;
    kraw[i] = G.GK[((size_t)bh * GU + u) * 64 + lane];
    qraw[i] = G.GQ[((size_t)bh * GU + u) * 64 + lane];
    float lgv = 0.f;
    if (u >= 48) {
      const f32x4* gp = (const f32x4*)(G.GLR + ((size_t)b * GU + u) * 16);
      const f32x4 g0 = gp[0], g1 = gp[1], g2 = gp[2], g3 = gp[3];
      float a = bgv;
      a += g0.x * wgr[0] + g0.y * wgr[1] + g0.z * wgr[2] + g0.w * wgr[3];
      a += g1.x * wgr[4] + g1.y * wgr[5] + g1.z * wgr[6] + g1.w * wgr[7];
      a += g2.x * wgr[8] + g2.y * wgr[9] + g2.z * wgr[10] + g2.w * wgr[11];
      a += g3.x * wgr[12] + g3.y * wgr[13] + g3.z * wgr[14] + g3.w * wgr[15];
      lgv = -softplus(-a) * (1.0f / 16.0f);
    }
    run += lgv; cs[i] = run;
  }
  tot[w][lane] = run;
  __syncthreads();
  float offset = 0.f, total = 0.f;
#pragma unroll
  for (int s2 = 0; s2 < 8; ++s2) { const float tv = tot[s2][lane]; total += tv; if (s2 < w) offset += tv; }
  const size_t cb = ((size_t)bh * 129 + c) * 4096;
  float kt[8];
#pragma unroll
  for (int i = 0; i < 8; ++i) {
    const float bc = offset + cs[i];
    kt[i] = bf2f(kraw[i]) * __expf(-bc);
    G.QT[cb + (8 * w + i) * 64 + lane] = (bf16_t)f2bf(bf2f(qraw[i]) * __expf(bc) * 0.125f);
    G.KT[cb + (8 * w + i) * 64 + lane] = (bf16_t)f2bf(kt[i]);
  }
  u32x4 kp; kp.x = pk2(kt[0], kt[1]); kp.y = pk2(kt[2], kt[3]); kp.z = pk2(kt[4], kt[5]); kp.w = pk2(kt[6], kt[7]);
  *(u32x4*)(G.KTT + cb + lane * 64 + 8 * w) = kp;
  if (w == 0) { G.DEC[((size_t)bh * 129 + c) * 64 + lane] = __expf(total); G.BL[((size_t)bh * 129 + c) * 64 + lane] = total; }
  __syncthreads();
}

struct GlaBuf { bf16_t Qt[64 * GLDS]; bf16_t Kt[64 * GLDS]; bf16_t KT[64 * GLDS]; };
struct GlaLds3 { GlaBuf B[2]; bf16_t P[64 * GLDS]; float ssq[8][64]; };
struct GlaPtrs3 { const bf16_t *QT, *KT, *KTT, *GVT, *GR; const float *DEC, *BL, *gla_g; float *SLOC, *DTOT; bf16_t* MIX; };

template <int PASS>
DI void gla_item3(int bh, int sc, char* smem, const GlaPtrs3& G) {
  GlaLds3& L = *(GlaLds3*)smem;
  const int tid = fresh_tid(), lane = tid & 63, w = __builtin_amdgcn_readfirstlane(tid >> 6), c16 = lane & 15, q = lane >> 4;
  const int b = bh >> 2, hd = bh & 3;
  const int cbeg = sc == 0 ? 0 : 8 * sc + 1, cend = 8 * sc + 9;
  f32x4 X[4];
#pragma unroll
  for (int i = 0; i < 4; ++i) X[i] = (f32x4){0.f, 0.f, 0.f, 0.f};
  if (PASS == 1) {
#pragma unroll 4
    for (int j = 0; j < sc; ++j) {
      const float* dt = G.DTOT + (size_t)(bh * 16 + j) * 64;
      const float* sl = G.SLOC + ((size_t)(bh * 16 + j) * 8 + w) * 16 * 64 + lane;
#pragma unroll
      for (int i = 0; i < 4; ++i) {
        const f32x4 d4 = *(const f32x4*)(dt + 16 * i + 4 * q);
        X[i][0] = d4.x * X[i][0] + sl[(4 * i + 0) * 64]; X[i][1] = d4.y * X[i][1] + sl[(4 * i + 1) * 64];
        X[i][2] = d4.z * X[i][2] + sl[(4 * i + 2) * 64]; X[i][3] = d4.w * X[i][3] + sl[(4 * i + 3) * 64];
      }
    }
  }
  f32x4 gain = {1.f, 1.f, 1.f, 1.f};
  if (PASS == 1) gain = *(const f32x4*)(G.gla_g + hd * 128 + 16 * w + 4 * q);
  const bf16_t* gvt = G.GVT + ((size_t)bh * 128 + 16 * w + c16) * GU + 8 * q;
  const int srow = tid >> 3, sc8 = tid & 7, soff = srow * GLDS + sc8 * 8;
  const size_t cb0 = (size_t)bh * 129 * 4096 + (size_t)srow * 64 + sc8 * 8;
  u32x4 rq, rk, rkt, rq2, rk2, rkt2; bf16x8 vfr[2], vfn[2], vfn2[2]; f32x4 dec[4], decn[4], decn2[4];
  {
    const size_t cb = cb0 + (size_t)cbeg * 4096;
    rkt = *(const u32x4*)(G.KTT + cb);
    if (PASS == 1) { rq = *(const u32x4*)(G.QT + cb); rk = *(const u32x4*)(G.KT + cb); }
    vfr[0] = *(const bf16x8*)(gvt + 64 * cbeg); vfr[1] = *(const bf16x8*)(gvt + 64 * cbeg + 32);
#pragma unroll
    for (int i = 0; i < 4; ++i) dec[i] = *(const f32x4*)(G.DEC + ((size_t)bh * 129 + cbeg) * 64 + 16 * i + 4 * q);
    *(u32x4*)&L.B[0].KT[soff] = rkt;
    if (PASS == 1) { *(u32x4*)&L.B[0].Qt[soff] = rq; *(u32x4*)&L.B[0].Kt[soff] = rk; }
    const size_t cb1 = cb0 + (size_t)(cbeg + 1) * 4096;
    rkt = *(const u32x4*)(G.KTT + cb1);
    if (PASS == 1) { rq = *(const u32x4*)(G.QT + cb1); rk = *(const u32x4*)(G.KT + cb1); }
    vfn[0] = *(const bf16x8*)(gvt + 64 * (cbeg + 1)); vfn[1] = *(const bf16x8*)(gvt + 64 * (cbeg + 1) + 32);
#pragma unroll
    for (int i = 0; i < 4; ++i) decn[i] = *(const f32x4*)(G.DEC + ((size_t)bh * 129 + cbeg + 1) * 64 + 16 * i + 4 * q);
  }
  __syncthreads();
  for (int c = cbeg; c < cend; ++c) {
    const int cur = (c - cbeg) & 1;
    const GlaBuf& Bc = L.B[cur];
    const bool more = c + 1 < cend, more2 = c + 2 < cend;
    if (more2) {
      const size_t cb = cb0 + (size_t)(c + 2) * 4096;
      rkt2 = *(const u32x4*)(G.KTT + cb);
      if (PASS == 1) { rq2 = *(const u32x4*)(G.QT + cb); rk2 = *(const u32x4*)(G.KT + cb); }
      vfn2[0] = *(const bf16x8*)(gvt + 64 * (c + 2)); vfn2[1] = *(const bf16x8*)(gvt + 64 * (c + 2) + 32);
#pragma unroll
      for (int i = 0; i < 4; ++i) decn2[i] = *(const f32x4*)(G.DEC + ((size_t)bh * 129 + c + 2) * 64 + 16 * i + 4 * q);
    }
    u32x2 grv[4];
    if (PASS == 1 && c >= 1) {
#pragma unroll
      for (int n = 0; n < 4; ++n) grv[n] = *(const u32x2*)(G.GR + ((size_t)b * SEQ + 64 * (c - 1) + 16 * n + c16) * 512 + hd * 128 + 16 * w + 4 * q);
    }
    f32x4 OT[4];
    if (PASS == 1) {
      const int is = w >> 1;
#pragma unroll
      for (int z = 0; z < 2; ++z) {
        const int it = 2 * (w & 1) + z;
        f32x4 pa = {0.f, 0.f, 0.f, 0.f};
        if (is <= it) {
#pragma unroll
          for (int kk = 0; kk < 2; ++kk) {
            const bf16x8 ka = *(const bf16x8*)&Bc.Kt[(16 * is + c16) * GLDS + 32 * kk + 8 * q];
            const bf16x8 qb = *(const bf16x8*)&Bc.Qt[(16 * it + c16) * GLDS + 32 * kk + 8 * q];
            pa = MFMA16(ka, qb, pa);
          }
          if (is == it) {
#pragma unroll
            for (int r = 0; r < 4; ++r) if (4 * q + r > c16) pa[r] = 0.f;
          }
        }
        u32x2 pw; pw.x = pk2(pa[0], pa[1]); pw.y = pk2(pa[2], pa[3]);
        *(u32x2*)&L.P[(16 * it + c16) * GLDS + 16 * is + 4 * q] = pw;
      }
#pragma unroll
      for (int n = 0; n < 4; ++n) OT[n] = (f32x4){0.f, 0.f, 0.f, 0.f};
#pragma unroll
      for (int kk = 0; kk < 2; ++kk) {
        u32x4 xp; xp.x = pk2(X[2 * kk][0], X[2 * kk][1]); xp.y = pk2(X[2 * kk][2], X[2 * kk][3]);
        xp.z = pk2(X[2 * kk + 1][0], X[2 * kk + 1][1]); xp.w = pk2(X[2 * kk + 1][2], X[2 * kk + 1][3]);
        const bf16x8 xa = __builtin_bit_cast(bf16x8, xp);
#pragma unroll
        for (int n = 0; n < 4; ++n) {
          const u32x2 lo = *(const u32x2*)&Bc.Qt[(16 * n + c16) * GLDS + 32 * kk + 4 * q];
          const u32x2 hi = *(const u32x2*)&Bc.Qt[(16 * n + c16) * GLDS + 32 * kk + 16 + 4 * q];
          u32x4 qq; qq.x = lo.x; qq.y = lo.y; qq.z = hi.x; qq.w = hi.y;
          OT[n] = MFMA16(xa, __builtin_bit_cast(bf16x8, qq), OT[n]);
        }
      }
      __syncthreads();
#pragma unroll
      for (int kk = 0; kk < 2; ++kk)
#pragma unroll
        for (int n = 0; n < 4; ++n) {
          const bf16x8 pb = *(const bf16x8*)&L.P[(16 * n + c16) * GLDS + 32 * kk + 8 * q];
          OT[n] = MFMA16(vfr[kk], pb, OT[n]);
        }
    }
#pragma unroll
    for (int i = 0; i < 4; ++i) {
#pragma unroll
      for (int kk = 0; kk < 2; ++kk) {
        const bf16x8 ka = *(const bf16x8*)&Bc.KT[(16 * i + c16) * GLDS + 32 * kk + 8 * q];
        X[i] = MFMA16(ka, vfr[kk], X[i]);
      }
      X[i][0] *= dec[i].x; X[i][1] *= dec[i].y; X[i][2] *= dec[i].z; X[i][3] *= dec[i].w;
    }
    if (PASS == 1 && c >= 1) {
      float ss[4];
#pragma unroll
      for (int n = 0; n < 4; ++n) {
        float v = OT[n][0] * OT[n][0] + OT[n][1] * OT[n][1] + OT[n][2] * OT[n][2] + OT[n][3] * OT[n][3];
        v += __shfl_xor(v, 16); v += __shfl_xor(v, 32);
        ss[n] = v;
      }
      if (q == 0) {
#pragma unroll
        for (int n = 0; n < 4; ++n) L.ssq[w][16 * n + c16] = ss[n];
      }
      __syncthreads();
#pragma unroll
      for (int n = 0; n < 4; ++n) {
        float tot = 0.f;
#pragma unroll
        for (int w2 = 0; w2 < 8; ++w2) tot += L.ssq[w2][16 * n + c16];
        const float scl = rsqrtf(tot * (1.0f / 128.0f) + EPS);
        const size_t m = (size_t)b * SEQ + 64 * (c - 1) + 16 * n + c16;
        const float r0 = bflo(grv[n].x), r1 = bfhi(grv[n].x), r2 = bflo(grv[n].y), r3 = bfhi(grv[n].y);
        const float o0 = OT[n][0] * scl * gain.x * (r0 / (1.f + __expf(-r0)));
        const float o1 = OT[n][1] * scl * gain.y * (r1 / (1.f + __expf(-r1)));
        const float o2 = OT[n][2] * scl * gain.z * (r2 / (1.f + __expf(-r2)));
        const float o3 = OT[n][3] * scl * gain.w * (r3 / (1.f + __expf(-r3)));
        u32x2 ow; ow.x = pk2(o0, o1); ow.y = pk2(o2, o3);
        *(u32x2*)(G.MIX + m * D + 512 + hd * 128 + 16 * w + 4 * q) = ow;
      }
    }
    if (more) {
      GlaBuf& Bn = L.B[cur ^ 1];
      *(u32x4*)&Bn.KT[soff] = rkt;
      if (PASS == 1) { *(u32x4*)&Bn.Qt[soff] = rq; *(u32x4*)&Bn.Kt[soff] = rk; }
      vfr[0] = vfn[0]; vfr[1] = vfn[1];
#pragma unroll
      for (int i = 0; i < 4; ++i) dec[i] = decn[i];
      rkt = rkt2; rq = rq2; rk = rk2; vfn[0] = vfn2[0]; vfn[1] = vfn2[1];
#pragma unroll
      for (int i = 0; i < 4; ++i) decn[i] = decn2[i];
    }
    __syncthreads();
  }
  if (PASS == 0) {
    float* sl = G.SLOC + ((size_t)(bh * 16 + sc) * 8 + w) * 16 * 64 + lane;
#pragma unroll
    for (int i = 0; i < 4; ++i)
#pragma unroll
      for (int r = 0; r < 4; ++r) sl[(4 * i + r) * 64] = X[i][r];
    if (w == 0) {
      float bl = 0.f;
      for (int c = cbeg; c < cend; ++c) bl += G.BL[((size_t)bh * 129 + c) * 64 + lane];
      G.DTOT[(size_t)(bh * 16 + sc) * 64 + lane] = __expf(bl);
    }
  }
}

DI void ph_gvtrans(int vb, char* smem, const bf16_t* __restrict__ GV, bf16_t* __restrict__ GVT) {
  const int tid256_ = fresh_tid() & 255;
  bf16_t (*t)[66] = (bf16_t (*)[66])smem;
  const int tid = TID;
  const int eh = vb & 1, rest = vb >> 1, bh = rest / 258, ut = rest % 258, u0 = ut * 32;
  {
    const int row = tid >> 3, c8 = tid & 7;
    const u32x4 v = *(const u32x4*)(GV + ((size_t)bh * GU + u0 + row) * 128 + eh * 64 + c8 * 8);
    unsigned* tp = (unsigned*)&t[row][c8 * 8];
    tp[0] = v.x; tp[1] = v.y; tp[2] = v.z; tp[3] = v.w;
  }
  __syncthreads();
  {
    const int d = tid >> 2, i4 = tid & 3;
    unsigned wv[4];
#pragma unroll
    for (int j = 0; j < 4; ++j) wv[j] = (unsigned)t[i4 * 8 + 2 * j][d] | ((unsigned)t[i4 * 8 + 2 * j + 1][d] << 16);
    *(u32x4*)(GVT + ((size_t)bh * 128 + eh * 64 + d) * GU + u0 + i4 * 8) = (u32x4){wv[0], wv[1], wv[2], wv[3]};
  }
  __syncthreads();
}

DI void ce_desc(float& a, float& b) {
  const float hi = __builtin_fmaxf(a, b), lo = __builtin_fminf(a, b);
  a = hi; b = lo;
}
DI float vmaxf(float a, float b) { return __builtin_fmaxf(a, b); }
template <int N> DI void bitonic_sort_desc(float (&v)[N]) {
#pragma unroll
  for (int k = 2; k <= N; k <<= 1) {
#pragma unroll
    for (int j = k >> 1; j > 0; j >>= 1) {
#pragma unroll
      for (int i = 0; i < N; ++i) {
        const int l = i ^ j;
        if (l > i) { if ((i & k) == 0) ce_desc(v[i], v[l]); else ce_desc(v[l], v[i]); }
      }
    }
  }
}
DI void bitonic_merge16_desc(float (&v)[16]) {
#pragma unroll
  for (int j = 8; j > 0; j >>= 1) {
#pragma unroll
    for (int i = 0; i < 16; ++i) { const int l = i ^ j; if (l > i) ce_desc(v[i], v[l]); }
  }
}
template <int NBV> DI void merge_prune16(float (&a)[16], const float (&b)[16]) {
#pragma unroll
  for (int i = 16 - NBV; i < 16; ++i) a[i] = vmaxf(a[i], b[15 - i]);
  bitonic_merge16_desc(a);
}
DI float selh(int hh, float a, float b) { asm volatile("" : "+v"(a), "+v"(b)); return hh == 0 ? a : b; }
DI float pack_idx(float v, unsigned idx, unsigned mask) { return __uint_as_float((__float_as_uint(v) & ~mask) | idx); }

DI void ph_route_v2(int vb, char* smem, const bf16_t* __restrict__ QP, const bf16_t* __restrict__ SK1b, const bf16_t* __restrict__ SK2b,
                    unsigned short* __restrict__ EIDX, float* __restrict__ GATE) {
  const int tid256_ = fresh_tid() & 255;
  const int lane = TID & 63, wave = TID >> 6, r = lane & 31, hh = lane >> 5;
  const int hd = vb & 7, tile = vb >> 3;
  const int m = tile * 128 + wave * 32 + r;
  float loc[2][16];
#pragma unroll
  for (int L = 0; L < 2; ++L) {
    const bf16_t* qp = QP + (size_t)m * D + hd * 128 + L * 64 + hh * 8;
    const bf16_t* kb = (L == 0 ? SK1b : SK2b) + (size_t)(hd * 128 + r) * 64 + hh * 8;
    bf16x8 qf[4];
#pragma unroll
    for (int ks = 0; ks < 4; ++ks) qf[ks] = *(const bf16x8*)(qp + ks * 16);
    float grp[4][16];
#pragma unroll
    for (int mt = 0; mt < 4; ++mt) {
      f32x16 acc;
#pragma unroll
      for (int e = 0; e < 16; ++e) acc[e] = 0.f;
#pragma unroll
      for (int ks = 0; ks < 4; ++ks) {
        const bf16x8 kf = *(const bf16x8*)(kb + (size_t)mt * 32 * 64 + ks * 16);
        acc = MFMA32(kf, qf[ks], acc);
      }
#pragma unroll
      for (int e = 0; e < 16; ++e) grp[mt][e] = pack_idx(acc[e], (unsigned)(mt * 32 + crow(e, hh)), 127u);
      bitonic_sort_desc<16>(grp[mt]);
    }
    merge_prune16<16>(grp[0], grp[1]);
    merge_prune16<16>(grp[2], grp[3]);
    merge_prune16<16>(grp[0], grp[2]);
#pragma unroll
    for (int i = 0; i < 16; ++i) loc[L][i] = grp[0][i];
  }
  float fin[16], oth[16];
#pragma unroll
  for (int i = 0; i < 16; ++i) {
    const float send = selh(hh, loc[1][i], loc[0][i]);
    oth[i] = __shfl_xor(send, 32);
    fin[i] = selh(hh, loc[0][i], loc[1][i]);
  }
  merge_prune16<16>(fin, oth);
  float v1[16], v2[16];
#pragma unroll
  for (int i = 0; i < 16; ++i) {
    const float o = __shfl_xor(fin[i], 32);
    v1[i] = selh(hh, fin[i], o);
    v2[i] = selh(hh, o, fin[i]);
  }
  unsigned* ib = (unsigned*)smem + (size_t)TID * 8;
#pragma unroll
  for (int q = 0; q < 4; ++q) {
    unsigned w1 = 0, w2 = 0;
#pragma unroll
    for (int j = 0; j < 4; ++j) {
      w1 |= (__float_as_uint(v1[4 * q + j]) & 127u) << (8 * j);
      w2 |= (__float_as_uint(v2[4 * q + j]) & 127u) << (8 * j);
    }
    ib[q] = w1; ib[4 + q] = w2;
  }
  float R[16], Bv[16];
#pragma unroll
  for (int j = 0; j < 16; ++j) R[j] = pack_idx(v1[0] + v2[j], (unsigned)j, 255u);
#define ROUTE_ROW(I, CNT) { _Pragma("unroll") for (int j = 0; j < 16; ++j) Bv[j] = (j < CNT) ? pack_idx(v1[I] + v2[j < CNT ? j : 0], (unsigned)(I * 16 + j), 255u) : 0.f; \
    merge_prune16<CNT>(R, Bv); }
  ROUTE_ROW(1, 8) ROUTE_ROW(2, 5) ROUTE_ROW(3, 4) ROUTE_ROW(4, 3) ROUTE_ROW(5, 2) ROUTE_ROW(6, 2) ROUTE_ROW(7, 2)
#undef ROUTE_ROW
#pragma unroll
  for (int j = 0; j < 16; ++j) Bv[j] = (j < 8) ? pack_idx(v1[8 + (j < 8 ? j : 0)] + v2[0], (unsigned)((8 + j) * 16), 255u) : 0.f;
  merge_prune16<8>(R, Bv);
  float ex[16], sum = 0.f;
#pragma unroll
  for (int i = 0; i < 16; ++i) { ex[i] = __expf(R[i] - R[0]); sum += ex[i]; }
  const float inv = 1.f / sum;
  const unsigned char* ibb = (const unsigned char*)ib;
  int eo[8]; float go[8];
#pragma unroll
  for (int w = 0; w < 8; ++w) {
    const float rv = selh(hh, R[w], R[8 + w]);
    const float ev = selh(hh, ex[w], ex[8 + w]);
    const unsigned pos = __float_as_uint(rv) & 255u;
    const unsigned i1 = ibb[pos >> 4], i2 = ibb[16 + (pos & 15u)];
    eo[w] = (int)(i1 * 128u + i2);
    go[w] = ev * inv;
  }
  unsigned short* ep = EIDX + (size_t)m * 128 + hd * 16 + hh * 8;
  float* gp = GATE + (size_t)m * 128 + hd * 16 + hh * 8;
  *(u32x4*)ep = (u32x4){(unsigned)eo[0] | ((unsigned)eo[1] << 16), (unsigned)eo[2] | ((unsigned)eo[3] << 16), (unsigned)eo[4] | ((unsigned)eo[5] << 16), (unsigned)eo[6] | ((unsigned)eo[7] << 16)};
  *(f32x4*)gp = (f32x4){go[0], go[1], go[2], go[3]};
  *(f32x4*)(gp + 4) = (f32x4){go[4], go[5], go[6], go[7]};
}

DI void ph_peer_v1(int vb, char* smem, const bf16_t* __restrict__ A2, const bf16_t* __restrict__ EU, const bf16_t* __restrict__ EV,
                                                 const int* __restrict__ EIDX, const float* __restrict__ GATE, const float* __restrict__ H1,
                                                 const float* __restrict__ gf, float* __restrict__ out) {
  const int tid256_ = fresh_tid() & 255;
  float (*cs)[128] = (float (*)[128])smem;
  int (*es)[128] = (int (*)[128])(smem + 2048);
  const int lane = TID & 63, wave = TID >> 6;
  const int m = vb * 4 + wave;
  const int g = lane >> 3, sub = lane & 7;
  u32x4 xf[16];
#pragma unroll
  for (int j = 0; j < 16; ++j) xf[j] = *(const u32x4*)(A2 + (size_t)m * D + (j * 8 + sub) * 8);
  for (int bt = 0; bt < 16; ++bt) {
    const int k = bt * 8 + g;
    const int e = EIDX[(size_t)m * 128 + k];
    const bf16_t* up = EU + (size_t)e * D + sub * 8;
    float acc = 0.f;
#pragma unroll
    for (int j = 0; j < 16; ++j) {
      const u32x4 u = *(const u32x4*)(up + j * 64);
      acc = dot2bf(u.x, xf[j].x, acc); acc = dot2bf(u.y, xf[j].y, acc); acc = dot2bf(u.z, xf[j].z, acc); acc = dot2bf(u.w, xf[j].w, acc);
    }
    acc += __shfl_xor(acc, 1); acc += __shfl_xor(acc, 2); acc += __shfl_xor(acc, 4);
    if (sub == 0) {
      const float act = 0.5f * acc * (1.f + erff(acc * 0.70710678118654752f));
      cs[wave][k] = GATE[(size_t)m * 128 + k] * act;
      es[wave][k] = e;
    }
  }
  __builtin_amdgcn_wave_barrier();
  __syncthreads();
  float y[16];
#pragma unroll
  for (int j = 0; j < 16; ++j) y[j] = 0.f;
#pragma unroll 4
  for (int k = 0; k < 128; ++k) {
    const float c = cs[wave][k];
    const bf16_t* vp = EV + (size_t)es[wave][k] * D + lane * 8;
    const u32x4 v0 = *(const u32x4*)vp, v1 = *(const u32x4*)(vp + 512);
    y[0] += c * bflo(v0.x); y[1] += c * bfhi(v0.x); y[2] += c * bflo(v0.y); y[3] += c * bfhi(v0.y);
    y[4] += c * bflo(v0.z); y[5] += c * bfhi(v0.z); y[6] += c * bflo(v0.w); y[7] += c * bfhi(v0.w);
    y[8] += c * bflo(v1.x); y[9] += c * bfhi(v1.x); y[10] += c * bflo(v1.y); y[11] += c * bfhi(v1.y);
    y[12] += c * bflo(v1.z); y[13] += c * bfhi(v1.z); y[14] += c * bflo(v1.w); y[15] += c * bfhi(v1.w);
  }
  const float* hp = H1 + (size_t)m * D + lane * 8;
  float ss = 0.f;
#pragma unroll
  for (int q = 0; q < 4; ++q) {
    const f32x4 hv = *(const f32x4*)(hp + (q >> 1) * 512 + (q & 1) * 4);
    y[q * 4 + 0] += hv.x; y[q * 4 + 1] += hv.y; y[q * 4 + 2] += hv.z; y[q * 4 + 3] += hv.w;
  }
#pragma unroll
  for (int j = 0; j < 16; ++j) ss += y[j] * y[j];
  ss = wave_sum(ss);
  const float sc = rsqrtf(ss * (1.0f / D) + EPS);
  float* op = out + (size_t)m * D + lane * 8;
#pragma unroll
  for (int q = 0; q < 4; ++q) {
    const int off = (q >> 1) * 512 + (q & 1) * 4;
    const f32x4 gg = *(const f32x4*)(gf + lane * 8 + off);
    *(f32x4*)(op + off) = (f32x4){y[q * 4 + 0] * sc * gg.x, y[q * 4 + 1] * sc * gg.y, y[q * 4 + 2] * sc * gg.z, y[q * 4 + 3] * sc * gg.w};
  }
}


DI void ph_convert_eu(const float* __restrict__ src, bf16_t* __restrict__ EUs) {
  size_t i = (size_t)blockIdx.x * blockDim.x + threadIdx.x;
  const size_t stride = (size_t)gridDim.x * blockDim.x;
  for (; i < (size_t)NEXP * 128; i += stride) {
    const int e = (int)(i >> 7), pz = (int)(i & 127);
    const f32x4 a = ((const f32x4*)src)[2 * i], b = ((const f32x4*)src)[2 * i + 1];
    u32x4 o; o.x = pk2(a.x, a.y); o.y = pk2(a.z, a.w); o.z = pk2(b.x, b.y); o.w = pk2(b.z, b.w);
    *(u32x4*)(EUs + ((size_t)(pz >> 3) * NEXP + e) * 64 + (pz & 7) * 8) = o;
  }
}
DI void ph_convert_ev(int vb, char* smem, const float* __restrict__ src, bf16_t* __restrict__ EVc) {
  const int tid256_ = fresh_tid() & 255;
  bf16_t (*t)[1028] = (bf16_t (*)[1028])smem;
  const int e0 = vb * 32;
  for (int r = 0; r < 32; ++r) {
    const f32x4 a = *(const f32x4*)(src + (size_t)(e0 + r) * D + TID * 4);
    u32x2 o; o.x = pk2(a.x, a.y); o.y = pk2(a.z, a.w);
    *(u32x2*)&t[r][TID * 4] = o;
  }
  __syncthreads();
  const int r = TID & 31, cs = TID >> 5;
  for (int c0 = 0; c0 < 256; c0 += 8) {
    const int cg = c0 + cs;
    const u32x2 v = *(const u32x2*)&t[r][cg * 4];
    *(u32x2*)(EVc + ((size_t)cg * NEXP + e0 + r) * 4) = v;
  }
  __syncthreads();
}

DI float dpp_f(float v, const int ctrl_sel) {
  int r;
  if (ctrl_sel == 0) r = __builtin_amdgcn_update_dpp(0, __builtin_bit_cast(int, v), 0xB1, 0xF, 0xF, true);
  else if (ctrl_sel == 1) r = __builtin_amdgcn_update_dpp(0, __builtin_bit_cast(int, v), 0x4E, 0xF, 0xF, true);
  else r = __builtin_amdgcn_update_dpp(0, __builtin_bit_cast(int, v), 0x141, 0xF, 0xF, true);
  return __builtin_bit_cast(float, r);
}
DI float dpp_sum8(float v) {
  v += dpp_f(v, 0); v += dpp_f(v, 1); v += dpp_f(v, 2);
  return v;
}
DI void ph_peer_u(int xi, int nx, int wv, int nwv, const bf16_t* __restrict__ A2, const bf16_t* __restrict__ EUs,
                  const unsigned short* __restrict__ EIDX, bf16_t* __restrict__ PP) {
  const int lane = fresh_tid() & 63, g = lane >> 3, sub = lane & 7;
  for (int s = xi; s < 16; s += nx) {
    const bf16_t* tab = EUs + (size_t)s * NEXP * 64 + sub * 8;
    bf16_t* pp = PP + (size_t)s * TREAL * 128;
    for (int t = wv; t < TREAL; t += nwv) {
      const unsigned idxpair = __builtin_nontemporal_load((const unsigned*)(EIDX + (size_t)t * 128) + lane);
      const u32x4 xs = *(const u32x4*)(A2 + (size_t)t * D + s * 64 + sub * 8);
      u32x4 u[16];
#pragma unroll
      for (int j = 0; j < 16; ++j) {
        const unsigned w = (unsigned)__shfl((int)idxpair, (lane & ~7) + (j >> 1));
        const unsigned e = (j & 1) ? (w >> 16) : (w & 0xffffu);
        u[j] = *(const u32x4*)(tab + (size_t)e * 64);
      }
      float res0 = 0.f, res1 = 0.f;
#pragma unroll
      for (int j = 0; j < 16; ++j) {
        float acc = 0.f;
        acc = dot2bf(u[j].x, xs.x, acc); acc = dot2bf(u[j].y, xs.y, acc); acc = dot2bf(u[j].z, xs.z, acc); acc = dot2bf(u[j].w, xs.w, acc);
        acc = dpp_sum8(acc);
        if (sub == (j >> 1)) { if (j & 1) res1 = acc; else res0 = acc; }
      }
      __builtin_nontemporal_store(pk2(res0, res1), (unsigned*)(pp + (size_t)t * 128) + lane);
    }
  }
}
DI void ph_peer_c(const bf16_t* __restrict__ PP, const unsigned short* __restrict__ EIDX, const float* __restrict__ GATE, unsigned* __restrict__ STREAM) {
  size_t i = (size_t)blockIdx.x * blockDim.x + threadIdx.x;
  const size_t stride = (size_t)gridDim.x * blockDim.x, n = (size_t)TREAL * 128;
  for (; i < n; i += stride) {
    float a = 0.f;
#pragma unroll
    for (int s = 0; s < 16; ++s) a += bf2f(PP[(size_t)s * n + i]);
    const float act = 0.5f * a * (1.f + erff(a * 0.70710678118654752f));
    const float c = GATE[i] * act;
    const size_t t = i >> 7; const unsigned k = (unsigned)(i & 127);
    STREAM[(((t >> 6) * 32 + (k >> 2)) * 64 + (t & 63)) * 4 + (k & 3)] = (unsigned)EIDX[i] | (f2bf(c) << 16);
  }
}
DI void ph_peer_v(char* smem, const unsigned* __restrict__ STREAM, const bf16_t* __restrict__ EVc, float* __restrict__ YT) {
  const int tid = fresh_tid(), lane = tid & 63, wave = tid >> 6;
  u32x2* tabl = (u32x2*)smem;
  for (int cg = blockIdx.x; cg < 256; cg += gridDim.x) {
    const u32x4* src = (const u32x4*)(EVc + (size_t)cg * NEXP * 4);
#pragma unroll 4
    for (int i = tid; i < NEXP * 8 / 16; i += 512) ((u32x4*)smem)[i] = src[i];
    __syncthreads();
    for (int it = wave; it < TREAL / 64; it += 8) {
      const int t = it * 64 + lane;
      const u32x4* sp = (const u32x4*)(STREAM + (size_t)it * 8192) + lane;
      float y0 = 0.f, y1 = 0.f, y2 = 0.f, y3 = 0.f;
#pragma unroll 4
      for (int q = 0; q < 32; ++q) {
        const u32x4 w4 = sp[q * 64];
#pragma unroll
        for (int z = 0; z < 4; ++z) {
          const unsigned w = z == 0 ? w4.x : z == 1 ? w4.y : z == 2 ? w4.z : w4.w;
          const float c = bfhi(w);
          const u32x2 v = tabl[w & 0xffffu];
          y0 += c * bflo(v.x); y1 += c * bfhi(v.x); y2 += c * bflo(v.y); y3 += c * bfhi(v.y);
        }
      }
      *(f32x4*)(YT + ((size_t)cg * TREAL + t) * 4) = (f32x4){y0, y1, y2, y3};
    }
    __syncthreads();
  }
}
DI void ph_final(int wv4, const float* __restrict__ H1, const float* __restrict__ YT, const float* __restrict__ gf, float* __restrict__ out) {
  const int lane = fresh_tid() & 63;
  const int t0 = wv4 * 4;
  f32x4 y[4][4];
#pragma unroll
  for (int j = 0; j < 4; ++j) {
    const f32x4* yp = (const f32x4*)(YT + ((size_t)(lane + 64 * j) * TREAL + t0) * 4);
#pragma unroll
    for (int q = 0; q < 4; ++q) y[j][q] = yp[q];
  }
#pragma unroll
  for (int q = 0; q < 4; ++q) {
    const size_t rowoff = (size_t)(t0 + q) * D;
    float ss = 0.f;
#pragma unroll
    for (int j = 0; j < 4; ++j) {
      const f32x4 hv = *(const f32x4*)(H1 + rowoff + (lane + 64 * j) * 4);
      y[j][q].x += hv.x; y[j][q].y += hv.y; y[j][q].z += hv.z; y[j][q].w += hv.w;
      ss += y[j][q].x * y[j][q].x + y[j][q].y * y[j][q].y + y[j][q].z * y[j][q].z + y[j][q].w * y[j][q].w;
    }
    ss = wave_sum(ss);
    const float sc = rsqrtf(ss * (1.0f / D) + EPS);
#pragma unroll
    for (int j = 0; j < 4; ++j) {
      const f32x4 gg = *(const f32x4*)(gf + (lane + 64 * j) * 4);
      *(f32x4*)(out + rowoff + (lane + 64 * j) * 4) = (f32x4){y[j][q].x * sc * gg.x, y[j][q].y * sc * gg.y, y[j][q].z * sc * gg.z, y[j][q].w * sc * gg.w};
    }
  }
}


typedef unsigned char u8_t;
constexpr size_t WS_SCU = 14 * MiB;
constexpr size_t WS_SCV = 14 * MiB + 65536;
DI float wave_max(float v) {
#pragma unroll
  for (int o = 32; o >= 1; o >>= 1) v = fmaxf(v, __shfl_xor(v, o));
  return v;
}
DI u32x4 quant_row16(const float* __restrict__ rowp, int lane, float& sc) {
  const f32x4* rp = (const f32x4*)(rowp + lane * 16);
  const f32x4 a = rp[0], b = rp[1], c = rp[2], d = rp[3];
  float m = fmaxf(fmaxf(fmaxf(fabsf(a.x), fabsf(a.y)), fmaxf(fabsf(a.z), fabsf(a.w))), fmaxf(fmaxf(fabsf(b.x), fabsf(b.y)), fmaxf(fabsf(b.z), fabsf(b.w))));
  m = fmaxf(m, fmaxf(fmaxf(fmaxf(fabsf(c.x), fabsf(c.y)), fmaxf(fabsf(c.z), fabsf(c.w))), fmaxf(fmaxf(fabsf(d.x), fabsf(d.y)), fmaxf(fabsf(d.z), fabsf(d.w)))));
  m = wave_max(m);
  sc = m > 0.f ? m * (1.0f / 448.0f) : 1.0f;
  const float inv = 1.0f / sc;
  u32x4 o; unsigned w;
  w = 0; w = __builtin_amdgcn_cvt_pk_fp8_f32(a.x * inv, a.y * inv, w, false); w = __builtin_amdgcn_cvt_pk_fp8_f32(a.z * inv, a.w * inv, w, true); o.x = w;
  w = 0; w = __builtin_amdgcn_cvt_pk_fp8_f32(b.x * inv, b.y * inv, w, false); w = __builtin_amdgcn_cvt_pk_fp8_f32(b.z * inv, b.w * inv, w, true); o.y = w;
  w = 0; w = __builtin_amdgcn_cvt_pk_fp8_f32(c.x * inv, c.y * inv, w, false); w = __builtin_amdgcn_cvt_pk_fp8_f32(c.z * inv, c.w * inv, w, true); o.z = w;
  w = 0; w = __builtin_amdgcn_cvt_pk_fp8_f32(d.x * inv, d.y * inv, w, false); w = __builtin_amdgcn_cvt_pk_fp8_f32(d.z * inv, d.w * inv, w, true); o.w = w;
  return o;
}
DI void ph_convert_eu8(const float* __restrict__ src, u8_t* __restrict__ EU8s, float* __restrict__ scaleU) {
  const int tid = fresh_tid(), lane = tid & 63, wave = tid >> 6;
  for (int e = (blockIdx.x * 8 + wave) * 2; e < NEXP; e += gridDim.x * 16) {
    float sc0, sc1 = 1.f;
    const bool two = e + 1 < NEXP;
    const u32x4 o0 = quant_row16(src + (size_t)e * D, lane, sc0);
    u32x4 o1 = o0;
    if (two) o1 = quant_row16(src + (size_t)(e + 1) * D, lane, sc1);
    *(u32x4*)(EU8s + ((size_t)(lane >> 3) * NEXP + e) * 128 + (lane & 7) * 16) = o0;
    if (two) *(u32x4*)(EU8s + ((size_t)(lane >> 3) * NEXP + e + 1) * 128 + (lane & 7) * 16) = o1;
    if (lane == 0) { scaleU[e] = sc0; if (two) scaleU[e + 1] = sc1; }
  }
}
DI void ph_convert_ev8(int vb, char* smem, const float* __restrict__ src, u8_t* __restrict__ EV8c, float* __restrict__ scaleV) {
  const int tid256_ = fresh_tid() & 255;
  u8_t (*t)[1040] = (u8_t (*)[1040])smem;
  const int lane = TID & 63, wave = TID >> 6, e0 = vb * 32;
  for (int rr = 0; rr < 8; ++rr) {
    const int r = wave * 8 + rr;
    float sc;
    const u32x4 o = quant_row16(src + (size_t)(e0 + r) * D, lane, sc);
    *(u32x4*)&t[r][lane * 16] = o;
    if (lane == 0) scaleV[e0 + r] = sc;
  }
  __syncthreads();
  const int r = TID & 31, cs = TID >> 5;
  for (int c0 = 0; c0 < 128; c0 += 8) {
    const int cg = c0 + cs;
    const u32x2 v = *(const u32x2*)&t[r][cg * 8];
    *(u32x2*)(EV8c + ((size_t)cg * NEXP + e0 + r) * 8) = v;
  }
  __syncthreads();
}
DI float dot4_fp8(unsigned w, float x0, float x1, float x2, float x3, float acc) {
  const f32x2 lo = __builtin_amdgcn_cvt_pk_f32_fp8(w, false), hi = __builtin_amdgcn_cvt_pk_f32_fp8(w, true);
  acc += lo.x * x0; acc += lo.y * x1; acc += hi.x * x2; acc += hi.y * x3;
  return acc;
}
struct PeerUHalf { u32x4 u[8]; };
template <int HF> DI void peer_u8_issue(PeerUHalf& H, unsigned idxpair, int lane, const u8_t* __restrict__ tab) {
#pragma unroll
  for (int jj = 0; jj < 8; ++jj) {
    const int j = 8 * HF + jj;
    const unsigned w = (unsigned)__shfl((int)idxpair, (lane & ~7) + (j >> 1));
    const unsigned e = (j & 1) ? (w >> 16) : (w & 0xffffu);
    H.u[jj] = *(const u32x4*)(tab + (size_t)e * 128);
  }
}
template <int HF> DI void peer_u8_compute(const PeerUHalf& H, const u32x4 xa, const u32x4 xb, int sub, float& res0, float& res1) {
  const float x0 = bflo(xa.x), x1 = bfhi(xa.x), x2 = bflo(xa.y), x3 = bfhi(xa.y), x4 = bflo(xa.z), x5 = bfhi(xa.z), x6 = bflo(xa.w), x7 = bfhi(xa.w);
  const float x8 = bflo(xb.x), x9 = bfhi(xb.x), x10 = bflo(xb.y), x11 = bfhi(xb.y), x12 = bflo(xb.z), x13 = bfhi(xb.z), x14 = bflo(xb.w), x15 = bfhi(xb.w);
#pragma unroll
  for (int jj = 0; jj < 8; ++jj) {
    const int j = 8 * HF + jj;
    float acc = 0.f;
    acc = dot4_fp8(H.u[jj].x, x0, x1, x2, x3, acc); acc = dot4_fp8(H.u[jj].y, x4, x5, x6, x7, acc);
    acc = dot4_fp8(H.u[jj].z, x8, x9, x10, x11, acc); acc = dot4_fp8(H.u[jj].w, x12, x13, x14, x15, acc);
    acc = dpp_sum8(acc);
    if (sub == (j >> 1)) { if (j & 1) res1 = acc; else res0 = acc; }
  }
}
DI unsigned peer_u8_idx(const unsigned short* __restrict__ EIDX, int t, int lane) {
  return t < TREAL ? __builtin_nontemporal_load((const unsigned*)(EIDX + (size_t)t * 128) + lane) : 0u;
}
DI void ph_peer_u8(int xi, int nx, int wv, int nwv, const bf16_t* __restrict__ A2, const u8_t* __restrict__ EU8s,
                   const unsigned short* __restrict__ EIDX, bf16_t* __restrict__ PP) {
  const int lane = fresh_tid() & 63, sub = lane & 7;
  const int ntok = (TREAL - wv + nwv - 1) / nwv;
#define PU_TOK(i) (wv + ((i) < ntok ? (i) : ntok - 1) * nwv)
#define PU_IDX(t) __builtin_nontemporal_load((const unsigned*)(EIDX + (size_t)(t) * 128) + lane)
#define PU_LDX(xa_, xb_, t) { xa_ = *(const u32x4*)(xbase + (size_t)(t) * D); xb_ = *(const u32x4*)(xbase + (size_t)(t) * D + 8); }
#define PU_STORE(t, r0, r1) __builtin_nontemporal_store(pk2(r0, r1), (unsigned*)(pp + (size_t)(t) * 128) + lane)
  for (int s = xi; s < 8; s += nx) {
    const u8_t* tab = EU8s + (size_t)s * NEXP * 128 + sub * 16;
    const bf16_t* xbase = A2 + s * 128 + sub * 16;
    bf16_t* pp = PP + (size_t)s * TREAL * 128;
    PeerUHalf HA, HB, HC;
    int ta = PU_TOK(0), tb = PU_TOK(1), tc = PU_TOK(2);
    unsigned ia = PU_IDX(ta), ib = PU_IDX(tb), ic = PU_IDX(tc);
    u32x4 xaa, xab; PU_LDX(xaa, xab, ta);
    peer_u8_issue<0>(HA, ia, lane, tab);
    peer_u8_issue<1>(HB, ia, lane, tab);
    for (int i = 0; i < ntok; i += 3) {
      const int td = PU_TOK(i + 3), te = PU_TOK(i + 4), tf = PU_TOK(i + 5);
      u32x4 xba, xbb, xca, xcb, xda, xdb;
      float r0, r1;
      peer_u8_issue<0>(HC, ib, lane, tab); PU_LDX(xba, xbb, tb); const unsigned id = PU_IDX(td);
      r0 = 0.f; r1 = 0.f;
      peer_u8_compute<0>(HA, xaa, xab, sub, r0, r1);
      peer_u8_issue<1>(HA, ib, lane, tab);
      peer_u8_compute<1>(HB, xaa, xab, sub, r0, r1);
      PU_STORE(ta, r0, r1);
      peer_u8_issue<0>(HB, ic, lane, tab); PU_LDX(xca, xcb, tc); const unsigned ie = PU_IDX(te);
      r0 = 0.f; r1 = 0.f;
      peer_u8_compute<0>(HC, xba, xbb, sub, r0, r1);
      peer_u8_issue<1>(HC, ic, lane, tab);
      peer_u8_compute<1>(HA, xba, xbb, sub, r0, r1);
      PU_STORE(tb, r0, r1);
      peer_u8_issue<0>(HA, id, lane, tab); PU_LDX(xda, xdb, td); const unsigned if_ = PU_IDX(tf);
      r0 = 0.f; r1 = 0.f;
      peer_u8_compute<0>(HB, xca, xcb, sub, r0, r1);
      peer_u8_issue<1>(HB, id, lane, tab);
      peer_u8_compute<1>(HC, xca, xcb, sub, r0, r1);
      PU_STORE(tc, r0, r1);
      ta = td; tb = te; tc = tf; ib = ie; ic = if_; xaa = xda; xab = xdb;
    }
  }
#undef PU_TOK
#undef PU_IDX
#undef PU_LDX
#undef PU_STORE
}
DI void ph_peer_c8(int unit, char* smem, const bf16_t* __restrict__ PP, const unsigned short* __restrict__ EIDX, const float* __restrict__ GATE,
                   const float* __restrict__ scaleU, const float* __restrict__ scaleV, unsigned* __restrict__ STREAM) {
  unsigned (*tile)[132] = (unsigned (*)[132])smem;
  const int tid = fresh_tid();
  const int tl = tid >> 3, kc = tid & 7;
  const size_t rowoff = ((size_t)unit * 64 + tl) * 128 + kc * 16;
  const size_t n = (size_t)TREAL * 128;
  float a[16];
#pragma unroll
  for (int j = 0; j < 16; ++j) a[j] = 0.f;
#pragma unroll
  for (int s = 0; s < 8; ++s) {
    const u32x4 p0 = *(const u32x4*)(PP + (size_t)s * n + rowoff), p1 = *(const u32x4*)(PP + (size_t)s * n + rowoff + 8);
    a[0] += bflo(p0.x); a[1] += bfhi(p0.x); a[2] += bflo(p0.y); a[3] += bfhi(p0.y); a[4] += bflo(p0.z); a[5] += bfhi(p0.z); a[6] += bflo(p0.w); a[7] += bfhi(p0.w);
    a[8] += bflo(p1.x); a[9] += bfhi(p1.x); a[10] += bflo(p1.y); a[11] += bfhi(p1.y); a[12] += bflo(p1.z); a[13] += bfhi(p1.z); a[14] += bflo(p1.w); a[15] += bfhi(p1.w);
  }
  const u32x4 e0 = *(const u32x4*)(EIDX + rowoff), e1 = *(const u32x4*)(EIDX + rowoff + 8);
  unsigned ev[16] = {e0.x & 0xffffu, e0.x >> 16, e0.y & 0xffffu, e0.y >> 16, e0.z & 0xffffu, e0.z >> 16, e0.w & 0xffffu, e0.w >> 16,
                     e1.x & 0xffffu, e1.x >> 16, e1.y & 0xffffu, e1.y >> 16, e1.z & 0xffffu, e1.z >> 16, e1.w & 0xffffu, e1.w >> 16};
  float gt[16];
#pragma unroll
  for (int j = 0; j < 4; ++j) { const f32x4 g4 = *(const f32x4*)(GATE + rowoff + 4 * j); gt[4 * j] = g4.x; gt[4 * j + 1] = g4.y; gt[4 * j + 2] = g4.z; gt[4 * j + 3] = g4.w; }
#pragma unroll
  for (int j = 0; j < 16; ++j) {
    const unsigned e = ev[j];
    const float av = a[j] * scaleU[e];
    const float act = 0.5f * av * (1.f + erff(av * 0.70710678118654752f));
    const float c = gt[j] * act * scaleV[e];
    tile[tl][kc * 16 + j] = e | (f2bf(c) << 16);
  }
  __syncthreads();
  unsigned* outp = STREAM + (size_t)unit * 8192;
#pragma unroll 4
  for (int j = 0; j < 16; ++j) {
    const int o = tid + 512 * j, q = o >> 8, t2 = (o >> 2) & 63, z = o & 3;
    outp[o] = tile[t2][4 * q + z];
  }
  __syncthreads();
}
struct PVW { u32x4 a, b; };
struct PVT { u32x2 v[8]; };
DI void pv_loadw(PVW& W, const unsigned* __restrict__ STREAM, int it, int g, int lane) {
  const u32x4* sp = (const u32x4*)(STREAM + (size_t)it * 8192) + lane;
  W.a = sp[(2 * g) * 64]; W.b = sp[(2 * g + 1) * 64];
}
DI void pv_readt(PVT& T, const PVW& W, const u32x2* tabl) {
  T.v[0] = tabl[W.a.x & 0xffffu]; T.v[1] = tabl[W.a.y & 0xffffu]; T.v[2] = tabl[W.a.z & 0xffffu]; T.v[3] = tabl[W.a.w & 0xffffu];
  T.v[4] = tabl[W.b.x & 0xffffu]; T.v[5] = tabl[W.b.y & 0xffffu]; T.v[6] = tabl[W.b.z & 0xffffu]; T.v[7] = tabl[W.b.w & 0xffffu];
}
DI void pv_fma1(unsigned w, const u32x2 v, f32x2 (&y)[4]) {
  const float c = bfhi(w);
  const f32x2 cc = {c, c};
  y[0] = __builtin_elementwise_fma(__builtin_amdgcn_cvt_pk_f32_fp8(v.x, false), cc, y[0]);
  y[1] = __builtin_elementwise_fma(__builtin_amdgcn_cvt_pk_f32_fp8(v.x, true), cc, y[1]);
  y[2] = __builtin_elementwise_fma(__builtin_amdgcn_cvt_pk_f32_fp8(v.y, false), cc, y[2]);
  y[3] = __builtin_elementwise_fma(__builtin_amdgcn_cvt_pk_f32_fp8(v.y, true), cc, y[3]);
}
DI void pv_fma(const PVW& W, const PVT& T, f32x2 (&y)[4]) {
  pv_fma1(W.a.x, T.v[0], y); pv_fma1(W.a.y, T.v[1], y); pv_fma1(W.a.z, T.v[2], y); pv_fma1(W.a.w, T.v[3], y);
  pv_fma1(W.b.x, T.v[4], y); pv_fma1(W.b.y, T.v[5], y); pv_fma1(W.b.z, T.v[6], y); pv_fma1(W.b.w, T.v[7], y);
}
DI void ph_peer_v8(char* smem, const unsigned* __restrict__ STREAM, const u8_t* __restrict__ EV8c, bf16_t* __restrict__ YT) {
  const int tid = fresh_tid(), lane = tid & 63, wave = tid >> 6;
  const u32x2* tabl = (const u32x2*)smem;
  for (int unit = blockIdx.x; unit < 256; unit += gridDim.x) {
    const int cg = unit & 127, th = unit >> 7;
    const u32x4* src = (const u32x4*)(EV8c + (size_t)cg * NEXP * 8);
#pragma unroll 4
    for (int i = tid; i < NEXP * 8 / 16; i += 512) ((u32x4*)smem)[i] = src[i];
    __syncthreads();
    const int it_end = th * 512 + 512;
    int it = th * 512 + wave;
    PVW W0, W1, W2, W3; PVT T0, T1;
    pv_loadw(W0, STREAM, it, 0, lane); pv_loadw(W1, STREAM, it, 1, lane);
    pv_readt(T0, W0, tabl);
    for (; it < it_end; it += 8) {
      const int itn = (it + 8 < it_end) ? it + 8 : it;
      f32x2 y[4];
#pragma unroll
      for (int z = 0; z < 4; ++z) y[z] = (f32x2){0.f, 0.f};
#define PV_STEP(g, Wld, Wrd, Trd, Wc, Tc) \
      pv_loadw(Wld, STREAM, ((g) + 2 < 16) ? it : itn, ((g) + 2) & 15, lane); \
      pv_readt(Trd, Wrd, tabl); \
      pv_fma(Wc, Tc, y); \
      asm volatile("" ::: "memory");
      PV_STEP(0, W2, W1, T1, W0, T0)  PV_STEP(1, W3, W2, T0, W1, T1)  PV_STEP(2, W0, W3, T1, W2, T0)  PV_STEP(3, W1, W0, T0, W3, T1)
      PV_STEP(4, W2, W1, T1, W0, T0)  PV_STEP(5, W3, W2, T0, W1, T1)  PV_STEP(6, W0, W3, T1, W2, T0)  PV_STEP(7, W1, W0, T0, W3, T1)
      PV_STEP(8, W2, W1, T1, W0, T0)  PV_STEP(9, W3, W2, T0, W1, T1)  PV_STEP(10, W0, W3, T1, W2, T0) PV_STEP(11, W1, W0, T0, W3, T1)
      PV_STEP(12, W2, W1, T1, W0, T0) PV_STEP(13, W3, W2, T0, W1, T1) PV_STEP(14, W0, W3, T1, W2, T0) PV_STEP(15, W1, W0, T0, W3, T1)
#undef PV_STEP
      const int t = it * 64 + lane;
      u32x4 yw; yw.x = pk2(y[0].x, y[0].y); yw.y = pk2(y[1].x, y[1].y); yw.z = pk2(y[2].x, y[2].y); yw.w = pk2(y[3].x, y[3].y);
      *(u32x4*)(YT + ((size_t)cg * TREAL + t) * 8) = yw;
    }
    __syncthreads();
  }
}
DI void ph_final8(int wv2, const float* __restrict__ H1, const float* __restrict__ YT, const float* __restrict__ gf, float* __restrict__ out) {
  const int lane = fresh_tid() & 63;
  const int t0 = wv2 * 2;
  f32x4 y[2][2][2];
#pragma unroll
  for (int j = 0; j < 2; ++j) {
    const f32x4* yp = (const f32x4*)(YT + ((size_t)(lane + 64 * j) * TREAL + t0) * 8);
    y[j][0][0] = yp[0]; y[j][0][1] = yp[1]; y[j][1][0] = yp[2]; y[j][1][1] = yp[3];
  }
#pragma unroll
  for (int q = 0; q < 2; ++q) {
    const size_t rowoff = (size_t)(t0 + q) * D;
    float ss = 0.f;
#pragma unroll
    for (int j = 0; j < 2; ++j)
#pragma unroll
      for (int hf = 0; hf < 2; ++hf) {
        const f32x4 hv = *(const f32x4*)(H1 + rowoff + (lane + 64 * j) * 8 + hf * 4);
        f32x4& yy = y[j][q][hf];
        yy.x += hv.x; yy.y += hv.y; yy.z += hv.z; yy.w += hv.w;
        ss += yy.x * yy.x + yy.y * yy.y + yy.z * yy.z + yy.w * yy.w;
      }
    ss = wave_sum(ss);
    const float sc = rsqrtf(ss * (1.0f / D) + EPS);
#pragma unroll
    for (int j = 0; j < 2; ++j)
#pragma unroll
      for (int hf = 0; hf < 2; ++hf) {
        const f32x4 gg = *(const f32x4*)(gf + (lane + 64 * j) * 8 + hf * 4);
        const f32x4 yy = y[j][q][hf];
        *(f32x4*)(out + rowoff + (lane + 64 * j) * 8 + hf * 4) = (f32x4){yy.x * sc * gg.x, yy.y * sc * gg.y, yy.z * sc * gg.z, yy.w * sc * gg.w};
      }
  }
}


DI void ph_final_lds(int unit, char* smem, const bf16_t* __restrict__ H1, const bf16_t* __restrict__ YT, const float* __restrict__ gf, float* __restrict__ out) {
  float (*h2)[1028] = (float (*)[1028])smem;
  const int tid = fresh_tid(), lane = tid & 63, wave = tid >> 6;
  const int t0 = unit * 32;
#pragma unroll
  for (int rr = 0; rr < 4; ++rr) {
    const int r = wave * 4 + rr;
    const bf16_t* hp = H1 + (size_t)(t0 + r) * D;
#pragma unroll
    for (int j = 0; j < 2; ++j) {
      const u32x4 hw = *(const u32x4*)(hp + j * 512 + lane * 8);
      *(f32x4*)&h2[r][j * 512 + lane * 8] = (f32x4){bflo(hw.x), bfhi(hw.x), bflo(hw.y), bfhi(hw.y)};
      *(f32x4*)&h2[r][j * 512 + lane * 8 + 4] = (f32x4){bflo(hw.z), bfhi(hw.z), bflo(hw.w), bfhi(hw.w)};
    }
  }
  __syncthreads();
  {
    const int tok = lane & 31;
#pragma unroll 4
    for (int cg = wave * 2 + (lane >> 5); cg < 128; cg += 16) {
      const u32x4 yw = *(const u32x4*)(YT + ((size_t)cg * TREAL + t0 + tok) * 8);
      f32x4* hp = (f32x4*)&h2[tok][cg * 8];
      f32x4 a = hp[0], b4 = hp[1];
      a.x += bflo(yw.x); a.y += bfhi(yw.x); a.z += bflo(yw.y); a.w += bfhi(yw.y);
      b4.x += bflo(yw.z); b4.y += bfhi(yw.z); b4.z += bflo(yw.w); b4.w += bfhi(yw.w);
      hp[0] = a; hp[1] = b4;
    }
  }
  __syncthreads();
#pragma unroll
  for (int rr = 0; rr < 4; ++rr) {
    const int r = wave * 4 + rr;
    f32x4 v[4]; float ss = 0.f;
#pragma unroll
    for (int j = 0; j < 4; ++j) { v[j] = *(const f32x4*)&h2[r][j * 256 + lane * 4]; ss += v[j].x * v[j].x + v[j].y * v[j].y + v[j].z * v[j].z + v[j].w * v[j].w; }
    ss = wave_sum(ss);
    const float sc = rsqrtf(ss * (1.0f / D) + EPS);
    float* op = out + (size_t)(t0 + r) * D;
#pragma unroll
    for (int j = 0; j < 4; ++j) {
      const f32x4 gg = *(const f32x4*)(gf + j * 256 + lane * 4);
      *(f32x4*)(op + j * 256 + lane * 4) = (f32x4){v[j].x * sc * gg.x, v[j].y * sc * gg.y, v[j].z * sc * gg.z, v[j].w * sc * gg.w};
    }
  }
  __syncthreads();
}

typedef int i32x4 __attribute__((ext_vector_type(4)));
constexpr size_t WS_XQ = 861 * MiB;
constexpr size_t WS_XS = 943 * MiB;
DI unsigned pack_i8x4(float a, float b, float c, float d) {
  const int ia = __float2int_rn(a), ib = __float2int_rn(b), ic = __float2int_rn(c), id = __float2int_rn(d);
  return ((unsigned)ia & 255u) | (((unsigned)ib & 255u) << 8) | (((unsigned)ic & 255u) << 16) | ((unsigned)id << 24);
}
DI u32x4 quant_row16_i8(const float* __restrict__ rowp, int lane, float& sc) {
  const f32x4* rp = (const f32x4*)(rowp + lane * 16);
  const f32x4 a = rp[0], b = rp[1], c = rp[2], d = rp[3];
  float m = fmaxf(fmaxf(fmaxf(fabsf(a.x), fabsf(a.y)), fmaxf(fabsf(a.z), fabsf(a.w))), fmaxf(fmaxf(fabsf(b.x), fabsf(b.y)), fmaxf(fabsf(b.z), fabsf(b.w))));
  m = fmaxf(m, fmaxf(fmaxf(fmaxf(fabsf(c.x), fabsf(c.y)), fmaxf(fabsf(c.z), fabsf(c.w))), fmaxf(fmaxf(fabsf(d.x), fabsf(d.y)), fmaxf(fabsf(d.z), fabsf(d.w)))));
  m = wave_max(m);
  sc = m > 0.f ? m * (1.0f / 127.0f) : 1.0f;
  const float inv = 1.0f / sc;
  u32x4 o;
  o.x = pack_i8x4(a.x * inv, a.y * inv, a.z * inv, a.w * inv); o.y = pack_i8x4(b.x * inv, b.y * inv, b.z * inv, b.w * inv);
  o.z = pack_i8x4(c.x * inv, c.y * inv, c.z * inv, c.w * inv); o.w = pack_i8x4(d.x * inv, d.y * inv, d.z * inv, d.w * inv);
  return o;
}
DI void ph_convert_eu_i8(const float* __restrict__ src, u8_t* __restrict__ EUq, float* __restrict__ scaleU) {
  const int tid = fresh_tid(), lane = tid & 63, wave = tid >> 6;
  for (int e = (blockIdx.x * 8 + wave) * 2; e < NEXP; e += gridDim.x * 16) {
    float sc0, sc1 = 1.f;
    const bool two = e + 1 < NEXP;
    const u32x4 o0 = quant_row16_i8(src + (size_t)e * D, lane, sc0);
    u32x4 o1 = o0;
    if (two) o1 = quant_row16_i8(src + (size_t)(e + 1) * D, lane, sc1);
    *(u32x4*)(EUq + ((size_t)(lane >> 3) * NEXP + e) * 128 + (lane & 7) * 16) = o0;
    if (two) *(u32x4*)(EUq + ((size_t)(lane >> 3) * NEXP + e + 1) * 128 + (lane & 7) * 16) = o1;
    if (lane == 0) { scaleU[e] = sc0; if (two) scaleU[e + 1] = sc1; }
  }
}
DI void ph_norm2_rows(int vb, const bf16_t* __restrict__ src, const float* __restrict__ gain, float* __restrict__ R2, u8_t* __restrict__ XQ, float* __restrict__ XS) {
  const int tid256_ = fresh_tid() & 255;
  const int row0 = vb * 16 + (TID >> 6) * 4, lane = TID & 63;
  u32x2 raw[4][4];
#pragma unroll
  for (int rr = 0; rr < 4; ++rr)
#pragma unroll
    for (int j = 0; j < 4; ++j) raw[rr][j] = *(const u32x2*)(src + (size_t)(row0 + rr) * D + j * 256 + lane * 4);
  f32x4 gg[4];
#pragma unroll
  for (int j = 0; j < 4; ++j) gg[j] = *(const f32x4*)(gain + j * 256 + lane * 4);
#pragma unroll
  for (int rr = 0; rr < 4; ++rr) {
    f32x4 v[4]; float ss = 0.f;
#pragma unroll
    for (int j = 0; j < 4; ++j) {
      v[j] = (f32x4){bflo(raw[rr][j].x), bfhi(raw[rr][j].x), bflo(raw[rr][j].y), bfhi(raw[rr][j].y)};
      ss += v[j].x * v[j].x + v[j].y * v[j].y + v[j].z * v[j].z + v[j].w * v[j].w;
    }
    ss = wave_sum(ss);
    const float r = rsqrtf(ss * (1.0f / D) + EPS);
    if (lane == 0) R2[row0 + rr] = r;
#pragma unroll
    for (int j = 0; j < 4; ++j) {
      const float a0 = v[j].x * gg[j].x, a1 = v[j].y * gg[j].y, a2 = v[j].z * gg[j].z, a3 = v[j].w * gg[j].w;
      float m = fmaxf(fmaxf(fabsf(a0), fabsf(a1)), fmaxf(fabsf(a2), fabsf(a3)));
#pragma unroll
      for (int sh = 16; sh >= 1; sh >>= 1) m = fmaxf(m, __shfl_xor(m, sh));
      const float inv = m > 0.f ? 127.0f / m : 0.f;
      *(unsigned*)(XQ + (size_t)(row0 + rr) * D + j * 256 + lane * 4) = pack_i8x4(a0 * inv, a1 * inv, a2 * inv, a3 * inv);
      if ((lane & 31) == 0) XS[(size_t)(row0 + rr) * 8 + 2 * j + (lane >> 5)] = m * r * (1.0f / 127.0f);
    }
  }
}
DI int dpp_i(int v, const int sel) {
  if (sel == 0) return __builtin_amdgcn_update_dpp(0, v, 0xB1, 0xF, 0xF, true);
  if (sel == 1) return __builtin_amdgcn_update_dpp(0, v, 0x4E, 0xF, 0xF, true);
  return __builtin_amdgcn_update_dpp(0, v, 0x141, 0xF, 0xF, true);
}
DI int dpp_isum8(int v) { v += dpp_i(v, 0); v += dpp_i(v, 1); v += dpp_i(v, 2); return v; }
template <int HF> DI void peer_ud4_issue(PeerUHalf& H, unsigned idxpair, int lane, const u8_t* __restrict__ tab) {
#pragma unroll
  for (int jj = 0; jj < 8; ++jj) {
    const int j = 8 * HF + jj;
    const unsigned w = (unsigned)__shfl((int)idxpair, (lane & ~7) + (j >> 1));
    const unsigned e = (j & 1) ? (w >> 16) : (w & 0xffffu);
    H.u[jj] = *(const u32x4*)(tab + (size_t)e * 128);
  }
}
template <int HF> DI void peer_ud4_compute(const PeerUHalf& H, const u32x4 xq, int sub, int& res0, int& res1) {
#pragma unroll
  for (int jj = 0; jj < 8; ++jj) {
    const int j = 8 * HF + jj;
    int acc = 0;
    acc = __builtin_amdgcn_sdot4((int)H.u[jj].x, (int)xq.x, acc, false); acc = __builtin_amdgcn_sdot4((int)H.u[jj].y, (int)xq.y, acc, false);
    acc = __builtin_amdgcn_sdot4((int)H.u[jj].z, (int)xq.z, acc, false); acc = __builtin_amdgcn_sdot4((int)H.u[jj].w, (int)xq.w, acc, false);
    acc = dpp_isum8(acc);
    if (sub == (j >> 1)) { if (j & 1) res1 = acc; else res0 = acc; }
  }
}
DI void ph_peer_u_d4(int xi, int nx, int wv, int nwv, const u8_t* __restrict__ XQ, const float* __restrict__ XS, const u8_t* __restrict__ EUq,
                     const unsigned short* __restrict__ EIDX, bf16_t* __restrict__ PP) {
  const int lane = fresh_tid() & 63, sub = lane & 7;
  const int ntok = (TREAL - wv + nwv - 1) / nwv;
#define PU_TOK(i) (wv + ((i) < ntok ? (i) : ntok - 1) * nwv)
#define PU_IDX(t) __builtin_nontemporal_load((const unsigned*)(EIDX + (size_t)(t) * 128) + lane)
#define PU_LDX(xq_, xs_, t) { xq_ = *(const u32x4*)(xbase + (size_t)(t) * D); xs_ = XS[(size_t)(t) * 8 + s]; }
#define PU_STORE(t, r0, r1, xs_) __builtin_nontemporal_store(pk2((float)(r0) * (xs_), (float)(r1) * (xs_)), (unsigned*)(pp + (size_t)(t) * 128) + lane)
  for (int s = xi; s < 8; s += nx) {
    const u8_t* tab = EUq + (size_t)s * NEXP * 128 + sub * 16;
    const u8_t* xbase = XQ + s * 128 + sub * 16;
    bf16_t* pp = PP + (size_t)s * TREAL * 128;
    PeerUHalf HA, HB, HC;
    int ta = PU_TOK(0), tb = PU_TOK(1), tc = PU_TOK(2);
    unsigned ia = PU_IDX(ta), ib = PU_IDX(tb), ic = PU_IDX(tc);
    u32x4 xqa; float xsa; PU_LDX(xqa, xsa, ta);
    peer_ud4_issue<0>(HA, ia, lane, tab);
    peer_ud4_issue<1>(HB, ia, lane, tab);
    for (int i = 0; i < ntok; i += 3) {
      const int td = PU_TOK(i + 3), te = PU_TOK(i + 4), tf = PU_TOK(i + 5);
      u32x4 xqb, xqc, xqd; float xsb, xsc, xsd;
      int r0, r1;
      peer_ud4_issue<0>(HC, ib, lane, tab); PU_LDX(xqb, xsb, tb); const unsigned id = PU_IDX(td);
      r0 = 0; r1 = 0;
      peer_ud4_compute<0>(HA, xqa, sub, r0, r1);
      peer_ud4_issue<1>(HA, ib, lane, tab);
      peer_ud4_compute<1>(HB, xqa, sub, r0, r1);
      PU_STORE(ta, r0, r1, xsa);
      peer_ud4_issue<0>(HB, ic, lane, tab); PU_LDX(xqc, xsc, tc); const unsigned ie = PU_IDX(te);
      r0 = 0; r1 = 0;
      peer_ud4_compute<0>(HC, xqb, sub, r0, r1);
      peer_ud4_issue<1>(HC, ic, lane, tab);
      peer_ud4_compute<1>(HA, xqb, sub, r0, r1);
      PU_STORE(tb, r0, r1, xsb);
      peer_ud4_issue<0>(HA, id, lane, tab); PU_LDX(xqd, xsd, td); const unsigned if_ = PU_IDX(tf);
      r0 = 0; r1 = 0;
      peer_ud4_compute<0>(HB, xqc, sub, r0, r1);
      peer_ud4_issue<1>(HB, id, lane, tab);
      peer_ud4_compute<1>(HC, xqc, sub, r0, r1);
      PU_STORE(tc, r0, r1, xsc);
      ta = td; tb = te; tc = tf; ib = ie; ic = if_; xqa = xqd; xsa = xsd;
    }
  }
#undef PU_TOK
#undef PU_IDX
#undef PU_LDX
#undef PU_STORE
}

struct PUI { i32x4 a[8]; };
struct PUE { int e[8]; };
DI void pui_idx(PUE& E, const unsigned short* __restrict__ EIDX, int t, int c16) {
#pragma unroll
  for (int tau = 0; tau < 8; ++tau) E.e[tau] = EIDX[(size_t)t * 128 + 16 * tau + c16];
}
template <int HF> DI void pui_issue(PUI& H, const PUE& E, const u8_t* __restrict__ tab) {
#pragma unroll
  for (int tt = 0; tt < 4; ++tt) {
    const u8_t* pz = tab + (size_t)E.e[4 * HF + tt] * 128;
    H.a[2 * tt] = *(const i32x4*)pz; H.a[2 * tt + 1] = *(const i32x4*)(pz + 64);
  }
}
DI i32x4 pui_compute(const PUI& H, const i32x4 xb0, const i32x4 xb1, int c16) {
  i32x4 out = {0, 0, 0, 0};
#pragma unroll
  for (int tt = 0; tt < 4; ++tt) {
    i32x4 acc = {0, 0, 0, 0};
    acc = __builtin_amdgcn_mfma_i32_16x16x64_i8(H.a[2 * tt], xb0, acc, 0, 0, 0);
    acc = __builtin_amdgcn_mfma_i32_16x16x64_i8(H.a[2 * tt + 1], xb1, acc, 0, 0, 0);
    if ((c16 & 3) == tt) out = acc;
  }
  return out;
}
DI void ph_peer_u_i8(int xi, int nx, int wv, int nwv, const u8_t* __restrict__ XQ, const float* __restrict__ XS, const u8_t* __restrict__ EUq,
                     const unsigned short* __restrict__ EIDX, bf16_t* __restrict__ PP) {
  const int lane = fresh_tid() & 63, c16 = lane & 15, q = lane >> 4;
  const int ntok = (TREAL - wv + nwv - 1) / nwv;
#define PU_TOK(i) (wv + ((i) < ntok ? (i) : ntok - 1) * nwv)
#define PU_LDX(x0_, x1_, xs_, t) { x0_ = *(const i32x4*)(xbase + (size_t)(t) * D); x1_ = *(const i32x4*)(xbase + (size_t)(t) * D + 64); xs_ = XS[(size_t)(t) * 8 + s]; }
#define PU_STORE(t, o0, o1, xs_) { const i32x4 sel = (c16 & 4) ? (o1) : (o0); \
    if (c16 < 8) { u32x2 w_; w_.x = pk2((float)sel.x * (xs_), (float)sel.y * (xs_)); w_.y = pk2((float)sel.z * (xs_), (float)sel.w * (xs_)); \
      __builtin_nontemporal_store(w_, (u32x2*)(pp + (size_t)(t) * 128 + 16 * c16 + 4 * q)); } }
  for (int s = xi; s < 8; s += nx) {
    const u8_t* tab = EUq + (size_t)s * NEXP * 128 + q * 16;
    const u8_t* xbase = XQ + s * 128 + q * 16;
    bf16_t* pp = PP + (size_t)s * TREAL * 128;
    PUI HA, HB, HC;
    PUE Ea, Eb, Ec, Ed;
    int ta = PU_TOK(0), tb = PU_TOK(1), tc = PU_TOK(2);
    pui_idx(Ea, EIDX, ta, c16); pui_idx(Eb, EIDX, tb, c16); pui_idx(Ec, EIDX, tc, c16);
    i32x4 xa0, xa1; float xsa; PU_LDX(xa0, xa1, xsa, ta);
    pui_issue<0>(HA, Ea, tab);
    pui_issue<1>(HB, Ea, tab);
    for (int i = 0; i < ntok; i += 3) {
      const int td = PU_TOK(i + 3), te = PU_TOK(i + 4), tf = PU_TOK(i + 5);
      i32x4 xb0, xb1, xc0, xc1, xd0, xd1; float xsb, xsc, xsd;
      i32x4 o0, o1;
      pui_issue<0>(HC, Eb, tab); PU_LDX(xb0, xb1, xsb, tb); pui_idx(Ed, EIDX, td, c16);
      o0 = pui_compute(HA, xa0, xa1, c16);
      pui_issue<1>(HA, Eb, tab);
      o1 = pui_compute(HB, xa0, xa1, c16);
      PU_STORE(ta, o0, o1, xsa);
      pui_issue<0>(HB, Ec, tab); PU_LDX(xc0, xc1, xsc, tc); pui_idx(Eb, EIDX, te, c16);
      o0 = pui_compute(HC, xb0, xb1, c16);
      pui_issue<1>(HC, Ec, tab);
      o1 = pui_compute(HA, xb0, xb1, c16);
      PU_STORE(tb, o0, o1, xsb);
      pui_issue<0>(HA, Ed, tab); PU_LDX(xd0, xd1, xsd, td); pui_idx(Ec, EIDX, tf, c16);
      o0 = pui_compute(HB, xc0, xc1, c16);
      pui_issue<1>(HB, Ed, tab);
      o1 = pui_compute(HC, xc0, xc1, c16);
      PU_STORE(tc, o0, o1, xsc);
      ta = td; tb = te; tc = tf; xa0 = xd0; xa1 = xd1; xsa = xsd;
    }
  }
#undef PU_TOK
#undef PU_LDX
#undef PU_STORE
}

#define XB_TMO      128
#define XB_XCNT(j)  (256  + 64 * (j))
#define XB_XSUB(j)  (1280 + 64 * (j))
#define XB_XGEN(j)  (2304 + 64 * (j))
#define XB_TOP      3328
#define XB_TOPGEN   3392
#define XCD_BAR_WORDS 3456
#define XB_SPIN_CAP (1u << 20)
#define LAS __attribute__((address_space(3)))
DI unsigned xb_ld(unsigned* p)              { return __hip_atomic_load(p, __ATOMIC_RELAXED, __HIP_MEMORY_SCOPE_AGENT); }
DI unsigned xb_add(unsigned* p, unsigned v) { return __hip_atomic_fetch_add(p, v, __ATOMIC_RELAXED, __HIP_MEMORY_SCOPE_AGENT); }
DI unsigned xb_xcc_id() { return (unsigned)__builtin_amdgcn_s_getreg((3 << 11) | 20) & 0xFu; }
#define XB_SPIN(cond, bar) do { unsigned _sp = 0; while (cond) { __builtin_amdgcn_s_sleep(1); \
    if ((++_sp & 255u) == 0u) { if (xb_ld(&(bar)[XB_TMO])) break; if (_sp > XB_SPIN_CAP) { atomicAdd(&(bar)[XB_TMO], 1u); break; } } } } while (0)
struct XcdBarrier { unsigned* bar; unsigned x; volatile unsigned* st; };
DI XcdBarrier xcd_barrier_post(unsigned* bar, volatile unsigned* st) {
  XcdBarrier b; b.bar = bar; b.x = xb_xcc_id(); b.st = st;
  if (threadIdx.x == 0) (void)xb_add(&bar[XB_XCNT(b.x)], 1u);
  return b;
}
DI void xcd_barrier_complete(unsigned* bar, unsigned x, unsigned& nloc, unsigned& nx) {
  const unsigned G = gridDim.x;
  unsigned sum, cnt, mine, sp = 0u;
  for (;;) {
    sum = 0u; cnt = 0u; mine = 0u;
#pragma unroll
    for (unsigned j = 0; j < 16; ++j) { const unsigned c = xb_ld(&bar[XB_XCNT(j)]); sum += c; cnt += (c > 0u) ? 1u : 0u; mine = (j == x) ? c : mine; }
    if (sum == G) break;
    __builtin_amdgcn_s_sleep(1);
    if ((++sp & 255u) == 0u) { if (xb_ld(&bar[XB_TMO])) break; if (sp > XB_SPIN_CAP) { atomicAdd(&bar[XB_TMO], 1u); break; } }
  }
  nloc = mine > 0u ? mine : 1u; nx = cnt > 0u ? cnt : 1u;
}
DI void xcd_barrier(const XcdBarrier& b) {
  asm volatile("s_waitcnt vmcnt(0)" ::: "memory");
  __syncthreads();
  if (threadIdx.x == 0) {
    unsigned* bar = b.bar;
    __builtin_amdgcn_s_waitcnt(0);
    unsigned nloc = b.st[0], nx = b.st[1];
    if (nloc == 0u) { xcd_barrier_complete(bar, b.x, nloc, nx); b.st[0] = nloc; b.st[1] = nx; }
    const unsigned old = xb_add(&bar[XB_XSUB(b.x)], 1u);
    const unsigned gen = old / nloc;
    if (old + 1u == (gen + 1u) * nloc) {
      __builtin_amdgcn_fence(__ATOMIC_RELEASE, "agent");
      asm volatile("s_waitcnt vmcnt(0)" ::: "memory");
      const unsigned og = xb_add(&bar[XB_TOP], 1u);
      const unsigned tg = og / nx;
      if (og + 1u == (tg + 1u) * nx) xb_add(&bar[XB_TOPGEN], 1u);
      else XB_SPIN(xb_ld(&bar[XB_TOPGEN]) == tg, bar);
      __builtin_amdgcn_fence(__ATOMIC_ACQUIRE, "agent");
      xb_add(&bar[XB_XGEN(b.x)], 1u);
      asm volatile("s_waitcnt vmcnt(0)" ::: "memory");
    } else {
      XB_SPIN(xb_ld(&bar[XB_XGEN(b.x)]) == gen, bar);
      __builtin_amdgcn_fence(__ATOMIC_ACQUIRE, "agent");
      asm volatile("s_waitcnt vmcnt(0)" ::: "memory");
    }
  }
  __syncthreads();
}

struct Params {
  const float *x, *meta, *norm1_g, *w_in, *wg, *bg, *sb_g, *gla_g, *w_out, *norm2_g, *w_pq, *sk1, *sk2, *eu, *ev, *gf;
  float* out; char* ws;
};
constexpr int HALF_SMEM = 73728;
constexpr int SMEM_BYTES = 2 * HALF_SMEM;
constexpr size_t WS_BAR = 0;

__global__ void __launch_bounds__(512, 2) k_fused(Params p) {
  extern __shared__ __attribute__((aligned(16))) char smem_dyn[];
  const int half = __builtin_amdgcn_readfirstlane((int)(threadIdx.x >> 8));
  char* smem = smem_dyn + half * HALF_SMEM;
  __shared__ unsigned xb_words[4];
  if (threadIdx.x < 4) xb_words[threadIdx.x] = 0u;
  __syncthreads();
  const XcdBarrier bar = xcd_barrier_post((unsigned*)(p.ws + WS_BAR), xb_words);
  if (threadIdx.x == 0) xb_words[2] = xb_add((unsigned*)(p.ws + WS_XRANK) + bar.x, 1u);
  const int G = 2 * gridDim.x, bid = 2 * blockIdx.x + half;
  char* ws = p.ws;
  bf16_t* WinT = (bf16_t*)(ws + WS_WIN);
  bf16_t* WoutT = (bf16_t*)(ws + WS_WOUT);
  bf16_t* WpqT = (bf16_t*)(ws + WS_WPQ);
  bf16_t* EU = (bf16_t*)(ws + WS_EU);
  bf16_t* EV = (bf16_t*)(ws + WS_EV);
  bf16_t* SK1b = (bf16_t*)(ws + WS_SK1);
  bf16_t* SK2b = (bf16_t*)(ws + WS_SK2);
  bf16_t* A1 = (bf16_t*)(ws + WS_A1);
  float* GO = (float*)(ws + WS_A1);
  bf16_t* A2 = (bf16_t*)(ws + WS_A1);
  InProjOut O;
  O.QSB = (bf16_t*)(ws + WS_QSB); O.KSB = (bf16_t*)(ws + WS_KSB); O.VTSB = (bf16_t*)(ws + WS_VTSB); O.VSB = (bf16_t*)(ws + WS_VSB);
  O.GQ = (bf16_t*)(ws + WS_GQ); O.GK = (bf16_t*)(ws + WS_GK); O.GV = (bf16_t*)(ws + WS_GVT); O.GR = (bf16_t*)(ws + WS_GR);
  O.GLR = (float*)(ws + WS_GLR);
  bf16_t* H1 = (bf16_t*)(ws + WS_H1);
  float* R2 = (float*)(ws + WS_XS + 3 * MiB);
  bf16_t* GVT = (bf16_t*)(ws + WS_GVT);
  GlaPtrs GP;
  GP.GQ = O.GQ; GP.GK = O.GK; GP.GVT = GVT; GP.GR = O.GR; GP.GLR = O.GLR; GP.wg = p.wg; GP.bg = p.bg; GP.gla_g = p.gla_g;
  GP.SLOC = (float*)(ws + WS_SLOC); GP.DTOT = (float*)(ws + WS_DTOT); GP.MIX = (bf16_t*)(ws + WS_MIX);
  GlaPrepPtrs GPP; GPP.GQ = O.GQ; GPP.GK = O.GK; GPP.GLR = O.GLR; GPP.wg = p.wg; GPP.bg = p.bg;
  GPP.QT = (bf16_t*)(ws + WS_GQT); GPP.KT = (bf16_t*)(ws + WS_GKT); GPP.KTT = (bf16_t*)(ws + WS_GKTT); GPP.DEC = (float*)(ws + WS_GDEC); GPP.BL = (float*)(ws + WS_GBL);
  GlaPtrs3 GP3; GP3.QT = GPP.QT; GP3.KT = GPP.KT; GP3.KTT = GPP.KTT; GP3.GVT = GVT; GP3.GR = O.GR; GP3.DEC = GPP.DEC; GP3.BL = GPP.BL; GP3.gla_g = p.gla_g;
  GP3.SLOC = GP.SLOC; GP3.DTOT = GP.DTOT; GP3.MIX = GP.MIX;
  bf16_t* MIX = (bf16_t*)(ws + WS_MIX);
  bf16_t* QP = (bf16_t*)(ws + WS_MIX);
  unsigned short* EIDX = (unsigned short*)(ws + WS_EIDX);
  bf16_t* PP = (bf16_t*)(ws + WS_PP);
  bf16_t* YT = (bf16_t*)(ws + WS_PP);
  unsigned* STREAM = (unsigned*)(ws + WS_STREAM);
  float* GATE = (float*)(ws + WS_GATE);

  for (int vb = bid; vb < 3328 + 1024 + 1024; vb += G) {
    if (vb < 3328) ph_transpose_w(vb % 104, vb / 104, smem, p.w_in, p.norm1_g, WinT, D, NIN);
    else if (vb < 4352) { const int t = vb - 3328; ph_transpose_w(t % 32, t / 32, smem, p.w_out, nullptr, WoutT, D, D); }
    else { const int t = vb - 4352; ph_transpose_w(t % 32, t / 32, smem, p.w_pq, p.norm2_g, WpqT, D, D); }
  }
  ph_convert_eu_i8(p.eu, (u8_t*)EU, (float*)(ws + WS_SCU));
  for (int vb = bid; vb < NEXP / 32; vb += G) ph_convert_ev8(vb, smem, p.ev, (u8_t*)EV, (float*)(ws + WS_SCV));
  ph_convert(p.sk1, SK1b, (size_t)8 * 128 * 64 / 8);
  ph_convert(p.sk2, SK2b, (size_t)8 * 128 * 64 / 8);
  ph_zero_pads(O.KSB, O.VTSB, O.GQ, O.GK, GVT);
  for (int vb = bid; vb < TREAL / 16; vb += G) ph_norm_rows<0>(vb, p.x, p.meta, A1);
  __syncthreads();
  for (int mb = blockIdx.x; mb < NIN / 16; mb += gridDim.x) ph_meta(mb, smem_dyn, p.meta, p.norm1_g, p.w_in, O);
  xcd_barrier(bar);
  {
    pg8::Gemm g{A1, WinT, TREAL, NINP, D}; pg8::StaticOrder S; S.init(TREAL, NINP, (int)gridDim.x, (int)blockIdx.x);
    EpiInProj E{O, GVT, smem_dyn + 131072};
    pg8::gemm_phase<EpiInProj, pg8::StaticOrder, true, true>((PG8_LAS unsigned char*)smem_dyn, g, S, E);
  }
  xcd_barrier(bar);
  for (int it = blockIdx.x; it < 32 * 129; it += gridDim.x) ph_gla_prep(it, smem_dyn, GPP);
  xcd_barrier(bar);
  for (int it = blockIdx.x; it < 32 * 15; it += gridDim.x) gla_item3<0>(it / 15, it % 15, smem_dyn, GP3);
  for (int vb = bid; vb < 64 * 64; vb += G) ph_sb_attn(vb, O.QSB, O.KSB, O.VTSB, p.sb_g, MIX);
  xcd_barrier(bar);
  for (int it = blockIdx.x; it < 32 * 16; it += gridDim.x) gla_item3<1>(it >> 4, it & 15, smem_dyn, GP3);
  xcd_barrier(bar);
  {
    pg8::Gemm g{MIX, WoutT, TREAL, D, D}; pg8::StaticOrder S; S.init(TREAL, D, (int)gridDim.x, (int)blockIdx.x);
    EpiOut E{p.x, H1};
    pg8::gemm_phase<EpiOut, pg8::StaticOrder, true, true>((PG8_LAS unsigned char*)smem_dyn, g, S, E);
  }
  xcd_barrier(bar);
  for (int vb = bid; vb < TREAL / 16; vb += G) ph_norm2_rows(vb, H1, p.norm2_g, R2, (u8_t*)(ws + WS_XQ), (float*)(ws + WS_XS));
  xcd_barrier(bar);
  {
    pg8::Gemm g{H1, WpqT, TREAL, D, D}; pg8::StaticOrder S; S.init(TREAL, D, (int)gridDim.x, (int)blockIdx.x);
    EpiPQ E{QP, R2};
    pg8::gemm_phase<EpiPQ, pg8::StaticOrder, true, true>((PG8_LAS unsigned char*)smem_dyn, g, S, E);
  }
  xcd_barrier(bar);
  for (int vb = bid; vb < 8 * (TREAL / 128); vb += G) ph_route_v2(vb, smem, QP, SK1b, SK2b, EIDX, GATE);
  xcd_barrier(bar);
  {
    __shared__ int xinfo[4];
    if (threadIdx.x == 0) {
      unsigned* barw = (unsigned*)(p.ws + WS_BAR);
      unsigned cnt = 0, ord = 0, mine = 1;
      for (unsigned j = 0; j < 16; ++j) { const unsigned c = xb_ld(&barw[XB_XCNT(j)]); if (c > 0) { if (j < bar.x) ++ord; ++cnt; } if (j == bar.x) mine = c; }
      xinfo[0] = (int)ord; xinfo[1] = (int)cnt; xinfo[2] = (int)xb_words[2]; xinfo[3] = (int)mine;
    }
    __syncthreads();
    const int xi = xinfo[0], nx = xinfo[1], rank = xinfo[2], nloc = xinfo[3];
    const int wave = __builtin_amdgcn_readfirstlane((int)(threadIdx.x >> 6));
    ph_peer_u_d4(xi, nx, rank * 8 + wave, nloc * 8, (const u8_t*)(ws + WS_XQ), (const float*)(ws + WS_XS), (const u8_t*)EU, EIDX, PP);
  }
  xcd_barrier(bar);
  for (int unit = blockIdx.x; unit < TREAL / 64; unit += gridDim.x) ph_peer_c8(unit, smem_dyn, PP, EIDX, GATE, (const float*)(ws + WS_SCU), (const float*)(ws + WS_SCV), STREAM);
  xcd_barrier(bar);
  ph_peer_v8(smem_dyn, STREAM, (const u8_t*)EV, YT);
  xcd_barrier(bar);
  for (int unit = blockIdx.x; unit < TREAL / 32; unit += gridDim.x) ph_final_lds(unit, smem_dyn, H1, YT, p.gf, p.out);
}

extern "C" void kernel_launch(void* const* d_in, const int* in_sizes, int n_in, void* d_out, int out_size, void* d_ws, size_t ws_size, hipStream_t stream) {
  static int grid = 0;
  if (grid == 0) {
    int dev = 0, cus = 0, per_cu = 0;
    hipGetDevice(&dev);
    hipDeviceGetAttribute(&cus, hipDeviceAttributeMultiprocessorCount, dev);
    hipFuncSetAttribute((const void*)k_fused, hipFuncAttributeMaxDynamicSharedMemorySize, SMEM_BYTES);
    hipOccupancyMaxActiveBlocksPerMultiprocessor(&per_cu, (const void*)k_fused, 512, SMEM_BYTES);
    if (per_cu > 1) per_cu = 1;
    if (per_cu < 1) per_cu = 1;
    grid = cus * per_cu;
  }
  hipMemsetAsync((char*)d_ws + WS_BAR, 0, 32768, stream);
  Params p{};
  p.x = (const float*)d_in[0]; p.meta = (const float*)d_in[1]; p.norm1_g = (const float*)d_in[2]; p.w_in = (const float*)d_in[3];
  p.wg = (const float*)d_in[4]; p.bg = (const float*)d_in[5]; p.sb_g = (const float*)d_in[6]; p.gla_g = (const float*)d_in[7];
  p.w_out = (const float*)d_in[8]; p.norm2_g = (const float*)d_in[9]; p.w_pq = (const float*)d_in[10]; p.sk1 = (const float*)d_in[11];
  p.sk2 = (const float*)d_in[12]; p.eu = (const float*)d_in[13]; p.ev = (const float*)d_in[14]; p.gf = (const float*)d_in[15];
  p.out = (float*)d_out; p.ws = (char*)d_ws;
  void* args[] = {&p};
  hipLaunchCooperativeKernel((const void*)k_fused, dim3(grid), dim3(512), args, SMEM_BYTES, stream);
}
```

```cpp
#include <hip/hip_runtime.h>
#include <stdint.h>
#include <stddef.h>

typedef unsigned short bf16_t;
typedef short bf16x8 __attribute__((ext_vector_type(8)));
typedef float f32x16 __attribute__((ext_vector_type(16)));
typedef float f32x4 __attribute__((ext_vector_type(4)));
typedef float f32x2 __attribute__((ext_vector_type(2)));
typedef unsigned u32x4 __attribute__((ext_vector_type(4)));
typedef unsigned u32x2 __attribute__((ext_vector_type(2)));
typedef __bf16 bf16x2_t __attribute__((ext_vector_type(2)));

#define DI __device__ __forceinline__
__device__ __forceinline__ int fresh_tid() { int t = (int)threadIdx.x; asm volatile("" : "+v"(t)); return t; }
#define TID tid256_
#define MFMA32(a, b, c) __builtin_amdgcn_mfma_f32_32x32x16_bf16((a), (b), (c), 0, 0, 0)

constexpr int D = 1024, NB = 8, SEQ = 8192, NMETA = 16;
constexpr int TREAL = NB * SEQ;
constexpr int MROWS = TREAL + 128;
constexpr int NIN = 3088, NINP = 3328;
constexpr int SBH = 8, SBD = 64;
constexpr int GH = 4, GDK = 64, GDV = 128;
constexpr int KIDX = SEQ + 32;
constexpr int GU = SEQ + 64;
constexpr int NEXP = 16384;
constexpr float EPS = 1e-6f;

constexpr size_t MiB = 1u << 20;
constexpr size_t WS_WIN = 1 * MiB;
constexpr size_t WS_WOUT = 8 * MiB;
constexpr size_t WS_WPQ = 10 * MiB;
constexpr size_t WS_SK1 = 12 * MiB;
constexpr size_t WS_SK2 = 13 * MiB;
constexpr size_t WS_EU = 16 * MiB;
constexpr size_t WS_EV = 48 * MiB;
constexpr size_t WS_A1 = 80 * MiB;
constexpr size_t WS_QSB = 210 * MiB;
constexpr size_t WS_KSB = 274 * MiB;
constexpr size_t WS_VTSB = 339 * MiB;
constexpr size_t WS_GQ = 404 * MiB;
constexpr size_t WS_GK = 437 * MiB;
constexpr size_t WS_H1 = 210 * MiB;
constexpr size_t WS_GV = 470 * MiB;
constexpr size_t WS_GR = 535 * MiB;
constexpr size_t WS_GLR = 599 * MiB;
constexpr size_t WS_LG = 604 * MiB;
constexpr size_t WS_MIX = 669 * MiB;
constexpr size_t WS_EIDX = 797 * MiB;
constexpr size_t WS_GATE = 829 * MiB;
constexpr size_t WS_PP = 470 * MiB;
constexpr size_t WS_STREAM = 726 * MiB;
constexpr size_t WS_XRANK = 16384;
constexpr size_t WS_VSB = 861 * MiB;
constexpr size_t WS_END = 926 * MiB;

DI unsigned f2bf(float f) { unsigned u = __float_as_uint(f); return (u + 0x7fffu + ((u >> 16) & 1u)) >> 16; }
DI float bf2f(unsigned b) { return __uint_as_float(b << 16); }
DI unsigned pk2(float lo, float hi) { f32x2 v = {lo, hi}; return __builtin_bit_cast(unsigned, __builtin_convertvector(v, bf16x2_t)); }
DI float bflo(unsigned u) { return __uint_as_float(u << 16); }
DI float bfhi(unsigned u) { return __uint_as_float(u & 0xffff0000u); }
DI int crow(int reg, int h) { return (reg & 3) + 8 * (reg >> 2) + 4 * h; }
DI float wave_sum(float v) {
#pragma unroll
  for (int o = 32; o >= 1; o >>= 1) v += __shfl_xor(v, o);
  return v;
}
DI float softplus(float z) { return fmaxf(z, 0.f) + __logf(1.f + __expf(-fabsf(z))); }

DI void ph_transpose_w(int bx, int by, char* smem, const float* __restrict__ W, const float* __restrict__ gain, bf16_t* __restrict__ WT, int K, int N) {
  const int tid256_ = fresh_tid() & 255;
  float (*t)[33] = (float (*)[33])smem;
  const int n0 = bx * 32, k0 = by * 32, tx = TID & 31, ty = TID >> 5;
  for (int r = ty; r < 32; r += 8) {
    const int k = k0 + r, n = n0 + tx;
    float v = 0.f;
    if (n < N) { v = W[(size_t)k * N + n]; if (gain) v *= gain[k]; }
    t[r][tx] = v;
  }
  __syncthreads();
  for (int r = ty; r < 32; r += 8) {
    const int n = n0 + r, k = k0 + tx;
    WT[(size_t)n * K + k] = (bf16_t)f2bf(t[tx][r]);
  }
  __syncthreads();
}
DI void ph_convert(const float* __restrict__ src, bf16_t* __restrict__ dst, size_t n8) {
  size_t i = (size_t)blockIdx.x * blockDim.x + threadIdx.x;
  const size_t stride = (size_t)gridDim.x * blockDim.x;
  for (; i < n8; i += stride) {
    const f32x4 a = ((const f32x4*)src)[2 * i], b = ((const f32x4*)src)[2 * i + 1];
    u32x4 o; o.x = pk2(a.x, a.y); o.y = pk2(a.z, a.w); o.z = pk2(b.x, b.y); o.w = pk2(b.z, b.w);
    ((u32x4*)dst)[i] = o;
  }
}
DI void ph_zero_pads(bf16_t* KSB, bf16_t* VTSB, bf16_t* GQ, bf16_t* GK, bf16_t* GVT) {
  const int tid = blockIdx.x * blockDim.x + threadIdx.x, nth = gridDim.x * blockDim.x;
  for (int i = tid; i < 64 * 16 * 64; i += nth) { const int bh = i / 1024, r = i % 1024; KSB[(size_t)bh * KIDX * 64 + r] = 0; }
  for (int i = tid; i < 64 * 64 * 16; i += nth) { const int row = i / 16, c = i % 16; VTSB[(size_t)row * KIDX + c] = 0; }
  for (int i = tid; i < 32 * 48 * 64; i += nth) { const int bh = i / 3072, r = i % 3072; GQ[(size_t)bh * GU * 64 + r] = 0; GK[(size_t)bh * GU * 64 + r] = 0; }
  for (int i = tid; i < 32 * 128 * 48; i += nth) { const int row = i / 48, c = i % 48; GVT[(size_t)row * GU + c] = 0; }
}

template <int MODE>
DI void ph_norm_rows(int vb, const float* __restrict__ src, const float* __restrict__ meta, bf16_t* __restrict__ dst) {
  const int tid256_ = fresh_tid() & 255;
  const int row0 = vb * 16 + (TID >> 6) * 4, lane = TID & 63;
  f32x4 v[4][4];
#pragma unroll
  for (int rr = 0; rr < 4; ++rr)
#pragma unroll
    for (int j = 0; j < 4; ++j) v[rr][j] = *(const f32x4*)(src + (size_t)(row0 + rr) * D + j * 256 + lane * 4);
  f32x4 gg[4];
#pragma unroll
  for (int j = 0; j < 4; ++j) { gg[j] = (f32x4){1.f, 1.f, 1.f, 1.f}; if (MODE == 1) gg[j] = *(const f32x4*)(meta + j * 256 + lane * 4); }
#pragma unroll
  for (int rr = 0; rr < 4; ++rr) {
    float ss = 0.f;
#pragma unroll
    for (int j = 0; j < 4; ++j) ss += v[rr][j].x * v[rr][j].x + v[rr][j].y * v[rr][j].y + v[rr][j].z * v[rr][j].z + v[rr][j].w * v[rr][j].w;
    ss = wave_sum(ss);
    const float r = rsqrtf(ss * (1.0f / D) + EPS);
#pragma unroll
    for (int j = 0; j < 4; ++j) {
      u32x2 o; o.x = pk2(v[rr][j].x * r * gg[j].x, v[rr][j].y * r * gg[j].y); o.y = pk2(v[rr][j].z * r * gg[j].z, v[rr][j].w * r * gg[j].w);
      *(u32x2*)(dst + (size_t)(row0 + rr) * D + j * 256 + lane * 4) = o;
    }
  }
}

namespace pg8 {
#define PG8_LAS __attribute__((address_space(3)))
typedef unsigned short bf16_t;
typedef short bf16x8 __attribute__((ext_vector_type(8)));
typedef float f32x4 __attribute__((ext_vector_type(4)));
typedef unsigned u32x4 __attribute__((ext_vector_type(4)));
constexpr int BM = 256, BK = 64, HALF = 128, HTB = HALF * BK * 2  , STAGE_BYTES = 8 * HTB, NXCD = 8, WGM = 8;

__host__ __device__ __forceinline__ int lds_byte(int r, int c) { const int st = (r >> 4) * 2 + (c >> 5), rr = r & 15, cc = c & 31, ob = rr * 64 + cc * 2; return st * 1024 + (ob ^ (((ob >> 9) & 1) << 5)); }
__host__ __device__ __forceinline__ void stage_rc(int b, int& R, int& C) { const int st = b / 1024, sb = b % 1024, swz = sb ^ (((sb >> 9) & 1) << 5); R = (st >> 1) * 16 + swz / 64; C = (st & 1) * 32 + (swz % 64) / 2; }
__host__ __device__ __forceinline__ int perm32(int rho) { const int n = rho >> 4, i = rho & 15; return 8 * (i >> 2) + 4 * n + (i & 3); }

struct Unit { int pm, pn; };
struct Gemm { const bf16_t* A; const bf16_t* Bt; int M, N, K; };

struct StaticOrder {
    int nM, nN, nwg, G, c;
    __host__ __device__ void init(int M, int N, int G_, int c_) { nM = M / BM; nN = N / BM; nwg = nM * nN; G = G_; c = c_; }
    __host__ __device__ bool next(int i, Unit& u) const {
        const long L = (long)i * G + c; if (L >= nwg) return false;
        int wgid = (int)L; { const int q = nwg / NXCD, r = nwg % NXCD, xcd = wgid % NXCD, off = wgid / NXCD; wgid = (xcd < r ? xcd * (q + 1) : r * (q + 1) + (xcd - r) * q) + off; }
        const int nig = WGM * nN, gid = wgid / nig, fm = gid * WGM, gsz = (nM - fm) < WGM ? (nM - fm) : WGM;
        u.pm = fm + ((wgid % nig) % gsz); u.pn = (wgid % nig) / gsz; return true;
    }
    __device__ __forceinline__ void a_ready(const Unit&) const {}
    __device__ __forceinline__ void done(const Unit&) const {}
};

template <class Epi, class Sched, bool ALIGN_EPI = false, bool SP2 = false>
__device__ __forceinline__ void gemm_phase(PG8_LAS unsigned char* lds, const Gemm g, const Sched& S, const Epi& E) {
    const int tid = fresh_tid(), wid = __builtin_amdgcn_readfirstlane(tid >> 6), lane = tid & 63, wr = wid >> 2, wc = wid & 3, fr = lane & 15, fq = lane >> 4;
    const int K = g.K, nt = K / BK;
    unsigned voffA[2], voffB[2];
#pragma unroll
    for (int i = 0; i < 2; ++i) { int R, C; stage_rc(tid * 16 + i * 8192, R, C); const int Rb = Epi::PERM ? ((R & ~31) + perm32(R & 31)) : R;
        voffA[i] = (unsigned)(R * K + C) * 2u; voffB[i] = (unsigned)(Rb * K + C) * 2u; }
    const size_t kstep = (size_t)(BK * 2);
    const size_t hstep = (size_t)HALF * K * 2;
    const size_t tstep = 2 * hstep;
    const unsigned ldsw = (unsigned)wid * 1024u;
    const int aoff = lds_byte(wr * 64 + fr, fq * 8), boff = lds_byte(wc * 32 + fr, fq * 8);
#define PG8_SA(b, h) (((b) * 2 + (h)) * HTB)
#define PG8_SB(b, h) ((4 + (b) * 2 + (h)) * HTB)
#define PG8_STAGE(bufoff, gbase, voff) do { _Pragma("unroll") for (int _i = 0; _i < 2; ++_i) \
        __builtin_amdgcn_global_load_lds((const unsigned*)((const char*)(gbase) + (voff)[_i]), (PG8_LAS unsigned*)(lds + (bufoff) + ldsw + _i * 8192), 16, 0, 0); } while (0)
#define PG8_LDA(dst, b, h) do { _Pragma("unroll") for (int m = 0; m < 4; ++m) _Pragma("unroll") for (int k = 0; k < 2; ++k) dst[m][k] = *(const PG8_LAS bf16x8*)(lds + PG8_SA(b, h) + aoff + m * 2048 + k * 1024); } while (0)
#define PG8_LDB(dst, b, h) do { _Pragma("unroll") for (int n = 0; n < 2; ++n) _Pragma("unroll") for (int k = 0; k < 2; ++k) dst[n][k] = *(const PG8_LAS bf16x8*)(lds + PG8_SB(b, h) + boff + n * 2048 + k * 1024); } while (0)
#define PG8_MMA(ai, bj, At, Bt) do { __builtin_amdgcn_s_setprio(1); _Pragma("unroll") for (int m = 0; m < 4; ++m) _Pragma("unroll") for (int n = 0; n < 2; ++n) _Pragma("unroll") for (int k = 0; k < 2; ++k) \
        acc[ai][bj][m][n] = __builtin_amdgcn_mfma_f32_16x16x32_bf16(Bt[n][k], At[m][k], acc[ai][bj][m][n], 0, 0, 0); __builtin_amdgcn_s_setprio(0); } while (0)
#define PG8_WAIT_V(n) asm volatile("s_waitcnt vmcnt(" #n ")" ::: "memory")
#define PG8_WAIT_L(n) asm volatile("s_waitcnt lgkmcnt(" #n ")" ::: "memory")
#define PG8_BAR __builtin_amdgcn_s_barrier()
#define PG8_SCHED __builtin_amdgcn_sched_barrier(0)
    Unit cur, nxt; int ui = 0;
    if (!S.next(0, cur)) return;
    f32x4 acc[2][2][4][2];
#pragma unroll
    for (int a = 0; a < 2; ++a)
#pragma unroll
        for (int b = 0; b < 2; ++b)
#pragma unroll
            for (int m = 0; m < 4; ++m)
#pragma unroll
                for (int n = 0; n < 2; ++n) acc[a][b][m][n] = (f32x4){0.f, 0.f, 0.f, 0.f};
    bf16x8 At[4][2], B0[2][2], B1[2][2];
    const char* cA = (const char*)g.A + (size_t)cur.pm * tstep; const char* cB = (const char*)g.Bt + (size_t)cur.pn * tstep;
    S.a_ready(cur);
    if constexpr (SP2) {
        PG8_STAGE(PG8_SB(0, 0), cB, voffB); PG8_STAGE(PG8_SB(0, 1), cB + hstep, voffB); PG8_STAGE(PG8_SA(0, 0), cA, voffA); PG8_STAGE(PG8_SA(0, 1), cA + hstep, voffA);
        if (wr == 1) PG8_BAR;
        PG8_WAIT_V(2); PG8_BAR;
        PG8_STAGE(PG8_SB(1, 0), cB + kstep, voffB); PG8_STAGE(PG8_SA(1, 0), cA + kstep, voffA); PG8_STAGE(PG8_SB(1, 1), cB + hstep + kstep, voffB);
        PG8_WAIT_V(6); PG8_BAR;
    } else {
        PG8_STAGE(PG8_SB(0, 0), cB, voffB); PG8_STAGE(PG8_SA(0, 0), cA, voffA); PG8_STAGE(PG8_SB(0, 1), cB + hstep, voffB); PG8_STAGE(PG8_SA(0, 1), cA + hstep, voffA);
        if (wr == 1) PG8_BAR;
        PG8_WAIT_V(4); PG8_BAR;
        PG8_STAGE(PG8_SB(1, 0), cB + kstep, voffB); PG8_STAGE(PG8_SA(1, 0), cA + kstep, voffA); PG8_STAGE(PG8_SB(1, 1), cB + hstep + kstep, voffB);
        PG8_WAIT_V(6); PG8_BAR;
    }
    for (;;) {
        const bool has_next = S.next(ui + 1, nxt);
        const char* nA = has_next ? (const char*)g.A + (size_t)nxt.pm * tstep : cA; const char* nB = has_next ? (const char*)g.Bt + (size_t)nxt.pn * tstep : cB;
        for (int t = 0; t < nt; t += 2) {
            const bool last = (t == nt - 2);
            const char* a1 = cA + (size_t)(t + 1) * kstep;
            const char* a2 = last ? nA : cA + (size_t)(t + 2) * kstep; const char* b2 = last ? nB : cB + (size_t)(t + 2) * kstep;
            const char* a3 = a2 + kstep; const char* b3 = b2 + kstep;
            if (last && has_next) S.a_ready(nxt);
            if constexpr (SP2) {
            PG8_LDB(B0, 0, 0); PG8_LDB(B1, 0, 1); PG8_SCHED; PG8_LDA(At, 0, 0); PG8_STAGE(PG8_SA(1, 1), a1 + hstep, voffA);
            PG8_WAIT_V(8); PG8_WAIT_L(0); PG8_BAR; PG8_MMA(0, 0, At, B0); PG8_MMA(0, 1, At, B1); PG8_BAR; PG8_SCHED;
            PG8_LDA(At, 0, 1); PG8_STAGE(PG8_SB(0, 0), b2, voffB); PG8_STAGE(PG8_SB(0, 1), b2 + hstep, voffB); PG8_STAGE(PG8_SA(0, 0), a2, voffA);
            PG8_WAIT_V(8); PG8_WAIT_L(0); PG8_BAR; PG8_MMA(1, 0, At, B0); PG8_MMA(1, 1, At, B1); PG8_BAR; PG8_SCHED;
            PG8_LDB(B0, 1, 0); PG8_LDB(B1, 1, 1); PG8_SCHED; PG8_LDA(At, 1, 0); PG8_STAGE(PG8_SA(0, 1), a2 + hstep, voffA);
            PG8_WAIT_V(8); PG8_WAIT_L(0); PG8_BAR; PG8_MMA(0, 0, At, B0); PG8_MMA(0, 1, At, B1); PG8_BAR; PG8_SCHED;
            PG8_LDA(At, 1, 1); PG8_STAGE(PG8_SB(1, 0), b3, voffB); PG8_STAGE(PG8_SB(1, 1), b3 + hstep, voffB); PG8_STAGE(PG8_SA(1, 0), a3, voffA);
            PG8_WAIT_V(8); PG8_WAIT_L(0); PG8_BAR; PG8_MMA(1, 0, At, B0); PG8_MMA(1, 1, At, B1); PG8_BAR; PG8_SCHED;
            } else {
            PG8_LDB(B0, 0, 0); PG8_SCHED; PG8_LDA(At, 0, 0); PG8_STAGE(PG8_SA(1, 1), a1 + hstep, voffA);
            PG8_WAIT_L(8); PG8_BAR; PG8_WAIT_L(0); PG8_MMA(0, 0, At, B0); PG8_BAR; PG8_SCHED;
            PG8_LDB(B1, 0, 1); PG8_STAGE(PG8_SB(0, 0), b2, voffB);
            PG8_BAR; PG8_WAIT_L(0); PG8_MMA(0, 1, At, B1); PG8_BAR;
            PG8_LDA(At, 0, 1); PG8_STAGE(PG8_SA(0, 0), a2, voffA);
            PG8_BAR; PG8_WAIT_L(0); PG8_MMA(1, 0, At, B0); PG8_BAR; PG8_SCHED;
            PG8_STAGE(PG8_SB(0, 1), b2 + hstep, voffB);
            PG8_WAIT_V(6); PG8_BAR; PG8_MMA(1, 1, At, B1); PG8_BAR;
            PG8_LDB(B0, 1, 0); PG8_SCHED; PG8_LDA(At, 1, 0); PG8_STAGE(PG8_SA(0, 1), a2 + hstep, voffA);
            PG8_WAIT_L(8); PG8_BAR; PG8_WAIT_L(0); PG8_MMA(0, 0, At, B0); PG8_BAR; PG8_SCHED;
            PG8_LDB(B1, 1, 1); PG8_STAGE(PG8_SB(1, 0), b3, voffB);
            PG8_BAR; PG8_WAIT_L(0); PG8_MMA(0, 1, At, B1); PG8_BAR;
            PG8_LDA(At, 1, 1); PG8_STAGE(PG8_SA(1, 0), a3, voffA);
            PG8_BAR; PG8_WAIT_L(0); PG8_MMA(1, 0, At, B0); PG8_BAR; PG8_SCHED;
            PG8_STAGE(PG8_SB(1, 1), b3 + hstep, voffB);
            PG8_WAIT_V(6); PG8_BAR; PG8_MMA(1, 1, At, B1); PG8_BAR;
            }
        }
        if constexpr (ALIGN_EPI) { if (wr == 0) PG8_BAR; }
        if constexpr (!Epi::AFTER_DRAIN) { E(acc, cur, wr, wc, fr, fq); S.done(cur); }
        if (!has_next) break;
#pragma unroll
        for (int a = 0; a < 2; ++a)
#pragma unroll
            for (int b = 0; b < 2; ++b)
#pragma unroll
                for (int m = 0; m < 4; ++m)
#pragma unroll
                    for (int n = 0; n < 2; ++n) acc[a][b][m][n] = (f32x4){0.f, 0.f, 0.f, 0.f};
        cur = nxt; cA = nA; cB = nB; ++ui;
        if constexpr (ALIGN_EPI) { if (wr == 1) PG8_BAR; }
    }
    PG8_WAIT_V(0);
    if constexpr (!ALIGN_EPI) { if (wr == 0) PG8_BAR; }
    PG8_BAR;
    if constexpr (Epi::AFTER_DRAIN) { E.fused(acc, cur, wr, wc, fr, fq, lds, wid, lane); S.done(cur); }
#undef PG8_SA
#undef PG8_SB
#undef PG8_STAGE
#undef PG8_LDA
#undef PG8_LDB
#undef PG8_MMA
#undef PG8_WAIT_V
#undef PG8_WAIT_L
#undef PG8_BAR
#undef PG8_SCHED
}
}

struct InProjOut { bf16_t *QSB, *KSB, *VSB, *VTSB, *GQ, *GK, *GV, *GR; float* GLR; };

struct EpiInProj {
  static constexpr bool PERM = true, AFTER_DRAIN = false;
  InProjOut O; bf16_t* GVT; char* stage;
  DI void store_vt(const pg8::f32x4 (&acc)[2][2][4][2], const pg8::Unit& u, int wr, int wc, int fr, int fq) const {
    bf16_t* st = (bf16_t*)(stage + (wr * 4 + wc) * 1280);
    const int lane = fr + 16 * fq;
    const int rc = lane >> 2, r8 = lane & 3;
#pragma unroll
    for (int ai = 0; ai < 2; ++ai)
#pragma unroll
      for (int bj = 0; bj < 2; ++bj)
#pragma unroll
        for (int mp = 0; mp < 2; ++mp)
#pragma unroll
          for (int ch = 0; ch < 2; ++ch) {
            if ((fq >> 1) == ch) {
#pragma unroll
              for (int m2 = 0; m2 < 2; ++m2)
#pragma unroll
                for (int n = 0; n < 2; ++n) {
                  const pg8::f32x4 v = acc[ai][bj][2 * mp + m2][n];
                  const int cl = 8 * (fq & 1) + 4 * n, rl = 16 * m2 + fr;
                  st[(cl + 0) * 40 + rl] = (bf16_t)f2bf(v[0]); st[(cl + 1) * 40 + rl] = (bf16_t)f2bf(v[1]);
                  st[(cl + 2) * 40 + rl] = (bf16_t)f2bf(v[2]); st[(cl + 3) * 40 + rl] = (bf16_t)f2bf(v[3]);
                }
            }
            asm volatile("s_waitcnt lgkmcnt(0)" ::: "memory");
            const u32x4 w = *(const u32x4*)&st[rc * 40 + 8 * r8];
            asm volatile("" ::: "memory");
            const int col = u.pn * 256 + bj * 128 + wc * 32 + 16 * ch + rc;
            const int row = u.pm * 256 + ai * 128 + wr * 64 + 32 * mp + 8 * r8;
            const int b = row >> 13, i = row & 8191;
            bf16_t* dst;
            if (u.pn < 6) { const int c = col - 1024; dst = O.VTSB + ((size_t)(b * SBH + (c >> 6)) * 64 + (c & 63)) * KIDX + 32 + i; }
            else          { const int c = col - 2048; dst = GVT + ((size_t)(b * GH + (c >> 7)) * 128 + (c & 127)) * GU + 64 + i; }
            *(u32x4*)dst = w;
          }
  }
  DI void operator()(const pg8::f32x4 (&acc)[2][2][4][2], const pg8::Unit& u, int wr, int wc, int fr, int fq) const {
    const int pn = u.pn;
    if (pn == 4 || pn == 5 || pn == 8 || pn == 9) { store_vt(acc, u, wr, wc, fr, fq); return; }
#pragma unroll
    for (int ai = 0; ai < 2; ++ai)
#pragma unroll
      for (int m = 0; m < 4; ++m) {
        const int row = u.pm * 256 + ai * 128 + wr * 64 + m * 16 + fr;
        const int b = row >> 13, i = row & 8191;
#pragma unroll
        for (int bj = 0; bj < 2; ++bj) {
          const int col = pn * 256 + bj * 128 + wc * 32 + 8 * fq;
          const pg8::f32x4 v0 = acc[ai][bj][m][0], v1 = acc[ai][bj][m][1];
          if (pn < 12) {
            u32x4 w; w.x = pk2(v0[0], v0[1]); w.y = pk2(v0[2], v0[3]); w.z = pk2(v1[0], v1[1]); w.w = pk2(v1[2], v1[3]);
            bf16_t* dst;
            if (pn < 2)       { const int c = col;        dst = O.QSB + ((size_t)(b * SBH + (c >> 6)) * SEQ + i) * 64 + (c & 63); }
            else if (pn < 4)  { const int c = col - 512;  dst = O.KSB + ((size_t)(b * SBH + (c >> 6)) * KIDX + 32 + i) * 64 + (c & 63); }
            else if (pn == 6) { const int c = col - 1536; dst = O.GQ + ((size_t)(b * GH + (c >> 6)) * GU + 64 + i) * 64 + (c & 63); }
            else if (pn == 7) { const int c = col - 1792; dst = O.GK + ((size_t)(b * GH + (c >> 6)) * GU + 64 + i) * 64 + (c & 63); }
            else              { const int c = col - 2560; dst = O.GR + (size_t)row * 512 + c; }
            *(u32x4*)dst = w;
          } else if (col < NIN) {
            float* dst = O.GLR + ((size_t)b * GU + 64 + i) * 16 + (col - 3072);
            *(f32x4*)dst = (f32x4){v0[0], v0[1], v0[2], v0[3]};
            *(f32x4*)(dst + 4) = (f32x4){v1[0], v1[1], v1[2], v1[3]};
          }
        }
      }
  }
};
struct EpiOut {
  static constexpr bool PERM = true, AFTER_DRAIN = false;
  const float* x; bf16_t* H1;
  DI void operator()(const pg8::f32x4 (&acc)[2][2][4][2], const pg8::Unit& u, int wr, int wc, int fr, int fq) const {
#pragma unroll
    for (int ai = 0; ai < 2; ++ai)
#pragma unroll
      for (int m = 0; m < 4; ++m) {
        const size_t rowoff = (size_t)(u.pm * 256 + ai * 128 + wr * 64 + m * 16 + fr) * D;
#pragma unroll
        for (int bj = 0; bj < 2; ++bj) {
          const size_t idx = rowoff + u.pn * 256 + bj * 128 + wc * 32 + 8 * fq;
          const f32x4 x0 = *(const f32x4*)(x + idx), x1 = *(const f32x4*)(x + idx + 4);
          const pg8::f32x4 v0 = acc[ai][bj][m][0], v1 = acc[ai][bj][m][1];
          u32x4 w; w.x = pk2(x0.x + v0[0], x0.y + v0[1]); w.y = pk2(x0.z + v0[2], x0.w + v0[3]); w.z = pk2(x1.x + v1[0], x1.y + v1[1]); w.w = pk2(x1.z + v1[2], x1.w + v1[3]);
          *(u32x4*)(H1 + idx) = w;
        }
      }
  }
};
struct EpiPQ {
  static constexpr bool PERM = true, AFTER_DRAIN = false;
  bf16_t* QP; const float* R2;
  DI void operator()(const pg8::f32x4 (&acc)[2][2][4][2], const pg8::Unit& u, int wr, int wc, int fr, int fq) const {
#pragma unroll
    for (int ai = 0; ai < 2; ++ai)
#pragma unroll
      for (int m = 0; m < 4; ++m) {
        const int row = u.pm * 256 + ai * 128 + wr * 64 + m * 16 + fr;
        const float r = R2[row];
        const size_t rowoff = (size_t)row * D;
#pragma unroll
        for (int bj = 0; bj < 2; ++bj) {
          const pg8::f32x4 v0 = acc[ai][bj][m][0], v1 = acc[ai][bj][m][1];
          u32x4 w; w.x = pk2(v0[0] * r, v0[1] * r); w.y = pk2(v0[2] * r, v0[3] * r); w.z = pk2(v1[0] * r, v1[1] * r); w.w = pk2(v1[2] * r, v1[3] * r);
          *(u32x4*)(QP + rowoff + u.pn * 256 + bj * 128 + wc * 32 + 8 * fq) = w;
        }
      }
  }
};

DI void ph_meta(int blk, char* smem, const float* __restrict__ meta, const float* __restrict__ g1, const float* __restrict__ w_in, const InProjOut& O) {
  float (*xmT)[16] = (float (*)[16])smem;
  float (*red)[256] = (float (*)[256])(smem + 65536);
  const int tid = fresh_tid(), lane = tid & 63, wave = tid >> 6;
  for (int rr = 0; rr < 2; ++rr) {
    const int mm = wave * 2 + rr;
    float v[16]; float ss = 0.f;
#pragma unroll
    for (int j = 0; j < 16; ++j) { v[j] = meta[(size_t)mm * D + j * 64 + lane]; ss += v[j] * v[j]; }
    ss = wave_sum(ss);
    const float r = rsqrtf(ss * (1.0f / D) + EPS);
#pragma unroll
    for (int j = 0; j < 16; ++j) xmT[j * 64 + lane][mm] = v[j] * r * g1[j * 64 + lane];
  }
  __syncthreads();
  {
    const int c = tid & 15, ks = tid >> 4, n = blk * 16 + c;
    float acc[16];
#pragma unroll
    for (int j = 0; j < 16; ++j) acc[j] = 0.f;
#pragma unroll 8
    for (int kk = 0; kk < 32; ++kk) {
      const int k = ks * 32 + kk;
      const float w = w_in[(size_t)k * NIN + n];
      const f32x4 a = *(const f32x4*)&xmT[k][0], b4 = *(const f32x4*)&xmT[k][4], c4 = *(const f32x4*)&xmT[k][8], d4 = *(const f32x4*)&xmT[k][12];
      acc[0] += a.x * w; acc[1] += a.y * w; acc[2] += a.z * w; acc[3] += a.w * w;
      acc[4] += b4.x * w; acc[5] += b4.y * w; acc[6] += b4.z * w; acc[7] += b4.w * w;
      acc[8] += c4.x * w; acc[9] += c4.y * w; acc[10] += c4.z * w; acc[11] += c4.w * w;
      acc[12] += d4.x * w; acc[13] += d4.y * w; acc[14] += d4.z * w; acc[15] += d4.w * w;
    }
#pragma unroll
    for (int mm = 0; mm < 16; ++mm) red[ks][c * 16 + mm] = acc[mm];
  }
  __syncthreads();
  if (tid < 256) {
    const int c = tid >> 4, mm = tid & 15, n = blk * 16 + c;
    float val = 0.f;
#pragma unroll 8
    for (int ks = 0; ks < 32; ++ks) val += red[ks][tid];
    const bf16_t hv = (bf16_t)f2bf(val);
    for (int bb = 0; bb < NB; ++bb) {
      if (n < 512) {}
      else if (n < 1024) { const int cc = n - 512;  O.KSB[((size_t)(bb * SBH + (cc >> 6)) * KIDX + 16 + mm) * 64 + (cc & 63)] = hv; }
      else if (n < 1536) { const int cc = n - 1024; O.VTSB[((size_t)(bb * SBH + (cc >> 6)) * 64 + (cc & 63)) * KIDX + 16 + mm] = hv; }
      else if (n < 1792) { const int cc = n - 1536; O.GQ[((size_t)(bb * GH + (cc >> 6)) * GU + 48 + mm) * 64 + (cc & 63)] = hv; }
      else if (n < 2048) { const int cc = n - 1792; O.GK[((size_t)(bb * GH + (cc >> 6)) * GU + 48 + mm) * 64 + (cc & 63)] = hv; }
      else if (n < 2560) { const int cc = n - 2048; O.GV[((size_t)(bb * GH + (cc >> 7)) * 128 + (cc & 127)) * GU + 48 + mm] = hv; }
      else if (n < 3072) {}
      else { O.GLR[((size_t)bb * GU + 48 + mm) * 16 + (n - 3072)] = val; }
    }
  }
  __syncthreads();
}


constexpr float SB_THR = -90.f;
DI void ph_sb_attn(int vb, const bf16_t* __restrict__ QSB, const bf16_t* __restrict__ KSB, const bf16_t* __restrict__ VTSB,
                                                 const float* __restrict__ sb_g, bf16_t* __restrict__ MIX) {
  const int tid256_ = fresh_tid() & 255;
  const int lane = TID & 63, wave = TID >> 6, r = lane & 31, h = lane >> 5;
  const int bh = vb >> 6, qb = vb & 63;
  const int b = bh >> 3, hd = bh & 7;
  const int i0 = qb * 128 + wave * 32;
  const bf16_t* Qb = QSB + ((size_t)bh * SEQ + i0) * 64;
  const bf16_t* Kb = KSB + (size_t)bh * KIDX * 64;
  const bf16_t* Vb = VTSB + (size_t)bh * 64 * KIDX;
  bf16x8 qf[4];
#pragma unroll
  for (int ks = 0; ks < 4; ++ks) qf[ks] = *(const bf16x8*)(Qb + r * 64 + ks * 16 + h * 8);
  f32x16 o[2];
#pragma unroll
  for (int e = 0; e < 16; ++e) { o[0][e] = 0.f; o[1][e] = 0.f; }
  float R = 0.f;
  const int qidx = 32 + i0 + r;
  for (int c = (i0 >> 5) + 1; c >= 0; --c) {
    const int k0 = 32 * c;
    bf16x8 kf[4];
#pragma unroll
    for (int ks = 0; ks < 4; ++ks) kf[ks] = *(const bf16x8*)(Kb + (size_t)(k0 + r) * 64 + ks * 16 + h * 8);
    bf16x8 vf[2][2];
#pragma unroll
    for (int mt = 0; mt < 2; ++mt)
#pragma unroll
      for (int s2 = 0; s2 < 2; ++s2) {
        const bf16_t* vp = Vb + (size_t)(mt * 32 + r) * KIDX + k0 + 16 * s2 + 4 * h;
        const u32x2 lo = *(const u32x2*)vp, hi = *(const u32x2*)(vp + 8);
        u32x4 t; t.x = lo.x; t.y = lo.y; t.z = hi.x; t.w = hi.y;
        vf[mt][s2] = __builtin_bit_cast(bf16x8, t);
      }
    f32x16 s;
#pragma unroll
    for (int e = 0; e < 16; ++e) s[e] = 0.f;
#pragma unroll
    for (int ks = 0; ks < 4; ++ks) s = MFMA32(kf[ks], qf[ks], s);
    float l1m[16], lb[16];
    bool valid[16];
#pragma unroll
    for (int e = 0; e < 16; ++e) {
      const int kidx = k0 + crow(e, h);
      valid[e] = (kidx < qidx) && (kidx >= 16);
      const float z = s[e] * 0.125f;
      const float sp = softplus(z);
      l1m[e] = valid[e] ? -sp : 0.f;
      lb[e] = z - sp;
    }
    float sfx[16], G[4], PG[4];
#pragma unroll
    for (int g = 0; g < 4; ++g) {
      sfx[4 * g + 3] = 0.f;
      sfx[4 * g + 2] = l1m[4 * g + 3];
      sfx[4 * g + 1] = sfx[4 * g + 2] + l1m[4 * g + 2];
      sfx[4 * g + 0] = sfx[4 * g + 1] + l1m[4 * g + 1];
      G[g] = sfx[4 * g + 0] + l1m[4 * g + 0];
      PG[g] = __shfl_xor(G[g], 32);
    }
    float HS[4];
    HS[3] = 0.f;
    HS[2] = G[3] + PG[3];
    HS[1] = HS[2] + G[2] + PG[2];
    HS[0] = HS[1] + G[1] + PG[1];
    const float total = HS[0] + G[0] + PG[0];
    float a[16];
#pragma unroll
    for (int e = 0; e < 16; ++e) {
      const int g = e >> 2;
      const float between = sfx[e] + (h == 0 ? PG[g] : 0.f) + HS[g] + R;
      a[e] = valid[e] ? __expf(lb[e] + between) : 0.f;
    }
    R += total;
#pragma unroll
    for (int s2 = 0; s2 < 2; ++s2) {
      u32x4 p;
      p.x = pk2(a[8 * s2 + 0], a[8 * s2 + 1]); p.y = pk2(a[8 * s2 + 2], a[8 * s2 + 3]);
      p.z = pk2(a[8 * s2 + 4], a[8 * s2 + 5]); p.w = pk2(a[8 * s2 + 6], a[8 * s2 + 7]);
      const bf16x8 pf = __builtin_bit_cast(bf16x8, p);
      o[0] = MFMA32(vf[0][s2], pf, o[0]);
      o[1] = MFMA32(vf[1][s2], pf, o[1]);
    }
    if (__all(R < SB_THR)) break;
  }
  float ss = 0.f;
#pragma unroll
  for (int e = 0; e < 16; ++e) ss += o[0][e] * o[0][e] + o[1][e] * o[1][e];
  ss += __shfl_xor(ss, 32);
  const float sc = rsqrtf(ss * (1.0f / 64.0f) + EPS);
  bf16_t* outp = MIX + (size_t)(b * SEQ + i0 + r) * D + hd * 64;
#pragma unroll
  for (int mt = 0; mt < 2; ++mt)
#pragma unroll
    for (int g = 0; g < 4; ++g) {
      const int d = mt * 32 + 8 * g + 4 * h;
      const f32x4 gg = *(const f32x4*)(sb_g + hd * 64 + d);
      u32x2 pk;
      pk.x = pk2(o[mt][4 * g] * sc * gg.x, o[mt][4 * g + 1] * sc * gg.y);
      pk.y = pk2(o[mt][4 * g + 2] * sc * gg.z, o[mt][4 * g + 3] * sc * gg.w);
      *(u32x2*)(outp + d) = pk;
    }
}


constexpr int RT_TOK_PER_BLOCK = 256;


#define MFMA16(a, b, c) __builtin_amdgcn_mfma_f32_16x16x32_bf16((a), (b), (c), 0, 0, 0)
constexpr int GLDS = 72;
struct GlaLds {
  bf16_t Qt[64 * GLDS];
  bf16_t Kt[64 * GLDS];
  bf16_t KT[64 * GLDS];
  bf16_t P[64 * GLDS];
  float dec[64];
  float tot[8][64];
  float ssq[8][64];
};
constexpr size_t WS_SLOC = 926 * MiB;
constexpr size_t WS_DTOT = 942 * MiB;
constexpr size_t WS_GVT = 604 * MiB;

struct GlaPtrs { const bf16_t *GQ, *GK, *GVT, *GR; const float *GLR, *wg, *bg, *gla_g; float *SLOC, *DTOT; bf16_t* MIX; };


constexpr size_t WS_GQT = 80 * MiB;
constexpr size_t WS_GKT = 113 * MiB;
constexpr size_t WS_GKTT = 146 * MiB;
constexpr size_t WS_GDEC = 179 * MiB;
constexpr size_t WS_GBL = 182 * MiB;
struct GlaPrepPtrs { const bf16_t *GQ, *GK; const float *GLR, *wg, *bg; bf16_t *QT, *KT, *KTT; float *DEC, *BL; };
DI void ph_gla_prep(int item, char* smem, const GlaPrepPtrs& G) {
  float (*tot)[64] = (float (*)[64])smem;
  const int tid = fresh_tid(), lane = tid & 63, w = tid >> 6;
  const int bh = item / 129, c = item % 129, b = bh >> 2, hd = bh & 3, u0 = 64 * c;
  float wgr[16];
#pragma unroll
  for (int k = 0; k < 16; ++k) wgr[k] = G.wg[k * 256 + hd * 64 + lane];
  const float bgv = G.bg[hd * 64 + lane];
  float cs[8]; float run = 0.f;
  unsigned short kraw[8], qraw[8];
#pragma unroll
  for (int i = 0; i < 8; ++i) {
    const int u = u0 + 8 * w + i;
    kraw[i] = G.GK[((size_t)bh * GU + u) * 64 + lane];
    qraw[i] = G.GQ[((size_t)bh * GU + u) * 64 + lane];
    float lgv = 0.f;
    if (u >= 48) {
      const f32x4* gp = (const f32x4*)(G.GLR + ((size_t)b * GU + u) * 16);
      const f32x4 g0 = gp[0], g1 = gp[1], g2 = gp[2], g3 = gp[3];
      float a = bgv;
      a += g0.x * wgr[0] + g0.y * wgr[1] + g0.z * wgr[2] + g0.w * wgr[3];
      a += g1.x * wgr[4] + g1.y * wgr[5] + g1.z * wgr[6] + g1.w * wgr[7];
      a += g2.x * wgr[8] + g2.y * wgr[9] + g2.z * wgr[10] + g2.w * wgr[11];
      a += g3.x * wgr[12] + g3.y * wgr[13] + g3.z * wgr[14] + g3.w * wgr[15];
      lgv = -softplus(-a) * (1.0f / 16.0f);
    }
    run += lgv; cs[i] = run;
  }
  tot[w][lane] = run;
  __syncthreads();
  float offset = 0.f, total = 0.f;
#pragma unroll
  for (int s2 = 0; s2 < 8; ++s2) { const float tv = tot[s2][lane]; total += tv; if (s2 < w) offset += tv; }
  const size_t cb = ((size_t)bh * 129 + c) * 4096;
  float kt[8];
#pragma unroll
  for (int i = 0; i < 8; ++i) {
    const float bc = offset + cs[i];
    kt[i] = bf2f(kraw[i]) * __expf(-bc);
    G.QT[cb + (8 * w + i) * 64 + lane] = (bf16_t)f2bf(bf2f(qraw[i]) * __expf(bc) * 0.125f);
    G.KT[cb + (8 * w + i) * 64 + lane] = (bf16_t)f2bf(kt[i]);
  }
  u32x4 kp; kp.x = pk2(kt[0], kt[1]); kp.y = pk2(kt[2], kt[3]); kp.z = pk2(kt[4], kt[5]); kp.w = pk2(kt[6], kt[7]);
  *(u32x4*)(G.KTT + cb + lane * 64 + 8 * w) = kp;
  if (w == 0) { G.DEC[((size_t)bh * 129 + c) * 64 + lane] = __expf(total); G.BL[((size_t)bh * 129 + c) * 64 + lane] = total; }
  __syncthreads();
}

struct GlaBuf { bf16_t Qt[64 * GLDS]; bf16_t Kt[64 * GLDS]; bf16_t KT[64 * GLDS]; };
struct GlaLds3 { GlaBuf B[2]; bf16_t P[64 * GLDS]; float ssq[8][64]; };
struct GlaPtrs3 { const bf16_t *QT, *KT, *KTT, *GVT, *GR; const float *DEC, *BL, *gla_g; float *SLOC, *DTOT; bf16_t* MIX; };

template <int PASS>
DI void gla_item3(int bh, int sc, char* smem, const GlaPtrs3& G) {
  GlaLds3& L = *(GlaLds3*)smem;
  const int tid = fresh_tid(), lane = tid & 63, w = __builtin_amdgcn_readfirstlane(tid >> 6), c16 = lane & 15, q = lane >> 4;
  const int b = bh >> 2, hd = bh & 3;
  const int cbeg = sc == 0 ? 0 : 8 * sc + 1, cend = 8 * sc + 9;
  f32x4 X[4];
#pragma unroll
  for (int i = 0; i < 4; ++i) X[i] = (f32x4){0.f, 0.f, 0.f, 0.f};
  if (PASS == 1) {
#pragma unroll 4
    for (int j = 0; j < sc; ++j) {
      const float* dt = G.DTOT + (size_t)(bh * 16 + j) * 64;
      const float* sl = G.SLOC + ((size_t)(bh * 16 + j) * 8 + w) * 16 * 64 + lane;
#pragma unroll
      for (int i = 0; i < 4; ++i) {
        const f32x4 d4 = *(const f32x4*)(dt + 16 * i + 4 * q);
        X[i][0] = d4.x * X[i][0] + sl[(4 * i + 0) * 64]; X[i][1] = d4.y * X[i][1] + sl[(4 * i + 1) * 64];
        X[i][2] = d4.z * X[i][2] + sl[(4 * i + 2) * 64]; X[i][3] = d4.w * X[i][3] + sl[(4 * i + 3) * 64];
      }
    }
  }
  f32x4 gain = {1.f, 1.f, 1.f, 1.f};
  if (PASS == 1) gain = *(const f32x4*)(G.gla_g + hd * 128 + 16 * w + 4 * q);
  const bf16_t* gvt = G.GVT + ((size_t)bh * 128 + 16 * w + c16) * GU + 8 * q;
  const int srow = tid >> 3, sc8 = tid & 7, soff = srow * GLDS + sc8 * 8;
  const size_t cb0 = (size_t)bh * 129 * 4096 + (size_t)srow * 64 + sc8 * 8;
  u32x4 rq, rk, rkt, rq2, rk2, rkt2; bf16x8 vfr[2], vfn[2], vfn2[2]; f32x4 dec[4], decn[4], decn2[4];
  {
    const size_t cb = cb0 + (size_t)cbeg * 4096;
    rkt = *(const u32x4*)(G.KTT + cb);
    if (PASS == 1) { rq = *(const u32x4*)(G.QT + cb); rk = *(const u32x4*)(G.KT + cb); }
    vfr[0] = *(const bf16x8*)(gvt + 64 * cbeg); vfr[1] = *(const bf16x8*)(gvt + 64 * cbeg + 32);
#pragma unroll
    for (int i = 0; i < 4; ++i) dec[i] = *(const f32x4*)(G.DEC + ((size_t)bh * 129 + cbeg) * 64 + 16 * i + 4 * q);
    *(u32x4*)&L.B[0].KT[soff] = rkt;
    if (PASS == 1) { *(u32x4*)&L.B[0].Qt[soff] = rq; *(u32x4*)&L.B[0].Kt[soff] = rk; }
    const size_t cb1 = cb0 + (size_t)(cbeg + 1) * 4096;
    rkt = *(const u32x4*)(G.KTT + cb1);
    if (PASS == 1) { rq = *(const u32x4*)(G.QT + cb1); rk = *(const u32x4*)(G.KT + cb1); }
    vfn[0] = *(const bf16x8*)(gvt + 64 * (cbeg + 1)); vfn[1] = *(const bf16x8*)(gvt + 64 * (cbeg + 1) + 32);
#pragma unroll
    for (int i = 0; i < 4; ++i) decn[i] = *(const f32x4*)(G.DEC + ((size_t)bh * 129 + cbeg + 1) * 64 + 16 * i + 4 * q);
  }
  __syncthreads();
  for (int c = cbeg; c < cend; ++c) {
    const int cur = (c - cbeg) & 1;
    const GlaBuf& Bc = L.B[cur];
    const bool more = c + 1 < cend, more2 = c + 2 < cend;
    if (more2) {
      const size_t cb = cb0 + (size_t)(c + 2) * 4096;
      rkt2 = *(const u32x4*)(G.KTT + cb);
      if (PASS == 1) { rq2 = *(const u32x4*)(G.QT + cb); rk2 = *(const u32x4*)(G.KT + cb); }
      vfn2[0] = *(const bf16x8*)(gvt + 64 * (c + 2)); vfn2[1] = *(const bf16x8*)(gvt + 64 * (c + 2) + 32);
#pragma unroll
      for (int i = 0; i < 4; ++i) decn2[i] = *(const f32x4*)(G.DEC + ((size_t)bh * 129 + c + 2) * 64 + 16 * i + 4 * q);
    }
    u32x2 grv[4];
    if (PASS == 1 && c >= 1) {
#pragma unroll
      for (int n = 0; n < 4; ++n) grv[n] = *(const u32x2*)(G.GR + ((size_t)b * SEQ + 64 * (c - 1) + 16 * n + c16) * 512 + hd * 128 + 16 * w + 4 * q);
    }
    f32x4 OT[4];
    if (PASS == 1) {
      const int is = w >> 1;
#pragma unroll
      for (int z = 0; z < 2; ++z) {
        const int it = 2 * (w & 1) + z;
        f32x4 pa = {0.f, 0.f, 0.f, 0.f};
        if (is <= it) {
#pragma unroll
          for (int kk = 0; kk < 2; ++kk) {
            const bf16x8 ka = *(const bf16x8*)&Bc.Kt[(16 * is + c16) * GLDS + 32 * kk + 8 * q];
            const bf16x8 qb = *(const bf16x8*)&Bc.Qt[(16 * it + c16) * GLDS + 32 * kk + 8 * q];
            pa = MFMA16(ka, qb, pa);
          }
          if (is == it) {
#pragma unroll
            for (int r = 0; r < 4; ++r) if (4 * q + r > c16) pa[r] = 0.f;
          }
        }
        u32x2 pw; pw.x = pk2(pa[0], pa[1]); pw.y = pk2(pa[2], pa[3]);
        *(u32x2*)&L.P[(16 * it + c16) * GLDS + 16 * is + 4 * q] = pw;
      }
#pragma unroll
      for (int n = 0; n < 4; ++n) OT[n] = (f32x4){0.f, 0.f, 0.f, 0.f};
#pragma unroll
      for (int kk = 0; kk < 2; ++kk) {
        u32x4 xp; xp.x = pk2(X[2 * kk][0], X[2 * kk][1]); xp.y = pk2(X[2 * kk][2], X[2 * kk][3]);
        xp.z = pk2(X[2 * kk + 1][0], X[2 * kk + 1][1]); xp.w = pk2(X[2 * kk + 1][2], X[2 * kk + 1][3]);
        const bf16x8 xa = __builtin_bit_cast(bf16x8, xp);
#pragma unroll
        for (int n = 0; n < 4; ++n) {
          const u32x2 lo = *(const u32x2*)&Bc.Qt[(16 * n + c16) * GLDS + 32 * kk + 4 * q];
          const u32x2 hi = *(const u32x2*)&Bc.Qt[(16 * n + c16) * GLDS + 32 * kk + 16 + 4 * q];
          u32x4 qq; qq.x = lo.x; qq.y = lo.y; qq.z = hi.x; qq.w = hi.y;
          OT[n] = MFMA16(xa, __builtin_bit_cast(bf16x8, qq), OT[n]);
        }
      }
      __syncthreads();
#pragma unroll
      for (int kk = 0; kk < 2; ++kk)
#pragma unroll
        for (int n = 0; n < 4; ++n) {
          const bf16x8 pb = *(const bf16x8*)&L.P[(16 * n + c16) * GLDS + 32 * kk + 8 * q];
          OT[n] = MFMA16(vfr[kk], pb, OT[n]);
        }
    }
#pragma unroll
    for (int i = 0; i < 4; ++i) {
#pragma unroll
      for (int kk = 0; kk < 2; ++kk) {
        const bf16x8 ka = *(const bf16x8*)&Bc.KT[(16 * i + c16) * GLDS + 32 * kk + 8 * q];
        X[i] = MFMA16(ka, vfr[kk], X[i]);
      }
      X[i][0] *= dec[i].x; X[i][1] *= dec[i].y; X[i][2] *= dec[i].z; X[i][3] *= dec[i].w;
    }
    if (PASS == 1 && c >= 1) {
      float ss[4];
#pragma unroll
      for (int n = 0; n < 4; ++n) {
        float v = OT[n][0] * OT[n][0] + OT[n][1] * OT[n][1] + OT[n][2] * OT[n][2] + OT[n][3] * OT[n][3];
        v += __shfl_xor(v, 16); v += __shfl_xor(v, 32);
        ss[n] = v;
      }
      if (q == 0) {
#pragma unroll
        for (int n = 0; n < 4; ++n) L.ssq[w][16 * n + c16] = ss[n];
      }
      __syncthreads();
#pragma unroll
      for (int n = 0; n < 4; ++n) {
        float tot = 0.f;
#pragma unroll
        for (int w2 = 0; w2 < 8; ++w2) tot += L.ssq[w2][16 * n + c16];
        const float scl = rsqrtf(tot * (1.0f / 128.0f) + EPS);
        const size_t m = (size_t)b * SEQ + 64 * (c - 1) + 16 * n + c16;
        const float r0 = bflo(grv[n].x), r1 = bfhi(grv[n].x), r2 = bflo(grv[n].y), r3 = bfhi(grv[n].y);
        const float o0 = OT[n][0] * scl * gain.x * (r0 / (1.f + __expf(-r0)));
        const float o1 = OT[n][1] * scl * gain.y * (r1 / (1.f + __expf(-r1)));
        const float o2 = OT[n][2] * scl * gain.z * (r2 / (1.f + __expf(-r2)));
        const float o3 = OT[n][3] * scl * gain.w * (r3 / (1.f + __expf(-r3)));
        u32x2 ow; ow.x = pk2(o0, o1); ow.y = pk2(o2, o3);
        *(u32x2*)(G.MIX + m * D + 512 + hd * 128 + 16 * w + 4 * q) = ow;
      }
    }
    if (more) {
      GlaBuf& Bn = L.B[cur ^ 1];
      *(u32x4*)&Bn.KT[soff] = rkt;
      if (PASS == 1) { *(u32x4*)&Bn.Qt[soff] = rq; *(u32x4*)&Bn.Kt[soff] = rk; }
      vfr[0] = vfn[0]; vfr[1] = vfn[1];
#pragma unroll
      for (int i = 0; i < 4; ++i) dec[i] = decn[i];
      rkt = rkt2; rq = rq2; rk = rk2; vfn[0] = vfn2[0]; vfn[1] = vfn2[1];
#pragma unroll
      for (int i = 0; i < 4; ++i) decn[i] = decn2[i];
    }
    __syncthreads();
  }
  if (PASS == 0) {
    float* sl = G.SLOC + ((size_t)(bh * 16 + sc) * 8 + w) * 16 * 64 + lane;
#pragma unroll
    for (int i = 0; i < 4; ++i)
#pragma unroll
      for (int r = 0; r < 4; ++r) sl[(4 * i + r) * 64] = X[i][r];
    if (w == 0) {
      float bl = 0.f;
      for (int c = cbeg; c < cend; ++c) bl += G.BL[((size_t)bh * 129 + c) * 64 + lane];
      G.DTOT[(size_t)(bh * 16 + sc) * 64 + lane] = __expf(bl);
    }
  }
}


DI void ce_desc(float& a, float& b) {
  const float hi = __builtin_fmaxf(a, b), lo = __builtin_fminf(a, b);
  a = hi; b = lo;
}
DI float vmaxf(float a, float b) { return __builtin_fmaxf(a, b); }
template <int N> DI void bitonic_sort_desc(float (&v)[N]) {
#pragma unroll
  for (int k = 2; k <= N; k <<= 1) {
#pragma unroll
    for (int j = k >> 1; j > 0; j >>= 1) {
#pragma unroll
      for (int i = 0; i < N; ++i) {
        const int l = i ^ j;
        if (l > i) { if ((i & k) == 0) ce_desc(v[i], v[l]); else ce_desc(v[l], v[i]); }
      }
    }
  }
}
DI void bitonic_merge16_desc(float (&v)[16]) {
#pragma unroll
  for (int j = 8; j > 0; j >>= 1) {
#pragma unroll
    for (int i = 0; i < 16; ++i) { const int l = i ^ j; if (l > i) ce_desc(v[i], v[l]); }
  }
}
template <int NBV> DI void merge_prune16(float (&a)[16], const float (&b)[16]) {
#pragma unroll
  for (int i = 16 - NBV; i < 16; ++i) a[i] = vmaxf(a[i], b[15 - i]);
  bitonic_merge16_desc(a);
}
DI float selh(int hh, float a, float b) { asm volatile("" : "+v"(a), "+v"(b)); return hh == 0 ? a : b; }
DI float pack_idx(float v, unsigned idx, unsigned mask) { return __uint_as_float((__float_as_uint(v) & ~mask) | idx); }

DI void ph_route_v2(int vb, char* smem, const bf16_t* __restrict__ QP, const bf16_t* __restrict__ SK1b, const bf16_t* __restrict__ SK2b,
                    unsigned short* __restrict__ EIDX, float* __restrict__ GATE) {
  const int tid256_ = fresh_tid() & 255;
  const int lane = TID & 63, wave = TID >> 6, r = lane & 31, hh = lane >> 5;
  const int hd = vb & 7, tile = vb >> 3;
  const int m = tile * 128 + wave * 32 + r;
  float loc[2][16];
#pragma unroll
  for (int L = 0; L < 2; ++L) {
    const bf16_t* qp = QP + (size_t)m * D + hd * 128 + L * 64 + hh * 8;
    const bf16_t* kb = (L == 0 ? SK1b : SK2b) + (size_t)(hd * 128 + r) * 64 + hh * 8;
    bf16x8 qf[4];
#pragma unroll
    for (int ks = 0; ks < 4; ++ks) qf[ks] = *(const bf16x8*)(qp + ks * 16);
    float grp[4][16];
#pragma unroll
    for (int mt = 0; mt < 4; ++mt) {
      f32x16 acc;
#pragma unroll
      for (int e = 0; e < 16; ++e) acc[e] = 0.f;
#pragma unroll
      for (int ks = 0; ks < 4; ++ks) {
        const bf16x8 kf = *(const bf16x8*)(kb + (size_t)mt * 32 * 64 + ks * 16);
        acc = MFMA32(kf, qf[ks], acc);
      }
#pragma unroll
      for (int e = 0; e < 16; ++e) grp[mt][e] = pack_idx(acc[e], (unsigned)(mt * 32 + crow(e, hh)), 127u);
      bitonic_sort_desc<16>(grp[mt]);
    }
    merge_prune16<16>(grp[0], grp[1]);
    merge_prune16<16>(grp[2], grp[3]);
    merge_prune16<16>(grp[0], grp[2]);
#pragma unroll
    for (int i = 0; i < 16; ++i) loc[L][i] = grp[0][i];
  }
  float fin[16], oth[16];
#pragma unroll
  for (int i = 0; i < 16; ++i) {
    const float send = selh(hh, loc[1][i], loc[0][i]);
    oth[i] = __shfl_xor(send, 32);
    fin[i] = selh(hh, loc[0][i], loc[1][i]);
  }
  merge_prune16<16>(fin, oth);
  float v1[16], v2[16];
#pragma unroll
  for (int i = 0; i < 16; ++i) {
    const float o = __shfl_xor(fin[i], 32);
    v1[i] = selh(hh, fin[i], o);
    v2[i] = selh(hh, o, fin[i]);
  }
  unsigned* ib = (unsigned*)smem + (size_t)TID * 8;
#pragma unroll
  for (int q = 0; q < 4; ++q) {
    unsigned w1 = 0, w2 = 0;
#pragma unroll
    for (int j = 0; j < 4; ++j) {
      w1 |= (__float_as_uint(v1[4 * q + j]) & 127u) << (8 * j);
      w2 |= (__float_as_uint(v2[4 * q + j]) & 127u) << (8 * j);
    }
    ib[q] = w1; ib[4 + q] = w2;
  }
  float R[16], Bv[16];
#pragma unroll
  for (int j = 0; j < 16; ++j) R[j] = pack_idx(v1[0] + v2[j], (unsigned)j, 255u);
#define ROUTE_ROW(I, CNT) { _Pragma("unroll") for (int j = 0; j < 16; ++j) Bv[j] = (j < CNT) ? pack_idx(v1[I] + v2[j < CNT ? j : 0], (unsigned)(I * 16 + j), 255u) : 0.f; \
    merge_prune16<CNT>(R, Bv); }
  ROUTE_ROW(1, 8) ROUTE_ROW(2, 5) ROUTE_ROW(3, 4) ROUTE_ROW(4, 3) ROUTE_ROW(5, 2) ROUTE_ROW(6, 2) ROUTE_ROW(7, 2)
#undef ROUTE_ROW
#pragma unroll
  for (int j = 0; j < 16; ++j) Bv[j] = (j < 8) ? pack_idx(v1[8 + (j < 8 ? j : 0)] + v2[0], (unsigned)((8 + j) * 16), 255u) : 0.f;
  merge_prune16<8>(R, Bv);
  float ex[16], sum = 0.f;
#pragma unroll
  for (int i = 0; i < 16; ++i) { ex[i] = __expf(R[i] - R[0]); sum += ex[i]; }
  const float inv = 1.f / sum;
  const unsigned char* ibb = (const unsigned char*)ib;
  int eo[8]; float go[8];
#pragma unroll
  for (int w = 0; w < 8; ++w) {
    const float rv = selh(hh, R[w], R[8 + w]);
    const float ev = selh(hh, ex[w], ex[8 + w]);
    const unsigned pos = __float_as_uint(rv) & 255u;
    const unsigned i1 = ibb[pos >> 4], i2 = ibb[16 + (pos & 15u)];
    eo[w] = (int)(i1 * 128u + i2);
    go[w] = ev * inv;
  }
  unsigned short* ep = EIDX + (size_t)m * 128 + hd * 16 + hh * 8;
  float* gp = GATE + (size_t)m * 128 + hd * 16 + hh * 8;
  *(u32x4*)ep = (u32x4){(unsigned)eo[0] | ((unsigned)eo[1] << 16), (unsigned)eo[2] | ((unsigned)eo[3] << 16), (unsigned)eo[4] | ((unsigned)eo[5] << 16), (unsigned)eo[6] | ((unsigned)eo[7] << 16)};
  *(f32x4*)gp = (f32x4){go[0], go[1], go[2], go[3]};
  *(f32x4*)(gp + 4) = (f32x4){go[4], go[5], go[6], go[7]};
}


typedef unsigned char u8_t;
constexpr size_t WS_SCU = 14 * MiB;
constexpr size_t WS_SCV = 14 * MiB + 65536;
DI float wave_max(float v) {
#pragma unroll
  for (int o = 32; o >= 1; o >>= 1) v = fmaxf(v, __shfl_xor(v, o));
  return v;
}
DI u32x4 quant_row16(const float* __restrict__ rowp, int lane, float& sc) {
  const f32x4* rp = (const f32x4*)(rowp + lane * 16);
  const f32x4 a = rp[0], b = rp[1], c = rp[2], d = rp[3];
  float m = fmaxf(fmaxf(fmaxf(fabsf(a.x), fabsf(a.y)), fmaxf(fabsf(a.z), fabsf(a.w))), fmaxf(fmaxf(fabsf(b.x), fabsf(b.y)), fmaxf(fabsf(b.z), fabsf(b.w))));
  m = fmaxf(m, fmaxf(fmaxf(fmaxf(fabsf(c.x), fabsf(c.y)), fmaxf(fabsf(c.z), fabsf(c.w))), fmaxf(fmaxf(fabsf(d.x), fabsf(d.y)), fmaxf(fabsf(d.z), fabsf(d.w)))));
  m = wave_max(m);
  sc = m > 0.f ? m * (1.0f / 448.0f) : 1.0f;
  const float inv = 1.0f / sc;
  u32x4 o; unsigned w;
  w = 0; w = __builtin_amdgcn_cvt_pk_fp8_f32(a.x * inv, a.y * inv, w, false); w = __builtin_amdgcn_cvt_pk_fp8_f32(a.z * inv, a.w * inv, w, true); o.x = w;
  w = 0; w = __builtin_amdgcn_cvt_pk_fp8_f32(b.x * inv, b.y * inv, w, false); w = __builtin_amdgcn_cvt_pk_fp8_f32(b.z * inv, b.w * inv, w, true); o.y = w;
  w = 0; w = __builtin_amdgcn_cvt_pk_fp8_f32(c.x * inv, c.y * inv, w, false); w = __builtin_amdgcn_cvt_pk_fp8_f32(c.z * inv, c.w * inv, w, true); o.z = w;
  w = 0; w = __builtin_amdgcn_cvt_pk_fp8_f32(d.x * inv, d.y * inv, w, false); w = __builtin_amdgcn_cvt_pk_fp8_f32(d.z * inv, d.w * inv, w, true); o.w = w;
  return o;
}
DI void ph_convert_ev8(int vb, char* smem, const float* __restrict__ src, u8_t* __restrict__ EV8c, float* __restrict__ scaleV) {
  const int tid256_ = fresh_tid() & 255;
  u8_t (*t)[1040] = (u8_t (*)[1040])smem;
  const int lane = TID & 63, wave = TID >> 6, e0 = vb * 32;
  for (int rr = 0; rr < 8; ++rr) {
    const int r = wave * 8 + rr;
    float sc;
    const u32x4 o = quant_row16(src + (size_t)(e0 + r) * D, lane, sc);
    *(u32x4*)&t[r][lane * 16] = o;
    if (lane == 0) scaleV[e0 + r] = sc;
  }
  __syncthreads();
  const int r = TID & 31, cs = TID >> 5;
  for (int c0 = 0; c0 < 128; c0 += 8) {
    const int cg = c0 + cs;
    const u32x2 v = *(const u32x2*)&t[r][cg * 8];
    *(u32x2*)(EV8c + ((size_t)cg * NEXP + e0 + r) * 8) = v;
  }
  __syncthreads();
}
struct PeerUHalf { u32x4 u[8]; };
DI void ph_peer_c8(int unit, char* smem, const bf16_t* __restrict__ PP, const unsigned short* __restrict__ EIDX, const float* __restrict__ GATE,
                   const float* __restrict__ scaleU, const float* __restrict__ scaleV, unsigned* __restrict__ STREAM) {
  unsigned (*tile)[132] = (unsigned (*)[132])smem;
  const int tid = fresh_tid();
  const int tl = tid >> 3, kc = tid & 7;
  const size_t rowoff = ((size_t)unit * 64 + tl) * 128 + kc * 16;
  const size_t n = (size_t)TREAL * 128;
  float a[16];
#pragma unroll
  for (int j = 0; j < 16; ++j) a[j] = 0.f;
#pragma unroll
  for (int s = 0; s < 8; ++s) {
    const u32x4 p0 = *(const u32x4*)(PP + (size_t)s * n + rowoff), p1 = *(const u32x4*)(PP + (size_t)s * n + rowoff + 8);
    a[0] += bflo(p0.x); a[1] += bfhi(p0.x); a[2] += bflo(p0.y); a[3] += bfhi(p0.y); a[4] += bflo(p0.z); a[5] += bfhi(p0.z); a[6] += bflo(p0.w); a[7] += bfhi(p0.w);
    a[8] += bflo(p1.x); a[9] += bfhi(p1.x); a[10] += bflo(p1.y); a[11] += bfhi(p1.y); a[12] += bflo(p1.z); a[13] += bfhi(p1.z); a[14] += bflo(p1.w); a[15] += bfhi(p1.w);
  }
  const u32x4 e0 = *(const u32x4*)(EIDX + rowoff), e1 = *(const u32x4*)(EIDX + rowoff + 8);
  unsigned ev[16] = {e0.x & 0xffffu, e0.x >> 16, e0.y & 0xffffu, e0.y >> 16, e0.z & 0xffffu, e0.z >> 16, e0.w & 0xffffu, e0.w >> 16,
                     e1.x & 0xffffu, e1.x >> 16, e1.y & 0xffffu, e1.y >> 16, e1.z & 0xffffu, e1.z >> 16, e1.w & 0xffffu, e1.w >> 16};
  float gt[16];
#pragma unroll
  for (int j = 0; j < 4; ++j) { const f32x4 g4 = *(const f32x4*)(GATE + rowoff + 4 * j); gt[4 * j] = g4.x; gt[4 * j + 1] = g4.y; gt[4 * j + 2] = g4.z; gt[4 * j + 3] = g4.w; }
#pragma unroll
  for (int j = 0; j < 16; ++j) {
    const unsigned e = ev[j];
    const float av = a[j] * scaleU[e];
    const float act = 0.5f * av * (1.f + erff(av * 0.70710678118654752f));
    const float c = gt[j] * act * scaleV[e];
    tile[tl][kc * 16 + j] = e | (f2bf(c) << 16);
  }
  __syncthreads();
  unsigned* outp = STREAM + (size_t)unit * 8192;
#pragma unroll 4
  for (int j = 0; j < 16; ++j) {
    const int o = tid + 512 * j, q = o >> 8, t2 = (o >> 2) & 63, z = o & 3;
    outp[o] = tile[t2][4 * q + z];
  }
  __syncthreads();
}
struct PVW { u32x4 a, b; };
struct PVT { u32x2 v[8]; };
DI void pv_loadw(PVW& W, const unsigned* __restrict__ STREAM, int it, int g, int lane) {
  const u32x4* sp = (const u32x4*)(STREAM + (size_t)it * 8192) + lane;
  W.a = sp[(2 * g) * 64]; W.b = sp[(2 * g + 1) * 64];
}
DI void pv_readt(PVT& T, const PVW& W, const u32x2* tabl) {
  T.v[0] = tabl[W.a.x & 0xffffu]; T.v[1] = tabl[W.a.y & 0xffffu]; T.v[2] = tabl[W.a.z & 0xffffu]; T.v[3] = tabl[W.a.w & 0xffffu];
  T.v[4] = tabl[W.b.x & 0xffffu]; T.v[5] = tabl[W.b.y & 0xffffu]; T.v[6] = tabl[W.b.z & 0xffffu]; T.v[7] = tabl[W.b.w & 0xffffu];
}
DI void pv_fma1(unsigned w, const u32x2 v, f32x2 (&y)[4]) {
  const float c = bfhi(w);
  const f32x2 cc = {c, c};
  y[0] = __builtin_elementwise_fma(__builtin_amdgcn_cvt_pk_f32_fp8(v.x, false), cc, y[0]);
  y[1] = __builtin_elementwise_fma(__builtin_amdgcn_cvt_pk_f32_fp8(v.x, true), cc, y[1]);
  y[2] = __builtin_elementwise_fma(__builtin_amdgcn_cvt_pk_f32_fp8(v.y, false), cc, y[2]);
  y[3] = __builtin_elementwise_fma(__builtin_amdgcn_cvt_pk_f32_fp8(v.y, true), cc, y[3]);
}
DI void pv_fma(const PVW& W, const PVT& T, f32x2 (&y)[4]) {
  pv_fma1(W.a.x, T.v[0], y); pv_fma1(W.a.y, T.v[1], y); pv_fma1(W.a.z, T.v[2], y); pv_fma1(W.a.w, T.v[3], y);
  pv_fma1(W.b.x, T.v[4], y); pv_fma1(W.b.y, T.v[5], y); pv_fma1(W.b.z, T.v[6], y); pv_fma1(W.b.w, T.v[7], y);
}
DI void ph_peer_v8(char* smem, const unsigned* __restrict__ STREAM, const u8_t* __restrict__ EV8c, bf16_t* __restrict__ YT) {
  const int tid = fresh_tid(), lane = tid & 63, wave = tid >> 6;
  const u32x2* tabl = (const u32x2*)smem;
  for (int unit = blockIdx.x; unit < 256; unit += gridDim.x) {
    const int cg = unit & 127, th = unit >> 7;
    const u32x4* src = (const u32x4*)(EV8c + (size_t)cg * NEXP * 8);
#pragma unroll 4
    for (int i = tid; i < NEXP * 8 / 16; i += 512) ((u32x4*)smem)[i] = src[i];
    __syncthreads();
    const int it_end = th * 512 + 512;
    int it = th * 512 + wave;
    PVW W0, W1, W2, W3; PVT T0, T1;
    pv_loadw(W0, STREAM, it, 0, lane); pv_loadw(W1, STREAM, it, 1, lane);
    pv_readt(T0, W0, tabl);
    for (; it < it_end; it += 8) {
      const int itn = (it + 8 < it_end) ? it + 8 : it;
      f32x2 y[4];
#pragma unroll
      for (int z = 0; z < 4; ++z) y[z] = (f32x2){0.f, 0.f};
#define PV_STEP(g, Wld, Wrd, Trd, Wc, Tc) \
      pv_loadw(Wld, STREAM, ((g) + 2 < 16) ? it : itn, ((g) + 2) & 15, lane); \
      pv_readt(Trd, Wrd, tabl); \
      pv_fma(Wc, Tc, y); \
      asm volatile("" ::: "memory");
      PV_STEP(0, W2, W1, T1, W0, T0)  PV_STEP(1, W3, W2, T0, W1, T1)  PV_STEP(2, W0, W3, T1, W2, T0)  PV_STEP(3, W1, W0, T0, W3, T1)
      PV_STEP(4, W2, W1, T1, W0, T0)  PV_STEP(5, W3, W2, T0, W1, T1)  PV_STEP(6, W0, W3, T1, W2, T0)  PV_STEP(7, W1, W0, T0, W3, T1)
      PV_STEP(8, W2, W1, T1, W0, T0)  PV_STEP(9, W3, W2, T0, W1, T1)  PV_STEP(10, W0, W3, T1, W2, T0) PV_STEP(11, W1, W0, T0, W3, T1)
      PV_STEP(12, W2, W1, T1, W0, T0) PV_STEP(13, W3, W2, T0, W1, T1) PV_STEP(14, W0, W3, T1, W2, T0) PV_STEP(15, W1, W0, T0, W3, T1)
#undef PV_STEP
      const int t = it * 64 + lane;
      u32x4 yw; yw.x = pk2(y[0].x, y[0].y); yw.y = pk2(y[1].x, y[1].y); yw.z = pk2(y[2].x, y[2].y); yw.w = pk2(y[3].x, y[3].y);
      *(u32x4*)(YT + ((size_t)cg * TREAL + t) * 8) = yw;
    }
    __syncthreads();
  }
}


DI void ph_final_lds(int unit, char* smem, const bf16_t* __restrict__ H1, const bf16_t* __restrict__ YT, const float* __restrict__ gf, float* __restrict__ out) {
  float (*h2)[1028] = (float (*)[1028])smem;
  const int tid = fresh_tid(), lane = tid & 63, wave = tid >> 6;
  const int t0 = unit * 32;
#pragma unroll
  for (int rr = 0; rr < 4; ++rr) {
    const int r = wave * 4 + rr;
    const bf16_t* hp = H1 + (size_t)(t0 + r) * D;
#pragma unroll
    for (int j = 0; j < 2; ++j) {
      const u32x4 hw = *(const u32x4*)(hp + j * 512 + lane * 8);
      *(f32x4*)&h2[r][j * 512 + lane * 8] = (f32x4){bflo(hw.x), bfhi(hw.x), bflo(hw.y), bfhi(hw.y)};
      *(f32x4*)&h2[r][j * 512 + lane * 8 + 4] = (f32x4){bflo(hw.z), bfhi(hw.z), bflo(hw.w), bfhi(hw.w)};
    }
  }
  __syncthreads();
  {
    const int tok = lane & 31;
#pragma unroll 4
    for (int cg = wave * 2 + (lane >> 5); cg < 128; cg += 16) {
      const u32x4 yw = *(const u32x4*)(YT + ((size_t)cg * TREAL + t0 + tok) * 8);
      f32x4* hp = (f32x4*)&h2[tok][cg * 8];
      f32x4 a = hp[0], b4 = hp[1];
      a.x += bflo(yw.x); a.y += bfhi(yw.x); a.z += bflo(yw.y); a.w += bfhi(yw.y);
      b4.x += bflo(yw.z); b4.y += bfhi(yw.z); b4.z += bflo(yw.w); b4.w += bfhi(yw.w);
      hp[0] = a; hp[1] = b4;
    }
  }
  __syncthreads();
#pragma unroll
  for (int rr = 0; rr < 4; ++rr) {
    const int r = wave * 4 + rr;
    f32x4 v[4]; float ss = 0.f;
#pragma unroll
    for (int j = 0; j < 4; ++j) { v[j] = *(const f32x4*)&h2[r][j * 256 + lane * 4]; ss += v[j].x * v[j].x + v[j].y * v[j].y + v[j].z * v[j].z + v[j].w * v[j].w; }
    ss = wave_sum(ss);
    const float sc = rsqrtf(ss * (1.0f / D) + EPS);
    float* op = out + (size_t)(t0 + r) * D;
#pragma unroll
    for (int j = 0; j < 4; ++j) {
      const f32x4 gg = *(const f32x4*)(gf + j * 256 + lane * 4);
      *(f32x4*)(op + j * 256 + lane * 4) = (f32x4){v[j].x * sc * gg.x, v[j].y * sc * gg.y, v[j].z * sc * gg.z, v[j].w * sc * gg.w};
    }
  }
  __syncthreads();
}

typedef int i32x4 __attribute__((ext_vector_type(4)));
constexpr size_t WS_XQ = 861 * MiB;
constexpr size_t WS_XS = 943 * MiB;
DI unsigned pack_i8x4(float a, float b, float c, float d) {
  const int ia = __float2int_rn(a), ib = __float2int_rn(b), ic = __float2int_rn(c), id = __float2int_rn(d);
  return ((unsigned)ia & 255u) | (((unsigned)ib & 255u) << 8) | (((unsigned)ic & 255u) << 16) | ((unsigned)id << 24);
}
DI u32x4 quant_row16_i8(const float* __restrict__ rowp, int lane, float& sc) {
  const f32x4* rp = (const f32x4*)(rowp + lane * 16);
  const f32x4 a = rp[0], b = rp[1], c = rp[2], d = rp[3];
  float m = fmaxf(fmaxf(fmaxf(fabsf(a.x), fabsf(a.y)), fmaxf(fabsf(a.z), fabsf(a.w))), fmaxf(fmaxf(fabsf(b.x), fabsf(b.y)), fmaxf(fabsf(b.z), fabsf(b.w))));
  m = fmaxf(m, fmaxf(fmaxf(fmaxf(fabsf(c.x), fabsf(c.y)), fmaxf(fabsf(c.z), fabsf(c.w))), fmaxf(fmaxf(fabsf(d.x), fabsf(d.y)), fmaxf(fabsf(d.z), fabsf(d.w)))));
  m = wave_max(m);
  sc = m > 0.f ? m * (1.0f / 127.0f) : 1.0f;
  const float inv = 1.0f / sc;
  u32x4 o;
  o.x = pack_i8x4(a.x * inv, a.y * inv, a.z * inv, a.w * inv); o.y = pack_i8x4(b.x * inv, b.y * inv, b.z * inv, b.w * inv);
  o.z = pack_i8x4(c.x * inv, c.y * inv, c.z * inv, c.w * inv); o.w = pack_i8x4(d.x * inv, d.y * inv, d.z * inv, d.w * inv);
  return o;
}
DI void ph_convert_eu_i8(const float* __restrict__ src, u8_t* __restrict__ EUq, float* __restrict__ scaleU) {
  const int tid = fresh_tid(), lane = tid & 63, wave = tid >> 6;
  for (int e = (blockIdx.x * 8 + wave) * 2; e < NEXP; e += gridDim.x * 16) {
    float sc0, sc1 = 1.f;
    const bool two = e + 1 < NEXP;
    const u32x4 o0 = quant_row16_i8(src + (size_t)e * D, lane, sc0);
    u32x4 o1 = o0;
    if (two) o1 = quant_row16_i8(src + (size_t)(e + 1) * D, lane, sc1);
    *(u32x4*)(EUq + ((size_t)(lane >> 3) * NEXP + e) * 128 + (lane & 7) * 16) = o0;
    if (two) *(u32x4*)(EUq + ((size_t)(lane >> 3) * NEXP + e + 1) * 128 + (lane & 7) * 16) = o1;
    if (lane == 0) { scaleU[e] = sc0; if (two) scaleU[e + 1] = sc1; }
  }
}
DI void ph_norm2_rows(int vb, const bf16_t* __restrict__ src, const float* __restrict__ gain, float* __restrict__ R2, u8_t* __restrict__ XQ, float* __restrict__ XS) {
  const int tid256_ = fresh_tid() & 255;
  const int row0 = vb * 16 + (TID >> 6) * 4, lane = TID & 63;
  u32x2 raw[4][4];
#pragma unroll
  for (int rr = 0; rr < 4; ++rr)
#pragma unroll
    for (int j = 0; j < 4; ++j) raw[rr][j] = *(const u32x2*)(src + (size_t)(row0 + rr) * D + j * 256 + lane * 4);
  f32x4 gg[4];
#pragma unroll
  for (int j = 0; j < 4; ++j) gg[j] = *(const f32x4*)(gain + j * 256 + lane * 4);
#pragma unroll
  for (int rr = 0; rr < 4; ++rr) {
    f32x4 v[4]; float ss = 0.f;
#pragma unroll
    for (int j = 0; j < 4; ++j) {
      v[j] = (f32x4){bflo(raw[rr][j].x), bfhi(raw[rr][j].x), bflo(raw[rr][j].y), bfhi(raw[rr][j].y)};
      ss += v[j].x * v[j].x + v[j].y * v[j].y + v[j].z * v[j].z + v[j].w * v[j].w;
    }
    ss = wave_sum(ss);
    const float r = rsqrtf(ss * (1.0f / D) + EPS);
    if (lane == 0) R2[row0 + rr] = r;
#pragma unroll
    for (int j = 0; j < 4; ++j) {
      const float a0 = v[j].x * gg[j].x, a1 = v[j].y * gg[j].y, a2 = v[j].z * gg[j].z, a3 = v[j].w * gg[j].w;
      float m = fmaxf(fmaxf(fabsf(a0), fabsf(a1)), fmaxf(fabsf(a2), fabsf(a3)));
#pragma unroll
      for (int sh = 16; sh >= 1; sh >>= 1) m = fmaxf(m, __shfl_xor(m, sh));
      const float inv = m > 0.f ? 127.0f / m : 0.f;
      *(unsigned*)(XQ + (size_t)(row0 + rr) * D + j * 256 + lane * 4) = pack_i8x4(a0 * inv, a1 * inv, a2 * inv, a3 * inv);
      if ((lane & 31) == 0) XS[(size_t)(row0 + rr) * 8 + 2 * j + (lane >> 5)] = m * r * (1.0f / 127.0f);
    }
  }
}
DI int dpp_i(int v, const int sel) {
  if (sel == 0) return __builtin_amdgcn_update_dpp(0, v, 0xB1, 0xF, 0xF, true);
  if (sel == 1) return __builtin_amdgcn_update_dpp(0, v, 0x4E, 0xF, 0xF, true);
  return __builtin_amdgcn_update_dpp(0, v, 0x141, 0xF, 0xF, true);
}
DI int dpp_isum8(int v) { v += dpp_i(v, 0); v += dpp_i(v, 1); v += dpp_i(v, 2); return v; }
template <int HF> DI void peer_ud4_issue(PeerUHalf& H, unsigned idxpair, int lane, const u8_t* __restrict__ tab) {
#pragma unroll
  for (int jj = 0; jj < 8; ++jj) {
    const int j = 8 * HF + jj;
    const unsigned w = (unsigned)__shfl((int)idxpair, (lane & ~7) + (j >> 1));
    const unsigned e = (j & 1) ? (w >> 16) : (w & 0xffffu);
    H.u[jj] = *(const u32x4*)(tab + (size_t)e * 128);
  }
}
template <int HF> DI void peer_ud4_compute(const PeerUHalf& H, const u32x4 xq, int sub, int& res0, int& res1) {
#pragma unroll
  for (int jj = 0; jj < 8; ++jj) {
    const int j = 8 * HF + jj;
    int acc = 0;
    acc = __builtin_amdgcn_sdot4((int)H.u[jj].x, (int)xq.x, acc, false); acc = __builtin_amdgcn_sdot4((int)H.u[jj].y, (int)xq.y, acc, false);
    acc = __builtin_amdgcn_sdot4((int)H.u[jj].z, (int)xq.z, acc, false); acc = __builtin_amdgcn_sdot4((int)H.u[jj].w, (int)xq.w, acc, false);
    acc = dpp_isum8(acc);
    if (sub == (j >> 1)) { if (j & 1) res1 = acc; else res0 = acc; }
  }
}
DI void ph_peer_u_d4(int xi, int nx, int wv, int nwv, const u8_t* __restrict__ XQ, const float* __restrict__ XS, const u8_t* __restrict__ EUq,
                     const unsigned short* __restrict__ EIDX, bf16_t* __restrict__ PP) {
  const int lane = fresh_tid() & 63, sub = lane & 7;
  const int ntok = (TREAL - wv + nwv - 1) / nwv;
#define PU_TOK(i) (wv + ((i) < ntok ? (i) : ntok - 1) * nwv)
#define PU_IDX(t) __builtin_nontemporal_load((const unsigned*)(EIDX + (size_t)(t) * 128) + lane)
#define PU_LDX(xq_, xs_, t) { xq_ = *(const u32x4*)(xbase + (size_t)(t) * D); xs_ = XS[(size_t)(t) * 8 + s]; }
#define PU_STORE(t, r0, r1, xs_) __builtin_nontemporal_store(pk2((float)(r0) * (xs_), (float)(r1) * (xs_)), (unsigned*)(pp + (size_t)(t) * 128) + lane)
  for (int s = xi; s < 8; s += nx) {
    const u8_t* tab = EUq + (size_t)s * NEXP * 128 + sub * 16;
    const u8_t* xbase = XQ + s * 128 + sub * 16;
    bf16_t* pp = PP + (size_t)s * TREAL * 128;
    PeerUHalf HA, HB, HC;
    int ta = PU_TOK(0), tb = PU_TOK(1), tc = PU_TOK(2);
    unsigned ia = PU_IDX(ta), ib = PU_IDX(tb), ic = PU_IDX(tc);
    u32x4 xqa; float xsa; PU_LDX(xqa, xsa, ta);
    peer_ud4_issue<0>(HA, ia, lane, tab);
    peer_ud4_issue<1>(HB, ia, lane, tab);
    for (int i = 0; i < ntok; i += 3) {
      const int td = PU_TOK(i + 3), te = PU_TOK(i + 4), tf = PU_TOK(i + 5);
      u32x4 xqb, xqc, xqd; float xsb, xsc, xsd;
      int r0, r1;
      peer_ud4_issue<0>(HC, ib, lane, tab); PU_LDX(xqb, xsb, tb); const unsigned id = PU_IDX(td);
      r0 = 0; r1 = 0;
      peer_ud4_compute<0>(HA, xqa, sub, r0, r1);
      peer_ud4_issue<1>(HA, ib, lane, tab);
      peer_ud4_compute<1>(HB, xqa, sub, r0, r1);
      PU_STORE(ta, r0, r1, xsa);
      peer_ud4_issue<0>(HB, ic, lane, tab); PU_LDX(xqc, xsc, tc); const unsigned ie = PU_IDX(te);
      r0 = 0; r1 = 0;
      peer_ud4_compute<0>(HC, xqb, sub, r0, r1);
      peer_ud4_issue<1>(HC, ic, lane, tab);
      peer_ud4_compute<1>(HA, xqb, sub, r0, r1);
      PU_STORE(tb, r0, r1, xsb);
      peer_ud4_issue<0>(HA, id, lane, tab); PU_LDX(xqd, xsd, td); const unsigned if_ = PU_IDX(tf);
      r0 = 0; r1 = 0;
      peer_ud4_compute<0>(HB, xqc, sub, r0, r1);
      peer_ud4_issue<1>(HB, id, lane, tab);
      peer_ud4_compute<1>(HC, xqc, sub, r0, r1);
      PU_STORE(tc, r0, r1, xsc);
      ta = td; tb = te; tc = tf; ib = ie; ic = if_; xqa = xqd; xsa = xsd;
    }
  }
#undef PU_TOK
#undef PU_IDX
#undef PU_LDX
#undef PU_STORE
}

struct PUI { i32x4 a[8]; };
struct PUE { int e[8]; };

#define XB_TMO      128
#define XB_XCNT(j)  (256  + 64 * (j))
#define XB_XSUB(j)  (1280 + 64 * (j))
#define XB_XGEN(j)  (2304 + 64 * (j))
#define XB_TOP      3328
#define XB_TOPGEN   3392
#define XCD_BAR_WORDS 3456
#define XB_SPIN_CAP (1u << 20)
#define LAS __attribute__((address_space(3)))
DI unsigned xb_ld(unsigned* p)              { return __hip_atomic_load(p, __ATOMIC_RELAXED, __HIP_MEMORY_SCOPE_AGENT); }
DI unsigned xb_add(unsigned* p, unsigned v) { return __hip_atomic_fetch_add(p, v, __ATOMIC_RELAXED, __HIP_MEMORY_SCOPE_AGENT); }
DI unsigned xb_xcc_id() { return (unsigned)__builtin_amdgcn_s_getreg((3 << 11) | 20) & 0xFu; }
#define XB_SPIN(cond, bar) do { unsigned _sp = 0; while (cond) { __builtin_amdgcn_s_sleep(1); \
    if ((++_sp & 255u) == 0u) { if (xb_ld(&(bar)[XB_TMO])) break; if (_sp > XB_SPIN_CAP) { atomicAdd(&(bar)[XB_TMO], 1u); break; } } } } while (0)
struct XcdBarrier { unsigned* bar; unsigned x; volatile unsigned* st; };
DI XcdBarrier xcd_barrier_post(unsigned* bar, volatile unsigned* st) {
  XcdBarrier b; b.bar = bar; b.x = xb_xcc_id(); b.st = st;
  if (threadIdx.x == 0) (void)xb_add(&bar[XB_XCNT(b.x)], 1u);
  return b;
}
DI void xcd_barrier_complete(unsigned* bar, unsigned x, unsigned& nloc, unsigned& nx) {
  const unsigned G = gridDim.x;
  unsigned sum, cnt, mine, sp = 0u;
  for (;;) {
    sum = 0u; cnt = 0u; mine = 0u;
#pragma unroll
    for (unsigned j = 0; j < 16; ++j) { const unsigned c = xb_ld(&bar[XB_XCNT(j)]); sum += c; cnt += (c > 0u) ? 1u : 0u; mine = (j == x) ? c : mine; }
    if (sum == G) break;
    __builtin_amdgcn_s_sleep(1);
    if ((++sp & 255u) == 0u) { if (xb_ld(&bar[XB_TMO])) break; if (sp > XB_SPIN_CAP) { atomicAdd(&bar[XB_TMO], 1u); break; } }
  }
  nloc = mine > 0u ? mine : 1u; nx = cnt > 0u ? cnt : 1u;
}
DI void xcd_barrier(const XcdBarrier& b) {
  asm volatile("s_waitcnt vmcnt(0)" ::: "memory");
  __syncthreads();
  if (threadIdx.x == 0) {
    unsigned* bar = b.bar;
    __builtin_amdgcn_s_waitcnt(0);
    unsigned nloc = b.st[0], nx = b.st[1];
    if (nloc == 0u) { xcd_barrier_complete(bar, b.x, nloc, nx); b.st[0] = nloc; b.st[1] = nx; }
    const unsigned old = xb_add(&bar[XB_XSUB(b.x)], 1u);
    const unsigned gen = old / nloc;
    if (old + 1u == (gen + 1u) * nloc) {
      __builtin_amdgcn_fence(__ATOMIC_RELEASE, "agent");
      asm volatile("s_waitcnt vmcnt(0)" ::: "memory");
      const unsigned og = xb_add(&bar[XB_TOP], 1u);
      const unsigned tg = og / nx;
      if (og + 1u == (tg + 1u) * nx) xb_add(&bar[XB_TOPGEN], 1u);
      else XB_SPIN(xb_ld(&bar[XB_TOPGEN]) == tg, bar);
      __builtin_amdgcn_fence(__ATOMIC_ACQUIRE, "agent");
      xb_add(&bar[XB_XGEN(b.x)], 1u);
      asm volatile("s_waitcnt vmcnt(0)" ::: "memory");
    } else {
      XB_SPIN(xb_ld(&bar[XB_XGEN(b.x)]) == gen, bar);
      __builtin_amdgcn_fence(__ATOMIC_ACQUIRE, "agent");
      asm volatile("s_waitcnt vmcnt(0)" ::: "memory");
    }
  }
  __syncthreads();
}

struct Params {
  const float *x, *meta, *norm1_g, *w_in, *wg, *bg, *sb_g, *gla_g, *w_out, *norm2_g, *w_pq, *sk1, *sk2, *eu, *ev, *gf;
  float* out; char* ws;
};
constexpr int HALF_SMEM = 73728;
constexpr int SMEM_BYTES = 2 * HALF_SMEM;
constexpr size_t WS_BAR = 0;

__global__ void __launch_bounds__(512, 2) k_fused(Params p) {
  extern __shared__ __attribute__((aligned(16))) char smem_dyn[];
  const int half = __builtin_amdgcn_readfirstlane((int)(threadIdx.x >> 8));
  char* smem = smem_dyn + half * HALF_SMEM;
  __shared__ unsigned xb_words[4];
  if (threadIdx.x < 4) xb_words[threadIdx.x] = 0u;
  __syncthreads();
  const XcdBarrier bar = xcd_barrier_post((unsigned*)(p.ws + WS_BAR), xb_words);
  if (threadIdx.x == 0) xb_words[2] = xb_add((unsigned*)(p.ws + WS_XRANK) + bar.x, 1u);
  const int G = 2 * gridDim.x, bid = 2 * blockIdx.x + half;
  char* ws = p.ws;
  bf16_t* WinT = (bf16_t*)(ws + WS_WIN);
  bf16_t* WoutT = (bf16_t*)(ws + WS_WOUT);
  bf16_t* WpqT = (bf16_t*)(ws + WS_WPQ);
  bf16_t* EU = (bf16_t*)(ws + WS_EU);
  bf16_t* EV = (bf16_t*)(ws + WS_EV);
  bf16_t* SK1b = (bf16_t*)(ws + WS_SK1);
  bf16_t* SK2b = (bf16_t*)(ws + WS_SK2);
  bf16_t* A1 = (bf16_t*)(ws + WS_A1);
  float* GO = (float*)(ws + WS_A1);
  bf16_t* A2 = (bf16_t*)(ws + WS_A1);
  InProjOut O;
  O.QSB = (bf16_t*)(ws + WS_QSB); O.KSB = (bf16_t*)(ws + WS_KSB); O.VTSB = (bf16_t*)(ws + WS_VTSB); O.VSB = (bf16_t*)(ws + WS_VSB);
  O.GQ = (bf16_t*)(ws + WS_GQ); O.GK = (bf16_t*)(ws + WS_GK); O.GV = (bf16_t*)(ws + WS_GVT); O.GR = (bf16_t*)(ws + WS_GR);
  O.GLR = (float*)(ws + WS_GLR);
  bf16_t* H1 = (bf16_t*)(ws + WS_H1);
  float* R2 = (float*)(ws + WS_XS + 3 * MiB);
  bf16_t* GVT = (bf16_t*)(ws + WS_GVT);
  GlaPtrs GP;
  GP.GQ = O.GQ; GP.GK = O.GK; GP.GVT = GVT; GP.GR = O.GR; GP.GLR = O.GLR; GP.wg = p.wg; GP.bg = p.bg; GP.gla_g = p.gla_g;
  GP.SLOC = (float*)(ws + WS_SLOC); GP.DTOT = (float*)(ws + WS_DTOT); GP.MIX = (bf16_t*)(ws + WS_MIX);
  GlaPrepPtrs GPP; GPP.GQ = O.GQ; GPP.GK = O.GK; GPP.GLR = O.GLR; GPP.wg = p.wg; GPP.bg = p.bg;
  GPP.QT = (bf16_t*)(ws + WS_GQT); GPP.KT = (bf16_t*)(ws + WS_GKT); GPP.KTT = (bf16_t*)(ws + WS_GKTT); GPP.DEC = (float*)(ws + WS_GDEC); GPP.BL = (float*)(ws + WS_GBL);
  GlaPtrs3 GP3; GP3.QT = GPP.QT; GP3.KT = GPP.KT; GP3.KTT = GPP.KTT; GP3.GVT = GVT; GP3.GR = O.GR; GP3.DEC = GPP.DEC; GP3.BL = GPP.BL; GP3.gla_g = p.gla_g;
  GP3.SLOC = GP.SLOC; GP3.DTOT = GP.DTOT; GP3.MIX = GP.MIX;
  bf16_t* MIX = (bf16_t*)(ws + WS_MIX);
  bf16_t* QP = (bf16_t*)(ws + WS_MIX);
  unsigned short* EIDX = (unsigned short*)(ws + WS_EIDX);
  bf16_t* PP = (bf16_t*)(ws + WS_PP);
  bf16_t* YT = (bf16_t*)(ws + WS_PP);
  unsigned* STREAM = (unsigned*)(ws + WS_STREAM);
  float* GATE = (float*)(ws + WS_GATE);

  for (int vb = bid; vb < 3328 + 1024 + 1024; vb += G) {
    if (vb < 3328) ph_transpose_w(vb % 104, vb / 104, smem, p.w_in, p.norm1_g, WinT, D, NIN);
    else if (vb < 4352) { const int t = vb - 3328; ph_transpose_w(t % 32, t / 32, smem, p.w_out, nullptr, WoutT, D, D); }
    else { const int t = vb - 4352; ph_transpose_w(t % 32, t / 32, smem, p.w_pq, p.norm2_g, WpqT, D, D); }
  }
  ph_convert_eu_i8(p.eu, (u8_t*)EU, (float*)(ws + WS_SCU));
  for (int vb = bid; vb < NEXP / 32; vb += G) ph_convert_ev8(vb, smem, p.ev, (u8_t*)EV, (float*)(ws + WS_SCV));
  ph_convert(p.sk1, SK1b, (size_t)8 * 128 * 64 / 8);
  ph_convert(p.sk2, SK2b, (size_t)8 * 128 * 64 / 8);
  ph_zero_pads(O.KSB, O.VTSB, O.GQ, O.GK, GVT);
  for (int vb = bid; vb < TREAL / 16; vb += G) ph_norm_rows<0>(vb, p.x, p.meta, A1);
  __syncthreads();
  for (int mb = blockIdx.x; mb < NIN / 16; mb += gridDim.x) ph_meta(mb, smem_dyn, p.meta, p.norm1_g, p.w_in, O);
  xcd_barrier(bar);
  {
    pg8::Gemm g{A1, WinT, TREAL, NINP, D}; pg8::StaticOrder S; S.init(TREAL, NINP, (int)gridDim.x, (int)blockIdx.x);
    EpiInProj E{O, GVT, smem_dyn + 131072};
    pg8::gemm_phase<EpiInProj, pg8::StaticOrder, true, true>((PG8_LAS unsigned char*)smem_dyn, g, S, E);
  }
  xcd_barrier(bar);
  for (int it = blockIdx.x; it < 32 * 129; it += gridDim.x) ph_gla_prep(it, smem_dyn, GPP);
  xcd_barrier(bar);
  for (int it = blockIdx.x; it < 32 * 15; it += gridDim.x) gla_item3<0>(it / 15, it % 15, smem_dyn, GP3);
  for (int vb = bid; vb < 64 * 64; vb += G) ph_sb_attn(vb, O.QSB, O.KSB, O.VTSB, p.sb_g, MIX);
  xcd_barrier(bar);
  for (int it = blockIdx.x; it < 32 * 16; it += gridDim.x) gla_item3<1>(it >> 4, it & 15, smem_dyn, GP3);
  xcd_barrier(bar);
  {
    pg8::Gemm g{MIX, WoutT, TREAL, D, D}; pg8::StaticOrder S; S.init(TREAL, D, (int)gridDim.x, (int)blockIdx.x);
    EpiOut E{p.x, H1};
    pg8::gemm_phase<EpiOut, pg8::StaticOrder, true, true>((PG8_LAS unsigned char*)smem_dyn, g, S, E);
  }
  xcd_barrier(bar);
  for (int vb = bid; vb < TREAL / 16; vb += G) ph_norm2_rows(vb, H1, p.norm2_g, R2, (u8_t*)(ws + WS_XQ), (float*)(ws + WS_XS));
  xcd_barrier(bar);
  {
    pg8::Gemm g{H1, WpqT, TREAL, D, D}; pg8::StaticOrder S; S.init(TREAL, D, (int)gridDim.x, (int)blockIdx.x);
    EpiPQ E{QP, R2};
    pg8::gemm_phase<EpiPQ, pg8::StaticOrder, true, true>((PG8_LAS unsigned char*)smem_dyn, g, S, E);
  }
  xcd_barrier(bar);
  for (int vb = bid; vb < 8 * (TREAL / 128); vb += G) ph_route_v2(vb, smem, QP, SK1b, SK2b, EIDX, GATE);
  xcd_barrier(bar);
  {
    __shared__ int xinfo[4];
    if (threadIdx.x == 0) {
      unsigned* barw = (unsigned*)(p.ws + WS_BAR);
      unsigned cnt = 0, ord = 0, mine = 1;
      for (unsigned j = 0; j < 16; ++j) { const unsigned c = xb_ld(&barw[XB_XCNT(j)]); if (c > 0) { if (j < bar.x) ++ord; ++cnt; } if (j == bar.x) mine = c; }
      xinfo[0] = (int)ord; xinfo[1] = (int)cnt; xinfo[2] = (int)xb_words[2]; xinfo[3] = (int)mine;
    }
    __syncthreads();
    const int xi = xinfo[0], nx = xinfo[1], rank = xinfo[2], nloc = xinfo[3];
    const int wave = __builtin_amdgcn_readfirstlane((int)(threadIdx.x >> 6));
    ph_peer_u_d4(xi, nx, rank * 8 + wave, nloc * 8, (const u8_t*)(ws + WS_XQ), (const float*)(ws + WS_XS), (const u8_t*)EU, EIDX, PP);
  }
  xcd_barrier(bar);
  for (int unit = blockIdx.x; unit < TREAL / 64; unit += gridDim.x) ph_peer_c8(unit, smem_dyn, PP, EIDX, GATE, (const float*)(ws + WS_SCU), (const float*)(ws + WS_SCV), STREAM);
  xcd_barrier(bar);
  ph_peer_v8(smem_dyn, STREAM, (const u8_t*)EV, YT);
  xcd_barrier(bar);
  for (int unit = blockIdx.x; unit < TREAL / 32; unit += gridDim.x) ph_final_lds(unit, smem_dyn, H1, YT, p.gf, p.out);
}

extern "C" void kernel_launch(void* const* d_in, const int* in_sizes, int n_in, void* d_out, int out_size, void* d_ws, size_t ws_size, hipStream_t stream) {
  static int grid = 0;
  if (grid == 0) {
    int dev = 0, cus = 0, per_cu = 0;
    hipGetDevice(&dev);
    hipDeviceGetAttribute(&cus, hipDeviceAttributeMultiprocessorCount, dev);
    hipFuncSetAttribute((const void*)k_fused, hipFuncAttributeMaxDynamicSharedMemorySize, SMEM_BYTES);
    hipOccupancyMaxActiveBlocksPerMultiprocessor(&per_cu, (const void*)k_fused, 512, SMEM_BYTES);
    if (per_cu > 1) per_cu = 1;
    if (per_cu < 1) per_cu = 1;
    grid = cus * per_cu;
  }
  hipMemsetAsync((char*)d_ws + WS_BAR, 0, 32768, stream);
  Params p{};
  p.x = (const float*)d_in[0]; p.meta = (const float*)d_in[1]; p.norm1_g = (const float*)d_in[2]; p.w_in = (const float*)d_in[3];
  p.wg = (const float*)d_in[4]; p.bg = (const float*)d_in[5]; p.sb_g = (const float*)d_in[6]; p.gla_g = (const float*)d_in[7];
  p.w_out = (const float*)d_in[8]; p.norm2_g = (const float*)d_in[9]; p.w_pq = (const float*)d_in[10]; p.sk1 = (const float*)d_in[11];
  p.sk2 = (const float*)d_in[12]; p.eu = (const float*)d_in[13]; p.ev = (const float*)d_in[14]; p.gf = (const float*)d_in[15];
  p.out = (float*)d_out; p.ws = (char*)d_ws;
  void* args[] = {&p};
  hipLaunchCooperativeKernel((const void*)k_fused, dim3(grid), dim3(512), args, SMEM_BYTES, stream);
}
```

```cpp
#include <hip/hip_runtime.h>
#include <stdint.h>
#include <stddef.h>

typedef unsigned short bf16_t;
typedef short bf16x8 __attribute__((ext_vector_type(8)));
typedef float f32x16 __attribute__((ext_vector_type(16)));
typedef float f32x4 __attribute__((ext_vector_type(4)));
typedef float f32x2 __attribute__((ext_vector_type(2)));
typedef unsigned u32x4 __attribute__((ext_vector_type(4)));
typedef unsigned u32x2 __attribute__((ext_vector_type(2)));
typedef __bf16 bf16x2_t __attribute__((ext_vector_type(2)));

#define DI __device__ __forceinline__
__device__ __forceinline__ int fresh_tid() { int t = (int)threadIdx.x; asm volatile("" : "+v"(t)); return t; }
#define TID tid256_
#define MFMA32(a, b, c) __builtin_amdgcn_mfma_f32_32x32x16_bf16((a), (b), (c), 0, 0, 0)

constexpr int D = 1024, NB = 8, SEQ = 8192, NMETA = 16;
constexpr int TREAL = NB * SEQ;
constexpr int MROWS = TREAL + 128;
constexpr int NIN = 3088, NINP = 3328;
constexpr int SBH = 8, SBD = 64;
constexpr int GH = 4, GDK = 64, GDV = 128;
constexpr int KIDX = SEQ + 32;
constexpr int GU = SEQ + 64;
constexpr int NEXP = 16384;
constexpr float EPS = 1e-6f;

constexpr size_t MiB = 1u << 20;
constexpr size_t WS_WIN = 1 * MiB;
constexpr size_t WS_WOUT = 8 * MiB;
constexpr size_t WS_WPQ = 10 * MiB;
constexpr size_t WS_SK1 = 12 * MiB;
constexpr size_t WS_SK2 = 13 * MiB;
constexpr size_t WS_EU = 16 * MiB;
constexpr size_t WS_EV = 48 * MiB;
constexpr size_t WS_A1 = 80 * MiB;
constexpr size_t WS_QSB = 210 * MiB;
constexpr size_t WS_KSB = 274 * MiB;
constexpr size_t WS_VTSB = 339 * MiB;
constexpr size_t WS_GQ = 404 * MiB;
constexpr size_t WS_GK = 437 * MiB;
constexpr size_t WS_H1 = 210 * MiB;
constexpr size_t WS_GV = 470 * MiB;
constexpr size_t WS_GR = 535 * MiB;
constexpr size_t WS_GLR = 599 * MiB;
constexpr size_t WS_LG = 604 * MiB;
constexpr size_t WS_MIX = 669 * MiB;
constexpr size_t WS_EIDX = 797 * MiB;
constexpr size_t WS_GATE = 829 * MiB;
constexpr size_t WS_PP = 470 * MiB;
constexpr size_t WS_STREAM = 726 * MiB;
constexpr size_t WS_XRANK = 16384;
constexpr size_t WS_VSB = 861 * MiB;
constexpr size_t WS_END = 926 * MiB;

DI unsigned f2bf(float f) { unsigned u = __float_as_uint(f); return (u + 0x7fffu + ((u >> 16) & 1u)) >> 16; }
DI float bf2f(unsigned b) { return __uint_as_float(b << 16); }
DI unsigned pk2(float lo, float hi) { f32x2 v = {lo, hi}; return __builtin_bit_cast(unsigned, __builtin_convertvector(v, bf16x2_t)); }
DI float bflo(unsigned u) { return __uint_as_float(u << 16); }
DI float bfhi(unsigned u) { return __uint_as_float(u & 0xffff0000u); }
DI int crow(int reg, int h) { return (reg & 3) + 8 * (reg >> 2) + 4 * h; }
DI float wave_sum(float v) {
#pragma unroll
  for (int o = 32; o >= 1; o >>= 1) v += __shfl_xor(v, o);
  return v;
}
DI float softplus(float z) { return fmaxf(z, 0.f) + __logf(1.f + __expf(-fabsf(z))); }

DI void ph_transpose_w(int bx, int by, char* smem, const float* __restrict__ W, const float* __restrict__ gain, bf16_t* __restrict__ WT, int K, int N) {
  const int tid256_ = fresh_tid() & 255;
  float (*t)[33] = (float (*)[33])smem;
  const int n0 = bx * 32, k0 = by * 32, tx = TID & 31, ty = TID >> 5;
  for (int r = ty; r < 32; r += 8) {
    const int k = k0 + r, n = n0 + tx;
    float v = 0.f;
    if (n < N) { v = W[(size_t)k * N + n]; if (gain) v *= gain[k]; }
    t[r][tx] = v;
  }
  __syncthreads();
  for (int r = ty; r < 32; r += 8) {
    const int n = n0 + r, k = k0 + tx;
    WT[(size_t)n * K + k] = (bf16_t)f2bf(t[tx][r]);
  }
  __syncthreads();
}
DI void ph_convert(const float* __restrict__ src, bf16_t* __restrict__ dst, size_t n8) {
  size_t i = (size_t)blockIdx.x * blockDim.x + threadIdx.x;
  const size_t stride = (size_t)gridDim.x * blockDim.x;
  for (; i < n8; i += stride) {
    const f32x4 a = ((const f32x4*)src)[2 * i], b = ((const f32x4*)src)[2 * i + 1];
    u32x4 o; o.x = pk2(a.x, a.y); o.y = pk2(a.z, a.w); o.z = pk2(b.x, b.y); o.w = pk2(b.z, b.w);
    ((u32x4*)dst)[i] = o;
  }
}
DI void ph_zero_pads(bf16_t* KSB, bf16_t* VTSB, bf16_t* GQ, bf16_t* GK, bf16_t* GVT) {
  const int tid = blockIdx.x * blockDim.x + threadIdx.x, nth = gridDim.x * blockDim.x;
  for (int i = tid; i < 64 * 16 * 64; i += nth) { const int bh = i / 1024, r = i % 1024; KSB[(size_t)bh * KIDX * 64 + r] = 0; }
  for (int i = tid; i < 64 * 64 * 16; i += nth) { const int row = i / 16, c = i % 16; VTSB[(size_t)row * KIDX + c] = 0; }
  for (int i = tid; i < 32 * 48 * 64; i += nth) { const int bh = i / 3072, r = i % 3072; GQ[(size_t)bh * GU * 64 + r] = 0; GK[(size_t)bh * GU * 64 + r] = 0; }
  for (int i = tid; i < 32 * 128 * 48; i += nth) { const int row = i / 48, c = i % 48; GVT[(size_t)row * GU + c] = 0; }
}

template <int MODE>
DI void ph_norm_rows(int vb, const float* __restrict__ src, const float* __restrict__ meta, bf16_t* __restrict__ dst) {
  const int tid256_ = fresh_tid() & 255;
  const int row0 = vb * 16 + (TID >> 6) * 4, lane = TID & 63;
  f32x4 v[4][4];
#pragma unroll
  for (int rr = 0; rr < 4; ++rr)
#pragma unroll
    for (int j = 0; j < 4; ++j) v[rr][j] = *(const f32x4*)(src + (size_t)(row0 + rr) * D + j * 256 + lane * 4);
  f32x4 gg[4];
#pragma unroll
  for (int j = 0; j < 4; ++j) { gg[j] = (f32x4){1.f, 1.f, 1.f, 1.f}; if (MODE == 1) gg[j] = *(const f32x4*)(meta + j * 256 + lane * 4); }
#pragma unroll
  for (int rr = 0; rr < 4; ++rr) {
    float ss = 0.f;
#pragma unroll
    for (int j = 0; j < 4; ++j) ss += v[rr][j].x * v[rr][j].x + v[rr][j].y * v[rr][j].y + v[rr][j].z * v[rr][j].z + v[rr][j].w * v[rr][j].w;
    ss = wave_sum(ss);
    const float r = rsqrtf(ss * (1.0f / D) + EPS);
#pragma unroll
    for (int j = 0; j < 4; ++j) {
      u32x2 o; o.x = pk2(v[rr][j].x * r * gg[j].x, v[rr][j].y * r * gg[j].y); o.y = pk2(v[rr][j].z * r * gg[j].z, v[rr][j].w * r * gg[j].w);
      *(u32x2*)(dst + (size_t)(row0 + rr) * D + j * 256 + lane * 4) = o;
    }
  }
}

namespace pg8 {
#define PG8_LAS __attribute__((address_space(3)))
typedef unsigned short bf16_t;
typedef short bf16x8 __attribute__((ext_vector_type(8)));
typedef float f32x4 __attribute__((ext_vector_type(4)));
typedef unsigned u32x4 __attribute__((ext_vector_type(4)));
constexpr int BM = 256, BK = 64, HALF = 128, HTB = HALF * BK * 2  , STAGE_BYTES = 8 * HTB, NXCD = 8, WGM = 8;

__host__ __device__ __forceinline__ int lds_byte(int r, int c) { const int st = (r >> 4) * 2 + (c >> 5), rr = r & 15, cc = c & 31, ob = rr * 64 + cc * 2; return st * 1024 + (ob ^ (((ob >> 9) & 1) << 5)); }
__host__ __device__ __forceinline__ void stage_rc(int b, int& R, int& C) { const int st = b / 1024, sb = b % 1024, swz = sb ^ (((sb >> 9) & 1) << 5); R = (st >> 1) * 16 + swz / 64; C = (st & 1) * 32 + (swz % 64) / 2; }
__host__ __device__ __forceinline__ int perm32(int rho) { const int n = rho >> 4, i = rho & 15; return 8 * (i >> 2) + 4 * n + (i & 3); }

struct Unit { int pm, pn; };
struct Gemm { const bf16_t* A; const bf16_t* Bt; int M, N, K; };

struct StaticOrder {
    int nM, nN, nwg, G, c;
    __host__ __device__ void init(int M, int N, int G_, int c_) { nM = M / BM; nN = N / BM; nwg = nM * nN; G = G_; c = c_; }
    __host__ __device__ bool next(int i, Unit& u) const {
        const long L = (long)i * G + c; if (L >= nwg) return false;
        int wgid = (int)L; { const int q = nwg / NXCD, r = nwg % NXCD, xcd = wgid % NXCD, off = wgid / NXCD; wgid = (xcd < r ? xcd * (q + 1) : r * (q + 1) + (xcd - r) * q) + off; }
        const int nig = WGM * nN, gid = wgid / nig, fm = gid * WGM, gsz = (nM - fm) < WGM ? (nM - fm) : WGM;
        u.pm = fm + ((wgid % nig) % gsz); u.pn = (wgid % nig) / gsz; return true;
    }
    __device__ __forceinline__ void a_ready(const Unit&) const {}
    __device__ __forceinline__ void done(const Unit&) const {}
};

template <class Epi, class Sched, bool ALIGN_EPI = false, bool SP2 = false>
__device__ __forceinline__ void gemm_phase(PG8_LAS unsigned char* lds, const Gemm g, const Sched& S, const Epi& E) {
    const int tid = fresh_tid(), wid = __builtin_amdgcn_readfirstlane(tid >> 6), lane = tid & 63, wr = wid >> 2, wc = wid & 3, fr = lane & 15, fq = lane >> 4;
    const int K = g.K, nt = K / BK;
    unsigned voffA[2], voffB[2];
#pragma unroll
    for (int i = 0; i < 2; ++i) { int R, C; stage_rc(tid * 16 + i * 8192, R, C); const int Rb = Epi::PERM ? ((R & ~31) + perm32(R & 31)) : R;
        voffA[i] = (unsigned)(R * K + C) * 2u; voffB[i] = (unsigned)(Rb * K + C) * 2u; }
    const size_t kstep = (size_t)(BK * 2);
    const size_t hstep = (size_t)HALF * K * 2;
    const size_t tstep = 2 * hstep;
    const unsigned ldsw = (unsigned)wid * 1024u;
    const int aoff = lds_byte(wr * 64 + fr, fq * 8), boff = lds_byte(wc * 32 + fr, fq * 8);
#define PG8_SA(b, h) (((b) * 2 + (h)) * HTB)
#define PG8_SB(b, h) ((4 + (b) * 2 + (h)) * HTB)
#define PG8_STAGE(bufoff, gbase, voff) do { _Pragma("unroll") for (int _i = 0; _i < 2; ++_i) \
        __builtin_amdgcn_global_load_lds((const unsigned*)((const char*)(gbase) + (voff)[_i]), (PG8_LAS unsigned*)(lds + (bufoff) + ldsw + _i * 8192), 16, 0, 0); } while (0)
#define PG8_LDA(dst, b, h) do { _Pragma("unroll") for (int m = 0; m < 4; ++m) _Pragma("unroll") for (int k = 0; k < 2; ++k) dst[m][k] = *(const PG8_LAS bf16x8*)(lds + PG8_SA(b, h) + aoff + m * 2048 + k * 1024); } while (0)
#define PG8_LDB(dst, b, h) do { _Pragma("unroll") for (int n = 0; n < 2; ++n) _Pragma("unroll") for (int k = 0; k < 2; ++k) dst[n][k] = *(const PG8_LAS bf16x8*)(lds + PG8_SB(b, h) + boff + n * 2048 + k * 1024); } while (0)
#define PG8_MMA(ai, bj, At, Bt) do { __builtin_amdgcn_s_setprio(1); _Pragma("unroll") for (int m = 0; m < 4; ++m) _Pragma("unroll") for (int n = 0; n < 2; ++n) _Pragma("unroll") for (int k = 0; k < 2; ++k) \
        acc[ai][bj][m][n] = __builtin_amdgcn_mfma_f32_16x16x32_bf16(Bt[n][k], At[m][k], acc[ai][bj][m][n], 0, 0, 0); __builtin_amdgcn_s_setprio(0); } while (0)
#define PG8_WAIT_V(n) asm volatile("s_waitcnt vmcnt(" #n ")" ::: "memory")
#define PG8_WAIT_L(n) asm volatile("s_waitcnt lgkmcnt(" #n ")" ::: "memory")
#define PG8_BAR __builtin_amdgcn_s_barrier()
#define PG8_SCHED __builtin_amdgcn_sched_barrier(0)
    Unit cur, nxt; int ui = 0;
    if (!S.next(0, cur)) return;
    f32x4 acc[2][2][4][2];
#pragma unroll
    for (int a = 0; a < 2; ++a)
#pragma unroll
        for (int b = 0; b < 2; ++b)
#pragma unroll
            for (int m = 0; m < 4; ++m)
#pragma unroll
                for (int n = 0; n < 2; ++n) acc[a][b][m][n] = (f32x4){0.f, 0.f, 0.f, 0.f};
    bf16x8 At[4][2], B0[2][2], B1[2][2];
    const char* cA = (const char*)g.A + (size_t)cur.pm * tstep; const char* cB = (const char*)g.Bt + (size_t)cur.pn * tstep;
    S.a_ready(cur);
    if constexpr (SP2) {
        PG8_STAGE(PG8_SB(0, 0), cB, voffB); PG8_STAGE(PG8_SB(0, 1), cB + hstep, voffB); PG8_STAGE(PG8_SA(0, 0), cA, voffA); PG8_STAGE(PG8_SA(0, 1), cA + hstep, voffA);
        if (wr == 1) PG8_BAR;
        PG8_WAIT_V(2); PG8_BAR;
        PG8_STAGE(PG8_SB(1, 0), cB + kstep, voffB); PG8_STAGE(PG8_SA(1, 0), cA + kstep, voffA); PG8_STAGE(PG8_SB(1, 1), cB + hstep + kstep, voffB);
        PG8_WAIT_V(6); PG8_BAR;
    } else {
        PG8_STAGE(PG8_SB(0, 0), cB, voffB); PG8_STAGE(PG8_SA(0, 0), cA, voffA); PG8_STAGE(PG8_SB(0, 1), cB + hstep, voffB); PG8_STAGE(PG8_SA(0, 1), cA + hstep, voffA);
        if (wr == 1) PG8_BAR;
        PG8_WAIT_V(4); PG8_BAR;
        PG8_STAGE(PG8_SB(1, 0), cB + kstep, voffB); PG8_STAGE(PG8_SA(1, 0), cA + kstep, voffA); PG8_STAGE(PG8_SB(1, 1), cB + hstep + kstep, voffB);
        PG8_WAIT_V(6); PG8_BAR;
    }
    for (;;) {
        const bool has_next = S.next(ui + 1, nxt);
        const char* nA = has_next ? (const char*)g.A + (size_t)nxt.pm * tstep : cA; const char* nB = has_next ? (const char*)g.Bt + (size_t)nxt.pn * tstep : cB;
        for (int t = 0; t < nt; t += 2) {
            const bool last = (t == nt - 2);
            const char* a1 = cA + (size_t)(t + 1) * kstep;
            const char* a2 = last ? nA : cA + (size_t)(t + 2) * kstep; const char* b2 = last ? nB : cB + (size_t)(t + 2) * kstep;
            const char* a3 = a2 + kstep; const char* b3 = b2 + kstep;
            if (last && has_next) S.a_ready(nxt);
            if constexpr (SP2) {
            PG8_LDB(B0, 0, 0); PG8_LDB(B1, 0, 1); PG8_SCHED; PG8_LDA(At, 0, 0); PG8_STAGE(PG8_SA(1, 1), a1 + hstep, voffA);
            PG8_WAIT_V(8); PG8_WAIT_L(0); PG8_BAR; PG8_MMA(0, 0, At, B0); PG8_MMA(0, 1, At, B1); PG8_BAR; PG8_SCHED;
            PG8_LDA(At, 0, 1); PG8_STAGE(PG8_SB(0, 0), b2, voffB); PG8_STAGE(PG8_SB(0, 1), b2 + hstep, voffB); PG8_STAGE(PG8_SA(0, 0), a2, voffA);
            PG8_WAIT_V(8); PG8_WAIT_L(0); PG8_BAR; PG8_MMA(1, 0, At, B0); PG8_MMA(1, 1, At, B1); PG8_BAR; PG8_SCHED;
            PG8_LDB(B0, 1, 0); PG8_LDB(B1, 1, 1); PG8_SCHED; PG8_LDA(At, 1, 0); PG8_STAGE(PG8_SA(0, 1), a2 + hstep, voffA);
            PG8_WAIT_V(8); PG8_WAIT_L(0); PG8_BAR; PG8_MMA(0, 0, At, B0); PG8_MMA(0, 1, At, B1); PG8_BAR; PG8_SCHED;
            PG8_LDA(At, 1, 1); PG8_STAGE(PG8_SB(1, 0), b3, voffB); PG8_STAGE(PG8_SB(1, 1), b3 + hstep, voffB); PG8_STAGE(PG8_SA(1, 0), a3, voffA);
            PG8_WAIT_V(8); PG8_WAIT_L(0); PG8_BAR; PG8_MMA(1, 0, At, B0); PG8_MMA(1, 1, At, B1); PG8_BAR; PG8_SCHED;
            } else {
            PG8_LDB(B0, 0, 0); PG8_SCHED; PG8_LDA(At, 0, 0); PG8_STAGE(PG8_SA(1, 1), a1 + hstep, voffA);
            PG8_WAIT_L(8); PG8_BAR; PG8_WAIT_L(0); PG8_MMA(0, 0, At, B0); PG8_BAR; PG8_SCHED;
            PG8_LDB(B1, 0, 1); PG8_STAGE(PG8_SB(0, 0), b2, voffB);
            PG8_BAR; PG8_WAIT_L(0); PG8_MMA(0, 1, At, B1); PG8_BAR;
            PG8_LDA(At, 0, 1); PG8_STAGE(PG8_SA(0, 0), a2, voffA);
            PG8_BAR; PG8_WAIT_L(0); PG8_MMA(1, 0, At, B0); PG8_BAR; PG8_SCHED;
            PG8_STAGE(PG8_SB(0, 1), b2 + hstep, voffB);
            PG8_WAIT_V(6); PG8_BAR; PG8_MMA(1, 1, At, B1); PG8_BAR;
            PG8_LDB(B0, 1, 0); PG8_SCHED; PG8_LDA(At, 1, 0); PG8_STAGE(PG8_SA(0, 1), a2 + hstep, voffA);
            PG8_WAIT_L(8); PG8_BAR; PG8_WAIT_L(0); PG8_MMA(0, 0, At, B0); PG8_BAR; PG8_SCHED;
            PG8_LDB(B1, 1, 1); PG8_STAGE(PG8_SB(1, 0), b3, voffB);
            PG8_BAR; PG8_WAIT_L(0); PG8_MMA(0, 1, At, B1); PG8_BAR;
            PG8_LDA(At, 1, 1); PG8_STAGE(PG8_SA(1, 0), a3, voffA);
            PG8_BAR; PG8_WAIT_L(0); PG8_MMA(1, 0, At, B0); PG8_BAR; PG8_SCHED;
            PG8_STAGE(PG8_SB(1, 1), b3 + hstep, voffB);
            PG8_WAIT_V(6); PG8_BAR; PG8_MMA(1, 1, At, B1); PG8_BAR;
            }
        }
        if constexpr (ALIGN_EPI) { if (wr == 0) PG8_BAR; }
        if constexpr (!Epi::AFTER_DRAIN) { E(acc, cur, wr, wc, fr, fq); S.done(cur); }
        if (!has_next) break;
#pragma unroll
        for (int a = 0; a < 2; ++a)
#pragma unroll
            for (int b = 0; b < 2; ++b)
#pragma unroll
                for (int m = 0; m < 4; ++m)
#pragma unroll
                    for (int n = 0; n < 2; ++n) acc[a][b][m][n] = (f32x4){0.f, 0.f, 0.f, 0.f};
        cur = nxt; cA = nA; cB = nB; ++ui;
        if constexpr (ALIGN_EPI) { if (wr == 1) PG8_BAR; }
    }
    PG8_WAIT_V(0);
    if constexpr (!ALIGN_EPI) { if (wr == 0) PG8_BAR; }
    PG8_BAR;
    if constexpr (Epi::AFTER_DRAIN) { E.fused(acc, cur, wr, wc, fr, fq, lds, wid, lane); S.done(cur); }
#undef PG8_SA
#undef PG8_SB
#undef PG8_STAGE
#undef PG8_LDA
#undef PG8_LDB
#undef PG8_MMA
#undef PG8_WAIT_V
#undef PG8_WAIT_L
#undef PG8_BAR
#undef PG8_SCHED
}
}

struct InProjOut { bf16_t *QSB, *KSB, *VSB, *VTSB, *GQ, *GK, *GV, *GR; float* GLR; };

struct EpiInProj {
  static constexpr bool PERM = true, AFTER_DRAIN = false;
  InProjOut O; bf16_t* GVT; char* stage;
  DI void store_vt(const pg8::f32x4 (&acc)[2][2][4][2], const pg8::Unit& u, int wr, int wc, int fr, int fq) const {
    bf16_t* st = (bf16_t*)(stage + (wr * 4 + wc) * 1280);
    const int lane = fr + 16 * fq;
    const int rc = lane >> 2, r8 = lane & 3;
#pragma unroll
    for (int ai = 0; ai < 2; ++ai)
#pragma unroll
      for (int bj = 0; bj < 2; ++bj)
#pragma unroll
        for (int mp = 0; mp < 2; ++mp)
#pragma unroll
          for (int ch = 0; ch < 2; ++ch) {
            if ((fq >> 1) == ch) {
#pragma unroll
              for (int m2 = 0; m2 < 2; ++m2)
#pragma unroll
                for (int n = 0; n < 2; ++n) {
                  const pg8::f32x4 v = acc[ai][bj][2 * mp + m2][n];
                  const int cl = 8 * (fq & 1) + 4 * n, rl = 16 * m2 + fr;
                  st[(cl + 0) * 40 + rl] = (bf16_t)f2bf(v[0]); st[(cl + 1) * 40 + rl] = (bf16_t)f2bf(v[1]);
                  st[(cl + 2) * 40 + rl] = (bf16_t)f2bf(v[2]); st[(cl + 3) * 40 + rl] = (bf16_t)f2bf(v[3]);
                }
            }
            asm volatile("s_waitcnt lgkmcnt(0)" ::: "memory");
            const u32x4 w = *(const u32x4*)&st[rc * 40 + 8 * r8];
            asm volatile("" ::: "memory");
            const int col = u.pn * 256 + bj * 128 + wc * 32 + 16 * ch + rc;
            const int row = u.pm * 256 + ai * 128 + wr * 64 + 32 * mp + 8 * r8;
            const int b = row >> 13, i = row & 8191;
            bf16_t* dst;
            if (u.pn < 6) { const int c = col - 1024; dst = O.VTSB + ((size_t)(b * SBH + (c >> 6)) * 64 + (c & 63)) * KIDX + 32 + i; }
            else          { const int c = col - 2048; dst = GVT + ((size_t)(b * GH + (c >> 7)) * 128 + (c & 127)) * GU + 64 + i; }
            *(u32x4*)dst = w;
          }
  }
  DI void operator()(const pg8::f32x4 (&acc)[2][2][4][2], const pg8::Unit& u, int wr, int wc, int fr, int fq) const {
    const int pn = u.pn;
    if (pn == 4 || pn == 5 || pn == 8 || pn == 9) { store_vt(acc, u, wr, wc, fr, fq); return; }
#pragma unroll
    for (int ai = 0; ai < 2; ++ai)
#pragma unroll
      for (int m = 0; m < 4; ++m) {
        const int row = u.pm * 256 + ai * 128 + wr * 64 + m * 16 + fr;
        const int b = row >> 13, i = row & 8191;
#pragma unroll
        for (int bj = 0; bj < 2; ++bj) {
          const int col = pn * 256 + bj * 128 + wc * 32 + 8 * fq;
          const pg8::f32x4 v0 = acc[ai][bj][m][0], v1 = acc[ai][bj][m][1];
          if (pn < 12) {
            u32x4 w; w.x = pk2(v0[0], v0[1]); w.y = pk2(v0[2], v0[3]); w.z = pk2(v1[0], v1[1]); w.w = pk2(v1[2], v1[3]);
            bf16_t* dst;
            if (pn < 2)       { const int c = col;        dst = O.QSB + ((size_t)(b * SBH + (c >> 6)) * SEQ + i) * 64 + (c & 63); }
            else if (pn < 4)  { const int c = col - 512;  dst = O.KSB + ((size_t)(b * SBH + (c >> 6)) * KIDX + 32 + i) * 64 + (c & 63); }
            else if (pn == 6) { const int c = col - 1536; dst = O.GQ + ((size_t)(b * GH + (c >> 6)) * GU + 64 + i) * 64 + (c & 63); }
            else if (pn == 7) { const int c = col - 1792; dst = O.GK + ((size_t)(b * GH + (c >> 6)) * GU + 64 + i) * 64 + (c & 63); }
            else              { const int c = col - 2560; dst = O.GR + (size_t)row * 512 + c; }
            *(u32x4*)dst = w;
          } else if (col < NIN) {
            float* dst = O.GLR + ((size_t)b * GU + 64 + i) * 16 + (col - 3072);
            *(f32x4*)dst = (f32x4){v0[0], v0[1], v0[2], v0[3]};
            *(f32x4*)(dst + 4) = (f32x4){v1[0], v1[1], v1[2], v1[3]};
          }
        }
      }
  }
};
struct EpiOut {
  static constexpr bool PERM = true, AFTER_DRAIN = false;
  const float* x; bf16_t* H1;
  DI void operator()(const pg8::f32x4 (&acc)[2][2][4][2], const pg8::Unit& u, int wr, int wc, int fr, int fq) const {
#pragma unroll
    for (int ai = 0; ai < 2; ++ai)
#pragma unroll
      for (int m = 0; m < 4; ++m) {
        const size_t rowoff = (size_t)(u.pm * 256 + ai * 128 + wr * 64 + m * 16 + fr) * D;
#pragma unroll
        for (int bj = 0; bj < 2; ++bj) {
          const size_t idx = rowoff + u.pn * 256 + bj * 128 + wc * 32 + 8 * fq;
          const f32x4 x0 = *(const f32x4*)(x + idx), x1 = *(const f32x4*)(x + idx + 4);
          const pg8::f32x4 v0 = acc[ai][bj][m][0], v1 = acc[ai][bj][m][1];
          u32x4 w; w.x = pk2(x0.x + v0[0], x0.y + v0[1]); w.y = pk2(x0.z + v0[2], x0.w + v0[3]); w.z = pk2(x1.x + v1[0], x1.y + v1[1]); w.w = pk2(x1.z + v1[2], x1.w + v1[3]);
          *(u32x4*)(H1 + idx) = w;
        }
      }
  }
};
struct EpiPQ {
  static constexpr bool PERM = true, AFTER_DRAIN = false;
  bf16_t* QP; const float* R2;
  DI void operator()(const pg8::f32x4 (&acc)[2][2][4][2], const pg8::Unit& u, int wr, int wc, int fr, int fq) const {
#pragma unroll
    for (int ai = 0; ai < 2; ++ai)
#pragma unroll
      for (int m = 0; m < 4; ++m) {
        const int row = u.pm * 256 + ai * 128 + wr * 64 + m * 16 + fr;
        const float r = R2[row];
        const size_t rowoff = (size_t)row * D;
#pragma unroll
        for (int bj = 0; bj < 2; ++bj) {
          const pg8::f32x4 v0 = acc[ai][bj][m][0], v1 = acc[ai][bj][m][1];
          u32x4 w; w.x = pk2(v0[0] * r, v0[1] * r); w.y = pk2(v0[2] * r, v0[3] * r); w.z = pk2(v1[0] * r, v1[1] * r); w.w = pk2(v1[2] * r, v1[3] * r);
          *(u32x4*)(QP + rowoff + u.pn * 256 + bj * 128 + wc * 32 + 8 * fq) = w;
        }
      }
  }
};

DI void ph_meta(int blk, char* smem, const float* __restrict__ meta, const float* __restrict__ g1, const float* __restrict__ w_in, const InProjOut& O) {
  float (*xmT)[16] = (float (*)[16])smem;
  float (*red)[256] = (float (*)[256])(smem + 65536);
  const int tid = fresh_tid(), lane = tid & 63, wave = tid >> 6;
  for (int rr = 0; rr < 2; ++rr) {
    const int mm = wave * 2 + rr;
    float v[16]; float ss = 0.f;
#pragma unroll
    for (int j = 0; j < 16; ++j) { v[j] = meta[(size_t)mm * D + j * 64 + lane]; ss += v[j] * v[j]; }
    ss = wave_sum(ss);
    const float r = rsqrtf(ss * (1.0f / D) + EPS);
#pragma unroll
    for (int j = 0; j < 16; ++j) xmT[j * 64 + lane][mm] = v[j] * r * g1[j * 64 + lane];
  }
  __syncthreads();
  {
    const int c = tid & 15, ks = tid >> 4, n = blk * 16 + c;
    float acc[16];
#pragma unroll
    for (int j = 0; j < 16; ++j) acc[j] = 0.f;
#pragma unroll 8
    for (int kk = 0; kk < 32; ++kk) {
      const int k = ks * 32 + kk;
      const float w = w_in[(size_t)k * NIN + n];
      const f32x4 a = *(const f32x4*)&xmT[k][0], b4 = *(const f32x4*)&xmT[k][4], c4 = *(const f32x4*)&xmT[k][8], d4 = *(const f32x4*)&xmT[k][12];
      acc[0] += a.x * w; acc[1] += a.y * w; acc[2] += a.z * w; acc[3] += a.w * w;
      acc[4] += b4.x * w; acc[5] += b4.y * w; acc[6] += b4.z * w; acc[7] += b4.w * w;
      acc[8] += c4.x * w; acc[9] += c4.y * w; acc[10] += c4.z * w; acc[11] += c4.w * w;
      acc[12] += d4.x * w; acc[13] += d4.y * w; acc[14] += d4.z * w; acc[15] += d4.w * w;
    }
#pragma unroll
    for (int mm = 0; mm < 16; ++mm) red[ks][c * 16 + mm] = acc[mm];
  }
  __syncthreads();
  if (tid < 256) {
    const int c = tid >> 4, mm = tid & 15, n = blk * 16 + c;
    float val = 0.f;
#pragma unroll 8
    for (int ks = 0; ks < 32; ++ks) val += red[ks][tid];
    const bf16_t hv = (bf16_t)f2bf(val);
    for (int bb = 0; bb < NB; ++bb) {
      if (n < 512) {}
      else if (n < 1024) { const int cc = n - 512;  O.KSB[((size_t)(bb * SBH + (cc >> 6)) * KIDX + 16 + mm) * 64 + (cc & 63)] = hv; }
      else if (n < 1536) { const int cc = n - 1024; O.VTSB[((size_t)(bb * SBH + (cc >> 6)) * 64 + (cc & 63)) * KIDX + 16 + mm] = hv; }
      else if (n < 1792) { const int cc = n - 1536; O.GQ[((size_t)(bb * GH + (cc >> 6)) * GU + 48 + mm) * 64 + (cc & 63)] = hv; }
      else if (n < 2048) { const int cc = n - 1792; O.GK[((size_t)(bb * GH + (cc >> 6)) * GU + 48 + mm) * 64 + (cc & 63)] = hv; }
      else if (n < 2560) { const int cc = n - 2048; O.GV[((size_t)(bb * GH + (cc >> 7)) * 128 + (cc & 127)) * GU + 48 + mm] = hv; }
      else if (n < 3072) {}
      else { O.GLR[((size_t)bb * GU + 48 + mm) * 16 + (n - 3072)] = val; }
    }
  }
  __syncthreads();
}


constexpr float SB_THR = 1.17549435e-38f;
DI void ph_sb_attn(int vb, const bf16_t* __restrict__ QSB, const bf16_t* __restrict__ KSB, const bf16_t* __restrict__ VTSB,
                                                 const float* __restrict__ sb_g, bf16_t* __restrict__ MIX) {
  const int tid256_ = fresh_tid() & 255;
  const int lane = TID & 63, wave = TID >> 6, r = lane & 31, h = lane >> 5;
  const int bh = vb >> 6, qb = vb & 63;
  const int b = bh >> 3, hd = bh & 7;
  const int i0 = qb * 128 + wave * 32;
  const bf16_t* Qb = QSB + ((size_t)bh * SEQ + i0) * 64;
  const bf16_t* Kb = KSB + (size_t)bh * KIDX * 64;
  const bf16_t* Vb = VTSB + (size_t)bh * 64 * KIDX;
  bf16x8 qf[4];
#pragma unroll
  for (int ks = 0; ks < 4; ++ks) qf[ks] = *(const bf16x8*)(Qb + r * 64 + ks * 16 + h * 8);
  f32x16 o[2];
#pragma unroll
  for (int e = 0; e < 16; ++e) { o[0][e] = 0.f; o[1][e] = 0.f; }
  float R = 1.f;
  const int qidx = 32 + i0 + r;
  for (int c = (i0 >> 5) + 1; c >= 0; --c) {
    const int k0 = 32 * c;
    bf16x8 kf[4];
#pragma unroll
    for (int ks = 0; ks < 4; ++ks) kf[ks] = *(const bf16x8*)(Kb + (size_t)(k0 + r) * 64 + ks * 16 + h * 8);
    bf16x8 vf[2][2];
#pragma unroll
    for (int mt = 0; mt < 2; ++mt)
#pragma unroll
      for (int s2 = 0; s2 < 2; ++s2) {
        const bf16_t* vp = Vb + (size_t)(mt * 32 + r) * KIDX + k0 + 16 * s2 + 4 * h;
        const u32x2 lo = *(const u32x2*)vp, hi = *(const u32x2*)(vp + 8);
        u32x4 t; t.x = lo.x; t.y = lo.y; t.z = hi.x; t.w = hi.y;
        vf[mt][s2] = __builtin_bit_cast(bf16x8, t);
      }
    f32x16 s;
#pragma unroll
    for (int e = 0; e < 16; ++e) s[e] = 0.f;
#pragma unroll
    for (int ks = 0; ks < 4; ++ks) s = MFMA32(kf[ks], qf[ks], s);
    float om[16], bt[16];
#pragma unroll
    for (int e = 0; e < 16; ++e) {
      const int kidx = k0 + crow(e, h);
      const bool valid = (kidx < qidx) && (kidx >= 16);
      const float z = s[e] * 0.125f;
      const float ez = __expf(-fabsf(z));
      const float big = __builtin_amdgcn_rcpf(1.f + ez), small = ez * big;
      const float beta = z >= 0.f ? big : small, onem = z >= 0.f ? small : big;
      om[e] = valid ? onem : 1.f;
      bt[e] = valid ? beta : 0.f;
    }
    float sfx[16], G[4], PG[4];
#pragma unroll
    for (int g = 0; g < 4; ++g) {
      sfx[4 * g + 3] = 1.f;
      sfx[4 * g + 2] = om[4 * g + 3];
      sfx[4 * g + 1] = sfx[4 * g + 2] * om[4 * g + 2];
      sfx[4 * g + 0] = sfx[4 * g + 1] * om[4 * g + 1];
      G[g] = sfx[4 * g + 0] * om[4 * g + 0];
      PG[g] = __shfl_xor(G[g], 32);
    }
    float HS[4];
    HS[3] = 1.f;
    HS[2] = G[3] * PG[3];
    HS[1] = HS[2] * (G[2] * PG[2]);
    HS[0] = HS[1] * (G[1] * PG[1]);
    const float total = HS[0] * (G[0] * PG[0]);
    float a[16];
#pragma unroll
    for (int e = 0; e < 16; ++e) {
      const int g = e >> 2;
      const float between = sfx[e] * (h == 0 ? PG[g] : 1.f) * (HS[g] * R);
      a[e] = bt[e] * between;
    }
    R *= total;
#pragma unroll
    for (int s2 = 0; s2 < 2; ++s2) {
      u32x4 p;
      p.x = pk2(a[8 * s2 + 0], a[8 * s2 + 1]); p.y = pk2(a[8 * s2 + 2], a[8 * s2 + 3]);
      p.z = pk2(a[8 * s2 + 4], a[8 * s2 + 5]); p.w = pk2(a[8 * s2 + 6], a[8 * s2 + 7]);
      const bf16x8 pf = __builtin_bit_cast(bf16x8, p);
      o[0] = MFMA32(vf[0][s2], pf, o[0]);
      o[1] = MFMA32(vf[1][s2], pf, o[1]);
    }
    if (__all(R < SB_THR)) break;
  }
  float ss = 0.f;
#pragma unroll
  for (int e = 0; e < 16; ++e) ss += o[0][e] * o[0][e] + o[1][e] * o[1][e];
  ss += __shfl_xor(ss, 32);
  const float sc = rsqrtf(ss * (1.0f / 64.0f) + EPS);
  bf16_t* outp = MIX + (size_t)(b * SEQ + i0 + r) * D + hd * 64;
#pragma unroll
  for (int mt = 0; mt < 2; ++mt)
#pragma unroll
    for (int g = 0; g < 4; ++g) {
      const int d = mt * 32 + 8 * g + 4 * h;
      const f32x4 gg = *(const f32x4*)(sb_g + hd * 64 + d);
      u32x2 pk;
      pk.x = pk2(o[mt][4 * g] * sc * gg.x, o[mt][4 * g + 1] * sc * gg.y);
      pk.y = pk2(o[mt][4 * g + 2] * sc * gg.z, o[mt][4 * g + 3] * sc * gg.w);
      *(u32x2*)(outp + d) = pk;
    }
}


constexpr int RT_TOK_PER_BLOCK = 256;


#define MFMA16(a, b, c) __builtin_amdgcn_mfma_f32_16x16x32_bf16((a), (b), (c), 0, 0, 0)
constexpr int GLDS = 72;
struct GlaLds {
  bf16_t Qt[64 * GLDS];
  bf16_t Kt[64 * GLDS];
  bf16_t KT[64 * GLDS];
  bf16_t P[64 * GLDS];
  float dec[64];
  float tot[8][64];
  float ssq[8][64];
};
constexpr size_t WS_SLOC = 926 * MiB;
constexpr size_t WS_DTOT = 942 * MiB;
constexpr size_t WS_GVT = 604 * MiB;

struct GlaPtrs { const bf16_t *GQ, *GK, *GVT, *GR; const float *GLR, *wg, *bg, *gla_g; float *SLOC, *DTOT; bf16_t* MIX; };


constexpr size_t WS_GQT = 80 * MiB;
constexpr size_t WS_GKT = 113 * MiB;
constexpr size_t WS_GKTT = 146 * MiB;
constexpr size_t WS_GDEC = 179 * MiB;
constexpr size_t WS_GBL = 182 * MiB;
struct GlaPrepPtrs { const bf16_t *GQ, *GK; const float *GLR, *wg, *bg; bf16_t *QT, *KT, *KTT; float *DEC, *BL; };
DI void ph_gla_prep(int item, char* smem, const GlaPrepPtrs& G) {
  float (*tot)[64] = (float (*)[64])smem;
  const int tid = fresh_tid(), lane = tid & 63, w = tid >> 6;
  const int bh = item / 129, c = item % 129, b = bh >> 2, hd = bh & 3, u0 = 64 * c;
  float wgr[16];
#pragma unroll
  for (int k = 0; k < 16; ++k) wgr[k] = G.wg[k * 256 + hd * 64 + lane];
  const float bgv = G.bg[hd * 64 + lane];
  float cs[8]; float run = 0.f;
  unsigned short kraw[8], qraw[8];
#pragma unroll
  for (int i = 0; i < 8; ++i) {
    const int u = u0 + 8 * w + i;
    kraw[i] = G.GK[((size_t)bh * GU + u) * 64 + lane];
    qraw[i] = G.GQ[((size_t)bh * GU + u) * 64 + lane];
    float lgv = 0.f;
    if (u >= 48) {
      const f32x4* gp = (const f32x4*)(G.GLR + ((size_t)b * GU + u) * 16);
      const f32x4 g0 = gp[0], g1 = gp[1], g2 = gp[2], g3 = gp[3];
      float a = bgv;
      a += g0.x * wgr[0] + g0.y * wgr[1] + g0.z * wgr[2] + g0.w * wgr[3];
      a += g1.x * wgr[4] + g1.y * wgr[5] + g1.z * wgr[6] + g1.w * wgr[7];
      a += g2.x * wgr[8] + g2.y * wgr[9] + g2.z * wgr[10] + g2.w * wgr[11];
      a += g3.x * wgr[12] + g3.y * wgr[13] + g3.z * wgr[14] + g3.w * wgr[15];
      lgv = -softplus(-a) * (1.0f / 16.0f);
    }
    run += lgv; cs[i] = run;
  }
  tot[w][lane] = run;
  __syncthreads();
  float offset = 0.f, total = 0.f;
#pragma unroll
  for (int s2 = 0; s2 < 8; ++s2) { const float tv = tot[s2][lane]; total += tv; if (s2 < w) offset += tv; }
  const size_t cb = ((size_t)bh * 129 + c) * 4096;
  float kt[8];
#pragma unroll
  for (int i = 0; i < 8; ++i) {
    const float bc = offset + cs[i];
    kt[i] = bf2f(kraw[i]) * __expf(-bc);
    G.QT[cb + (8 * w + i) * 64 + lane] = (bf16_t)f2bf(bf2f(qraw[i]) * __expf(bc) * 0.125f);
    G.KT[cb + (8 * w + i) * 64 + lane] = (bf16_t)f2bf(kt[i]);
  }
  u32x4 kp; kp.x = pk2(kt[0], kt[1]); kp.y = pk2(kt[2], kt[3]); kp.z = pk2(kt[4], kt[5]); kp.w = pk2(kt[6], kt[7]);
  *(u32x4*)(G.KTT + cb + lane * 64 + 8 * w) = kp;
  if (w == 0) { G.DEC[((size_t)bh * 129 + c) * 64 + lane] = __expf(total); G.BL[((size_t)bh * 129 + c) * 64 + lane] = total; }
  __syncthreads();
}

struct GlaBuf { bf16_t Qt[64 * GLDS]; bf16_t Kt[64 * GLDS]; bf16_t KT[64 * GLDS]; };
struct GlaLds3 { GlaBuf B[2]; bf16_t P[64 * GLDS]; float ssq[8][64]; };
struct GlaPtrs3 { const bf16_t *QT, *KT, *KTT, *GVT, *GR; const float *DEC, *BL, *gla_g; float *SLOC, *DTOT; bf16_t* MIX; };

template <int PASS>
DI void gla_item3(int bh, int sc, char* smem, const GlaPtrs3& G) {
  GlaLds3& L = *(GlaLds3*)smem;
  const int tid = fresh_tid(), lane = tid & 63, w = __builtin_amdgcn_readfirstlane(tid >> 6), c16 = lane & 15, q = lane >> 4;
  const int b = bh >> 2, hd = bh & 3;
  const int cbeg = sc == 0 ? 0 : 8 * sc + 1, cend = 8 * sc + 9;
  f32x4 X[4];
#pragma unroll
  for (int i = 0; i < 4; ++i) X[i] = (f32x4){0.f, 0.f, 0.f, 0.f};
  if (PASS == 1) {
#pragma unroll 4
    for (int j = 0; j < sc; ++j) {
      const float* dt = G.DTOT + (size_t)(bh * 16 + j) * 64;
      const float* sl = G.SLOC + ((size_t)(bh * 16 + j) * 8 + w) * 16 * 64 + lane;
#pragma unroll
      for (int i = 0; i < 4; ++i) {
        const f32x4 d4 = *(const f32x4*)(dt + 16 * i + 4 * q);
        X[i][0] = d4.x * X[i][0] + sl[(4 * i + 0) * 64]; X[i][1] = d4.y * X[i][1] + sl[(4 * i + 1) * 64];
        X[i][2] = d4.z * X[i][2] + sl[(4 * i + 2) * 64]; X[i][3] = d4.w * X[i][3] + sl[(4 * i + 3) * 64];
      }
    }
  }
  f32x4 gain = {1.f, 1.f, 1.f, 1.f};
  if (PASS == 1) gain = *(const f32x4*)(G.gla_g + hd * 128 + 16 * w + 4 * q);
  const bf16_t* gvt = G.GVT + ((size_t)bh * 128 + 16 * w + c16) * GU + 8 * q;
  const int srow = tid >> 3, sc8 = tid & 7, soff = srow * GLDS + sc8 * 8;
  const size_t cb0 = (size_t)bh * 129 * 4096 + (size_t)srow * 64 + sc8 * 8;
  u32x4 rq, rk, rkt, rq2, rk2, rkt2; bf16x8 vfr[2], vfn[2], vfn2[2]; f32x4 dec[4], decn[4], decn2[4];
  {
    const size_t cb = cb0 + (size_t)cbeg * 4096;
    rkt = *(const u32x4*)(G.KTT + cb);
    if (PASS == 1) { rq = *(const u32x4*)(G.QT + cb); rk = *(const u32x4*)(G.KT + cb); }
    vfr[0] = *(const bf16x8*)(gvt + 64 * cbeg); vfr[1] = *(const bf16x8*)(gvt + 64 * cbeg + 32);
#pragma unroll
    for (int i = 0; i < 4; ++i) dec[i] = *(const f32x4*)(G.DEC + ((size_t)bh * 129 + cbeg) * 64 + 16 * i + 4 * q);
    *(u32x4*)&L.B[0].KT[soff] = rkt;
    if (PASS == 1) { *(u32x4*)&L.B[0].Qt[soff] = rq; *(u32x4*)&L.B[0].Kt[soff] = rk; }
    const size_t cb1 = cb0 + (size_t)(cbeg + 1) * 4096;
    rkt = *(const u32x4*)(G.KTT + cb1);
    if (PASS == 1) { rq = *(const u32x4*)(G.QT + cb1); rk = *(const u32x4*)(G.KT + cb1); }
    vfn[0] = *(const bf16x8*)(gvt + 64 * (cbeg + 1)); vfn[1] = *(const bf16x8*)(gvt + 64 * (cbeg + 1) + 32);
#pragma unroll
    for (int i = 0; i < 4; ++i) decn[i] = *(const f32x4*)(G.DEC + ((size_t)bh * 129 + cbeg + 1) * 64 + 16 * i + 4 * q);
  }
  __syncthreads();
  for (int c = cbeg; c < cend; ++c) {
    const int cur = (c - cbeg) & 1;
    const GlaBuf& Bc = L.B[cur];
    const bool more = c + 1 < cend, more2 = c + 2 < cend;
    if (more2) {
      const size_t cb = cb0 + (size_t)(c + 2) * 4096;
      rkt2 = *(const u32x4*)(G.KTT + cb);
      if (PASS == 1) { rq2 = *(const u32x4*)(G.QT + cb); rk2 = *(const u32x4*)(G.KT + cb); }
      vfn2[0] = *(const bf16x8*)(gvt + 64 * (c + 2)); vfn2[1] = *(const bf16x8*)(gvt + 64 * (c + 2) + 32);
#pragma unroll
      for (int i = 0; i < 4; ++i) decn2[i] = *(const f32x4*)(G.DEC + ((size_t)bh * 129 + c + 2) * 64 + 16 * i + 4 * q);
    }
    u32x2 grv[4];
    if (PASS == 1 && c >= 1) {
#pragma unroll
      for (int n = 0; n < 4; ++n) grv[n] = *(const u32x2*)(G.GR + ((size_t)b * SEQ + 64 * (c - 1) + 16 * n + c16) * 512 + hd * 128 + 16 * w + 4 * q);
    }
    f32x4 OT[4];
    if (PASS == 1) {
      const int is = w >> 1;
#pragma unroll
      for (int z = 0; z < 2; ++z) {
        const int it = 2 * (w & 1) + z;
        f32x4 pa = {0.f, 0.f, 0.f, 0.f};
        if (is <= it) {
#pragma unroll
          for (int kk = 0; kk < 2; ++kk) {
            const bf16x8 ka = *(const bf16x8*)&Bc.Kt[(16 * is + c16) * GLDS + 32 * kk + 8 * q];
            const bf16x8 qb = *(const bf16x8*)&Bc.Qt[(16 * it + c16) * GLDS + 32 * kk + 8 * q];
            pa = MFMA16(ka, qb, pa);
          }
          if (is == it) {
#pragma unroll
            for (int r = 0; r < 4; ++r) if (4 * q + r > c16) pa[r] = 0.f;
          }
        }
        u32x2 pw; pw.x = pk2(pa[0], pa[1]); pw.y = pk2(pa[2], pa[3]);
        *(u32x2*)&L.P[(16 * it + c16) * GLDS + 16 * is + 4 * q] = pw;
      }
#pragma unroll
      for (int n = 0; n < 4; ++n) OT[n] = (f32x4){0.f, 0.f, 0.f, 0.f};
#pragma unroll
      for (int kk = 0; kk < 2; ++kk) {
        u32x4 xp; xp.x = pk2(X[2 * kk][0], X[2 * kk][1]); xp.y = pk2(X[2 * kk][2], X[2 * kk][3]);
        xp.z = pk2(X[2 * kk + 1][0], X[2 * kk + 1][1]); xp.w = pk2(X[2 * kk + 1][2], X[2 * kk + 1][3]);
        const bf16x8 xa = __builtin_bit_cast(bf16x8, xp);
#pragma unroll
        for (int n = 0; n < 4; ++n) {
          const u32x2 lo = *(const u32x2*)&Bc.Qt[(16 * n + c16) * GLDS + 32 * kk + 4 * q];
          const u32x2 hi = *(const u32x2*)&Bc.Qt[(16 * n + c16) * GLDS + 32 * kk + 16 + 4 * q];
          u32x4 qq; qq.x = lo.x; qq.y = lo.y; qq.z = hi.x; qq.w = hi.y;
          OT[n] = MFMA16(xa, __builtin_bit_cast(bf16x8, qq), OT[n]);
        }
      }
      __syncthreads();
#pragma unroll
      for (int kk = 0; kk < 2; ++kk)
#pragma unroll
        for (int n = 0; n < 4; ++n) {
          const bf16x8 pb = *(const bf16x8*)&L.P[(16 * n + c16) * GLDS + 32 * kk + 8 * q];
          OT[n] = MFMA16(vfr[kk], pb, OT[n]);
        }
    }
#pragma unroll
    for (int i = 0; i < 4; ++i) {
#pragma unroll
      for (int kk = 0; kk < 2; ++kk) {
        const bf16x8 ka = *(const bf16x8*)&Bc.KT[(16 * i + c16) * GLDS + 32 * kk + 8 * q];
        X[i] = MFMA16(ka, vfr[kk], X[i]);
      }
      X[i][0] *= dec[i].x; X[i][1] *= dec[i].y; X[i][2] *= dec[i].z; X[i][3] *= dec[i].w;
    }
    if (PASS == 1 && c >= 1) {
      float ss[4];
#pragma unroll
      for (int n = 0; n < 4; ++n) {
        float v = OT[n][0] * OT[n][0] + OT[n][1] * OT[n][1] + OT[n][2] * OT[n][2] + OT[n][3] * OT[n][3];
        v += __shfl_xor(v, 16); v += __shfl_xor(v, 32);
        ss[n] = v;
      }
      if (q == 0) {
#pragma unroll
        for (int n = 0; n < 4; ++n) L.ssq[w][16 * n + c16] = ss[n];
      }
      __syncthreads();
#pragma unroll
      for (int n = 0; n < 4; ++n) {
        float tot = 0.f;
#pragma unroll
        for (int w2 = 0; w2 < 8; ++w2) tot += L.ssq[w2][16 * n + c16];
        const float scl = rsqrtf(tot * (1.0f / 128.0f) + EPS);
        const size_t m = (size_t)b * SEQ + 64 * (c - 1) + 16 * n + c16;
        const float r0 = bflo(grv[n].x), r1 = bfhi(grv[n].x), r2 = bflo(grv[n].y), r3 = bfhi(grv[n].y);
        const float o0 = OT[n][0] * scl * gain.x * (r0 / (1.f + __expf(-r0)));
        const float o1 = OT[n][1] * scl * gain.y * (r1 / (1.f + __expf(-r1)));
        const float o2 = OT[n][2] * scl * gain.z * (r2 / (1.f + __expf(-r2)));
        const float o3 = OT[n][3] * scl * gain.w * (r3 / (1.f + __expf(-r3)));
        u32x2 ow; ow.x = pk2(o0, o1); ow.y = pk2(o2, o3);
        *(u32x2*)(G.MIX + m * D + 512 + hd * 128 + 16 * w + 4 * q) = ow;
      }
    }
    if (more) {
      GlaBuf& Bn = L.B[cur ^ 1];
      *(u32x4*)&Bn.KT[soff] = rkt;
      if (PASS == 1) { *(u32x4*)&Bn.Qt[soff] = rq; *(u32x4*)&Bn.Kt[soff] = rk; }
      vfr[0] = vfn[0]; vfr[1] = vfn[1];
#pragma unroll
      for (int i = 0; i < 4; ++i) dec[i] = decn[i];
      rkt = rkt2; rq = rq2; rk = rk2; vfn[0] = vfn2[0]; vfn[1] = vfn2[1];
#pragma unroll
      for (int i = 0; i < 4; ++i) decn[i] = decn2[i];
    }
    __syncthreads();
  }
  if (PASS == 0) {
    float* sl = G.SLOC + ((size_t)(bh * 16 + sc) * 8 + w) * 16 * 64 + lane;
#pragma unroll
    for (int i = 0; i < 4; ++i)
#pragma unroll
      for (int r = 0; r < 4; ++r) sl[(4 * i + r) * 64] = X[i][r];
    if (w == 0) {
      float bl = 0.f;
      for (int c = cbeg; c < cend; ++c) bl += G.BL[((size_t)bh * 129 + c) * 64 + lane];
      G.DTOT[(size_t)(bh * 16 + sc) * 64 + lane] = __expf(bl);
    }
  }
}


struct GlaLds4 { GlaBuf B[2]; bf16_t P[64 * GLDS]; float ssq[4][64]; };
template <int PASS>
DI void gla_item4(int bh_lo, int sc, char* smem, const GlaPtrs3& G) {
  const int tid = fresh_tid(), lane = tid & 63, w = __builtin_amdgcn_readfirstlane(tid >> 6), c16 = lane & 15, q = lane >> 4;
  const int hb = w >> 2, w4 = w & 3, tid4 = tid & 255;
  GlaLds4& L = *(GlaLds4*)(smem + hb * (int)sizeof(GlaLds4));
  const int bh = bh_lo + 16 * hb, b = bh >> 2, hd = bh & 3;
  const int cbeg = sc == 0 ? 0 : 8 * sc + 1, cend = 8 * sc + 9;
  f32x4 X[2][4];
#pragma unroll
  for (int et = 0; et < 2; ++et)
#pragma unroll
    for (int i = 0; i < 4; ++i) X[et][i] = (f32x4){0.f, 0.f, 0.f, 0.f};
  if (PASS == 1) {
#pragma unroll 2
    for (int j = 0; j < sc; ++j) {
      const float* dt = G.DTOT + (size_t)(bh * 16 + j) * 64;
#pragma unroll
      for (int et = 0; et < 2; ++et) {
        const float* sl = G.SLOC + ((size_t)(bh * 16 + j) * 8 + w4 * 2 + et) * 16 * 64 + lane;
#pragma unroll
        for (int i = 0; i < 4; ++i) {
          const f32x4 d4 = *(const f32x4*)(dt + 16 * i + 4 * q);
          X[et][i][0] = d4.x * X[et][i][0] + sl[(4 * i + 0) * 64]; X[et][i][1] = d4.y * X[et][i][1] + sl[(4 * i + 1) * 64];
          X[et][i][2] = d4.z * X[et][i][2] + sl[(4 * i + 2) * 64]; X[et][i][3] = d4.w * X[et][i][3] + sl[(4 * i + 3) * 64];
        }
      }
    }
  }
  f32x4 gain[2];
#pragma unroll
  for (int et = 0; et < 2; ++et) gain[et] = PASS == 1 ? *(const f32x4*)(G.gla_g + hd * 128 + 32 * w4 + 16 * et + 4 * q) : (f32x4){1.f, 1.f, 1.f, 1.f};
  const bf16_t* gvt0 = G.GVT + ((size_t)bh * 128 + 32 * w4 + c16) * GU + 8 * q;
  const bf16_t* gvt1 = gvt0 + (size_t)16 * GU;
  const int soffA = (tid4 >> 3) * GLDS + (tid4 & 7) * 8, soffB = soffA + 32 * GLDS;
  const size_t cb0 = (size_t)bh * 129 * 4096 + (size_t)(tid4 >> 3) * 64 + (tid4 & 7) * 8;
  u32x4 rq[2], rk[2], rkt[2], rq2[2], rk2[2], rkt2[2];
  bf16x8 vfr[2][2], vfn[2][2]; f32x4 dec[4], decn[4];
#define G4_LOADT(rq_, rk_, rkt_, c_) { const size_t cb_ = cb0 + (size_t)(c_) * 4096; \
    rkt_[0] = *(const u32x4*)(G.KTT + cb_); rkt_[1] = *(const u32x4*)(G.KTT + cb_ + 2048); \
    if (PASS == 1) { rq_[0] = *(const u32x4*)(G.QT + cb_); rq_[1] = *(const u32x4*)(G.QT + cb_ + 2048); rk_[0] = *(const u32x4*)(G.KT + cb_); rk_[1] = *(const u32x4*)(G.KT + cb_ + 2048); } }
#define G4_LOADV(vf_, dc_, c_) { vf_[0][0] = *(const bf16x8*)(gvt0 + 64 * (c_)); vf_[0][1] = *(const bf16x8*)(gvt0 + 64 * (c_) + 32); \
    vf_[1][0] = *(const bf16x8*)(gvt1 + 64 * (c_)); vf_[1][1] = *(const bf16x8*)(gvt1 + 64 * (c_) + 32); \
    _Pragma("unroll") for (int i = 0; i < 4; ++i) dc_[i] = *(const f32x4*)(G.DEC + ((size_t)bh * 129 + (c_)) * 64 + 16 * i + 4 * q); }
#define G4_STORET(Bn_, rq_, rk_, rkt_) { *(u32x4*)&Bn_.KT[soffA] = rkt_[0]; *(u32x4*)&Bn_.KT[soffB] = rkt_[1]; \
    if (PASS == 1) { *(u32x4*)&Bn_.Qt[soffA] = rq_[0]; *(u32x4*)&Bn_.Qt[soffB] = rq_[1]; *(u32x4*)&Bn_.Kt[soffA] = rk_[0]; *(u32x4*)&Bn_.Kt[soffB] = rk_[1]; } }
  G4_LOADT(rq, rk, rkt, cbeg)
  G4_LOADV(vfr, dec, cbeg)
  G4_STORET(L.B[0], rq, rk, rkt)
  G4_LOADT(rq, rk, rkt, cbeg + 1)
  G4_LOADV(vfn, decn, cbeg + 1)
  __syncthreads();
  for (int c = cbeg; c < cend; ++c) {
    const int cur = (c - cbeg) & 1;
    const GlaBuf& Bc = L.B[cur];
    const bool more = c + 1 < cend, more2 = c + 2 < cend;
    if (more2) G4_LOADT(rq2, rk2, rkt2, c + 2)
    u32x2 grv[2][4];
    if (PASS == 1 && c >= 1) {
#pragma unroll
      for (int et = 0; et < 2; ++et)
#pragma unroll
        for (int n = 0; n < 4; ++n) grv[et][n] = *(const u32x2*)(G.GR + ((size_t)b * SEQ + 64 * (c - 1) + 16 * n + c16) * 512 + hd * 128 + 32 * w4 + 16 * et + 4 * q);
    }
    f32x4 OT[2][4];
    if (PASS == 1) {
      const int is = w4;
#pragma unroll
      for (int it = 0; it < 4; ++it) {
        f32x4 pa = {0.f, 0.f, 0.f, 0.f};
        if (is <= it) {
#pragma unroll
          for (int kk = 0; kk < 2; ++kk) {
            const bf16x8 ka = *(const bf16x8*)&Bc.Kt[(16 * is + c16) * GLDS + 32 * kk + 8 * q];
            const bf16x8 qb = *(const bf16x8*)&Bc.Qt[(16 * it + c16) * GLDS + 32 * kk + 8 * q];
            pa = MFMA16(ka, qb, pa);
          }
          if (is == it) {
#pragma unroll
            for (int r = 0; r < 4; ++r) if (4 * q + r > c16) pa[r] = 0.f;
          }
        }
        u32x2 pw; pw.x = pk2(pa[0], pa[1]); pw.y = pk2(pa[2], pa[3]);
        *(u32x2*)&L.P[(16 * it + c16) * GLDS + 16 * is + 4 * q] = pw;
      }
#pragma unroll
      for (int et = 0; et < 2; ++et)
#pragma unroll
        for (int n = 0; n < 4; ++n) OT[et][n] = (f32x4){0.f, 0.f, 0.f, 0.f};
#pragma unroll
      for (int kk = 0; kk < 2; ++kk) {
        bf16x8 xa[2];
#pragma unroll
        for (int et = 0; et < 2; ++et) {
          u32x4 xp; xp.x = pk2(X[et][2 * kk][0], X[et][2 * kk][1]); xp.y = pk2(X[et][2 * kk][2], X[et][2 * kk][3]);
          xp.z = pk2(X[et][2 * kk + 1][0], X[et][2 * kk + 1][1]); xp.w = pk2(X[et][2 * kk + 1][2], X[et][2 * kk + 1][3]);
          xa[et] = __builtin_bit_cast(bf16x8, xp);
        }
#pragma unroll
        for (int n = 0; n < 4; ++n) {
          const u32x2 lo = *(const u32x2*)&Bc.Qt[(16 * n + c16) * GLDS + 32 * kk + 4 * q];
          const u32x2 hi = *(const u32x2*)&Bc.Qt[(16 * n + c16) * GLDS + 32 * kk + 16 + 4 * q];
          u32x4 qq; qq.x = lo.x; qq.y = lo.y; qq.z = hi.x; qq.w = hi.y;
          const bf16x8 qf = __builtin_bit_cast(bf16x8, qq);
          OT[0][n] = MFMA16(xa[0], qf, OT[0][n]);
          OT[1][n] = MFMA16(xa[1], qf, OT[1][n]);
        }
      }
      __syncthreads();
#pragma unroll
      for (int kk = 0; kk < 2; ++kk)
#pragma unroll
        for (int n = 0; n < 4; ++n) {
          const bf16x8 pb = *(const bf16x8*)&L.P[(16 * n + c16) * GLDS + 32 * kk + 8 * q];
          OT[0][n] = MFMA16(vfr[0][kk], pb, OT[0][n]);
          OT[1][n] = MFMA16(vfr[1][kk], pb, OT[1][n]);
        }
    }
#pragma unroll
    for (int i = 0; i < 4; ++i) {
#pragma unroll
      for (int kk = 0; kk < 2; ++kk) {
        const bf16x8 ka = *(const bf16x8*)&Bc.KT[(16 * i + c16) * GLDS + 32 * kk + 8 * q];
        X[0][i] = MFMA16(ka, vfr[0][kk], X[0][i]);
        X[1][i] = MFMA16(ka, vfr[1][kk], X[1][i]);
      }
#pragma unroll
      for (int et = 0; et < 2; ++et) { X[et][i][0] *= dec[i].x; X[et][i][1] *= dec[i].y; X[et][i][2] *= dec[i].z; X[et][i][3] *= dec[i].w; }
    }
    if (PASS == 1 && c >= 1) {
      float ss[4];
#pragma unroll
      for (int n = 0; n < 4; ++n) {
        float v = OT[0][n][0] * OT[0][n][0] + OT[0][n][1] * OT[0][n][1] + OT[0][n][2] * OT[0][n][2] + OT[0][n][3] * OT[0][n][3]
                + OT[1][n][0] * OT[1][n][0] + OT[1][n][1] * OT[1][n][1] + OT[1][n][2] * OT[1][n][2] + OT[1][n][3] * OT[1][n][3];
        v += __shfl_xor(v, 16); v += __shfl_xor(v, 32);
        ss[n] = v;
      }
      if (q == 0) {
#pragma unroll
        for (int n = 0; n < 4; ++n) L.ssq[w4][16 * n + c16] = ss[n];
      }
      __syncthreads();
#pragma unroll
      for (int n = 0; n < 4; ++n) {
        const float tot = L.ssq[0][16 * n + c16] + L.ssq[1][16 * n + c16] + L.ssq[2][16 * n + c16] + L.ssq[3][16 * n + c16];
        const float scl = rsqrtf(tot * (1.0f / 128.0f) + EPS);
        const size_t m = (size_t)b * SEQ + 64 * (c - 1) + 16 * n + c16;
#pragma unroll
        for (int et = 0; et < 2; ++et) {
          const float r0 = bflo(grv[et][n].x), r1 = bfhi(grv[et][n].x), r2 = bflo(grv[et][n].y), r3 = bfhi(grv[et][n].y);
          const float o0 = OT[et][n][0] * scl * gain[et].x * r0 * __builtin_amdgcn_rcpf(1.f + __expf(-r0));
          const float o1 = OT[et][n][1] * scl * gain[et].y * r1 * __builtin_amdgcn_rcpf(1.f + __expf(-r1));
          const float o2 = OT[et][n][2] * scl * gain[et].z * r2 * __builtin_amdgcn_rcpf(1.f + __expf(-r2));
          const float o3 = OT[et][n][3] * scl * gain[et].w * r3 * __builtin_amdgcn_rcpf(1.f + __expf(-r3));
          u32x2 ow; ow.x = pk2(o0, o1); ow.y = pk2(o2, o3);
          *(u32x2*)(G.MIX + m * D + 512 + hd * 128 + 32 * w4 + 16 * et + 4 * q) = ow;
        }
      }
    }
    if (more) {
      GlaBuf& Bn = L.B[cur ^ 1];
      G4_STORET(Bn, rq, rk, rkt)
#pragma unroll
      for (int et = 0; et < 2; ++et) { vfr[et][0] = vfn[et][0]; vfr[et][1] = vfn[et][1]; }
#pragma unroll
      for (int i = 0; i < 4; ++i) dec[i] = decn[i];
#pragma unroll
      for (int z = 0; z < 2; ++z) { rkt[z] = rkt2[z]; rq[z] = rq2[z]; rk[z] = rk2[z]; }
      if (more2) G4_LOADV(vfn, decn, c + 2)
    }
    __syncthreads();
  }
#undef G4_LOADT
#undef G4_LOADV
#undef G4_STORET
  if (PASS == 0) {
#pragma unroll
    for (int et = 0; et < 2; ++et) {
      float* sl = G.SLOC + ((size_t)(bh * 16 + sc) * 8 + w4 * 2 + et) * 16 * 64 + lane;
#pragma unroll
      for (int i = 0; i < 4; ++i)
#pragma unroll
        for (int r = 0; r < 4; ++r) sl[(4 * i + r) * 64] = X[et][i][r];
    }
    if (w4 == 0) {
      float bl = 0.f;
      for (int c = cbeg; c < cend; ++c) bl += G.BL[((size_t)bh * 129 + c) * 64 + lane];
      G.DTOT[(size_t)(bh * 16 + sc) * 64 + lane] = __expf(bl);
    }
  }
}

DI void ce_desc(float& a, float& b) {
  const float hi = __builtin_fmaxf(a, b), lo = __builtin_fminf(a, b);
  a = hi; b = lo;
}
DI float vmaxf(float a, float b) { return __builtin_fmaxf(a, b); }
template <int N> DI void bitonic_sort_desc(float (&v)[N]) {
#pragma unroll
  for (int k = 2; k <= N; k <<= 1) {
#pragma unroll
    for (int j = k >> 1; j > 0; j >>= 1) {
#pragma unroll
      for (int i = 0; i < N; ++i) {
        const int l = i ^ j;
        if (l > i) { if ((i & k) == 0) ce_desc(v[i], v[l]); else ce_desc(v[l], v[i]); }
      }
    }
  }
}
DI void bitonic_merge16_desc(float (&v)[16]) {
#pragma unroll
  for (int j = 8; j > 0; j >>= 1) {
#pragma unroll
    for (int i = 0; i < 16; ++i) { const int l = i ^ j; if (l > i) ce_desc(v[i], v[l]); }
  }
}
template <int NBV> DI void merge_prune16(float (&a)[16], const float (&b)[16]) {
#pragma unroll
  for (int i = 16 - NBV; i < 16; ++i) a[i] = vmaxf(a[i], b[15 - i]);
  bitonic_merge16_desc(a);
}
DI float selh(int hh, float a, float b) { asm volatile("" : "+v"(a), "+v"(b)); return hh == 0 ? a : b; }
DI float pack_idx(float v, unsigned idx, unsigned mask) { return __uint_as_float((__float_as_uint(v) & ~mask) | idx); }

DI void ph_route_v2(int vb, char* smem, const bf16_t* __restrict__ QP, const bf16_t* __restrict__ SK1b, const bf16_t* __restrict__ SK2b,
                    unsigned short* __restrict__ EIDX, float* __restrict__ GATE) {
  const int tid256_ = fresh_tid() & 255;
  const int lane = TID & 63, wave = TID >> 6, r = lane & 31, hh = lane >> 5;
  const int hd = vb & 7, tile = vb >> 3;
  const int m = tile * 128 + wave * 32 + r;
  float loc[2][16];
#pragma unroll
  for (int L = 0; L < 2; ++L) {
    const bf16_t* qp = QP + (size_t)m * D + hd * 128 + L * 64 + hh * 8;
    const bf16_t* kb = (L == 0 ? SK1b : SK2b) + (size_t)(hd * 128 + r) * 64 + hh * 8;
    bf16x8 qf[4];
#pragma unroll
    for (int ks = 0; ks < 4; ++ks) qf[ks] = *(const bf16x8*)(qp + ks * 16);
    float grp[4][16];
#pragma unroll
    for (int mt = 0; mt < 4; ++mt) {
      f32x16 acc;
#pragma unroll
      for (int e = 0; e < 16; ++e) acc[e] = 0.f;
#pragma unroll
      for (int ks = 0; ks < 4; ++ks) {
        const bf16x8 kf = *(const bf16x8*)(kb + (size_t)mt * 32 * 64 + ks * 16);
        acc = MFMA32(kf, qf[ks], acc);
      }
#pragma unroll
      for (int e = 0; e < 16; ++e) grp[mt][e] = pack_idx(acc[e], (unsigned)(mt * 32 + crow(e, hh)), 127u);
      bitonic_sort_desc<16>(grp[mt]);
    }
    merge_prune16<16>(grp[0], grp[1]);
    merge_prune16<16>(grp[2], grp[3]);
    merge_prune16<16>(grp[0], grp[2]);
#pragma unroll
    for (int i = 0; i < 16; ++i) loc[L][i] = grp[0][i];
  }
  float fin[16], oth[16];
#pragma unroll
  for (int i = 0; i < 16; ++i) {
    const float send = selh(hh, loc[1][i], loc[0][i]);
    oth[i] = __shfl_xor(send, 32);
    fin[i] = selh(hh, loc[0][i], loc[1][i]);
  }
  merge_prune16<16>(fin, oth);
  float v1[16], v2[16];
#pragma unroll
  for (int i = 0; i < 16; ++i) {
    const float o = __shfl_xor(fin[i], 32);
    v1[i] = selh(hh, fin[i], o);
    v2[i] = selh(hh, o, fin[i]);
  }
  unsigned* ib = (unsigned*)smem + (size_t)TID * 8;
#pragma unroll
  for (int q = 0; q < 4; ++q) {
    unsigned w1 = 0, w2 = 0;
#pragma unroll
    for (int j = 0; j < 4; ++j) {
      w1 |= (__float_as_uint(v1[4 * q + j]) & 127u) << (8 * j);
      w2 |= (__float_as_uint(v2[4 * q + j]) & 127u) << (8 * j);
    }
    ib[q] = w1; ib[4 + q] = w2;
  }
  float R[16], Bv[16];
#pragma unroll
  for (int j = 0; j < 16; ++j) R[j] = pack_idx(v1[0] + v2[j], (unsigned)j, 255u);
#define ROUTE_ROW(I, CNT) { _Pragma("unroll") for (int j = 0; j < 16; ++j) Bv[j] = (j < CNT) ? pack_idx(v1[I] + v2[j < CNT ? j : 0], (unsigned)(I * 16 + j), 255u) : 0.f; \
    merge_prune16<CNT>(R, Bv); }
  ROUTE_ROW(1, 8) ROUTE_ROW(2, 5) ROUTE_ROW(3, 4) ROUTE_ROW(4, 3) ROUTE_ROW(5, 2) ROUTE_ROW(6, 2) ROUTE_ROW(7, 2)
#undef ROUTE_ROW
#pragma unroll
  for (int j = 0; j < 16; ++j) Bv[j] = (j < 8) ? pack_idx(v1[8 + (j < 8 ? j : 0)] + v2[0], (unsigned)((8 + j) * 16), 255u) : 0.f;
  merge_prune16<8>(R, Bv);
  float ex[16], sum = 0.f;
#pragma unroll
  for (int i = 0; i < 16; ++i) { ex[i] = __expf(R[i] - R[0]); sum += ex[i]; }
  const float inv = 1.f / sum;
  const unsigned char* ibb = (const unsigned char*)ib;
  int eo[8]; float go[8];
#pragma unroll
  for (int w = 0; w < 8; ++w) {
    const float rv = selh(hh, R[w], R[8 + w]);
    const float ev = selh(hh, ex[w], ex[8 + w]);
    const unsigned pos = __float_as_uint(rv) & 255u;
    const unsigned i1 = ibb[pos >> 4], i2 = ibb[16 + (pos & 15u)];
    eo[w] = (int)(i1 * 128u + i2);
    go[w] = ev * inv;
  }
  unsigned short* ep = EIDX + (size_t)m * 128 + hd * 16 + hh * 8;
  float* gp = GATE + (size_t)m * 128 + hd * 16 + hh * 8;
  *(u32x4*)ep = (u32x4){(unsigned)eo[0] | ((unsigned)eo[1] << 16), (unsigned)eo[2] | ((unsigned)eo[3] << 16), (unsigned)eo[4] | ((unsigned)eo[5] << 16), (unsigned)eo[6] | ((unsigned)eo[7] << 16)};
  *(f32x4*)gp = (f32x4){go[0], go[1], go[2], go[3]};
  *(f32x4*)(gp + 4) = (f32x4){go[4], go[5], go[6], go[7]};
}


typedef unsigned char u8_t;
constexpr size_t WS_SCU = 14 * MiB;
constexpr size_t WS_SCV = 14 * MiB + 65536;
DI float wave_max(float v) {
#pragma unroll
  for (int o = 32; o >= 1; o >>= 1) v = fmaxf(v, __shfl_xor(v, o));
  return v;
}
DI u32x4 quant_row16(const float* __restrict__ rowp, int lane, float& sc) {
  const f32x4* rp = (const f32x4*)(rowp + lane * 16);
  const f32x4 a = rp[0], b = rp[1], c = rp[2], d = rp[3];
  float m = fmaxf(fmaxf(fmaxf(fabsf(a.x), fabsf(a.y)), fmaxf(fabsf(a.z), fabsf(a.w))), fmaxf(fmaxf(fabsf(b.x), fabsf(b.y)), fmaxf(fabsf(b.z), fabsf(b.w))));
  m = fmaxf(m, fmaxf(fmaxf(fmaxf(fabsf(c.x), fabsf(c.y)), fmaxf(fabsf(c.z), fabsf(c.w))), fmaxf(fmaxf(fabsf(d.x), fabsf(d.y)), fmaxf(fabsf(d.z), fabsf(d.w)))));
  m = wave_max(m);
  sc = m > 0.f ? m * (1.0f / 448.0f) : 1.0f;
  const float inv = 1.0f / sc;
  u32x4 o; unsigned w;
  w = 0; w = __builtin_amdgcn_cvt_pk_fp8_f32(a.x * inv, a.y * inv, w, false); w = __builtin_amdgcn_cvt_pk_fp8_f32(a.z * inv, a.w * inv, w, true); o.x = w;
  w = 0; w = __builtin_amdgcn_cvt_pk_fp8_f32(b.x * inv, b.y * inv, w, false); w = __builtin_amdgcn_cvt_pk_fp8_f32(b.z * inv, b.w * inv, w, true); o.y = w;
  w = 0; w = __builtin_amdgcn_cvt_pk_fp8_f32(c.x * inv, c.y * inv, w, false); w = __builtin_amdgcn_cvt_pk_fp8_f32(c.z * inv, c.w * inv, w, true); o.z = w;
  w = 0; w = __builtin_amdgcn_cvt_pk_fp8_f32(d.x * inv, d.y * inv, w, false); w = __builtin_amdgcn_cvt_pk_fp8_f32(d.z * inv, d.w * inv, w, true); o.w = w;
  return o;
}
DI void ph_convert_ev8(int vb, char* smem, const float* __restrict__ src, u8_t* __restrict__ EV8c, float* __restrict__ scaleV) {
  const int tid256_ = fresh_tid() & 255;
  u8_t (*t)[1040] = (u8_t (*)[1040])smem;
  const int lane = TID & 63, wave = TID >> 6, e0 = vb * 32;
  for (int rr = 0; rr < 8; ++rr) {
    const int r = wave * 8 + rr;
    float sc;
    const u32x4 o = quant_row16(src + (size_t)(e0 + r) * D, lane, sc);
    *(u32x4*)&t[r][lane * 16] = o;
    if (lane == 0) scaleV[e0 + r] = sc;
  }
  __syncthreads();
  const int r = TID & 31, cs = TID >> 5;
  for (int c0 = 0; c0 < 128; c0 += 8) {
    const int cg = c0 + cs;
    const u32x2 v = *(const u32x2*)&t[r][cg * 8];
    *(u32x2*)(EV8c + ((size_t)cg * NEXP + e0 + r) * 8) = v;
  }
  __syncthreads();
}
struct PeerUHalf { u32x4 u[8]; };
DI void ph_peer_c8(int unit, char* smem, const bf16_t* __restrict__ PP, const unsigned short* __restrict__ EIDX, const float* __restrict__ GATE,
                   const float* __restrict__ scaleU, const float* __restrict__ scaleV, unsigned* __restrict__ STREAM) {
  unsigned (*tile)[132] = (unsigned (*)[132])smem;
  const int tid = fresh_tid();
  const int tl = tid >> 3, kc = tid & 7;
  const size_t rowoff = ((size_t)unit * 64 + tl) * 128 + kc * 16;
  const size_t n = (size_t)TREAL * 128;
  float a[16];
#pragma unroll
  for (int j = 0; j < 16; ++j) a[j] = 0.f;
#pragma unroll
  for (int s = 0; s < 8; ++s) {
    const u32x4 p0 = *(const u32x4*)(PP + (size_t)s * n + rowoff), p1 = *(const u32x4*)(PP + (size_t)s * n + rowoff + 8);
    a[0] += bflo(p0.x); a[1] += bfhi(p0.x); a[2] += bflo(p0.y); a[3] += bfhi(p0.y); a[4] += bflo(p0.z); a[5] += bfhi(p0.z); a[6] += bflo(p0.w); a[7] += bfhi(p0.w);
    a[8] += bflo(p1.x); a[9] += bfhi(p1.x); a[10] += bflo(p1.y); a[11] += bfhi(p1.y); a[12] += bflo(p1.z); a[13] += bfhi(p1.z); a[14] += bflo(p1.w); a[15] += bfhi(p1.w);
  }
  const u32x4 e0 = *(const u32x4*)(EIDX + rowoff), e1 = *(const u32x4*)(EIDX + rowoff + 8);
  unsigned ev[16] = {e0.x & 0xffffu, e0.x >> 16, e0.y & 0xffffu, e0.y >> 16, e0.z & 0xffffu, e0.z >> 16, e0.w & 0xffffu, e0.w >> 16,
                     e1.x & 0xffffu, e1.x >> 16, e1.y & 0xffffu, e1.y >> 16, e1.z & 0xffffu, e1.z >> 16, e1.w & 0xffffu, e1.w >> 16};
  float gt[16];
#pragma unroll
  for (int j = 0; j < 4; ++j) { const f32x4 g4 = *(const f32x4*)(GATE + rowoff + 4 * j); gt[4 * j] = g4.x; gt[4 * j + 1] = g4.y; gt[4 * j + 2] = g4.z; gt[4 * j + 3] = g4.w; }
#pragma unroll
  for (int j = 0; j < 16; ++j) {
    const unsigned e = ev[j];
    const float av = a[j] * scaleU[e];
    const float act = 0.5f * av * (1.f + erff(av * 0.70710678118654752f));
    const float c = gt[j] * act * scaleV[e];
    tile[tl][kc * 16 + j] = e | (f2bf(c) << 16);
  }
  __syncthreads();
  unsigned* outp = STREAM + (size_t)unit * 8192;
#pragma unroll 4
  for (int j = 0; j < 16; ++j) {
    const int o = tid + 512 * j, q = o >> 8, t2 = (o >> 2) & 63, z = o & 3;
    outp[o] = tile[t2][4 * q + z];
  }
  __syncthreads();
}
struct PVW { u32x4 a, b; };
struct PVT { u32x2 v[8]; };
DI void pv_loadw(PVW& W, const unsigned* __restrict__ STREAM, int it, int g, int lane) {
  const u32x4* sp = (const u32x4*)(STREAM + (size_t)it * 8192) + lane;
  W.a = sp[(2 * g) * 64]; W.b = sp[(2 * g + 1) * 64];
}
DI void pv_readt(PVT& T, const PVW& W, const u32x2* tabl) {
  T.v[0] = tabl[W.a.x & 0xffffu]; T.v[1] = tabl[W.a.y & 0xffffu]; T.v[2] = tabl[W.a.z & 0xffffu]; T.v[3] = tabl[W.a.w & 0xffffu];
  T.v[4] = tabl[W.b.x & 0xffffu]; T.v[5] = tabl[W.b.y & 0xffffu]; T.v[6] = tabl[W.b.z & 0xffffu]; T.v[7] = tabl[W.b.w & 0xffffu];
}
DI void pv_fma1(unsigned w, const u32x2 v, f32x2 (&y)[4]) {
  const float c = bfhi(w);
  const f32x2 cc = {c, c};
  y[0] = __builtin_elementwise_fma(__builtin_amdgcn_cvt_pk_f32_fp8(v.x, false), cc, y[0]);
  y[1] = __builtin_elementwise_fma(__builtin_amdgcn_cvt_pk_f32_fp8(v.x, true), cc, y[1]);
  y[2] = __builtin_elementwise_fma(__builtin_amdgcn_cvt_pk_f32_fp8(v.y, false), cc, y[2]);
  y[3] = __builtin_elementwise_fma(__builtin_amdgcn_cvt_pk_f32_fp8(v.y, true), cc, y[3]);
}
DI void pv_fma(const PVW& W, const PVT& T, f32x2 (&y)[4]) {
  pv_fma1(W.a.x, T.v[0], y); pv_fma1(W.a.y, T.v[1], y); pv_fma1(W.a.z, T.v[2], y); pv_fma1(W.a.w, T.v[3], y);
  pv_fma1(W.b.x, T.v[4], y); pv_fma1(W.b.y, T.v[5], y); pv_fma1(W.b.z, T.v[6], y); pv_fma1(W.b.w, T.v[7], y);
}
DI void ph_peer_v8(char* smem, const unsigned* __restrict__ STREAM, const u8_t* __restrict__ EV8c, bf16_t* __restrict__ YT) {
  const int tid = fresh_tid(), lane = tid & 63, wave = tid >> 6;
  const u32x2* tabl = (const u32x2*)smem;
  for (int unit = blockIdx.x; unit < 256; unit += gridDim.x) {
    const int cg = unit & 127, th = unit >> 7;
    const u32x4* src = (const u32x4*)(EV8c + (size_t)cg * NEXP * 8);
#pragma unroll 4
    for (int i = tid; i < NEXP * 8 / 16; i += 512) ((u32x4*)smem)[i] = src[i];
    __syncthreads();
    const int it_end = th * 512 + 512;
    int it = th * 512 + wave;
    PVW W0, W1, W2, W3; PVT T0, T1;
    pv_loadw(W0, STREAM, it, 0, lane); pv_loadw(W1, STREAM, it, 1, lane);
    pv_readt(T0, W0, tabl);
    for (; it < it_end; it += 8) {
      const int itn = (it + 8 < it_end) ? it + 8 : it;
      f32x2 y[4];
#pragma unroll
      for (int z = 0; z < 4; ++z) y[z] = (f32x2){0.f, 0.f};
#define PV_STEP(g, Wld, Wrd, Trd, Wc, Tc) \
      pv_loadw(Wld, STREAM, ((g) + 2 < 16) ? it : itn, ((g) + 2) & 15, lane); \
      pv_readt(Trd, Wrd, tabl); \
      pv_fma(Wc, Tc, y); \
      asm volatile("" ::: "memory");
      PV_STEP(0, W2, W1, T1, W0, T0)  PV_STEP(1, W3, W2, T0, W1, T1)  PV_STEP(2, W0, W3, T1, W2, T0)  PV_STEP(3, W1, W0, T0, W3, T1)
      PV_STEP(4, W2, W1, T1, W0, T0)  PV_STEP(5, W3, W2, T0, W1, T1)  PV_STEP(6, W0, W3, T1, W2, T0)  PV_STEP(7, W1, W0, T0, W3, T1)
      PV_STEP(8, W2, W1, T1, W0, T0)  PV_STEP(9, W3, W2, T0, W1, T1)  PV_STEP(10, W0, W3, T1, W2, T0) PV_STEP(11, W1, W0, T0, W3, T1)
      PV_STEP(12, W2, W1, T1, W0, T0) PV_STEP(13, W3, W2, T0, W1, T1) PV_STEP(14, W0, W3, T1, W2, T0) PV_STEP(15, W1, W0, T0, W3, T1)
#undef PV_STEP
      const int t = it * 64 + lane;
      u32x4 yw; yw.x = pk2(y[0].x, y[0].y); yw.y = pk2(y[1].x, y[1].y); yw.z = pk2(y[2].x, y[2].y); yw.w = pk2(y[3].x, y[3].y);
      *(u32x4*)(YT + ((size_t)cg * TREAL + t) * 8) = yw;
    }
    __syncthreads();
  }
}


DI void ph_final_lds(int unit, char* smem, const bf16_t* __restrict__ H1, const bf16_t* __restrict__ YT, const float* __restrict__ gf, float* __restrict__ out) {
  float (*h2)[1028] = (float (*)[1028])smem;
  const int tid = fresh_tid(), lane = tid & 63, wave = tid >> 6;
  const int t0 = unit * 32;
#pragma unroll
  for (int rr = 0; rr < 4; ++rr) {
    const int r = wave * 4 + rr;
    const bf16_t* hp = H1 + (size_t)(t0 + r) * D;
#pragma unroll
    for (int j = 0; j < 2; ++j) {
      const u32x4 hw = *(const u32x4*)(hp + j * 512 + lane * 8);
      *(f32x4*)&h2[r][j * 512 + lane * 8] = (f32x4){bflo(hw.x), bfhi(hw.x), bflo(hw.y), bfhi(hw.y)};
      *(f32x4*)&h2[r][j * 512 + lane * 8 + 4] = (f32x4){bflo(hw.z), bfhi(hw.z), bflo(hw.w), bfhi(hw.w)};
    }
  }
  __syncthreads();
  {
    const int tok = lane & 31;
#pragma unroll 4
    for (int cg = wave * 2 + (lane >> 5); cg < 128; cg += 16) {
      const u32x4 yw = *(const u32x4*)(YT + ((size_t)cg * TREAL + t0 + tok) * 8);
      f32x4* hp = (f32x4*)&h2[tok][cg * 8];
      f32x4 a = hp[0], b4 = hp[1];
      a.x += bflo(yw.x); a.y += bfhi(yw.x); a.z += bflo(yw.y); a.w += bfhi(yw.y);
      b4.x += bflo(yw.z); b4.y += bfhi(yw.z); b4.z += bflo(yw.w); b4.w += bfhi(yw.w);
      hp[0] = a; hp[1] = b4;
    }
  }
  __syncthreads();
#pragma unroll
  for (int rr = 0; rr < 4; ++rr) {
    const int r = wave * 4 + rr;
    f32x4 v[4]; float ss = 0.f;
#pragma unroll
    for (int j = 0; j < 4; ++j) { v[j] = *(const f32x4*)&h2[r][j * 256 + lane * 4]; ss += v[j].x * v[j].x + v[j].y * v[j].y + v[j].z * v[j].z + v[j].w * v[j].w; }
    ss = wave_sum(ss);
    const float sc = rsqrtf(ss * (1.0f / D) + EPS);
    float* op = out + (size_t)(t0 + r) * D;
#pragma unroll
    for (int j = 0; j < 4; ++j) {
      const f32x4 gg = *(const f32x4*)(gf + j * 256 + lane * 4);
      *(f32x4*)(op + j * 256 + lane * 4) = (f32x4){v[j].x * sc * gg.x, v[j].y * sc * gg.y, v[j].z * sc * gg.z, v[j].w * sc * gg.w};
    }
  }
  __syncthreads();
}

typedef int i32x4 __attribute__((ext_vector_type(4)));
constexpr size_t WS_XQ = 861 * MiB;
constexpr size_t WS_XS = 943 * MiB;
DI unsigned pack_i8x4(float a, float b, float c, float d) {
  const int ia = __float2int_rn(a), ib = __float2int_rn(b), ic = __float2int_rn(c), id = __float2int_rn(d);
  return ((unsigned)ia & 255u) | (((unsigned)ib & 255u) << 8) | (((unsigned)ic & 255u) << 16) | ((unsigned)id << 24);
}
DI u32x4 quant_row16_i8(const float* __restrict__ rowp, int lane, float& sc) {
  const f32x4* rp = (const f32x4*)(rowp + lane * 16);
  const f32x4 a = rp[0], b = rp[1], c = rp[2], d = rp[3];
  float m = fmaxf(fmaxf(fmaxf(fabsf(a.x), fabsf(a.y)), fmaxf(fabsf(a.z), fabsf(a.w))), fmaxf(fmaxf(fabsf(b.x), fabsf(b.y)), fmaxf(fabsf(b.z), fabsf(b.w))));
  m = fmaxf(m, fmaxf(fmaxf(fmaxf(fabsf(c.x), fabsf(c.y)), fmaxf(fabsf(c.z), fabsf(c.w))), fmaxf(fmaxf(fabsf(d.x), fabsf(d.y)), fmaxf(fabsf(d.z), fabsf(d.w)))));
  m = wave_max(m);
  sc = m > 0.f ? m * (1.0f / 127.0f) : 1.0f;
  const float inv = 1.0f / sc;
  u32x4 o;
  o.x = pack_i8x4(a.x * inv, a.y * inv, a.z * inv, a.w * inv); o.y = pack_i8x4(b.x * inv, b.y * inv, b.z * inv, b.w * inv);
  o.z = pack_i8x4(c.x * inv, c.y * inv, c.z * inv, c.w * inv); o.w = pack_i8x4(d.x * inv, d.y * inv, d.z * inv, d.w * inv);
  return o;
}
DI void ph_convert_eu_i8(const float* __restrict__ src, u8_t* __restrict__ EUq, float* __restrict__ scaleU) {
  const int tid = fresh_tid(), lane = tid & 63, wave = tid >> 6;
  for (int e = (blockIdx.x * 8 + wave) * 2; e < NEXP; e += gridDim.x * 16) {
    float sc0, sc1 = 1.f;
    const bool two = e + 1 < NEXP;
    const u32x4 o0 = quant_row16_i8(src + (size_t)e * D, lane, sc0);
    u32x4 o1 = o0;
    if (two) o1 = quant_row16_i8(src + (size_t)(e + 1) * D, lane, sc1);
    *(u32x4*)(EUq + ((size_t)(lane >> 3) * NEXP + e) * 128 + (lane & 7) * 16) = o0;
    if (two) *(u32x4*)(EUq + ((size_t)(lane >> 3) * NEXP + e + 1) * 128 + (lane & 7) * 16) = o1;
    if (lane == 0) { scaleU[e] = sc0; if (two) scaleU[e + 1] = sc1; }
  }
}
DI void ph_norm2_rows(int vb, const bf16_t* __restrict__ src, const float* __restrict__ gain, float* __restrict__ R2, u8_t* __restrict__ XQ, float* __restrict__ XS) {
  const int tid256_ = fresh_tid() & 255;
  const int row0 = vb * 16 + (TID >> 6) * 4, lane = TID & 63;
  u32x2 raw[4][4];
#pragma unroll
  for (int rr = 0; rr < 4; ++rr)
#pragma unroll
    for (int j = 0; j < 4; ++j) raw[rr][j] = *(const u32x2*)(src + (size_t)(row0 + rr) * D + j * 256 + lane * 4);
  f32x4 gg[4];
#pragma unroll
  for (int j = 0; j < 4; ++j) gg[j] = *(const f32x4*)(gain + j * 256 + lane * 4);
#pragma unroll
  for (int rr = 0; rr < 4; ++rr) {
    f32x4 v[4]; float ss = 0.f;
#pragma unroll
    for (int j = 0; j < 4; ++j) {
      v[j] = (f32x4){bflo(raw[rr][j].x), bfhi(raw[rr][j].x), bflo(raw[rr][j].y), bfhi(raw[rr][j].y)};
      ss += v[j].x * v[j].x + v[j].y * v[j].y + v[j].z * v[j].z + v[j].w * v[j].w;
    }
    ss = wave_sum(ss);
    const float r = rsqrtf(ss * (1.0f / D) + EPS);
    if (lane == 0) R2[row0 + rr] = r;
#pragma unroll
    for (int j = 0; j < 4; ++j) {
      const float a0 = v[j].x * gg[j].x, a1 = v[j].y * gg[j].y, a2 = v[j].z * gg[j].z, a3 = v[j].w * gg[j].w;
      float m = fmaxf(fmaxf(fabsf(a0), fabsf(a1)), fmaxf(fabsf(a2), fabsf(a3)));
#pragma unroll
      for (int sh = 16; sh >= 1; sh >>= 1) m = fmaxf(m, __shfl_xor(m, sh));
      const float inv = m > 0.f ? 127.0f / m : 0.f;
      *(unsigned*)(XQ + (size_t)(row0 + rr) * D + j * 256 + lane * 4) = pack_i8x4(a0 * inv, a1 * inv, a2 * inv, a3 * inv);
      if ((lane & 31) == 0) XS[(size_t)(row0 + rr) * 8 + 2 * j + (lane >> 5)] = m * r * (1.0f / 127.0f);
    }
  }
}
DI int dpp_i(int v, const int sel) {
  if (sel == 0) return __builtin_amdgcn_update_dpp(0, v, 0xB1, 0xF, 0xF, true);
  if (sel == 1) return __builtin_amdgcn_update_dpp(0, v, 0x4E, 0xF, 0xF, true);
  return __builtin_amdgcn_update_dpp(0, v, 0x141, 0xF, 0xF, true);
}
DI int dpp_isum8(int v) { v += dpp_i(v, 0); v += dpp_i(v, 1); v += dpp_i(v, 2); return v; }
template <int HF> DI void peer_ud4_issue(PeerUHalf& H, unsigned idxpair, int lane, const u8_t* __restrict__ tab) {
#pragma unroll
  for (int jj = 0; jj < 8; ++jj) {
    const int j = 8 * HF + jj;
    const unsigned w = (unsigned)__shfl((int)idxpair, (lane & ~7) + (j >> 1));
    const unsigned e = (j & 1) ? (w >> 16) : (w & 0xffffu);
    H.u[jj] = *(const u32x4*)(tab + (size_t)e * 128);
  }
}
template <int HF> DI void peer_ud4_compute(const PeerUHalf& H, const u32x4 xq, int sub, int& res0, int& res1) {
#pragma unroll
  for (int jj = 0; jj < 8; ++jj) {
    const int j = 8 * HF + jj;
    int acc = 0;
    acc = __builtin_amdgcn_sdot4((int)H.u[jj].x, (int)xq.x, acc, false); acc = __builtin_amdgcn_sdot4((int)H.u[jj].y, (int)xq.y, acc, false);
    acc = __builtin_amdgcn_sdot4((int)H.u[jj].z, (int)xq.z, acc, false); acc = __builtin_amdgcn_sdot4((int)H.u[jj].w, (int)xq.w, acc, false);
    acc = dpp_isum8(acc);
    if (sub == (j >> 1)) { if (j & 1) res1 = acc; else res0 = acc; }
  }
}
DI void ph_peer_u_d4(int xi, int nx, int wv, int nwv, const u8_t* __restrict__ XQ, const float* __restrict__ XS, const u8_t* __restrict__ EUq,
                     const unsigned short* __restrict__ EIDX, bf16_t* __restrict__ PP) {
  const int lane = fresh_tid() & 63, sub = lane & 7;
  const int ntok = (TREAL - wv + nwv - 1) / nwv;
#define PU_TOK(i) (wv + ((i) < ntok ? (i) : ntok - 1) * nwv)
#define PU_IDX(t) __builtin_nontemporal_load((const unsigned*)(EIDX + (size_t)(t) * 128) + lane)
#define PU_LDX(xq_, xs_, t) { xq_ = *(const u32x4*)(xbase + (size_t)(t) * D); xs_ = XS[(size_t)(t) * 8 + s]; }
#define PU_STORE(t, r0, r1, xs_) __builtin_nontemporal_store(pk2((float)(r0) * (xs_), (float)(r1) * (xs_)), (unsigned*)(pp + (size_t)(t) * 128) + lane)
  for (int s = xi; s < 8; s += nx) {
    const u8_t* tab = EUq + (size_t)s * NEXP * 128 + sub * 16;
    const u8_t* xbase = XQ + s * 128 + sub * 16;
    bf16_t* pp = PP + (size_t)s * TREAL * 128;
    PeerUHalf HA, HB, HC;
    int ta = PU_TOK(0), tb = PU_TOK(1), tc = PU_TOK(2);
    unsigned ia = PU_IDX(ta), ib = PU_IDX(tb), ic = PU_IDX(tc);
    u32x4 xqa; float xsa; PU_LDX(xqa, xsa, ta);
    peer_ud4_issue<0>(HA, ia, lane, tab);
    peer_ud4_issue<1>(HB, ia, lane, tab);
    for (int i = 0; i < ntok; i += 3) {
      const int td = PU_TOK(i + 3), te = PU_TOK(i + 4), tf = PU_TOK(i + 5);
      u32x4 xqb, xqc, xqd; float xsb, xsc, xsd;
      int r0, r1;
      peer_ud4_issue<0>(HC, ib, lane, tab); PU_LDX(xqb, xsb, tb); const unsigned id = PU_IDX(td);
      r0 = 0; r1 = 0;
      peer_ud4_compute<0>(HA, xqa, sub, r0, r1);
      peer_ud4_issue<1>(HA, ib, lane, tab);
      peer_ud4_compute<1>(HB, xqa, sub, r0, r1);
      PU_STORE(ta, r0, r1, xsa);
      peer_ud4_issue<0>(HB, ic, lane, tab); PU_LDX(xqc, xsc, tc); const unsigned ie = PU_IDX(te);
      r0 = 0; r1 = 0;
      peer_ud4_compute<0>(HC, xqb, sub, r0, r1);
      peer_ud4_issue<1>(HC, ic, lane, tab);
      peer_ud4_compute<1>(HA, xqb, sub, r0, r1);
      PU_STORE(tb, r0, r1, xsb);
      peer_ud4_issue<0>(HA, id, lane, tab); PU_LDX(xqd, xsd, td); const unsigned if_ = PU_IDX(tf);
      r0 = 0; r1 = 0;
      peer_ud4_compute<0>(HB, xqc, sub, r0, r1);
      peer_ud4_issue<1>(HB, id, lane, tab);
      peer_ud4_compute<1>(HC, xqc, sub, r0, r1);
      PU_STORE(tc, r0, r1, xsc);
      ta = td; tb = te; tc = tf; ib = ie; ic = if_; xqa = xqd; xsa = xsd;
    }
  }
#undef PU_TOK
#undef PU_IDX
#undef PU_LDX
#undef PU_STORE
}

struct PUI { i32x4 a[8]; };
struct PUE { int e[8]; };

#define XB_TMO      128
#define XB_XCNT(j)  (256  + 64 * (j))
#define XB_XSUB(j)  (1280 + 64 * (j))
#define XB_XGEN(j)  (2304 + 64 * (j))
#define XB_TOP      3328
#define XB_TOPGEN   3392
#define XCD_BAR_WORDS 3456
#define XB_SPIN_CAP (1u << 20)
#define LAS __attribute__((address_space(3)))
DI unsigned xb_ld(unsigned* p)              { return __hip_atomic_load(p, __ATOMIC_RELAXED, __HIP_MEMORY_SCOPE_AGENT); }
DI unsigned xb_add(unsigned* p, unsigned v) { return __hip_atomic_fetch_add(p, v, __ATOMIC_RELAXED, __HIP_MEMORY_SCOPE_AGENT); }
DI unsigned xb_xcc_id() { return (unsigned)__builtin_amdgcn_s_getreg((3 << 11) | 20) & 0xFu; }
#define XB_SPIN(cond, bar) do { unsigned _sp = 0; while (cond) { __builtin_amdgcn_s_sleep(1); \
    if ((++_sp & 255u) == 0u) { if (xb_ld(&(bar)[XB_TMO])) break; if (_sp > XB_SPIN_CAP) { atomicAdd(&(bar)[XB_TMO], 1u); break; } } } } while (0)
struct XcdBarrier { unsigned* bar; unsigned x; volatile unsigned* st; };
DI XcdBarrier xcd_barrier_post(unsigned* bar, volatile unsigned* st) {
  XcdBarrier b; b.bar = bar; b.x = xb_xcc_id(); b.st = st;
  if (threadIdx.x == 0) (void)xb_add(&bar[XB_XCNT(b.x)], 1u);
  return b;
}
DI void xcd_barrier_complete(unsigned* bar, unsigned x, unsigned& nloc, unsigned& nx) {
  const unsigned G = gridDim.x;
  unsigned sum, cnt, mine, sp = 0u;
  for (;;) {
    sum = 0u; cnt = 0u; mine = 0u;
#pragma unroll
    for (unsigned j = 0; j < 16; ++j) { const unsigned c = xb_ld(&bar[XB_XCNT(j)]); sum += c; cnt += (c > 0u) ? 1u : 0u; mine = (j == x) ? c : mine; }
    if (sum == G) break;
    __builtin_amdgcn_s_sleep(1);
    if ((++sp & 255u) == 0u) { if (xb_ld(&bar[XB_TMO])) break; if (sp > XB_SPIN_CAP) { atomicAdd(&bar[XB_TMO], 1u); break; } }
  }
  nloc = mine > 0u ? mine : 1u; nx = cnt > 0u ? cnt : 1u;
}
DI void xcd_barrier(const XcdBarrier& b) {
  asm volatile("s_waitcnt vmcnt(0)" ::: "memory");
  __syncthreads();
  if (threadIdx.x == 0) {
    unsigned* bar = b.bar;
    __builtin_amdgcn_s_waitcnt(0);
    unsigned nloc = b.st[0], nx = b.st[1];
    if (nloc == 0u) { xcd_barrier_complete(bar, b.x, nloc, nx); b.st[0] = nloc; b.st[1] = nx; }
    const unsigned old = xb_add(&bar[XB_XSUB(b.x)], 1u);
    const unsigned gen = old / nloc;
    if (old + 1u == (gen + 1u) * nloc) {
      __builtin_amdgcn_fence(__ATOMIC_RELEASE, "agent");
      asm volatile("s_waitcnt vmcnt(0)" ::: "memory");
      const unsigned og = xb_add(&bar[XB_TOP], 1u);
      const unsigned tg = og / nx;
      if (og + 1u == (tg + 1u) * nx) xb_add(&bar[XB_TOPGEN], 1u);
      else XB_SPIN(xb_ld(&bar[XB_TOPGEN]) == tg, bar);
      __builtin_amdgcn_fence(__ATOMIC_ACQUIRE, "agent");
      xb_add(&bar[XB_XGEN(b.x)], 1u);
      asm volatile("s_waitcnt vmcnt(0)" ::: "memory");
    } else {
      XB_SPIN(xb_ld(&bar[XB_XGEN(b.x)]) == gen, bar);
      __builtin_amdgcn_fence(__ATOMIC_ACQUIRE, "agent");
      asm volatile("s_waitcnt vmcnt(0)" ::: "memory");
    }
  }
  __syncthreads();
}

struct Params {
  const float *x, *meta, *norm1_g, *w_in, *wg, *bg, *sb_g, *gla_g, *w_out, *norm2_g, *w_pq, *sk1, *sk2, *eu, *ev, *gf;
  float* out; char* ws;
};
constexpr int HALF_SMEM = 73728;
constexpr int SMEM_BYTES = 2 * HALF_SMEM;
constexpr size_t WS_BAR = 0;

__global__ void __launch_bounds__(512, 2) k_fused(Params p) {
  extern __shared__ __attribute__((aligned(16))) char smem_dyn[];
  const int half = __builtin_amdgcn_readfirstlane((int)(threadIdx.x >> 8));
  char* smem = smem_dyn + half * HALF_SMEM;
  __shared__ unsigned xb_words[4];
  if (threadIdx.x < 4) xb_words[threadIdx.x] = 0u;
  __syncthreads();
  const XcdBarrier bar = xcd_barrier_post((unsigned*)(p.ws + WS_BAR), xb_words);
  if (threadIdx.x == 0) xb_words[2] = xb_add((unsigned*)(p.ws + WS_XRANK) + bar.x, 1u);
  const int G = 2 * gridDim.x, bid = 2 * blockIdx.x + half;
  char* ws = p.ws;
  bf16_t* WinT = (bf16_t*)(ws + WS_WIN);
  bf16_t* WoutT = (bf16_t*)(ws + WS_WOUT);
  bf16_t* WpqT = (bf16_t*)(ws + WS_WPQ);
  bf16_t* EU = (bf16_t*)(ws + WS_EU);
  bf16_t* EV = (bf16_t*)(ws + WS_EV);
  bf16_t* SK1b = (bf16_t*)(ws + WS_SK1);
  bf16_t* SK2b = (bf16_t*)(ws + WS_SK2);
  bf16_t* A1 = (bf16_t*)(ws + WS_A1);
  float* GO = (float*)(ws + WS_A1);
  bf16_t* A2 = (bf16_t*)(ws + WS_A1);
  InProjOut O;
  O.QSB = (bf16_t*)(ws + WS_QSB); O.KSB = (bf16_t*)(ws + WS_KSB); O.VTSB = (bf16_t*)(ws + WS_VTSB); O.VSB = (bf16_t*)(ws + WS_VSB);
  O.GQ = (bf16_t*)(ws + WS_GQ); O.GK = (bf16_t*)(ws + WS_GK); O.GV = (bf16_t*)(ws + WS_GVT); O.GR = (bf16_t*)(ws + WS_GR);
  O.GLR = (float*)(ws + WS_GLR);
  bf16_t* H1 = (bf16_t*)(ws + WS_H1);
  float* R2 = (float*)(ws + WS_XS + 3 * MiB);
  bf16_t* GVT = (bf16_t*)(ws + WS_GVT);
  GlaPtrs GP;
  GP.GQ = O.GQ; GP.GK = O.GK; GP.GVT = GVT; GP.GR = O.GR; GP.GLR = O.GLR; GP.wg = p.wg; GP.bg = p.bg; GP.gla_g = p.gla_g;
  GP.SLOC = (float*)(ws + WS_SLOC); GP.DTOT = (float*)(ws + WS_DTOT); GP.MIX = (bf16_t*)(ws + WS_MIX);
  GlaPrepPtrs GPP; GPP.GQ = O.GQ; GPP.GK = O.GK; GPP.GLR = O.GLR; GPP.wg = p.wg; GPP.bg = p.bg;
  GPP.QT = (bf16_t*)(ws + WS_GQT); GPP.KT = (bf16_t*)(ws + WS_GKT); GPP.KTT = (bf16_t*)(ws + WS_GKTT); GPP.DEC = (float*)(ws + WS_GDEC); GPP.BL = (float*)(ws + WS_GBL);
  GlaPtrs3 GP3; GP3.QT = GPP.QT; GP3.KT = GPP.KT; GP3.KTT = GPP.KTT; GP3.GVT = GVT; GP3.GR = O.GR; GP3.DEC = GPP.DEC; GP3.BL = GPP.BL; GP3.gla_g = p.gla_g;
  GP3.SLOC = GP.SLOC; GP3.DTOT = GP.DTOT; GP3.MIX = GP.MIX;
  bf16_t* MIX = (bf16_t*)(ws + WS_MIX);
  bf16_t* QP = (bf16_t*)(ws + WS_MIX);
  unsigned short* EIDX = (unsigned short*)(ws + WS_EIDX);
  bf16_t* PP = (bf16_t*)(ws + WS_PP);
  bf16_t* YT = (bf16_t*)(ws + WS_PP);
  unsigned* STREAM = (unsigned*)(ws + WS_STREAM);
  float* GATE = (float*)(ws + WS_GATE);

  for (int vb = bid; vb < 3328 + 1024 + 1024; vb += G) {
    if (vb < 3328) ph_transpose_w(vb % 104, vb / 104, smem, p.w_in, p.norm1_g, WinT, D, NIN);
    else if (vb < 4352) { const int t = vb - 3328; ph_transpose_w(t % 32, t / 32, smem, p.w_out, nullptr, WoutT, D, D); }
    else { const int t = vb - 4352; ph_transpose_w(t % 32, t / 32, smem, p.w_pq, p.norm2_g, WpqT, D, D); }
  }
  ph_convert_eu_i8(p.eu, (u8_t*)EU, (float*)(ws + WS_SCU));
  for (int vb = bid; vb < NEXP / 32; vb += G) ph_convert_ev8(vb, smem, p.ev, (u8_t*)EV, (float*)(ws + WS_SCV));
  ph_convert(p.sk1, SK1b, (size_t)8 * 128 * 64 / 8);
  ph_convert(p.sk2, SK2b, (size_t)8 * 128 * 64 / 8);
  ph_zero_pads(O.KSB, O.VTSB, O.GQ, O.GK, GVT);
  for (int vb = bid; vb < TREAL / 16; vb += G) ph_norm_rows<0>(vb, p.x, p.meta, A1);
  __syncthreads();
  for (int mb = blockIdx.x; mb < NIN / 16; mb += gridDim.x) ph_meta(mb, smem_dyn, p.meta, p.norm1_g, p.w_in, O);
  xcd_barrier(bar);
  {
    pg8::Gemm g{A1, WinT, TREAL, NINP, D}; pg8::StaticOrder S; S.init(TREAL, NINP, (int)gridDim.x, (int)blockIdx.x);
    EpiInProj E{O, GVT, smem_dyn + 131072};
    pg8::gemm_phase<EpiInProj, pg8::StaticOrder, true, true>((PG8_LAS unsigned char*)smem_dyn, g, S, E);
  }
  xcd_barrier(bar);
  for (int it = blockIdx.x; it < 32 * 129; it += gridDim.x) ph_gla_prep(it, smem_dyn, GPP);
  xcd_barrier(bar);
  for (int it = blockIdx.x; it < 16 * 15; it += gridDim.x) gla_item4<0>(it / 15, it % 15, smem_dyn, GP3);
  for (int vb = bid; vb < 64 * 64; vb += G) ph_sb_attn(vb, O.QSB, O.KSB, O.VTSB, p.sb_g, MIX);
  xcd_barrier(bar);
  for (int it = blockIdx.x; it < 16 * 16; it += gridDim.x) gla_item4<1>(it >> 4, it & 15, smem_dyn, GP3);
  xcd_barrier(bar);
  {
    pg8::Gemm g{MIX, WoutT, TREAL, D, D}; pg8::StaticOrder S; S.init(TREAL, D, (int)gridDim.x, (int)blockIdx.x);
    EpiOut E{p.x, H1};
    pg8::gemm_phase<EpiOut, pg8::StaticOrder, true, true>((PG8_LAS unsigned char*)smem_dyn, g, S, E);
  }
  xcd_barrier(bar);
  for (int vb = bid; vb < TREAL / 16; vb += G) ph_norm2_rows(vb, H1, p.norm2_g, R2, (u8_t*)(ws + WS_XQ), (float*)(ws + WS_XS));
  xcd_barrier(bar);
  {
    pg8::Gemm g{H1, WpqT, TREAL, D, D}; pg8::StaticOrder S; S.init(TREAL, D, (int)gridDim.x, (int)blockIdx.x);
    EpiPQ E{QP, R2};
    pg8::gemm_phase<EpiPQ, pg8::StaticOrder, true, true>((PG8_LAS unsigned char*)smem_dyn, g, S, E);
  }
  xcd_barrier(bar);
  for (int vb = bid; vb < 8 * (TREAL / 128); vb += G) ph_route_v2(vb, smem, QP, SK1b, SK2b, EIDX, GATE);
  xcd_barrier(bar);
  {
    __shared__ int xinfo[4];
    if (threadIdx.x == 0) {
      unsigned* barw = (unsigned*)(p.ws + WS_BAR);
      unsigned cnt = 0, ord = 0, mine = 1;
      for (unsigned j = 0; j < 16; ++j) { const unsigned c = xb_ld(&barw[XB_XCNT(j)]); if (c > 0) { if (j < bar.x) ++ord; ++cnt; } if (j == bar.x) mine = c; }
      xinfo[0] = (int)ord; xinfo[1] = (int)cnt; xinfo[2] = (int)xb_words[2]; xinfo[3] = (int)mine;
    }
    __syncthreads();
    const int xi = xinfo[0], nx = xinfo[1], rank = xinfo[2], nloc = xinfo[3];
    const int wave = __builtin_amdgcn_readfirstlane((int)(threadIdx.x >> 6));
    ph_peer_u_d4(xi, nx, rank * 8 + wave, nloc * 8, (const u8_t*)(ws + WS_XQ), (const float*)(ws + WS_XS), (const u8_t*)EU, EIDX, PP);
  }
  xcd_barrier(bar);
  for (int unit = blockIdx.x; unit < TREAL / 64; unit += gridDim.x) ph_peer_c8(unit, smem_dyn, PP, EIDX, GATE, (const float*)(ws + WS_SCU), (const float*)(ws + WS_SCV), STREAM);
  xcd_barrier(bar);
  ph_peer_v8(smem_dyn, STREAM, (const u8_t*)EV, YT);
  xcd_barrier(bar);
  for (int unit = blockIdx.x; unit < TREAL / 32; unit += gridDim.x) ph_final_lds(unit, smem_dyn, H1, YT, p.gf, p.out);
}

extern "C" void kernel_launch(void* const* d_in, const int* in_sizes, int n_in, void* d_out, int out_size, void* d_ws, size_t ws_size, hipStream_t stream) {
  static int grid = 0;
  if (grid == 0) {
    int dev = 0, cus = 0, per_cu = 0;
    hipGetDevice(&dev);
    hipDeviceGetAttribute(&cus, hipDeviceAttributeMultiprocessorCount, dev);
    hipFuncSetAttribute((const void*)k_fused, hipFuncAttributeMaxDynamicSharedMemorySize, SMEM_BYTES);
    hipOccupancyMaxActiveBlocksPerMultiprocessor(&per_cu, (const void*)k_fused, 512, SMEM_BYTES);
    if (per_cu > 1) per_cu = 1;
    if (per_cu < 1) per_cu = 1;
    grid = cus * per_cu;
  }
  hipMemsetAsync((char*)d_ws + WS_BAR, 0, 32768, stream);
  Params p{};
  p.x = (const float*)d_in[0]; p.meta = (const float*)d_in[1]; p.norm1_g = (const float*)d_in[2]; p.w_in = (const float*)d_in[3];
  p.wg = (const float*)d_in[4]; p.bg = (const float*)d_in[5]; p.sb_g = (const float*)d_in[6]; p.gla_g = (const float*)d_in[7];
  p.w_out = (const float*)d_in[8]; p.norm2_g = (const float*)d_in[9]; p.w_pq = (const float*)d_in[10]; p.sk1 = (const float*)d_in[11];
  p.sk2 = (const float*)d_in[12]; p.eu = (const float*)d_in[13]; p.ev = (const float*)d_in[14]; p.gf = (const float*)d_in[15];
  p.out = (float*)d_out; p.ws = (char*)d_ws;
  void* args[] = {&p};
  hipLaunchCooperativeKernel((const void*)k_fused, dim3(grid), dim3(512), args, SMEM_BYTES, stream);
}
```

```cpp
#include <hip/hip_runtime.h>
#include <stdint.h>
#include <stddef.h>

typedef unsigned short bf16_t;
typedef short bf16x8 __attribute__((ext_vector_type(8)));
typedef float f32x16 __attribute__((ext_vector_type(16)));
typedef float f32x4 __attribute__((ext_vector_type(4)));
typedef float f32x2 __attribute__((ext_vector_type(2)));
typedef unsigned u32x4 __attribute__((ext_vector_type(4)));
typedef unsigned u32x2 __attribute__((ext_vector_type(2)));
typedef __bf16 bf16x2_t __attribute__((ext_vector_type(2)));

#define DI __device__ __forceinline__
__device__ __forceinline__ int fresh_tid() { int t = (int)threadIdx.x; asm volatile("" : "+v"(t)); return t; }
#define TID tid256_
#define MFMA32(a, b, c) __builtin_amdgcn_mfma_f32_32x32x16_bf16((a), (b), (c), 0, 0, 0)

constexpr int D = 1024, NB = 8, SEQ = 8192, NMETA = 16;
constexpr int TREAL = NB * SEQ;
constexpr int MROWS = TREAL + 128;
constexpr int NIN = 3088, NINP = 3328;
constexpr int SBH = 8, SBD = 64;
constexpr int GH = 4, GDK = 64, GDV = 128;
constexpr int KIDX = SEQ + 32;
constexpr int GU = SEQ + 64;
constexpr int NEXP = 16384;
constexpr float EPS = 1e-6f;

constexpr size_t MiB = 1u << 20;
constexpr size_t WS_WIN = 1 * MiB;
constexpr size_t WS_WOUT = 8 * MiB;
constexpr size_t WS_WPQ = 10 * MiB;
constexpr size_t WS_SK1 = 12 * MiB;
constexpr size_t WS_SK2 = 13 * MiB;
constexpr size_t WS_EU = 16 * MiB;
constexpr size_t WS_EV = 48 * MiB;
constexpr size_t WS_A1 = 80 * MiB;
constexpr size_t WS_QSB = 210 * MiB;
constexpr size_t WS_KSB = 274 * MiB;
constexpr size_t WS_VTSB = 339 * MiB;
constexpr size_t WS_GQ = 404 * MiB;
constexpr size_t WS_GK = 437 * MiB;
constexpr size_t WS_H1 = 210 * MiB;
constexpr size_t WS_GV = 470 * MiB;
constexpr size_t WS_GR = 535 * MiB;
constexpr size_t WS_GLR = 599 * MiB;
constexpr size_t WS_LG = 604 * MiB;
constexpr size_t WS_MIX = 669 * MiB;
constexpr size_t WS_EIDX = 797 * MiB;
constexpr size_t WS_GATE = 829 * MiB;
constexpr size_t WS_PP = 470 * MiB;
constexpr size_t WS_STREAM = 726 * MiB;
constexpr size_t WS_XRANK = 16384;
constexpr size_t WS_VSB = 861 * MiB;
constexpr size_t WS_END = 926 * MiB;

DI unsigned f2bf(float f) { unsigned u = __float_as_uint(f); return (u + 0x7fffu + ((u >> 16) & 1u)) >> 16; }
DI float bf2f(unsigned b) { return __uint_as_float(b << 16); }
DI unsigned pk2(float lo, float hi) { f32x2 v = {lo, hi}; return __builtin_bit_cast(unsigned, __builtin_convertvector(v, bf16x2_t)); }
DI float bflo(unsigned u) { return __uint_as_float(u << 16); }
DI float bfhi(unsigned u) { return __uint_as_float(u & 0xffff0000u); }
DI int crow(int reg, int h) { return (reg & 3) + 8 * (reg >> 2) + 4 * h; }
DI float wave_sum(float v) {
#pragma unroll
  for (int o = 32; o >= 1; o >>= 1) v += __shfl_xor(v, o);
  return v;
}
DI float softplus(float z) { return fmaxf(z, 0.f) + __logf(1.f + __expf(-fabsf(z))); }

DI void ph_transpose_w(int bx, int by, char* smem, const float* __restrict__ W, const float* __restrict__ gain, bf16_t* __restrict__ WT, int K, int N) {
  const int tid256_ = fresh_tid() & 255;
  float (*t)[33] = (float (*)[33])smem;
  const int n0 = bx * 32, k0 = by * 128;
  {
    const int kr = TID >> 3, c4 = (TID & 7) * 4;
    f32x4 v[4];
#pragma unroll
    for (int j = 0; j < 4; ++j) v[j] = (n0 + c4 < N) ? *(const f32x4*)(W + (size_t)(k0 + kr + 32 * j) * N + n0 + c4) : (f32x4){0.f, 0.f, 0.f, 0.f};
#pragma unroll
    for (int j = 0; j < 4; ++j) {
      const float g = gain ? gain[k0 + kr + 32 * j] : 1.f;
      t[kr + 32 * j][c4 + 0] = v[j].x * g; t[kr + 32 * j][c4 + 1] = v[j].y * g; t[kr + 32 * j][c4 + 2] = v[j].z * g; t[kr + 32 * j][c4 + 3] = v[j].w * g;
    }
  }
  __syncthreads();
  {
    const int n = TID >> 3, ks = (TID & 7) * 16;
    unsigned w[8];
#pragma unroll
    for (int i = 0; i < 8; ++i) w[i] = pk2(t[ks + 2 * i][n], t[ks + 2 * i + 1][n]);
    bf16_t* dst = WT + (size_t)(n0 + n) * K + k0 + ks;
    *(u32x4*)dst = (u32x4){w[0], w[1], w[2], w[3]};
    *(u32x4*)(dst + 8) = (u32x4){w[4], w[5], w[6], w[7]};
  }
  __syncthreads();
}
DI void ph_convert(const float* __restrict__ src, bf16_t* __restrict__ dst, size_t n8) {
  size_t i = (size_t)blockIdx.x * blockDim.x + threadIdx.x;
  const size_t stride = (size_t)gridDim.x * blockDim.x;
  for (; i < n8; i += stride) {
    const f32x4 a = ((const f32x4*)src)[2 * i], b = ((const f32x4*)src)[2 * i + 1];
    u32x4 o; o.x = pk2(a.x, a.y); o.y = pk2(a.z, a.w); o.z = pk2(b.x, b.y); o.w = pk2(b.z, b.w);
    ((u32x4*)dst)[i] = o;
  }
}
DI void ph_zero_pads(bf16_t* KSB, bf16_t* VTSB, bf16_t* GQ, bf16_t* GK, bf16_t* GVT) {
  const int tid = blockIdx.x * blockDim.x + threadIdx.x, nth = gridDim.x * blockDim.x;
  for (int i = tid; i < 64 * 16 * 64; i += nth) { const int bh = i / 1024, r = i % 1024; KSB[(size_t)bh * KIDX * 64 + r] = 0; }
  for (int i = tid; i < 64 * 64 * 16; i += nth) { const int row = i / 16, c = i % 16; VTSB[(size_t)row * KIDX + c] = 0; }
  for (int i = tid; i < 32 * 48 * 64; i += nth) { const int bh = i / 3072, r = i % 3072; GQ[(size_t)bh * GU * 64 + r] = 0; GK[(size_t)bh * GU * 64 + r] = 0; }
  for (int i = tid; i < 32 * 128 * 48; i += nth) { const int row = i / 48, c = i % 48; GVT[(size_t)row * GU + c] = 0; }
}

template <int MODE>
DI void ph_norm_rows(int vb, const float* __restrict__ src, const float* __restrict__ meta, bf16_t* __restrict__ dst) {
  const int tid256_ = fresh_tid() & 255;
  const int row0 = vb * 16 + (TID >> 6) * 4, lane = TID & 63;
  f32x4 v[4][4];
#pragma unroll
  for (int rr = 0; rr < 4; ++rr)
#pragma unroll
    for (int j = 0; j < 4; ++j) v[rr][j] = *(const f32x4*)(src + (size_t)(row0 + rr) * D + j * 256 + lane * 4);
  f32x4 gg[4];
#pragma unroll
  for (int j = 0; j < 4; ++j) { gg[j] = (f32x4){1.f, 1.f, 1.f, 1.f}; if (MODE == 1) gg[j] = *(const f32x4*)(meta + j * 256 + lane * 4); }
#pragma unroll
  for (int rr = 0; rr < 4; ++rr) {
    float ss = 0.f;
#pragma unroll
    for (int j = 0; j < 4; ++j) ss += v[rr][j].x * v[rr][j].x + v[rr][j].y * v[rr][j].y + v[rr][j].z * v[rr][j].z + v[rr][j].w * v[rr][j].w;
    ss = wave_sum(ss);
    const float r = rsqrtf(ss * (1.0f / D) + EPS);
#pragma unroll
    for (int j = 0; j < 4; ++j) {
      u32x2 o; o.x = pk2(v[rr][j].x * r * gg[j].x, v[rr][j].y * r * gg[j].y); o.y = pk2(v[rr][j].z * r * gg[j].z, v[rr][j].w * r * gg[j].w);
      *(u32x2*)(dst + (size_t)(row0 + rr) * D + j * 256 + lane * 4) = o;
    }
  }
}

namespace pg8 {
#define PG8_LAS __attribute__((address_space(3)))
typedef unsigned short bf16_t;
typedef short bf16x8 __attribute__((ext_vector_type(8)));
typedef float f32x4 __attribute__((ext_vector_type(4)));
typedef unsigned u32x4 __attribute__((ext_vector_type(4)));
constexpr int BM = 256, BK = 64, HALF = 128, HTB = HALF * BK * 2  , STAGE_BYTES = 8 * HTB, NXCD = 8, WGM = 8;

__host__ __device__ __forceinline__ int lds_byte(int r, int c) { const int st = (r >> 4) * 2 + (c >> 5), rr = r & 15, cc = c & 31, ob = rr * 64 + cc * 2; return st * 1024 + (ob ^ (((ob >> 9) & 1) << 5)); }
__host__ __device__ __forceinline__ void stage_rc(int b, int& R, int& C) { const int st = b / 1024, sb = b % 1024, swz = sb ^ (((sb >> 9) & 1) << 5); R = (st >> 1) * 16 + swz / 64; C = (st & 1) * 32 + (swz % 64) / 2; }
__host__ __device__ __forceinline__ int perm32(int rho) { const int n = rho >> 4, i = rho & 15; return 8 * (i >> 2) + 4 * n + (i & 3); }

struct Unit { int pm, pn; };
struct Gemm { const bf16_t* A; const bf16_t* Bt; int M, N, K; };

struct StaticOrder {
    int nM, nN, nwg, G, c;
    __host__ __device__ void init(int M, int N, int G_, int c_) { nM = M / BM; nN = N / BM; nwg = nM * nN; G = G_; c = c_; }
    __host__ __device__ bool next(int i, Unit& u) const {
        const long L = (long)i * G + c; if (L >= nwg) return false;
        int wgid = (int)L; { const int q = nwg / NXCD, r = nwg % NXCD, xcd = wgid % NXCD, off = wgid / NXCD; wgid = (xcd < r ? xcd * (q + 1) : r * (q + 1) + (xcd - r) * q) + off; }
        const int nig = WGM * nN, gid = wgid / nig, fm = gid * WGM, gsz = (nM - fm) < WGM ? (nM - fm) : WGM;
        u.pm = fm + ((wgid % nig) % gsz); u.pn = (wgid % nig) / gsz; return true;
    }
    __device__ __forceinline__ void a_ready(const Unit&) const {}
    __device__ __forceinline__ void done(const Unit&) const {}
};

template <class Epi, class Sched, bool ALIGN_EPI = false, bool SP2 = false>
__device__ __forceinline__ void gemm_phase(PG8_LAS unsigned char* lds, const Gemm g, const Sched& S, const Epi& E) {
    const int tid = fresh_tid(), wid = __builtin_amdgcn_readfirstlane(tid >> 6), lane = tid & 63, wr = wid >> 2, wc = wid & 3, fr = lane & 15, fq = lane >> 4;
    const int K = g.K, nt = K / BK;
    unsigned voffA[2], voffB[2];
#pragma unroll
    for (int i = 0; i < 2; ++i) { int R, C; stage_rc(tid * 16 + i * 8192, R, C); const int Rb = Epi::PERM ? ((R & ~31) + perm32(R & 31)) : R;
        voffA[i] = (unsigned)(R * K + C) * 2u; voffB[i] = (unsigned)(Rb * K + C) * 2u; }
    const size_t kstep = (size_t)(BK * 2);
    const size_t hstep = (size_t)HALF * K * 2;
    const size_t tstep = 2 * hstep;
    const unsigned ldsw = (unsigned)wid * 1024u;
    const int aoff = lds_byte(wr * 64 + fr, fq * 8), boff = lds_byte(wc * 32 + fr, fq * 8);
#define PG8_SA(b, h) (((b) * 2 + (h)) * HTB)
#define PG8_SB(b, h) ((4 + (b) * 2 + (h)) * HTB)
#define PG8_STAGE(bufoff, gbase, voff) do { _Pragma("unroll") for (int _i = 0; _i < 2; ++_i) \
        __builtin_amdgcn_global_load_lds((const unsigned*)((const char*)(gbase) + (voff)[_i]), (PG8_LAS unsigned*)(lds + (bufoff) + ldsw + _i * 8192), 16, 0, 0); } while (0)
#define PG8_LDA(dst, b, h) do { _Pragma("unroll") for (int m = 0; m < 4; ++m) _Pragma("unroll") for (int k = 0; k < 2; ++k) dst[m][k] = *(const PG8_LAS bf16x8*)(lds + PG8_SA(b, h) + aoff + m * 2048 + k * 1024); } while (0)
#define PG8_LDB(dst, b, h) do { _Pragma("unroll") for (int n = 0; n < 2; ++n) _Pragma("unroll") for (int k = 0; k < 2; ++k) dst[n][k] = *(const PG8_LAS bf16x8*)(lds + PG8_SB(b, h) + boff + n * 2048 + k * 1024); } while (0)
#define PG8_MMA(ai, bj, At, Bt) do { __builtin_amdgcn_s_setprio(1); _Pragma("unroll") for (int m = 0; m < 4; ++m) _Pragma("unroll") for (int n = 0; n < 2; ++n) _Pragma("unroll") for (int k = 0; k < 2; ++k) \
        acc[ai][bj][m][n] = __builtin_amdgcn_mfma_f32_16x16x32_bf16(Bt[n][k], At[m][k], acc[ai][bj][m][n], 0, 0, 0); __builtin_amdgcn_s_setprio(0); } while (0)
#define PG8_WAIT_V(n) asm volatile("s_waitcnt vmcnt(" #n ")" ::: "memory")
#define PG8_WAIT_L(n) asm volatile("s_waitcnt lgkmcnt(" #n ")" ::: "memory")
#define PG8_BAR __builtin_amdgcn_s_barrier()
#define PG8_SCHED __builtin_amdgcn_sched_barrier(0)
    Unit cur, nxt; int ui = 0;
    if (!S.next(0, cur)) return;
    f32x4 acc[2][2][4][2];
#pragma unroll
    for (int a = 0; a < 2; ++a)
#pragma unroll
        for (int b = 0; b < 2; ++b)
#pragma unroll
            for (int m = 0; m < 4; ++m)
#pragma unroll
                for (int n = 0; n < 2; ++n) acc[a][b][m][n] = (f32x4){0.f, 0.f, 0.f, 0.f};
    bf16x8 At[4][2], B0[2][2], B1[2][2];
    const char* cA = (const char*)g.A + (size_t)cur.pm * tstep; const char* cB = (const char*)g.Bt + (size_t)cur.pn * tstep;
    S.a_ready(cur);
    if constexpr (SP2) {
        PG8_STAGE(PG8_SB(0, 0), cB, voffB); PG8_STAGE(PG8_SB(0, 1), cB + hstep, voffB); PG8_STAGE(PG8_SA(0, 0), cA, voffA); PG8_STAGE(PG8_SA(0, 1), cA + hstep, voffA);
        if (wr == 1) PG8_BAR;
        PG8_WAIT_V(2); PG8_BAR;
        PG8_STAGE(PG8_SB(1, 0), cB + kstep, voffB); PG8_STAGE(PG8_SA(1, 0), cA + kstep, voffA); PG8_STAGE(PG8_SB(1, 1), cB + hstep + kstep, voffB);
        PG8_WAIT_V(6); PG8_BAR;
    } else {
        PG8_STAGE(PG8_SB(0, 0), cB, voffB); PG8_STAGE(PG8_SA(0, 0), cA, voffA); PG8_STAGE(PG8_SB(0, 1), cB + hstep, voffB); PG8_STAGE(PG8_SA(0, 1), cA + hstep, voffA);
        if (wr == 1) PG8_BAR;
        PG8_WAIT_V(4); PG8_BAR;
        PG8_STAGE(PG8_SB(1, 0), cB + kstep, voffB); PG8_STAGE(PG8_SA(1, 0), cA + kstep, voffA); PG8_STAGE(PG8_SB(1, 1), cB + hstep + kstep, voffB);
        PG8_WAIT_V(6); PG8_BAR;
    }
    for (;;) {
        const bool has_next = S.next(ui + 1, nxt);
        const char* nA = has_next ? (const char*)g.A + (size_t)nxt.pm * tstep : cA; const char* nB = has_next ? (const char*)g.Bt + (size_t)nxt.pn * tstep : cB;
        for (int t = 0; t < nt; t += 2) {
            const bool last = (t == nt - 2);
            const char* a1 = cA + (size_t)(t + 1) * kstep;
            const char* a2 = last ? nA : cA + (size_t)(t + 2) * kstep; const char* b2 = last ? nB : cB + (size_t)(t + 2) * kstep;
            const char* a3 = a2 + kstep; const char* b3 = b2 + kstep;
            if (last && has_next) S.a_ready(nxt);
            if constexpr (SP2) {
            PG8_LDB(B0, 0, 0); PG8_LDB(B1, 0, 1); PG8_SCHED; PG8_LDA(At, 0, 0); PG8_STAGE(PG8_SA(1, 1), a1 + hstep, voffA);
            PG8_WAIT_V(8); PG8_WAIT_L(0); PG8_BAR; PG8_MMA(0, 0, At, B0); PG8_MMA(0, 1, At, B1); PG8_BAR; PG8_SCHED;
            PG8_LDA(At, 0, 1); PG8_STAGE(PG8_SB(0, 0), b2, voffB); PG8_STAGE(PG8_SB(0, 1), b2 + hstep, voffB); PG8_STAGE(PG8_SA(0, 0), a2, voffA);
            PG8_WAIT_V(8); PG8_WAIT_L(0); PG8_BAR; PG8_MMA(1, 0, At, B0); PG8_MMA(1, 1, At, B1); PG8_BAR; PG8_SCHED;
            PG8_LDB(B0, 1, 0); PG8_LDB(B1, 1, 1); PG8_SCHED; PG8_LDA(At, 1, 0); PG8_STAGE(PG8_SA(0, 1), a2 + hstep, voffA);
            PG8_WAIT_V(8); PG8_WAIT_L(0); PG8_BAR; PG8_MMA(0, 0, At, B0); PG8_MMA(0, 1, At, B1); PG8_BAR; PG8_SCHED;
            PG8_LDA(At, 1, 1); PG8_STAGE(PG8_SB(1, 0), b3, voffB); PG8_STAGE(PG8_SB(1, 1), b3 + hstep, voffB); PG8_STAGE(PG8_SA(1, 0), a3, voffA);
            PG8_WAIT_V(8); PG8_WAIT_L(0); PG8_BAR; PG8_MMA(1, 0, At, B0); PG8_MMA(1, 1, At, B1); PG8_BAR; PG8_SCHED;
            } else {
            PG8_LDB(B0, 0, 0); PG8_SCHED; PG8_LDA(At, 0, 0); PG8_STAGE(PG8_SA(1, 1), a1 + hstep, voffA);
            PG8_WAIT_L(8); PG8_BAR; PG8_WAIT_L(0); PG8_MMA(0, 0, At, B0); PG8_BAR; PG8_SCHED;
            PG8_LDB(B1, 0, 1); PG8_STAGE(PG8_SB(0, 0), b2, voffB);
            PG8_BAR; PG8_WAIT_L(0); PG8_MMA(0, 1, At, B1); PG8_BAR;
            PG8_LDA(At, 0, 1); PG8_STAGE(PG8_SA(0, 0), a2, voffA);
            PG8_BAR; PG8_WAIT_L(0); PG8_MMA(1, 0, At, B0); PG8_BAR; PG8_SCHED;
            PG8_STAGE(PG8_SB(0, 1), b2 + hstep, voffB);
            PG8_WAIT_V(6); PG8_BAR; PG8_MMA(1, 1, At, B1); PG8_BAR;
            PG8_LDB(B0, 1, 0); PG8_SCHED; PG8_LDA(At, 1, 0); PG8_STAGE(PG8_SA(0, 1), a2 + hstep, voffA);
            PG8_WAIT_L(8); PG8_BAR; PG8_WAIT_L(0); PG8_MMA(0, 0, At, B0); PG8_BAR; PG8_SCHED;
            PG8_LDB(B1, 1, 1); PG8_STAGE(PG8_SB(1, 0), b3, voffB);
            PG8_BAR; PG8_WAIT_L(0); PG8_MMA(0, 1, At, B1); PG8_BAR;
            PG8_LDA(At, 1, 1); PG8_STAGE(PG8_SA(1, 0), a3, voffA);
            PG8_BAR; PG8_WAIT_L(0); PG8_MMA(1, 0, At, B0); PG8_BAR; PG8_SCHED;
            PG8_STAGE(PG8_SB(1, 1), b3 + hstep, voffB);
            PG8_WAIT_V(6); PG8_BAR; PG8_MMA(1, 1, At, B1); PG8_BAR;
            }
        }
        if constexpr (ALIGN_EPI) { if (wr == 0) PG8_BAR; }
        if constexpr (!Epi::AFTER_DRAIN) { E(acc, cur, wr, wc, fr, fq); S.done(cur); }
        if (!has_next) break;
#pragma unroll
        for (int a = 0; a < 2; ++a)
#pragma unroll
            for (int b = 0; b < 2; ++b)
#pragma unroll
                for (int m = 0; m < 4; ++m)
#pragma unroll
                    for (int n = 0; n < 2; ++n) acc[a][b][m][n] = (f32x4){0.f, 0.f, 0.f, 0.f};
        cur = nxt; cA = nA; cB = nB; ++ui;
        if constexpr (ALIGN_EPI) { if (wr == 1) PG8_BAR; }
    }
    PG8_WAIT_V(0);
    if constexpr (!ALIGN_EPI) { if (wr == 0) PG8_BAR; }
    PG8_BAR;
    if constexpr (Epi::AFTER_DRAIN) { E.fused(acc, cur, wr, wc, fr, fq, lds, wid, lane); S.done(cur); }
#undef PG8_SA
#undef PG8_SB
#undef PG8_STAGE
#undef PG8_LDA
#undef PG8_LDB
#undef PG8_MMA
#undef PG8_WAIT_V
#undef PG8_WAIT_L
#undef PG8_BAR
#undef PG8_SCHED
}
}

struct InProjOut { bf16_t *QSB, *KSB, *VSB, *VTSB, *GQ, *GK, *GV, *GR; float* GLR; };

struct EpiInProj {
  static constexpr bool PERM = true, AFTER_DRAIN = false;
  InProjOut O; bf16_t* GVT; char* stage;
  DI void store_vt(const pg8::f32x4 (&acc)[2][2][4][2], const pg8::Unit& u, int wr, int wc, int fr, int fq) const {
    bf16_t* st = (bf16_t*)(stage + (wr * 4 + wc) * 1280);
    const int lane = fr + 16 * fq;
    const int rc = lane >> 2, r8 = lane & 3;
#pragma unroll
    for (int ai = 0; ai < 2; ++ai)
#pragma unroll
      for (int bj = 0; bj < 2; ++bj)
#pragma unroll
        for (int mp = 0; mp < 2; ++mp)
#pragma unroll
          for (int ch = 0; ch < 2; ++ch) {
            if ((fq >> 1) == ch) {
#pragma unroll
              for (int m2 = 0; m2 < 2; ++m2)
#pragma unroll
                for (int n = 0; n < 2; ++n) {
                  const pg8::f32x4 v = acc[ai][bj][2 * mp + m2][n];
                  const int cl = 8 * (fq & 1) + 4 * n, rl = 16 * m2 + fr;
                  st[(cl + 0) * 40 + rl] = (bf16_t)f2bf(v[0]); st[(cl + 1) * 40 + rl] = (bf16_t)f2bf(v[1]);
                  st[(cl + 2) * 40 + rl] = (bf16_t)f2bf(v[2]); st[(cl + 3) * 40 + rl] = (bf16_t)f2bf(v[3]);
                }
            }
            asm volatile("s_waitcnt lgkmcnt(0)" ::: "memory");
            const u32x4 w = *(const u32x4*)&st[rc * 40 + 8 * r8];
            asm volatile("" ::: "memory");
            const int col = u.pn * 256 + bj * 128 + wc * 32 + 16 * ch + rc;
            const int row = u.pm * 256 + ai * 128 + wr * 64 + 32 * mp + 8 * r8;
            const int b = row >> 13, i = row & 8191;
            bf16_t* dst;
            if (u.pn < 6) { const int c = col - 1024; dst = O.VTSB + ((size_t)(b * SBH + (c >> 6)) * 64 + (c & 63)) * KIDX + 32 + i; }
            else          { const int c = col - 2048; dst = GVT + ((size_t)(b * GH + (c >> 7)) * 128 + (c & 127)) * GU + 64 + i; }
            *(u32x4*)dst = w;
          }
  }
  DI void operator()(const pg8::f32x4 (&acc)[2][2][4][2], const pg8::Unit& u, int wr, int wc, int fr, int fq) const {
    const int pn = u.pn;
    if (pn == 4 || pn == 5 || pn == 8 || pn == 9) { store_vt(acc, u, wr, wc, fr, fq); return; }
#pragma unroll
    for (int ai = 0; ai < 2; ++ai)
#pragma unroll
      for (int m = 0; m < 4; ++m) {
        const int row = u.pm * 256 + ai * 128 + wr * 64 + m * 16 + fr;
        const int b = row >> 13, i = row & 8191;
#pragma unroll
        for (int bj = 0; bj < 2; ++bj) {
          const int col = pn * 256 + bj * 128 + wc * 32 + 8 * fq;
          const pg8::f32x4 v0 = acc[ai][bj][m][0], v1 = acc[ai][bj][m][1];
          if (pn < 12) {
            u32x4 w; w.x = pk2(v0[0], v0[1]); w.y = pk2(v0[2], v0[3]); w.z = pk2(v1[0], v1[1]); w.w = pk2(v1[2], v1[3]);
            bf16_t* dst;
            if (pn < 2)       { const int c = col;        dst = O.QSB + ((size_t)(b * SBH + (c >> 6)) * SEQ + i) * 64 + (c & 63); }
            else if (pn < 4)  { const int c = col - 512;  dst = O.KSB + ((size_t)(b * SBH + (c >> 6)) * KIDX + 32 + i) * 64 + (c & 63); }
            else if (pn == 6) { const int c = col - 1536; dst = O.GQ + ((size_t)(b * GH + (c >> 6)) * GU + 64 + i) * 64 + (c & 63); }
            else if (pn == 7) { const int c = col - 1792; dst = O.GK + ((size_t)(b * GH + (c >> 6)) * GU + 64 + i) * 64 + (c & 63); }
            else              { const int c = col - 2560; dst = O.GR + (size_t)row * 512 + c; }
            *(u32x4*)dst = w;
          } else if (col < NIN) {
            float* dst = O.GLR + ((size_t)b * GU + 64 + i) * 16 + (col - 3072);
            *(f32x4*)dst = (f32x4){v0[0], v0[1], v0[2], v0[3]};
            *(f32x4*)(dst + 4) = (f32x4){v1[0], v1[1], v1[2], v1[3]};
          }
        }
      }
  }
};
struct EpiOut {
  static constexpr bool PERM = true, AFTER_DRAIN = false;
  const float* x; bf16_t* H1;
  DI void operator()(const pg8::f32x4 (&acc)[2][2][4][2], const pg8::Unit& u, int wr, int wc, int fr, int fq) const {
#pragma unroll
    for (int ai = 0; ai < 2; ++ai)
#pragma unroll
      for (int m = 0; m < 4; ++m) {
        const size_t rowoff = (size_t)(u.pm * 256 + ai * 128 + wr * 64 + m * 16 + fr) * D;
#pragma unroll
        for (int bj = 0; bj < 2; ++bj) {
          const size_t idx = rowoff + u.pn * 256 + bj * 128 + wc * 32 + 8 * fq;
          const f32x4 x0 = *(const f32x4*)(x + idx), x1 = *(const f32x4*)(x + idx + 4);
          const pg8::f32x4 v0 = acc[ai][bj][m][0], v1 = acc[ai][bj][m][1];
          u32x4 w; w.x = pk2(x0.x + v0[0], x0.y + v0[1]); w.y = pk2(x0.z + v0[2], x0.w + v0[3]); w.z = pk2(x1.x + v1[0], x1.y + v1[1]); w.w = pk2(x1.z + v1[2], x1.w + v1[3]);
          *(u32x4*)(H1 + idx) = w;
        }
      }
  }
};
struct EpiPQ {
  static constexpr bool PERM = true, AFTER_DRAIN = false;
  bf16_t* QP; const float* R2;
  DI void operator()(const pg8::f32x4 (&acc)[2][2][4][2], const pg8::Unit& u, int wr, int wc, int fr, int fq) const {
#pragma unroll
    for (int ai = 0; ai < 2; ++ai)
#pragma unroll
      for (int m = 0; m < 4; ++m) {
        const int row = u.pm * 256 + ai * 128 + wr * 64 + m * 16 + fr;
        const float r = R2[row];
        const size_t rowoff = (size_t)row * D;
#pragma unroll
        for (int bj = 0; bj < 2; ++bj) {
          const pg8::f32x4 v0 = acc[ai][bj][m][0], v1 = acc[ai][bj][m][1];
          u32x4 w; w.x = pk2(v0[0] * r, v0[1] * r); w.y = pk2(v0[2] * r, v0[3] * r); w.z = pk2(v1[0] * r, v1[1] * r); w.w = pk2(v1[2] * r, v1[3] * r);
          *(u32x4*)(QP + rowoff + u.pn * 256 + bj * 128 + wc * 32 + 8 * fq) = w;
        }
      }
  }
};

DI void ph_meta(int blk, char* smem, const float* __restrict__ meta, const float* __restrict__ g1, const float* __restrict__ w_in, const InProjOut& O) {
  float (*xmT)[16] = (float (*)[16])smem;
  float (*red)[256] = (float (*)[256])(smem + 65536);
  const int tid = fresh_tid(), lane = tid & 63, wave = tid >> 6;
  for (int rr = 0; rr < 2; ++rr) {
    const int mm = wave * 2 + rr;
    float v[16]; float ss = 0.f;
#pragma unroll
    for (int j = 0; j < 16; ++j) { v[j] = meta[(size_t)mm * D + j * 64 + lane]; ss += v[j] * v[j]; }
    ss = wave_sum(ss);
    const float r = rsqrtf(ss * (1.0f / D) + EPS);
#pragma unroll
    for (int j = 0; j < 16; ++j) xmT[j * 64 + lane][mm] = v[j] * r * g1[j * 64 + lane];
  }
  __syncthreads();
  {
    const int c = tid & 15, ks = tid >> 4, n = blk * 16 + c;
    float acc[16];
#pragma unroll
    for (int j = 0; j < 16; ++j) acc[j] = 0.f;
#pragma unroll 8
    for (int kk = 0; kk < 32; ++kk) {
      const int k = ks * 32 + kk;
      const float w = w_in[(size_t)k * NIN + n];
      const f32x4 a = *(const f32x4*)&xmT[k][0], b4 = *(const f32x4*)&xmT[k][4], c4 = *(const f32x4*)&xmT[k][8], d4 = *(const f32x4*)&xmT[k][12];
      acc[0] += a.x * w; acc[1] += a.y * w; acc[2] += a.z * w; acc[3] += a.w * w;
      acc[4] += b4.x * w; acc[5] += b4.y * w; acc[6] += b4.z * w; acc[7] += b4.w * w;
      acc[8] += c4.x * w; acc[9] += c4.y * w; acc[10] += c4.z * w; acc[11] += c4.w * w;
      acc[12] += d4.x * w; acc[13] += d4.y * w; acc[14] += d4.z * w; acc[15] += d4.w * w;
    }
#pragma unroll
    for (int mm = 0; mm < 16; ++mm) red[ks][c * 16 + mm] = acc[mm];
  }
  __syncthreads();
  if (tid < 256) {
    const int c = tid >> 4, mm = tid & 15, n = blk * 16 + c;
    float val = 0.f;
#pragma unroll 8
    for (int ks = 0; ks < 32; ++ks) val += red[ks][tid];
    const bf16_t hv = (bf16_t)f2bf(val);
    for (int bb = 0; bb < NB; ++bb) {
      if (n < 512) {}
      else if (n < 1024) { const int cc = n - 512;  O.KSB[((size_t)(bb * SBH + (cc >> 6)) * KIDX + 16 + mm) * 64 + (cc & 63)] = hv; }
      else if (n < 1536) { const int cc = n - 1024; O.VTSB[((size_t)(bb * SBH + (cc >> 6)) * 64 + (cc & 63)) * KIDX + 16 + mm] = hv; }
      else if (n < 1792) { const int cc = n - 1536; O.GQ[((size_t)(bb * GH + (cc >> 6)) * GU + 48 + mm) * 64 + (cc & 63)] = hv; }
      else if (n < 2048) { const int cc = n - 1792; O.GK[((size_t)(bb * GH + (cc >> 6)) * GU + 48 + mm) * 64 + (cc & 63)] = hv; }
      else if (n < 2560) { const int cc = n - 2048; O.GV[((size_t)(bb * GH + (cc >> 7)) * 128 + (cc & 127)) * GU + 48 + mm] = hv; }
      else if (n < 3072) {}
      else { O.GLR[((size_t)bb * GU + 48 + mm) * 16 + (n - 3072)] = val; }
    }
  }
  __syncthreads();
}


constexpr float SB_THR = 1.17549435e-38f;
DI void ph_sb_attn(int vb, const bf16_t* __restrict__ QSB, const bf16_t* __restrict__ KSB, const bf16_t* __restrict__ VTSB,
                                                 const float* __restrict__ sb_g, bf16_t* __restrict__ MIX) {
  const int tid256_ = fresh_tid() & 255;
  const int lane = TID & 63, wave = TID >> 6, r = lane & 31, h = lane >> 5;
  const int bh = vb >> 6, qb = vb & 63;
  const int b = bh >> 3, hd = bh & 7;
  const int i0 = qb * 128 + wave * 32;
  const bf16_t* Qb = QSB + ((size_t)bh * SEQ + i0) * 64;
  const bf16_t* Kb = KSB + (size_t)bh * KIDX * 64;
  const bf16_t* Vb = VTSB + (size_t)bh * 64 * KIDX;
  bf16x8 qf[4];
#pragma unroll
  for (int ks = 0; ks < 4; ++ks) qf[ks] = *(const bf16x8*)(Qb + r * 64 + ks * 16 + h * 8);
  f32x16 o[2];
#pragma unroll
  for (int e = 0; e < 16; ++e) { o[0][e] = 0.f; o[1][e] = 0.f; }
  float R = 1.f;
  const int qidx = 32 + i0 + r;
  for (int c = (i0 >> 5) + 1; c >= 0; --c) {
    const int k0 = 32 * c;
    bf16x8 kf[4];
#pragma unroll
    for (int ks = 0; ks < 4; ++ks) kf[ks] = *(const bf16x8*)(Kb + (size_t)(k0 + r) * 64 + ks * 16 + h * 8);
    bf16x8 vf[2][2];
#pragma unroll
    for (int mt = 0; mt < 2; ++mt)
#pragma unroll
      for (int s2 = 0; s2 < 2; ++s2) {
        const bf16_t* vp = Vb + (size_t)(mt * 32 + r) * KIDX + k0 + 16 * s2 + 4 * h;
        const u32x2 lo = *(const u32x2*)vp, hi = *(const u32x2*)(vp + 8);
        u32x4 t; t.x = lo.x; t.y = lo.y; t.z = hi.x; t.w = hi.y;
        vf[mt][s2] = __builtin_bit_cast(bf16x8, t);
      }
    f32x16 s;
#pragma unroll
    for (int e = 0; e < 16; ++e) s[e] = 0.f;
#pragma unroll
    for (int ks = 0; ks < 4; ++ks) s = MFMA32(kf[ks], qf[ks], s);
    float om[16], bt[16];
#pragma unroll
    for (int e = 0; e < 16; ++e) {
      const int kidx = k0 + crow(e, h);
      const bool valid = (kidx < qidx) && (kidx >= 16);
      const float z = s[e] * 0.125f;
      const float ez = __expf(-fabsf(z));
      const float big = __builtin_amdgcn_rcpf(1.f + ez), small = ez * big;
      const float beta = z >= 0.f ? big : small, onem = z >= 0.f ? small : big;
      om[e] = valid ? onem : 1.f;
      bt[e] = valid ? beta : 0.f;
    }
    float sfx[16], G[4], PG[4];
#pragma unroll
    for (int g = 0; g < 4; ++g) {
      sfx[4 * g + 3] = 1.f;
      sfx[4 * g + 2] = om[4 * g + 3];
      sfx[4 * g + 1] = sfx[4 * g + 2] * om[4 * g + 2];
      sfx[4 * g + 0] = sfx[4 * g + 1] * om[4 * g + 1];
      G[g] = sfx[4 * g + 0] * om[4 * g + 0];
      PG[g] = __shfl_xor(G[g], 32);
    }
    float HS[4];
    HS[3] = 1.f;
    HS[2] = G[3] * PG[3];
    HS[1] = HS[2] * (G[2] * PG[2]);
    HS[0] = HS[1] * (G[1] * PG[1]);
    const float total = HS[0] * (G[0] * PG[0]);
    float a[16];
#pragma unroll
    for (int e = 0; e < 16; ++e) {
      const int g = e >> 2;
      const float between = sfx[e] * (h == 0 ? PG[g] : 1.f) * (HS[g] * R);
      a[e] = bt[e] * between;
    }
    R *= total;
#pragma unroll
    for (int s2 = 0; s2 < 2; ++s2) {
      u32x4 p;
      p.x = pk2(a[8 * s2 + 0], a[8 * s2 + 1]); p.y = pk2(a[8 * s2 + 2], a[8 * s2 + 3]);
      p.z = pk2(a[8 * s2 + 4], a[8 * s2 + 5]); p.w = pk2(a[8 * s2 + 6], a[8 * s2 + 7]);
      const bf16x8 pf = __builtin_bit_cast(bf16x8, p);
      o[0] = MFMA32(vf[0][s2], pf, o[0]);
      o[1] = MFMA32(vf[1][s2], pf, o[1]);
    }
    if (__all(R < SB_THR)) break;
  }
  float ss = 0.f;
#pragma unroll
  for (int e = 0; e < 16; ++e) ss += o[0][e] * o[0][e] + o[1][e] * o[1][e];
  ss += __shfl_xor(ss, 32);
  const float sc = rsqrtf(ss * (1.0f / 64.0f) + EPS);
  bf16_t* outp = MIX + (size_t)(b * SEQ + i0 + r) * D + hd * 64;
#pragma unroll
  for (int mt = 0; mt < 2; ++mt)
#pragma unroll
    for (int g = 0; g < 4; ++g) {
      const int d = mt * 32 + 8 * g + 4 * h;
      const f32x4 gg = *(const f32x4*)(sb_g + hd * 64 + d);
      u32x2 pk;
      pk.x = pk2(o[mt][4 * g] * sc * gg.x, o[mt][4 * g + 1] * sc * gg.y);
      pk.y = pk2(o[mt][4 * g + 2] * sc * gg.z, o[mt][4 * g + 3] * sc * gg.w);
      *(u32x2*)(outp + d) = pk;
    }
}


constexpr int RT_TOK_PER_BLOCK = 256;


#define MFMA16(a, b, c) __builtin_amdgcn_mfma_f32_16x16x32_bf16((a), (b), (c), 0, 0, 0)
constexpr int GLDS = 72;
struct GlaLds {
  bf16_t Qt[64 * GLDS];
  bf16_t Kt[64 * GLDS];
  bf16_t KT[64 * GLDS];
  bf16_t P[64 * GLDS];
  float dec[64];
  float tot[8][64];
  float ssq[8][64];
};
constexpr size_t WS_SLOC = 926 * MiB;
constexpr size_t WS_DTOT = 942 * MiB;
constexpr size_t WS_GVT = 604 * MiB;

struct GlaPtrs { const bf16_t *GQ, *GK, *GVT, *GR; const float *GLR, *wg, *bg, *gla_g; float *SLOC, *DTOT; bf16_t* MIX; };


constexpr size_t WS_GQT = 80 * MiB;
constexpr size_t WS_GKT = 113 * MiB;
constexpr size_t WS_GKTT = 146 * MiB;
constexpr size_t WS_GDEC = 179 * MiB;
constexpr size_t WS_GBL = 182 * MiB;
struct GlaPrepPtrs { const bf16_t *GQ, *GK; const float *GLR, *wg, *bg; bf16_t *QT, *KT, *KTT; float *DEC, *BL; };
DI void ph_gla_prep(int item, char* smem, const GlaPrepPtrs& G) {
  float (*tot)[64] = (float (*)[64])smem;
  const int tid = fresh_tid(), lane = tid & 63, w = tid >> 6;
  const int bh = item / 129, c = item % 129, b = bh >> 2, hd = bh & 3, u0 = 64 * c;
  float wgr[16];
#pragma unroll
  for (int k = 0; k < 16; ++k) wgr[k] = G.wg[k * 256 + hd * 64 + lane];
  const float bgv = G.bg[hd * 64 + lane];
  float cs[8]; float run = 0.f;
  unsigned short kraw[8], qraw[8];
#pragma unroll
  for (int i = 0; i < 8; ++i) {
    const int u = u0 + 8 * w + i;
    kraw[i] = G.GK[((size_t)bh * GU + u) * 64 + lane];
    qraw[i] = G.GQ[((size_t)bh * GU + u) * 64 + lane];
    float lgv = 0.f;
    if (u >= 48) {
      const f32x4* gp = (const f32x4*)(G.GLR + ((size_t)b * GU + u) * 16);
      const f32x4 g0 = gp[0], g1 = gp[1], g2 = gp[2], g3 = gp[3];
      float a = bgv;
      a += g0.x * wgr[0] + g0.y * wgr[1] + g0.z * wgr[2] + g0.w * wgr[3];
      a += g1.x * wgr[4] + g1.y * wgr[5] + g1.z * wgr[6] + g1.w * wgr[7];
      a += g2.x * wgr[8] + g2.y * wgr[9] + g2.z * wgr[10] + g2.w * wgr[11];
      a += g3.x * wgr[12] + g3.y * wgr[13] + g3.z * wgr[14] + g3.w * wgr[15];
      lgv = -softplus(-a) * (1.0f / 16.0f);
    }
    run += lgv; cs[i] = run;
  }
  tot[w][lane] = run;
  __syncthreads();
  float offset = 0.f, total = 0.f;
#pragma unroll
  for (int s2 = 0; s2 < 8; ++s2) { const float tv = tot[s2][lane]; total += tv; if (s2 < w) offset += tv; }
  const size_t cb = ((size_t)bh * 129 + c) * 4096;
  float kt[8];
#pragma unroll
  for (int i = 0; i < 8; ++i) {
    const float bc = offset + cs[i];
    kt[i] = bf2f(kraw[i]) * __expf(-bc);
    G.QT[cb + (8 * w + i) * 64 + lane] = (bf16_t)f2bf(bf2f(qraw[i]) * __expf(bc) * 0.125f);
    G.KT[cb + (8 * w + i) * 64 + lane] = (bf16_t)f2bf(kt[i]);
  }
  u32x4 kp; kp.x = pk2(kt[0], kt[1]); kp.y = pk2(kt[2], kt[3]); kp.z = pk2(kt[4], kt[5]); kp.w = pk2(kt[6], kt[7]);
  *(u32x4*)(G.KTT + cb + lane * 64 + 8 * w) = kp;
  if (w == 0) { G.DEC[((size_t)bh * 129 + c) * 64 + lane] = __expf(total); G.BL[((size_t)bh * 129 + c) * 64 + lane] = total; }
  __syncthreads();
}

struct GlaBuf { bf16_t Qt[64 * GLDS]; bf16_t Kt[64 * GLDS]; bf16_t KT[64 * GLDS]; };
struct GlaLds3 { GlaBuf B[2]; bf16_t P[64 * GLDS]; float ssq[8][64]; };
struct GlaPtrs3 { const bf16_t *QT, *KT, *KTT, *GVT, *GR; const float *DEC, *BL, *gla_g; float *SLOC, *DTOT; bf16_t* MIX; };

template <int PASS>
DI void gla_item3(int bh, int sc, char* smem, const GlaPtrs3& G) {
  GlaLds3& L = *(GlaLds3*)smem;
  const int tid = fresh_tid(), lane = tid & 63, w = __builtin_amdgcn_readfirstlane(tid >> 6), c16 = lane & 15, q = lane >> 4;
  const int b = bh >> 2, hd = bh & 3;
  const int cbeg = sc == 0 ? 0 : 8 * sc + 1, cend = 8 * sc + 9;
  f32x4 X[4];
#pragma unroll
  for (int i = 0; i < 4; ++i) X[i] = (f32x4){0.f, 0.f, 0.f, 0.f};
  if (PASS == 1) {
#pragma unroll 4
    for (int j = 0; j < sc; ++j) {
      const float* dt = G.DTOT + (size_t)(bh * 16 + j) * 64;
      const float* sl = G.SLOC + ((size_t)(bh * 16 + j) * 8 + w) * 16 * 64 + lane;
#pragma unroll
      for (int i = 0; i < 4; ++i) {
        const f32x4 d4 = *(const f32x4*)(dt + 16 * i + 4 * q);
        X[i][0] = d4.x * X[i][0] + sl[(4 * i + 0) * 64]; X[i][1] = d4.y * X[i][1] + sl[(4 * i + 1) * 64];
        X[i][2] = d4.z * X[i][2] + sl[(4 * i + 2) * 64]; X[i][3] = d4.w * X[i][3] + sl[(4 * i + 3) * 64];
      }
    }
  }
  f32x4 gain = {1.f, 1.f, 1.f, 1.f};
  if (PASS == 1) gain = *(const f32x4*)(G.gla_g + hd * 128 + 16 * w + 4 * q);
  const bf16_t* gvt = G.GVT + ((size_t)bh * 128 + 16 * w + c16) * GU + 8 * q;
  const int srow = tid >> 3, sc8 = tid & 7, soff = srow * GLDS + sc8 * 8;
  const size_t cb0 = (size_t)bh * 129 * 4096 + (size_t)srow * 64 + sc8 * 8;
  u32x4 rq, rk, rkt, rq2, rk2, rkt2; bf16x8 vfr[2], vfn[2], vfn2[2]; f32x4 dec[4], decn[4], decn2[4];
  {
    const size_t cb = cb0 + (size_t)cbeg * 4096;
    rkt = *(const u32x4*)(G.KTT + cb);
    if (PASS == 1) { rq = *(const u32x4*)(G.QT + cb); rk = *(const u32x4*)(G.KT + cb); }
    vfr[0] = *(const bf16x8*)(gvt + 64 * cbeg); vfr[1] = *(const bf16x8*)(gvt + 64 * cbeg + 32);
#pragma unroll
    for (int i = 0; i < 4; ++i) dec[i] = *(const f32x4*)(G.DEC + ((size_t)bh * 129 + cbeg) * 64 + 16 * i + 4 * q);
    *(u32x4*)&L.B[0].KT[soff] = rkt;
    if (PASS == 1) { *(u32x4*)&L.B[0].Qt[soff] = rq; *(u32x4*)&L.B[0].Kt[soff] = rk; }
    const size_t cb1 = cb0 + (size_t)(cbeg + 1) * 4096;
    rkt = *(const u32x4*)(G.KTT + cb1);
    if (PASS == 1) { rq = *(const u32x4*)(G.QT + cb1); rk = *(const u32x4*)(G.KT + cb1); }
    vfn[0] = *(const bf16x8*)(gvt + 64 * (cbeg + 1)); vfn[1] = *(const bf16x8*)(gvt + 64 * (cbeg + 1) + 32);
#pragma unroll
    for (int i = 0; i < 4; ++i) decn[i] = *(const f32x4*)(G.DEC + ((size_t)bh * 129 + cbeg + 1) * 64 + 16 * i + 4 * q);
  }
  __syncthreads();
  for (int c = cbeg; c < cend; ++c) {
    const int cur = (c - cbeg) & 1;
    const GlaBuf& Bc = L.B[cur];
    const bool more = c + 1 < cend, more2 = c + 2 < cend;
    if (more2) {
      const size_t cb = cb0 + (size_t)(c + 2) * 4096;
      rkt2 = *(const u32x4*)(G.KTT + cb);
      if (PASS == 1) { rq2 = *(const u32x4*)(G.QT + cb); rk2 = *(const u32x4*)(G.KT + cb); }
      vfn2[0] = *(const bf16x8*)(gvt + 64 * (c + 2)); vfn2[1] = *(const bf16x8*)(gvt + 64 * (c + 2) + 32);
#pragma unroll
      for (int i = 0; i < 4; ++i) decn2[i] = *(const f32x4*)(G.DEC + ((size_t)bh * 129 + c + 2) * 64 + 16 * i + 4 * q);
    }
    u32x2 grv[4];
    if (PASS == 1 && c >= 1) {
#pragma unroll
      for (int n = 0; n < 4; ++n) grv[n] = *(const u32x2*)(G.GR + ((size_t)b * SEQ + 64 * (c - 1) + 16 * n + c16) * 512 + hd * 128 + 16 * w + 4 * q);
    }
    f32x4 OT[4];
    if (PASS == 1) {
      const int is = w >> 1;
#pragma unroll
      for (int z = 0; z < 2; ++z) {
        const int it = 2 * (w & 1) + z;
        f32x4 pa = {0.f, 0.f, 0.f, 0.f};
        if (is <= it) {
#pragma unroll
          for (int kk = 0; kk < 2; ++kk) {
            const bf16x8 ka = *(const bf16x8*)&Bc.Kt[(16 * is + c16) * GLDS + 32 * kk + 8 * q];
            const bf16x8 qb = *(const bf16x8*)&Bc.Qt[(16 * it + c16) * GLDS + 32 * kk + 8 * q];
            pa = MFMA16(ka, qb, pa);
          }
          if (is == it) {
#pragma unroll
            for (int r = 0; r < 4; ++r) if (4 * q + r > c16) pa[r] = 0.f;
          }
        }
        u32x2 pw; pw.x = pk2(pa[0], pa[1]); pw.y = pk2(pa[2], pa[3]);
        *(u32x2*)&L.P[(16 * it + c16) * GLDS + 16 * is + 4 * q] = pw;
      }
#pragma unroll
      for (int n = 0; n < 4; ++n) OT[n] = (f32x4){0.f, 0.f, 0.f, 0.f};
#pragma unroll
      for (int kk = 0; kk < 2; ++kk) {
        u32x4 xp; xp.x = pk2(X[2 * kk][0], X[2 * kk][1]); xp.y = pk2(X[2 * kk][2], X[2 * kk][3]);
        xp.z = pk2(X[2 * kk + 1][0], X[2 * kk + 1][1]); xp.w = pk2(X[2 * kk + 1][2], X[2 * kk + 1][3]);
        const bf16x8 xa = __builtin_bit_cast(bf16x8, xp);
#pragma unroll
        for (int n = 0; n < 4; ++n) {
          const u32x2 lo = *(const u32x2*)&Bc.Qt[(16 * n + c16) * GLDS + 32 * kk + 4 * q];
          const u32x2 hi = *(const u32x2*)&Bc.Qt[(16 * n + c16) * GLDS + 32 * kk + 16 + 4 * q];
          u32x4 qq; qq.x = lo.x; qq.y = lo.y; qq.z = hi.x; qq.w = hi.y;
          OT[n] = MFMA16(xa, __builtin_bit_cast(bf16x8, qq), OT[n]);
        }
      }
      __syncthreads();
#pragma unroll
      for (int kk = 0; kk < 2; ++kk)
#pragma unroll
        for (int n = 0; n < 4; ++n) {
          const bf16x8 pb = *(const bf16x8*)&L.P[(16 * n + c16) * GLDS + 32 * kk + 8 * q];
          OT[n] = MFMA16(vfr[kk], pb, OT[n]);
        }
    }
#pragma unroll
    for (int i = 0; i < 4; ++i) {
#pragma unroll
      for (int kk = 0; kk < 2; ++kk) {
        const bf16x8 ka = *(const bf16x8*)&Bc.KT[(16 * i + c16) * GLDS + 32 * kk + 8 * q];
        X[i] = MFMA16(ka, vfr[kk], X[i]);
      }
      X[i][0] *= dec[i].x; X[i][1] *= dec[i].y; X[i][2] *= dec[i].z; X[i][3] *= dec[i].w;
    }
    if (PASS == 1 && c >= 1) {
      float ss[4];
#pragma unroll
      for (int n = 0; n < 4; ++n) {
        float v = OT[n][0] * OT[n][0] + OT[n][1] * OT[n][1] + OT[n][2] * OT[n][2] + OT[n][3] * OT[n][3];
        v += __shfl_xor(v, 16); v += __shfl_xor(v, 32);
        ss[n] = v;
      }
      if (q == 0) {
#pragma unroll
        for (int n = 0; n < 4; ++n) L.ssq[w][16 * n + c16] = ss[n];
      }
      __syncthreads();
#pragma unroll
      for (int n = 0; n < 4; ++n) {
        float tot = 0.f;
#pragma unroll
        for (int w2 = 0; w2 < 8; ++w2) tot += L.ssq[w2][16 * n + c16];
        const float scl = rsqrtf(tot * (1.0f / 128.0f) + EPS);
        const size_t m = (size_t)b * SEQ + 64 * (c - 1) + 16 * n + c16;
        const float r0 = bflo(grv[n].x), r1 = bfhi(grv[n].x), r2 = bflo(grv[n].y), r3 = bfhi(grv[n].y);
        const float o0 = OT[n][0] * scl * gain.x * (r0 / (1.f + __expf(-r0)));
        const float o1 = OT[n][1] * scl * gain.y * (r1 / (1.f + __expf(-r1)));
        const float o2 = OT[n][2] * scl * gain.z * (r2 / (1.f + __expf(-r2)));
        const float o3 = OT[n][3] * scl * gain.w * (r3 / (1.f + __expf(-r3)));
        u32x2 ow; ow.x = pk2(o0, o1); ow.y = pk2(o2, o3);
        *(u32x2*)(G.MIX + m * D + 512 + hd * 128 + 16 * w + 4 * q) = ow;
      }
    }
    if (more) {
      GlaBuf& Bn = L.B[cur ^ 1];
      *(u32x4*)&Bn.KT[soff] = rkt;
      if (PASS == 1) { *(u32x4*)&Bn.Qt[soff] = rq; *(u32x4*)&Bn.Kt[soff] = rk; }
      vfr[0] = vfn[0]; vfr[1] = vfn[1];
#pragma unroll
      for (int i = 0; i < 4; ++i) dec[i] = decn[i];
      rkt = rkt2; rq = rq2; rk = rk2; vfn[0] = vfn2[0]; vfn[1] = vfn2[1];
#pragma unroll
      for (int i = 0; i < 4; ++i) decn[i] = decn2[i];
    }
    __syncthreads();
  }
  if (PASS == 0) {
    float* sl = G.SLOC + ((size_t)(bh * 16 + sc) * 8 + w) * 16 * 64 + lane;
#pragma unroll
    for (int i = 0; i < 4; ++i)
#pragma unroll
      for (int r = 0; r < 4; ++r) sl[(4 * i + r) * 64] = X[i][r];
    if (w == 0) {
      float bl = 0.f;
      for (int c = cbeg; c < cend; ++c) bl += G.BL[((size_t)bh * 129 + c) * 64 + lane];
      G.DTOT[(size_t)(bh * 16 + sc) * 64 + lane] = __expf(bl);
    }
  }
}


struct GlaLds4 { GlaBuf B[2]; bf16_t P[64 * GLDS]; float ssq[4][64]; };
template <int PASS>
DI void gla_item4(int bh_lo, int sc, char* smem, const GlaPtrs3& G) {
  const int tid = fresh_tid(), lane = tid & 63, w = __builtin_amdgcn_readfirstlane(tid >> 6), c16 = lane & 15, q = lane >> 4;
  const int hb = w >> 2, w4 = w & 3, tid4 = tid & 255;
  GlaLds4& L = *(GlaLds4*)(smem + hb * (int)sizeof(GlaLds4));
  const int bh = bh_lo + 16 * hb, b = bh >> 2, hd = bh & 3;
  const int cbeg = sc == 0 ? 0 : 8 * sc + 1, cend = 8 * sc + 9;
  f32x4 X[2][4];
#pragma unroll
  for (int et = 0; et < 2; ++et)
#pragma unroll
    for (int i = 0; i < 4; ++i) X[et][i] = (f32x4){0.f, 0.f, 0.f, 0.f};
  if (PASS == 1) {
#pragma unroll 2
    for (int j = 0; j < sc; ++j) {
      const float* dt = G.DTOT + (size_t)(bh * 16 + j) * 64;
#pragma unroll
      for (int et = 0; et < 2; ++et) {
        const float* sl = G.SLOC + ((size_t)(bh * 16 + j) * 8 + w4 * 2 + et) * 16 * 64 + lane;
#pragma unroll
        for (int i = 0; i < 4; ++i) {
          const f32x4 d4 = *(const f32x4*)(dt + 16 * i + 4 * q);
          X[et][i][0] = d4.x * X[et][i][0] + sl[(4 * i + 0) * 64]; X[et][i][1] = d4.y * X[et][i][1] + sl[(4 * i + 1) * 64];
          X[et][i][2] = d4.z * X[et][i][2] + sl[(4 * i + 2) * 64]; X[et][i][3] = d4.w * X[et][i][3] + sl[(4 * i + 3) * 64];
        }
      }
    }
  }
  f32x4 gain[2];
#pragma unroll
  for (int et = 0; et < 2; ++et) gain[et] = PASS == 1 ? *(const f32x4*)(G.gla_g + hd * 128 + 32 * w4 + 16 * et + 4 * q) : (f32x4){1.f, 1.f, 1.f, 1.f};
  const bf16_t* gvt0 = G.GVT + ((size_t)bh * 128 + 32 * w4 + c16) * GU + 8 * q;
  const bf16_t* gvt1 = gvt0 + (size_t)16 * GU;
  const int soffA = (tid4 >> 3) * GLDS + (tid4 & 7) * 8, soffB = soffA + 32 * GLDS;
  const size_t cb0 = (size_t)bh * 129 * 4096 + (size_t)(tid4 >> 3) * 64 + (tid4 & 7) * 8;
  u32x4 rq[2], rk[2], rkt[2], rq2[2], rk2[2], rkt2[2];
  bf16x8 vfr[2][2], vfn[2][2]; f32x4 dec[4], decn[4];
#define G4_LOADT(rq_, rk_, rkt_, c_) { const size_t cb_ = cb0 + (size_t)(c_) * 4096; \
    rkt_[0] = *(const u32x4*)(G.KTT + cb_); rkt_[1] = *(const u32x4*)(G.KTT + cb_ + 2048); \
    if (PASS == 1) { rq_[0] = *(const u32x4*)(G.QT + cb_); rq_[1] = *(const u32x4*)(G.QT + cb_ + 2048); rk_[0] = *(const u32x4*)(G.KT + cb_); rk_[1] = *(const u32x4*)(G.KT + cb_ + 2048); } }
#define G4_LOADV(vf_, dc_, c_) { vf_[0][0] = *(const bf16x8*)(gvt0 + 64 * (c_)); vf_[0][1] = *(const bf16x8*)(gvt0 + 64 * (c_) + 32); \
    vf_[1][0] = *(const bf16x8*)(gvt1 + 64 * (c_)); vf_[1][1] = *(const bf16x8*)(gvt1 + 64 * (c_) + 32); \
    _Pragma("unroll") for (int i = 0; i < 4; ++i) dc_[i] = *(const f32x4*)(G.DEC + ((size_t)bh * 129 + (c_)) * 64 + 16 * i + 4 * q); }
#define G4_STORET(Bn_, rq_, rk_, rkt_) { *(u32x4*)&Bn_.KT[soffA] = rkt_[0]; *(u32x4*)&Bn_.KT[soffB] = rkt_[1]; \
    if (PASS == 1) { *(u32x4*)&Bn_.Qt[soffA] = rq_[0]; *(u32x4*)&Bn_.Qt[soffB] = rq_[1]; *(u32x4*)&Bn_.Kt[soffA] = rk_[0]; *(u32x4*)&Bn_.Kt[soffB] = rk_[1]; } }
  G4_LOADT(rq, rk, rkt, cbeg)
  G4_LOADV(vfr, dec, cbeg)
  G4_STORET(L.B[0], rq, rk, rkt)
  G4_LOADT(rq, rk, rkt, cbeg + 1)
  G4_LOADV(vfn, decn, cbeg + 1)
  __syncthreads();
  for (int c = cbeg; c < cend; ++c) {
    const int cur = (c - cbeg) & 1;
    const GlaBuf& Bc = L.B[cur];
    const bool more = c + 1 < cend, more2 = c + 2 < cend;
    if (more2) G4_LOADT(rq2, rk2, rkt2, c + 2)
    u32x2 grv[2][4];
    if (PASS == 1 && c >= 1) {
#pragma unroll
      for (int et = 0; et < 2; ++et)
#pragma unroll
        for (int n = 0; n < 4; ++n) grv[et][n] = *(const u32x2*)(G.GR + ((size_t)b * SEQ + 64 * (c - 1) + 16 * n + c16) * 512 + hd * 128 + 32 * w4 + 16 * et + 4 * q);
    }
    f32x4 OT[2][4];
    if (PASS == 1) {
      const int is = w4;
#pragma unroll
      for (int it = 0; it < 4; ++it) {
        f32x4 pa = {0.f, 0.f, 0.f, 0.f};
        if (is <= it) {
#pragma unroll
          for (int kk = 0; kk < 2; ++kk) {
            const bf16x8 ka = *(const bf16x8*)&Bc.Kt[(16 * is + c16) * GLDS + 32 * kk + 8 * q];
            const bf16x8 qb = *(const bf16x8*)&Bc.Qt[(16 * it + c16) * GLDS + 32 * kk + 8 * q];
            pa = MFMA16(ka, qb, pa);
          }
          if (is == it) {
#pragma unroll
            for (int r = 0; r < 4; ++r) if (4 * q + r > c16) pa[r] = 0.f;
          }
        }
        u32x2 pw; pw.x = pk2(pa[0], pa[1]); pw.y = pk2(pa[2], pa[3]);
        *(u32x2*)&L.P[(16 * it + c16) * GLDS + 16 * is + 4 * q] = pw;
      }
#pragma unroll
      for (int et = 0; et < 2; ++et)
#pragma unroll
        for (int n = 0; n < 4; ++n) OT[et][n] = (f32x4){0.f, 0.f, 0.f, 0.f};
#pragma unroll
      for (int kk = 0; kk < 2; ++kk) {
        bf16x8 xa[2];
#pragma unroll
        for (int et = 0; et < 2; ++et) {
          u32x4 xp; xp.x = pk2(X[et][2 * kk][0], X[et][2 * kk][1]); xp.y = pk2(X[et][2 * kk][2], X[et][2 * kk][3]);
          xp.z = pk2(X[et][2 * kk + 1][0], X[et][2 * kk + 1][1]); xp.w = pk2(X[et][2 * kk + 1][2], X[et][2 * kk + 1][3]);
          xa[et] = __builtin_bit_cast(bf16x8, xp);
        }
#pragma unroll
        for (int n = 0; n < 4; ++n) {
          const u32x2 lo = *(const u32x2*)&Bc.Qt[(16 * n + c16) * GLDS + 32 * kk + 4 * q];
          const u32x2 hi = *(const u32x2*)&Bc.Qt[(16 * n + c16) * GLDS + 32 * kk + 16 + 4 * q];
          u32x4 qq; qq.x = lo.x; qq.y = lo.y; qq.z = hi.x; qq.w = hi.y;
          const bf16x8 qf = __builtin_bit_cast(bf16x8, qq);
          OT[0][n] = MFMA16(xa[0], qf, OT[0][n]);
          OT[1][n] = MFMA16(xa[1], qf, OT[1][n]);
        }
      }
      __syncthreads();
#pragma unroll
      for (int kk = 0; kk < 2; ++kk)
#pragma unroll
        for (int n = 0; n < 4; ++n) {
          const bf16x8 pb = *(const bf16x8*)&L.P[(16 * n + c16) * GLDS + 32 * kk + 8 * q];
          OT[0][n] = MFMA16(vfr[0][kk], pb, OT[0][n]);
          OT[1][n] = MFMA16(vfr[1][kk], pb, OT[1][n]);
        }
    }
#pragma unroll
    for (int i = 0; i < 4; ++i) {
#pragma unroll
      for (int kk = 0; kk < 2; ++kk) {
        const bf16x8 ka = *(const bf16x8*)&Bc.KT[(16 * i + c16) * GLDS + 32 * kk + 8 * q];
        X[0][i] = MFMA16(ka, vfr[0][kk], X[0][i]);
        X[1][i] = MFMA16(ka, vfr[1][kk], X[1][i]);
      }
#pragma unroll
      for (int et = 0; et < 2; ++et) { X[et][i][0] *= dec[i].x; X[et][i][1] *= dec[i].y; X[et][i][2] *= dec[i].z; X[et][i][3] *= dec[i].w; }
    }
    if (PASS == 1 && c >= 1) {
      float ss[4];
#pragma unroll
      for (int n = 0; n < 4; ++n) {
        float v = OT[0][n][0] * OT[0][n][0] + OT[0][n][1] * OT[0][n][1] + OT[0][n][2] * OT[0][n][2] + OT[0][n][3] * OT[0][n][3]
                + OT[1][n][0] * OT[1][n][0] + OT[1][n][1] * OT[1][n][1] + OT[1][n][2] * OT[1][n][2] + OT[1][n][3] * OT[1][n][3];
        v += __shfl_xor(v, 16); v += __shfl_xor(v, 32);
        ss[n] = v;
      }
      if (q == 0) {
#pragma unroll
        for (int n = 0; n < 4; ++n) L.ssq[w4][16 * n + c16] = ss[n];
      }
      __syncthreads();
#pragma unroll
      for (int n = 0; n < 4; ++n) {
        const float tot = L.ssq[0][16 * n + c16] + L.ssq[1][16 * n + c16] + L.ssq[2][16 * n + c16] + L.ssq[3][16 * n + c16];
        const float scl = rsqrtf(tot * (1.0f / 128.0f) + EPS);
        const size_t m = (size_t)b * SEQ + 64 * (c - 1) + 16 * n + c16;
#pragma unroll
        for (int et = 0; et < 2; ++et) {
          const float r0 = bflo(grv[et][n].x), r1 = bfhi(grv[et][n].x), r2 = bflo(grv[et][n].y), r3 = bfhi(grv[et][n].y);
          const float o0 = OT[et][n][0] * scl * gain[et].x * r0 * __builtin_amdgcn_rcpf(1.f + __expf(-r0));
          const float o1 = OT[et][n][1] * scl * gain[et].y * r1 * __builtin_amdgcn_rcpf(1.f + __expf(-r1));
          const float o2 = OT[et][n][2] * scl * gain[et].z * r2 * __builtin_amdgcn_rcpf(1.f + __expf(-r2));
          const float o3 = OT[et][n][3] * scl * gain[et].w * r3 * __builtin_amdgcn_rcpf(1.f + __expf(-r3));
          u32x2 ow; ow.x = pk2(o0, o1); ow.y = pk2(o2, o3);
          *(u32x2*)(G.MIX + m * D + 512 + hd * 128 + 32 * w4 + 16 * et + 4 * q) = ow;
        }
      }
    }
    if (more) {
      GlaBuf& Bn = L.B[cur ^ 1];
      G4_STORET(Bn, rq, rk, rkt)
#pragma unroll
      for (int et = 0; et < 2; ++et) { vfr[et][0] = vfn[et][0]; vfr[et][1] = vfn[et][1]; }
#pragma unroll
      for (int i = 0; i < 4; ++i) dec[i] = decn[i];
#pragma unroll
      for (int z = 0; z < 2; ++z) { rkt[z] = rkt2[z]; rq[z] = rq2[z]; rk[z] = rk2[z]; }
      if (more2) G4_LOADV(vfn, decn, c + 2)
    }
    __syncthreads();
  }
#undef G4_LOADT
#undef G4_LOADV
#undef G4_STORET
  if (PASS == 0) {
#pragma unroll
    for (int et = 0; et < 2; ++et) {
      float* sl = G.SLOC + ((size_t)(bh * 16 + sc) * 8 + w4 * 2 + et) * 16 * 64 + lane;
#pragma unroll
      for (int i = 0; i < 4; ++i)
#pragma unroll
        for (int r = 0; r < 4; ++r) sl[(4 * i + r) * 64] = X[et][i][r];
    }
    if (w4 == 0) {
      float bl = 0.f;
      for (int c = cbeg; c < cend; ++c) bl += G.BL[((size_t)bh * 129 + c) * 64 + lane];
      G.DTOT[(size_t)(bh * 16 + sc) * 64 + lane] = __expf(bl);
    }
  }
}

DI void ce_desc(float& a, float& b) {
  const float hi = __builtin_fmaxf(a, b), lo = __builtin_fminf(a, b);
  a = hi; b = lo;
}
DI float vmaxf(float a, float b) { return __builtin_fmaxf(a, b); }
template <int N> DI void bitonic_sort_desc(float (&v)[N]) {
#pragma unroll
  for (int k = 2; k <= N; k <<= 1) {
#pragma unroll
    for (int j = k >> 1; j > 0; j >>= 1) {
#pragma unroll
      for (int i = 0; i < N; ++i) {
        const int l = i ^ j;
        if (l > i) { if ((i & k) == 0) ce_desc(v[i], v[l]); else ce_desc(v[l], v[i]); }
      }
    }
  }
}
DI void bitonic_merge16_desc(float (&v)[16]) {
#pragma unroll
  for (int j = 8; j > 0; j >>= 1) {
#pragma unroll
    for (int i = 0; i < 16; ++i) { const int l = i ^ j; if (l > i) ce_desc(v[i], v[l]); }
  }
}
template <int NBV> DI void merge_prune16(float (&a)[16], const float (&b)[16]) {
#pragma unroll
  for (int i = 16 - NBV; i < 16; ++i) a[i] = vmaxf(a[i], b[15 - i]);
  bitonic_merge16_desc(a);
}
DI float selh(int hh, float a, float b) { asm volatile("" : "+v"(a), "+v"(b)); return hh == 0 ? a : b; }
DI float pack_idx(float v, unsigned idx, unsigned mask) { return __uint_as_float((__float_as_uint(v) & ~mask) | idx); }

DI void ph_route_v2(int vb, char* smem, const bf16_t* __restrict__ QP, const bf16_t* __restrict__ SK1b, const bf16_t* __restrict__ SK2b,
                    unsigned short* __restrict__ EIDX, float* __restrict__ GATE) {
  const int tid256_ = fresh_tid() & 255;
  const int lane = TID & 63, wave = TID >> 6, r = lane & 31, hh = lane >> 5;
  const int hd = vb & 7, tile = vb >> 3;
  const int m = tile * 128 + wave * 32 + r;
  float loc[2][16];
#pragma unroll
  for (int L = 0; L < 2; ++L) {
    const bf16_t* qp = QP + (size_t)m * D + hd * 128 + L * 64 + hh * 8;
    const bf16_t* kb = (L == 0 ? SK1b : SK2b) + (size_t)(hd * 128 + r) * 64 + hh * 8;
    bf16x8 qf[4];
#pragma unroll
    for (int ks = 0; ks < 4; ++ks) qf[ks] = *(const bf16x8*)(qp + ks * 16);
    float grp[4][16];
#pragma unroll
    for (int mt = 0; mt < 4; ++mt) {
      f32x16 acc;
#pragma unroll
      for (int e = 0; e < 16; ++e) acc[e] = 0.f;
#pragma unroll
      for (int ks = 0; ks < 4; ++ks) {
        const bf16x8 kf = *(const bf16x8*)(kb + (size_t)mt * 32 * 64 + ks * 16);
        acc = MFMA32(kf, qf[ks], acc);
      }
#pragma unroll
      for (int e = 0; e < 16; ++e) grp[mt][e] = pack_idx(acc[e], (unsigned)(mt * 32 + crow(e, hh)), 127u);
      bitonic_sort_desc<16>(grp[mt]);
    }
    merge_prune16<16>(grp[0], grp[1]);
    merge_prune16<16>(grp[2], grp[3]);
    merge_prune16<16>(grp[0], grp[2]);
#pragma unroll
    for (int i = 0; i < 16; ++i) loc[L][i] = grp[0][i];
  }
  float fin[16], oth[16];
#pragma unroll
  for (int i = 0; i < 16; ++i) {
    const float send = selh(hh, loc[1][i], loc[0][i]);
    oth[i] = __shfl_xor(send, 32);
    fin[i] = selh(hh, loc[0][i], loc[1][i]);
  }
  merge_prune16<16>(fin, oth);
  float v1[16], v2[16];
#pragma unroll
  for (int i = 0; i < 16; ++i) {
    const float o = __shfl_xor(fin[i], 32);
    v1[i] = selh(hh, fin[i], o);
    v2[i] = selh(hh, o, fin[i]);
  }
  unsigned* ib = (unsigned*)smem + (size_t)TID * 8;
#pragma unroll
  for (int q = 0; q < 4; ++q) {
    unsigned w1 = 0, w2 = 0;
#pragma unroll
    for (int j = 0; j < 4; ++j) {
      w1 |= (__float_as_uint(v1[4 * q + j]) & 127u) << (8 * j);
      w2 |= (__float_as_uint(v2[4 * q + j]) & 127u) << (8 * j);
    }
    ib[q] = w1; ib[4 + q] = w2;
  }
  float R[16], Bv[16];
#pragma unroll
  for (int j = 0; j < 16; ++j) R[j] = pack_idx(v1[0] + v2[j], (unsigned)j, 255u);
#define ROUTE_ROW(I, CNT) { _Pragma("unroll") for (int j = 0; j < 16; ++j) Bv[j] = (j < CNT) ? pack_idx(v1[I] + v2[j < CNT ? j : 0], (unsigned)(I * 16 + j), 255u) : 0.f; \
    merge_prune16<CNT>(R, Bv); }
  ROUTE_ROW(1, 8) ROUTE_ROW(2, 5) ROUTE_ROW(3, 4) ROUTE_ROW(4, 3) ROUTE_ROW(5, 2) ROUTE_ROW(6, 2) ROUTE_ROW(7, 2)
#undef ROUTE_ROW
#pragma unroll
  for (int j = 0; j < 16; ++j) Bv[j] = (j < 8) ? pack_idx(v1[8 + (j < 8 ? j : 0)] + v2[0], (unsigned)((8 + j) * 16), 255u) : 0.f;
  merge_prune16<8>(R, Bv);
  float ex[16], sum = 0.f;
#pragma unroll
  for (int i = 0; i < 16; ++i) { ex[i] = __expf(R[i] - R[0]); sum += ex[i]; }
  const float inv = 1.f / sum;
  const unsigned char* ibb = (const unsigned char*)ib;
  int eo[8]; float go[8];
#pragma unroll
  for (int w = 0; w < 8; ++w) {
    const float rv = selh(hh, R[w], R[8 + w]);
    const float ev = selh(hh, ex[w], ex[8 + w]);
    const unsigned pos = __float_as_uint(rv) & 255u;
    const unsigned i1 = ibb[pos >> 4], i2 = ibb[16 + (pos & 15u)];
    eo[w] = (int)(i1 * 128u + i2);
    go[w] = ev * inv;
  }
  unsigned short* ep = EIDX + (size_t)m * 128 + hd * 16 + hh * 8;
  float* gp = GATE + (size_t)m * 128 + hd * 16 + hh * 8;
  *(u32x4*)ep = (u32x4){(unsigned)eo[0] | ((unsigned)eo[1] << 16), (unsigned)eo[2] | ((unsigned)eo[3] << 16), (unsigned)eo[4] | ((unsigned)eo[5] << 16), (unsigned)eo[6] | ((unsigned)eo[7] << 16)};
  *(f32x4*)gp = (f32x4){go[0], go[1], go[2], go[3]};
  *(f32x4*)(gp + 4) = (f32x4){go[4], go[5], go[6], go[7]};
}


typedef unsigned char u8_t;
constexpr size_t WS_SCU = 14 * MiB;
constexpr size_t WS_SCV = 14 * MiB + 65536;
DI float wave_max(float v) {
#pragma unroll
  for (int o = 32; o >= 1; o >>= 1) v = fmaxf(v, __shfl_xor(v, o));
  return v;
}
DI u32x4 quant_row16(const float* __restrict__ rowp, int lane, float& sc) {
  const f32x4* rp = (const f32x4*)(rowp + lane * 16);
  const f32x4 a = rp[0], b = rp[1], c = rp[2], d = rp[3];
  float m = fmaxf(fmaxf(fmaxf(fabsf(a.x), fabsf(a.y)), fmaxf(fabsf(a.z), fabsf(a.w))), fmaxf(fmaxf(fabsf(b.x), fabsf(b.y)), fmaxf(fabsf(b.z), fabsf(b.w))));
  m = fmaxf(m, fmaxf(fmaxf(fmaxf(fabsf(c.x), fabsf(c.y)), fmaxf(fabsf(c.z), fabsf(c.w))), fmaxf(fmaxf(fabsf(d.x), fabsf(d.y)), fmaxf(fabsf(d.z), fabsf(d.w)))));
  m = wave_max(m);
  sc = m > 0.f ? m * (1.0f / 448.0f) : 1.0f;
  const float inv = 1.0f / sc;
  u32x4 o; unsigned w;
  w = 0; w = __builtin_amdgcn_cvt_pk_fp8_f32(a.x * inv, a.y * inv, w, false); w = __builtin_amdgcn_cvt_pk_fp8_f32(a.z * inv, a.w * inv, w, true); o.x = w;
  w = 0; w = __builtin_amdgcn_cvt_pk_fp8_f32(b.x * inv, b.y * inv, w, false); w = __builtin_amdgcn_cvt_pk_fp8_f32(b.z * inv, b.w * inv, w, true); o.y = w;
  w = 0; w = __builtin_amdgcn_cvt_pk_fp8_f32(c.x * inv, c.y * inv, w, false); w = __builtin_amdgcn_cvt_pk_fp8_f32(c.z * inv, c.w * inv, w, true); o.z = w;
  w = 0; w = __builtin_amdgcn_cvt_pk_fp8_f32(d.x * inv, d.y * inv, w, false); w = __builtin_amdgcn_cvt_pk_fp8_f32(d.z * inv, d.w * inv, w, true); o.w = w;
  return o;
}
DI void ph_convert_ev8(int vb, char* smem, const float* __restrict__ src, u8_t* __restrict__ EV8c, float* __restrict__ scaleV) {
  const int tid256_ = fresh_tid() & 255;
  u8_t (*t)[1040] = (u8_t (*)[1040])smem;
  const int lane = TID & 63, wave = TID >> 6, e0 = vb * 32;
  for (int rr = 0; rr < 8; ++rr) {
    const int r = wave * 8 + rr;
    float sc;
    const u32x4 o = quant_row16(src + (size_t)(e0 + r) * D, lane, sc);
    *(u32x4*)&t[r][lane * 16] = o;
    if (lane == 0) scaleV[e0 + r] = sc;
  }
  __syncthreads();
  const int r = TID & 31, cs = TID >> 5;
  for (int c0 = 0; c0 < 128; c0 += 8) {
    const int cg = c0 + cs;
    const u32x2 v = *(const u32x2*)&t[r][cg * 8];
    *(u32x2*)(EV8c + ((size_t)cg * NEXP + e0 + r) * 8) = v;
  }
  __syncthreads();
}
struct PeerUHalf { u32x4 u[8]; };
DI void ph_peer_c8(int unit, char* smem, const bf16_t* __restrict__ PP, const unsigned short* __restrict__ EIDX, const float* __restrict__ GATE,
                   const float* __restrict__ scaleU, const float* __restrict__ scaleV, unsigned* __restrict__ STREAM) {
  unsigned (*tile)[132] = (unsigned (*)[132])smem;
  const int tid = fresh_tid();
  const int tl = tid >> 3, kc = tid & 7;
  const size_t rowoff = ((size_t)unit * 64 + tl) * 128 + kc * 16;
  const size_t n = (size_t)TREAL * 128;
  float a[16];
#pragma unroll
  for (int j = 0; j < 16; ++j) a[j] = 0.f;
#pragma unroll
  for (int s = 0; s < 8; ++s) {
    const u32x4 p0 = *(const u32x4*)(PP + (size_t)s * n + rowoff), p1 = *(const u32x4*)(PP + (size_t)s * n + rowoff + 8);
    a[0] += bflo(p0.x); a[1] += bfhi(p0.x); a[2] += bflo(p0.y); a[3] += bfhi(p0.y); a[4] += bflo(p0.z); a[5] += bfhi(p0.z); a[6] += bflo(p0.w); a[7] += bfhi(p0.w);
    a[8] += bflo(p1.x); a[9] += bfhi(p1.x); a[10] += bflo(p1.y); a[11] += bfhi(p1.y); a[12] += bflo(p1.z); a[13] += bfhi(p1.z); a[14] += bflo(p1.w); a[15] += bfhi(p1.w);
  }
  const u32x4 e0 = *(const u32x4*)(EIDX + rowoff), e1 = *(const u32x4*)(EIDX + rowoff + 8);
  unsigned ev[16] = {e0.x & 0xffffu, e0.x >> 16, e0.y & 0xffffu, e0.y >> 16, e0.z & 0xffffu, e0.z >> 16, e0.w & 0xffffu, e0.w >> 16,
                     e1.x & 0xffffu, e1.x >> 16, e1.y & 0xffffu, e1.y >> 16, e1.z & 0xffffu, e1.z >> 16, e1.w & 0xffffu, e1.w >> 16};
  float gt[16];
#pragma unroll
  for (int j = 0; j < 4; ++j) { const f32x4 g4 = *(const f32x4*)(GATE + rowoff + 4 * j); gt[4 * j] = g4.x; gt[4 * j + 1] = g4.y; gt[4 * j + 2] = g4.z; gt[4 * j + 3] = g4.w; }
#pragma unroll
  for (int j = 0; j < 16; ++j) {
    const unsigned e = ev[j];
    const float av = a[j] * scaleU[e];
    const float act = 0.5f * av * (1.f + erff(av * 0.70710678118654752f));
    const float c = gt[j] * act * scaleV[e];
    tile[tl][kc * 16 + j] = e | (f2bf(c) << 16);
  }
  __syncthreads();
  unsigned* outp = STREAM + (size_t)unit * 8192;
#pragma unroll 4
  for (int j = 0; j < 16; ++j) {
    const int o = tid + 512 * j, q = o >> 8, t2 = (o >> 2) & 63, z = o & 3;
    outp[o] = tile[t2][4 * q + z];
  }
  __syncthreads();
}
struct PVW { u32x4 a, b; };
struct PVT { u32x2 v[8]; };
DI void pv_loadw(PVW& W, const unsigned* __restrict__ STREAM, int it, int g, int lane) {
  const u32x4* sp = (const u32x4*)(STREAM + (size_t)it * 8192) + lane;
  W.a = sp[(2 * g) * 64]; W.b = sp[(2 * g + 1) * 64];
}
DI void pv_readt(PVT& T, const PVW& W, const u32x2* tabl) {
  T.v[0] = tabl[W.a.x & 0xffffu]; T.v[1] = tabl[W.a.y & 0xffffu]; T.v[2] = tabl[W.a.z & 0xffffu]; T.v[3] = tabl[W.a.w & 0xffffu];
  T.v[4] = tabl[W.b.x & 0xffffu]; T.v[5] = tabl[W.b.y & 0xffffu]; T.v[6] = tabl[W.b.z & 0xffffu]; T.v[7] = tabl[W.b.w & 0xffffu];
}
DI void pv_fma1(unsigned w, const u32x2 v, f32x2 (&y)[4]) {
  const float c = bfhi(w);
  const f32x2 cc = {c, c};
  y[0] = __builtin_elementwise_fma(__builtin_amdgcn_cvt_pk_f32_fp8(v.x, false), cc, y[0]);
  y[1] = __builtin_elementwise_fma(__builtin_amdgcn_cvt_pk_f32_fp8(v.x, true), cc, y[1]);
  y[2] = __builtin_elementwise_fma(__builtin_amdgcn_cvt_pk_f32_fp8(v.y, false), cc, y[2]);
  y[3] = __builtin_elementwise_fma(__builtin_amdgcn_cvt_pk_f32_fp8(v.y, true), cc, y[3]);
}
DI void pv_fma(const PVW& W, const PVT& T, f32x2 (&y)[4]) {
  pv_fma1(W.a.x, T.v[0], y); pv_fma1(W.a.y, T.v[1], y); pv_fma1(W.a.z, T.v[2], y); pv_fma1(W.a.w, T.v[3], y);
  pv_fma1(W.b.x, T.v[4], y); pv_fma1(W.b.y, T.v[5], y); pv_fma1(W.b.z, T.v[6], y); pv_fma1(W.b.w, T.v[7], y);
}
DI void ph_peer_v8(char* smem, const unsigned* __restrict__ STREAM, const u8_t* __restrict__ EV8c, bf16_t* __restrict__ YT) {
  const int tid = fresh_tid(), lane = tid & 63, wave = tid >> 6;
  const u32x2* tabl = (const u32x2*)smem;
  for (int unit = blockIdx.x; unit < 256; unit += gridDim.x) {
    const int cg = unit & 127, th = unit >> 7;
    const u32x4* src = (const u32x4*)(EV8c + (size_t)cg * NEXP * 8);
#pragma unroll 4
    for (int i = tid; i < NEXP * 8 / 16; i += 512) ((u32x4*)smem)[i] = src[i];
    __syncthreads();
    const int it_end = th * 512 + 512;
    int it = th * 512 + wave;
    PVW W0, W1, W2, W3; PVT T0, T1;
    pv_loadw(W0, STREAM, it, 0, lane); pv_loadw(W1, STREAM, it, 1, lane);
    pv_readt(T0, W0, tabl);
    for (; it < it_end; it += 8) {
      const int itn = (it + 8 < it_end) ? it + 8 : it;
      f32x2 y[4];
#pragma unroll
      for (int z = 0; z < 4; ++z) y[z] = (f32x2){0.f, 0.f};
#define PV_STEP(g, Wld, Wrd, Trd, Wc, Tc) \
      pv_loadw(Wld, STREAM, ((g) + 2 < 16) ? it : itn, ((g) + 2) & 15, lane); \
      pv_readt(Trd, Wrd, tabl); \
      pv_fma(Wc, Tc, y); \
      asm volatile("" ::: "memory");
      PV_STEP(0, W2, W1, T1, W0, T0)  PV_STEP(1, W3, W2, T0, W1, T1)  PV_STEP(2, W0, W3, T1, W2, T0)  PV_STEP(3, W1, W0, T0, W3, T1)
      PV_STEP(4, W2, W1, T1, W0, T0)  PV_STEP(5, W3, W2, T0, W1, T1)  PV_STEP(6, W0, W3, T1, W2, T0)  PV_STEP(7, W1, W0, T0, W3, T1)
      PV_STEP(8, W2, W1, T1, W0, T0)  PV_STEP(9, W3, W2, T0, W1, T1)  PV_STEP(10, W0, W3, T1, W2, T0) PV_STEP(11, W1, W0, T0, W3, T1)
      PV_STEP(12, W2, W1, T1, W0, T0) PV_STEP(13, W3, W2, T0, W1, T1) PV_STEP(14, W0, W3, T1, W2, T0) PV_STEP(15, W1, W0, T0, W3, T1)
#undef PV_STEP
      const int t = it * 64 + lane;
      u32x4 yw; yw.x = pk2(y[0].x, y[0].y); yw.y = pk2(y[1].x, y[1].y); yw.z = pk2(y[2].x, y[2].y); yw.w = pk2(y[3].x, y[3].y);
      *(u32x4*)(YT + ((size_t)cg * TREAL + t) * 8) = yw;
    }
    __syncthreads();
  }
}


DI void ph_final_lds(int unit, char* smem, const bf16_t* __restrict__ H1, const bf16_t* __restrict__ YT, const float* __restrict__ gf, float* __restrict__ out) {
  float (*h2)[1028] = (float (*)[1028])smem;
  const int tid = fresh_tid(), lane = tid & 63, wave = tid >> 6;
  const int t0 = unit * 32;
#pragma unroll
  for (int rr = 0; rr < 4; ++rr) {
    const int r = wave * 4 + rr;
    const bf16_t* hp = H1 + (size_t)(t0 + r) * D;
#pragma unroll
    for (int j = 0; j < 2; ++j) {
      const u32x4 hw = *(const u32x4*)(hp + j * 512 + lane * 8);
      *(f32x4*)&h2[r][j * 512 + lane * 8] = (f32x4){bflo(hw.x), bfhi(hw.x), bflo(hw.y), bfhi(hw.y)};
      *(f32x4*)&h2[r][j * 512 + lane * 8 + 4] = (f32x4){bflo(hw.z), bfhi(hw.z), bflo(hw.w), bfhi(hw.w)};
    }
  }
  __syncthreads();
  {
    const int tok = lane & 31;
#pragma unroll 4
    for (int cg = wave * 2 + (lane >> 5); cg < 128; cg += 16) {
      const u32x4 yw = *(const u32x4*)(YT + ((size_t)cg * TREAL + t0 + tok) * 8);
      f32x4* hp = (f32x4*)&h2[tok][cg * 8];
      f32x4 a = hp[0], b4 = hp[1];
      a.x += bflo(yw.x); a.y += bfhi(yw.x); a.z += bflo(yw.y); a.w += bfhi(yw.y);
      b4.x += bflo(yw.z); b4.y += bfhi(yw.z); b4.z += bflo(yw.w); b4.w += bfhi(yw.w);
      hp[0] = a; hp[1] = b4;
    }
  }
  __syncthreads();
#pragma unroll
  for (int rr = 0; rr < 4; ++rr) {
    const int r = wave * 4 + rr;
    f32x4 v[4]; float ss = 0.f;
#pragma unroll
    for (int j = 0; j < 4; ++j) { v[j] = *(const f32x4*)&h2[r][j * 256 + lane * 4]; ss += v[j].x * v[j].x + v[j].y * v[j].y + v[j].z * v[j].z + v[j].w * v[j].w; }
    ss = wave_sum(ss);
    const float sc = rsqrtf(ss * (1.0f / D) + EPS);
    float* op = out + (size_t)(t0 + r) * D;
#pragma unroll
    for (int j = 0; j < 4; ++j) {
      const f32x4 gg = *(const f32x4*)(gf + j * 256 + lane * 4);
      *(f32x4*)(op + j * 256 + lane * 4) = (f32x4){v[j].x * sc * gg.x, v[j].y * sc * gg.y, v[j].z * sc * gg.z, v[j].w * sc * gg.w};
    }
  }
  __syncthreads();
}

typedef int i32x4 __attribute__((ext_vector_type(4)));
constexpr size_t WS_XQ = 861 * MiB;
constexpr size_t WS_XS = 943 * MiB;
DI unsigned pack_i8x4(float a, float b, float c, float d) {
  const int ia = __float2int_rn(a), ib = __float2int_rn(b), ic = __float2int_rn(c), id = __float2int_rn(d);
  return ((unsigned)ia & 255u) | (((unsigned)ib & 255u) << 8) | (((unsigned)ic & 255u) << 16) | ((unsigned)id << 24);
}
DI u32x4 quant_row16_i8(const float* __restrict__ rowp, int lane, float& sc) {
  const f32x4* rp = (const f32x4*)(rowp + lane * 16);
  const f32x4 a = rp[0], b = rp[1], c = rp[2], d = rp[3];
  float m = fmaxf(fmaxf(fmaxf(fabsf(a.x), fabsf(a.y)), fmaxf(fabsf(a.z), fabsf(a.w))), fmaxf(fmaxf(fabsf(b.x), fabsf(b.y)), fmaxf(fabsf(b.z), fabsf(b.w))));
  m = fmaxf(m, fmaxf(fmaxf(fmaxf(fabsf(c.x), fabsf(c.y)), fmaxf(fabsf(c.z), fabsf(c.w))), fmaxf(fmaxf(fabsf(d.x), fabsf(d.y)), fmaxf(fabsf(d.z), fabsf(d.w)))));
  m = wave_max(m);
  sc = m > 0.f ? m * (1.0f / 127.0f) : 1.0f;
  const float inv = 1.0f / sc;
  u32x4 o;
  o.x = pack_i8x4(a.x * inv, a.y * inv, a.z * inv, a.w * inv); o.y = pack_i8x4(b.x * inv, b.y * inv, b.z * inv, b.w * inv);
  o.z = pack_i8x4(c.x * inv, c.y * inv, c.z * inv, c.w * inv); o.w = pack_i8x4(d.x * inv, d.y * inv, d.z * inv, d.w * inv);
  return o;
}
DI void ph_convert_eu_i8(const float* __restrict__ src, u8_t* __restrict__ EUq, float* __restrict__ scaleU) {
  const int tid = fresh_tid(), lane = tid & 63, wave = tid >> 6;
  for (int e = (blockIdx.x * 8 + wave) * 2; e < NEXP; e += gridDim.x * 16) {
    float sc0, sc1 = 1.f;
    const bool two = e + 1 < NEXP;
    const u32x4 o0 = quant_row16_i8(src + (size_t)e * D, lane, sc0);
    u32x4 o1 = o0;
    if (two) o1 = quant_row16_i8(src + (size_t)(e + 1) * D, lane, sc1);
    *(u32x4*)(EUq + ((size_t)(lane >> 3) * NEXP + e) * 128 + (lane & 7) * 16) = o0;
    if (two) *(u32x4*)(EUq + ((size_t)(lane >> 3) * NEXP + e + 1) * 128 + (lane & 7) * 16) = o1;
    if (lane == 0) { scaleU[e] = sc0; if (two) scaleU[e + 1] = sc1; }
  }
}
DI void ph_norm2_rows(int vb, const bf16_t* __restrict__ src, const float* __restrict__ gain, float* __restrict__ R2, u8_t* __restrict__ XQ, float* __restrict__ XS) {
  const int tid256_ = fresh_tid() & 255;
  const int row0 = vb * 16 + (TID >> 6) * 4, lane = TID & 63;
  u32x2 raw[4][4];
#pragma unroll
  for (int rr = 0; rr < 4; ++rr)
#pragma unroll
    for (int j = 0; j < 4; ++j) raw[rr][j] = *(const u32x2*)(src + (size_t)(row0 + rr) * D + j * 256 + lane * 4);
  f32x4 gg[4];
#pragma unroll
  for (int j = 0; j < 4; ++j) gg[j] = *(const f32x4*)(gain + j * 256 + lane * 4);
#pragma unroll
  for (int rr = 0; rr < 4; ++rr) {
    f32x4 v[4]; float ss = 0.f;
#pragma unroll
    for (int j = 0; j < 4; ++j) {
      v[j] = (f32x4){bflo(raw[rr][j].x), bfhi(raw[rr][j].x), bflo(raw[rr][j].y), bfhi(raw[rr][j].y)};
      ss += v[j].x * v[j].x + v[j].y * v[j].y + v[j].z * v[j].z + v[j].w * v[j].w;
    }
    ss = wave_sum(ss);
    const float r = rsqrtf(ss * (1.0f / D) + EPS);
    if (lane == 0) R2[row0 + rr] = r;
#pragma unroll
    for (int j = 0; j < 4; ++j) {
      const float a0 = v[j].x * gg[j].x, a1 = v[j].y * gg[j].y, a2 = v[j].z * gg[j].z, a3 = v[j].w * gg[j].w;
      float m = fmaxf(fmaxf(fabsf(a0), fabsf(a1)), fmaxf(fabsf(a2), fabsf(a3)));
#pragma unroll
      for (int sh = 16; sh >= 1; sh >>= 1) m = fmaxf(m, __shfl_xor(m, sh));
      const float inv = m > 0.f ? 127.0f / m : 0.f;
      *(unsigned*)(XQ + (size_t)(row0 + rr) * D + j * 256 + lane * 4) = pack_i8x4(a0 * inv, a1 * inv, a2 * inv, a3 * inv);
      if ((lane & 31) == 0) XS[(size_t)(row0 + rr) * 8 + 2 * j + (lane >> 5)] = m * r * (1.0f / 127.0f);
    }
  }
}
DI int dpp_i(int v, const int sel) {
  if (sel == 0) return __builtin_amdgcn_update_dpp(0, v, 0xB1, 0xF, 0xF, true);
  if (sel == 1) return __builtin_amdgcn_update_dpp(0, v, 0x4E, 0xF, 0xF, true);
  return __builtin_amdgcn_update_dpp(0, v, 0x141, 0xF, 0xF, true);
}
DI int dpp_isum8(int v) { v += dpp_i(v, 0); v += dpp_i(v, 1); v += dpp_i(v, 2); return v; }
template <int HF> DI void peer_ud4_issue(PeerUHalf& H, unsigned idxpair, int lane, const u8_t* __restrict__ tab) {
#pragma unroll
  for (int jj = 0; jj < 8; ++jj) {
    const int j = 8 * HF + jj;
    const unsigned w = (unsigned)__shfl((int)idxpair, (lane & ~7) + (j >> 1));
    const unsigned e = (j & 1) ? (w >> 16) : (w & 0xffffu);
    H.u[jj] = *(const u32x4*)(tab + (size_t)e * 128);
  }
}
template <int HF> DI void peer_ud4_compute(const PeerUHalf& H, const u32x4 xq, int sub, int& res0, int& res1) {
#pragma unroll
  for (int jj = 0; jj < 8; ++jj) {
    const int j = 8 * HF + jj;
    int acc = 0;
    acc = __builtin_amdgcn_sdot4((int)H.u[jj].x, (int)xq.x, acc, false); acc = __builtin_amdgcn_sdot4((int)H.u[jj].y, (int)xq.y, acc, false);
    acc = __builtin_amdgcn_sdot4((int)H.u[jj].z, (int)xq.z, acc, false); acc = __builtin_amdgcn_sdot4((int)H.u[jj].w, (int)xq.w, acc, false);
    acc = dpp_isum8(acc);
    if (sub == (j >> 1)) { if (j & 1) res1 = acc; else res0 = acc; }
  }
}
DI void ph_peer_u_d4(int xi, int nx, int wv, int nwv, const u8_t* __restrict__ XQ, const float* __restrict__ XS, const u8_t* __restrict__ EUq,
                     const unsigned short* __restrict__ EIDX, bf16_t* __restrict__ PP) {
  const int lane = fresh_tid() & 63, sub = lane & 7;
  const int ntok = (TREAL - wv + nwv - 1) / nwv;
#define PU_TOK(i) (wv + ((i) < ntok ? (i) : ntok - 1) * nwv)
#define PU_IDX(t) __builtin_nontemporal_load((const unsigned*)(EIDX + (size_t)(t) * 128) + lane)
#define PU_LDX(xq_, xs_, t) { xq_ = *(const u32x4*)(xbase + (size_t)(t) * D); xs_ = XS[(size_t)(t) * 8 + s]; }
#define PU_STORE(t, r0, r1, xs_) __builtin_nontemporal_store(pk2((float)(r0) * (xs_), (float)(r1) * (xs_)), (unsigned*)(pp + (size_t)(t) * 128) + lane)
  for (int s = xi; s < 8; s += nx) {
    const u8_t* tab = EUq + (size_t)s * NEXP * 128 + sub * 16;
    const u8_t* xbase = XQ + s * 128 + sub * 16;
    bf16_t* pp = PP + (size_t)s * TREAL * 128;
    PeerUHalf HA, HB, HC;
    int ta = PU_TOK(0), tb = PU_TOK(1), tc = PU_TOK(2);
    unsigned ia = PU_IDX(ta), ib = PU_IDX(tb), ic = PU_IDX(tc);
    u32x4 xqa; float xsa; PU_LDX(xqa, xsa, ta);
    peer_ud4_issue<0>(HA, ia, lane, tab);
    peer_ud4_issue<1>(HB, ia, lane, tab);
    for (int i = 0; i < ntok; i += 3) {
      const int td = PU_TOK(i + 3), te = PU_TOK(i + 4), tf = PU_TOK(i + 5);
      u32x4 xqb, xqc, xqd; float xsb, xsc, xsd;
      int r0, r1;
      peer_ud4_issue<0>(HC, ib, lane, tab); PU_LDX(xqb, xsb, tb); const unsigned id = PU_IDX(td);
      r0 = 0; r1 = 0;
      peer_ud4_compute<0>(HA, xqa, sub, r0, r1);
      peer_ud4_issue<1>(HA, ib, lane, tab);
      peer_ud4_compute<1>(HB, xqa, sub, r0, r1);
      PU_STORE(ta, r0, r1, xsa);
      peer_ud4_issue<0>(HB, ic, lane, tab); PU_LDX(xqc, xsc, tc); const unsigned ie = PU_IDX(te);
      r0 = 0; r1 = 0;
      peer_ud4_compute<0>(HC, xqb, sub, r0, r1);
      peer_ud4_issue<1>(HC, ic, lane, tab);
      peer_ud4_compute<1>(HA, xqb, sub, r0, r1);
      PU_STORE(tb, r0, r1, xsb);
      peer_ud4_issue<0>(HA, id, lane, tab); PU_LDX(xqd, xsd, td); const unsigned if_ = PU_IDX(tf);
      r0 = 0; r1 = 0;
      peer_ud4_compute<0>(HB, xqc, sub, r0, r1);
      peer_ud4_issue<1>(HB, id, lane, tab);
      peer_ud4_compute<1>(HC, xqc, sub, r0, r1);
      PU_STORE(tc, r0, r1, xsc);
      ta = td; tb = te; tc = tf; ib = ie; ic = if_; xqa = xqd; xsa = xsd;
    }
  }
#undef PU_TOK
#undef PU_IDX
#undef PU_LDX
#undef PU_STORE
}

struct PUI { i32x4 a[8]; };
struct PUE { int e[8]; };

#define XB_TMO      128
#define XB_XCNT(j)  (256  + 64 * (j))
#define XB_XSUB(j)  (1280 + 64 * (j))
#define XB_XGEN(j)  (2304 + 64 * (j))
#define XB_TOP      3328
#define XB_TOPGEN   3392
#define XCD_BAR_WORDS 3456
#define XB_SPIN_CAP (1u << 20)
#define LAS __attribute__((address_space(3)))
DI unsigned xb_ld(unsigned* p)              { return __hip_atomic_load(p, __ATOMIC_RELAXED, __HIP_MEMORY_SCOPE_AGENT); }
DI unsigned xb_add(unsigned* p, unsigned v) { return __hip_atomic_fetch_add(p, v, __ATOMIC_RELAXED, __HIP_MEMORY_SCOPE_AGENT); }
DI unsigned xb_xcc_id() { return (unsigned)__builtin_amdgcn_s_getreg((3 << 11) | 20) & 0xFu; }
#define XB_SPIN(cond, bar) do { unsigned _sp = 0; while (cond) { __builtin_amdgcn_s_sleep(1); \
    if ((++_sp & 255u) == 0u) { if (xb_ld(&(bar)[XB_TMO])) break; if (_sp > XB_SPIN_CAP) { atomicAdd(&(bar)[XB_TMO], 1u); break; } } } } while (0)
struct XcdBarrier { unsigned* bar; unsigned x; volatile unsigned* st; };
DI XcdBarrier xcd_barrier_post(unsigned* bar, volatile unsigned* st) {
  XcdBarrier b; b.bar = bar; b.x = xb_xcc_id(); b.st = st;
  if (threadIdx.x == 0) (void)xb_add(&bar[XB_XCNT(b.x)], 1u);
  return b;
}
DI void xcd_barrier_complete(unsigned* bar, unsigned x, unsigned& nloc, unsigned& nx) {
  const unsigned G = gridDim.x;
  unsigned sum, cnt, mine, sp = 0u;
  for (;;) {
    sum = 0u; cnt = 0u; mine = 0u;
#pragma unroll
    for (unsigned j = 0; j < 16; ++j) { const unsigned c = xb_ld(&bar[XB_XCNT(j)]); sum += c; cnt += (c > 0u) ? 1u : 0u; mine = (j == x) ? c : mine; }
    if (sum == G) break;
    __builtin_amdgcn_s_sleep(1);
    if ((++sp & 255u) == 0u) { if (xb_ld(&bar[XB_TMO])) break; if (sp > XB_SPIN_CAP) { atomicAdd(&bar[XB_TMO], 1u); break; } }
  }
  nloc = mine > 0u ? mine : 1u; nx = cnt > 0u ? cnt : 1u;
}
DI void xcd_barrier(const XcdBarrier& b) {
  asm volatile("s_waitcnt vmcnt(0)" ::: "memory");
  __syncthreads();
  if (threadIdx.x == 0) {
    unsigned* bar = b.bar;
    __builtin_amdgcn_s_waitcnt(0);
    unsigned nloc = b.st[0], nx = b.st[1];
    if (nloc == 0u) { xcd_barrier_complete(bar, b.x, nloc, nx); b.st[0] = nloc; b.st[1] = nx; }
    const unsigned old = xb_add(&bar[XB_XSUB(b.x)], 1u);
    const unsigned gen = old / nloc;
    if (old + 1u == (gen + 1u) * nloc) {
      __builtin_amdgcn_fence(__ATOMIC_RELEASE, "agent");
      asm volatile("s_waitcnt vmcnt(0)" ::: "memory");
      const unsigned og = xb_add(&bar[XB_TOP], 1u);
      const unsigned tg = og / nx;
      if (og + 1u == (tg + 1u) * nx) xb_add(&bar[XB_TOPGEN], 1u);
      else XB_SPIN(xb_ld(&bar[XB_TOPGEN]) == tg, bar);
      __builtin_amdgcn_fence(__ATOMIC_ACQUIRE, "agent");
      xb_add(&bar[XB_XGEN(b.x)], 1u);
      asm volatile("s_waitcnt vmcnt(0)" ::: "memory");
    } else {
      XB_SPIN(xb_ld(&bar[XB_XGEN(b.x)]) == gen, bar);
      __builtin_amdgcn_fence(__ATOMIC_ACQUIRE, "agent");
      asm volatile("s_waitcnt vmcnt(0)" ::: "memory");
    }
  }
  __syncthreads();
}

struct Params {
  const float *x, *meta, *norm1_g, *w_in, *wg, *bg, *sb_g, *gla_g, *w_out, *norm2_g, *w_pq, *sk1, *sk2, *eu, *ev, *gf;
  float* out; char* ws;
};
constexpr int HALF_SMEM = 73728;
constexpr int SMEM_BYTES = 2 * HALF_SMEM;
constexpr size_t WS_BAR = 0;

__global__ void __launch_bounds__(512, 2) k_fused(Params p) {
  extern __shared__ __attribute__((aligned(16))) char smem_dyn[];
  const int half = __builtin_amdgcn_readfirstlane((int)(threadIdx.x >> 8));
  char* smem = smem_dyn + half * HALF_SMEM;
  __shared__ unsigned xb_words[4];
  if (threadIdx.x < 4) xb_words[threadIdx.x] = 0u;
  __syncthreads();
  const XcdBarrier bar = xcd_barrier_post((unsigned*)(p.ws + WS_BAR), xb_words);
  if (threadIdx.x == 0) xb_words[2] = xb_add((unsigned*)(p.ws + WS_XRANK) + bar.x, 1u);
  const int G = 2 * gridDim.x, bid = 2 * blockIdx.x + half;
  char* ws = p.ws;
  bf16_t* WinT = (bf16_t*)(ws + WS_WIN);
  bf16_t* WoutT = (bf16_t*)(ws + WS_WOUT);
  bf16_t* WpqT = (bf16_t*)(ws + WS_WPQ);
  bf16_t* EU = (bf16_t*)(ws + WS_EU);
  bf16_t* EV = (bf16_t*)(ws + WS_EV);
  bf16_t* SK1b = (bf16_t*)(ws + WS_SK1);
  bf16_t* SK2b = (bf16_t*)(ws + WS_SK2);
  bf16_t* A1 = (bf16_t*)(ws + WS_A1);
  float* GO = (float*)(ws + WS_A1);
  bf16_t* A2 = (bf16_t*)(ws + WS_A1);
  InProjOut O;
  O.QSB = (bf16_t*)(ws + WS_QSB); O.KSB = (bf16_t*)(ws + WS_KSB); O.VTSB = (bf16_t*)(ws + WS_VTSB); O.VSB = (bf16_t*)(ws + WS_VSB);
  O.GQ = (bf16_t*)(ws + WS_GQ); O.GK = (bf16_t*)(ws + WS_GK); O.GV = (bf16_t*)(ws + WS_GVT); O.GR = (bf16_t*)(ws + WS_GR);
  O.GLR = (float*)(ws + WS_GLR);
  bf16_t* H1 = (bf16_t*)(ws + WS_H1);
  float* R2 = (float*)(ws + WS_XS + 3 * MiB);
  bf16_t* GVT = (bf16_t*)(ws + WS_GVT);
  GlaPtrs GP;
  GP.GQ = O.GQ; GP.GK = O.GK; GP.GVT = GVT; GP.GR = O.GR; GP.GLR = O.GLR; GP.wg = p.wg; GP.bg = p.bg; GP.gla_g = p.gla_g;
  GP.SLOC = (float*)(ws + WS_SLOC); GP.DTOT = (float*)(ws + WS_DTOT); GP.MIX = (bf16_t*)(ws + WS_MIX);
  GlaPrepPtrs GPP; GPP.GQ = O.GQ; GPP.GK = O.GK; GPP.GLR = O.GLR; GPP.wg = p.wg; GPP.bg = p.bg;
  GPP.QT = (bf16_t*)(ws + WS_GQT); GPP.KT = (bf16_t*)(ws + WS_GKT); GPP.KTT = (bf16_t*)(ws + WS_GKTT); GPP.DEC = (float*)(ws + WS_GDEC); GPP.BL = (float*)(ws + WS_GBL);
  GlaPtrs3 GP3; GP3.QT = GPP.QT; GP3.KT = GPP.KT; GP3.KTT = GPP.KTT; GP3.GVT = GVT; GP3.GR = O.GR; GP3.DEC = GPP.DEC; GP3.BL = GPP.BL; GP3.gla_g = p.gla_g;
  GP3.SLOC = GP.SLOC; GP3.DTOT = GP.DTOT; GP3.MIX = GP.MIX;
  bf16_t* MIX = (bf16_t*)(ws + WS_MIX);
  bf16_t* QP = (bf16_t*)(ws + WS_MIX);
  unsigned short* EIDX = (unsigned short*)(ws + WS_EIDX);
  bf16_t* PP = (bf16_t*)(ws + WS_PP);
  bf16_t* YT = (bf16_t*)(ws + WS_PP);
  unsigned* STREAM = (unsigned*)(ws + WS_STREAM);
  float* GATE = (float*)(ws + WS_GATE);

  for (int vb = bid; vb < 832 + 256 + 256; vb += G) {
    if (vb < 832) ph_transpose_w(vb % 104, vb / 104, smem, p.w_in, p.norm1_g, WinT, D, NIN);
    else if (vb < 1088) { const int t = vb - 832; ph_transpose_w(t % 32, t / 32, smem, p.w_out, nullptr, WoutT, D, D); }
    else { const int t = vb - 1088; ph_transpose_w(t % 32, t / 32, smem, p.w_pq, p.norm2_g, WpqT, D, D); }
  }
  ph_convert_eu_i8(p.eu, (u8_t*)EU, (float*)(ws + WS_SCU));
  for (int vb = bid; vb < NEXP / 32; vb += G) ph_convert_ev8(vb, smem, p.ev, (u8_t*)EV, (float*)(ws + WS_SCV));
  ph_convert(p.sk1, SK1b, (size_t)8 * 128 * 64 / 8);
  ph_convert(p.sk2, SK2b, (size_t)8 * 128 * 64 / 8);
  ph_zero_pads(O.KSB, O.VTSB, O.GQ, O.GK, GVT);
  for (int vb = bid; vb < TREAL / 16; vb += G) ph_norm_rows<0>(vb, p.x, p.meta, A1);
  __syncthreads();
  for (int mb = blockIdx.x; mb < NIN / 16; mb += gridDim.x) ph_meta(mb, smem_dyn, p.meta, p.norm1_g, p.w_in, O);
  xcd_barrier(bar);
  {
    pg8::Gemm g{A1, WinT, TREAL, NINP, D}; pg8::StaticOrder S; S.init(TREAL, NINP, (int)gridDim.x, (int)blockIdx.x);
    EpiInProj E{O, GVT, smem_dyn + 131072};
    pg8::gemm_phase<EpiInProj, pg8::StaticOrder, true, true>((PG8_LAS unsigned char*)smem_dyn, g, S, E);
  }
  xcd_barrier(bar);
  for (int it = blockIdx.x; it < 32 * 129; it += gridDim.x) ph_gla_prep(it, smem_dyn, GPP);
  xcd_barrier(bar);
  for (int it = blockIdx.x; it < 16 * 15; it += gridDim.x) gla_item4<0>(it / 15, it % 15, smem_dyn, GP3);
  for (int vb = bid; vb < 64 * 64; vb += G) ph_sb_attn(vb, O.QSB, O.KSB, O.VTSB, p.sb_g, MIX);
  xcd_barrier(bar);
  for (int it = blockIdx.x; it < 16 * 16; it += gridDim.x) gla_item4<1>(it >> 4, it & 15, smem_dyn, GP3);
  xcd_barrier(bar);
  {
    pg8::Gemm g{MIX, WoutT, TREAL, D, D}; pg8::StaticOrder S; S.init(TREAL, D, (int)gridDim.x, (int)blockIdx.x);
    EpiOut E{p.x, H1};
    pg8::gemm_phase<EpiOut, pg8::StaticOrder, true, true>((PG8_LAS unsigned char*)smem_dyn, g, S, E);
  }
  xcd_barrier(bar);
  for (int vb = bid; vb < TREAL / 16; vb += G) ph_norm2_rows(vb, H1, p.norm2_g, R2, (u8_t*)(ws + WS_XQ), (float*)(ws + WS_XS));
  xcd_barrier(bar);
  {
    pg8::Gemm g{H1, WpqT, TREAL, D, D}; pg8::StaticOrder S; S.init(TREAL, D, (int)gridDim.x, (int)blockIdx.x);
    EpiPQ E{QP, R2};
    pg8::gemm_phase<EpiPQ, pg8::StaticOrder, true, true>((PG8_LAS unsigned char*)smem_dyn, g, S, E);
  }
  xcd_barrier(bar);
  for (int vb = bid; vb < 8 * (TREAL / 128); vb += G) ph_route_v2(vb, smem, QP, SK1b, SK2b, EIDX, GATE);
  xcd_barrier(bar);
  {
    __shared__ int xinfo[4];
    if (threadIdx.x == 0) {
      unsigned* barw = (unsigned*)(p.ws + WS_BAR);
      unsigned cnt = 0, ord = 0, mine = 1;
      for (unsigned j = 0; j < 16; ++j) { const unsigned c = xb_ld(&barw[XB_XCNT(j)]); if (c > 0) { if (j < bar.x) ++ord; ++cnt; } if (j == bar.x) mine = c; }
      xinfo[0] = (int)ord; xinfo[1] = (int)cnt; xinfo[2] = (int)xb_words[2]; xinfo[3] = (int)mine;
    }
    __syncthreads();
    const int xi = xinfo[0], nx = xinfo[1], rank = xinfo[2], nloc = xinfo[3];
    const int wave = __builtin_amdgcn_readfirstlane((int)(threadIdx.x >> 6));
    ph_peer_u_d4(xi, nx, rank * 8 + wave, nloc * 8, (const u8_t*)(ws + WS_XQ), (const float*)(ws + WS_XS), (const u8_t*)EU, EIDX, PP);
  }
  xcd_barrier(bar);
  for (int unit = blockIdx.x; unit < TREAL / 64; unit += gridDim.x) ph_peer_c8(unit, smem_dyn, PP, EIDX, GATE, (const float*)(ws + WS_SCU), (const float*)(ws + WS_SCV), STREAM);
  xcd_barrier(bar);
  ph_peer_v8(smem_dyn, STREAM, (const u8_t*)EV, YT);
  xcd_barrier(bar);
  for (int unit = blockIdx.x; unit < TREAL / 32; unit += gridDim.x) ph_final_lds(unit, smem_dyn, H1, YT, p.gf, p.out);
}

extern "C" void kernel_launch(void* const* d_in, const int* in_sizes, int n_in, void* d_out, int out_size, void* d_ws, size_t ws_size, hipStream_t stream) {
  static int grid = 0;
  if (grid == 0) {
    int dev = 0, cus = 0, per_cu = 0;
    hipGetDevice(&dev);
    hipDeviceGetAttribute(&cus, hipDeviceAttributeMultiprocessorCount, dev);
    hipFuncSetAttribute((const void*)k_fused, hipFuncAttributeMaxDynamicSharedMemorySize, SMEM_BYTES);
    hipOccupancyMaxActiveBlocksPerMultiprocessor(&per_cu, (const void*)k_fused, 512, SMEM_BYTES);
    if (per_cu > 1) per_cu = 1;
    if (per_cu < 1) per_cu = 1;
    grid = cus * per_cu;
  }
  hipMemsetAsync((char*)d_ws + WS_BAR, 0, 32768, stream);
  Params p{};
  p.x = (const float*)d_in[0]; p.meta = (const float*)d_in[1]; p.norm1_g = (const float*)d_in[2]; p.w_in = (const float*)d_in[3];
  p.wg = (const float*)d_in[4]; p.bg = (const float*)d_in[5]; p.sb_g = (const float*)d_in[6]; p.gla_g = (const float*)d_in[7];
  p.w_out = (const float*)d_in[8]; p.norm2_g = (const float*)d_in[9]; p.w_pq = (const float*)d_in[10]; p.sk1 = (const float*)d_in[11];
  p.sk2 = (const float*)d_in[12]; p.eu = (const float*)d_in[13]; p.ev = (const float*)d_in[14]; p.gf = (const float*)d_in[15];
  p.out = (float*)d_out; p.ws = (char*)d_ws;
  void* args[] = {&p};
  hipLaunchCooperativeKernel((const void*)k_fused, dim3(grid), dim3(512), args, SMEM_BYTES, stream);
}
```

```cpp
#include <hip/hip_runtime.h>
#include <stdint.h>
#include <stddef.h>

typedef unsigned short bf16_t;
typedef short bf16x8 __attribute__((ext_vector_type(8)));
typedef float f32x16 __attribute__((ext_vector_type(16)));
typedef float f32x4 __attribute__((ext_vector_type(4)));
typedef float f32x2 __attribute__((ext_vector_type(2)));
typedef unsigned u32x4 __attribute__((ext_vector_type(4)));
typedef unsigned u32x2 __attribute__((ext_vector_type(2)));
typedef __bf16 bf16x2_t __attribute__((ext_vector_type(2)));

#define DI __device__ __forceinline__
__device__ __forceinline__ int fresh_tid() { int t = (int)threadIdx.x; asm volatile("" : "+v"(t)); return t; }
#define TID tid256_
#define MFMA32(a, b, c) __builtin_amdgcn_mfma_f32_32x32x16_bf16((a), (b), (c), 0, 0, 0)

constexpr int D = 1024, NB = 8, SEQ = 8192, NMETA = 16;
constexpr int TREAL = NB * SEQ;
constexpr int MROWS = TREAL + 128;
constexpr int NIN = 3088, NINP = 3328;
constexpr int SBH = 8, SBD = 64;
constexpr int GH = 4, GDK = 64, GDV = 128;
constexpr int KIDX = SEQ + 32;
constexpr int GU = SEQ + 64;
constexpr int NEXP = 16384;
constexpr float EPS = 1e-6f;

constexpr size_t MiB = 1u << 20;
constexpr size_t WS_WIN = 1 * MiB;
constexpr size_t WS_WOUT = 8 * MiB;
constexpr size_t WS_WPQ = 10 * MiB;
constexpr size_t WS_SK1 = 12 * MiB;
constexpr size_t WS_SK2 = 13 * MiB;
constexpr size_t WS_EU = 16 * MiB;
constexpr size_t WS_EV = 48 * MiB;
constexpr size_t WS_A1 = 80 * MiB;
constexpr size_t WS_QSB = 210 * MiB;
constexpr size_t WS_KSB = 274 * MiB;
constexpr size_t WS_VTSB = 339 * MiB;
constexpr size_t WS_GQ = 404 * MiB;
constexpr size_t WS_GK = 437 * MiB;
constexpr size_t WS_H1 = 210 * MiB;
constexpr size_t WS_GV = 470 * MiB;
constexpr size_t WS_GR = 535 * MiB;
constexpr size_t WS_GLR = 599 * MiB;
constexpr size_t WS_LG = 604 * MiB;
constexpr size_t WS_MIX = 669 * MiB;
constexpr size_t WS_EIDX = 797 * MiB;
constexpr size_t WS_GATE = 829 * MiB;
constexpr size_t WS_PP = 470 * MiB;
constexpr size_t WS_STREAM = 726 * MiB;
constexpr size_t WS_XRANK = 16384;
constexpr size_t WS_VSB = 861 * MiB;
constexpr size_t WS_END = 926 * MiB;

DI unsigned f2bf(float f) { unsigned u = __float_as_uint(f); return (u + 0x7fffu + ((u >> 16) & 1u)) >> 16; }
DI float bf2f(unsigned b) { return __uint_as_float(b << 16); }
DI unsigned pk2(float lo, float hi) { f32x2 v = {lo, hi}; return __builtin_bit_cast(unsigned, __builtin_convertvector(v, bf16x2_t)); }
DI float bflo(unsigned u) { return __uint_as_float(u << 16); }
DI float bfhi(unsigned u) { return __uint_as_float(u & 0xffff0000u); }
DI int crow(int reg, int h) { return (reg & 3) + 8 * (reg >> 2) + 4 * h; }
DI float wave_sum(float v) {
#pragma unroll
  for (int o = 32; o >= 1; o >>= 1) v += __shfl_xor(v, o);
  return v;
}
DI float softplus(float z) { return fmaxf(z, 0.f) + __logf(1.f + __expf(-fabsf(z))); }

DI void ph_transpose_w(int bx, int by, char* smem, const float* __restrict__ W, const float* __restrict__ gain, bf16_t* __restrict__ WT, int K, int N) {
  const int tid256_ = fresh_tid() & 255;
  float (*t)[33] = (float (*)[33])smem;
  const int n0 = bx * 32, k0 = by * 128;
  {
    const int kr = TID >> 3, c4 = (TID & 7) * 4;
    f32x4 v[4];
#pragma unroll
    for (int j = 0; j < 4; ++j) v[j] = (n0 + c4 < N) ? *(const f32x4*)(W + (size_t)(k0 + kr + 32 * j) * N + n0 + c4) : (f32x4){0.f, 0.f, 0.f, 0.f};
#pragma unroll
    for (int j = 0; j < 4; ++j) {
      const float g = gain ? gain[k0 + kr + 32 * j] : 1.f;
      t[kr + 32 * j][c4 + 0] = v[j].x * g; t[kr + 32 * j][c4 + 1] = v[j].y * g; t[kr + 32 * j][c4 + 2] = v[j].z * g; t[kr + 32 * j][c4 + 3] = v[j].w * g;
    }
  }
  __syncthreads();
  {
    const int n = TID >> 3, ks = (TID & 7) * 16;
    unsigned w[8];
#pragma unroll
    for (int i = 0; i < 8; ++i) w[i] = pk2(t[ks + 2 * i][n], t[ks + 2 * i + 1][n]);
    bf16_t* dst = WT + (size_t)(n0 + n) * K + k0 + ks;
    *(u32x4*)dst = (u32x4){w[0], w[1], w[2], w[3]};
    *(u32x4*)(dst + 8) = (u32x4){w[4], w[5], w[6], w[7]};
  }
  __syncthreads();
}
DI void ph_convert(const float* __restrict__ src, bf16_t* __restrict__ dst, size_t n8) {
  size_t i = (size_t)blockIdx.x * blockDim.x + threadIdx.x;
  const size_t stride = (size_t)gridDim.x * blockDim.x;
  for (; i < n8; i += stride) {
    const f32x4 a = ((const f32x4*)src)[2 * i], b = ((const f32x4*)src)[2 * i + 1];
    u32x4 o; o.x = pk2(a.x, a.y); o.y = pk2(a.z, a.w); o.z = pk2(b.x, b.y); o.w = pk2(b.z, b.w);
    ((u32x4*)dst)[i] = o;
  }
}
DI void ph_zero_pads(bf16_t* KSB, bf16_t* VTSB, bf16_t* GQ, bf16_t* GK, bf16_t* GVT) {
  const int tid = blockIdx.x * blockDim.x + threadIdx.x, nth = gridDim.x * blockDim.x;
  for (int i = tid; i < 64 * 16 * 64; i += nth) { const int bh = i / 1024, r = i % 1024; KSB[(size_t)bh * KIDX * 64 + r] = 0; }
  for (int i = tid; i < 64 * 64 * 16; i += nth) { const int row = i / 16, c = i % 16; VTSB[(size_t)row * KIDX + c] = 0; }
  for (int i = tid; i < 32 * 48 * 64; i += nth) { const int bh = i / 3072, r = i % 3072; GQ[(size_t)bh * GU * 64 + r] = 0; GK[(size_t)bh * GU * 64 + r] = 0; }
  for (int i = tid; i < 32 * 128 * 48; i += nth) { const int row = i / 48, c = i % 48; GVT[(size_t)row * GU + c] = 0; }
}

template <int MODE>
DI void ph_norm_rows(int vb, const float* __restrict__ src, const float* __restrict__ meta, bf16_t* __restrict__ dst) {
  const int tid256_ = fresh_tid() & 255;
  const int row0 = vb * 16 + (TID >> 6) * 4, lane = TID & 63;
  f32x4 v[4][4];
#pragma unroll
  for (int rr = 0; rr < 4; ++rr)
#pragma unroll
    for (int j = 0; j < 4; ++j) v[rr][j] = *(const f32x4*)(src + (size_t)(row0 + rr) * D + j * 256 + lane * 4);
  f32x4 gg[4];
#pragma unroll
  for (int j = 0; j < 4; ++j) { gg[j] = (f32x4){1.f, 1.f, 1.f, 1.f}; if (MODE == 1) gg[j] = *(const f32x4*)(meta + j * 256 + lane * 4); }
#pragma unroll
  for (int rr = 0; rr < 4; ++rr) {
    float ss = 0.f;
#pragma unroll
    for (int j = 0; j < 4; ++j) ss += v[rr][j].x * v[rr][j].x + v[rr][j].y * v[rr][j].y + v[rr][j].z * v[rr][j].z + v[rr][j].w * v[rr][j].w;
    ss = wave_sum(ss);
    const float r = rsqrtf(ss * (1.0f / D) + EPS);
#pragma unroll
    for (int j = 0; j < 4; ++j) {
      u32x2 o; o.x = pk2(v[rr][j].x * r * gg[j].x, v[rr][j].y * r * gg[j].y); o.y = pk2(v[rr][j].z * r * gg[j].z, v[rr][j].w * r * gg[j].w);
      *(u32x2*)(dst + (size_t)(row0 + rr) * D + j * 256 + lane * 4) = o;
    }
  }
}

namespace pg8 {
#define PG8_LAS __attribute__((address_space(3)))
typedef unsigned short bf16_t;
typedef short bf16x8 __attribute__((ext_vector_type(8)));
typedef float f32x4 __attribute__((ext_vector_type(4)));
typedef unsigned u32x4 __attribute__((ext_vector_type(4)));
constexpr int BM = 256, BK = 64, HALF = 128, HTB = HALF * BK * 2  , STAGE_BYTES = 8 * HTB, NXCD = 8, WGM = 8;

__host__ __device__ __forceinline__ int lds_byte(int r, int c) { const int st = (r >> 4) * 2 + (c >> 5), rr = r & 15, cc = c & 31, ob = rr * 64 + cc * 2; return st * 1024 + (ob ^ (((ob >> 9) & 1) << 5)); }
__host__ __device__ __forceinline__ void stage_rc(int b, int& R, int& C) { const int st = b / 1024, sb = b % 1024, swz = sb ^ (((sb >> 9) & 1) << 5); R = (st >> 1) * 16 + swz / 64; C = (st & 1) * 32 + (swz % 64) / 2; }
__host__ __device__ __forceinline__ int perm32(int rho) { const int n = rho >> 4, i = rho & 15; return 8 * (i >> 2) + 4 * n + (i & 3); }

struct Unit { int pm, pn; };
struct Gemm { const bf16_t* A; const bf16_t* Bt; int M, N, K; };

struct StaticOrder {
    int nM, nN, nwg, G, c;
    __host__ __device__ void init(int M, int N, int G_, int c_) { nM = M / BM; nN = N / BM; nwg = nM * nN; G = G_; c = c_; }
    __host__ __device__ bool next(int i, Unit& u) const {
        const long L = (long)i * G + c; if (L >= nwg) return false;
        int wgid = (int)L; { const int q = nwg / NXCD, r = nwg % NXCD, xcd = wgid % NXCD, off = wgid / NXCD; wgid = (xcd < r ? xcd * (q + 1) : r * (q + 1) + (xcd - r) * q) + off; }
        const int nig = WGM * nN, gid = wgid / nig, fm = gid * WGM, gsz = (nM - fm) < WGM ? (nM - fm) : WGM;
        u.pm = fm + ((wgid % nig) % gsz); u.pn = (wgid % nig) / gsz; return true;
    }
    __device__ __forceinline__ void a_ready(const Unit&) const {}
    __device__ __forceinline__ void done(const Unit&) const {}
};

template <class Epi, class Sched, bool ALIGN_EPI = false, bool SP2 = false>
__device__ __forceinline__ void gemm_phase(PG8_LAS unsigned char* lds, const Gemm g, const Sched& S, const Epi& E) {
    const int tid = fresh_tid(), wid = __builtin_amdgcn_readfirstlane(tid >> 6), lane = tid & 63, wr = wid >> 2, wc = wid & 3, fr = lane & 15, fq = lane >> 4;
    const int K = g.K, nt = K / BK;
    unsigned voffA[2], voffB[2];
#pragma unroll
    for (int i = 0; i < 2; ++i) { int R, C; stage_rc(tid * 16 + i * 8192, R, C); const int Rb = Epi::PERM ? ((R & ~31) + perm32(R & 31)) : R;
        voffA[i] = (unsigned)(R * K + C) * 2u; voffB[i] = (unsigned)(Rb * K + C) * 2u; }
    const size_t kstep = (size_t)(BK * 2);
    const size_t hstep = (size_t)HALF * K * 2;
    const size_t tstep = 2 * hstep;
    const unsigned ldsw = (unsigned)wid * 1024u;
    const int aoff = lds_byte(wr * 64 + fr, fq * 8), boff = lds_byte(wc * 32 + fr, fq * 8);
#define PG8_SA(b, h) (((b) * 2 + (h)) * HTB)
#define PG8_SB(b, h) ((4 + (b) * 2 + (h)) * HTB)
#define PG8_STAGE(bufoff, gbase, voff) do { _Pragma("unroll") for (int _i = 0; _i < 2; ++_i) \
        __builtin_amdgcn_global_load_lds((const unsigned*)((const char*)(gbase) + (voff)[_i]), (PG8_LAS unsigned*)(lds + (bufoff) + ldsw + _i * 8192), 16, 0, 0); } while (0)
#define PG8_LDA(dst, b, h) do { _Pragma("unroll") for (int m = 0; m < 4; ++m) _Pragma("unroll") for (int k = 0; k < 2; ++k) dst[m][k] = *(const PG8_LAS bf16x8*)(lds + PG8_SA(b, h) + aoff + m * 2048 + k * 1024); } while (0)
#define PG8_LDB(dst, b, h) do { _Pragma("unroll") for (int n = 0; n < 2; ++n) _Pragma("unroll") for (int k = 0; k < 2; ++k) dst[n][k] = *(const PG8_LAS bf16x8*)(lds + PG8_SB(b, h) + boff + n * 2048 + k * 1024); } while (0)
#define PG8_MMA(ai, bj, At, Bt) do { __builtin_amdgcn_s_setprio(1); _Pragma("unroll") for (int m = 0; m < 4; ++m) _Pragma("unroll") for (int n = 0; n < 2; ++n) _Pragma("unroll") for (int k = 0; k < 2; ++k) \
        acc[ai][bj][m][n] = __builtin_amdgcn_mfma_f32_16x16x32_bf16(Bt[n][k], At[m][k], acc[ai][bj][m][n], 0, 0, 0); __builtin_amdgcn_s_setprio(0); } while (0)
#define PG8_WAIT_V(n) asm volatile("s_waitcnt vmcnt(" #n ")" ::: "memory")
#define PG8_WAIT_L(n) asm volatile("s_waitcnt lgkmcnt(" #n ")" ::: "memory")
#define PG8_BAR __builtin_amdgcn_s_barrier()
#define PG8_SCHED __builtin_amdgcn_sched_barrier(0)
    Unit cur, nxt; int ui = 0;
    if (!S.next(0, cur)) return;
    f32x4 acc[2][2][4][2];
#pragma unroll
    for (int a = 0; a < 2; ++a)
#pragma unroll
        for (int b = 0; b < 2; ++b)
#pragma unroll
            for (int m = 0; m < 4; ++m)
#pragma unroll
                for (int n = 0; n < 2; ++n) acc[a][b][m][n] = (f32x4){0.f, 0.f, 0.f, 0.f};
    bf16x8 At[4][2], B0[2][2], B1[2][2];
    const char* cA = (const char*)g.A + (size_t)cur.pm * tstep; const char* cB = (const char*)g.Bt + (size_t)cur.pn * tstep;
    S.a_ready(cur);
    if constexpr (SP2) {
        PG8_STAGE(PG8_SB(0, 0), cB, voffB); PG8_STAGE(PG8_SB(0, 1), cB + hstep, voffB); PG8_STAGE(PG8_SA(0, 0), cA, voffA); PG8_STAGE(PG8_SA(0, 1), cA + hstep, voffA);
        if (wr == 1) PG8_BAR;
        PG8_WAIT_V(2); PG8_BAR;
        PG8_STAGE(PG8_SB(1, 0), cB + kstep, voffB); PG8_STAGE(PG8_SA(1, 0), cA + kstep, voffA); PG8_STAGE(PG8_SB(1, 1), cB + hstep + kstep, voffB);
        PG8_WAIT_V(6); PG8_BAR;
    } else {
        PG8_STAGE(PG8_SB(0, 0), cB, voffB); PG8_STAGE(PG8_SA(0, 0), cA, voffA); PG8_STAGE(PG8_SB(0, 1), cB + hstep, voffB); PG8_STAGE(PG8_SA(0, 1), cA + hstep, voffA);
        if (wr == 1) PG8_BAR;
        PG8_WAIT_V(4); PG8_BAR;
        PG8_STAGE(PG8_SB(1, 0), cB + kstep, voffB); PG8_STAGE(PG8_SA(1, 0), cA + kstep, voffA); PG8_STAGE(PG8_SB(1, 1), cB + hstep + kstep, voffB);
        PG8_WAIT_V(6); PG8_BAR;
    }
    for (;;) {
        const bool has_next = S.next(ui + 1, nxt);
        const char* nA = has_next ? (const char*)g.A + (size_t)nxt.pm * tstep : cA; const char* nB = has_next ? (const char*)g.Bt + (size_t)nxt.pn * tstep : cB;
        for (int t = 0; t < nt; t += 2) {
            const bool last = (t == nt - 2);
            const char* a1 = cA + (size_t)(t + 1) * kstep;
            const char* a2 = last ? nA : cA + (size_t)(t + 2) * kstep; const char* b2 = last ? nB : cB + (size_t)(t + 2) * kstep;
            const char* a3 = a2 + kstep; const char* b3 = b2 + kstep;
            if (last && has_next) S.a_ready(nxt);
            if constexpr (SP2) {
            PG8_LDB(B0, 0, 0); PG8_LDB(B1, 0, 1); PG8_SCHED; PG8_LDA(At, 0, 0); PG8_STAGE(PG8_SA(1, 1), a1 + hstep, voffA);
            PG8_WAIT_V(8); PG8_WAIT_L(0); PG8_BAR; PG8_MMA(0, 0, At, B0); PG8_MMA(0, 1, At, B1); PG8_BAR; PG8_SCHED;
            PG8_LDA(At, 0, 1); PG8_STAGE(PG8_SB(0, 0), b2, voffB); PG8_STAGE(PG8_SB(0, 1), b2 + hstep, voffB); PG8_STAGE(PG8_SA(0, 0), a2, voffA);
            PG8_WAIT_V(8); PG8_WAIT_L(0); PG8_BAR; PG8_MMA(1, 0, At, B0); PG8_MMA(1, 1, At, B1); PG8_BAR; PG8_SCHED;
            PG8_LDB(B0, 1, 0); PG8_LDB(B1, 1, 1); PG8_SCHED; PG8_LDA(At, 1, 0); PG8_STAGE(PG8_SA(0, 1), a2 + hstep, voffA);
            PG8_WAIT_V(8); PG8_WAIT_L(0); PG8_BAR; PG8_MMA(0, 0, At, B0); PG8_MMA(0, 1, At, B1); PG8_BAR; PG8_SCHED;
            PG8_LDA(At, 1, 1); PG8_STAGE(PG8_SB(1, 0), b3, voffB); PG8_STAGE(PG8_SB(1, 1), b3 + hstep, voffB); PG8_STAGE(PG8_SA(1, 0), a3, voffA);
            PG8_WAIT_V(8); PG8_WAIT_L(0); PG8_BAR; PG8_MMA(1, 0, At, B0); PG8_MMA(1, 1, At, B1); PG8_BAR; PG8_SCHED;
            } else {
            PG8_LDB(B0, 0, 0); PG8_SCHED; PG8_LDA(At, 0, 0); PG8_STAGE(PG8_SA(1, 1), a1 + hstep, voffA);
            PG8_WAIT_L(8); PG8_BAR; PG8_WAIT_L(0); PG8_MMA(0, 0, At, B0); PG8_BAR; PG8_SCHED;
            PG8_LDB(B1, 0, 1); PG8_STAGE(PG8_SB(0, 0), b2, voffB);
            PG8_BAR; PG8_WAIT_L(0); PG8_MMA(0, 1, At, B1); PG8_BAR;
            PG8_LDA(At, 0, 1); PG8_STAGE(PG8_SA(0, 0), a2, voffA);
            PG8_BAR; PG8_WAIT_L(0); PG8_MMA(1, 0, At, B0); PG8_BAR; PG8_SCHED;
            PG8_STAGE(PG8_SB(0, 1), b2 + hstep, voffB);
            PG8_WAIT_V(6); PG8_BAR; PG8_MMA(1, 1, At, B1); PG8_BAR;
            PG8_LDB(B0, 1, 0); PG8_SCHED; PG8_LDA(At, 1, 0); PG8_STAGE(PG8_SA(0, 1), a2 + hstep, voffA);
            PG8_WAIT_L(8); PG8_BAR; PG8_WAIT_L(0); PG8_MMA(0, 0, At, B0); PG8_BAR; PG8_SCHED;
            PG8_LDB(B1, 1, 1); PG8_STAGE(PG8_SB(1, 0), b3, voffB);
            PG8_BAR; PG8_WAIT_L(0); PG8_MMA(0, 1, At, B1); PG8_BAR;
            PG8_LDA(At, 1, 1); PG8_STAGE(PG8_SA(1, 0), a3, voffA);
            PG8_BAR; PG8_WAIT_L(0); PG8_MMA(1, 0, At, B0); PG8_BAR; PG8_SCHED;
            PG8_STAGE(PG8_SB(1, 1), b3 + hstep, voffB);
            PG8_WAIT_V(6); PG8_BAR; PG8_MMA(1, 1, At, B1); PG8_BAR;
            }
        }
        if constexpr (ALIGN_EPI) { if (wr == 0) PG8_BAR; }
        if constexpr (!Epi::AFTER_DRAIN) { E(acc, cur, wr, wc, fr, fq); S.done(cur); }
        if (!has_next) break;
#pragma unroll
        for (int a = 0; a < 2; ++a)
#pragma unroll
            for (int b = 0; b < 2; ++b)
#pragma unroll
                for (int m = 0; m < 4; ++m)
#pragma unroll
                    for (int n = 0; n < 2; ++n) acc[a][b][m][n] = (f32x4){0.f, 0.f, 0.f, 0.f};
        cur = nxt; cA = nA; cB = nB; ++ui;
        if constexpr (ALIGN_EPI) { if (wr == 1) PG8_BAR; }
    }
    PG8_WAIT_V(0);
    if constexpr (!ALIGN_EPI) { if (wr == 0) PG8_BAR; }
    PG8_BAR;
    if constexpr (Epi::AFTER_DRAIN) { E.fused(acc, cur, wr, wc, fr, fq, lds, wid, lane); S.done(cur); }
#undef PG8_SA
#undef PG8_SB
#undef PG8_STAGE
#undef PG8_LDA
#undef PG8_LDB
#undef PG8_MMA
#undef PG8_WAIT_V
#undef PG8_WAIT_L
#undef PG8_BAR
#undef PG8_SCHED
}
}

struct InProjOut { bf16_t *QSB, *KSB, *VSB, *VTSB, *GQ, *GK, *GV, *GR; float* GLR; };

struct EpiInProj {
  static constexpr bool PERM = true, AFTER_DRAIN = false;
  InProjOut O; bf16_t* GVT; char* stage;
  DI void store_vt(const pg8::f32x4 (&acc)[2][2][4][2], const pg8::Unit& u, int wr, int wc, int fr, int fq) const {
    bf16_t* st = (bf16_t*)(stage + (wr * 4 + wc) * 1280);
    const int lane = fr + 16 * fq;
    const int rc = lane >> 2, r8 = lane & 3;
#pragma unroll
    for (int ai = 0; ai < 2; ++ai)
#pragma unroll
      for (int bj = 0; bj < 2; ++bj)
#pragma unroll
        for (int mp = 0; mp < 2; ++mp)
#pragma unroll
          for (int ch = 0; ch < 2; ++ch) {
            if ((fq >> 1) == ch) {
#pragma unroll
              for (int m2 = 0; m2 < 2; ++m2)
#pragma unroll
                for (int n = 0; n < 2; ++n) {
                  const pg8::f32x4 v = acc[ai][bj][2 * mp + m2][n];
                  const int cl = 8 * (fq & 1) + 4 * n, rl = 16 * m2 + fr;
                  st[(cl + 0) * 40 + rl] = (bf16_t)f2bf(v[0]); st[(cl + 1) * 40 + rl] = (bf16_t)f2bf(v[1]);
                  st[(cl + 2) * 40 + rl] = (bf16_t)f2bf(v[2]); st[(cl + 3) * 40 + rl] = (bf16_t)f2bf(v[3]);
                }
            }
            asm volatile("s_waitcnt lgkmcnt(0)" ::: "memory");
            const u32x4 w = *(const u32x4*)&st[rc * 40 + 8 * r8];
            asm volatile("" ::: "memory");
            const int col = u.pn * 256 + bj * 128 + wc * 32 + 16 * ch + rc;
            const int row = u.pm * 256 + ai * 128 + wr * 64 + 32 * mp + 8 * r8;
            const int b = row >> 13, i = row & 8191;
            bf16_t* dst;
            if (u.pn < 6) { const int c = col - 1024; dst = O.VTSB + ((size_t)(b * SBH + (c >> 6)) * 64 + (c & 63)) * KIDX + 32 + i; }
            else          { const int c = col - 2048; dst = GVT + ((size_t)(b * GH + (c >> 7)) * 128 + (c & 127)) * GU + 64 + i; }
            *(u32x4*)dst = w;
          }
  }
  DI void operator()(const pg8::f32x4 (&acc)[2][2][4][2], const pg8::Unit& u, int wr, int wc, int fr, int fq) const {
    const int pn = u.pn;
    if (pn == 4 || pn == 5 || pn == 8 || pn == 9) { store_vt(acc, u, wr, wc, fr, fq); return; }
#pragma unroll
    for (int ai = 0; ai < 2; ++ai)
#pragma unroll
      for (int m = 0; m < 4; ++m) {
        const int row = u.pm * 256 + ai * 128 + wr * 64 + m * 16 + fr;
        const int b = row >> 13, i = row & 8191;
#pragma unroll
        for (int bj = 0; bj < 2; ++bj) {
          const int col = pn * 256 + bj * 128 + wc * 32 + 8 * fq;
          const pg8::f32x4 v0 = acc[ai][bj][m][0], v1 = acc[ai][bj][m][1];
          if (pn < 12) {
            u32x4 w; w.x = pk2(v0[0], v0[1]); w.y = pk2(v0[2], v0[3]); w.z = pk2(v1[0], v1[1]); w.w = pk2(v1[2], v1[3]);
            bf16_t* dst;
            if (pn < 2)       { const int c = col;        dst = O.QSB + ((size_t)(b * SBH + (c >> 6)) * SEQ + i) * 64 + (c & 63); }
            else if (pn < 4)  { const int c = col - 512;  dst = O.KSB + ((size_t)(b * SBH + (c >> 6)) * KIDX + 32 + i) * 64 + (c & 63); }
            else if (pn == 6) { const int c = col - 1536; dst = O.GQ + ((size_t)(b * GH + (c >> 6)) * GU + 64 + i) * 64 + (c & 63); }
            else if (pn == 7) { const int c = col - 1792; dst = O.GK + ((size_t)(b * GH + (c >> 6)) * GU + 64 + i) * 64 + (c & 63); }
            else              { const int c = col - 2560; dst = O.GR + (size_t)row * 512 + c; }
            *(u32x4*)dst = w;
          } else if (col < NIN) {
            float* dst = O.GLR + ((size_t)b * GU + 64 + i) * 16 + (col - 3072);
            *(f32x4*)dst = (f32x4){v0[0], v0[1], v0[2], v0[3]};
            *(f32x4*)(dst + 4) = (f32x4){v1[0], v1[1], v1[2], v1[3]};
          }
        }
      }
  }
};
struct EpiOut {
  static constexpr bool PERM = true, AFTER_DRAIN = false;
  const float* x; bf16_t* H1;
  DI void operator()(const pg8::f32x4 (&acc)[2][2][4][2], const pg8::Unit& u, int wr, int wc, int fr, int fq) const {
#pragma unroll
    for (int ai = 0; ai < 2; ++ai)
#pragma unroll
      for (int m = 0; m < 4; ++m) {
        const size_t rowoff = (size_t)(u.pm * 256 + ai * 128 + wr * 64 + m * 16 + fr) * D;
#pragma unroll
        for (int bj = 0; bj < 2; ++bj) {
          const size_t idx = rowoff + u.pn * 256 + bj * 128 + wc * 32 + 8 * fq;
          const f32x4 x0 = *(const f32x4*)(x + idx), x1 = *(const f32x4*)(x + idx + 4);
          const pg8::f32x4 v0 = acc[ai][bj][m][0], v1 = acc[ai][bj][m][1];
          u32x4 w; w.x = pk2(x0.x + v0[0], x0.y + v0[1]); w.y = pk2(x0.z + v0[2], x0.w + v0[3]); w.z = pk2(x1.x + v1[0], x1.y + v1[1]); w.w = pk2(x1.z + v1[2], x1.w + v1[3]);
          *(u32x4*)(H1 + idx) = w;
        }
      }
  }
};
struct EpiPQ {
  static constexpr bool PERM = true, AFTER_DRAIN = false;
  bf16_t* QP; const float* R2;
  DI void operator()(const pg8::f32x4 (&acc)[2][2][4][2], const pg8::Unit& u, int wr, int wc, int fr, int fq) const {
#pragma unroll
    for (int ai = 0; ai < 2; ++ai)
#pragma unroll
      for (int m = 0; m < 4; ++m) {
        const int row = u.pm * 256 + ai * 128 + wr * 64 + m * 16 + fr;
        const float r = R2[row];
        const size_t rowoff = (size_t)row * D;
#pragma unroll
        for (int bj = 0; bj < 2; ++bj) {
          const pg8::f32x4 v0 = acc[ai][bj][m][0], v1 = acc[ai][bj][m][1];
          u32x4 w; w.x = pk2(v0[0] * r, v0[1] * r); w.y = pk2(v0[2] * r, v0[3] * r); w.z = pk2(v1[0] * r, v1[1] * r); w.w = pk2(v1[2] * r, v1[3] * r);
          *(u32x4*)(QP + rowoff + u.pn * 256 + bj * 128 + wc * 32 + 8 * fq) = w;
        }
      }
  }
};

DI void ph_meta(int blk, char* smem, const float* __restrict__ meta, const float* __restrict__ g1, const float* __restrict__ w_in, const InProjOut& O) {
  float (*xmT)[16] = (float (*)[16])smem;
  float (*red)[256] = (float (*)[256])(smem + 65536);
  const int tid = fresh_tid(), lane = tid & 63, wave = tid >> 6;
  for (int rr = 0; rr < 2; ++rr) {
    const int mm = wave * 2 + rr;
    float v[16]; float ss = 0.f;
#pragma unroll
    for (int j = 0; j < 16; ++j) { v[j] = meta[(size_t)mm * D + j * 64 + lane]; ss += v[j] * v[j]; }
    ss = wave_sum(ss);
    const float r = rsqrtf(ss * (1.0f / D) + EPS);
#pragma unroll
    for (int j = 0; j < 16; ++j) xmT[j * 64 + lane][mm] = v[j] * r * g1[j * 64 + lane];
  }
  __syncthreads();
  {
    const int c = tid & 15, ks = tid >> 4, n = blk * 16 + c;
    float acc[16];
#pragma unroll
    for (int j = 0; j < 16; ++j) acc[j] = 0.f;
#pragma unroll 8
    for (int kk = 0; kk < 32; ++kk) {
      const int k = ks * 32 + kk;
      const float w = w_in[(size_t)k * NIN + n];
      const f32x4 a = *(const f32x4*)&xmT[k][0], b4 = *(const f32x4*)&xmT[k][4], c4 = *(const f32x4*)&xmT[k][8], d4 = *(const f32x4*)&xmT[k][12];
      acc[0] += a.x * w; acc[1] += a.y * w; acc[2] += a.z * w; acc[3] += a.w * w;
      acc[4] += b4.x * w; acc[5] += b4.y * w; acc[6] += b4.z * w; acc[7] += b4.w * w;
      acc[8] += c4.x * w; acc[9] += c4.y * w; acc[10] += c4.z * w; acc[11] += c4.w * w;
      acc[12] += d4.x * w; acc[13] += d4.y * w; acc[14] += d4.z * w; acc[15] += d4.w * w;
    }
#pragma unroll
    for (int mm = 0; mm < 16; ++mm) red[ks][c * 16 + mm] = acc[mm];
  }
  __syncthreads();
  if (tid < 256) {
    const int c = tid >> 4, mm = tid & 15, n = blk * 16 + c;
    float val = 0.f;
#pragma unroll 8
    for (int ks = 0; ks < 32; ++ks) val += red[ks][tid];
    const bf16_t hv = (bf16_t)f2bf(val);
    for (int bb = 0; bb < NB; ++bb) {
      if (n < 512) {}
      else if (n < 1024) { const int cc = n - 512;  O.KSB[((size_t)(bb * SBH + (cc >> 6)) * KIDX + 16 + mm) * 64 + (cc & 63)] = hv; }
      else if (n < 1536) { const int cc = n - 1024; O.VTSB[((size_t)(bb * SBH + (cc >> 6)) * 64 + (cc & 63)) * KIDX + 16 + mm] = hv; }
      else if (n < 1792) { const int cc = n - 1536; O.GQ[((size_t)(bb * GH + (cc >> 6)) * GU + 48 + mm) * 64 + (cc & 63)] = hv; }
      else if (n < 2048) { const int cc = n - 1792; O.GK[((size_t)(bb * GH + (cc >> 6)) * GU + 48 + mm) * 64 + (cc & 63)] = hv; }
      else if (n < 2560) { const int cc = n - 2048; O.GV[((size_t)(bb * GH + (cc >> 7)) * 128 + (cc & 127)) * GU + 48 + mm] = hv; }
      else if (n < 3072) {}
      else { O.GLR[((size_t)bb * GU + 48 + mm) * 16 + (n - 3072)] = val; }
    }
  }
  __syncthreads();
}


constexpr float SB_THR = 5.421010862e-20f;
DI void ph_sb_attn(int vb, const bf16_t* __restrict__ QSB, const bf16_t* __restrict__ KSB, const bf16_t* __restrict__ VTSB,
                                                 const float* __restrict__ sb_g, bf16_t* __restrict__ MIX) {
  const int tid256_ = fresh_tid() & 255;
  const int lane = TID & 63, wave = TID >> 6, r = lane & 31, h = lane >> 5;
  const int bh = vb >> 6, qb = vb & 63;
  const int b = bh >> 3, hd = bh & 7;
  const int i0 = qb * 128 + wave * 32;
  const bf16_t* Qb = QSB + ((size_t)bh * SEQ + i0) * 64;
  const bf16_t* Kb = KSB + (size_t)bh * KIDX * 64;
  const bf16_t* Vb = VTSB + (size_t)bh * 64 * KIDX;
  bf16x8 qf[4];
#pragma unroll
  for (int ks = 0; ks < 4; ++ks) qf[ks] = *(const bf16x8*)(Qb + r * 64 + ks * 16 + h * 8);
  f32x16 o[2];
#pragma unroll
  for (int e = 0; e < 16; ++e) { o[0][e] = 0.f; o[1][e] = 0.f; }
  float R = 1.f;
  const int qidx = 32 + i0 + r;
  for (int c = (i0 >> 5) + 1; c >= 0; --c) {
    const int k0 = 32 * c;
    bf16x8 kf[4];
#pragma unroll
    for (int ks = 0; ks < 4; ++ks) kf[ks] = *(const bf16x8*)(Kb + (size_t)(k0 + r) * 64 + ks * 16 + h * 8);
    bf16x8 vf[2][2];
#pragma unroll
    for (int mt = 0; mt < 2; ++mt)
#pragma unroll
      for (int s2 = 0; s2 < 2; ++s2) {
        const bf16_t* vp = Vb + (size_t)(mt * 32 + r) * KIDX + k0 + 16 * s2 + 4 * h;
        const u32x2 lo = *(const u32x2*)vp, hi = *(const u32x2*)(vp + 8);
        u32x4 t; t.x = lo.x; t.y = lo.y; t.z = hi.x; t.w = hi.y;
        vf[mt][s2] = __builtin_bit_cast(bf16x8, t);
      }
    f32x16 s;
#pragma unroll
    for (int e = 0; e < 16; ++e) s[e] = 0.f;
#pragma unroll
    for (int ks = 0; ks < 4; ++ks) s = MFMA32(kf[ks], qf[ks], s);
    float om[16], bt[16];
#pragma unroll
    for (int e = 0; e < 16; ++e) {
      const int kidx = k0 + crow(e, h);
      const bool valid = (kidx < qidx) && (kidx >= 16);
      const float z = s[e] * 0.125f;
      const float ez = __expf(-fabsf(z));
      const float big = __builtin_amdgcn_rcpf(1.f + ez), small = ez * big;
      const float beta = z >= 0.f ? big : small, onem = z >= 0.f ? small : big;
      om[e] = valid ? onem : 1.f;
      bt[e] = valid ? beta : 0.f;
    }
    float sfx[16], G[4], PG[4];
#pragma unroll
    for (int g = 0; g < 4; ++g) {
      sfx[4 * g + 3] = 1.f;
      sfx[4 * g + 2] = om[4 * g + 3];
      sfx[4 * g + 1] = sfx[4 * g + 2] * om[4 * g + 2];
      sfx[4 * g + 0] = sfx[4 * g + 1] * om[4 * g + 1];
      G[g] = sfx[4 * g + 0] * om[4 * g + 0];
      PG[g] = __shfl_xor(G[g], 32);
    }
    float HS[4];
    HS[3] = 1.f;
    HS[2] = G[3] * PG[3];
    HS[1] = HS[2] * (G[2] * PG[2]);
    HS[0] = HS[1] * (G[1] * PG[1]);
    const float total = HS[0] * (G[0] * PG[0]);
    float a[16];
#pragma unroll
    for (int e = 0; e < 16; ++e) {
      const int g = e >> 2;
      const float between = sfx[e] * (h == 0 ? PG[g] : 1.f) * (HS[g] * R);
      a[e] = bt[e] * between;
    }
    R *= total;
#pragma unroll
    for (int s2 = 0; s2 < 2; ++s2) {
      u32x4 p;
      p.x = pk2(a[8 * s2 + 0], a[8 * s2 + 1]); p.y = pk2(a[8 * s2 + 2], a[8 * s2 + 3]);
      p.z = pk2(a[8 * s2 + 4], a[8 * s2 + 5]); p.w = pk2(a[8 * s2 + 6], a[8 * s2 + 7]);
      const bf16x8 pf = __builtin_bit_cast(bf16x8, p);
      o[0] = MFMA32(vf[0][s2], pf, o[0]);
      o[1] = MFMA32(vf[1][s2], pf, o[1]);
    }
    if (__all(R < SB_THR)) break;
  }
  float ss = 0.f;
#pragma unroll
  for (int e = 0; e < 16; ++e) ss += o[0][e] * o[0][e] + o[1][e] * o[1][e];
  ss += __shfl_xor(ss, 32);
  const float sc = rsqrtf(ss * (1.0f / 64.0f) + EPS);
  bf16_t* outp = MIX + (size_t)(b * SEQ + i0 + r) * D + hd * 64;
#pragma unroll
  for (int mt = 0; mt < 2; ++mt)
#pragma unroll
    for (int g = 0; g < 4; ++g) {
      const int d = mt * 32 + 8 * g + 4 * h;
      const f32x4 gg = *(const f32x4*)(sb_g + hd * 64 + d);
      u32x2 pk;
      pk.x = pk2(o[mt][4 * g] * sc * gg.x, o[mt][4 * g + 1] * sc * gg.y);
      pk.y = pk2(o[mt][4 * g + 2] * sc * gg.z, o[mt][4 * g + 3] * sc * gg.w);
      *(u32x2*)(outp + d) = pk;
    }
}


DI void sb_tile_step(const f32x16& s, int k0, int qidx, int h, float& R, const bf16x8 (&vf)[2][2], f32x16 (&o)[2]) {
  float om[16], bt[16];
#pragma unroll
  for (int e = 0; e < 16; ++e) {
    const int kidx = k0 + crow(e, h);
    const bool valid = (kidx < qidx) && (kidx >= 16);
    const float z = s[e] * 0.125f;
    const float ez = __expf(-fabsf(z));
    const float big = __builtin_amdgcn_rcpf(1.f + ez), small = ez * big;
    const float beta = z >= 0.f ? big : small, onem = z >= 0.f ? small : big;
    om[e] = valid ? onem : 1.f;
    bt[e] = valid ? beta : 0.f;
  }
  float sfx[16], G[4], PG[4];
#pragma unroll
  for (int g = 0; g < 4; ++g) {
    sfx[4 * g + 3] = 1.f;
    sfx[4 * g + 2] = om[4 * g + 3];
    sfx[4 * g + 1] = sfx[4 * g + 2] * om[4 * g + 2];
    sfx[4 * g + 0] = sfx[4 * g + 1] * om[4 * g + 1];
    G[g] = sfx[4 * g + 0] * om[4 * g + 0];
    PG[g] = __shfl_xor(G[g], 32);
  }
  float HS[4];
  HS[3] = 1.f; HS[2] = G[3] * PG[3]; HS[1] = HS[2] * (G[2] * PG[2]); HS[0] = HS[1] * (G[1] * PG[1]);
  const float total = HS[0] * (G[0] * PG[0]);
  float a[16];
#pragma unroll
  for (int e = 0; e < 16; ++e) { const int g = e >> 2; a[e] = bt[e] * (sfx[e] * (h == 0 ? PG[g] : 1.f) * (HS[g] * R)); }
  R *= total;
#pragma unroll
  for (int s2 = 0; s2 < 2; ++s2) {
    u32x4 p;
    p.x = pk2(a[8 * s2 + 0], a[8 * s2 + 1]); p.y = pk2(a[8 * s2 + 2], a[8 * s2 + 3]);
    p.z = pk2(a[8 * s2 + 4], a[8 * s2 + 5]); p.w = pk2(a[8 * s2 + 6], a[8 * s2 + 7]);
    const bf16x8 pf = __builtin_bit_cast(bf16x8, p);
    o[0] = MFMA32(vf[0][s2], pf, o[0]);
    o[1] = MFMA32(vf[1][s2], pf, o[1]);
  }
}
DI void sb_tile_out(const f32x16 (&o)[2], int h, const float* __restrict__ sb_gh, bf16_t* __restrict__ outp) {
  float ss = 0.f;
#pragma unroll
  for (int e = 0; e < 16; ++e) ss += o[0][e] * o[0][e] + o[1][e] * o[1][e];
  ss += __shfl_xor(ss, 32);
  const float sc = rsqrtf(ss * (1.0f / 64.0f) + EPS);
#pragma unroll
  for (int mt = 0; mt < 2; ++mt)
#pragma unroll
    for (int g = 0; g < 4; ++g) {
      const int d = mt * 32 + 8 * g + 4 * h;
      const f32x4 gg = *(const f32x4*)(sb_gh + d);
      u32x2 pk;
      pk.x = pk2(o[mt][4 * g] * sc * gg.x, o[mt][4 * g + 1] * sc * gg.y);
      pk.y = pk2(o[mt][4 * g + 2] * sc * gg.z, o[mt][4 * g + 3] * sc * gg.w);
      *(u32x2*)(outp + d) = pk;
    }
}
DI void ph_sb_attn2(int vb, const bf16_t* __restrict__ QSB, const bf16_t* __restrict__ KSB, const bf16_t* __restrict__ VTSB,
                    const float* __restrict__ sb_g, bf16_t* __restrict__ MIX) {
  const int tid256_ = fresh_tid() & 255;
  const int lane = TID & 63, wave = TID >> 6, r = lane & 31, h = lane >> 5;
  const int bh = vb >> 5, qb = vb & 31;
  const int b = bh >> 3, hd = bh & 7;
  const int i0 = qb * 256 + wave * 64;
  const bf16_t* Qb = QSB + ((size_t)bh * SEQ + i0) * 64;
  const bf16_t* Kb = KSB + (size_t)bh * KIDX * 64;
  const bf16_t* Vb = VTSB + (size_t)bh * 64 * KIDX;
  bf16x8 qfA[4], qfB[4];
#pragma unroll
  for (int ks = 0; ks < 4; ++ks) { qfA[ks] = *(const bf16x8*)(Qb + r * 64 + ks * 16 + h * 8); qfB[ks] = *(const bf16x8*)(Qb + (32 + r) * 64 + ks * 16 + h * 8); }
  f32x16 oA[2], oB[2];
#pragma unroll
  for (int e = 0; e < 16; ++e) { oA[0][e] = 0.f; oA[1][e] = 0.f; oB[0][e] = 0.f; oB[1][e] = 0.f; }
  float RA = 1.f, RB = 1.f;
  const int qidxA = 32 + i0 + r, qidxB = qidxA + 32;
  for (int c = (i0 >> 5) + 2; c >= 0; --c) {
    const int k0 = 32 * c;
    bf16x8 kf[4];
#pragma unroll
    for (int ks = 0; ks < 4; ++ks) kf[ks] = *(const bf16x8*)(Kb + (size_t)(k0 + r) * 64 + ks * 16 + h * 8);
    bf16x8 vf[2][2];
#pragma unroll
    for (int mt = 0; mt < 2; ++mt)
#pragma unroll
      for (int s2 = 0; s2 < 2; ++s2) {
        const bf16_t* vp = Vb + (size_t)(mt * 32 + r) * KIDX + k0 + 16 * s2 + 4 * h;
        const u32x2 lo = *(const u32x2*)vp, hi = *(const u32x2*)(vp + 8);
        u32x4 t; t.x = lo.x; t.y = lo.y; t.z = hi.x; t.w = hi.y;
        vf[mt][s2] = __builtin_bit_cast(bf16x8, t);
      }
    f32x16 sA, sB;
#pragma unroll
    for (int e = 0; e < 16; ++e) { sA[e] = 0.f; sB[e] = 0.f; }
#pragma unroll
    for (int ks = 0; ks < 4; ++ks) { sA = MFMA32(kf[ks], qfA[ks], sA); sB = MFMA32(kf[ks], qfB[ks], sB); }
    sb_tile_step(sB, k0, qidxB, h, RB, vf, oB);
    sb_tile_step(sA, k0, qidxA, h, RA, vf, oA);
    if (__all(RA < SB_THR && RB < SB_THR)) break;
  }
  sb_tile_out(oA, h, sb_g + hd * 64, MIX + (size_t)(b * SEQ + i0 + r) * D + hd * 64);
  sb_tile_out(oB, h, sb_g + hd * 64, MIX + (size_t)(b * SEQ + i0 + 32 + r) * D + hd * 64);
}


constexpr int RT_TOK_PER_BLOCK = 256;


#define MFMA16(a, b, c) __builtin_amdgcn_mfma_f32_16x16x32_bf16((a), (b), (c), 0, 0, 0)
constexpr int GLDS = 72;
struct GlaLds {
  bf16_t Qt[64 * GLDS];
  bf16_t Kt[64 * GLDS];
  bf16_t KT[64 * GLDS];
  bf16_t P[64 * GLDS];
  float dec[64];
  float tot[8][64];
  float ssq[8][64];
};
constexpr size_t WS_SLOC = 926 * MiB;
constexpr size_t WS_DTOT = 942 * MiB;
constexpr size_t WS_GVT = 604 * MiB;

struct GlaPtrs { const bf16_t *GQ, *GK, *GVT, *GR; const float *GLR, *wg, *bg, *gla_g; float *SLOC, *DTOT; bf16_t* MIX; };


constexpr size_t WS_GQT = 80 * MiB;
constexpr size_t WS_GKT = 113 * MiB;
constexpr size_t WS_GKTT = 146 * MiB;
constexpr size_t WS_GDEC = 179 * MiB;
constexpr size_t WS_GBL = 182 * MiB;
struct GlaPrepPtrs { const bf16_t *GQ, *GK; const float *GLR, *wg, *bg; bf16_t *QT, *KT, *KTT; float *DEC, *BL; };
DI void ph_gla_prep(int item, char* smem, const GlaPrepPtrs& G) {
  float (*tot)[64] = (float (*)[64])smem;
  const int tid = fresh_tid(), lane = tid & 63, w = tid >> 6;
  const int bh = item / 129, c = item % 129, b = bh >> 2, hd = bh & 3, u0 = 64 * c;
  float wgr[16];
#pragma unroll
  for (int k = 0; k < 16; ++k) wgr[k] = G.wg[k * 256 + hd * 64 + lane];
  const float bgv = G.bg[hd * 64 + lane];
  float cs[8]; float run = 0.f;
  unsigned short kraw[8], qraw[8];
#pragma unroll
  for (int i = 0; i < 8; ++i) {
    const int u = u0 + 8 * w + i;
    kraw[i] = G.GK[((size_t)bh * GU + u) * 64 + lane];
    qraw[i] = G.GQ[((size_t)bh * GU + u) * 64 + lane];
    float lgv = 0.f;
    if (u >= 48) {
      const f32x4* gp = (const f32x4*)(G.GLR + ((size_t)b * GU + u) * 16);
      const f32x4 g0 = gp[0], g1 = gp[1], g2 = gp[2], g3 = gp[3];
      float a = bgv;
      a += g0.x * wgr[0] + g0.y * wgr[1] + g0.z * wgr[2] + g0.w * wgr[3];
      a += g1.x * wgr[4] + g1.y * wgr[5] + g1.z * wgr[6] + g1.w * wgr[7];
      a += g2.x * wgr[8] + g2.y * wgr[9] + g2.z * wgr[10] + g2.w * wgr[11];
      a += g3.x * wgr[12] + g3.y * wgr[13] + g3.z * wgr[14] + g3.w * wgr[15];
      lgv = -softplus(-a) * (1.0f / 16.0f);
    }
    run += lgv; cs[i] = run;
  }
  tot[w][lane] = run;
  __syncthreads();
  float offset = 0.f, total = 0.f;
#pragma unroll
  for (int s2 = 0; s2 < 8; ++s2) { const float tv = tot[s2][lane]; total += tv; if (s2 < w) offset += tv; }
  const size_t cb = ((size_t)bh * 129 + c) * 4096;
  float kt[8];
#pragma unroll
  for (int i = 0; i < 8; ++i) {
    const float bc = offset + cs[i];
    kt[i] = bf2f(kraw[i]) * __expf(-bc);
    G.QT[cb + (8 * w + i) * 64 + lane] = (bf16_t)f2bf(bf2f(qraw[i]) * __expf(bc) * 0.125f);
    G.KT[cb + (8 * w + i) * 64 + lane] = (bf16_t)f2bf(kt[i]);
  }
  u32x4 kp; kp.x = pk2(kt[0], kt[1]); kp.y = pk2(kt[2], kt[3]); kp.z = pk2(kt[4], kt[5]); kp.w = pk2(kt[6], kt[7]);
  *(u32x4*)(G.KTT + cb + lane * 64 + 8 * w) = kp;
  if (w == 0) { G.DEC[((size_t)bh * 129 + c) * 64 + lane] = __expf(total); G.BL[((size_t)bh * 129 + c) * 64 + lane] = total; }
  __syncthreads();
}

struct GlaBuf { bf16_t Qt[64 * GLDS]; bf16_t Kt[64 * GLDS]; bf16_t KT[64 * GLDS]; };
struct GlaLds3 { GlaBuf B[2]; bf16_t P[64 * GLDS]; float ssq[8][64]; };
struct GlaPtrs3 { const bf16_t *QT, *KT, *KTT, *GVT, *GR; const float *DEC, *BL, *gla_g; float *SLOC, *DTOT; bf16_t* MIX; };

template <int PASS>
DI void gla_item3(int bh, int sc, char* smem, const GlaPtrs3& G) {
  GlaLds3& L = *(GlaLds3*)smem;
  const int tid = fresh_tid(), lane = tid & 63, w = __builtin_amdgcn_readfirstlane(tid >> 6), c16 = lane & 15, q = lane >> 4;
  const int b = bh >> 2, hd = bh & 3;
  const int cbeg = sc == 0 ? 0 : 8 * sc + 1, cend = 8 * sc + 9;
  f32x4 X[4];
#pragma unroll
  for (int i = 0; i < 4; ++i) X[i] = (f32x4){0.f, 0.f, 0.f, 0.f};
  if (PASS == 1) {
#pragma unroll 4
    for (int j = 0; j < sc; ++j) {
      const float* dt = G.DTOT + (size_t)(bh * 16 + j) * 64;
      const float* sl = G.SLOC + ((size_t)(bh * 16 + j) * 8 + w) * 16 * 64 + lane;
#pragma unroll
      for (int i = 0; i < 4; ++i) {
        const f32x4 d4 = *(const f32x4*)(dt + 16 * i + 4 * q);
        X[i][0] = d4.x * X[i][0] + sl[(4 * i + 0) * 64]; X[i][1] = d4.y * X[i][1] + sl[(4 * i + 1) * 64];
        X[i][2] = d4.z * X[i][2] + sl[(4 * i + 2) * 64]; X[i][3] = d4.w * X[i][3] + sl[(4 * i + 3) * 64];
      }
    }
  }
  f32x4 gain = {1.f, 1.f, 1.f, 1.f};
  if (PASS == 1) gain = *(const f32x4*)(G.gla_g + hd * 128 + 16 * w + 4 * q);
  const bf16_t* gvt = G.GVT + ((size_t)bh * 128 + 16 * w + c16) * GU + 8 * q;
  const int srow = tid >> 3, sc8 = tid & 7, soff = srow * GLDS + sc8 * 8;
  const size_t cb0 = (size_t)bh * 129 * 4096 + (size_t)srow * 64 + sc8 * 8;
  u32x4 rq, rk, rkt, rq2, rk2, rkt2; bf16x8 vfr[2], vfn[2], vfn2[2]; f32x4 dec[4], decn[4], decn2[4];
  {
    const size_t cb = cb0 + (size_t)cbeg * 4096;
    rkt = *(const u32x4*)(G.KTT + cb);
    if (PASS == 1) { rq = *(const u32x4*)(G.QT + cb); rk = *(const u32x4*)(G.KT + cb); }
    vfr[0] = *(const bf16x8*)(gvt + 64 * cbeg); vfr[1] = *(const bf16x8*)(gvt + 64 * cbeg + 32);
#pragma unroll
    for (int i = 0; i < 4; ++i) dec[i] = *(const f32x4*)(G.DEC + ((size_t)bh * 129 + cbeg) * 64 + 16 * i + 4 * q);
    *(u32x4*)&L.B[0].KT[soff] = rkt;
    if (PASS == 1) { *(u32x4*)&L.B[0].Qt[soff] = rq; *(u32x4*)&L.B[0].Kt[soff] = rk; }
    const size_t cb1 = cb0 + (size_t)(cbeg + 1) * 4096;
    rkt = *(const u32x4*)(G.KTT + cb1);
    if (PASS == 1) { rq = *(const u32x4*)(G.QT + cb1); rk = *(const u32x4*)(G.KT + cb1); }
    vfn[0] = *(const bf16x8*)(gvt + 64 * (cbeg + 1)); vfn[1] = *(const bf16x8*)(gvt + 64 * (cbeg + 1) + 32);
#pragma unroll
    for (int i = 0; i < 4; ++i) decn[i] = *(const f32x4*)(G.DEC + ((size_t)bh * 129 + cbeg + 1) * 64 + 16 * i + 4 * q);
  }
  __syncthreads();
  for (int c = cbeg; c < cend; ++c) {
    const int cur = (c - cbeg) & 1;
    const GlaBuf& Bc = L.B[cur];
    const bool more = c + 1 < cend, more2 = c + 2 < cend;
    if (more2) {
      const size_t cb = cb0 + (size_t)(c + 2) * 4096;
      rkt2 = *(const u32x4*)(G.KTT + cb);
      if (PASS == 1) { rq2 = *(const u32x4*)(G.QT + cb); rk2 = *(const u32x4*)(G.KT + cb); }
      vfn2[0] = *(const bf16x8*)(gvt + 64 * (c + 2)); vfn2[1] = *(const bf16x8*)(gvt + 64 * (c + 2) + 32);
#pragma unroll
      for (int i = 0; i < 4; ++i) decn2[i] = *(const f32x4*)(G.DEC + ((size_t)bh * 129 + c + 2) * 64 + 16 * i + 4 * q);
    }
    u32x2 grv[4];
    if (PASS == 1 && c >= 1) {
#pragma unroll
      for (int n = 0; n < 4; ++n) grv[n] = *(const u32x2*)(G.GR + ((size_t)b * SEQ + 64 * (c - 1) + 16 * n + c16) * 512 + hd * 128 + 16 * w + 4 * q);
    }
    f32x4 OT[4];
    if (PASS == 1) {
      const int is = w >> 1;
#pragma unroll
      for (int z = 0; z < 2; ++z) {
        const int it = 2 * (w & 1) + z;
        f32x4 pa = {0.f, 0.f, 0.f, 0.f};
        if (is <= it) {
#pragma unroll
          for (int kk = 0; kk < 2; ++kk) {
            const bf16x8 ka = *(const bf16x8*)&Bc.Kt[(16 * is + c16) * GLDS + 32 * kk + 8 * q];
            const bf16x8 qb = *(const bf16x8*)&Bc.Qt[(16 * it + c16) * GLDS + 32 * kk + 8 * q];
            pa = MFMA16(ka, qb, pa);
          }
          if (is == it) {
#pragma unroll
            for (int r = 0; r < 4; ++r) if (4 * q + r > c16) pa[r] = 0.f;
          }
        }
        u32x2 pw; pw.x = pk2(pa[0], pa[1]); pw.y = pk2(pa[2], pa[3]);
        *(u32x2*)&L.P[(16 * it + c16) * GLDS + 16 * is + 4 * q] = pw;
      }
#pragma unroll
      for (int n = 0; n < 4; ++n) OT[n] = (f32x4){0.f, 0.f, 0.f, 0.f};
#pragma unroll
      for (int kk = 0; kk < 2; ++kk) {
        u32x4 xp; xp.x = pk2(X[2 * kk][0], X[2 * kk][1]); xp.y = pk2(X[2 * kk][2], X[2 * kk][3]);
        xp.z = pk2(X[2 * kk + 1][0], X[2 * kk + 1][1]); xp.w = pk2(X[2 * kk + 1][2], X[2 * kk + 1][3]);
        const bf16x8 xa = __builtin_bit_cast(bf16x8, xp);
#pragma unroll
        for (int n = 0; n < 4; ++n) {
          const u32x2 lo = *(const u32x2*)&Bc.Qt[(16 * n + c16) * GLDS + 32 * kk + 4 * q];
          const u32x2 hi = *(const u32x2*)&Bc.Qt[(16 * n + c16) * GLDS + 32 * kk + 16 + 4 * q];
          u32x4 qq; qq.x = lo.x; qq.y = lo.y; qq.z = hi.x; qq.w = hi.y;
          OT[n] = MFMA16(xa, __builtin_bit_cast(bf16x8, qq), OT[n]);
        }
      }
      __syncthreads();
#pragma unroll
      for (int kk = 0; kk < 2; ++kk)
#pragma unroll
        for (int n = 0; n < 4; ++n) {
          const bf16x8 pb = *(const bf16x8*)&L.P[(16 * n + c16) * GLDS + 32 * kk + 8 * q];
          OT[n] = MFMA16(vfr[kk], pb, OT[n]);
        }
    }
#pragma unroll
    for (int i = 0; i < 4; ++i) {
#pragma unroll
      for (int kk = 0; kk < 2; ++kk) {
        const bf16x8 ka = *(const bf16x8*)&Bc.KT[(16 * i + c16) * GLDS + 32 * kk + 8 * q];
        X[i] = MFMA16(ka, vfr[kk], X[i]);
      }
      X[i][0] *= dec[i].x; X[i][1] *= dec[i].y; X[i][2] *= dec[i].z; X[i][3] *= dec[i].w;
    }
    if (PASS == 1 && c >= 1) {
      float ss[4];
#pragma unroll
      for (int n = 0; n < 4; ++n) {
        float v = OT[n][0] * OT[n][0] + OT[n][1] * OT[n][1] + OT[n][2] * OT[n][2] + OT[n][3] * OT[n][3];
        v += __shfl_xor(v, 16); v += __shfl_xor(v, 32);
        ss[n] = v;
      }
      if (q == 0) {
#pragma unroll
        for (int n = 0; n < 4; ++n) L.ssq[w][16 * n + c16] = ss[n];
      }
      __syncthreads();
#pragma unroll
      for (int n = 0; n < 4; ++n) {
        float tot = 0.f;
#pragma unroll
        for (int w2 = 0; w2 < 8; ++w2) tot += L.ssq[w2][16 * n + c16];
        const float scl = rsqrtf(tot * (1.0f / 128.0f) + EPS);
        const size_t m = (size_t)b * SEQ + 64 * (c - 1) + 16 * n + c16;
        const float r0 = bflo(grv[n].x), r1 = bfhi(grv[n].x), r2 = bflo(grv[n].y), r3 = bfhi(grv[n].y);
        const float o0 = OT[n][0] * scl * gain.x * (r0 / (1.f + __expf(-r0)));
        const float o1 = OT[n][1] * scl * gain.y * (r1 / (1.f + __expf(-r1)));
        const float o2 = OT[n][2] * scl * gain.z * (r2 / (1.f + __expf(-r2)));
        const float o3 = OT[n][3] * scl * gain.w * (r3 / (1.f + __expf(-r3)));
        u32x2 ow; ow.x = pk2(o0, o1); ow.y = pk2(o2, o3);
        *(u32x2*)(G.MIX + m * D + 512 + hd * 128 + 16 * w + 4 * q) = ow;
      }
    }
    if (more) {
      GlaBuf& Bn = L.B[cur ^ 1];
      *(u32x4*)&Bn.KT[soff] = rkt;
      if (PASS == 1) { *(u32x4*)&Bn.Qt[soff] = rq; *(u32x4*)&Bn.Kt[soff] = rk; }
      vfr[0] = vfn[0]; vfr[1] = vfn[1];
#pragma unroll
      for (int i = 0; i < 4; ++i) dec[i] = decn[i];
      rkt = rkt2; rq = rq2; rk = rk2; vfn[0] = vfn2[0]; vfn[1] = vfn2[1];
#pragma unroll
      for (int i = 0; i < 4; ++i) decn[i] = decn2[i];
    }
    __syncthreads();
  }
  if (PASS == 0) {
    float* sl = G.SLOC + ((size_t)(bh * 16 + sc) * 8 + w) * 16 * 64 + lane;
#pragma unroll
    for (int i = 0; i < 4; ++i)
#pragma unroll
      for (int r = 0; r < 4; ++r) sl[(4 * i + r) * 64] = X[i][r];
    if (w == 0) {
      float bl = 0.f;
      for (int c = cbeg; c < cend; ++c) bl += G.BL[((size_t)bh * 129 + c) * 64 + lane];
      G.DTOT[(size_t)(bh * 16 + sc) * 64 + lane] = __expf(bl);
    }
  }
}


struct GlaLds4 { GlaBuf B[2]; bf16_t P[64 * GLDS]; float ssq[4][64]; };
template <int PASS>
DI void gla_item4(int bh_lo, int sc, char* smem, const GlaPtrs3& G) {
  const int tid = fresh_tid(), lane = tid & 63, w = __builtin_amdgcn_readfirstlane(tid >> 6), c16 = lane & 15, q = lane >> 4;
  const int hb = w >> 2, w4 = w & 3, tid4 = tid & 255;
  GlaLds4& L = *(GlaLds4*)(smem + hb * (int)sizeof(GlaLds4));
  const int bh = bh_lo + 16 * hb, b = bh >> 2, hd = bh & 3;
  const int cbeg = sc == 0 ? 0 : 8 * sc + 1, cend = 8 * sc + 9;
  f32x4 X[2][4];
#pragma unroll
  for (int et = 0; et < 2; ++et)
#pragma unroll
    for (int i = 0; i < 4; ++i) X[et][i] = (f32x4){0.f, 0.f, 0.f, 0.f};
  if (PASS == 1) {
#pragma unroll 2
    for (int j = 0; j < sc; ++j) {
      const float* dt = G.DTOT + (size_t)(bh * 16 + j) * 64;
#pragma unroll
      for (int et = 0; et < 2; ++et) {
        const float* sl = G.SLOC + ((size_t)(bh * 16 + j) * 8 + w4 * 2 + et) * 16 * 64 + lane;
#pragma unroll
        for (int i = 0; i < 4; ++i) {
          const f32x4 d4 = *(const f32x4*)(dt + 16 * i + 4 * q);
          X[et][i][0] = d4.x * X[et][i][0] + sl[(4 * i + 0) * 64]; X[et][i][1] = d4.y * X[et][i][1] + sl[(4 * i + 1) * 64];
          X[et][i][2] = d4.z * X[et][i][2] + sl[(4 * i + 2) * 64]; X[et][i][3] = d4.w * X[et][i][3] + sl[(4 * i + 3) * 64];
        }
      }
    }
  }
  f32x4 gain[2];
#pragma unroll
  for (int et = 0; et < 2; ++et) gain[et] = PASS == 1 ? *(const f32x4*)(G.gla_g + hd * 128 + 32 * w4 + 16 * et + 4 * q) : (f32x4){1.f, 1.f, 1.f, 1.f};
  const bf16_t* gvt0 = G.GVT + ((size_t)bh * 128 + 32 * w4 + c16) * GU + 8 * q;
  const bf16_t* gvt1 = gvt0 + (size_t)16 * GU;
  const int soffA = (tid4 >> 3) * GLDS + (tid4 & 7) * 8, soffB = soffA + 32 * GLDS;
  const size_t cb0 = (size_t)bh * 129 * 4096 + (size_t)(tid4 >> 3) * 64 + (tid4 & 7) * 8;
  u32x4 rq[2], rk[2], rkt[2], rq2[2], rk2[2], rkt2[2];
  bf16x8 vfr[2][2], vfn[2][2]; f32x4 dec[4], decn[4];
#define G4_LOADT(rq_, rk_, rkt_, c_) { const size_t cb_ = cb0 + (size_t)(c_) * 4096; \
    rkt_[0] = *(const u32x4*)(G.KTT + cb_); rkt_[1] = *(const u32x4*)(G.KTT + cb_ + 2048); \
    if (PASS == 1) { rq_[0] = *(const u32x4*)(G.QT + cb_); rq_[1] = *(const u32x4*)(G.QT + cb_ + 2048); rk_[0] = *(const u32x4*)(G.KT + cb_); rk_[1] = *(const u32x4*)(G.KT + cb_ + 2048); } }
#define G4_LOADV(vf_, dc_, c_) { vf_[0][0] = *(const bf16x8*)(gvt0 + 64 * (c_)); vf_[0][1] = *(const bf16x8*)(gvt0 + 64 * (c_) + 32); \
    vf_[1][0] = *(const bf16x8*)(gvt1 + 64 * (c_)); vf_[1][1] = *(const bf16x8*)(gvt1 + 64 * (c_) + 32); \
    _Pragma("unroll") for (int i = 0; i < 4; ++i) dc_[i] = *(const f32x4*)(G.DEC + ((size_t)bh * 129 + (c_)) * 64 + 16 * i + 4 * q); }
#define G4_STORET(Bn_, rq_, rk_, rkt_) { *(u32x4*)&Bn_.KT[soffA] = rkt_[0]; *(u32x4*)&Bn_.KT[soffB] = rkt_[1]; \
    if (PASS == 1) { *(u32x4*)&Bn_.Qt[soffA] = rq_[0]; *(u32x4*)&Bn_.Qt[soffB] = rq_[1]; *(u32x4*)&Bn_.Kt[soffA] = rk_[0]; *(u32x4*)&Bn_.Kt[soffB] = rk_[1]; } }
  G4_LOADT(rq, rk, rkt, cbeg)
  G4_LOADV(vfr, dec, cbeg)
  G4_STORET(L.B[0], rq, rk, rkt)
  G4_LOADT(rq, rk, rkt, cbeg + 1)
  G4_LOADV(vfn, decn, cbeg + 1)
  __syncthreads();
  for (int c = cbeg; c < cend; ++c) {
    const int cur = (c - cbeg) & 1;
    const GlaBuf& Bc = L.B[cur];
    const bool more = c + 1 < cend, more2 = c + 2 < cend;
    if (more2) G4_LOADT(rq2, rk2, rkt2, c + 2)
    u32x2 grv[2][4];
    if (PASS == 1 && c >= 1) {
#pragma unroll
      for (int et = 0; et < 2; ++et)
#pragma unroll
        for (int n = 0; n < 4; ++n) grv[et][n] = *(const u32x2*)(G.GR + ((size_t)b * SEQ + 64 * (c - 1) + 16 * n + c16) * 512 + hd * 128 + 32 * w4 + 16 * et + 4 * q);
    }
    f32x4 OT[2][4];
    if (PASS == 1) {
      const int is = w4;
#pragma unroll
      for (int it = 0; it < 4; ++it) {
        f32x4 pa = {0.f, 0.f, 0.f, 0.f};
        if (is <= it) {
#pragma unroll
          for (int kk = 0; kk < 2; ++kk) {
            const bf16x8 ka = *(const bf16x8*)&Bc.Kt[(16 * is + c16) * GLDS + 32 * kk + 8 * q];
            const bf16x8 qb = *(const bf16x8*)&Bc.Qt[(16 * it + c16) * GLDS + 32 * kk + 8 * q];
            pa = MFMA16(ka, qb, pa);
          }
          if (is == it) {
#pragma unroll
            for (int r = 0; r < 4; ++r) if (4 * q + r > c16) pa[r] = 0.f;
          }
        }
        u32x2 pw; pw.x = pk2(pa[0], pa[1]); pw.y = pk2(pa[2], pa[3]);
        *(u32x2*)&L.P[(16 * it + c16) * GLDS + 16 * is + 4 * q] = pw;
      }
#pragma unroll
      for (int et = 0; et < 2; ++et)
#pragma unroll
        for (int n = 0; n < 4; ++n) OT[et][n] = (f32x4){0.f, 0.f, 0.f, 0.f};
#pragma unroll
      for (int kk = 0; kk < 2; ++kk) {
        bf16x8 xa[2];
#pragma unroll
        for (int et = 0; et < 2; ++et) {
          u32x4 xp; xp.x = pk2(X[et][2 * kk][0], X[et][2 * kk][1]); xp.y = pk2(X[et][2 * kk][2], X[et][2 * kk][3]);
          xp.z = pk2(X[et][2 * kk + 1][0], X[et][2 * kk + 1][1]); xp.w = pk2(X[et][2 * kk + 1][2], X[et][2 * kk + 1][3]);
          xa[et] = __builtin_bit_cast(bf16x8, xp);
        }
#pragma unroll
        for (int n = 0; n < 4; ++n) {
          const u32x2 lo = *(const u32x2*)&Bc.Qt[(16 * n + c16) * GLDS + 32 * kk + 4 * q];
          const u32x2 hi = *(const u32x2*)&Bc.Qt[(16 * n + c16) * GLDS + 32 * kk + 16 + 4 * q];
          u32x4 qq; qq.x = lo.x; qq.y = lo.y; qq.z = hi.x; qq.w = hi.y;
          const bf16x8 qf = __builtin_bit_cast(bf16x8, qq);
          OT[0][n] = MFMA16(xa[0], qf, OT[0][n]);
          OT[1][n] = MFMA16(xa[1], qf, OT[1][n]);
        }
      }
      __syncthreads();
#pragma unroll
      for (int kk = 0; kk < 2; ++kk)
#pragma unroll
        for (int n = 0; n < 4; ++n) {
          const bf16x8 pb = *(const bf16x8*)&L.P[(16 * n + c16) * GLDS + 32 * kk + 8 * q];
          OT[0][n] = MFMA16(vfr[0][kk], pb, OT[0][n]);
          OT[1][n] = MFMA16(vfr[1][kk], pb, OT[1][n]);
        }
    }
#pragma unroll
    for (int i = 0; i < 4; ++i) {
#pragma unroll
      for (int kk = 0; kk < 2; ++kk) {
        const bf16x8 ka = *(const bf16x8*)&Bc.KT[(16 * i + c16) * GLDS + 32 * kk + 8 * q];
        X[0][i] = MFMA16(ka, vfr[0][kk], X[0][i]);
        X[1][i] = MFMA16(ka, vfr[1][kk], X[1][i]);
      }
#pragma unroll
      for (int et = 0; et < 2; ++et) { X[et][i][0] *= dec[i].x; X[et][i][1] *= dec[i].y; X[et][i][2] *= dec[i].z; X[et][i][3] *= dec[i].w; }
    }
    if (PASS == 1 && c >= 1) {
      float ss[4];
#pragma unroll
      for (int n = 0; n < 4; ++n) {
        float v = OT[0][n][0] * OT[0][n][0] + OT[0][n][1] * OT[0][n][1] + OT[0][n][2] * OT[0][n][2] + OT[0][n][3] * OT[0][n][3]
                + OT[1][n][0] * OT[1][n][0] + OT[1][n][1] * OT[1][n][1] + OT[1][n][2] * OT[1][n][2] + OT[1][n][3] * OT[1][n][3];
        v += __shfl_xor(v, 16); v += __shfl_xor(v, 32);
        ss[n] = v;
      }
      if (q == 0) {
#pragma unroll
        for (int n = 0; n < 4; ++n) L.ssq[w4][16 * n + c16] = ss[n];
      }
      __syncthreads();
#pragma unroll
      for (int n = 0; n < 4; ++n) {
        const float tot = L.ssq[0][16 * n + c16] + L.ssq[1][16 * n + c16] + L.ssq[2][16 * n + c16] + L.ssq[3][16 * n + c16];
        const float scl = rsqrtf(tot * (1.0f / 128.0f) + EPS);
        const size_t m = (size_t)b * SEQ + 64 * (c - 1) + 16 * n + c16;
#pragma unroll
        for (int et = 0; et < 2; ++et) {
          const float r0 = bflo(grv[et][n].x), r1 = bfhi(grv[et][n].x), r2 = bflo(grv[et][n].y), r3 = bfhi(grv[et][n].y);
          const float o0 = OT[et][n][0] * scl * gain[et].x * r0 * __builtin_amdgcn_rcpf(1.f + __expf(-r0));
          const float o1 = OT[et][n][1] * scl * gain[et].y * r1 * __builtin_amdgcn_rcpf(1.f + __expf(-r1));
          const float o2 = OT[et][n][2] * scl * gain[et].z * r2 * __builtin_amdgcn_rcpf(1.f + __expf(-r2));
          const float o3 = OT[et][n][3] * scl * gain[et].w * r3 * __builtin_amdgcn_rcpf(1.f + __expf(-r3));
          u32x2 ow; ow.x = pk2(o0, o1); ow.y = pk2(o2, o3);
          *(u32x2*)(G.MIX + m * D + 512 + hd * 128 + 32 * w4 + 16 * et + 4 * q) = ow;
        }
      }
    }
    if (more) {
      GlaBuf& Bn = L.B[cur ^ 1];
      G4_STORET(Bn, rq, rk, rkt)
#pragma unroll
      for (int et = 0; et < 2; ++et) { vfr[et][0] = vfn[et][0]; vfr[et][1] = vfn[et][1]; }
#pragma unroll
      for (int i = 0; i < 4; ++i) dec[i] = decn[i];
#pragma unroll
      for (int z = 0; z < 2; ++z) { rkt[z] = rkt2[z]; rq[z] = rq2[z]; rk[z] = rk2[z]; }
      if (more2) G4_LOADV(vfn, decn, c + 2)
    }
    __syncthreads();
  }
#undef G4_LOADT
#undef G4_LOADV
#undef G4_STORET
  if (PASS == 0) {
#pragma unroll
    for (int et = 0; et < 2; ++et) {
      float* sl = G.SLOC + ((size_t)(bh * 16 + sc) * 8 + w4 * 2 + et) * 16 * 64 + lane;
#pragma unroll
      for (int i = 0; i < 4; ++i)
#pragma unroll
        for (int r = 0; r < 4; ++r) sl[(4 * i + r) * 64] = X[et][i][r];
    }
    if (w4 == 0) {
      float bl = 0.f;
      for (int c = cbeg; c < cend; ++c) bl += G.BL[((size_t)bh * 129 + c) * 64 + lane];
      G.DTOT[(size_t)(bh * 16 + sc) * 64 + lane] = __expf(bl);
    }
  }
}

DI void ce_desc(float& a, float& b) {
  const float hi = __builtin_fmaxf(a, b), lo = __builtin_fminf(a, b);
  a = hi; b = lo;
}
DI float vmaxf(float a, float b) { return __builtin_fmaxf(a, b); }
template <int N> DI void bitonic_sort_desc(float (&v)[N]) {
#pragma unroll
  for (int k = 2; k <= N; k <<= 1) {
#pragma unroll
    for (int j = k >> 1; j > 0; j >>= 1) {
#pragma unroll
      for (int i = 0; i < N; ++i) {
        const int l = i ^ j;
        if (l > i) { if ((i & k) == 0) ce_desc(v[i], v[l]); else ce_desc(v[l], v[i]); }
      }
    }
  }
}
DI void bitonic_merge16_desc(float (&v)[16]) {
#pragma unroll
  for (int j = 8; j > 0; j >>= 1) {
#pragma unroll
    for (int i = 0; i < 16; ++i) { const int l = i ^ j; if (l > i) ce_desc(v[i], v[l]); }
  }
}
template <int NBV> DI void merge_prune16(float (&a)[16], const float (&b)[16]) {
#pragma unroll
  for (int i = 16 - NBV; i < 16; ++i) a[i] = vmaxf(a[i], b[15 - i]);
  bitonic_merge16_desc(a);
}
DI float selh(int hh, float a, float b) { asm volatile("" : "+v"(a), "+v"(b)); return hh == 0 ? a : b; }
DI float pack_idx(float v, unsigned idx, unsigned mask) { return __uint_as_float((__float_as_uint(v) & ~mask) | idx); }

DI void ph_route_v2(int vb, char* smem, const bf16_t* __restrict__ QP, const bf16_t* __restrict__ SK1b, const bf16_t* __restrict__ SK2b,
                    unsigned short* __restrict__ EIDX, float* __restrict__ GATE) {
  const int tid256_ = fresh_tid() & 255;
  const int lane = TID & 63, wave = TID >> 6, r = lane & 31, hh = lane >> 5;
  const int hd = vb & 7, tile = vb >> 3;
  const int m = tile * 128 + wave * 32 + r;
  float loc[2][16];
#pragma unroll
  for (int L = 0; L < 2; ++L) {
    const bf16_t* qp = QP + (size_t)m * D + hd * 128 + L * 64 + hh * 8;
    const bf16_t* kb = (L == 0 ? SK1b : SK2b) + (size_t)(hd * 128 + r) * 64 + hh * 8;
    bf16x8 qf[4];
#pragma unroll
    for (int ks = 0; ks < 4; ++ks) qf[ks] = *(const bf16x8*)(qp + ks * 16);
    float grp[4][16];
#pragma unroll
    for (int mt = 0; mt < 4; ++mt) {
      f32x16 acc;
#pragma unroll
      for (int e = 0; e < 16; ++e) acc[e] = 0.f;
#pragma unroll
      for (int ks = 0; ks < 4; ++ks) {
        const bf16x8 kf = *(const bf16x8*)(kb + (size_t)mt * 32 * 64 + ks * 16);
        acc = MFMA32(kf, qf[ks], acc);
      }
#pragma unroll
      for (int e = 0; e < 16; ++e) grp[mt][e] = pack_idx(acc[e], (unsigned)(mt * 32 + crow(e, hh)), 127u);
      bitonic_sort_desc<16>(grp[mt]);
    }
    merge_prune16<16>(grp[0], grp[1]);
    merge_prune16<16>(grp[2], grp[3]);
    merge_prune16<16>(grp[0], grp[2]);
#pragma unroll
    for (int i = 0; i < 16; ++i) loc[L][i] = grp[0][i];
  }
  float fin[16], oth[16];
#pragma unroll
  for (int i = 0; i < 16; ++i) {
    const float send = selh(hh, loc[1][i], loc[0][i]);
    oth[i] = __shfl_xor(send, 32);
    fin[i] = selh(hh, loc[0][i], loc[1][i]);
  }
  merge_prune16<16>(fin, oth);
  float v1[16], v2[16];
#pragma unroll
  for (int i = 0; i < 16; ++i) {
    const float o = __shfl_xor(fin[i], 32);
    v1[i] = selh(hh, fin[i], o);
    v2[i] = selh(hh, o, fin[i]);
  }
  unsigned* ib = (unsigned*)smem + (size_t)TID * 8;
#pragma unroll
  for (int q = 0; q < 4; ++q) {
    unsigned w1 = 0, w2 = 0;
#pragma unroll
    for (int j = 0; j < 4; ++j) {
      w1 |= (__float_as_uint(v1[4 * q + j]) & 127u) << (8 * j);
      w2 |= (__float_as_uint(v2[4 * q + j]) & 127u) << (8 * j);
    }
    ib[q] = w1; ib[4 + q] = w2;
  }
  float R[16], Bv[16];
#pragma unroll
  for (int j = 0; j < 16; ++j) R[j] = pack_idx(v1[0] + v2[j], (unsigned)j, 255u);
#define ROUTE_ROW(I, CNT) { _Pragma("unroll") for (int j = 0; j < 16; ++j) Bv[j] = (j < CNT) ? pack_idx(v1[I] + v2[j < CNT ? j : 0], (unsigned)(I * 16 + j), 255u) : 0.f; \
    merge_prune16<CNT>(R, Bv); }
  ROUTE_ROW(1, 8) ROUTE_ROW(2, 5) ROUTE_ROW(3, 4) ROUTE_ROW(4, 3) ROUTE_ROW(5, 2) ROUTE_ROW(6, 2) ROUTE_ROW(7, 2)
#undef ROUTE_ROW
#pragma unroll
  for (int j = 0; j < 16; ++j) Bv[j] = (j < 8) ? pack_idx(v1[8 + (j < 8 ? j : 0)] + v2[0], (unsigned)((8 + j) * 16), 255u) : 0.f;
  merge_prune16<8>(R, Bv);
  float ex[16], sum = 0.f;
#pragma unroll
  for (int i = 0; i < 16; ++i) { ex[i] = __expf(R[i] - R[0]); sum += ex[i]; }
  const float inv = 1.f / sum;
  const unsigned char* ibb = (const unsigned char*)ib;
  int eo[8]; float go[8];
#pragma unroll
  for (int w = 0; w < 8; ++w) {
    const float rv = selh(hh, R[w], R[8 + w]);
    const float ev = selh(hh, ex[w], ex[8 + w]);
    const unsigned pos = __float_as_uint(rv) & 255u;
    const unsigned i1 = ibb[pos >> 4], i2 = ibb[16 + (pos & 15u)];
    eo[w] = (int)(i1 * 128u + i2);
    go[w] = ev * inv;
  }
  unsigned short* ep = EIDX + (size_t)m * 128 + hd * 16 + hh * 8;
  float* gp = GATE + (size_t)m * 128 + hd * 16 + hh * 8;
  *(u32x4*)ep = (u32x4){(unsigned)eo[0] | ((unsigned)eo[1] << 16), (unsigned)eo[2] | ((unsigned)eo[3] << 16), (unsigned)eo[4] | ((unsigned)eo[5] << 16), (unsigned)eo[6] | ((unsigned)eo[7] << 16)};
  *(f32x4*)gp = (f32x4){go[0], go[1], go[2], go[3]};
  *(f32x4*)(gp + 4) = (f32x4){go[4], go[5], go[6], go[7]};
}


typedef unsigned char u8_t;
constexpr size_t WS_SCU = 14 * MiB;
constexpr size_t WS_SCV = 14 * MiB + 65536;
DI float wave_max(float v) {
#pragma unroll
  for (int o = 32; o >= 1; o >>= 1) v = fmaxf(v, __shfl_xor(v, o));
  return v;
}
DI u32x4 quant_row16(const float* __restrict__ rowp, int lane, float& sc) {
  const f32x4* rp = (const f32x4*)(rowp + lane * 16);
  const f32x4 a = rp[0], b = rp[1], c = rp[2], d = rp[3];
  float m = fmaxf(fmaxf(fmaxf(fabsf(a.x), fabsf(a.y)), fmaxf(fabsf(a.z), fabsf(a.w))), fmaxf(fmaxf(fabsf(b.x), fabsf(b.y)), fmaxf(fabsf(b.z), fabsf(b.w))));
  m = fmaxf(m, fmaxf(fmaxf(fmaxf(fabsf(c.x), fabsf(c.y)), fmaxf(fabsf(c.z), fabsf(c.w))), fmaxf(fmaxf(fabsf(d.x), fabsf(d.y)), fmaxf(fabsf(d.z), fabsf(d.w)))));
  m = wave_max(m);
  sc = m > 0.f ? m * (1.0f / 448.0f) : 1.0f;
  const float inv = 1.0f / sc;
  u32x4 o; unsigned w;
  w = 0; w = __builtin_amdgcn_cvt_pk_fp8_f32(a.x * inv, a.y * inv, w, false); w = __builtin_amdgcn_cvt_pk_fp8_f32(a.z * inv, a.w * inv, w, true); o.x = w;
  w = 0; w = __builtin_amdgcn_cvt_pk_fp8_f32(b.x * inv, b.y * inv, w, false); w = __builtin_amdgcn_cvt_pk_fp8_f32(b.z * inv, b.w * inv, w, true); o.y = w;
  w = 0; w = __builtin_amdgcn_cvt_pk_fp8_f32(c.x * inv, c.y * inv, w, false); w = __builtin_amdgcn_cvt_pk_fp8_f32(c.z * inv, c.w * inv, w, true); o.z = w;
  w = 0; w = __builtin_amdgcn_cvt_pk_fp8_f32(d.x * inv, d.y * inv, w, false); w = __builtin_amdgcn_cvt_pk_fp8_f32(d.z * inv, d.w * inv, w, true); o.w = w;
  return o;
}
DI void ph_convert_ev8(int vb, char* smem, const float* __restrict__ src, u8_t* __restrict__ EV8c, float* __restrict__ scaleV) {
  const int tid256_ = fresh_tid() & 255;
  u8_t (*t)[1040] = (u8_t (*)[1040])smem;
  const int lane = TID & 63, wave = TID >> 6, e0 = vb * 32;
  for (int rr = 0; rr < 8; ++rr) {
    const int r = wave * 8 + rr;
    float sc;
    const u32x4 o = quant_row16(src + (size_t)(e0 + r) * D, lane, sc);
    *(u32x4*)&t[r][lane * 16] = o;
    if (lane == 0) scaleV[e0 + r] = sc;
  }
  __syncthreads();
  const int r = TID & 31, cs = TID >> 5;
  for (int c0 = 0; c0 < 128; c0 += 8) {
    const int cg = c0 + cs;
    const u32x2 v = *(const u32x2*)&t[r][cg * 8];
    *(u32x2*)(EV8c + ((size_t)cg * NEXP + e0 + r) * 8) = v;
  }
  __syncthreads();
}
struct PeerUHalf { u32x4 u[8]; };
DI void ph_peer_c8(int unit, char* smem, const bf16_t* __restrict__ PP, const unsigned short* __restrict__ EIDX, const float* __restrict__ GATE,
                   const float* __restrict__ scaleU, const float* __restrict__ scaleV, unsigned* __restrict__ STREAM) {
  unsigned (*tile)[132] = (unsigned (*)[132])smem;
  const int tid = fresh_tid();
  const int tl = tid >> 3, kc = tid & 7;
  const size_t rowoff = ((size_t)unit * 64 + tl) * 128 + kc * 16;
  const size_t n = (size_t)TREAL * 128;
  float a[16];
#pragma unroll
  for (int j = 0; j < 16; ++j) a[j] = 0.f;
#pragma unroll
  for (int s = 0; s < 8; ++s) {
    const u32x4 p0 = *(const u32x4*)(PP + (size_t)s * n + rowoff), p1 = *(const u32x4*)(PP + (size_t)s * n + rowoff + 8);
    a[0] += bflo(p0.x); a[1] += bfhi(p0.x); a[2] += bflo(p0.y); a[3] += bfhi(p0.y); a[4] += bflo(p0.z); a[5] += bfhi(p0.z); a[6] += bflo(p0.w); a[7] += bfhi(p0.w);
    a[8] += bflo(p1.x); a[9] += bfhi(p1.x); a[10] += bflo(p1.y); a[11] += bfhi(p1.y); a[12] += bflo(p1.z); a[13] += bfhi(p1.z); a[14] += bflo(p1.w); a[15] += bfhi(p1.w);
  }
  const u32x4 e0 = *(const u32x4*)(EIDX + rowoff), e1 = *(const u32x4*)(EIDX + rowoff + 8);
  unsigned ev[16] = {e0.x & 0xffffu, e0.x >> 16, e0.y & 0xffffu, e0.y >> 16, e0.z & 0xffffu, e0.z >> 16, e0.w & 0xffffu, e0.w >> 16,
                     e1.x & 0xffffu, e1.x >> 16, e1.y & 0xffffu, e1.y >> 16, e1.z & 0xffffu, e1.z >> 16, e1.w & 0xffffu, e1.w >> 16};
  float gt[16];
#pragma unroll
  for (int j = 0; j < 4; ++j) { const f32x4 g4 = *(const f32x4*)(GATE + rowoff + 4 * j); gt[4 * j] = g4.x; gt[4 * j + 1] = g4.y; gt[4 * j + 2] = g4.z; gt[4 * j + 3] = g4.w; }
#pragma unroll
  for (int j = 0; j < 16; ++j) {
    const unsigned e = ev[j];
    const float av = a[j] * scaleU[e];
    const float act = 0.5f * av * (1.f + erff(av * 0.70710678118654752f));
    const float c = gt[j] * act * scaleV[e];
    tile[tl][kc * 16 + j] = e | (f2bf(c) << 16);
  }
  __syncthreads();
  unsigned* outp = STREAM + (size_t)unit * 8192;
#pragma unroll 4
  for (int j = 0; j < 16; ++j) {
    const int o = tid + 512 * j, q = o >> 8, t2 = (o >> 2) & 63, z = o & 3;
    outp[o] = tile[t2][4 * q + z];
  }
  __syncthreads();
}
struct PVW { u32x4 a, b; };
struct PVT { u32x2 v[8]; };
DI void pv_loadw(PVW& W, const unsigned* __restrict__ STREAM, int it, int g, int lane) {
  const u32x4* sp = (const u32x4*)(STREAM + (size_t)it * 8192) + lane;
  W.a = sp[(2 * g) * 64]; W.b = sp[(2 * g + 1) * 64];
}
DI void pv_readt(PVT& T, const PVW& W, const u32x2* tabl) {
  T.v[0] = tabl[W.a.x & 0xffffu]; T.v[1] = tabl[W.a.y & 0xffffu]; T.v[2] = tabl[W.a.z & 0xffffu]; T.v[3] = tabl[W.a.w & 0xffffu];
  T.v[4] = tabl[W.b.x & 0xffffu]; T.v[5] = tabl[W.b.y & 0xffffu]; T.v[6] = tabl[W.b.z & 0xffffu]; T.v[7] = tabl[W.b.w & 0xffffu];
}
DI void pv_fma1(unsigned w, const u32x2 v, f32x2 (&y)[4]) {
  const float c = bfhi(w);
  const f32x2 cc = {c, c};
  y[0] = __builtin_elementwise_fma(__builtin_amdgcn_cvt_pk_f32_fp8(v.x, false), cc, y[0]);
  y[1] = __builtin_elementwise_fma(__builtin_amdgcn_cvt_pk_f32_fp8(v.x, true), cc, y[1]);
  y[2] = __builtin_elementwise_fma(__builtin_amdgcn_cvt_pk_f32_fp8(v.y, false), cc, y[2]);
  y[3] = __builtin_elementwise_fma(__builtin_amdgcn_cvt_pk_f32_fp8(v.y, true), cc, y[3]);
}
DI void pv_fma(const PVW& W, const PVT& T, f32x2 (&y)[4]) {
  pv_fma1(W.a.x, T.v[0], y); pv_fma1(W.a.y, T.v[1], y); pv_fma1(W.a.z, T.v[2], y); pv_fma1(W.a.w, T.v[3], y);
  pv_fma1(W.b.x, T.v[4], y); pv_fma1(W.b.y, T.v[5], y); pv_fma1(W.b.z, T.v[6], y); pv_fma1(W.b.w, T.v[7], y);
}
DI void ph_peer_v8(char* smem, const unsigned* __restrict__ STREAM, const u8_t* __restrict__ EV8c, bf16_t* __restrict__ YT) {
  const int tid = fresh_tid(), lane = tid & 63, wave = tid >> 6;
  const u32x2* tabl = (const u32x2*)smem;
  for (int unit = blockIdx.x; unit < 256; unit += gridDim.x) {
    const int cg = unit & 127, th = unit >> 7;
    const u32x4* src = (const u32x4*)(EV8c + (size_t)cg * NEXP * 8);
#pragma unroll 4
    for (int i = tid; i < NEXP * 8 / 16; i += 512) ((u32x4*)smem)[i] = src[i];
    __syncthreads();
    const int it_end = th * 512 + 512;
    int it = th * 512 + wave;
    PVW W0, W1, W2, W3; PVT T0, T1;
    pv_loadw(W0, STREAM, it, 0, lane); pv_loadw(W1, STREAM, it, 1, lane);
    pv_readt(T0, W0, tabl);
    for (; it < it_end; it += 8) {
      const int itn = (it + 8 < it_end) ? it + 8 : it;
      f32x2 y[4];
#pragma unroll
      for (int z = 0; z < 4; ++z) y[z] = (f32x2){0.f, 0.f};
#define PV_STEP(g, Wld, Wrd, Trd, Wc, Tc) \
      pv_loadw(Wld, STREAM, ((g) + 2 < 16) ? it : itn, ((g) + 2) & 15, lane); \
      pv_readt(Trd, Wrd, tabl); \
      pv_fma(Wc, Tc, y); \
      asm volatile("" ::: "memory");
      PV_STEP(0, W2, W1, T1, W0, T0)  PV_STEP(1, W3, W2, T0, W1, T1)  PV_STEP(2, W0, W3, T1, W2, T0)  PV_STEP(3, W1, W0, T0, W3, T1)
      PV_STEP(4, W2, W1, T1, W0, T0)  PV_STEP(5, W3, W2, T0, W1, T1)  PV_STEP(6, W0, W3, T1, W2, T0)  PV_STEP(7, W1, W0, T0, W3, T1)
      PV_STEP(8, W2, W1, T1, W0, T0)  PV_STEP(9, W3, W2, T0, W1, T1)  PV_STEP(10, W0, W3, T1, W2, T0) PV_STEP(11, W1, W0, T0, W3, T1)
      PV_STEP(12, W2, W1, T1, W0, T0) PV_STEP(13, W3, W2, T0, W1, T1) PV_STEP(14, W0, W3, T1, W2, T0) PV_STEP(15, W1, W0, T0, W3, T1)
#undef PV_STEP
      const int t = it * 64 + lane;
      u32x4 yw; yw.x = pk2(y[0].x, y[0].y); yw.y = pk2(y[1].x, y[1].y); yw.z = pk2(y[2].x, y[2].y); yw.w = pk2(y[3].x, y[3].y);
      *(u32x4*)(YT + ((size_t)cg * TREAL + t) * 8) = yw;
    }
    __syncthreads();
  }
}


DI void ph_final_lds(int unit, char* smem, const bf16_t* __restrict__ H1, const bf16_t* __restrict__ YT, const float* __restrict__ gf, float* __restrict__ out) {
  float (*h2)[1028] = (float (*)[1028])smem;
  const int tid = fresh_tid(), lane = tid & 63, wave = tid >> 6;
  const int t0 = unit * 32;
#pragma unroll
  for (int rr = 0; rr < 4; ++rr) {
    const int r = wave * 4 + rr;
    const bf16_t* hp = H1 + (size_t)(t0 + r) * D;
#pragma unroll
    for (int j = 0; j < 2; ++j) {
      const u32x4 hw = *(const u32x4*)(hp + j * 512 + lane * 8);
      *(f32x4*)&h2[r][j * 512 + lane * 8] = (f32x4){bflo(hw.x), bfhi(hw.x), bflo(hw.y), bfhi(hw.y)};
      *(f32x4*)&h2[r][j * 512 + lane * 8 + 4] = (f32x4){bflo(hw.z), bfhi(hw.z), bflo(hw.w), bfhi(hw.w)};
    }
  }
  __syncthreads();
  {
    const int tok = lane & 31;
#pragma unroll 4
    for (int cg = wave * 2 + (lane >> 5); cg < 128; cg += 16) {
      const u32x4 yw = *(const u32x4*)(YT + ((size_t)cg * TREAL + t0 + tok) * 8);
      f32x4* hp = (f32x4*)&h2[tok][cg * 8];
      f32x4 a = hp[0], b4 = hp[1];
      a.x += bflo(yw.x); a.y += bfhi(yw.x); a.z += bflo(yw.y); a.w += bfhi(yw.y);
      b4.x += bflo(yw.z); b4.y += bfhi(yw.z); b4.z += bflo(yw.w); b4.w += bfhi(yw.w);
      hp[0] = a; hp[1] = b4;
    }
  }
  __syncthreads();
#pragma unroll
  for (int rr = 0; rr < 4; ++rr) {
    const int r = wave * 4 + rr;
    f32x4 v[4]; float ss = 0.f;
#pragma unroll
    for (int j = 0; j < 4; ++j) { v[j] = *(const f32x4*)&h2[r][j * 256 + lane * 4]; ss += v[j].x * v[j].x + v[j].y * v[j].y + v[j].z * v[j].z + v[j].w * v[j].w; }
    ss = wave_sum(ss);
    const float sc = rsqrtf(ss * (1.0f / D) + EPS);
    float* op = out + (size_t)(t0 + r) * D;
#pragma unroll
    for (int j = 0; j < 4; ++j) {
      const f32x4 gg = *(const f32x4*)(gf + j * 256 + lane * 4);
      *(f32x4*)(op + j * 256 + lane * 4) = (f32x4){v[j].x * sc * gg.x, v[j].y * sc * gg.y, v[j].z * sc * gg.z, v[j].w * sc * gg.w};
    }
  }
  __syncthreads();
}

typedef int i32x4 __attribute__((ext_vector_type(4)));
constexpr size_t WS_XQ = 861 * MiB;
constexpr size_t WS_XS = 943 * MiB;
DI unsigned pack_i8x4(float a, float b, float c, float d) {
  const int ia = __float2int_rn(a), ib = __float2int_rn(b), ic = __float2int_rn(c), id = __float2int_rn(d);
  return ((unsigned)ia & 255u) | (((unsigned)ib & 255u) << 8) | (((unsigned)ic & 255u) << 16) | ((unsigned)id << 24);
}
DI u32x4 quant_row16_i8(const float* __restrict__ rowp, int lane, float& sc) {
  const f32x4* rp = (const f32x4*)(rowp + lane * 16);
  const f32x4 a = rp[0], b = rp[1], c = rp[2], d = rp[3];
  float m = fmaxf(fmaxf(fmaxf(fabsf(a.x), fabsf(a.y)), fmaxf(fabsf(a.z), fabsf(a.w))), fmaxf(fmaxf(fabsf(b.x), fabsf(b.y)), fmaxf(fabsf(b.z), fabsf(b.w))));
  m = fmaxf(m, fmaxf(fmaxf(fmaxf(fabsf(c.x), fabsf(c.y)), fmaxf(fabsf(c.z), fabsf(c.w))), fmaxf(fmaxf(fabsf(d.x), fabsf(d.y)), fmaxf(fabsf(d.z), fabsf(d.w)))));
  m = wave_max(m);
  sc = m > 0.f ? m * (1.0f / 127.0f) : 1.0f;
  const float inv = 1.0f / sc;
  u32x4 o;
  o.x = pack_i8x4(a.x * inv, a.y * inv, a.z * inv, a.w * inv); o.y = pack_i8x4(b.x * inv, b.y * inv, b.z * inv, b.w * inv);
  o.z = pack_i8x4(c.x * inv, c.y * inv, c.z * inv, c.w * inv); o.w = pack_i8x4(d.x * inv, d.y * inv, d.z * inv, d.w * inv);
  return o;
}
DI void ph_convert_eu_i8(const float* __restrict__ src, u8_t* __restrict__ EUq, float* __restrict__ scaleU) {
  const int tid = fresh_tid(), lane = tid & 63, wave = tid >> 6;
  for (int e = (blockIdx.x * 8 + wave) * 2; e < NEXP; e += gridDim.x * 16) {
    float sc0, sc1 = 1.f;
    const bool two = e + 1 < NEXP;
    const u32x4 o0 = quant_row16_i8(src + (size_t)e * D, lane, sc0);
    u32x4 o1 = o0;
    if (two) o1 = quant_row16_i8(src + (size_t)(e + 1) * D, lane, sc1);
    *(u32x4*)(EUq + ((size_t)(lane >> 3) * NEXP + e) * 128 + (lane & 7) * 16) = o0;
    if (two) *(u32x4*)(EUq + ((size_t)(lane >> 3) * NEXP + e + 1) * 128 + (lane & 7) * 16) = o1;
    if (lane == 0) { scaleU[e] = sc0; if (two) scaleU[e + 1] = sc1; }
  }
}
DI void ph_norm2_rows(int vb, const bf16_t* __restrict__ src, const float* __restrict__ gain, float* __restrict__ R2, u8_t* __restrict__ XQ, float* __restrict__ XS) {
  const int tid256_ = fresh_tid() & 255;
  const int row0 = vb * 16 + (TID >> 6) * 4, lane = TID & 63;
  u32x2 raw[4][4];
#pragma unroll
  for (int rr = 0; rr < 4; ++rr)
#pragma unroll
    for (int j = 0; j < 4; ++j) raw[rr][j] = *(const u32x2*)(src + (size_t)(row0 + rr) * D + j * 256 + lane * 4);
  f32x4 gg[4];
#pragma unroll
  for (int j = 0; j < 4; ++j) gg[j] = *(const f32x4*)(gain + j * 256 + lane * 4);
#pragma unroll
  for (int rr = 0; rr < 4; ++rr) {
    f32x4 v[4]; float ss = 0.f;
#pragma unroll
    for (int j = 0; j < 4; ++j) {
      v[j] = (f32x4){bflo(raw[rr][j].x), bfhi(raw[rr][j].x), bflo(raw[rr][j].y), bfhi(raw[rr][j].y)};
      ss += v[j].x * v[j].x + v[j].y * v[j].y + v[j].z * v[j].z + v[j].w * v[j].w;
    }
    ss = wave_sum(ss);
    const float r = rsqrtf(ss * (1.0f / D) + EPS);
    if (lane == 0) R2[row0 + rr] = r;
#pragma unroll
    for (int j = 0; j < 4; ++j) {
      const float a0 = v[j].x * gg[j].x, a1 = v[j].y * gg[j].y, a2 = v[j].z * gg[j].z, a3 = v[j].w * gg[j].w;
      float m = fmaxf(fmaxf(fabsf(a0), fabsf(a1)), fmaxf(fabsf(a2), fabsf(a3)));
#pragma unroll
      for (int sh = 16; sh >= 1; sh >>= 1) m = fmaxf(m, __shfl_xor(m, sh));
      const float inv = m > 0.f ? 127.0f / m : 0.f;
      *(unsigned*)(XQ + (size_t)(row0 + rr) * D + j * 256 + lane * 4) = pack_i8x4(a0 * inv, a1 * inv, a2 * inv, a3 * inv);
      if ((lane & 31) == 0) XS[(size_t)(row0 + rr) * 8 + 2 * j + (lane >> 5)] = m * r * (1.0f / 127.0f);
    }
  }
}
DI int dpp_i(int v, const int sel) {
  if (sel == 0) return __builtin_amdgcn_update_dpp(0, v, 0xB1, 0xF, 0xF, true);
  if (sel == 1) return __builtin_amdgcn_update_dpp(0, v, 0x4E, 0xF, 0xF, true);
  return __builtin_amdgcn_update_dpp(0, v, 0x141, 0xF, 0xF, true);
}
DI int dpp_isum8(int v) { v += dpp_i(v, 0); v += dpp_i(v, 1); v += dpp_i(v, 2); return v; }
template <int HF> DI void peer_ud4_issue(PeerUHalf& H, unsigned idxpair, int lane, const u8_t* __restrict__ tab) {
#pragma unroll
  for (int jj = 0; jj < 8; ++jj) {
    const int j = 8 * HF + jj;
    const unsigned w = (unsigned)__shfl((int)idxpair, (lane & ~7) + (j >> 1));
    const unsigned e = (j & 1) ? (w >> 16) : (w & 0xffffu);
    H.u[jj] = *(const u32x4*)(tab + (size_t)e * 128);
  }
}
template <int HF> DI void peer_ud4_compute(const PeerUHalf& H, const u32x4 xq, int sub, int& res0, int& res1) {
#pragma unroll
  for (int jj = 0; jj < 8; ++jj) {
    const int j = 8 * HF + jj;
    int acc = 0;
    acc = __builtin_amdgcn_sdot4((int)H.u[jj].x, (int)xq.x, acc, false); acc = __builtin_amdgcn_sdot4((int)H.u[jj].y, (int)xq.y, acc, false);
    acc = __builtin_amdgcn_sdot4((int)H.u[jj].z, (int)xq.z, acc, false); acc = __builtin_amdgcn_sdot4((int)H.u[jj].w, (int)xq.w, acc, false);
    acc = dpp_isum8(acc);
    if (sub == (j >> 1)) { if (j & 1) res1 = acc; else res0 = acc; }
  }
}
DI void ph_peer_u_d4(int xi, int nx, int wv, int nwv, const u8_t* __restrict__ XQ, const float* __restrict__ XS, const u8_t* __restrict__ EUq,
                     const unsigned short* __restrict__ EIDX, bf16_t* __restrict__ PP) {
  const int lane = fresh_tid() & 63, sub = lane & 7;
  const int ntok = (TREAL - wv + nwv - 1) / nwv;
#define PU_TOK(i) (wv + ((i) < ntok ? (i) : ntok - 1) * nwv)
#define PU_IDX(t) __builtin_nontemporal_load((const unsigned*)(EIDX + (size_t)(t) * 128) + lane)
#define PU_LDX(xq_, xs_, t) { xq_ = *(const u32x4*)(xbase + (size_t)(t) * D); xs_ = XS[(size_t)(t) * 8 + s]; }
#define PU_STORE(t, r0, r1, xs_) __builtin_nontemporal_store(pk2((float)(r0) * (xs_), (float)(r1) * (xs_)), (unsigned*)(pp + (size_t)(t) * 128) + lane)
  for (int s = xi; s < 8; s += nx) {
    const u8_t* tab = EUq + (size_t)s * NEXP * 128 + sub * 16;
    const u8_t* xbase = XQ + s * 128 + sub * 16;
    bf16_t* pp = PP + (size_t)s * TREAL * 128;
    PeerUHalf HA, HB, HC;
    int ta = PU_TOK(0), tb = PU_TOK(1), tc = PU_TOK(2);
    unsigned ia = PU_IDX(ta), ib = PU_IDX(tb), ic = PU_IDX(tc);
    u32x4 xqa; float xsa; PU_LDX(xqa, xsa, ta);
    peer_ud4_issue<0>(HA, ia, lane, tab);
    peer_ud4_issue<1>(HB, ia, lane, tab);
    for (int i = 0; i < ntok; i += 3) {
      const int td = PU_TOK(i + 3), te = PU_TOK(i + 4), tf = PU_TOK(i + 5);
      u32x4 xqb, xqc, xqd; float xsb, xsc, xsd;
      int r0, r1;
      peer_ud4_issue<0>(HC, ib, lane, tab); PU_LDX(xqb, xsb, tb); const unsigned id = PU_IDX(td);
      r0 = 0; r1 = 0;
      peer_ud4_compute<0>(HA, xqa, sub, r0, r1);
      peer_ud4_issue<1>(HA, ib, lane, tab);
      peer_ud4_compute<1>(HB, xqa, sub, r0, r1);
      PU_STORE(ta, r0, r1, xsa);
      peer_ud4_issue<0>(HB, ic, lane, tab); PU_LDX(xqc, xsc, tc); const unsigned ie = PU_IDX(te);
      r0 = 0; r1 = 0;
      peer_ud4_compute<0>(HC, xqb, sub, r0, r1);
      peer_ud4_issue<1>(HC, ic, lane, tab);
      peer_ud4_compute<1>(HA, xqb, sub, r0, r1);
      PU_STORE(tb, r0, r1, xsb);
      peer_ud4_issue<0>(HA, id, lane, tab); PU_LDX(xqd, xsd, td); const unsigned if_ = PU_IDX(tf);
      r0 = 0; r1 = 0;
      peer_ud4_compute<0>(HB, xqc, sub, r0, r1);
      peer_ud4_issue<1>(HB, id, lane, tab);
      peer_ud4_compute<1>(HC, xqc, sub, r0, r1);
      PU_STORE(tc, r0, r1, xsc);
      ta = td; tb = te; tc = tf; ib = ie; ic = if_; xqa = xqd; xsa = xsd;
    }
  }
#undef PU_TOK
#undef PU_IDX
#undef PU_LDX
#undef PU_STORE
}

struct PUI { i32x4 a[8]; };
struct PUE { int e[8]; };

#define XB_TMO      128
#define XB_XCNT(j)  (256  + 64 * (j))
#define XB_XSUB(j)  (1280 + 64 * (j))
#define XB_XGEN(j)  (2304 + 64 * (j))
#define XB_TOP      3328
#define XB_TOPGEN   3392
#define XCD_BAR_WORDS 3456
#define XB_SPIN_CAP (1u << 20)
#define LAS __attribute__((address_space(3)))
DI unsigned xb_ld(unsigned* p)              { return __hip_atomic_load(p, __ATOMIC_RELAXED, __HIP_MEMORY_SCOPE_AGENT); }
DI unsigned xb_add(unsigned* p, unsigned v) { return __hip_atomic_fetch_add(p, v, __ATOMIC_RELAXED, __HIP_MEMORY_SCOPE_AGENT); }
DI unsigned xb_xcc_id() { return (unsigned)__builtin_amdgcn_s_getreg((3 << 11) | 20) & 0xFu; }
#define XB_SPIN(cond, bar) do { unsigned _sp = 0; while (cond) { __builtin_amdgcn_s_sleep(1); \
    if ((++_sp & 255u) == 0u) { if (xb_ld(&(bar)[XB_TMO])) break; if (_sp > XB_SPIN_CAP) { atomicAdd(&(bar)[XB_TMO], 1u); break; } } } } while (0)
struct XcdBarrier { unsigned* bar; unsigned x; volatile unsigned* st; };
DI XcdBarrier xcd_barrier_post(unsigned* bar, volatile unsigned* st) {
  XcdBarrier b; b.bar = bar; b.x = xb_xcc_id(); b.st = st;
  if (threadIdx.x == 0) (void)xb_add(&bar[XB_XCNT(b.x)], 1u);
  return b;
}
DI void xcd_barrier_complete(unsigned* bar, unsigned x, unsigned& nloc, unsigned& nx) {
  const unsigned G = gridDim.x;
  unsigned sum, cnt, mine, sp = 0u;
  for (;;) {
    sum = 0u; cnt = 0u; mine = 0u;
#pragma unroll
    for (unsigned j = 0; j < 16; ++j) { const unsigned c = xb_ld(&bar[XB_XCNT(j)]); sum += c; cnt += (c > 0u) ? 1u : 0u; mine = (j == x) ? c : mine; }
    if (sum == G) break;
    __builtin_amdgcn_s_sleep(1);
    if ((++sp & 255u) == 0u) { if (xb_ld(&bar[XB_TMO])) break; if (sp > XB_SPIN_CAP) { atomicAdd(&bar[XB_TMO], 1u); break; } }
  }
  nloc = mine > 0u ? mine : 1u; nx = cnt > 0u ? cnt : 1u;
}
DI void xcd_barrier(const XcdBarrier& b) {
  asm volatile("s_waitcnt vmcnt(0)" ::: "memory");
  __syncthreads();
  if (threadIdx.x == 0) {
    unsigned* bar = b.bar;
    __builtin_amdgcn_s_waitcnt(0);
    unsigned nloc = b.st[0], nx = b.st[1];
    if (nloc == 0u) { xcd_barrier_complete(bar, b.x, nloc, nx); b.st[0] = nloc; b.st[1] = nx; }
    const unsigned old = xb_add(&bar[XB_XSUB(b.x)], 1u);
    const unsigned gen = old / nloc;
    if (old + 1u == (gen + 1u) * nloc) {
      __builtin_amdgcn_fence(__ATOMIC_RELEASE, "agent");
      asm volatile("s_waitcnt vmcnt(0)" ::: "memory");
      const unsigned og = xb_add(&bar[XB_TOP], 1u);
      const unsigned tg = og / nx;
      if (og + 1u == (tg + 1u) * nx) xb_add(&bar[XB_TOPGEN], 1u);
      else XB_SPIN(xb_ld(&bar[XB_TOPGEN]) == tg, bar);
      __builtin_amdgcn_fence(__ATOMIC_ACQUIRE, "agent");
      xb_add(&bar[XB_XGEN(b.x)], 1u);
      asm volatile("s_waitcnt vmcnt(0)" ::: "memory");
    } else {
      XB_SPIN(xb_ld(&bar[XB_XGEN(b.x)]) == gen, bar);
      __builtin_amdgcn_fence(__ATOMIC_ACQUIRE, "agent");
      asm volatile("s_waitcnt vmcnt(0)" ::: "memory");
    }
  }
  __syncthreads();
}

struct Params {
  const float *x, *meta, *norm1_g, *w_in, *wg, *bg, *sb_g, *gla_g, *w_out, *norm2_g, *w_pq, *sk1, *sk2, *eu, *ev, *gf;
  float* out; char* ws;
};
constexpr int HALF_SMEM = 73728;
constexpr int SMEM_BYTES = 2 * HALF_SMEM;
constexpr size_t WS_BAR = 0;

__global__ void __launch_bounds__(512, 2) k_fused(Params p) {
  extern __shared__ __attribute__((aligned(16))) char smem_dyn[];
  const int half = __builtin_amdgcn_readfirstlane((int)(threadIdx.x >> 8));
  char* smem = smem_dyn + half * HALF_SMEM;
  __shared__ unsigned xb_words[4];
  if (threadIdx.x < 4) xb_words[threadIdx.x] = 0u;
  __syncthreads();
  const XcdBarrier bar = xcd_barrier_post((unsigned*)(p.ws + WS_BAR), xb_words);
  if (threadIdx.x == 0) xb_words[2] = xb_add((unsigned*)(p.ws + WS_XRANK) + bar.x, 1u);
  const int G = 2 * gridDim.x, bid = 2 * blockIdx.x + half;
  char* ws = p.ws;
  bf16_t* WinT = (bf16_t*)(ws + WS_WIN);
  bf16_t* WoutT = (bf16_t*)(ws + WS_WOUT);
  bf16_t* WpqT = (bf16_t*)(ws + WS_WPQ);
  bf16_t* EU = (bf16_t*)(ws + WS_EU);
  bf16_t* EV = (bf16_t*)(ws + WS_EV);
  bf16_t* SK1b = (bf16_t*)(ws + WS_SK1);
  bf16_t* SK2b = (bf16_t*)(ws + WS_SK2);
  bf16_t* A1 = (bf16_t*)(ws + WS_A1);
  float* GO = (float*)(ws + WS_A1);
  bf16_t* A2 = (bf16_t*)(ws + WS_A1);
  InProjOut O;
  O.QSB = (bf16_t*)(ws + WS_QSB); O.KSB = (bf16_t*)(ws + WS_KSB); O.VTSB = (bf16_t*)(ws + WS_VTSB); O.VSB = (bf16_t*)(ws + WS_VSB);
  O.GQ = (bf16_t*)(ws + WS_GQ); O.GK = (bf16_t*)(ws + WS_GK); O.GV = (bf16_t*)(ws + WS_GVT); O.GR = (bf16_t*)(ws + WS_GR);
  O.GLR = (float*)(ws + WS_GLR);
  bf16_t* H1 = (bf16_t*)(ws + WS_H1);
  float* R2 = (float*)(ws + WS_XS + 3 * MiB);
  bf16_t* GVT = (bf16_t*)(ws + WS_GVT);
  GlaPtrs GP;
  GP.GQ = O.GQ; GP.GK = O.GK; GP.GVT = GVT; GP.GR = O.GR; GP.GLR = O.GLR; GP.wg = p.wg; GP.bg = p.bg; GP.gla_g = p.gla_g;
  GP.SLOC = (float*)(ws + WS_SLOC); GP.DTOT = (float*)(ws + WS_DTOT); GP.MIX = (bf16_t*)(ws + WS_MIX);
  GlaPrepPtrs GPP; GPP.GQ = O.GQ; GPP.GK = O.GK; GPP.GLR = O.GLR; GPP.wg = p.wg; GPP.bg = p.bg;
  GPP.QT = (bf16_t*)(ws + WS_GQT); GPP.KT = (bf16_t*)(ws + WS_GKT); GPP.KTT = (bf16_t*)(ws + WS_GKTT); GPP.DEC = (float*)(ws + WS_GDEC); GPP.BL = (float*)(ws + WS_GBL);
  GlaPtrs3 GP3; GP3.QT = GPP.QT; GP3.KT = GPP.KT; GP3.KTT = GPP.KTT; GP3.GVT = GVT; GP3.GR = O.GR; GP3.DEC = GPP.DEC; GP3.BL = GPP.BL; GP3.gla_g = p.gla_g;
  GP3.SLOC = GP.SLOC; GP3.DTOT = GP.DTOT; GP3.MIX = GP.MIX;
  bf16_t* MIX = (bf16_t*)(ws + WS_MIX);
  bf16_t* QP = (bf16_t*)(ws + WS_MIX);
  unsigned short* EIDX = (unsigned short*)(ws + WS_EIDX);
  bf16_t* PP = (bf16_t*)(ws + WS_PP);
  bf16_t* YT = (bf16_t*)(ws + WS_PP);
  unsigned* STREAM = (unsigned*)(ws + WS_STREAM);
  float* GATE = (float*)(ws + WS_GATE);

  for (int vb = bid; vb < 832 + 256 + 256; vb += G) {
    if (vb < 832) ph_transpose_w(vb % 104, vb / 104, smem, p.w_in, p.norm1_g, WinT, D, NIN);
    else if (vb < 1088) { const int t = vb - 832; ph_transpose_w(t % 32, t / 32, smem, p.w_out, nullptr, WoutT, D, D); }
    else { const int t = vb - 1088; ph_transpose_w(t % 32, t / 32, smem, p.w_pq, p.norm2_g, WpqT, D, D); }
  }
  ph_convert_eu_i8(p.eu, (u8_t*)EU, (float*)(ws + WS_SCU));
  for (int vb = bid; vb < NEXP / 32; vb += G) ph_convert_ev8(vb, smem, p.ev, (u8_t*)EV, (float*)(ws + WS_SCV));
  ph_convert(p.sk1, SK1b, (size_t)8 * 128 * 64 / 8);
  ph_convert(p.sk2, SK2b, (size_t)8 * 128 * 64 / 8);
  ph_zero_pads(O.KSB, O.VTSB, O.GQ, O.GK, GVT);
  for (int vb = bid; vb < TREAL / 16; vb += G) ph_norm_rows<0>(vb, p.x, p.meta, A1);
  __syncthreads();
  for (int mb = blockIdx.x; mb < NIN / 16; mb += gridDim.x) ph_meta(mb, smem_dyn, p.meta, p.norm1_g, p.w_in, O);
  xcd_barrier(bar);
  {
    pg8::Gemm g{A1, WinT, TREAL, NINP, D}; pg8::StaticOrder S; S.init(TREAL, NINP, (int)gridDim.x, (int)blockIdx.x);
    EpiInProj E{O, GVT, smem_dyn + 131072};
    pg8::gemm_phase<EpiInProj, pg8::StaticOrder, true, true>((PG8_LAS unsigned char*)smem_dyn, g, S, E);
  }
  xcd_barrier(bar);
  for (int it = blockIdx.x; it < 32 * 129; it += gridDim.x) ph_gla_prep(it, smem_dyn, GPP);
  xcd_barrier(bar);
  for (int it = blockIdx.x; it < 16 * 15; it += gridDim.x) gla_item4<0>(it / 15, it % 15, smem_dyn, GP3);
  for (int vb = bid; vb < 64 * 32; vb += G) ph_sb_attn2(vb, O.QSB, O.KSB, O.VTSB, p.sb_g, MIX);
  xcd_barrier(bar);
  for (int it = blockIdx.x; it < 16 * 16; it += gridDim.x) gla_item4<1>(it >> 4, it & 15, smem_dyn, GP3);
  xcd_barrier(bar);
  {
    pg8::Gemm g{MIX, WoutT, TREAL, D, D}; pg8::StaticOrder S; S.init(TREAL, D, (int)gridDim.x, (int)blockIdx.x);
    EpiOut E{p.x, H1};
    pg8::gemm_phase<EpiOut, pg8::StaticOrder, true, true>((PG8_LAS unsigned char*)smem_dyn, g, S, E);
  }
  xcd_barrier(bar);
  for (int vb = bid; vb < TREAL / 16; vb += G) ph_norm2_rows(vb, H1, p.norm2_g, R2, (u8_t*)(ws + WS_XQ), (float*)(ws + WS_XS));
  xcd_barrier(bar);
  {
    pg8::Gemm g{H1, WpqT, TREAL, D, D}; pg8::StaticOrder S; S.init(TREAL, D, (int)gridDim.x, (int)blockIdx.x);
    EpiPQ E{QP, R2};
    pg8::gemm_phase<EpiPQ, pg8::StaticOrder, true, true>((PG8_LAS unsigned char*)smem_dyn, g, S, E);
  }
  xcd_barrier(bar);
  for (int vb = bid; vb < 8 * (TREAL / 128); vb += G) ph_route_v2(vb, smem, QP, SK1b, SK2b, EIDX, GATE);
  xcd_barrier(bar);
  {
    __shared__ int xinfo[4];
    if (threadIdx.x == 0) {
      unsigned* barw = (unsigned*)(p.ws + WS_BAR);
      unsigned cnt = 0, ord = 0, mine = 1;
      for (unsigned j = 0; j < 16; ++j) { const unsigned c = xb_ld(&barw[XB_XCNT(j)]); if (c > 0) { if (j < bar.x) ++ord; ++cnt; } if (j == bar.x) mine = c; }
      xinfo[0] = (int)ord; xinfo[1] = (int)cnt; xinfo[2] = (int)xb_words[2]; xinfo[3] = (int)mine;
    }
    __syncthreads();
    const int xi = xinfo[0], nx = xinfo[1], rank = xinfo[2], nloc = xinfo[3];
    const int wave = __builtin_amdgcn_readfirstlane((int)(threadIdx.x >> 6));
    ph_peer_u_d4(xi, nx, rank * 8 + wave, nloc * 8, (const u8_t*)(ws + WS_XQ), (const float*)(ws + WS_XS), (const u8_t*)EU, EIDX, PP);
  }
  xcd_barrier(bar);
  for (int unit = blockIdx.x; unit < TREAL / 64; unit += gridDim.x) ph_peer_c8(unit, smem_dyn, PP, EIDX, GATE, (const float*)(ws + WS_SCU), (const float*)(ws + WS_SCV), STREAM);
  xcd_barrier(bar);
  ph_peer_v8(smem_dyn, STREAM, (const u8_t*)EV, YT);
  xcd_barrier(bar);
  for (int unit = blockIdx.x; unit < TREAL / 32; unit += gridDim.x) ph_final_lds(unit, smem_dyn, H1, YT, p.gf, p.out);
}

extern "C" void kernel_launch(void* const* d_in, const int* in_sizes, int n_in, void* d_out, int out_size, void* d_ws, size_t ws_size, hipStream_t stream) {
  static int grid = 0;
  if (grid == 0) {
    int dev = 0, cus = 0, per_cu = 0;
    hipGetDevice(&dev);
    hipDeviceGetAttribute(&cus, hipDeviceAttributeMultiprocessorCount, dev);
    hipFuncSetAttribute((const void*)k_fused, hipFuncAttributeMaxDynamicSharedMemorySize, SMEM_BYTES);
    hipOccupancyMaxActiveBlocksPerMultiprocessor(&per_cu, (const void*)k_fused, 512, SMEM_BYTES);
    if (per_cu > 1) per_cu = 1;
    if (per_cu < 1) per_cu = 1;
    grid = cus * per_cu;
  }
  hipMemsetAsync((char*)d_ws + WS_BAR, 0, 32768, stream);
  Params p{};
  p.x = (const float*)d_in[0]; p.meta = (const float*)d_in[1]; p.norm1_g = (const float*)d_in[2]; p.w_in = (const float*)d_in[3];
  p.wg = (const float*)d_in[4]; p.bg = (const float*)d_in[5]; p.sb_g = (const float*)d_in[6]; p.gla_g = (const float*)d_in[7];
  p.w_out = (const float*)d_in[8]; p.norm2_g = (const float*)d_in[9]; p.w_pq = (const float*)d_in[10]; p.sk1 = (const float*)d_in[11];
  p.sk2 = (const float*)d_in[12]; p.eu = (const float*)d_in[13]; p.ev = (const float*)d_in[14]; p.gf = (const float*)d_in[15];
  p.out = (float*)d_out; p.ws = (char*)d_ws;
  void* args[] = {&p};
  hipLaunchCooperativeKernel((const void*)k_fused, dim3(grid), dim3(512), args, SMEM_BYTES, stream);
}
```

```cpp
#include <hip/hip_runtime.h>
#include <stdint.h>
#include <stddef.h>

typedef unsigned short bf16_t;
typedef short bf16x8 __attribute__((ext_vector_type(8)));
typedef float f32x16 __attribute__((ext_vector_type(16)));
typedef float f32x4 __attribute__((ext_vector_type(4)));
typedef float f32x2 __attribute__((ext_vector_type(2)));
typedef unsigned u32x4 __attribute__((ext_vector_type(4)));
typedef unsigned u32x2 __attribute__((ext_vector_type(2)));
typedef __bf16 bf16x2_t __attribute__((ext_vector_type(2)));

#define DI __device__ __forceinline__
__device__ __forceinline__ int fresh_tid() { int t = (int)threadIdx.x; asm volatile("" : "+v"(t)); return t; }
#define TID tid256_
#define MFMA32(a, b, c) __builtin_amdgcn_mfma_f32_32x32x16_bf16((a), (b), (c), 0, 0, 0)

constexpr int D = 1024, NB = 8, SEQ = 8192, NMETA = 16;
constexpr int TREAL = NB * SEQ;
constexpr int MROWS = TREAL + 128;
constexpr int NIN = 3088, NINP = 3328;
constexpr int SBH = 8, SBD = 64;
constexpr int GH = 4, GDK = 64, GDV = 128;
constexpr int KIDX = SEQ + 32;
constexpr int GU = SEQ + 64;
constexpr int NEXP = 16384;
constexpr float EPS = 1e-6f;

constexpr size_t MiB = 1u << 20;
constexpr size_t WS_WIN = 1 * MiB;
constexpr size_t WS_WOUT = 8 * MiB;
constexpr size_t WS_WPQ = 10 * MiB;
constexpr size_t WS_SK1 = 12 * MiB;
constexpr size_t WS_SK2 = 13 * MiB;
constexpr size_t WS_EU = 16 * MiB;
constexpr size_t WS_EV = 48 * MiB;
constexpr size_t WS_A1 = 80 * MiB;
constexpr size_t WS_QSB = 210 * MiB;
constexpr size_t WS_KSB = 274 * MiB;
constexpr size_t WS_VTSB = 339 * MiB;
constexpr size_t WS_GQ = 404 * MiB;
constexpr size_t WS_GK = 437 * MiB;
constexpr size_t WS_H1 = 210 * MiB;
constexpr size_t WS_GV = 470 * MiB;
constexpr size_t WS_GR = 535 * MiB;
constexpr size_t WS_GLR = 599 * MiB;
constexpr size_t WS_LG = 604 * MiB;
constexpr size_t WS_MIX = 669 * MiB;
constexpr size_t WS_EIDX = 797 * MiB;
constexpr size_t WS_GATE = 829 * MiB;
constexpr size_t WS_PP = 470 * MiB;
constexpr size_t WS_STREAM = 726 * MiB;
constexpr size_t WS_XRANK = 16384;
constexpr size_t WS_VSB = 861 * MiB;
constexpr size_t WS_END = 926 * MiB;

DI unsigned f2bf(float f) { unsigned u = __float_as_uint(f); return (u + 0x7fffu + ((u >> 16) & 1u)) >> 16; }
DI float bf2f(unsigned b) { return __uint_as_float(b << 16); }
DI unsigned pk2(float lo, float hi) { f32x2 v = {lo, hi}; return __builtin_bit_cast(unsigned, __builtin_convertvector(v, bf16x2_t)); }
DI float bflo(unsigned u) { return __uint_as_float(u << 16); }
DI float bfhi(unsigned u) { return __uint_as_float(u & 0xffff0000u); }
DI int crow(int reg, int h) { return (reg & 3) + 8 * (reg >> 2) + 4 * h; }
DI float wave_sum(float v) {
#pragma unroll
  for (int o = 32; o >= 1; o >>= 1) v += __shfl_xor(v, o);
  return v;
}
DI float softplus(float z) { return fmaxf(z, 0.f) + __logf(1.f + __expf(-fabsf(z))); }

DI void ph_transpose_w(int bx, int by, char* smem, const float* __restrict__ W, const float* __restrict__ gain, bf16_t* __restrict__ WT, int K, int N) {
  const int tid256_ = fresh_tid() & 255;
  float (*t)[33] = (float (*)[33])smem;
  const int n0 = bx * 32, k0 = by * 128;
  {
    const int kr = TID >> 3, c4 = (TID & 7) * 4;
    f32x4 v[4];
#pragma unroll
    for (int j = 0; j < 4; ++j) v[j] = (n0 + c4 < N) ? *(const f32x4*)(W + (size_t)(k0 + kr + 32 * j) * N + n0 + c4) : (f32x4){0.f, 0.f, 0.f, 0.f};
#pragma unroll
    for (int j = 0; j < 4; ++j) {
      const float g = gain ? gain[k0 + kr + 32 * j] : 1.f;
      t[kr + 32 * j][c4 + 0] = v[j].x * g; t[kr + 32 * j][c4 + 1] = v[j].y * g; t[kr + 32 * j][c4 + 2] = v[j].z * g; t[kr + 32 * j][c4 + 3] = v[j].w * g;
    }
  }
  __syncthreads();
  {
    const int n = TID >> 3, ks = (TID & 7) * 16;
    unsigned w[8];
#pragma unroll
    for (int i = 0; i < 8; ++i) w[i] = pk2(t[ks + 2 * i][n], t[ks + 2 * i + 1][n]);
    bf16_t* dst = WT + (size_t)(n0 + n) * K + k0 + ks;
    *(u32x4*)dst = (u32x4){w[0], w[1], w[2], w[3]};
    *(u32x4*)(dst + 8) = (u32x4){w[4], w[5], w[6], w[7]};
  }
  __syncthreads();
}
DI void ph_convert(const float* __restrict__ src, bf16_t* __restrict__ dst, size_t n8) {
  size_t i = (size_t)blockIdx.x * blockDim.x + threadIdx.x;
  const size_t stride = (size_t)gridDim.x * blockDim.x;
  for (; i < n8; i += stride) {
    const f32x4 a = ((const f32x4*)src)[2 * i], b = ((const f32x4*)src)[2 * i + 1];
    u32x4 o; o.x = pk2(a.x, a.y); o.y = pk2(a.z, a.w); o.z = pk2(b.x, b.y); o.w = pk2(b.z, b.w);
    ((u32x4*)dst)[i] = o;
  }
}
DI void ph_zero_pads(bf16_t* KSB, bf16_t* VTSB, bf16_t* GQ, bf16_t* GK, bf16_t* GVT) {
  const int tid = blockIdx.x * blockDim.x + threadIdx.x, nth = gridDim.x * blockDim.x;
  for (int i = tid; i < 64 * 16 * 64; i += nth) { const int bh = i / 1024, r = i % 1024; KSB[(size_t)bh * KIDX * 64 + r] = 0; }
  for (int i = tid; i < 64 * 64 * 16; i += nth) { const int row = i / 16, c = i % 16; VTSB[(size_t)row * KIDX + c] = 0; }
  for (int i = tid; i < 32 * 48 * 64; i += nth) { const int bh = i / 3072, r = i % 3072; GQ[(size_t)bh * GU * 64 + r] = 0; GK[(size_t)bh * GU * 64 + r] = 0; }
  for (int i = tid; i < 32 * 128 * 48; i += nth) { const int row = i / 48, c = i % 48; GVT[(size_t)row * GU + c] = 0; }
}

template <int MODE>
DI void ph_norm_rows(int vb, const float* __restrict__ src, const float* __restrict__ meta, bf16_t* __restrict__ dst) {
  const int tid256_ = fresh_tid() & 255;
  const int row0 = vb * 16 + (TID >> 6) * 4, lane = TID & 63;
  f32x4 v[4][4];
#pragma unroll
  for (int rr = 0; rr < 4; ++rr)
#pragma unroll
    for (int j = 0; j < 4; ++j) v[rr][j] = *(const f32x4*)(src + (size_t)(row0 + rr) * D + j * 256 + lane * 4);
  f32x4 gg[4];
#pragma unroll
  for (int j = 0; j < 4; ++j) { gg[j] = (f32x4){1.f, 1.f, 1.f, 1.f}; if (MODE == 1) gg[j] = *(const f32x4*)(meta + j * 256 + lane * 4); }
#pragma unroll
  for (int rr = 0; rr < 4; ++rr) {
    float ss = 0.f;
#pragma unroll
    for (int j = 0; j < 4; ++j) ss += v[rr][j].x * v[rr][j].x + v[rr][j].y * v[rr][j].y + v[rr][j].z * v[rr][j].z + v[rr][j].w * v[rr][j].w;
    ss = wave_sum(ss);
    const float r = rsqrtf(ss * (1.0f / D) + EPS);
#pragma unroll
    for (int j = 0; j < 4; ++j) {
      u32x2 o; o.x = pk2(v[rr][j].x * r * gg[j].x, v[rr][j].y * r * gg[j].y); o.y = pk2(v[rr][j].z * r * gg[j].z, v[rr][j].w * r * gg[j].w);
      *(u32x2*)(dst + (size_t)(row0 + rr) * D + j * 256 + lane * 4) = o;
    }
  }
}

namespace pg8 {
#define PG8_LAS __attribute__((address_space(3)))
typedef unsigned short bf16_t;
typedef short bf16x8 __attribute__((ext_vector_type(8)));
typedef float f32x4 __attribute__((ext_vector_type(4)));
typedef unsigned u32x4 __attribute__((ext_vector_type(4)));
constexpr int BM = 256, BK = 64, HALF = 128, HTB = HALF * BK * 2  , STAGE_BYTES = 8 * HTB, NXCD = 8, WGM = 8;

__host__ __device__ __forceinline__ int lds_byte(int r, int c) { const int st = (r >> 4) * 2 + (c >> 5), rr = r & 15, cc = c & 31, ob = rr * 64 + cc * 2; return st * 1024 + (ob ^ (((ob >> 9) & 1) << 5)); }
__host__ __device__ __forceinline__ void stage_rc(int b, int& R, int& C) { const int st = b / 1024, sb = b % 1024, swz = sb ^ (((sb >> 9) & 1) << 5); R = (st >> 1) * 16 + swz / 64; C = (st & 1) * 32 + (swz % 64) / 2; }
__host__ __device__ __forceinline__ int perm32(int rho) { const int n = rho >> 4, i = rho & 15; return 8 * (i >> 2) + 4 * n + (i & 3); }

struct Unit { int pm, pn; };
struct Gemm { const bf16_t* A; const bf16_t* Bt; int M, N, K; };

struct StaticOrder {
    int nM, nN, nwg, G, c;
    __host__ __device__ void init(int M, int N, int G_, int c_) { nM = M / BM; nN = N / BM; nwg = nM * nN; G = G_; c = c_; }
    __host__ __device__ bool next(int i, Unit& u) const {
        const long L = (long)i * G + c; if (L >= nwg) return false;
        int wgid = (int)L; { const int q = nwg / NXCD, r = nwg % NXCD, xcd = wgid % NXCD, off = wgid / NXCD; wgid = (xcd < r ? xcd * (q + 1) : r * (q + 1) + (xcd - r) * q) + off; }
        const int nig = WGM * nN, gid = wgid / nig, fm = gid * WGM, gsz = (nM - fm) < WGM ? (nM - fm) : WGM;
        u.pm = fm + ((wgid % nig) % gsz); u.pn = (wgid % nig) / gsz; return true;
    }
    __device__ __forceinline__ void a_ready(const Unit&) const {}
    __device__ __forceinline__ void done(const Unit&) const {}
};

template <class Epi, class Sched, bool ALIGN_EPI = false, bool SP2 = false>
__device__ __forceinline__ void gemm_phase(PG8_LAS unsigned char* lds, const Gemm g, const Sched& S, const Epi& E) {
    const int tid = fresh_tid(), wid = __builtin_amdgcn_readfirstlane(tid >> 6), lane = tid & 63, wr = wid >> 2, wc = wid & 3, fr = lane & 15, fq = lane >> 4;
    const int K = g.K, nt = K / BK;
    unsigned voffA[2], voffB[2];
#pragma unroll
    for (int i = 0; i < 2; ++i) { int R, C; stage_rc(tid * 16 + i * 8192, R, C); const int Rb = Epi::PERM ? ((R & ~31) + perm32(R & 31)) : R;
        voffA[i] = (unsigned)(R * K + C) * 2u; voffB[i] = (unsigned)(Rb * K + C) * 2u; }
    const size_t kstep = (size_t)(BK * 2);
    const size_t hstep = (size_t)HALF * K * 2;
    const size_t tstep = 2 * hstep;
    const unsigned ldsw = (unsigned)wid * 1024u;
    const int aoff = lds_byte(wr * 64 + fr, fq * 8), boff = lds_byte(wc * 32 + fr, fq * 8);
#define PG8_SA(b, h) (((b) * 2 + (h)) * HTB)
#define PG8_SB(b, h) ((4 + (b) * 2 + (h)) * HTB)
#define PG8_STAGE(bufoff, gbase, voff) do { _Pragma("unroll") for (int _i = 0; _i < 2; ++_i) \
        __builtin_amdgcn_global_load_lds((const unsigned*)((const char*)(gbase) + (voff)[_i]), (PG8_LAS unsigned*)(lds + (bufoff) + ldsw + _i * 8192), 16, 0, 0); } while (0)
#define PG8_LDA(dst, b, h) do { _Pragma("unroll") for (int m = 0; m < 4; ++m) _Pragma("unroll") for (int k = 0; k < 2; ++k) dst[m][k] = *(const PG8_LAS bf16x8*)(lds + PG8_SA(b, h) + aoff + m * 2048 + k * 1024); } while (0)
#define PG8_LDB(dst, b, h) do { _Pragma("unroll") for (int n = 0; n < 2; ++n) _Pragma("unroll") for (int k = 0; k < 2; ++k) dst[n][k] = *(const PG8_LAS bf16x8*)(lds + PG8_SB(b, h) + boff + n * 2048 + k * 1024); } while (0)
#define PG8_MMA(ai, bj, At, Bt) do { __builtin_amdgcn_s_setprio(1); _Pragma("unroll") for (int m = 0; m < 4; ++m) _Pragma("unroll") for (int n = 0; n < 2; ++n) _Pragma("unroll") for (int k = 0; k < 2; ++k) \
        acc[ai][bj][m][n] = __builtin_amdgcn_mfma_f32_16x16x32_bf16(Bt[n][k], At[m][k], acc[ai][bj][m][n], 0, 0, 0); __builtin_amdgcn_s_setprio(0); } while (0)
#define PG8_WAIT_V(n) asm volatile("s_waitcnt vmcnt(" #n ")" ::: "memory")
#define PG8_WAIT_L(n) asm volatile("s_waitcnt lgkmcnt(" #n ")" ::: "memory")
#define PG8_BAR __builtin_amdgcn_s_barrier()
#define PG8_SCHED __builtin_amdgcn_sched_barrier(0)
    Unit cur, nxt; int ui = 0;
    if (!S.next(0, cur)) return;
    f32x4 acc[2][2][4][2];
#pragma unroll
    for (int a = 0; a < 2; ++a)
#pragma unroll
        for (int b = 0; b < 2; ++b)
#pragma unroll
            for (int m = 0; m < 4; ++m)
#pragma unroll
                for (int n = 0; n < 2; ++n) acc[a][b][m][n] = (f32x4){0.f, 0.f, 0.f, 0.f};
    bf16x8 At[4][2], B0[2][2], B1[2][2];
    const char* cA = (const char*)g.A + (size_t)cur.pm * tstep; const char* cB = (const char*)g.Bt + (size_t)cur.pn * tstep;
    S.a_ready(cur);
    if constexpr (SP2) {
        PG8_STAGE(PG8_SB(0, 0), cB, voffB); PG8_STAGE(PG8_SB(0, 1), cB + hstep, voffB); PG8_STAGE(PG8_SA(0, 0), cA, voffA); PG8_STAGE(PG8_SA(0, 1), cA + hstep, voffA);
        if (wr == 1) PG8_BAR;
        PG8_WAIT_V(2); PG8_BAR;
        PG8_STAGE(PG8_SB(1, 0), cB + kstep, voffB); PG8_STAGE(PG8_SA(1, 0), cA + kstep, voffA); PG8_STAGE(PG8_SB(1, 1), cB + hstep + kstep, voffB);
        PG8_WAIT_V(6); PG8_BAR;
    } else {
        PG8_STAGE(PG8_SB(0, 0), cB, voffB); PG8_STAGE(PG8_SA(0, 0), cA, voffA); PG8_STAGE(PG8_SB(0, 1), cB + hstep, voffB); PG8_STAGE(PG8_SA(0, 1), cA + hstep, voffA);
        if (wr == 1) PG8_BAR;
        PG8_WAIT_V(4); PG8_BAR;
        PG8_STAGE(PG8_SB(1, 0), cB + kstep, voffB); PG8_STAGE(PG8_SA(1, 0), cA + kstep, voffA); PG8_STAGE(PG8_SB(1, 1), cB + hstep + kstep, voffB);
        PG8_WAIT_V(6); PG8_BAR;
    }
    for (;;) {
        const bool has_next = S.next(ui + 1, nxt);
        const char* nA = has_next ? (const char*)g.A + (size_t)nxt.pm * tstep : cA; const char* nB = has_next ? (const char*)g.Bt + (size_t)nxt.pn * tstep : cB;
        for (int t = 0; t < nt; t += 2) {
            const bool last = (t == nt - 2);
            const char* a1 = cA + (size_t)(t + 1) * kstep;
            const char* a2 = last ? nA : cA + (size_t)(t + 2) * kstep; const char* b2 = last ? nB : cB + (size_t)(t + 2) * kstep;
            const char* a3 = a2 + kstep; const char* b3 = b2 + kstep;
            if (last && has_next) S.a_ready(nxt);
            if constexpr (SP2) {
            PG8_LDB(B0, 0, 0); PG8_LDB(B1, 0, 1); PG8_SCHED; PG8_LDA(At, 0, 0); PG8_STAGE(PG8_SA(1, 1), a1 + hstep, voffA);
            PG8_WAIT_V(8); PG8_WAIT_L(0); PG8_BAR; PG8_MMA(0, 0, At, B0); PG8_MMA(0, 1, At, B1); PG8_BAR; PG8_SCHED;
            PG8_LDA(At, 0, 1); PG8_STAGE(PG8_SB(0, 0), b2, voffB); PG8_STAGE(PG8_SB(0, 1), b2 + hstep, voffB); PG8_STAGE(PG8_SA(0, 0), a2, voffA);
            PG8_WAIT_V(8); PG8_WAIT_L(0); PG8_BAR; PG8_MMA(1, 0, At, B0); PG8_MMA(1, 1, At, B1); PG8_BAR; PG8_SCHED;
            PG8_LDB(B0, 1, 0); PG8_LDB(B1, 1, 1); PG8_SCHED; PG8_LDA(At, 1, 0); PG8_STAGE(PG8_SA(0, 1), a2 + hstep, voffA);
            PG8_WAIT_V(8); PG8_WAIT_L(0); PG8_BAR; PG8_MMA(0, 0, At, B0); PG8_MMA(0, 1, At, B1); PG8_BAR; PG8_SCHED;
            PG8_LDA(At, 1, 1); PG8_STAGE(PG8_SB(1, 0), b3, voffB); PG8_STAGE(PG8_SB(1, 1), b3 + hstep, voffB); PG8_STAGE(PG8_SA(1, 0), a3, voffA);
            PG8_WAIT_V(8); PG8_WAIT_L(0); PG8_BAR; PG8_MMA(1, 0, At, B0); PG8_MMA(1, 1, At, B1); PG8_BAR; PG8_SCHED;
            } else {
            PG8_LDB(B0, 0, 0); PG8_SCHED; PG8_LDA(At, 0, 0); PG8_STAGE(PG8_SA(1, 1), a1 + hstep, voffA);
            PG8_WAIT_L(8); PG8_BAR; PG8_WAIT_L(0); PG8_MMA(0, 0, At, B0); PG8_BAR; PG8_SCHED;
            PG8_LDB(B1, 0, 1); PG8_STAGE(PG8_SB(0, 0), b2, voffB);
            PG8_BAR; PG8_WAIT_L(0); PG8_MMA(0, 1, At, B1); PG8_BAR;
            PG8_LDA(At, 0, 1); PG8_STAGE(PG8_SA(0, 0), a2, voffA);
            PG8_BAR; PG8_WAIT_L(0); PG8_MMA(1, 0, At, B0); PG8_BAR; PG8_SCHED;
            PG8_STAGE(PG8_SB(0, 1), b2 + hstep, voffB);
            PG8_WAIT_V(6); PG8_BAR; PG8_MMA(1, 1, At, B1); PG8_BAR;
            PG8_LDB(B0, 1, 0); PG8_SCHED; PG8_LDA(At, 1, 0); PG8_STAGE(PG8_SA(0, 1), a2 + hstep, voffA);
            PG8_WAIT_L(8); PG8_BAR; PG8_WAIT_L(0); PG8_MMA(0, 0, At, B0); PG8_BAR; PG8_SCHED;
            PG8_LDB(B1, 1, 1); PG8_STAGE(PG8_SB(1, 0), b3, voffB);
            PG8_BAR; PG8_WAIT_L(0); PG8_MMA(0, 1, At, B1); PG8_BAR;
            PG8_LDA(At, 1, 1); PG8_STAGE(PG8_SA(1, 0), a3, voffA);
            PG8_BAR; PG8_WAIT_L(0); PG8_MMA(1, 0, At, B0); PG8_BAR; PG8_SCHED;
            PG8_STAGE(PG8_SB(1, 1), b3 + hstep, voffB);
            PG8_WAIT_V(6); PG8_BAR; PG8_MMA(1, 1, At, B1); PG8_BAR;
            }
        }
        if constexpr (ALIGN_EPI) { if (wr == 0) PG8_BAR; }
        if constexpr (!Epi::AFTER_DRAIN) { E(acc, cur, wr, wc, fr, fq); S.done(cur); }
        if (!has_next) break;
#pragma unroll
        for (int a = 0; a < 2; ++a)
#pragma unroll
            for (int b = 0; b < 2; ++b)
#pragma unroll
                for (int m = 0; m < 4; ++m)
#pragma unroll
                    for (int n = 0; n < 2; ++n) acc[a][b][m][n] = (f32x4){0.f, 0.f, 0.f, 0.f};
        cur = nxt; cA = nA; cB = nB; ++ui;
        if constexpr (ALIGN_EPI) { if (wr == 1) PG8_BAR; }
    }
    PG8_WAIT_V(0);
    if constexpr (!ALIGN_EPI) { if (wr == 0) PG8_BAR; }
    PG8_BAR;
    if constexpr (Epi::AFTER_DRAIN) { E.fused(acc, cur, wr, wc, fr, fq, lds, wid, lane); S.done(cur); }
#undef PG8_SA
#undef PG8_SB
#undef PG8_STAGE
#undef PG8_LDA
#undef PG8_LDB
#undef PG8_MMA
#undef PG8_WAIT_V
#undef PG8_WAIT_L
#undef PG8_BAR
#undef PG8_SCHED
}
}

struct InProjOut { bf16_t *QSB, *KSB, *VSB, *VTSB, *GQ, *GK, *GV, *GR; float* GLR; };

struct EpiInProj {
  static constexpr bool PERM = true, AFTER_DRAIN = false;
  InProjOut O; bf16_t* GVT; char* stage;
  DI void store_vt(const pg8::f32x4 (&acc)[2][2][4][2], const pg8::Unit& u, int wr, int wc, int fr, int fq) const {
    bf16_t* st = (bf16_t*)(stage + (wr * 4 + wc) * 1280);
    const int lane = fr + 16 * fq;
    const int rc = lane >> 2, r8 = lane & 3;
#pragma unroll
    for (int ai = 0; ai < 2; ++ai)
#pragma unroll
      for (int bj = 0; bj < 2; ++bj)
#pragma unroll
        for (int mp = 0; mp < 2; ++mp)
#pragma unroll
          for (int ch = 0; ch < 2; ++ch) {
            if ((fq >> 1) == ch) {
#pragma unroll
              for (int m2 = 0; m2 < 2; ++m2)
#pragma unroll
                for (int n = 0; n < 2; ++n) {
                  const pg8::f32x4 v = acc[ai][bj][2 * mp + m2][n];
                  const int cl = 8 * (fq & 1) + 4 * n, rl = 16 * m2 + fr;
                  st[(cl + 0) * 40 + rl] = (bf16_t)f2bf(v[0]); st[(cl + 1) * 40 + rl] = (bf16_t)f2bf(v[1]);
                  st[(cl + 2) * 40 + rl] = (bf16_t)f2bf(v[2]); st[(cl + 3) * 40 + rl] = (bf16_t)f2bf(v[3]);
                }
            }
            asm volatile("s_waitcnt lgkmcnt(0)" ::: "memory");
            const u32x4 w = *(const u32x4*)&st[rc * 40 + 8 * r8];
            asm volatile("" ::: "memory");
            const int col = u.pn * 256 + bj * 128 + wc * 32 + 16 * ch + rc;
            const int row = u.pm * 256 + ai * 128 + wr * 64 + 32 * mp + 8 * r8;
            const int b = row >> 13, i = row & 8191;
            bf16_t* dst;
            if (u.pn < 6) { const int c = col - 1024; dst = O.VTSB + ((size_t)(b * SBH + (c >> 6)) * 64 + (c & 63)) * KIDX + 32 + i; }
            else          { const int c = col - 2048; dst = GVT + ((size_t)(b * GH + (c >> 7)) * 128 + (c & 127)) * GU + 64 + i; }
            *(u32x4*)dst = w;
          }
  }
  DI void operator()(const pg8::f32x4 (&acc)[2][2][4][2], const pg8::Unit& u, int wr, int wc, int fr, int fq) const {
    const int pn = u.pn;
    if (pn == 4 || pn == 5 || pn == 8 || pn == 9) { store_vt(acc, u, wr, wc, fr, fq); return; }
#pragma unroll
    for (int ai = 0; ai < 2; ++ai)
#pragma unroll
      for (int m = 0; m < 4; ++m) {
        const int row = u.pm * 256 + ai * 128 + wr * 64 + m * 16 + fr;
        const int b = row >> 13, i = row & 8191;
#pragma unroll
        for (int bj = 0; bj < 2; ++bj) {
          const int col = pn * 256 + bj * 128 + wc * 32 + 8 * fq;
          const pg8::f32x4 v0 = acc[ai][bj][m][0], v1 = acc[ai][bj][m][1];
          if (pn < 12) {
            u32x4 w; w.x = pk2(v0[0], v0[1]); w.y = pk2(v0[2], v0[3]); w.z = pk2(v1[0], v1[1]); w.w = pk2(v1[2], v1[3]);
            bf16_t* dst;
            if (pn < 2)       { const int c = col;        dst = O.QSB + ((size_t)(b * SBH + (c >> 6)) * SEQ + i) * 64 + (c & 63); }
            else if (pn < 4)  { const int c = col - 512;  dst = O.KSB + ((size_t)(b * SBH + (c >> 6)) * KIDX + 32 + i) * 64 + (c & 63); }
            else if (pn == 6) { const int c = col - 1536; dst = O.GQ + ((size_t)(b * GH + (c >> 6)) * GU + 64 + i) * 64 + (c & 63); }
            else if (pn == 7) { const int c = col - 1792; dst = O.GK + ((size_t)(b * GH + (c >> 6)) * GU + 64 + i) * 64 + (c & 63); }
            else              { const int c = col - 2560; dst = O.GR + (size_t)row * 512 + c; }
            *(u32x4*)dst = w;
          } else if (col < NIN) {
            float* dst = O.GLR + ((size_t)b * GU + 64 + i) * 16 + (col - 3072);
            *(f32x4*)dst = (f32x4){v0[0], v0[1], v0[2], v0[3]};
            *(f32x4*)(dst + 4) = (f32x4){v1[0], v1[1], v1[2], v1[3]};
          }
        }
      }
  }
};
struct EpiOut {
  static constexpr bool PERM = true, AFTER_DRAIN = false;
  const float* x; bf16_t* H1;
  DI void operator()(const pg8::f32x4 (&acc)[2][2][4][2], const pg8::Unit& u, int wr, int wc, int fr, int fq) const {
#pragma unroll
    for (int ai = 0; ai < 2; ++ai)
#pragma unroll
      for (int m = 0; m < 4; ++m) {
        const size_t rowoff = (size_t)(u.pm * 256 + ai * 128 + wr * 64 + m * 16 + fr) * D;
#pragma unroll
        for (int bj = 0; bj < 2; ++bj) {
          const size_t idx = rowoff + u.pn * 256 + bj * 128 + wc * 32 + 8 * fq;
          const f32x4 x0 = *(const f32x4*)(x + idx), x1 = *(const f32x4*)(x + idx + 4);
          const pg8::f32x4 v0 = acc[ai][bj][m][0], v1 = acc[ai][bj][m][1];
          u32x4 w; w.x = pk2(x0.x + v0[0], x0.y + v0[1]); w.y = pk2(x0.z + v0[2], x0.w + v0[3]); w.z = pk2(x1.x + v1[0], x1.y + v1[1]); w.w = pk2(x1.z + v1[2], x1.w + v1[3]);
          *(u32x4*)(H1 + idx) = w;
        }
      }
  }
};
struct EpiPQ {
  static constexpr bool PERM = true, AFTER_DRAIN = false;
  bf16_t* QP; const float* R2;
  DI void operator()(const pg8::f32x4 (&acc)[2][2][4][2], const pg8::Unit& u, int wr, int wc, int fr, int fq) const {
#pragma unroll
    for (int ai = 0; ai < 2; ++ai)
#pragma unroll
      for (int m = 0; m < 4; ++m) {
        const int row = u.pm * 256 + ai * 128 + wr * 64 + m * 16 + fr;
        const float r = R2[row];
        const size_t rowoff = (size_t)row * D;
#pragma unroll
        for (int bj = 0; bj < 2; ++bj) {
          const pg8::f32x4 v0 = acc[ai][bj][m][0], v1 = acc[ai][bj][m][1];
          u32x4 w; w.x = pk2(v0[0] * r, v0[1] * r); w.y = pk2(v0[2] * r, v0[3] * r); w.z = pk2(v1[0] * r, v1[1] * r); w.w = pk2(v1[2] * r, v1[3] * r);
          *(u32x4*)(QP + rowoff + u.pn * 256 + bj * 128 + wc * 32 + 8 * fq) = w;
        }
      }
  }
};

DI void ph_meta(int blk, char* smem, const float* __restrict__ meta, const float* __restrict__ g1, const float* __restrict__ w_in, const InProjOut& O) {
  float (*xmT)[16] = (float (*)[16])smem;
  float (*red)[256] = (float (*)[256])(smem + 65536);
  const int tid = fresh_tid(), lane = tid & 63, wave = tid >> 6;
  for (int rr = 0; rr < 2; ++rr) {
    const int mm = wave * 2 + rr;
    float v[16]; float ss = 0.f;
#pragma unroll
    for (int j = 0; j < 16; ++j) { v[j] = meta[(size_t)mm * D + j * 64 + lane]; ss += v[j] * v[j]; }
    ss = wave_sum(ss);
    const float r = rsqrtf(ss * (1.0f / D) + EPS);
#pragma unroll
    for (int j = 0; j < 16; ++j) xmT[j * 64 + lane][mm] = v[j] * r * g1[j * 64 + lane];
  }
  __syncthreads();
  {
    const int c = tid & 15, ks = tid >> 4, n = blk * 16 + c;
    float acc[16];
#pragma unroll
    for (int j = 0; j < 16; ++j) acc[j] = 0.f;
#pragma unroll 8
    for (int kk = 0; kk < 32; ++kk) {
      const int k = ks * 32 + kk;
      const float w = w_in[(size_t)k * NIN + n];
      const f32x4 a = *(const f32x4*)&xmT[k][0], b4 = *(const f32x4*)&xmT[k][4], c4 = *(const f32x4*)&xmT[k][8], d4 = *(const f32x4*)&xmT[k][12];
      acc[0] += a.x * w; acc[1] += a.y * w; acc[2] += a.z * w; acc[3] += a.w * w;
      acc[4] += b4.x * w; acc[5] += b4.y * w; acc[6] += b4.z * w; acc[7] += b4.w * w;
      acc[8] += c4.x * w; acc[9] += c4.y * w; acc[10] += c4.z * w; acc[11] += c4.w * w;
      acc[12] += d4.x * w; acc[13] += d4.y * w; acc[14] += d4.z * w; acc[15] += d4.w * w;
    }
#pragma unroll
    for (int mm = 0; mm < 16; ++mm) red[ks][c * 16 + mm] = acc[mm];
  }
  __syncthreads();
  if (tid < 256) {
    const int c = tid >> 4, mm = tid & 15, n = blk * 16 + c;
    float val = 0.f;
#pragma unroll 8
    for (int ks = 0; ks < 32; ++ks) val += red[ks][tid];
    const bf16_t hv = (bf16_t)f2bf(val);
    for (int bb = 0; bb < NB; ++bb) {
      if (n < 512) {}
      else if (n < 1024) { const int cc = n - 512;  O.KSB[((size_t)(bb * SBH + (cc >> 6)) * KIDX + 16 + mm) * 64 + (cc & 63)] = hv; }
      else if (n < 1536) { const int cc = n - 1024; O.VTSB[((size_t)(bb * SBH + (cc >> 6)) * 64 + (cc & 63)) * KIDX + 16 + mm] = hv; }
      else if (n < 1792) { const int cc = n - 1536; O.GQ[((size_t)(bb * GH + (cc >> 6)) * GU + 48 + mm) * 64 + (cc & 63)] = hv; }
      else if (n < 2048) { const int cc = n - 1792; O.GK[((size_t)(bb * GH + (cc >> 6)) * GU + 48 + mm) * 64 + (cc & 63)] = hv; }
      else if (n < 2560) { const int cc = n - 2048; O.GV[((size_t)(bb * GH + (cc >> 7)) * 128 + (cc & 127)) * GU + 48 + mm] = hv; }
      else if (n < 3072) {}
      else { O.GLR[((size_t)bb * GU + 48 + mm) * 16 + (n - 3072)] = val; }
    }
  }
  __syncthreads();
}


constexpr float SB_THR = 5.421010862e-20f;
DI void ph_sb_attn(int vb, const bf16_t* __restrict__ QSB, const bf16_t* __restrict__ KSB, const bf16_t* __restrict__ VTSB,
                                                 const float* __restrict__ sb_g, bf16_t* __restrict__ MIX) {
  const int tid256_ = fresh_tid() & 255;
  const int lane = TID & 63, wave = TID >> 6, r = lane & 31, h = lane >> 5;
  const int bh = vb >> 6, qb = vb & 63;
  const int b = bh >> 3, hd = bh & 7;
  const int i0 = qb * 128 + wave * 32;
  const bf16_t* Qb = QSB + ((size_t)bh * SEQ + i0) * 64;
  const bf16_t* Kb = KSB + (size_t)bh * KIDX * 64;
  const bf16_t* Vb = VTSB + (size_t)bh * 64 * KIDX;
  bf16x8 qf[4];
#pragma unroll
  for (int ks = 0; ks < 4; ++ks) qf[ks] = *(const bf16x8*)(Qb + r * 64 + ks * 16 + h * 8);
  f32x16 o[2];
#pragma unroll
  for (int e = 0; e < 16; ++e) { o[0][e] = 0.f; o[1][e] = 0.f; }
  float R = 1.f;
  const int qidx = 32 + i0 + r;
  for (int c = (i0 >> 5) + 1; c >= 0; --c) {
    const int k0 = 32 * c;
    bf16x8 kf[4];
#pragma unroll
    for (int ks = 0; ks < 4; ++ks) kf[ks] = *(const bf16x8*)(Kb + (size_t)(k0 + r) * 64 + ks * 16 + h * 8);
    bf16x8 vf[2][2];
#pragma unroll
    for (int mt = 0; mt < 2; ++mt)
#pragma unroll
      for (int s2 = 0; s2 < 2; ++s2) {
        const bf16_t* vp = Vb + (size_t)(mt * 32 + r) * KIDX + k0 + 16 * s2 + 4 * h;
        const u32x2 lo = *(const u32x2*)vp, hi = *(const u32x2*)(vp + 8);
        u32x4 t; t.x = lo.x; t.y = lo.y; t.z = hi.x; t.w = hi.y;
        vf[mt][s2] = __builtin_bit_cast(bf16x8, t);
      }
    f32x16 s;
#pragma unroll
    for (int e = 0; e < 16; ++e) s[e] = 0.f;
#pragma unroll
    for (int ks = 0; ks < 4; ++ks) s = MFMA32(kf[ks], qf[ks], s);
    float om[16], bt[16];
#pragma unroll
    for (int e = 0; e < 16; ++e) {
      const int kidx = k0 + crow(e, h);
      const bool valid = (kidx < qidx) && (kidx >= 16);
      const float z = s[e] * 0.125f;
      const float ez = __expf(-fabsf(z));
      const float big = __builtin_amdgcn_rcpf(1.f + ez), small = ez * big;
      const float beta = z >= 0.f ? big : small, onem = z >= 0.f ? small : big;
      om[e] = valid ? onem : 1.f;
      bt[e] = valid ? beta : 0.f;
    }
    float sfx[16], G[4], PG[4];
#pragma unroll
    for (int g = 0; g < 4; ++g) {
      sfx[4 * g + 3] = 1.f;
      sfx[4 * g + 2] = om[4 * g + 3];
      sfx[4 * g + 1] = sfx[4 * g + 2] * om[4 * g + 2];
      sfx[4 * g + 0] = sfx[4 * g + 1] * om[4 * g + 1];
      G[g] = sfx[4 * g + 0] * om[4 * g + 0];
      PG[g] = __shfl_xor(G[g], 32);
    }
    float HS[4];
    HS[3] = 1.f;
    HS[2] = G[3] * PG[3];
    HS[1] = HS[2] * (G[2] * PG[2]);
    HS[0] = HS[1] * (G[1] * PG[1]);
    const float total = HS[0] * (G[0] * PG[0]);
    float a[16];
#pragma unroll
    for (int e = 0; e < 16; ++e) {
      const int g = e >> 2;
      const float between = sfx[e] * (h == 0 ? PG[g] : 1.f) * (HS[g] * R);
      a[e] = bt[e] * between;
    }
    R *= total;
#pragma unroll
    for (int s2 = 0; s2 < 2; ++s2) {
      u32x4 p;
      p.x = pk2(a[8 * s2 + 0], a[8 * s2 + 1]); p.y = pk2(a[8 * s2 + 2], a[8 * s2 + 3]);
      p.z = pk2(a[8 * s2 + 4], a[8 * s2 + 5]); p.w = pk2(a[8 * s2 + 6], a[8 * s2 + 7]);
      const bf16x8 pf = __builtin_bit_cast(bf16x8, p);
      o[0] = MFMA32(vf[0][s2], pf, o[0]);
      o[1] = MFMA32(vf[1][s2], pf, o[1]);
    }
    if (__all(R < SB_THR)) break;
  }
  float ss = 0.f;
#pragma unroll
  for (int e = 0; e < 16; ++e) ss += o[0][e] * o[0][e] + o[1][e] * o[1][e];
  ss += __shfl_xor(ss, 32);
  const float sc = rsqrtf(ss * (1.0f / 64.0f) + EPS);
  bf16_t* outp = MIX + (size_t)(b * SEQ + i0 + r) * D + hd * 64;
#pragma unroll
  for (int mt = 0; mt < 2; ++mt)
#pragma unroll
    for (int g = 0; g < 4; ++g) {
      const int d = mt * 32 + 8 * g + 4 * h;
      const f32x4 gg = *(const f32x4*)(sb_g + hd * 64 + d);
      u32x2 pk;
      pk.x = pk2(o[mt][4 * g] * sc * gg.x, o[mt][4 * g + 1] * sc * gg.y);
      pk.y = pk2(o[mt][4 * g + 2] * sc * gg.z, o[mt][4 * g + 3] * sc * gg.w);
      *(u32x2*)(outp + d) = pk;
    }
}


DI void sb_tile_step(const f32x16& s, int k0, int qidx, int h, float& R, const bf16x8 (&vf)[2][2], f32x16 (&o)[2]) {
  float om[16], bt[16];
#pragma unroll
  for (int e = 0; e < 16; ++e) {
    const int kidx = k0 + crow(e, h);
    const bool valid = (kidx < qidx) && (kidx >= 16);
    const float z = s[e] * 0.125f;
    const float ez = __expf(-fabsf(z));
    const float big = __builtin_amdgcn_rcpf(1.f + ez), small = ez * big;
    const float beta = z >= 0.f ? big : small, onem = z >= 0.f ? small : big;
    om[e] = valid ? onem : 1.f;
    bt[e] = valid ? beta : 0.f;
  }
  float sfx[16], G[4], PG[4];
#pragma unroll
  for (int g = 0; g < 4; ++g) {
    sfx[4 * g + 3] = 1.f;
    sfx[4 * g + 2] = om[4 * g + 3];
    sfx[4 * g + 1] = sfx[4 * g + 2] * om[4 * g + 2];
    sfx[4 * g + 0] = sfx[4 * g + 1] * om[4 * g + 1];
    G[g] = sfx[4 * g + 0] * om[4 * g + 0];
    PG[g] = __shfl_xor(G[g], 32);
  }
  float HS[4];
  HS[3] = 1.f; HS[2] = G[3] * PG[3]; HS[1] = HS[2] * (G[2] * PG[2]); HS[0] = HS[1] * (G[1] * PG[1]);
  const float total = HS[0] * (G[0] * PG[0]);
  float a[16];
#pragma unroll
  for (int e = 0; e < 16; ++e) { const int g = e >> 2; a[e] = bt[e] * (sfx[e] * (h == 0 ? PG[g] : 1.f) * (HS[g] * R)); }
  R *= total;
#pragma unroll
  for (int s2 = 0; s2 < 2; ++s2) {
    u32x4 p;
    p.x = pk2(a[8 * s2 + 0], a[8 * s2 + 1]); p.y = pk2(a[8 * s2 + 2], a[8 * s2 + 3]);
    p.z = pk2(a[8 * s2 + 4], a[8 * s2 + 5]); p.w = pk2(a[8 * s2 + 6], a[8 * s2 + 7]);
    const bf16x8 pf = __builtin_bit_cast(bf16x8, p);
    o[0] = MFMA32(vf[0][s2], pf, o[0]);
    o[1] = MFMA32(vf[1][s2], pf, o[1]);
  }
}
DI void sb_tile_out(const f32x16 (&o)[2], int h, const float* __restrict__ sb_gh, bf16_t* __restrict__ outp) {
  float ss = 0.f;
#pragma unroll
  for (int e = 0; e < 16; ++e) ss += o[0][e] * o[0][e] + o[1][e] * o[1][e];
  ss += __shfl_xor(ss, 32);
  const float sc = rsqrtf(ss * (1.0f / 64.0f) + EPS);
#pragma unroll
  for (int mt = 0; mt < 2; ++mt)
#pragma unroll
    for (int g = 0; g < 4; ++g) {
      const int d = mt * 32 + 8 * g + 4 * h;
      const f32x4 gg = *(const f32x4*)(sb_gh + d);
      u32x2 pk;
      pk.x = pk2(o[mt][4 * g] * sc * gg.x, o[mt][4 * g + 1] * sc * gg.y);
      pk.y = pk2(o[mt][4 * g + 2] * sc * gg.z, o[mt][4 * g + 3] * sc * gg.w);
      *(u32x2*)(outp + d) = pk;
    }
}
DI void ph_sb_attn2(int vb, const bf16_t* __restrict__ QSB, const bf16_t* __restrict__ KSB, const bf16_t* __restrict__ VTSB,
                    const float* __restrict__ sb_g, bf16_t* __restrict__ MIX) {
  const int tid256_ = fresh_tid() & 255;
  const int lane = TID & 63, wave = TID >> 6, r = lane & 31, h = lane >> 5;
  const int bh = vb >> 5, qb = vb & 31;
  const int b = bh >> 3, hd = bh & 7;
  const int i0 = qb * 256 + wave * 64;
  const bf16_t* Qb = QSB + ((size_t)bh * SEQ + i0) * 64;
  const bf16_t* Kb = KSB + (size_t)bh * KIDX * 64;
  const bf16_t* Vb = VTSB + (size_t)bh * 64 * KIDX;
  bf16x8 qfA[4], qfB[4];
#pragma unroll
  for (int ks = 0; ks < 4; ++ks) { qfA[ks] = *(const bf16x8*)(Qb + r * 64 + ks * 16 + h * 8); qfB[ks] = *(const bf16x8*)(Qb + (32 + r) * 64 + ks * 16 + h * 8); }
  f32x16 oA[2], oB[2];
#pragma unroll
  for (int e = 0; e < 16; ++e) { oA[0][e] = 0.f; oA[1][e] = 0.f; oB[0][e] = 0.f; oB[1][e] = 0.f; }
  float RA = 1.f, RB = 1.f;
  const int qidxA = 32 + i0 + r, qidxB = qidxA + 32;
  for (int c = (i0 >> 5) + 2; c >= 0; --c) {
    const int k0 = 32 * c;
    bf16x8 kf[4];
#pragma unroll
    for (int ks = 0; ks < 4; ++ks) kf[ks] = *(const bf16x8*)(Kb + (size_t)(k0 + r) * 64 + ks * 16 + h * 8);
    bf16x8 vf[2][2];
#pragma unroll
    for (int mt = 0; mt < 2; ++mt)
#pragma unroll
      for (int s2 = 0; s2 < 2; ++s2) {
        const bf16_t* vp = Vb + (size_t)(mt * 32 + r) * KIDX + k0 + 16 * s2 + 4 * h;
        const u32x2 lo = *(const u32x2*)vp, hi = *(const u32x2*)(vp + 8);
        u32x4 t; t.x = lo.x; t.y = lo.y; t.z = hi.x; t.w = hi.y;
        vf[mt][s2] = __builtin_bit_cast(bf16x8, t);
      }
    f32x16 sA, sB;
#pragma unroll
    for (int e = 0; e < 16; ++e) { sA[e] = 0.f; sB[e] = 0.f; }
#pragma unroll
    for (int ks = 0; ks < 4; ++ks) { sA = MFMA32(kf[ks], qfA[ks], sA); sB = MFMA32(kf[ks], qfB[ks], sB); }
    sb_tile_step(sB, k0, qidxB, h, RB, vf, oB);
    sb_tile_step(sA, k0, qidxA, h, RA, vf, oA);
    if (__all(RA < SB_THR && RB < SB_THR)) break;
  }
  sb_tile_out(oA, h, sb_g + hd * 64, MIX + (size_t)(b * SEQ + i0 + r) * D + hd * 64);
  sb_tile_out(oB, h, sb_g + hd * 64, MIX + (size_t)(b * SEQ + i0 + 32 + r) * D + hd * 64);
}


constexpr int RT_TOK_PER_BLOCK = 256;


#define MFMA16(a, b, c) __builtin_amdgcn_mfma_f32_16x16x32_bf16((a), (b), (c), 0, 0, 0)
constexpr int GLDS = 72;
struct GlaLds {
  bf16_t Qt[64 * GLDS];
  bf16_t Kt[64 * GLDS];
  bf16_t KT[64 * GLDS];
  bf16_t P[64 * GLDS];
  float dec[64];
  float tot[8][64];
  float ssq[8][64];
};
constexpr size_t WS_SLOC = 926 * MiB;
constexpr size_t WS_DTOT = 942 * MiB;
constexpr size_t WS_GVT = 604 * MiB;

struct GlaPtrs { const bf16_t *GQ, *GK, *GVT, *GR; const float *GLR, *wg, *bg, *gla_g; float *SLOC, *DTOT; bf16_t* MIX; };


constexpr size_t WS_GQT = 80 * MiB;
constexpr size_t WS_GKT = 113 * MiB;
constexpr size_t WS_GKTT = 146 * MiB;
constexpr size_t WS_GDEC = 179 * MiB;
constexpr size_t WS_GBL = 182 * MiB;
struct GlaPrepPtrs { const bf16_t *GQ, *GK; const float *GLR, *wg, *bg; bf16_t *QT, *KT, *KTT; float *DEC, *BL; };
DI void ph_gla_prep(int pair, char* smem, const GlaPrepPtrs& G) {
  const int tid = fresh_tid(), lane = tid & 63, w = tid >> 6, hb = w >> 2, w4 = w & 3;
  float (*tot)[64] = (float (*)[64])(smem + hb * 1024);
  const int item = 2 * pair + hb;
  const int bh = item / 129, c = item % 129, b = bh >> 2, hd = bh & 3, u0 = 64 * c;
  float wgr[16];
#pragma unroll
  for (int k = 0; k < 16; ++k) wgr[k] = G.wg[k * 256 + hd * 64 + lane];
  const float bgv = G.bg[hd * 64 + lane];
  float cs[16]; float run = 0.f;
  unsigned short kraw[16], qraw[16];
#pragma unroll
  for (int i = 0; i < 16; ++i) {
    const int u = u0 + 16 * w4 + i;
    kraw[i] = G.GK[((size_t)bh * GU + u) * 64 + lane];
    qraw[i] = G.GQ[((size_t)bh * GU + u) * 64 + lane];
  }
#pragma unroll
  for (int i = 0; i < 16; ++i) {
    const int u = u0 + 16 * w4 + i;
    float lgv = 0.f;
    if (u >= 48) {
      const f32x4* gp = (const f32x4*)(G.GLR + ((size_t)b * GU + u) * 16);
      const f32x4 g0 = gp[0], g1 = gp[1], g2 = gp[2], g3 = gp[3];
      float a = bgv;
      a += g0.x * wgr[0] + g0.y * wgr[1] + g0.z * wgr[2] + g0.w * wgr[3];
      a += g1.x * wgr[4] + g1.y * wgr[5] + g1.z * wgr[6] + g1.w * wgr[7];
      a += g2.x * wgr[8] + g2.y * wgr[9] + g2.z * wgr[10] + g2.w * wgr[11];
      a += g3.x * wgr[12] + g3.y * wgr[13] + g3.z * wgr[14] + g3.w * wgr[15];
      lgv = -softplus(-a) * (1.0f / 16.0f);
    }
    run += lgv; cs[i] = run;
  }
  tot[w4][lane] = run;
  __syncthreads();
  float offset = 0.f, total = 0.f;
#pragma unroll
  for (int s2 = 0; s2 < 4; ++s2) { const float tv = tot[s2][lane]; total += tv; if (s2 < w4) offset += tv; }
  const size_t cb = ((size_t)bh * 129 + c) * 4096;
  float kt[16];
#pragma unroll
  for (int i = 0; i < 16; ++i) {
    const float bc = offset + cs[i];
    kt[i] = bf2f(kraw[i]) * __expf(-bc);
    G.QT[cb + (16 * w4 + i) * 64 + lane] = (bf16_t)f2bf(bf2f(qraw[i]) * __expf(bc) * 0.125f);
    G.KT[cb + (16 * w4 + i) * 64 + lane] = (bf16_t)f2bf(kt[i]);
  }
  u32x4 kp; kp.x = pk2(kt[0], kt[1]); kp.y = pk2(kt[2], kt[3]); kp.z = pk2(kt[4], kt[5]); kp.w = pk2(kt[6], kt[7]);
  *(u32x4*)(G.KTT + cb + lane * 64 + 16 * w4) = kp;
  kp.x = pk2(kt[8], kt[9]); kp.y = pk2(kt[10], kt[11]); kp.z = pk2(kt[12], kt[13]); kp.w = pk2(kt[14], kt[15]);
  *(u32x4*)(G.KTT + cb + lane * 64 + 16 * w4 + 8) = kp;
  if (w4 == 0) { G.DEC[((size_t)bh * 129 + c) * 64 + lane] = __expf(total); G.BL[((size_t)bh * 129 + c) * 64 + lane] = total; }
  __syncthreads();
}

struct GlaBuf { bf16_t Qt[64 * GLDS]; bf16_t Kt[64 * GLDS]; bf16_t KT[64 * GLDS]; };
struct GlaLds3 { GlaBuf B[2]; bf16_t P[64 * GLDS]; float ssq[8][64]; };
struct GlaPtrs3 { const bf16_t *QT, *KT, *KTT, *GVT, *GR; const float *DEC, *BL, *gla_g; float *SLOC, *DTOT; bf16_t* MIX; };

template <int PASS>
DI void gla_item3(int bh, int sc, char* smem, const GlaPtrs3& G) {
  GlaLds3& L = *(GlaLds3*)smem;
  const int tid = fresh_tid(), lane = tid & 63, w = __builtin_amdgcn_readfirstlane(tid >> 6), c16 = lane & 15, q = lane >> 4;
  const int b = bh >> 2, hd = bh & 3;
  const int cbeg = sc == 0 ? 0 : 8 * sc + 1, cend = 8 * sc + 9;
  f32x4 X[4];
#pragma unroll
  for (int i = 0; i < 4; ++i) X[i] = (f32x4){0.f, 0.f, 0.f, 0.f};
  if (PASS == 1) {
#pragma unroll 4
    for (int j = 0; j < sc; ++j) {
      const float* dt = G.DTOT + (size_t)(bh * 16 + j) * 64;
      const float* sl = G.SLOC + ((size_t)(bh * 16 + j) * 8 + w) * 16 * 64 + lane;
#pragma unroll
      for (int i = 0; i < 4; ++i) {
        const f32x4 d4 = *(const f32x4*)(dt + 16 * i + 4 * q);
        X[i][0] = d4.x * X[i][0] + sl[(4 * i + 0) * 64]; X[i][1] = d4.y * X[i][1] + sl[(4 * i + 1) * 64];
        X[i][2] = d4.z * X[i][2] + sl[(4 * i + 2) * 64]; X[i][3] = d4.w * X[i][3] + sl[(4 * i + 3) * 64];
      }
    }
  }
  f32x4 gain = {1.f, 1.f, 1.f, 1.f};
  if (PASS == 1) gain = *(const f32x4*)(G.gla_g + hd * 128 + 16 * w + 4 * q);
  const bf16_t* gvt = G.GVT + ((size_t)bh * 128 + 16 * w + c16) * GU + 8 * q;
  const int srow = tid >> 3, sc8 = tid & 7, soff = srow * GLDS + sc8 * 8;
  const size_t cb0 = (size_t)bh * 129 * 4096 + (size_t)srow * 64 + sc8 * 8;
  u32x4 rq, rk, rkt, rq2, rk2, rkt2; bf16x8 vfr[2], vfn[2], vfn2[2]; f32x4 dec[4], decn[4], decn2[4];
  {
    const size_t cb = cb0 + (size_t)cbeg * 4096;
    rkt = *(const u32x4*)(G.KTT + cb);
    if (PASS == 1) { rq = *(const u32x4*)(G.QT + cb); rk = *(const u32x4*)(G.KT + cb); }
    vfr[0] = *(const bf16x8*)(gvt + 64 * cbeg); vfr[1] = *(const bf16x8*)(gvt + 64 * cbeg + 32);
#pragma unroll
    for (int i = 0; i < 4; ++i) dec[i] = *(const f32x4*)(G.DEC + ((size_t)bh * 129 + cbeg) * 64 + 16 * i + 4 * q);
    *(u32x4*)&L.B[0].KT[soff] = rkt;
    if (PASS == 1) { *(u32x4*)&L.B[0].Qt[soff] = rq; *(u32x4*)&L.B[0].Kt[soff] = rk; }
    const size_t cb1 = cb0 + (size_t)(cbeg + 1) * 4096;
    rkt = *(const u32x4*)(G.KTT + cb1);
    if (PASS == 1) { rq = *(const u32x4*)(G.QT + cb1); rk = *(const u32x4*)(G.KT + cb1); }
    vfn[0] = *(const bf16x8*)(gvt + 64 * (cbeg + 1)); vfn[1] = *(const bf16x8*)(gvt + 64 * (cbeg + 1) + 32);
#pragma unroll
    for (int i = 0; i < 4; ++i) decn[i] = *(const f32x4*)(G.DEC + ((size_t)bh * 129 + cbeg + 1) * 64 + 16 * i + 4 * q);
  }
  __syncthreads();
  for (int c = cbeg; c < cend; ++c) {
    const int cur = (c - cbeg) & 1;
    const GlaBuf& Bc = L.B[cur];
    const bool more = c + 1 < cend, more2 = c + 2 < cend;
    if (more2) {
      const size_t cb = cb0 + (size_t)(c + 2) * 4096;
      rkt2 = *(const u32x4*)(G.KTT + cb);
      if (PASS == 1) { rq2 = *(const u32x4*)(G.QT + cb); rk2 = *(const u32x4*)(G.KT + cb); }
      vfn2[0] = *(const bf16x8*)(gvt + 64 * (c + 2)); vfn2[1] = *(const bf16x8*)(gvt + 64 * (c + 2) + 32);
#pragma unroll
      for (int i = 0; i < 4; ++i) decn2[i] = *(const f32x4*)(G.DEC + ((size_t)bh * 129 + c + 2) * 64 + 16 * i + 4 * q);
    }
    u32x2 grv[4];
    if (PASS == 1 && c >= 1) {
#pragma unroll
      for (int n = 0; n < 4; ++n) grv[n] = *(const u32x2*)(G.GR + ((size_t)b * SEQ + 64 * (c - 1) + 16 * n + c16) * 512 + hd * 128 + 16 * w + 4 * q);
    }
    f32x4 OT[4];
    if (PASS == 1) {
      const int is = w >> 1;
#pragma unroll
      for (int z = 0; z < 2; ++z) {
        const int it = 2 * (w & 1) + z;
        f32x4 pa = {0.f, 0.f, 0.f, 0.f};
        if (is <= it) {
#pragma unroll
          for (int kk = 0; kk < 2; ++kk) {
            const bf16x8 ka = *(const bf16x8*)&Bc.Kt[(16 * is + c16) * GLDS + 32 * kk + 8 * q];
            const bf16x8 qb = *(const bf16x8*)&Bc.Qt[(16 * it + c16) * GLDS + 32 * kk + 8 * q];
            pa = MFMA16(ka, qb, pa);
          }
          if (is == it) {
#pragma unroll
            for (int r = 0; r < 4; ++r) if (4 * q + r > c16) pa[r] = 0.f;
          }
        }
        u32x2 pw; pw.x = pk2(pa[0], pa[1]); pw.y = pk2(pa[2], pa[3]);
        *(u32x2*)&L.P[(16 * it + c16) * GLDS + 16 * is + 4 * q] = pw;
      }
#pragma unroll
      for (int n = 0; n < 4; ++n) OT[n] = (f32x4){0.f, 0.f, 0.f, 0.f};
#pragma unroll
      for (int kk = 0; kk < 2; ++kk) {
        u32x4 xp; xp.x = pk2(X[2 * kk][0], X[2 * kk][1]); xp.y = pk2(X[2 * kk][2], X[2 * kk][3]);
        xp.z = pk2(X[2 * kk + 1][0], X[2 * kk + 1][1]); xp.w = pk2(X[2 * kk + 1][2], X[2 * kk + 1][3]);
        const bf16x8 xa = __builtin_bit_cast(bf16x8, xp);
#pragma unroll
        for (int n = 0; n < 4; ++n) {
          const u32x2 lo = *(const u32x2*)&Bc.Qt[(16 * n + c16) * GLDS + 32 * kk + 4 * q];
          const u32x2 hi = *(const u32x2*)&Bc.Qt[(16 * n + c16) * GLDS + 32 * kk + 16 + 4 * q];
          u32x4 qq; qq.x = lo.x; qq.y = lo.y; qq.z = hi.x; qq.w = hi.y;
          OT[n] = MFMA16(xa, __builtin_bit_cast(bf16x8, qq), OT[n]);
        }
      }
      __syncthreads();
#pragma unroll
      for (int kk = 0; kk < 2; ++kk)
#pragma unroll
        for (int n = 0; n < 4; ++n) {
          const bf16x8 pb = *(const bf16x8*)&L.P[(16 * n + c16) * GLDS + 32 * kk + 8 * q];
          OT[n] = MFMA16(vfr[kk], pb, OT[n]);
        }
    }
#pragma unroll
    for (int i = 0; i < 4; ++i) {
#pragma unroll
      for (int kk = 0; kk < 2; ++kk) {
        const bf16x8 ka = *(const bf16x8*)&Bc.KT[(16 * i + c16) * GLDS + 32 * kk + 8 * q];
        X[i] = MFMA16(ka, vfr[kk], X[i]);
      }
      X[i][0] *= dec[i].x; X[i][1] *= dec[i].y; X[i][2] *= dec[i].z; X[i][3] *= dec[i].w;
    }
    if (PASS == 1 && c >= 1) {
      float ss[4];
#pragma unroll
      for (int n = 0; n < 4; ++n) {
        float v = OT[n][0] * OT[n][0] + OT[n][1] * OT[n][1] + OT[n][2] * OT[n][2] + OT[n][3] * OT[n][3];
        v += __shfl_xor(v, 16); v += __shfl_xor(v, 32);
        ss[n] = v;
      }
      if (q == 0) {
#pragma unroll
        for (int n = 0; n < 4; ++n) L.ssq[w][16 * n + c16] = ss[n];
      }
      __syncthreads();
#pragma unroll
      for (int n = 0; n < 4; ++n) {
        float tot = 0.f;
#pragma unroll
        for (int w2 = 0; w2 < 8; ++w2) tot += L.ssq[w2][16 * n + c16];
        const float scl = rsqrtf(tot * (1.0f / 128.0f) + EPS);
        const size_t m = (size_t)b * SEQ + 64 * (c - 1) + 16 * n + c16;
        const float r0 = bflo(grv[n].x), r1 = bfhi(grv[n].x), r2 = bflo(grv[n].y), r3 = bfhi(grv[n].y);
        const float o0 = OT[n][0] * scl * gain.x * (r0 / (1.f + __expf(-r0)));
        const float o1 = OT[n][1] * scl * gain.y * (r1 / (1.f + __expf(-r1)));
        const float o2 = OT[n][2] * scl * gain.z * (r2 / (1.f + __expf(-r2)));
        const float o3 = OT[n][3] * scl * gain.w * (r3 / (1.f + __expf(-r3)));
        u32x2 ow; ow.x = pk2(o0, o1); ow.y = pk2(o2, o3);
        *(u32x2*)(G.MIX + m * D + 512 + hd * 128 + 16 * w + 4 * q) = ow;
      }
    }
    if (more) {
      GlaBuf& Bn = L.B[cur ^ 1];
      *(u32x4*)&Bn.KT[soff] = rkt;
      if (PASS == 1) { *(u32x4*)&Bn.Qt[soff] = rq; *(u32x4*)&Bn.Kt[soff] = rk; }
      vfr[0] = vfn[0]; vfr[1] = vfn[1];
#pragma unroll
      for (int i = 0; i < 4; ++i) dec[i] = decn[i];
      rkt = rkt2; rq = rq2; rk = rk2; vfn[0] = vfn2[0]; vfn[1] = vfn2[1];
#pragma unroll
      for (int i = 0; i < 4; ++i) decn[i] = decn2[i];
    }
    __syncthreads();
  }
  if (PASS == 0) {
    float* sl = G.SLOC + ((size_t)(bh * 16 + sc) * 8 + w) * 16 * 64 + lane;
#pragma unroll
    for (int i = 0; i < 4; ++i)
#pragma unroll
      for (int r = 0; r < 4; ++r) sl[(4 * i + r) * 64] = X[i][r];
    if (w == 0) {
      float bl = 0.f;
      for (int c = cbeg; c < cend; ++c) bl += G.BL[((size_t)bh * 129 + c) * 64 + lane];
      G.DTOT[(size_t)(bh * 16 + sc) * 64 + lane] = __expf(bl);
    }
  }
}


struct GlaLds4 { GlaBuf B[2]; bf16_t P[64 * GLDS]; float ssq[4][64]; };
template <int PASS>
DI void gla_item4(int bh_lo, int sc, char* smem, const GlaPtrs3& G) {
  const int tid = fresh_tid(), lane = tid & 63, w = __builtin_amdgcn_readfirstlane(tid >> 6), c16 = lane & 15, q = lane >> 4;
  const int hb = w >> 2, w4 = w & 3, tid4 = tid & 255;
  GlaLds4& L = *(GlaLds4*)(smem + hb * (int)sizeof(GlaLds4));
  const int bh = bh_lo + 16 * hb, b = bh >> 2, hd = bh & 3;
  const int cbeg = sc == 0 ? 0 : 8 * sc + 1, cend = 8 * sc + 9;
  f32x4 X[2][4];
#pragma unroll
  for (int et = 0; et < 2; ++et)
#pragma unroll
    for (int i = 0; i < 4; ++i) X[et][i] = (f32x4){0.f, 0.f, 0.f, 0.f};
  if (PASS == 1) {
#pragma unroll 2
    for (int j = 0; j < sc; ++j) {
      const float* dt = G.DTOT + (size_t)(bh * 16 + j) * 64;
#pragma unroll
      for (int et = 0; et < 2; ++et) {
        const float* sl = G.SLOC + ((size_t)(bh * 16 + j) * 8 + w4 * 2 + et) * 16 * 64 + lane;
#pragma unroll
        for (int i = 0; i < 4; ++i) {
          const f32x4 d4 = *(const f32x4*)(dt + 16 * i + 4 * q);
          X[et][i][0] = d4.x * X[et][i][0] + sl[(4 * i + 0) * 64]; X[et][i][1] = d4.y * X[et][i][1] + sl[(4 * i + 1) * 64];
          X[et][i][2] = d4.z * X[et][i][2] + sl[(4 * i + 2) * 64]; X[et][i][3] = d4.w * X[et][i][3] + sl[(4 * i + 3) * 64];
        }
      }
    }
  }
  f32x4 gain[2];
#pragma unroll
  for (int et = 0; et < 2; ++et) gain[et] = PASS == 1 ? *(const f32x4*)(G.gla_g + hd * 128 + 32 * w4 + 16 * et + 4 * q) : (f32x4){1.f, 1.f, 1.f, 1.f};
  const bf16_t* gvt0 = G.GVT + ((size_t)bh * 128 + 32 * w4 + c16) * GU + 8 * q;
  const bf16_t* gvt1 = gvt0 + (size_t)16 * GU;
  const int soffA = (tid4 >> 3) * GLDS + (tid4 & 7) * 8, soffB = soffA + 32 * GLDS;
  const size_t cb0 = (size_t)bh * 129 * 4096 + (size_t)(tid4 >> 3) * 64 + (tid4 & 7) * 8;
  u32x4 rq[2], rk[2], rkt[2], rq2[2], rk2[2], rkt2[2];
  bf16x8 vfr[2][2], vfn[2][2]; f32x4 dec[4], decn[4];
#define G4_LOADT(rq_, rk_, rkt_, c_) { const size_t cb_ = cb0 + (size_t)(c_) * 4096; \
    rkt_[0] = *(const u32x4*)(G.KTT + cb_); rkt_[1] = *(const u32x4*)(G.KTT + cb_ + 2048); \
    if (PASS == 1) { rq_[0] = *(const u32x4*)(G.QT + cb_); rq_[1] = *(const u32x4*)(G.QT + cb_ + 2048); rk_[0] = *(const u32x4*)(G.KT + cb_); rk_[1] = *(const u32x4*)(G.KT + cb_ + 2048); } }
#define G4_LOADV(vf_, dc_, c_) { vf_[0][0] = *(const bf16x8*)(gvt0 + 64 * (c_)); vf_[0][1] = *(const bf16x8*)(gvt0 + 64 * (c_) + 32); \
    vf_[1][0] = *(const bf16x8*)(gvt1 + 64 * (c_)); vf_[1][1] = *(const bf16x8*)(gvt1 + 64 * (c_) + 32); \
    _Pragma("unroll") for (int i = 0; i < 4; ++i) dc_[i] = *(const f32x4*)(G.DEC + ((size_t)bh * 129 + (c_)) * 64 + 16 * i + 4 * q); }
#define G4_STORET(Bn_, rq_, rk_, rkt_) { *(u32x4*)&Bn_.KT[soffA] = rkt_[0]; *(u32x4*)&Bn_.KT[soffB] = rkt_[1]; \
    if (PASS == 1) { *(u32x4*)&Bn_.Qt[soffA] = rq_[0]; *(u32x4*)&Bn_.Qt[soffB] = rq_[1]; *(u32x4*)&Bn_.Kt[soffA] = rk_[0]; *(u32x4*)&Bn_.Kt[soffB] = rk_[1]; } }
  G4_LOADT(rq, rk, rkt, cbeg)
  G4_LOADV(vfr, dec, cbeg)
  G4_STORET(L.B[0], rq, rk, rkt)
  G4_LOADT(rq, rk, rkt, cbeg + 1)
  G4_LOADV(vfn, decn, cbeg + 1)
  __syncthreads();
  for (int c = cbeg; c < cend; ++c) {
    const int cur = (c - cbeg) & 1;
    const GlaBuf& Bc = L.B[cur];
    const bool more = c + 1 < cend, more2 = c + 2 < cend;
    if (more2) G4_LOADT(rq2, rk2, rkt2, c + 2)
    u32x2 grv[2][4];
    if (PASS == 1 && c >= 1) {
#pragma unroll
      for (int et = 0; et < 2; ++et)
#pragma unroll
        for (int n = 0; n < 4; ++n) grv[et][n] = *(const u32x2*)(G.GR + ((size_t)b * SEQ + 64 * (c - 1) + 16 * n + c16) * 512 + hd * 128 + 32 * w4 + 16 * et + 4 * q);
    }
    f32x4 OT[2][4];
    if (PASS == 1) {
      const int is = w4;
#pragma unroll
      for (int it = 0; it < 4; ++it) {
        f32x4 pa = {0.f, 0.f, 0.f, 0.f};
        if (is <= it) {
#pragma unroll
          for (int kk = 0; kk < 2; ++kk) {
            const bf16x8 ka = *(const bf16x8*)&Bc.Kt[(16 * is + c16) * GLDS + 32 * kk + 8 * q];
            const bf16x8 qb = *(const bf16x8*)&Bc.Qt[(16 * it + c16) * GLDS + 32 * kk + 8 * q];
            pa = MFMA16(ka, qb, pa);
          }
          if (is == it) {
#pragma unroll
            for (int r = 0; r < 4; ++r) if (4 * q + r > c16) pa[r] = 0.f;
          }
        }
        u32x2 pw; pw.x = pk2(pa[0], pa[1]); pw.y = pk2(pa[2], pa[3]);
        *(u32x2*)&L.P[(16 * it + c16) * GLDS + 16 * is + 4 * q] = pw;
      }
#pragma unroll
      for (int et = 0; et < 2; ++et)
#pragma unroll
        for (int n = 0; n < 4; ++n) OT[et][n] = (f32x4){0.f, 0.f, 0.f, 0.f};
#pragma unroll
      for (int kk = 0; kk < 2; ++kk) {
        bf16x8 xa[2];
#pragma unroll
        for (int et = 0; et < 2; ++et) {
          u32x4 xp; xp.x = pk2(X[et][2 * kk][0], X[et][2 * kk][1]); xp.y = pk2(X[et][2 * kk][2], X[et][2 * kk][3]);
          xp.z = pk2(X[et][2 * kk + 1][0], X[et][2 * kk + 1][1]); xp.w = pk2(X[et][2 * kk + 1][2], X[et][2 * kk + 1][3]);
          xa[et] = __builtin_bit_cast(bf16x8, xp);
        }
#pragma unroll
        for (int n = 0; n < 4; ++n) {
          const u32x2 lo = *(const u32x2*)&Bc.Qt[(16 * n + c16) * GLDS + 32 * kk + 4 * q];
          const u32x2 hi = *(const u32x2*)&Bc.Qt[(16 * n + c16) * GLDS + 32 * kk + 16 + 4 * q];
          u32x4 qq; qq.x = lo.x; qq.y = lo.y; qq.z = hi.x; qq.w = hi.y;
          const bf16x8 qf = __builtin_bit_cast(bf16x8, qq);
          OT[0][n] = MFMA16(xa[0], qf, OT[0][n]);
          OT[1][n] = MFMA16(xa[1], qf, OT[1][n]);
        }
      }
      __syncthreads();
#pragma unroll
      for (int kk = 0; kk < 2; ++kk)
#pragma unroll
        for (int n = 0; n < 4; ++n) {
          const bf16x8 pb = *(const bf16x8*)&L.P[(16 * n + c16) * GLDS + 32 * kk + 8 * q];
          OT[0][n] = MFMA16(vfr[0][kk], pb, OT[0][n]);
          OT[1][n] = MFMA16(vfr[1][kk], pb, OT[1][n]);
        }
    }
#pragma unroll
    for (int i = 0; i < 4; ++i) {
#pragma unroll
      for (int kk = 0; kk < 2; ++kk) {
        const bf16x8 ka = *(const bf16x8*)&Bc.KT[(16 * i + c16) * GLDS + 32 * kk + 8 * q];
        X[0][i] = MFMA16(ka, vfr[0][kk], X[0][i]);
        X[1][i] = MFMA16(ka, vfr[1][kk], X[1][i]);
      }
#pragma unroll
      for (int et = 0; et < 2; ++et) { X[et][i][0] *= dec[i].x; X[et][i][1] *= dec[i].y; X[et][i][2] *= dec[i].z; X[et][i][3] *= dec[i].w; }
    }
    if (PASS == 1 && c >= 1) {
      float ss[4];
#pragma unroll
      for (int n = 0; n < 4; ++n) {
        float v = OT[0][n][0] * OT[0][n][0] + OT[0][n][1] * OT[0][n][1] + OT[0][n][2] * OT[0][n][2] + OT[0][n][3] * OT[0][n][3]
                + OT[1][n][0] * OT[1][n][0] + OT[1][n][1] * OT[1][n][1] + OT[1][n][2] * OT[1][n][2] + OT[1][n][3] * OT[1][n][3];
        v += __shfl_xor(v, 16); v += __shfl_xor(v, 32);
        ss[n] = v;
      }
      if (q == 0) {
#pragma unroll
        for (int n = 0; n < 4; ++n) L.ssq[w4][16 * n + c16] = ss[n];
      }
      __syncthreads();
#pragma unroll
      for (int n = 0; n < 4; ++n) {
        const float tot = L.ssq[0][16 * n + c16] + L.ssq[1][16 * n + c16] + L.ssq[2][16 * n + c16] + L.ssq[3][16 * n + c16];
        const float scl = rsqrtf(tot * (1.0f / 128.0f) + EPS);
        const size_t m = (size_t)b * SEQ + 64 * (c - 1) + 16 * n + c16;
#pragma unroll
        for (int et = 0; et < 2; ++et) {
          const float r0 = bflo(grv[et][n].x), r1 = bfhi(grv[et][n].x), r2 = bflo(grv[et][n].y), r3 = bfhi(grv[et][n].y);
          const float o0 = OT[et][n][0] * scl * gain[et].x * r0 * __builtin_amdgcn_rcpf(1.f + __expf(-r0));
          const float o1 = OT[et][n][1] * scl * gain[et].y * r1 * __builtin_amdgcn_rcpf(1.f + __expf(-r1));
          const float o2 = OT[et][n][2] * scl * gain[et].z * r2 * __builtin_amdgcn_rcpf(1.f + __expf(-r2));
          const float o3 = OT[et][n][3] * scl * gain[et].w * r3 * __builtin_amdgcn_rcpf(1.f + __expf(-r3));
          u32x2 ow; ow.x = pk2(o0, o1); ow.y = pk2(o2, o3);
          *(u32x2*)(G.MIX + m * D + 512 + hd * 128 + 32 * w4 + 16 * et + 4 * q) = ow;
        }
      }
    }
    if (more) {
      GlaBuf& Bn = L.B[cur ^ 1];
      G4_STORET(Bn, rq, rk, rkt)
#pragma unroll
      for (int et = 0; et < 2; ++et) { vfr[et][0] = vfn[et][0]; vfr[et][1] = vfn[et][1]; }
#pragma unroll
      for (int i = 0; i < 4; ++i) dec[i] = decn[i];
#pragma unroll
      for (int z = 0; z < 2; ++z) { rkt[z] = rkt2[z]; rq[z] = rq2[z]; rk[z] = rk2[z]; }
      if (more2) G4_LOADV(vfn, decn, c + 2)
    }
    __syncthreads();
  }
#undef G4_LOADT
#undef G4_LOADV
#undef G4_STORET
  if (PASS == 0) {
#pragma unroll
    for (int et = 0; et < 2; ++et) {
      float* sl = G.SLOC + ((size_t)(bh * 16 + sc) * 8 + w4 * 2 + et) * 16 * 64 + lane;
#pragma unroll
      for (int i = 0; i < 4; ++i)
#pragma unroll
        for (int r = 0; r < 4; ++r) sl[(4 * i + r) * 64] = X[et][i][r];
    }
    if (w4 == 0) {
      float bl = 0.f;
      for (int c = cbeg; c < cend; ++c) bl += G.BL[((size_t)bh * 129 + c) * 64 + lane];
      G.DTOT[(size_t)(bh * 16 + sc) * 64 + lane] = __expf(bl);
    }
  }
}

DI void ce_desc(float& a, float& b) {
  const float hi = __builtin_fmaxf(a, b), lo = __builtin_fminf(a, b);
  a = hi; b = lo;
}
DI float vmaxf(float a, float b) { return __builtin_fmaxf(a, b); }
template <int N> DI void bitonic_sort_desc(float (&v)[N]) {
#pragma unroll
  for (int k = 2; k <= N; k <<= 1) {
#pragma unroll
    for (int j = k >> 1; j > 0; j >>= 1) {
#pragma unroll
      for (int i = 0; i < N; ++i) {
        const int l = i ^ j;
        if (l > i) { if ((i & k) == 0) ce_desc(v[i], v[l]); else ce_desc(v[l], v[i]); }
      }
    }
  }
}
DI void bitonic_merge16_desc(float (&v)[16]) {
#pragma unroll
  for (int j = 8; j > 0; j >>= 1) {
#pragma unroll
    for (int i = 0; i < 16; ++i) { const int l = i ^ j; if (l > i) ce_desc(v[i], v[l]); }
  }
}
template <int NBV> DI void merge_prune16(float (&a)[16], const float (&b)[16]) {
#pragma unroll
  for (int i = 16 - NBV; i < 16; ++i) a[i] = vmaxf(a[i], b[15 - i]);
  bitonic_merge16_desc(a);
}
DI float selh(int hh, float a, float b) { asm volatile("" : "+v"(a), "+v"(b)); return hh == 0 ? a : b; }
DI float pack_idx(float v, unsigned idx, unsigned mask) { return __uint_as_float((__float_as_uint(v) & ~mask) | idx); }

DI void ph_route_v2(int vb, char* smem, const bf16_t* __restrict__ QP, const bf16_t* __restrict__ SK1b, const bf16_t* __restrict__ SK2b,
                    unsigned short* __restrict__ EIDX, float* __restrict__ GATE) {
  const int tid256_ = fresh_tid() & 255;
  const int lane = TID & 63, wave = TID >> 6, r = lane & 31, hh = lane >> 5;
  const int hd = vb & 7, tile = vb >> 3;
  const int m = tile * 128 + wave * 32 + r;
  float loc[2][16];
#pragma unroll
  for (int L = 0; L < 2; ++L) {
    const bf16_t* qp = QP + (size_t)m * D + hd * 128 + L * 64 + hh * 8;
    const bf16_t* kb = (L == 0 ? SK1b : SK2b) + (size_t)(hd * 128 + r) * 64 + hh * 8;
    bf16x8 qf[4];
#pragma unroll
    for (int ks = 0; ks < 4; ++ks) qf[ks] = *(const bf16x8*)(qp + ks * 16);
    float grp[4][16];
#pragma unroll
    for (int mt = 0; mt < 4; ++mt) {
      f32x16 acc;
#pragma unroll
      for (int e = 0; e < 16; ++e) acc[e] = 0.f;
#pragma unroll
      for (int ks = 0; ks < 4; ++ks) {
        const bf16x8 kf = *(const bf16x8*)(kb + (size_t)mt * 32 * 64 + ks * 16);
        acc = MFMA32(kf, qf[ks], acc);
      }
#pragma unroll
      for (int e = 0; e < 16; ++e) grp[mt][e] = pack_idx(acc[e], (unsigned)(mt * 32 + crow(e, hh)), 127u);
      bitonic_sort_desc<16>(grp[mt]);
    }
    merge_prune16<16>(grp[0], grp[1]);
    merge_prune16<16>(grp[2], grp[3]);
    merge_prune16<16>(grp[0], grp[2]);
#pragma unroll
    for (int i = 0; i < 16; ++i) loc[L][i] = grp[0][i];
  }
  float fin[16], oth[16];
#pragma unroll
  for (int i = 0; i < 16; ++i) {
    const float send = selh(hh, loc[1][i], loc[0][i]);
    oth[i] = __shfl_xor(send, 32);
    fin[i] = selh(hh, loc[0][i], loc[1][i]);
  }
  merge_prune16<16>(fin, oth);
  float v1[16], v2[16];
#pragma unroll
  for (int i = 0; i < 16; ++i) {
    const float o = __shfl_xor(fin[i], 32);
    v1[i] = selh(hh, fin[i], o);
    v2[i] = selh(hh, o, fin[i]);
  }
  unsigned* ib = (unsigned*)smem + (size_t)TID * 8;
#pragma unroll
  for (int q = 0; q < 4; ++q) {
    unsigned w1 = 0, w2 = 0;
#pragma unroll
    for (int j = 0; j < 4; ++j) {
      w1 |= (__float_as_uint(v1[4 * q + j]) & 127u) << (8 * j);
      w2 |= (__float_as_uint(v2[4 * q + j]) & 127u) << (8 * j);
    }
    ib[q] = w1; ib[4 + q] = w2;
  }
  float R[16], Bv[16];
#pragma unroll
  for (int j = 0; j < 16; ++j) R[j] = pack_idx(v1[0] + v2[j], (unsigned)j, 255u);
#define ROUTE_ROW(I, CNT) { _Pragma("unroll") for (int j = 0; j < 16; ++j) Bv[j] = (j < CNT) ? pack_idx(v1[I] + v2[j < CNT ? j : 0], (unsigned)(I * 16 + j), 255u) : 0.f; \
    merge_prune16<CNT>(R, Bv); }
  ROUTE_ROW(1, 8) ROUTE_ROW(2, 5) ROUTE_ROW(3, 4) ROUTE_ROW(4, 3) ROUTE_ROW(5, 2) ROUTE_ROW(6, 2) ROUTE_ROW(7, 2)
#undef ROUTE_ROW
#pragma unroll
  for (int j = 0; j < 16; ++j) Bv[j] = (j < 8) ? pack_idx(v1[8 + (j < 8 ? j : 0)] + v2[0], (unsigned)((8 + j) * 16), 255u) : 0.f;
  merge_prune16<8>(R, Bv);
  float ex[16], sum = 0.f;
#pragma unroll
  for (int i = 0; i < 16; ++i) { ex[i] = __expf(R[i] - R[0]); sum += ex[i]; }
  const float inv = 1.f / sum;
  const unsigned char* ibb = (const unsigned char*)ib;
  int eo[8]; float go[8];
#pragma unroll
  for (int w = 0; w < 8; ++w) {
    const float rv = selh(hh, R[w], R[8 + w]);
    const float ev = selh(hh, ex[w], ex[8 + w]);
    const unsigned pos = __float_as_uint(rv) & 255u;
    const unsigned i1 = ibb[pos >> 4], i2 = ibb[16 + (pos & 15u)];
    eo[w] = (int)(i1 * 128u + i2);
    go[w] = ev * inv;
  }
  unsigned short* ep = EIDX + (size_t)m * 128 + hd * 16 + hh * 8;
  float* gp = GATE + (size_t)m * 128 + hd * 16 + hh * 8;
  *(u32x4*)ep = (u32x4){(unsigned)eo[0] | ((unsigned)eo[1] << 16), (unsigned)eo[2] | ((unsigned)eo[3] << 16), (unsigned)eo[4] | ((unsigned)eo[5] << 16), (unsigned)eo[6] | ((unsigned)eo[7] << 16)};
  *(f32x4*)gp = (f32x4){go[0], go[1], go[2], go[3]};
  *(f32x4*)(gp + 4) = (f32x4){go[4], go[5], go[6], go[7]};
}


typedef unsigned char u8_t;
constexpr size_t WS_SCU = 14 * MiB;
constexpr size_t WS_SCV = 14 * MiB + 65536;
DI float wave_max(float v) {
#pragma unroll
  for (int o = 32; o >= 1; o >>= 1) v = fmaxf(v, __shfl_xor(v, o));
  return v;
}
DI u32x4 quant_row16(const float* __restrict__ rowp, int lane, float& sc) {
  const f32x4* rp = (const f32x4*)(rowp + lane * 16);
  const f32x4 a = rp[0], b = rp[1], c = rp[2], d = rp[3];
  float m = fmaxf(fmaxf(fmaxf(fabsf(a.x), fabsf(a.y)), fmaxf(fabsf(a.z), fabsf(a.w))), fmaxf(fmaxf(fabsf(b.x), fabsf(b.y)), fmaxf(fabsf(b.z), fabsf(b.w))));
  m = fmaxf(m, fmaxf(fmaxf(fmaxf(fabsf(c.x), fabsf(c.y)), fmaxf(fabsf(c.z), fabsf(c.w))), fmaxf(fmaxf(fabsf(d.x), fabsf(d.y)), fmaxf(fabsf(d.z), fabsf(d.w)))));
  m = wave_max(m);
  sc = m > 0.f ? m * (1.0f / 448.0f) : 1.0f;
  const float inv = 1.0f / sc;
  u32x4 o; unsigned w;
  w = 0; w = __builtin_amdgcn_cvt_pk_fp8_f32(a.x * inv, a.y * inv, w, false); w = __builtin_amdgcn_cvt_pk_fp8_f32(a.z * inv, a.w * inv, w, true); o.x = w;
  w = 0; w = __builtin_amdgcn_cvt_pk_fp8_f32(b.x * inv, b.y * inv, w, false); w = __builtin_amdgcn_cvt_pk_fp8_f32(b.z * inv, b.w * inv, w, true); o.y = w;
  w = 0; w = __builtin_amdgcn_cvt_pk_fp8_f32(c.x * inv, c.y * inv, w, false); w = __builtin_amdgcn_cvt_pk_fp8_f32(c.z * inv, c.w * inv, w, true); o.z = w;
  w = 0; w = __builtin_amdgcn_cvt_pk_fp8_f32(d.x * inv, d.y * inv, w, false); w = __builtin_amdgcn_cvt_pk_fp8_f32(d.z * inv, d.w * inv, w, true); o.w = w;
  return o;
}
DI void ph_convert_ev8(int vb, char* smem, const float* __restrict__ src, u8_t* __restrict__ EV8c, float* __restrict__ scaleV) {
  const int tid256_ = fresh_tid() & 255;
  u8_t (*t)[1040] = (u8_t (*)[1040])smem;
  const int lane = TID & 63, wave = TID >> 6, e0 = vb * 32;
  for (int rr = 0; rr < 8; ++rr) {
    const int r = wave * 8 + rr;
    float sc;
    const u32x4 o = quant_row16(src + (size_t)(e0 + r) * D, lane, sc);
    *(u32x4*)&t[r][lane * 16] = o;
    if (lane == 0) scaleV[e0 + r] = sc;
  }
  __syncthreads();
  const int r = TID & 31, cs = TID >> 5;
  for (int c0 = 0; c0 < 128; c0 += 8) {
    const int cg = c0 + cs;
    const u32x2 v = *(const u32x2*)&t[r][cg * 8];
    *(u32x2*)(EV8c + ((size_t)cg * NEXP + e0 + r) * 8) = v;
  }
  __syncthreads();
}
struct PeerUHalf { u32x4 u[8]; };
DI void ph_peer_c8(int unit, char* smem, const bf16_t* __restrict__ PP, const unsigned short* __restrict__ EIDX, const float* __restrict__ GATE,
                   const float* __restrict__ scaleU, const float* __restrict__ scaleV, unsigned* __restrict__ STREAM) {
  unsigned (*tile)[132] = (unsigned (*)[132])smem;
  const int tid = fresh_tid();
  const int tl = tid >> 3, kc = tid & 7;
  const size_t rowoff = ((size_t)unit * 64 + tl) * 128 + kc * 16;
  const size_t n = (size_t)TREAL * 128;
  float a[16];
#pragma unroll
  for (int j = 0; j < 16; ++j) a[j] = 0.f;
#pragma unroll
  for (int s = 0; s < 8; ++s) {
    const u32x4 p0 = *(const u32x4*)(PP + (size_t)s * n + rowoff), p1 = *(const u32x4*)(PP + (size_t)s * n + rowoff + 8);
    a[0] += bflo(p0.x); a[1] += bfhi(p0.x); a[2] += bflo(p0.y); a[3] += bfhi(p0.y); a[4] += bflo(p0.z); a[5] += bfhi(p0.z); a[6] += bflo(p0.w); a[7] += bfhi(p0.w);
    a[8] += bflo(p1.x); a[9] += bfhi(p1.x); a[10] += bflo(p1.y); a[11] += bfhi(p1.y); a[12] += bflo(p1.z); a[13] += bfhi(p1.z); a[14] += bflo(p1.w); a[15] += bfhi(p1.w);
  }
  const u32x4 e0 = *(const u32x4*)(EIDX + rowoff), e1 = *(const u32x4*)(EIDX + rowoff + 8);
  unsigned ev[16] = {e0.x & 0xffffu, e0.x >> 16, e0.y & 0xffffu, e0.y >> 16, e0.z & 0xffffu, e0.z >> 16, e0.w & 0xffffu, e0.w >> 16,
                     e1.x & 0xffffu, e1.x >> 16, e1.y & 0xffffu, e1.y >> 16, e1.z & 0xffffu, e1.z >> 16, e1.w & 0xffffu, e1.w >> 16};
  float gt[16];
#pragma unroll
  for (int j = 0; j < 4; ++j) { const f32x4 g4 = *(const f32x4*)(GATE + rowoff + 4 * j); gt[4 * j] = g4.x; gt[4 * j + 1] = g4.y; gt[4 * j + 2] = g4.z; gt[4 * j + 3] = g4.w; }
#pragma unroll
  for (int j = 0; j < 16; ++j) {
    const unsigned e = ev[j];
    const float av = a[j] * scaleU[e];
    const float act = 0.5f * av * (1.f + erff(av * 0.70710678118654752f));
    const float c = gt[j] * act * scaleV[e];
    tile[tl][kc * 16 + j] = e | (f2bf(c) << 16);
  }
  __syncthreads();
  unsigned* outp = STREAM + (size_t)unit * 8192;
#pragma unroll 4
  for (int j = 0; j < 16; ++j) {
    const int o = tid + 512 * j, q = o >> 8, t2 = (o >> 2) & 63, z = o & 3;
    outp[o] = tile[t2][4 * q + z];
  }
  __syncthreads();
}
struct PVW { u32x4 a, b; };
struct PVT { u32x2 v[8]; };
DI void pv_loadw(PVW& W, const unsigned* __restrict__ STREAM, int it, int g, int lane) {
  const u32x4* sp = (const u32x4*)(STREAM + (size_t)it * 8192) + lane;
  W.a = sp[(2 * g) * 64]; W.b = sp[(2 * g + 1) * 64];
}
DI void pv_readt(PVT& T, const PVW& W, const u32x2* tabl) {
  T.v[0] = tabl[W.a.x & 0xffffu]; T.v[1] = tabl[W.a.y & 0xffffu]; T.v[2] = tabl[W.a.z & 0xffffu]; T.v[3] = tabl[W.a.w & 0xffffu];
  T.v[4] = tabl[W.b.x & 0xffffu]; T.v[5] = tabl[W.b.y & 0xffffu]; T.v[6] = tabl[W.b.z & 0xffffu]; T.v[7] = tabl[W.b.w & 0xffffu];
}
DI void pv_fma1(unsigned w, const u32x2 v, f32x2 (&y)[4]) {
  const float c = bfhi(w);
  const f32x2 cc = {c, c};
  y[0] = __builtin_elementwise_fma(__builtin_amdgcn_cvt_pk_f32_fp8(v.x, false), cc, y[0]);
  y[1] = __builtin_elementwise_fma(__builtin_amdgcn_cvt_pk_f32_fp8(v.x, true), cc, y[1]);
  y[2] = __builtin_elementwise_fma(__builtin_amdgcn_cvt_pk_f32_fp8(v.y, false), cc, y[2]);
  y[3] = __builtin_elementwise_fma(__builtin_amdgcn_cvt_pk_f32_fp8(v.y, true), cc, y[3]);
}
DI void pv_fma(const PVW& W, const PVT& T, f32x2 (&y)[4]) {
  pv_fma1(W.a.x, T.v[0], y); pv_fma1(W.a.y, T.v[1], y); pv_fma1(W.a.z, T.v[2], y); pv_fma1(W.a.w, T.v[3], y);
  pv_fma1(W.b.x, T.v[4], y); pv_fma1(W.b.y, T.v[5], y); pv_fma1(W.b.z, T.v[6], y); pv_fma1(W.b.w, T.v[7], y);
}
DI void ph_peer_v8(char* smem, const unsigned* __restrict__ STREAM, const u8_t* __restrict__ EV8c, bf16_t* __restrict__ YT) {
  const int tid = fresh_tid(), lane = tid & 63, wave = tid >> 6;
  const u32x2* tabl = (const u32x2*)smem;
  for (int unit = blockIdx.x; unit < 256; unit += gridDim.x) {
    const int cg = unit & 127, th = unit >> 7;
    const u32x4* src = (const u32x4*)(EV8c + (size_t)cg * NEXP * 8);
#pragma unroll 4
    for (int i = tid; i < NEXP * 8 / 16; i += 512) ((u32x4*)smem)[i] = src[i];
    __syncthreads();
    const int it_end = th * 512 + 512;
    int it = th * 512 + wave;
    PVW W0, W1, W2, W3; PVT T0, T1;
    pv_loadw(W0, STREAM, it, 0, lane); pv_loadw(W1, STREAM, it, 1, lane);
    pv_readt(T0, W0, tabl);
    for (; it < it_end; it += 8) {
      const int itn = (it + 8 < it_end) ? it + 8 : it;
      f32x2 y[4];
#pragma unroll
      for (int z = 0; z < 4; ++z) y[z] = (f32x2){0.f, 0.f};
#define PV_STEP(g, Wld, Wrd, Trd, Wc, Tc) \
      pv_loadw(Wld, STREAM, ((g) + 2 < 16) ? it : itn, ((g) + 2) & 15, lane); \
      pv_readt(Trd, Wrd, tabl); \
      pv_fma(Wc, Tc, y); \
      asm volatile("" ::: "memory");
      PV_STEP(0, W2, W1, T1, W0, T0)  PV_STEP(1, W3, W2, T0, W1, T1)  PV_STEP(2, W0, W3, T1, W2, T0)  PV_STEP(3, W1, W0, T0, W3, T1)
      PV_STEP(4, W2, W1, T1, W0, T0)  PV_STEP(5, W3, W2, T0, W1, T1)  PV_STEP(6, W0, W3, T1, W2, T0)  PV_STEP(7, W1, W0, T0, W3, T1)
      PV_STEP(8, W2, W1, T1, W0, T0)  PV_STEP(9, W3, W2, T0, W1, T1)  PV_STEP(10, W0, W3, T1, W2, T0) PV_STEP(11, W1, W0, T0, W3, T1)
      PV_STEP(12, W2, W1, T1, W0, T0) PV_STEP(13, W3, W2, T0, W1, T1) PV_STEP(14, W0, W3, T1, W2, T0) PV_STEP(15, W1, W0, T0, W3, T1)
#undef PV_STEP
      const int t = it * 64 + lane;
      u32x4 yw; yw.x = pk2(y[0].x, y[0].y); yw.y = pk2(y[1].x, y[1].y); yw.z = pk2(y[2].x, y[2].y); yw.w = pk2(y[3].x, y[3].y);
      *(u32x4*)(YT + ((size_t)cg * TREAL + t) * 8) = yw;
    }
    __syncthreads();
  }
}


DI void ph_final_lds(int unit, char* smem, const bf16_t* __restrict__ H1, const bf16_t* __restrict__ YT, const float* __restrict__ gf, float* __restrict__ out) {
  float (*h2)[1028] = (float (*)[1028])smem;
  const int tid = fresh_tid(), lane = tid & 63, wave = tid >> 6;
  const int t0 = unit * 32;
#pragma unroll
  for (int rr = 0; rr < 4; ++rr) {
    const int r = wave * 4 + rr;
    const bf16_t* hp = H1 + (size_t)(t0 + r) * D;
#pragma unroll
    for (int j = 0; j < 2; ++j) {
      const u32x4 hw = *(const u32x4*)(hp + j * 512 + lane * 8);
      *(f32x4*)&h2[r][j * 512 + lane * 8] = (f32x4){bflo(hw.x), bfhi(hw.x), bflo(hw.y), bfhi(hw.y)};
      *(f32x4*)&h2[r][j * 512 + lane * 8 + 4] = (f32x4){bflo(hw.z), bfhi(hw.z), bflo(hw.w), bfhi(hw.w)};
    }
  }
  __syncthreads();
  {
    const int tok = lane & 31;
#pragma unroll 4
    for (int cg = wave * 2 + (lane >> 5); cg < 128; cg += 16) {
      const u32x4 yw = *(const u32x4*)(YT + ((size_t)cg * TREAL + t0 + tok) * 8);
      f32x4* hp = (f32x4*)&h2[tok][cg * 8];
      f32x4 a = hp[0], b4 = hp[1];
      a.x += bflo(yw.x); a.y += bfhi(yw.x); a.z += bflo(yw.y); a.w += bfhi(yw.y);
      b4.x += bflo(yw.z); b4.y += bfhi(yw.z); b4.z += bflo(yw.w); b4.w += bfhi(yw.w);
      hp[0] = a; hp[1] = b4;
    }
  }
  __syncthreads();
#pragma unroll
  for (int rr = 0; rr < 4; ++rr) {
    const int r = wave * 4 + rr;
    f32x4 v[4]; float ss = 0.f;
#pragma unroll
    for (int j = 0; j < 4; ++j) { v[j] = *(const f32x4*)&h2[r][j * 256 + lane * 4]; ss += v[j].x * v[j].x + v[j].y * v[j].y + v[j].z * v[j].z + v[j].w * v[j].w; }
    ss = wave_sum(ss);
    const float sc = rsqrtf(ss * (1.0f / D) + EPS);
    float* op = out + (size_t)(t0 + r) * D;
#pragma unroll
    for (int j = 0; j < 4; ++j) {
      const f32x4 gg = *(const f32x4*)(gf + j * 256 + lane * 4);
      *(f32x4*)(op + j * 256 + lane * 4) = (f32x4){v[j].x * sc * gg.x, v[j].y * sc * gg.y, v[j].z * sc * gg.z, v[j].w * sc * gg.w};
    }
  }
  __syncthreads();
}

typedef int i32x4 __attribute__((ext_vector_type(4)));
constexpr size_t WS_XQ = 861 * MiB;
constexpr size_t WS_XS = 943 * MiB;
DI unsigned pack_i8x4(float a, float b, float c, float d) {
  const int ia = __float2int_rn(a), ib = __float2int_rn(b), ic = __float2int_rn(c), id = __float2int_rn(d);
  return ((unsigned)ia & 255u) | (((unsigned)ib & 255u) << 8) | (((unsigned)ic & 255u) << 16) | ((unsigned)id << 24);
}
DI u32x4 quant_row16_i8(const float* __restrict__ rowp, int lane, float& sc) {
  const f32x4* rp = (const f32x4*)(rowp + lane * 16);
  const f32x4 a = rp[0], b = rp[1], c = rp[2], d = rp[3];
  float m = fmaxf(fmaxf(fmaxf(fabsf(a.x), fabsf(a.y)), fmaxf(fabsf(a.z), fabsf(a.w))), fmaxf(fmaxf(fabsf(b.x), fabsf(b.y)), fmaxf(fabsf(b.z), fabsf(b.w))));
  m = fmaxf(m, fmaxf(fmaxf(fmaxf(fabsf(c.x), fabsf(c.y)), fmaxf(fabsf(c.z), fabsf(c.w))), fmaxf(fmaxf(fabsf(d.x), fabsf(d.y)), fmaxf(fabsf(d.z), fabsf(d.w)))));
  m = wave_max(m);
  sc = m > 0.f ? m * (1.0f / 127.0f) : 1.0f;
  const float inv = 1.0f / sc;
  u32x4 o;
  o.x = pack_i8x4(a.x * inv, a.y * inv, a.z * inv, a.w * inv); o.y = pack_i8x4(b.x * inv, b.y * inv, b.z * inv, b.w * inv);
  o.z = pack_i8x4(c.x * inv, c.y * inv, c.z * inv, c.w * inv); o.w = pack_i8x4(d.x * inv, d.y * inv, d.z * inv, d.w * inv);
  return o;
}
DI void ph_convert_eu_i8(const float* __restrict__ src, u8_t* __restrict__ EUq, float* __restrict__ scaleU) {
  const int tid = fresh_tid(), lane = tid & 63, wave = tid >> 6;
  for (int e = (blockIdx.x * 8 + wave) * 2; e < NEXP; e += gridDim.x * 16) {
    float sc0, sc1 = 1.f;
    const bool two = e + 1 < NEXP;
    const u32x4 o0 = quant_row16_i8(src + (size_t)e * D, lane, sc0);
    u32x4 o1 = o0;
    if (two) o1 = quant_row16_i8(src + (size_t)(e + 1) * D, lane, sc1);
    *(u32x4*)(EUq + ((size_t)(lane >> 3) * NEXP + e) * 128 + (lane & 7) * 16) = o0;
    if (two) *(u32x4*)(EUq + ((size_t)(lane >> 3) * NEXP + e + 1) * 128 + (lane & 7) * 16) = o1;
    if (lane == 0) { scaleU[e] = sc0; if (two) scaleU[e + 1] = sc1; }
  }
}
DI void ph_norm2_rows(int vb, const bf16_t* __restrict__ src, const float* __restrict__ gain, float* __restrict__ R2, u8_t* __restrict__ XQ, float* __restrict__ XS) {
  const int tid256_ = fresh_tid() & 255;
  const int row0 = vb * 16 + (TID >> 6) * 4, lane = TID & 63;
  u32x2 raw[4][4];
#pragma unroll
  for (int rr = 0; rr < 4; ++rr)
#pragma unroll
    for (int j = 0; j < 4; ++j) raw[rr][j] = *(const u32x2*)(src + (size_t)(row0 + rr) * D + j * 256 + lane * 4);
  f32x4 gg[4];
#pragma unroll
  for (int j = 0; j < 4; ++j) gg[j] = *(const f32x4*)(gain + j * 256 + lane * 4);
#pragma unroll
  for (int rr = 0; rr < 4; ++rr) {
    f32x4 v[4]; float ss = 0.f;
#pragma unroll
    for (int j = 0; j < 4; ++j) {
      v[j] = (f32x4){bflo(raw[rr][j].x), bfhi(raw[rr][j].x), bflo(raw[rr][j].y), bfhi(raw[rr][j].y)};
      ss += v[j].x * v[j].x + v[j].y * v[j].y + v[j].z * v[j].z + v[j].w * v[j].w;
    }
    ss = wave_sum(ss);
    const float r = rsqrtf(ss * (1.0f / D) + EPS);
    if (lane == 0) R2[row0 + rr] = r;
#pragma unroll
    for (int j = 0; j < 4; ++j) {
      const float a0 = v[j].x * gg[j].x, a1 = v[j].y * gg[j].y, a2 = v[j].z * gg[j].z, a3 = v[j].w * gg[j].w;
      float m = fmaxf(fmaxf(fabsf(a0), fabsf(a1)), fmaxf(fabsf(a2), fabsf(a3)));
#pragma unroll
      for (int sh = 16; sh >= 1; sh >>= 1) m = fmaxf(m, __shfl_xor(m, sh));
      const float inv = m > 0.f ? 127.0f / m : 0.f;
      *(unsigned*)(XQ + (size_t)(row0 + rr) * D + j * 256 + lane * 4) = pack_i8x4(a0 * inv, a1 * inv, a2 * inv, a3 * inv);
      if ((lane & 31) == 0) XS[(size_t)(row0 + rr) * 8 + 2 * j + (lane >> 5)] = m * r * (1.0f / 127.0f);
    }
  }
}
DI int dpp_i(int v, const int sel) {
  if (sel == 0) return __builtin_amdgcn_update_dpp(0, v, 0xB1, 0xF, 0xF, true);
  if (sel == 1) return __builtin_amdgcn_update_dpp(0, v, 0x4E, 0xF, 0xF, true);
  return __builtin_amdgcn_update_dpp(0, v, 0x141, 0xF, 0xF, true);
}
DI int dpp_isum8(int v) { v += dpp_i(v, 0); v += dpp_i(v, 1); v += dpp_i(v, 2); return v; }
template <int HF> DI void peer_ud4_issue(PeerUHalf& H, unsigned idxpair, int lane, const u8_t* __restrict__ tab) {
#pragma unroll
  for (int jj = 0; jj < 8; ++jj) {
    const int j = 8 * HF + jj;
    const unsigned w = (unsigned)__shfl((int)idxpair, (lane & ~7) + (j >> 1));
    const unsigned e = (j & 1) ? (w >> 16) : (w & 0xffffu);
    H.u[jj] = *(const u32x4*)(tab + (size_t)e * 128);
  }
}
template <int HF> DI void peer_ud4_compute(const PeerUHalf& H, const u32x4 xq, int sub, int& res0, int& res1) {
#pragma unroll
  for (int jj = 0; jj < 8; ++jj) {
    const int j = 8 * HF + jj;
    int acc = 0;
    acc = __builtin_amdgcn_sdot4((int)H.u[jj].x, (int)xq.x, acc, false); acc = __builtin_amdgcn_sdot4((int)H.u[jj].y, (int)xq.y, acc, false);
    acc = __builtin_amdgcn_sdot4((int)H.u[jj].z, (int)xq.z, acc, false); acc = __builtin_amdgcn_sdot4((int)H.u[jj].w, (int)xq.w, acc, false);
    acc = dpp_isum8(acc);
    if (sub == (j >> 1)) { if (j & 1) res1 = acc; else res0 = acc; }
  }
}
DI void ph_peer_u_d4(int xi, int nx, int wv, int nwv, const u8_t* __restrict__ XQ, const float* __restrict__ XS, const u8_t* __restrict__ EUq,
                     const unsigned short* __restrict__ EIDX, bf16_t* __restrict__ PP) {
  const int lane = fresh_tid() & 63, sub = lane & 7;
  const int ntok = (TREAL - wv + nwv - 1) / nwv;
#define PU_TOK(i) (wv + ((i) < ntok ? (i) : ntok - 1) * nwv)
#define PU_IDX(t) __builtin_nontemporal_load((const unsigned*)(EIDX + (size_t)(t) * 128) + lane)
#define PU_LDX(xq_, xs_, t) { xq_ = *(const u32x4*)(xbase + (size_t)(t) * D); xs_ = XS[(size_t)(t) * 8 + s]; }
#define PU_STORE(t, r0, r1, xs_) __builtin_nontemporal_store(pk2((float)(r0) * (xs_), (float)(r1) * (xs_)), (unsigned*)(pp + (size_t)(t) * 128) + lane)
  for (int s = xi; s < 8; s += nx) {
    const u8_t* tab = EUq + (size_t)s * NEXP * 128 + sub * 16;
    const u8_t* xbase = XQ + s * 128 + sub * 16;
    bf16_t* pp = PP + (size_t)s * TREAL * 128;
    PeerUHalf HA, HB, HC;
    int ta = PU_TOK(0), tb = PU_TOK(1), tc = PU_TOK(2);
    unsigned ia = PU_IDX(ta), ib = PU_IDX(tb), ic = PU_IDX(tc);
    u32x4 xqa; float xsa; PU_LDX(xqa, xsa, ta);
    peer_ud4_issue<0>(HA, ia, lane, tab);
    peer_ud4_issue<1>(HB, ia, lane, tab);
    for (int i = 0; i < ntok; i += 3) {
      const int td = PU_TOK(i + 3), te = PU_TOK(i + 4), tf = PU_TOK(i + 5);
      u32x4 xqb, xqc, xqd; float xsb, xsc, xsd;
      int r0, r1;
      peer_ud4_issue<0>(HC, ib, lane, tab); PU_LDX(xqb, xsb, tb); const unsigned id = PU_IDX(td);
      r0 = 0; r1 = 0;
      peer_ud4_compute<0>(HA, xqa, sub, r0, r1);
      peer_ud4_issue<1>(HA, ib, lane, tab);
      peer_ud4_compute<1>(HB, xqa, sub, r0, r1);
      PU_STORE(ta, r0, r1, xsa);
      peer_ud4_issue<0>(HB, ic, lane, tab); PU_LDX(xqc, xsc, tc); const unsigned ie = PU_IDX(te);
      r0 = 0; r1 = 0;
      peer_ud4_compute<0>(HC, xqb, sub, r0, r1);
      peer_ud4_issue<1>(HC, ic, lane, tab);
      peer_ud4_compute<1>(HA, xqb, sub, r0, r1);
      PU_STORE(tb, r0, r1, xsb);
      peer_ud4_issue<0>(HA, id, lane, tab); PU_LDX(xqd, xsd, td); const unsigned if_ = PU_IDX(tf);
      r0 = 0; r1 = 0;
      peer_ud4_compute<0>(HB, xqc, sub, r0, r1);
      peer_ud4_issue<1>(HB, id, lane, tab);
      peer_ud4_compute<1>(HC, xqc, sub, r0, r1);
      PU_STORE(tc, r0, r1, xsc);
      ta = td; tb = te; tc = tf; ib = ie; ic = if_; xqa = xqd; xsa = xsd;
    }
  }
#undef PU_TOK
#undef PU_IDX
#undef PU_LDX
#undef PU_STORE
}

struct PUI { i32x4 a[8]; };
struct PUE { int e[8]; };

#define XB_TMO      128
#define XB_XCNT(j)  (256  + 64 * (j))
#define XB_XSUB(j)  (1280 + 64 * (j))
#define XB_XGEN(j)  (2304 + 64 * (j))
#define XB_TOP      3328
#define XB_TOPGEN   3392
#define XCD_BAR_WORDS 3456
#define XB_SPIN_CAP (1u << 20)
#define LAS __attribute__((address_space(3)))
DI unsigned xb_ld(unsigned* p)              { return __hip_atomic_load(p, __ATOMIC_RELAXED, __HIP_MEMORY_SCOPE_AGENT); }
DI unsigned xb_add(unsigned* p, unsigned v) { return __hip_atomic_fetch_add(p, v, __ATOMIC_RELAXED, __HIP_MEMORY_SCOPE_AGENT); }
DI unsigned xb_xcc_id() { return (unsigned)__builtin_amdgcn_s_getreg((3 << 11) | 20) & 0xFu; }
#define XB_SPIN(cond, bar) do { unsigned _sp = 0; while (cond) { __builtin_amdgcn_s_sleep(1); \
    if ((++_sp & 255u) == 0u) { if (xb_ld(&(bar)[XB_TMO])) break; if (_sp > XB_SPIN_CAP) { atomicAdd(&(bar)[XB_TMO], 1u); break; } } } } while (0)
struct XcdBarrier { unsigned* bar; unsigned x; volatile unsigned* st; };
DI XcdBarrier xcd_barrier_post(unsigned* bar, volatile unsigned* st) {
  XcdBarrier b; b.bar = bar; b.x = xb_xcc_id(); b.st = st;
  if (threadIdx.x == 0) (void)xb_add(&bar[XB_XCNT(b.x)], 1u);
  return b;
}
DI void xcd_barrier_complete(unsigned* bar, unsigned x, unsigned& nloc, unsigned& nx) {
  const unsigned G = gridDim.x;
  unsigned sum, cnt, mine, sp = 0u;
  for (;;) {
    sum = 0u; cnt = 0u; mine = 0u;
#pragma unroll
    for (unsigned j = 0; j < 16; ++j) { const unsigned c = xb_ld(&bar[XB_XCNT(j)]); sum += c; cnt += (c > 0u) ? 1u : 0u; mine = (j == x) ? c : mine; }
    if (sum == G) break;
    __builtin_amdgcn_s_sleep(1);
    if ((++sp & 255u) == 0u) { if (xb_ld(&bar[XB_TMO])) break; if (sp > XB_SPIN_CAP) { atomicAdd(&bar[XB_TMO], 1u); break; } }
  }
  nloc = mine > 0u ? mine : 1u; nx = cnt > 0u ? cnt : 1u;
}
DI void xcd_barrier(const XcdBarrier& b) {
  asm volatile("s_waitcnt vmcnt(0)" ::: "memory");
  __syncthreads();
  if (threadIdx.x == 0) {
    unsigned* bar = b.bar;
    __builtin_amdgcn_s_waitcnt(0);
    unsigned nloc = b.st[0], nx = b.st[1];
    if (nloc == 0u) { xcd_barrier_complete(bar, b.x, nloc, nx); b.st[0] = nloc; b.st[1] = nx; }
    const unsigned old = xb_add(&bar[XB_XSUB(b.x)], 1u);
    const unsigned gen = old / nloc;
    if (old + 1u == (gen + 1u) * nloc) {
      __builtin_amdgcn_fence(__ATOMIC_RELEASE, "agent");
      asm volatile("s_waitcnt vmcnt(0)" ::: "memory");
      const unsigned og = xb_add(&bar[XB_TOP], 1u);
      const unsigned tg = og / nx;
      if (og + 1u == (tg + 1u) * nx) xb_add(&bar[XB_TOPGEN], 1u);
      else XB_SPIN(xb_ld(&bar[XB_TOPGEN]) == tg, bar);
      __builtin_amdgcn_fence(__ATOMIC_ACQUIRE, "agent");
      xb_add(&bar[XB_XGEN(b.x)], 1u);
      asm volatile("s_waitcnt vmcnt(0)" ::: "memory");
    } else {
      XB_SPIN(xb_ld(&bar[XB_XGEN(b.x)]) == gen, bar);
      __builtin_amdgcn_fence(__ATOMIC_ACQUIRE, "agent");
      asm volatile("s_waitcnt vmcnt(0)" ::: "memory");
    }
  }
  __syncthreads();
}

struct Params {
  const float *x, *meta, *norm1_g, *w_in, *wg, *bg, *sb_g, *gla_g, *w_out, *norm2_g, *w_pq, *sk1, *sk2, *eu, *ev, *gf;
  float* out; char* ws;
};
constexpr int HALF_SMEM = 73728;
constexpr int SMEM_BYTES = 2 * HALF_SMEM;
constexpr size_t WS_BAR = 0;

__global__ void __launch_bounds__(512, 2) k_fused(Params p) {
  extern __shared__ __attribute__((aligned(16))) char smem_dyn[];
  const int half = __builtin_amdgcn_readfirstlane((int)(threadIdx.x >> 8));
  char* smem = smem_dyn + half * HALF_SMEM;
  __shared__ unsigned xb_words[4];
  if (threadIdx.x < 4) xb_words[threadIdx.x] = 0u;
  __syncthreads();
  const XcdBarrier bar = xcd_barrier_post((unsigned*)(p.ws + WS_BAR), xb_words);
  if (threadIdx.x == 0) xb_words[2] = xb_add((unsigned*)(p.ws + WS_XRANK) + bar.x, 1u);
  const int G = 2 * gridDim.x, bid = 2 * blockIdx.x + half;
  char* ws = p.ws;
  bf16_t* WinT = (bf16_t*)(ws + WS_WIN);
  bf16_t* WoutT = (bf16_t*)(ws + WS_WOUT);
  bf16_t* WpqT = (bf16_t*)(ws + WS_WPQ);
  bf16_t* EU = (bf16_t*)(ws + WS_EU);
  bf16_t* EV = (bf16_t*)(ws + WS_EV);
  bf16_t* SK1b = (bf16_t*)(ws + WS_SK1);
  bf16_t* SK2b = (bf16_t*)(ws + WS_SK2);
  bf16_t* A1 = (bf16_t*)(ws + WS_A1);
  float* GO = (float*)(ws + WS_A1);
  bf16_t* A2 = (bf16_t*)(ws + WS_A1);
  InProjOut O;
  O.QSB = (bf16_t*)(ws + WS_QSB); O.KSB = (bf16_t*)(ws + WS_KSB); O.VTSB = (bf16_t*)(ws + WS_VTSB); O.VSB = (bf16_t*)(ws + WS_VSB);
  O.GQ = (bf16_t*)(ws + WS_GQ); O.GK = (bf16_t*)(ws + WS_GK); O.GV = (bf16_t*)(ws + WS_GVT); O.GR = (bf16_t*)(ws + WS_GR);
  O.GLR = (float*)(ws + WS_GLR);
  bf16_t* H1 = (bf16_t*)(ws + WS_H1);
  float* R2 = (float*)(ws + WS_XS + 3 * MiB);
  bf16_t* GVT = (bf16_t*)(ws + WS_GVT);
  GlaPtrs GP;
  GP.GQ = O.GQ; GP.GK = O.GK; GP.GVT = GVT; GP.GR = O.GR; GP.GLR = O.GLR; GP.wg = p.wg; GP.bg = p.bg; GP.gla_g = p.gla_g;
  GP.SLOC = (float*)(ws + WS_SLOC); GP.DTOT = (float*)(ws + WS_DTOT); GP.MIX = (bf16_t*)(ws + WS_MIX);
  GlaPrepPtrs GPP; GPP.GQ = O.GQ; GPP.GK = O.GK; GPP.GLR = O.GLR; GPP.wg = p.wg; GPP.bg = p.bg;
  GPP.QT = (bf16_t*)(ws + WS_GQT); GPP.KT = (bf16_t*)(ws + WS_GKT); GPP.KTT = (bf16_t*)(ws + WS_GKTT); GPP.DEC = (float*)(ws + WS_GDEC); GPP.BL = (float*)(ws + WS_GBL);
  GlaPtrs3 GP3; GP3.QT = GPP.QT; GP3.KT = GPP.KT; GP3.KTT = GPP.KTT; GP3.GVT = GVT; GP3.GR = O.GR; GP3.DEC = GPP.DEC; GP3.BL = GPP.BL; GP3.gla_g = p.gla_g;
  GP3.SLOC = GP.SLOC; GP3.DTOT = GP.DTOT; GP3.MIX = GP.MIX;
  bf16_t* MIX = (bf16_t*)(ws + WS_MIX);
  bf16_t* QP = (bf16_t*)(ws + WS_MIX);
  unsigned short* EIDX = (unsigned short*)(ws + WS_EIDX);
  bf16_t* PP = (bf16_t*)(ws + WS_PP);
  bf16_t* YT = (bf16_t*)(ws + WS_PP);
  unsigned* STREAM = (unsigned*)(ws + WS_STREAM);
  float* GATE = (float*)(ws + WS_GATE);

  for (int vb = bid; vb < 832 + 256 + 256; vb += G) {
    if (vb < 832) ph_transpose_w(vb % 104, vb / 104, smem, p.w_in, p.norm1_g, WinT, D, NIN);
    else if (vb < 1088) { const int t = vb - 832; ph_transpose_w(t % 32, t / 32, smem, p.w_out, nullptr, WoutT, D, D); }
    else { const int t = vb - 1088; ph_transpose_w(t % 32, t / 32, smem, p.w_pq, p.norm2_g, WpqT, D, D); }
  }
  ph_convert_eu_i8(p.eu, (u8_t*)EU, (float*)(ws + WS_SCU));
  for (int vb = bid; vb < NEXP / 32; vb += G) ph_convert_ev8(vb, smem, p.ev, (u8_t*)EV, (float*)(ws + WS_SCV));
  ph_convert(p.sk1, SK1b, (size_t)8 * 128 * 64 / 8);
  ph_convert(p.sk2, SK2b, (size_t)8 * 128 * 64 / 8);
  ph_zero_pads(O.KSB, O.VTSB, O.GQ, O.GK, GVT);
  for (int vb = bid; vb < TREAL / 16; vb += G) ph_norm_rows<0>(vb, p.x, p.meta, A1);
  __syncthreads();
  for (int mb = blockIdx.x; mb < NIN / 16; mb += gridDim.x) ph_meta(mb, smem_dyn, p.meta, p.norm1_g, p.w_in, O);
  xcd_barrier(bar);
  {
    pg8::Gemm g{A1, WinT, TREAL, NINP, D}; pg8::StaticOrder S; S.init(TREAL, NINP, (int)gridDim.x, (int)blockIdx.x);
    EpiInProj E{O, GVT, smem_dyn + 131072};
    pg8::gemm_phase<EpiInProj, pg8::StaticOrder, true, true>((PG8_LAS unsigned char*)smem_dyn, g, S, E);
  }
  xcd_barrier(bar);
  for (int it = blockIdx.x; it < 16 * 129; it += gridDim.x) ph_gla_prep(it, smem_dyn, GPP);
  xcd_barrier(bar);
  for (int it = blockIdx.x; it < 16 * 15; it += gridDim.x) gla_item4<0>(it / 15, it % 15, smem_dyn, GP3);
  for (int vb = bid; vb < 64 * 32; vb += G) ph_sb_attn2(vb, O.QSB, O.KSB, O.VTSB, p.sb_g, MIX);
  xcd_barrier(bar);
  for (int it = blockIdx.x; it < 16 * 16; it += gridDim.x) gla_item4<1>(it >> 4, it & 15, smem_dyn, GP3);
  xcd_barrier(bar);
  {
    pg8::Gemm g{MIX, WoutT, TREAL, D, D}; pg8::StaticOrder S; S.init(TREAL, D, (int)gridDim.x, (int)blockIdx.x);
    EpiOut E{p.x, H1};
    pg8::gemm_phase<EpiOut, pg8::StaticOrder, true, true>((PG8_LAS unsigned char*)smem_dyn, g, S, E);
  }
  xcd_barrier(bar);
  for (int vb = bid; vb < TREAL / 16; vb += G) ph_norm2_rows(vb, H1, p.norm2_g, R2, (u8_t*)(ws + WS_XQ), (float*)(ws + WS_XS));
  xcd_barrier(bar);
  {
    pg8::Gemm g{H1, WpqT, TREAL, D, D}; pg8::StaticOrder S; S.init(TREAL, D, (int)gridDim.x, (int)blockIdx.x);
    EpiPQ E{QP, R2};
    pg8::gemm_phase<EpiPQ, pg8::StaticOrder, true, true>((PG8_LAS unsigned char*)smem_dyn, g, S, E);
  }
  xcd_barrier(bar);
  for (int vb = bid; vb < 8 * (TREAL / 128); vb += G) ph_route_v2(vb, smem, QP, SK1b, SK2b, EIDX, GATE);
  xcd_barrier(bar);
  {
    __shared__ int xinfo[4];
    if (threadIdx.x == 0) {
      unsigned* barw = (unsigned*)(p.ws + WS_BAR);
      unsigned cnt = 0, ord = 0, mine = 1;
      for (unsigned j = 0; j < 16; ++j) { const unsigned c = xb_ld(&barw[XB_XCNT(j)]); if (c > 0) { if (j < bar.x) ++ord; ++cnt; } if (j == bar.x) mine = c; }
      xinfo[0] = (int)ord; xinfo[1] = (int)cnt; xinfo[2] = (int)xb_words[2]; xinfo[3] = (int)mine;
    }
    __syncthreads();
    const int xi = xinfo[0], nx = xinfo[1], rank = xinfo[2], nloc = xinfo[3];
    const int wave = __builtin_amdgcn_readfirstlane((int)(threadIdx.x >> 6));
    ph_peer_u_d4(xi, nx, rank * 8 + wave, nloc * 8, (const u8_t*)(ws + WS_XQ), (const float*)(ws + WS_XS), (const u8_t*)EU, EIDX, PP);
  }
  xcd_barrier(bar);
  for (int unit = blockIdx.x; unit < TREAL / 64; unit += gridDim.x) ph_peer_c8(unit, smem_dyn, PP, EIDX, GATE, (const float*)(ws + WS_SCU), (const float*)(ws + WS_SCV), STREAM);
  xcd_barrier(bar);
  ph_peer_v8(smem_dyn, STREAM, (const u8_t*)EV, YT);
  xcd_barrier(bar);
  for (int unit = blockIdx.x; unit < TREAL / 32; unit += gridDim.x) ph_final_lds(unit, smem_dyn, H1, YT, p.gf, p.out);
}

extern "C" void kernel_launch(void* const* d_in, const int* in_sizes, int n_in, void* d_out, int out_size, void* d_ws, size_t ws_size, hipStream_t stream) {
  static int grid = 0;
  if (grid == 0) {
    int dev = 0, cus = 0, per_cu = 0;
    hipGetDevice(&dev);
    hipDeviceGetAttribute(&cus, hipDeviceAttributeMultiprocessorCount, dev);
    hipFuncSetAttribute((const void*)k_fused, hipFuncAttributeMaxDynamicSharedMemorySize, SMEM_BYTES);
    hipOccupancyMaxActiveBlocksPerMultiprocessor(&per_cu, (const void*)k_fused, 512, SMEM_BYTES);
    if (per_cu > 1) per_cu = 1;
    if (per_cu < 1) per_cu = 1;
    grid = cus * per_cu;
  }
  hipMemsetAsync((char*)d_ws + WS_BAR, 0, 32768, stream);
  Params p{};
  p.x = (const float*)d_in[0]; p.meta = (const float*)d_in[1]; p.norm1_g = (const float*)d_in[2]; p.w_in = (const float*)d_in[3];
  p.wg = (const float*)d_in[4]; p.bg = (const float*)d_in[5]; p.sb_g = (const float*)d_in[6]; p.gla_g = (const float*)d_in[7];
  p.w_out = (const float*)d_in[8]; p.norm2_g = (const float*)d_in[9]; p.w_pq = (const float*)d_in[10]; p.sk1 = (const float*)d_in[11];
  p.sk2 = (const float*)d_in[12]; p.eu = (const float*)d_in[13]; p.ev = (const float*)d_in[14]; p.gf = (const float*)d_in[15];
  p.out = (float*)d_out; p.ws = (char*)d_ws;
  void* args[] = {&p};
  hipLaunchCooperativeKernel((const void*)k_fused, dim3(grid), dim3(512), args, SMEM_BYTES, stream);
}
```

```cpp
#include <hip/hip_runtime.h>
#include <stdint.h>
#include <stddef.h>

typedef unsigned short bf16_t;
typedef short bf16x8 __attribute__((ext_vector_type(8)));
typedef float f32x16 __attribute__((ext_vector_type(16)));
typedef float f32x4 __attribute__((ext_vector_type(4)));
typedef float f32x2 __attribute__((ext_vector_type(2)));
typedef unsigned u32x4 __attribute__((ext_vector_type(4)));
typedef unsigned u32x2 __attribute__((ext_vector_type(2)));
typedef __bf16 bf16x2_t __attribute__((ext_vector_type(2)));

#define DI __device__ __forceinline__
__device__ __forceinline__ int fresh_tid() { int t = (int)threadIdx.x; asm volatile("" : "+v"(t)); return t; }
#define TID tid256_
#define MFMA32(a, b, c) __builtin_amdgcn_mfma_f32_32x32x16_bf16((a), (b), (c), 0, 0, 0)

constexpr int D = 1024, NB = 8, SEQ = 8192, NMETA = 16;
constexpr int TREAL = NB * SEQ;
constexpr int MROWS = TREAL + 128;
constexpr int NIN = 3088, NINP = 3328;
constexpr int SBH = 8, SBD = 64;
constexpr int GH = 4, GDK = 64, GDV = 128;
constexpr int KIDX = SEQ + 32;
constexpr int GU = SEQ + 64;
constexpr int NEXP = 16384;
constexpr float EPS = 1e-6f;

constexpr size_t MiB = 1u << 20;
constexpr size_t WS_WIN = 1 * MiB;
constexpr size_t WS_WOUT = 8 * MiB;
constexpr size_t WS_WPQ = 10 * MiB;
constexpr size_t WS_SK1 = 12 * MiB;
constexpr size_t WS_SK2 = 13 * MiB;
constexpr size_t WS_EU = 16 * MiB;
constexpr size_t WS_EV = 48 * MiB;
constexpr size_t WS_A1 = 80 * MiB;
constexpr size_t WS_QSB = 210 * MiB;
constexpr size_t WS_KSB = 274 * MiB;
constexpr size_t WS_VTSB = 339 * MiB;
constexpr size_t WS_GQ = 404 * MiB;
constexpr size_t WS_GK = 437 * MiB;
constexpr size_t WS_H1 = 210 * MiB;
constexpr size_t WS_GV = 470 * MiB;
constexpr size_t WS_GR = 535 * MiB;
constexpr size_t WS_GLR = 599 * MiB;
constexpr size_t WS_LG = 604 * MiB;
constexpr size_t WS_MIX = 669 * MiB;
constexpr size_t WS_EIDX = 797 * MiB;
constexpr size_t WS_GATE = 829 * MiB;
constexpr size_t WS_PP = 470 * MiB;
constexpr size_t WS_STREAM = 726 * MiB;
constexpr size_t WS_XRANK = 16384;
constexpr size_t WS_VSB = 861 * MiB;
constexpr size_t WS_END = 926 * MiB;

DI unsigned f2bf(float f) { unsigned u = __float_as_uint(f); return (u + 0x7fffu + ((u >> 16) & 1u)) >> 16; }
DI float bf2f(unsigned b) { return __uint_as_float(b << 16); }
DI unsigned pk2(float lo, float hi) { f32x2 v = {lo, hi}; return __builtin_bit_cast(unsigned, __builtin_convertvector(v, bf16x2_t)); }
DI float bflo(unsigned u) { return __uint_as_float(u << 16); }
DI float bfhi(unsigned u) { return __uint_as_float(u & 0xffff0000u); }
DI int crow(int reg, int h) { return (reg & 3) + 8 * (reg >> 2) + 4 * h; }
DI float wave_sum(float v) {
#pragma unroll
  for (int o = 32; o >= 1; o >>= 1) v += __shfl_xor(v, o);
  return v;
}
DI float softplus(float z) { return fmaxf(z, 0.f) + __logf(1.f + __expf(-fabsf(z))); }

DI void ph_transpose_w(int bx, int by, char* smem, const float* __restrict__ W, const float* __restrict__ gain, bf16_t* __restrict__ WT, int K, int N) {
  const int tid256_ = fresh_tid() & 255;
  float (*t)[33] = (float (*)[33])smem;
  const int n0 = bx * 32, k0 = by * 128;
  {
    const int kr = TID >> 3, c4 = (TID & 7) * 4;
    f32x4 v[4];
#pragma unroll
    for (int j = 0; j < 4; ++j) v[j] = (n0 + c4 < N) ? *(const f32x4*)(W + (size_t)(k0 + kr + 32 * j) * N + n0 + c4) : (f32x4){0.f, 0.f, 0.f, 0.f};
#pragma unroll
    for (int j = 0; j < 4; ++j) {
      const float g = gain ? gain[k0 + kr + 32 * j] : 1.f;
      t[kr + 32 * j][c4 + 0] = v[j].x * g; t[kr + 32 * j][c4 + 1] = v[j].y * g; t[kr + 32 * j][c4 + 2] = v[j].z * g; t[kr + 32 * j][c4 + 3] = v[j].w * g;
    }
  }
  __syncthreads();
  {
    const int n = TID >> 3, ks = (TID & 7) * 16;
    unsigned w[8];
#pragma unroll
    for (int i = 0; i < 8; ++i) w[i] = pk2(t[ks + 2 * i][n], t[ks + 2 * i + 1][n]);
    bf16_t* dst = WT + (size_t)(n0 + n) * K + k0 + ks;
    *(u32x4*)dst = (u32x4){w[0], w[1], w[2], w[3]};
    *(u32x4*)(dst + 8) = (u32x4){w[4], w[5], w[6], w[7]};
  }
  __syncthreads();
}
DI void ph_convert(const float* __restrict__ src, bf16_t* __restrict__ dst, size_t n8) {
  size_t i = (size_t)blockIdx.x * blockDim.x + threadIdx.x;
  const size_t stride = (size_t)gridDim.x * blockDim.x;
  for (; i < n8; i += stride) {
    const f32x4 a = ((const f32x4*)src)[2 * i], b = ((const f32x4*)src)[2 * i + 1];
    u32x4 o; o.x = pk2(a.x, a.y); o.y = pk2(a.z, a.w); o.z = pk2(b.x, b.y); o.w = pk2(b.z, b.w);
    ((u32x4*)dst)[i] = o;
  }
}
DI void ph_zero_pads(bf16_t* KSB, bf16_t* VTSB, bf16_t* GQ, bf16_t* GK, bf16_t* GVT) {
  const int tid = blockIdx.x * blockDim.x + threadIdx.x, nth = gridDim.x * blockDim.x;
  for (int i = tid; i < 64 * 16 * 64; i += nth) { const int bh = i / 1024, r = i % 1024; KSB[(size_t)bh * KIDX * 64 + r] = 0; }
  for (int i = tid; i < 64 * 64 * 16; i += nth) { const int row = i / 16, c = i % 16; VTSB[(size_t)row * KIDX + c] = 0; }
  for (int i = tid; i < 32 * 48 * 64; i += nth) { const int bh = i / 3072, r = i % 3072; GQ[(size_t)bh * GU * 64 + r] = 0; GK[(size_t)bh * GU * 64 + r] = 0; }
  for (int i = tid; i < 32 * 128 * 48; i += nth) { const int row = i / 48, c = i % 48; GVT[(size_t)row * GU + c] = 0; }
}

template <int MODE>
DI void ph_norm_rows(int vb, const float* __restrict__ src, const float* __restrict__ meta, bf16_t* __restrict__ dst) {
  const int tid256_ = fresh_tid() & 255;
  const int row0 = vb * 16 + (TID >> 6) * 4, lane = TID & 63;
  f32x4 v[4][4];
#pragma unroll
  for (int rr = 0; rr < 4; ++rr)
#pragma unroll
    for (int j = 0; j < 4; ++j) v[rr][j] = *(const f32x4*)(src + (size_t)(row0 + rr) * D + j * 256 + lane * 4);
  f32x4 gg[4];
#pragma unroll
  for (int j = 0; j < 4; ++j) { gg[j] = (f32x4){1.f, 1.f, 1.f, 1.f}; if (MODE == 1) gg[j] = *(const f32x4*)(meta + j * 256 + lane * 4); }
#pragma unroll
  for (int rr = 0; rr < 4; ++rr) {
    float ss = 0.f;
#pragma unroll
    for (int j = 0; j < 4; ++j) ss += v[rr][j].x * v[rr][j].x + v[rr][j].y * v[rr][j].y + v[rr][j].z * v[rr][j].z + v[rr][j].w * v[rr][j].w;
    ss = wave_sum(ss);
    const float r = rsqrtf(ss * (1.0f / D) + EPS);
    if (MODE == 0 && lane == 0) const_cast<float*>(meta)[row0 + rr] = sqrtf(ss * (1.0f / D) + EPS);
#pragma unroll
    for (int j = 0; j < 4; ++j) {
      u32x2 o; o.x = pk2(v[rr][j].x * r * gg[j].x, v[rr][j].y * r * gg[j].y); o.y = pk2(v[rr][j].z * r * gg[j].z, v[rr][j].w * r * gg[j].w);
      *(u32x2*)(dst + (size_t)(row0 + rr) * D + j * 256 + lane * 4) = o;
    }
  }
}

namespace pg8 {
#define PG8_LAS __attribute__((address_space(3)))
typedef unsigned short bf16_t;
typedef short bf16x8 __attribute__((ext_vector_type(8)));
typedef float f32x4 __attribute__((ext_vector_type(4)));
typedef unsigned u32x4 __attribute__((ext_vector_type(4)));
constexpr int BM = 256, BK = 64, HALF = 128, HTB = HALF * BK * 2  , STAGE_BYTES = 8 * HTB, NXCD = 8, WGM = 8;

__host__ __device__ __forceinline__ int lds_byte(int r, int c) { const int st = (r >> 4) * 2 + (c >> 5), rr = r & 15, cc = c & 31, ob = rr * 64 + cc * 2; return st * 1024 + (ob ^ (((ob >> 9) & 1) << 5)); }
__host__ __device__ __forceinline__ void stage_rc(int b, int& R, int& C) { const int st = b / 1024, sb = b % 1024, swz = sb ^ (((sb >> 9) & 1) << 5); R = (st >> 1) * 16 + swz / 64; C = (st & 1) * 32 + (swz % 64) / 2; }
__host__ __device__ __forceinline__ int perm32(int rho) { const int n = rho >> 4, i = rho & 15; return 8 * (i >> 2) + 4 * n + (i & 3); }

struct Unit { int pm, pn; };
struct Gemm { const bf16_t* A; const bf16_t* Bt; int M, N, K; };

struct StaticOrder {
    int nM, nN, nwg, G, c;
    __host__ __device__ void init(int M, int N, int G_, int c_) { nM = M / BM; nN = N / BM; nwg = nM * nN; G = G_; c = c_; }
    __host__ __device__ bool next(int i, Unit& u) const {
        const long L = (long)i * G + c; if (L >= nwg) return false;
        int wgid = (int)L; { const int q = nwg / NXCD, r = nwg % NXCD, xcd = wgid % NXCD, off = wgid / NXCD; wgid = (xcd < r ? xcd * (q + 1) : r * (q + 1) + (xcd - r) * q) + off; }
        const int nig = WGM * nN, gid = wgid / nig, fm = gid * WGM, gsz = (nM - fm) < WGM ? (nM - fm) : WGM;
        u.pm = fm + ((wgid % nig) % gsz); u.pn = (wgid % nig) / gsz; return true;
    }
    __device__ __forceinline__ void a_ready(const Unit&) const {}
    __device__ __forceinline__ void done(const Unit&) const {}
};

template <class Epi, class Sched, bool ALIGN_EPI = false, bool SP2 = false>
__device__ __forceinline__ void gemm_phase(PG8_LAS unsigned char* lds, const Gemm g, const Sched& S, const Epi& E) {
    const int tid = fresh_tid(), wid = __builtin_amdgcn_readfirstlane(tid >> 6), lane = tid & 63, wr = wid >> 2, wc = wid & 3, fr = lane & 15, fq = lane >> 4;
    const int K = g.K, nt = K / BK;
    unsigned voffA[2], voffB[2];
#pragma unroll
    for (int i = 0; i < 2; ++i) { int R, C; stage_rc(tid * 16 + i * 8192, R, C); const int Rb = Epi::PERM ? ((R & ~31) + perm32(R & 31)) : R;
        voffA[i] = (unsigned)(R * K + C) * 2u; voffB[i] = (unsigned)(Rb * K + C) * 2u; }
    const size_t kstep = (size_t)(BK * 2);
    const size_t hstep = (size_t)HALF * K * 2;
    const size_t tstep = 2 * hstep;
    const unsigned ldsw = (unsigned)wid * 1024u;
    const int aoff = lds_byte(wr * 64 + fr, fq * 8), boff = lds_byte(wc * 32 + fr, fq * 8);
#define PG8_SA(b, h) (((b) * 2 + (h)) * HTB)
#define PG8_SB(b, h) ((4 + (b) * 2 + (h)) * HTB)
#define PG8_STAGE(bufoff, gbase, voff) do { _Pragma("unroll") for (int _i = 0; _i < 2; ++_i) \
        __builtin_amdgcn_global_load_lds((const unsigned*)((const char*)(gbase) + (voff)[_i]), (PG8_LAS unsigned*)(lds + (bufoff) + ldsw + _i * 8192), 16, 0, 0); } while (0)
#define PG8_LDA(dst, b, h) do { _Pragma("unroll") for (int m = 0; m < 4; ++m) _Pragma("unroll") for (int k = 0; k < 2; ++k) dst[m][k] = *(const PG8_LAS bf16x8*)(lds + PG8_SA(b, h) + aoff + m * 2048 + k * 1024); } while (0)
#define PG8_LDB(dst, b, h) do { _Pragma("unroll") for (int n = 0; n < 2; ++n) _Pragma("unroll") for (int k = 0; k < 2; ++k) dst[n][k] = *(const PG8_LAS bf16x8*)(lds + PG8_SB(b, h) + boff + n * 2048 + k * 1024); } while (0)
#define PG8_MMA(ai, bj, At, Bt) do { __builtin_amdgcn_s_setprio(1); _Pragma("unroll") for (int m = 0; m < 4; ++m) _Pragma("unroll") for (int n = 0; n < 2; ++n) _Pragma("unroll") for (int k = 0; k < 2; ++k) \
        acc[ai][bj][m][n] = __builtin_amdgcn_mfma_f32_16x16x32_bf16(Bt[n][k], At[m][k], acc[ai][bj][m][n], 0, 0, 0); __builtin_amdgcn_s_setprio(0); } while (0)
#define PG8_WAIT_V(n) asm volatile("s_waitcnt vmcnt(" #n ")" ::: "memory")
#define PG8_WAIT_L(n) asm volatile("s_waitcnt lgkmcnt(" #n ")" ::: "memory")
#define PG8_BAR __builtin_amdgcn_s_barrier()
#define PG8_SCHED __builtin_amdgcn_sched_barrier(0)
    Unit cur, nxt; int ui = 0;
    if (!S.next(0, cur)) return;
    f32x4 acc[2][2][4][2];
#pragma unroll
    for (int a = 0; a < 2; ++a)
#pragma unroll
        for (int b = 0; b < 2; ++b)
#pragma unroll
            for (int m = 0; m < 4; ++m)
#pragma unroll
                for (int n = 0; n < 2; ++n) acc[a][b][m][n] = (f32x4){0.f, 0.f, 0.f, 0.f};
    bf16x8 At[4][2], B0[2][2], B1[2][2];
    const char* cA = (const char*)g.A + (size_t)cur.pm * tstep; const char* cB = (const char*)g.Bt + (size_t)cur.pn * tstep;
    S.a_ready(cur);
    if constexpr (SP2) {
        PG8_STAGE(PG8_SB(0, 0), cB, voffB); PG8_STAGE(PG8_SB(0, 1), cB + hstep, voffB); PG8_STAGE(PG8_SA(0, 0), cA, voffA); PG8_STAGE(PG8_SA(0, 1), cA + hstep, voffA);
        if (wr == 1) PG8_BAR;
        PG8_WAIT_V(2); PG8_BAR;
        PG8_STAGE(PG8_SB(1, 0), cB + kstep, voffB); PG8_STAGE(PG8_SA(1, 0), cA + kstep, voffA); PG8_STAGE(PG8_SB(1, 1), cB + hstep + kstep, voffB);
        PG8_WAIT_V(6); PG8_BAR;
    } else {
        PG8_STAGE(PG8_SB(0, 0), cB, voffB); PG8_STAGE(PG8_SA(0, 0), cA, voffA); PG8_STAGE(PG8_SB(0, 1), cB + hstep, voffB); PG8_STAGE(PG8_SA(0, 1), cA + hstep, voffA);
        if (wr == 1) PG8_BAR;
        PG8_WAIT_V(4); PG8_BAR;
        PG8_STAGE(PG8_SB(1, 0), cB + kstep, voffB); PG8_STAGE(PG8_SA(1, 0), cA + kstep, voffA); PG8_STAGE(PG8_SB(1, 1), cB + hstep + kstep, voffB);
        PG8_WAIT_V(6); PG8_BAR;
    }
    for (;;) {
        const bool has_next = S.next(ui + 1, nxt);
        const char* nA = has_next ? (const char*)g.A + (size_t)nxt.pm * tstep : cA; const char* nB = has_next ? (const char*)g.Bt + (size_t)nxt.pn * tstep : cB;
        for (int t = 0; t < nt; t += 2) {
            const bool last = (t == nt - 2);
            const char* a1 = cA + (size_t)(t + 1) * kstep;
            const char* a2 = last ? nA : cA + (size_t)(t + 2) * kstep; const char* b2 = last ? nB : cB + (size_t)(t + 2) * kstep;
            const char* a3 = a2 + kstep; const char* b3 = b2 + kstep;
            if (last && has_next) S.a_ready(nxt);
            if constexpr (SP2) {
            PG8_LDB(B0, 0, 0); PG8_LDB(B1, 0, 1); PG8_SCHED; PG8_LDA(At, 0, 0); PG8_STAGE(PG8_SA(1, 1), a1 + hstep, voffA);
            PG8_WAIT_V(8); PG8_WAIT_L(0); PG8_BAR; PG8_MMA(0, 0, At, B0); PG8_MMA(0, 1, At, B1); PG8_BAR; PG8_SCHED;
            PG8_LDA(At, 0, 1); PG8_STAGE(PG8_SB(0, 0), b2, voffB); PG8_STAGE(PG8_SB(0, 1), b2 + hstep, voffB); PG8_STAGE(PG8_SA(0, 0), a2, voffA);
            PG8_WAIT_V(8); PG8_WAIT_L(0); PG8_BAR; PG8_MMA(1, 0, At, B0); PG8_MMA(1, 1, At, B1); PG8_BAR; PG8_SCHED;
            PG8_LDB(B0, 1, 0); PG8_LDB(B1, 1, 1); PG8_SCHED; PG8_LDA(At, 1, 0); PG8_STAGE(PG8_SA(0, 1), a2 + hstep, voffA);
            PG8_WAIT_V(8); PG8_WAIT_L(0); PG8_BAR; PG8_MMA(0, 0, At, B0); PG8_MMA(0, 1, At, B1); PG8_BAR; PG8_SCHED;
            PG8_LDA(At, 1, 1); PG8_STAGE(PG8_SB(1, 0), b3, voffB); PG8_STAGE(PG8_SB(1, 1), b3 + hstep, voffB); PG8_STAGE(PG8_SA(1, 0), a3, voffA);
            PG8_WAIT_V(8); PG8_WAIT_L(0); PG8_BAR; PG8_MMA(1, 0, At, B0); PG8_MMA(1, 1, At, B1); PG8_BAR; PG8_SCHED;
            } else {
            PG8_LDB(B0, 0, 0); PG8_SCHED; PG8_LDA(At, 0, 0); PG8_STAGE(PG8_SA(1, 1), a1 + hstep, voffA);
            PG8_WAIT_L(8); PG8_BAR; PG8_WAIT_L(0); PG8_MMA(0, 0, At, B0); PG8_BAR; PG8_SCHED;
            PG8_LDB(B1, 0, 1); PG8_STAGE(PG8_SB(0, 0), b2, voffB);
            PG8_BAR; PG8_WAIT_L(0); PG8_MMA(0, 1, At, B1); PG8_BAR;
            PG8_LDA(At, 0, 1); PG8_STAGE(PG8_SA(0, 0), a2, voffA);
            PG8_BAR; PG8_WAIT_L(0); PG8_MMA(1, 0, At, B0); PG8_BAR; PG8_SCHED;
            PG8_STAGE(PG8_SB(0, 1), b2 + hstep, voffB);
            PG8_WAIT_V(6); PG8_BAR; PG8_MMA(1, 1, At, B1); PG8_BAR;
            PG8_LDB(B0, 1, 0); PG8_SCHED; PG8_LDA(At, 1, 0); PG8_STAGE(PG8_SA(0, 1), a2 + hstep, voffA);
            PG8_WAIT_L(8); PG8_BAR; PG8_WAIT_L(0); PG8_MMA(0, 0, At, B0); PG8_BAR; PG8_SCHED;
            PG8_LDB(B1, 1, 1); PG8_STAGE(PG8_SB(1, 0), b3, voffB);
            PG8_BAR; PG8_WAIT_L(0); PG8_MMA(0, 1, At, B1); PG8_BAR;
            PG8_LDA(At, 1, 1); PG8_STAGE(PG8_SA(1, 0), a3, voffA);
            PG8_BAR; PG8_WAIT_L(0); PG8_MMA(1, 0, At, B0); PG8_BAR; PG8_SCHED;
            PG8_STAGE(PG8_SB(1, 1), b3 + hstep, voffB);
            PG8_WAIT_V(6); PG8_BAR; PG8_MMA(1, 1, At, B1); PG8_BAR;
            }
        }
        if constexpr (ALIGN_EPI) { if (wr == 0) PG8_BAR; }
        if constexpr (!Epi::AFTER_DRAIN) { E(acc, cur, wr, wc, fr, fq); S.done(cur); }
        if (!has_next) break;
#pragma unroll
        for (int a = 0; a < 2; ++a)
#pragma unroll
            for (int b = 0; b < 2; ++b)
#pragma unroll
                for (int m = 0; m < 4; ++m)
#pragma unroll
                    for (int n = 0; n < 2; ++n) acc[a][b][m][n] = (f32x4){0.f, 0.f, 0.f, 0.f};
        cur = nxt; cA = nA; cB = nB; ++ui;
        if constexpr (ALIGN_EPI) { if (wr == 1) PG8_BAR; }
    }
    PG8_WAIT_V(0);
    if constexpr (!ALIGN_EPI) { if (wr == 0) PG8_BAR; }
    PG8_BAR;
    if constexpr (Epi::AFTER_DRAIN) { E.fused(acc, cur, wr, wc, fr, fq, lds, wid, lane); S.done(cur); }
#undef PG8_SA
#undef PG8_SB
#undef PG8_STAGE
#undef PG8_LDA
#undef PG8_LDB
#undef PG8_MMA
#undef PG8_WAIT_V
#undef PG8_WAIT_L
#undef PG8_BAR
#undef PG8_SCHED
}
}

struct InProjOut { bf16_t *QSB, *KSB, *VSB, *VTSB, *GQ, *GK, *GV, *GR; float* GLR; };

struct EpiInProj {
  static constexpr bool PERM = true, AFTER_DRAIN = false;
  InProjOut O; bf16_t* GVT; char* stage;
  DI void store_vt(const pg8::f32x4 (&acc)[2][2][4][2], const pg8::Unit& u, int wr, int wc, int fr, int fq) const {
    bf16_t* st = (bf16_t*)(stage + (wr * 4 + wc) * 1280);
    const int lane = fr + 16 * fq;
    const int rc = lane >> 2, r8 = lane & 3;
#pragma unroll
    for (int ai = 0; ai < 2; ++ai)
#pragma unroll
      for (int bj = 0; bj < 2; ++bj)
#pragma unroll
        for (int mp = 0; mp < 2; ++mp)
#pragma unroll
          for (int ch = 0; ch < 2; ++ch) {
            if ((fq >> 1) == ch) {
#pragma unroll
              for (int m2 = 0; m2 < 2; ++m2)
#pragma unroll
                for (int n = 0; n < 2; ++n) {
                  const pg8::f32x4 v = acc[ai][bj][2 * mp + m2][n];
                  const int cl = 8 * (fq & 1) + 4 * n, rl = 16 * m2 + fr;
                  st[(cl + 0) * 40 + rl] = (bf16_t)f2bf(v[0]); st[(cl + 1) * 40 + rl] = (bf16_t)f2bf(v[1]);
                  st[(cl + 2) * 40 + rl] = (bf16_t)f2bf(v[2]); st[(cl + 3) * 40 + rl] = (bf16_t)f2bf(v[3]);
                }
            }
            asm volatile("s_waitcnt lgkmcnt(0)" ::: "memory");
            const u32x4 w = *(const u32x4*)&st[rc * 40 + 8 * r8];
            asm volatile("" ::: "memory");
            const int col = u.pn * 256 + bj * 128 + wc * 32 + 16 * ch + rc;
            const int row = u.pm * 256 + ai * 128 + wr * 64 + 32 * mp + 8 * r8;
            const int b = row >> 13, i = row & 8191;
            bf16_t* dst;
            if (u.pn < 6) { const int c = col - 1024; dst = O.VTSB + ((size_t)(b * SBH + (c >> 6)) * 64 + (c & 63)) * KIDX + 32 + i; }
            else          { const int c = col - 2048; dst = GVT + ((size_t)(b * GH + (c >> 7)) * 128 + (c & 127)) * GU + 64 + i; }
            *(u32x4*)dst = w;
          }
  }
  DI void operator()(const pg8::f32x4 (&acc)[2][2][4][2], const pg8::Unit& u, int wr, int wc, int fr, int fq) const {
    const int pn = u.pn;
    if (pn == 4 || pn == 5 || pn == 8 || pn == 9) { store_vt(acc, u, wr, wc, fr, fq); return; }
#pragma unroll
    for (int ai = 0; ai < 2; ++ai)
#pragma unroll
      for (int m = 0; m < 4; ++m) {
        const int row = u.pm * 256 + ai * 128 + wr * 64 + m * 16 + fr;
        const int b = row >> 13, i = row & 8191;
#pragma unroll
        for (int bj = 0; bj < 2; ++bj) {
          const int col = pn * 256 + bj * 128 + wc * 32 + 8 * fq;
          const pg8::f32x4 v0 = acc[ai][bj][m][0], v1 = acc[ai][bj][m][1];
          if (pn < 12) {
            u32x4 w; w.x = pk2(v0[0], v0[1]); w.y = pk2(v0[2], v0[3]); w.z = pk2(v1[0], v1[1]); w.w = pk2(v1[2], v1[3]);
            bf16_t* dst;
            if (pn < 2)       { const int c = col;        dst = O.QSB + ((size_t)(b * SBH + (c >> 6)) * SEQ + i) * 64 + (c & 63); }
            else if (pn < 4)  { const int c = col - 512;  dst = O.KSB + ((size_t)(b * SBH + (c >> 6)) * KIDX + 32 + i) * 64 + (c & 63); }
            else if (pn == 6) { const int c = col - 1536; dst = O.GQ + ((size_t)(b * GH + (c >> 6)) * GU + 64 + i) * 64 + (c & 63); }
            else if (pn == 7) { const int c = col - 1792; dst = O.GK + ((size_t)(b * GH + (c >> 6)) * GU + 64 + i) * 64 + (c & 63); }
            else              { const int c = col - 2560; dst = O.GR + (size_t)row * 512 + c; }
            *(u32x4*)dst = w;
          } else if (col < NIN) {
            float* dst = O.GLR + ((size_t)b * GU + 64 + i) * 16 + (col - 3072);
            *(f32x4*)dst = (f32x4){v0[0], v0[1], v0[2], v0[3]};
            *(f32x4*)(dst + 4) = (f32x4){v1[0], v1[1], v1[2], v1[3]};
          }
        }
      }
  }
};
struct EpiOut {
  static constexpr bool PERM = true, AFTER_DRAIN = false;
  const bf16_t* A1; const float* R1I; bf16_t* H1;
  DI void operator()(const pg8::f32x4 (&acc)[2][2][4][2], const pg8::Unit& u, int wr, int wc, int fr, int fq) const {
#pragma unroll
    for (int ai = 0; ai < 2; ++ai)
#pragma unroll
      for (int m = 0; m < 4; ++m) {
        const int row = u.pm * 256 + ai * 128 + wr * 64 + m * 16 + fr;
        const size_t rowoff = (size_t)row * D;
        const float ri = R1I[row];
#pragma unroll
        for (int bj = 0; bj < 2; ++bj) {
          const size_t idx = rowoff + u.pn * 256 + bj * 128 + wc * 32 + 8 * fq;
          const u32x4 aw = *(const u32x4*)(A1 + idx);
          const f32x4 x0 = {bflo(aw.x) * ri, bfhi(aw.x) * ri, bflo(aw.y) * ri, bfhi(aw.y) * ri}, x1 = {bflo(aw.z) * ri, bfhi(aw.z) * ri, bflo(aw.w) * ri, bfhi(aw.w) * ri};
          const pg8::f32x4 v0 = acc[ai][bj][m][0], v1 = acc[ai][bj][m][1];
          u32x4 w; w.x = pk2(x0.x + v0[0], x0.y + v0[1]); w.y = pk2(x0.z + v0[2], x0.w + v0[3]); w.z = pk2(x1.x + v1[0], x1.y + v1[1]); w.w = pk2(x1.z + v1[2], x1.w + v1[3]);
          *(u32x4*)(H1 + idx) = w;
        }
      }
  }
};
struct EpiPQ {
  static constexpr bool PERM = true, AFTER_DRAIN = false;
  bf16_t* QP; const float* R2;
  DI void operator()(const pg8::f32x4 (&acc)[2][2][4][2], const pg8::Unit& u, int wr, int wc, int fr, int fq) const {
#pragma unroll
    for (int ai = 0; ai < 2; ++ai)
#pragma unroll
      for (int m = 0; m < 4; ++m) {
        const int row = u.pm * 256 + ai * 128 + wr * 64 + m * 16 + fr;
        const float r = R2[row];
        const size_t rowoff = (size_t)row * D;
#pragma unroll
        for (int bj = 0; bj < 2; ++bj) {
          const pg8::f32x4 v0 = acc[ai][bj][m][0], v1 = acc[ai][bj][m][1];
          u32x4 w; w.x = pk2(v0[0] * r, v0[1] * r); w.y = pk2(v0[2] * r, v0[3] * r); w.z = pk2(v1[0] * r, v1[1] * r); w.w = pk2(v1[2] * r, v1[3] * r);
          *(u32x4*)(QP + rowoff + u.pn * 256 + bj * 128 + wc * 32 + 8 * fq) = w;
        }
      }
  }
};

DI void ph_meta(int blk, char* smem, const float* __restrict__ meta, const float* __restrict__ g1, const float* __restrict__ w_in, const InProjOut& O) {
  float (*xmT)[16] = (float (*)[16])smem;
  float (*red)[256] = (float (*)[256])(smem + 65536);
  const int tid = fresh_tid(), lane = tid & 63, wave = tid >> 6;
  for (int rr = 0; rr < 2; ++rr) {
    const int mm = wave * 2 + rr;
    float v[16]; float ss = 0.f;
#pragma unroll
    for (int j = 0; j < 16; ++j) { v[j] = meta[(size_t)mm * D + j * 64 + lane]; ss += v[j] * v[j]; }
    ss = wave_sum(ss);
    const float r = rsqrtf(ss * (1.0f / D) + EPS);
#pragma unroll
    for (int j = 0; j < 16; ++j) xmT[j * 64 + lane][mm] = v[j] * r * g1[j * 64 + lane];
  }
  __syncthreads();
  {
    const int c = tid & 15, ks = tid >> 4, n = blk * 16 + c;
    float acc[16];
#pragma unroll
    for (int j = 0; j < 16; ++j) acc[j] = 0.f;
#pragma unroll 8
    for (int kk = 0; kk < 32; ++kk) {
      const int k = ks * 32 + kk;
      const float w = w_in[(size_t)k * NIN + n];
      const f32x4 a = *(const f32x4*)&xmT[k][0], b4 = *(const f32x4*)&xmT[k][4], c4 = *(const f32x4*)&xmT[k][8], d4 = *(const f32x4*)&xmT[k][12];
      acc[0] += a.x * w; acc[1] += a.y * w; acc[2] += a.z * w; acc[3] += a.w * w;
      acc[4] += b4.x * w; acc[5] += b4.y * w; acc[6] += b4.z * w; acc[7] += b4.w * w;
      acc[8] += c4.x * w; acc[9] += c4.y * w; acc[10] += c4.z * w; acc[11] += c4.w * w;
      acc[12] += d4.x * w; acc[13] += d4.y * w; acc[14] += d4.z * w; acc[15] += d4.w * w;
    }
#pragma unroll
    for (int mm = 0; mm < 16; ++mm) red[ks][c * 16 + mm] = acc[mm];
  }
  __syncthreads();
  if (tid < 256) {
    const int c = tid >> 4, mm = tid & 15, n = blk * 16 + c;
    float val = 0.f;
#pragma unroll 8
    for (int ks = 0; ks < 32; ++ks) val += red[ks][tid];
    const bf16_t hv = (bf16_t)f2bf(val);
    for (int bb = 0; bb < NB; ++bb) {
      if (n < 512) {}
      else if (n < 1024) { const int cc = n - 512;  O.KSB[((size_t)(bb * SBH + (cc >> 6)) * KIDX + 16 + mm) * 64 + (cc & 63)] = hv; }
      else if (n < 1536) { const int cc = n - 1024; O.VTSB[((size_t)(bb * SBH + (cc >> 6)) * 64 + (cc & 63)) * KIDX + 16 + mm] = hv; }
      else if (n < 1792) { const int cc = n - 1536; O.GQ[((size_t)(bb * GH + (cc >> 6)) * GU + 48 + mm) * 64 + (cc & 63)] = hv; }
      else if (n < 2048) { const int cc = n - 1792; O.GK[((size_t)(bb * GH + (cc >> 6)) * GU + 48 + mm) * 64 + (cc & 63)] = hv; }
      else if (n < 2560) { const int cc = n - 2048; O.GV[((size_t)(bb * GH + (cc >> 7)) * 128 + (cc & 127)) * GU + 48 + mm] = hv; }
      else if (n < 3072) {}
      else { O.GLR[((size_t)bb * GU + 48 + mm) * 16 + (n - 3072)] = val; }
    }
  }
  __syncthreads();
}


constexpr float SB_THR = 5.421010862e-20f;
DI void ph_sb_attn(int vb, const bf16_t* __restrict__ QSB, const bf16_t* __restrict__ KSB, const bf16_t* __restrict__ VTSB,
                                                 const float* __restrict__ sb_g, bf16_t* __restrict__ MIX) {
  const int tid256_ = fresh_tid() & 255;
  const int lane = TID & 63, wave = TID >> 6, r = lane & 31, h = lane >> 5;
  const int bh = vb >> 6, qb = vb & 63;
  const int b = bh >> 3, hd = bh & 7;
  const int i0 = qb * 128 + wave * 32;
  const bf16_t* Qb = QSB + ((size_t)bh * SEQ + i0) * 64;
  const bf16_t* Kb = KSB + (size_t)bh * KIDX * 64;
  const bf16_t* Vb = VTSB + (size_t)bh * 64 * KIDX;
  bf16x8 qf[4];
#pragma unroll
  for (int ks = 0; ks < 4; ++ks) qf[ks] = *(const bf16x8*)(Qb + r * 64 + ks * 16 + h * 8);
  f32x16 o[2];
#pragma unroll
  for (int e = 0; e < 16; ++e) { o[0][e] = 0.f; o[1][e] = 0.f; }
  float R = 1.f;
  const int qidx = 32 + i0 + r;
  for (int c = (i0 >> 5) + 1; c >= 0; --c) {
    const int k0 = 32 * c;
    bf16x8 kf[4];
#pragma unroll
    for (int ks = 0; ks < 4; ++ks) kf[ks] = *(const bf16x8*)(Kb + (size_t)(k0 + r) * 64 + ks * 16 + h * 8);
    bf16x8 vf[2][2];
#pragma unroll
    for (int mt = 0; mt < 2; ++mt)
#pragma unroll
      for (int s2 = 0; s2 < 2; ++s2) {
        const bf16_t* vp = Vb + (size_t)(mt * 32 + r) * KIDX + k0 + 16 * s2 + 4 * h;
        const u32x2 lo = *(const u32x2*)vp, hi = *(const u32x2*)(vp + 8);
        u32x4 t; t.x = lo.x; t.y = lo.y; t.z = hi.x; t.w = hi.y;
        vf[mt][s2] = __builtin_bit_cast(bf16x8, t);
      }
    f32x16 s;
#pragma unroll
    for (int e = 0; e < 16; ++e) s[e] = 0.f;
#pragma unroll
    for (int ks = 0; ks < 4; ++ks) s = MFMA32(kf[ks], qf[ks], s);
    float om[16], bt[16];
#pragma unroll
    for (int e = 0; e < 16; ++e) {
      const int kidx = k0 + crow(e, h);
      const bool valid = (kidx < qidx) && (kidx >= 16);
      const float z = s[e] * 0.125f;
      const float ez = __expf(-fabsf(z));
      const float big = __builtin_amdgcn_rcpf(1.f + ez), small = ez * big;
      const float beta = z >= 0.f ? big : small, onem = z >= 0.f ? small : big;
      om[e] = valid ? onem : 1.f;
      bt[e] = valid ? beta : 0.f;
    }
    float sfx[16], G[4], PG[4];
#pragma unroll
    for (int g = 0; g < 4; ++g) {
      sfx[4 * g + 3] = 1.f;
      sfx[4 * g + 2] = om[4 * g + 3];
      sfx[4 * g + 1] = sfx[4 * g + 2] * om[4 * g + 2];
      sfx[4 * g + 0] = sfx[4 * g + 1] * om[4 * g + 1];
      G[g] = sfx[4 * g + 0] * om[4 * g + 0];
      PG[g] = __shfl_xor(G[g], 32);
    }
    float HS[4];
    HS[3] = 1.f;
    HS[2] = G[3] * PG[3];
    HS[1] = HS[2] * (G[2] * PG[2]);
    HS[0] = HS[1] * (G[1] * PG[1]);
    const float total = HS[0] * (G[0] * PG[0]);
    float a[16];
#pragma unroll
    for (int e = 0; e < 16; ++e) {
      const int g = e >> 2;
      const float between = sfx[e] * (h == 0 ? PG[g] : 1.f) * (HS[g] * R);
      a[e] = bt[e] * between;
    }
    R *= total;
#pragma unroll
    for (int s2 = 0; s2 < 2; ++s2) {
      u32x4 p;
      p.x = pk2(a[8 * s2 + 0], a[8 * s2 + 1]); p.y = pk2(a[8 * s2 + 2], a[8 * s2 + 3]);
      p.z = pk2(a[8 * s2 + 4], a[8 * s2 + 5]); p.w = pk2(a[8 * s2 + 6], a[8 * s2 + 7]);
      const bf16x8 pf = __builtin_bit_cast(bf16x8, p);
      o[0] = MFMA32(vf[0][s2], pf, o[0]);
      o[1] = MFMA32(vf[1][s2], pf, o[1]);
    }
    if (__all(R < SB_THR)) break;
  }
  float ss = 0.f;
#pragma unroll
  for (int e = 0; e < 16; ++e) ss += o[0][e] * o[0][e] + o[1][e] * o[1][e];
  ss += __shfl_xor(ss, 32);
  const float sc = rsqrtf(ss * (1.0f / 64.0f) + EPS);
  bf16_t* outp = MIX + (size_t)(b * SEQ + i0 + r) * D + hd * 64;
#pragma unroll
  for (int mt = 0; mt < 2; ++mt)
#pragma unroll
    for (int g = 0; g < 4; ++g) {
      const int d = mt * 32 + 8 * g + 4 * h;
      const f32x4 gg = *(const f32x4*)(sb_g + hd * 64 + d);
      u32x2 pk;
      pk.x = pk2(o[mt][4 * g] * sc * gg.x, o[mt][4 * g + 1] * sc * gg.y);
      pk.y = pk2(o[mt][4 * g + 2] * sc * gg.z, o[mt][4 * g + 3] * sc * gg.w);
      *(u32x2*)(outp + d) = pk;
    }
}


DI void sb_tile_step(const f32x16& s, int k0, int qidx, int h, float& R, const bf16x8 (&vf)[2][2], f32x16 (&o)[2]) {
  float om[16], bt[16];
#pragma unroll
  for (int e = 0; e < 16; ++e) {
    const int kidx = k0 + crow(e, h);
    const bool valid = (kidx < qidx) && (kidx >= 16);
    const float z = s[e] * 0.125f;
    const float ez = __expf(-fabsf(z));
    const float big = __builtin_amdgcn_rcpf(1.f + ez), small = ez * big;
    const float beta = z >= 0.f ? big : small, onem = z >= 0.f ? small : big;
    om[e] = valid ? onem : 1.f;
    bt[e] = valid ? beta : 0.f;
  }
  float sfx[16], G[4], PG[4];
#pragma unroll
  for (int g = 0; g < 4; ++g) {
    sfx[4 * g + 3] = 1.f;
    sfx[4 * g + 2] = om[4 * g + 3];
    sfx[4 * g + 1] = sfx[4 * g + 2] * om[4 * g + 2];
    sfx[4 * g + 0] = sfx[4 * g + 1] * om[4 * g + 1];
    G[g] = sfx[4 * g + 0] * om[4 * g + 0];
    PG[g] = __shfl_xor(G[g], 32);
  }
  float HS[4];
  HS[3] = 1.f; HS[2] = G[3] * PG[3]; HS[1] = HS[2] * (G[2] * PG[2]); HS[0] = HS[1] * (G[1] * PG[1]);
  const float total = HS[0] * (G[0] * PG[0]);
  float a[16];
#pragma unroll
  for (int e = 0; e < 16; ++e) { const int g = e >> 2; a[e] = bt[e] * (sfx[e] * (h == 0 ? PG[g] : 1.f) * (HS[g] * R)); }
  R *= total;
#pragma unroll
  for (int s2 = 0; s2 < 2; ++s2) {
    u32x4 p;
    p.x = pk2(a[8 * s2 + 0], a[8 * s2 + 1]); p.y = pk2(a[8 * s2 + 2], a[8 * s2 + 3]);
    p.z = pk2(a[8 * s2 + 4], a[8 * s2 + 5]); p.w = pk2(a[8 * s2 + 6], a[8 * s2 + 7]);
    const bf16x8 pf = __builtin_bit_cast(bf16x8, p);
    o[0] = MFMA32(vf[0][s2], pf, o[0]);
    o[1] = MFMA32(vf[1][s2], pf, o[1]);
  }
}
DI void sb_tile_out(const f32x16 (&o)[2], int h, const float* __restrict__ sb_gh, bf16_t* __restrict__ outp) {
  float ss = 0.f;
#pragma unroll
  for (int e = 0; e < 16; ++e) ss += o[0][e] * o[0][e] + o[1][e] * o[1][e];
  ss += __shfl_xor(ss, 32);
  const float sc = rsqrtf(ss * (1.0f / 64.0f) + EPS);
#pragma unroll
  for (int mt = 0; mt < 2; ++mt)
#pragma unroll
    for (int g = 0; g < 4; ++g) {
      const int d = mt * 32 + 8 * g + 4 * h;
      const f32x4 gg = *(const f32x4*)(sb_gh + d);
      u32x2 pk;
      pk.x = pk2(o[mt][4 * g] * sc * gg.x, o[mt][4 * g + 1] * sc * gg.y);
      pk.y = pk2(o[mt][4 * g + 2] * sc * gg.z, o[mt][4 * g + 3] * sc * gg.w);
      *(u32x2*)(outp + d) = pk;
    }
}
DI void ph_sb_attn2(int vb, const bf16_t* __restrict__ QSB, const bf16_t* __restrict__ KSB, const bf16_t* __restrict__ VTSB,
                    const float* __restrict__ sb_g, bf16_t* __restrict__ MIX) {
  const int tid256_ = fresh_tid() & 255;
  const int lane = TID & 63, wave = TID >> 6, r = lane & 31, h = lane >> 5;
  const int bh = vb >> 5, qb = vb & 31;
  const int b = bh >> 3, hd = bh & 7;
  const int i0 = qb * 256 + wave * 64;
  const bf16_t* Qb = QSB + ((size_t)bh * SEQ + i0) * 64;
  const bf16_t* Kb = KSB + (size_t)bh * KIDX * 64;
  const bf16_t* Vb = VTSB + (size_t)bh * 64 * KIDX;
  bf16x8 qfA[4], qfB[4];
#pragma unroll
  for (int ks = 0; ks < 4; ++ks) { qfA[ks] = *(const bf16x8*)(Qb + r * 64 + ks * 16 + h * 8); qfB[ks] = *(const bf16x8*)(Qb + (32 + r) * 64 + ks * 16 + h * 8); }
  f32x16 oA[2], oB[2];
#pragma unroll
  for (int e = 0; e < 16; ++e) { oA[0][e] = 0.f; oA[1][e] = 0.f; oB[0][e] = 0.f; oB[1][e] = 0.f; }
  float RA = 1.f, RB = 1.f;
  const int qidxA = 32 + i0 + r, qidxB = qidxA + 32;
  for (int c = (i0 >> 5) + 2; c >= 0; --c) {
    const int k0 = 32 * c;
    bf16x8 kf[4];
#pragma unroll
    for (int ks = 0; ks < 4; ++ks) kf[ks] = *(const bf16x8*)(Kb + (size_t)(k0 + r) * 64 + ks * 16 + h * 8);
    bf16x8 vf[2][2];
#pragma unroll
    for (int mt = 0; mt < 2; ++mt)
#pragma unroll
      for (int s2 = 0; s2 < 2; ++s2) {
        const bf16_t* vp = Vb + (size_t)(mt * 32 + r) * KIDX + k0 + 16 * s2 + 4 * h;
        const u32x2 lo = *(const u32x2*)vp, hi = *(const u32x2*)(vp + 8);
        u32x4 t; t.x = lo.x; t.y = lo.y; t.z = hi.x; t.w = hi.y;
        vf[mt][s2] = __builtin_bit_cast(bf16x8, t);
      }
    f32x16 sA, sB;
#pragma unroll
    for (int e = 0; e < 16; ++e) { sA[e] = 0.f; sB[e] = 0.f; }
#pragma unroll
    for (int ks = 0; ks < 4; ++ks) { sA = MFMA32(kf[ks], qfA[ks], sA); sB = MFMA32(kf[ks], qfB[ks], sB); }
    sb_tile_step(sB, k0, qidxB, h, RB, vf, oB);
    sb_tile_step(sA, k0, qidxA, h, RA, vf, oA);
    if (__all(RA < SB_THR && RB < SB_THR)) break;
  }
  sb_tile_out(oA, h, sb_g + hd * 64, MIX + (size_t)(b * SEQ + i0 + r) * D + hd * 64);
  sb_tile_out(oB, h, sb_g + hd * 64, MIX + (size_t)(b * SEQ + i0 + 32 + r) * D + hd * 64);
}


constexpr int RT_TOK_PER_BLOCK = 256;


#define MFMA16(a, b, c) __builtin_amdgcn_mfma_f32_16x16x32_bf16((a), (b), (c), 0, 0, 0)
constexpr int GLDS = 72;
struct GlaLds {
  bf16_t Qt[64 * GLDS];
  bf16_t Kt[64 * GLDS];
  bf16_t KT[64 * GLDS];
  bf16_t P[64 * GLDS];
  float dec[64];
  float tot[8][64];
  float ssq[8][64];
};
constexpr size_t WS_SLOC = 926 * MiB;
constexpr size_t WS_DTOT = 942 * MiB;
constexpr size_t WS_GVT = 604 * MiB;

struct GlaPtrs { const bf16_t *GQ, *GK, *GVT, *GR; const float *GLR, *wg, *bg, *gla_g; float *SLOC, *DTOT; bf16_t* MIX; };


constexpr size_t WS_GQT = 470 * MiB;
constexpr size_t WS_GKT = 502 * MiB + 512 * 1024;
constexpr size_t WS_GKTT = 861 * MiB;
constexpr size_t WS_GDEC = 894 * MiB;
constexpr size_t WS_GBL = 896 * MiB;
struct GlaPrepPtrs { const bf16_t *GQ, *GK; const float *GLR, *wg, *bg; bf16_t *QT, *KT, *KTT; float *DEC, *BL; };
DI void ph_gla_prep(int pair, char* smem, const GlaPrepPtrs& G) {
  const int tid = fresh_tid(), lane = tid & 63, w = tid >> 6, hb = w >> 2, w4 = w & 3;
  float (*tot)[64] = (float (*)[64])(smem + hb * 1024);
  const int item = 2 * pair + hb;
  const int bh = item / 129, c = item % 129, b = bh >> 2, hd = bh & 3, u0 = 64 * c;
  float wgr[16];
#pragma unroll
  for (int k = 0; k < 16; ++k) wgr[k] = G.wg[k * 256 + hd * 64 + lane];
  const float bgv = G.bg[hd * 64 + lane];
  float cs[16]; float run = 0.f;
  unsigned short kraw[16], qraw[16];
#pragma unroll
  for (int i = 0; i < 16; ++i) {
    const int u = u0 + 16 * w4 + i;
    kraw[i] = G.GK[((size_t)bh * GU + u) * 64 + lane];
    qraw[i] = G.GQ[((size_t)bh * GU + u) * 64 + lane];
  }
#pragma unroll
  for (int i = 0; i < 16; ++i) {
    const int u = u0 + 16 * w4 + i;
    float lgv = 0.f;
    if (u >= 48) {
      const f32x4* gp = (const f32x4*)(G.GLR + ((size_t)b * GU + u) * 16);
      const f32x4 g0 = gp[0], g1 = gp[1], g2 = gp[2], g3 = gp[3];
      float a = bgv;
      a += g0.x * wgr[0] + g0.y * wgr[1] + g0.z * wgr[2] + g0.w * wgr[3];
      a += g1.x * wgr[4] + g1.y * wgr[5] + g1.z * wgr[6] + g1.w * wgr[7];
      a += g2.x * wgr[8] + g2.y * wgr[9] + g2.z * wgr[10] + g2.w * wgr[11];
      a += g3.x * wgr[12] + g3.y * wgr[13] + g3.z * wgr[14] + g3.w * wgr[15];
      lgv = -softplus(-a) * (1.0f / 16.0f);
    }
    run += lgv; cs[i] = run;
  }
  tot[w4][lane] = run;
  __syncthreads();
  float offset = 0.f, total = 0.f;
#pragma unroll
  for (int s2 = 0; s2 < 4; ++s2) { const float tv = tot[s2][lane]; total += tv; if (s2 < w4) offset += tv; }
  const size_t cb = ((size_t)bh * 129 + c) * 4096;
  float kt[16];
#pragma unroll
  for (int i = 0; i < 16; ++i) {
    const float bc = offset + cs[i];
    kt[i] = bf2f(kraw[i]) * __expf(-bc);
    G.QT[cb + (16 * w4 + i) * 64 + lane] = (bf16_t)f2bf(bf2f(qraw[i]) * __expf(bc) * 0.125f);
    G.KT[cb + (16 * w4 + i) * 64 + lane] = (bf16_t)f2bf(kt[i]);
  }
  u32x4 kp; kp.x = pk2(kt[0], kt[1]); kp.y = pk2(kt[2], kt[3]); kp.z = pk2(kt[4], kt[5]); kp.w = pk2(kt[6], kt[7]);
  *(u32x4*)(G.KTT + cb + lane * 64 + 16 * w4) = kp;
  kp.x = pk2(kt[8], kt[9]); kp.y = pk2(kt[10], kt[11]); kp.z = pk2(kt[12], kt[13]); kp.w = pk2(kt[14], kt[15]);
  *(u32x4*)(G.KTT + cb + lane * 64 + 16 * w4 + 8) = kp;
  if (w4 == 0) { G.DEC[((size_t)bh * 129 + c) * 64 + lane] = __expf(total); G.BL[((size_t)bh * 129 + c) * 64 + lane] = total; }
  __syncthreads();
}

struct GlaBuf { bf16_t Qt[64 * GLDS]; bf16_t Kt[64 * GLDS]; bf16_t KT[64 * GLDS]; };
struct GlaLds3 { GlaBuf B[2]; bf16_t P[64 * GLDS]; float ssq[8][64]; };
struct GlaPtrs3 { const bf16_t *QT, *KT, *KTT, *GVT, *GR; const float *DEC, *BL, *gla_g; float *SLOC, *DTOT; bf16_t* MIX; };

template <int PASS>
DI void gla_item3(int bh, int sc, char* smem, const GlaPtrs3& G) {
  GlaLds3& L = *(GlaLds3*)smem;
  const int tid = fresh_tid(), lane = tid & 63, w = __builtin_amdgcn_readfirstlane(tid >> 6), c16 = lane & 15, q = lane >> 4;
  const int b = bh >> 2, hd = bh & 3;
  const int cbeg = sc == 0 ? 0 : 8 * sc + 1, cend = 8 * sc + 9;
  f32x4 X[4];
#pragma unroll
  for (int i = 0; i < 4; ++i) X[i] = (f32x4){0.f, 0.f, 0.f, 0.f};
  if (PASS == 1) {
#pragma unroll 4
    for (int j = 0; j < sc; ++j) {
      const float* dt = G.DTOT + (size_t)(bh * 16 + j) * 64;
      const float* sl = G.SLOC + ((size_t)(bh * 16 + j) * 8 + w) * 16 * 64 + lane;
#pragma unroll
      for (int i = 0; i < 4; ++i) {
        const f32x4 d4 = *(const f32x4*)(dt + 16 * i + 4 * q);
        X[i][0] = d4.x * X[i][0] + sl[(4 * i + 0) * 64]; X[i][1] = d4.y * X[i][1] + sl[(4 * i + 1) * 64];
        X[i][2] = d4.z * X[i][2] + sl[(4 * i + 2) * 64]; X[i][3] = d4.w * X[i][3] + sl[(4 * i + 3) * 64];
      }
    }
  }
  f32x4 gain = {1.f, 1.f, 1.f, 1.f};
  if (PASS == 1) gain = *(const f32x4*)(G.gla_g + hd * 128 + 16 * w + 4 * q);
  const bf16_t* gvt = G.GVT + ((size_t)bh * 128 + 16 * w + c16) * GU + 8 * q;
  const int srow = tid >> 3, sc8 = tid & 7, soff = srow * GLDS + sc8 * 8;
  const size_t cb0 = (size_t)bh * 129 * 4096 + (size_t)srow * 64 + sc8 * 8;
  u32x4 rq, rk, rkt, rq2, rk2, rkt2; bf16x8 vfr[2], vfn[2], vfn2[2]; f32x4 dec[4], decn[4], decn2[4];
  {
    const size_t cb = cb0 + (size_t)cbeg * 4096;
    rkt = *(const u32x4*)(G.KTT + cb);
    if (PASS == 1) { rq = *(const u32x4*)(G.QT + cb); rk = *(const u32x4*)(G.KT + cb); }
    vfr[0] = *(const bf16x8*)(gvt + 64 * cbeg); vfr[1] = *(const bf16x8*)(gvt + 64 * cbeg + 32);
#pragma unroll
    for (int i = 0; i < 4; ++i) dec[i] = *(const f32x4*)(G.DEC + ((size_t)bh * 129 + cbeg) * 64 + 16 * i + 4 * q);
    *(u32x4*)&L.B[0].KT[soff] = rkt;
    if (PASS == 1) { *(u32x4*)&L.B[0].Qt[soff] = rq; *(u32x4*)&L.B[0].Kt[soff] = rk; }
    const size_t cb1 = cb0 + (size_t)(cbeg + 1) * 4096;
    rkt = *(const u32x4*)(G.KTT + cb1);
    if (PASS == 1) { rq = *(const u32x4*)(G.QT + cb1); rk = *(const u32x4*)(G.KT + cb1); }
    vfn[0] = *(const bf16x8*)(gvt + 64 * (cbeg + 1)); vfn[1] = *(const bf16x8*)(gvt + 64 * (cbeg + 1) + 32);
#pragma unroll
    for (int i = 0; i < 4; ++i) decn[i] = *(const f32x4*)(G.DEC + ((size_t)bh * 129 + cbeg + 1) * 64 + 16 * i + 4 * q);
  }
  __syncthreads();
  for (int c = cbeg; c < cend; ++c) {
    const int cur = (c - cbeg) & 1;
    const GlaBuf& Bc = L.B[cur];
    const bool more = c + 1 < cend, more2 = c + 2 < cend;
    if (more2) {
      const size_t cb = cb0 + (size_t)(c + 2) * 4096;
      rkt2 = *(const u32x4*)(G.KTT + cb);
      if (PASS == 1) { rq2 = *(const u32x4*)(G.QT + cb); rk2 = *(const u32x4*)(G.KT + cb); }
      vfn2[0] = *(const bf16x8*)(gvt + 64 * (c + 2)); vfn2[1] = *(const bf16x8*)(gvt + 64 * (c + 2) + 32);
#pragma unroll
      for (int i = 0; i < 4; ++i) decn2[i] = *(const f32x4*)(G.DEC + ((size_t)bh * 129 + c + 2) * 64 + 16 * i + 4 * q);
    }
    u32x2 grv[4];
    if (PASS == 1 && c >= 1) {
#pragma unroll
      for (int n = 0; n < 4; ++n) grv[n] = *(const u32x2*)(G.GR + ((size_t)b * SEQ + 64 * (c - 1) + 16 * n + c16) * 512 + hd * 128 + 16 * w + 4 * q);
    }
    f32x4 OT[4];
    if (PASS == 1) {
      const int is = w >> 1;
#pragma unroll
      for (int z = 0; z < 2; ++z) {
        const int it = 2 * (w & 1) + z;
        f32x4 pa = {0.f, 0.f, 0.f, 0.f};
        if (is <= it) {
#pragma unroll
          for (int kk = 0; kk < 2; ++kk) {
            const bf16x8 ka = *(const bf16x8*)&Bc.Kt[(16 * is + c16) * GLDS + 32 * kk + 8 * q];
            const bf16x8 qb = *(const bf16x8*)&Bc.Qt[(16 * it + c16) * GLDS + 32 * kk + 8 * q];
            pa = MFMA16(ka, qb, pa);
          }
          if (is == it) {
#pragma unroll
            for (int r = 0; r < 4; ++r) if (4 * q + r > c16) pa[r] = 0.f;
          }
        }
        u32x2 pw; pw.x = pk2(pa[0], pa[1]); pw.y = pk2(pa[2], pa[3]);
        *(u32x2*)&L.P[(16 * it + c16) * GLDS + 16 * is + 4 * q] = pw;
      }
#pragma unroll
      for (int n = 0; n < 4; ++n) OT[n] = (f32x4){0.f, 0.f, 0.f, 0.f};
#pragma unroll
      for (int kk = 0; kk < 2; ++kk) {
        u32x4 xp; xp.x = pk2(X[2 * kk][0], X[2 * kk][1]); xp.y = pk2(X[2 * kk][2], X[2 * kk][3]);
        xp.z = pk2(X[2 * kk + 1][0], X[2 * kk + 1][1]); xp.w = pk2(X[2 * kk + 1][2], X[2 * kk + 1][3]);
        const bf16x8 xa = __builtin_bit_cast(bf16x8, xp);
#pragma unroll
        for (int n = 0; n < 4; ++n) {
          const u32x2 lo = *(const u32x2*)&Bc.Qt[(16 * n + c16) * GLDS + 32 * kk + 4 * q];
          const u32x2 hi = *(const u32x2*)&Bc.Qt[(16 * n + c16) * GLDS + 32 * kk + 16 + 4 * q];
          u32x4 qq; qq.x = lo.x; qq.y = lo.y; qq.z = hi.x; qq.w = hi.y;
          OT[n] = MFMA16(xa, __builtin_bit_cast(bf16x8, qq), OT[n]);
        }
      }
      __syncthreads();
#pragma unroll
      for (int kk = 0; kk < 2; ++kk)
#pragma unroll
        for (int n = 0; n < 4; ++n) {
          const bf16x8 pb = *(const bf16x8*)&L.P[(16 * n + c16) * GLDS + 32 * kk + 8 * q];
          OT[n] = MFMA16(vfr[kk], pb, OT[n]);
        }
    }
#pragma unroll
    for (int i = 0; i < 4; ++i) {
#pragma unroll
      for (int kk = 0; kk < 2; ++kk) {
        const bf16x8 ka = *(const bf16x8*)&Bc.KT[(16 * i + c16) * GLDS + 32 * kk + 8 * q];
        X[i] = MFMA16(ka, vfr[kk], X[i]);
      }
      X[i][0] *= dec[i].x; X[i][1] *= dec[i].y; X[i][2] *= dec[i].z; X[i][3] *= dec[i].w;
    }
    if (PASS == 1 && c >= 1) {
      float ss[4];
#pragma unroll
      for (int n = 0; n < 4; ++n) {
        float v = OT[n][0] * OT[n][0] + OT[n][1] * OT[n][1] + OT[n][2] * OT[n][2] + OT[n][3] * OT[n][3];
        v += __shfl_xor(v, 16); v += __shfl_xor(v, 32);
        ss[n] = v;
      }
      if (q == 0) {
#pragma unroll
        for (int n = 0; n < 4; ++n) L.ssq[w][16 * n + c16] = ss[n];
      }
      __syncthreads();
#pragma unroll
      for (int n = 0; n < 4; ++n) {
        float tot = 0.f;
#pragma unroll
        for (int w2 = 0; w2 < 8; ++w2) tot += L.ssq[w2][16 * n + c16];
        const float scl = rsqrtf(tot * (1.0f / 128.0f) + EPS);
        const size_t m = (size_t)b * SEQ + 64 * (c - 1) + 16 * n + c16;
        const float r0 = bflo(grv[n].x), r1 = bfhi(grv[n].x), r2 = bflo(grv[n].y), r3 = bfhi(grv[n].y);
        const float o0 = OT[n][0] * scl * gain.x * (r0 / (1.f + __expf(-r0)));
        const float o1 = OT[n][1] * scl * gain.y * (r1 / (1.f + __expf(-r1)));
        const float o2 = OT[n][2] * scl * gain.z * (r2 / (1.f + __expf(-r2)));
        const float o3 = OT[n][3] * scl * gain.w * (r3 / (1.f + __expf(-r3)));
        u32x2 ow; ow.x = pk2(o0, o1); ow.y = pk2(o2, o3);
        *(u32x2*)(G.MIX + m * D + 512 + hd * 128 + 16 * w + 4 * q) = ow;
      }
    }
    if (more) {
      GlaBuf& Bn = L.B[cur ^ 1];
      *(u32x4*)&Bn.KT[soff] = rkt;
      if (PASS == 1) { *(u32x4*)&Bn.Qt[soff] = rq; *(u32x4*)&Bn.Kt[soff] = rk; }
      vfr[0] = vfn[0]; vfr[1] = vfn[1];
#pragma unroll
      for (int i = 0; i < 4; ++i) dec[i] = decn[i];
      rkt = rkt2; rq = rq2; rk = rk2; vfn[0] = vfn2[0]; vfn[1] = vfn2[1];
#pragma unroll
      for (int i = 0; i < 4; ++i) decn[i] = decn2[i];
    }
    __syncthreads();
  }
  if (PASS == 0) {
    float* sl = G.SLOC + ((size_t)(bh * 16 + sc) * 8 + w) * 16 * 64 + lane;
#pragma unroll
    for (int i = 0; i < 4; ++i)
#pragma unroll
      for (int r = 0; r < 4; ++r) sl[(4 * i + r) * 64] = X[i][r];
    if (w == 0) {
      float bl = 0.f;
      for (int c = cbeg; c < cend; ++c) bl += G.BL[((size_t)bh * 129 + c) * 64 + lane];
      G.DTOT[(size_t)(bh * 16 + sc) * 64 + lane] = __expf(bl);
    }
  }
}


struct GlaLds4 { GlaBuf B[2]; bf16_t P[64 * GLDS]; float ssq[4][64]; };
template <int PASS>
DI void gla_item4(int bh_lo, int sc, char* smem, const GlaPtrs3& G) {
  const int tid = fresh_tid(), lane = tid & 63, w = __builtin_amdgcn_readfirstlane(tid >> 6), c16 = lane & 15, q = lane >> 4;
  const int hb = w >> 2, w4 = w & 3, tid4 = tid & 255;
  GlaLds4& L = *(GlaLds4*)(smem + hb * (int)sizeof(GlaLds4));
  const int bh = bh_lo + 16 * hb, b = bh >> 2, hd = bh & 3;
  const int cbeg = sc == 0 ? 0 : 8 * sc + 1, cend = 8 * sc + 9;
  f32x4 X[2][4];
#pragma unroll
  for (int et = 0; et < 2; ++et)
#pragma unroll
    for (int i = 0; i < 4; ++i) X[et][i] = (f32x4){0.f, 0.f, 0.f, 0.f};
  if (PASS == 1) {
#pragma unroll 2
    for (int j = 0; j < sc; ++j) {
      const float* dt = G.DTOT + (size_t)(bh * 16 + j) * 64;
#pragma unroll
      for (int et = 0; et < 2; ++et) {
        const float* sl = G.SLOC + ((size_t)(bh * 16 + j) * 8 + w4 * 2 + et) * 16 * 64 + lane;
#pragma unroll
        for (int i = 0; i < 4; ++i) {
          const f32x4 d4 = *(const f32x4*)(dt + 16 * i + 4 * q);
          X[et][i][0] = d4.x * X[et][i][0] + sl[(4 * i + 0) * 64]; X[et][i][1] = d4.y * X[et][i][1] + sl[(4 * i + 1) * 64];
          X[et][i][2] = d4.z * X[et][i][2] + sl[(4 * i + 2) * 64]; X[et][i][3] = d4.w * X[et][i][3] + sl[(4 * i + 3) * 64];
        }
      }
    }
  }
  f32x4 gain[2];
#pragma unroll
  for (int et = 0; et < 2; ++et) gain[et] = PASS == 1 ? *(const f32x4*)(G.gla_g + hd * 128 + 32 * w4 + 16 * et + 4 * q) : (f32x4){1.f, 1.f, 1.f, 1.f};
  const bf16_t* gvt0 = G.GVT + ((size_t)bh * 128 + 32 * w4 + c16) * GU + 8 * q;
  const bf16_t* gvt1 = gvt0 + (size_t)16 * GU;
  const int soffA = (tid4 >> 3) * GLDS + (tid4 & 7) * 8, soffB = soffA + 32 * GLDS;
  const size_t cb0 = (size_t)bh * 129 * 4096 + (size_t)(tid4 >> 3) * 64 + (tid4 & 7) * 8;
  u32x4 rq[2], rk[2], rkt[2], rq2[2], rk2[2], rkt2[2];
  bf16x8 vfr[2][2], vfn[2][2]; f32x4 dec[4], decn[4];
#define G4_LOADT(rq_, rk_, rkt_, c_) { const size_t cb_ = cb0 + (size_t)(c_) * 4096; \
    rkt_[0] = *(const u32x4*)(G.KTT + cb_); rkt_[1] = *(const u32x4*)(G.KTT + cb_ + 2048); \
    if (PASS == 1) { rq_[0] = *(const u32x4*)(G.QT + cb_); rq_[1] = *(const u32x4*)(G.QT + cb_ + 2048); rk_[0] = *(const u32x4*)(G.KT + cb_); rk_[1] = *(const u32x4*)(G.KT + cb_ + 2048); } }
#define G4_LOADV(vf_, dc_, c_) { vf_[0][0] = *(const bf16x8*)(gvt0 + 64 * (c_)); vf_[0][1] = *(const bf16x8*)(gvt0 + 64 * (c_) + 32); \
    vf_[1][0] = *(const bf16x8*)(gvt1 + 64 * (c_)); vf_[1][1] = *(const bf16x8*)(gvt1 + 64 * (c_) + 32); \
    _Pragma("unroll") for (int i = 0; i < 4; ++i) dc_[i] = *(const f32x4*)(G.DEC + ((size_t)bh * 129 + (c_)) * 64 + 16 * i + 4 * q); }
#define G4_STORET(Bn_, rq_, rk_, rkt_) { *(u32x4*)&Bn_.KT[soffA] = rkt_[0]; *(u32x4*)&Bn_.KT[soffB] = rkt_[1]; \
    if (PASS == 1) { *(u32x4*)&Bn_.Qt[soffA] = rq_[0]; *(u32x4*)&Bn_.Qt[soffB] = rq_[1]; *(u32x4*)&Bn_.Kt[soffA] = rk_[0]; *(u32x4*)&Bn_.Kt[soffB] = rk_[1]; } }
  G4_LOADT(rq, rk, rkt, cbeg)
  G4_LOADV(vfr, dec, cbeg)
  G4_STORET(L.B[0], rq, rk, rkt)
  G4_LOADT(rq, rk, rkt, cbeg + 1)
  G4_LOADV(vfn, decn, cbeg + 1)
  __syncthreads();
  for (int c = cbeg; c < cend; ++c) {
    const int cur = (c - cbeg) & 1;
    const GlaBuf& Bc = L.B[cur];
    const bool more = c + 1 < cend, more2 = c + 2 < cend;
    if (more2) G4_LOADT(rq2, rk2, rkt2, c + 2)
    u32x2 grv[2][4];
    if (PASS == 1 && c >= 1) {
#pragma unroll
      for (int et = 0; et < 2; ++et)
#pragma unroll
        for (int n = 0; n < 4; ++n) grv[et][n] = *(const u32x2*)(G.GR + ((size_t)b * SEQ + 64 * (c - 1) + 16 * n + c16) * 512 + hd * 128 + 32 * w4 + 16 * et + 4 * q);
    }
    f32x4 OT[2][4];
    if (PASS == 1) {
      const int is = w4;
#pragma unroll
      for (int it = 0; it < 4; ++it) {
        f32x4 pa = {0.f, 0.f, 0.f, 0.f};
        if (is <= it) {
#pragma unroll
          for (int kk = 0; kk < 2; ++kk) {
            const bf16x8 ka = *(const bf16x8*)&Bc.Kt[(16 * is + c16) * GLDS + 32 * kk + 8 * q];
            const bf16x8 qb = *(const bf16x8*)&Bc.Qt[(16 * it + c16) * GLDS + 32 * kk + 8 * q];
            pa = MFMA16(ka, qb, pa);
          }
          if (is == it) {
#pragma unroll
            for (int r = 0; r < 4; ++r) if (4 * q + r > c16) pa[r] = 0.f;
          }
        }
        u32x2 pw; pw.x = pk2(pa[0], pa[1]); pw.y = pk2(pa[2], pa[3]);
        *(u32x2*)&L.P[(16 * it + c16) * GLDS + 16 * is + 4 * q] = pw;
      }
#pragma unroll
      for (int et = 0; et < 2; ++et)
#pragma unroll
        for (int n = 0; n < 4; ++n) OT[et][n] = (f32x4){0.f, 0.f, 0.f, 0.f};
#pragma unroll
      for (int kk = 0; kk < 2; ++kk) {
        bf16x8 xa[2];
#pragma unroll
        for (int et = 0; et < 2; ++et) {
          u32x4 xp; xp.x = pk2(X[et][2 * kk][0], X[et][2 * kk][1]); xp.y = pk2(X[et][2 * kk][2], X[et][2 * kk][3]);
          xp.z = pk2(X[et][2 * kk + 1][0], X[et][2 * kk + 1][1]); xp.w = pk2(X[et][2 * kk + 1][2], X[et][2 * kk + 1][3]);
          xa[et] = __builtin_bit_cast(bf16x8, xp);
        }
#pragma unroll
        for (int n = 0; n < 4; ++n) {
          const u32x2 lo = *(const u32x2*)&Bc.Qt[(16 * n + c16) * GLDS + 32 * kk + 4 * q];
          const u32x2 hi = *(const u32x2*)&Bc.Qt[(16 * n + c16) * GLDS + 32 * kk + 16 + 4 * q];
          u32x4 qq; qq.x = lo.x; qq.y = lo.y; qq.z = hi.x; qq.w = hi.y;
          const bf16x8 qf = __builtin_bit_cast(bf16x8, qq);
          OT[0][n] = MFMA16(xa[0], qf, OT[0][n]);
          OT[1][n] = MFMA16(xa[1], qf, OT[1][n]);
        }
      }
      __syncthreads();
#pragma unroll
      for (int kk = 0; kk < 2; ++kk)
#pragma unroll
        for (int n = 0; n < 4; ++n) {
          const bf16x8 pb = *(const bf16x8*)&L.P[(16 * n + c16) * GLDS + 32 * kk + 8 * q];
          OT[0][n] = MFMA16(vfr[0][kk], pb, OT[0][n]);
          OT[1][n] = MFMA16(vfr[1][kk], pb, OT[1][n]);
        }
    }
#pragma unroll
    for (int i = 0; i < 4; ++i) {
#pragma unroll
      for (int kk = 0; kk < 2; ++kk) {
        const bf16x8 ka = *(const bf16x8*)&Bc.KT[(16 * i + c16) * GLDS + 32 * kk + 8 * q];
        X[0][i] = MFMA16(ka, vfr[0][kk], X[0][i]);
        X[1][i] = MFMA16(ka, vfr[1][kk], X[1][i]);
      }
#pragma unroll
      for (int et = 0; et < 2; ++et) { X[et][i][0] *= dec[i].x; X[et][i][1] *= dec[i].y; X[et][i][2] *= dec[i].z; X[et][i][3] *= dec[i].w; }
    }
    if (PASS == 1 && c >= 1) {
      float ss[4];
#pragma unroll
      for (int n = 0; n < 4; ++n) {
        float v = OT[0][n][0] * OT[0][n][0] + OT[0][n][1] * OT[0][n][1] + OT[0][n][2] * OT[0][n][2] + OT[0][n][3] * OT[0][n][3]
                + OT[1][n][0] * OT[1][n][0] + OT[1][n][1] * OT[1][n][1] + OT[1][n][2] * OT[1][n][2] + OT[1][n][3] * OT[1][n][3];
        v += __shfl_xor(v, 16); v += __shfl_xor(v, 32);
        ss[n] = v;
      }
      if (q == 0) {
#pragma unroll
        for (int n = 0; n < 4; ++n) L.ssq[w4][16 * n + c16] = ss[n];
      }
      __syncthreads();
#pragma unroll
      for (int n = 0; n < 4; ++n) {
        const float tot = L.ssq[0][16 * n + c16] + L.ssq[1][16 * n + c16] + L.ssq[2][16 * n + c16] + L.ssq[3][16 * n + c16];
        const float scl = rsqrtf(tot * (1.0f / 128.0f) + EPS);
        const size_t m = (size_t)b * SEQ + 64 * (c - 1) + 16 * n + c16;
#pragma unroll
        for (int et = 0; et < 2; ++et) {
          const float r0 = bflo(grv[et][n].x), r1 = bfhi(grv[et][n].x), r2 = bflo(grv[et][n].y), r3 = bfhi(grv[et][n].y);
          const float o0 = OT[et][n][0] * scl * gain[et].x * r0 * __builtin_amdgcn_rcpf(1.f + __expf(-r0));
          const float o1 = OT[et][n][1] * scl * gain[et].y * r1 * __builtin_amdgcn_rcpf(1.f + __expf(-r1));
          const float o2 = OT[et][n][2] * scl * gain[et].z * r2 * __builtin_amdgcn_rcpf(1.f + __expf(-r2));
          const float o3 = OT[et][n][3] * scl * gain[et].w * r3 * __builtin_amdgcn_rcpf(1.f + __expf(-r3));
          u32x2 ow; ow.x = pk2(o0, o1); ow.y = pk2(o2, o3);
          *(u32x2*)(G.MIX + m * D + 512 + hd * 128 + 32 * w4 + 16 * et + 4 * q) = ow;
        }
      }
    }
    if (more) {
      GlaBuf& Bn = L.B[cur ^ 1];
      G4_STORET(Bn, rq, rk, rkt)
#pragma unroll
      for (int et = 0; et < 2; ++et) { vfr[et][0] = vfn[et][0]; vfr[et][1] = vfn[et][1]; }
#pragma unroll
      for (int i = 0; i < 4; ++i) dec[i] = decn[i];
#pragma unroll
      for (int z = 0; z < 2; ++z) { rkt[z] = rkt2[z]; rq[z] = rq2[z]; rk[z] = rk2[z]; }
      if (more2) G4_LOADV(vfn, decn, c + 2)
    }
    __syncthreads();
  }
#undef G4_LOADT
#undef G4_LOADV
#undef G4_STORET
  if (PASS == 0) {
#pragma unroll
    for (int et = 0; et < 2; ++et) {
      float* sl = G.SLOC + ((size_t)(bh * 16 + sc) * 8 + w4 * 2 + et) * 16 * 64 + lane;
#pragma unroll
      for (int i = 0; i < 4; ++i)
#pragma unroll
        for (int r = 0; r < 4; ++r) sl[(4 * i + r) * 64] = X[et][i][r];
    }
    if (w4 == 0) {
      float bl = 0.f;
      for (int c = cbeg; c < cend; ++c) bl += G.BL[((size_t)bh * 129 + c) * 64 + lane];
      G.DTOT[(size_t)(bh * 16 + sc) * 64 + lane] = __expf(bl);
    }
  }
}

DI void ce_desc(float& a, float& b) {
  const float hi = __builtin_fmaxf(a, b), lo = __builtin_fminf(a, b);
  a = hi; b = lo;
}
DI float vmaxf(float a, float b) { return __builtin_fmaxf(a, b); }
template <int N> DI void bitonic_sort_desc(float (&v)[N]) {
#pragma unroll
  for (int k = 2; k <= N; k <<= 1) {
#pragma unroll
    for (int j = k >> 1; j > 0; j >>= 1) {
#pragma unroll
      for (int i = 0; i < N; ++i) {
        const int l = i ^ j;
        if (l > i) { if ((i & k) == 0) ce_desc(v[i], v[l]); else ce_desc(v[l], v[i]); }
      }
    }
  }
}
DI void sort16_desc(float (&v)[16]) {
  ce_desc(v[0], v[1]); ce_desc(v[2], v[3]); ce_desc(v[0], v[2]); ce_desc(v[1], v[3]); ce_desc(v[1], v[2]); ce_desc(v[4], v[5]); ce_desc(v[6], v[7]); ce_desc(v[4], v[6]); ce_desc(v[5], v[7]); ce_desc(v[5], v[6]); ce_desc(v[0], v[4]); ce_desc(v[2], v[6]); ce_desc(v[2], v[4]); ce_desc(v[1], v[5]); ce_desc(v[3], v[7]); ce_desc(v[3], v[5]); ce_desc(v[1], v[2]); ce_desc(v[3], v[4]); ce_desc(v[5], v[6]); ce_desc(v[8], v[9]); ce_desc(v[10], v[11]); ce_desc(v[8], v[10]); ce_desc(v[9], v[11]); ce_desc(v[9], v[10]); ce_desc(v[12], v[13]); ce_desc(v[14], v[15]); ce_desc(v[12], v[14]); ce_desc(v[13], v[15]); ce_desc(v[13], v[14]); ce_desc(v[8], v[12]); ce_desc(v[10], v[14]); ce_desc(v[10], v[12]); ce_desc(v[9], v[13]); ce_desc(v[11], v[15]); ce_desc(v[11], v[13]); ce_desc(v[9], v[10]); ce_desc(v[11], v[12]); ce_desc(v[13], v[14]); ce_desc(v[0], v[8]); ce_desc(v[4], v[12]); ce_desc(v[4], v[8]); ce_desc(v[2], v[10]); ce_desc(v[6], v[14]); ce_desc(v[6], v[10]); ce_desc(v[2], v[4]); ce_desc(v[6], v[8]); ce_desc(v[10], v[12]); ce_desc(v[1], v[9]); ce_desc(v[5], v[13]); ce_desc(v[5], v[9]); ce_desc(v[3], v[11]); ce_desc(v[7], v[15]); ce_desc(v[7], v[11]); ce_desc(v[3], v[5]); ce_desc(v[7], v[9]); ce_desc(v[11], v[13]); ce_desc(v[1], v[2]); ce_desc(v[3], v[4]); ce_desc(v[5], v[6]); ce_desc(v[7], v[8]); ce_desc(v[9], v[10]); ce_desc(v[11], v[12]); ce_desc(v[13], v[14]);
}
DI void bitonic_merge16_desc(float (&v)[16]) {
#pragma unroll
  for (int j = 8; j > 0; j >>= 1) {
#pragma unroll
    for (int i = 0; i < 16; ++i) { const int l = i ^ j; if (l > i) ce_desc(v[i], v[l]); }
  }
}
template <int NBV> DI void merge_prune16(float (&a)[16], const float (&b)[16]) {
#pragma unroll
  for (int i = 16 - NBV; i < 16; ++i) a[i] = vmaxf(a[i], b[15 - i]);
  bitonic_merge16_desc(a);
}
DI float selh(int hh, float a, float b) { asm volatile("" : "+v"(a), "+v"(b)); return hh == 0 ? a : b; }
DI float pack_idx(float v, unsigned idx, unsigned mask) { return __uint_as_float((__float_as_uint(v) & ~mask) | idx); }

DI void route_stage_keys(int hd, char* smem, const bf16_t* __restrict__ SK1b, const bf16_t* __restrict__ SK2b) {
  const int tid256_ = fresh_tid() & 255;
  bf16_t* kl = (bf16_t*)smem;
#pragma unroll
  for (int i = 0; i < 8; ++i) {
    const int pz = TID + 256 * i, L = pz >> 10, row = (pz >> 3) & 127, c8 = pz & 7;
    const bf16_t* src = (L == 0 ? SK1b : SK2b) + (size_t)(hd * 128 + row) * 64 + c8 * 8;
    *(u32x4*)&kl[(L * 128 + row) * 72 + c8 * 8] = *(const u32x4*)src;
  }
  __syncthreads();
}
DI void route_load_q(bf16x8 (&qf)[2][4], const bf16_t* __restrict__ QP, int m, int hd, int hh) {
#pragma unroll
  for (int L = 0; L < 2; ++L)
#pragma unroll
    for (int ks = 0; ks < 4; ++ks) qf[L][ks] = *(const bf16x8*)(QP + (size_t)m * D + hd * 128 + L * 64 + hh * 8 + ks * 16);
}
DI void ph_route_v2(int vb, char* smem, const bf16x8 (&qf)[2][4], unsigned short* __restrict__ EIDX, float* __restrict__ GATE) {
  const int tid256_ = fresh_tid() & 255;
  const int lane = TID & 63, wave = TID >> 6, r = lane & 31, hh = lane >> 5;
  const int hd = vb & 7, tile = vb >> 3;
  const int m = tile * 128 + wave * 32 + r;
  const bf16_t* kl = (const bf16_t*)smem;
  float loc[2][16];
#pragma unroll
  for (int L = 0; L < 2; ++L) {
    float grp[4][16];
#pragma unroll
    for (int mt = 0; mt < 4; ++mt) {
      f32x16 acc;
#pragma unroll
      for (int e = 0; e < 16; ++e) acc[e] = 0.f;
#pragma unroll
      for (int ks = 0; ks < 4; ++ks) {
        const bf16x8 kf = *(const bf16x8*)&kl[(L * 128 + mt * 32 + r) * 72 + ks * 16 + hh * 8];
        acc = MFMA32(kf, qf[L][ks], acc);
      }
#pragma unroll
      for (int e = 0; e < 16; ++e) grp[mt][e] = pack_idx(acc[e], (unsigned)(mt * 32 + crow(e, hh)), 127u);
      sort16_desc(grp[mt]);
    }
    merge_prune16<16>(grp[0], grp[1]);
    merge_prune16<16>(grp[2], grp[3]);
    merge_prune16<16>(grp[0], grp[2]);
#pragma unroll
    for (int i = 0; i < 16; ++i) loc[L][i] = grp[0][i];
  }
  float fin[16], oth[16];
#pragma unroll
  for (int i = 0; i < 16; ++i) {
    const float send = selh(hh, loc[1][i], loc[0][i]);
    oth[i] = __shfl_xor(send, 32);
    fin[i] = selh(hh, loc[0][i], loc[1][i]);
  }
  merge_prune16<16>(fin, oth);
  float v1[16], v2[16];
#pragma unroll
  for (int i = 0; i < 16; ++i) {
    const float o = __shfl_xor(fin[i], 32);
    v1[i] = selh(hh, fin[i], o);
    v2[i] = selh(hh, o, fin[i]);
  }
  unsigned* ib = (unsigned*)(smem + 36864) + (size_t)TID * 8;
#pragma unroll
  for (int q = 0; q < 4; ++q) {
    unsigned w1 = 0, w2 = 0;
#pragma unroll
    for (int j = 0; j < 4; ++j) {
      w1 |= (__float_as_uint(v1[4 * q + j]) & 127u) << (8 * j);
      w2 |= (__float_as_uint(v2[4 * q + j]) & 127u) << (8 * j);
    }
    ib[q] = w1; ib[4 + q] = w2;
  }
  float R[16], Bv[16];
#pragma unroll
  for (int j = 0; j < 16; ++j) R[j] = pack_idx(v1[0] + v2[j], (unsigned)j, 255u);
#define ROUTE_ROW(I, CNT) { _Pragma("unroll") for (int j = 0; j < 16; ++j) Bv[j] = (j < CNT) ? pack_idx(v1[I] + v2[j < CNT ? j : 0], (unsigned)(I * 16 + j), 255u) : 0.f; \
    merge_prune16<CNT>(R, Bv); }
  ROUTE_ROW(1, 8) ROUTE_ROW(2, 5) ROUTE_ROW(3, 4) ROUTE_ROW(4, 3) ROUTE_ROW(5, 2) ROUTE_ROW(6, 2) ROUTE_ROW(7, 2)
#undef ROUTE_ROW
#pragma unroll
  for (int j = 0; j < 16; ++j) Bv[j] = (j < 8) ? pack_idx(v1[8 + (j < 8 ? j : 0)] + v2[0], (unsigned)((8 + j) * 16), 255u) : 0.f;
  merge_prune16<8>(R, Bv);
  float ex[16], sum = 0.f;
#pragma unroll
  for (int i = 0; i < 16; ++i) { ex[i] = __expf(R[i] - R[0]); sum += ex[i]; }
  const float inv = 1.f / sum;
  const unsigned char* ibb = (const unsigned char*)ib;
  int eo[8]; float go[8];
#pragma unroll
  for (int w = 0; w < 8; ++w) {
    const float rv = selh(hh, R[w], R[8 + w]);
    const float ev = selh(hh, ex[w], ex[8 + w]);
    const unsigned pos = __float_as_uint(rv) & 255u;
    const unsigned i1 = ibb[pos >> 4], i2 = ibb[16 + (pos & 15u)];
    eo[w] = (int)(i1 * 128u + i2);
    go[w] = ev * inv;
  }
  unsigned short* ep = EIDX + (size_t)m * 128 + hd * 16 + hh * 8;
  float* gp = GATE + (size_t)m * 128 + hd * 16 + hh * 8;
  *(u32x4*)ep = (u32x4){(unsigned)eo[0] | ((unsigned)eo[1] << 16), (unsigned)eo[2] | ((unsigned)eo[3] << 16), (unsigned)eo[4] | ((unsigned)eo[5] << 16), (unsigned)eo[6] | ((unsigned)eo[7] << 16)};
  *(f32x4*)gp = (f32x4){go[0], go[1], go[2], go[3]};
  *(f32x4*)(gp + 4) = (f32x4){go[4], go[5], go[6], go[7]};
}


typedef unsigned char u8_t;
constexpr size_t WS_SCU = 14 * MiB;
constexpr size_t WS_SCV = 14 * MiB + 65536;
DI float wave_max(float v) {
#pragma unroll
  for (int o = 32; o >= 1; o >>= 1) v = fmaxf(v, __shfl_xor(v, o));
  return v;
}
DI u32x4 quant_row16(const float* __restrict__ rowp, int lane, float& sc) {
  const f32x4* rp = (const f32x4*)(rowp + lane * 16);
  const f32x4 a = rp[0], b = rp[1], c = rp[2], d = rp[3];
  float m = fmaxf(fmaxf(fmaxf(fabsf(a.x), fabsf(a.y)), fmaxf(fabsf(a.z), fabsf(a.w))), fmaxf(fmaxf(fabsf(b.x), fabsf(b.y)), fmaxf(fabsf(b.z), fabsf(b.w))));
  m = fmaxf(m, fmaxf(fmaxf(fmaxf(fabsf(c.x), fabsf(c.y)), fmaxf(fabsf(c.z), fabsf(c.w))), fmaxf(fmaxf(fabsf(d.x), fabsf(d.y)), fmaxf(fabsf(d.z), fabsf(d.w)))));
  m = wave_max(m);
  sc = m > 0.f ? m * (1.0f / 448.0f) : 1.0f;
  const float inv = 1.0f / sc;
  u32x4 o; unsigned w;
  w = 0; w = __builtin_amdgcn_cvt_pk_fp8_f32(a.x * inv, a.y * inv, w, false); w = __builtin_amdgcn_cvt_pk_fp8_f32(a.z * inv, a.w * inv, w, true); o.x = w;
  w = 0; w = __builtin_amdgcn_cvt_pk_fp8_f32(b.x * inv, b.y * inv, w, false); w = __builtin_amdgcn_cvt_pk_fp8_f32(b.z * inv, b.w * inv, w, true); o.y = w;
  w = 0; w = __builtin_amdgcn_cvt_pk_fp8_f32(c.x * inv, c.y * inv, w, false); w = __builtin_amdgcn_cvt_pk_fp8_f32(c.z * inv, c.w * inv, w, true); o.z = w;
  w = 0; w = __builtin_amdgcn_cvt_pk_fp8_f32(d.x * inv, d.y * inv, w, false); w = __builtin_amdgcn_cvt_pk_fp8_f32(d.z * inv, d.w * inv, w, true); o.w = w;
  return o;
}
DI void ph_convert_ev8(int vb, char* smem, const float* __restrict__ src, u8_t* __restrict__ EV8c, float* __restrict__ scaleV) {
  const int tid256_ = fresh_tid() & 255;
  u8_t (*t)[1040] = (u8_t (*)[1040])smem;
  const int lane = TID & 63, wave = TID >> 6, e0 = vb * 32;
  for (int rr = 0; rr < 8; ++rr) {
    const int r = wave * 8 + rr;
    float sc;
    const u32x4 o = quant_row16(src + (size_t)(e0 + r) * D, lane, sc);
    *(u32x4*)&t[r][lane * 16] = o;
    if (lane == 0) scaleV[e0 + r] = sc;
  }
  __syncthreads();
  const int r = TID & 31, cs = TID >> 5;
  for (int c0 = 0; c0 < 128; c0 += 8) {
    const int cg = c0 + cs;
    const u32x2 v = *(const u32x2*)&t[r][cg * 8];
    *(u32x2*)(EV8c + ((size_t)cg * NEXP + e0 + r) * 8) = v;
  }
  __syncthreads();
}
struct PeerUHalf { u32x4 u[8]; };
DI void ph_peer_c8(int unit, char* smem, const bf16_t* __restrict__ PP, const unsigned short* __restrict__ EIDX, const float* __restrict__ GATE,
                   const float* __restrict__ scaleU, const float* __restrict__ scaleV, unsigned* __restrict__ STREAM) {
  unsigned (*tile)[132] = (unsigned (*)[132])smem;
  const int tid = fresh_tid();
  const int tl = tid >> 3, kc = tid & 7;
  const size_t rowoff = ((size_t)unit * 64 + tl) * 128 + kc * 16;
  const size_t n = (size_t)TREAL * 128;
  float a[16];
#pragma unroll
  for (int j = 0; j < 16; ++j) a[j] = 0.f;
#pragma unroll
  for (int s = 0; s < 8; ++s) {
    const u32x4 p0 = *(const u32x4*)(PP + (size_t)s * n + rowoff), p1 = *(const u32x4*)(PP + (size_t)s * n + rowoff + 8);
    a[0] += bflo(p0.x); a[1] += bfhi(p0.x); a[2] += bflo(p0.y); a[3] += bfhi(p0.y); a[4] += bflo(p0.z); a[5] += bfhi(p0.z); a[6] += bflo(p0.w); a[7] += bfhi(p0.w);
    a[8] += bflo(p1.x); a[9] += bfhi(p1.x); a[10] += bflo(p1.y); a[11] += bfhi(p1.y); a[12] += bflo(p1.z); a[13] += bfhi(p1.z); a[14] += bflo(p1.w); a[15] += bfhi(p1.w);
  }
  const u32x4 e0 = *(const u32x4*)(EIDX + rowoff), e1 = *(const u32x4*)(EIDX + rowoff + 8);
  unsigned ev[16] = {e0.x & 0xffffu, e0.x >> 16, e0.y & 0xffffu, e0.y >> 16, e0.z & 0xffffu, e0.z >> 16, e0.w & 0xffffu, e0.w >> 16,
                     e1.x & 0xffffu, e1.x >> 16, e1.y & 0xffffu, e1.y >> 16, e1.z & 0xffffu, e1.z >> 16, e1.w & 0xffffu, e1.w >> 16};
  float gt[16];
#pragma unroll
  for (int j = 0; j < 4; ++j) { const f32x4 g4 = *(const f32x4*)(GATE + rowoff + 4 * j); gt[4 * j] = g4.x; gt[4 * j + 1] = g4.y; gt[4 * j + 2] = g4.z; gt[4 * j + 3] = g4.w; }
#pragma unroll
  for (int j = 0; j < 16; ++j) {
    const unsigned e = ev[j];
    const float av = a[j] * scaleU[e];
    const float act = 0.5f * av * (1.f + erff(av * 0.70710678118654752f));
    const float c = gt[j] * act * scaleV[e];
    tile[tl][kc * 16 + j] = e | (f2bf(c) << 16);
  }
  __syncthreads();
  unsigned* outp = STREAM + (size_t)unit * 8192;
#pragma unroll 4
  for (int j = 0; j < 16; ++j) {
    const int o = tid + 512 * j, q = o >> 8, t2 = (o >> 2) & 63, z = o & 3;
    outp[o] = tile[t2][4 * q + z];
  }
  __syncthreads();
}
struct PVW { u32x4 a, b; };
struct PVT { u32x2 v[8]; };
DI void pv_loadw(PVW& W, const unsigned* __restrict__ STREAM, int it, int g, int lane) {
  const u32x4* sp = (const u32x4*)(STREAM + (size_t)it * 8192) + lane;
  W.a = sp[(2 * g) * 64]; W.b = sp[(2 * g + 1) * 64];
}
DI void pv_readt(PVT& T, const PVW& W, const u32x2* tabl) {
  T.v[0] = tabl[W.a.x & 0xffffu]; T.v[1] = tabl[W.a.y & 0xffffu]; T.v[2] = tabl[W.a.z & 0xffffu]; T.v[3] = tabl[W.a.w & 0xffffu];
  T.v[4] = tabl[W.b.x & 0xffffu]; T.v[5] = tabl[W.b.y & 0xffffu]; T.v[6] = tabl[W.b.z & 0xffffu]; T.v[7] = tabl[W.b.w & 0xffffu];
}
DI void pv_fma1(unsigned w, const u32x2 v, f32x2 (&y)[4]) {
  const float c = bfhi(w);
  const f32x2 cc = {c, c};
  y[0] = __builtin_elementwise_fma(__builtin_amdgcn_cvt_pk_f32_fp8(v.x, false), cc, y[0]);
  y[1] = __builtin_elementwise_fma(__builtin_amdgcn_cvt_pk_f32_fp8(v.x, true), cc, y[1]);
  y[2] = __builtin_elementwise_fma(__builtin_amdgcn_cvt_pk_f32_fp8(v.y, false), cc, y[2]);
  y[3] = __builtin_elementwise_fma(__builtin_amdgcn_cvt_pk_f32_fp8(v.y, true), cc, y[3]);
}
DI void pv_fma(const PVW& W, const PVT& T, f32x2 (&y)[4]) {
  pv_fma1(W.a.x, T.v[0], y); pv_fma1(W.a.y, T.v[1], y); pv_fma1(W.a.z, T.v[2], y); pv_fma1(W.a.w, T.v[3], y);
  pv_fma1(W.b.x, T.v[4], y); pv_fma1(W.b.y, T.v[5], y); pv_fma1(W.b.z, T.v[6], y); pv_fma1(W.b.w, T.v[7], y);
}
DI void ph_peer_v8(char* smem, const unsigned* __restrict__ STREAM, const u8_t* __restrict__ EV8c, bf16_t* __restrict__ YT) {
  const int tid = fresh_tid(), lane = tid & 63, wave = tid >> 6;
  const u32x2* tabl = (const u32x2*)smem;
  for (int unit = blockIdx.x; unit < 256; unit += gridDim.x) {
    const int cg = unit & 127, th = unit >> 7;
    const u32x4* src = (const u32x4*)(EV8c + (size_t)cg * NEXP * 8);
#pragma unroll 4
    for (int i = tid; i < NEXP * 8 / 16; i += 512) ((u32x4*)smem)[i] = src[i];
    __syncthreads();
    const int it_end = th * 512 + 512;
    int it = th * 512 + wave;
    PVW W0, W1, W2, W3; PVT T0, T1;
    pv_loadw(W0, STREAM, it, 0, lane); pv_loadw(W1, STREAM, it, 1, lane);
    pv_readt(T0, W0, tabl);
    for (; it < it_end; it += 8) {
      const int itn = (it + 8 < it_end) ? it + 8 : it;
      f32x2 y[4];
#pragma unroll
      for (int z = 0; z < 4; ++z) y[z] = (f32x2){0.f, 0.f};
#define PV_STEP(g, Wld, Wrd, Trd, Wc, Tc) \
      pv_loadw(Wld, STREAM, ((g) + 2 < 16) ? it : itn, ((g) + 2) & 15, lane); \
      pv_readt(Trd, Wrd, tabl); \
      pv_fma(Wc, Tc, y); \
      asm volatile("" ::: "memory");
      PV_STEP(0, W2, W1, T1, W0, T0)  PV_STEP(1, W3, W2, T0, W1, T1)  PV_STEP(2, W0, W3, T1, W2, T0)  PV_STEP(3, W1, W0, T0, W3, T1)
      PV_STEP(4, W2, W1, T1, W0, T0)  PV_STEP(5, W3, W2, T0, W1, T1)  PV_STEP(6, W0, W3, T1, W2, T0)  PV_STEP(7, W1, W0, T0, W3, T1)
      PV_STEP(8, W2, W1, T1, W0, T0)  PV_STEP(9, W3, W2, T0, W1, T1)  PV_STEP(10, W0, W3, T1, W2, T0) PV_STEP(11, W1, W0, T0, W3, T1)
      PV_STEP(12, W2, W1, T1, W0, T0) PV_STEP(13, W3, W2, T0, W1, T1) PV_STEP(14, W0, W3, T1, W2, T0) PV_STEP(15, W1, W0, T0, W3, T1)
#undef PV_STEP
      const int t = it * 64 + lane;
      u32x4 yw; yw.x = pk2(y[0].x, y[0].y); yw.y = pk2(y[1].x, y[1].y); yw.z = pk2(y[2].x, y[2].y); yw.w = pk2(y[3].x, y[3].y);
      *(u32x4*)(YT + ((size_t)cg * TREAL + t) * 8) = yw;
    }
    __syncthreads();
  }
}


DI void ph_final_lds(int unit, char* smem, const bf16_t* __restrict__ H1, const bf16_t* __restrict__ YT, const float* __restrict__ gf, float* __restrict__ out) {
  float (*h2)[1028] = (float (*)[1028])smem;
  const int tid = fresh_tid(), lane = tid & 63, wave = tid >> 6;
  const int t0 = unit * 32;
#pragma unroll
  for (int rr = 0; rr < 4; ++rr) {
    const int r = wave * 4 + rr;
    const bf16_t* hp = H1 + (size_t)(t0 + r) * D;
#pragma unroll
    for (int j = 0; j < 2; ++j) {
      const u32x4 hw = *(const u32x4*)(hp + j * 512 + lane * 8);
      *(f32x4*)&h2[r][j * 512 + lane * 8] = (f32x4){bflo(hw.x), bfhi(hw.x), bflo(hw.y), bfhi(hw.y)};
      *(f32x4*)&h2[r][j * 512 + lane * 8 + 4] = (f32x4){bflo(hw.z), bfhi(hw.z), bflo(hw.w), bfhi(hw.w)};
    }
  }
  __syncthreads();
  {
    const int tok = lane & 31;
#pragma unroll 4
    for (int cg = wave * 2 + (lane >> 5); cg < 128; cg += 16) {
      const u32x4 yw = *(const u32x4*)(YT + ((size_t)cg * TREAL + t0 + tok) * 8);
      f32x4* hp = (f32x4*)&h2[tok][cg * 8];
      f32x4 a = hp[0], b4 = hp[1];
      a.x += bflo(yw.x); a.y += bfhi(yw.x); a.z += bflo(yw.y); a.w += bfhi(yw.y);
      b4.x += bflo(yw.z); b4.y += bfhi(yw.z); b4.z += bflo(yw.w); b4.w += bfhi(yw.w);
      hp[0] = a; hp[1] = b4;
    }
  }
  __syncthreads();
#pragma unroll
  for (int rr = 0; rr < 4; ++rr) {
    const int r = wave * 4 + rr;
    f32x4 v[4]; float ss = 0.f;
#pragma unroll
    for (int j = 0; j < 4; ++j) { v[j] = *(const f32x4*)&h2[r][j * 256 + lane * 4]; ss += v[j].x * v[j].x + v[j].y * v[j].y + v[j].z * v[j].z + v[j].w * v[j].w; }
    ss = wave_sum(ss);
    const float sc = rsqrtf(ss * (1.0f / D) + EPS);
    float* op = out + (size_t)(t0 + r) * D;
#pragma unroll
    for (int j = 0; j < 4; ++j) {
      const f32x4 gg = *(const f32x4*)(gf + j * 256 + lane * 4);
      *(f32x4*)(op + j * 256 + lane * 4) = (f32x4){v[j].x * sc * gg.x, v[j].y * sc * gg.y, v[j].z * sc * gg.z, v[j].w * sc * gg.w};
    }
  }
  __syncthreads();
}

typedef int i32x4 __attribute__((ext_vector_type(4)));
constexpr size_t WS_XQ = 861 * MiB;
constexpr size_t WS_XS = 943 * MiB;
DI unsigned pack_i8x4(float a, float b, float c, float d) {
  const int ia = __float2int_rn(a), ib = __float2int_rn(b), ic = __float2int_rn(c), id = __float2int_rn(d);
  return ((unsigned)ia & 255u) | (((unsigned)ib & 255u) << 8) | (((unsigned)ic & 255u) << 16) | ((unsigned)id << 24);
}
DI u32x4 quant_row16_i8(const float* __restrict__ rowp, int lane, float& sc) {
  const f32x4* rp = (const f32x4*)(rowp + lane * 16);
  const f32x4 a = rp[0], b = rp[1], c = rp[2], d = rp[3];
  float m = fmaxf(fmaxf(fmaxf(fabsf(a.x), fabsf(a.y)), fmaxf(fabsf(a.z), fabsf(a.w))), fmaxf(fmaxf(fabsf(b.x), fabsf(b.y)), fmaxf(fabsf(b.z), fabsf(b.w))));
  m = fmaxf(m, fmaxf(fmaxf(fmaxf(fabsf(c.x), fabsf(c.y)), fmaxf(fabsf(c.z), fabsf(c.w))), fmaxf(fmaxf(fabsf(d.x), fabsf(d.y)), fmaxf(fabsf(d.z), fabsf(d.w)))));
  m = wave_max(m);
  sc = m > 0.f ? m * (1.0f / 127.0f) : 1.0f;
  const float inv = 1.0f / sc;
  u32x4 o;
  o.x = pack_i8x4(a.x * inv, a.y * inv, a.z * inv, a.w * inv); o.y = pack_i8x4(b.x * inv, b.y * inv, b.z * inv, b.w * inv);
  o.z = pack_i8x4(c.x * inv, c.y * inv, c.z * inv, c.w * inv); o.w = pack_i8x4(d.x * inv, d.y * inv, d.z * inv, d.w * inv);
  return o;
}
DI void ph_convert_eu_i8(const float* __restrict__ src, u8_t* __restrict__ EUq, float* __restrict__ scaleU) {
  const int tid = fresh_tid(), lane = tid & 63, wave = tid >> 6;
  for (int e = (blockIdx.x * 8 + wave) * 2; e < NEXP; e += gridDim.x * 16) {
    float sc0, sc1 = 1.f;
    const bool two = e + 1 < NEXP;
    const u32x4 o0 = quant_row16_i8(src + (size_t)e * D, lane, sc0);
    u32x4 o1 = o0;
    if (two) o1 = quant_row16_i8(src + (size_t)(e + 1) * D, lane, sc1);
    *(u32x4*)(EUq + ((size_t)(lane >> 3) * NEXP + e) * 128 + (lane & 7) * 16) = o0;
    if (two) *(u32x4*)(EUq + ((size_t)(lane >> 3) * NEXP + e + 1) * 128 + (lane & 7) * 16) = o1;
    if (lane == 0) { scaleU[e] = sc0; if (two) scaleU[e + 1] = sc1; }
  }
}
DI void ph_norm2_rows(int vb, const bf16_t* __restrict__ src, const float* __restrict__ gain, float* __restrict__ R2, u8_t* __restrict__ XQ, float* __restrict__ XS) {
  const int tid256_ = fresh_tid() & 255;
  const int row0 = vb * 16 + (TID >> 6) * 4, lane = TID & 63;
  u32x2 raw[4][4];
#pragma unroll
  for (int rr = 0; rr < 4; ++rr)
#pragma unroll
    for (int j = 0; j < 4; ++j) raw[rr][j] = *(const u32x2*)(src + (size_t)(row0 + rr) * D + j * 256 + lane * 4);
  f32x4 gg[4];
#pragma unroll
  for (int j = 0; j < 4; ++j) gg[j] = *(const f32x4*)(gain + j * 256 + lane * 4);
#pragma unroll
  for (int rr = 0; rr < 4; ++rr) {
    f32x4 v[4]; float ss = 0.f;
#pragma unroll
    for (int j = 0; j < 4; ++j) {
      v[j] = (f32x4){bflo(raw[rr][j].x), bfhi(raw[rr][j].x), bflo(raw[rr][j].y), bfhi(raw[rr][j].y)};
      ss += v[j].x * v[j].x + v[j].y * v[j].y + v[j].z * v[j].z + v[j].w * v[j].w;
    }
    ss = wave_sum(ss);
    const float r = rsqrtf(ss * (1.0f / D) + EPS);
    if (lane == 0) R2[row0 + rr] = r;
#pragma unroll
    for (int j = 0; j < 4; ++j) {
      const float a0 = v[j].x * gg[j].x, a1 = v[j].y * gg[j].y, a2 = v[j].z * gg[j].z, a3 = v[j].w * gg[j].w;
      float m = fmaxf(fmaxf(fabsf(a0), fabsf(a1)), fmaxf(fabsf(a2), fabsf(a3)));
#pragma unroll
      for (int sh = 16; sh >= 1; sh >>= 1) m = fmaxf(m, __shfl_xor(m, sh));
      const float inv = m > 0.f ? 127.0f / m : 0.f;
      *(unsigned*)(XQ + (size_t)(row0 + rr) * D + j * 256 + lane * 4) = pack_i8x4(a0 * inv, a1 * inv, a2 * inv, a3 * inv);
      if ((lane & 31) == 0) XS[(size_t)(row0 + rr) * 8 + 2 * j + (lane >> 5)] = m * r * (1.0f / 127.0f);
    }
  }
}
DI int dpp_i(int v, const int sel) {
  if (sel == 0) return __builtin_amdgcn_update_dpp(0, v, 0xB1, 0xF, 0xF, true);
  if (sel == 1) return __builtin_amdgcn_update_dpp(0, v, 0x4E, 0xF, 0xF, true);
  return __builtin_amdgcn_update_dpp(0, v, 0x141, 0xF, 0xF, true);
}
DI int dpp_isum8(int v) { v += dpp_i(v, 0); v += dpp_i(v, 1); v += dpp_i(v, 2); return v; }
template <int HF> DI void peer_ud4_issue(PeerUHalf& H, unsigned idxpair, int lane, const u8_t* __restrict__ tab) {
#pragma unroll
  for (int jj = 0; jj < 8; ++jj) {
    const int j = 8 * HF + jj;
    const unsigned w = (unsigned)__shfl((int)idxpair, (lane & ~7) + (j >> 1));
    const unsigned e = (j & 1) ? (w >> 16) : (w & 0xffffu);
    H.u[jj] = *(const u32x4*)(tab + (size_t)e * 128);
  }
}
template <int HF> DI void peer_ud4_compute(const PeerUHalf& H, const u32x4 xq, int sub, int& res0, int& res1) {
#pragma unroll
  for (int jj = 0; jj < 8; ++jj) {
    const int j = 8 * HF + jj;
    int acc = 0;
    acc = __builtin_amdgcn_sdot4((int)H.u[jj].x, (int)xq.x, acc, false); acc = __builtin_amdgcn_sdot4((int)H.u[jj].y, (int)xq.y, acc, false);
    acc = __builtin_amdgcn_sdot4((int)H.u[jj].z, (int)xq.z, acc, false); acc = __builtin_amdgcn_sdot4((int)H.u[jj].w, (int)xq.w, acc, false);
    acc = dpp_isum8(acc);
    if (sub == (j >> 1)) { if (j & 1) res1 = acc; else res0 = acc; }
  }
}
DI void ph_peer_u_d4(int xi, int nx, int wv, int nwv, const u8_t* __restrict__ XQ, const float* __restrict__ XS, const u8_t* __restrict__ EUq,
                     const unsigned short* __restrict__ EIDX, bf16_t* __restrict__ PP) {
  const int lane = fresh_tid() & 63, sub = lane & 7;
  const int ntok = (TREAL - wv + nwv - 1) / nwv;
#define PU_TOK(i) (wv + ((i) < ntok ? (i) : ntok - 1) * nwv)
#define PU_IDX(t) __builtin_nontemporal_load((const unsigned*)(EIDX + (size_t)(t) * 128) + lane)
#define PU_LDX(xq_, xs_, t) { xq_ = *(const u32x4*)(xbase + (size_t)(t) * D); xs_ = XS[(size_t)(t) * 8 + s]; }
#define PU_STORE(t, r0, r1, xs_) __builtin_nontemporal_store(pk2((float)(r0) * (xs_), (float)(r1) * (xs_)), (unsigned*)(pp + (size_t)(t) * 128) + lane)
  for (int s = xi; s < 8; s += nx) {
    const u8_t* tab = EUq + (size_t)s * NEXP * 128 + sub * 16;
    const u8_t* xbase = XQ + s * 128 + sub * 16;
    bf16_t* pp = PP + (size_t)s * TREAL * 128;
    PeerUHalf HA, HB, HC;
    int ta = PU_TOK(0), tb = PU_TOK(1), tc = PU_TOK(2);
    unsigned ia = PU_IDX(ta), ib = PU_IDX(tb), ic = PU_IDX(tc);
    u32x4 xqa; float xsa; PU_LDX(xqa, xsa, ta);
    peer_ud4_issue<0>(HA, ia, lane, tab);
    peer_ud4_issue<1>(HB, ia, lane, tab);
    for (int i = 0; i < ntok; i += 3) {
      const int td = PU_TOK(i + 3), te = PU_TOK(i + 4), tf = PU_TOK(i + 5);
      u32x4 xqb, xqc, xqd; float xsb, xsc, xsd;
      int r0, r1;
      peer_ud4_issue<0>(HC, ib, lane, tab); PU_LDX(xqb, xsb, tb); const unsigned id = PU_IDX(td);
      r0 = 0; r1 = 0;
      peer_ud4_compute<0>(HA, xqa, sub, r0, r1);
      peer_ud4_issue<1>(HA, ib, lane, tab);
      peer_ud4_compute<1>(HB, xqa, sub, r0, r1);
      PU_STORE(ta, r0, r1, xsa);
      peer_ud4_issue<0>(HB, ic, lane, tab); PU_LDX(xqc, xsc, tc); const unsigned ie = PU_IDX(te);
      r0 = 0; r1 = 0;
      peer_ud4_compute<0>(HC, xqb, sub, r0, r1);
      peer_ud4_issue<1>(HC, ic, lane, tab);
      peer_ud4_compute<1>(HA, xqb, sub, r0, r1);
      PU_STORE(tb, r0, r1, xsb);
      peer_ud4_issue<0>(HA, id, lane, tab); PU_LDX(xqd, xsd, td); const unsigned if_ = PU_IDX(tf);
      r0 = 0; r1 = 0;
      peer_ud4_compute<0>(HB, xqc, sub, r0, r1);
      peer_ud4_issue<1>(HB, id, lane, tab);
      peer_ud4_compute<1>(HC, xqc, sub, r0, r1);
      PU_STORE(tc, r0, r1, xsc);
      ta = td; tb = te; tc = tf; ib = ie; ic = if_; xqa = xqd; xsa = xsd;
    }
  }
#undef PU_TOK
#undef PU_IDX
#undef PU_LDX
#undef PU_STORE
}

struct PUI { i32x4 a[8]; };
struct PUE { int e[8]; };

#define XB_TMO      128
#define XB_XCNT(j)  (256  + 64 * (j))
#define XB_XSUB(j)  (1280 + 64 * (j))
#define XB_XGEN(j)  (2304 + 64 * (j))
#define XB_TOP      3328
#define XB_TOPGEN   3392
#define XCD_BAR_WORDS 3456
#define XB_SPIN_CAP (1u << 20)
#define LAS __attribute__((address_space(3)))
DI unsigned xb_ld(unsigned* p)              { return __hip_atomic_load(p, __ATOMIC_RELAXED, __HIP_MEMORY_SCOPE_AGENT); }
DI unsigned xb_add(unsigned* p, unsigned v) { return __hip_atomic_fetch_add(p, v, __ATOMIC_RELAXED, __HIP_MEMORY_SCOPE_AGENT); }
DI unsigned xb_xcc_id() { return (unsigned)__builtin_amdgcn_s_getreg((3 << 11) | 20) & 0xFu; }
#define XB_SPIN(cond, bar) do { unsigned _sp = 0; while (cond) { __builtin_amdgcn_s_sleep(1); \
    if ((++_sp & 255u) == 0u) { if (xb_ld(&(bar)[XB_TMO])) break; if (_sp > XB_SPIN_CAP) { atomicAdd(&(bar)[XB_TMO], 1u); break; } } } } while (0)
struct XcdBarrier { unsigned* bar; unsigned x; volatile unsigned* st; };
DI XcdBarrier xcd_barrier_post(unsigned* bar, volatile unsigned* st) {
  XcdBarrier b; b.bar = bar; b.x = xb_xcc_id(); b.st = st;
  if (threadIdx.x == 0) (void)xb_add(&bar[XB_XCNT(b.x)], 1u);
  return b;
}
DI void xcd_barrier_complete(unsigned* bar, unsigned x, unsigned& nloc, unsigned& nx) {
  const unsigned G = gridDim.x;
  unsigned sum, cnt, mine, sp = 0u;
  for (;;) {
    sum = 0u; cnt = 0u; mine = 0u;
#pragma unroll
    for (unsigned j = 0; j < 16; ++j) { const unsigned c = xb_ld(&bar[XB_XCNT(j)]); sum += c; cnt += (c > 0u) ? 1u : 0u; mine = (j == x) ? c : mine; }
    if (sum == G) break;
    __builtin_amdgcn_s_sleep(1);
    if ((++sp & 255u) == 0u) { if (xb_ld(&bar[XB_TMO])) break; if (sp > XB_SPIN_CAP) { atomicAdd(&bar[XB_TMO], 1u); break; } }
  }
  nloc = mine > 0u ? mine : 1u; nx = cnt > 0u ? cnt : 1u;
}
DI void xcd_barrier(const XcdBarrier& b) {
  asm volatile("s_waitcnt vmcnt(0)" ::: "memory");
  __syncthreads();
  if (threadIdx.x == 0) {
    unsigned* bar = b.bar;
    __builtin_amdgcn_s_waitcnt(0);
    unsigned nloc = b.st[0], nx = b.st[1];
    if (nloc == 0u) { xcd_barrier_complete(bar, b.x, nloc, nx); b.st[0] = nloc; b.st[1] = nx; }
    const unsigned old = xb_add(&bar[XB_XSUB(b.x)], 1u);
    const unsigned gen = old / nloc;
    if (old + 1u == (gen + 1u) * nloc) {
      __builtin_amdgcn_fence(__ATOMIC_RELEASE, "agent");
      asm volatile("s_waitcnt vmcnt(0)" ::: "memory");
      const unsigned og = xb_add(&bar[XB_TOP], 1u);
      const unsigned tg = og / nx;
      if (og + 1u == (tg + 1u) * nx) xb_add(&bar[XB_TOPGEN], 1u);
      else XB_SPIN(xb_ld(&bar[XB_TOPGEN]) == tg, bar);
      __builtin_amdgcn_fence(__ATOMIC_ACQUIRE, "agent");
      xb_add(&bar[XB_XGEN(b.x)], 1u);
      asm volatile("s_waitcnt vmcnt(0)" ::: "memory");
    } else {
      XB_SPIN(xb_ld(&bar[XB_XGEN(b.x)]) == gen, bar);
      __builtin_amdgcn_fence(__ATOMIC_ACQUIRE, "agent");
      asm volatile("s_waitcnt vmcnt(0)" ::: "memory");
    }
  }
  __syncthreads();
}

struct Params {
  const float *x, *meta, *norm1_g, *w_in, *wg, *bg, *sb_g, *gla_g, *w_out, *norm2_g, *w_pq, *sk1, *sk2, *eu, *ev, *gf;
  float* out; char* ws;
};
constexpr int HALF_SMEM = 73728;
constexpr int SMEM_BYTES = 2 * HALF_SMEM;
constexpr size_t WS_BAR = 0;

__global__ void __launch_bounds__(512, 2) k_fused(Params p) {
  extern __shared__ __attribute__((aligned(16))) char smem_dyn[];
  const int half = __builtin_amdgcn_readfirstlane((int)(threadIdx.x >> 8));
  char* smem = smem_dyn + half * HALF_SMEM;
  __shared__ unsigned xb_words[4];
  if (threadIdx.x < 4) xb_words[threadIdx.x] = 0u;
  __syncthreads();
  const XcdBarrier bar = xcd_barrier_post((unsigned*)(p.ws + WS_BAR), xb_words);
  if (threadIdx.x == 0) xb_words[2] = xb_add((unsigned*)(p.ws + WS_XRANK) + bar.x, 1u);
  const int G = 2 * gridDim.x, bid = 2 * blockIdx.x + half;
  char* ws = p.ws;
  bf16_t* WinT = (bf16_t*)(ws + WS_WIN);
  bf16_t* WoutT = (bf16_t*)(ws + WS_WOUT);
  bf16_t* WpqT = (bf16_t*)(ws + WS_WPQ);
  bf16_t* EU = (bf16_t*)(ws + WS_EU);
  bf16_t* EV = (bf16_t*)(ws + WS_EV);
  bf16_t* SK1b = (bf16_t*)(ws + WS_SK1);
  bf16_t* SK2b = (bf16_t*)(ws + WS_SK2);
  bf16_t* A1 = (bf16_t*)(ws + WS_A1);
  float* GO = (float*)(ws + WS_A1);
  bf16_t* A2 = (bf16_t*)(ws + WS_A1);
  InProjOut O;
  O.QSB = (bf16_t*)(ws + WS_QSB); O.KSB = (bf16_t*)(ws + WS_KSB); O.VTSB = (bf16_t*)(ws + WS_VTSB); O.VSB = (bf16_t*)(ws + WS_VSB);
  O.GQ = (bf16_t*)(ws + WS_GQ); O.GK = (bf16_t*)(ws + WS_GK); O.GV = (bf16_t*)(ws + WS_GVT); O.GR = (bf16_t*)(ws + WS_GR);
  O.GLR = (float*)(ws + WS_GLR);
  bf16_t* H1 = (bf16_t*)(ws + WS_H1);
  float* R2 = (float*)(ws + WS_XS + 3 * MiB);
  float* R1I = (float*)(ws + WS_XS + 4 * MiB);
  bf16_t* GVT = (bf16_t*)(ws + WS_GVT);
  GlaPtrs GP;
  GP.GQ = O.GQ; GP.GK = O.GK; GP.GVT = GVT; GP.GR = O.GR; GP.GLR = O.GLR; GP.wg = p.wg; GP.bg = p.bg; GP.gla_g = p.gla_g;
  GP.SLOC = (float*)(ws + WS_SLOC); GP.DTOT = (float*)(ws + WS_DTOT); GP.MIX = (bf16_t*)(ws + WS_MIX);
  GlaPrepPtrs GPP; GPP.GQ = O.GQ; GPP.GK = O.GK; GPP.GLR = O.GLR; GPP.wg = p.wg; GPP.bg = p.bg;
  GPP.QT = (bf16_t*)(ws + WS_GQT); GPP.KT = (bf16_t*)(ws + WS_GKT); GPP.KTT = (bf16_t*)(ws + WS_GKTT); GPP.DEC = (float*)(ws + WS_GDEC); GPP.BL = (float*)(ws + WS_GBL);
  GlaPtrs3 GP3; GP3.QT = GPP.QT; GP3.KT = GPP.KT; GP3.KTT = GPP.KTT; GP3.GVT = GVT; GP3.GR = O.GR; GP3.DEC = GPP.DEC; GP3.BL = GPP.BL; GP3.gla_g = p.gla_g;
  GP3.SLOC = GP.SLOC; GP3.DTOT = GP.DTOT; GP3.MIX = GP.MIX;
  bf16_t* MIX = (bf16_t*)(ws + WS_MIX);
  bf16_t* QP = (bf16_t*)(ws + WS_MIX);
  unsigned short* EIDX = (unsigned short*)(ws + WS_EIDX);
  bf16_t* PP = (bf16_t*)(ws + WS_PP);
  bf16_t* YT = (bf16_t*)(ws + WS_PP);
  unsigned* STREAM = (unsigned*)(ws + WS_STREAM);
  float* GATE = (float*)(ws + WS_GATE);

  for (int vb = bid; vb < 832 + 256 + 256; vb += G) {
    if (vb < 832) ph_transpose_w(vb % 104, vb / 104, smem, p.w_in, p.norm1_g, WinT, D, NIN);
    else if (vb < 1088) { const int t = vb - 832; ph_transpose_w(t % 32, t / 32, smem, p.w_out, nullptr, WoutT, D, D); }
    else { const int t = vb - 1088; ph_transpose_w(t % 32, t / 32, smem, p.w_pq, p.norm2_g, WpqT, D, D); }
  }
  ph_convert_eu_i8(p.eu, (u8_t*)EU, (float*)(ws + WS_SCU));
  for (int vb = bid; vb < NEXP / 32; vb += G) ph_convert_ev8(vb, smem, p.ev, (u8_t*)EV, (float*)(ws + WS_SCV));
  ph_convert(p.sk1, SK1b, (size_t)8 * 128 * 64 / 8);
  ph_convert(p.sk2, SK2b, (size_t)8 * 128 * 64 / 8);
  ph_zero_pads(O.KSB, O.VTSB, O.GQ, O.GK, GVT);
  for (int vb = bid; vb < TREAL / 16; vb += G) ph_norm_rows<0>(vb, p.x, R1I, A1);
  __syncthreads();
  for (int mb = blockIdx.x; mb < NIN / 16; mb += gridDim.x) ph_meta(mb, smem_dyn, p.meta, p.norm1_g, p.w_in, O);
  xcd_barrier(bar);
  {
    pg8::Gemm g{A1, WinT, TREAL, NINP, D}; pg8::StaticOrder S; S.init(TREAL, NINP, (int)gridDim.x, (int)blockIdx.x);
    EpiInProj E{O, GVT, smem_dyn + 131072};
    pg8::gemm_phase<EpiInProj, pg8::StaticOrder, true, true>((PG8_LAS unsigned char*)smem_dyn, g, S, E);
  }
  xcd_barrier(bar);
  for (int it = blockIdx.x; it < 16 * 129; it += gridDim.x) ph_gla_prep(it, smem_dyn, GPP);
  xcd_barrier(bar);
  for (int it = blockIdx.x; it < 16 * 15; it += gridDim.x) gla_item4<0>(it / 15, it % 15, smem_dyn, GP3);
  for (int vb = bid; vb < 64 * 32; vb += G) ph_sb_attn2(vb, O.QSB, O.KSB, O.VTSB, p.sb_g, MIX);
  xcd_barrier(bar);
  for (int it = blockIdx.x; it < 16 * 16; it += gridDim.x) gla_item4<1>(it >> 4, it & 15, smem_dyn, GP3);
  xcd_barrier(bar);
  {
    pg8::Gemm g{MIX, WoutT, TREAL, D, D}; pg8::StaticOrder S; S.init(TREAL, D, (int)gridDim.x, (int)blockIdx.x);
    EpiOut E{A1, R1I, H1};
    pg8::gemm_phase<EpiOut, pg8::StaticOrder, true, true>((PG8_LAS unsigned char*)smem_dyn, g, S, E);
  }
  xcd_barrier(bar);
  for (int vb = bid; vb < TREAL / 16; vb += G) ph_norm2_rows(vb, H1, p.norm2_g, R2, (u8_t*)(ws + WS_XQ), (float*)(ws + WS_XS));
  xcd_barrier(bar);
  {
    pg8::Gemm g{H1, WpqT, TREAL, D, D}; pg8::StaticOrder S; S.init(TREAL, D, (int)gridDim.x, (int)blockIdx.x);
    EpiPQ E{QP, R2};
    pg8::gemm_phase<EpiPQ, pg8::StaticOrder, true, true>((PG8_LAS unsigned char*)smem_dyn, g, S, E);
  }
  xcd_barrier(bar);
  {
    const int NV = 8 * (TREAL / 128);
    route_stage_keys(bid & 7, smem, SK1b, SK2b);
    const int rlane = (int)(threadIdx.x & 63u), rwave = (int)((threadIdx.x >> 6) & 3u);
    bf16x8 qa[2][4], qb[2][4];
    if (bid < NV) route_load_q(qa, QP, (bid >> 3) * 128 + rwave * 32 + (rlane & 31), bid & 7, rlane >> 5);
    for (int vb = bid; vb < NV; vb += 2 * G) {
      const int v1 = vb + G, v2 = vb + 2 * G;
      if (v1 < NV) route_load_q(qb, QP, (v1 >> 3) * 128 + rwave * 32 + (rlane & 31), v1 & 7, rlane >> 5);
      ph_route_v2(vb, smem, qa, EIDX, GATE);
      if (v1 < NV) {
        if (v2 < NV) route_load_q(qa, QP, (v2 >> 3) * 128 + rwave * 32 + (rlane & 31), v2 & 7, rlane >> 5);
        ph_route_v2(v1, smem, qb, EIDX, GATE);
      }
    }
  }
  xcd_barrier(bar);
  {
    __shared__ int xinfo[4];
    if (threadIdx.x == 0) {
      unsigned* barw = (unsigned*)(p.ws + WS_BAR);
      unsigned cnt = 0, ord = 0, mine = 1;
      for (unsigned j = 0; j < 16; ++j) { const unsigned c = xb_ld(&barw[XB_XCNT(j)]); if (c > 0) { if (j < bar.x) ++ord; ++cnt; } if (j == bar.x) mine = c; }
      xinfo[0] = (int)ord; xinfo[1] = (int)cnt; xinfo[2] = (int)xb_words[2]; xinfo[3] = (int)mine;
    }
    __syncthreads();
    const int xi = xinfo[0], nx = xinfo[1], rank = xinfo[2], nloc = xinfo[3];
    const int wave = __builtin_amdgcn_readfirstlane((int)(threadIdx.x >> 6));
    ph_peer_u_d4(xi, nx, rank * 8 + wave, nloc * 8, (const u8_t*)(ws + WS_XQ), (const float*)(ws + WS_XS), (const u8_t*)EU, EIDX, PP);
  }
  xcd_barrier(bar);
  for (int unit = blockIdx.x; unit < TREAL / 64; unit += gridDim.x) ph_peer_c8(unit, smem_dyn, PP, EIDX, GATE, (const float*)(ws + WS_SCU), (const float*)(ws + WS_SCV), STREAM);
  xcd_barrier(bar);
  ph_peer_v8(smem_dyn, STREAM, (const u8_t*)EV, YT);
  xcd_barrier(bar);
  for (int unit = blockIdx.x; unit < TREAL / 32; unit += gridDim.x) ph_final_lds(unit, smem_dyn, H1, YT, p.gf, p.out);
}

extern "C" void kernel_launch(void* const* d_in, const int* in_sizes, int n_in, void* d_out, int out_size, void* d_ws, size_t ws_size, hipStream_t stream) {
  static int grid = 0;
  if (grid == 0) {
    int dev = 0, cus = 0, per_cu = 0;
    hipGetDevice(&dev);
    hipDeviceGetAttribute(&cus, hipDeviceAttributeMultiprocessorCount, dev);
    hipFuncSetAttribute((const void*)k_fused, hipFuncAttributeMaxDynamicSharedMemorySize, SMEM_BYTES);
    hipOccupancyMaxActiveBlocksPerMultiprocessor(&per_cu, (const void*)k_fused, 512, SMEM_BYTES);
    if (per_cu > 1) per_cu = 1;
    if (per_cu < 1) per_cu = 1;
    grid = cus * per_cu;
  }
  hipMemsetAsync((char*)d_ws + WS_BAR, 0, 32768, stream);
  Params p{};
  p.x = (const float*)d_in[0]; p.meta = (const float*)d_in[1]; p.norm1_g = (const float*)d_in[2]; p.w_in = (const float*)d_in[3];
  p.wg = (const float*)d_in[4]; p.bg = (const float*)d_in[5]; p.sb_g = (const float*)d_in[6]; p.gla_g = (const float*)d_in[7];
  p.w_out = (const float*)d_in[8]; p.norm2_g = (const float*)d_in[9]; p.w_pq = (const float*)d_in[10]; p.sk1 = (const float*)d_in[11];
  p.sk2 = (const float*)d_in[12]; p.eu = (const float*)d_in[13]; p.ev = (const float*)d_in[14]; p.gf = (const float*)d_in[15];
  p.out = (float*)d_out; p.ws = (char*)d_ws;
  void* args[] = {&p};
  hipLaunchCooperativeKernel((const void*)k_fused, dim3(grid), dim3(512), args, SMEM_BYTES, stream);
}
```

```cpp
#include <hip/hip_runtime.h>
#include <stdint.h>
#include <stddef.h>

typedef unsigned short bf16_t;
typedef short bf16x8 __attribute__((ext_vector_type(8)));
typedef float f32x16 __attribute__((ext_vector_type(16)));
typedef float f32x4 __attribute__((ext_vector_type(4)));
typedef float f32x2 __attribute__((ext_vector_type(2)));
typedef unsigned u32x4 __attribute__((ext_vector_type(4)));
typedef unsigned u32x2 __attribute__((ext_vector_type(2)));
typedef __bf16 bf16x2_t __attribute__((ext_vector_type(2)));

#define DI __device__ __forceinline__
__device__ __forceinline__ int fresh_tid() { int t = (int)threadIdx.x; asm volatile("" : "+v"(t)); return t; }
#define TID tid256_
#define MFMA32(a, b, c) __builtin_amdgcn_mfma_f32_32x32x16_bf16((a), (b), (c), 0, 0, 0)

constexpr int D = 1024, NB = 8, SEQ = 8192, NMETA = 16;
constexpr int TREAL = NB * SEQ;
constexpr int MROWS = TREAL + 128;
constexpr int NIN = 3088, NINP = 3328;
constexpr int SBH = 8, SBD = 64;
constexpr int GH = 4, GDK = 64, GDV = 128;
constexpr int KIDX = SEQ + 32;
constexpr int GU = SEQ + 64;
constexpr int NEXP = 16384;
constexpr float EPS = 1e-6f;

constexpr size_t MiB = 1u << 20;
constexpr size_t WS_WIN = 1 * MiB;
constexpr size_t WS_WOUT = 8 * MiB;
constexpr size_t WS_WPQ = 10 * MiB;
constexpr size_t WS_SK1 = 12 * MiB;
constexpr size_t WS_SK2 = 13 * MiB;
constexpr size_t WS_EU = 16 * MiB;
constexpr size_t WS_EV = 48 * MiB;
constexpr size_t WS_A1 = 80 * MiB;
constexpr size_t WS_QSB = 210 * MiB;
constexpr size_t WS_KSB = 274 * MiB;
constexpr size_t WS_VTSB = 339 * MiB;
constexpr size_t WS_GQ = 404 * MiB;
constexpr size_t WS_GK = 437 * MiB;
constexpr size_t WS_H1 = 210 * MiB;
constexpr size_t WS_GV = 470 * MiB;
constexpr size_t WS_GR = 535 * MiB;
constexpr size_t WS_GLR = 599 * MiB;
constexpr size_t WS_LG = 604 * MiB;
constexpr size_t WS_MIX = 669 * MiB;
constexpr size_t WS_EIDX = 797 * MiB;
constexpr size_t WS_GATE = 829 * MiB;
constexpr size_t WS_PP = 470 * MiB;
constexpr size_t WS_STREAM = 726 * MiB;
constexpr size_t WS_XRANK = 16384;
constexpr size_t WS_VSB = 861 * MiB;
constexpr size_t WS_END = 926 * MiB;

DI unsigned f2bf(float f) { unsigned u = __float_as_uint(f); return (u + 0x7fffu + ((u >> 16) & 1u)) >> 16; }
DI float bf2f(unsigned b) { return __uint_as_float(b << 16); }
DI unsigned pk2(float lo, float hi) { f32x2 v = {lo, hi}; return __builtin_bit_cast(unsigned, __builtin_convertvector(v, bf16x2_t)); }
DI float bflo(unsigned u) { return __uint_as_float(u << 16); }
DI float bfhi(unsigned u) { return __uint_as_float(u & 0xffff0000u); }
DI int crow(int reg, int h) { return (reg & 3) + 8 * (reg >> 2) + 4 * h; }
DI float wave_sum(float v) {
#pragma unroll
  for (int o = 32; o >= 1; o >>= 1) v += __shfl_xor(v, o);
  return v;
}
DI float softplus(float z) { return fmaxf(z, 0.f) + __logf(1.f + __expf(-fabsf(z))); }

DI void ph_transpose_w(int bx, int by, char* smem, const float* __restrict__ W, const float* __restrict__ gain, bf16_t* __restrict__ WT, int K, int N) {
  const int tid256_ = fresh_tid() & 255;
  float (*t)[33] = (float (*)[33])smem;
  const int n0 = bx * 32, k0 = by * 128;
  {
    const int kr = TID >> 3, c4 = (TID & 7) * 4;
    f32x4 v[4];
#pragma unroll
    for (int j = 0; j < 4; ++j) v[j] = (n0 + c4 < N) ? *(const f32x4*)(W + (size_t)(k0 + kr + 32 * j) * N + n0 + c4) : (f32x4){0.f, 0.f, 0.f, 0.f};
#pragma unroll
    for (int j = 0; j < 4; ++j) {
      const float g = gain ? gain[k0 + kr + 32 * j] : 1.f;
      t[kr + 32 * j][c4 + 0] = v[j].x * g; t[kr + 32 * j][c4 + 1] = v[j].y * g; t[kr + 32 * j][c4 + 2] = v[j].z * g; t[kr + 32 * j][c4 + 3] = v[j].w * g;
    }
  }
  __syncthreads();
  {
    const int n = TID >> 3, ks = (TID & 7) * 16;
    unsigned w[8];
#pragma unroll
    for (int i = 0; i < 8; ++i) w[i] = pk2(t[ks + 2 * i][n], t[ks + 2 * i + 1][n]);
    bf16_t* dst = WT + (size_t)(n0 + n) * K + k0 + ks;
    *(u32x4*)dst = (u32x4){w[0], w[1], w[2], w[3]};
    *(u32x4*)(dst + 8) = (u32x4){w[4], w[5], w[6], w[7]};
  }
  __syncthreads();
}
DI void ph_convert(const float* __restrict__ src, bf16_t* __restrict__ dst, size_t n8) {
  size_t i = (size_t)blockIdx.x * blockDim.x + threadIdx.x;
  const size_t stride = (size_t)gridDim.x * blockDim.x;
  for (; i < n8; i += stride) {
    const f32x4 a = ((const f32x4*)src)[2 * i], b = ((const f32x4*)src)[2 * i + 1];
    u32x4 o; o.x = pk2(a.x, a.y); o.y = pk2(a.z, a.w); o.z = pk2(b.x, b.y); o.w = pk2(b.z, b.w);
    ((u32x4*)dst)[i] = o;
  }
}
DI void ph_zero_pads(bf16_t* KSB, bf16_t* VTSB, bf16_t* GQ, bf16_t* GK, bf16_t* GVT) {
  const int tid = blockIdx.x * blockDim.x + threadIdx.x, nth = gridDim.x * blockDim.x;
  for (int i = tid; i < 64 * 16 * 64; i += nth) { const int bh = i / 1024, r = i % 1024; KSB[(size_t)bh * KIDX * 64 + r] = 0; }
  for (int i = tid; i < 64 * 64 * 16; i += nth) { const int row = i / 16, c = i % 16; VTSB[(size_t)row * KIDX + c] = 0; }
  for (int i = tid; i < 32 * 48 * 64; i += nth) { const int bh = i / 3072, r = i % 3072; GQ[(size_t)bh * GU * 64 + r] = 0; GK[(size_t)bh * GU * 64 + r] = 0; }
  for (int i = tid; i < 32 * 128 * 48; i += nth) { const int row = i / 48, c = i % 48; GVT[(size_t)row * GU + c] = 0; }
}

template <int MODE>
DI void ph_norm_rows(int vb, const float* __restrict__ src, const float* __restrict__ meta, bf16_t* __restrict__ dst) {
  const int tid256_ = fresh_tid() & 255;
  const int row0 = vb * 16 + (TID >> 6) * 4, lane = TID & 63;
  f32x4 v[4][4];
#pragma unroll
  for (int rr = 0; rr < 4; ++rr)
#pragma unroll
    for (int j = 0; j < 4; ++j) v[rr][j] = *(const f32x4*)(src + (size_t)(row0 + rr) * D + j * 256 + lane * 4);
  f32x4 gg[4];
#pragma unroll
  for (int j = 0; j < 4; ++j) { gg[j] = (f32x4){1.f, 1.f, 1.f, 1.f}; if (MODE == 1) gg[j] = *(const f32x4*)(meta + j * 256 + lane * 4); }
#pragma unroll
  for (int rr = 0; rr < 4; ++rr) {
    float ss = 0.f;
#pragma unroll
    for (int j = 0; j < 4; ++j) ss += v[rr][j].x * v[rr][j].x + v[rr][j].y * v[rr][j].y + v[rr][j].z * v[rr][j].z + v[rr][j].w * v[rr][j].w;
    ss = wave_sum(ss);
    const float r = rsqrtf(ss * (1.0f / D) + EPS);
    if (MODE == 0 && lane == 0) const_cast<float*>(meta)[row0 + rr] = sqrtf(ss * (1.0f / D) + EPS);
#pragma unroll
    for (int j = 0; j < 4; ++j) {
      u32x2 o; o.x = pk2(v[rr][j].x * r * gg[j].x, v[rr][j].y * r * gg[j].y); o.y = pk2(v[rr][j].z * r * gg[j].z, v[rr][j].w * r * gg[j].w);
      *(u32x2*)(dst + (size_t)(row0 + rr) * D + j * 256 + lane * 4) = o;
    }
  }
}

namespace pg8 {
#define PG8_LAS __attribute__((address_space(3)))
typedef unsigned short bf16_t;
typedef short bf16x8 __attribute__((ext_vector_type(8)));
typedef float f32x4 __attribute__((ext_vector_type(4)));
typedef unsigned u32x4 __attribute__((ext_vector_type(4)));
constexpr int BM = 256, BK = 64, HALF = 128, HTB = HALF * BK * 2  , STAGE_BYTES = 8 * HTB, NXCD = 8, WGM = 8;

__host__ __device__ __forceinline__ int lds_byte(int r, int c) { const int st = (r >> 4) * 2 + (c >> 5), rr = r & 15, cc = c & 31, ob = rr * 64 + cc * 2; return st * 1024 + (ob ^ (((ob >> 9) & 1) << 5)); }
__host__ __device__ __forceinline__ void stage_rc(int b, int& R, int& C) { const int st = b / 1024, sb = b % 1024, swz = sb ^ (((sb >> 9) & 1) << 5); R = (st >> 1) * 16 + swz / 64; C = (st & 1) * 32 + (swz % 64) / 2; }
__host__ __device__ __forceinline__ int perm32(int rho) { const int n = rho >> 4, i = rho & 15; return 8 * (i >> 2) + 4 * n + (i & 3); }

struct Unit { int pm, pn; };
struct Gemm { const bf16_t* A; const bf16_t* Bt; int M, N, K; };

struct StaticOrder {
    int nM, nN, nwg, G, c;
    __host__ __device__ void init(int M, int N, int G_, int c_) { nM = M / BM; nN = N / BM; nwg = nM * nN; G = G_; c = c_; }
    __host__ __device__ bool next(int i, Unit& u) const {
        const long L = (long)i * G + c; if (L >= nwg) return false;
        int wgid = (int)L; { const int q = nwg / NXCD, r = nwg % NXCD, xcd = wgid % NXCD, off = wgid / NXCD; wgid = (xcd < r ? xcd * (q + 1) : r * (q + 1) + (xcd - r) * q) + off; }
        const int nig = WGM * nN, gid = wgid / nig, fm = gid * WGM, gsz = (nM - fm) < WGM ? (nM - fm) : WGM;
        u.pm = fm + ((wgid % nig) % gsz); u.pn = (wgid % nig) / gsz; return true;
    }
    __device__ __forceinline__ void a_ready(const Unit&) const {}
    __device__ __forceinline__ void done(const Unit&) const {}
};

template <class Epi, class Sched, bool ALIGN_EPI = false, bool SP2 = false>
__device__ __forceinline__ void gemm_phase(PG8_LAS unsigned char* lds, const Gemm g, const Sched& S, const Epi& E) {
    const int tid = fresh_tid(), wid = __builtin_amdgcn_readfirstlane(tid >> 6), lane = tid & 63, wr = wid >> 2, wc = wid & 3, fr = lane & 15, fq = lane >> 4;
    const int K = g.K, nt = K / BK;
    unsigned voffA[2], voffB[2];
#pragma unroll
    for (int i = 0; i < 2; ++i) { int R, C; stage_rc(tid * 16 + i * 8192, R, C); const int Rb = Epi::PERM ? ((R & ~31) + perm32(R & 31)) : R;
        voffA[i] = (unsigned)(R * K + C) * 2u; voffB[i] = (unsigned)(Rb * K + C) * 2u; }
    const size_t kstep = (size_t)(BK * 2);
    const size_t hstep = (size_t)HALF * K * 2;
    const size_t tstep = 2 * hstep;
    const unsigned ldsw = (unsigned)wid * 1024u;
    const int aoff = lds_byte(wr * 64 + fr, fq * 8), boff = lds_byte(wc * 32 + fr, fq * 8);
#define PG8_SA(b, h) (((b) * 2 + (h)) * HTB)
#define PG8_SB(b, h) ((4 + (b) * 2 + (h)) * HTB)
#define PG8_STAGE(bufoff, gbase, voff) do { _Pragma("unroll") for (int _i = 0; _i < 2; ++_i) \
        __builtin_amdgcn_global_load_lds((const unsigned*)((const char*)(gbase) + (voff)[_i]), (PG8_LAS unsigned*)(lds + (bufoff) + ldsw + _i * 8192), 16, 0, 0); } while (0)
#define PG8_LDA(dst, b, h) do { _Pragma("unroll") for (int m = 0; m < 4; ++m) _Pragma("unroll") for (int k = 0; k < 2; ++k) dst[m][k] = *(const PG8_LAS bf16x8*)(lds + PG8_SA(b, h) + aoff + m * 2048 + k * 1024); } while (0)
#define PG8_LDB(dst, b, h) do { _Pragma("unroll") for (int n = 0; n < 2; ++n) _Pragma("unroll") for (int k = 0; k < 2; ++k) dst[n][k] = *(const PG8_LAS bf16x8*)(lds + PG8_SB(b, h) + boff + n * 2048 + k * 1024); } while (0)
#define PG8_MMA(ai, bj, At, Bt) do { __builtin_amdgcn_s_setprio(1); _Pragma("unroll") for (int m = 0; m < 4; ++m) _Pragma("unroll") for (int n = 0; n < 2; ++n) _Pragma("unroll") for (int k = 0; k < 2; ++k) \
        acc[ai][bj][m][n] = __builtin_amdgcn_mfma_f32_16x16x32_bf16(Bt[n][k], At[m][k], acc[ai][bj][m][n], 0, 0, 0); __builtin_amdgcn_s_setprio(0); } while (0)
#define PG8_WAIT_V(n) asm volatile("s_waitcnt vmcnt(" #n ")" ::: "memory")
#define PG8_WAIT_L(n) asm volatile("s_waitcnt lgkmcnt(" #n ")" ::: "memory")
#define PG8_BAR __builtin_amdgcn_s_barrier()
#define PG8_SCHED __builtin_amdgcn_sched_barrier(0)
    Unit cur, nxt; int ui = 0;
    if (!S.next(0, cur)) return;
    f32x4 acc[2][2][4][2];
#pragma unroll
    for (int a = 0; a < 2; ++a)
#pragma unroll
        for (int b = 0; b < 2; ++b)
#pragma unroll
            for (int m = 0; m < 4; ++m)
#pragma unroll
                for (int n = 0; n < 2; ++n) acc[a][b][m][n] = (f32x4){0.f, 0.f, 0.f, 0.f};
    bf16x8 At[4][2], B0[2][2], B1[2][2];
    const char* cA = (const char*)g.A + (size_t)cur.pm * tstep; const char* cB = (const char*)g.Bt + (size_t)cur.pn * tstep;
    S.a_ready(cur);
    if constexpr (SP2) {
        PG8_STAGE(PG8_SB(0, 0), cB, voffB); PG8_STAGE(PG8_SB(0, 1), cB + hstep, voffB); PG8_STAGE(PG8_SA(0, 0), cA, voffA); PG8_STAGE(PG8_SA(0, 1), cA + hstep, voffA);
        if (wr == 1) PG8_BAR;
        PG8_WAIT_V(2); PG8_BAR;
        PG8_STAGE(PG8_SB(1, 0), cB + kstep, voffB); PG8_STAGE(PG8_SA(1, 0), cA + kstep, voffA); PG8_STAGE(PG8_SB(1, 1), cB + hstep + kstep, voffB);
        PG8_WAIT_V(6); PG8_BAR;
    } else {
        PG8_STAGE(PG8_SB(0, 0), cB, voffB); PG8_STAGE(PG8_SA(0, 0), cA, voffA); PG8_STAGE(PG8_SB(0, 1), cB + hstep, voffB); PG8_STAGE(PG8_SA(0, 1), cA + hstep, voffA);
        if (wr == 1) PG8_BAR;
        PG8_WAIT_V(4); PG8_BAR;
        PG8_STAGE(PG8_SB(1, 0), cB + kstep, voffB); PG8_STAGE(PG8_SA(1, 0), cA + kstep, voffA); PG8_STAGE(PG8_SB(1, 1), cB + hstep + kstep, voffB);
        PG8_WAIT_V(6); PG8_BAR;
    }
    for (;;) {
        const bool has_next = S.next(ui + 1, nxt);
        const char* nA = has_next ? (const char*)g.A + (size_t)nxt.pm * tstep : cA; const char* nB = has_next ? (const char*)g.Bt + (size_t)nxt.pn * tstep : cB;
        for (int t = 0; t < nt; t += 2) {
            const bool last = (t == nt - 2);
            const char* a1 = cA + (size_t)(t + 1) * kstep;
            const char* a2 = last ? nA : cA + (size_t)(t + 2) * kstep; const char* b2 = last ? nB : cB + (size_t)(t + 2) * kstep;
            const char* a3 = a2 + kstep; const char* b3 = b2 + kstep;
            if (last && has_next) S.a_ready(nxt);
            if constexpr (SP2) {
            PG8_LDB(B0, 0, 0); PG8_LDB(B1, 0, 1); PG8_SCHED; PG8_LDA(At, 0, 0); PG8_STAGE(PG8_SA(1, 1), a1 + hstep, voffA);
            PG8_WAIT_V(8); PG8_WAIT_L(0); PG8_BAR; PG8_MMA(0, 0, At, B0); PG8_MMA(0, 1, At, B1); PG8_BAR; PG8_SCHED;
            PG8_LDA(At, 0, 1); PG8_STAGE(PG8_SB(0, 0), b2, voffB); PG8_STAGE(PG8_SB(0, 1), b2 + hstep, voffB); PG8_STAGE(PG8_SA(0, 0), a2, voffA);
            PG8_WAIT_V(8); PG8_WAIT_L(0); PG8_BAR; PG8_MMA(1, 0, At, B0); PG8_MMA(1, 1, At, B1); PG8_BAR; PG8_SCHED;
            PG8_LDB(B0, 1, 0); PG8_LDB(B1, 1, 1); PG8_SCHED; PG8_LDA(At, 1, 0); PG8_STAGE(PG8_SA(0, 1), a2 + hstep, voffA);
            PG8_WAIT_V(8); PG8_WAIT_L(0); PG8_BAR; PG8_MMA(0, 0, At, B0); PG8_MMA(0, 1, At, B1); PG8_BAR; PG8_SCHED;
            PG8_LDA(At, 1, 1); PG8_STAGE(PG8_SB(1, 0), b3, voffB); PG8_STAGE(PG8_SB(1, 1), b3 + hstep, voffB); PG8_STAGE(PG8_SA(1, 0), a3, voffA);
            PG8_WAIT_V(8); PG8_WAIT_L(0); PG8_BAR; PG8_MMA(1, 0, At, B0); PG8_MMA(1, 1, At, B1); PG8_BAR; PG8_SCHED;
            } else {
            PG8_LDB(B0, 0, 0); PG8_SCHED; PG8_LDA(At, 0, 0); PG8_STAGE(PG8_SA(1, 1), a1 + hstep, voffA);
            PG8_WAIT_L(8); PG8_BAR; PG8_WAIT_L(0); PG8_MMA(0, 0, At, B0); PG8_BAR; PG8_SCHED;
            PG8_LDB(B1, 0, 1); PG8_STAGE(PG8_SB(0, 0), b2, voffB);
            PG8_BAR; PG8_WAIT_L(0); PG8_MMA(0, 1, At, B1); PG8_BAR;
            PG8_LDA(At, 0, 1); PG8_STAGE(PG8_SA(0, 0), a2, voffA);
            PG8_BAR; PG8_WAIT_L(0); PG8_MMA(1, 0, At, B0); PG8_BAR; PG8_SCHED;
            PG8_STAGE(PG8_SB(0, 1), b2 + hstep, voffB);
            PG8_WAIT_V(6); PG8_BAR; PG8_MMA(1, 1, At, B1); PG8_BAR;
            PG8_LDB(B0, 1, 0); PG8_SCHED; PG8_LDA(At, 1, 0); PG8_STAGE(PG8_SA(0, 1), a2 + hstep, voffA);
            PG8_WAIT_L(8); PG8_BAR; PG8_WAIT_L(0); PG8_MMA(0, 0, At, B0); PG8_BAR; PG8_SCHED;
            PG8_LDB(B1, 1, 1); PG8_STAGE(PG8_SB(1, 0), b3, voffB);
            PG8_BAR; PG8_WAIT_L(0); PG8_MMA(0, 1, At, B1); PG8_BAR;
            PG8_LDA(At, 1, 1); PG8_STAGE(PG8_SA(1, 0), a3, voffA);
            PG8_BAR; PG8_WAIT_L(0); PG8_MMA(1, 0, At, B0); PG8_BAR; PG8_SCHED;
            PG8_STAGE(PG8_SB(1, 1), b3 + hstep, voffB);
            PG8_WAIT_V(6); PG8_BAR; PG8_MMA(1, 1, At, B1); PG8_BAR;
            }
        }
        if constexpr (ALIGN_EPI) { if (wr == 0) PG8_BAR; }
        if constexpr (!Epi::AFTER_DRAIN) { E(acc, cur, wr, wc, fr, fq); S.done(cur); }
        if (!has_next) break;
#pragma unroll
        for (int a = 0; a < 2; ++a)
#pragma unroll
            for (int b = 0; b < 2; ++b)
#pragma unroll
                for (int m = 0; m < 4; ++m)
#pragma unroll
                    for (int n = 0; n < 2; ++n) acc[a][b][m][n] = (f32x4){0.f, 0.f, 0.f, 0.f};
        cur = nxt; cA = nA; cB = nB; ++ui;
        if constexpr (ALIGN_EPI) { if (wr == 1) PG8_BAR; }
    }
    PG8_WAIT_V(0);
    if constexpr (!ALIGN_EPI) { if (wr == 0) PG8_BAR; }
    PG8_BAR;
    if constexpr (Epi::AFTER_DRAIN) { E.fused(acc, cur, wr, wc, fr, fq, lds, wid, lane); S.done(cur); }
#undef PG8_SA
#undef PG8_SB
#undef PG8_STAGE
#undef PG8_LDA
#undef PG8_LDB
#undef PG8_MMA
#undef PG8_WAIT_V
#undef PG8_WAIT_L
#undef PG8_BAR
#undef PG8_SCHED
}
}

struct InProjOut { bf16_t *QSB, *KSB, *VSB, *VTSB, *GQ, *GK, *GV, *GR; float* GLR; };

struct EpiInProj {
  static constexpr bool PERM = true, AFTER_DRAIN = false;
  InProjOut O; bf16_t* GVT; char* stage;
  DI void store_vt(const pg8::f32x4 (&acc)[2][2][4][2], const pg8::Unit& u, int wr, int wc, int fr, int fq) const {
    bf16_t* st = (bf16_t*)(stage + (wr * 4 + wc) * 1280);
    const int lane = fr + 16 * fq;
    const int rc = lane >> 2, r8 = lane & 3;
#pragma unroll
    for (int ai = 0; ai < 2; ++ai)
#pragma unroll
      for (int bj = 0; bj < 2; ++bj)
#pragma unroll
        for (int mp = 0; mp < 2; ++mp)
#pragma unroll
          for (int ch = 0; ch < 2; ++ch) {
            if ((fq >> 1) == ch) {
#pragma unroll
              for (int m2 = 0; m2 < 2; ++m2)
#pragma unroll
                for (int n = 0; n < 2; ++n) {
                  const pg8::f32x4 v = acc[ai][bj][2 * mp + m2][n];
                  const int cl = 8 * (fq & 1) + 4 * n, rl = 16 * m2 + fr;
                  st[(cl + 0) * 40 + rl] = (bf16_t)f2bf(v[0]); st[(cl + 1) * 40 + rl] = (bf16_t)f2bf(v[1]);
                  st[(cl + 2) * 40 + rl] = (bf16_t)f2bf(v[2]); st[(cl + 3) * 40 + rl] = (bf16_t)f2bf(v[3]);
                }
            }
            asm volatile("s_waitcnt lgkmcnt(0)" ::: "memory");
            const u32x4 w = *(const u32x4*)&st[rc * 40 + 8 * r8];
            asm volatile("" ::: "memory");
            const int col = u.pn * 256 + bj * 128 + wc * 32 + 16 * ch + rc;
            const int row = u.pm * 256 + ai * 128 + wr * 64 + 32 * mp + 8 * r8;
            const int b = row >> 13, i = row & 8191;
            bf16_t* dst;
            if (u.pn < 6) { const int c = col - 1024; dst = O.VTSB + ((size_t)(b * SBH + (c >> 6)) * 64 + (c & 63)) * KIDX + 32 + i; }
            else          { const int c = col - 2048; dst = GVT + ((size_t)(b * GH + (c >> 7)) * 128 + (c & 127)) * GU + 64 + i; }
            *(u32x4*)dst = w;
          }
  }
  DI void operator()(const pg8::f32x4 (&acc)[2][2][4][2], const pg8::Unit& u, int wr, int wc, int fr, int fq) const {
    const int pn = u.pn;
    if (pn == 4 || pn == 5 || pn == 8 || pn == 9) { store_vt(acc, u, wr, wc, fr, fq); return; }
#pragma unroll
    for (int ai = 0; ai < 2; ++ai)
#pragma unroll
      for (int m = 0; m < 4; ++m) {
        const int row = u.pm * 256 + ai * 128 + wr * 64 + m * 16 + fr;
        const int b = row >> 13, i = row & 8191;
#pragma unroll
        for (int bj = 0; bj < 2; ++bj) {
          const int col = pn * 256 + bj * 128 + wc * 32 + 8 * fq;
          const pg8::f32x4 v0 = acc[ai][bj][m][0], v1 = acc[ai][bj][m][1];
          if (pn < 12) {
            u32x4 w; w.x = pk2(v0[0], v0[1]); w.y = pk2(v0[2], v0[3]); w.z = pk2(v1[0], v1[1]); w.w = pk2(v1[2], v1[3]);
            bf16_t* dst;
            if (pn < 2)       { const int c = col;        dst = O.QSB + ((size_t)(b * SBH + (c >> 6)) * SEQ + i) * 64 + (c & 63); }
            else if (pn < 4)  { const int c = col - 512;  dst = O.KSB + ((size_t)(b * SBH + (c >> 6)) * KIDX + 32 + i) * 64 + (c & 63); }
            else if (pn == 6) { const int c = col - 1536; dst = O.GQ + ((size_t)(b * GH + (c >> 6)) * GU + 64 + i) * 64 + (c & 63); }
            else if (pn == 7) { const int c = col - 1792; dst = O.GK + ((size_t)(b * GH + (c >> 6)) * GU + 64 + i) * 64 + (c & 63); }
            else              { const int c = col - 2560; dst = O.GR + (size_t)row * 512 + c; }
            *(u32x4*)dst = w;
          } else if (col < NIN) {
            float* dst = O.GLR + ((size_t)b * GU + 64 + i) * 16 + (col - 3072);
            *(f32x4*)dst = (f32x4){v0[0], v0[1], v0[2], v0[3]};
            *(f32x4*)(dst + 4) = (f32x4){v1[0], v1[1], v1[2], v1[3]};
          }
        }
      }
  }
};
struct EpiOut {
  static constexpr bool PERM = true, AFTER_DRAIN = false;
  const bf16_t* A1; const float* R1I; bf16_t* H1;
  DI void operator()(const pg8::f32x4 (&acc)[2][2][4][2], const pg8::Unit& u, int wr, int wc, int fr, int fq) const {
#pragma unroll
    for (int ai = 0; ai < 2; ++ai)
#pragma unroll
      for (int m = 0; m < 4; ++m) {
        const int row = u.pm * 256 + ai * 128 + wr * 64 + m * 16 + fr;
        const size_t rowoff = (size_t)row * D;
        const float ri = R1I[row];
#pragma unroll
        for (int bj = 0; bj < 2; ++bj) {
          const size_t idx = rowoff + u.pn * 256 + bj * 128 + wc * 32 + 8 * fq;
          const u32x4 aw = *(const u32x4*)(A1 + idx);
          const f32x4 x0 = {bflo(aw.x) * ri, bfhi(aw.x) * ri, bflo(aw.y) * ri, bfhi(aw.y) * ri}, x1 = {bflo(aw.z) * ri, bfhi(aw.z) * ri, bflo(aw.w) * ri, bfhi(aw.w) * ri};
          const pg8::f32x4 v0 = acc[ai][bj][m][0], v1 = acc[ai][bj][m][1];
          u32x4 w; w.x = pk2(x0.x + v0[0], x0.y + v0[1]); w.y = pk2(x0.z + v0[2], x0.w + v0[3]); w.z = pk2(x1.x + v1[0], x1.y + v1[1]); w.w = pk2(x1.z + v1[2], x1.w + v1[3]);
          *(u32x4*)(H1 + idx) = w;
        }
      }
  }
};
struct EpiPQ {
  static constexpr bool PERM = true, AFTER_DRAIN = false;
  bf16_t* QP; const float* R2;
  DI void operator()(const pg8::f32x4 (&acc)[2][2][4][2], const pg8::Unit& u, int wr, int wc, int fr, int fq) const {
#pragma unroll
    for (int ai = 0; ai < 2; ++ai)
#pragma unroll
      for (int m = 0; m < 4; ++m) {
        const int row = u.pm * 256 + ai * 128 + wr * 64 + m * 16 + fr;
        const float r = R2[row];
        const size_t rowoff = (size_t)row * D;
#pragma unroll
        for (int bj = 0; bj < 2; ++bj) {
          const pg8::f32x4 v0 = acc[ai][bj][m][0], v1 = acc[ai][bj][m][1];
          u32x4 w; w.x = pk2(v0[0] * r, v0[1] * r); w.y = pk2(v0[2] * r, v0[3] * r); w.z = pk2(v1[0] * r, v1[1] * r); w.w = pk2(v1[2] * r, v1[3] * r);
          *(u32x4*)(QP + rowoff + u.pn * 256 + bj * 128 + wc * 32 + 8 * fq) = w;
        }
      }
  }
};

DI void ph_meta(int blk, char* smem, const float* __restrict__ meta, const float* __restrict__ g1, const float* __restrict__ w_in, const InProjOut& O) {
  float (*xmT)[16] = (float (*)[16])smem;
  float (*red)[256] = (float (*)[256])(smem + 65536);
  const int tid = fresh_tid(), lane = tid & 63, wave = tid >> 6;
  for (int rr = 0; rr < 2; ++rr) {
    const int mm = wave * 2 + rr;
    float v[16]; float ss = 0.f;
#pragma unroll
    for (int j = 0; j < 16; ++j) { v[j] = meta[(size_t)mm * D + j * 64 + lane]; ss += v[j] * v[j]; }
    ss = wave_sum(ss);
    const float r = rsqrtf(ss * (1.0f / D) + EPS);
#pragma unroll
    for (int j = 0; j < 16; ++j) xmT[j * 64 + lane][mm] = v[j] * r * g1[j * 64 + lane];
  }
  __syncthreads();
  {
    const int c = tid & 15, ks = tid >> 4, n = blk * 16 + c;
    float acc[16];
#pragma unroll
    for (int j = 0; j < 16; ++j) acc[j] = 0.f;
#pragma unroll 8
    for (int kk = 0; kk < 32; ++kk) {
      const int k = ks * 32 + kk;
      const float w = w_in[(size_t)k * NIN + n];
      const f32x4 a = *(const f32x4*)&xmT[k][0], b4 = *(const f32x4*)&xmT[k][4], c4 = *(const f32x4*)&xmT[k][8], d4 = *(const f32x4*)&xmT[k][12];
      acc[0] += a.x * w; acc[1] += a.y * w; acc[2] += a.z * w; acc[3] += a.w * w;
      acc[4] += b4.x * w; acc[5] += b4.y * w; acc[6] += b4.z * w; acc[7] += b4.w * w;
      acc[8] += c4.x * w; acc[9] += c4.y * w; acc[10] += c4.z * w; acc[11] += c4.w * w;
      acc[12] += d4.x * w; acc[13] += d4.y * w; acc[14] += d4.z * w; acc[15] += d4.w * w;
    }
#pragma unroll
    for (int mm = 0; mm < 16; ++mm) red[ks][c * 16 + mm] = acc[mm];
  }
  __syncthreads();
  if (tid < 256) {
    const int c = tid >> 4, mm = tid & 15, n = blk * 16 + c;
    float val = 0.f;
#pragma unroll 8
    for (int ks = 0; ks < 32; ++ks) val += red[ks][tid];
    const bf16_t hv = (bf16_t)f2bf(val);
    for (int bb = 0; bb < NB; ++bb) {
      if (n < 512) {}
      else if (n < 1024) { const int cc = n - 512;  O.KSB[((size_t)(bb * SBH + (cc >> 6)) * KIDX + 16 + mm) * 64 + (cc & 63)] = hv; }
      else if (n < 1536) { const int cc = n - 1024; O.VTSB[((size_t)(bb * SBH + (cc >> 6)) * 64 + (cc & 63)) * KIDX + 16 + mm] = hv; }
      else if (n < 1792) { const int cc = n - 1536; O.GQ[((size_t)(bb * GH + (cc >> 6)) * GU + 48 + mm) * 64 + (cc & 63)] = hv; }
      else if (n < 2048) { const int cc = n - 1792; O.GK[((size_t)(bb * GH + (cc >> 6)) * GU + 48 + mm) * 64 + (cc & 63)] = hv; }
      else if (n < 2560) { const int cc = n - 2048; O.GV[((size_t)(bb * GH + (cc >> 7)) * 128 + (cc & 127)) * GU + 48 + mm] = hv; }
      else if (n < 3072) {}
      else { O.GLR[((size_t)bb * GU + 48 + mm) * 16 + (n - 3072)] = val; }
    }
  }
  __syncthreads();
}


constexpr float SB_THR = 5.421010862e-20f;
DI void ph_sb_attn(int vb, const bf16_t* __restrict__ QSB, const bf16_t* __restrict__ KSB, const bf16_t* __restrict__ VTSB,
                                                 const float* __restrict__ sb_g, bf16_t* __restrict__ MIX) {
  const int tid256_ = fresh_tid() & 255;
  const int lane = TID & 63, wave = TID >> 6, r = lane & 31, h = lane >> 5;
  const int bh = vb >> 6, qb = vb & 63;
  const int b = bh >> 3, hd = bh & 7;
  const int i0 = qb * 128 + wave * 32;
  const bf16_t* Qb = QSB + ((size_t)bh * SEQ + i0) * 64;
  const bf16_t* Kb = KSB + (size_t)bh * KIDX * 64;
  const bf16_t* Vb = VTSB + (size_t)bh * 64 * KIDX;
  bf16x8 qf[4];
#pragma unroll
  for (int ks = 0; ks < 4; ++ks) qf[ks] = *(const bf16x8*)(Qb + r * 64 + ks * 16 + h * 8);
  f32x16 o[2];
#pragma unroll
  for (int e = 0; e < 16; ++e) { o[0][e] = 0.f; o[1][e] = 0.f; }
  float R = 1.f;
  const int qidx = 32 + i0 + r;
  for (int c = (i0 >> 5) + 1; c >= 0; --c) {
    const int k0 = 32 * c;
    bf16x8 kf[4];
#pragma unroll
    for (int ks = 0; ks < 4; ++ks) kf[ks] = *(const bf16x8*)(Kb + (size_t)(k0 + r) * 64 + ks * 16 + h * 8);
    bf16x8 vf[2][2];
#pragma unroll
    for (int mt = 0; mt < 2; ++mt)
#pragma unroll
      for (int s2 = 0; s2 < 2; ++s2) {
        const bf16_t* vp = Vb + (size_t)(mt * 32 + r) * KIDX + k0 + 16 * s2 + 4 * h;
        const u32x2 lo = *(const u32x2*)vp, hi = *(const u32x2*)(vp + 8);
        u32x4 t; t.x = lo.x; t.y = lo.y; t.z = hi.x; t.w = hi.y;
        vf[mt][s2] = __builtin_bit_cast(bf16x8, t);
      }
    f32x16 s;
#pragma unroll
    for (int e = 0; e < 16; ++e) s[e] = 0.f;
#pragma unroll
    for (int ks = 0; ks < 4; ++ks) s = MFMA32(kf[ks], qf[ks], s);
    float om[16], bt[16];
#pragma unroll
    for (int e = 0; e < 16; ++e) {
      const int kidx = k0 + crow(e, h);
      const bool valid = (kidx < qidx) && (kidx >= 16);
      const float z = s[e] * 0.125f;
      const float ez = __expf(-fabsf(z));
      const float big = __builtin_amdgcn_rcpf(1.f + ez), small = ez * big;
      const float beta = z >= 0.f ? big : small, onem = z >= 0.f ? small : big;
      om[e] = valid ? onem : 1.f;
      bt[e] = valid ? beta : 0.f;
    }
    float sfx[16], G[4], PG[4];
#pragma unroll
    for (int g = 0; g < 4; ++g) {
      sfx[4 * g + 3] = 1.f;
      sfx[4 * g + 2] = om[4 * g + 3];
      sfx[4 * g + 1] = sfx[4 * g + 2] * om[4 * g + 2];
      sfx[4 * g + 0] = sfx[4 * g + 1] * om[4 * g + 1];
      G[g] = sfx[4 * g + 0] * om[4 * g + 0];
      PG[g] = __shfl_xor(G[g], 32);
    }
    float HS[4];
    HS[3] = 1.f;
    HS[2] = G[3] * PG[3];
    HS[1] = HS[2] * (G[2] * PG[2]);
    HS[0] = HS[1] * (G[1] * PG[1]);
    const float total = HS[0] * (G[0] * PG[0]);
    float a[16];
#pragma unroll
    for (int e = 0; e < 16; ++e) {
      const int g = e >> 2;
      const float between = sfx[e] * (h == 0 ? PG[g] : 1.f) * (HS[g] * R);
      a[e] = bt[e] * between;
    }
    R *= total;
#pragma unroll
    for (int s2 = 0; s2 < 2; ++s2) {
      u32x4 p;
      p.x = pk2(a[8 * s2 + 0], a[8 * s2 + 1]); p.y = pk2(a[8 * s2 + 2], a[8 * s2 + 3]);
      p.z = pk2(a[8 * s2 + 4], a[8 * s2 + 5]); p.w = pk2(a[8 * s2 + 6], a[8 * s2 + 7]);
      const bf16x8 pf = __builtin_bit_cast(bf16x8, p);
      o[0] = MFMA32(vf[0][s2], pf, o[0]);
      o[1] = MFMA32(vf[1][s2], pf, o[1]);
    }
    if (__all(R < SB_THR)) break;
  }
  float ss = 0.f;
#pragma unroll
  for (int e = 0; e < 16; ++e) ss += o[0][e] * o[0][e] + o[1][e] * o[1][e];
  ss += __shfl_xor(ss, 32);
  const float sc = rsqrtf(ss * (1.0f / 64.0f) + EPS);
  bf16_t* outp = MIX + (size_t)(b * SEQ + i0 + r) * D + hd * 64;
#pragma unroll
  for (int mt = 0; mt < 2; ++mt)
#pragma unroll
    for (int g = 0; g < 4; ++g) {
      const int d = mt * 32 + 8 * g + 4 * h;
      const f32x4 gg = *(const f32x4*)(sb_g + hd * 64 + d);
      u32x2 pk;
      pk.x = pk2(o[mt][4 * g] * sc * gg.x, o[mt][4 * g + 1] * sc * gg.y);
      pk.y = pk2(o[mt][4 * g + 2] * sc * gg.z, o[mt][4 * g + 3] * sc * gg.w);
      *(u32x2*)(outp + d) = pk;
    }
}


DI void sb_tile_step(const f32x16& s, int k0, int qidx, int h, float& R, const bf16x8 (&vf)[2][2], f32x16 (&o)[2]) {
  float om[16], bt[16];
#pragma unroll
  for (int e = 0; e < 16; ++e) {
    const int kidx = k0 + crow(e, h);
    const bool valid = (kidx < qidx) && (kidx >= 16);
    const float z = s[e] * 0.125f;
    const float ez = __expf(-fabsf(z));
    const float big = __builtin_amdgcn_rcpf(1.f + ez), small = ez * big;
    const float beta = z >= 0.f ? big : small, onem = z >= 0.f ? small : big;
    om[e] = valid ? onem : 1.f;
    bt[e] = valid ? beta : 0.f;
  }
  float sfx[16], G[4], PG[4];
#pragma unroll
  for (int g = 0; g < 4; ++g) {
    sfx[4 * g + 3] = 1.f;
    sfx[4 * g + 2] = om[4 * g + 3];
    sfx[4 * g + 1] = sfx[4 * g + 2] * om[4 * g + 2];
    sfx[4 * g + 0] = sfx[4 * g + 1] * om[4 * g + 1];
    G[g] = sfx[4 * g + 0] * om[4 * g + 0];
    PG[g] = __shfl_xor(G[g], 32);
  }
  float HS[4];
  HS[3] = 1.f; HS[2] = G[3] * PG[3]; HS[1] = HS[2] * (G[2] * PG[2]); HS[0] = HS[1] * (G[1] * PG[1]);
  const float total = HS[0] * (G[0] * PG[0]);
  float a[16];
#pragma unroll
  for (int e = 0; e < 16; ++e) { const int g = e >> 2; a[e] = bt[e] * (sfx[e] * (h == 0 ? PG[g] : 1.f) * (HS[g] * R)); }
  R *= total;
#pragma unroll
  for (int s2 = 0; s2 < 2; ++s2) {
    u32x4 p;
    p.x = pk2(a[8 * s2 + 0], a[8 * s2 + 1]); p.y = pk2(a[8 * s2 + 2], a[8 * s2 + 3]);
    p.z = pk2(a[8 * s2 + 4], a[8 * s2 + 5]); p.w = pk2(a[8 * s2 + 6], a[8 * s2 + 7]);
    const bf16x8 pf = __builtin_bit_cast(bf16x8, p);
    o[0] = MFMA32(vf[0][s2], pf, o[0]);
    o[1] = MFMA32(vf[1][s2], pf, o[1]);
  }
}
DI void sb_tile_out(const f32x16 (&o)[2], int h, const float* __restrict__ sb_gh, bf16_t* __restrict__ outp) {
  float ss = 0.f;
#pragma unroll
  for (int e = 0; e < 16; ++e) ss += o[0][e] * o[0][e] + o[1][e] * o[1][e];
  ss += __shfl_xor(ss, 32);
  const float sc = rsqrtf(ss * (1.0f / 64.0f) + EPS);
#pragma unroll
  for (int mt = 0; mt < 2; ++mt)
#pragma unroll
    for (int g = 0; g < 4; ++g) {
      const int d = mt * 32 + 8 * g + 4 * h;
      const f32x4 gg = *(const f32x4*)(sb_gh + d);
      u32x2 pk;
      pk.x = pk2(o[mt][4 * g] * sc * gg.x, o[mt][4 * g + 1] * sc * gg.y);
      pk.y = pk2(o[mt][4 * g + 2] * sc * gg.z, o[mt][4 * g + 3] * sc * gg.w);
      *(u32x2*)(outp + d) = pk;
    }
}
DI void ph_sb_attn2(int vb, const bf16_t* __restrict__ QSB, const bf16_t* __restrict__ KSB, const bf16_t* __restrict__ VTSB,
                    const float* __restrict__ sb_g, bf16_t* __restrict__ MIX) {
  const int tid256_ = fresh_tid() & 255;
  const int lane = TID & 63, wave = TID >> 6, r = lane & 31, h = lane >> 5;
  const int bh = vb >> 5, qb = vb & 31;
  const int b = bh >> 3, hd = bh & 7;
  const int i0 = qb * 256 + wave * 64;
  const bf16_t* Qb = QSB + ((size_t)bh * SEQ + i0) * 64;
  const bf16_t* Kb = KSB + (size_t)bh * KIDX * 64;
  const bf16_t* Vb = VTSB + (size_t)bh * 64 * KIDX;
  bf16x8 qfA[4], qfB[4];
#pragma unroll
  for (int ks = 0; ks < 4; ++ks) { qfA[ks] = *(const bf16x8*)(Qb + r * 64 + ks * 16 + h * 8); qfB[ks] = *(const bf16x8*)(Qb + (32 + r) * 64 + ks * 16 + h * 8); }
  f32x16 oA[2], oB[2];
#pragma unroll
  for (int e = 0; e < 16; ++e) { oA[0][e] = 0.f; oA[1][e] = 0.f; oB[0][e] = 0.f; oB[1][e] = 0.f; }
  float RA = 1.f, RB = 1.f;
  const int qidxA = 32 + i0 + r, qidxB = qidxA + 32;
  for (int c = (i0 >> 5) + 2; c >= 0; --c) {
    const int k0 = 32 * c;
    bf16x8 kf[4];
#pragma unroll
    for (int ks = 0; ks < 4; ++ks) kf[ks] = *(const bf16x8*)(Kb + (size_t)(k0 + r) * 64 + ks * 16 + h * 8);
    bf16x8 vf[2][2];
#pragma unroll
    for (int mt = 0; mt < 2; ++mt)
#pragma unroll
      for (int s2 = 0; s2 < 2; ++s2) {
        const bf16_t* vp = Vb + (size_t)(mt * 32 + r) * KIDX + k0 + 16 * s2 + 4 * h;
        const u32x2 lo = *(const u32x2*)vp, hi = *(const u32x2*)(vp + 8);
        u32x4 t; t.x = lo.x; t.y = lo.y; t.z = hi.x; t.w = hi.y;
        vf[mt][s2] = __builtin_bit_cast(bf16x8, t);
      }
    f32x16 sA, sB;
#pragma unroll
    for (int e = 0; e < 16; ++e) { sA[e] = 0.f; sB[e] = 0.f; }
#pragma unroll
    for (int ks = 0; ks < 4; ++ks) { sA = MFMA32(kf[ks], qfA[ks], sA); sB = MFMA32(kf[ks], qfB[ks], sB); }
    sb_tile_step(sB, k0, qidxB, h, RB, vf, oB);
    sb_tile_step(sA, k0, qidxA, h, RA, vf, oA);
    if (__all(RA < SB_THR && RB < SB_THR)) break;
  }
  sb_tile_out(oA, h, sb_g + hd * 64, MIX + (size_t)(b * SEQ + i0 + r) * D + hd * 64);
  sb_tile_out(oB, h, sb_g + hd * 64, MIX + (size_t)(b * SEQ + i0 + 32 + r) * D + hd * 64);
}


constexpr int RT_TOK_PER_BLOCK = 256;


#define MFMA16(a, b, c) __builtin_amdgcn_mfma_f32_16x16x32_bf16((a), (b), (c), 0, 0, 0)
constexpr int GLDS = 72;
struct GlaLds {
  bf16_t Qt[64 * GLDS];
  bf16_t Kt[64 * GLDS];
  bf16_t KT[64 * GLDS];
  bf16_t P[64 * GLDS];
  float dec[64];
  float tot[8][64];
  float ssq[8][64];
};
constexpr size_t WS_SLOC = 926 * MiB;
constexpr size_t WS_DTOT = 942 * MiB;
constexpr size_t WS_GVT = 604 * MiB;

struct GlaPtrs { const bf16_t *GQ, *GK, *GVT, *GR; const float *GLR, *wg, *bg, *gla_g; float *SLOC, *DTOT; bf16_t* MIX; };


constexpr size_t WS_GQT = 470 * MiB;
constexpr size_t WS_GKT = 502 * MiB + 512 * 1024;
constexpr size_t WS_GKTT = 861 * MiB;
constexpr size_t WS_GDEC = 894 * MiB;
constexpr size_t WS_GBL = 896 * MiB;
struct GlaPrepPtrs { const bf16_t *GQ, *GK; const float *GLR, *wg, *bg; bf16_t *QT, *KT, *KTT; float *DEC, *BL; };
DI void ph_gla_prep(int pair, char* smem, const GlaPrepPtrs& G) {
  const int tid = fresh_tid(), lane = tid & 63, w = tid >> 6, hb = w >> 2, w4 = w & 3;
  float (*tot)[64] = (float (*)[64])(smem + hb * 1024);
  const int item = 2 * pair + hb;
  const int bh = item / 129, c = item % 129, b = bh >> 2, hd = bh & 3, u0 = 64 * c;
  float wgr[16];
#pragma unroll
  for (int k = 0; k < 16; ++k) wgr[k] = G.wg[k * 256 + hd * 64 + lane];
  const float bgv = G.bg[hd * 64 + lane];
  float cs[16]; float run = 0.f;
  unsigned short kraw[16], qraw[16];
#pragma unroll
  for (int i = 0; i < 16; ++i) {
    const int u = u0 + 16 * w4 + i;
    kraw[i] = G.GK[((size_t)bh * GU + u) * 64 + lane];
    qraw[i] = G.GQ[((size_t)bh * GU + u) * 64 + lane];
  }
#pragma unroll
  for (int i = 0; i < 16; ++i) {
    const int u = u0 + 16 * w4 + i;
    float lgv = 0.f;
    if (u >= 48) {
      const f32x4* gp = (const f32x4*)(G.GLR + ((size_t)b * GU + u) * 16);
      const f32x4 g0 = gp[0], g1 = gp[1], g2 = gp[2], g3 = gp[3];
      float a = bgv;
      a += g0.x * wgr[0] + g0.y * wgr[1] + g0.z * wgr[2] + g0.w * wgr[3];
      a += g1.x * wgr[4] + g1.y * wgr[5] + g1.z * wgr[6] + g1.w * wgr[7];
      a += g2.x * wgr[8] + g2.y * wgr[9] + g2.z * wgr[10] + g2.w * wgr[11];
      a += g3.x * wgr[12] + g3.y * wgr[13] + g3.z * wgr[14] + g3.w * wgr[15];
      lgv = -softplus(-a) * (1.0f / 16.0f);
    }
    run += lgv; cs[i] = run;
  }
  tot[w4][lane] = run;
  __syncthreads();
  float offset = 0.f, total = 0.f;
#pragma unroll
  for (int s2 = 0; s2 < 4; ++s2) { const float tv = tot[s2][lane]; total += tv; if (s2 < w4) offset += tv; }
  const size_t cb = ((size_t)bh * 129 + c) * 4096;
  float kt[16];
#pragma unroll
  for (int i = 0; i < 16; ++i) {
    const float bc = offset + cs[i];
    kt[i] = bf2f(kraw[i]) * __expf(-bc);
    G.QT[cb + (16 * w4 + i) * 64 + lane] = (bf16_t)f2bf(bf2f(qraw[i]) * __expf(bc) * 0.125f);
    G.KT[cb + (16 * w4 + i) * 64 + lane] = (bf16_t)f2bf(kt[i]);
  }
  u32x4 kp; kp.x = pk2(kt[0], kt[1]); kp.y = pk2(kt[2], kt[3]); kp.z = pk2(kt[4], kt[5]); kp.w = pk2(kt[6], kt[7]);
  *(u32x4*)(G.KTT + cb + lane * 64 + 16 * w4) = kp;
  kp.x = pk2(kt[8], kt[9]); kp.y = pk2(kt[10], kt[11]); kp.z = pk2(kt[12], kt[13]); kp.w = pk2(kt[14], kt[15]);
  *(u32x4*)(G.KTT + cb + lane * 64 + 16 * w4 + 8) = kp;
  if (w4 == 0) { G.DEC[((size_t)bh * 129 + c) * 64 + lane] = __expf(total); G.BL[((size_t)bh * 129 + c) * 64 + lane] = total; }
  __syncthreads();
}

struct GlaBuf { bf16_t Qt[64 * GLDS]; bf16_t Kt[64 * GLDS]; bf16_t KT[64 * GLDS]; };
struct GlaLds3 { GlaBuf B[2]; bf16_t P[64 * GLDS]; float ssq[8][64]; };
struct GlaPtrs3 { const bf16_t *QT, *KT, *KTT, *GVT, *GR; const float *DEC, *BL, *gla_g; float *SLOC, *DTOT; bf16_t* MIX; };

template <int PASS>
DI void gla_item3(int bh, int sc, char* smem, const GlaPtrs3& G) {
  GlaLds3& L = *(GlaLds3*)smem;
  const int tid = fresh_tid(), lane = tid & 63, w = __builtin_amdgcn_readfirstlane(tid >> 6), c16 = lane & 15, q = lane >> 4;
  const int b = bh >> 2, hd = bh & 3;
  const int cbeg = sc == 0 ? 0 : 8 * sc + 1, cend = 8 * sc + 9;
  f32x4 X[4];
#pragma unroll
  for (int i = 0; i < 4; ++i) X[i] = (f32x4){0.f, 0.f, 0.f, 0.f};
  if (PASS == 1) {
#pragma unroll 4
    for (int j = 0; j < sc; ++j) {
      const float* dt = G.DTOT + (size_t)(bh * 16 + j) * 64;
      const float* sl = G.SLOC + ((size_t)(bh * 16 + j) * 8 + w) * 16 * 64 + lane;
#pragma unroll
      for (int i = 0; i < 4; ++i) {
        const f32x4 d4 = *(const f32x4*)(dt + 16 * i + 4 * q);
        X[i][0] = d4.x * X[i][0] + sl[(4 * i + 0) * 64]; X[i][1] = d4.y * X[i][1] + sl[(4 * i + 1) * 64];
        X[i][2] = d4.z * X[i][2] + sl[(4 * i + 2) * 64]; X[i][3] = d4.w * X[i][3] + sl[(4 * i + 3) * 64];
      }
    }
  }
  f32x4 gain = {1.f, 1.f, 1.f, 1.f};
  if (PASS == 1) gain = *(const f32x4*)(G.gla_g + hd * 128 + 16 * w + 4 * q);
  const bf16_t* gvt = G.GVT + ((size_t)bh * 128 + 16 * w + c16) * GU + 8 * q;
  const int srow = tid >> 3, sc8 = tid & 7, soff = srow * GLDS + sc8 * 8;
  const size_t cb0 = (size_t)bh * 129 * 4096 + (size_t)srow * 64 + sc8 * 8;
  u32x4 rq, rk, rkt, rq2, rk2, rkt2; bf16x8 vfr[2], vfn[2], vfn2[2]; f32x4 dec[4], decn[4], decn2[4];
  {
    const size_t cb = cb0 + (size_t)cbeg * 4096;
    rkt = *(const u32x4*)(G.KTT + cb);
    if (PASS == 1) { rq = *(const u32x4*)(G.QT + cb); rk = *(const u32x4*)(G.KT + cb); }
    vfr[0] = *(const bf16x8*)(gvt + 64 * cbeg); vfr[1] = *(const bf16x8*)(gvt + 64 * cbeg + 32);
#pragma unroll
    for (int i = 0; i < 4; ++i) dec[i] = *(const f32x4*)(G.DEC + ((size_t)bh * 129 + cbeg) * 64 + 16 * i + 4 * q);
    *(u32x4*)&L.B[0].KT[soff] = rkt;
    if (PASS == 1) { *(u32x4*)&L.B[0].Qt[soff] = rq; *(u32x4*)&L.B[0].Kt[soff] = rk; }
    const size_t cb1 = cb0 + (size_t)(cbeg + 1) * 4096;
    rkt = *(const u32x4*)(G.KTT + cb1);
    if (PASS == 1) { rq = *(const u32x4*)(G.QT + cb1); rk = *(const u32x4*)(G.KT + cb1); }
    vfn[0] = *(const bf16x8*)(gvt + 64 * (cbeg + 1)); vfn[1] = *(const bf16x8*)(gvt + 64 * (cbeg + 1) + 32);
#pragma unroll
    for (int i = 0; i < 4; ++i) decn[i] = *(const f32x4*)(G.DEC + ((size_t)bh * 129 + cbeg + 1) * 64 + 16 * i + 4 * q);
  }
  __syncthreads();
  for (int c = cbeg; c < cend; ++c) {
    const int cur = (c - cbeg) & 1;
    const GlaBuf& Bc = L.B[cur];
    const bool more = c + 1 < cend, more2 = c + 2 < cend;
    if (more2) {
      const size_t cb = cb0 + (size_t)(c + 2) * 4096;
      rkt2 = *(const u32x4*)(G.KTT + cb);
      if (PASS == 1) { rq2 = *(const u32x4*)(G.QT + cb); rk2 = *(const u32x4*)(G.KT + cb); }
      vfn2[0] = *(const bf16x8*)(gvt + 64 * (c + 2)); vfn2[1] = *(const bf16x8*)(gvt + 64 * (c + 2) + 32);
#pragma unroll
      for (int i = 0; i < 4; ++i) decn2[i] = *(const f32x4*)(G.DEC + ((size_t)bh * 129 + c + 2) * 64 + 16 * i + 4 * q);
    }
    u32x2 grv[4];
    if (PASS == 1 && c >= 1) {
#pragma unroll
      for (int n = 0; n < 4; ++n) grv[n] = *(const u32x2*)(G.GR + ((size_t)b * SEQ + 64 * (c - 1) + 16 * n + c16) * 512 + hd * 128 + 16 * w + 4 * q);
    }
    f32x4 OT[4];
    if (PASS == 1) {
      const int is = w >> 1;
#pragma unroll
      for (int z = 0; z < 2; ++z) {
        const int it = 2 * (w & 1) + z;
        f32x4 pa = {0.f, 0.f, 0.f, 0.f};
        if (is <= it) {
#pragma unroll
          for (int kk = 0; kk < 2; ++kk) {
            const bf16x8 ka = *(const bf16x8*)&Bc.Kt[(16 * is + c16) * GLDS + 32 * kk + 8 * q];
            const bf16x8 qb = *(const bf16x8*)&Bc.Qt[(16 * it + c16) * GLDS + 32 * kk + 8 * q];
            pa = MFMA16(ka, qb, pa);
          }
          if (is == it) {
#pragma unroll
            for (int r = 0; r < 4; ++r) if (4 * q + r > c16) pa[r] = 0.f;
          }
        }
        u32x2 pw; pw.x = pk2(pa[0], pa[1]); pw.y = pk2(pa[2], pa[3]);
        *(u32x2*)&L.P[(16 * it + c16) * GLDS + 16 * is + 4 * q] = pw;
      }
#pragma unroll
      for (int n = 0; n < 4; ++n) OT[n] = (f32x4){0.f, 0.f, 0.f, 0.f};
#pragma unroll
      for (int kk = 0; kk < 2; ++kk) {
        u32x4 xp; xp.x = pk2(X[2 * kk][0], X[2 * kk][1]); xp.y = pk2(X[2 * kk][2], X[2 * kk][3]);
        xp.z = pk2(X[2 * kk + 1][0], X[2 * kk + 1][1]); xp.w = pk2(X[2 * kk + 1][2], X[2 * kk + 1][3]);
        const bf16x8 xa = __builtin_bit_cast(bf16x8, xp);
#pragma unroll
        for (int n = 0; n < 4; ++n) {
          const u32x2 lo = *(const u32x2*)&Bc.Qt[(16 * n + c16) * GLDS + 32 * kk + 4 * q];
          const u32x2 hi = *(const u32x2*)&Bc.Qt[(16 * n + c16) * GLDS + 32 * kk + 16 + 4 * q];
          u32x4 qq; qq.x = lo.x; qq.y = lo.y; qq.z = hi.x; qq.w = hi.y;
          OT[n] = MFMA16(xa, __builtin_bit_cast(bf16x8, qq), OT[n]);
        }
      }
      __syncthreads();
#pragma unroll
      for (int kk = 0; kk < 2; ++kk)
#pragma unroll
        for (int n = 0; n < 4; ++n) {
          const bf16x8 pb = *(const bf16x8*)&L.P[(16 * n + c16) * GLDS + 32 * kk + 8 * q];
          OT[n] = MFMA16(vfr[kk], pb, OT[n]);
        }
    }
#pragma unroll
    for (int i = 0; i < 4; ++i) {
#pragma unroll
      for (int kk = 0; kk < 2; ++kk) {
        const bf16x8 ka = *(const bf16x8*)&Bc.KT[(16 * i + c16) * GLDS + 32 * kk + 8 * q];
        X[i] = MFMA16(ka, vfr[kk], X[i]);
      }
      X[i][0] *= dec[i].x; X[i][1] *= dec[i].y; X[i][2] *= dec[i].z; X[i][3] *= dec[i].w;
    }
    if (PASS == 1 && c >= 1) {
      float ss[4];
#pragma unroll
      for (int n = 0; n < 4; ++n) {
        float v = OT[n][0] * OT[n][0] + OT[n][1] * OT[n][1] + OT[n][2] * OT[n][2] + OT[n][3] * OT[n][3];
        v += __shfl_xor(v, 16); v += __shfl_xor(v, 32);
        ss[n] = v;
      }
      if (q == 0) {
#pragma unroll
        for (int n = 0; n < 4; ++n) L.ssq[w][16 * n + c16] = ss[n];
      }
      __syncthreads();
#pragma unroll
      for (int n = 0; n < 4; ++n) {
        float tot = 0.f;
#pragma unroll
        for (int w2 = 0; w2 < 8; ++w2) tot += L.ssq[w2][16 * n + c16];
        const float scl = rsqrtf(tot * (1.0f / 128.0f) + EPS);
        const size_t m = (size_t)b * SEQ + 64 * (c - 1) + 16 * n + c16;
        const float r0 = bflo(grv[n].x), r1 = bfhi(grv[n].x), r2 = bflo(grv[n].y), r3 = bfhi(grv[n].y);
        const float o0 = OT[n][0] * scl * gain.x * (r0 / (1.f + __expf(-r0)));
        const float o1 = OT[n][1] * scl * gain.y * (r1 / (1.f + __expf(-r1)));
        const float o2 = OT[n][2] * scl * gain.z * (r2 / (1.f + __expf(-r2)));
        const float o3 = OT[n][3] * scl * gain.w * (r3 / (1.f + __expf(-r3)));
        u32x2 ow; ow.x = pk2(o0, o1); ow.y = pk2(o2, o3);
        *(u32x2*)(G.MIX + m * D + 512 + hd * 128 + 16 * w + 4 * q) = ow;
      }
    }
    if (more) {
      GlaBuf& Bn = L.B[cur ^ 1];
      *(u32x4*)&Bn.KT[soff] = rkt;
      if (PASS == 1) { *(u32x4*)&Bn.Qt[soff] = rq; *(u32x4*)&Bn.Kt[soff] = rk; }
      vfr[0] = vfn[0]; vfr[1] = vfn[1];
#pragma unroll
      for (int i = 0; i < 4; ++i) dec[i] = decn[i];
      rkt = rkt2; rq = rq2; rk = rk2; vfn[0] = vfn2[0]; vfn[1] = vfn2[1];
#pragma unroll
      for (int i = 0; i < 4; ++i) decn[i] = decn2[i];
    }
    __syncthreads();
  }
  if (PASS == 0) {
    float* sl = G.SLOC + ((size_t)(bh * 16 + sc) * 8 + w) * 16 * 64 + lane;
#pragma unroll
    for (int i = 0; i < 4; ++i)
#pragma unroll
      for (int r = 0; r < 4; ++r) sl[(4 * i + r) * 64] = X[i][r];
    if (w == 0) {
      float bl = 0.f;
      for (int c = cbeg; c < cend; ++c) bl += G.BL[((size_t)bh * 129 + c) * 64 + lane];
      G.DTOT[(size_t)(bh * 16 + sc) * 64 + lane] = __expf(bl);
    }
  }
}


struct GlaLds4 { GlaBuf B[2]; bf16_t P[64 * GLDS]; float ssq[4][64]; };
template <int PASS>
DI void gla_item4(int bh_lo, int sc, char* smem, const GlaPtrs3& G) {
  const int tid = fresh_tid(), lane = tid & 63, w = __builtin_amdgcn_readfirstlane(tid >> 6), c16 = lane & 15, q = lane >> 4;
  const int hb = w >> 2, w4 = w & 3, tid4 = tid & 255;
  GlaLds4& L = *(GlaLds4*)(smem + hb * (int)sizeof(GlaLds4));
  const int bh = bh_lo + 16 * hb, b = bh >> 2, hd = bh & 3;
  const int cbeg = sc == 0 ? 0 : 8 * sc + 1, cend = 8 * sc + 9;
  f32x4 X[2][4];
#pragma unroll
  for (int et = 0; et < 2; ++et)
#pragma unroll
    for (int i = 0; i < 4; ++i) X[et][i] = (f32x4){0.f, 0.f, 0.f, 0.f};
  if (PASS == 1) {
#pragma unroll 2
    for (int j = 0; j < sc; ++j) {
      const float* dt = G.DTOT + (size_t)(bh * 16 + j) * 64;
#pragma unroll
      for (int et = 0; et < 2; ++et) {
        const float* sl = G.SLOC + ((size_t)(bh * 16 + j) * 8 + w4 * 2 + et) * 16 * 64 + lane;
#pragma unroll
        for (int i = 0; i < 4; ++i) {
          const f32x4 d4 = *(const f32x4*)(dt + 16 * i + 4 * q);
          X[et][i][0] = d4.x * X[et][i][0] + sl[(4 * i + 0) * 64]; X[et][i][1] = d4.y * X[et][i][1] + sl[(4 * i + 1) * 64];
          X[et][i][2] = d4.z * X[et][i][2] + sl[(4 * i + 2) * 64]; X[et][i][3] = d4.w * X[et][i][3] + sl[(4 * i + 3) * 64];
        }
      }
    }
  }
  f32x4 gain[2];
#pragma unroll
  for (int et = 0; et < 2; ++et) gain[et] = PASS == 1 ? *(const f32x4*)(G.gla_g + hd * 128 + 32 * w4 + 16 * et + 4 * q) : (f32x4){1.f, 1.f, 1.f, 1.f};
  const bf16_t* gvt0 = G.GVT + ((size_t)bh * 128 + 32 * w4 + c16) * GU + 8 * q;
  const bf16_t* gvt1 = gvt0 + (size_t)16 * GU;
  const int soffA = (tid4 >> 3) * GLDS + (tid4 & 7) * 8, soffB = soffA + 32 * GLDS;
  const size_t cb0 = (size_t)bh * 129 * 4096 + (size_t)(tid4 >> 3) * 64 + (tid4 & 7) * 8;
  u32x4 rq[2], rk[2], rkt[2], rq2[2], rk2[2], rkt2[2];
  bf16x8 vfr[2][2], vfn[2][2]; f32x4 dec[4], decn[4];
#define G4_LOADT(rq_, rk_, rkt_, c_) { const size_t cb_ = cb0 + (size_t)(c_) * 4096; \
    rkt_[0] = *(const u32x4*)(G.KTT + cb_); rkt_[1] = *(const u32x4*)(G.KTT + cb_ + 2048); \
    if (PASS == 1) { rq_[0] = *(const u32x4*)(G.QT + cb_); rq_[1] = *(const u32x4*)(G.QT + cb_ + 2048); rk_[0] = *(const u32x4*)(G.KT + cb_); rk_[1] = *(const u32x4*)(G.KT + cb_ + 2048); } }
#define G4_LOADV(vf_, dc_, c_) { vf_[0][0] = *(const bf16x8*)(gvt0 + 64 * (c_)); vf_[0][1] = *(const bf16x8*)(gvt0 + 64 * (c_) + 32); \
    vf_[1][0] = *(const bf16x8*)(gvt1 + 64 * (c_)); vf_[1][1] = *(const bf16x8*)(gvt1 + 64 * (c_) + 32); \
    _Pragma("unroll") for (int i = 0; i < 4; ++i) dc_[i] = *(const f32x4*)(G.DEC + ((size_t)bh * 129 + (c_)) * 64 + 16 * i + 4 * q); }
#define G4_STORET(Bn_, rq_, rk_, rkt_) { *(u32x4*)&Bn_.KT[soffA] = rkt_[0]; *(u32x4*)&Bn_.KT[soffB] = rkt_[1]; \
    if (PASS == 1) { *(u32x4*)&Bn_.Qt[soffA] = rq_[0]; *(u32x4*)&Bn_.Qt[soffB] = rq_[1]; *(u32x4*)&Bn_.Kt[soffA] = rk_[0]; *(u32x4*)&Bn_.Kt[soffB] = rk_[1]; } }
  G4_LOADT(rq, rk, rkt, cbeg)
  G4_LOADV(vfr, dec, cbeg)
  G4_STORET(L.B[0], rq, rk, rkt)
  G4_LOADT(rq, rk, rkt, cbeg + 1)
  G4_LOADV(vfn, decn, cbeg + 1)
  __syncthreads();
  for (int c = cbeg; c < cend; ++c) {
    const int cur = (c - cbeg) & 1;
    const GlaBuf& Bc = L.B[cur];
    const bool more = c + 1 < cend, more2 = c + 2 < cend;
    if (more2) G4_LOADT(rq2, rk2, rkt2, c + 2)
    u32x2 grv[2][4];
    if (PASS == 1 && c >= 1) {
#pragma unroll
      for (int et = 0; et < 2; ++et)
#pragma unroll
        for (int n = 0; n < 4; ++n) grv[et][n] = *(const u32x2*)(G.GR + ((size_t)b * SEQ + 64 * (c - 1) + 16 * n + c16) * 512 + hd * 128 + 32 * w4 + 16 * et + 4 * q);
    }
    f32x4 OT[2][4];
    if (PASS == 1) {
      const int is = w4;
#pragma unroll
      for (int it = 0; it < 4; ++it) {
        f32x4 pa = {0.f, 0.f, 0.f, 0.f};
        if (is <= it) {
#pragma unroll
          for (int kk = 0; kk < 2; ++kk) {
            const bf16x8 ka = *(const bf16x8*)&Bc.Kt[(16 * is + c16) * GLDS + 32 * kk + 8 * q];
            const bf16x8 qb = *(const bf16x8*)&Bc.Qt[(16 * it + c16) * GLDS + 32 * kk + 8 * q];
            pa = MFMA16(ka, qb, pa);
          }
          if (is == it) {
#pragma unroll
            for (int r = 0; r < 4; ++r) if (4 * q + r > c16) pa[r] = 0.f;
          }
        }
        u32x2 pw; pw.x = pk2(pa[0], pa[1]); pw.y = pk2(pa[2], pa[3]);
        *(u32x2*)&L.P[(16 * it + c16) * GLDS + 16 * is + 4 * q] = pw;
      }
#pragma unroll
      for (int et = 0; et < 2; ++et)
#pragma unroll
        for (int n = 0; n < 4; ++n) OT[et][n] = (f32x4){0.f, 0.f, 0.f, 0.f};
#pragma unroll
      for (int kk = 0; kk < 2; ++kk) {
        bf16x8 xa[2];
#pragma unroll
        for (int et = 0; et < 2; ++et) {
          u32x4 xp; xp.x = pk2(X[et][2 * kk][0], X[et][2 * kk][1]); xp.y = pk2(X[et][2 * kk][2], X[et][2 * kk][3]);
          xp.z = pk2(X[et][2 * kk + 1][0], X[et][2 * kk + 1][1]); xp.w = pk2(X[et][2 * kk + 1][2], X[et][2 * kk + 1][3]);
          xa[et] = __builtin_bit_cast(bf16x8, xp);
        }
#pragma unroll
        for (int n = 0; n < 4; ++n) {
          const u32x2 lo = *(const u32x2*)&Bc.Qt[(16 * n + c16) * GLDS + 32 * kk + 4 * q];
          const u32x2 hi = *(const u32x2*)&Bc.Qt[(16 * n + c16) * GLDS + 32 * kk + 16 + 4 * q];
          u32x4 qq; qq.x = lo.x; qq.y = lo.y; qq.z = hi.x; qq.w = hi.y;
          const bf16x8 qf = __builtin_bit_cast(bf16x8, qq);
          OT[0][n] = MFMA16(xa[0], qf, OT[0][n]);
          OT[1][n] = MFMA16(xa[1], qf, OT[1][n]);
        }
      }
      __syncthreads();
#pragma unroll
      for (int kk = 0; kk < 2; ++kk)
#pragma unroll
        for (int n = 0; n < 4; ++n) {
          const bf16x8 pb = *(const bf16x8*)&L.P[(16 * n + c16) * GLDS + 32 * kk + 8 * q];
          OT[0][n] = MFMA16(vfr[0][kk], pb, OT[0][n]);
          OT[1][n] = MFMA16(vfr[1][kk], pb, OT[1][n]);
        }
    }
#pragma unroll
    for (int i = 0; i < 4; ++i) {
#pragma unroll
      for (int kk = 0; kk < 2; ++kk) {
        const bf16x8 ka = *(const bf16x8*)&Bc.KT[(16 * i + c16) * GLDS + 32 * kk + 8 * q];
        X[0][i] = MFMA16(ka, vfr[0][kk], X[0][i]);
        X[1][i] = MFMA16(ka, vfr[1][kk], X[1][i]);
      }
#pragma unroll
      for (int et = 0; et < 2; ++et) { X[et][i][0] *= dec[i].x; X[et][i][1] *= dec[i].y; X[et][i][2] *= dec[i].z; X[et][i][3] *= dec[i].w; }
    }
    if (PASS == 1 && c >= 1) {
      float ss[4];
#pragma unroll
      for (int n = 0; n < 4; ++n) {
        float v = OT[0][n][0] * OT[0][n][0] + OT[0][n][1] * OT[0][n][1] + OT[0][n][2] * OT[0][n][2] + OT[0][n][3] * OT[0][n][3]
                + OT[1][n][0] * OT[1][n][0] + OT[1][n][1] * OT[1][n][1] + OT[1][n][2] * OT[1][n][2] + OT[1][n][3] * OT[1][n][3];
        v += __shfl_xor(v, 16); v += __shfl_xor(v, 32);
        ss[n] = v;
      }
      if (q == 0) {
#pragma unroll
        for (int n = 0; n < 4; ++n) L.ssq[w4][16 * n + c16] = ss[n];
      }
      __syncthreads();
#pragma unroll
      for (int n = 0; n < 4; ++n) {
        const float tot = L.ssq[0][16 * n + c16] + L.ssq[1][16 * n + c16] + L.ssq[2][16 * n + c16] + L.ssq[3][16 * n + c16];
        const float scl = rsqrtf(tot * (1.0f / 128.0f) + EPS);
        const size_t m = (size_t)b * SEQ + 64 * (c - 1) + 16 * n + c16;
#pragma unroll
        for (int et = 0; et < 2; ++et) {
          const float r0 = bflo(grv[et][n].x), r1 = bfhi(grv[et][n].x), r2 = bflo(grv[et][n].y), r3 = bfhi(grv[et][n].y);
          const float o0 = OT[et][n][0] * scl * gain[et].x * r0 * __builtin_amdgcn_rcpf(1.f + __expf(-r0));
          const float o1 = OT[et][n][1] * scl * gain[et].y * r1 * __builtin_amdgcn_rcpf(1.f + __expf(-r1));
          const float o2 = OT[et][n][2] * scl * gain[et].z * r2 * __builtin_amdgcn_rcpf(1.f + __expf(-r2));
          const float o3 = OT[et][n][3] * scl * gain[et].w * r3 * __builtin_amdgcn_rcpf(1.f + __expf(-r3));
          u32x2 ow; ow.x = pk2(o0, o1); ow.y = pk2(o2, o3);
          *(u32x2*)(G.MIX + m * D + 512 + hd * 128 + 32 * w4 + 16 * et + 4 * q) = ow;
        }
      }
    }
    if (more) {
      GlaBuf& Bn = L.B[cur ^ 1];
      G4_STORET(Bn, rq, rk, rkt)
#pragma unroll
      for (int et = 0; et < 2; ++et) { vfr[et][0] = vfn[et][0]; vfr[et][1] = vfn[et][1]; }
#pragma unroll
      for (int i = 0; i < 4; ++i) dec[i] = decn[i];
#pragma unroll
      for (int z = 0; z < 2; ++z) { rkt[z] = rkt2[z]; rq[z] = rq2[z]; rk[z] = rk2[z]; }
      if (more2) G4_LOADV(vfn, decn, c + 2)
    }
    __syncthreads();
  }
#undef G4_LOADT
#undef G4_LOADV
#undef G4_STORET
  if (PASS == 0) {
#pragma unroll
    for (int et = 0; et < 2; ++et) {
      float* sl = G.SLOC + ((size_t)(bh * 16 + sc) * 8 + w4 * 2 + et) * 16 * 64 + lane;
#pragma unroll
      for (int i = 0; i < 4; ++i)
#pragma unroll
        for (int r = 0; r < 4; ++r) sl[(4 * i + r) * 64] = X[et][i][r];
    }
    if (w4 == 0) {
      float bl = 0.f;
      for (int c = cbeg; c < cend; ++c) bl += G.BL[((size_t)bh * 129 + c) * 64 + lane];
      G.DTOT[(size_t)(bh * 16 + sc) * 64 + lane] = __expf(bl);
    }
  }
}

DI void ce_desc(float& a, float& b) {
  const float hi = __builtin_fmaxf(a, b), lo = __builtin_fminf(a, b);
  a = hi; b = lo;
}
DI float vmaxf(float a, float b) { return __builtin_fmaxf(a, b); }
template <int N> DI void bitonic_sort_desc(float (&v)[N]) {
#pragma unroll
  for (int k = 2; k <= N; k <<= 1) {
#pragma unroll
    for (int j = k >> 1; j > 0; j >>= 1) {
#pragma unroll
      for (int i = 0; i < N; ++i) {
        const int l = i ^ j;
        if (l > i) { if ((i & k) == 0) ce_desc(v[i], v[l]); else ce_desc(v[l], v[i]); }
      }
    }
  }
}
DI void sort16_desc(float (&v)[16]) {
  ce_desc(v[0], v[1]); ce_desc(v[2], v[3]); ce_desc(v[0], v[2]); ce_desc(v[1], v[3]); ce_desc(v[1], v[2]); ce_desc(v[4], v[5]); ce_desc(v[6], v[7]); ce_desc(v[4], v[6]); ce_desc(v[5], v[7]); ce_desc(v[5], v[6]); ce_desc(v[0], v[4]); ce_desc(v[2], v[6]); ce_desc(v[2], v[4]); ce_desc(v[1], v[5]); ce_desc(v[3], v[7]); ce_desc(v[3], v[5]); ce_desc(v[1], v[2]); ce_desc(v[3], v[4]); ce_desc(v[5], v[6]); ce_desc(v[8], v[9]); ce_desc(v[10], v[11]); ce_desc(v[8], v[10]); ce_desc(v[9], v[11]); ce_desc(v[9], v[10]); ce_desc(v[12], v[13]); ce_desc(v[14], v[15]); ce_desc(v[12], v[14]); ce_desc(v[13], v[15]); ce_desc(v[13], v[14]); ce_desc(v[8], v[12]); ce_desc(v[10], v[14]); ce_desc(v[10], v[12]); ce_desc(v[9], v[13]); ce_desc(v[11], v[15]); ce_desc(v[11], v[13]); ce_desc(v[9], v[10]); ce_desc(v[11], v[12]); ce_desc(v[13], v[14]); ce_desc(v[0], v[8]); ce_desc(v[4], v[12]); ce_desc(v[4], v[8]); ce_desc(v[2], v[10]); ce_desc(v[6], v[14]); ce_desc(v[6], v[10]); ce_desc(v[2], v[4]); ce_desc(v[6], v[8]); ce_desc(v[10], v[12]); ce_desc(v[1], v[9]); ce_desc(v[5], v[13]); ce_desc(v[5], v[9]); ce_desc(v[3], v[11]); ce_desc(v[7], v[15]); ce_desc(v[7], v[11]); ce_desc(v[3], v[5]); ce_desc(v[7], v[9]); ce_desc(v[11], v[13]); ce_desc(v[1], v[2]); ce_desc(v[3], v[4]); ce_desc(v[5], v[6]); ce_desc(v[7], v[8]); ce_desc(v[9], v[10]); ce_desc(v[11], v[12]); ce_desc(v[13], v[14]);
}
DI void bitonic_merge16_desc(float (&v)[16]) {
#pragma unroll
  for (int j = 8; j > 0; j >>= 1) {
#pragma unroll
    for (int i = 0; i < 16; ++i) { const int l = i ^ j; if (l > i) ce_desc(v[i], v[l]); }
  }
}
template <int NBV> DI void merge_prune16(float (&a)[16], const float (&b)[16]) {
#pragma unroll
  for (int i = 16 - NBV; i < 16; ++i) a[i] = vmaxf(a[i], b[15 - i]);
  bitonic_merge16_desc(a);
}
DI float selh(int hh, float a, float b) { asm volatile("" : "+v"(a), "+v"(b)); return hh == 0 ? a : b; }
DI float pack_idx(float v, unsigned idx, unsigned mask) { return __uint_as_float((__float_as_uint(v) & ~mask) | idx); }

DI void route_stage_keys(int hd, char* smem, const bf16_t* __restrict__ SK1b, const bf16_t* __restrict__ SK2b) {
  const int tid256_ = fresh_tid() & 255;
  bf16_t* kl = (bf16_t*)smem;
#pragma unroll
  for (int i = 0; i < 8; ++i) {
    const int pz = TID + 256 * i, L = pz >> 10, row = (pz >> 3) & 127, c8 = pz & 7;
    const bf16_t* src = (L == 0 ? SK1b : SK2b) + (size_t)(hd * 128 + row) * 64 + c8 * 8;
    *(u32x4*)&kl[(L * 128 + row) * 72 + c8 * 8] = *(const u32x4*)src;
  }
  __syncthreads();
}
DI void route_load_q(bf16x8 (&qf)[2][4], const bf16_t* __restrict__ QP, int m, int hd, int hh) {
#pragma unroll
  for (int L = 0; L < 2; ++L)
#pragma unroll
    for (int ks = 0; ks < 4; ++ks) qf[L][ks] = *(const bf16x8*)(QP + (size_t)m * D + hd * 128 + L * 64 + hh * 8 + ks * 16);
}
DI void ph_route_v2(int vb, char* smem, const bf16x8 (&qf)[2][4], unsigned short* __restrict__ EIDX, float* __restrict__ GATE) {
  const int tid256_ = fresh_tid() & 255;
  const int lane = TID & 63, wave = TID >> 6, r = lane & 31, hh = lane >> 5;
  const int hd = vb & 7, tile = vb >> 3;
  const int m = tile * 128 + wave * 32 + r;
  const bf16_t* kl = (const bf16_t*)smem;
  float loc[2][16];
#pragma unroll
  for (int L = 0; L < 2; ++L) {
    float grp[4][16];
#pragma unroll
    for (int mt = 0; mt < 4; ++mt) {
      f32x16 acc;
#pragma unroll
      for (int e = 0; e < 16; ++e) acc[e] = 0.f;
#pragma unroll
      for (int ks = 0; ks < 4; ++ks) {
        const bf16x8 kf = *(const bf16x8*)&kl[(L * 128 + mt * 32 + r) * 72 + ks * 16 + hh * 8];
        acc = MFMA32(kf, qf[L][ks], acc);
      }
#pragma unroll
      for (int e = 0; e < 16; ++e) grp[mt][e] = pack_idx(acc[e], (unsigned)(mt * 32 + crow(e, hh)), 127u);
      sort16_desc(grp[mt]);
    }
    merge_prune16<16>(grp[0], grp[1]);
    merge_prune16<16>(grp[2], grp[3]);
    merge_prune16<16>(grp[0], grp[2]);
#pragma unroll
    for (int i = 0; i < 16; ++i) loc[L][i] = grp[0][i];
  }
  float fin[16], oth[16];
#pragma unroll
  for (int i = 0; i < 16; ++i) {
    const float send = selh(hh, loc[1][i], loc[0][i]);
    oth[i] = __shfl_xor(send, 32);
    fin[i] = selh(hh, loc[0][i], loc[1][i]);
  }
  merge_prune16<16>(fin, oth);
  float v1[16], v2[16];
#pragma unroll
  for (int i = 0; i < 16; ++i) {
    const float o = __shfl_xor(fin[i], 32);
    v1[i] = selh(hh, fin[i], o);
    v2[i] = selh(hh, o, fin[i]);
  }
  unsigned* ib = (unsigned*)(smem + 36864) + (size_t)TID * 8;
#pragma unroll
  for (int q = 0; q < 4; ++q) {
    unsigned w1 = 0, w2 = 0;
#pragma unroll
    for (int j = 0; j < 4; ++j) {
      w1 |= (__float_as_uint(v1[4 * q + j]) & 127u) << (8 * j);
      w2 |= (__float_as_uint(v2[4 * q + j]) & 127u) << (8 * j);
    }
    ib[q] = w1; ib[4 + q] = w2;
  }
  float R[16], Bv[16];
#pragma unroll
  for (int j = 0; j < 16; ++j) R[j] = pack_idx(v1[0] + v2[j], (unsigned)j, 255u);
#define ROUTE_ROW(I, CNT) { _Pragma("unroll") for (int j = 0; j < 16; ++j) Bv[j] = (j < CNT) ? pack_idx(v1[I] + v2[j < CNT ? j : 0], (unsigned)(I * 16 + j), 255u) : 0.f; \
    merge_prune16<CNT>(R, Bv); }
  ROUTE_ROW(1, 8) ROUTE_ROW(2, 5) ROUTE_ROW(3, 4) ROUTE_ROW(4, 3) ROUTE_ROW(5, 2) ROUTE_ROW(6, 2) ROUTE_ROW(7, 2)
#undef ROUTE_ROW
#pragma unroll
  for (int j = 0; j < 16; ++j) Bv[j] = (j < 8) ? pack_idx(v1[8 + (j < 8 ? j : 0)] + v2[0], (unsigned)((8 + j) * 16), 255u) : 0.f;
  merge_prune16<8>(R, Bv);
  float ex[16], sum = 0.f;
#pragma unroll
  for (int i = 0; i < 16; ++i) { ex[i] = __expf(R[i] - R[0]); sum += ex[i]; }
  const float inv = 1.f / sum;
  const unsigned char* ibb = (const unsigned char*)ib;
  int eo[8]; float go[8];
#pragma unroll
  for (int w = 0; w < 8; ++w) {
    const float rv = selh(hh, R[w], R[8 + w]);
    const float ev = selh(hh, ex[w], ex[8 + w]);
    const unsigned pos = __float_as_uint(rv) & 255u;
    const unsigned i1 = ibb[pos >> 4], i2 = ibb[16 + (pos & 15u)];
    eo[w] = (int)(i1 * 128u + i2);
    go[w] = ev * inv;
  }
  unsigned short* ep = EIDX + (size_t)m * 128 + hd * 16 + hh * 8;
  float* gp = GATE + (size_t)m * 128 + hd * 16 + hh * 8;
  *(u32x4*)ep = (u32x4){(unsigned)eo[0] | ((unsigned)eo[1] << 16), (unsigned)eo[2] | ((unsigned)eo[3] << 16), (unsigned)eo[4] | ((unsigned)eo[5] << 16), (unsigned)eo[6] | ((unsigned)eo[7] << 16)};
  *(f32x4*)gp = (f32x4){go[0], go[1], go[2], go[3]};
  *(f32x4*)(gp + 4) = (f32x4){go[4], go[5], go[6], go[7]};
}


typedef unsigned char u8_t;
constexpr size_t WS_SCU = 14 * MiB;
constexpr size_t WS_SCV = 14 * MiB + 65536;
DI float wave_max(float v) {
#pragma unroll
  for (int o = 32; o >= 1; o >>= 1) v = fmaxf(v, __shfl_xor(v, o));
  return v;
}
DI u32x4 quant_row16(const float* __restrict__ rowp, int lane, float& sc) {
  const f32x4* rp = (const f32x4*)(rowp + lane * 16);
  const f32x4 a = rp[0], b = rp[1], c = rp[2], d = rp[3];
  float m = fmaxf(fmaxf(fmaxf(fabsf(a.x), fabsf(a.y)), fmaxf(fabsf(a.z), fabsf(a.w))), fmaxf(fmaxf(fabsf(b.x), fabsf(b.y)), fmaxf(fabsf(b.z), fabsf(b.w))));
  m = fmaxf(m, fmaxf(fmaxf(fmaxf(fabsf(c.x), fabsf(c.y)), fmaxf(fabsf(c.z), fabsf(c.w))), fmaxf(fmaxf(fabsf(d.x), fabsf(d.y)), fmaxf(fabsf(d.z), fabsf(d.w)))));
  m = wave_max(m);
  sc = m > 0.f ? m * (1.0f / 448.0f) : 1.0f;
  const float inv = 1.0f / sc;
  u32x4 o; unsigned w;
  w = 0; w = __builtin_amdgcn_cvt_pk_fp8_f32(a.x * inv, a.y * inv, w, false); w = __builtin_amdgcn_cvt_pk_fp8_f32(a.z * inv, a.w * inv, w, true); o.x = w;
  w = 0; w = __builtin_amdgcn_cvt_pk_fp8_f32(b.x * inv, b.y * inv, w, false); w = __builtin_amdgcn_cvt_pk_fp8_f32(b.z * inv, b.w * inv, w, true); o.y = w;
  w = 0; w = __builtin_amdgcn_cvt_pk_fp8_f32(c.x * inv, c.y * inv, w, false); w = __builtin_amdgcn_cvt_pk_fp8_f32(c.z * inv, c.w * inv, w, true); o.z = w;
  w = 0; w = __builtin_amdgcn_cvt_pk_fp8_f32(d.x * inv, d.y * inv, w, false); w = __builtin_amdgcn_cvt_pk_fp8_f32(d.z * inv, d.w * inv, w, true); o.w = w;
  return o;
}
DI void ph_convert_ev8(int vb, char* smem, const float* __restrict__ src, u8_t* __restrict__ EV8c, float* __restrict__ scaleV) {
  const int tid256_ = fresh_tid() & 255;
  u8_t (*t)[1040] = (u8_t (*)[1040])smem;
  const int lane = TID & 63, wave = TID >> 6, e0 = vb * 32;
  for (int rr = 0; rr < 8; ++rr) {
    const int r = wave * 8 + rr;
    float sc;
    const u32x4 o = quant_row16(src + (size_t)(e0 + r) * D, lane, sc);
    *(u32x4*)&t[r][lane * 16] = o;
    if (lane == 0) scaleV[e0 + r] = sc;
  }
  __syncthreads();
  const int r = TID & 31, cs = TID >> 5;
  for (int c0 = 0; c0 < 128; c0 += 8) {
    const int cg = c0 + cs;
    const u32x2 v = *(const u32x2*)&t[r][cg * 8];
    *(u32x2*)(EV8c + ((size_t)cg * NEXP + e0 + r) * 8) = v;
  }
  __syncthreads();
}
struct PeerUHalf { u32x4 u[8]; };
DI float gelu_as(float v) {
  const float av = fabsf(v);
  const float t = __builtin_amdgcn_rcpf(av * 0.2316418882f + 1.0f);
  float q = t * 0.5307027145f + (-0.7265760135f); q = q * t + 0.7107068705f; q = q * t + (-0.142248368f); q = q * t + 0.127414796f; q = q * t;
  const float e = __builtin_amdgcn_exp2f((v * v) * (-0.72134752044f));
  const float m = v * (q * e);
  return v < 0.f ? m : v - m;
}
DI void pc_stage_scales(char* smem, const float* __restrict__ scaleU, const float* __restrict__ scaleV) {
  unsigned* sc = (unsigned*)(smem + 34816);
  const int tid = fresh_tid();
#pragma unroll 4
  for (int i = tid; i < NEXP; i += 512) sc[i] = f2bf(scaleU[i]) | (f2bf(scaleV[i]) << 16);
  __syncthreads();
}
DI void ph_peer_c8(int unit, char* smem, const bf16_t* __restrict__ PP, const unsigned short* __restrict__ EIDX, const float* __restrict__ GATE,
                   unsigned* __restrict__ STREAM) {
  unsigned (*tile)[132] = (unsigned (*)[132])smem;
  const unsigned* sc = (const unsigned*)(smem + 34816);
  const int tid = fresh_tid();
  const int tl = tid >> 3, kc = tid & 7;
  const size_t rowoff = ((size_t)unit * 64 + tl) * 128 + kc * 16;
  const size_t n = (size_t)TREAL * 128;
  float a[16];
#pragma unroll
  for (int j = 0; j < 16; ++j) a[j] = 0.f;
#pragma unroll
  for (int s = 0; s < 8; ++s) {
    const u32x4 p0 = *(const u32x4*)(PP + (size_t)s * n + rowoff), p1 = *(const u32x4*)(PP + (size_t)s * n + rowoff + 8);
    a[0] += bflo(p0.x); a[1] += bfhi(p0.x); a[2] += bflo(p0.y); a[3] += bfhi(p0.y); a[4] += bflo(p0.z); a[5] += bfhi(p0.z); a[6] += bflo(p0.w); a[7] += bfhi(p0.w);
    a[8] += bflo(p1.x); a[9] += bfhi(p1.x); a[10] += bflo(p1.y); a[11] += bfhi(p1.y); a[12] += bflo(p1.z); a[13] += bfhi(p1.z); a[14] += bflo(p1.w); a[15] += bfhi(p1.w);
  }
  const u32x4 e0 = *(const u32x4*)(EIDX + rowoff), e1 = *(const u32x4*)(EIDX + rowoff + 8);
  unsigned ev[16] = {e0.x & 0xffffu, e0.x >> 16, e0.y & 0xffffu, e0.y >> 16, e0.z & 0xffffu, e0.z >> 16, e0.w & 0xffffu, e0.w >> 16,
                     e1.x & 0xffffu, e1.x >> 16, e1.y & 0xffffu, e1.y >> 16, e1.z & 0xffffu, e1.z >> 16, e1.w & 0xffffu, e1.w >> 16};
  float gt[16];
#pragma unroll
  for (int j = 0; j < 4; ++j) { const f32x4 g4 = *(const f32x4*)(GATE + rowoff + 4 * j); gt[4 * j] = g4.x; gt[4 * j + 1] = g4.y; gt[4 * j + 2] = g4.z; gt[4 * j + 3] = g4.w; }
#pragma unroll
  for (int j = 0; j < 16; ++j) {
    const unsigned e = ev[j];
    const unsigned sw = sc[e];
    const float av = a[j] * bflo(sw);
    const float act = gelu_as(av);
    const float c = gt[j] * act * bfhi(sw);
    tile[tl][kc * 16 + j] = e | (f2bf(c) << 16);
  }
  __syncthreads();
  unsigned* outp = STREAM + (size_t)unit * 8192;
#pragma unroll 4
  for (int j = 0; j < 16; ++j) {
    const int o = tid + 512 * j, q = o >> 8, t2 = (o >> 2) & 63, z = o & 3;
    outp[o] = tile[t2][4 * q + z];
  }
  __syncthreads();
}
struct PVW { u32x4 a, b; };
struct PVT { u32x2 v[8]; };
DI void pv_loadw(PVW& W, const unsigned* __restrict__ STREAM, int it, int g, int lane) {
  const u32x4* sp = (const u32x4*)(STREAM + (size_t)it * 8192) + lane;
  W.a = sp[(2 * g) * 64]; W.b = sp[(2 * g + 1) * 64];
}
DI void pv_readt(PVT& T, const PVW& W, const u32x2* tabl) {
  T.v[0] = tabl[W.a.x & 0xffffu]; T.v[1] = tabl[W.a.y & 0xffffu]; T.v[2] = tabl[W.a.z & 0xffffu]; T.v[3] = tabl[W.a.w & 0xffffu];
  T.v[4] = tabl[W.b.x & 0xffffu]; T.v[5] = tabl[W.b.y & 0xffffu]; T.v[6] = tabl[W.b.z & 0xffffu]; T.v[7] = tabl[W.b.w & 0xffffu];
}
DI void pv_fma1(unsigned w, const u32x2 v, f32x2 (&y)[4]) {
  const float c = bfhi(w);
  const f32x2 cc = {c, c};
  y[0] = __builtin_elementwise_fma(__builtin_amdgcn_cvt_pk_f32_fp8(v.x, false), cc, y[0]);
  y[1] = __builtin_elementwise_fma(__builtin_amdgcn_cvt_pk_f32_fp8(v.x, true), cc, y[1]);
  y[2] = __builtin_elementwise_fma(__builtin_amdgcn_cvt_pk_f32_fp8(v.y, false), cc, y[2]);
  y[3] = __builtin_elementwise_fma(__builtin_amdgcn_cvt_pk_f32_fp8(v.y, true), cc, y[3]);
}
DI void pv_fma(const PVW& W, const PVT& T, f32x2 (&y)[4]) {
  pv_fma1(W.a.x, T.v[0], y); pv_fma1(W.a.y, T.v[1], y); pv_fma1(W.a.z, T.v[2], y); pv_fma1(W.a.w, T.v[3], y);
  pv_fma1(W.b.x, T.v[4], y); pv_fma1(W.b.y, T.v[5], y); pv_fma1(W.b.z, T.v[6], y); pv_fma1(W.b.w, T.v[7], y);
}
DI void ph_peer_v8(char* smem, const unsigned* __restrict__ STREAM, const u8_t* __restrict__ EV8c, bf16_t* __restrict__ YT) {
  const int tid = fresh_tid(), lane = tid & 63, wave = tid >> 6;
  const u32x2* tabl = (const u32x2*)smem;
  for (int unit = blockIdx.x; unit < 256; unit += gridDim.x) {
    const int cg = unit & 127, th = unit >> 7;
    const u32x4* src = (const u32x4*)(EV8c + (size_t)cg * NEXP * 8);
#pragma unroll 4
    for (int i = tid; i < NEXP * 8 / 16; i += 512) ((u32x4*)smem)[i] = src[i];
    __syncthreads();
    const int it_end = th * 512 + 512;
    int it = th * 512 + wave;
    PVW W0, W1, W2, W3; PVT T0, T1;
    pv_loadw(W0, STREAM, it, 0, lane); pv_loadw(W1, STREAM, it, 1, lane);
    pv_readt(T0, W0, tabl);
    for (; it < it_end; it += 8) {
      const int itn = (it + 8 < it_end) ? it + 8 : it;
      f32x2 y[4];
#pragma unroll
      for (int z = 0; z < 4; ++z) y[z] = (f32x2){0.f, 0.f};
#define PV_STEP(g, Wld, Wrd, Trd, Wc, Tc) \
      pv_loadw(Wld, STREAM, ((g) + 2 < 16) ? it : itn, ((g) + 2) & 15, lane); \
      pv_readt(Trd, Wrd, tabl); \
      pv_fma(Wc, Tc, y); \
      asm volatile("" ::: "memory");
      PV_STEP(0, W2, W1, T1, W0, T0)  PV_STEP(1, W3, W2, T0, W1, T1)  PV_STEP(2, W0, W3, T1, W2, T0)  PV_STEP(3, W1, W0, T0, W3, T1)
      PV_STEP(4, W2, W1, T1, W0, T0)  PV_STEP(5, W3, W2, T0, W1, T1)  PV_STEP(6, W0, W3, T1, W2, T0)  PV_STEP(7, W1, W0, T0, W3, T1)
      PV_STEP(8, W2, W1, T1, W0, T0)  PV_STEP(9, W3, W2, T0, W1, T1)  PV_STEP(10, W0, W3, T1, W2, T0) PV_STEP(11, W1, W0, T0, W3, T1)
      PV_STEP(12, W2, W1, T1, W0, T0) PV_STEP(13, W3, W2, T0, W1, T1) PV_STEP(14, W0, W3, T1, W2, T0) PV_STEP(15, W1, W0, T0, W3, T1)
#undef PV_STEP
      const int t = it * 64 + lane;
      u32x4 yw; yw.x = pk2(y[0].x, y[0].y); yw.y = pk2(y[1].x, y[1].y); yw.z = pk2(y[2].x, y[2].y); yw.w = pk2(y[3].x, y[3].y);
      *(u32x4*)(YT + ((size_t)cg * TREAL + t) * 8) = yw;
    }
    __syncthreads();
  }
}


DI void ph_final_lds(int unit, char* smem, const bf16_t* __restrict__ H1, const bf16_t* __restrict__ YT, const float* __restrict__ gf, float* __restrict__ out) {
  float (*h2)[1028] = (float (*)[1028])smem;
  const int tid = fresh_tid(), lane = tid & 63, wave = tid >> 6;
  const int t0 = unit * 32;
#pragma unroll
  for (int rr = 0; rr < 4; ++rr) {
    const int r = wave * 4 + rr;
    const bf16_t* hp = H1 + (size_t)(t0 + r) * D;
#pragma unroll
    for (int j = 0; j < 2; ++j) {
      const u32x4 hw = *(const u32x4*)(hp + j * 512 + lane * 8);
      *(f32x4*)&h2[r][j * 512 + lane * 8] = (f32x4){bflo(hw.x), bfhi(hw.x), bflo(hw.y), bfhi(hw.y)};
      *(f32x4*)&h2[r][j * 512 + lane * 8 + 4] = (f32x4){bflo(hw.z), bfhi(hw.z), bflo(hw.w), bfhi(hw.w)};
    }
  }
  __syncthreads();
  {
    const int tok = lane & 31;
#pragma unroll 4
    for (int cg = wave * 2 + (lane >> 5); cg < 128; cg += 16) {
      const u32x4 yw = *(const u32x4*)(YT + ((size_t)cg * TREAL + t0 + tok) * 8);
      f32x4* hp = (f32x4*)&h2[tok][cg * 8];
      f32x4 a = hp[0], b4 = hp[1];
      a.x += bflo(yw.x); a.y += bfhi(yw.x); a.z += bflo(yw.y); a.w += bfhi(yw.y);
      b4.x += bflo(yw.z); b4.y += bfhi(yw.z); b4.z += bflo(yw.w); b4.w += bfhi(yw.w);
      hp[0] = a; hp[1] = b4;
    }
  }
  __syncthreads();
#pragma unroll
  for (int rr = 0; rr < 4; ++rr) {
    const int r = wave * 4 + rr;
    f32x4 v[4]; float ss = 0.f;
#pragma unroll
    for (int j = 0; j < 4; ++j) { v[j] = *(const f32x4*)&h2[r][j * 256 + lane * 4]; ss += v[j].x * v[j].x + v[j].y * v[j].y + v[j].z * v[j].z + v[j].w * v[j].w; }
    ss = wave_sum(ss);
    const float sc = rsqrtf(ss * (1.0f / D) + EPS);
    float* op = out + (size_t)(t0 + r) * D;
#pragma unroll
    for (int j = 0; j < 4; ++j) {
      const f32x4 gg = *(const f32x4*)(gf + j * 256 + lane * 4);
      *(f32x4*)(op + j * 256 + lane * 4) = (f32x4){v[j].x * sc * gg.x, v[j].y * sc * gg.y, v[j].z * sc * gg.z, v[j].w * sc * gg.w};
    }
  }
  __syncthreads();
}

typedef int i32x4 __attribute__((ext_vector_type(4)));
constexpr size_t WS_XQ = 861 * MiB;
constexpr size_t WS_XS = 943 * MiB;
DI unsigned pack_i8x4(float a, float b, float c, float d) {
  const int ia = __float2int_rn(a), ib = __float2int_rn(b), ic = __float2int_rn(c), id = __float2int_rn(d);
  return ((unsigned)ia & 255u) | (((unsigned)ib & 255u) << 8) | (((unsigned)ic & 255u) << 16) | ((unsigned)id << 24);
}
DI u32x4 quant_row16_i8(const float* __restrict__ rowp, int lane, float& sc) {
  const f32x4* rp = (const f32x4*)(rowp + lane * 16);
  const f32x4 a = rp[0], b = rp[1], c = rp[2], d = rp[3];
  float m = fmaxf(fmaxf(fmaxf(fabsf(a.x), fabsf(a.y)), fmaxf(fabsf(a.z), fabsf(a.w))), fmaxf(fmaxf(fabsf(b.x), fabsf(b.y)), fmaxf(fabsf(b.z), fabsf(b.w))));
  m = fmaxf(m, fmaxf(fmaxf(fmaxf(fabsf(c.x), fabsf(c.y)), fmaxf(fabsf(c.z), fabsf(c.w))), fmaxf(fmaxf(fabsf(d.x), fabsf(d.y)), fmaxf(fabsf(d.z), fabsf(d.w)))));
  m = wave_max(m);
  sc = m > 0.f ? m * (1.0f / 127.0f) : 1.0f;
  const float inv = 1.0f / sc;
  u32x4 o;
  o.x = pack_i8x4(a.x * inv, a.y * inv, a.z * inv, a.w * inv); o.y = pack_i8x4(b.x * inv, b.y * inv, b.z * inv, b.w * inv);
  o.z = pack_i8x4(c.x * inv, c.y * inv, c.z * inv, c.w * inv); o.w = pack_i8x4(d.x * inv, d.y * inv, d.z * inv, d.w * inv);
  return o;
}
DI void ph_convert_eu_i8(const float* __restrict__ src, u8_t* __restrict__ EUq, float* __restrict__ scaleU) {
  const int tid = fresh_tid(), lane = tid & 63, wave = tid >> 6;
  for (int e = (blockIdx.x * 8 + wave) * 2; e < NEXP; e += gridDim.x * 16) {
    float sc0, sc1 = 1.f;
    const bool two = e + 1 < NEXP;
    const u32x4 o0 = quant_row16_i8(src + (size_t)e * D, lane, sc0);
    u32x4 o1 = o0;
    if (two) o1 = quant_row16_i8(src + (size_t)(e + 1) * D, lane, sc1);
    *(u32x4*)(EUq + ((size_t)(lane >> 3) * NEXP + e) * 128 + (lane & 7) * 16) = o0;
    if (two) *(u32x4*)(EUq + ((size_t)(lane >> 3) * NEXP + e + 1) * 128 + (lane & 7) * 16) = o1;
    if (lane == 0) { scaleU[e] = sc0; if (two) scaleU[e + 1] = sc1; }
  }
}
DI void ph_norm2_rows(int vb, const bf16_t* __restrict__ src, const float* __restrict__ gain, float* __restrict__ R2, u8_t* __restrict__ XQ, float* __restrict__ XS) {
  const int tid256_ = fresh_tid() & 255;
  const int row0 = vb * 16 + (TID >> 6) * 4, lane = TID & 63;
  u32x2 raw[4][4];
#pragma unroll
  for (int rr = 0; rr < 4; ++rr)
#pragma unroll
    for (int j = 0; j < 4; ++j) raw[rr][j] = *(const u32x2*)(src + (size_t)(row0 + rr) * D + j * 256 + lane * 4);
  f32x4 gg[4];
#pragma unroll
  for (int j = 0; j < 4; ++j) gg[j] = *(const f32x4*)(gain + j * 256 + lane * 4);
#pragma unroll
  for (int rr = 0; rr < 4; ++rr) {
    f32x4 v[4]; float ss = 0.f;
#pragma unroll
    for (int j = 0; j < 4; ++j) {
      v[j] = (f32x4){bflo(raw[rr][j].x), bfhi(raw[rr][j].x), bflo(raw[rr][j].y), bfhi(raw[rr][j].y)};
      ss += v[j].x * v[j].x + v[j].y * v[j].y + v[j].z * v[j].z + v[j].w * v[j].w;
    }
    ss = wave_sum(ss);
    const float r = rsqrtf(ss * (1.0f / D) + EPS);
    if (lane == 0) R2[row0 + rr] = r;
#pragma unroll
    for (int j = 0; j < 4; ++j) {
      const float a0 = v[j].x * gg[j].x, a1 = v[j].y * gg[j].y, a2 = v[j].z * gg[j].z, a3 = v[j].w * gg[j].w;
      float m = fmaxf(fmaxf(fabsf(a0), fabsf(a1)), fmaxf(fabsf(a2), fabsf(a3)));
#pragma unroll
      for (int sh = 16; sh >= 1; sh >>= 1) m = fmaxf(m, __shfl_xor(m, sh));
      const float inv = m > 0.f ? 127.0f / m : 0.f;
      *(unsigned*)(XQ + (size_t)(row0 + rr) * D + j * 256 + lane * 4) = pack_i8x4(a0 * inv, a1 * inv, a2 * inv, a3 * inv);
      if ((lane & 31) == 0) XS[(size_t)(row0 + rr) * 8 + 2 * j + (lane >> 5)] = m * r * (1.0f / 127.0f);
    }
  }
}
DI int dpp_i(int v, const int sel) {
  if (sel == 0) return __builtin_amdgcn_update_dpp(0, v, 0xB1, 0xF, 0xF, true);
  if (sel == 1) return __builtin_amdgcn_update_dpp(0, v, 0x4E, 0xF, 0xF, true);
  return __builtin_amdgcn_update_dpp(0, v, 0x141, 0xF, 0xF, true);
}
DI int dpp_isum8(int v) { v += dpp_i(v, 0); v += dpp_i(v, 1); v += dpp_i(v, 2); return v; }
template <int HF> DI void peer_ud4_issue(PeerUHalf& H, unsigned idxpair, int lane, const u8_t* __restrict__ tab) {
#pragma unroll
  for (int jj = 0; jj < 8; ++jj) {
    const int j = 8 * HF + jj;
    const unsigned w = (unsigned)__shfl((int)idxpair, (lane & ~7) + (j >> 1));
    const unsigned e = (j & 1) ? (w >> 16) : (w & 0xffffu);
    H.u[jj] = *(const u32x4*)(tab + (size_t)e * 128);
  }
}
template <int HF> DI void peer_ud4_compute(const PeerUHalf& H, const u32x4 xq, int sub, int& res0, int& res1) {
#pragma unroll
  for (int jj = 0; jj < 8; ++jj) {
    const int j = 8 * HF + jj;
    int acc = 0;
    acc = __builtin_amdgcn_sdot4((int)H.u[jj].x, (int)xq.x, acc, false); acc = __builtin_amdgcn_sdot4((int)H.u[jj].y, (int)xq.y, acc, false);
    acc = __builtin_amdgcn_sdot4((int)H.u[jj].z, (int)xq.z, acc, false); acc = __builtin_amdgcn_sdot4((int)H.u[jj].w, (int)xq.w, acc, false);
    acc = dpp_isum8(acc);
    if (sub == (j >> 1)) { if (j & 1) res1 = acc; else res0 = acc; }
  }
}
DI void ph_peer_u_d4(int xi, int nx, int wv, int nwv, const u8_t* __restrict__ XQ, const float* __restrict__ XS, const u8_t* __restrict__ EUq,
                     const unsigned short* __restrict__ EIDX, bf16_t* __restrict__ PP) {
  const int lane = fresh_tid() & 63, sub = lane & 7;
  const int ntok = (TREAL - wv + nwv - 1) / nwv;
#define PU_TOK(i) (wv + ((i) < ntok ? (i) : ntok - 1) * nwv)
#define PU_IDX(t) __builtin_nontemporal_load((const unsigned*)(EIDX + (size_t)(t) * 128) + lane)
#define PU_LDX(xq_, xs_, t) { xq_ = *(const u32x4*)(xbase + (size_t)(t) * D); xs_ = XS[(size_t)(t) * 8 + s]; }
#define PU_STORE(t, r0, r1, xs_) __builtin_nontemporal_store(pk2((float)(r0) * (xs_), (float)(r1) * (xs_)), (unsigned*)(pp + (size_t)(t) * 128) + lane)
  for (int s = xi; s < 8; s += nx) {
    const u8_t* tab = EUq + (size_t)s * NEXP * 128 + sub * 16;
    const u8_t* xbase = XQ + s * 128 + sub * 16;
    bf16_t* pp = PP + (size_t)s * TREAL * 128;
    PeerUHalf HA, HB, HC;
    int ta = PU_TOK(0), tb = PU_TOK(1), tc = PU_TOK(2);
    unsigned ia = PU_IDX(ta), ib = PU_IDX(tb), ic = PU_IDX(tc);
    u32x4 xqa; float xsa; PU_LDX(xqa, xsa, ta);
    peer_ud4_issue<0>(HA, ia, lane, tab);
    peer_ud4_issue<1>(HB, ia, lane, tab);
    for (int i = 0; i < ntok; i += 3) {
      const int td = PU_TOK(i + 3), te = PU_TOK(i + 4), tf = PU_TOK(i + 5);
      u32x4 xqb, xqc, xqd; float xsb, xsc, xsd;
      int r0, r1;
      peer_ud4_issue<0>(HC, ib, lane, tab); PU_LDX(xqb, xsb, tb); const unsigned id = PU_IDX(td);
      r0 = 0; r1 = 0;
      peer_ud4_compute<0>(HA, xqa, sub, r0, r1);
      peer_ud4_issue<1>(HA, ib, lane, tab);
      peer_ud4_compute<1>(HB, xqa, sub, r0, r1);
      PU_STORE(ta, r0, r1, xsa);
      peer_ud4_issue<0>(HB, ic, lane, tab); PU_LDX(xqc, xsc, tc); const unsigned ie = PU_IDX(te);
      r0 = 0; r1 = 0;
      peer_ud4_compute<0>(HC, xqb, sub, r0, r1);
      peer_ud4_issue<1>(HC, ic, lane, tab);
      peer_ud4_compute<1>(HA, xqb, sub, r0, r1);
      PU_STORE(tb, r0, r1, xsb);
      peer_ud4_issue<0>(HA, id, lane, tab); PU_LDX(xqd, xsd, td); const unsigned if_ = PU_IDX(tf);
      r0 = 0; r1 = 0;
      peer_ud4_compute<0>(HB, xqc, sub, r0, r1);
      peer_ud4_issue<1>(HB, id, lane, tab);
      peer_ud4_compute<1>(HC, xqc, sub, r0, r1);
      PU_STORE(tc, r0, r1, xsc);
      ta = td; tb = te; tc = tf; ib = ie; ic = if_; xqa = xqd; xsa = xsd;
    }
  }
#undef PU_TOK
#undef PU_IDX
#undef PU_LDX
#undef PU_STORE
}

struct PUI { i32x4 a[8]; };
struct PUE { int e[8]; };

#define XB_TMO      128
#define XB_XCNT(j)  (256  + 64 * (j))
#define XB_XSUB(j)  (1280 + 64 * (j))
#define XB_XGEN(j)  (2304 + 64 * (j))
#define XB_TOP      3328
#define XB_TOPGEN   3392
#define XCD_BAR_WORDS 3456
#define XB_SPIN_CAP (1u << 20)
#define LAS __attribute__((address_space(3)))
DI unsigned xb_ld(unsigned* p)              { return __hip_atomic_load(p, __ATOMIC_RELAXED, __HIP_MEMORY_SCOPE_AGENT); }
DI unsigned xb_add(unsigned* p, unsigned v) { return __hip_atomic_fetch_add(p, v, __ATOMIC_RELAXED, __HIP_MEMORY_SCOPE_AGENT); }
DI unsigned xb_xcc_id() { return (unsigned)__builtin_amdgcn_s_getreg((3 << 11) | 20) & 0xFu; }
#define XB_SPIN(cond, bar) do { unsigned _sp = 0; while (cond) { __builtin_amdgcn_s_sleep(1); \
    if ((++_sp & 255u) == 0u) { if (xb_ld(&(bar)[XB_TMO])) break; if (_sp > XB_SPIN_CAP) { atomicAdd(&(bar)[XB_TMO], 1u); break; } } } } while (0)
struct XcdBarrier { unsigned* bar; unsigned x; volatile unsigned* st; };
DI XcdBarrier xcd_barrier_post(unsigned* bar, volatile unsigned* st) {
  XcdBarrier b; b.bar = bar; b.x = xb_xcc_id(); b.st = st;
  if (threadIdx.x == 0) (void)xb_add(&bar[XB_XCNT(b.x)], 1u);
  return b;
}
DI void xcd_barrier_complete(unsigned* bar, unsigned x, unsigned& nloc, unsigned& nx) {
  const unsigned G = gridDim.x;
  unsigned sum, cnt, mine, sp = 0u;
  for (;;) {
    sum = 0u; cnt = 0u; mine = 0u;
#pragma unroll
    for (unsigned j = 0; j < 16; ++j) { const unsigned c = xb_ld(&bar[XB_XCNT(j)]); sum += c; cnt += (c > 0u) ? 1u : 0u; mine = (j == x) ? c : mine; }
    if (sum == G) break;
    __builtin_amdgcn_s_sleep(1);
    if ((++sp & 255u) == 0u) { if (xb_ld(&bar[XB_TMO])) break; if (sp > XB_SPIN_CAP) { atomicAdd(&bar[XB_TMO], 1u); break; } }
  }
  nloc = mine > 0u ? mine : 1u; nx = cnt > 0u ? cnt : 1u;
}
DI void xcd_barrier(const XcdBarrier& b) {
  asm volatile("s_waitcnt vmcnt(0)" ::: "memory");
  __syncthreads();
  if (threadIdx.x == 0) {
    unsigned* bar = b.bar;
    __builtin_amdgcn_s_waitcnt(0);
    unsigned nloc = b.st[0], nx = b.st[1];
    if (nloc == 0u) { xcd_barrier_complete(bar, b.x, nloc, nx); b.st[0] = nloc; b.st[1] = nx; }
    const unsigned old = xb_add(&bar[XB_XSUB(b.x)], 1u);
    const unsigned gen = old / nloc;
    if (old + 1u == (gen + 1u) * nloc) {
      __builtin_amdgcn_fence(__ATOMIC_RELEASE, "agent");
      asm volatile("s_waitcnt vmcnt(0)" ::: "memory");
      const unsigned og = xb_add(&bar[XB_TOP], 1u);
      const unsigned tg = og / nx;
      if (og + 1u == (tg + 1u) * nx) xb_add(&bar[XB_TOPGEN], 1u);
      else XB_SPIN(xb_ld(&bar[XB_TOPGEN]) == tg, bar);
      __builtin_amdgcn_fence(__ATOMIC_ACQUIRE, "agent");
      xb_add(&bar[XB_XGEN(b.x)], 1u);
      asm volatile("s_waitcnt vmcnt(0)" ::: "memory");
    } else {
      XB_SPIN(xb_ld(&bar[XB_XGEN(b.x)]) == gen, bar);
      __builtin_amdgcn_fence(__ATOMIC_ACQUIRE, "agent");
      asm volatile("s_waitcnt vmcnt(0)" ::: "memory");
    }
  }
  __syncthreads();
}

struct Params {
  const float *x, *meta, *norm1_g, *w_in, *wg, *bg, *sb_g, *gla_g, *w_out, *norm2_g, *w_pq, *sk1, *sk2, *eu, *ev, *gf;
  float* out; char* ws;
};
constexpr int HALF_SMEM = 73728;
constexpr int SMEM_BYTES = 2 * HALF_SMEM;
constexpr size_t WS_BAR = 0;

__global__ void __launch_bounds__(512, 2) k_fused(Params p) {
  extern __shared__ __attribute__((aligned(16))) char smem_dyn[];
  const int half = __builtin_amdgcn_readfirstlane((int)(threadIdx.x >> 8));
  char* smem = smem_dyn + half * HALF_SMEM;
  __shared__ unsigned xb_words[4];
  if (threadIdx.x < 4) xb_words[threadIdx.x] = 0u;
  __syncthreads();
  const XcdBarrier bar = xcd_barrier_post((unsigned*)(p.ws + WS_BAR), xb_words);
  if (threadIdx.x == 0) xb_words[2] = xb_add((unsigned*)(p.ws + WS_XRANK) + bar.x, 1u);
  const int G = 2 * gridDim.x, bid = 2 * blockIdx.x + half;
  char* ws = p.ws;
  bf16_t* WinT = (bf16_t*)(ws + WS_WIN);
  bf16_t* WoutT = (bf16_t*)(ws + WS_WOUT);
  bf16_t* WpqT = (bf16_t*)(ws + WS_WPQ);
  bf16_t* EU = (bf16_t*)(ws + WS_EU);
  bf16_t* EV = (bf16_t*)(ws + WS_EV);
  bf16_t* SK1b = (bf16_t*)(ws + WS_SK1);
  bf16_t* SK2b = (bf16_t*)(ws + WS_SK2);
  bf16_t* A1 = (bf16_t*)(ws + WS_A1);
  float* GO = (float*)(ws + WS_A1);
  bf16_t* A2 = (bf16_t*)(ws + WS_A1);
  InProjOut O;
  O.QSB = (bf16_t*)(ws + WS_QSB); O.KSB = (bf16_t*)(ws + WS_KSB); O.VTSB = (bf16_t*)(ws + WS_VTSB); O.VSB = (bf16_t*)(ws + WS_VSB);
  O.GQ = (bf16_t*)(ws + WS_GQ); O.GK = (bf16_t*)(ws + WS_GK); O.GV = (bf16_t*)(ws + WS_GVT); O.GR = (bf16_t*)(ws + WS_GR);
  O.GLR = (float*)(ws + WS_GLR);
  bf16_t* H1 = (bf16_t*)(ws + WS_H1);
  float* R2 = (float*)(ws + WS_XS + 3 * MiB);
  float* R1I = (float*)(ws + WS_XS + 4 * MiB);
  bf16_t* GVT = (bf16_t*)(ws + WS_GVT);
  GlaPtrs GP;
  GP.GQ = O.GQ; GP.GK = O.GK; GP.GVT = GVT; GP.GR = O.GR; GP.GLR = O.GLR; GP.wg = p.wg; GP.bg = p.bg; GP.gla_g = p.gla_g;
  GP.SLOC = (float*)(ws + WS_SLOC); GP.DTOT = (float*)(ws + WS_DTOT); GP.MIX = (bf16_t*)(ws + WS_MIX);
  GlaPrepPtrs GPP; GPP.GQ = O.GQ; GPP.GK = O.GK; GPP.GLR = O.GLR; GPP.wg = p.wg; GPP.bg = p.bg;
  GPP.QT = (bf16_t*)(ws + WS_GQT); GPP.KT = (bf16_t*)(ws + WS_GKT); GPP.KTT = (bf16_t*)(ws + WS_GKTT); GPP.DEC = (float*)(ws + WS_GDEC); GPP.BL = (float*)(ws + WS_GBL);
  GlaPtrs3 GP3; GP3.QT = GPP.QT; GP3.KT = GPP.KT; GP3.KTT = GPP.KTT; GP3.GVT = GVT; GP3.GR = O.GR; GP3.DEC = GPP.DEC; GP3.BL = GPP.BL; GP3.gla_g = p.gla_g;
  GP3.SLOC = GP.SLOC; GP3.DTOT = GP.DTOT; GP3.MIX = GP.MIX;
  bf16_t* MIX = (bf16_t*)(ws + WS_MIX);
  bf16_t* QP = (bf16_t*)(ws + WS_MIX);
  unsigned short* EIDX = (unsigned short*)(ws + WS_EIDX);
  bf16_t* PP = (bf16_t*)(ws + WS_PP);
  bf16_t* YT = (bf16_t*)(ws + WS_PP);
  unsigned* STREAM = (unsigned*)(ws + WS_STREAM);
  float* GATE = (float*)(ws + WS_GATE);

  for (int vb = bid; vb < 832 + 256 + 256; vb += G) {
    if (vb < 832) ph_transpose_w(vb % 104, vb / 104, smem, p.w_in, p.norm1_g, WinT, D, NIN);
    else if (vb < 1088) { const int t = vb - 832; ph_transpose_w(t % 32, t / 32, smem, p.w_out, nullptr, WoutT, D, D); }
    else { const int t = vb - 1088; ph_transpose_w(t % 32, t / 32, smem, p.w_pq, p.norm2_g, WpqT, D, D); }
  }
  ph_convert_eu_i8(p.eu, (u8_t*)EU, (float*)(ws + WS_SCU));
  for (int vb = bid; vb < NEXP / 32; vb += G) ph_convert_ev8(vb, smem, p.ev, (u8_t*)EV, (float*)(ws + WS_SCV));
  ph_convert(p.sk1, SK1b, (size_t)8 * 128 * 64 / 8);
  ph_convert(p.sk2, SK2b, (size_t)8 * 128 * 64 / 8);
  ph_zero_pads(O.KSB, O.VTSB, O.GQ, O.GK, GVT);
  for (int vb = bid; vb < TREAL / 16; vb += G) ph_norm_rows<0>(vb, p.x, R1I, A1);
  __syncthreads();
  for (int mb = blockIdx.x; mb < NIN / 16; mb += gridDim.x) ph_meta(mb, smem_dyn, p.meta, p.norm1_g, p.w_in, O);
  xcd_barrier(bar);
  {
    pg8::Gemm g{A1, WinT, TREAL, NINP, D}; pg8::StaticOrder S; S.init(TREAL, NINP, (int)gridDim.x, (int)blockIdx.x);
    EpiInProj E{O, GVT, smem_dyn + 131072};
    pg8::gemm_phase<EpiInProj, pg8::StaticOrder, true, true>((PG8_LAS unsigned char*)smem_dyn, g, S, E);
  }
  xcd_barrier(bar);
  for (int it = blockIdx.x; it < 16 * 129; it += gridDim.x) ph_gla_prep(it, smem_dyn, GPP);
  xcd_barrier(bar);
  for (int it = blockIdx.x; it < 16 * 15; it += gridDim.x) gla_item4<0>(it / 15, it % 15, smem_dyn, GP3);
  for (int vb = bid; vb < 64 * 32; vb += G) ph_sb_attn2(vb, O.QSB, O.KSB, O.VTSB, p.sb_g, MIX);
  xcd_barrier(bar);
  for (int it = blockIdx.x; it < 16 * 16; it += gridDim.x) gla_item4<1>(it >> 4, it & 15, smem_dyn, GP3);
  xcd_barrier(bar);
  {
    pg8::Gemm g{MIX, WoutT, TREAL, D, D}; pg8::StaticOrder S; S.init(TREAL, D, (int)gridDim.x, (int)blockIdx.x);
    EpiOut E{A1, R1I, H1};
    pg8::gemm_phase<EpiOut, pg8::StaticOrder, true, true>((PG8_LAS unsigned char*)smem_dyn, g, S, E);
  }
  xcd_barrier(bar);
  for (int vb = bid; vb < TREAL / 16; vb += G) ph_norm2_rows(vb, H1, p.norm2_g, R2, (u8_t*)(ws + WS_XQ), (float*)(ws + WS_XS));
  xcd_barrier(bar);
  {
    pg8::Gemm g{H1, WpqT, TREAL, D, D}; pg8::StaticOrder S; S.init(TREAL, D, (int)gridDim.x, (int)blockIdx.x);
    EpiPQ E{QP, R2};
    pg8::gemm_phase<EpiPQ, pg8::StaticOrder, true, true>((PG8_LAS unsigned char*)smem_dyn, g, S, E);
  }
  xcd_barrier(bar);
  {
    const int NV = 8 * (TREAL / 128);
    route_stage_keys(bid & 7, smem, SK1b, SK2b);
    const int rlane = (int)(threadIdx.x & 63u), rwave = (int)((threadIdx.x >> 6) & 3u);
    bf16x8 qa[2][4], qb[2][4];
    if (bid < NV) route_load_q(qa, QP, (bid >> 3) * 128 + rwave * 32 + (rlane & 31), bid & 7, rlane >> 5);
    for (int vb = bid; vb < NV; vb += 2 * G) {
      const int v1 = vb + G, v2 = vb + 2 * G;
      if (v1 < NV) route_load_q(qb, QP, (v1 >> 3) * 128 + rwave * 32 + (rlane & 31), v1 & 7, rlane >> 5);
      ph_route_v2(vb, smem, qa, EIDX, GATE);
      if (v1 < NV) {
        if (v2 < NV) route_load_q(qa, QP, (v2 >> 3) * 128 + rwave * 32 + (rlane & 31), v2 & 7, rlane >> 5);
        ph_route_v2(v1, smem, qb, EIDX, GATE);
      }
    }
  }
  xcd_barrier(bar);
  {
    __shared__ int xinfo[4];
    if (threadIdx.x == 0) {
      unsigned* barw = (unsigned*)(p.ws + WS_BAR);
      unsigned cnt = 0, ord = 0, mine = 1;
      for (unsigned j = 0; j < 16; ++j) { const unsigned c = xb_ld(&barw[XB_XCNT(j)]); if (c > 0) { if (j < bar.x) ++ord; ++cnt; } if (j == bar.x) mine = c; }
      xinfo[0] = (int)ord; xinfo[1] = (int)cnt; xinfo[2] = (int)xb_words[2]; xinfo[3] = (int)mine;
    }
    __syncthreads();
    const int xi = xinfo[0], nx = xinfo[1], rank = xinfo[2], nloc = xinfo[3];
    const int wave = __builtin_amdgcn_readfirstlane((int)(threadIdx.x >> 6));
    ph_peer_u_d4(xi, nx, rank * 8 + wave, nloc * 8, (const u8_t*)(ws + WS_XQ), (const float*)(ws + WS_XS), (const u8_t*)EU, EIDX, PP);
  }
  xcd_barrier(bar);
  pc_stage_scales(smem_dyn, (const float*)(ws + WS_SCU), (const float*)(ws + WS_SCV));
  for (int unit = blockIdx.x; unit < TREAL / 64; unit += gridDim.x) ph_peer_c8(unit, smem_dyn, PP, EIDX, GATE, STREAM);
  xcd_barrier(bar);
  ph_peer_v8(smem_dyn, STREAM, (const u8_t*)EV, YT);
  xcd_barrier(bar);
  for (int unit = blockIdx.x; unit < TREAL / 32; unit += gridDim.x) ph_final_lds(unit, smem_dyn, H1, YT, p.gf, p.out);
}

extern "C" void kernel_launch(void* const* d_in, const int* in_sizes, int n_in, void* d_out, int out_size, void* d_ws, size_t ws_size, hipStream_t stream) {
  static int grid = 0;
  if (grid == 0) {
    int dev = 0, cus = 0, per_cu = 0;
    hipGetDevice(&dev);
    hipDeviceGetAttribute(&cus, hipDeviceAttributeMultiprocessorCount, dev);
    hipFuncSetAttribute((const void*)k_fused, hipFuncAttributeMaxDynamicSharedMemorySize, SMEM_BYTES);
    hipOccupancyMaxActiveBlocksPerMultiprocessor(&per_cu, (const void*)k_fused, 512, SMEM_BYTES);
    if (per_cu > 1) per_cu = 1;
    if (per_cu < 1) per_cu = 1;
    grid = cus * per_cu;
  }
  hipMemsetAsync((char*)d_ws + WS_BAR, 0, 32768, stream);
  Params p{};
  p.x = (const float*)d_in[0]; p.meta = (const float*)d_in[1]; p.norm1_g = (const float*)d_in[2]; p.w_in = (const float*)d_in[3];
  p.wg = (const float*)d_in[4]; p.bg = (const float*)d_in[5]; p.sb_g = (const float*)d_in[6]; p.gla_g = (const float*)d_in[7];
  p.w_out = (const float*)d_in[8]; p.norm2_g = (const float*)d_in[9]; p.w_pq = (const float*)d_in[10]; p.sk1 = (const float*)d_in[11];
  p.sk2 = (const float*)d_in[12]; p.eu = (const float*)d_in[13]; p.ev = (const float*)d_in[14]; p.gf = (const float*)d_in[15];
  p.out = (float*)d_out; p.ws = (char*)d_ws;
  void* args[] = {&p};
  hipLaunchCooperativeKernel((const void*)k_fused, dim3(grid), dim3(512), args, SMEM_BYTES, stream);
}
```

```cpp
#include <hip/hip_runtime.h>
#include <stdint.h>
#include <stddef.h>

typedef unsigned short bf16_t;
typedef short bf16x8 __attribute__((ext_vector_type(8)));
typedef float f32x16 __attribute__((ext_vector_type(16)));
typedef float f32x4 __attribute__((ext_vector_type(4)));
typedef float f32x2 __attribute__((ext_vector_type(2)));
typedef unsigned u32x4 __attribute__((ext_vector_type(4)));
typedef unsigned u32x2 __attribute__((ext_vector_type(2)));
typedef __bf16 bf16x2_t __attribute__((ext_vector_type(2)));

#define DI __device__ __forceinline__
__device__ __forceinline__ int fresh_tid() { int t = (int)threadIdx.x; asm volatile("" : "+v"(t)); return t; }
#define TID tid256_
#define MFMA32(a, b, c) __builtin_amdgcn_mfma_f32_32x32x16_bf16((a), (b), (c), 0, 0, 0)

constexpr int D = 1024, NB = 8, SEQ = 8192, NMETA = 16;
constexpr int TREAL = NB * SEQ;
constexpr int MROWS = TREAL + 128;
constexpr int NIN = 3088, NINP = 3328;
constexpr int SBH = 8, SBD = 64;
constexpr int GH = 4, GDK = 64, GDV = 128;
constexpr int KIDX = SEQ + 32;
constexpr int GU = SEQ + 64;
constexpr int NEXP = 16384;
constexpr float EPS = 1e-6f;

constexpr size_t MiB = 1u << 20;
constexpr size_t WS_WIN = 1 * MiB;
constexpr size_t WS_WOUT = 8 * MiB;
constexpr size_t WS_WPQ = 10 * MiB;
constexpr size_t WS_SK1 = 12 * MiB;
constexpr size_t WS_SK2 = 13 * MiB;
constexpr size_t WS_EU = 16 * MiB;
constexpr size_t WS_EV = 48 * MiB;
constexpr size_t WS_A1 = 80 * MiB;
constexpr size_t WS_QSB = 210 * MiB;
constexpr size_t WS_KSB = 274 * MiB;
constexpr size_t WS_VTSB = 339 * MiB;
constexpr size_t WS_GQ = 404 * MiB;
constexpr size_t WS_GK = 437 * MiB;
constexpr size_t WS_H1 = 210 * MiB;
constexpr size_t WS_GV = 470 * MiB;
constexpr size_t WS_GR = 535 * MiB;
constexpr size_t WS_GLR = 599 * MiB;
constexpr size_t WS_LG = 604 * MiB;
constexpr size_t WS_MIX = 669 * MiB;
constexpr size_t WS_EIDX = 797 * MiB;
constexpr size_t WS_GATE = 829 * MiB;
constexpr size_t WS_PP = 470 * MiB;
constexpr size_t WS_STREAM = 726 * MiB;
constexpr size_t WS_XRANK = 16384;
constexpr size_t WS_VSB = 861 * MiB;
constexpr size_t WS_END = 926 * MiB;

DI unsigned f2bf(float f) { unsigned u = __float_as_uint(f); return (u + 0x7fffu + ((u >> 16) & 1u)) >> 16; }
DI float bf2f(unsigned b) { return __uint_as_float(b << 16); }
DI unsigned pk2(float lo, float hi) { f32x2 v = {lo, hi}; return __builtin_bit_cast(unsigned, __builtin_convertvector(v, bf16x2_t)); }
DI float bflo(unsigned u) { return __uint_as_float(u << 16); }
DI float bfhi(unsigned u) { return __uint_as_float(u & 0xffff0000u); }
DI int crow(int reg, int h) { return (reg & 3) + 8 * (reg >> 2) + 4 * h; }
DI float wave_sum(float v) {
#pragma unroll
  for (int o = 32; o >= 1; o >>= 1) v += __shfl_xor(v, o);
  return v;
}
DI float softplus(float z) { return fmaxf(z, 0.f) + __logf(1.f + __expf(-fabsf(z))); }

DI void ph_transpose_w(int bx, int by, char* smem, const float* __restrict__ W, const float* __restrict__ gain, bf16_t* __restrict__ WT, int K, int N) {
  const int tid256_ = fresh_tid() & 255;
  float (*t)[33] = (float (*)[33])smem;
  const int n0 = bx * 32, k0 = by * 128;
  {
    const int kr = TID >> 3, c4 = (TID & 7) * 4;
    f32x4 v[4];
#pragma unroll
    for (int j = 0; j < 4; ++j) v[j] = (n0 + c4 < N) ? *(const f32x4*)(W + (size_t)(k0 + kr + 32 * j) * N + n0 + c4) : (f32x4){0.f, 0.f, 0.f, 0.f};
#pragma unroll
    for (int j = 0; j < 4; ++j) {
      const float g = gain ? gain[k0 + kr + 32 * j] : 1.f;
      t[kr + 32 * j][c4 + 0] = v[j].x * g; t[kr + 32 * j][c4 + 1] = v[j].y * g; t[kr + 32 * j][c4 + 2] = v[j].z * g; t[kr + 32 * j][c4 + 3] = v[j].w * g;
    }
  }
  __syncthreads();
  {
    const int n = TID >> 3, ks = (TID & 7) * 16;
    unsigned w[8];
#pragma unroll
    for (int i = 0; i < 8; ++i) w[i] = pk2(t[ks + 2 * i][n], t[ks + 2 * i + 1][n]);
    bf16_t* dst = WT + (size_t)(n0 + n) * K + k0 + ks;
    *(u32x4*)dst = (u32x4){w[0], w[1], w[2], w[3]};
    *(u32x4*)(dst + 8) = (u32x4){w[4], w[5], w[6], w[7]};
  }
  __syncthreads();
}
DI void ph_convert(const float* __restrict__ src, bf16_t* __restrict__ dst, size_t n8) {
  size_t i = (size_t)blockIdx.x * blockDim.x + threadIdx.x;
  const size_t stride = (size_t)gridDim.x * blockDim.x;
  for (; i < n8; i += stride) {
    const f32x4 a = ((const f32x4*)src)[2 * i], b = ((const f32x4*)src)[2 * i + 1];
    u32x4 o; o.x = pk2(a.x, a.y); o.y = pk2(a.z, a.w); o.z = pk2(b.x, b.y); o.w = pk2(b.z, b.w);
    ((u32x4*)dst)[i] = o;
  }
}
DI void ph_zero_pads(bf16_t* KSB, bf16_t* VTSB, bf16_t* GQ, bf16_t* GK, bf16_t* GVT) {
  const int tid = blockIdx.x * blockDim.x + threadIdx.x, nth = gridDim.x * blockDim.x;
  for (int i = tid; i < 64 * 16 * 64; i += nth) { const int bh = i / 1024, r = i % 1024; KSB[(size_t)bh * KIDX * 64 + r] = 0; }
  for (int i = tid; i < 64 * 64 * 16; i += nth) { const int row = i / 16, c = i % 16; VTSB[(size_t)row * KIDX + c] = 0; }
  for (int i = tid; i < 32 * 48 * 64; i += nth) { const int bh = i / 3072, r = i % 3072; GQ[(size_t)bh * GU * 64 + r] = 0; GK[(size_t)bh * GU * 64 + r] = 0; }
  for (int i = tid; i < 32 * 128 * 48; i += nth) { const int row = i / 48, c = i % 48; GVT[(size_t)row * GU + c] = 0; }
}

template <int MODE>
DI void ph_norm_rows(int vb, const float* __restrict__ src, const float* __restrict__ meta, bf16_t* __restrict__ dst) {
  const int tid256_ = fresh_tid() & 255;
  const int row0 = vb * 16 + (TID >> 6) * 4, lane = TID & 63;
  f32x4 v[4][4];
#pragma unroll
  for (int rr = 0; rr < 4; ++rr)
#pragma unroll
    for (int j = 0; j < 4; ++j) v[rr][j] = *(const f32x4*)(src + (size_t)(row0 + rr) * D + j * 256 + lane * 4);
  f32x4 gg[4];
#pragma unroll
  for (int j = 0; j < 4; ++j) { gg[j] = (f32x4){1.f, 1.f, 1.f, 1.f}; if (MODE == 1) gg[j] = *(const f32x4*)(meta + j * 256 + lane * 4); }
#pragma unroll
  for (int rr = 0; rr < 4; ++rr) {
    float ss = 0.f;
#pragma unroll
    for (int j = 0; j < 4; ++j) ss += v[rr][j].x * v[rr][j].x + v[rr][j].y * v[rr][j].y + v[rr][j].z * v[rr][j].z + v[rr][j].w * v[rr][j].w;
    ss = wave_sum(ss);
    const float r = rsqrtf(ss * (1.0f / D) + EPS);
    if (MODE == 0 && lane == 0) const_cast<float*>(meta)[row0 + rr] = sqrtf(ss * (1.0f / D) + EPS);
#pragma unroll
    for (int j = 0; j < 4; ++j) {
      u32x2 o; o.x = pk2(v[rr][j].x * r * gg[j].x, v[rr][j].y * r * gg[j].y); o.y = pk2(v[rr][j].z * r * gg[j].z, v[rr][j].w * r * gg[j].w);
      *(u32x2*)(dst + (size_t)(row0 + rr) * D + j * 256 + lane * 4) = o;
    }
  }
}

namespace pg8 {
#define PG8_LAS __attribute__((address_space(3)))
typedef unsigned short bf16_t;
typedef short bf16x8 __attribute__((ext_vector_type(8)));
typedef float f32x4 __attribute__((ext_vector_type(4)));
typedef unsigned u32x4 __attribute__((ext_vector_type(4)));
constexpr int BM = 256, BK = 64, HALF = 128, HTB = HALF * BK * 2  , STAGE_BYTES = 8 * HTB, NXCD = 8, WGM = 8;

__host__ __device__ __forceinline__ int lds_byte(int r, int c) { const int st = (r >> 4) * 2 + (c >> 5), rr = r & 15, cc = c & 31, ob = rr * 64 + cc * 2; return st * 1024 + (ob ^ (((ob >> 9) & 1) << 5)); }
__host__ __device__ __forceinline__ void stage_rc(int b, int& R, int& C) { const int st = b / 1024, sb = b % 1024, swz = sb ^ (((sb >> 9) & 1) << 5); R = (st >> 1) * 16 + swz / 64; C = (st & 1) * 32 + (swz % 64) / 2; }
__host__ __device__ __forceinline__ int perm32(int rho) { const int n = rho >> 4, i = rho & 15; return 8 * (i >> 2) + 4 * n + (i & 3); }

struct Unit { int pm, pn; };
struct Gemm { const bf16_t* A; const bf16_t* Bt; int M, N, K; };

struct StaticOrder {
    int nM, nN, nwg, G, c;
    __host__ __device__ void init(int M, int N, int G_, int c_) { nM = M / BM; nN = N / BM; nwg = nM * nN; G = G_; c = c_; }
    __host__ __device__ bool next(int i, Unit& u) const {
        const long L = (long)i * G + c; if (L >= nwg) return false;
        int wgid = (int)L; { const int q = nwg / NXCD, r = nwg % NXCD, xcd = wgid % NXCD, off = wgid / NXCD; wgid = (xcd < r ? xcd * (q + 1) : r * (q + 1) + (xcd - r) * q) + off; }
        const int nig = WGM * nN, gid = wgid / nig, fm = gid * WGM, gsz = (nM - fm) < WGM ? (nM - fm) : WGM;
        u.pm = fm + ((wgid % nig) % gsz); u.pn = (wgid % nig) / gsz; return true;
    }
    __device__ __forceinline__ void a_ready(const Unit&) const {}
    __device__ __forceinline__ void done(const Unit&) const {}
};

template <class Epi, class Sched, bool ALIGN_EPI = false, bool SP2 = false>
__device__ __forceinline__ void gemm_phase(PG8_LAS unsigned char* lds, const Gemm g, const Sched& S, const Epi& E) {
    const int tid = fresh_tid(), wid = __builtin_amdgcn_readfirstlane(tid >> 6), lane = tid & 63, wr = wid >> 2, wc = wid & 3, fr = lane & 15, fq = lane >> 4;
    const int K = g.K, nt = K / BK;
    unsigned voffA[2], voffB[2];
#pragma unroll
    for (int i = 0; i < 2; ++i) { int R, C; stage_rc(tid * 16 + i * 8192, R, C); const int Rb = Epi::PERM ? ((R & ~31) + perm32(R & 31)) : R;
        voffA[i] = (unsigned)(R * K + C) * 2u; voffB[i] = (unsigned)(Rb * K + C) * 2u; }
    const size_t kstep = (size_t)(BK * 2);
    const size_t hstep = (size_t)HALF * K * 2;
    const size_t tstep = 2 * hstep;
    const unsigned ldsw = (unsigned)wid * 1024u;
    const int aoff = lds_byte(wr * 64 + fr, fq * 8), boff = lds_byte(wc * 32 + fr, fq * 8);
#define PG8_SA(b, h) (((b) * 2 + (h)) * HTB)
#define PG8_SB(b, h) ((4 + (b) * 2 + (h)) * HTB)
#define PG8_STAGE(bufoff, gbase, voff) do { _Pragma("unroll") for (int _i = 0; _i < 2; ++_i) \
        __builtin_amdgcn_global_load_lds((const unsigned*)((const char*)(gbase) + (voff)[_i]), (PG8_LAS unsigned*)(lds + (bufoff) + ldsw + _i * 8192), 16, 0, 0); } while (0)
#define PG8_LDA(dst, b, h) do { _Pragma("unroll") for (int m = 0; m < 4; ++m) _Pragma("unroll") for (int k = 0; k < 2; ++k) dst[m][k] = *(const PG8_LAS bf16x8*)(lds + PG8_SA(b, h) + aoff + m * 2048 + k * 1024); } while (0)
#define PG8_LDB(dst, b, h) do { _Pragma("unroll") for (int n = 0; n < 2; ++n) _Pragma("unroll") for (int k = 0; k < 2; ++k) dst[n][k] = *(const PG8_LAS bf16x8*)(lds + PG8_SB(b, h) + boff + n * 2048 + k * 1024); } while (0)
#define PG8_MMA(ai, bj, At, Bt) do { __builtin_amdgcn_s_setprio(1); _Pragma("unroll") for (int m = 0; m < 4; ++m) _Pragma("unroll") for (int n = 0; n < 2; ++n) _Pragma("unroll") for (int k = 0; k < 2; ++k) \
        acc[ai][bj][m][n] = __builtin_amdgcn_mfma_f32_16x16x32_bf16(Bt[n][k], At[m][k], acc[ai][bj][m][n], 0, 0, 0); __builtin_amdgcn_s_setprio(0); } while (0)
#define PG8_WAIT_V(n) asm volatile("s_waitcnt vmcnt(" #n ")" ::: "memory")
#define PG8_WAIT_L(n) asm volatile("s_waitcnt lgkmcnt(" #n ")" ::: "memory")
#define PG8_BAR __builtin_amdgcn_s_barrier()
#define PG8_SCHED __builtin_amdgcn_sched_barrier(0)
    Unit cur, nxt; int ui = 0;
    if (!S.next(0, cur)) return;
    f32x4 acc[2][2][4][2];
#pragma unroll
    for (int a = 0; a < 2; ++a)
#pragma unroll
        for (int b = 0; b < 2; ++b)
#pragma unroll
            for (int m = 0; m < 4; ++m)
#pragma unroll
                for (int n = 0; n < 2; ++n) acc[a][b][m][n] = (f32x4){0.f, 0.f, 0.f, 0.f};
    bf16x8 At[4][2], B0[2][2], B1[2][2];
    const char* cA = (const char*)g.A + (size_t)cur.pm * tstep; const char* cB = (const char*)g.Bt + (size_t)cur.pn * tstep;
    S.a_ready(cur);
    if constexpr (SP2) {
        PG8_STAGE(PG8_SB(0, 0), cB, voffB); PG8_STAGE(PG8_SB(0, 1), cB + hstep, voffB); PG8_STAGE(PG8_SA(0, 0), cA, voffA); PG8_STAGE(PG8_SA(0, 1), cA + hstep, voffA);
        if (wr == 1) PG8_BAR;
        PG8_WAIT_V(2); PG8_BAR;
        PG8_STAGE(PG8_SB(1, 0), cB + kstep, voffB); PG8_STAGE(PG8_SA(1, 0), cA + kstep, voffA); PG8_STAGE(PG8_SB(1, 1), cB + hstep + kstep, voffB);
        PG8_WAIT_V(6); PG8_BAR;
    } else {
        PG8_STAGE(PG8_SB(0, 0), cB, voffB); PG8_STAGE(PG8_SA(0, 0), cA, voffA); PG8_STAGE(PG8_SB(0, 1), cB + hstep, voffB); PG8_STAGE(PG8_SA(0, 1), cA + hstep, voffA);
        if (wr == 1) PG8_BAR;
        PG8_WAIT_V(4); PG8_BAR;
        PG8_STAGE(PG8_SB(1, 0), cB + kstep, voffB); PG8_STAGE(PG8_SA(1, 0), cA + kstep, voffA); PG8_STAGE(PG8_SB(1, 1), cB + hstep + kstep, voffB);
        PG8_WAIT_V(6); PG8_BAR;
    }
    for (;;) {
        const bool has_next = S.next(ui + 1, nxt);
        const char* nA = has_next ? (const char*)g.A + (size_t)nxt.pm * tstep : cA; const char* nB = has_next ? (const char*)g.Bt + (size_t)nxt.pn * tstep : cB;
        for (int t = 0; t < nt; t += 2) {
            const bool last = (t == nt - 2);
            const char* a1 = cA + (size_t)(t + 1) * kstep;
            const char* a2 = last ? nA : cA + (size_t)(t + 2) * kstep; const char* b2 = last ? nB : cB + (size_t)(t + 2) * kstep;
            const char* a3 = a2 + kstep; const char* b3 = b2 + kstep;
            if (last && has_next) S.a_ready(nxt);
            if constexpr (SP2) {
            PG8_LDB(B0, 0, 0); PG8_LDB(B1, 0, 1); PG8_SCHED; PG8_LDA(At, 0, 0); PG8_STAGE(PG8_SA(1, 1), a1 + hstep, voffA);
            PG8_WAIT_V(8); PG8_WAIT_L(0); PG8_BAR; PG8_MMA(0, 0, At, B0); PG8_MMA(0, 1, At, B1); PG8_BAR; PG8_SCHED;
            PG8_LDA(At, 0, 1); PG8_STAGE(PG8_SB(0, 0), b2, voffB); PG8_STAGE(PG8_SB(0, 1), b2 + hstep, voffB); PG8_STAGE(PG8_SA(0, 0), a2, voffA);
            PG8_WAIT_V(8); PG8_WAIT_L(0); PG8_BAR; PG8_MMA(1, 0, At, B0); PG8_MMA(1, 1, At, B1); PG8_BAR; PG8_SCHED;
            PG8_LDB(B0, 1, 0); PG8_LDB(B1, 1, 1); PG8_SCHED; PG8_LDA(At, 1, 0); PG8_STAGE(PG8_SA(0, 1), a2 + hstep, voffA);
            PG8_WAIT_V(8); PG8_WAIT_L(0); PG8_BAR; PG8_MMA(0, 0, At, B0); PG8_MMA(0, 1, At, B1); PG8_BAR; PG8_SCHED;
            PG8_LDA(At, 1, 1); PG8_STAGE(PG8_SB(1, 0), b3, voffB); PG8_STAGE(PG8_SB(1, 1), b3 + hstep, voffB); PG8_STAGE(PG8_SA(1, 0), a3, voffA);
            PG8_WAIT_V(8); PG8_WAIT_L(0); PG8_BAR; PG8_MMA(1, 0, At, B0); PG8_MMA(1, 1, At, B1); PG8_BAR; PG8_SCHED;
            } else {
            PG8_LDB(B0, 0, 0); PG8_SCHED; PG8_LDA(At, 0, 0); PG8_STAGE(PG8_SA(1, 1), a1 + hstep, voffA);
            PG8_WAIT_L(8); PG8_BAR; PG8_WAIT_L(0); PG8_MMA(0, 0, At, B0); PG8_BAR; PG8_SCHED;
            PG8_LDB(B1, 0, 1); PG8_STAGE(PG8_SB(0, 0), b2, voffB);
            PG8_BAR; PG8_WAIT_L(0); PG8_MMA(0, 1, At, B1); PG8_BAR;
            PG8_LDA(At, 0, 1); PG8_STAGE(PG8_SA(0, 0), a2, voffA);
            PG8_BAR; PG8_WAIT_L(0); PG8_MMA(1, 0, At, B0); PG8_BAR; PG8_SCHED;
            PG8_STAGE(PG8_SB(0, 1), b2 + hstep, voffB);
            PG8_WAIT_V(6); PG8_BAR; PG8_MMA(1, 1, At, B1); PG8_BAR;
            PG8_LDB(B0, 1, 0); PG8_SCHED; PG8_LDA(At, 1, 0); PG8_STAGE(PG8_SA(0, 1), a2 + hstep, voffA);
            PG8_WAIT_L(8); PG8_BAR; PG8_WAIT_L(0); PG8_MMA(0, 0, At, B0); PG8_BAR; PG8_SCHED;
            PG8_LDB(B1, 1, 1); PG8_STAGE(PG8_SB(1, 0), b3, voffB);
            PG8_BAR; PG8_WAIT_L(0); PG8_MMA(0, 1, At, B1); PG8_BAR;
            PG8_LDA(At, 1, 1); PG8_STAGE(PG8_SA(1, 0), a3, voffA);
            PG8_BAR; PG8_WAIT_L(0); PG8_MMA(1, 0, At, B0); PG8_BAR; PG8_SCHED;
            PG8_STAGE(PG8_SB(1, 1), b3 + hstep, voffB);
            PG8_WAIT_V(6); PG8_BAR; PG8_MMA(1, 1, At, B1); PG8_BAR;
            }
        }
        if constexpr (ALIGN_EPI) { if (wr == 0) PG8_BAR; }
        if constexpr (!Epi::AFTER_DRAIN) { E(acc, cur, wr, wc, fr, fq); S.done(cur); }
        if (!has_next) break;
#pragma unroll
        for (int a = 0; a < 2; ++a)
#pragma unroll
            for (int b = 0; b < 2; ++b)
#pragma unroll
                for (int m = 0; m < 4; ++m)
#pragma unroll
                    for (int n = 0; n < 2; ++n) acc[a][b][m][n] = (f32x4){0.f, 0.f, 0.f, 0.f};
        cur = nxt; cA = nA; cB = nB; ++ui;
        if constexpr (ALIGN_EPI) { if (wr == 1) PG8_BAR; }
    }
    PG8_WAIT_V(0);
    if constexpr (!ALIGN_EPI) { if (wr == 0) PG8_BAR; }
    PG8_BAR;
    if constexpr (Epi::AFTER_DRAIN) { E.fused(acc, cur, wr, wc, fr, fq, lds, wid, lane); S.done(cur); }
#undef PG8_SA
#undef PG8_SB
#undef PG8_STAGE
#undef PG8_LDA
#undef PG8_LDB
#undef PG8_MMA
#undef PG8_WAIT_V
#undef PG8_WAIT_L
#undef PG8_BAR
#undef PG8_SCHED
}
}

struct InProjOut { bf16_t *QSB, *KSB, *VSB, *VTSB, *GQ, *GK, *GV, *GR; float* GLR; };

struct EpiInProj {
  static constexpr bool PERM = true, AFTER_DRAIN = false;
  InProjOut O; bf16_t* GVT; char* stage;
  DI void store_vt(const pg8::f32x4 (&acc)[2][2][4][2], const pg8::Unit& u, int wr, int wc, int fr, int fq) const {
    bf16_t* st = (bf16_t*)(stage + (wr * 4 + wc) * 1280);
    const int lane = fr + 16 * fq;
    const int rc = lane >> 2, r8 = lane & 3;
#pragma unroll
    for (int ai = 0; ai < 2; ++ai)
#pragma unroll
      for (int bj = 0; bj < 2; ++bj)
#pragma unroll
        for (int mp = 0; mp < 2; ++mp)
#pragma unroll
          for (int ch = 0; ch < 2; ++ch) {
            if ((fq >> 1) == ch) {
#pragma unroll
              for (int m2 = 0; m2 < 2; ++m2)
#pragma unroll
                for (int n = 0; n < 2; ++n) {
                  const pg8::f32x4 v = acc[ai][bj][2 * mp + m2][n];
                  const int cl = 8 * (fq & 1) + 4 * n, rl = 16 * m2 + fr;
                  st[(cl + 0) * 40 + rl] = (bf16_t)f2bf(v[0]); st[(cl + 1) * 40 + rl] = (bf16_t)f2bf(v[1]);
                  st[(cl + 2) * 40 + rl] = (bf16_t)f2bf(v[2]); st[(cl + 3) * 40 + rl] = (bf16_t)f2bf(v[3]);
                }
            }
            asm volatile("s_waitcnt lgkmcnt(0)" ::: "memory");
            const u32x4 w = *(const u32x4*)&st[rc * 40 + 8 * r8];
            asm volatile("" ::: "memory");
            const int col = u.pn * 256 + bj * 128 + wc * 32 + 16 * ch + rc;
            const int row = u.pm * 256 + ai * 128 + wr * 64 + 32 * mp + 8 * r8;
            const int b = row >> 13, i = row & 8191;
            bf16_t* dst;
            if (u.pn < 6) { const int c = col - 1024; dst = O.VTSB + ((size_t)(b * SBH + (c >> 6)) * 64 + (c & 63)) * KIDX + 32 + i; }
            else          { const int c = col - 2048; dst = GVT + ((size_t)(b * GH + (c >> 7)) * 128 + (c & 127)) * GU + 64 + i; }
            *(u32x4*)dst = w;
          }
  }
  DI void operator()(const pg8::f32x4 (&acc)[2][2][4][2], const pg8::Unit& u, int wr, int wc, int fr, int fq) const {
    const int pn = u.pn;
    if (pn == 4 || pn == 5 || pn == 8 || pn == 9) { store_vt(acc, u, wr, wc, fr, fq); return; }
#pragma unroll
    for (int ai = 0; ai < 2; ++ai)
#pragma unroll
      for (int m = 0; m < 4; ++m) {
        const int row = u.pm * 256 + ai * 128 + wr * 64 + m * 16 + fr;
        const int b = row >> 13, i = row & 8191;
#pragma unroll
        for (int bj = 0; bj < 2; ++bj) {
          const int col = pn * 256 + bj * 128 + wc * 32 + 8 * fq;
          const pg8::f32x4 v0 = acc[ai][bj][m][0], v1 = acc[ai][bj][m][1];
          if (pn < 12) {
            u32x4 w; w.x = pk2(v0[0], v0[1]); w.y = pk2(v0[2], v0[3]); w.z = pk2(v1[0], v1[1]); w.w = pk2(v1[2], v1[3]);
            bf16_t* dst;
            if (pn < 2)       { const int c = col;        dst = O.QSB + ((size_t)(b * SBH + (c >> 6)) * SEQ + i) * 64 + (c & 63); }
            else if (pn < 4)  { const int c = col - 512;  dst = O.KSB + ((size_t)(b * SBH + (c >> 6)) * KIDX + 32 + i) * 64 + (c & 63); }
            else if (pn == 6) { const int c = col - 1536; dst = O.GQ + ((size_t)(b * GH + (c >> 6)) * GU + 64 + i) * 64 + (c & 63); }
            else if (pn == 7) { const int c = col - 1792; dst = O.GK + ((size_t)(b * GH + (c >> 6)) * GU + 64 + i) * 64 + (c & 63); }
            else              { const int c = col - 2560; dst = O.GR + (size_t)row * 512 + c; }
            *(u32x4*)dst = w;
          } else if (col < NIN) {
            float* dst = O.GLR + ((size_t)b * GU + 64 + i) * 16 + (col - 3072);
            *(f32x4*)dst = (f32x4){v0[0], v0[1], v0[2], v0[3]};
            *(f32x4*)(dst + 4) = (f32x4){v1[0], v1[1], v1[2], v1[3]};
          }
        }
      }
  }
};
typedef unsigned char u8_t;
DI unsigned pack_i8x4(float a, float b, float c, float d);
struct EpiOut {
  static constexpr bool PERM = true, AFTER_DRAIN = false;
  const bf16_t* A1; const float* R1I; bf16_t* H1;
  u8_t* XQ; float* XS; float* SSQ; float* xch;
  DI void operator()(const pg8::f32x4 (&acc_)[2][2][4][2], const pg8::Unit& u, int wr, int wc, int fr, int fq) const {
    pg8::f32x4 (&acc)[2][2][4][2] = const_cast<pg8::f32x4 (&)[2][2][4][2]>(acc_);
    float* xa = xch;
    float* xs = xch + 2048;
#pragma unroll
    for (int ai = 0; ai < 2; ++ai)
#pragma unroll
      for (int m = 0; m < 4; ++m) {
        const int row = u.pm * 256 + ai * 128 + wr * 64 + m * 16 + fr;
        const size_t rowoff = (size_t)row * D;
        const float ri = R1I[row];
        float ss = 0.f;
#pragma unroll
        for (int bj = 0; bj < 2; ++bj) {
          const size_t idx = rowoff + u.pn * 256 + bj * 128 + wc * 32 + 8 * fq;
          const u32x4 aw = *(const u32x4*)(A1 + idx);
          const pg8::f32x4 v0 = acc[ai][bj][m][0], v1 = acc[ai][bj][m][1];
          pg8::f32x4 h0, h1;
          h0[0] = bflo(aw.x) * ri + v0[0]; h0[1] = bfhi(aw.x) * ri + v0[1]; h0[2] = bflo(aw.y) * ri + v0[2]; h0[3] = bfhi(aw.y) * ri + v0[3];
          h1[0] = bflo(aw.z) * ri + v1[0]; h1[1] = bfhi(aw.z) * ri + v1[1]; h1[2] = bflo(aw.w) * ri + v1[2]; h1[3] = bfhi(aw.w) * ri + v1[3];
          u32x4 w; w.x = pk2(h0[0], h0[1]); w.y = pk2(h0[2], h0[3]); w.z = pk2(h1[0], h1[1]); w.w = pk2(h1[2], h1[3]);
          *(u32x4*)(H1 + idx) = w;
          acc[ai][bj][m][0] = h0; acc[ai][bj][m][1] = h1;
          ss += h0[0] * h0[0] + h0[1] * h0[1] + h0[2] * h0[2] + h0[3] * h0[3] + h1[0] * h1[0] + h1[1] * h1[1] + h1[2] * h1[2] + h1[3] * h1[3];
          float am = fmaxf(fmaxf(fmaxf(fabsf(h0[0]), fabsf(h0[1])), fmaxf(fabsf(h0[2]), fabsf(h0[3]))), fmaxf(fmaxf(fabsf(h1[0]), fabsf(h1[1])), fmaxf(fabsf(h1[2]), fabsf(h1[3]))));
          am = fmaxf(am, __shfl_xor(am, 16)); am = fmaxf(am, __shfl_xor(am, 32));
          if (fq == 0) xa[((((wr * 2 + ai) * 4 + m) * 2 + bj) * 16 + fr) * 4 + wc] = am;
        }
        ss += __shfl_xor(ss, 16); ss += __shfl_xor(ss, 32);
        if (fq == 0) xs[(((wr * 2 + ai) * 4 + m) * 16 + fr) * 4 + wc] = ss;
      }
    asm volatile("s_waitcnt lgkmcnt(0)\n\ts_barrier" ::: "memory");
#pragma unroll
    for (int ai = 0; ai < 2; ++ai)
#pragma unroll
      for (int m = 0; m < 4; ++m) {
        const int row = u.pm * 256 + ai * 128 + wr * 64 + m * 16 + fr;
#pragma unroll
        for (int bj = 0; bj < 2; ++bj) {
          const f32x4 pm = *(const f32x4*)&xa[((((wr * 2 + ai) * 4 + m) * 2 + bj) * 16 + fr) * 4];
          const float M = fmaxf(fmaxf(pm.x, pm.y), fmaxf(pm.z, pm.w));
          const float inv = M > 0.f ? 127.0f / M : 0.f;
          const pg8::f32x4 h0 = acc[ai][bj][m][0], h1 = acc[ai][bj][m][1];
          u32x2 q;
          q.x = pack_i8x4(h0[0] * inv, h0[1] * inv, h0[2] * inv, h0[3] * inv);
          q.y = pack_i8x4(h1[0] * inv, h1[1] * inv, h1[2] * inv, h1[3] * inv);
          *(u32x2*)(XQ + (size_t)row * D + u.pn * 256 + bj * 128 + wc * 32 + 8 * fq) = q;
          if (wc == 0 && fq == 0) XS[(size_t)row * 8 + 2 * u.pn + bj] = M * (1.0f / 127.0f);
        }
        if (wc == 0 && fq == 0) {
          const f32x4 ps = *(const f32x4*)&xs[(((wr * 2 + ai) * 4 + m) * 16 + fr) * 4];
          SSQ[(size_t)u.pn * TREAL + row] = (ps.x + ps.y) + (ps.z + ps.w);
        }
      }
  }
};
struct EpiPQ {
  static constexpr bool PERM = true, AFTER_DRAIN = false;
  bf16_t* QP; const float* SSQ;
  DI void operator()(const pg8::f32x4 (&acc)[2][2][4][2], const pg8::Unit& u, int wr, int wc, int fr, int fq) const {
#pragma unroll
    for (int ai = 0; ai < 2; ++ai)
#pragma unroll
      for (int m = 0; m < 4; ++m) {
        const int row = u.pm * 256 + ai * 128 + wr * 64 + m * 16 + fr;
        const float r = rsqrtf(((SSQ[row] + SSQ[TREAL + row]) + (SSQ[2 * TREAL + row] + SSQ[3 * TREAL + row])) * (1.0f / D) + EPS);
        const size_t rowoff = (size_t)row * D;
#pragma unroll
        for (int bj = 0; bj < 2; ++bj) {
          const pg8::f32x4 v0 = acc[ai][bj][m][0], v1 = acc[ai][bj][m][1];
          u32x4 w; w.x = pk2(v0[0] * r, v0[1] * r); w.y = pk2(v0[2] * r, v0[3] * r); w.z = pk2(v1[0] * r, v1[1] * r); w.w = pk2(v1[2] * r, v1[3] * r);
          *(u32x4*)(QP + rowoff + u.pn * 256 + bj * 128 + wc * 32 + 8 * fq) = w;
        }
      }
  }
};

DI void ph_meta(int blk, char* smem, const float* __restrict__ meta, const float* __restrict__ g1, const float* __restrict__ w_in, const InProjOut& O) {
  float (*xmT)[16] = (float (*)[16])smem;
  float (*red)[256] = (float (*)[256])(smem + 65536);
  const int tid = fresh_tid(), lane = tid & 63, wave = tid >> 6;
  for (int rr = 0; rr < 2; ++rr) {
    const int mm = wave * 2 + rr;
    float v[16]; float ss = 0.f;
#pragma unroll
    for (int j = 0; j < 16; ++j) { v[j] = meta[(size_t)mm * D + j * 64 + lane]; ss += v[j] * v[j]; }
    ss = wave_sum(ss);
    const float r = rsqrtf(ss * (1.0f / D) + EPS);
#pragma unroll
    for (int j = 0; j < 16; ++j) xmT[j * 64 + lane][mm] = v[j] * r * g1[j * 64 + lane];
  }
  __syncthreads();
  {
    const int c = tid & 15, ks = tid >> 4, n = blk * 16 + c;
    float acc[16];
#pragma unroll
    for (int j = 0; j < 16; ++j) acc[j] = 0.f;
#pragma unroll 8
    for (int kk = 0; kk < 32; ++kk) {
      const int k = ks * 32 + kk;
      const float w = w_in[(size_t)k * NIN + n];
      const f32x4 a = *(const f32x4*)&xmT[k][0], b4 = *(const f32x4*)&xmT[k][4], c4 = *(const f32x4*)&xmT[k][8], d4 = *(const f32x4*)&xmT[k][12];
      acc[0] += a.x * w; acc[1] += a.y * w; acc[2] += a.z * w; acc[3] += a.w * w;
      acc[4] += b4.x * w; acc[5] += b4.y * w; acc[6] += b4.z * w; acc[7] += b4.w * w;
      acc[8] += c4.x * w; acc[9] += c4.y * w; acc[10] += c4.z * w; acc[11] += c4.w * w;
      acc[12] += d4.x * w; acc[13] += d4.y * w; acc[14] += d4.z * w; acc[15] += d4.w * w;
    }
#pragma unroll
    for (int mm = 0; mm < 16; ++mm) red[ks][c * 16 + mm] = acc[mm];
  }
  __syncthreads();
  if (tid < 256) {
    const int c = tid >> 4, mm = tid & 15, n = blk * 16 + c;
    float val = 0.f;
#pragma unroll 8
    for (int ks = 0; ks < 32; ++ks) val += red[ks][tid];
    const bf16_t hv = (bf16_t)f2bf(val);
    for (int bb = 0; bb < NB; ++bb) {
      if (n < 512) {}
      else if (n < 1024) { const int cc = n - 512;  O.KSB[((size_t)(bb * SBH + (cc >> 6)) * KIDX + 16 + mm) * 64 + (cc & 63)] = hv; }
      else if (n < 1536) { const int cc = n - 1024; O.VTSB[((size_t)(bb * SBH + (cc >> 6)) * 64 + (cc & 63)) * KIDX + 16 + mm] = hv; }
      else if (n < 1792) { const int cc = n - 1536; O.GQ[((size_t)(bb * GH + (cc >> 6)) * GU + 48 + mm) * 64 + (cc & 63)] = hv; }
      else if (n < 2048) { const int cc = n - 1792; O.GK[((size_t)(bb * GH + (cc >> 6)) * GU + 48 + mm) * 64 + (cc & 63)] = hv; }
      else if (n < 2560) { const int cc = n - 2048; O.GV[((size_t)(bb * GH + (cc >> 7)) * 128 + (cc & 127)) * GU + 48 + mm] = hv; }
      else if (n < 3072) {}
      else { O.GLR[((size_t)bb * GU + 48 + mm) * 16 + (n - 3072)] = val; }
    }
  }
  __syncthreads();
}


constexpr float SB_THR = 5.421010862e-20f;
DI void ph_sb_attn(int vb, const bf16_t* __restrict__ QSB, const bf16_t* __restrict__ KSB, const bf16_t* __restrict__ VTSB,
                                                 const float* __restrict__ sb_g, bf16_t* __restrict__ MIX) {
  const int tid256_ = fresh_tid() & 255;
  const int lane = TID & 63, wave = TID >> 6, r = lane & 31, h = lane >> 5;
  const int bh = vb >> 6, qb = vb & 63;
  const int b = bh >> 3, hd = bh & 7;
  const int i0 = qb * 128 + wave * 32;
  const bf16_t* Qb = QSB + ((size_t)bh * SEQ + i0) * 64;
  const bf16_t* Kb = KSB + (size_t)bh * KIDX * 64;
  const bf16_t* Vb = VTSB + (size_t)bh * 64 * KIDX;
  bf16x8 qf[4];
#pragma unroll
  for (int ks = 0; ks < 4; ++ks) qf[ks] = *(const bf16x8*)(Qb + r * 64 + ks * 16 + h * 8);
  f32x16 o[2];
#pragma unroll
  for (int e = 0; e < 16; ++e) { o[0][e] = 0.f; o[1][e] = 0.f; }
  float R = 1.f;
  const int qidx = 32 + i0 + r;
  for (int c = (i0 >> 5) + 1; c >= 0; --c) {
    const int k0 = 32 * c;
    bf16x8 kf[4];
#pragma unroll
    for (int ks = 0; ks < 4; ++ks) kf[ks] = *(const bf16x8*)(Kb + (size_t)(k0 + r) * 64 + ks * 16 + h * 8);
    bf16x8 vf[2][2];
#pragma unroll
    for (int mt = 0; mt < 2; ++mt)
#pragma unroll
      for (int s2 = 0; s2 < 2; ++s2) {
        const bf16_t* vp = Vb + (size_t)(mt * 32 + r) * KIDX + k0 + 16 * s2 + 4 * h;
        const u32x2 lo = *(const u32x2*)vp, hi = *(const u32x2*)(vp + 8);
        u32x4 t; t.x = lo.x; t.y = lo.y; t.z = hi.x; t.w = hi.y;
        vf[mt][s2] = __builtin_bit_cast(bf16x8, t);
      }
    f32x16 s;
#pragma unroll
    for (int e = 0; e < 16; ++e) s[e] = 0.f;
#pragma unroll
    for (int ks = 0; ks < 4; ++ks) s = MFMA32(kf[ks], qf[ks], s);
    float om[16], bt[16];
#pragma unroll
    for (int e = 0; e < 16; ++e) {
      const int kidx = k0 + crow(e, h);
      const bool valid = (kidx < qidx) && (kidx >= 16);
      const float z = s[e] * 0.125f;
      const float ez = __expf(-fabsf(z));
      const float big = __builtin_amdgcn_rcpf(1.f + ez), small = ez * big;
      const float beta = z >= 0.f ? big : small, onem = z >= 0.f ? small : big;
      om[e] = valid ? onem : 1.f;
      bt[e] = valid ? beta : 0.f;
    }
    float sfx[16], G[4], PG[4];
#pragma unroll
    for (int g = 0; g < 4; ++g) {
      sfx[4 * g + 3] = 1.f;
      sfx[4 * g + 2] = om[4 * g + 3];
      sfx[4 * g + 1] = sfx[4 * g + 2] * om[4 * g + 2];
      sfx[4 * g + 0] = sfx[4 * g + 1] * om[4 * g + 1];
      G[g] = sfx[4 * g + 0] * om[4 * g + 0];
      PG[g] = __shfl_xor(G[g], 32);
    }
    float HS[4];
    HS[3] = 1.f;
    HS[2] = G[3] * PG[3];
    HS[1] = HS[2] * (G[2] * PG[2]);
    HS[0] = HS[1] * (G[1] * PG[1]);
    const float total = HS[0] * (G[0] * PG[0]);
    float a[16];
#pragma unroll
    for (int e = 0; e < 16; ++e) {
      const int g = e >> 2;
      const float between = sfx[e] * (h == 0 ? PG[g] : 1.f) * (HS[g] * R);
      a[e] = bt[e] * between;
    }
    R *= total;
#pragma unroll
    for (int s2 = 0; s2 < 2; ++s2) {
      u32x4 p;
      p.x = pk2(a[8 * s2 + 0], a[8 * s2 + 1]); p.y = pk2(a[8 * s2 + 2], a[8 * s2 + 3]);
      p.z = pk2(a[8 * s2 + 4], a[8 * s2 + 5]); p.w = pk2(a[8 * s2 + 6], a[8 * s2 + 7]);
      const bf16x8 pf = __builtin_bit_cast(bf16x8, p);
      o[0] = MFMA32(vf[0][s2], pf, o[0]);
      o[1] = MFMA32(vf[1][s2], pf, o[1]);
    }
    if (__all(R < SB_THR)) break;
  }
  float ss = 0.f;
#pragma unroll
  for (int e = 0; e < 16; ++e) ss += o[0][e] * o[0][e] + o[1][e] * o[1][e];
  ss += __shfl_xor(ss, 32);
  const float sc = rsqrtf(ss * (1.0f / 64.0f) + EPS);
  bf16_t* outp = MIX + (size_t)(b * SEQ + i0 + r) * D + hd * 64;
#pragma unroll
  for (int mt = 0; mt < 2; ++mt)
#pragma unroll
    for (int g = 0; g < 4; ++g) {
      const int d = mt * 32 + 8 * g + 4 * h;
      const f32x4 gg = *(const f32x4*)(sb_g + hd * 64 + d);
      u32x2 pk;
      pk.x = pk2(o[mt][4 * g] * sc * gg.x, o[mt][4 * g + 1] * sc * gg.y);
      pk.y = pk2(o[mt][4 * g + 2] * sc * gg.z, o[mt][4 * g + 3] * sc * gg.w);
      *(u32x2*)(outp + d) = pk;
    }
}


DI void sb_tile_step(const f32x16& s, int k0, int qidx, int h, float& R, const bf16x8 (&vf)[2][2], f32x16 (&o)[2]) {
  float om[16], bt[16];
#pragma unroll
  for (int e = 0; e < 16; ++e) {
    const int kidx = k0 + crow(e, h);
    const bool valid = (kidx < qidx) && (kidx >= 16);
    const float z = s[e] * 0.125f;
    const float ez = __expf(-fabsf(z));
    const float big = __builtin_amdgcn_rcpf(1.f + ez), small = ez * big;
    const float beta = z >= 0.f ? big : small, onem = z >= 0.f ? small : big;
    om[e] = valid ? onem : 1.f;
    bt[e] = valid ? beta : 0.f;
  }
  float sfx[16], G[4], PG[4];
#pragma unroll
  for (int g = 0; g < 4; ++g) {
    sfx[4 * g + 3] = 1.f;
    sfx[4 * g + 2] = om[4 * g + 3];
    sfx[4 * g + 1] = sfx[4 * g + 2] * om[4 * g + 2];
    sfx[4 * g + 0] = sfx[4 * g + 1] * om[4 * g + 1];
    G[g] = sfx[4 * g + 0] * om[4 * g + 0];
    PG[g] = __shfl_xor(G[g], 32);
  }
  float HS[4];
  HS[3] = 1.f; HS[2] = G[3] * PG[3]; HS[1] = HS[2] * (G[2] * PG[2]); HS[0] = HS[1] * (G[1] * PG[1]);
  const float total = HS[0] * (G[0] * PG[0]);
  float a[16];
#pragma unroll
  for (int e = 0; e < 16; ++e) { const int g = e >> 2; a[e] = bt[e] * (sfx[e] * (h == 0 ? PG[g] : 1.f) * (HS[g] * R)); }
  R *= total;
#pragma unroll
  for (int s2 = 0; s2 < 2; ++s2) {
    u32x4 p;
    p.x = pk2(a[8 * s2 + 0], a[8 * s2 + 1]); p.y = pk2(a[8 * s2 + 2], a[8 * s2 + 3]);
    p.z = pk2(a[8 * s2 + 4], a[8 * s2 + 5]); p.w = pk2(a[8 * s2 + 6], a[8 * s2 + 7]);
    const bf16x8 pf = __builtin_bit_cast(bf16x8, p);
    o[0] = MFMA32(vf[0][s2], pf, o[0]);
    o[1] = MFMA32(vf[1][s2], pf, o[1]);
  }
}
DI void sb_tile_out(const f32x16 (&o)[2], int h, const float* __restrict__ sb_gh, bf16_t* __restrict__ outp) {
  float ss = 0.f;
#pragma unroll
  for (int e = 0; e < 16; ++e) ss += o[0][e] * o[0][e] + o[1][e] * o[1][e];
  ss += __shfl_xor(ss, 32);
  const float sc = rsqrtf(ss * (1.0f / 64.0f) + EPS);
#pragma unroll
  for (int mt = 0; mt < 2; ++mt)
#pragma unroll
    for (int g = 0; g < 4; ++g) {
      const int d = mt * 32 + 8 * g + 4 * h;
      const f32x4 gg = *(const f32x4*)(sb_gh + d);
      u32x2 pk;
      pk.x = pk2(o[mt][4 * g] * sc * gg.x, o[mt][4 * g + 1] * sc * gg.y);
      pk.y = pk2(o[mt][4 * g + 2] * sc * gg.z, o[mt][4 * g + 3] * sc * gg.w);
      *(u32x2*)(outp + d) = pk;
    }
}
DI void ph_sb_attn2(int vb, const bf16_t* __restrict__ QSB, const bf16_t* __restrict__ KSB, const bf16_t* __restrict__ VTSB,
                    const float* __restrict__ sb_g, bf16_t* __restrict__ MIX) {
  const int tid256_ = fresh_tid() & 255;
  const int lane = TID & 63, wave = TID >> 6, r = lane & 31, h = lane >> 5;
  const int bh = vb >> 5, qb = vb & 31;
  const int b = bh >> 3, hd = bh & 7;
  const int i0 = qb * 256 + wave * 64;
  const bf16_t* Qb = QSB + ((size_t)bh * SEQ + i0) * 64;
  const bf16_t* Kb = KSB + (size_t)bh * KIDX * 64;
  const bf16_t* Vb = VTSB + (size_t)bh * 64 * KIDX;
  bf16x8 qfA[4], qfB[4];
#pragma unroll
  for (int ks = 0; ks < 4; ++ks) { qfA[ks] = *(const bf16x8*)(Qb + r * 64 + ks * 16 + h * 8); qfB[ks] = *(const bf16x8*)(Qb + (32 + r) * 64 + ks * 16 + h * 8); }
  f32x16 oA[2], oB[2];
#pragma unroll
  for (int e = 0; e < 16; ++e) { oA[0][e] = 0.f; oA[1][e] = 0.f; oB[0][e] = 0.f; oB[1][e] = 0.f; }
  float RA = 1.f, RB = 1.f;
  const int qidxA = 32 + i0 + r, qidxB = qidxA + 32;
  for (int c = (i0 >> 5) + 2; c >= 0; --c) {
    const int k0 = 32 * c;
    bf16x8 kf[4];
#pragma unroll
    for (int ks = 0; ks < 4; ++ks) kf[ks] = *(const bf16x8*)(Kb + (size_t)(k0 + r) * 64 + ks * 16 + h * 8);
    bf16x8 vf[2][2];
#pragma unroll
    for (int mt = 0; mt < 2; ++mt)
#pragma unroll
      for (int s2 = 0; s2 < 2; ++s2) {
        const bf16_t* vp = Vb + (size_t)(mt * 32 + r) * KIDX + k0 + 16 * s2 + 4 * h;
        const u32x2 lo = *(const u32x2*)vp, hi = *(const u32x2*)(vp + 8);
        u32x4 t; t.x = lo.x; t.y = lo.y; t.z = hi.x; t.w = hi.y;
        vf[mt][s2] = __builtin_bit_cast(bf16x8, t);
      }
    f32x16 sA, sB;
#pragma unroll
    for (int e = 0; e < 16; ++e) { sA[e] = 0.f; sB[e] = 0.f; }
#pragma unroll
    for (int ks = 0; ks < 4; ++ks) { sA = MFMA32(kf[ks], qfA[ks], sA); sB = MFMA32(kf[ks], qfB[ks], sB); }
    sb_tile_step(sB, k0, qidxB, h, RB, vf, oB);
    sb_tile_step(sA, k0, qidxA, h, RA, vf, oA);
    if (__all(RA < SB_THR && RB < SB_THR)) break;
  }
  sb_tile_out(oA, h, sb_g + hd * 64, MIX + (size_t)(b * SEQ + i0 + r) * D + hd * 64);
  sb_tile_out(oB, h, sb_g + hd * 64, MIX + (size_t)(b * SEQ + i0 + 32 + r) * D + hd * 64);
}


constexpr int RT_TOK_PER_BLOCK = 256;


#define MFMA16(a, b, c) __builtin_amdgcn_mfma_f32_16x16x32_bf16((a), (b), (c), 0, 0, 0)
constexpr int GLDS = 72;
struct GlaLds {
  bf16_t Qt[64 * GLDS];
  bf16_t Kt[64 * GLDS];
  bf16_t KT[64 * GLDS];
  bf16_t P[64 * GLDS];
  float dec[64];
  float tot[8][64];
  float ssq[8][64];
};
constexpr size_t WS_SLOC = 926 * MiB;
constexpr size_t WS_DTOT = 942 * MiB;
constexpr size_t WS_GVT = 604 * MiB;

struct GlaPtrs { const bf16_t *GQ, *GK, *GVT, *GR; const float *GLR, *wg, *bg, *gla_g; float *SLOC, *DTOT; bf16_t* MIX; };


constexpr size_t WS_GQT = 470 * MiB;
constexpr size_t WS_GKT = 502 * MiB + 512 * 1024;
constexpr size_t WS_GKTT = 861 * MiB;
constexpr size_t WS_GDEC = 894 * MiB;
constexpr size_t WS_GBL = 896 * MiB;
struct GlaPrepPtrs { const bf16_t *GQ, *GK; const float *GLR, *wg, *bg; bf16_t *QT, *KT, *KTT; float *DEC, *BL; };
DI void ph_gla_prep(int pair, char* smem, const GlaPrepPtrs& G) {
  const int tid = fresh_tid(), lane = tid & 63, w = tid >> 6, hb = w >> 2, w4 = w & 3;
  float (*tot)[64] = (float (*)[64])(smem + hb * 1024);
  const int item = 2 * pair + hb;
  const int bh = item / 129, c = item % 129, b = bh >> 2, hd = bh & 3, u0 = 64 * c;
  float wgr[16];
#pragma unroll
  for (int k = 0; k < 16; ++k) wgr[k] = G.wg[k * 256 + hd * 64 + lane];
  const float bgv = G.bg[hd * 64 + lane];
  float cs[16]; float run = 0.f;
  unsigned short kraw[16], qraw[16];
#pragma unroll
  for (int i = 0; i < 16; ++i) {
    const int u = u0 + 16 * w4 + i;
    kraw[i] = G.GK[((size_t)bh * GU + u) * 64 + lane];
    qraw[i] = G.GQ[((size_t)bh * GU + u) * 64 + lane];
  }
#pragma unroll
  for (int i = 0; i < 16; ++i) {
    const int u = u0 + 16 * w4 + i;
    float lgv = 0.f;
    if (u >= 48) {
      const f32x4* gp = (const f32x4*)(G.GLR + ((size_t)b * GU + u) * 16);
      const f32x4 g0 = gp[0], g1 = gp[1], g2 = gp[2], g3 = gp[3];
      float a = bgv;
      a += g0.x * wgr[0] + g0.y * wgr[1] + g0.z * wgr[2] + g0.w * wgr[3];
      a += g1.x * wgr[4] + g1.y * wgr[5] + g1.z * wgr[6] + g1.w * wgr[7];
      a += g2.x * wgr[8] + g2.y * wgr[9] + g2.z * wgr[10] + g2.w * wgr[11];
      a += g3.x * wgr[12] + g3.y * wgr[13] + g3.z * wgr[14] + g3.w * wgr[15];
      lgv = -softplus(-a) * (1.0f / 16.0f);
    }
    run += lgv; cs[i] = run;
  }
  tot[w4][lane] = run;
  __syncthreads();
  float offset = 0.f, total = 0.f;
#pragma unroll
  for (int s2 = 0; s2 < 4; ++s2) { const float tv = tot[s2][lane]; total += tv; if (s2 < w4) offset += tv; }
  const size_t cb = ((size_t)bh * 129 + c) * 4096;
  float kt[16];
#pragma unroll
  for (int i = 0; i < 16; ++i) {
    const float bc = offset + cs[i];
    kt[i] = bf2f(kraw[i]) * __expf(-bc);
    G.QT[cb + (16 * w4 + i) * 64 + lane] = (bf16_t)f2bf(bf2f(qraw[i]) * __expf(bc) * 0.125f);
    G.KT[cb + (16 * w4 + i) * 64 + lane] = (bf16_t)f2bf(kt[i]);
  }
  u32x4 kp; kp.x = pk2(kt[0], kt[1]); kp.y = pk2(kt[2], kt[3]); kp.z = pk2(kt[4], kt[5]); kp.w = pk2(kt[6], kt[7]);
  *(u32x4*)(G.KTT + cb + lane * 64 + 16 * w4) = kp;
  kp.x = pk2(kt[8], kt[9]); kp.y = pk2(kt[10], kt[11]); kp.z = pk2(kt[12], kt[13]); kp.w = pk2(kt[14], kt[15]);
  *(u32x4*)(G.KTT + cb + lane * 64 + 16 * w4 + 8) = kp;
  if (w4 == 0) { G.DEC[((size_t)bh * 129 + c) * 64 + lane] = __expf(total); G.BL[((size_t)bh * 129 + c) * 64 + lane] = total; }
  __syncthreads();
}

struct GlaBuf { bf16_t Qt[64 * GLDS]; bf16_t Kt[64 * GLDS]; bf16_t KT[64 * GLDS]; };
struct GlaLds3 { GlaBuf B[2]; bf16_t P[64 * GLDS]; float ssq[8][64]; };
struct GlaPtrs3 { const bf16_t *QT, *KT, *KTT, *GVT, *GR; const float *DEC, *BL, *gla_g; float *SLOC, *DTOT; bf16_t* MIX; };

template <int PASS>
DI void gla_item3(int bh, int sc, char* smem, const GlaPtrs3& G) {
  GlaLds3& L = *(GlaLds3*)smem;
  const int tid = fresh_tid(), lane = tid & 63, w = __builtin_amdgcn_readfirstlane(tid >> 6), c16 = lane & 15, q = lane >> 4;
  const int b = bh >> 2, hd = bh & 3;
  const int cbeg = sc == 0 ? 0 : 8 * sc + 1, cend = 8 * sc + 9;
  f32x4 X[4];
#pragma unroll
  for (int i = 0; i < 4; ++i) X[i] = (f32x4){0.f, 0.f, 0.f, 0.f};
  if (PASS == 1) {
#pragma unroll 4
    for (int j = 0; j < sc; ++j) {
      const float* dt = G.DTOT + (size_t)(bh * 16 + j) * 64;
      const float* sl = G.SLOC + ((size_t)(bh * 16 + j) * 8 + w) * 16 * 64 + lane;
#pragma unroll
      for (int i = 0; i < 4; ++i) {
        const f32x4 d4 = *(const f32x4*)(dt + 16 * i + 4 * q);
        X[i][0] = d4.x * X[i][0] + sl[(4 * i + 0) * 64]; X[i][1] = d4.y * X[i][1] + sl[(4 * i + 1) * 64];
        X[i][2] = d4.z * X[i][2] + sl[(4 * i + 2) * 64]; X[i][3] = d4.w * X[i][3] + sl[(4 * i + 3) * 64];
      }
    }
  }
  f32x4 gain = {1.f, 1.f, 1.f, 1.f};
  if (PASS == 1) gain = *(const f32x4*)(G.gla_g + hd * 128 + 16 * w + 4 * q);
  const bf16_t* gvt = G.GVT + ((size_t)bh * 128 + 16 * w + c16) * GU + 8 * q;
  const int srow = tid >> 3, sc8 = tid & 7, soff = srow * GLDS + sc8 * 8;
  const size_t cb0 = (size_t)bh * 129 * 4096 + (size_t)srow * 64 + sc8 * 8;
  u32x4 rq, rk, rkt, rq2, rk2, rkt2; bf16x8 vfr[2], vfn[2], vfn2[2]; f32x4 dec[4], decn[4], decn2[4];
  {
    const size_t cb = cb0 + (size_t)cbeg * 4096;
    rkt = *(const u32x4*)(G.KTT + cb);
    if (PASS == 1) { rq = *(const u32x4*)(G.QT + cb); rk = *(const u32x4*)(G.KT + cb); }
    vfr[0] = *(const bf16x8*)(gvt + 64 * cbeg); vfr[1] = *(const bf16x8*)(gvt + 64 * cbeg + 32);
#pragma unroll
    for (int i = 0; i < 4; ++i) dec[i] = *(const f32x4*)(G.DEC + ((size_t)bh * 129 + cbeg) * 64 + 16 * i + 4 * q);
    *(u32x4*)&L.B[0].KT[soff] = rkt;
    if (PASS == 1) { *(u32x4*)&L.B[0].Qt[soff] = rq; *(u32x4*)&L.B[0].Kt[soff] = rk; }
    const size_t cb1 = cb0 + (size_t)(cbeg + 1) * 4096;
    rkt = *(const u32x4*)(G.KTT + cb1);
    if (PASS == 1) { rq = *(const u32x4*)(G.QT + cb1); rk = *(const u32x4*)(G.KT + cb1); }
    vfn[0] = *(const bf16x8*)(gvt + 64 * (cbeg + 1)); vfn[1] = *(const bf16x8*)(gvt + 64 * (cbeg + 1) + 32);
#pragma unroll
    for (int i = 0; i < 4; ++i) decn[i] = *(const f32x4*)(G.DEC + ((size_t)bh * 129 + cbeg + 1) * 64 + 16 * i + 4 * q);
  }
  __syncthreads();
  for (int c = cbeg; c < cend; ++c) {
    const int cur = (c - cbeg) & 1;
    const GlaBuf& Bc = L.B[cur];
    const bool more = c + 1 < cend, more2 = c + 2 < cend;
    if (more2) {
      const size_t cb = cb0 + (size_t)(c + 2) * 4096;
      rkt2 = *(const u32x4*)(G.KTT + cb);
      if (PASS == 1) { rq2 = *(const u32x4*)(G.QT + cb); rk2 = *(const u32x4*)(G.KT + cb); }
      vfn2[0] = *(const bf16x8*)(gvt + 64 * (c + 2)); vfn2[1] = *(const bf16x8*)(gvt + 64 * (c + 2) + 32);
#pragma unroll
      for (int i = 0; i < 4; ++i) decn2[i] = *(const f32x4*)(G.DEC + ((size_t)bh * 129 + c + 2) * 64 + 16 * i + 4 * q);
    }
    u32x2 grv[4];
    if (PASS == 1 && c >= 1) {
#pragma unroll
      for (int n = 0; n < 4; ++n) grv[n] = *(const u32x2*)(G.GR + ((size_t)b * SEQ + 64 * (c - 1) + 16 * n + c16) * 512 + hd * 128 + 16 * w + 4 * q);
    }
    f32x4 OT[4];
    if (PASS == 1) {
      const int is = w >> 1;
#pragma unroll
      for (int z = 0; z < 2; ++z) {
        const int it = 2 * (w & 1) + z;
        f32x4 pa = {0.f, 0.f, 0.f, 0.f};
        if (is <= it) {
#pragma unroll
          for (int kk = 0; kk < 2; ++kk) {
            const bf16x8 ka = *(const bf16x8*)&Bc.Kt[(16 * is + c16) * GLDS + 32 * kk + 8 * q];
            const bf16x8 qb = *(const bf16x8*)&Bc.Qt[(16 * it + c16) * GLDS + 32 * kk + 8 * q];
            pa = MFMA16(ka, qb, pa);
          }
          if (is == it) {
#pragma unroll
            for (int r = 0; r < 4; ++r) if (4 * q + r > c16) pa[r] = 0.f;
          }
        }
        u32x2 pw; pw.x = pk2(pa[0], pa[1]); pw.y = pk2(pa[2], pa[3]);
        *(u32x2*)&L.P[(16 * it + c16) * GLDS + 16 * is + 4 * q] = pw;
      }
#pragma unroll
      for (int n = 0; n < 4; ++n) OT[n] = (f32x4){0.f, 0.f, 0.f, 0.f};
#pragma unroll
      for (int kk = 0; kk < 2; ++kk) {
        u32x4 xp; xp.x = pk2(X[2 * kk][0], X[2 * kk][1]); xp.y = pk2(X[2 * kk][2], X[2 * kk][3]);
        xp.z = pk2(X[2 * kk + 1][0], X[2 * kk + 1][1]); xp.w = pk2(X[2 * kk + 1][2], X[2 * kk + 1][3]);
        const bf16x8 xa = __builtin_bit_cast(bf16x8, xp);
#pragma unroll
        for (int n = 0; n < 4; ++n) {
          const u32x2 lo = *(const u32x2*)&Bc.Qt[(16 * n + c16) * GLDS + 32 * kk + 4 * q];
          const u32x2 hi = *(const u32x2*)&Bc.Qt[(16 * n + c16) * GLDS + 32 * kk + 16 + 4 * q];
          u32x4 qq; qq.x = lo.x; qq.y = lo.y; qq.z = hi.x; qq.w = hi.y;
          OT[n] = MFMA16(xa, __builtin_bit_cast(bf16x8, qq), OT[n]);
        }
      }
      __syncthreads();
#pragma unroll
      for (int kk = 0; kk < 2; ++kk)
#pragma unroll
        for (int n = 0; n < 4; ++n) {
          const bf16x8 pb = *(const bf16x8*)&L.P[(16 * n + c16) * GLDS + 32 * kk + 8 * q];
          OT[n] = MFMA16(vfr[kk], pb, OT[n]);
        }
    }
#pragma unroll
    for (int i = 0; i < 4; ++i) {
#pragma unroll
      for (int kk = 0; kk < 2; ++kk) {
        const bf16x8 ka = *(const bf16x8*)&Bc.KT[(16 * i + c16) * GLDS + 32 * kk + 8 * q];
        X[i] = MFMA16(ka, vfr[kk], X[i]);
      }
      X[i][0] *= dec[i].x; X[i][1] *= dec[i].y; X[i][2] *= dec[i].z; X[i][3] *= dec[i].w;
    }
    if (PASS == 1 && c >= 1) {
      float ss[4];
#pragma unroll
      for (int n = 0; n < 4; ++n) {
        float v = OT[n][0] * OT[n][0] + OT[n][1] * OT[n][1] + OT[n][2] * OT[n][2] + OT[n][3] * OT[n][3];
        v += __shfl_xor(v, 16); v += __shfl_xor(v, 32);
        ss[n] = v;
      }
      if (q == 0) {
#pragma unroll
        for (int n = 0; n < 4; ++n) L.ssq[w][16 * n + c16] = ss[n];
      }
      __syncthreads();
#pragma unroll
      for (int n = 0; n < 4; ++n) {
        float tot = 0.f;
#pragma unroll
        for (int w2 = 0; w2 < 8; ++w2) tot += L.ssq[w2][16 * n + c16];
        const float scl = rsqrtf(tot * (1.0f / 128.0f) + EPS);
        const size_t m = (size_t)b * SEQ + 64 * (c - 1) + 16 * n + c16;
        const float r0 = bflo(grv[n].x), r1 = bfhi(grv[n].x), r2 = bflo(grv[n].y), r3 = bfhi(grv[n].y);
        const float o0 = OT[n][0] * scl * gain.x * (r0 / (1.f + __expf(-r0)));
        const float o1 = OT[n][1] * scl * gain.y * (r1 / (1.f + __expf(-r1)));
        const float o2 = OT[n][2] * scl * gain.z * (r2 / (1.f + __expf(-r2)));
        const float o3 = OT[n][3] * scl * gain.w * (r3 / (1.f + __expf(-r3)));
        u32x2 ow; ow.x = pk2(o0, o1); ow.y = pk2(o2, o3);
        *(u32x2*)(G.MIX + m * D + 512 + hd * 128 + 16 * w + 4 * q) = ow;
      }
    }
    if (more) {
      GlaBuf& Bn = L.B[cur ^ 1];
      *(u32x4*)&Bn.KT[soff] = rkt;
      if (PASS == 1) { *(u32x4*)&Bn.Qt[soff] = rq; *(u32x4*)&Bn.Kt[soff] = rk; }
      vfr[0] = vfn[0]; vfr[1] = vfn[1];
#pragma unroll
      for (int i = 0; i < 4; ++i) dec[i] = decn[i];
      rkt = rkt2; rq = rq2; rk = rk2; vfn[0] = vfn2[0]; vfn[1] = vfn2[1];
#pragma unroll
      for (int i = 0; i < 4; ++i) decn[i] = decn2[i];
    }
    __syncthreads();
  }
  if (PASS == 0) {
    float* sl = G.SLOC + ((size_t)(bh * 16 + sc) * 8 + w) * 16 * 64 + lane;
#pragma unroll
    for (int i = 0; i < 4; ++i)
#pragma unroll
      for (int r = 0; r < 4; ++r) sl[(4 * i + r) * 64] = X[i][r];
    if (w == 0) {
      float bl = 0.f;
      for (int c = cbeg; c < cend; ++c) bl += G.BL[((size_t)bh * 129 + c) * 64 + lane];
      G.DTOT[(size_t)(bh * 16 + sc) * 64 + lane] = __expf(bl);
    }
  }
}


struct GlaLds4 { GlaBuf B[2]; bf16_t P[64 * GLDS]; float ssq[4][64]; };
template <int PASS>
DI void gla_item4(int bh_lo, int sc, char* smem, const GlaPtrs3& G) {
  const int tid = fresh_tid(), lane = tid & 63, w = __builtin_amdgcn_readfirstlane(tid >> 6), c16 = lane & 15, q = lane >> 4;
  const int hb = w >> 2, w4 = w & 3, tid4 = tid & 255;
  GlaLds4& L = *(GlaLds4*)(smem + hb * (int)sizeof(GlaLds4));
  const int bh = bh_lo + 16 * hb, b = bh >> 2, hd = bh & 3;
  const int cbeg = sc == 0 ? 0 : 8 * sc + 1, cend = 8 * sc + 9;
  f32x4 X[2][4];
#pragma unroll
  for (int et = 0; et < 2; ++et)
#pragma unroll
    for (int i = 0; i < 4; ++i) X[et][i] = (f32x4){0.f, 0.f, 0.f, 0.f};
  if (PASS == 1) {
#pragma unroll 2
    for (int j = 0; j < sc; ++j) {
      const float* dt = G.DTOT + (size_t)(bh * 16 + j) * 64;
#pragma unroll
      for (int et = 0; et < 2; ++et) {
        const float* sl = G.SLOC + ((size_t)(bh * 16 + j) * 8 + w4 * 2 + et) * 16 * 64 + lane;
#pragma unroll
        for (int i = 0; i < 4; ++i) {
          const f32x4 d4 = *(const f32x4*)(dt + 16 * i + 4 * q);
          X[et][i][0] = d4.x * X[et][i][0] + sl[(4 * i + 0) * 64]; X[et][i][1] = d4.y * X[et][i][1] + sl[(4 * i + 1) * 64];
          X[et][i][2] = d4.z * X[et][i][2] + sl[(4 * i + 2) * 64]; X[et][i][3] = d4.w * X[et][i][3] + sl[(4 * i + 3) * 64];
        }
      }
    }
  }
  f32x4 gain[2];
#pragma unroll
  for (int et = 0; et < 2; ++et) gain[et] = PASS == 1 ? *(const f32x4*)(G.gla_g + hd * 128 + 32 * w4 + 16 * et + 4 * q) : (f32x4){1.f, 1.f, 1.f, 1.f};
  const bf16_t* gvt0 = G.GVT + ((size_t)bh * 128 + 32 * w4 + c16) * GU + 8 * q;
  const bf16_t* gvt1 = gvt0 + (size_t)16 * GU;
  const int soffA = (tid4 >> 3) * GLDS + (tid4 & 7) * 8, soffB = soffA + 32 * GLDS;
  const size_t cb0 = (size_t)bh * 129 * 4096 + (size_t)(tid4 >> 3) * 64 + (tid4 & 7) * 8;
  u32x4 rq[2], rk[2], rkt[2], rq2[2], rk2[2], rkt2[2];
  bf16x8 vfr[2][2], vfn[2][2]; f32x4 dec[4], decn[4];
#define G4_LOADT(rq_, rk_, rkt_, c_) { const size_t cb_ = cb0 + (size_t)(c_) * 4096; \
    rkt_[0] = *(const u32x4*)(G.KTT + cb_); rkt_[1] = *(const u32x4*)(G.KTT + cb_ + 2048); \
    if (PASS == 1) { rq_[0] = *(const u32x4*)(G.QT + cb_); rq_[1] = *(const u32x4*)(G.QT + cb_ + 2048); rk_[0] = *(const u32x4*)(G.KT + cb_); rk_[1] = *(const u32x4*)(G.KT + cb_ + 2048); } }
#define G4_LOADV(vf_, dc_, c_) { vf_[0][0] = *(const bf16x8*)(gvt0 + 64 * (c_)); vf_[0][1] = *(const bf16x8*)(gvt0 + 64 * (c_) + 32); \
    vf_[1][0] = *(const bf16x8*)(gvt1 + 64 * (c_)); vf_[1][1] = *(const bf16x8*)(gvt1 + 64 * (c_) + 32); \
    _Pragma("unroll") for (int i = 0; i < 4; ++i) dc_[i] = *(const f32x4*)(G.DEC + ((size_t)bh * 129 + (c_)) * 64 + 16 * i + 4 * q); }
#define G4_STORET(Bn_, rq_, rk_, rkt_) { *(u32x4*)&Bn_.KT[soffA] = rkt_[0]; *(u32x4*)&Bn_.KT[soffB] = rkt_[1]; \
    if (PASS == 1) { *(u32x4*)&Bn_.Qt[soffA] = rq_[0]; *(u32x4*)&Bn_.Qt[soffB] = rq_[1]; *(u32x4*)&Bn_.Kt[soffA] = rk_[0]; *(u32x4*)&Bn_.Kt[soffB] = rk_[1]; } }
  G4_LOADT(rq, rk, rkt, cbeg)
  G4_LOADV(vfr, dec, cbeg)
  G4_STORET(L.B[0], rq, rk, rkt)
  G4_LOADT(rq, rk, rkt, cbeg + 1)
  G4_LOADV(vfn, decn, cbeg + 1)
  __syncthreads();
  for (int c = cbeg; c < cend; ++c) {
    const int cur = (c - cbeg) & 1;
    const GlaBuf& Bc = L.B[cur];
    const bool more = c + 1 < cend, more2 = c + 2 < cend;
    if (more2) G4_LOADT(rq2, rk2, rkt2, c + 2)
    u32x2 grv[2][4];
    if (PASS == 1 && c >= 1) {
#pragma unroll
      for (int et = 0; et < 2; ++et)
#pragma unroll
        for (int n = 0; n < 4; ++n) grv[et][n] = *(const u32x2*)(G.GR + ((size_t)b * SEQ + 64 * (c - 1) + 16 * n + c16) * 512 + hd * 128 + 32 * w4 + 16 * et + 4 * q);
    }
    f32x4 OT[2][4];
    if (PASS == 1) {
      const int is = w4;
#pragma unroll
      for (int it = 0; it < 4; ++it) {
        f32x4 pa = {0.f, 0.f, 0.f, 0.f};
        if (is <= it) {
#pragma unroll
          for (int kk = 0; kk < 2; ++kk) {
            const bf16x8 ka = *(const bf16x8*)&Bc.Kt[(16 * is + c16) * GLDS + 32 * kk + 8 * q];
            const bf16x8 qb = *(const bf16x8*)&Bc.Qt[(16 * it + c16) * GLDS + 32 * kk + 8 * q];
            pa = MFMA16(ka, qb, pa);
          }
          if (is == it) {
#pragma unroll
            for (int r = 0; r < 4; ++r) if (4 * q + r > c16) pa[r] = 0.f;
          }
        }
        u32x2 pw; pw.x = pk2(pa[0], pa[1]); pw.y = pk2(pa[2], pa[3]);
        *(u32x2*)&L.P[(16 * it + c16) * GLDS + 16 * is + 4 * q] = pw;
      }
#pragma unroll
      for (int et = 0; et < 2; ++et)
#pragma unroll
        for (int n = 0; n < 4; ++n) OT[et][n] = (f32x4){0.f, 0.f, 0.f, 0.f};
#pragma unroll
      for (int kk = 0; kk < 2; ++kk) {
        bf16x8 xa[2];
#pragma unroll
        for (int et = 0; et < 2; ++et) {
          u32x4 xp; xp.x = pk2(X[et][2 * kk][0], X[et][2 * kk][1]); xp.y = pk2(X[et][2 * kk][2], X[et][2 * kk][3]);
          xp.z = pk2(X[et][2 * kk + 1][0], X[et][2 * kk + 1][1]); xp.w = pk2(X[et][2 * kk + 1][2], X[et][2 * kk + 1][3]);
          xa[et] = __builtin_bit_cast(bf16x8, xp);
        }
#pragma unroll
        for (int n = 0; n < 4; ++n) {
          const u32x2 lo = *(const u32x2*)&Bc.Qt[(16 * n + c16) * GLDS + 32 * kk + 4 * q];
          const u32x2 hi = *(const u32x2*)&Bc.Qt[(16 * n + c16) * GLDS + 32 * kk + 16 + 4 * q];
          u32x4 qq; qq.x = lo.x; qq.y = lo.y; qq.z = hi.x; qq.w = hi.y;
          const bf16x8 qf = __builtin_bit_cast(bf16x8, qq);
          OT[0][n] = MFMA16(xa[0], qf, OT[0][n]);
          OT[1][n] = MFMA16(xa[1], qf, OT[1][n]);
        }
      }
      __syncthreads();
#pragma unroll
      for (int kk = 0; kk < 2; ++kk)
#pragma unroll
        for (int n = 0; n < 4; ++n) {
          const bf16x8 pb = *(const bf16x8*)&L.P[(16 * n + c16) * GLDS + 32 * kk + 8 * q];
          OT[0][n] = MFMA16(vfr[0][kk], pb, OT[0][n]);
          OT[1][n] = MFMA16(vfr[1][kk], pb, OT[1][n]);
        }
    }
#pragma unroll
    for (int i = 0; i < 4; ++i) {
#pragma unroll
      for (int kk = 0; kk < 2; ++kk) {
        const bf16x8 ka = *(const bf16x8*)&Bc.KT[(16 * i + c16) * GLDS + 32 * kk + 8 * q];
        X[0][i] = MFMA16(ka, vfr[0][kk], X[0][i]);
        X[1][i] = MFMA16(ka, vfr[1][kk], X[1][i]);
      }
#pragma unroll
      for (int et = 0; et < 2; ++et) { X[et][i][0] *= dec[i].x; X[et][i][1] *= dec[i].y; X[et][i][2] *= dec[i].z; X[et][i][3] *= dec[i].w; }
    }
    if (PASS == 1 && c >= 1) {
      float ss[4];
#pragma unroll
      for (int n = 0; n < 4; ++n) {
        float v = OT[0][n][0] * OT[0][n][0] + OT[0][n][1] * OT[0][n][1] + OT[0][n][2] * OT[0][n][2] + OT[0][n][3] * OT[0][n][3]
                + OT[1][n][0] * OT[1][n][0] + OT[1][n][1] * OT[1][n][1] + OT[1][n][2] * OT[1][n][2] + OT[1][n][3] * OT[1][n][3];
        v += __shfl_xor(v, 16); v += __shfl_xor(v, 32);
        ss[n] = v;
      }
      if (q == 0) {
#pragma unroll
        for (int n = 0; n < 4; ++n) L.ssq[w4][16 * n + c16] = ss[n];
      }
      __syncthreads();
#pragma unroll
      for (int n = 0; n < 4; ++n) {
        const float tot = L.ssq[0][16 * n + c16] + L.ssq[1][16 * n + c16] + L.ssq[2][16 * n + c16] + L.ssq[3][16 * n + c16];
        const float scl = rsqrtf(tot * (1.0f / 128.0f) + EPS);
        const size_t m = (size_t)b * SEQ + 64 * (c - 1) + 16 * n + c16;
#pragma unroll
        for (int et = 0; et < 2; ++et) {
          const float r0 = bflo(grv[et][n].x), r1 = bfhi(grv[et][n].x), r2 = bflo(grv[et][n].y), r3 = bfhi(grv[et][n].y);
          const float o0 = OT[et][n][0] * scl * gain[et].x * r0 * __builtin_amdgcn_rcpf(1.f + __expf(-r0));
          const float o1 = OT[et][n][1] * scl * gain[et].y * r1 * __builtin_amdgcn_rcpf(1.f + __expf(-r1));
          const float o2 = OT[et][n][2] * scl * gain[et].z * r2 * __builtin_amdgcn_rcpf(1.f + __expf(-r2));
          const float o3 = OT[et][n][3] * scl * gain[et].w * r3 * __builtin_amdgcn_rcpf(1.f + __expf(-r3));
          u32x2 ow; ow.x = pk2(o0, o1); ow.y = pk2(o2, o3);
          *(u32x2*)(G.MIX + m * D + 512 + hd * 128 + 32 * w4 + 16 * et + 4 * q) = ow;
        }
      }
    }
    if (more) {
      GlaBuf& Bn = L.B[cur ^ 1];
      G4_STORET(Bn, rq, rk, rkt)
#pragma unroll
      for (int et = 0; et < 2; ++et) { vfr[et][0] = vfn[et][0]; vfr[et][1] = vfn[et][1]; }
#pragma unroll
      for (int i = 0; i < 4; ++i) dec[i] = decn[i];
#pragma unroll
      for (int z = 0; z < 2; ++z) { rkt[z] = rkt2[z]; rq[z] = rq2[z]; rk[z] = rk2[z]; }
      if (more2) G4_LOADV(vfn, decn, c + 2)
    }
    __syncthreads();
  }
#undef G4_LOADT
#undef G4_LOADV
#undef G4_STORET
  if (PASS == 0) {
#pragma unroll
    for (int et = 0; et < 2; ++et) {
      float* sl = G.SLOC + ((size_t)(bh * 16 + sc) * 8 + w4 * 2 + et) * 16 * 64 + lane;
#pragma unroll
      for (int i = 0; i < 4; ++i)
#pragma unroll
        for (int r = 0; r < 4; ++r) sl[(4 * i + r) * 64] = X[et][i][r];
    }
    if (w4 == 0) {
      float bl = 0.f;
      for (int c = cbeg; c < cend; ++c) bl += G.BL[((size_t)bh * 129 + c) * 64 + lane];
      G.DTOT[(size_t)(bh * 16 + sc) * 64 + lane] = __expf(bl);
    }
  }
}

DI void ce_desc(float& a, float& b) {
  const float hi = __builtin_fmaxf(a, b), lo = __builtin_fminf(a, b);
  a = hi; b = lo;
}
DI float vmaxf(float a, float b) { return __builtin_fmaxf(a, b); }
template <int N> DI void bitonic_sort_desc(float (&v)[N]) {
#pragma unroll
  for (int k = 2; k <= N; k <<= 1) {
#pragma unroll
    for (int j = k >> 1; j > 0; j >>= 1) {
#pragma unroll
      for (int i = 0; i < N; ++i) {
        const int l = i ^ j;
        if (l > i) { if ((i & k) == 0) ce_desc(v[i], v[l]); else ce_desc(v[l], v[i]); }
      }
    }
  }
}
DI void sort16_desc(float (&v)[16]) {
  ce_desc(v[0], v[1]); ce_desc(v[2], v[3]); ce_desc(v[0], v[2]); ce_desc(v[1], v[3]); ce_desc(v[1], v[2]); ce_desc(v[4], v[5]); ce_desc(v[6], v[7]); ce_desc(v[4], v[6]); ce_desc(v[5], v[7]); ce_desc(v[5], v[6]); ce_desc(v[0], v[4]); ce_desc(v[2], v[6]); ce_desc(v[2], v[4]); ce_desc(v[1], v[5]); ce_desc(v[3], v[7]); ce_desc(v[3], v[5]); ce_desc(v[1], v[2]); ce_desc(v[3], v[4]); ce_desc(v[5], v[6]); ce_desc(v[8], v[9]); ce_desc(v[10], v[11]); ce_desc(v[8], v[10]); ce_desc(v[9], v[11]); ce_desc(v[9], v[10]); ce_desc(v[12], v[13]); ce_desc(v[14], v[15]); ce_desc(v[12], v[14]); ce_desc(v[13], v[15]); ce_desc(v[13], v[14]); ce_desc(v[8], v[12]); ce_desc(v[10], v[14]); ce_desc(v[10], v[12]); ce_desc(v[9], v[13]); ce_desc(v[11], v[15]); ce_desc(v[11], v[13]); ce_desc(v[9], v[10]); ce_desc(v[11], v[12]); ce_desc(v[13], v[14]); ce_desc(v[0], v[8]); ce_desc(v[4], v[12]); ce_desc(v[4], v[8]); ce_desc(v[2], v[10]); ce_desc(v[6], v[14]); ce_desc(v[6], v[10]); ce_desc(v[2], v[4]); ce_desc(v[6], v[8]); ce_desc(v[10], v[12]); ce_desc(v[1], v[9]); ce_desc(v[5], v[13]); ce_desc(v[5], v[9]); ce_desc(v[3], v[11]); ce_desc(v[7], v[15]); ce_desc(v[7], v[11]); ce_desc(v[3], v[5]); ce_desc(v[7], v[9]); ce_desc(v[11], v[13]); ce_desc(v[1], v[2]); ce_desc(v[3], v[4]); ce_desc(v[5], v[6]); ce_desc(v[7], v[8]); ce_desc(v[9], v[10]); ce_desc(v[11], v[12]); ce_desc(v[13], v[14]);
}
DI void bitonic_merge16_desc(float (&v)[16]) {
#pragma unroll
  for (int j = 8; j > 0; j >>= 1) {
#pragma unroll
    for (int i = 0; i < 16; ++i) { const int l = i ^ j; if (l > i) ce_desc(v[i], v[l]); }
  }
}
template <int NBV> DI void merge_prune16(float (&a)[16], const float (&b)[16]) {
#pragma unroll
  for (int i = 16 - NBV; i < 16; ++i) a[i] = vmaxf(a[i], b[15 - i]);
  bitonic_merge16_desc(a);
}
DI float selh(int hh, float a, float b) { asm volatile("" : "+v"(a), "+v"(b)); return hh == 0 ? a : b; }
DI float pack_idx(float v, unsigned idx, unsigned mask) { return __uint_as_float((__float_as_uint(v) & ~mask) | idx); }

DI void route_stage_keys(int hd, char* smem, const bf16_t* __restrict__ SK1b, const bf16_t* __restrict__ SK2b) {
  const int tid256_ = fresh_tid() & 255;
  bf16_t* kl = (bf16_t*)smem;
#pragma unroll
  for (int i = 0; i < 8; ++i) {
    const int pz = TID + 256 * i, L = pz >> 10, row = (pz >> 3) & 127, c8 = pz & 7;
    const bf16_t* src = (L == 0 ? SK1b : SK2b) + (size_t)(hd * 128 + row) * 64 + c8 * 8;
    *(u32x4*)&kl[(L * 128 + row) * 72 + c8 * 8] = *(const u32x4*)src;
  }
  __syncthreads();
}
DI void route_load_q(bf16x8 (&qf)[2][4], const bf16_t* __restrict__ QP, int m, int hd, int hh) {
#pragma unroll
  for (int L = 0; L < 2; ++L)
#pragma unroll
    for (int ks = 0; ks < 4; ++ks) qf[L][ks] = *(const bf16x8*)(QP + (size_t)m * D + hd * 128 + L * 64 + hh * 8 + ks * 16);
}
DI void ph_route_v2(int vb, char* smem, const bf16x8 (&qf)[2][4], unsigned short* __restrict__ EIDX, float* __restrict__ GATE) {
  const int tid256_ = fresh_tid() & 255;
  const int lane = TID & 63, wave = TID >> 6, r = lane & 31, hh = lane >> 5;
  const int hd = vb & 7, tile = vb >> 3;
  const int m = tile * 128 + wave * 32 + r;
  const bf16_t* kl = (const bf16_t*)smem;
  float loc[2][16];
#pragma unroll
  for (int L = 0; L < 2; ++L) {
    float grp[4][16];
#pragma unroll
    for (int mt = 0; mt < 4; ++mt) {
      f32x16 acc;
#pragma unroll
      for (int e = 0; e < 16; ++e) acc[e] = 0.f;
#pragma unroll
      for (int ks = 0; ks < 4; ++ks) {
        const bf16x8 kf = *(const bf16x8*)&kl[(L * 128 + mt * 32 + r) * 72 + ks * 16 + hh * 8];
        acc = MFMA32(kf, qf[L][ks], acc);
      }
#pragma unroll
      for (int e = 0; e < 16; ++e) grp[mt][e] = pack_idx(acc[e], (unsigned)(mt * 32 + crow(e, hh)), 127u);
      sort16_desc(grp[mt]);
    }
    merge_prune16<16>(grp[0], grp[1]);
    merge_prune16<16>(grp[2], grp[3]);
    merge_prune16<16>(grp[0], grp[2]);
#pragma unroll
    for (int i = 0; i < 16; ++i) loc[L][i] = grp[0][i];
  }
  float fin[16], oth[16];
#pragma unroll
  for (int i = 0; i < 16; ++i) {
    const float send = selh(hh, loc[1][i], loc[0][i]);
    oth[i] = __shfl_xor(send, 32);
    fin[i] = selh(hh, loc[0][i], loc[1][i]);
  }
  merge_prune16<16>(fin, oth);
  float v1[16], v2[16];
#pragma unroll
  for (int i = 0; i < 16; ++i) {
    const float o = __shfl_xor(fin[i], 32);
    v1[i] = selh(hh, fin[i], o);
    v2[i] = selh(hh, o, fin[i]);
  }
  unsigned* ib = (unsigned*)(smem + 36864) + (size_t)TID * 8;
#pragma unroll
  for (int q = 0; q < 4; ++q) {
    unsigned w1 = 0, w2 = 0;
#pragma unroll
    for (int j = 0; j < 4; ++j) {
      w1 |= (__float_as_uint(v1[4 * q + j]) & 127u) << (8 * j);
      w2 |= (__float_as_uint(v2[4 * q + j]) & 127u) << (8 * j);
    }
    ib[q] = w1; ib[4 + q] = w2;
  }
  float R[16], Bv[16];
#pragma unroll
  for (int j = 0; j < 16; ++j) R[j] = pack_idx(v1[0] + v2[j], (unsigned)j, 255u);
#define ROUTE_ROW(I, CNT) { _Pragma("unroll") for (int j = 0; j < 16; ++j) Bv[j] = (j < CNT) ? pack_idx(v1[I] + v2[j < CNT ? j : 0], (unsigned)(I * 16 + j), 255u) : 0.f; \
    merge_prune16<CNT>(R, Bv); }
  ROUTE_ROW(1, 8) ROUTE_ROW(2, 5) ROUTE_ROW(3, 4) ROUTE_ROW(4, 3) ROUTE_ROW(5, 2) ROUTE_ROW(6, 2) ROUTE_ROW(7, 2)
#undef ROUTE_ROW
#pragma unroll
  for (int j = 0; j < 16; ++j) Bv[j] = (j < 8) ? pack_idx(v1[8 + (j < 8 ? j : 0)] + v2[0], (unsigned)((8 + j) * 16), 255u) : 0.f;
  merge_prune16<8>(R, Bv);
  float ex[16], sum = 0.f;
#pragma unroll
  for (int i = 0; i < 16; ++i) { ex[i] = __expf(R[i] - R[0]); sum += ex[i]; }
  const float inv = 1.f / sum;
  const unsigned char* ibb = (const unsigned char*)ib;
  int eo[8]; float go[8];
#pragma unroll
  for (int w = 0; w < 8; ++w) {
    const float rv = selh(hh, R[w], R[8 + w]);
    const float ev = selh(hh, ex[w], ex[8 + w]);
    const unsigned pos = __float_as_uint(rv) & 255u;
    const unsigned i1 = ibb[pos >> 4], i2 = ibb[16 + (pos & 15u)];
    eo[w] = (int)(i1 * 128u + i2);
    go[w] = ev * inv;
  }
  unsigned short* ep = EIDX + (size_t)m * 128 + hd * 16 + hh * 8;
  float* gp = GATE + (size_t)m * 128 + hd * 16 + hh * 8;
  *(u32x4*)ep = (u32x4){(unsigned)eo[0] | ((unsigned)eo[1] << 16), (unsigned)eo[2] | ((unsigned)eo[3] << 16), (unsigned)eo[4] | ((unsigned)eo[5] << 16), (unsigned)eo[6] | ((unsigned)eo[7] << 16)};
  *(f32x4*)gp = (f32x4){go[0], go[1], go[2], go[3]};
  *(f32x4*)(gp + 4) = (f32x4){go[4], go[5], go[6], go[7]};
}


constexpr size_t WS_SCU = 14 * MiB;
constexpr size_t WS_SCV = 14 * MiB + 65536;
DI float wave_max(float v) {
#pragma unroll
  for (int o = 32; o >= 1; o >>= 1) v = fmaxf(v, __shfl_xor(v, o));
  return v;
}
DI u32x4 quant_row16(const float* __restrict__ rowp, int lane, float& sc) {
  const f32x4* rp = (const f32x4*)(rowp + lane * 16);
  const f32x4 a = rp[0], b = rp[1], c = rp[2], d = rp[3];
  float m = fmaxf(fmaxf(fmaxf(fabsf(a.x), fabsf(a.y)), fmaxf(fabsf(a.z), fabsf(a.w))), fmaxf(fmaxf(fabsf(b.x), fabsf(b.y)), fmaxf(fabsf(b.z), fabsf(b.w))));
  m = fmaxf(m, fmaxf(fmaxf(fmaxf(fabsf(c.x), fabsf(c.y)), fmaxf(fabsf(c.z), fabsf(c.w))), fmaxf(fmaxf(fabsf(d.x), fabsf(d.y)), fmaxf(fabsf(d.z), fabsf(d.w)))));
  m = wave_max(m);
  sc = m > 0.f ? m * (1.0f / 448.0f) : 1.0f;
  const float inv = 1.0f / sc;
  u32x4 o; unsigned w;
  w = 0; w = __builtin_amdgcn_cvt_pk_fp8_f32(a.x * inv, a.y * inv, w, false); w = __builtin_amdgcn_cvt_pk_fp8_f32(a.z * inv, a.w * inv, w, true); o.x = w;
  w = 0; w = __builtin_amdgcn_cvt_pk_fp8_f32(b.x * inv, b.y * inv, w, false); w = __builtin_amdgcn_cvt_pk_fp8_f32(b.z * inv, b.w * inv, w, true); o.y = w;
  w = 0; w = __builtin_amdgcn_cvt_pk_fp8_f32(c.x * inv, c.y * inv, w, false); w = __builtin_amdgcn_cvt_pk_fp8_f32(c.z * inv, c.w * inv, w, true); o.z = w;
  w = 0; w = __builtin_amdgcn_cvt_pk_fp8_f32(d.x * inv, d.y * inv, w, false); w = __builtin_amdgcn_cvt_pk_fp8_f32(d.z * inv, d.w * inv, w, true); o.w = w;
  return o;
}
DI void ph_convert_ev8(int vb, char* smem, const float* __restrict__ src, u8_t* __restrict__ EV8c, float* __restrict__ scaleV) {
  const int tid256_ = fresh_tid() & 255;
  u8_t (*t)[1040] = (u8_t (*)[1040])smem;
  const int lane = TID & 63, wave = TID >> 6, e0 = vb * 32;
  for (int rr = 0; rr < 8; ++rr) {
    const int r = wave * 8 + rr;
    float sc;
    const u32x4 o = quant_row16(src + (size_t)(e0 + r) * D, lane, sc);
    *(u32x4*)&t[r][lane * 16] = o;
    if (lane == 0) scaleV[e0 + r] = sc;
  }
  __syncthreads();
  const int r = TID & 31, cs = TID >> 5;
  for (int c0 = 0; c0 < 128; c0 += 8) {
    const int cg = c0 + cs;
    const u32x2 v = *(const u32x2*)&t[r][cg * 8];
    *(u32x2*)(EV8c + ((size_t)cg * NEXP + e0 + r) * 8) = v;
  }
  __syncthreads();
}
struct PeerUHalf { u32x4 u[8]; };
DI float gelu_as(float v) {
  const float av = fabsf(v);
  const float t = __builtin_amdgcn_rcpf(av * 0.2316418882f + 1.0f);
  float q = t * 0.5307027145f + (-0.7265760135f); q = q * t + 0.7107068705f; q = q * t + (-0.142248368f); q = q * t + 0.127414796f; q = q * t;
  const float e = __builtin_amdgcn_exp2f((v * v) * (-0.72134752044f));
  const float m = v * (q * e);
  return v < 0.f ? m : v - m;
}
DI void pc_stage_scales(char* smem, const float* __restrict__ scaleU, const float* __restrict__ scaleV) {
  unsigned* sc = (unsigned*)(smem + 34816);
  const int tid = fresh_tid();
#pragma unroll 4
  for (int i = tid; i < NEXP; i += 512) sc[i] = f2bf(scaleU[i]) | (f2bf(scaleV[i]) << 16);
  __syncthreads();
}
DI void ph_peer_c8(int unit, char* smem, const bf16_t* __restrict__ PP, const unsigned short* __restrict__ EIDX, const float* __restrict__ GATE,
                   const float* __restrict__ SSQ, unsigned* __restrict__ STREAM) {
  unsigned (*tile)[132] = (unsigned (*)[132])smem;
  const unsigned* sc = (const unsigned*)(smem + 34816);
  const int tid = fresh_tid();
  const int tl = tid >> 3, kc = tid & 7;
  const size_t rowoff = ((size_t)unit * 64 + tl) * 128 + kc * 16;
  const size_t n = (size_t)TREAL * 128;
  const int tok = unit * 64 + tl;
  const float r2 = rsqrtf(((SSQ[tok] + SSQ[TREAL + tok]) + (SSQ[2 * TREAL + tok] + SSQ[3 * TREAL + tok])) * (1.0f / D) + EPS);
  float a[16];
#pragma unroll
  for (int j = 0; j < 16; ++j) a[j] = 0.f;
#pragma unroll
  for (int s = 0; s < 8; ++s) {
    const u32x4 p0 = *(const u32x4*)(PP + (size_t)s * n + rowoff), p1 = *(const u32x4*)(PP + (size_t)s * n + rowoff + 8);
    a[0] += bflo(p0.x); a[1] += bfhi(p0.x); a[2] += bflo(p0.y); a[3] += bfhi(p0.y); a[4] += bflo(p0.z); a[5] += bfhi(p0.z); a[6] += bflo(p0.w); a[7] += bfhi(p0.w);
    a[8] += bflo(p1.x); a[9] += bfhi(p1.x); a[10] += bflo(p1.y); a[11] += bfhi(p1.y); a[12] += bflo(p1.z); a[13] += bfhi(p1.z); a[14] += bflo(p1.w); a[15] += bfhi(p1.w);
  }
  const u32x4 e0 = *(const u32x4*)(EIDX + rowoff), e1 = *(const u32x4*)(EIDX + rowoff + 8);
  unsigned ev[16] = {e0.x & 0xffffu, e0.x >> 16, e0.y & 0xffffu, e0.y >> 16, e0.z & 0xffffu, e0.z >> 16, e0.w & 0xffffu, e0.w >> 16,
                     e1.x & 0xffffu, e1.x >> 16, e1.y & 0xffffu, e1.y >> 16, e1.z & 0xffffu, e1.z >> 16, e1.w & 0xffffu, e1.w >> 16};
  float gt[16];
#pragma unroll
  for (int j = 0; j < 4; ++j) { const f32x4 g4 = *(const f32x4*)(GATE + rowoff + 4 * j); gt[4 * j] = g4.x; gt[4 * j + 1] = g4.y; gt[4 * j + 2] = g4.z; gt[4 * j + 3] = g4.w; }
#pragma unroll
  for (int j = 0; j < 16; ++j) {
    const unsigned e = ev[j];
    const unsigned sw = sc[e];
    const float av = a[j] * (r2 * bflo(sw));
    const float act = gelu_as(av);
    const float c = gt[j] * act * bfhi(sw);
    tile[tl][kc * 16 + j] = e | (f2bf(c) << 16);
  }
  __syncthreads();
  unsigned* outp = STREAM + (size_t)unit * 8192;
#pragma unroll 4
  for (int j = 0; j < 16; ++j) {
    const int o = tid + 512 * j, q = o >> 8, t2 = (o >> 2) & 63, z = o & 3;
    outp[o] = tile[t2][4 * q + z];
  }
  __syncthreads();
}
struct PVW { u32x4 a, b; };
struct PVT { u32x2 v[8]; };
DI void pv_loadw(PVW& W, const unsigned* __restrict__ STREAM, int it, int g, int lane) {
  const u32x4* sp = (const u32x4*)(STREAM + (size_t)it * 8192) + lane;
  W.a = sp[(2 * g) * 64]; W.b = sp[(2 * g + 1) * 64];
}
DI void pv_readt(PVT& T, const PVW& W, const u32x2* tabl) {
  T.v[0] = tabl[W.a.x & 0xffffu]; T.v[1] = tabl[W.a.y & 0xffffu]; T.v[2] = tabl[W.a.z & 0xffffu]; T.v[3] = tabl[W.a.w & 0xffffu];
  T.v[4] = tabl[W.b.x & 0xffffu]; T.v[5] = tabl[W.b.y & 0xffffu]; T.v[6] = tabl[W.b.z & 0xffffu]; T.v[7] = tabl[W.b.w & 0xffffu];
}
DI void pv_fma1(unsigned w, const u32x2 v, f32x2 (&y)[4]) {
  const float c = bfhi(w);
  const f32x2 cc = {c, c};
  y[0] = __builtin_elementwise_fma(__builtin_amdgcn_cvt_pk_f32_fp8(v.x, false), cc, y[0]);
  y[1] = __builtin_elementwise_fma(__builtin_amdgcn_cvt_pk_f32_fp8(v.x, true), cc, y[1]);
  y[2] = __builtin_elementwise_fma(__builtin_amdgcn_cvt_pk_f32_fp8(v.y, false), cc, y[2]);
  y[3] = __builtin_elementwise_fma(__builtin_amdgcn_cvt_pk_f32_fp8(v.y, true), cc, y[3]);
}
DI void pv_fma(const PVW& W, const PVT& T, f32x2 (&y)[4]) {
  pv_fma1(W.a.x, T.v[0], y); pv_fma1(W.a.y, T.v[1], y); pv_fma1(W.a.z, T.v[2], y); pv_fma1(W.a.w, T.v[3], y);
  pv_fma1(W.b.x, T.v[4], y); pv_fma1(W.b.y, T.v[5], y); pv_fma1(W.b.z, T.v[6], y); pv_fma1(W.b.w, T.v[7], y);
}
DI void ph_peer_v8(char* smem, const unsigned* __restrict__ STREAM, const u8_t* __restrict__ EV8c, bf16_t* __restrict__ YT) {
  const int tid = fresh_tid(), lane = tid & 63, wave = tid >> 6;
  const u32x2* tabl = (const u32x2*)smem;
  for (int unit = blockIdx.x; unit < 256; unit += gridDim.x) {
    const int cg = unit & 127, th = unit >> 7;
    const u32x4* src = (const u32x4*)(EV8c + (size_t)cg * NEXP * 8);
#pragma unroll 4
    for (int i = tid; i < NEXP * 8 / 16; i += 512) ((u32x4*)smem)[i] = src[i];
    __syncthreads();
    const int it_end = th * 512 + 512;
    int it = th * 512 + wave;
    PVW W0, W1, W2, W3; PVT T0, T1;
    pv_loadw(W0, STREAM, it, 0, lane); pv_loadw(W1, STREAM, it, 1, lane);
    pv_readt(T0, W0, tabl);
    for (; it < it_end; it += 8) {
      const int itn = (it + 8 < it_end) ? it + 8 : it;
      f32x2 y[4];
#pragma unroll
      for (int z = 0; z < 4; ++z) y[z] = (f32x2){0.f, 0.f};
#define PV_STEP(g, Wld, Wrd, Trd, Wc, Tc) \
      pv_loadw(Wld, STREAM, ((g) + 2 < 16) ? it : itn, ((g) + 2) & 15, lane); \
      pv_readt(Trd, Wrd, tabl); \
      pv_fma(Wc, Tc, y); \
      asm volatile("" ::: "memory");
      PV_STEP(0, W2, W1, T1, W0, T0)  PV_STEP(1, W3, W2, T0, W1, T1)  PV_STEP(2, W0, W3, T1, W2, T0)  PV_STEP(3, W1, W0, T0, W3, T1)
      PV_STEP(4, W2, W1, T1, W0, T0)  PV_STEP(5, W3, W2, T0, W1, T1)  PV_STEP(6, W0, W3, T1, W2, T0)  PV_STEP(7, W1, W0, T0, W3, T1)
      PV_STEP(8, W2, W1, T1, W0, T0)  PV_STEP(9, W3, W2, T0, W1, T1)  PV_STEP(10, W0, W3, T1, W2, T0) PV_STEP(11, W1, W0, T0, W3, T1)
      PV_STEP(12, W2, W1, T1, W0, T0) PV_STEP(13, W3, W2, T0, W1, T1) PV_STEP(14, W0, W3, T1, W2, T0) PV_STEP(15, W1, W0, T0, W3, T1)
#undef PV_STEP
      const int t = it * 64 + lane;
      u32x4 yw; yw.x = pk2(y[0].x, y[0].y); yw.y = pk2(y[1].x, y[1].y); yw.z = pk2(y[2].x, y[2].y); yw.w = pk2(y[3].x, y[3].y);
      *(u32x4*)(YT + ((size_t)cg * TREAL + t) * 8) = yw;
    }
    __syncthreads();
  }
}


DI void ph_final_lds(int unit, char* smem, const bf16_t* __restrict__ H1, const bf16_t* __restrict__ YT, const float* __restrict__ gf, float* __restrict__ out) {
  float (*h2)[1028] = (float (*)[1028])smem;
  const int tid = fresh_tid(), lane = tid & 63, wave = tid >> 6;
  const int t0 = unit * 32;
#pragma unroll
  for (int rr = 0; rr < 4; ++rr) {
    const int r = wave * 4 + rr;
    const bf16_t* hp = H1 + (size_t)(t0 + r) * D;
#pragma unroll
    for (int j = 0; j < 2; ++j) {
      const u32x4 hw = *(const u32x4*)(hp + j * 512 + lane * 8);
      *(f32x4*)&h2[r][j * 512 + lane * 8] = (f32x4){bflo(hw.x), bfhi(hw.x), bflo(hw.y), bfhi(hw.y)};
      *(f32x4*)&h2[r][j * 512 + lane * 8 + 4] = (f32x4){bflo(hw.z), bfhi(hw.z), bflo(hw.w), bfhi(hw.w)};
    }
  }
  __syncthreads();
  {
    const int tok = lane & 31;
#pragma unroll 4
    for (int cg = wave * 2 + (lane >> 5); cg < 128; cg += 16) {
      const u32x4 yw = *(const u32x4*)(YT + ((size_t)cg * TREAL + t0 + tok) * 8);
      f32x4* hp = (f32x4*)&h2[tok][cg * 8];
      f32x4 a = hp[0], b4 = hp[1];
      a.x += bflo(yw.x); a.y += bfhi(yw.x); a.z += bflo(yw.y); a.w += bfhi(yw.y);
      b4.x += bflo(yw.z); b4.y += bfhi(yw.z); b4.z += bflo(yw.w); b4.w += bfhi(yw.w);
      hp[0] = a; hp[1] = b4;
    }
  }
  __syncthreads();
#pragma unroll
  for (int rr = 0; rr < 4; ++rr) {
    const int r = wave * 4 + rr;
    f32x4 v[4]; float ss = 0.f;
#pragma unroll
    for (int j = 0; j < 4; ++j) { v[j] = *(const f32x4*)&h2[r][j * 256 + lane * 4]; ss += v[j].x * v[j].x + v[j].y * v[j].y + v[j].z * v[j].z + v[j].w * v[j].w; }
    ss = wave_sum(ss);
    const float sc = rsqrtf(ss * (1.0f / D) + EPS);
    float* op = out + (size_t)(t0 + r) * D;
#pragma unroll
    for (int j = 0; j < 4; ++j) {
      const f32x4 gg = *(const f32x4*)(gf + j * 256 + lane * 4);
      *(f32x4*)(op + j * 256 + lane * 4) = (f32x4){v[j].x * sc * gg.x, v[j].y * sc * gg.y, v[j].z * sc * gg.z, v[j].w * sc * gg.w};
    }
  }
  __syncthreads();
}

typedef int i32x4 __attribute__((ext_vector_type(4)));
constexpr size_t WS_XQ = 861 * MiB;
constexpr size_t WS_XS = 943 * MiB;
DI unsigned pack_i8x4(float a, float b, float c, float d) {
  const int ia = __float2int_rn(a), ib = __float2int_rn(b), ic = __float2int_rn(c), id = __float2int_rn(d);
  return ((unsigned)ia & 255u) | (((unsigned)ib & 255u) << 8) | (((unsigned)ic & 255u) << 16) | ((unsigned)id << 24);
}
DI u32x4 quant_row16_i8(const float* __restrict__ rowp, const f32x4 (&g)[4], int lane, float& sc) {
  const f32x4* rp = (const f32x4*)(rowp + lane * 16);
  const f32x4 a = rp[0] * g[0], b = rp[1] * g[1], c = rp[2] * g[2], d = rp[3] * g[3];
  float m = fmaxf(fmaxf(fmaxf(fabsf(a.x), fabsf(a.y)), fmaxf(fabsf(a.z), fabsf(a.w))), fmaxf(fmaxf(fabsf(b.x), fabsf(b.y)), fmaxf(fabsf(b.z), fabsf(b.w))));
  m = fmaxf(m, fmaxf(fmaxf(fmaxf(fabsf(c.x), fabsf(c.y)), fmaxf(fabsf(c.z), fabsf(c.w))), fmaxf(fmaxf(fabsf(d.x), fabsf(d.y)), fmaxf(fabsf(d.z), fabsf(d.w)))));
  m = wave_max(m);
  sc = m > 0.f ? m * (1.0f / 127.0f) : 1.0f;
  const float inv = 1.0f / sc;
  u32x4 o;
  o.x = pack_i8x4(a.x * inv, a.y * inv, a.z * inv, a.w * inv); o.y = pack_i8x4(b.x * inv, b.y * inv, b.z * inv, b.w * inv);
  o.z = pack_i8x4(c.x * inv, c.y * inv, c.z * inv, c.w * inv); o.w = pack_i8x4(d.x * inv, d.y * inv, d.z * inv, d.w * inv);
  return o;
}
DI void ph_convert_eu_i8(const float* __restrict__ src, const float* __restrict__ gain, u8_t* __restrict__ EUq, float* __restrict__ scaleU) {
  const int tid = fresh_tid(), lane = tid & 63, wave = tid >> 6;
  f32x4 g[4];
#pragma unroll
  for (int j = 0; j < 4; ++j) g[j] = *(const f32x4*)(gain + lane * 16 + 4 * j);
  for (int e = (blockIdx.x * 8 + wave) * 2; e < NEXP; e += gridDim.x * 16) {
    float sc0, sc1 = 1.f;
    const bool two = e + 1 < NEXP;
    const u32x4 o0 = quant_row16_i8(src + (size_t)e * D, g, lane, sc0);
    u32x4 o1 = o0;
    if (two) o1 = quant_row16_i8(src + (size_t)(e + 1) * D, g, lane, sc1);
    *(u32x4*)(EUq + ((size_t)(lane >> 3) * NEXP + e) * 128 + (lane & 7) * 16) = o0;
    if (two) *(u32x4*)(EUq + ((size_t)(lane >> 3) * NEXP + e + 1) * 128 + (lane & 7) * 16) = o1;
    if (lane == 0) { scaleU[e] = sc0; if (two) scaleU[e + 1] = sc1; }
  }
}
DI int dpp_i(int v, const int sel) {
  if (sel == 0) return __builtin_amdgcn_update_dpp(0, v, 0xB1, 0xF, 0xF, true);
  if (sel == 1) return __builtin_amdgcn_update_dpp(0, v, 0x4E, 0xF, 0xF, true);
  return __builtin_amdgcn_update_dpp(0, v, 0x141, 0xF, 0xF, true);
}
DI int dpp_isum8(int v) { v += dpp_i(v, 0); v += dpp_i(v, 1); v += dpp_i(v, 2); return v; }
template <int HF> DI void peer_ud4_issue(PeerUHalf& H, unsigned idxpair, int lane, const u8_t* __restrict__ tab) {
#pragma unroll
  for (int jj = 0; jj < 8; ++jj) {
    const int j = 8 * HF + jj;
    const unsigned w = (unsigned)__shfl((int)idxpair, (lane & ~7) + (j >> 1));
    const unsigned e = (j & 1) ? (w >> 16) : (w & 0xffffu);
    H.u[jj] = *(const u32x4*)(tab + (size_t)e * 128);
  }
}
template <int HF> DI void peer_ud4_compute(const PeerUHalf& H, const u32x4 xq, int sub, int& res0, int& res1) {
#pragma unroll
  for (int jj = 0; jj < 8; ++jj) {
    const int j = 8 * HF + jj;
    int acc = 0;
    acc = __builtin_amdgcn_sdot4((int)H.u[jj].x, (int)xq.x, acc, false); acc = __builtin_amdgcn_sdot4((int)H.u[jj].y, (int)xq.y, acc, false);
    acc = __builtin_amdgcn_sdot4((int)H.u[jj].z, (int)xq.z, acc, false); acc = __builtin_amdgcn_sdot4((int)H.u[jj].w, (int)xq.w, acc, false);
    acc = dpp_isum8(acc);
    if (sub == (j >> 1)) { if (j & 1) res1 = acc; else res0 = acc; }
  }
}
DI void ph_peer_u_d4(int xi, int nx, int wv, int nwv, const u8_t* __restrict__ XQ, const float* __restrict__ XS, const u8_t* __restrict__ EUq,
                     const unsigned short* __restrict__ EIDX, bf16_t* __restrict__ PP) {
  const int lane = fresh_tid() & 63, sub = lane & 7;
  const int ntok = (TREAL - wv + nwv - 1) / nwv;
#define PU_TOK(i) (wv + ((i) < ntok ? (i) : ntok - 1) * nwv)
#define PU_IDX(t) __builtin_nontemporal_load((const unsigned*)(EIDX + (size_t)(t) * 128) + lane)
#define PU_LDX(xq_, xs_, t) { xq_ = *(const u32x4*)(xbase + (size_t)(t) * D); xs_ = XS[(size_t)(t) * 8 + s]; }
#define PU_STORE(t, r0, r1, xs_) __builtin_nontemporal_store(pk2((float)(r0) * (xs_), (float)(r1) * (xs_)), (unsigned*)(pp + (size_t)(t) * 128) + lane)
  for (int s = xi; s < 8; s += nx) {
    const u8_t* tab = EUq + (size_t)s * NEXP * 128 + sub * 16;
    const u8_t* xbase = XQ + s * 128 + sub * 16;
    bf16_t* pp = PP + (size_t)s * TREAL * 128;
    PeerUHalf HA, HB, HC;
    int ta = PU_TOK(0), tb = PU_TOK(1), tc = PU_TOK(2);
    unsigned ia = PU_IDX(ta), ib = PU_IDX(tb), ic = PU_IDX(tc);
    u32x4 xqa; float xsa; PU_LDX(xqa, xsa, ta);
    peer_ud4_issue<0>(HA, ia, lane, tab);
    peer_ud4_issue<1>(HB, ia, lane, tab);
    for (int i = 0; i < ntok; i += 3) {
      const int td = PU_TOK(i + 3), te = PU_TOK(i + 4), tf = PU_TOK(i + 5);
      u32x4 xqb, xqc, xqd; float xsb, xsc, xsd;
      int r0, r1;
      peer_ud4_issue<0>(HC, ib, lane, tab); PU_LDX(xqb, xsb, tb); const unsigned id = PU_IDX(td);
      r0 = 0; r1 = 0;
      peer_ud4_compute<0>(HA, xqa, sub, r0, r1);
      peer_ud4_issue<1>(HA, ib, lane, tab);
      peer_ud4_compute<1>(HB, xqa, sub, r0, r1);
      PU_STORE(ta, r0, r1, xsa);
      peer_ud4_issue<0>(HB, ic, lane, tab); PU_LDX(xqc, xsc, tc); const unsigned ie = PU_IDX(te);
      r0 = 0; r1 = 0;
      peer_ud4_compute<0>(HC, xqb, sub, r0, r1);
      peer_ud4_issue<1>(HC, ic, lane, tab);
      peer_ud4_compute<1>(HA, xqb, sub, r0, r1);
      PU_STORE(tb, r0, r1, xsb);
      peer_ud4_issue<0>(HA, id, lane, tab); PU_LDX(xqd, xsd, td); const unsigned if_ = PU_IDX(tf);
      r0 = 0; r1 = 0;
      peer_ud4_compute<0>(HB, xqc, sub, r0, r1);
      peer_ud4_issue<1>(HB, id, lane, tab);
      peer_ud4_compute<1>(HC, xqc, sub, r0, r1);
      PU_STORE(tc, r0, r1, xsc);
      ta = td; tb = te; tc = tf; ib = ie; ic = if_; xqa = xqd; xsa = xsd;
    }
  }
#undef PU_TOK
#undef PU_IDX
#undef PU_LDX
#undef PU_STORE
}

struct PUI { i32x4 a[8]; };
struct PUE { int e[8]; };

#define XB_TMO      128
#define XB_XCNT(j)  (256  + 64 * (j))
#define XB_XSUB(j)  (1280 + 64 * (j))
#define XB_XGEN(j)  (2304 + 64 * (j))
#define XB_TOP      3328
#define XB_TOPGEN   3392
#define XCD_BAR_WORDS 3456
#define XB_SPIN_CAP (1u << 20)
#define LAS __attribute__((address_space(3)))
DI unsigned xb_ld(unsigned* p)              { return __hip_atomic_load(p, __ATOMIC_RELAXED, __HIP_MEMORY_SCOPE_AGENT); }
DI unsigned xb_add(unsigned* p, unsigned v) { return __hip_atomic_fetch_add(p, v, __ATOMIC_RELAXED, __HIP_MEMORY_SCOPE_AGENT); }
DI unsigned xb_xcc_id() { return (unsigned)__builtin_amdgcn_s_getreg((3 << 11) | 20) & 0xFu; }
#define XB_SPIN(cond, bar) do { unsigned _sp = 0; while (cond) { __builtin_amdgcn_s_sleep(1); \
    if ((++_sp & 255u) == 0u) { if (xb_ld(&(bar)[XB_TMO])) break; if (_sp > XB_SPIN_CAP) { atomicAdd(&(bar)[XB_TMO], 1u); break; } } } } while (0)
struct XcdBarrier { unsigned* bar; unsigned x; volatile unsigned* st; };
DI XcdBarrier xcd_barrier_post(unsigned* bar, volatile unsigned* st) {
  XcdBarrier b; b.bar = bar; b.x = xb_xcc_id(); b.st = st;
  if (threadIdx.x == 0) (void)xb_add(&bar[XB_XCNT(b.x)], 1u);
  return b;
}
DI void xcd_barrier_complete(unsigned* bar, unsigned x, unsigned& nloc, unsigned& nx) {
  const unsigned G = gridDim.x;
  unsigned sum, cnt, mine, sp = 0u;
  for (;;) {
    sum = 0u; cnt = 0u; mine = 0u;
#pragma unroll
    for (unsigned j = 0; j < 16; ++j) { const unsigned c = xb_ld(&bar[XB_XCNT(j)]); sum += c; cnt += (c > 0u) ? 1u : 0u; mine = (j == x) ? c : mine; }
    if (sum == G) break;
    __builtin_amdgcn_s_sleep(1);
    if ((++sp & 255u) == 0u) { if (xb_ld(&bar[XB_TMO])) break; if (sp > XB_SPIN_CAP) { atomicAdd(&bar[XB_TMO], 1u); break; } }
  }
  nloc = mine > 0u ? mine : 1u; nx = cnt > 0u ? cnt : 1u;
}
DI void xcd_barrier(const XcdBarrier& b) {
  asm volatile("s_waitcnt vmcnt(0)" ::: "memory");
  __syncthreads();
  if (threadIdx.x == 0) {
    unsigned* bar = b.bar;
    __builtin_amdgcn_s_waitcnt(0);
    unsigned nloc = b.st[0], nx = b.st[1];
    if (nloc == 0u) { xcd_barrier_complete(bar, b.x, nloc, nx); b.st[0] = nloc; b.st[1] = nx; }
    const unsigned old = xb_add(&bar[XB_XSUB(b.x)], 1u);
    const unsigned gen = old / nloc;
    if (old + 1u == (gen + 1u) * nloc) {
      __builtin_amdgcn_fence(__ATOMIC_RELEASE, "agent");
      asm volatile("s_waitcnt vmcnt(0)" ::: "memory");
      const unsigned og = xb_add(&bar[XB_TOP], 1u);
      const unsigned tg = og / nx;
      if (og + 1u == (tg + 1u) * nx) xb_add(&bar[XB_TOPGEN], 1u);
      else XB_SPIN(xb_ld(&bar[XB_TOPGEN]) == tg, bar);
      __builtin_amdgcn_fence(__ATOMIC_ACQUIRE, "agent");
      xb_add(&bar[XB_XGEN(b.x)], 1u);
      asm volatile("s_waitcnt vmcnt(0)" ::: "memory");
    } else {
      XB_SPIN(xb_ld(&bar[XB_XGEN(b.x)]) == gen, bar);
      __builtin_amdgcn_fence(__ATOMIC_ACQUIRE, "agent");
      asm volatile("s_waitcnt vmcnt(0)" ::: "memory");
    }
  }
  __syncthreads();
}

struct Params {
  const float *x, *meta, *norm1_g, *w_in, *wg, *bg, *sb_g, *gla_g, *w_out, *norm2_g, *w_pq, *sk1, *sk2, *eu, *ev, *gf;
  float* out; char* ws;
};
constexpr int HALF_SMEM = 73728;
constexpr int SMEM_BYTES = 2 * HALF_SMEM;
constexpr size_t WS_BAR = 0;

__global__ void __launch_bounds__(512, 2) k_fused(Params p) {
  extern __shared__ __attribute__((aligned(16))) char smem_dyn[];
  const int half = __builtin_amdgcn_readfirstlane((int)(threadIdx.x >> 8));
  char* smem = smem_dyn + half * HALF_SMEM;
  __shared__ unsigned xb_words[4];
  if (threadIdx.x < 4) xb_words[threadIdx.x] = 0u;
  __syncthreads();
  const XcdBarrier bar = xcd_barrier_post((unsigned*)(p.ws + WS_BAR), xb_words);
  if (threadIdx.x == 0) xb_words[2] = xb_add((unsigned*)(p.ws + WS_XRANK) + bar.x, 1u);
  const int G = 2 * gridDim.x, bid = 2 * blockIdx.x + half;
  char* ws = p.ws;
  bf16_t* WinT = (bf16_t*)(ws + WS_WIN);
  bf16_t* WoutT = (bf16_t*)(ws + WS_WOUT);
  bf16_t* WpqT = (bf16_t*)(ws + WS_WPQ);
  bf16_t* EU = (bf16_t*)(ws + WS_EU);
  bf16_t* EV = (bf16_t*)(ws + WS_EV);
  bf16_t* SK1b = (bf16_t*)(ws + WS_SK1);
  bf16_t* SK2b = (bf16_t*)(ws + WS_SK2);
  bf16_t* A1 = (bf16_t*)(ws + WS_A1);
  float* GO = (float*)(ws + WS_A1);
  bf16_t* A2 = (bf16_t*)(ws + WS_A1);
  InProjOut O;
  O.QSB = (bf16_t*)(ws + WS_QSB); O.KSB = (bf16_t*)(ws + WS_KSB); O.VTSB = (bf16_t*)(ws + WS_VTSB); O.VSB = (bf16_t*)(ws + WS_VSB);
  O.GQ = (bf16_t*)(ws + WS_GQ); O.GK = (bf16_t*)(ws + WS_GK); O.GV = (bf16_t*)(ws + WS_GVT); O.GR = (bf16_t*)(ws + WS_GR);
  O.GLR = (float*)(ws + WS_GLR);
  bf16_t* H1 = (bf16_t*)(ws + WS_H1);
  float* SSQ = (float*)(ws + WS_XS + 3 * MiB);
  float* R1I = (float*)(ws + WS_XS + 4 * MiB);
  bf16_t* GVT = (bf16_t*)(ws + WS_GVT);
  GlaPtrs GP;
  GP.GQ = O.GQ; GP.GK = O.GK; GP.GVT = GVT; GP.GR = O.GR; GP.GLR = O.GLR; GP.wg = p.wg; GP.bg = p.bg; GP.gla_g = p.gla_g;
  GP.SLOC = (float*)(ws + WS_SLOC); GP.DTOT = (float*)(ws + WS_DTOT); GP.MIX = (bf16_t*)(ws + WS_MIX);
  GlaPrepPtrs GPP; GPP.GQ = O.GQ; GPP.GK = O.GK; GPP.GLR = O.GLR; GPP.wg = p.wg; GPP.bg = p.bg;
  GPP.QT = (bf16_t*)(ws + WS_GQT); GPP.KT = (bf16_t*)(ws + WS_GKT); GPP.KTT = (bf16_t*)(ws + WS_GKTT); GPP.DEC = (float*)(ws + WS_GDEC); GPP.BL = (float*)(ws + WS_GBL);
  GlaPtrs3 GP3; GP3.QT = GPP.QT; GP3.KT = GPP.KT; GP3.KTT = GPP.KTT; GP3.GVT = GVT; GP3.GR = O.GR; GP3.DEC = GPP.DEC; GP3.BL = GPP.BL; GP3.gla_g = p.gla_g;
  GP3.SLOC = GP.SLOC; GP3.DTOT = GP.DTOT; GP3.MIX = GP.MIX;
  bf16_t* MIX = (bf16_t*)(ws + WS_MIX);
  bf16_t* QP = (bf16_t*)(ws + WS_MIX);
  unsigned short* EIDX = (unsigned short*)(ws + WS_EIDX);
  bf16_t* PP = (bf16_t*)(ws + WS_PP);
  bf16_t* YT = (bf16_t*)(ws + WS_PP);
  unsigned* STREAM = (unsigned*)(ws + WS_STREAM);
  float* GATE = (float*)(ws + WS_GATE);

  for (int vb = bid; vb < 832 + 256 + 256; vb += G) {
    if (vb < 832) ph_transpose_w(vb % 104, vb / 104, smem, p.w_in, p.norm1_g, WinT, D, NIN);
    else if (vb < 1088) { const int t = vb - 832; ph_transpose_w(t % 32, t / 32, smem, p.w_out, nullptr, WoutT, D, D); }
    else { const int t = vb - 1088; ph_transpose_w(t % 32, t / 32, smem, p.w_pq, p.norm2_g, WpqT, D, D); }
  }
  ph_convert_eu_i8(p.eu, p.norm2_g, (u8_t*)EU, (float*)(ws + WS_SCU));
  for (int vb = bid; vb < NEXP / 32; vb += G) ph_convert_ev8(vb, smem, p.ev, (u8_t*)EV, (float*)(ws + WS_SCV));
  ph_convert(p.sk1, SK1b, (size_t)8 * 128 * 64 / 8);
  ph_convert(p.sk2, SK2b, (size_t)8 * 128 * 64 / 8);
  ph_zero_pads(O.KSB, O.VTSB, O.GQ, O.GK, GVT);
  for (int vb = bid; vb < TREAL / 16; vb += G) ph_norm_rows<0>(vb, p.x, R1I, A1);
  __syncthreads();
  for (int mb = blockIdx.x; mb < NIN / 16; mb += gridDim.x) ph_meta(mb, smem_dyn, p.meta, p.norm1_g, p.w_in, O);
  xcd_barrier(bar);
  {
    pg8::Gemm g{A1, WinT, TREAL, NINP, D}; pg8::StaticOrder S; S.init(TREAL, NINP, (int)gridDim.x, (int)blockIdx.x);
    EpiInProj E{O, GVT, smem_dyn + 131072};
    pg8::gemm_phase<EpiInProj, pg8::StaticOrder, true, true>((PG8_LAS unsigned char*)smem_dyn, g, S, E);
  }
  xcd_barrier(bar);
  for (int it = blockIdx.x; it < 16 * 129; it += gridDim.x) ph_gla_prep(it, smem_dyn, GPP);
  xcd_barrier(bar);
  for (int it = blockIdx.x; it < 16 * 15; it += gridDim.x) gla_item4<0>(it / 15, it % 15, smem_dyn, GP3);
  for (int vb = bid; vb < 64 * 32; vb += G) ph_sb_attn2(vb, O.QSB, O.KSB, O.VTSB, p.sb_g, MIX);
  xcd_barrier(bar);
  for (int it = blockIdx.x; it < 16 * 16; it += gridDim.x) gla_item4<1>(it >> 4, it & 15, smem_dyn, GP3);
  xcd_barrier(bar);
  {
    pg8::Gemm g{MIX, WoutT, TREAL, D, D}; pg8::StaticOrder S; S.init(TREAL, D, (int)gridDim.x, (int)blockIdx.x);
    EpiOut E{A1, R1I, H1, (u8_t*)(ws + WS_XQ), (float*)(ws + WS_XS), SSQ, (float*)(smem_dyn + 131072)};
    pg8::gemm_phase<EpiOut, pg8::StaticOrder, true, true>((PG8_LAS unsigned char*)smem_dyn, g, S, E);
  }
  xcd_barrier(bar);
  {
    pg8::Gemm g{H1, WpqT, TREAL, D, D}; pg8::StaticOrder S; S.init(TREAL, D, (int)gridDim.x, (int)blockIdx.x);
    EpiPQ E{QP, SSQ};
    pg8::gemm_phase<EpiPQ, pg8::StaticOrder, true, true>((PG8_LAS unsigned char*)smem_dyn, g, S, E);
  }
  xcd_barrier(bar);
  {
    const int NV = 8 * (TREAL / 128);
    route_stage_keys(bid & 7, smem, SK1b, SK2b);
    const int rlane = (int)(threadIdx.x & 63u), rwave = (int)((threadIdx.x >> 6) & 3u);
    bf16x8 qa[2][4], qb[2][4];
    if (bid < NV) route_load_q(qa, QP, (bid >> 3) * 128 + rwave * 32 + (rlane & 31), bid & 7, rlane >> 5);
    for (int vb = bid; vb < NV; vb += 2 * G) {
      const int v1 = vb + G, v2 = vb + 2 * G;
      if (v1 < NV) route_load_q(qb, QP, (v1 >> 3) * 128 + rwave * 32 + (rlane & 31), v1 & 7, rlane >> 5);
      ph_route_v2(vb, smem, qa, EIDX, GATE);
      if (v1 < NV) {
        if (v2 < NV) route_load_q(qa, QP, (v2 >> 3) * 128 + rwave * 32 + (rlane & 31), v2 & 7, rlane >> 5);
        ph_route_v2(v1, smem, qb, EIDX, GATE);
      }
    }
  }
  xcd_barrier(bar);
  {
    __shared__ int xinfo[4];
    if (threadIdx.x == 0) {
      unsigned* barw = (unsigned*)(p.ws + WS_BAR);
      unsigned cnt = 0, ord = 0, mine = 1;
      for (unsigned j = 0; j < 16; ++j) { const unsigned c = xb_ld(&barw[XB_XCNT(j)]); if (c > 0) { if (j < bar.x) ++ord; ++cnt; } if (j == bar.x) mine = c; }
      xinfo[0] = (int)ord; xinfo[1] = (int)cnt; xinfo[2] = (int)xb_words[2]; xinfo[3] = (int)mine;
    }
    __syncthreads();
    const int xi = xinfo[0], nx = xinfo[1], rank = xinfo[2], nloc = xinfo[3];
    const int wave = __builtin_amdgcn_readfirstlane((int)(threadIdx.x >> 6));
    ph_peer_u_d4(xi, nx, rank * 8 + wave, nloc * 8, (const u8_t*)(ws + WS_XQ), (const float*)(ws + WS_XS), (const u8_t*)EU, EIDX, PP);
  }
  xcd_barrier(bar);
  pc_stage_scales(smem_dyn, (const float*)(ws + WS_SCU), (const float*)(ws + WS_SCV));
  for (int unit = blockIdx.x; unit < TREAL / 64; unit += gridDim.x) ph_peer_c8(unit, smem_dyn, PP, EIDX, GATE, SSQ, STREAM);
  xcd_barrier(bar);
  ph_peer_v8(smem_dyn, STREAM, (const u8_t*)EV, YT);
  xcd_barrier(bar);
  for (int unit = blockIdx.x; unit < TREAL / 32; unit += gridDim.x) ph_final_lds(unit, smem_dyn, H1, YT, p.gf, p.out);
}

extern "C" void kernel_launch(void* const* d_in, const int* in_sizes, int n_in, void* d_out, int out_size, void* d_ws, size_t ws_size, hipStream_t stream) {
  static int grid = 0;
  if (grid == 0) {
    int dev = 0, cus = 0, per_cu = 0;
    hipGetDevice(&dev);
    hipDeviceGetAttribute(&cus, hipDeviceAttributeMultiprocessorCount, dev);
    hipFuncSetAttribute((const void*)k_fused, hipFuncAttributeMaxDynamicSharedMemorySize, SMEM_BYTES);
    hipOccupancyMaxActiveBlocksPerMultiprocessor(&per_cu, (const void*)k_fused, 512, SMEM_BYTES);
    if (per_cu > 1) per_cu = 1;
    if (per_cu < 1) per_cu = 1;
    grid = cus * per_cu;
  }
  hipMemsetAsync((char*)d_ws + WS_BAR, 0, 32768, stream);
  Params p{};
  p.x = (const float*)d_in[0]; p.meta = (const float*)d_in[1]; p.norm1_g = (const float*)d_in[2]; p.w_in = (const float*)d_in[3];
  p.wg = (const float*)d_in[4]; p.bg = (const float*)d_in[5]; p.sb_g = (const float*)d_in[6]; p.gla_g = (const float*)d_in[7];
  p.w_out = (const float*)d_in[8]; p.norm2_g = (const float*)d_in[9]; p.w_pq = (const float*)d_in[10]; p.sk1 = (const float*)d_in[11];
  p.sk2 = (const float*)d_in[12]; p.eu = (const float*)d_in[13]; p.ev = (const float*)d_in[14]; p.gf = (const float*)d_in[15];
  p.out = (float*)d_out; p.ws = (char*)d_ws;
  void* args[] = {&p};
  hipLaunchCooperativeKernel((const void*)k_fused, dim3(grid), dim3(512), args, SMEM_BYTES, stream);
}
```

```cpp
#include <hip/hip_runtime.h>
#include <stdint.h>
#include <stddef.h>

typedef unsigned short bf16_t;
typedef short bf16x8 __attribute__((ext_vector_type(8)));
typedef float f32x16 __attribute__((ext_vector_type(16)));
typedef float f32x4 __attribute__((ext_vector_type(4)));
typedef float f32x2 __attribute__((ext_vector_type(2)));
typedef unsigned u32x4 __attribute__((ext_vector_type(4)));
typedef unsigned u32x2 __attribute__((ext_vector_type(2)));
typedef __bf16 bf16x2_t __attribute__((ext_vector_type(2)));

#define DI __device__ __forceinline__
__device__ __forceinline__ int fresh_tid() { int t = (int)threadIdx.x; asm volatile("" : "+v"(t)); return t; }
#define TID tid256_
#define MFMA32(a, b, c) __builtin_amdgcn_mfma_f32_32x32x16_bf16((a), (b), (c), 0, 0, 0)

constexpr int D = 1024, NB = 8, SEQ = 8192, NMETA = 16;
constexpr int TREAL = NB * SEQ;
constexpr int MROWS = TREAL + 128;
constexpr int NIN = 3088, NINP = 3328;
constexpr int SBH = 8, SBD = 64;
constexpr int GH = 4, GDK = 64, GDV = 128;
constexpr int KIDX = SEQ + 32;
constexpr int GU = SEQ + 64;
constexpr int NEXP = 16384;
constexpr float EPS = 1e-6f;

constexpr size_t MiB = 1u << 20;
constexpr size_t WS_WIN = 1 * MiB;
constexpr size_t WS_WOUT = 8 * MiB;
constexpr size_t WS_WPQ = 10 * MiB;
constexpr size_t WS_SK1 = 12 * MiB;
constexpr size_t WS_SK2 = 13 * MiB;
constexpr size_t WS_EU = 16 * MiB;
constexpr size_t WS_EV = 48 * MiB;
constexpr size_t WS_A1 = 80 * MiB;
constexpr size_t WS_QSB = 210 * MiB;
constexpr size_t WS_KSB = 274 * MiB;
constexpr size_t WS_VTSB = 339 * MiB;
constexpr size_t WS_GQ = 404 * MiB;
constexpr size_t WS_GK = 437 * MiB;
constexpr size_t WS_H1 = 210 * MiB;
constexpr size_t WS_GV = 470 * MiB;
constexpr size_t WS_GR = 535 * MiB;
constexpr size_t WS_GLR = 599 * MiB;
constexpr size_t WS_LG = 604 * MiB;
constexpr size_t WS_MIX = 669 * MiB;
constexpr size_t WS_EIDX = 797 * MiB;
constexpr size_t WS_GATE = 829 * MiB;
constexpr size_t WS_PP = 470 * MiB;
constexpr size_t WS_STREAM = 726 * MiB;
constexpr size_t WS_XRANK = 16384;
constexpr size_t WS_VSB = 861 * MiB;
constexpr size_t WS_END = 926 * MiB;

DI unsigned f2bf(float f) { unsigned u = __float_as_uint(f); return (u + 0x7fffu + ((u >> 16) & 1u)) >> 16; }
DI float bf2f(unsigned b) { return __uint_as_float(b << 16); }
DI unsigned pk2(float lo, float hi) { f32x2 v = {lo, hi}; return __builtin_bit_cast(unsigned, __builtin_convertvector(v, bf16x2_t)); }
DI float bflo(unsigned u) { return __uint_as_float(u << 16); }
DI float bfhi(unsigned u) { return __uint_as_float(u & 0xffff0000u); }
DI int crow(int reg, int h) { return (reg & 3) + 8 * (reg >> 2) + 4 * h; }
DI float wave_sum(float v) {
#pragma unroll
  for (int o = 32; o >= 1; o >>= 1) v += __shfl_xor(v, o);
  return v;
}
DI float softplus(float z) { return fmaxf(z, 0.f) + __logf(1.f + __expf(-fabsf(z))); }

DI void ph_transpose_w(int bx, int by, char* smem, const float* __restrict__ W, const float* __restrict__ gain, bf16_t* __restrict__ WT, int K, int N) {
  const int tid256_ = fresh_tid() & 255;
  float (*t)[33] = (float (*)[33])smem;
  const int n0 = bx * 32, k0 = by * 128;
  {
    const int kr = TID >> 3, c4 = (TID & 7) * 4;
    f32x4 v[4];
#pragma unroll
    for (int j = 0; j < 4; ++j) v[j] = (n0 + c4 < N) ? *(const f32x4*)(W + (size_t)(k0 + kr + 32 * j) * N + n0 + c4) : (f32x4){0.f, 0.f, 0.f, 0.f};
#pragma unroll
    for (int j = 0; j < 4; ++j) {
      const float g = gain ? gain[k0 + kr + 32 * j] : 1.f;
      t[kr + 32 * j][c4 + 0] = v[j].x * g; t[kr + 32 * j][c4 + 1] = v[j].y * g; t[kr + 32 * j][c4 + 2] = v[j].z * g; t[kr + 32 * j][c4 + 3] = v[j].w * g;
    }
  }
  __syncthreads();
  {
    const int n = TID >> 3, ks = (TID & 7) * 16;
    unsigned w[8];
#pragma unroll
    for (int i = 0; i < 8; ++i) w[i] = pk2(t[ks + 2 * i][n], t[ks + 2 * i + 1][n]);
    bf16_t* dst = WT + (size_t)(n0 + n) * K + k0 + ks;
    *(u32x4*)dst = (u32x4){w[0], w[1], w[2], w[3]};
    *(u32x4*)(dst + 8) = (u32x4){w[4], w[5], w[6], w[7]};
  }
  __syncthreads();
}
DI void ph_convert(const float* __restrict__ src, bf16_t* __restrict__ dst, size_t n8) {
  size_t i = (size_t)blockIdx.x * blockDim.x + threadIdx.x;
  const size_t stride = (size_t)gridDim.x * blockDim.x;
  for (; i < n8; i += stride) {
    const f32x4 a = ((const f32x4*)src)[2 * i], b = ((const f32x4*)src)[2 * i + 1];
    u32x4 o; o.x = pk2(a.x, a.y); o.y = pk2(a.z, a.w); o.z = pk2(b.x, b.y); o.w = pk2(b.z, b.w);
    ((u32x4*)dst)[i] = o;
  }
}
DI void ph_zero_pads(bf16_t* KSB, bf16_t* VTSB, bf16_t* GQ, bf16_t* GK, bf16_t* GVT) {
  const int tid = blockIdx.x * blockDim.x + threadIdx.x, nth = gridDim.x * blockDim.x;
  for (int i = tid; i < 64 * 16 * 64; i += nth) { const int bh = i / 1024, r = i % 1024; KSB[(size_t)bh * KIDX * 64 + r] = 0; }
  for (int i = tid; i < 64 * 64 * 16; i += nth) { const int row = i / 16, c = i % 16; VTSB[(size_t)row * KIDX + c] = 0; }
  for (int i = tid; i < 32 * 48 * 64; i += nth) { const int bh = i / 3072, r = i % 3072; GQ[(size_t)bh * GU * 64 + r] = 0; GK[(size_t)bh * GU * 64 + r] = 0; }
  for (int i = tid; i < 32 * 128 * 48; i += nth) { const int row = i / 48, c = i % 48; GVT[(size_t)row * GU + c] = 0; }
}

template <int MODE>
DI void ph_norm_rows(int vb, const float* __restrict__ src, const float* __restrict__ meta, bf16_t* __restrict__ dst) {
  const int tid256_ = fresh_tid() & 255;
  const int row0 = vb * 16 + (TID >> 6) * 4, lane = TID & 63;
  f32x4 v[4][4];
#pragma unroll
  for (int rr = 0; rr < 4; ++rr)
#pragma unroll
    for (int j = 0; j < 4; ++j) v[rr][j] = *(const f32x4*)(src + (size_t)(row0 + rr) * D + j * 256 + lane * 4);
  f32x4 gg[4];
#pragma unroll
  for (int j = 0; j < 4; ++j) { gg[j] = (f32x4){1.f, 1.f, 1.f, 1.f}; if (MODE == 1) gg[j] = *(const f32x4*)(meta + j * 256 + lane * 4); }
#pragma unroll
  for (int rr = 0; rr < 4; ++rr) {
    float ss = 0.f;
#pragma unroll
    for (int j = 0; j < 4; ++j) ss += v[rr][j].x * v[rr][j].x + v[rr][j].y * v[rr][j].y + v[rr][j].z * v[rr][j].z + v[rr][j].w * v[rr][j].w;
    ss = wave_sum(ss);
    const float r = rsqrtf(ss * (1.0f / D) + EPS);
    if (MODE == 0 && lane == 0) const_cast<float*>(meta)[row0 + rr] = sqrtf(ss * (1.0f / D) + EPS);
#pragma unroll
    for (int j = 0; j < 4; ++j) {
      u32x2 o; o.x = pk2(v[rr][j].x * r * gg[j].x, v[rr][j].y * r * gg[j].y); o.y = pk2(v[rr][j].z * r * gg[j].z, v[rr][j].w * r * gg[j].w);
      *(u32x2*)(dst + (size_t)(row0 + rr) * D + j * 256 + lane * 4) = o;
    }
  }
}

namespace pg8 {
#define PG8_LAS __attribute__((address_space(3)))
typedef unsigned short bf16_t;
typedef short bf16x8 __attribute__((ext_vector_type(8)));
typedef float f32x4 __attribute__((ext_vector_type(4)));
typedef unsigned u32x4 __attribute__((ext_vector_type(4)));
constexpr int BM = 256, BK = 64, HALF = 128, HTB = HALF * BK * 2  , STAGE_BYTES = 8 * HTB, NXCD = 8, WGM = 8;

__host__ __device__ __forceinline__ int lds_byte(int r, int c) { const int st = (r >> 4) * 2 + (c >> 5), rr = r & 15, cc = c & 31, ob = rr * 64 + cc * 2; return st * 1024 + (ob ^ (((ob >> 9) & 1) << 5)); }
__host__ __device__ __forceinline__ void stage_rc(int b, int& R, int& C) { const int st = b / 1024, sb = b % 1024, swz = sb ^ (((sb >> 9) & 1) << 5); R = (st >> 1) * 16 + swz / 64; C = (st & 1) * 32 + (swz % 64) / 2; }
__host__ __device__ __forceinline__ int perm32(int rho) { const int n = rho >> 4, i = rho & 15; return 8 * (i >> 2) + 4 * n + (i & 3); }

struct Unit { int pm, pn; };
struct Gemm { const bf16_t* A; const bf16_t* Bt; int M, N, K; };

struct StaticOrder {
    int nM, nN, nwg, G, c;
    __host__ __device__ void init(int M, int N, int G_, int c_) { nM = M / BM; nN = N / BM; nwg = nM * nN; G = G_; c = c_; }
    __host__ __device__ bool next(int i, Unit& u) const {
        const long L = (long)i * G + c; if (L >= nwg) return false;
        int wgid = (int)L; { const int q = nwg / NXCD, r = nwg % NXCD, xcd = wgid % NXCD, off = wgid / NXCD; wgid = (xcd < r ? xcd * (q + 1) : r * (q + 1) + (xcd - r) * q) + off; }
        const int nig = WGM * nN, gid = wgid / nig, fm = gid * WGM, gsz = (nM - fm) < WGM ? (nM - fm) : WGM;
        u.pm = fm + ((wgid % nig) % gsz); u.pn = (wgid % nig) / gsz; return true;
    }
    __device__ __forceinline__ void a_ready(const Unit&) const {}
    __device__ __forceinline__ void done(const Unit&) const {}
};

template <class Epi, class Sched, bool ALIGN_EPI = false, bool SP2 = false>
__device__ __forceinline__ void gemm_phase(PG8_LAS unsigned char* lds, const Gemm g, const Sched& S, const Epi& E) {
    const int tid = fresh_tid(), wid = __builtin_amdgcn_readfirstlane(tid >> 6), lane = tid & 63, wr = wid >> 2, wc = wid & 3, fr = lane & 15, fq = lane >> 4;
    const int K = g.K, nt = K / BK;
    unsigned voffA[2], voffB[2];
#pragma unroll
    for (int i = 0; i < 2; ++i) { int R, C; stage_rc(tid * 16 + i * 8192, R, C); const int Rb = Epi::PERM ? ((R & ~31) + perm32(R & 31)) : R;
        voffA[i] = (unsigned)(R * K + C) * 2u; voffB[i] = (unsigned)(Rb * K + C) * 2u; }
    const size_t kstep = (size_t)(BK * 2);
    const size_t hstep = (size_t)HALF * K * 2;
    const size_t tstep = 2 * hstep;
    const unsigned ldsw = (unsigned)wid * 1024u;
    const int aoff = lds_byte(wr * 64 + fr, fq * 8), boff = lds_byte(wc * 32 + fr, fq * 8);
#define PG8_SA(b, h) (((b) * 2 + (h)) * HTB)
#define PG8_SB(b, h) ((4 + (b) * 2 + (h)) * HTB)
#define PG8_STAGE(bufoff, gbase, voff) do { _Pragma("unroll") for (int _i = 0; _i < 2; ++_i) \
        __builtin_amdgcn_global_load_lds((const unsigned*)((const char*)(gbase) + (voff)[_i]), (PG8_LAS unsigned*)(lds + (bufoff) + ldsw + _i * 8192), 16, 0, 0); } while (0)
#define PG8_LDA(dst, b, h) do { _Pragma("unroll") for (int m = 0; m < 4; ++m) _Pragma("unroll") for (int k = 0; k < 2; ++k) dst[m][k] = *(const PG8_LAS bf16x8*)(lds + PG8_SA(b, h) + aoff + m * 2048 + k * 1024); } while (0)
#define PG8_LDB(dst, b, h) do { _Pragma("unroll") for (int n = 0; n < 2; ++n) _Pragma("unroll") for (int k = 0; k < 2; ++k) dst[n][k] = *(const PG8_LAS bf16x8*)(lds + PG8_SB(b, h) + boff + n * 2048 + k * 1024); } while (0)
#define PG8_MMA(ai, bj, At, Bt) do { __builtin_amdgcn_s_setprio(1); _Pragma("unroll") for (int m = 0; m < 4; ++m) _Pragma("unroll") for (int n = 0; n < 2; ++n) _Pragma("unroll") for (int k = 0; k < 2; ++k) \
        acc[ai][bj][m][n] = __builtin_amdgcn_mfma_f32_16x16x32_bf16(Bt[n][k], At[m][k], acc[ai][bj][m][n], 0, 0, 0); __builtin_amdgcn_s_setprio(0); } while (0)
#define PG8_WAIT_V(n) asm volatile("s_waitcnt vmcnt(" #n ")" ::: "memory")
#define PG8_WAIT_L(n) asm volatile("s_waitcnt lgkmcnt(" #n ")" ::: "memory")
#define PG8_BAR __builtin_amdgcn_s_barrier()
#define PG8_SCHED __builtin_amdgcn_sched_barrier(0)
    Unit cur, nxt; int ui = 0;
    if (!S.next(0, cur)) return;
    f32x4 acc[2][2][4][2];
#pragma unroll
    for (int a = 0; a < 2; ++a)
#pragma unroll
        for (int b = 0; b < 2; ++b)
#pragma unroll
            for (int m = 0; m < 4; ++m)
#pragma unroll
                for (int n = 0; n < 2; ++n) acc[a][b][m][n] = (f32x4){0.f, 0.f, 0.f, 0.f};
    bf16x8 At[4][2], B0[2][2], B1[2][2];
    const char* cA = (const char*)g.A + (size_t)cur.pm * tstep; const char* cB = (const char*)g.Bt + (size_t)cur.pn * tstep;
    S.a_ready(cur);
    if constexpr (SP2) {
        PG8_STAGE(PG8_SB(0, 0), cB, voffB); PG8_STAGE(PG8_SB(0, 1), cB + hstep, voffB); PG8_STAGE(PG8_SA(0, 0), cA, voffA); PG8_STAGE(PG8_SA(0, 1), cA + hstep, voffA);
        if (wr == 1) PG8_BAR;
        PG8_WAIT_V(2); PG8_BAR;
        PG8_STAGE(PG8_SB(1, 0), cB + kstep, voffB); PG8_STAGE(PG8_SA(1, 0), cA + kstep, voffA); PG8_STAGE(PG8_SB(1, 1), cB + hstep + kstep, voffB);
        PG8_WAIT_V(6); PG8_BAR;
    } else {
        PG8_STAGE(PG8_SB(0, 0), cB, voffB); PG8_STAGE(PG8_SA(0, 0), cA, voffA); PG8_STAGE(PG8_SB(0, 1), cB + hstep, voffB); PG8_STAGE(PG8_SA(0, 1), cA + hstep, voffA);
        if (wr == 1) PG8_BAR;
        PG8_WAIT_V(4); PG8_BAR;
        PG8_STAGE(PG8_SB(1, 0), cB + kstep, voffB); PG8_STAGE(PG8_SA(1, 0), cA + kstep, voffA); PG8_STAGE(PG8_SB(1, 1), cB + hstep + kstep, voffB);
        PG8_WAIT_V(6); PG8_BAR;
    }
    for (;;) {
        const bool has_next = S.next(ui + 1, nxt);
        const char* nA = has_next ? (const char*)g.A + (size_t)nxt.pm * tstep : cA; const char* nB = has_next ? (const char*)g.Bt + (size_t)nxt.pn * tstep : cB;
        for (int t = 0; t < nt; t += 2) {
            const bool last = (t == nt - 2);
            const char* a1 = cA + (size_t)(t + 1) * kstep;
            const char* a2 = last ? nA : cA + (size_t)(t + 2) * kstep; const char* b2 = last ? nB : cB + (size_t)(t + 2) * kstep;
            const char* a3 = a2 + kstep; const char* b3 = b2 + kstep;
            if (last && has_next) S.a_ready(nxt);
            if constexpr (SP2) {
            PG8_LDB(B0, 0, 0); PG8_LDB(B1, 0, 1); PG8_SCHED; PG8_LDA(At, 0, 0); PG8_STAGE(PG8_SA(1, 1), a1 + hstep, voffA);
            PG8_WAIT_V(8); PG8_WAIT_L(0); PG8_BAR; PG8_MMA(0, 0, At, B0); PG8_MMA(0, 1, At, B1); PG8_BAR; PG8_SCHED;
            PG8_LDA(At, 0, 1); PG8_STAGE(PG8_SB(0, 0), b2, voffB); PG8_STAGE(PG8_SB(0, 1), b2 + hstep, voffB); PG8_STAGE(PG8_SA(0, 0), a2, voffA);
            PG8_WAIT_V(8); PG8_WAIT_L(0); PG8_BAR; PG8_MMA(1, 0, At, B0); PG8_MMA(1, 1, At, B1); PG8_BAR; PG8_SCHED;
            PG8_LDB(B0, 1, 0); PG8_LDB(B1, 1, 1); PG8_SCHED; PG8_LDA(At, 1, 0); PG8_STAGE(PG8_SA(0, 1), a2 + hstep, voffA);
            PG8_WAIT_V(8); PG8_WAIT_L(0); PG8_BAR; PG8_MMA(0, 0, At, B0); PG8_MMA(0, 1, At, B1); PG8_BAR; PG8_SCHED;
            PG8_LDA(At, 1, 1); PG8_STAGE(PG8_SB(1, 0), b3, voffB); PG8_STAGE(PG8_SB(1, 1), b3 + hstep, voffB); PG8_STAGE(PG8_SA(1, 0), a3, voffA);
            PG8_WAIT_V(8); PG8_WAIT_L(0); PG8_BAR; PG8_MMA(1, 0, At, B0); PG8_MMA(1, 1, At, B1); PG8_BAR; PG8_SCHED;
            } else {
            PG8_LDB(B0, 0, 0); PG8_SCHED; PG8_LDA(At, 0, 0); PG8_STAGE(PG8_SA(1, 1), a1 + hstep, voffA);
            PG8_WAIT_L(8); PG8_BAR; PG8_WAIT_L(0); PG8_MMA(0, 0, At, B0); PG8_BAR; PG8_SCHED;
            PG8_LDB(B1, 0, 1); PG8_STAGE(PG8_SB(0, 0), b2, voffB);
            PG8_BAR; PG8_WAIT_L(0); PG8_MMA(0, 1, At, B1); PG8_BAR;
            PG8_LDA(At, 0, 1); PG8_STAGE(PG8_SA(0, 0), a2, voffA);
            PG8_BAR; PG8_WAIT_L(0); PG8_MMA(1, 0, At, B0); PG8_BAR; PG8_SCHED;
            PG8_STAGE(PG8_SB(0, 1), b2 + hstep, voffB);
            PG8_WAIT_V(6); PG8_BAR; PG8_MMA(1, 1, At, B1); PG8_BAR;
            PG8_LDB(B0, 1, 0); PG8_SCHED; PG8_LDA(At, 1, 0); PG8_STAGE(PG8_SA(0, 1), a2 + hstep, voffA);
            PG8_WAIT_L(8); PG8_BAR; PG8_WAIT_L(0); PG8_MMA(0, 0, At, B0); PG8_BAR; PG8_SCHED;
            PG8_LDB(B1, 1, 1); PG8_STAGE(PG8_SB(1, 0), b3, voffB);
            PG8_BAR; PG8_WAIT_L(0); PG8_MMA(0, 1, At, B1); PG8_BAR;
            PG8_LDA(At, 1, 1); PG8_STAGE(PG8_SA(1, 0), a3, voffA);
            PG8_BAR; PG8_WAIT_L(0); PG8_MMA(1, 0, At, B0); PG8_BAR; PG8_SCHED;
            PG8_STAGE(PG8_SB(1, 1), b3 + hstep, voffB);
            PG8_WAIT_V(6); PG8_BAR; PG8_MMA(1, 1, At, B1); PG8_BAR;
            }
        }
        if constexpr (ALIGN_EPI) { if (wr == 0) PG8_BAR; }
        if constexpr (!Epi::AFTER_DRAIN) { E(acc, cur, wr, wc, fr, fq); S.done(cur); }
        if (!has_next) break;
#pragma unroll
        for (int a = 0; a < 2; ++a)
#pragma unroll
            for (int b = 0; b < 2; ++b)
#pragma unroll
                for (int m = 0; m < 4; ++m)
#pragma unroll
                    for (int n = 0; n < 2; ++n) acc[a][b][m][n] = (f32x4){0.f, 0.f, 0.f, 0.f};
        cur = nxt; cA = nA; cB = nB; ++ui;
        if constexpr (ALIGN_EPI) { if (wr == 1) PG8_BAR; }
    }
    PG8_WAIT_V(0);
    if constexpr (!ALIGN_EPI) { if (wr == 0) PG8_BAR; }
    PG8_BAR;
    if constexpr (Epi::AFTER_DRAIN) { E.fused(acc, cur, wr, wc, fr, fq, lds, wid, lane); S.done(cur); }
#undef PG8_SA
#undef PG8_SB
#undef PG8_STAGE
#undef PG8_LDA
#undef PG8_LDB
#undef PG8_MMA
#undef PG8_WAIT_V
#undef PG8_WAIT_L
#undef PG8_BAR
#undef PG8_SCHED
}
}

struct InProjOut { bf16_t *QSB, *KSB, *VSB, *VTSB, *GQ, *GK, *GV, *GR; float* GLR; };

struct EpiInProj {
  static constexpr bool PERM = true, AFTER_DRAIN = false;
  InProjOut O; bf16_t* GVT; char* stage;
  DI void store_vt(const pg8::f32x4 (&acc)[2][2][4][2], const pg8::Unit& u, int wr, int wc, int fr, int fq) const {
    bf16_t* st = (bf16_t*)(stage + (wr * 4 + wc) * 1280);
    const int lane = fr + 16 * fq;
    const int rc = lane >> 2, r8 = lane & 3;
#pragma unroll
    for (int ai = 0; ai < 2; ++ai)
#pragma unroll
      for (int bj = 0; bj < 2; ++bj)
#pragma unroll
        for (int mp = 0; mp < 2; ++mp)
#pragma unroll
          for (int ch = 0; ch < 2; ++ch) {
            if ((fq >> 1) == ch) {
#pragma unroll
              for (int m2 = 0; m2 < 2; ++m2)
#pragma unroll
                for (int n = 0; n < 2; ++n) {
                  const pg8::f32x4 v = acc[ai][bj][2 * mp + m2][n];
                  const int cl = 8 * (fq & 1) + 4 * n, rl = 16 * m2 + fr;
                  st[(cl + 0) * 40 + rl] = (bf16_t)f2bf(v[0]); st[(cl + 1) * 40 + rl] = (bf16_t)f2bf(v[1]);
                  st[(cl + 2) * 40 + rl] = (bf16_t)f2bf(v[2]); st[(cl + 3) * 40 + rl] = (bf16_t)f2bf(v[3]);
                }
            }
            asm volatile("s_waitcnt lgkmcnt(0)" ::: "memory");
            const u32x4 w = *(const u32x4*)&st[rc * 40 + 8 * r8];
            asm volatile("" ::: "memory");
            const int col = u.pn * 256 + bj * 128 + wc * 32 + 16 * ch + rc;
            const int row = u.pm * 256 + ai * 128 + wr * 64 + 32 * mp + 8 * r8;
            const int b = row >> 13, i = row & 8191;
            bf16_t* dst;
            if (u.pn < 6) { const int c = col - 1024; dst = O.VTSB + ((size_t)(b * SBH + (c >> 6)) * 64 + (c & 63)) * KIDX + 32 + i; }
            else          { const int c = col - 2048; dst = GVT + ((size_t)(b * GH + (c >> 7)) * 128 + (c & 127)) * GU + 64 + i; }
            *(u32x4*)dst = w;
          }
  }
  DI void operator()(const pg8::f32x4 (&acc)[2][2][4][2], const pg8::Unit& u, int wr, int wc, int fr, int fq) const {
    const int pn = u.pn;
    if (pn == 4 || pn == 5 || pn == 8 || pn == 9) { store_vt(acc, u, wr, wc, fr, fq); return; }
#pragma unroll
    for (int ai = 0; ai < 2; ++ai)
#pragma unroll
      for (int m = 0; m < 4; ++m) {
        const int row = u.pm * 256 + ai * 128 + wr * 64 + m * 16 + fr;
        const int b = row >> 13, i = row & 8191;
#pragma unroll
        for (int bj = 0; bj < 2; ++bj) {
          const int col = pn * 256 + bj * 128 + wc * 32 + 8 * fq;
          const pg8::f32x4 v0 = acc[ai][bj][m][0], v1 = acc[ai][bj][m][1];
          if (pn < 12) {
            u32x4 w; w.x = pk2(v0[0], v0[1]); w.y = pk2(v0[2], v0[3]); w.z = pk2(v1[0], v1[1]); w.w = pk2(v1[2], v1[3]);
            bf16_t* dst;
            if (pn < 2)       { const int c = col;        dst = O.QSB + ((size_t)(b * SBH + (c >> 6)) * SEQ + i) * 64 + (c & 63); }
            else if (pn < 4)  { const int c = col - 512;  dst = O.KSB + ((size_t)(b * SBH + (c >> 6)) * KIDX + 32 + i) * 64 + (c & 63); }
            else if (pn == 6) { const int c = col - 1536; dst = O.GQ + ((size_t)(b * GH + (c >> 6)) * GU + 64 + i) * 64 + (c & 63); }
            else if (pn == 7) { const int c = col - 1792; dst = O.GK + ((size_t)(b * GH + (c >> 6)) * GU + 64 + i) * 64 + (c & 63); }
            else              { const int c = col - 2560; dst = O.GR + (size_t)row * 512 + c; }
            *(u32x4*)dst = w;
          } else if (col < NIN) {
            float* dst = O.GLR + ((size_t)b * GU + 64 + i) * 16 + (col - 3072);
            *(f32x4*)dst = (f32x4){v0[0], v0[1], v0[2], v0[3]};
            *(f32x4*)(dst + 4) = (f32x4){v1[0], v1[1], v1[2], v1[3]};
          }
        }
      }
  }
};
typedef unsigned char u8_t;
DI unsigned pack_i8x4(float a, float b, float c, float d);
struct EpiOut {
  static constexpr bool PERM = true, AFTER_DRAIN = false;
  const bf16_t* A1; const float* R1I; bf16_t* H1;
  u8_t* XQ; float* XS; float* SSQ; float* xch;
  DI void operator()(const pg8::f32x4 (&acc_)[2][2][4][2], const pg8::Unit& u, int wr, int wc, int fr, int fq) const {
    pg8::f32x4 (&acc)[2][2][4][2] = const_cast<pg8::f32x4 (&)[2][2][4][2]>(acc_);
    float* xa = xch;
    float* xs = xch + 2048;
#pragma unroll
    for (int ai = 0; ai < 2; ++ai)
#pragma unroll
      for (int m = 0; m < 4; ++m) {
        const int row = u.pm * 256 + ai * 128 + wr * 64 + m * 16 + fr;
        const size_t rowoff = (size_t)row * D;
        const float ri = R1I[row];
        float ss = 0.f;
#pragma unroll
        for (int bj = 0; bj < 2; ++bj) {
          const size_t idx = rowoff + u.pn * 256 + bj * 128 + wc * 32 + 8 * fq;
          const u32x4 aw = *(const u32x4*)(A1 + idx);
          const pg8::f32x4 v0 = acc[ai][bj][m][0], v1 = acc[ai][bj][m][1];
          pg8::f32x4 h0, h1;
          h0[0] = bflo(aw.x) * ri + v0[0]; h0[1] = bfhi(aw.x) * ri + v0[1]; h0[2] = bflo(aw.y) * ri + v0[2]; h0[3] = bfhi(aw.y) * ri + v0[3];
          h1[0] = bflo(aw.z) * ri + v1[0]; h1[1] = bfhi(aw.z) * ri + v1[1]; h1[2] = bflo(aw.w) * ri + v1[2]; h1[3] = bfhi(aw.w) * ri + v1[3];
          u32x4 w; w.x = pk2(h0[0], h0[1]); w.y = pk2(h0[2], h0[3]); w.z = pk2(h1[0], h1[1]); w.w = pk2(h1[2], h1[3]);
          *(u32x4*)(H1 + idx) = w;
          acc[ai][bj][m][0] = h0; acc[ai][bj][m][1] = h1;
          ss += h0[0] * h0[0] + h0[1] * h0[1] + h0[2] * h0[2] + h0[3] * h0[3] + h1[0] * h1[0] + h1[1] * h1[1] + h1[2] * h1[2] + h1[3] * h1[3];
          float am = fmaxf(fmaxf(fmaxf(fabsf(h0[0]), fabsf(h0[1])), fmaxf(fabsf(h0[2]), fabsf(h0[3]))), fmaxf(fmaxf(fabsf(h1[0]), fabsf(h1[1])), fmaxf(fabsf(h1[2]), fabsf(h1[3]))));
          am = fmaxf(am, __shfl_xor(am, 16)); am = fmaxf(am, __shfl_xor(am, 32));
          if (fq == 0) xa[((((wr * 2 + ai) * 4 + m) * 2 + bj) * 16 + fr) * 4 + wc] = am;
        }
        ss += __shfl_xor(ss, 16); ss += __shfl_xor(ss, 32);
        if (fq == 0) xs[(((wr * 2 + ai) * 4 + m) * 16 + fr) * 4 + wc] = ss;
      }
    asm volatile("s_waitcnt lgkmcnt(0)\n\ts_barrier" ::: "memory");
#pragma unroll
    for (int ai = 0; ai < 2; ++ai)
#pragma unroll
      for (int m = 0; m < 4; ++m) {
        const int row = u.pm * 256 + ai * 128 + wr * 64 + m * 16 + fr;
#pragma unroll
        for (int bj = 0; bj < 2; ++bj) {
          const f32x4 pm = *(const f32x4*)&xa[((((wr * 2 + ai) * 4 + m) * 2 + bj) * 16 + fr) * 4];
          const float M = fmaxf(fmaxf(pm.x, pm.y), fmaxf(pm.z, pm.w));
          const float inv = M > 0.f ? 127.0f / M : 0.f;
          const pg8::f32x4 h0 = acc[ai][bj][m][0], h1 = acc[ai][bj][m][1];
          u32x2 q;
          q.x = pack_i8x4(h0[0] * inv, h0[1] * inv, h0[2] * inv, h0[3] * inv);
          q.y = pack_i8x4(h1[0] * inv, h1[1] * inv, h1[2] * inv, h1[3] * inv);
          *(u32x2*)(XQ + (size_t)row * D + u.pn * 256 + bj * 128 + wc * 32 + 8 * fq) = q;
          if (wc == 0 && fq == 0) XS[(size_t)row * 8 + 2 * u.pn + bj] = M * (1.0f / 127.0f);
        }
        if (wc == 0 && fq == 0) {
          const f32x4 ps = *(const f32x4*)&xs[(((wr * 2 + ai) * 4 + m) * 16 + fr) * 4];
          SSQ[(size_t)u.pn * TREAL + row] = (ps.x + ps.y) + (ps.z + ps.w);
        }
      }
  }
};
struct EpiPQ {
  static constexpr bool PERM = true, AFTER_DRAIN = false;
  bf16_t* QP; const float* SSQ;
  DI void operator()(const pg8::f32x4 (&acc)[2][2][4][2], const pg8::Unit& u, int wr, int wc, int fr, int fq) const {
#pragma unroll
    for (int ai = 0; ai < 2; ++ai)
#pragma unroll
      for (int m = 0; m < 4; ++m) {
        const int row = u.pm * 256 + ai * 128 + wr * 64 + m * 16 + fr;
        const float r = rsqrtf(((SSQ[row] + SSQ[TREAL + row]) + (SSQ[2 * TREAL + row] + SSQ[3 * TREAL + row])) * (1.0f / D) + EPS);
        const size_t rowoff = (size_t)row * D;
#pragma unroll
        for (int bj = 0; bj < 2; ++bj) {
          const pg8::f32x4 v0 = acc[ai][bj][m][0], v1 = acc[ai][bj][m][1];
          u32x4 w; w.x = pk2(v0[0] * r, v0[1] * r); w.y = pk2(v0[2] * r, v0[3] * r); w.z = pk2(v1[0] * r, v1[1] * r); w.w = pk2(v1[2] * r, v1[3] * r);
          *(u32x4*)(QP + rowoff + u.pn * 256 + bj * 128 + wc * 32 + 8 * fq) = w;
        }
      }
  }
};

DI void ph_meta(int blk, char* smem, const float* __restrict__ meta, const float* __restrict__ g1, const float* __restrict__ w_in, const InProjOut& O) {
  float (*xmT)[16] = (float (*)[16])smem;
  float (*red)[256] = (float (*)[256])(smem + 65536);
  const int tid = fresh_tid(), lane = tid & 63, wave = tid >> 6;
  for (int rr = 0; rr < 2; ++rr) {
    const int mm = wave * 2 + rr;
    float v[16]; float ss = 0.f;
#pragma unroll
    for (int j = 0; j < 16; ++j) { v[j] = meta[(size_t)mm * D + j * 64 + lane]; ss += v[j] * v[j]; }
    ss = wave_sum(ss);
    const float r = rsqrtf(ss * (1.0f / D) + EPS);
#pragma unroll
    for (int j = 0; j < 16; ++j) xmT[j * 64 + lane][mm] = v[j] * r * g1[j * 64 + lane];
  }
  __syncthreads();
  {
    const int c = tid & 15, ks = tid >> 4, n = blk * 16 + c;
    float acc[16];
#pragma unroll
    for (int j = 0; j < 16; ++j) acc[j] = 0.f;
#pragma unroll 8
    for (int kk = 0; kk < 32; ++kk) {
      const int k = ks * 32 + kk;
      const float w = w_in[(size_t)k * NIN + n];
      const f32x4 a = *(const f32x4*)&xmT[k][0], b4 = *(const f32x4*)&xmT[k][4], c4 = *(const f32x4*)&xmT[k][8], d4 = *(const f32x4*)&xmT[k][12];
      acc[0] += a.x * w; acc[1] += a.y * w; acc[2] += a.z * w; acc[3] += a.w * w;
      acc[4] += b4.x * w; acc[5] += b4.y * w; acc[6] += b4.z * w; acc[7] += b4.w * w;
      acc[8] += c4.x * w; acc[9] += c4.y * w; acc[10] += c4.z * w; acc[11] += c4.w * w;
      acc[12] += d4.x * w; acc[13] += d4.y * w; acc[14] += d4.z * w; acc[15] += d4.w * w;
    }
#pragma unroll
    for (int mm = 0; mm < 16; ++mm) red[ks][c * 16 + mm] = acc[mm];
  }
  __syncthreads();
  if (tid < 256) {
    const int c = tid >> 4, mm = tid & 15, n = blk * 16 + c;
    float val = 0.f;
#pragma unroll 8
    for (int ks = 0; ks < 32; ++ks) val += red[ks][tid];
    const bf16_t hv = (bf16_t)f2bf(val);
    for (int bb = 0; bb < NB; ++bb) {
      if (n < 512) {}
      else if (n < 1024) { const int cc = n - 512;  O.KSB[((size_t)(bb * SBH + (cc >> 6)) * KIDX + 16 + mm) * 64 + (cc & 63)] = hv; }
      else if (n < 1536) { const int cc = n - 1024; O.VTSB[((size_t)(bb * SBH + (cc >> 6)) * 64 + (cc & 63)) * KIDX + 16 + mm] = hv; }
      else if (n < 1792) { const int cc = n - 1536; O.GQ[((size_t)(bb * GH + (cc >> 6)) * GU + 48 + mm) * 64 + (cc & 63)] = hv; }
      else if (n < 2048) { const int cc = n - 1792; O.GK[((size_t)(bb * GH + (cc >> 6)) * GU + 48 + mm) * 64 + (cc & 63)] = hv; }
      else if (n < 2560) { const int cc = n - 2048; O.GV[((size_t)(bb * GH + (cc >> 7)) * 128 + (cc & 127)) * GU + 48 + mm] = hv; }
      else if (n < 3072) {}
      else { O.GLR[((size_t)bb * GU + 48 + mm) * 16 + (n - 3072)] = val; }
    }
  }
  __syncthreads();
}


constexpr float SB_THR = 5.421010862e-20f;
DI void ph_sb_attn(int vb, const bf16_t* __restrict__ QSB, const bf16_t* __restrict__ KSB, const bf16_t* __restrict__ VTSB,
                                                 const float* __restrict__ sb_g, bf16_t* __restrict__ MIX) {
  const int tid256_ = fresh_tid() & 255;
  const int lane = TID & 63, wave = TID >> 6, r = lane & 31, h = lane >> 5;
  const int bh = vb >> 6, qb = vb & 63;
  const int b = bh >> 3, hd = bh & 7;
  const int i0 = qb * 128 + wave * 32;
  const bf16_t* Qb = QSB + ((size_t)bh * SEQ + i0) * 64;
  const bf16_t* Kb = KSB + (size_t)bh * KIDX * 64;
  const bf16_t* Vb = VTSB + (size_t)bh * 64 * KIDX;
  bf16x8 qf[4];
#pragma unroll
  for (int ks = 0; ks < 4; ++ks) qf[ks] = *(const bf16x8*)(Qb + r * 64 + ks * 16 + h * 8);
  f32x16 o[2];
#pragma unroll
  for (int e = 0; e < 16; ++e) { o[0][e] = 0.f; o[1][e] = 0.f; }
  float R = 1.f;
  const int qidx = 32 + i0 + r;
  for (int c = (i0 >> 5) + 1; c >= 0; --c) {
    const int k0 = 32 * c;
    bf16x8 kf[4];
#pragma unroll
    for (int ks = 0; ks < 4; ++ks) kf[ks] = *(const bf16x8*)(Kb + (size_t)(k0 + r) * 64 + ks * 16 + h * 8);
    bf16x8 vf[2][2];
#pragma unroll
    for (int mt = 0; mt < 2; ++mt)
#pragma unroll
      for (int s2 = 0; s2 < 2; ++s2) {
        const bf16_t* vp = Vb + (size_t)(mt * 32 + r) * KIDX + k0 + 16 * s2 + 4 * h;
        const u32x2 lo = *(const u32x2*)vp, hi = *(const u32x2*)(vp + 8);
        u32x4 t; t.x = lo.x; t.y = lo.y; t.z = hi.x; t.w = hi.y;
        vf[mt][s2] = __builtin_bit_cast(bf16x8, t);
      }
    f32x16 s;
#pragma unroll
    for (int e = 0; e < 16; ++e) s[e] = 0.f;
#pragma unroll
    for (int ks = 0; ks < 4; ++ks) s = MFMA32(kf[ks], qf[ks], s);
    float om[16], bt[16];
#pragma unroll
    for (int e = 0; e < 16; ++e) {
      const int kidx = k0 + crow(e, h);
      const bool valid = (kidx < qidx) && (kidx >= 16);
      const float z = s[e] * 0.125f;
      const float ez = __expf(-fabsf(z));
      const float big = __builtin_amdgcn_rcpf(1.f + ez), small = ez * big;
      const float beta = z >= 0.f ? big : small, onem = z >= 0.f ? small : big;
      om[e] = valid ? onem : 1.f;
      bt[e] = valid ? beta : 0.f;
    }
    float sfx[16], G[4], PG[4];
#pragma unroll
    for (int g = 0; g < 4; ++g) {
      sfx[4 * g + 3] = 1.f;
      sfx[4 * g + 2] = om[4 * g + 3];
      sfx[4 * g + 1] = sfx[4 * g + 2] * om[4 * g + 2];
      sfx[4 * g + 0] = sfx[4 * g + 1] * om[4 * g + 1];
      G[g] = sfx[4 * g + 0] * om[4 * g + 0];
      PG[g] = __shfl_xor(G[g], 32);
    }
    float HS[4];
    HS[3] = 1.f;
    HS[2] = G[3] * PG[3];
    HS[1] = HS[2] * (G[2] * PG[2]);
    HS[0] = HS[1] * (G[1] * PG[1]);
    const float total = HS[0] * (G[0] * PG[0]);
    float a[16];
#pragma unroll
    for (int e = 0; e < 16; ++e) {
      const int g = e >> 2;
      const float between = sfx[e] * (h == 0 ? PG[g] : 1.f) * (HS[g] * R);
      a[e] = bt[e] * between;
    }
    R *= total;
#pragma unroll
    for (int s2 = 0; s2 < 2; ++s2) {
      u32x4 p;
      p.x = pk2(a[8 * s2 + 0], a[8 * s2 + 1]); p.y = pk2(a[8 * s2 + 2], a[8 * s2 + 3]);
      p.z = pk2(a[8 * s2 + 4], a[8 * s2 + 5]); p.w = pk2(a[8 * s2 + 6], a[8 * s2 + 7]);
      const bf16x8 pf = __builtin_bit_cast(bf16x8, p);
      o[0] = MFMA32(vf[0][s2], pf, o[0]);
      o[1] = MFMA32(vf[1][s2], pf, o[1]);
    }
    if (__all(R < SB_THR)) break;
  }
  float ss = 0.f;
#pragma unroll
  for (int e = 0; e < 16; ++e) ss += o[0][e] * o[0][e] + o[1][e] * o[1][e];
  ss += __shfl_xor(ss, 32);
  const float sc = rsqrtf(ss * (1.0f / 64.0f) + EPS);
  bf16_t* outp = MIX + (size_t)(b * SEQ + i0 + r) * D + hd * 64;
#pragma unroll
  for (int mt = 0; mt < 2; ++mt)
#pragma unroll
    for (int g = 0; g < 4; ++g) {
      const int d = mt * 32 + 8 * g + 4 * h;
      const f32x4 gg = *(const f32x4*)(sb_g + hd * 64 + d);
      u32x2 pk;
      pk.x = pk2(o[mt][4 * g] * sc * gg.x, o[mt][4 * g + 1] * sc * gg.y);
      pk.y = pk2(o[mt][4 * g + 2] * sc * gg.z, o[mt][4 * g + 3] * sc * gg.w);
      *(u32x2*)(outp + d) = pk;
    }
}


DI void sb_tile_step(const f32x16& s, int k0, int qidx, int h, float& R, const bf16x8 (&vf)[2][2], f32x16 (&o)[2]) {
  float om[16], bt[16];
#pragma unroll
  for (int e = 0; e < 16; ++e) {
    const int kidx = k0 + crow(e, h);
    const bool valid = (kidx < qidx) && (kidx >= 16);
    const float z = s[e] * 0.125f;
    const float ez = __expf(-fabsf(z));
    const float big = __builtin_amdgcn_rcpf(1.f + ez), small = ez * big;
    const float beta = z >= 0.f ? big : small, onem = z >= 0.f ? small : big;
    om[e] = valid ? onem : 1.f;
    bt[e] = valid ? beta : 0.f;
  }
  float sfx[16], G[4], PG[4];
#pragma unroll
  for (int g = 0; g < 4; ++g) {
    sfx[4 * g + 3] = 1.f;
    sfx[4 * g + 2] = om[4 * g + 3];
    sfx[4 * g + 1] = sfx[4 * g + 2] * om[4 * g + 2];
    sfx[4 * g + 0] = sfx[4 * g + 1] * om[4 * g + 1];
    G[g] = sfx[4 * g + 0] * om[4 * g + 0];
    PG[g] = __shfl_xor(G[g], 32);
  }
  float HS[4];
  HS[3] = 1.f; HS[2] = G[3] * PG[3]; HS[1] = HS[2] * (G[2] * PG[2]); HS[0] = HS[1] * (G[1] * PG[1]);
  const float total = HS[0] * (G[0] * PG[0]);
  float a[16];
#pragma unroll
  for (int e = 0; e < 16; ++e) { const int g = e >> 2; a[e] = bt[e] * (sfx[e] * (h == 0 ? PG[g] : 1.f) * (HS[g] * R)); }
  R *= total;
#pragma unroll
  for (int s2 = 0; s2 < 2; ++s2) {
    u32x4 p;
    p.x = pk2(a[8 * s2 + 0], a[8 * s2 + 1]); p.y = pk2(a[8 * s2 + 2], a[8 * s2 + 3]);
    p.z = pk2(a[8 * s2 + 4], a[8 * s2 + 5]); p.w = pk2(a[8 * s2 + 6], a[8 * s2 + 7]);
    const bf16x8 pf = __builtin_bit_cast(bf16x8, p);
    o[0] = MFMA32(vf[0][s2], pf, o[0]);
    o[1] = MFMA32(vf[1][s2], pf, o[1]);
  }
}
DI void sb_tile_out(const f32x16 (&o)[2], int h, const float* __restrict__ sb_gh, bf16_t* __restrict__ outp) {
  float ss = 0.f;
#pragma unroll
  for (int e = 0; e < 16; ++e) ss += o[0][e] * o[0][e] + o[1][e] * o[1][e];
  ss += __shfl_xor(ss, 32);
  const float sc = rsqrtf(ss * (1.0f / 64.0f) + EPS);
#pragma unroll
  for (int mt = 0; mt < 2; ++mt)
#pragma unroll
    for (int g = 0; g < 4; ++g) {
      const int d = mt * 32 + 8 * g + 4 * h;
      const f32x4 gg = *(const f32x4*)(sb_gh + d);
      u32x2 pk;
      pk.x = pk2(o[mt][4 * g] * sc * gg.x, o[mt][4 * g + 1] * sc * gg.y);
      pk.y = pk2(o[mt][4 * g + 2] * sc * gg.z, o[mt][4 * g + 3] * sc * gg.w);
      *(u32x2*)(outp + d) = pk;
    }
}
DI void ph_sb_attn2(int vb, const bf16_t* __restrict__ QSB, const bf16_t* __restrict__ KSB, const bf16_t* __restrict__ VTSB,
                    const float* __restrict__ sb_g, bf16_t* __restrict__ MIX) {
  const int tid256_ = fresh_tid() & 255;
  const int lane = TID & 63, wave = TID >> 6, r = lane & 31, h = lane >> 5;
  const int bh = vb >> 5, qb = vb & 31;
  const int b = bh >> 3, hd = bh & 7;
  const int i0 = qb * 256 + wave * 64;
  const bf16_t* Qb = QSB + ((size_t)bh * SEQ + i0) * 64;
  const bf16_t* Kb = KSB + (size_t)bh * KIDX * 64;
  const bf16_t* Vb = VTSB + (size_t)bh * 64 * KIDX;
  bf16x8 qfA[4], qfB[4];
#pragma unroll
  for (int ks = 0; ks < 4; ++ks) { qfA[ks] = *(const bf16x8*)(Qb + r * 64 + ks * 16 + h * 8); qfB[ks] = *(const bf16x8*)(Qb + (32 + r) * 64 + ks * 16 + h * 8); }
  f32x16 oA[2], oB[2];
#pragma unroll
  for (int e = 0; e < 16; ++e) { oA[0][e] = 0.f; oA[1][e] = 0.f; oB[0][e] = 0.f; oB[1][e] = 0.f; }
  float RA = 1.f, RB = 1.f;
  const int qidxA = 32 + i0 + r, qidxB = qidxA + 32;
  for (int c = (i0 >> 5) + 2; c >= 0; --c) {
    const int k0 = 32 * c;
    bf16x8 kf[4];
#pragma unroll
    for (int ks = 0; ks < 4; ++ks) kf[ks] = *(const bf16x8*)(Kb + (size_t)(k0 + r) * 64 + ks * 16 + h * 8);
    bf16x8 vf[2][2];
#pragma unroll
    for (int mt = 0; mt < 2; ++mt)
#pragma unroll
      for (int s2 = 0; s2 < 2; ++s2) {
        const bf16_t* vp = Vb + (size_t)(mt * 32 + r) * KIDX + k0 + 16 * s2 + 4 * h;
        const u32x2 lo = *(const u32x2*)vp, hi = *(const u32x2*)(vp + 8);
        u32x4 t; t.x = lo.x; t.y = lo.y; t.z = hi.x; t.w = hi.y;
        vf[mt][s2] = __builtin_bit_cast(bf16x8, t);
      }
    f32x16 sA, sB;
#pragma unroll
    for (int e = 0; e < 16; ++e) { sA[e] = 0.f; sB[e] = 0.f; }
#pragma unroll
    for (int ks = 0; ks < 4; ++ks) { sA = MFMA32(kf[ks], qfA[ks], sA); sB = MFMA32(kf[ks], qfB[ks], sB); }
    sb_tile_step(sB, k0, qidxB, h, RB, vf, oB);
    sb_tile_step(sA, k0, qidxA, h, RA, vf, oA);
    if (__all(RA < SB_THR && RB < SB_THR)) break;
  }
  sb_tile_out(oA, h, sb_g + hd * 64, MIX + (size_t)(b * SEQ + i0 + r) * D + hd * 64);
  sb_tile_out(oB, h, sb_g + hd * 64, MIX + (size_t)(b * SEQ + i0 + 32 + r) * D + hd * 64);
}


constexpr int RT_TOK_PER_BLOCK = 256;


#define MFMA16(a, b, c) __builtin_amdgcn_mfma_f32_16x16x32_bf16((a), (b), (c), 0, 0, 0)
constexpr int GLDS = 72;
struct GlaLds {
  bf16_t Qt[64 * GLDS];
  bf16_t Kt[64 * GLDS];
  bf16_t KT[64 * GLDS];
  bf16_t P[64 * GLDS];
  float dec[64];
  float tot[8][64];
  float ssq[8][64];
};
constexpr size_t WS_SLOC = 926 * MiB;
constexpr size_t WS_DTOT = 942 * MiB;
constexpr size_t WS_GVT = 604 * MiB;

struct GlaPtrs { const bf16_t *GQ, *GK, *GVT, *GR; const float *GLR, *wg, *bg, *gla_g; float *SLOC, *DTOT; bf16_t* MIX; };


constexpr size_t WS_GQT = 470 * MiB;
constexpr size_t WS_GKT = 502 * MiB + 512 * 1024;
constexpr size_t WS_GKTT = 861 * MiB;
constexpr size_t WS_GDEC = 894 * MiB;
constexpr size_t WS_GBL = 896 * MiB;
struct GlaPrepPtrs { const bf16_t *GQ, *GK; const float *GLR, *wg, *bg; bf16_t *QT, *KT, *KTT; float *DEC, *BL; };
DI void ph_gla_prep(int pair, char* smem, const GlaPrepPtrs& G) {
  const int tid = fresh_tid(), lane = tid & 63, w = tid >> 6, hb = w >> 2, w4 = w & 3;
  float (*tot)[64] = (float (*)[64])(smem + hb * 1024);
  const int item = 2 * pair + hb;
  const int bh = item / 129, c = item % 129, b = bh >> 2, hd = bh & 3, u0 = 64 * c;
  float wgr[16];
#pragma unroll
  for (int k = 0; k < 16; ++k) wgr[k] = G.wg[k * 256 + hd * 64 + lane];
  const float bgv = G.bg[hd * 64 + lane];
  float cs[16]; float run = 0.f;
  unsigned short kraw[16], qraw[16];
#pragma unroll
  for (int i = 0; i < 16; ++i) {
    const int u = u0 + 16 * w4 + i;
    kraw[i] = G.GK[((size_t)bh * GU + u) * 64 + lane];
    qraw[i] = G.GQ[((size_t)bh * GU + u) * 64 + lane];
  }
#pragma unroll
  for (int i = 0; i < 16; ++i) {
    const int u = u0 + 16 * w4 + i;
    float lgv = 0.f;
    if (u >= 48) {
      const f32x4* gp = (const f32x4*)(G.GLR + ((size_t)b * GU + u) * 16);
      const f32x4 g0 = gp[0], g1 = gp[1], g2 = gp[2], g3 = gp[3];
      float a = bgv;
      a += g0.x * wgr[0] + g0.y * wgr[1] + g0.z * wgr[2] + g0.w * wgr[3];
      a += g1.x * wgr[4] + g1.y * wgr[5] + g1.z * wgr[6] + g1.w * wgr[7];
      a += g2.x * wgr[8] + g2.y * wgr[9] + g2.z * wgr[10] + g2.w * wgr[11];
      a += g3.x * wgr[12] + g3.y * wgr[13] + g3.z * wgr[14] + g3.w * wgr[15];
      lgv = -softplus(-a) * (1.0f / 16.0f);
    }
    run += lgv; cs[i] = run;
  }
  tot[w4][lane] = run;
  __syncthreads();
  float offset = 0.f, total = 0.f;
#pragma unroll
  for (int s2 = 0; s2 < 4; ++s2) { const float tv = tot[s2][lane]; total += tv; if (s2 < w4) offset += tv; }
  const size_t cb = ((size_t)bh * 129 + c) * 4096;
  float kt[16];
#pragma unroll
  for (int i = 0; i < 16; ++i) {
    const float bc = offset + cs[i];
    kt[i] = bf2f(kraw[i]) * __expf(-bc);
    G.QT[cb + (16 * w4 + i) * 64 + lane] = (bf16_t)f2bf(bf2f(qraw[i]) * __expf(bc) * 0.125f);
    G.KT[cb + (16 * w4 + i) * 64 + lane] = (bf16_t)f2bf(kt[i]);
  }
  u32x4 kp; kp.x = pk2(kt[0], kt[1]); kp.y = pk2(kt[2], kt[3]); kp.z = pk2(kt[4], kt[5]); kp.w = pk2(kt[6], kt[7]);
  *(u32x4*)(G.KTT + cb + lane * 64 + 16 * w4) = kp;
  kp.x = pk2(kt[8], kt[9]); kp.y = pk2(kt[10], kt[11]); kp.z = pk2(kt[12], kt[13]); kp.w = pk2(kt[14], kt[15]);
  *(u32x4*)(G.KTT + cb + lane * 64 + 16 * w4 + 8) = kp;
  if (w4 == 0) { G.DEC[((size_t)bh * 129 + c) * 64 + lane] = __expf(total); G.BL[((size_t)bh * 129 + c) * 64 + lane] = total; }
  __syncthreads();
}

struct GlaBuf { bf16_t Qt[64 * GLDS]; bf16_t Kt[64 * GLDS]; bf16_t KT[64 * GLDS]; };
struct GlaLds3 { GlaBuf B[2]; bf16_t P[64 * GLDS]; float ssq[8][64]; };
struct GlaPtrs3 { const bf16_t *QT, *KT, *KTT, *GVT, *GR; const float *DEC, *BL, *gla_g; float *SLOC, *DTOT; bf16_t* MIX; };

template <int PASS>
DI void gla_item3(int bh, int sc, char* smem, const GlaPtrs3& G) {
  GlaLds3& L = *(GlaLds3*)smem;
  const int tid = fresh_tid(), lane = tid & 63, w = __builtin_amdgcn_readfirstlane(tid >> 6), c16 = lane & 15, q = lane >> 4;
  const int b = bh >> 2, hd = bh & 3;
  const int cbeg = sc == 0 ? 0 : 8 * sc + 1, cend = 8 * sc + 9;
  f32x4 X[4];
#pragma unroll
  for (int i = 0; i < 4; ++i) X[i] = (f32x4){0.f, 0.f, 0.f, 0.f};
  if (PASS == 1) {
#pragma unroll 4
    for (int j = 0; j < sc; ++j) {
      const float* dt = G.DTOT + (size_t)(bh * 16 + j) * 64;
      const float* sl = G.SLOC + ((size_t)(bh * 16 + j) * 8 + w) * 16 * 64 + lane;
#pragma unroll
      for (int i = 0; i < 4; ++i) {
        const f32x4 d4 = *(const f32x4*)(dt + 16 * i + 4 * q);
        X[i][0] = d4.x * X[i][0] + sl[(4 * i + 0) * 64]; X[i][1] = d4.y * X[i][1] + sl[(4 * i + 1) * 64];
        X[i][2] = d4.z * X[i][2] + sl[(4 * i + 2) * 64]; X[i][3] = d4.w * X[i][3] + sl[(4 * i + 3) * 64];
      }
    }
  }
  f32x4 gain = {1.f, 1.f, 1.f, 1.f};
  if (PASS == 1) gain = *(const f32x4*)(G.gla_g + hd * 128 + 16 * w + 4 * q);
  const bf16_t* gvt = G.GVT + ((size_t)bh * 128 + 16 * w + c16) * GU + 8 * q;
  const int srow = tid >> 3, sc8 = tid & 7, soff = srow * GLDS + sc8 * 8;
  const size_t cb0 = (size_t)bh * 129 * 4096 + (size_t)srow * 64 + sc8 * 8;
  u32x4 rq, rk, rkt, rq2, rk2, rkt2; bf16x8 vfr[2], vfn[2], vfn2[2]; f32x4 dec[4], decn[4], decn2[4];
  {
    const size_t cb = cb0 + (size_t)cbeg * 4096;
    rkt = *(const u32x4*)(G.KTT + cb);
    if (PASS == 1) { rq = *(const u32x4*)(G.QT + cb); rk = *(const u32x4*)(G.KT + cb); }
    vfr[0] = *(const bf16x8*)(gvt + 64 * cbeg); vfr[1] = *(const bf16x8*)(gvt + 64 * cbeg + 32);
#pragma unroll
    for (int i = 0; i < 4; ++i) dec[i] = *(const f32x4*)(G.DEC + ((size_t)bh * 129 + cbeg) * 64 + 16 * i + 4 * q);
    *(u32x4*)&L.B[0].KT[soff] = rkt;
    if (PASS == 1) { *(u32x4*)&L.B[0].Qt[soff] = rq; *(u32x4*)&L.B[0].Kt[soff] = rk; }
    const size_t cb1 = cb0 + (size_t)(cbeg + 1) * 4096;
    rkt = *(const u32x4*)(G.KTT + cb1);
    if (PASS == 1) { rq = *(const u32x4*)(G.QT + cb1); rk = *(const u32x4*)(G.KT + cb1); }
    vfn[0] = *(const bf16x8*)(gvt + 64 * (cbeg + 1)); vfn[1] = *(const bf16x8*)(gvt + 64 * (cbeg + 1) + 32);
#pragma unroll
    for (int i = 0; i < 4; ++i) decn[i] = *(const f32x4*)(G.DEC + ((size_t)bh * 129 + cbeg + 1) * 64 + 16 * i + 4 * q);
  }
  __syncthreads();
  for (int c = cbeg; c < cend; ++c) {
    const int cur = (c - cbeg) & 1;
    const GlaBuf& Bc = L.B[cur];
    const bool more = c + 1 < cend, more2 = c + 2 < cend;
    if (more2) {
      const size_t cb = cb0 + (size_t)(c + 2) * 4096;
      rkt2 = *(const u32x4*)(G.KTT + cb);
      if (PASS == 1) { rq2 = *(const u32x4*)(G.QT + cb); rk2 = *(const u32x4*)(G.KT + cb); }
      vfn2[0] = *(const bf16x8*)(gvt + 64 * (c + 2)); vfn2[1] = *(const bf16x8*)(gvt + 64 * (c + 2) + 32);
#pragma unroll
      for (int i = 0; i < 4; ++i) decn2[i] = *(const f32x4*)(G.DEC + ((size_t)bh * 129 + c + 2) * 64 + 16 * i + 4 * q);
    }
    u32x2 grv[4];
    if (PASS == 1 && c >= 1) {
#pragma unroll
      for (int n = 0; n < 4; ++n) grv[n] = *(const u32x2*)(G.GR + ((size_t)b * SEQ + 64 * (c - 1) + 16 * n + c16) * 512 + hd * 128 + 16 * w + 4 * q);
    }
    f32x4 OT[4];
    if (PASS == 1) {
      const int is = w >> 1;
#pragma unroll
      for (int z = 0; z < 2; ++z) {
        const int it = 2 * (w & 1) + z;
        f32x4 pa = {0.f, 0.f, 0.f, 0.f};
        if (is <= it) {
#pragma unroll
          for (int kk = 0; kk < 2; ++kk) {
            const bf16x8 ka = *(const bf16x8*)&Bc.Kt[(16 * is + c16) * GLDS + 32 * kk + 8 * q];
            const bf16x8 qb = *(const bf16x8*)&Bc.Qt[(16 * it + c16) * GLDS + 32 * kk + 8 * q];
            pa = MFMA16(ka, qb, pa);
          }
          if (is == it) {
#pragma unroll
            for (int r = 0; r < 4; ++r) if (4 * q + r > c16) pa[r] = 0.f;
          }
        }
        u32x2 pw; pw.x = pk2(pa[0], pa[1]); pw.y = pk2(pa[2], pa[3]);
        *(u32x2*)&L.P[(16 * it + c16) * GLDS + 16 * is + 4 * q] = pw;
      }
#pragma unroll
      for (int n = 0; n < 4; ++n) OT[n] = (f32x4){0.f, 0.f, 0.f, 0.f};
#pragma unroll
      for (int kk = 0; kk < 2; ++kk) {
        u32x4 xp; xp.x = pk2(X[2 * kk][0], X[2 * kk][1]); xp.y = pk2(X[2 * kk][2], X[2 * kk][3]);
        xp.z = pk2(X[2 * kk + 1][0], X[2 * kk + 1][1]); xp.w = pk2(X[2 * kk + 1][2], X[2 * kk + 1][3]);
        const bf16x8 xa = __builtin_bit_cast(bf16x8, xp);
#pragma unroll
        for (int n = 0; n < 4; ++n) {
          const u32x2 lo = *(const u32x2*)&Bc.Qt[(16 * n + c16) * GLDS + 32 * kk + 4 * q];
          const u32x2 hi = *(const u32x2*)&Bc.Qt[(16 * n + c16) * GLDS + 32 * kk + 16 + 4 * q];
          u32x4 qq; qq.x = lo.x; qq.y = lo.y; qq.z = hi.x; qq.w = hi.y;
          OT[n] = MFMA16(xa, __builtin_bit_cast(bf16x8, qq), OT[n]);
        }
      }
      __syncthreads();
#pragma unroll
      for (int kk = 0; kk < 2; ++kk)
#pragma unroll
        for (int n = 0; n < 4; ++n) {
          const bf16x8 pb = *(const bf16x8*)&L.P[(16 * n + c16) * GLDS + 32 * kk + 8 * q];
          OT[n] = MFMA16(vfr[kk], pb, OT[n]);
        }
    }
#pragma unroll
    for (int i = 0; i < 4; ++i) {
#pragma unroll
      for (int kk = 0; kk < 2; ++kk) {
        const bf16x8 ka = *(const bf16x8*)&Bc.KT[(16 * i + c16) * GLDS + 32 * kk + 8 * q];
        X[i] = MFMA16(ka, vfr[kk], X[i]);
      }
      X[i][0] *= dec[i].x; X[i][1] *= dec[i].y; X[i][2] *= dec[i].z; X[i][3] *= dec[i].w;
    }
    if (PASS == 1 && c >= 1) {
      float ss[4];
#pragma unroll
      for (int n = 0; n < 4; ++n) {
        float v = OT[n][0] * OT[n][0] + OT[n][1] * OT[n][1] + OT[n][2] * OT[n][2] + OT[n][3] * OT[n][3];
        v += __shfl_xor(v, 16); v += __shfl_xor(v, 32);
        ss[n] = v;
      }
      if (q == 0) {
#pragma unroll
        for (int n = 0; n < 4; ++n) L.ssq[w][16 * n + c16] = ss[n];
      }
      __syncthreads();
#pragma unroll
      for (int n = 0; n < 4; ++n) {
        float tot = 0.f;
#pragma unroll
        for (int w2 = 0; w2 < 8; ++w2) tot += L.ssq[w2][16 * n + c16];
        const float scl = rsqrtf(tot * (1.0f / 128.0f) + EPS);
        const size_t m = (size_t)b * SEQ + 64 * (c - 1) + 16 * n + c16;
        const float r0 = bflo(grv[n].x), r1 = bfhi(grv[n].x), r2 = bflo(grv[n].y), r3 = bfhi(grv[n].y);
        const float o0 = OT[n][0] * scl * gain.x * (r0 / (1.f + __expf(-r0)));
        const float o1 = OT[n][1] * scl * gain.y * (r1 / (1.f + __expf(-r1)));
        const float o2 = OT[n][2] * scl * gain.z * (r2 / (1.f + __expf(-r2)));
        const float o3 = OT[n][3] * scl * gain.w * (r3 / (1.f + __expf(-r3)));
        u32x2 ow; ow.x = pk2(o0, o1); ow.y = pk2(o2, o3);
        *(u32x2*)(G.MIX + m * D + 512 + hd * 128 + 16 * w + 4 * q) = ow;
      }
    }
    if (more) {
      GlaBuf& Bn = L.B[cur ^ 1];
      *(u32x4*)&Bn.KT[soff] = rkt;
      if (PASS == 1) { *(u32x4*)&Bn.Qt[soff] = rq; *(u32x4*)&Bn.Kt[soff] = rk; }
      vfr[0] = vfn[0]; vfr[1] = vfn[1];
#pragma unroll
      for (int i = 0; i < 4; ++i) dec[i] = decn[i];
      rkt = rkt2; rq = rq2; rk = rk2; vfn[0] = vfn2[0]; vfn[1] = vfn2[1];
#pragma unroll
      for (int i = 0; i < 4; ++i) decn[i] = decn2[i];
    }
    __syncthreads();
  }
  if (PASS == 0) {
    float* sl = G.SLOC + ((size_t)(bh * 16 + sc) * 8 + w) * 16 * 64 + lane;
#pragma unroll
    for (int i = 0; i < 4; ++i)
#pragma unroll
      for (int r = 0; r < 4; ++r) sl[(4 * i + r) * 64] = X[i][r];
    if (w == 0) {
      float bl = 0.f;
      for (int c = cbeg; c < cend; ++c) bl += G.BL[((size_t)bh * 129 + c) * 64 + lane];
      G.DTOT[(size_t)(bh * 16 + sc) * 64 + lane] = __expf(bl);
    }
  }
}


struct GlaLds4 { GlaBuf B[2]; bf16_t P[64 * GLDS]; float ssq[4][64]; };
template <int PASS>
DI void gla_item4(int bh_lo, int sc, char* smem, const GlaPtrs3& G) {
  const int tid = fresh_tid(), lane = tid & 63, w = __builtin_amdgcn_readfirstlane(tid >> 6), c16 = lane & 15, q = lane >> 4;
  const int hb = w >> 2, w4 = w & 3, tid4 = tid & 255;
  GlaLds4& L = *(GlaLds4*)(smem + hb * (int)sizeof(GlaLds4));
  const int bh = bh_lo + 16 * hb, b = bh >> 2, hd = bh & 3;
  const int cbeg = sc == 0 ? 0 : 8 * sc + 1, cend = 8 * sc + 9;
  f32x4 X[2][4];
#pragma unroll
  for (int et = 0; et < 2; ++et)
#pragma unroll
    for (int i = 0; i < 4; ++i) X[et][i] = (f32x4){0.f, 0.f, 0.f, 0.f};
  if (PASS == 1) {
#pragma unroll 2
    for (int j = 0; j < sc; ++j) {
      const float* dt = G.DTOT + (size_t)(bh * 16 + j) * 64;
#pragma unroll
      for (int et = 0; et < 2; ++et) {
        const float* sl = G.SLOC + ((size_t)(bh * 16 + j) * 8 + w4 * 2 + et) * 16 * 64 + lane;
#pragma unroll
        for (int i = 0; i < 4; ++i) {
          const f32x4 d4 = *(const f32x4*)(dt + 16 * i + 4 * q);
          X[et][i][0] = d4.x * X[et][i][0] + sl[(4 * i + 0) * 64]; X[et][i][1] = d4.y * X[et][i][1] + sl[(4 * i + 1) * 64];
          X[et][i][2] = d4.z * X[et][i][2] + sl[(4 * i + 2) * 64]; X[et][i][3] = d4.w * X[et][i][3] + sl[(4 * i + 3) * 64];
        }
      }
    }
  }
  f32x4 gain[2];
#pragma unroll
  for (int et = 0; et < 2; ++et) gain[et] = PASS == 1 ? *(const f32x4*)(G.gla_g + hd * 128 + 32 * w4 + 16 * et + 4 * q) : (f32x4){1.f, 1.f, 1.f, 1.f};
  const bf16_t* gvt0 = G.GVT + ((size_t)bh * 128 + 32 * w4 + c16) * GU + 8 * q;
  const bf16_t* gvt1 = gvt0 + (size_t)16 * GU;
  const int soffA = (tid4 >> 3) * GLDS + (tid4 & 7) * 8, soffB = soffA + 32 * GLDS;
  const size_t cb0 = (size_t)bh * 129 * 4096 + (size_t)(tid4 >> 3) * 64 + (tid4 & 7) * 8;
  u32x4 rq[2], rk[2], rkt[2], rq2[2], rk2[2], rkt2[2];
  bf16x8 vfr[2][2], vfn[2][2]; f32x4 dec[4], decn[4];
#define G4_LOADT(rq_, rk_, rkt_, c_) { const size_t cb_ = cb0 + (size_t)(c_) * 4096; \
    rkt_[0] = *(const u32x4*)(G.KTT + cb_); rkt_[1] = *(const u32x4*)(G.KTT + cb_ + 2048); \
    if (PASS == 1) { rq_[0] = *(const u32x4*)(G.QT + cb_); rq_[1] = *(const u32x4*)(G.QT + cb_ + 2048); rk_[0] = *(const u32x4*)(G.KT + cb_); rk_[1] = *(const u32x4*)(G.KT + cb_ + 2048); } }
#define G4_LOADV(vf_, dc_, c_) { vf_[0][0] = *(const bf16x8*)(gvt0 + 64 * (c_)); vf_[0][1] = *(const bf16x8*)(gvt0 + 64 * (c_) + 32); \
    vf_[1][0] = *(const bf16x8*)(gvt1 + 64 * (c_)); vf_[1][1] = *(const bf16x8*)(gvt1 + 64 * (c_) + 32); \
    _Pragma("unroll") for (int i = 0; i < 4; ++i) dc_[i] = *(const f32x4*)(G.DEC + ((size_t)bh * 129 + (c_)) * 64 + 16 * i + 4 * q); }
#define G4_STORET(Bn_, rq_, rk_, rkt_) { *(u32x4*)&Bn_.KT[soffA] = rkt_[0]; *(u32x4*)&Bn_.KT[soffB] = rkt_[1]; \
    if (PASS == 1) { *(u32x4*)&Bn_.Qt[soffA] = rq_[0]; *(u32x4*)&Bn_.Qt[soffB] = rq_[1]; *(u32x4*)&Bn_.Kt[soffA] = rk_[0]; *(u32x4*)&Bn_.Kt[soffB] = rk_[1]; } }
  G4_LOADT(rq, rk, rkt, cbeg)
  G4_LOADV(vfr, dec, cbeg)
  G4_STORET(L.B[0], rq, rk, rkt)
  G4_LOADT(rq, rk, rkt, cbeg + 1)
  G4_LOADV(vfn, decn, cbeg + 1)
  __syncthreads();
  for (int c = cbeg; c < cend; ++c) {
    const int cur = (c - cbeg) & 1;
    const GlaBuf& Bc = L.B[cur];
    const bool more = c + 1 < cend, more2 = c + 2 < cend;
    if (more2) G4_LOADT(rq2, rk2, rkt2, c + 2)
    u32x2 grv[2][4];
    if (PASS == 1 && c >= 1) {
#pragma unroll
      for (int et = 0; et < 2; ++et)
#pragma unroll
        for (int n = 0; n < 4; ++n) grv[et][n] = *(const u32x2*)(G.GR + ((size_t)b * SEQ + 64 * (c - 1) + 16 * n + c16) * 512 + hd * 128 + 32 * w4 + 16 * et + 4 * q);
    }
    f32x4 OT[2][4];
    if (PASS == 1) {
      const int is = w4;
#pragma unroll
      for (int it = 0; it < 4; ++it) {
        f32x4 pa = {0.f, 0.f, 0.f, 0.f};
        if (is <= it) {
#pragma unroll
          for (int kk = 0; kk < 2; ++kk) {
            const bf16x8 ka = *(const bf16x8*)&Bc.Kt[(16 * is + c16) * GLDS + 32 * kk + 8 * q];
            const bf16x8 qb = *(const bf16x8*)&Bc.Qt[(16 * it + c16) * GLDS + 32 * kk + 8 * q];
            pa = MFMA16(ka, qb, pa);
          }
          if (is == it) {
#pragma unroll
            for (int r = 0; r < 4; ++r) if (4 * q + r > c16) pa[r] = 0.f;
          }
        }
        u32x2 pw; pw.x = pk2(pa[0], pa[1]); pw.y = pk2(pa[2], pa[3]);
        *(u32x2*)&L.P[(16 * it + c16) * GLDS + 16 * is + 4 * q] = pw;
      }
#pragma unroll
      for (int et = 0; et < 2; ++et)
#pragma unroll
        for (int n = 0; n < 4; ++n) OT[et][n] = (f32x4){0.f, 0.f, 0.f, 0.f};
#pragma unroll
      for (int kk = 0; kk < 2; ++kk) {
        bf16x8 xa[2];
#pragma unroll
        for (int et = 0; et < 2; ++et) {
          u32x4 xp; xp.x = pk2(X[et][2 * kk][0], X[et][2 * kk][1]); xp.y = pk2(X[et][2 * kk][2], X[et][2 * kk][3]);
          xp.z = pk2(X[et][2 * kk + 1][0], X[et][2 * kk + 1][1]); xp.w = pk2(X[et][2 * kk + 1][2], X[et][2 * kk + 1][3]);
          xa[et] = __builtin_bit_cast(bf16x8, xp);
        }
#pragma unroll
        for (int n = 0; n < 4; ++n) {
          const u32x2 lo = *(const u32x2*)&Bc.Qt[(16 * n + c16) * GLDS + 32 * kk + 4 * q];
          const u32x2 hi = *(const u32x2*)&Bc.Qt[(16 * n + c16) * GLDS + 32 * kk + 16 + 4 * q];
          u32x4 qq; qq.x = lo.x; qq.y = lo.y; qq.z = hi.x; qq.w = hi.y;
          const bf16x8 qf = __builtin_bit_cast(bf16x8, qq);
          OT[0][n] = MFMA16(xa[0], qf, OT[0][n]);
          OT[1][n] = MFMA16(xa[1], qf, OT[1][n]);
        }
      }
      __syncthreads();
#pragma unroll
      for (int kk = 0; kk < 2; ++kk)
#pragma unroll
        for (int n = 0; n < 4; ++n) {
          const bf16x8 pb = *(const bf16x8*)&L.P[(16 * n + c16) * GLDS + 32 * kk + 8 * q];
          OT[0][n] = MFMA16(vfr[0][kk], pb, OT[0][n]);
          OT[1][n] = MFMA16(vfr[1][kk], pb, OT[1][n]);
        }
    }
#pragma unroll
    for (int i = 0; i < 4; ++i) {
#pragma unroll
      for (int kk = 0; kk < 2; ++kk) {
        const bf16x8 ka = *(const bf16x8*)&Bc.KT[(16 * i + c16) * GLDS + 32 * kk + 8 * q];
        X[0][i] = MFMA16(ka, vfr[0][kk], X[0][i]);
        X[1][i] = MFMA16(ka, vfr[1][kk], X[1][i]);
      }
#pragma unroll
      for (int et = 0; et < 2; ++et) { X[et][i][0] *= dec[i].x; X[et][i][1] *= dec[i].y; X[et][i][2] *= dec[i].z; X[et][i][3] *= dec[i].w; }
    }
    if (PASS == 1 && c >= 1) {
      float ss[4];
#pragma unroll
      for (int n = 0; n < 4; ++n) {
        float v = OT[0][n][0] * OT[0][n][0] + OT[0][n][1] * OT[0][n][1] + OT[0][n][2] * OT[0][n][2] + OT[0][n][3] * OT[0][n][3]
                + OT[1][n][0] * OT[1][n][0] + OT[1][n][1] * OT[1][n][1] + OT[1][n][2] * OT[1][n][2] + OT[1][n][3] * OT[1][n][3];
        v += __shfl_xor(v, 16); v += __shfl_xor(v, 32);
        ss[n] = v;
      }
      if (q == 0) {
#pragma unroll
        for (int n = 0; n < 4; ++n) L.ssq[w4][16 * n + c16] = ss[n];
      }
      __syncthreads();
#pragma unroll
      for (int n = 0; n < 4; ++n) {
        const float tot = L.ssq[0][16 * n + c16] + L.ssq[1][16 * n + c16] + L.ssq[2][16 * n + c16] + L.ssq[3][16 * n + c16];
        const float scl = rsqrtf(tot * (1.0f / 128.0f) + EPS);
        const size_t m = (size_t)b * SEQ + 64 * (c - 1) + 16 * n + c16;
#pragma unroll
        for (int et = 0; et < 2; ++et) {
          const float r0 = bflo(grv[et][n].x), r1 = bfhi(grv[et][n].x), r2 = bflo(grv[et][n].y), r3 = bfhi(grv[et][n].y);
          const float o0 = OT[et][n][0] * scl * gain[et].x * r0 * __builtin_amdgcn_rcpf(1.f + __expf(-r0));
          const float o1 = OT[et][n][1] * scl * gain[et].y * r1 * __builtin_amdgcn_rcpf(1.f + __expf(-r1));
          const float o2 = OT[et][n][2] * scl * gain[et].z * r2 * __builtin_amdgcn_rcpf(1.f + __expf(-r2));
          const float o3 = OT[et][n][3] * scl * gain[et].w * r3 * __builtin_amdgcn_rcpf(1.f + __expf(-r3));
          u32x2 ow; ow.x = pk2(o0, o1); ow.y = pk2(o2, o3);
          *(u32x2*)(G.MIX + m * D + 512 + hd * 128 + 32 * w4 + 16 * et + 4 * q) = ow;
        }
      }
    }
    if (more) {
      GlaBuf& Bn = L.B[cur ^ 1];
      G4_STORET(Bn, rq, rk, rkt)
#pragma unroll
      for (int et = 0; et < 2; ++et) { vfr[et][0] = vfn[et][0]; vfr[et][1] = vfn[et][1]; }
#pragma unroll
      for (int i = 0; i < 4; ++i) dec[i] = decn[i];
#pragma unroll
      for (int z = 0; z < 2; ++z) { rkt[z] = rkt2[z]; rq[z] = rq2[z]; rk[z] = rk2[z]; }
      if (more2) G4_LOADV(vfn, decn, c + 2)
    }
    __syncthreads();
  }
#undef G4_LOADT
#undef G4_LOADV
#undef G4_STORET
  if (PASS == 0) {
#pragma unroll
    for (int et = 0; et < 2; ++et) {
      float* sl = G.SLOC + ((size_t)(bh * 16 + sc) * 8 + w4 * 2 + et) * 16 * 64 + lane;
#pragma unroll
      for (int i = 0; i < 4; ++i)
#pragma unroll
        for (int r = 0; r < 4; ++r) sl[(4 * i + r) * 64] = X[et][i][r];
    }
    if (w4 == 0) {
      float bl = 0.f;
      for (int c = cbeg; c < cend; ++c) bl += G.BL[((size_t)bh * 129 + c) * 64 + lane];
      G.DTOT[(size_t)(bh * 16 + sc) * 64 + lane] = __expf(bl);
    }
  }
}

DI void ce_desc(float& a, float& b) {
  const float hi = __builtin_fmaxf(a, b), lo = __builtin_fminf(a, b);
  a = hi; b = lo;
}
DI float vmaxf(float a, float b) { return __builtin_fmaxf(a, b); }
template <int N> DI void bitonic_sort_desc(float (&v)[N]) {
#pragma unroll
  for (int k = 2; k <= N; k <<= 1) {
#pragma unroll
    for (int j = k >> 1; j > 0; j >>= 1) {
#pragma unroll
      for (int i = 0; i < N; ++i) {
        const int l = i ^ j;
        if (l > i) { if ((i & k) == 0) ce_desc(v[i], v[l]); else ce_desc(v[l], v[i]); }
      }
    }
  }
}
DI void sort16_desc(float (&v)[16]) {
  ce_desc(v[0], v[1]); ce_desc(v[2], v[3]); ce_desc(v[0], v[2]); ce_desc(v[1], v[3]); ce_desc(v[1], v[2]); ce_desc(v[4], v[5]); ce_desc(v[6], v[7]); ce_desc(v[4], v[6]); ce_desc(v[5], v[7]); ce_desc(v[5], v[6]); ce_desc(v[0], v[4]); ce_desc(v[2], v[6]); ce_desc(v[2], v[4]); ce_desc(v[1], v[5]); ce_desc(v[3], v[7]); ce_desc(v[3], v[5]); ce_desc(v[1], v[2]); ce_desc(v[3], v[4]); ce_desc(v[5], v[6]); ce_desc(v[8], v[9]); ce_desc(v[10], v[11]); ce_desc(v[8], v[10]); ce_desc(v[9], v[11]); ce_desc(v[9], v[10]); ce_desc(v[12], v[13]); ce_desc(v[14], v[15]); ce_desc(v[12], v[14]); ce_desc(v[13], v[15]); ce_desc(v[13], v[14]); ce_desc(v[8], v[12]); ce_desc(v[10], v[14]); ce_desc(v[10], v[12]); ce_desc(v[9], v[13]); ce_desc(v[11], v[15]); ce_desc(v[11], v[13]); ce_desc(v[9], v[10]); ce_desc(v[11], v[12]); ce_desc(v[13], v[14]); ce_desc(v[0], v[8]); ce_desc(v[4], v[12]); ce_desc(v[4], v[8]); ce_desc(v[2], v[10]); ce_desc(v[6], v[14]); ce_desc(v[6], v[10]); ce_desc(v[2], v[4]); ce_desc(v[6], v[8]); ce_desc(v[10], v[12]); ce_desc(v[1], v[9]); ce_desc(v[5], v[13]); ce_desc(v[5], v[9]); ce_desc(v[3], v[11]); ce_desc(v[7], v[15]); ce_desc(v[7], v[11]); ce_desc(v[3], v[5]); ce_desc(v[7], v[9]); ce_desc(v[11], v[13]); ce_desc(v[1], v[2]); ce_desc(v[3], v[4]); ce_desc(v[5], v[6]); ce_desc(v[7], v[8]); ce_desc(v[9], v[10]); ce_desc(v[11], v[12]); ce_desc(v[13], v[14]);
}
DI void bitonic_merge16_desc(float (&v)[16]) {
#pragma unroll
  for (int j = 8; j > 0; j >>= 1) {
#pragma unroll
    for (int i = 0; i < 16; ++i) { const int l = i ^ j; if (l > i) ce_desc(v[i], v[l]); }
  }
}
template <int NBV> DI void merge_prune16(float (&a)[16], const float (&b)[16]) {
#pragma unroll
  for (int i = 16 - NBV; i < 16; ++i) a[i] = vmaxf(a[i], b[15 - i]);
  bitonic_merge16_desc(a);
}
DI float selh(int hh, float a, float b) { asm volatile("" : "+v"(a), "+v"(b)); return hh == 0 ? a : b; }
DI float pack_idx(float v, unsigned idx, unsigned mask) { return __uint_as_float((__float_as_uint(v) & ~mask) | idx); }

DI void route_stage_keys(int hd, char* smem, const bf16_t* __restrict__ SK1b, const bf16_t* __restrict__ SK2b) {
  const int tid256_ = fresh_tid() & 255;
  bf16_t* kl = (bf16_t*)smem;
#pragma unroll
  for (int i = 0; i < 8; ++i) {
    const int pz = TID + 256 * i, L = pz >> 10, row = (pz >> 3) & 127, c8 = pz & 7;
    const bf16_t* src = (L == 0 ? SK1b : SK2b) + (size_t)(hd * 128 + row) * 64 + c8 * 8;
    *(u32x4*)&kl[(L * 128 + row) * 72 + c8 * 8] = *(const u32x4*)src;
  }
  __syncthreads();
}
DI void route_load_q(bf16x8 (&qf)[2][4], const bf16_t* __restrict__ QP, int m, int hd, int hh) {
#pragma unroll
  for (int L = 0; L < 2; ++L)
#pragma unroll
    for (int ks = 0; ks < 4; ++ks) qf[L][ks] = *(const bf16x8*)(QP + (size_t)m * D + hd * 128 + L * 64 + hh * 8 + ks * 16);
}
DI void ph_route_v2(int vb, char* smem, const bf16x8 (&qf)[2][4], unsigned short* __restrict__ EIDX, float* __restrict__ GATE) {
  const int tid256_ = fresh_tid() & 255;
  const int lane = TID & 63, wave = TID >> 6, r = lane & 31, hh = lane >> 5;
  const int hd = vb & 7, tile = vb >> 3;
  const int m = tile * 128 + wave * 32 + r;
  const bf16_t* kl = (const bf16_t*)smem;
  float loc[2][16];
#pragma unroll
  for (int L = 0; L < 2; ++L) {
    float grp[4][16];
#pragma unroll
    for (int mt = 0; mt < 4; ++mt) {
      f32x16 acc;
#pragma unroll
      for (int e = 0; e < 16; ++e) acc[e] = 0.f;
#pragma unroll
      for (int ks = 0; ks < 4; ++ks) {
        const bf16x8 kf = *(const bf16x8*)&kl[(L * 128 + mt * 32 + r) * 72 + ks * 16 + hh * 8];
        acc = MFMA32(kf, qf[L][ks], acc);
      }
#pragma unroll
      for (int e = 0; e < 16; ++e) grp[mt][e] = pack_idx(acc[e], (unsigned)(mt * 32 + crow(e, hh)), 127u);
      sort16_desc(grp[mt]);
    }
    merge_prune16<16>(grp[0], grp[1]);
    merge_prune16<16>(grp[2], grp[3]);
    merge_prune16<16>(grp[0], grp[2]);
#pragma unroll
    for (int i = 0; i < 16; ++i) loc[L][i] = grp[0][i];
  }
  float fin[16], oth[16];
#pragma unroll
  for (int i = 0; i < 16; ++i) {
    const float send = selh(hh, loc[1][i], loc[0][i]);
    oth[i] = __shfl_xor(send, 32);
    fin[i] = selh(hh, loc[0][i], loc[1][i]);
  }
  merge_prune16<16>(fin, oth);
  float v1[16], v2[16];
#pragma unroll
  for (int i = 0; i < 16; ++i) {
    const float o = __shfl_xor(fin[i], 32);
    v1[i] = selh(hh, fin[i], o);
    v2[i] = selh(hh, o, fin[i]);
  }
  unsigned* ib = (unsigned*)(smem + 36864) + (size_t)TID * 8;
#pragma unroll
  for (int q = 0; q < 4; ++q) {
    unsigned w1 = 0, w2 = 0;
#pragma unroll
    for (int j = 0; j < 4; ++j) {
      w1 |= (__float_as_uint(v1[4 * q + j]) & 127u) << (8 * j);
      w2 |= (__float_as_uint(v2[4 * q + j]) & 127u) << (8 * j);
    }
    ib[q] = w1; ib[4 + q] = w2;
  }
  float R[16], Bv[16];
#pragma unroll
  for (int j = 0; j < 16; ++j) R[j] = pack_idx(v1[0] + v2[j], (unsigned)j, 255u);
#define ROUTE_ROW(I, CNT) { _Pragma("unroll") for (int j = 0; j < 16; ++j) Bv[j] = (j < CNT) ? pack_idx(v1[I] + v2[j < CNT ? j : 0], (unsigned)(I * 16 + j), 255u) : 0.f; \
    merge_prune16<CNT>(R, Bv); }
  ROUTE_ROW(1, 8) ROUTE_ROW(2, 5) ROUTE_ROW(3, 4) ROUTE_ROW(4, 3) ROUTE_ROW(5, 2) ROUTE_ROW(6, 2) ROUTE_ROW(7, 2)
#undef ROUTE_ROW
#pragma unroll
  for (int j = 0; j < 16; ++j) Bv[j] = (j < 8) ? pack_idx(v1[8 + (j < 8 ? j : 0)] + v2[0], (unsigned)((8 + j) * 16), 255u) : 0.f;
  merge_prune16<8>(R, Bv);
  float ex[16], sum = 0.f;
#pragma unroll
  for (int i = 0; i < 16; ++i) { ex[i] = __expf(R[i] - R[0]); sum += ex[i]; }
  const float inv = 1.f / sum;
  const unsigned char* ibb = (const unsigned char*)ib;
  int eo[8]; float go[8];
#pragma unroll
  for (int w = 0; w < 8; ++w) {
    const float rv = selh(hh, R[w], R[8 + w]);
    const float ev = selh(hh, ex[w], ex[8 + w]);
    const unsigned pos = __float_as_uint(rv) & 255u;
    const unsigned i1 = ibb[pos >> 4], i2 = ibb[16 + (pos & 15u)];
    eo[w] = (int)(i1 * 128u + i2);
    go[w] = ev * inv;
  }
  unsigned short* ep = EIDX + (size_t)m * 128 + hd * 16 + hh * 8;
  float* gp = GATE + (size_t)m * 128 + hd * 16 + hh * 8;
  *(u32x4*)ep = (u32x4){(unsigned)eo[0] | ((unsigned)eo[1] << 16), (unsigned)eo[2] | ((unsigned)eo[3] << 16), (unsigned)eo[4] | ((unsigned)eo[5] << 16), (unsigned)eo[6] | ((unsigned)eo[7] << 16)};
  *(f32x4*)gp = (f32x4){go[0], go[1], go[2], go[3]};
  *(f32x4*)(gp + 4) = (f32x4){go[4], go[5], go[6], go[7]};
}


constexpr size_t WS_SCU = 14 * MiB;
constexpr size_t WS_SCV = 14 * MiB + 65536;
DI float wave_max(float v) {
#pragma unroll
  for (int o = 32; o >= 1; o >>= 1) v = fmaxf(v, __shfl_xor(v, o));
  return v;
}
DI u32x4 quant_row16(const float* __restrict__ rowp, int lane, float& sc) {
  const f32x4* rp = (const f32x4*)(rowp + lane * 16);
  const f32x4 a = rp[0], b = rp[1], c = rp[2], d = rp[3];
  float m = fmaxf(fmaxf(fmaxf(fabsf(a.x), fabsf(a.y)), fmaxf(fabsf(a.z), fabsf(a.w))), fmaxf(fmaxf(fabsf(b.x), fabsf(b.y)), fmaxf(fabsf(b.z), fabsf(b.w))));
  m = fmaxf(m, fmaxf(fmaxf(fmaxf(fabsf(c.x), fabsf(c.y)), fmaxf(fabsf(c.z), fabsf(c.w))), fmaxf(fmaxf(fabsf(d.x), fabsf(d.y)), fmaxf(fabsf(d.z), fabsf(d.w)))));
  m = wave_max(m);
  sc = m > 0.f ? m * (1.0f / 448.0f) : 1.0f;
  const float inv = 1.0f / sc;
  u32x4 o; unsigned w;
  w = 0; w = __builtin_amdgcn_cvt_pk_fp8_f32(a.x * inv, a.y * inv, w, false); w = __builtin_amdgcn_cvt_pk_fp8_f32(a.z * inv, a.w * inv, w, true); o.x = w;
  w = 0; w = __builtin_amdgcn_cvt_pk_fp8_f32(b.x * inv, b.y * inv, w, false); w = __builtin_amdgcn_cvt_pk_fp8_f32(b.z * inv, b.w * inv, w, true); o.y = w;
  w = 0; w = __builtin_amdgcn_cvt_pk_fp8_f32(c.x * inv, c.y * inv, w, false); w = __builtin_amdgcn_cvt_pk_fp8_f32(c.z * inv, c.w * inv, w, true); o.z = w;
  w = 0; w = __builtin_amdgcn_cvt_pk_fp8_f32(d.x * inv, d.y * inv, w, false); w = __builtin_amdgcn_cvt_pk_fp8_f32(d.z * inv, d.w * inv, w, true); o.w = w;
  return o;
}
DI void ph_convert_ev8(int vb, char* smem, const float* __restrict__ src, u8_t* __restrict__ EV8c, float* __restrict__ scaleV) {
  const int tid256_ = fresh_tid() & 255;
  u8_t (*t)[1040] = (u8_t (*)[1040])smem;
  const int lane = TID & 63, wave = TID >> 6, e0 = vb * 32;
  for (int rr = 0; rr < 8; ++rr) {
    const int r = wave * 8 + rr;
    float sc;
    const u32x4 o = quant_row16(src + (size_t)(e0 + r) * D, lane, sc);
    *(u32x4*)&t[r][lane * 16] = o;
    if (lane == 0) scaleV[e0 + r] = sc;
  }
  __syncthreads();
  const int r = TID & 31, cs = TID >> 5;
  for (int c0 = 0; c0 < 128; c0 += 8) {
    const int cg = c0 + cs;
    const u32x2 v = *(const u32x2*)&t[r][cg * 8];
    *(u32x2*)(EV8c + ((size_t)cg * NEXP + e0 + r) * 8) = v;
  }
  __syncthreads();
}
struct PeerUHalf { u32x4 u[8]; };
DI float gelu_as(float v) {
  const float av = fabsf(v);
  const float t = __builtin_amdgcn_rcpf(av * 0.2316418882f + 1.0f);
  float q = t * 0.5307027145f + (-0.7265760135f); q = q * t + 0.7107068705f; q = q * t + (-0.142248368f); q = q * t + 0.127414796f; q = q * t;
  const float e = __builtin_amdgcn_exp2f((v * v) * (-0.72134752044f));
  const float m = v * (q * e);
  return v < 0.f ? m : v - m;
}
DI void pc_stage_scales(char* smem, const float* __restrict__ scaleU, const float* __restrict__ scaleV) {
  unsigned* sc = (unsigned*)(smem + 34816);
  const int tid = fresh_tid();
#pragma unroll 4
  for (int i = tid; i < NEXP; i += 512) sc[i] = f2bf(scaleU[i]) | (f2bf(scaleV[i]) << 16);
  __syncthreads();
}
DI void ph_peer_c8(int unit, char* smem, const bf16_t* __restrict__ PP, const unsigned short* __restrict__ EIDX, const float* __restrict__ GATE,
                   const float* __restrict__ SSQ, unsigned* __restrict__ STREAM) {
  unsigned (*tile)[132] = (unsigned (*)[132])smem;
  const unsigned* sc = (const unsigned*)(smem + 34816);
  const int tid = fresh_tid();
  const int tl = tid >> 3, kc = tid & 7;
  const size_t rowoff = ((size_t)unit * 64 + tl) * 128 + kc * 16;
  const size_t n = (size_t)TREAL * 128;
  const int tok = unit * 64 + tl;
  const float r2 = rsqrtf(((SSQ[tok] + SSQ[TREAL + tok]) + (SSQ[2 * TREAL + tok] + SSQ[3 * TREAL + tok])) * (1.0f / D) + EPS);
  float a[16];
#pragma unroll
  for (int j = 0; j < 16; ++j) a[j] = 0.f;
#pragma unroll
  for (int s = 0; s < 8; ++s) {
    const u32x4 p0 = *(const u32x4*)(PP + (size_t)s * n + rowoff), p1 = *(const u32x4*)(PP + (size_t)s * n + rowoff + 8);
    a[0] += bflo(p0.x); a[1] += bfhi(p0.x); a[2] += bflo(p0.y); a[3] += bfhi(p0.y); a[4] += bflo(p0.z); a[5] += bfhi(p0.z); a[6] += bflo(p0.w); a[7] += bfhi(p0.w);
    a[8] += bflo(p1.x); a[9] += bfhi(p1.x); a[10] += bflo(p1.y); a[11] += bfhi(p1.y); a[12] += bflo(p1.z); a[13] += bfhi(p1.z); a[14] += bflo(p1.w); a[15] += bfhi(p1.w);
  }
  const u32x4 e0 = *(const u32x4*)(EIDX + rowoff), e1 = *(const u32x4*)(EIDX + rowoff + 8);
  unsigned ev[16] = {e0.x & 0xffffu, e0.x >> 16, e0.y & 0xffffu, e0.y >> 16, e0.z & 0xffffu, e0.z >> 16, e0.w & 0xffffu, e0.w >> 16,
                     e1.x & 0xffffu, e1.x >> 16, e1.y & 0xffffu, e1.y >> 16, e1.z & 0xffffu, e1.z >> 16, e1.w & 0xffffu, e1.w >> 16};
  float gt[16];
#pragma unroll
  for (int j = 0; j < 4; ++j) { const f32x4 g4 = *(const f32x4*)(GATE + rowoff + 4 * j); gt[4 * j] = g4.x; gt[4 * j + 1] = g4.y; gt[4 * j + 2] = g4.z; gt[4 * j + 3] = g4.w; }
#pragma unroll
  for (int j = 0; j < 16; ++j) {
    const unsigned e = ev[j];
    const unsigned sw = sc[e];
    const float av = a[j] * (r2 * bflo(sw));
    const float act = gelu_as(av);
    const float c = gt[j] * act * bfhi(sw);
    tile[tl][kc * 16 + j] = e | (f2bf(c) << 16);
  }
  __syncthreads();
  unsigned* outp = STREAM + (size_t)unit * 8192;
#pragma unroll 4
  for (int j = 0; j < 16; ++j) {
    const int o = tid + 512 * j, q = o >> 8, t2 = (o >> 2) & 63, z = o & 3;
    outp[o] = tile[t2][4 * q + z];
  }
  __syncthreads();
}
struct PVW { u32x4 a, b; };
struct PVT { u32x2 v[8]; };
DI void pv_loadw(PVW& W, const unsigned* __restrict__ STREAM, int it, int g, int lane) {
  const u32x4* sp = (const u32x4*)(STREAM + (size_t)it * 8192) + lane;
  W.a = sp[(2 * g) * 64]; W.b = sp[(2 * g + 1) * 64];
}
DI void pv_readt(PVT& T, const PVW& W, const u32x2* tabl) {
  T.v[0] = tabl[W.a.x & 0xffffu]; T.v[1] = tabl[W.a.y & 0xffffu]; T.v[2] = tabl[W.a.z & 0xffffu]; T.v[3] = tabl[W.a.w & 0xffffu];
  T.v[4] = tabl[W.b.x & 0xffffu]; T.v[5] = tabl[W.b.y & 0xffffu]; T.v[6] = tabl[W.b.z & 0xffffu]; T.v[7] = tabl[W.b.w & 0xffffu];
}
DI void pv_fma1(unsigned w, const u32x2 v, f32x2 (&y)[4]) {
  const float c = bfhi(w);
  const f32x2 cc = {c, c};
  y[0] = __builtin_elementwise_fma(__builtin_amdgcn_cvt_pk_f32_fp8(v.x, false), cc, y[0]);
  y[1] = __builtin_elementwise_fma(__builtin_amdgcn_cvt_pk_f32_fp8(v.x, true), cc, y[1]);
  y[2] = __builtin_elementwise_fma(__builtin_amdgcn_cvt_pk_f32_fp8(v.y, false), cc, y[2]);
  y[3] = __builtin_elementwise_fma(__builtin_amdgcn_cvt_pk_f32_fp8(v.y, true), cc, y[3]);
}
DI void pv_fma(const PVW& W, const PVT& T, f32x2 (&y)[4]) {
  pv_fma1(W.a.x, T.v[0], y); pv_fma1(W.a.y, T.v[1], y); pv_fma1(W.a.z, T.v[2], y); pv_fma1(W.a.w, T.v[3], y);
  pv_fma1(W.b.x, T.v[4], y); pv_fma1(W.b.y, T.v[5], y); pv_fma1(W.b.z, T.v[6], y); pv_fma1(W.b.w, T.v[7], y);
}
DI void pv_load_table(char* smem, const u8_t* __restrict__ EV8c, int cg) {
  const int tid = fresh_tid();
  const u32x4* src = (const u32x4*)(EV8c + (size_t)cg * NEXP * 8);
#pragma unroll 4
  for (int i = tid; i < NEXP * 8 / 16; i += 512) ((u32x4*)smem)[i] = src[i];
  __syncthreads();
}
DI void pv_process(const char* smem, const unsigned* __restrict__ STREAM, bf16_t* __restrict__ YT, int cg, int it0, int it_end, int step) {
  const int lane = fresh_tid() & 63;
  const u32x2* tabl = (const u32x2*)smem;
  int it = it0;
  if (it >= it_end) return;
  PVW W0, W1, W2, W3; PVT T0, T1;
  pv_loadw(W0, STREAM, it, 0, lane); pv_loadw(W1, STREAM, it, 1, lane);
  pv_readt(T0, W0, tabl);
  for (; it < it_end; it += step) {
    const int itn = (it + step < it_end) ? it + step : it;
    f32x2 y[4];
#pragma unroll
    for (int z = 0; z < 4; ++z) y[z] = (f32x2){0.f, 0.f};
#define PV_STEP(g, Wld, Wrd, Trd, Wc, Tc) \
    pv_loadw(Wld, STREAM, ((g) + 2 < 16) ? it : itn, ((g) + 2) & 15, lane); \
    pv_readt(Trd, Wrd, tabl); \
    pv_fma(Wc, Tc, y); \
    asm volatile("" ::: "memory");
    PV_STEP(0, W2, W1, T1, W0, T0)  PV_STEP(1, W3, W2, T0, W1, T1)  PV_STEP(2, W0, W3, T1, W2, T0)  PV_STEP(3, W1, W0, T0, W3, T1)
    PV_STEP(4, W2, W1, T1, W0, T0)  PV_STEP(5, W3, W2, T0, W1, T1)  PV_STEP(6, W0, W3, T1, W2, T0)  PV_STEP(7, W1, W0, T0, W3, T1)
    PV_STEP(8, W2, W1, T1, W0, T0)  PV_STEP(9, W3, W2, T0, W1, T1)  PV_STEP(10, W0, W3, T1, W2, T0) PV_STEP(11, W1, W0, T0, W3, T1)
    PV_STEP(12, W2, W1, T1, W0, T0) PV_STEP(13, W3, W2, T0, W1, T1) PV_STEP(14, W0, W3, T1, W2, T0) PV_STEP(15, W1, W0, T0, W3, T1)
#undef PV_STEP
    const int t = it * 64 + lane;
    u32x4 yw; yw.x = pk2(y[0].x, y[0].y); yw.y = pk2(y[1].x, y[1].y); yw.z = pk2(y[2].x, y[2].y); yw.w = pk2(y[3].x, y[3].y);
    *(u32x4*)(YT + ((size_t)cg * TREAL + t) * 8) = yw;
  }
}
DI void ph_peer_v8(char* smem, const unsigned* __restrict__ STREAM, const u8_t* __restrict__ EV8c, bf16_t* __restrict__ YT, int itb, int nit) {
  const int wave = __builtin_amdgcn_readfirstlane((int)(threadIdx.x >> 6));
  for (int unit = blockIdx.x; unit < 256; unit += gridDim.x) {
    const int cg = unit & 127, th = unit >> 7;
    pv_load_table(smem, EV8c, cg);
    pv_process(smem, STREAM, YT, cg, itb + th * (nit / 2) + wave, itb + (th + 1) * (nit / 2), 8);
    __syncthreads();
  }
}


DI void ph_final_lds(int unit, char* smem, const bf16_t* __restrict__ H1, const bf16_t* __restrict__ YT, const float* __restrict__ gf, float* __restrict__ out) {
  float (*h2)[1028] = (float (*)[1028])smem;
  const int tid = fresh_tid(), lane = tid & 63, wave = tid >> 6;
  const int t0 = unit * 32;
#pragma unroll
  for (int rr = 0; rr < 4; ++rr) {
    const int r = wave * 4 + rr;
    const bf16_t* hp = H1 + (size_t)(t0 + r) * D;
#pragma unroll
    for (int j = 0; j < 2; ++j) {
      const u32x4 hw = *(const u32x4*)(hp + j * 512 + lane * 8);
      *(f32x4*)&h2[r][j * 512 + lane * 8] = (f32x4){bflo(hw.x), bfhi(hw.x), bflo(hw.y), bfhi(hw.y)};
      *(f32x4*)&h2[r][j * 512 + lane * 8 + 4] = (f32x4){bflo(hw.z), bfhi(hw.z), bflo(hw.w), bfhi(hw.w)};
    }
  }
  __syncthreads();
  {
    const int tok = lane & 31;
#pragma unroll 4
    for (int cg = wave * 2 + (lane >> 5); cg < 128; cg += 16) {
      const u32x4 yw = *(const u32x4*)(YT + ((size_t)cg * TREAL + t0 + tok) * 8);
      f32x4* hp = (f32x4*)&h2[tok][cg * 8];
      f32x4 a = hp[0], b4 = hp[1];
      a.x += bflo(yw.x); a.y += bfhi(yw.x); a.z += bflo(yw.y); a.w += bfhi(yw.y);
      b4.x += bflo(yw.z); b4.y += bfhi(yw.z); b4.z += bflo(yw.w); b4.w += bfhi(yw.w);
      hp[0] = a; hp[1] = b4;
    }
  }
  __syncthreads();
#pragma unroll
  for (int rr = 0; rr < 4; ++rr) {
    const int r = wave * 4 + rr;
    f32x4 v[4]; float ss = 0.f;
#pragma unroll
    for (int j = 0; j < 4; ++j) { v[j] = *(const f32x4*)&h2[r][j * 256 + lane * 4]; ss += v[j].x * v[j].x + v[j].y * v[j].y + v[j].z * v[j].z + v[j].w * v[j].w; }
    ss = wave_sum(ss);
    const float sc = rsqrtf(ss * (1.0f / D) + EPS);
    float* op = out + (size_t)(t0 + r) * D;
#pragma unroll
    for (int j = 0; j < 4; ++j) {
      const f32x4 gg = *(const f32x4*)(gf + j * 256 + lane * 4);
      *(f32x4*)(op + j * 256 + lane * 4) = (f32x4){v[j].x * sc * gg.x, v[j].y * sc * gg.y, v[j].z * sc * gg.z, v[j].w * sc * gg.w};
    }
  }
  __syncthreads();
}

typedef int i32x4 __attribute__((ext_vector_type(4)));
constexpr size_t WS_XQ = 861 * MiB;
constexpr size_t WS_XS = 943 * MiB;
DI unsigned pack_i8x4(float a, float b, float c, float d) {
  const int ia = __float2int_rn(a), ib = __float2int_rn(b), ic = __float2int_rn(c), id = __float2int_rn(d);
  return ((unsigned)ia & 255u) | (((unsigned)ib & 255u) << 8) | (((unsigned)ic & 255u) << 16) | ((unsigned)id << 24);
}
DI u32x4 quant_row16_i8(const float* __restrict__ rowp, const f32x4 (&g)[4], int lane, float& sc) {
  const f32x4* rp = (const f32x4*)(rowp + lane * 16);
  const f32x4 a = rp[0] * g[0], b = rp[1] * g[1], c = rp[2] * g[2], d = rp[3] * g[3];
  float m = fmaxf(fmaxf(fmaxf(fabsf(a.x), fabsf(a.y)), fmaxf(fabsf(a.z), fabsf(a.w))), fmaxf(fmaxf(fabsf(b.x), fabsf(b.y)), fmaxf(fabsf(b.z), fabsf(b.w))));
  m = fmaxf(m, fmaxf(fmaxf(fmaxf(fabsf(c.x), fabsf(c.y)), fmaxf(fabsf(c.z), fabsf(c.w))), fmaxf(fmaxf(fabsf(d.x), fabsf(d.y)), fmaxf(fabsf(d.z), fabsf(d.w)))));
  m = wave_max(m);
  sc = m > 0.f ? m * (1.0f / 127.0f) : 1.0f;
  const float inv = 1.0f / sc;
  u32x4 o;
  o.x = pack_i8x4(a.x * inv, a.y * inv, a.z * inv, a.w * inv); o.y = pack_i8x4(b.x * inv, b.y * inv, b.z * inv, b.w * inv);
  o.z = pack_i8x4(c.x * inv, c.y * inv, c.z * inv, c.w * inv); o.w = pack_i8x4(d.x * inv, d.y * inv, d.z * inv, d.w * inv);
  return o;
}
DI void ph_convert_eu_i8(const float* __restrict__ src, const float* __restrict__ gain, u8_t* __restrict__ EUq, float* __restrict__ scaleU) {
  const int tid = fresh_tid(), lane = tid & 63, wave = tid >> 6;
  f32x4 g[4];
#pragma unroll
  for (int j = 0; j < 4; ++j) g[j] = *(const f32x4*)(gain + lane * 16 + 4 * j);
  for (int e = (blockIdx.x * 8 + wave) * 2; e < NEXP; e += gridDim.x * 16) {
    float sc0, sc1 = 1.f;
    const bool two = e + 1 < NEXP;
    const u32x4 o0 = quant_row16_i8(src + (size_t)e * D, g, lane, sc0);
    u32x4 o1 = o0;
    if (two) o1 = quant_row16_i8(src + (size_t)(e + 1) * D, g, lane, sc1);
    *(u32x4*)(EUq + ((size_t)(lane >> 3) * NEXP + e) * 128 + (lane & 7) * 16) = o0;
    if (two) *(u32x4*)(EUq + ((size_t)(lane >> 3) * NEXP + e + 1) * 128 + (lane & 7) * 16) = o1;
    if (lane == 0) { scaleU[e] = sc0; if (two) scaleU[e + 1] = sc1; }
  }
}
DI int dpp_i(int v, const int sel) {
  if (sel == 0) return __builtin_amdgcn_update_dpp(0, v, 0xB1, 0xF, 0xF, true);
  if (sel == 1) return __builtin_amdgcn_update_dpp(0, v, 0x4E, 0xF, 0xF, true);
  return __builtin_amdgcn_update_dpp(0, v, 0x141, 0xF, 0xF, true);
}
DI int dpp_isum8(int v) { v += dpp_i(v, 0); v += dpp_i(v, 1); v += dpp_i(v, 2); return v; }
template <int HF> DI void peer_ud4_issue(PeerUHalf& H, unsigned idxpair, int lane, const u8_t* __restrict__ tab) {
#pragma unroll
  for (int jj = 0; jj < 8; ++jj) {
    const int j = 8 * HF + jj;
    const unsigned w = (unsigned)__shfl((int)idxpair, (lane & ~7) + (j >> 1));
    const unsigned e = (j & 1) ? (w >> 16) : (w & 0xffffu);
    H.u[jj] = *(const u32x4*)(tab + (size_t)e * 128);
  }
}
template <int HF> DI void peer_ud4_compute(const PeerUHalf& H, const u32x4 xq, int sub, int& res0, int& res1) {
#pragma unroll
  for (int jj = 0; jj < 8; ++jj) {
    const int j = 8 * HF + jj;
    int acc = 0;
    acc = __builtin_amdgcn_sdot4((int)H.u[jj].x, (int)xq.x, acc, false); acc = __builtin_amdgcn_sdot4((int)H.u[jj].y, (int)xq.y, acc, false);
    acc = __builtin_amdgcn_sdot4((int)H.u[jj].z, (int)xq.z, acc, false); acc = __builtin_amdgcn_sdot4((int)H.u[jj].w, (int)xq.w, acc, false);
    acc = dpp_isum8(acc);
    if (sub == (j >> 1)) { if (j & 1) res1 = acc; else res0 = acc; }
  }
}
DI void ph_peer_u_d4(int xi, int nx, int wv, int nwv, int tbeg, int tend, const u8_t* __restrict__ XQ, const float* __restrict__ XS, const u8_t* __restrict__ EUq,
                     const unsigned short* __restrict__ EIDX, bf16_t* __restrict__ PP) {
  const int lane = fresh_tid() & 63, sub = lane & 7;
  const int ntok = (tend - tbeg - wv + nwv - 1) / nwv;
  if (ntok <= 0) return;
#define PU_TOK(i) (tbeg + wv + ((i) < ntok ? (i) : ntok - 1) * nwv)
#define PU_IDX(t) __builtin_nontemporal_load((const unsigned*)(EIDX + (size_t)(t) * 128) + lane)
#define PU_LDX(xq_, xs_, t) { xq_ = *(const u32x4*)(xbase + (size_t)(t) * D); xs_ = XS[(size_t)(t) * 8 + s]; }
#define PU_STORE(t, r0, r1, xs_) __builtin_nontemporal_store(pk2((float)(r0) * (xs_), (float)(r1) * (xs_)), (unsigned*)(pp + (size_t)(t) * 128) + lane)
  for (int s = xi; s < 8; s += nx) {
    const u8_t* tab = EUq + (size_t)s * NEXP * 128 + sub * 16;
    const u8_t* xbase = XQ + s * 128 + sub * 16;
    bf16_t* pp = PP + (size_t)s * TREAL * 128;
    PeerUHalf HA, HB, HC;
    int ta = PU_TOK(0), tb = PU_TOK(1), tc = PU_TOK(2);
    unsigned ia = PU_IDX(ta), ib = PU_IDX(tb), ic = PU_IDX(tc);
    u32x4 xqa; float xsa; PU_LDX(xqa, xsa, ta);
    peer_ud4_issue<0>(HA, ia, lane, tab);
    peer_ud4_issue<1>(HB, ia, lane, tab);
    for (int i = 0; i < ntok; i += 3) {
      const int td = PU_TOK(i + 3), te = PU_TOK(i + 4), tf = PU_TOK(i + 5);
      u32x4 xqb, xqc, xqd; float xsb, xsc, xsd;
      int r0, r1;
      peer_ud4_issue<0>(HC, ib, lane, tab); PU_LDX(xqb, xsb, tb); const unsigned id = PU_IDX(td);
      r0 = 0; r1 = 0;
      peer_ud4_compute<0>(HA, xqa, sub, r0, r1);
      peer_ud4_issue<1>(HA, ib, lane, tab);
      peer_ud4_compute<1>(HB, xqa, sub, r0, r1);
      PU_STORE(ta, r0, r1, xsa);
      peer_ud4_issue<0>(HB, ic, lane, tab); PU_LDX(xqc, xsc, tc); const unsigned ie = PU_IDX(te);
      r0 = 0; r1 = 0;
      peer_ud4_compute<0>(HC, xqb, sub, r0, r1);
      peer_ud4_issue<1>(HC, ic, lane, tab);
      peer_ud4_compute<1>(HA, xqb, sub, r0, r1);
      PU_STORE(tb, r0, r1, xsb);
      peer_ud4_issue<0>(HA, id, lane, tab); PU_LDX(xqd, xsd, td); const unsigned if_ = PU_IDX(tf);
      r0 = 0; r1 = 0;
      peer_ud4_compute<0>(HB, xqc, sub, r0, r1);
      peer_ud4_issue<1>(HB, id, lane, tab);
      peer_ud4_compute<1>(HC, xqc, sub, r0, r1);
      PU_STORE(tc, r0, r1, xsc);
      ta = td; tb = te; tc = tf; ib = ie; ic = if_; xqa = xqd; xsa = xsd;
    }
  }
#undef PU_TOK
#undef PU_IDX
#undef PU_LDX
#undef PU_STORE
}

struct PUI { i32x4 a[8]; };
struct PUE { int e[8]; };

#define XB_TMO      128
#define XB_XCNT(j)  (256  + 64 * (j))
#define XB_XSUB(j)  (1280 + 64 * (j))
#define XB_XGEN(j)  (2304 + 64 * (j))
#define XB_TOP      3328
#define XB_TOPGEN   3392
#define XCD_BAR_WORDS 3456
#define XB_SPIN_CAP (1u << 20)
#define LAS __attribute__((address_space(3)))
DI unsigned xb_ld(unsigned* p)              { return __hip_atomic_load(p, __ATOMIC_RELAXED, __HIP_MEMORY_SCOPE_AGENT); }
DI unsigned xb_add(unsigned* p, unsigned v) { return __hip_atomic_fetch_add(p, v, __ATOMIC_RELAXED, __HIP_MEMORY_SCOPE_AGENT); }
DI unsigned xb_xcc_id() { return (unsigned)__builtin_amdgcn_s_getreg((3 << 11) | 20) & 0xFu; }
#define XB_SPIN(cond, bar) do { unsigned _sp = 0; while (cond) { __builtin_amdgcn_s_sleep(1); \
    if ((++_sp & 255u) == 0u) { if (xb_ld(&(bar)[XB_TMO])) break; if (_sp > XB_SPIN_CAP) { atomicAdd(&(bar)[XB_TMO], 1u); break; } } } } while (0)
struct XcdBarrier { unsigned* bar; unsigned x; volatile unsigned* st; };
DI XcdBarrier xcd_barrier_post(unsigned* bar, volatile unsigned* st) {
  XcdBarrier b; b.bar = bar; b.x = xb_xcc_id(); b.st = st;
  if (threadIdx.x == 0) (void)xb_add(&bar[XB_XCNT(b.x)], 1u);
  return b;
}
DI void xcd_barrier_complete(unsigned* bar, unsigned x, unsigned& nloc, unsigned& nx) {
  const unsigned G = gridDim.x;
  unsigned sum, cnt, mine, sp = 0u;
  for (;;) {
    sum = 0u; cnt = 0u; mine = 0u;
#pragma unroll
    for (unsigned j = 0; j < 16; ++j) { const unsigned c = xb_ld(&bar[XB_XCNT(j)]); sum += c; cnt += (c > 0u) ? 1u : 0u; mine = (j == x) ? c : mine; }
    if (sum == G) break;
    __builtin_amdgcn_s_sleep(1);
    if ((++sp & 255u) == 0u) { if (xb_ld(&bar[XB_TMO])) break; if (sp > XB_SPIN_CAP) { atomicAdd(&bar[XB_TMO], 1u); break; } }
  }
  nloc = mine > 0u ? mine : 1u; nx = cnt > 0u ? cnt : 1u;
}
DI void xcd_barrier(const XcdBarrier& b) {
  asm volatile("s_waitcnt vmcnt(0)" ::: "memory");
  __syncthreads();
  if (threadIdx.x == 0) {
    unsigned* bar = b.bar;
    __builtin_amdgcn_s_waitcnt(0);
    unsigned nloc = b.st[0], nx = b.st[1];
    if (nloc == 0u) { xcd_barrier_complete(bar, b.x, nloc, nx); b.st[0] = nloc; b.st[1] = nx; }
    const unsigned old = xb_add(&bar[XB_XSUB(b.x)], 1u);
    const unsigned gen = old / nloc;
    if (old + 1u == (gen + 1u) * nloc) {
      __builtin_amdgcn_fence(__ATOMIC_RELEASE, "agent");
      asm volatile("s_waitcnt vmcnt(0)" ::: "memory");
      const unsigned og = xb_add(&bar[XB_TOP], 1u);
      const unsigned tg = og / nx;
      if (og + 1u == (tg + 1u) * nx) xb_add(&bar[XB_TOPGEN], 1u);
      else XB_SPIN(xb_ld(&bar[XB_TOPGEN]) == tg, bar);
      __builtin_amdgcn_fence(__ATOMIC_ACQUIRE, "agent");
      xb_add(&bar[XB_XGEN(b.x)], 1u);
      asm volatile("s_waitcnt vmcnt(0)" ::: "memory");
    } else {
      XB_SPIN(xb_ld(&bar[XB_XGEN(b.x)]) == gen, bar);
      __builtin_amdgcn_fence(__ATOMIC_ACQUIRE, "agent");
      asm volatile("s_waitcnt vmcnt(0)" ::: "memory");
    }
  }
  __syncthreads();
}

struct Params {
  const float *x, *meta, *norm1_g, *w_in, *wg, *bg, *sb_g, *gla_g, *w_out, *norm2_g, *w_pq, *sk1, *sk2, *eu, *ev, *gf;
  float* out; char* ws;
};
constexpr int PEER_SPLIT_IT = 512;
constexpr int HALF_SMEM = 73728;
constexpr int SMEM_BYTES = 2 * HALF_SMEM;
constexpr size_t WS_BAR = 0;

__global__ void __launch_bounds__(512, 2) k_fused(Params p) {
  extern __shared__ __attribute__((aligned(16))) char smem_dyn[];
  const int half = __builtin_amdgcn_readfirstlane((int)(threadIdx.x >> 8));
  char* smem = smem_dyn + half * HALF_SMEM;
  __shared__ unsigned xb_words[4];
  if (threadIdx.x < 4) xb_words[threadIdx.x] = 0u;
  __syncthreads();
  const XcdBarrier bar = xcd_barrier_post((unsigned*)(p.ws + WS_BAR), xb_words);
  if (threadIdx.x == 0) xb_words[2] = xb_add((unsigned*)(p.ws + WS_XRANK) + bar.x, 1u);
  const int G = 2 * gridDim.x, bid = 2 * blockIdx.x + half;
  char* ws = p.ws;
  bf16_t* WinT = (bf16_t*)(ws + WS_WIN);
  bf16_t* WoutT = (bf16_t*)(ws + WS_WOUT);
  bf16_t* WpqT = (bf16_t*)(ws + WS_WPQ);
  bf16_t* EU = (bf16_t*)(ws + WS_EU);
  bf16_t* EV = (bf16_t*)(ws + WS_EV);
  bf16_t* SK1b = (bf16_t*)(ws + WS_SK1);
  bf16_t* SK2b = (bf16_t*)(ws + WS_SK2);
  bf16_t* A1 = (bf16_t*)(ws + WS_A1);
  float* GO = (float*)(ws + WS_A1);
  bf16_t* A2 = (bf16_t*)(ws + WS_A1);
  InProjOut O;
  O.QSB = (bf16_t*)(ws + WS_QSB); O.KSB = (bf16_t*)(ws + WS_KSB); O.VTSB = (bf16_t*)(ws + WS_VTSB); O.VSB = (bf16_t*)(ws + WS_VSB);
  O.GQ = (bf16_t*)(ws + WS_GQ); O.GK = (bf16_t*)(ws + WS_GK); O.GV = (bf16_t*)(ws + WS_GVT); O.GR = (bf16_t*)(ws + WS_GR);
  O.GLR = (float*)(ws + WS_GLR);
  bf16_t* H1 = (bf16_t*)(ws + WS_H1);
  float* SSQ = (float*)(ws + WS_XS + 3 * MiB);
  float* R1I = (float*)(ws + WS_XS + 4 * MiB);
  bf16_t* GVT = (bf16_t*)(ws + WS_GVT);
  GlaPtrs GP;
  GP.GQ = O.GQ; GP.GK = O.GK; GP.GVT = GVT; GP.GR = O.GR; GP.GLR = O.GLR; GP.wg = p.wg; GP.bg = p.bg; GP.gla_g = p.gla_g;
  GP.SLOC = (float*)(ws + WS_SLOC); GP.DTOT = (float*)(ws + WS_DTOT); GP.MIX = (bf16_t*)(ws + WS_MIX);
  GlaPrepPtrs GPP; GPP.GQ = O.GQ; GPP.GK = O.GK; GPP.GLR = O.GLR; GPP.wg = p.wg; GPP.bg = p.bg;
  GPP.QT = (bf16_t*)(ws + WS_GQT); GPP.KT = (bf16_t*)(ws + WS_GKT); GPP.KTT = (bf16_t*)(ws + WS_GKTT); GPP.DEC = (float*)(ws + WS_GDEC); GPP.BL = (float*)(ws + WS_GBL);
  GlaPtrs3 GP3; GP3.QT = GPP.QT; GP3.KT = GPP.KT; GP3.KTT = GPP.KTT; GP3.GVT = GVT; GP3.GR = O.GR; GP3.DEC = GPP.DEC; GP3.BL = GPP.BL; GP3.gla_g = p.gla_g;
  GP3.SLOC = GP.SLOC; GP3.DTOT = GP.DTOT; GP3.MIX = GP.MIX;
  bf16_t* MIX = (bf16_t*)(ws + WS_MIX);
  bf16_t* QP = (bf16_t*)(ws + WS_MIX);
  unsigned short* EIDX = (unsigned short*)(ws + WS_EIDX);
  bf16_t* PP = (bf16_t*)(ws + WS_PP);
  bf16_t* YT = (bf16_t*)(ws + WS_A1);
  unsigned* STREAM = (unsigned*)(ws + WS_STREAM);
  float* GATE = (float*)(ws + WS_GATE);

  for (int vb = bid; vb < 832 + 256 + 256; vb += G) {
    if (vb < 832) ph_transpose_w(vb % 104, vb / 104, smem, p.w_in, p.norm1_g, WinT, D, NIN);
    else if (vb < 1088) { const int t = vb - 832; ph_transpose_w(t % 32, t / 32, smem, p.w_out, nullptr, WoutT, D, D); }
    else { const int t = vb - 1088; ph_transpose_w(t % 32, t / 32, smem, p.w_pq, p.norm2_g, WpqT, D, D); }
  }
  ph_convert_eu_i8(p.eu, p.norm2_g, (u8_t*)EU, (float*)(ws + WS_SCU));
  for (int vb = bid; vb < NEXP / 32; vb += G) ph_convert_ev8(vb, smem, p.ev, (u8_t*)EV, (float*)(ws + WS_SCV));
  ph_convert(p.sk1, SK1b, (size_t)8 * 128 * 64 / 8);
  ph_convert(p.sk2, SK2b, (size_t)8 * 128 * 64 / 8);
  ph_zero_pads(O.KSB, O.VTSB, O.GQ, O.GK, GVT);
  for (int vb = bid; vb < TREAL / 16; vb += G) ph_norm_rows<0>(vb, p.x, R1I, A1);
  __syncthreads();
  for (int mb = blockIdx.x; mb < NIN / 16; mb += gridDim.x) ph_meta(mb, smem_dyn, p.meta, p.norm1_g, p.w_in, O);
  xcd_barrier(bar);
  {
    pg8::Gemm g{A1, WinT, TREAL, NINP, D}; pg8::StaticOrder S; S.init(TREAL, NINP, (int)gridDim.x, (int)blockIdx.x);
    EpiInProj E{O, GVT, smem_dyn + 131072};
    pg8::gemm_phase<EpiInProj, pg8::StaticOrder, true, true>((PG8_LAS unsigned char*)smem_dyn, g, S, E);
  }
  xcd_barrier(bar);
  for (int it = blockIdx.x; it < 16 * 129; it += gridDim.x) ph_gla_prep(it, smem_dyn, GPP);
  xcd_barrier(bar);
  for (int it = blockIdx.x; it < 16 * 15; it += gridDim.x) gla_item4<0>(it / 15, it % 15, smem_dyn, GP3);
  for (int vb = bid; vb < 64 * 32; vb += G) ph_sb_attn2(vb, O.QSB, O.KSB, O.VTSB, p.sb_g, MIX);
  xcd_barrier(bar);
  for (int it = blockIdx.x; it < 16 * 16; it += gridDim.x) gla_item4<1>(it >> 4, it & 15, smem_dyn, GP3);
  xcd_barrier(bar);
  {
    pg8::Gemm g{MIX, WoutT, TREAL, D, D}; pg8::StaticOrder S; S.init(TREAL, D, (int)gridDim.x, (int)blockIdx.x);
    EpiOut E{A1, R1I, H1, (u8_t*)(ws + WS_XQ), (float*)(ws + WS_XS), SSQ, (float*)(smem_dyn + 131072)};
    pg8::gemm_phase<EpiOut, pg8::StaticOrder, true, true>((PG8_LAS unsigned char*)smem_dyn, g, S, E);
  }
  xcd_barrier(bar);
  {
    pg8::Gemm g{H1, WpqT, TREAL, D, D}; pg8::StaticOrder S; S.init(TREAL, D, (int)gridDim.x, (int)blockIdx.x);
    EpiPQ E{QP, SSQ};
    pg8::gemm_phase<EpiPQ, pg8::StaticOrder, true, true>((PG8_LAS unsigned char*)smem_dyn, g, S, E);
  }
  xcd_barrier(bar);
  {
    const int NV = 8 * (TREAL / 128);
    route_stage_keys(bid & 7, smem, SK1b, SK2b);
    const int rlane = (int)(threadIdx.x & 63u), rwave = (int)((threadIdx.x >> 6) & 3u);
    bf16x8 qa[2][4], qb[2][4];
    if (bid < NV) route_load_q(qa, QP, (bid >> 3) * 128 + rwave * 32 + (rlane & 31), bid & 7, rlane >> 5);
    for (int vb = bid; vb < NV; vb += 2 * G) {
      const int v1 = vb + G, v2 = vb + 2 * G;
      if (v1 < NV) route_load_q(qb, QP, (v1 >> 3) * 128 + rwave * 32 + (rlane & 31), v1 & 7, rlane >> 5);
      ph_route_v2(vb, smem, qa, EIDX, GATE);
      if (v1 < NV) {
        if (v2 < NV) route_load_q(qa, QP, (v2 >> 3) * 128 + rwave * 32 + (rlane & 31), v2 & 7, rlane >> 5);
        ph_route_v2(v1, smem, qb, EIDX, GATE);
      }
    }
  }
  xcd_barrier(bar);
  {
    __shared__ int xinfo[4];
    if (threadIdx.x == 0) {
      unsigned* barw = (unsigned*)(p.ws + WS_BAR);
      unsigned cnt = 0, ord = 0, mine = 1;
      for (unsigned j = 0; j < 16; ++j) { const unsigned c = xb_ld(&barw[XB_XCNT(j)]); if (c > 0) { if (j < bar.x) ++ord; ++cnt; } if (j == bar.x) mine = c; }
      xinfo[0] = (int)ord; xinfo[1] = (int)cnt; xinfo[2] = (int)xb_words[2]; xinfo[3] = (int)mine;
    }
    __syncthreads();
    const int xi = xinfo[0], nx = xinfo[1], rank = xinfo[2], nloc = xinfo[3];
    const int wave = __builtin_amdgcn_readfirstlane((int)(threadIdx.x >> 6));
    const u8_t* XQp = (const u8_t*)(ws + WS_XQ); const float* XSp = (const float*)(ws + WS_XS);
    constexpr int ITA = PEER_SPLIT_IT, TSPLIT = ITA * 64;
    ph_peer_u_d4(xi, nx, rank * 8 + wave, nloc * 8, 0, TSPLIT, XQp, XSp, (const u8_t*)EU, EIDX, PP);
    xcd_barrier(bar);
    pc_stage_scales(smem_dyn, (const float*)(ws + WS_SCU), (const float*)(ws + WS_SCV));
    for (int unit = blockIdx.x; unit < ITA; unit += gridDim.x) ph_peer_c8(unit, smem_dyn, PP, EIDX, GATE, SSQ, STREAM);
    xcd_barrier(bar);
    if (gridDim.x >= 256) {
      const int cg = blockIdx.x & 127, th = (blockIdx.x >> 7) & 1;
      if (blockIdx.x < 256) pv_load_table(smem_dyn, (const u8_t*)EV, cg); else __syncthreads();
      if (wave < 4) { if (blockIdx.x < 256) pv_process(smem_dyn, STREAM, YT, cg, th * (ITA / 2) + wave, (th + 1) * (ITA / 2), 4); }
      else ph_peer_u_d4(xi, nx, rank * 4 + wave - 4, nloc * 4, TSPLIT, TREAL, XQp, XSp, (const u8_t*)EU, EIDX, PP);
    } else {
      ph_peer_u_d4(xi, nx, rank * 8 + wave, nloc * 8, TSPLIT, TREAL, XQp, XSp, (const u8_t*)EU, EIDX, PP);
      ph_peer_v8(smem_dyn, STREAM, (const u8_t*)EV, YT, 0, ITA);
    }
    xcd_barrier(bar);
    pc_stage_scales(smem_dyn, (const float*)(ws + WS_SCU), (const float*)(ws + WS_SCV));
    for (int unit = ITA + blockIdx.x; unit < TREAL / 64; unit += gridDim.x) ph_peer_c8(unit, smem_dyn, PP, EIDX, GATE, SSQ, STREAM);
    xcd_barrier(bar);
    ph_peer_v8(smem_dyn, STREAM, (const u8_t*)EV, YT, ITA, TREAL / 64 - ITA);
  }
  xcd_barrier(bar);
  for (int unit = blockIdx.x; unit < TREAL / 32; unit += gridDim.x) ph_final_lds(unit, smem_dyn, H1, YT, p.gf, p.out);
}

extern "C" void kernel_launch(void* const* d_in, const int* in_sizes, int n_in, void* d_out, int out_size, void* d_ws, size_t ws_size, hipStream_t stream) {
  static int grid = 0;
  if (grid == 0) {
    int dev = 0, cus = 0, per_cu = 0;
    hipGetDevice(&dev);
    hipDeviceGetAttribute(&cus, hipDeviceAttributeMultiprocessorCount, dev);
    hipFuncSetAttribute((const void*)k_fused, hipFuncAttributeMaxDynamicSharedMemorySize, SMEM_BYTES);
    hipOccupancyMaxActiveBlocksPerMultiprocessor(&per_cu, (const void*)k_fused, 512, SMEM_BYTES);
    if (per_cu > 1) per_cu = 1;
    if (per_cu < 1) per_cu = 1;
    grid = cus * per_cu;
  }
  hipMemsetAsync((char*)d_ws + WS_BAR, 0, 32768, stream);
  Params p{};
  p.x = (const float*)d_in[0]; p.meta = (const float*)d_in[1]; p.norm1_g = (const float*)d_in[2]; p.w_in = (const float*)d_in[3];
  p.wg = (const float*)d_in[4]; p.bg = (const float*)d_in[5]; p.sb_g = (const float*)d_in[6]; p.gla_g = (const float*)d_in[7];
  p.w_out = (const float*)d_in[8]; p.norm2_g = (const float*)d_in[9]; p.w_pq = (const float*)d_in[10]; p.sk1 = (const float*)d_in[11];
  p.sk2 = (const float*)d_in[12]; p.eu = (const float*)d_in[13]; p.ev = (const float*)d_in[14]; p.gf = (const float*)d_in[15];
  p.out = (float*)d_out; p.ws = (char*)d_ws;
  void* args[] = {&p};
  hipLaunchCooperativeKernel((const void*)k_fused, dim3(grid), dim3(512), args, SMEM_BYTES, stream);
}
```

```cpp
#include <hip/hip_runtime.h>
#include <stdint.h>
#include <stddef.h>

typedef unsigned short bf16_t;
typedef short bf16x8 __attribute__((ext_vector_type(8)));
typedef float f32x16 __attribute__((ext_vector_type(16)));
typedef float f32x4 __attribute__((ext_vector_type(4)));
typedef float f32x2 __attribute__((ext_vector_type(2)));
typedef unsigned u32x4 __attribute__((ext_vector_type(4)));
typedef unsigned u32x2 __attribute__((ext_vector_type(2)));
typedef __bf16 bf16x2_t __attribute__((ext_vector_type(2)));

#define DI __device__ __forceinline__
__device__ __forceinline__ int fresh_tid() { int t = (int)threadIdx.x; asm volatile("" : "+v"(t)); return t; }
#define TID tid256_
#define MFMA32(a, b, c) __builtin_amdgcn_mfma_f32_32x32x16_bf16((a), (b), (c), 0, 0, 0)

constexpr int D = 1024, NB = 8, SEQ = 8192, NMETA = 16;
constexpr int TREAL = NB * SEQ;
constexpr int MROWS = TREAL + 128;
constexpr int NIN = 3088, NINP = 3328;
constexpr int SBH = 8, SBD = 64;
constexpr int GH = 4, GDK = 64, GDV = 128;
constexpr int KIDX = SEQ + 32;
constexpr int GU = SEQ + 64;
constexpr int NEXP = 16384;
constexpr float EPS = 1e-6f;

constexpr size_t MiB = 1u << 20;
constexpr size_t WS_WIN = 1 * MiB;
constexpr size_t WS_WOUT = 8 * MiB;
constexpr size_t WS_WPQ = 10 * MiB;
constexpr size_t WS_SK1 = 12 * MiB;
constexpr size_t WS_SK2 = 13 * MiB;
constexpr size_t WS_EU = 16 * MiB;
constexpr size_t WS_EV = 48 * MiB;
constexpr size_t WS_A1 = 80 * MiB;
constexpr size_t WS_QSB = 210 * MiB;
constexpr size_t WS_KSB = 274 * MiB;
constexpr size_t WS_VTSB = 339 * MiB;
constexpr size_t WS_GQ = 404 * MiB;
constexpr size_t WS_GK = 437 * MiB;
constexpr size_t WS_H1 = 210 * MiB;
constexpr size_t WS_GV = 470 * MiB;
constexpr size_t WS_GR = 535 * MiB;
constexpr size_t WS_GLR = 599 * MiB;
constexpr size_t WS_LG = 604 * MiB;
constexpr size_t WS_MIX = 669 * MiB;
constexpr size_t WS_EIDX = 797 * MiB;
constexpr size_t WS_GATE = 829 * MiB;
constexpr size_t WS_PP = 470 * MiB;
constexpr size_t WS_STREAM = 726 * MiB;
constexpr size_t WS_XRANK = 16384;
constexpr size_t WS_VSB = 861 * MiB;
constexpr size_t WS_END = 926 * MiB;

DI unsigned f2bf(float f) { unsigned u = __float_as_uint(f); return (u + 0x7fffu + ((u >> 16) & 1u)) >> 16; }
DI float bf2f(unsigned b) { return __uint_as_float(b << 16); }
DI unsigned pk2(float lo, float hi) { f32x2 v = {lo, hi}; return __builtin_bit_cast(unsigned, __builtin_convertvector(v, bf16x2_t)); }
DI float bflo(unsigned u) { return __uint_as_float(u << 16); }
DI float bfhi(unsigned u) { return __uint_as_float(u & 0xffff0000u); }
DI int crow(int reg, int h) { return (reg & 3) + 8 * (reg >> 2) + 4 * h; }
DI float wave_sum(float v) {
#pragma unroll
  for (int o = 32; o >= 1; o >>= 1) v += __shfl_xor(v, o);
  return v;
}
DI float softplus(float z) { return fmaxf(z, 0.f) + __logf(1.f + __expf(-fabsf(z))); }

DI void ph_transpose_w(int bx, int by, char* smem, const float* __restrict__ W, const float* __restrict__ gain, bf16_t* __restrict__ WT, int K, int N) {
  const int tid256_ = fresh_tid() & 255;
  float (*t)[33] = (float (*)[33])smem;
  const int n0 = bx * 32, k0 = by * 128;
  {
    const int kr = TID >> 3, c4 = (TID & 7) * 4;
    f32x4 v[4];
#pragma unroll
    for (int j = 0; j < 4; ++j) v[j] = (n0 + c4 < N) ? *(const f32x4*)(W + (size_t)(k0 + kr + 32 * j) * N + n0 + c4) : (f32x4){0.f, 0.f, 0.f, 0.f};
#pragma unroll
    for (int j = 0; j < 4; ++j) {
      const float g = gain ? gain[k0 + kr + 32 * j] : 1.f;
      t[kr + 32 * j][c4 + 0] = v[j].x * g; t[kr + 32 * j][c4 + 1] = v[j].y * g; t[kr + 32 * j][c4 + 2] = v[j].z * g; t[kr + 32 * j][c4 + 3] = v[j].w * g;
    }
  }
  __syncthreads();
  {
    const int n = TID >> 3, ks = (TID & 7) * 16;
    unsigned w[8];
#pragma unroll
    for (int i = 0; i < 8; ++i) w[i] = pk2(t[ks + 2 * i][n], t[ks + 2 * i + 1][n]);
    bf16_t* dst = WT + (size_t)(n0 + n) * K + k0 + ks;
    *(u32x4*)dst = (u32x4){w[0], w[1], w[2], w[3]};
    *(u32x4*)(dst + 8) = (u32x4){w[4], w[5], w[6], w[7]};
  }
  __syncthreads();
}
DI void ph_convert(const float* __restrict__ src, bf16_t* __restrict__ dst, size_t n8) {
  size_t i = (size_t)blockIdx.x * blockDim.x + threadIdx.x;
  const size_t stride = (size_t)gridDim.x * blockDim.x;
  for (; i < n8; i += stride) {
    const f32x4 a = ((const f32x4*)src)[2 * i], b = ((const f32x4*)src)[2 * i + 1];
    u32x4 o; o.x = pk2(a.x, a.y); o.y = pk2(a.z, a.w); o.z = pk2(b.x, b.y); o.w = pk2(b.z, b.w);
    ((u32x4*)dst)[i] = o;
  }
}
DI void ph_zero_pads(bf16_t* KSB, bf16_t* VTSB, bf16_t* GQ, bf16_t* GK, bf16_t* GVT) {
  const int tid = blockIdx.x * blockDim.x + threadIdx.x, nth = gridDim.x * blockDim.x;
  for (int i = tid; i < 64 * 16 * 64; i += nth) { const int bh = i / 1024, r = i % 1024; KSB[(size_t)bh * KIDX * 64 + r] = 0; }
  for (int i = tid; i < 64 * 64 * 16; i += nth) { const int row = i / 16, c = i % 16; VTSB[(size_t)row * KIDX + c] = 0; }
  for (int i = tid; i < 32 * 48 * 64; i += nth) { const int bh = i / 3072, r = i % 3072; GQ[(size_t)bh * GU * 64 + r] = 0; GK[(size_t)bh * GU * 64 + r] = 0; }
  for (int i = tid; i < 32 * 128 * 48; i += nth) { const int row = i / 48, c = i % 48; GVT[(size_t)row * GU + c] = 0; }
}

template <int MODE>
DI void ph_norm_rows(int vb, const float* __restrict__ src, const float* __restrict__ meta, bf16_t* __restrict__ dst) {
  const int tid256_ = fresh_tid() & 255;
  const int row0 = vb * 16 + (TID >> 6) * 4, lane = TID & 63;
  f32x4 v[4][4];
#pragma unroll
  for (int rr = 0; rr < 4; ++rr)
#pragma unroll
    for (int j = 0; j < 4; ++j) v[rr][j] = *(const f32x4*)(src + (size_t)(row0 + rr) * D + j * 256 + lane * 4);
  f32x4 gg[4];
#pragma unroll
  for (int j = 0; j < 4; ++j) { gg[j] = (f32x4){1.f, 1.f, 1.f, 1.f}; if (MODE == 1) gg[j] = *(const f32x4*)(meta + j * 256 + lane * 4); }
#pragma unroll
  for (int rr = 0; rr < 4; ++rr) {
    float ss = 0.f;
#pragma unroll
    for (int j = 0; j < 4; ++j) ss += v[rr][j].x * v[rr][j].x + v[rr][j].y * v[rr][j].y + v[rr][j].z * v[rr][j].z + v[rr][j].w * v[rr][j].w;
    ss = wave_sum(ss);
    const float r = rsqrtf(ss * (1.0f / D) + EPS);
    if (MODE == 0 && lane == 0) const_cast<float*>(meta)[row0 + rr] = sqrtf(ss * (1.0f / D) + EPS);
#pragma unroll
    for (int j = 0; j < 4; ++j) {
      u32x2 o; o.x = pk2(v[rr][j].x * r * gg[j].x, v[rr][j].y * r * gg[j].y); o.y = pk2(v[rr][j].z * r * gg[j].z, v[rr][j].w * r * gg[j].w);
      *(u32x2*)(dst + (size_t)(row0 + rr) * D + j * 256 + lane * 4) = o;
    }
  }
}

namespace pg8 {
#define PG8_LAS __attribute__((address_space(3)))
typedef unsigned short bf16_t;
typedef short bf16x8 __attribute__((ext_vector_type(8)));
typedef float f32x4 __attribute__((ext_vector_type(4)));
typedef unsigned u32x4 __attribute__((ext_vector_type(4)));
constexpr int BM = 256, BK = 64, HALF = 128, HTB = HALF * BK * 2  , STAGE_BYTES = 8 * HTB, NXCD = 8, WGM = 8;

__host__ __device__ __forceinline__ int lds_byte(int r, int c) { const int st = (r >> 4) * 2 + (c >> 5), rr = r & 15, cc = c & 31, ob = rr * 64 + cc * 2; return st * 1024 + (ob ^ (((ob >> 9) & 1) << 5)); }
__host__ __device__ __forceinline__ void stage_rc(int b, int& R, int& C) { const int st = b / 1024, sb = b % 1024, swz = sb ^ (((sb >> 9) & 1) << 5); R = (st >> 1) * 16 + swz / 64; C = (st & 1) * 32 + (swz % 64) / 2; }
__host__ __device__ __forceinline__ int perm32(int rho) { const int n = rho >> 4, i = rho & 15; return 8 * (i >> 2) + 4 * n + (i & 3); }

struct Unit { int pm, pn; };
struct Gemm { const bf16_t* A; const bf16_t* Bt; int M, N, K; };

struct StaticOrder {
    int nM, nN, nwg, G, c;
    __host__ __device__ void init(int M, int N, int G_, int c_) { nM = M / BM; nN = N / BM; nwg = nM * nN; G = G_; c = c_; }
    __host__ __device__ bool next(int i, Unit& u) const {
        const long L = (long)i * G + c; if (L >= nwg) return false;
        int wgid = (int)L; { const int q = nwg / NXCD, r = nwg % NXCD, xcd = wgid % NXCD, off = wgid / NXCD; wgid = (xcd < r ? xcd * (q + 1) : r * (q + 1) + (xcd - r) * q) + off; }
        const int nig = WGM * nN, gid = wgid / nig, fm = gid * WGM, gsz = (nM - fm) < WGM ? (nM - fm) : WGM;
        u.pm = fm + ((wgid % nig) % gsz); u.pn = (wgid % nig) / gsz; return true;
    }
    __device__ __forceinline__ void a_ready(const Unit&) const {}
    __device__ __forceinline__ void done(const Unit&) const {}
};

template <class Epi, class Sched, bool ALIGN_EPI = false, bool SP2 = false>
__device__ __forceinline__ void gemm_phase(PG8_LAS unsigned char* lds, const Gemm g, const Sched& S, const Epi& E) {
    const int tid = fresh_tid(), wid = __builtin_amdgcn_readfirstlane(tid >> 6), lane = tid & 63, wr = wid >> 2, wc = wid & 3, fr = lane & 15, fq = lane >> 4;
    const int K = g.K, nt = K / BK;
    unsigned voffA[2], voffB[2];
#pragma unroll
    for (int i = 0; i < 2; ++i) { int R, C; stage_rc(tid * 16 + i * 8192, R, C); const int Rb = Epi::PERM ? ((R & ~31) + perm32(R & 31)) : R;
        voffA[i] = (unsigned)(R * K + C) * 2u; voffB[i] = (unsigned)(Rb * K + C) * 2u; }
    const size_t kstep = (size_t)(BK * 2);
    const size_t hstep = (size_t)HALF * K * 2;
    const size_t tstep = 2 * hstep;
    const unsigned ldsw = (unsigned)wid * 1024u;
    const int aoff = lds_byte(wr * 64 + fr, fq * 8), boff = lds_byte(wc * 32 + fr, fq * 8);
#define PG8_SA(b, h) (((b) * 2 + (h)) * HTB)
#define PG8_SB(b, h) ((4 + (b) * 2 + (h)) * HTB)
#define PG8_STAGE(bufoff, gbase, voff) do { _Pragma("unroll") for (int _i = 0; _i < 2; ++_i) \
        __builtin_amdgcn_global_load_lds((const unsigned*)((const char*)(gbase) + (voff)[_i]), (PG8_LAS unsigned*)(lds + (bufoff) + ldsw + _i * 8192), 16, 0, 0); } while (0)
#define PG8_LDA(dst, b, h) do { _Pragma("unroll") for (int m = 0; m < 4; ++m) _Pragma("unroll") for (int k = 0; k < 2; ++k) dst[m][k] = *(const PG8_LAS bf16x8*)(lds + PG8_SA(b, h) + aoff + m * 2048 + k * 1024); } while (0)
#define PG8_LDB(dst, b, h) do { _Pragma("unroll") for (int n = 0; n < 2; ++n) _Pragma("unroll") for (int k = 0; k < 2; ++k) dst[n][k] = *(const PG8_LAS bf16x8*)(lds + PG8_SB(b, h) + boff + n * 2048 + k * 1024); } while (0)
#define PG8_MMA(ai, bj, At, Bt) do { __builtin_amdgcn_s_setprio(1); _Pragma("unroll") for (int m = 0; m < 4; ++m) _Pragma("unroll") for (int n = 0; n < 2; ++n) _Pragma("unroll") for (int k = 0; k < 2; ++k) \
        acc[ai][bj][m][n] = __builtin_amdgcn_mfma_f32_16x16x32_bf16(Bt[n][k], At[m][k], acc[ai][bj][m][n], 0, 0, 0); __builtin_amdgcn_s_setprio(0); } while (0)
#define PG8_WAIT_V(n) asm volatile("s_waitcnt vmcnt(" #n ")" ::: "memory")
#define PG8_WAIT_L(n) asm volatile("s_waitcnt lgkmcnt(" #n ")" ::: "memory")
#define PG8_BAR __builtin_amdgcn_s_barrier()
#define PG8_SCHED __builtin_amdgcn_sched_barrier(0)
    Unit cur, nxt; int ui = 0;
    if (!S.next(0, cur)) return;
    f32x4 acc[2][2][4][2];
#pragma unroll
    for (int a = 0; a < 2; ++a)
#pragma unroll
        for (int b = 0; b < 2; ++b)
#pragma unroll
            for (int m = 0; m < 4; ++m)
#pragma unroll
                for (int n = 0; n < 2; ++n) acc[a][b][m][n] = (f32x4){0.f, 0.f, 0.f, 0.f};
    bf16x8 At[4][2], B0[2][2], B1[2][2];
    const char* cA = (const char*)g.A + (size_t)cur.pm * tstep; const char* cB = (const char*)g.Bt + (size_t)cur.pn * tstep;
    S.a_ready(cur);
    if constexpr (SP2) {
        PG8_STAGE(PG8_SB(0, 0), cB, voffB); PG8_STAGE(PG8_SB(0, 1), cB + hstep, voffB); PG8_STAGE(PG8_SA(0, 0), cA, voffA); PG8_STAGE(PG8_SA(0, 1), cA + hstep, voffA);
        if (wr == 1) PG8_BAR;
        PG8_WAIT_V(2); PG8_BAR;
        PG8_STAGE(PG8_SB(1, 0), cB + kstep, voffB); PG8_STAGE(PG8_SA(1, 0), cA + kstep, voffA); PG8_STAGE(PG8_SB(1, 1), cB + hstep + kstep, voffB);
        PG8_WAIT_V(6); PG8_BAR;
    } else {
        PG8_STAGE(PG8_SB(0, 0), cB, voffB); PG8_STAGE(PG8_SA(0, 0), cA, voffA); PG8_STAGE(PG8_SB(0, 1), cB + hstep, voffB); PG8_STAGE(PG8_SA(0, 1), cA + hstep, voffA);
        if (wr == 1) PG8_BAR;
        PG8_WAIT_V(4); PG8_BAR;
        PG8_STAGE(PG8_SB(1, 0), cB + kstep, voffB); PG8_STAGE(PG8_SA(1, 0), cA + kstep, voffA); PG8_STAGE(PG8_SB(1, 1), cB + hstep + kstep, voffB);
        PG8_WAIT_V(6); PG8_BAR;
    }
    for (;;) {
        const bool has_next = S.next(ui + 1, nxt);
        const char* nA = has_next ? (const char*)g.A + (size_t)nxt.pm * tstep : cA; const char* nB = has_next ? (const char*)g.Bt + (size_t)nxt.pn * tstep : cB;
        for (int t = 0; t < nt; t += 2) {
            const bool last = (t == nt - 2);
            const char* a1 = cA + (size_t)(t + 1) * kstep;
            const char* a2 = last ? nA : cA + (size_t)(t + 2) * kstep; const char* b2 = last ? nB : cB + (size_t)(t + 2) * kstep;
            const char* a3 = a2 + kstep; const char* b3 = b2 + kstep;
            if (last && has_next) S.a_ready(nxt);
            if constexpr (SP2) {
            PG8_LDB(B0, 0, 0); PG8_LDB(B1, 0, 1); PG8_SCHED; PG8_LDA(At, 0, 0); PG8_STAGE(PG8_SA(1, 1), a1 + hstep, voffA);
            PG8_WAIT_V(8); PG8_WAIT_L(0); PG8_BAR; PG8_MMA(0, 0, At, B0); PG8_MMA(0, 1, At, B1); PG8_BAR; PG8_SCHED;
            PG8_LDA(At, 0, 1); PG8_STAGE(PG8_SB(0, 0), b2, voffB); PG8_STAGE(PG8_SB(0, 1), b2 + hstep, voffB); PG8_STAGE(PG8_SA(0, 0), a2, voffA);
            PG8_WAIT_V(8); PG8_WAIT_L(0); PG8_BAR; PG8_MMA(1, 0, At, B0); PG8_MMA(1, 1, At, B1); PG8_BAR; PG8_SCHED;
            PG8_LDB(B0, 1, 0); PG8_LDB(B1, 1, 1); PG8_SCHED; PG8_LDA(At, 1, 0); PG8_STAGE(PG8_SA(0, 1), a2 + hstep, voffA);
            PG8_WAIT_V(8); PG8_WAIT_L(0); PG8_BAR; PG8_MMA(0, 0, At, B0); PG8_MMA(0, 1, At, B1); PG8_BAR; PG8_SCHED;
            PG8_LDA(At, 1, 1); PG8_STAGE(PG8_SB(1, 0), b3, voffB); PG8_STAGE(PG8_SB(1, 1), b3 + hstep, voffB); PG8_STAGE(PG8_SA(1, 0), a3, voffA);
            PG8_WAIT_V(8); PG8_WAIT_L(0); PG8_BAR; PG8_MMA(1, 0, At, B0); PG8_MMA(1, 1, At, B1); PG8_BAR; PG8_SCHED;
            } else {
            PG8_LDB(B0, 0, 0); PG8_SCHED; PG8_LDA(At, 0, 0); PG8_STAGE(PG8_SA(1, 1), a1 + hstep, voffA);
            PG8_WAIT_L(8); PG8_BAR; PG8_WAIT_L(0); PG8_MMA(0, 0, At, B0); PG8_BAR; PG8_SCHED;
            PG8_LDB(B1, 0, 1); PG8_STAGE(PG8_SB(0, 0), b2, voffB);
            PG8_BAR; PG8_WAIT_L(0); PG8_MMA(0, 1, At, B1); PG8_BAR;
            PG8_LDA(At, 0, 1); PG8_STAGE(PG8_SA(0, 0), a2, voffA);
            PG8_BAR; PG8_WAIT_L(0); PG8_MMA(1, 0, At, B0); PG8_BAR; PG8_SCHED;
            PG8_STAGE(PG8_SB(0, 1), b2 + hstep, voffB);
            PG8_WAIT_V(6); PG8_BAR; PG8_MMA(1, 1, At, B1); PG8_BAR;
            PG8_LDB(B0, 1, 0); PG8_SCHED; PG8_LDA(At, 1, 0); PG8_STAGE(PG8_SA(0, 1), a2 + hstep, voffA);
            PG8_WAIT_L(8); PG8_BAR; PG8_WAIT_L(0); PG8_MMA(0, 0, At, B0); PG8_BAR; PG8_SCHED;
            PG8_LDB(B1, 1, 1); PG8_STAGE(PG8_SB(1, 0), b3, voffB);
            PG8_BAR; PG8_WAIT_L(0); PG8_MMA(0, 1, At, B1); PG8_BAR;
            PG8_LDA(At, 1, 1); PG8_STAGE(PG8_SA(1, 0), a3, voffA);
            PG8_BAR; PG8_WAIT_L(0); PG8_MMA(1, 0, At, B0); PG8_BAR; PG8_SCHED;
            PG8_STAGE(PG8_SB(1, 1), b3 + hstep, voffB);
            PG8_WAIT_V(6); PG8_BAR; PG8_MMA(1, 1, At, B1); PG8_BAR;
            }
        }
        if constexpr (ALIGN_EPI) { if (wr == 0) PG8_BAR; }
        if constexpr (!Epi::AFTER_DRAIN) { E(acc, cur, wr, wc, fr, fq); S.done(cur); }
        if (!has_next) break;
#pragma unroll
        for (int a = 0; a < 2; ++a)
#pragma unroll
            for (int b = 0; b < 2; ++b)
#pragma unroll
                for (int m = 0; m < 4; ++m)
#pragma unroll
                    for (int n = 0; n < 2; ++n) acc[a][b][m][n] = (f32x4){0.f, 0.f, 0.f, 0.f};
        cur = nxt; cA = nA; cB = nB; ++ui;
        if constexpr (ALIGN_EPI) { if (wr == 1) PG8_BAR; }
    }
    PG8_WAIT_V(0);
    if constexpr (!ALIGN_EPI) { if (wr == 0) PG8_BAR; }
    PG8_BAR;
    if constexpr (Epi::AFTER_DRAIN) { E.fused(acc, cur, wr, wc, fr, fq, lds, wid, lane); S.done(cur); }
#undef PG8_SA
#undef PG8_SB
#undef PG8_STAGE
#undef PG8_LDA
#undef PG8_LDB
#undef PG8_MMA
#undef PG8_WAIT_V
#undef PG8_WAIT_L
#undef PG8_BAR
#undef PG8_SCHED
}
}

struct InProjOut { bf16_t *QSB, *KSB, *VSB, *VTSB, *GQ, *GK, *GV, *GR; float* GLR; };

struct EpiInProj {
  static constexpr bool PERM = true, AFTER_DRAIN = false;
  InProjOut O; bf16_t* GVT; char* stage;
  DI void store_vt(const pg8::f32x4 (&acc)[2][2][4][2], const pg8::Unit& u, int wr, int wc, int fr, int fq) const {
    bf16_t* st = (bf16_t*)(stage + (wr * 4 + wc) * 1280);
    const int lane = fr + 16 * fq;
    const int rc = lane >> 2, r8 = lane & 3;
#pragma unroll
    for (int ai = 0; ai < 2; ++ai)
#pragma unroll
      for (int bj = 0; bj < 2; ++bj)
#pragma unroll
        for (int mp = 0; mp < 2; ++mp)
#pragma unroll
          for (int ch = 0; ch < 2; ++ch) {
            if ((fq >> 1) == ch) {
#pragma unroll
              for (int m2 = 0; m2 < 2; ++m2)
#pragma unroll
                for (int n = 0; n < 2; ++n) {
                  const pg8::f32x4 v = acc[ai][bj][2 * mp + m2][n];
                  const int cl = 8 * (fq & 1) + 4 * n, rl = 16 * m2 + fr;
                  st[(cl + 0) * 40 + rl] = (bf16_t)f2bf(v[0]); st[(cl + 1) * 40 + rl] = (bf16_t)f2bf(v[1]);
                  st[(cl + 2) * 40 + rl] = (bf16_t)f2bf(v[2]); st[(cl + 3) * 40 + rl] = (bf16_t)f2bf(v[3]);
                }
            }
            asm volatile("s_waitcnt lgkmcnt(0)" ::: "memory");
            const u32x4 w = *(const u32x4*)&st[rc * 40 + 8 * r8];
            asm volatile("" ::: "memory");
            const int col = u.pn * 256 + bj * 128 + wc * 32 + 16 * ch + rc;
            const int row = u.pm * 256 + ai * 128 + wr * 64 + 32 * mp + 8 * r8;
            const int b = row >> 13, i = row & 8191;
            bf16_t* dst;
            if (u.pn < 6) { const int c = col - 1024; dst = O.VTSB + ((size_t)(b * SBH + (c >> 6)) * 64 + (c & 63)) * KIDX + 32 + i; }
            else          { const int c = col - 2048; dst = GVT + ((size_t)(b * GH + (c >> 7)) * 128 + (c & 127)) * GU + 64 + i; }
            *(u32x4*)dst = w;
          }
  }
  DI void operator()(const pg8::f32x4 (&acc)[2][2][4][2], const pg8::Unit& u, int wr, int wc, int fr, int fq) const {
    const int pn = u.pn;
    if (pn == 4 || pn == 5 || pn == 8 || pn == 9) { store_vt(acc, u, wr, wc, fr, fq); return; }
#pragma unroll
    for (int ai = 0; ai < 2; ++ai)
#pragma unroll
      for (int m = 0; m < 4; ++m) {
        const int row = u.pm * 256 + ai * 128 + wr * 64 + m * 16 + fr;
        const int b = row >> 13, i = row & 8191;
#pragma unroll
        for (int bj = 0; bj < 2; ++bj) {
          const int col = pn * 256 + bj * 128 + wc * 32 + 8 * fq;
          const pg8::f32x4 v0 = acc[ai][bj][m][0], v1 = acc[ai][bj][m][1];
          if (pn < 12) {
            u32x4 w; w.x = pk2(v0[0], v0[1]); w.y = pk2(v0[2], v0[3]); w.z = pk2(v1[0], v1[1]); w.w = pk2(v1[2], v1[3]);
            bf16_t* dst;
            if (pn < 2)       { const int c = col;        dst = O.QSB + ((size_t)(b * SBH + (c >> 6)) * SEQ + i) * 64 + (c & 63); }
            else if (pn < 4)  { const int c = col - 512;  dst = O.KSB + ((size_t)(b * SBH + (c >> 6)) * KIDX + 32 + i) * 64 + (c & 63); }
            else if (pn == 6) { const int c = col - 1536; dst = O.GQ + ((size_t)(b * GH + (c >> 6)) * GU + 64 + i) * 64 + (c & 63); }
            else if (pn == 7) { const int c = col - 1792; dst = O.GK + ((size_t)(b * GH + (c >> 6)) * GU + 64 + i) * 64 + (c & 63); }
            else              { const int c = col - 2560; dst = O.GR + (size_t)row * 512 + c; }
            *(u32x4*)dst = w;
          } else if (col < NIN) {
            float* dst = O.GLR + ((size_t)b * GU + 64 + i) * 16 + (col - 3072);
            *(f32x4*)dst = (f32x4){v0[0], v0[1], v0[2], v0[3]};
            *(f32x4*)(dst + 4) = (f32x4){v1[0], v1[1], v1[2], v1[3]};
          }
        }
      }
  }
};
typedef unsigned char u8_t;
DI unsigned pack_i8x4(float a, float b, float c, float d);
struct EpiOut {
  static constexpr bool PERM = true, AFTER_DRAIN = false;
  const bf16_t* A1; const float* R1I; bf16_t* H1;
  u8_t* XQ; float* XS; float* SSQ; float* xch;
  DI void operator()(const pg8::f32x4 (&acc_)[2][2][4][2], const pg8::Unit& u, int wr, int wc, int fr, int fq) const {
    pg8::f32x4 (&acc)[2][2][4][2] = const_cast<pg8::f32x4 (&)[2][2][4][2]>(acc_);
    float* xa = xch;
    float* xs = xch + 2048;
#pragma unroll
    for (int ai = 0; ai < 2; ++ai)
#pragma unroll
      for (int m = 0; m < 4; ++m) {
        const int row = u.pm * 256 + ai * 128 + wr * 64 + m * 16 + fr;
        const size_t rowoff = (size_t)row * D;
        const float ri = R1I[row];
        float ss = 0.f;
#pragma unroll
        for (int bj = 0; bj < 2; ++bj) {
          const size_t idx = rowoff + u.pn * 256 + bj * 128 + wc * 32 + 8 * fq;
          const u32x4 aw = *(const u32x4*)(A1 + idx);
          const pg8::f32x4 v0 = acc[ai][bj][m][0], v1 = acc[ai][bj][m][1];
          pg8::f32x4 h0, h1;
          h0[0] = bflo(aw.x) * ri + v0[0]; h0[1] = bfhi(aw.x) * ri + v0[1]; h0[2] = bflo(aw.y) * ri + v0[2]; h0[3] = bfhi(aw.y) * ri + v0[3];
          h1[0] = bflo(aw.z) * ri + v1[0]; h1[1] = bfhi(aw.z) * ri + v1[1]; h1[2] = bflo(aw.w) * ri + v1[2]; h1[3] = bfhi(aw.w) * ri + v1[3];
          u32x4 w; w.x = pk2(h0[0], h0[1]); w.y = pk2(h0[2], h0[3]); w.z = pk2(h1[0], h1[1]); w.w = pk2(h1[2], h1[3]);
          *(u32x4*)(H1 + idx) = w;
          acc[ai][bj][m][0] = h0; acc[ai][bj][m][1] = h1;
          ss += h0[0] * h0[0] + h0[1] * h0[1] + h0[2] * h0[2] + h0[3] * h0[3] + h1[0] * h1[0] + h1[1] * h1[1] + h1[2] * h1[2] + h1[3] * h1[3];
          float am = fmaxf(fmaxf(fmaxf(fabsf(h0[0]), fabsf(h0[1])), fmaxf(fabsf(h0[2]), fabsf(h0[3]))), fmaxf(fmaxf(fabsf(h1[0]), fabsf(h1[1])), fmaxf(fabsf(h1[2]), fabsf(h1[3]))));
          am = fmaxf(am, __shfl_xor(am, 16)); am = fmaxf(am, __shfl_xor(am, 32));
          if (fq == 0) xa[((((wr * 2 + ai) * 4 + m) * 2 + bj) * 16 + fr) * 4 + wc] = am;
        }
        ss += __shfl_xor(ss, 16); ss += __shfl_xor(ss, 32);
        if (fq == 0) xs[(((wr * 2 + ai) * 4 + m) * 16 + fr) * 4 + wc] = ss;
      }
    asm volatile("s_waitcnt lgkmcnt(0)\n\ts_barrier" ::: "memory");
#pragma unroll
    for (int ai = 0; ai < 2; ++ai)
#pragma unroll
      for (int m = 0; m < 4; ++m) {
        const int row = u.pm * 256 + ai * 128 + wr * 64 + m * 16 + fr;
#pragma unroll
        for (int bj = 0; bj < 2; ++bj) {
          const f32x4 pm = *(const f32x4*)&xa[((((wr * 2 + ai) * 4 + m) * 2 + bj) * 16 + fr) * 4];
          const float M = fmaxf(fmaxf(pm.x, pm.y), fmaxf(pm.z, pm.w));
          const float inv = M > 0.f ? 127.0f / M : 0.f;
          const pg8::f32x4 h0 = acc[ai][bj][m][0], h1 = acc[ai][bj][m][1];
          u32x2 q;
          q.x = pack_i8x4(h0[0] * inv, h0[1] * inv, h0[2] * inv, h0[3] * inv);
          q.y = pack_i8x4(h1[0] * inv, h1[1] * inv, h1[2] * inv, h1[3] * inv);
          *(u32x2*)(XQ + (size_t)row * D + u.pn * 256 + bj * 128 + wc * 32 + 8 * fq) = q;
          if (wc == 0 && fq == 0) XS[(size_t)row * 8 + 2 * u.pn + bj] = M * (1.0f / 127.0f);
        }
        if (wc == 0 && fq == 0) {
          const f32x4 ps = *(const f32x4*)&xs[(((wr * 2 + ai) * 4 + m) * 16 + fr) * 4];
          SSQ[(size_t)u.pn * TREAL + row] = (ps.x + ps.y) + (ps.z + ps.w);
        }
      }
  }
};
struct EpiPQ {
  static constexpr bool PERM = true, AFTER_DRAIN = false;
  bf16_t* QP; const float* SSQ;
  DI void operator()(const pg8::f32x4 (&acc)[2][2][4][2], const pg8::Unit& u, int wr, int wc, int fr, int fq) const {
#pragma unroll
    for (int ai = 0; ai < 2; ++ai)
#pragma unroll
      for (int m = 0; m < 4; ++m) {
        const int row = u.pm * 256 + ai * 128 + wr * 64 + m * 16 + fr;
        const float r = rsqrtf(((SSQ[row] + SSQ[TREAL + row]) + (SSQ[2 * TREAL + row] + SSQ[3 * TREAL + row])) * (1.0f / D) + EPS);
        const size_t rowoff = (size_t)row * D;
#pragma unroll
        for (int bj = 0; bj < 2; ++bj) {
          const pg8::f32x4 v0 = acc[ai][bj][m][0], v1 = acc[ai][bj][m][1];
          u32x4 w; w.x = pk2(v0[0] * r, v0[1] * r); w.y = pk2(v0[2] * r, v0[3] * r); w.z = pk2(v1[0] * r, v1[1] * r); w.w = pk2(v1[2] * r, v1[3] * r);
          *(u32x4*)(QP + rowoff + u.pn * 256 + bj * 128 + wc * 32 + 8 * fq) = w;
        }
      }
  }
};

DI void ph_meta(int blk, char* smem, const float* __restrict__ meta, const float* __restrict__ g1, const float* __restrict__ w_in, const InProjOut& O) {
  float (*xmT)[16] = (float (*)[16])smem;
  float (*red)[256] = (float (*)[256])(smem + 65536);
  const int tid = fresh_tid(), lane = tid & 63, wave = tid >> 6;
  for (int rr = 0; rr < 2; ++rr) {
    const int mm = wave * 2 + rr;
    float v[16]; float ss = 0.f;
#pragma unroll
    for (int j = 0; j < 16; ++j) { v[j] = meta[(size_t)mm * D + j * 64 + lane]; ss += v[j] * v[j]; }
    ss = wave_sum(ss);
    const float r = rsqrtf(ss * (1.0f / D) + EPS);
#pragma unroll
    for (int j = 0; j < 16; ++j) xmT[j * 64 + lane][mm] = v[j] * r * g1[j * 64 + lane];
  }
  __syncthreads();
  {
    const int c = tid & 15, ks = tid >> 4, n = blk * 16 + c;
    float acc[16];
#pragma unroll
    for (int j = 0; j < 16; ++j) acc[j] = 0.f;
#pragma unroll 8
    for (int kk = 0; kk < 32; ++kk) {
      const int k = ks * 32 + kk;
      const float w = w_in[(size_t)k * NIN + n];
      const f32x4 a = *(const f32x4*)&xmT[k][0], b4 = *(const f32x4*)&xmT[k][4], c4 = *(const f32x4*)&xmT[k][8], d4 = *(const f32x4*)&xmT[k][12];
      acc[0] += a.x * w; acc[1] += a.y * w; acc[2] += a.z * w; acc[3] += a.w * w;
      acc[4] += b4.x * w; acc[5] += b4.y * w; acc[6] += b4.z * w; acc[7] += b4.w * w;
      acc[8] += c4.x * w; acc[9] += c4.y * w; acc[10] += c4.z * w; acc[11] += c4.w * w;
      acc[12] += d4.x * w; acc[13] += d4.y * w; acc[14] += d4.z * w; acc[15] += d4.w * w;
    }
#pragma unroll
    for (int mm = 0; mm < 16; ++mm) red[ks][c * 16 + mm] = acc[mm];
  }
  __syncthreads();
  if (tid < 256) {
    const int c = tid >> 4, mm = tid & 15, n = blk * 16 + c;
    float val = 0.f;
#pragma unroll 8
    for (int ks = 0; ks < 32; ++ks) val += red[ks][tid];
    const bf16_t hv = (bf16_t)f2bf(val);
    for (int bb = 0; bb < NB; ++bb) {
      if (n < 512) {}
      else if (n < 1024) { const int cc = n - 512;  O.KSB[((size_t)(bb * SBH + (cc >> 6)) * KIDX + 16 + mm) * 64 + (cc & 63)] = hv; }
      else if (n < 1536) { const int cc = n - 1024; O.VTSB[((size_t)(bb * SBH + (cc >> 6)) * 64 + (cc & 63)) * KIDX + 16 + mm] = hv; }
      else if (n < 1792) { const int cc = n - 1536; O.GQ[((size_t)(bb * GH + (cc >> 6)) * GU + 48 + mm) * 64 + (cc & 63)] = hv; }
      else if (n < 2048) { const int cc = n - 1792; O.GK[((size_t)(bb * GH + (cc >> 6)) * GU + 48 + mm) * 64 + (cc & 63)] = hv; }
      else if (n < 2560) { const int cc = n - 2048; O.GV[((size_t)(bb * GH + (cc >> 7)) * 128 + (cc & 127)) * GU + 48 + mm] = hv; }
      else if (n < 3072) {}
      else { O.GLR[((size_t)bb * GU + 48 + mm) * 16 + (n - 3072)] = val; }
    }
  }
  __syncthreads();
}


constexpr float SB_THR = 5.421010862e-20f;
DI void ph_sb_attn(int vb, const bf16_t* __restrict__ QSB, const bf16_t* __restrict__ KSB, const bf16_t* __restrict__ VTSB,
                                                 const float* __restrict__ sb_g, bf16_t* __restrict__ MIX) {
  const int tid256_ = fresh_tid() & 255;
  const int lane = TID & 63, wave = TID >> 6, r = lane & 31, h = lane >> 5;
  const int bh = vb >> 6, qb = vb & 63;
  const int b = bh >> 3, hd = bh & 7;
  const int i0 = qb * 128 + wave * 32;
  const bf16_t* Qb = QSB + ((size_t)bh * SEQ + i0) * 64;
  const bf16_t* Kb = KSB + (size_t)bh * KIDX * 64;
  const bf16_t* Vb = VTSB + (size_t)bh * 64 * KIDX;
  bf16x8 qf[4];
#pragma unroll
  for (int ks = 0; ks < 4; ++ks) qf[ks] = *(const bf16x8*)(Qb + r * 64 + ks * 16 + h * 8);
  f32x16 o[2];
#pragma unroll
  for (int e = 0; e < 16; ++e) { o[0][e] = 0.f; o[1][e] = 0.f; }
  float R = 1.f;
  const int qidx = 32 + i0 + r;
  for (int c = (i0 >> 5) + 1; c >= 0; --c) {
    const int k0 = 32 * c;
    bf16x8 kf[4];
#pragma unroll
    for (int ks = 0; ks < 4; ++ks) kf[ks] = *(const bf16x8*)(Kb + (size_t)(k0 + r) * 64 + ks * 16 + h * 8);
    bf16x8 vf[2][2];
#pragma unroll
    for (int mt = 0; mt < 2; ++mt)
#pragma unroll
      for (int s2 = 0; s2 < 2; ++s2) {
        const bf16_t* vp = Vb + (size_t)(mt * 32 + r) * KIDX + k0 + 16 * s2 + 4 * h;
        const u32x2 lo = *(const u32x2*)vp, hi = *(const u32x2*)(vp + 8);
        u32x4 t; t.x = lo.x; t.y = lo.y; t.z = hi.x; t.w = hi.y;
        vf[mt][s2] = __builtin_bit_cast(bf16x8, t);
      }
    f32x16 s;
#pragma unroll
    for (int e = 0; e < 16; ++e) s[e] = 0.f;
#pragma unroll
    for (int ks = 0; ks < 4; ++ks) s = MFMA32(kf[ks], qf[ks], s);
    float om[16], bt[16];
#pragma unroll
    for (int e = 0; e < 16; ++e) {
      const int kidx = k0 + crow(e, h);
      const bool valid = (kidx < qidx) && (kidx >= 16);
      const float z = s[e] * 0.125f;
      const float ez = __expf(-fabsf(z));
      const float big = __builtin_amdgcn_rcpf(1.f + ez), small = ez * big;
      const float beta = z >= 0.f ? big : small, onem = z >= 0.f ? small : big;
      om[e] = valid ? onem : 1.f;
      bt[e] = valid ? beta : 0.f;
    }
    float sfx[16], G[4], PG[4];
#pragma unroll
    for (int g = 0; g < 4; ++g) {
      sfx[4 * g + 3] = 1.f;
      sfx[4 * g + 2] = om[4 * g + 3];
      sfx[4 * g + 1] = sfx[4 * g + 2] * om[4 * g + 2];
      sfx[4 * g + 0] = sfx[4 * g + 1] * om[4 * g + 1];
      G[g] = sfx[4 * g + 0] * om[4 * g + 0];
      PG[g] = __shfl_xor(G[g], 32);
    }
    float HS[4];
    HS[3] = 1.f;
    HS[2] = G[3] * PG[3];
    HS[1] = HS[2] * (G[2] * PG[2]);
    HS[0] = HS[1] * (G[1] * PG[1]);
    const float total = HS[0] * (G[0] * PG[0]);
    float a[16];
#pragma unroll
    for (int e = 0; e < 16; ++e) {
      const int g = e >> 2;
      const float between = sfx[e] * (h == 0 ? PG[g] : 1.f) * (HS[g] * R);
      a[e] = bt[e] * between;
    }
    R *= total;
#pragma unroll
    for (int s2 = 0; s2 < 2; ++s2) {
      u32x4 p;
      p.x = pk2(a[8 * s2 + 0], a[8 * s2 + 1]); p.y = pk2(a[8 * s2 + 2], a[8 * s2 + 3]);
      p.z = pk2(a[8 * s2 + 4], a[8 * s2 + 5]); p.w = pk2(a[8 * s2 + 6], a[8 * s2 + 7]);
      const bf16x8 pf = __builtin_bit_cast(bf16x8, p);
      o[0] = MFMA32(vf[0][s2], pf, o[0]);
      o[1] = MFMA32(vf[1][s2], pf, o[1]);
    }
    if (__all(R < SB_THR)) break;
  }
  float ss = 0.f;
#pragma unroll
  for (int e = 0; e < 16; ++e) ss += o[0][e] * o[0][e] + o[1][e] * o[1][e];
  ss += __shfl_xor(ss, 32);
  const float sc = rsqrtf(ss * (1.0f / 64.0f) + EPS);
  bf16_t* outp = MIX + (size_t)(b * SEQ + i0 + r) * D + hd * 64;
#pragma unroll
  for (int mt = 0; mt < 2; ++mt)
#pragma unroll
    for (int g = 0; g < 4; ++g) {
      const int d = mt * 32 + 8 * g + 4 * h;
      const f32x4 gg = *(const f32x4*)(sb_g + hd * 64 + d);
      u32x2 pk;
      pk.x = pk2(o[mt][4 * g] * sc * gg.x, o[mt][4 * g + 1] * sc * gg.y);
      pk.y = pk2(o[mt][4 * g + 2] * sc * gg.z, o[mt][4 * g + 3] * sc * gg.w);
      *(u32x2*)(outp + d) = pk;
    }
}


DI void sb_tile_step(const f32x16& s, int k0, int qidx, int h, float& R, const bf16x8 (&vf)[2][2], f32x16 (&o)[2]) {
  float om[16], bt[16];
#pragma unroll
  for (int e = 0; e < 16; ++e) {
    const int kidx = k0 + crow(e, h);
    const bool valid = (kidx < qidx) && (kidx >= 16);
    const float z = s[e] * 0.125f;
    const float ez = __expf(-fabsf(z));
    const float big = __builtin_amdgcn_rcpf(1.f + ez), small = ez * big;
    const float beta = z >= 0.f ? big : small, onem = z >= 0.f ? small : big;
    om[e] = valid ? onem : 1.f;
    bt[e] = valid ? beta : 0.f;
  }
  float sfx[16], G[4], PG[4];
#pragma unroll
  for (int g = 0; g < 4; ++g) {
    sfx[4 * g + 3] = 1.f;
    sfx[4 * g + 2] = om[4 * g + 3];
    sfx[4 * g + 1] = sfx[4 * g + 2] * om[4 * g + 2];
    sfx[4 * g + 0] = sfx[4 * g + 1] * om[4 * g + 1];
    G[g] = sfx[4 * g + 0] * om[4 * g + 0];
    PG[g] = __shfl_xor(G[g], 32);
  }
  float HS[4];
  HS[3] = 1.f; HS[2] = G[3] * PG[3]; HS[1] = HS[2] * (G[2] * PG[2]); HS[0] = HS[1] * (G[1] * PG[1]);
  const float total = HS[0] * (G[0] * PG[0]);
  float a[16];
#pragma unroll
  for (int e = 0; e < 16; ++e) { const int g = e >> 2; a[e] = bt[e] * (sfx[e] * (h == 0 ? PG[g] : 1.f) * (HS[g] * R)); }
  R *= total;
#pragma unroll
  for (int s2 = 0; s2 < 2; ++s2) {
    u32x4 p;
    p.x = pk2(a[8 * s2 + 0], a[8 * s2 + 1]); p.y = pk2(a[8 * s2 + 2], a[8 * s2 + 3]);
    p.z = pk2(a[8 * s2 + 4], a[8 * s2 + 5]); p.w = pk2(a[8 * s2 + 6], a[8 * s2 + 7]);
    const bf16x8 pf = __builtin_bit_cast(bf16x8, p);
    o[0] = MFMA32(vf[0][s2], pf, o[0]);
    o[1] = MFMA32(vf[1][s2], pf, o[1]);
  }
}
DI void sb_tile_out(const f32x16 (&o)[2], int h, const float* __restrict__ sb_gh, bf16_t* __restrict__ outp) {
  float ss = 0.f;
#pragma unroll
  for (int e = 0; e < 16; ++e) ss += o[0][e] * o[0][e] + o[1][e] * o[1][e];
  ss += __shfl_xor(ss, 32);
  const float sc = rsqrtf(ss * (1.0f / 64.0f) + EPS);
#pragma unroll
  for (int mt = 0; mt < 2; ++mt)
#pragma unroll
    for (int g = 0; g < 4; ++g) {
      const int d = mt * 32 + 8 * g + 4 * h;
      const f32x4 gg = *(const f32x4*)(sb_gh + d);
      u32x2 pk;
      pk.x = pk2(o[mt][4 * g] * sc * gg.x, o[mt][4 * g + 1] * sc * gg.y);
      pk.y = pk2(o[mt][4 * g + 2] * sc * gg.z, o[mt][4 * g + 3] * sc * gg.w);
      *(u32x2*)(outp + d) = pk;
    }
}
DI void ph_sb_attn2(int vb, const bf16_t* __restrict__ QSB, const bf16_t* __restrict__ KSB, const bf16_t* __restrict__ VTSB,
                    const float* __restrict__ sb_g, bf16_t* __restrict__ MIX) {
  const int tid256_ = fresh_tid() & 255;
  const int lane = TID & 63, wave = TID >> 6, r = lane & 31, h = lane >> 5;
  const int bh = vb >> 5, qb = vb & 31;
  const int b = bh >> 3, hd = bh & 7;
  const int i0 = qb * 256 + wave * 64;
  const bf16_t* Qb = QSB + ((size_t)bh * SEQ + i0) * 64;
  const bf16_t* Kb = KSB + (size_t)bh * KIDX * 64;
  const bf16_t* Vb = VTSB + (size_t)bh * 64 * KIDX;
  bf16x8 qfA[4], qfB[4];
#pragma unroll
  for (int ks = 0; ks < 4; ++ks) { qfA[ks] = *(const bf16x8*)(Qb + r * 64 + ks * 16 + h * 8); qfB[ks] = *(const bf16x8*)(Qb + (32 + r) * 64 + ks * 16 + h * 8); }
  f32x16 oA[2], oB[2];
#pragma unroll
  for (int e = 0; e < 16; ++e) { oA[0][e] = 0.f; oA[1][e] = 0.f; oB[0][e] = 0.f; oB[1][e] = 0.f; }
  float RA = 1.f, RB = 1.f;
  const int qidxA = 32 + i0 + r, qidxB = qidxA + 32;
  for (int c = (i0 >> 5) + 2; c >= 0; --c) {
    const int k0 = 32 * c;
    bf16x8 kf[4];
#pragma unroll
    for (int ks = 0; ks < 4; ++ks) kf[ks] = *(const bf16x8*)(Kb + (size_t)(k0 + r) * 64 + ks * 16 + h * 8);
    bf16x8 vf[2][2];
#pragma unroll
    for (int mt = 0; mt < 2; ++mt)
#pragma unroll
      for (int s2 = 0; s2 < 2; ++s2) {
        const bf16_t* vp = Vb + (size_t)(mt * 32 + r) * KIDX + k0 + 16 * s2 + 4 * h;
        const u32x2 lo = *(const u32x2*)vp, hi = *(const u32x2*)(vp + 8);
        u32x4 t; t.x = lo.x; t.y = lo.y; t.z = hi.x; t.w = hi.y;
        vf[mt][s2] = __builtin_bit_cast(bf16x8, t);
      }
    f32x16 sA, sB;
#pragma unroll
    for (int e = 0; e < 16; ++e) { sA[e] = 0.f; sB[e] = 0.f; }
#pragma unroll
    for (int ks = 0; ks < 4; ++ks) { sA = MFMA32(kf[ks], qfA[ks], sA); sB = MFMA32(kf[ks], qfB[ks], sB); }
    sb_tile_step(sB, k0, qidxB, h, RB, vf, oB);
    sb_tile_step(sA, k0, qidxA, h, RA, vf, oA);
    if (__all(RA < SB_THR && RB < SB_THR)) break;
  }
  sb_tile_out(oA, h, sb_g + hd * 64, MIX + (size_t)(b * SEQ + i0 + r) * D + hd * 64);
  sb_tile_out(oB, h, sb_g + hd * 64, MIX + (size_t)(b * SEQ + i0 + 32 + r) * D + hd * 64);
}


constexpr int RT_TOK_PER_BLOCK = 256;


#define MFMA16(a, b, c) __builtin_amdgcn_mfma_f32_16x16x32_bf16((a), (b), (c), 0, 0, 0)
constexpr int GLDS = 72;
struct GlaLds {
  bf16_t Qt[64 * GLDS];
  bf16_t Kt[64 * GLDS];
  bf16_t KT[64 * GLDS];
  bf16_t P[64 * GLDS];
  float dec[64];
  float tot[8][64];
  float ssq[8][64];
};
constexpr size_t WS_SLOC = 926 * MiB;
constexpr size_t WS_DTOT = 942 * MiB;
constexpr size_t WS_GVT = 604 * MiB;

struct GlaPtrs { const bf16_t *GQ, *GK, *GVT, *GR; const float *GLR, *wg, *bg, *gla_g; float *SLOC, *DTOT; bf16_t* MIX; };


constexpr size_t WS_GQT = 470 * MiB;
constexpr size_t WS_GKT = 502 * MiB + 512 * 1024;
constexpr size_t WS_GKTT = 861 * MiB;
constexpr size_t WS_GDEC = 894 * MiB;
constexpr size_t WS_GBL = 896 * MiB;
struct GlaPrepPtrs { const bf16_t *GQ, *GK; const float *GLR, *wg, *bg; bf16_t *QT, *KT, *KTT; float *DEC, *BL; };
DI void ph_glr(int panel, const bf16_t* __restrict__ A1, const bf16_t* __restrict__ WinT, float* __restrict__ GLR) {
  const int tid = fresh_tid(), lane = tid & 63, wave = tid >> 6, c16 = lane & 15, q = lane >> 4;
  const int row0 = panel * 256 + wave * 32;
  const bf16_t* a0 = A1 + (size_t)(row0 + c16) * D + 8 * q;
  const bf16_t* a1 = a0 + (size_t)16 * D;
  const bf16_t* bp = WinT + (size_t)(3072 + c16) * D + 8 * q;
  f32x4 acc0 = {0.f, 0.f, 0.f, 0.f}, acc1 = {0.f, 0.f, 0.f, 0.f};
#pragma unroll 8
  for (int ks = 0; ks < D / 32; ++ks) {
    const bf16x8 fa0 = *(const bf16x8*)(a0 + 32 * ks), fa1 = *(const bf16x8*)(a1 + 32 * ks), fb = *(const bf16x8*)(bp + 32 * ks);
    acc0 = MFMA16(fa0, fb, acc0); acc1 = MFMA16(fa1, fb, acc1);
  }
#pragma unroll
  for (int r = 0; r < 4; ++r) {
    const int ra = row0 + 4 * q + r, rb = ra + 16;
    GLR[((size_t)(ra >> 13) * GU + 64 + (ra & 8191)) * 16 + c16] = acc0[r];
    GLR[((size_t)(rb >> 13) * GU + 64 + (rb & 8191)) * 16 + c16] = acc1[r];
  }
}
DI void ph_gla_prep(int pair, char* smem, const GlaPrepPtrs& G) {
  const int tid = fresh_tid(), lane = tid & 63, w = tid >> 6, hb = w >> 2, w4 = w & 3;
  float (*tot)[64] = (float (*)[64])(smem + hb * 1024);
  const int item = 2 * pair + hb;
  const int bh = item / 129, c = item % 129, b = bh >> 2, hd = bh & 3, u0 = 64 * c;
  float wgr[16];
#pragma unroll
  for (int k = 0; k < 16; ++k) wgr[k] = G.wg[k * 256 + hd * 64 + lane];
  const float bgv = G.bg[hd * 64 + lane];
  float cs[16]; float run = 0.f;
  unsigned short kraw[16], qraw[16];
#pragma unroll
  for (int i = 0; i < 16; ++i) {
    const int u = u0 + 16 * w4 + i;
    kraw[i] = G.GK[((size_t)bh * GU + u) * 64 + lane];
    qraw[i] = G.GQ[((size_t)bh * GU + u) * 64 + lane];
  }
#pragma unroll
  for (int i = 0; i < 16; ++i) {
    const int u = u0 + 16 * w4 + i;
    float lgv = 0.f;
    if (u >= 48) {
      const f32x4* gp = (const f32x4*)(G.GLR + ((size_t)b * GU + u) * 16);
      const f32x4 g0 = gp[0], g1 = gp[1], g2 = gp[2], g3 = gp[3];
      float a = bgv;
      a += g0.x * wgr[0] + g0.y * wgr[1] + g0.z * wgr[2] + g0.w * wgr[3];
      a += g1.x * wgr[4] + g1.y * wgr[5] + g1.z * wgr[6] + g1.w * wgr[7];
      a += g2.x * wgr[8] + g2.y * wgr[9] + g2.z * wgr[10] + g2.w * wgr[11];
      a += g3.x * wgr[12] + g3.y * wgr[13] + g3.z * wgr[14] + g3.w * wgr[15];
      lgv = -softplus(-a) * (1.0f / 16.0f);
    }
    run += lgv; cs[i] = run;
  }
  tot[w4][lane] = run;
  __syncthreads();
  float offset = 0.f, total = 0.f;
#pragma unroll
  for (int s2 = 0; s2 < 4; ++s2) { const float tv = tot[s2][lane]; total += tv; if (s2 < w4) offset += tv; }
  const size_t cb = ((size_t)bh * 129 + c) * 4096;
  float kt[16];
#pragma unroll
  for (int i = 0; i < 16; ++i) {
    const float bc = offset + cs[i];
    kt[i] = bf2f(kraw[i]) * __expf(-bc);
    G.QT[cb + (16 * w4 + i) * 64 + lane] = (bf16_t)f2bf(bf2f(qraw[i]) * __expf(bc) * 0.125f);
    G.KT[cb + (16 * w4 + i) * 64 + lane] = (bf16_t)f2bf(kt[i]);
  }
  u32x4 kp; kp.x = pk2(kt[0], kt[1]); kp.y = pk2(kt[2], kt[3]); kp.z = pk2(kt[4], kt[5]); kp.w = pk2(kt[6], kt[7]);
  *(u32x4*)(G.KTT + cb + lane * 64 + 16 * w4) = kp;
  kp.x = pk2(kt[8], kt[9]); kp.y = pk2(kt[10], kt[11]); kp.z = pk2(kt[12], kt[13]); kp.w = pk2(kt[14], kt[15]);
  *(u32x4*)(G.KTT + cb + lane * 64 + 16 * w4 + 8) = kp;
  if (w4 == 0) { G.DEC[((size_t)bh * 129 + c) * 64 + lane] = __expf(total); G.BL[((size_t)bh * 129 + c) * 64 + lane] = total; }
  __syncthreads();
}

struct GlaBuf { bf16_t Qt[64 * GLDS]; bf16_t Kt[64 * GLDS]; bf16_t KT[64 * GLDS]; };
struct GlaLds3 { GlaBuf B[2]; bf16_t P[64 * GLDS]; float ssq[8][64]; };
struct GlaPtrs3 { const bf16_t *QT, *KT, *KTT, *GVT, *GR; const float *DEC, *BL, *gla_g; float *SLOC, *DTOT; bf16_t* MIX; };

template <int PASS>
DI void gla_item3(int bh, int sc, char* smem, const GlaPtrs3& G) {
  GlaLds3& L = *(GlaLds3*)smem;
  const int tid = fresh_tid(), lane = tid & 63, w = __builtin_amdgcn_readfirstlane(tid >> 6), c16 = lane & 15, q = lane >> 4;
  const int b = bh >> 2, hd = bh & 3;
  const int cbeg = sc == 0 ? 0 : 8 * sc + 1, cend = 8 * sc + 9;
  f32x4 X[4];
#pragma unroll
  for (int i = 0; i < 4; ++i) X[i] = (f32x4){0.f, 0.f, 0.f, 0.f};
  if (PASS == 1) {
#pragma unroll 4
    for (int j = 0; j < sc; ++j) {
      const float* dt = G.DTOT + (size_t)(bh * 16 + j) * 64;
      const float* sl = G.SLOC + ((size_t)(bh * 16 + j) * 8 + w) * 16 * 64 + lane;
#pragma unroll
      for (int i = 0; i < 4; ++i) {
        const f32x4 d4 = *(const f32x4*)(dt + 16 * i + 4 * q);
        X[i][0] = d4.x * X[i][0] + sl[(4 * i + 0) * 64]; X[i][1] = d4.y * X[i][1] + sl[(4 * i + 1) * 64];
        X[i][2] = d4.z * X[i][2] + sl[(4 * i + 2) * 64]; X[i][3] = d4.w * X[i][3] + sl[(4 * i + 3) * 64];
      }
    }
  }
  f32x4 gain = {1.f, 1.f, 1.f, 1.f};
  if (PASS == 1) gain = *(const f32x4*)(G.gla_g + hd * 128 + 16 * w + 4 * q);
  const bf16_t* gvt = G.GVT + ((size_t)bh * 128 + 16 * w + c16) * GU + 8 * q;
  const int srow = tid >> 3, sc8 = tid & 7, soff = srow * GLDS + sc8 * 8;
  const size_t cb0 = (size_t)bh * 129 * 4096 + (size_t)srow * 64 + sc8 * 8;
  u32x4 rq, rk, rkt, rq2, rk2, rkt2; bf16x8 vfr[2], vfn[2], vfn2[2]; f32x4 dec[4], decn[4], decn2[4];
  {
    const size_t cb = cb0 + (size_t)cbeg * 4096;
    rkt = *(const u32x4*)(G.KTT + cb);
    if (PASS == 1) { rq = *(const u32x4*)(G.QT + cb); rk = *(const u32x4*)(G.KT + cb); }
    vfr[0] = *(const bf16x8*)(gvt + 64 * cbeg); vfr[1] = *(const bf16x8*)(gvt + 64 * cbeg + 32);
#pragma unroll
    for (int i = 0; i < 4; ++i) dec[i] = *(const f32x4*)(G.DEC + ((size_t)bh * 129 + cbeg) * 64 + 16 * i + 4 * q);
    *(u32x4*)&L.B[0].KT[soff] = rkt;
    if (PASS == 1) { *(u32x4*)&L.B[0].Qt[soff] = rq; *(u32x4*)&L.B[0].Kt[soff] = rk; }
    const size_t cb1 = cb0 + (size_t)(cbeg + 1) * 4096;
    rkt = *(const u32x4*)(G.KTT + cb1);
    if (PASS == 1) { rq = *(const u32x4*)(G.QT + cb1); rk = *(const u32x4*)(G.KT + cb1); }
    vfn[0] = *(const bf16x8*)(gvt + 64 * (cbeg + 1)); vfn[1] = *(const bf16x8*)(gvt + 64 * (cbeg + 1) + 32);
#pragma unroll
    for (int i = 0; i < 4; ++i) decn[i] = *(const f32x4*)(G.DEC + ((size_t)bh * 129 + cbeg + 1) * 64 + 16 * i + 4 * q);
  }
  __syncthreads();
  for (int c = cbeg; c < cend; ++c) {
    const int cur = (c - cbeg) & 1;
    const GlaBuf& Bc = L.B[cur];
    const bool more = c + 1 < cend, more2 = c + 2 < cend;
    if (more2) {
      const size_t cb = cb0 + (size_t)(c + 2) * 4096;
      rkt2 = *(const u32x4*)(G.KTT + cb);
      if (PASS == 1) { rq2 = *(const u32x4*)(G.QT + cb); rk2 = *(const u32x4*)(G.KT + cb); }
      vfn2[0] = *(const bf16x8*)(gvt + 64 * (c + 2)); vfn2[1] = *(const bf16x8*)(gvt + 64 * (c + 2) + 32);
#pragma unroll
      for (int i = 0; i < 4; ++i) decn2[i] = *(const f32x4*)(G.DEC + ((size_t)bh * 129 + c + 2) * 64 + 16 * i + 4 * q);
    }
    u32x2 grv[4];
    if (PASS == 1 && c >= 1) {
#pragma unroll
      for (int n = 0; n < 4; ++n) grv[n] = *(const u32x2*)(G.GR + ((size_t)b * SEQ + 64 * (c - 1) + 16 * n + c16) * 512 + hd * 128 + 16 * w + 4 * q);
    }
    f32x4 OT[4];
    if (PASS == 1) {
      const int is = w >> 1;
#pragma unroll
      for (int z = 0; z < 2; ++z) {
        const int it = 2 * (w & 1) + z;
        f32x4 pa = {0.f, 0.f, 0.f, 0.f};
        if (is <= it) {
#pragma unroll
          for (int kk = 0; kk < 2; ++kk) {
            const bf16x8 ka = *(const bf16x8*)&Bc.Kt[(16 * is + c16) * GLDS + 32 * kk + 8 * q];
            const bf16x8 qb = *(const bf16x8*)&Bc.Qt[(16 * it + c16) * GLDS + 32 * kk + 8 * q];
            pa = MFMA16(ka, qb, pa);
          }
          if (is == it) {
#pragma unroll
            for (int r = 0; r < 4; ++r) if (4 * q + r > c16) pa[r] = 0.f;
          }
        }
        u32x2 pw; pw.x = pk2(pa[0], pa[1]); pw.y = pk2(pa[2], pa[3]);
        *(u32x2*)&L.P[(16 * it + c16) * GLDS + 16 * is + 4 * q] = pw;
      }
#pragma unroll
      for (int n = 0; n < 4; ++n) OT[n] = (f32x4){0.f, 0.f, 0.f, 0.f};
#pragma unroll
      for (int kk = 0; kk < 2; ++kk) {
        u32x4 xp; xp.x = pk2(X[2 * kk][0], X[2 * kk][1]); xp.y = pk2(X[2 * kk][2], X[2 * kk][3]);
        xp.z = pk2(X[2 * kk + 1][0], X[2 * kk + 1][1]); xp.w = pk2(X[2 * kk + 1][2], X[2 * kk + 1][3]);
        const bf16x8 xa = __builtin_bit_cast(bf16x8, xp);
#pragma unroll
        for (int n = 0; n < 4; ++n) {
          const u32x2 lo = *(const u32x2*)&Bc.Qt[(16 * n + c16) * GLDS + 32 * kk + 4 * q];
          const u32x2 hi = *(const u32x2*)&Bc.Qt[(16 * n + c16) * GLDS + 32 * kk + 16 + 4 * q];
          u32x4 qq; qq.x = lo.x; qq.y = lo.y; qq.z = hi.x; qq.w = hi.y;
          OT[n] = MFMA16(xa, __builtin_bit_cast(bf16x8, qq), OT[n]);
        }
      }
      __syncthreads();
#pragma unroll
      for (int kk = 0; kk < 2; ++kk)
#pragma unroll
        for (int n = 0; n < 4; ++n) {
          const bf16x8 pb = *(const bf16x8*)&L.P[(16 * n + c16) * GLDS + 32 * kk + 8 * q];
          OT[n] = MFMA16(vfr[kk], pb, OT[n]);
        }
    }
#pragma unroll
    for (int i = 0; i < 4; ++i) {
#pragma unroll
      for (int kk = 0; kk < 2; ++kk) {
        const bf16x8 ka = *(const bf16x8*)&Bc.KT[(16 * i + c16) * GLDS + 32 * kk + 8 * q];
        X[i] = MFMA16(ka, vfr[kk], X[i]);
      }
      X[i][0] *= dec[i].x; X[i][1] *= dec[i].y; X[i][2] *= dec[i].z; X[i][3] *= dec[i].w;
    }
    if (PASS == 1 && c >= 1) {
      float ss[4];
#pragma unroll
      for (int n = 0; n < 4; ++n) {
        float v = OT[n][0] * OT[n][0] + OT[n][1] * OT[n][1] + OT[n][2] * OT[n][2] + OT[n][3] * OT[n][3];
        v += __shfl_xor(v, 16); v += __shfl_xor(v, 32);
        ss[n] = v;
      }
      if (q == 0) {
#pragma unroll
        for (int n = 0; n < 4; ++n) L.ssq[w][16 * n + c16] = ss[n];
      }
      __syncthreads();
#pragma unroll
      for (int n = 0; n < 4; ++n) {
        float tot = 0.f;
#pragma unroll
        for (int w2 = 0; w2 < 8; ++w2) tot += L.ssq[w2][16 * n + c16];
        const float scl = rsqrtf(tot * (1.0f / 128.0f) + EPS);
        const size_t m = (size_t)b * SEQ + 64 * (c - 1) + 16 * n + c16;
        const float r0 = bflo(grv[n].x), r1 = bfhi(grv[n].x), r2 = bflo(grv[n].y), r3 = bfhi(grv[n].y);
        const float o0 = OT[n][0] * scl * gain.x * (r0 / (1.f + __expf(-r0)));
        const float o1 = OT[n][1] * scl * gain.y * (r1 / (1.f + __expf(-r1)));
        const float o2 = OT[n][2] * scl * gain.z * (r2 / (1.f + __expf(-r2)));
        const float o3 = OT[n][3] * scl * gain.w * (r3 / (1.f + __expf(-r3)));
        u32x2 ow; ow.x = pk2(o0, o1); ow.y = pk2(o2, o3);
        *(u32x2*)(G.MIX + m * D + 512 + hd * 128 + 16 * w + 4 * q) = ow;
      }
    }
    if (more) {
      GlaBuf& Bn = L.B[cur ^ 1];
      *(u32x4*)&Bn.KT[soff] = rkt;
      if (PASS == 1) { *(u32x4*)&Bn.Qt[soff] = rq; *(u32x4*)&Bn.Kt[soff] = rk; }
      vfr[0] = vfn[0]; vfr[1] = vfn[1];
#pragma unroll
      for (int i = 0; i < 4; ++i) dec[i] = decn[i];
      rkt = rkt2; rq = rq2; rk = rk2; vfn[0] = vfn2[0]; vfn[1] = vfn2[1];
#pragma unroll
      for (int i = 0; i < 4; ++i) decn[i] = decn2[i];
    }
    __syncthreads();
  }
  if (PASS == 0) {
    float* sl = G.SLOC + ((size_t)(bh * 16 + sc) * 8 + w) * 16 * 64 + lane;
#pragma unroll
    for (int i = 0; i < 4; ++i)
#pragma unroll
      for (int r = 0; r < 4; ++r) sl[(4 * i + r) * 64] = X[i][r];
    if (w == 0) {
      float bl = 0.f;
      for (int c = cbeg; c < cend; ++c) bl += G.BL[((size_t)bh * 129 + c) * 64 + lane];
      G.DTOT[(size_t)(bh * 16 + sc) * 64 + lane] = __expf(bl);
    }
  }
}


struct GlaLds4 { GlaBuf B[2]; bf16_t P[64 * GLDS]; float ssq[4][64]; };
template <int PASS>
DI void gla_item4(int bh_lo, int sc, char* smem, const GlaPtrs3& G) {
  const int tid = fresh_tid(), lane = tid & 63, w = __builtin_amdgcn_readfirstlane(tid >> 6), c16 = lane & 15, q = lane >> 4;
  const int hb = w >> 2, w4 = w & 3, tid4 = tid & 255;
  GlaLds4& L = *(GlaLds4*)(smem + hb * (int)sizeof(GlaLds4));
  const int bh = bh_lo + 16 * hb, b = bh >> 2, hd = bh & 3;
  const int cbeg = sc == 0 ? 0 : 8 * sc + 1, cend = 8 * sc + 9;
  f32x4 X[2][4];
#pragma unroll
  for (int et = 0; et < 2; ++et)
#pragma unroll
    for (int i = 0; i < 4; ++i) X[et][i] = (f32x4){0.f, 0.f, 0.f, 0.f};
  if (PASS == 1) {
#pragma unroll 2
    for (int j = 0; j < sc; ++j) {
      const float* dt = G.DTOT + (size_t)(bh * 16 + j) * 64;
#pragma unroll
      for (int et = 0; et < 2; ++et) {
        const float* sl = G.SLOC + ((size_t)(bh * 16 + j) * 8 + w4 * 2 + et) * 16 * 64 + lane;
#pragma unroll
        for (int i = 0; i < 4; ++i) {
          const f32x4 d4 = *(const f32x4*)(dt + 16 * i + 4 * q);
          X[et][i][0] = d4.x * X[et][i][0] + sl[(4 * i + 0) * 64]; X[et][i][1] = d4.y * X[et][i][1] + sl[(4 * i + 1) * 64];
          X[et][i][2] = d4.z * X[et][i][2] + sl[(4 * i + 2) * 64]; X[et][i][3] = d4.w * X[et][i][3] + sl[(4 * i + 3) * 64];
        }
      }
    }
  }
  f32x4 gain[2];
#pragma unroll
  for (int et = 0; et < 2; ++et) gain[et] = PASS == 1 ? *(const f32x4*)(G.gla_g + hd * 128 + 32 * w4 + 16 * et + 4 * q) : (f32x4){1.f, 1.f, 1.f, 1.f};
  const bf16_t* gvt0 = G.GVT + ((size_t)bh * 128 + 32 * w4 + c16) * GU + 8 * q;
  const bf16_t* gvt1 = gvt0 + (size_t)16 * GU;
  const int soffA = (tid4 >> 3) * GLDS + (tid4 & 7) * 8, soffB = soffA + 32 * GLDS;
  const size_t cb0 = (size_t)bh * 129 * 4096 + (size_t)(tid4 >> 3) * 64 + (tid4 & 7) * 8;
  u32x4 rq[2], rk[2], rkt[2], rq2[2], rk2[2], rkt2[2];
  bf16x8 vfr[2][2], vfn[2][2]; f32x4 dec[4], decn[4];
#define G4_LOADT(rq_, rk_, rkt_, c_) { const size_t cb_ = cb0 + (size_t)(c_) * 4096; \
    rkt_[0] = *(const u32x4*)(G.KTT + cb_); rkt_[1] = *(const u32x4*)(G.KTT + cb_ + 2048); \
    if (PASS == 1) { rq_[0] = *(const u32x4*)(G.QT + cb_); rq_[1] = *(const u32x4*)(G.QT + cb_ + 2048); rk_[0] = *(const u32x4*)(G.KT + cb_); rk_[1] = *(const u32x4*)(G.KT + cb_ + 2048); } }
#define G4_LOADV(vf_, dc_, c_) { vf_[0][0] = *(const bf16x8*)(gvt0 + 64 * (c_)); vf_[0][1] = *(const bf16x8*)(gvt0 + 64 * (c_) + 32); \
    vf_[1][0] = *(const bf16x8*)(gvt1 + 64 * (c_)); vf_[1][1] = *(const bf16x8*)(gvt1 + 64 * (c_) + 32); \
    _Pragma("unroll") for (int i = 0; i < 4; ++i) dc_[i] = *(const f32x4*)(G.DEC + ((size_t)bh * 129 + (c_)) * 64 + 16 * i + 4 * q); }
#define G4_STORET(Bn_, rq_, rk_, rkt_) { *(u32x4*)&Bn_.KT[soffA] = rkt_[0]; *(u32x4*)&Bn_.KT[soffB] = rkt_[1]; \
    if (PASS == 1) { *(u32x4*)&Bn_.Qt[soffA] = rq_[0]; *(u32x4*)&Bn_.Qt[soffB] = rq_[1]; *(u32x4*)&Bn_.Kt[soffA] = rk_[0]; *(u32x4*)&Bn_.Kt[soffB] = rk_[1]; } }
  G4_LOADT(rq, rk, rkt, cbeg)
  G4_LOADV(vfr, dec, cbeg)
  G4_STORET(L.B[0], rq, rk, rkt)
  G4_LOADT(rq, rk, rkt, cbeg + 1)
  G4_LOADV(vfn, decn, cbeg + 1)
  __syncthreads();
  for (int c = cbeg; c < cend; ++c) {
    const int cur = (c - cbeg) & 1;
    const GlaBuf& Bc = L.B[cur];
    const bool more = c + 1 < cend, more2 = c + 2 < cend;
    if (more2) G4_LOADT(rq2, rk2, rkt2, c + 2)
    u32x2 grv[2][4];
    if (PASS == 1 && c >= 1) {
#pragma unroll
      for (int et = 0; et < 2; ++et)
#pragma unroll
        for (int n = 0; n < 4; ++n) grv[et][n] = *(const u32x2*)(G.GR + ((size_t)b * SEQ + 64 * (c - 1) + 16 * n + c16) * 512 + hd * 128 + 32 * w4 + 16 * et + 4 * q);
    }
    f32x4 OT[2][4];
    if (PASS == 1) {
      const int is = w4;
#pragma unroll
      for (int it = 0; it < 4; ++it) {
        f32x4 pa = {0.f, 0.f, 0.f, 0.f};
        if (is <= it) {
#pragma unroll
          for (int kk = 0; kk < 2; ++kk) {
            const bf16x8 ka = *(const bf16x8*)&Bc.Kt[(16 * is + c16) * GLDS + 32 * kk + 8 * q];
            const bf16x8 qb = *(const bf16x8*)&Bc.Qt[(16 * it + c16) * GLDS + 32 * kk + 8 * q];
            pa = MFMA16(ka, qb, pa);
          }
          if (is == it) {
#pragma unroll
            for (int r = 0; r < 4; ++r) if (4 * q + r > c16) pa[r] = 0.f;
          }
        }
        u32x2 pw; pw.x = pk2(pa[0], pa[1]); pw.y = pk2(pa[2], pa[3]);
        *(u32x2*)&L.P[(16 * it + c16) * GLDS + 16 * is + 4 * q] = pw;
      }
#pragma unroll
      for (int et = 0; et < 2; ++et)
#pragma unroll
        for (int n = 0; n < 4; ++n) OT[et][n] = (f32x4){0.f, 0.f, 0.f, 0.f};
#pragma unroll
      for (int kk = 0; kk < 2; ++kk) {
        bf16x8 xa[2];
#pragma unroll
        for (int et = 0; et < 2; ++et) {
          u32x4 xp; xp.x = pk2(X[et][2 * kk][0], X[et][2 * kk][1]); xp.y = pk2(X[et][2 * kk][2], X[et][2 * kk][3]);
          xp.z = pk2(X[et][2 * kk + 1][0], X[et][2 * kk + 1][1]); xp.w = pk2(X[et][2 * kk + 1][2], X[et][2 * kk + 1][3]);
          xa[et] = __builtin_bit_cast(bf16x8, xp);
        }
#pragma unroll
        for (int n = 0; n < 4; ++n) {
          const u32x2 lo = *(const u32x2*)&Bc.Qt[(16 * n + c16) * GLDS + 32 * kk + 4 * q];
          const u32x2 hi = *(const u32x2*)&Bc.Qt[(16 * n + c16) * GLDS + 32 * kk + 16 + 4 * q];
          u32x4 qq; qq.x = lo.x; qq.y = lo.y; qq.z = hi.x; qq.w = hi.y;
          const bf16x8 qf = __builtin_bit_cast(bf16x8, qq);
          OT[0][n] = MFMA16(xa[0], qf, OT[0][n]);
          OT[1][n] = MFMA16(xa[1], qf, OT[1][n]);
        }
      }
      __syncthreads();
#pragma unroll
      for (int kk = 0; kk < 2; ++kk)
#pragma unroll
        for (int n = 0; n < 4; ++n) {
          const bf16x8 pb = *(const bf16x8*)&L.P[(16 * n + c16) * GLDS + 32 * kk + 8 * q];
          OT[0][n] = MFMA16(vfr[0][kk], pb, OT[0][n]);
          OT[1][n] = MFMA16(vfr[1][kk], pb, OT[1][n]);
        }
    }
#pragma unroll
    for (int i = 0; i < 4; ++i) {
#pragma unroll
      for (int kk = 0; kk < 2; ++kk) {
        const bf16x8 ka = *(const bf16x8*)&Bc.KT[(16 * i + c16) * GLDS + 32 * kk + 8 * q];
        X[0][i] = MFMA16(ka, vfr[0][kk], X[0][i]);
        X[1][i] = MFMA16(ka, vfr[1][kk], X[1][i]);
      }
#pragma unroll
      for (int et = 0; et < 2; ++et) { X[et][i][0] *= dec[i].x; X[et][i][1] *= dec[i].y; X[et][i][2] *= dec[i].z; X[et][i][3] *= dec[i].w; }
    }
    if (PASS == 1 && c >= 1) {
      float ss[4];
#pragma unroll
      for (int n = 0; n < 4; ++n) {
        float v = OT[0][n][0] * OT[0][n][0] + OT[0][n][1] * OT[0][n][1] + OT[0][n][2] * OT[0][n][2] + OT[0][n][3] * OT[0][n][3]
                + OT[1][n][0] * OT[1][n][0] + OT[1][n][1] * OT[1][n][1] + OT[1][n][2] * OT[1][n][2] + OT[1][n][3] * OT[1][n][3];
        v += __shfl_xor(v, 16); v += __shfl_xor(v, 32);
        ss[n] = v;
      }
      if (q == 0) {
#pragma unroll
        for (int n = 0; n < 4; ++n) L.ssq[w4][16 * n + c16] = ss[n];
      }
      __syncthreads();
#pragma unroll
      for (int n = 0; n < 4; ++n) {
        const float tot = L.ssq[0][16 * n + c16] + L.ssq[1][16 * n + c16] + L.ssq[2][16 * n + c16] + L.ssq[3][16 * n + c16];
        const float scl = rsqrtf(tot * (1.0f / 128.0f) + EPS);
        const size_t m = (size_t)b * SEQ + 64 * (c - 1) + 16 * n + c16;
#pragma unroll
        for (int et = 0; et < 2; ++et) {
          const float r0 = bflo(grv[et][n].x), r1 = bfhi(grv[et][n].x), r2 = bflo(grv[et][n].y), r3 = bfhi(grv[et][n].y);
          const float o0 = OT[et][n][0] * scl * gain[et].x * r0 * __builtin_amdgcn_rcpf(1.f + __expf(-r0));
          const float o1 = OT[et][n][1] * scl * gain[et].y * r1 * __builtin_amdgcn_rcpf(1.f + __expf(-r1));
          const float o2 = OT[et][n][2] * scl * gain[et].z * r2 * __builtin_amdgcn_rcpf(1.f + __expf(-r2));
          const float o3 = OT[et][n][3] * scl * gain[et].w * r3 * __builtin_amdgcn_rcpf(1.f + __expf(-r3));
          u32x2 ow; ow.x = pk2(o0, o1); ow.y = pk2(o2, o3);
          *(u32x2*)(G.MIX + m * D + 512 + hd * 128 + 32 * w4 + 16 * et + 4 * q) = ow;
        }
      }
    }
    if (more) {
      GlaBuf& Bn = L.B[cur ^ 1];
      G4_STORET(Bn, rq, rk, rkt)
#pragma unroll
      for (int et = 0; et < 2; ++et) { vfr[et][0] = vfn[et][0]; vfr[et][1] = vfn[et][1]; }
#pragma unroll
      for (int i = 0; i < 4; ++i) dec[i] = decn[i];
#pragma unroll
      for (int z = 0; z < 2; ++z) { rkt[z] = rkt2[z]; rq[z] = rq2[z]; rk[z] = rk2[z]; }
      if (more2) G4_LOADV(vfn, decn, c + 2)
    }
    __syncthreads();
  }
#undef G4_LOADT
#undef G4_LOADV
#undef G4_STORET
  if (PASS == 0) {
#pragma unroll
    for (int et = 0; et < 2; ++et) {
      float* sl = G.SLOC + ((size_t)(bh * 16 + sc) * 8 + w4 * 2 + et) * 16 * 64 + lane;
#pragma unroll
      for (int i = 0; i < 4; ++i)
#pragma unroll
        for (int r = 0; r < 4; ++r) sl[(4 * i + r) * 64] = X[et][i][r];
    }
    if (w4 == 0) {
      float bl = 0.f;
      for (int c = cbeg; c < cend; ++c) bl += G.BL[((size_t)bh * 129 + c) * 64 + lane];
      G.DTOT[(size_t)(bh * 16 + sc) * 64 + lane] = __expf(bl);
    }
  }
}

DI void ce_desc(float& a, float& b) {
  const float hi = __builtin_fmaxf(a, b), lo = __builtin_fminf(a, b);
  a = hi; b = lo;
}
DI float vmaxf(float a, float b) { return __builtin_fmaxf(a, b); }
template <int N> DI void bitonic_sort_desc(float (&v)[N]) {
#pragma unroll
  for (int k = 2; k <= N; k <<= 1) {
#pragma unroll
    for (int j = k >> 1; j > 0; j >>= 1) {
#pragma unroll
      for (int i = 0; i < N; ++i) {
        const int l = i ^ j;
        if (l > i) { if ((i & k) == 0) ce_desc(v[i], v[l]); else ce_desc(v[l], v[i]); }
      }
    }
  }
}
DI void sort16_desc(float (&v)[16]) {
  ce_desc(v[0], v[1]); ce_desc(v[2], v[3]); ce_desc(v[0], v[2]); ce_desc(v[1], v[3]); ce_desc(v[1], v[2]); ce_desc(v[4], v[5]); ce_desc(v[6], v[7]); ce_desc(v[4], v[6]); ce_desc(v[5], v[7]); ce_desc(v[5], v[6]); ce_desc(v[0], v[4]); ce_desc(v[2], v[6]); ce_desc(v[2], v[4]); ce_desc(v[1], v[5]); ce_desc(v[3], v[7]); ce_desc(v[3], v[5]); ce_desc(v[1], v[2]); ce_desc(v[3], v[4]); ce_desc(v[5], v[6]); ce_desc(v[8], v[9]); ce_desc(v[10], v[11]); ce_desc(v[8], v[10]); ce_desc(v[9], v[11]); ce_desc(v[9], v[10]); ce_desc(v[12], v[13]); ce_desc(v[14], v[15]); ce_desc(v[12], v[14]); ce_desc(v[13], v[15]); ce_desc(v[13], v[14]); ce_desc(v[8], v[12]); ce_desc(v[10], v[14]); ce_desc(v[10], v[12]); ce_desc(v[9], v[13]); ce_desc(v[11], v[15]); ce_desc(v[11], v[13]); ce_desc(v[9], v[10]); ce_desc(v[11], v[12]); ce_desc(v[13], v[14]); ce_desc(v[0], v[8]); ce_desc(v[4], v[12]); ce_desc(v[4], v[8]); ce_desc(v[2], v[10]); ce_desc(v[6], v[14]); ce_desc(v[6], v[10]); ce_desc(v[2], v[4]); ce_desc(v[6], v[8]); ce_desc(v[10], v[12]); ce_desc(v[1], v[9]); ce_desc(v[5], v[13]); ce_desc(v[5], v[9]); ce_desc(v[3], v[11]); ce_desc(v[7], v[15]); ce_desc(v[7], v[11]); ce_desc(v[3], v[5]); ce_desc(v[7], v[9]); ce_desc(v[11], v[13]); ce_desc(v[1], v[2]); ce_desc(v[3], v[4]); ce_desc(v[5], v[6]); ce_desc(v[7], v[8]); ce_desc(v[9], v[10]); ce_desc(v[11], v[12]); ce_desc(v[13], v[14]);
}
DI void bitonic_merge16_desc(float (&v)[16]) {
#pragma unroll
  for (int j = 8; j > 0; j >>= 1) {
#pragma unroll
    for (int i = 0; i < 16; ++i) { const int l = i ^ j; if (l > i) ce_desc(v[i], v[l]); }
  }
}
template <int NBV> DI void merge_prune16(float (&a)[16], const float (&b)[16]) {
#pragma unroll
  for (int i = 16 - NBV; i < 16; ++i) a[i] = vmaxf(a[i], b[15 - i]);
  bitonic_merge16_desc(a);
}
DI float selh(int hh, float a, float b) { asm volatile("" : "+v"(a), "+v"(b)); return hh == 0 ? a : b; }
DI float pack_idx(float v, unsigned idx, unsigned mask) { return __uint_as_float((__float_as_uint(v) & ~mask) | idx); }

DI void route_stage_keys(int hd, char* smem, const bf16_t* __restrict__ SK1b, const bf16_t* __restrict__ SK2b) {
  const int tid256_ = fresh_tid() & 255;
  bf16_t* kl = (bf16_t*)smem;
#pragma unroll
  for (int i = 0; i < 8; ++i) {
    const int pz = TID + 256 * i, L = pz >> 10, row = (pz >> 3) & 127, c8 = pz & 7;
    const bf16_t* src = (L == 0 ? SK1b : SK2b) + (size_t)(hd * 128 + row) * 64 + c8 * 8;
    *(u32x4*)&kl[(L * 128 + row) * 72 + c8 * 8] = *(const u32x4*)src;
  }
  __syncthreads();
}
DI void route_load_q(bf16x8 (&qf)[2][4], const bf16_t* __restrict__ QP, int m, int hd, int hh) {
#pragma unroll
  for (int L = 0; L < 2; ++L)
#pragma unroll
    for (int ks = 0; ks < 4; ++ks) qf[L][ks] = *(const bf16x8*)(QP + (size_t)m * D + hd * 128 + L * 64 + hh * 8 + ks * 16);
}
DI void ph_route_v2(int vb, char* smem, const bf16x8 (&qf)[2][4], unsigned short* __restrict__ EIDX, float* __restrict__ GATE) {
  const int tid256_ = fresh_tid() & 255;
  const int lane = TID & 63, wave = TID >> 6, r = lane & 31, hh = lane >> 5;
  const int hd = vb & 7, tile = vb >> 3;
  const int m = tile * 128 + wave * 32 + r;
  const bf16_t* kl = (const bf16_t*)smem;
  float loc[2][16];
#pragma unroll
  for (int L = 0; L < 2; ++L) {
    float grp[4][16];
#pragma unroll
    for (int mt = 0; mt < 4; ++mt) {
      f32x16 acc;
#pragma unroll
      for (int e = 0; e < 16; ++e) acc[e] = 0.f;
#pragma unroll
      for (int ks = 0; ks < 4; ++ks) {
        const bf16x8 kf = *(const bf16x8*)&kl[(L * 128 + mt * 32 + r) * 72 + ks * 16 + hh * 8];
        acc = MFMA32(kf, qf[L][ks], acc);
      }
#pragma unroll
      for (int e = 0; e < 16; ++e) grp[mt][e] = pack_idx(acc[e], (unsigned)(mt * 32 + crow(e, hh)), 127u);
      sort16_desc(grp[mt]);
    }
    merge_prune16<16>(grp[0], grp[1]);
    merge_prune16<16>(grp[2], grp[3]);
    merge_prune16<16>(grp[0], grp[2]);
#pragma unroll
    for (int i = 0; i < 16; ++i) loc[L][i] = grp[0][i];
  }
  float fin[16], oth[16];
#pragma unroll
  for (int i = 0; i < 16; ++i) {
    const float send = selh(hh, loc[1][i], loc[0][i]);
    oth[i] = __shfl_xor(send, 32);
    fin[i] = selh(hh, loc[0][i], loc[1][i]);
  }
  merge_prune16<16>(fin, oth);
  float v1[16], v2[16];
#pragma unroll
  for (int i = 0; i < 16; ++i) {
    const float o = __shfl_xor(fin[i], 32);
    v1[i] = selh(hh, fin[i], o);
    v2[i] = selh(hh, o, fin[i]);
  }
  unsigned* ib = (unsigned*)(smem + 36864) + (size_t)TID * 8;
#pragma unroll
  for (int q = 0; q < 4; ++q) {
    unsigned w1 = 0, w2 = 0;
#pragma unroll
    for (int j = 0; j < 4; ++j) {
      w1 |= (__float_as_uint(v1[4 * q + j]) & 127u) << (8 * j);
      w2 |= (__float_as_uint(v2[4 * q + j]) & 127u) << (8 * j);
    }
    ib[q] = w1; ib[4 + q] = w2;
  }
  float R[16], Bv[16];
#pragma unroll
  for (int j = 0; j < 16; ++j) R[j] = pack_idx(v1[0] + v2[j], (unsigned)j, 255u);
#define ROUTE_ROW(I, CNT) { _Pragma("unroll") for (int j = 0; j < 16; ++j) Bv[j] = (j < CNT) ? pack_idx(v1[I] + v2[j < CNT ? j : 0], (unsigned)(I * 16 + j), 255u) : 0.f; \
    merge_prune16<CNT>(R, Bv); }
  ROUTE_ROW(1, 8) ROUTE_ROW(2, 5) ROUTE_ROW(3, 4) ROUTE_ROW(4, 3) ROUTE_ROW(5, 2) ROUTE_ROW(6, 2) ROUTE_ROW(7, 2)
#undef ROUTE_ROW
#pragma unroll
  for (int j = 0; j < 16; ++j) Bv[j] = (j < 8) ? pack_idx(v1[8 + (j < 8 ? j : 0)] + v2[0], (unsigned)((8 + j) * 16), 255u) : 0.f;
  merge_prune16<8>(R, Bv);
  float ex[16], sum = 0.f;
#pragma unroll
  for (int i = 0; i < 16; ++i) { ex[i] = __expf(R[i] - R[0]); sum += ex[i]; }
  const float inv = 1.f / sum;
  const unsigned char* ibb = (const unsigned char*)ib;
  int eo[8]; float go[8];
#pragma unroll
  for (int w = 0; w < 8; ++w) {
    const float rv = selh(hh, R[w], R[8 + w]);
    const float ev = selh(hh, ex[w], ex[8 + w]);
    const unsigned pos = __float_as_uint(rv) & 255u;
    const unsigned i1 = ibb[pos >> 4], i2 = ibb[16 + (pos & 15u)];
    eo[w] = (int)(i1 * 128u + i2);
    go[w] = ev * inv;
  }
  unsigned short* ep = EIDX + (size_t)m * 128 + hd * 16 + hh * 8;
  float* gp = GATE + (size_t)m * 128 + hd * 16 + hh * 8;
  *(u32x4*)ep = (u32x4){(unsigned)eo[0] | ((unsigned)eo[1] << 16), (unsigned)eo[2] | ((unsigned)eo[3] << 16), (unsigned)eo[4] | ((unsigned)eo[5] << 16), (unsigned)eo[6] | ((unsigned)eo[7] << 16)};
  *(f32x4*)gp = (f32x4){go[0], go[1], go[2], go[3]};
  *(f32x4*)(gp + 4) = (f32x4){go[4], go[5], go[6], go[7]};
}


constexpr size_t WS_SCU = 14 * MiB;
constexpr size_t WS_SCV = 14 * MiB + 65536;
DI float wave_max(float v) {
#pragma unroll
  for (int o = 32; o >= 1; o >>= 1) v = fmaxf(v, __shfl_xor(v, o));
  return v;
}
DI u32x4 quant_row16(const float* __restrict__ rowp, int lane, float& sc) {
  const f32x4* rp = (const f32x4*)(rowp + lane * 16);
  const f32x4 a = rp[0], b = rp[1], c = rp[2], d = rp[3];
  float m = fmaxf(fmaxf(fmaxf(fabsf(a.x), fabsf(a.y)), fmaxf(fabsf(a.z), fabsf(a.w))), fmaxf(fmaxf(fabsf(b.x), fabsf(b.y)), fmaxf(fabsf(b.z), fabsf(b.w))));
  m = fmaxf(m, fmaxf(fmaxf(fmaxf(fabsf(c.x), fabsf(c.y)), fmaxf(fabsf(c.z), fabsf(c.w))), fmaxf(fmaxf(fabsf(d.x), fabsf(d.y)), fmaxf(fabsf(d.z), fabsf(d.w)))));
  m = wave_max(m);
  sc = m > 0.f ? m * (1.0f / 448.0f) : 1.0f;
  const float inv = 1.0f / sc;
  u32x4 o; unsigned w;
  w = 0; w = __builtin_amdgcn_cvt_pk_fp8_f32(a.x * inv, a.y * inv, w, false); w = __builtin_amdgcn_cvt_pk_fp8_f32(a.z * inv, a.w * inv, w, true); o.x = w;
  w = 0; w = __builtin_amdgcn_cvt_pk_fp8_f32(b.x * inv, b.y * inv, w, false); w = __builtin_amdgcn_cvt_pk_fp8_f32(b.z * inv, b.w * inv, w, true); o.y = w;
  w = 0; w = __builtin_amdgcn_cvt_pk_fp8_f32(c.x * inv, c.y * inv, w, false); w = __builtin_amdgcn_cvt_pk_fp8_f32(c.z * inv, c.w * inv, w, true); o.z = w;
  w = 0; w = __builtin_amdgcn_cvt_pk_fp8_f32(d.x * inv, d.y * inv, w, false); w = __builtin_amdgcn_cvt_pk_fp8_f32(d.z * inv, d.w * inv, w, true); o.w = w;
  return o;
}
DI void ph_convert_ev8(int vb, char* smem, const float* __restrict__ src, u8_t* __restrict__ EV8c, float* __restrict__ scaleV) {
  const int tid256_ = fresh_tid() & 255;
  u8_t (*t)[1040] = (u8_t (*)[1040])smem;
  const int lane = TID & 63, wave = TID >> 6, e0 = vb * 32;
  for (int rr = 0; rr < 8; ++rr) {
    const int r = wave * 8 + rr;
    float sc;
    const u32x4 o = quant_row16(src + (size_t)(e0 + r) * D, lane, sc);
    *(u32x4*)&t[r][lane * 16] = o;
    if (lane == 0) scaleV[e0 + r] = sc;
  }
  __syncthreads();
  const int r = TID & 31, cs = TID >> 5;
  for (int c0 = 0; c0 < 128; c0 += 8) {
    const int cg = c0 + cs;
    const u32x2 v = *(const u32x2*)&t[r][cg * 8];
    *(u32x2*)(EV8c + ((size_t)cg * NEXP + e0 + r) * 8) = v;
  }
  __syncthreads();
}
struct PeerUHalf { u32x4 u[8]; };
DI float gelu_as(float v) {
  const float av = fabsf(v);
  const float t = __builtin_amdgcn_rcpf(av * 0.2316418882f + 1.0f);
  float q = t * 0.5307027145f + (-0.7265760135f); q = q * t + 0.7107068705f; q = q * t + (-0.142248368f); q = q * t + 0.127414796f; q = q * t;
  const float e = __builtin_amdgcn_exp2f((v * v) * (-0.72134752044f));
  const float m = v * (q * e);
  return v < 0.f ? m : v - m;
}
DI void pc_stage_scales(char* smem, const float* __restrict__ scaleU, const float* __restrict__ scaleV) {
  unsigned* sc = (unsigned*)(smem + 34816);
  const int tid = fresh_tid();
#pragma unroll 4
  for (int i = tid; i < NEXP; i += 512) sc[i] = f2bf(scaleU[i]) | (f2bf(scaleV[i]) << 16);
  __syncthreads();
}
DI void ph_peer_c8(int unit, char* smem, const bf16_t* __restrict__ PP, const unsigned short* __restrict__ EIDX, const float* __restrict__ GATE,
                   const float* __restrict__ SSQ, unsigned* __restrict__ STREAM) {
  unsigned (*tile)[132] = (unsigned (*)[132])smem;
  const unsigned* sc = (const unsigned*)(smem + 34816);
  const int tid = fresh_tid();
  const int tl = tid >> 3, kc = tid & 7;
  const size_t rowoff = ((size_t)unit * 64 + tl) * 128 + kc * 16;
  const size_t n = (size_t)TREAL * 128;
  const int tok = unit * 64 + tl;
  const float r2 = rsqrtf(((SSQ[tok] + SSQ[TREAL + tok]) + (SSQ[2 * TREAL + tok] + SSQ[3 * TREAL + tok])) * (1.0f / D) + EPS);
  float a[16];
#pragma unroll
  for (int j = 0; j < 16; ++j) a[j] = 0.f;
#pragma unroll
  for (int s = 0; s < 8; ++s) {
    const u32x4 p0 = *(const u32x4*)(PP + (size_t)s * n + rowoff), p1 = *(const u32x4*)(PP + (size_t)s * n + rowoff + 8);
    a[0] += bflo(p0.x); a[1] += bfhi(p0.x); a[2] += bflo(p0.y); a[3] += bfhi(p0.y); a[4] += bflo(p0.z); a[5] += bfhi(p0.z); a[6] += bflo(p0.w); a[7] += bfhi(p0.w);
    a[8] += bflo(p1.x); a[9] += bfhi(p1.x); a[10] += bflo(p1.y); a[11] += bfhi(p1.y); a[12] += bflo(p1.z); a[13] += bfhi(p1.z); a[14] += bflo(p1.w); a[15] += bfhi(p1.w);
  }
  const u32x4 e0 = *(const u32x4*)(EIDX + rowoff), e1 = *(const u32x4*)(EIDX + rowoff + 8);
  unsigned ev[16] = {e0.x & 0xffffu, e0.x >> 16, e0.y & 0xffffu, e0.y >> 16, e0.z & 0xffffu, e0.z >> 16, e0.w & 0xffffu, e0.w >> 16,
                     e1.x & 0xffffu, e1.x >> 16, e1.y & 0xffffu, e1.y >> 16, e1.z & 0xffffu, e1.z >> 16, e1.w & 0xffffu, e1.w >> 16};
  float gt[16];
#pragma unroll
  for (int j = 0; j < 4; ++j) { const f32x4 g4 = *(const f32x4*)(GATE + rowoff + 4 * j); gt[4 * j] = g4.x; gt[4 * j + 1] = g4.y; gt[4 * j + 2] = g4.z; gt[4 * j + 3] = g4.w; }
#pragma unroll
  for (int j = 0; j < 16; ++j) {
    const unsigned e = ev[j];
    const unsigned sw = sc[e];
    const float av = a[j] * (r2 * bflo(sw));
    const float act = gelu_as(av);
    const float c = gt[j] * act * bfhi(sw);
    tile[tl][kc * 16 + j] = e | (f2bf(c) << 16);
  }
  __syncthreads();
  unsigned* outp = STREAM + (size_t)unit * 8192;
#pragma unroll 4
  for (int j = 0; j < 16; ++j) {
    const int o = tid + 512 * j, q = o >> 8, t2 = (o >> 2) & 63, z = o & 3;
    outp[o] = tile[t2][4 * q + z];
  }
  __syncthreads();
}
struct PVW { u32x4 a, b; };
struct PVT { u32x2 v[8]; };
DI void pv_loadw(PVW& W, const unsigned* __restrict__ STREAM, int it, int g, int lane) {
  const u32x4* sp = (const u32x4*)(STREAM + (size_t)it * 8192) + lane;
  W.a = sp[(2 * g) * 64]; W.b = sp[(2 * g + 1) * 64];
}
DI void pv_readt(PVT& T, const PVW& W, const u32x2* tabl) {
  T.v[0] = tabl[W.a.x & 0xffffu]; T.v[1] = tabl[W.a.y & 0xffffu]; T.v[2] = tabl[W.a.z & 0xffffu]; T.v[3] = tabl[W.a.w & 0xffffu];
  T.v[4] = tabl[W.b.x & 0xffffu]; T.v[5] = tabl[W.b.y & 0xffffu]; T.v[6] = tabl[W.b.z & 0xffffu]; T.v[7] = tabl[W.b.w & 0xffffu];
}
DI void pv_fma1(unsigned w, const u32x2 v, f32x2 (&y)[4]) {
  const float c = bfhi(w);
  const f32x2 cc = {c, c};
  y[0] = __builtin_elementwise_fma(__builtin_amdgcn_cvt_pk_f32_fp8(v.x, false), cc, y[0]);
  y[1] = __builtin_elementwise_fma(__builtin_amdgcn_cvt_pk_f32_fp8(v.x, true), cc, y[1]);
  y[2] = __builtin_elementwise_fma(__builtin_amdgcn_cvt_pk_f32_fp8(v.y, false), cc, y[2]);
  y[3] = __builtin_elementwise_fma(__builtin_amdgcn_cvt_pk_f32_fp8(v.y, true), cc, y[3]);
}
DI void pv_fma(const PVW& W, const PVT& T, f32x2 (&y)[4]) {
  pv_fma1(W.a.x, T.v[0], y); pv_fma1(W.a.y, T.v[1], y); pv_fma1(W.a.z, T.v[2], y); pv_fma1(W.a.w, T.v[3], y);
  pv_fma1(W.b.x, T.v[4], y); pv_fma1(W.b.y, T.v[5], y); pv_fma1(W.b.z, T.v[6], y); pv_fma1(W.b.w, T.v[7], y);
}
DI void pv_load_table(char* smem, const u8_t* __restrict__ EV8c, int cg) {
  const int tid = fresh_tid();
  const u32x4* src = (const u32x4*)(EV8c + (size_t)cg * NEXP * 8);
#pragma unroll 4
  for (int i = tid; i < NEXP * 8 / 16; i += 512) ((u32x4*)smem)[i] = src[i];
  __syncthreads();
}
DI void pv_process(const char* smem, const unsigned* __restrict__ STREAM, bf16_t* __restrict__ YT, int cg, int it0, int it_end, int step) {
  const int lane = fresh_tid() & 63;
  const u32x2* tabl = (const u32x2*)smem;
  int it = it0;
  if (it >= it_end) return;
  PVW W0, W1, W2, W3; PVT T0, T1;
  pv_loadw(W0, STREAM, it, 0, lane); pv_loadw(W1, STREAM, it, 1, lane);
  pv_readt(T0, W0, tabl);
  for (; it < it_end; it += step) {
    const int itn = (it + step < it_end) ? it + step : it;
    f32x2 y[4];
#pragma unroll
    for (int z = 0; z < 4; ++z) y[z] = (f32x2){0.f, 0.f};
#define PV_STEP(g, Wld, Wrd, Trd, Wc, Tc) \
    pv_loadw(Wld, STREAM, ((g) + 2 < 16) ? it : itn, ((g) + 2) & 15, lane); \
    pv_readt(Trd, Wrd, tabl); \
    pv_fma(Wc, Tc, y); \
    asm volatile("" ::: "memory");
    PV_STEP(0, W2, W1, T1, W0, T0)  PV_STEP(1, W3, W2, T0, W1, T1)  PV_STEP(2, W0, W3, T1, W2, T0)  PV_STEP(3, W1, W0, T0, W3, T1)
    PV_STEP(4, W2, W1, T1, W0, T0)  PV_STEP(5, W3, W2, T0, W1, T1)  PV_STEP(6, W0, W3, T1, W2, T0)  PV_STEP(7, W1, W0, T0, W3, T1)
    PV_STEP(8, W2, W1, T1, W0, T0)  PV_STEP(9, W3, W2, T0, W1, T1)  PV_STEP(10, W0, W3, T1, W2, T0) PV_STEP(11, W1, W0, T0, W3, T1)
    PV_STEP(12, W2, W1, T1, W0, T0) PV_STEP(13, W3, W2, T0, W1, T1) PV_STEP(14, W0, W3, T1, W2, T0) PV_STEP(15, W1, W0, T0, W3, T1)
#undef PV_STEP
    const int t = it * 64 + lane;
    u32x4 yw; yw.x = pk2(y[0].x, y[0].y); yw.y = pk2(y[1].x, y[1].y); yw.z = pk2(y[2].x, y[2].y); yw.w = pk2(y[3].x, y[3].y);
    *(u32x4*)(YT + ((size_t)cg * TREAL + t) * 8) = yw;
  }
}
DI void ph_peer_v8(char* smem, const unsigned* __restrict__ STREAM, const u8_t* __restrict__ EV8c, bf16_t* __restrict__ YT, int itb, int nit) {
  const int wave = __builtin_amdgcn_readfirstlane((int)(threadIdx.x >> 6));
  for (int unit = blockIdx.x; unit < 256; unit += gridDim.x) {
    const int cg = unit & 127, th = unit >> 7;
    pv_load_table(smem, EV8c, cg);
    pv_process(smem, STREAM, YT, cg, itb + th * (nit / 2) + wave, itb + (th + 1) * (nit / 2), 8);
    __syncthreads();
  }
}


DI void ph_final_lds(int unit, char* smem, const bf16_t* __restrict__ H1, const bf16_t* __restrict__ YT, const float* __restrict__ gf, float* __restrict__ out) {
  float (*h2)[1028] = (float (*)[1028])smem;
  const int tid = fresh_tid(), lane = tid & 63, wave = tid >> 6;
  const int t0 = unit * 32;
#pragma unroll
  for (int rr = 0; rr < 4; ++rr) {
    const int r = wave * 4 + rr;
    const bf16_t* hp = H1 + (size_t)(t0 + r) * D;
#pragma unroll
    for (int j = 0; j < 2; ++j) {
      const u32x4 hw = *(const u32x4*)(hp + j * 512 + lane * 8);
      *(f32x4*)&h2[r][j * 512 + lane * 8] = (f32x4){bflo(hw.x), bfhi(hw.x), bflo(hw.y), bfhi(hw.y)};
      *(f32x4*)&h2[r][j * 512 + lane * 8 + 4] = (f32x4){bflo(hw.z), bfhi(hw.z), bflo(hw.w), bfhi(hw.w)};
    }
  }
  __syncthreads();
  {
    const int tok = lane & 31;
#pragma unroll 4
    for (int cg = wave * 2 + (lane >> 5); cg < 128; cg += 16) {
      const u32x4 yw = *(const u32x4*)(YT + ((size_t)cg * TREAL + t0 + tok) * 8);
      f32x4* hp = (f32x4*)&h2[tok][cg * 8];
      f32x4 a = hp[0], b4 = hp[1];
      a.x += bflo(yw.x); a.y += bfhi(yw.x); a.z += bflo(yw.y); a.w += bfhi(yw.y);
      b4.x += bflo(yw.z); b4.y += bfhi(yw.z); b4.z += bflo(yw.w); b4.w += bfhi(yw.w);
      hp[0] = a; hp[1] = b4;
    }
  }
  __syncthreads();
#pragma unroll
  for (int rr = 0; rr < 4; ++rr) {
    const int r = wave * 4 + rr;
    f32x4 v[4]; float ss = 0.f;
#pragma unroll
    for (int j = 0; j < 4; ++j) { v[j] = *(const f32x4*)&h2[r][j * 256 + lane * 4]; ss += v[j].x * v[j].x + v[j].y * v[j].y + v[j].z * v[j].z + v[j].w * v[j].w; }
    ss = wave_sum(ss);
    const float sc = rsqrtf(ss * (1.0f / D) + EPS);
    float* op = out + (size_t)(t0 + r) * D;
#pragma unroll
    for (int j = 0; j < 4; ++j) {
      const f32x4 gg = *(const f32x4*)(gf + j * 256 + lane * 4);
      *(f32x4*)(op + j * 256 + lane * 4) = (f32x4){v[j].x * sc * gg.x, v[j].y * sc * gg.y, v[j].z * sc * gg.z, v[j].w * sc * gg.w};
    }
  }
  __syncthreads();
}

typedef int i32x4 __attribute__((ext_vector_type(4)));
constexpr size_t WS_XQ = 861 * MiB;
constexpr size_t WS_XS = 943 * MiB;
DI unsigned pack_i8x4(float a, float b, float c, float d) {
  const int ia = __float2int_rn(a), ib = __float2int_rn(b), ic = __float2int_rn(c), id = __float2int_rn(d);
  return ((unsigned)ia & 255u) | (((unsigned)ib & 255u) << 8) | (((unsigned)ic & 255u) << 16) | ((unsigned)id << 24);
}
DI u32x4 quant_row16_i8(const float* __restrict__ rowp, const f32x4 (&g)[4], int lane, float& sc) {
  const f32x4* rp = (const f32x4*)(rowp + lane * 16);
  const f32x4 a = rp[0] * g[0], b = rp[1] * g[1], c = rp[2] * g[2], d = rp[3] * g[3];
  float m = fmaxf(fmaxf(fmaxf(fabsf(a.x), fabsf(a.y)), fmaxf(fabsf(a.z), fabsf(a.w))), fmaxf(fmaxf(fabsf(b.x), fabsf(b.y)), fmaxf(fabsf(b.z), fabsf(b.w))));
  m = fmaxf(m, fmaxf(fmaxf(fmaxf(fabsf(c.x), fabsf(c.y)), fmaxf(fabsf(c.z), fabsf(c.w))), fmaxf(fmaxf(fabsf(d.x), fabsf(d.y)), fmaxf(fabsf(d.z), fabsf(d.w)))));
  m = wave_max(m);
  sc = m > 0.f ? m * (1.0f / 127.0f) : 1.0f;
  const float inv = 1.0f / sc;
  u32x4 o;
  o.x = pack_i8x4(a.x * inv, a.y * inv, a.z * inv, a.w * inv); o.y = pack_i8x4(b.x * inv, b.y * inv, b.z * inv, b.w * inv);
  o.z = pack_i8x4(c.x * inv, c.y * inv, c.z * inv, c.w * inv); o.w = pack_i8x4(d.x * inv, d.y * inv, d.z * inv, d.w * inv);
  return o;
}
DI void ph_convert_eu_i8(const float* __restrict__ src, const float* __restrict__ gain, u8_t* __restrict__ EUq, float* __restrict__ scaleU) {
  const int tid = fresh_tid(), lane = tid & 63, wave = tid >> 6;
  f32x4 g[4];
#pragma unroll
  for (int j = 0; j < 4; ++j) g[j] = *(const f32x4*)(gain + lane * 16 + 4 * j);
  for (int e = (blockIdx.x * 8 + wave) * 2; e < NEXP; e += gridDim.x * 16) {
    float sc0, sc1 = 1.f;
    const bool two = e + 1 < NEXP;
    const u32x4 o0 = quant_row16_i8(src + (size_t)e * D, g, lane, sc0);
    u32x4 o1 = o0;
    if (two) o1 = quant_row16_i8(src + (size_t)(e + 1) * D, g, lane, sc1);
    *(u32x4*)(EUq + ((size_t)(lane >> 3) * NEXP + e) * 128 + (lane & 7) * 16) = o0;
    if (two) *(u32x4*)(EUq + ((size_t)(lane >> 3) * NEXP + e + 1) * 128 + (lane & 7) * 16) = o1;
    if (lane == 0) { scaleU[e] = sc0; if (two) scaleU[e + 1] = sc1; }
  }
}
DI int dpp_i(int v, const int sel) {
  if (sel == 0) return __builtin_amdgcn_update_dpp(0, v, 0xB1, 0xF, 0xF, true);
  if (sel == 1) return __builtin_amdgcn_update_dpp(0, v, 0x4E, 0xF, 0xF, true);
  return __builtin_amdgcn_update_dpp(0, v, 0x141, 0xF, 0xF, true);
}
DI int dpp_isum8(int v) { v += dpp_i(v, 0); v += dpp_i(v, 1); v += dpp_i(v, 2); return v; }
template <int HF> DI void peer_ud4_issue(PeerUHalf& H, unsigned idxpair, int lane, const u8_t* __restrict__ tab) {
#pragma unroll
  for (int jj = 0; jj < 8; ++jj) {
    const int j = 8 * HF + jj;
    const unsigned w = (unsigned)__shfl((int)idxpair, (lane & ~7) + (j >> 1));
    const unsigned e = (j & 1) ? (w >> 16) : (w & 0xffffu);
    H.u[jj] = *(const u32x4*)(tab + (size_t)e * 128);
  }
}
template <int HF> DI void peer_ud4_compute(const PeerUHalf& H, const u32x4 xq, int sub, int& res0, int& res1) {
#pragma unroll
  for (int jj = 0; jj < 8; ++jj) {
    const int j = 8 * HF + jj;
    int acc = 0;
    acc = __builtin_amdgcn_sdot4((int)H.u[jj].x, (int)xq.x, acc, false); acc = __builtin_amdgcn_sdot4((int)H.u[jj].y, (int)xq.y, acc, false);
    acc = __builtin_amdgcn_sdot4((int)H.u[jj].z, (int)xq.z, acc, false); acc = __builtin_amdgcn_sdot4((int)H.u[jj].w, (int)xq.w, acc, false);
    acc = dpp_isum8(acc);
    if (sub == (j >> 1)) { if (j & 1) res1 = acc; else res0 = acc; }
  }
}
DI void ph_peer_u_d4(int xi, int nx, int wv, int nwv, int tbeg, int tend, const u8_t* __restrict__ XQ, const float* __restrict__ XS, const u8_t* __restrict__ EUq,
                     const unsigned short* __restrict__ EIDX, bf16_t* __restrict__ PP) {
  const int lane = fresh_tid() & 63, sub = lane & 7;
  const int ntok = (tend - tbeg - wv + nwv - 1) / nwv;
  if (ntok <= 0) return;
#define PU_TOK(i) (tbeg + wv + ((i) < ntok ? (i) : ntok - 1) * nwv)
#define PU_IDX(t) __builtin_nontemporal_load((const unsigned*)(EIDX + (size_t)(t) * 128) + lane)
#define PU_LDX(xq_, xs_, t) { xq_ = *(const u32x4*)(xbase + (size_t)(t) * D); xs_ = XS[(size_t)(t) * 8 + s]; }
#define PU_STORE(t, r0, r1, xs_) __builtin_nontemporal_store(pk2((float)(r0) * (xs_), (float)(r1) * (xs_)), (unsigned*)(pp + (size_t)(t) * 128) + lane)
  for (int s = xi; s < 8; s += nx) {
    const u8_t* tab = EUq + (size_t)s * NEXP * 128 + sub * 16;
    const u8_t* xbase = XQ + s * 128 + sub * 16;
    bf16_t* pp = PP + (size_t)s * TREAL * 128;
    PeerUHalf HA, HB, HC;
    int ta = PU_TOK(0), tb = PU_TOK(1), tc = PU_TOK(2);
    unsigned ia = PU_IDX(ta), ib = PU_IDX(tb), ic = PU_IDX(tc);
    u32x4 xqa; float xsa; PU_LDX(xqa, xsa, ta);
    peer_ud4_issue<0>(HA, ia, lane, tab);
    peer_ud4_issue<1>(HB, ia, lane, tab);
    for (int i = 0; i < ntok; i += 3) {
      const int td = PU_TOK(i + 3), te = PU_TOK(i + 4), tf = PU_TOK(i + 5);
      u32x4 xqb, xqc, xqd; float xsb, xsc, xsd;
      int r0, r1;
      peer_ud4_issue<0>(HC, ib, lane, tab); PU_LDX(xqb, xsb, tb); const unsigned id = PU_IDX(td);
      r0 = 0; r1 = 0;
      peer_ud4_compute<0>(HA, xqa, sub, r0, r1);
      peer_ud4_issue<1>(HA, ib, lane, tab);
      peer_ud4_compute<1>(HB, xqa, sub, r0, r1);
      PU_STORE(ta, r0, r1, xsa);
      peer_ud4_issue<0>(HB, ic, lane, tab); PU_LDX(xqc, xsc, tc); const unsigned ie = PU_IDX(te);
      r0 = 0; r1 = 0;
      peer_ud4_compute<0>(HC, xqb, sub, r0, r1);
      peer_ud4_issue<1>(HC, ic, lane, tab);
      peer_ud4_compute<1>(HA, xqb, sub, r0, r1);
      PU_STORE(tb, r0, r1, xsb);
      peer_ud4_issue<0>(HA, id, lane, tab); PU_LDX(xqd, xsd, td); const unsigned if_ = PU_IDX(tf);
      r0 = 0; r1 = 0;
      peer_ud4_compute<0>(HB, xqc, sub, r0, r1);
      peer_ud4_issue<1>(HB, id, lane, tab);
      peer_ud4_compute<1>(HC, xqc, sub, r0, r1);
      PU_STORE(tc, r0, r1, xsc);
      ta = td; tb = te; tc = tf; ib = ie; ic = if_; xqa = xqd; xsa = xsd;
    }
  }
#undef PU_TOK
#undef PU_IDX
#undef PU_LDX
#undef PU_STORE
}

struct PUI { i32x4 a[8]; };
struct PUE { int e[8]; };

#define XB_TMO      128
#define XB_XCNT(j)  (256  + 64 * (j))
#define XB_XSUB(j)  (1280 + 64 * (j))
#define XB_XGEN(j)  (2304 + 64 * (j))
#define XB_TOP      3328
#define XB_TOPGEN   3392
#define XCD_BAR_WORDS 3456
#define XB_SPIN_CAP (1u << 20)
#define LAS __attribute__((address_space(3)))
DI unsigned xb_ld(unsigned* p)              { return __hip_atomic_load(p, __ATOMIC_RELAXED, __HIP_MEMORY_SCOPE_AGENT); }
DI unsigned xb_add(unsigned* p, unsigned v) { return __hip_atomic_fetch_add(p, v, __ATOMIC_RELAXED, __HIP_MEMORY_SCOPE_AGENT); }
DI unsigned xb_xcc_id() { return (unsigned)__builtin_amdgcn_s_getreg((3 << 11) | 20) & 0xFu; }
#define XB_SPIN(cond, bar) do { unsigned _sp = 0; while (cond) { __builtin_amdgcn_s_sleep(1); \
    if ((++_sp & 255u) == 0u) { if (xb_ld(&(bar)[XB_TMO])) break; if (_sp > XB_SPIN_CAP) { atomicAdd(&(bar)[XB_TMO], 1u); break; } } } } while (0)
struct XcdBarrier { unsigned* bar; unsigned x; volatile unsigned* st; };
DI XcdBarrier xcd_barrier_post(unsigned* bar, volatile unsigned* st) {
  XcdBarrier b; b.bar = bar; b.x = xb_xcc_id(); b.st = st;
  if (threadIdx.x == 0) (void)xb_add(&bar[XB_XCNT(b.x)], 1u);
  return b;
}
DI void xcd_barrier_complete(unsigned* bar, unsigned x, unsigned& nloc, unsigned& nx) {
  const unsigned G = gridDim.x;
  unsigned sum, cnt, mine, sp = 0u;
  for (;;) {
    sum = 0u; cnt = 0u; mine = 0u;
#pragma unroll
    for (unsigned j = 0; j < 16; ++j) { const unsigned c = xb_ld(&bar[XB_XCNT(j)]); sum += c; cnt += (c > 0u) ? 1u : 0u; mine = (j == x) ? c : mine; }
    if (sum == G) break;
    __builtin_amdgcn_s_sleep(1);
    if ((++sp & 255u) == 0u) { if (xb_ld(&bar[XB_TMO])) break; if (sp > XB_SPIN_CAP) { atomicAdd(&bar[XB_TMO], 1u); break; } }
  }
  nloc = mine > 0u ? mine : 1u; nx = cnt > 0u ? cnt : 1u;
}
DI void xcd_barrier(const XcdBarrier& b) {
  asm volatile("s_waitcnt vmcnt(0)" ::: "memory");
  __syncthreads();
  if (threadIdx.x == 0) {
    unsigned* bar = b.bar;
    __builtin_amdgcn_s_waitcnt(0);
    unsigned nloc = b.st[0], nx = b.st[1];
    if (nloc == 0u) { xcd_barrier_complete(bar, b.x, nloc, nx); b.st[0] = nloc; b.st[1] = nx; }
    const unsigned old = xb_add(&bar[XB_XSUB(b.x)], 1u);
    const unsigned gen = old / nloc;
    if (old + 1u == (gen + 1u) * nloc) {
      __builtin_amdgcn_fence(__ATOMIC_RELEASE, "agent");
      asm volatile("s_waitcnt vmcnt(0)" ::: "memory");
      const unsigned og = xb_add(&bar[XB_TOP], 1u);
      const unsigned tg = og / nx;
      if (og + 1u == (tg + 1u) * nx) xb_add(&bar[XB_TOPGEN], 1u);
      else XB_SPIN(xb_ld(&bar[XB_TOPGEN]) == tg, bar);
      __builtin_amdgcn_fence(__ATOMIC_ACQUIRE, "agent");
      xb_add(&bar[XB_XGEN(b.x)], 1u);
      asm volatile("s_waitcnt vmcnt(0)" ::: "memory");
    } else {
      XB_SPIN(xb_ld(&bar[XB_XGEN(b.x)]) == gen, bar);
      __builtin_amdgcn_fence(__ATOMIC_ACQUIRE, "agent");
      asm volatile("s_waitcnt vmcnt(0)" ::: "memory");
    }
  }
  __syncthreads();
}

struct Params {
  const float *x, *meta, *norm1_g, *w_in, *wg, *bg, *sb_g, *gla_g, *w_out, *norm2_g, *w_pq, *sk1, *sk2, *eu, *ev, *gf;
  float* out; char* ws;
};
constexpr int PEER_SPLIT_IT = 512;
constexpr int HALF_SMEM = 73728;
constexpr int SMEM_BYTES = 2 * HALF_SMEM;
constexpr size_t WS_BAR = 0;

__global__ void __launch_bounds__(512, 2) k_fused(Params p) {
  extern __shared__ __attribute__((aligned(16))) char smem_dyn[];
  const int half = __builtin_amdgcn_readfirstlane((int)(threadIdx.x >> 8));
  char* smem = smem_dyn + half * HALF_SMEM;
  __shared__ unsigned xb_words[4];
  if (threadIdx.x < 4) xb_words[threadIdx.x] = 0u;
  __syncthreads();
  const XcdBarrier bar = xcd_barrier_post((unsigned*)(p.ws + WS_BAR), xb_words);
  if (threadIdx.x == 0) xb_words[2] = xb_add((unsigned*)(p.ws + WS_XRANK) + bar.x, 1u);
  const int G = 2 * gridDim.x, bid = 2 * blockIdx.x + half;
  char* ws = p.ws;
  bf16_t* WinT = (bf16_t*)(ws + WS_WIN);
  bf16_t* WoutT = (bf16_t*)(ws + WS_WOUT);
  bf16_t* WpqT = (bf16_t*)(ws + WS_WPQ);
  bf16_t* EU = (bf16_t*)(ws + WS_EU);
  bf16_t* EV = (bf16_t*)(ws + WS_EV);
  bf16_t* SK1b = (bf16_t*)(ws + WS_SK1);
  bf16_t* SK2b = (bf16_t*)(ws + WS_SK2);
  bf16_t* A1 = (bf16_t*)(ws + WS_A1);
  float* GO = (float*)(ws + WS_A1);
  bf16_t* A2 = (bf16_t*)(ws + WS_A1);
  InProjOut O;
  O.QSB = (bf16_t*)(ws + WS_QSB); O.KSB = (bf16_t*)(ws + WS_KSB); O.VTSB = (bf16_t*)(ws + WS_VTSB); O.VSB = (bf16_t*)(ws + WS_VSB);
  O.GQ = (bf16_t*)(ws + WS_GQ); O.GK = (bf16_t*)(ws + WS_GK); O.GV = (bf16_t*)(ws + WS_GVT); O.GR = (bf16_t*)(ws + WS_GR);
  O.GLR = (float*)(ws + WS_GLR);
  bf16_t* H1 = (bf16_t*)(ws + WS_H1);
  float* SSQ = (float*)(ws + WS_XS + 3 * MiB);
  float* R1I = (float*)(ws + WS_XS + 4 * MiB);
  bf16_t* GVT = (bf16_t*)(ws + WS_GVT);
  GlaPtrs GP;
  GP.GQ = O.GQ; GP.GK = O.GK; GP.GVT = GVT; GP.GR = O.GR; GP.GLR = O.GLR; GP.wg = p.wg; GP.bg = p.bg; GP.gla_g = p.gla_g;
  GP.SLOC = (float*)(ws + WS_SLOC); GP.DTOT = (float*)(ws + WS_DTOT); GP.MIX = (bf16_t*)(ws + WS_MIX);
  GlaPrepPtrs GPP; GPP.GQ = O.GQ; GPP.GK = O.GK; GPP.GLR = O.GLR; GPP.wg = p.wg; GPP.bg = p.bg;
  GPP.QT = (bf16_t*)(ws + WS_GQT); GPP.KT = (bf16_t*)(ws + WS_GKT); GPP.KTT = (bf16_t*)(ws + WS_GKTT); GPP.DEC = (float*)(ws + WS_GDEC); GPP.BL = (float*)(ws + WS_GBL);
  GlaPtrs3 GP3; GP3.QT = GPP.QT; GP3.KT = GPP.KT; GP3.KTT = GPP.KTT; GP3.GVT = GVT; GP3.GR = O.GR; GP3.DEC = GPP.DEC; GP3.BL = GPP.BL; GP3.gla_g = p.gla_g;
  GP3.SLOC = GP.SLOC; GP3.DTOT = GP.DTOT; GP3.MIX = GP.MIX;
  bf16_t* MIX = (bf16_t*)(ws + WS_MIX);
  bf16_t* QP = (bf16_t*)(ws + WS_MIX);
  unsigned short* EIDX = (unsigned short*)(ws + WS_EIDX);
  bf16_t* PP = (bf16_t*)(ws + WS_PP);
  bf16_t* YT = (bf16_t*)(ws + WS_A1);
  unsigned* STREAM = (unsigned*)(ws + WS_STREAM);
  float* GATE = (float*)(ws + WS_GATE);

  for (int vb = bid; vb < 832 + 256 + 256; vb += G) {
    if (vb < 832) ph_transpose_w(vb % 104, vb / 104, smem, p.w_in, p.norm1_g, WinT, D, NIN);
    else if (vb < 1088) { const int t = vb - 832; ph_transpose_w(t % 32, t / 32, smem, p.w_out, nullptr, WoutT, D, D); }
    else { const int t = vb - 1088; ph_transpose_w(t % 32, t / 32, smem, p.w_pq, p.norm2_g, WpqT, D, D); }
  }
  ph_convert_eu_i8(p.eu, p.norm2_g, (u8_t*)EU, (float*)(ws + WS_SCU));
  for (int vb = bid; vb < NEXP / 32; vb += G) ph_convert_ev8(vb, smem, p.ev, (u8_t*)EV, (float*)(ws + WS_SCV));
  ph_convert(p.sk1, SK1b, (size_t)8 * 128 * 64 / 8);
  ph_convert(p.sk2, SK2b, (size_t)8 * 128 * 64 / 8);
  ph_zero_pads(O.KSB, O.VTSB, O.GQ, O.GK, GVT);
  for (int vb = bid; vb < TREAL / 16; vb += G) ph_norm_rows<0>(vb, p.x, R1I, A1);
  __syncthreads();
  for (int mb = blockIdx.x; mb < NIN / 16; mb += gridDim.x) ph_meta(mb, smem_dyn, p.meta, p.norm1_g, p.w_in, O);
  xcd_barrier(bar);
  {
    pg8::Gemm g{A1, WinT, TREAL, 3072, D}; pg8::StaticOrder S; S.init(TREAL, 3072, (int)gridDim.x, (int)blockIdx.x);
    EpiInProj E{O, GVT, smem_dyn + 131072};
    pg8::gemm_phase<EpiInProj, pg8::StaticOrder, true, true>((PG8_LAS unsigned char*)smem_dyn, g, S, E);
  }
  for (int panel = blockIdx.x; panel < TREAL / 256; panel += gridDim.x) ph_glr(panel, A1, WinT, O.GLR);
  xcd_barrier(bar);
  for (int it = blockIdx.x; it < 16 * 129; it += gridDim.x) ph_gla_prep(it, smem_dyn, GPP);
  xcd_barrier(bar);
  for (int it = blockIdx.x; it < 16 * 15; it += gridDim.x) gla_item4<0>(it / 15, it % 15, smem_dyn, GP3);
  for (int vb = bid; vb < 64 * 32; vb += G) ph_sb_attn2(vb, O.QSB, O.KSB, O.VTSB, p.sb_g, MIX);
  xcd_barrier(bar);
  for (int it = blockIdx.x; it < 16 * 16; it += gridDim.x) gla_item4<1>(it >> 4, it & 15, smem_dyn, GP3);
  xcd_barrier(bar);
  {
    pg8::Gemm g{MIX, WoutT, TREAL, D, D}; pg8::StaticOrder S; S.init(TREAL, D, (int)gridDim.x, (int)blockIdx.x);
    EpiOut E{A1, R1I, H1, (u8_t*)(ws + WS_XQ), (float*)(ws + WS_XS), SSQ, (float*)(smem_dyn + 131072)};
    pg8::gemm_phase<EpiOut, pg8::StaticOrder, true, true>((PG8_LAS unsigned char*)smem_dyn, g, S, E);
  }
  xcd_barrier(bar);
  {
    pg8::Gemm g{H1, WpqT, TREAL, D, D}; pg8::StaticOrder S; S.init(TREAL, D, (int)gridDim.x, (int)blockIdx.x);
    EpiPQ E{QP, SSQ};
    pg8::gemm_phase<EpiPQ, pg8::StaticOrder, true, true>((PG8_LAS unsigned char*)smem_dyn, g, S, E);
  }
  xcd_barrier(bar);
  {
    const int NV = 8 * (TREAL / 128);
    route_stage_keys(bid & 7, smem, SK1b, SK2b);
    const int rlane = (int)(threadIdx.x & 63u), rwave = (int)((threadIdx.x >> 6) & 3u);
    bf16x8 qa[2][4], qb[2][4];
    if (bid < NV) route_load_q(qa, QP, (bid >> 3) * 128 + rwave * 32 + (rlane & 31), bid & 7, rlane >> 5);
    for (int vb = bid; vb < NV; vb += 2 * G) {
      const int v1 = vb + G, v2 = vb + 2 * G;
      if (v1 < NV) route_load_q(qb, QP, (v1 >> 3) * 128 + rwave * 32 + (rlane & 31), v1 & 7, rlane >> 5);
      ph_route_v2(vb, smem, qa, EIDX, GATE);
      if (v1 < NV) {
        if (v2 < NV) route_load_q(qa, QP, (v2 >> 3) * 128 + rwave * 32 + (rlane & 31), v2 & 7, rlane >> 5);
        ph_route_v2(v1, smem, qb, EIDX, GATE);
      }
    }
  }
  xcd_barrier(bar);
  {
    __shared__ int xinfo[4];
    if (threadIdx.x == 0) {
      unsigned* barw = (unsigned*)(p.ws + WS_BAR);
      unsigned cnt = 0, ord = 0, mine = 1;
      for (unsigned j = 0; j < 16; ++j) { const unsigned c = xb_ld(&barw[XB_XCNT(j)]); if (c > 0) { if (j < bar.x) ++ord; ++cnt; } if (j == bar.x) mine = c; }
      xinfo[0] = (int)ord; xinfo[1] = (int)cnt; xinfo[2] = (int)xb_words[2]; xinfo[3] = (int)mine;
    }
    __syncthreads();
    const int xi = xinfo[0], nx = xinfo[1], rank = xinfo[2], nloc = xinfo[3];
    const int wave = __builtin_amdgcn_readfirstlane((int)(threadIdx.x >> 6));
    const u8_t* XQp = (const u8_t*)(ws + WS_XQ); const float* XSp = (const float*)(ws + WS_XS);
    constexpr int ITA = PEER_SPLIT_IT, TSPLIT = ITA * 64;
    ph_peer_u_d4(xi, nx, rank * 8 + wave, nloc * 8, 0, TSPLIT, XQp, XSp, (const u8_t*)EU, EIDX, PP);
    xcd_barrier(bar);
    pc_stage_scales(smem_dyn, (const float*)(ws + WS_SCU), (const float*)(ws + WS_SCV));
    for (int unit = blockIdx.x; unit < ITA; unit += gridDim.x) ph_peer_c8(unit, smem_dyn, PP, EIDX, GATE, SSQ, STREAM);
    xcd_barrier(bar);
    if (gridDim.x >= 256) {
      const int cg = blockIdx.x & 127, th = (blockIdx.x >> 7) & 1;
      if (blockIdx.x < 256) pv_load_table(smem_dyn, (const u8_t*)EV, cg); else __syncthreads();
      if (wave < 4) { if (blockIdx.x < 256) pv_process(smem_dyn, STREAM, YT, cg, th * (ITA / 2) + wave, (th + 1) * (ITA / 2), 4); }
      else ph_peer_u_d4(xi, nx, rank * 4 + wave - 4, nloc * 4, TSPLIT, TREAL, XQp, XSp, (const u8_t*)EU, EIDX, PP);
    } else {
      ph_peer_u_d4(xi, nx, rank * 8 + wave, nloc * 8, TSPLIT, TREAL, XQp, XSp, (const u8_t*)EU, EIDX, PP);
      ph_peer_v8(smem_dyn, STREAM, (const u8_t*)EV, YT, 0, ITA);
    }
    xcd_barrier(bar);
    pc_stage_scales(smem_dyn, (const float*)(ws + WS_SCU), (const float*)(ws + WS_SCV));
    for (int unit = ITA + blockIdx.x; unit < TREAL / 64; unit += gridDim.x) ph_peer_c8(unit, smem_dyn, PP, EIDX, GATE, SSQ, STREAM);
    xcd_barrier(bar);
    ph_peer_v8(smem_dyn, STREAM, (const u8_t*)EV, YT, ITA, TREAL / 64 - ITA);
  }
  xcd_barrier(bar);
  for (int unit = blockIdx.x; unit < TREAL / 32; unit += gridDim.x) ph_final_lds(unit, smem_dyn, H1, YT, p.gf, p.out);
}

extern "C" void kernel_launch(void* const* d_in, const int* in_sizes, int n_in, void* d_out, int out_size, void* d_ws, size_t ws_size, hipStream_t stream) {
  static int grid = 0;
  if (grid == 0) {
    int dev = 0, cus = 0, per_cu = 0;
    hipGetDevice(&dev);
    hipDeviceGetAttribute(&cus, hipDeviceAttributeMultiprocessorCount, dev);
    hipFuncSetAttribute((const void*)k_fused, hipFuncAttributeMaxDynamicSharedMemorySize, SMEM_BYTES);
    hipOccupancyMaxActiveBlocksPerMultiprocessor(&per_cu, (const void*)k_fused, 512, SMEM_BYTES);
    if (per_cu > 1) per_cu = 1;
    if (per_cu < 1) per_cu = 1;
    grid = cus * per_cu;
  }
  hipMemsetAsync((char*)d_ws + WS_BAR, 0, 32768, stream);
  Params p{};
  p.x = (const float*)d_in[0]; p.meta = (const float*)d_in[1]; p.norm1_g = (const float*)d_in[2]; p.w_in = (const float*)d_in[3];
  p.wg = (const float*)d_in[4]; p.bg = (const float*)d_in[5]; p.sb_g = (const float*)d_in[6]; p.gla_g = (const float*)d_in[7];
  p.w_out = (const float*)d_in[8]; p.norm2_g = (const float*)d_in[9]; p.w_pq = (const float*)d_in[10]; p.sk1 = (const float*)d_in[11];
  p.sk2 = (const float*)d_in[12]; p.eu = (const float*)d_in[13]; p.ev = (const float*)d_in[14]; p.gf = (const float*)d_in[15];
  p.out = (float*)d_out; p.ws = (char*)d_ws;
  void* args[] = {&p};
  hipLaunchCooperativeKernel((const void*)k_fused, dim3(grid), dim3(512), args, SMEM_BYTES, stream);
}
```

```cpp
#include <hip/hip_runtime.h>
#include <stdint.h>
#include <stddef.h>

typedef unsigned short bf16_t;
typedef short bf16x8 __attribute__((ext_vector_type(8)));
typedef float f32x16 __attribute__((ext_vector_type(16)));
typedef float f32x4 __attribute__((ext_vector_type(4)));
typedef float f32x2 __attribute__((ext_vector_type(2)));
typedef unsigned u32x4 __attribute__((ext_vector_type(4)));
typedef unsigned u32x2 __attribute__((ext_vector_type(2)));
typedef __bf16 bf16x2_t __attribute__((ext_vector_type(2)));

#define DI __device__ __forceinline__
__device__ __forceinline__ int fresh_tid() { int t = (int)threadIdx.x; asm volatile("" : "+v"(t)); return t; }
#define TID tid256_
#define MFMA32(a, b, c) __builtin_amdgcn_mfma_f32_32x32x16_bf16((a), (b), (c), 0, 0, 0)

constexpr int D = 1024, NB = 8, SEQ = 8192, NMETA = 16;
constexpr int TREAL = NB * SEQ;
constexpr int MROWS = TREAL + 128;
constexpr int NIN = 3088, NINP = 3328;
constexpr int SBH = 8, SBD = 64;
constexpr int GH = 4, GDK = 64, GDV = 128;
constexpr int KIDX = SEQ + 32;
constexpr int GU = SEQ + 64;
constexpr int NEXP = 16384;
constexpr float EPS = 1e-6f;

constexpr size_t MiB = 1u << 20;
constexpr size_t WS_WIN = 1 * MiB;
constexpr size_t WS_WOUT = 8 * MiB;
constexpr size_t WS_WPQ = 10 * MiB;
constexpr size_t WS_SK1 = 12 * MiB;
constexpr size_t WS_SK2 = 13 * MiB;
constexpr size_t WS_EU = 16 * MiB;
constexpr size_t WS_EV = 48 * MiB;
constexpr size_t WS_A1 = 80 * MiB;
constexpr size_t WS_QSB = 210 * MiB;
constexpr size_t WS_KSB = 274 * MiB;
constexpr size_t WS_VTSB = 339 * MiB;
constexpr size_t WS_GQ = 404 * MiB;
constexpr size_t WS_GK = 437 * MiB;
constexpr size_t WS_H1 = 210 * MiB;
constexpr size_t WS_GV = 470 * MiB;
constexpr size_t WS_GR = 535 * MiB;
constexpr size_t WS_GLR = 599 * MiB;
constexpr size_t WS_LG = 604 * MiB;
constexpr size_t WS_MIX = 669 * MiB;
constexpr size_t WS_EIDX = 797 * MiB;
constexpr size_t WS_GATE = 829 * MiB;
constexpr size_t WS_PP = 470 * MiB;
constexpr size_t WS_STREAM = 726 * MiB;
constexpr size_t WS_XRANK = 16384;
constexpr size_t WS_VSB = 861 * MiB;
constexpr size_t WS_END = 926 * MiB;

DI unsigned f2bf(float f) { unsigned u = __float_as_uint(f); return (u + 0x7fffu + ((u >> 16) & 1u)) >> 16; }
DI float bf2f(unsigned b) { return __uint_as_float(b << 16); }
DI unsigned pk2(float lo, float hi) { f32x2 v = {lo, hi}; return __builtin_bit_cast(unsigned, __builtin_convertvector(v, bf16x2_t)); }
DI float bflo(unsigned u) { return __uint_as_float(u << 16); }
DI float bfhi(unsigned u) { return __uint_as_float(u & 0xffff0000u); }
DI int crow(int reg, int h) { return (reg & 3) + 8 * (reg >> 2) + 4 * h; }
DI float wave_sum(float v) {
#pragma unroll
  for (int o = 32; o >= 1; o >>= 1) v += __shfl_xor(v, o);
  return v;
}
DI float softplus(float z) { return fmaxf(z, 0.f) + __logf(1.f + __expf(-fabsf(z))); }

DI void ph_transpose_w(int bx, int by, char* smem, const float* __restrict__ W, const float* __restrict__ gain, bf16_t* __restrict__ WT, int K, int N) {
  const int tid256_ = fresh_tid() & 255;
  float (*t)[33] = (float (*)[33])smem;
  const int n0 = bx * 32, k0 = by * 128;
  {
    const int kr = TID >> 3, c4 = (TID & 7) * 4;
    f32x4 v[4];
#pragma unroll
    for (int j = 0; j < 4; ++j) v[j] = (n0 + c4 < N) ? *(const f32x4*)(W + (size_t)(k0 + kr + 32 * j) * N + n0 + c4) : (f32x4){0.f, 0.f, 0.f, 0.f};
#pragma unroll
    for (int j = 0; j < 4; ++j) {
      const float g = gain ? gain[k0 + kr + 32 * j] : 1.f;
      t[kr + 32 * j][c4 + 0] = v[j].x * g; t[kr + 32 * j][c4 + 1] = v[j].y * g; t[kr + 32 * j][c4 + 2] = v[j].z * g; t[kr + 32 * j][c4 + 3] = v[j].w * g;
    }
  }
  __syncthreads();
  {
    const int n = TID >> 3, ks = (TID & 7) * 16;
    unsigned w[8];
#pragma unroll
    for (int i = 0; i < 8; ++i) w[i] = pk2(t[ks + 2 * i][n], t[ks + 2 * i + 1][n]);
    bf16_t* dst = WT + (size_t)(n0 + n) * K + k0 + ks;
    *(u32x4*)dst = (u32x4){w[0], w[1], w[2], w[3]};
    *(u32x4*)(dst + 8) = (u32x4){w[4], w[5], w[6], w[7]};
  }
  __syncthreads();
}
DI void ph_convert(const float* __restrict__ src, bf16_t* __restrict__ dst, size_t n8) {
  size_t i = (size_t)blockIdx.x * blockDim.x + threadIdx.x;
  const size_t stride = (size_t)gridDim.x * blockDim.x;
  for (; i < n8; i += stride) {
    const f32x4 a = ((const f32x4*)src)[2 * i], b = ((const f32x4*)src)[2 * i + 1];
    u32x4 o; o.x = pk2(a.x, a.y); o.y = pk2(a.z, a.w); o.z = pk2(b.x, b.y); o.w = pk2(b.z, b.w);
    ((u32x4*)dst)[i] = o;
  }
}
DI void ph_zero_pads(bf16_t* KSB, bf16_t* VTSB, bf16_t* GQ, bf16_t* GK, bf16_t* GVT) {
  const int tid = blockIdx.x * blockDim.x + threadIdx.x, nth = gridDim.x * blockDim.x;
  for (int i = tid; i < 64 * 16 * 64; i += nth) { const int bh = i / 1024, r = i % 1024; KSB[(size_t)bh * KIDX * 64 + r] = 0; }
  for (int i = tid; i < 64 * 64 * 16; i += nth) { const int row = i / 16, c = i % 16; VTSB[(size_t)row * KIDX + c] = 0; }
  for (int i = tid; i < 32 * 48 * 64; i += nth) { const int bh = i / 3072, r = i % 3072; GQ[(size_t)bh * GU * 64 + r] = 0; GK[(size_t)bh * GU * 64 + r] = 0; }
  for (int i = tid; i < 32 * 128 * 48; i += nth) { const int row = i / 48, c = i % 48; GVT[(size_t)row * GU + c] = 0; }
}

template <int MODE>
DI void ph_norm_rows(int vb, const float* __restrict__ src, const float* __restrict__ meta, bf16_t* __restrict__ dst) {
  const int tid256_ = fresh_tid() & 255;
  const int row0 = vb * 16 + (TID >> 6) * 4, lane = TID & 63;
  f32x4 v[4][4];
#pragma unroll
  for (int rr = 0; rr < 4; ++rr)
#pragma unroll
    for (int j = 0; j < 4; ++j) v[rr][j] = *(const f32x4*)(src + (size_t)(row0 + rr) * D + j * 256 + lane * 4);
  f32x4 gg[4];
#pragma unroll
  for (int j = 0; j < 4; ++j) { gg[j] = (f32x4){1.f, 1.f, 1.f, 1.f}; if (MODE == 1) gg[j] = *(const f32x4*)(meta + j * 256 + lane * 4); }
#pragma unroll
  for (int rr = 0; rr < 4; ++rr) {
    float ss = 0.f;
#pragma unroll
    for (int j = 0; j < 4; ++j) ss += v[rr][j].x * v[rr][j].x + v[rr][j].y * v[rr][j].y + v[rr][j].z * v[rr][j].z + v[rr][j].w * v[rr][j].w;
    ss = wave_sum(ss);
    const float r = rsqrtf(ss * (1.0f / D) + EPS);
    if (MODE == 0 && lane == 0) const_cast<float*>(meta)[row0 + rr] = sqrtf(ss * (1.0f / D) + EPS);
#pragma unroll
    for (int j = 0; j < 4; ++j) {
      u32x2 o; o.x = pk2(v[rr][j].x * r * gg[j].x, v[rr][j].y * r * gg[j].y); o.y = pk2(v[rr][j].z * r * gg[j].z, v[rr][j].w * r * gg[j].w);
      *(u32x2*)(dst + (size_t)(row0 + rr) * D + j * 256 + lane * 4) = o;
    }
  }
}

namespace pg8 {
#define PG8_LAS __attribute__((address_space(3)))
typedef unsigned short bf16_t;
typedef short bf16x8 __attribute__((ext_vector_type(8)));
typedef float f32x4 __attribute__((ext_vector_type(4)));
typedef unsigned u32x4 __attribute__((ext_vector_type(4)));
constexpr int BM = 256, BK = 64, HALF = 128, HTB = HALF * BK * 2  , STAGE_BYTES = 8 * HTB, NXCD = 8, WGM = 8;

__host__ __device__ __forceinline__ int lds_byte(int r, int c) { const int st = (r >> 4) * 2 + (c >> 5), rr = r & 15, cc = c & 31, ob = rr * 64 + cc * 2; return st * 1024 + (ob ^ (((ob >> 9) & 1) << 5)); }
__host__ __device__ __forceinline__ void stage_rc(int b, int& R, int& C) { const int st = b / 1024, sb = b % 1024, swz = sb ^ (((sb >> 9) & 1) << 5); R = (st >> 1) * 16 + swz / 64; C = (st & 1) * 32 + (swz % 64) / 2; }
__host__ __device__ __forceinline__ int perm32(int rho) { const int n = rho >> 4, i = rho & 15; return 8 * (i >> 2) + 4 * n + (i & 3); }

struct Unit { int pm, pn; };
struct Gemm { const bf16_t* A; const bf16_t* Bt; int M, N, K; };

struct StaticOrder {
    int nM, nN, nwg, G, c;
    __host__ __device__ void init(int M, int N, int G_, int c_) { nM = M / BM; nN = N / BM; nwg = nM * nN; G = G_; c = c_; }
    __host__ __device__ bool next(int i, Unit& u) const {
        const long L = (long)i * G + c; if (L >= nwg) return false;
        int wgid = (int)L; { const int q = nwg / NXCD, r = nwg % NXCD, xcd = wgid % NXCD, off = wgid / NXCD; wgid = (xcd < r ? xcd * (q + 1) : r * (q + 1) + (xcd - r) * q) + off; }
        const int nig = WGM * nN, gid = wgid / nig, fm = gid * WGM, gsz = (nM - fm) < WGM ? (nM - fm) : WGM;
        u.pm = fm + ((wgid % nig) % gsz); u.pn = (wgid % nig) / gsz; return true;
    }
    __device__ __forceinline__ void a_ready(const Unit&) const {}
    __device__ __forceinline__ void done(const Unit&) const {}
};

template <class Epi, class Sched, bool ALIGN_EPI = false, bool SP2 = false>
__device__ __forceinline__ void gemm_phase(PG8_LAS unsigned char* lds, const Gemm g, const Sched& S, const Epi& E) {
    const int tid = fresh_tid(), wid = __builtin_amdgcn_readfirstlane(tid >> 6), lane = tid & 63, wr = wid >> 2, wc = wid & 3, fr = lane & 15, fq = lane >> 4;
    const int K = g.K, nt = K / BK;
    unsigned voffA[2], voffB[2];
#pragma unroll
    for (int i = 0; i < 2; ++i) { int R, C; stage_rc(tid * 16 + i * 8192, R, C); const int Rb = Epi::PERM ? ((R & ~31) + perm32(R & 31)) : R;
        voffA[i] = (unsigned)(R * K + C) * 2u; voffB[i] = (unsigned)(Rb * K + C) * 2u; }
    const size_t kstep = (size_t)(BK * 2);
    const size_t hstep = (size_t)HALF * K * 2;
    const size_t tstep = 2 * hstep;
    const unsigned ldsw = (unsigned)wid * 1024u;
    const int aoff = lds_byte(wr * 64 + fr, fq * 8), boff = lds_byte(wc * 32 + fr, fq * 8);
#define PG8_SA(b, h) (((b) * 2 + (h)) * HTB)
#define PG8_SB(b, h) ((4 + (b) * 2 + (h)) * HTB)
#define PG8_STAGE(bufoff, gbase, voff) do { _Pragma("unroll") for (int _i = 0; _i < 2; ++_i) \
        __builtin_amdgcn_global_load_lds((const unsigned*)((const char*)(gbase) + (voff)[_i]), (PG8_LAS unsigned*)(lds + (bufoff) + ldsw + _i * 8192), 16, 0, 0); } while (0)
#define PG8_LDA(dst, b, h) do { _Pragma("unroll") for (int m = 0; m < 4; ++m) _Pragma("unroll") for (int k = 0; k < 2; ++k) dst[m][k] = *(const PG8_LAS bf16x8*)(lds + PG8_SA(b, h) + aoff + m * 2048 + k * 1024); } while (0)
#define PG8_LDB(dst, b, h) do { _Pragma("unroll") for (int n = 0; n < 2; ++n) _Pragma("unroll") for (int k = 0; k < 2; ++k) dst[n][k] = *(const PG8_LAS bf16x8*)(lds + PG8_SB(b, h) + boff + n * 2048 + k * 1024); } while (0)
#define PG8_MMA(ai, bj, At, Bt) do { __builtin_amdgcn_s_setprio(1); _Pragma("unroll") for (int m = 0; m < 4; ++m) _Pragma("unroll") for (int n = 0; n < 2; ++n) _Pragma("unroll") for (int k = 0; k < 2; ++k) \
        acc[ai][bj][m][n] = __builtin_amdgcn_mfma_f32_16x16x32_bf16(Bt[n][k], At[m][k], acc[ai][bj][m][n], 0, 0, 0); __builtin_amdgcn_s_setprio(0); } while (0)
#define PG8_WAIT_V(n) asm volatile("s_waitcnt vmcnt(" #n ")" ::: "memory")
#define PG8_WAIT_L(n) asm volatile("s_waitcnt lgkmcnt(" #n ")" ::: "memory")
#define PG8_BAR __builtin_amdgcn_s_barrier()
#define PG8_SCHED __builtin_amdgcn_sched_barrier(0)
    Unit cur, nxt; int ui = 0;
    if (!S.next(0, cur)) return;
    f32x4 acc[2][2][4][2];
#pragma unroll
    for (int a = 0; a < 2; ++a)
#pragma unroll
        for (int b = 0; b < 2; ++b)
#pragma unroll
            for (int m = 0; m < 4; ++m)
#pragma unroll
                for (int n = 0; n < 2; ++n) acc[a][b][m][n] = (f32x4){0.f, 0.f, 0.f, 0.f};
    bf16x8 At[4][2], B0[2][2], B1[2][2];
    const char* cA = (const char*)g.A + (size_t)cur.pm * tstep; const char* cB = (const char*)g.Bt + (size_t)cur.pn * tstep;
    S.a_ready(cur);
    if constexpr (SP2) {
        PG8_STAGE(PG8_SB(0, 0), cB, voffB); PG8_STAGE(PG8_SB(0, 1), cB + hstep, voffB); PG8_STAGE(PG8_SA(0, 0), cA, voffA); PG8_STAGE(PG8_SA(0, 1), cA + hstep, voffA);
        if (wr == 1) PG8_BAR;
        PG8_WAIT_V(2); PG8_BAR;
        PG8_STAGE(PG8_SB(1, 0), cB + kstep, voffB); PG8_STAGE(PG8_SA(1, 0), cA + kstep, voffA); PG8_STAGE(PG8_SB(1, 1), cB + hstep + kstep, voffB);
        PG8_WAIT_V(6); PG8_BAR;
    } else {
        PG8_STAGE(PG8_SB(0, 0), cB, voffB); PG8_STAGE(PG8_SA(0, 0), cA, voffA); PG8_STAGE(PG8_SB(0, 1), cB + hstep, voffB); PG8_STAGE(PG8_SA(0, 1), cA + hstep, voffA);
        if (wr == 1) PG8_BAR;
        PG8_WAIT_V(4); PG8_BAR;
        PG8_STAGE(PG8_SB(1, 0), cB + kstep, voffB); PG8_STAGE(PG8_SA(1, 0), cA + kstep, voffA); PG8_STAGE(PG8_SB(1, 1), cB + hstep + kstep, voffB);
        PG8_WAIT_V(6); PG8_BAR;
    }
    for (;;) {
        const bool has_next = S.next(ui + 1, nxt);
        const char* nA = has_next ? (const char*)g.A + (size_t)nxt.pm * tstep : cA; const char* nB = has_next ? (const char*)g.Bt + (size_t)nxt.pn * tstep : cB;
        for (int t = 0; t < nt; t += 2) {
            const bool last = (t == nt - 2);
            const char* a1 = cA + (size_t)(t + 1) * kstep;
            const char* a2 = last ? nA : cA + (size_t)(t + 2) * kstep; const char* b2 = last ? nB : cB + (size_t)(t + 2) * kstep;
            const char* a3 = a2 + kstep; const char* b3 = b2 + kstep;
            if (last && has_next) S.a_ready(nxt);
            if constexpr (SP2) {
            PG8_LDB(B0, 0, 0); PG8_LDB(B1, 0, 1); PG8_SCHED; PG8_LDA(At, 0, 0); PG8_STAGE(PG8_SA(1, 1), a1 + hstep, voffA);
            PG8_WAIT_V(8); PG8_WAIT_L(0); PG8_BAR; PG8_MMA(0, 0, At, B0); PG8_MMA(0, 1, At, B1); PG8_BAR; PG8_SCHED;
            PG8_LDA(At, 0, 1); PG8_STAGE(PG8_SB(0, 0), b2, voffB); PG8_STAGE(PG8_SB(0, 1), b2 + hstep, voffB); PG8_STAGE(PG8_SA(0, 0), a2, voffA);
            PG8_WAIT_V(8); PG8_WAIT_L(0); PG8_BAR; PG8_MMA(1, 0, At, B0); PG8_MMA(1, 1, At, B1); PG8_BAR; PG8_SCHED;
            PG8_LDB(B0, 1, 0); PG8_LDB(B1, 1, 1); PG8_SCHED; PG8_LDA(At, 1, 0); PG8_STAGE(PG8_SA(0, 1), a2 + hstep, voffA);
            PG8_WAIT_V(8); PG8_WAIT_L(0); PG8_BAR; PG8_MMA(0, 0, At, B0); PG8_MMA(0, 1, At, B1); PG8_BAR; PG8_SCHED;
            PG8_LDA(At, 1, 1); PG8_STAGE(PG8_SB(1, 0), b3, voffB); PG8_STAGE(PG8_SB(1, 1), b3 + hstep, voffB); PG8_STAGE(PG8_SA(1, 0), a3, voffA);
            PG8_WAIT_V(8); PG8_WAIT_L(0); PG8_BAR; PG8_MMA(1, 0, At, B0); PG8_MMA(1, 1, At, B1); PG8_BAR; PG8_SCHED;
            } else {
            PG8_LDB(B0, 0, 0); PG8_SCHED; PG8_LDA(At, 0, 0); PG8_STAGE(PG8_SA(1, 1), a1 + hstep, voffA);
            PG8_WAIT_L(8); PG8_BAR; PG8_WAIT_L(0); PG8_MMA(0, 0, At, B0); PG8_BAR; PG8_SCHED;
            PG8_LDB(B1, 0, 1); PG8_STAGE(PG8_SB(0, 0), b2, voffB);
            PG8_BAR; PG8_WAIT_L(0); PG8_MMA(0, 1, At, B1); PG8_BAR;
            PG8_LDA(At, 0, 1); PG8_STAGE(PG8_SA(0, 0), a2, voffA);
            PG8_BAR; PG8_WAIT_L(0); PG8_MMA(1, 0, At, B0); PG8_BAR; PG8_SCHED;
            PG8_STAGE(PG8_SB(0, 1), b2 + hstep, voffB);
            PG8_WAIT_V(6); PG8_BAR; PG8_MMA(1, 1, At, B1); PG8_BAR;
            PG8_LDB(B0, 1, 0); PG8_SCHED; PG8_LDA(At, 1, 0); PG8_STAGE(PG8_SA(0, 1), a2 + hstep, voffA);
            PG8_WAIT_L(8); PG8_BAR; PG8_WAIT_L(0); PG8_MMA(0, 0, At, B0); PG8_BAR; PG8_SCHED;
            PG8_LDB(B1, 1, 1); PG8_STAGE(PG8_SB(1, 0), b3, voffB);
            PG8_BAR; PG8_WAIT_L(0); PG8_MMA(0, 1, At, B1); PG8_BAR;
            PG8_LDA(At, 1, 1); PG8_STAGE(PG8_SA(1, 0), a3, voffA);
            PG8_BAR; PG8_WAIT_L(0); PG8_MMA(1, 0, At, B0); PG8_BAR; PG8_SCHED;
            PG8_STAGE(PG8_SB(1, 1), b3 + hstep, voffB);
            PG8_WAIT_V(6); PG8_BAR; PG8_MMA(1, 1, At, B1); PG8_BAR;
            }
        }
        if constexpr (ALIGN_EPI) { if (wr == 0) PG8_BAR; }
        if constexpr (!Epi::AFTER_DRAIN) { E(acc, cur, wr, wc, fr, fq); S.done(cur); }
        if (!has_next) break;
#pragma unroll
        for (int a = 0; a < 2; ++a)
#pragma unroll
            for (int b = 0; b < 2; ++b)
#pragma unroll
                for (int m = 0; m < 4; ++m)
#pragma unroll
                    for (int n = 0; n < 2; ++n) acc[a][b][m][n] = (f32x4){0.f, 0.f, 0.f, 0.f};
        cur = nxt; cA = nA; cB = nB; ++ui;
        if constexpr (ALIGN_EPI) { if (wr == 1) PG8_BAR; }
    }
    PG8_WAIT_V(0);
    if constexpr (!ALIGN_EPI) { if (wr == 0) PG8_BAR; }
    PG8_BAR;
    if constexpr (Epi::AFTER_DRAIN) { E.fused(acc, cur, wr, wc, fr, fq, lds, wid, lane); S.done(cur); }
#undef PG8_SA
#undef PG8_SB
#undef PG8_STAGE
#undef PG8_LDA
#undef PG8_LDB
#undef PG8_MMA
#undef PG8_WAIT_V
#undef PG8_WAIT_L
#undef PG8_BAR
#undef PG8_SCHED
}
}

struct InProjOut { bf16_t *QSB, *KSB, *VSB, *VTSB, *GQ, *GK, *GV, *GR; float* GLR; };

struct EpiInProj {
  static constexpr bool PERM = true, AFTER_DRAIN = false;
  InProjOut O; bf16_t* GVT; char* stage;
  DI void store_vt(const pg8::f32x4 (&acc)[2][2][4][2], const pg8::Unit& u, int wr, int wc, int fr, int fq) const {
    bf16_t* st = (bf16_t*)(stage + (wr * 4 + wc) * 1280);
    const int lane = fr + 16 * fq;
    const int rc = lane >> 2, r8 = lane & 3;
#pragma unroll
    for (int ai = 0; ai < 2; ++ai)
#pragma unroll
      for (int bj = 0; bj < 2; ++bj)
#pragma unroll
        for (int mp = 0; mp < 2; ++mp)
#pragma unroll
          for (int ch = 0; ch < 2; ++ch) {
            if ((fq >> 1) == ch) {
#pragma unroll
              for (int m2 = 0; m2 < 2; ++m2)
#pragma unroll
                for (int n = 0; n < 2; ++n) {
                  const pg8::f32x4 v = acc[ai][bj][2 * mp + m2][n];
                  const int cl = 8 * (fq & 1) + 4 * n, rl = 16 * m2 + fr;
                  st[(cl + 0) * 40 + rl] = (bf16_t)f2bf(v[0]); st[(cl + 1) * 40 + rl] = (bf16_t)f2bf(v[1]);
                  st[(cl + 2) * 40 + rl] = (bf16_t)f2bf(v[2]); st[(cl + 3) * 40 + rl] = (bf16_t)f2bf(v[3]);
                }
            }
            asm volatile("s_waitcnt lgkmcnt(0)" ::: "memory");
            const u32x4 w = *(const u32x4*)&st[rc * 40 + 8 * r8];
            asm volatile("" ::: "memory");
            const int col = u.pn * 256 + bj * 128 + wc * 32 + 16 * ch + rc;
            const int row = u.pm * 256 + ai * 128 + wr * 64 + 32 * mp + 8 * r8;
            const int b = row >> 13, i = row & 8191;
            bf16_t* dst;
            if (u.pn < 6) { const int c = col - 1024; dst = O.VTSB + ((size_t)(b * SBH + (c >> 6)) * 64 + (c & 63)) * KIDX + 32 + i; }
            else          { const int c = col - 2048; dst = GVT + ((size_t)(b * GH + (c >> 7)) * 128 + (c & 127)) * GU + 64 + i; }
            *(u32x4*)dst = w;
          }
  }
  DI void operator()(const pg8::f32x4 (&acc)[2][2][4][2], const pg8::Unit& u, int wr, int wc, int fr, int fq) const {
    const int pn = u.pn;
    if (pn == 4 || pn == 5 || pn == 8 || pn == 9) { store_vt(acc, u, wr, wc, fr, fq); return; }
#pragma unroll
    for (int ai = 0; ai < 2; ++ai)
#pragma unroll
      for (int m = 0; m < 4; ++m) {
        const int row = u.pm * 256 + ai * 128 + wr * 64 + m * 16 + fr;
        const int b = row >> 13, i = row & 8191;
#pragma unroll
        for (int bj = 0; bj < 2; ++bj) {
          const int col = pn * 256 + bj * 128 + wc * 32 + 8 * fq;
          const pg8::f32x4 v0 = acc[ai][bj][m][0], v1 = acc[ai][bj][m][1];
          if (pn < 12) {
            u32x4 w; w.x = pk2(v0[0], v0[1]); w.y = pk2(v0[2], v0[3]); w.z = pk2(v1[0], v1[1]); w.w = pk2(v1[2], v1[3]);
            bf16_t* dst;
            if (pn < 2)       { const int c = col;        dst = O.QSB + ((size_t)(b * SBH + (c >> 6)) * SEQ + i) * 64 + (c & 63); }
            else if (pn < 4)  { const int c = col - 512;  dst = O.KSB + ((size_t)(b * SBH + (c >> 6)) * KIDX + 32 + i) * 64 + (c & 63); }
            else if (pn == 6) { const int c = col - 1536; dst = O.GQ + ((size_t)(b * GH + (c >> 6)) * GU + 64 + i) * 64 + (c & 63); }
            else if (pn == 7) { const int c = col - 1792; dst = O.GK + ((size_t)(b * GH + (c >> 6)) * GU + 64 + i) * 64 + (c & 63); }
            else              { const int c = col - 2560; dst = O.GR + (size_t)row * 512 + c; }
            *(u32x4*)dst = w;
          } else if (col < NIN) {
            float* dst = O.GLR + ((size_t)b * GU + 64 + i) * 16 + (col - 3072);
            *(f32x4*)dst = (f32x4){v0[0], v0[1], v0[2], v0[3]};
            *(f32x4*)(dst + 4) = (f32x4){v1[0], v1[1], v1[2], v1[3]};
          }
        }
      }
  }
};
typedef unsigned char u8_t;
DI unsigned pack_i8x4(float a, float b, float c, float d);
struct EpiOut {
  static constexpr bool PERM = true, AFTER_DRAIN = false;
  const bf16_t* A1; const float* R1I; bf16_t* H1;
  u8_t* XQ; float* XS; float* SSQ; float* xch;
  DI void operator()(const pg8::f32x4 (&acc_)[2][2][4][2], const pg8::Unit& u, int wr, int wc, int fr, int fq) const {
    pg8::f32x4 (&acc)[2][2][4][2] = const_cast<pg8::f32x4 (&)[2][2][4][2]>(acc_);
    float* xa = xch;
    float* xs = xch + 2048;
#pragma unroll
    for (int ai = 0; ai < 2; ++ai)
#pragma unroll
      for (int m = 0; m < 4; ++m) {
        const int row = u.pm * 256 + ai * 128 + wr * 64 + m * 16 + fr;
        const size_t rowoff = (size_t)row * D;
        const float ri = R1I[row];
        float ss = 0.f;
#pragma unroll
        for (int bj = 0; bj < 2; ++bj) {
          const size_t idx = rowoff + u.pn * 256 + bj * 128 + wc * 32 + 8 * fq;
          const u32x4 aw = *(const u32x4*)(A1 + idx);
          const pg8::f32x4 v0 = acc[ai][bj][m][0], v1 = acc[ai][bj][m][1];
          pg8::f32x4 h0, h1;
          h0[0] = bflo(aw.x) * ri + v0[0]; h0[1] = bfhi(aw.x) * ri + v0[1]; h0[2] = bflo(aw.y) * ri + v0[2]; h0[3] = bfhi(aw.y) * ri + v0[3];
          h1[0] = bflo(aw.z) * ri + v1[0]; h1[1] = bfhi(aw.z) * ri + v1[1]; h1[2] = bflo(aw.w) * ri + v1[2]; h1[3] = bfhi(aw.w) * ri + v1[3];
          u32x4 w; w.x = pk2(h0[0], h0[1]); w.y = pk2(h0[2], h0[3]); w.z = pk2(h1[0], h1[1]); w.w = pk2(h1[2], h1[3]);
          *(u32x4*)(H1 + idx) = w;
          acc[ai][bj][m][0] = h0; acc[ai][bj][m][1] = h1;
          ss += h0[0] * h0[0] + h0[1] * h0[1] + h0[2] * h0[2] + h0[3] * h0[3] + h1[0] * h1[0] + h1[1] * h1[1] + h1[2] * h1[2] + h1[3] * h1[3];
          float am = fmaxf(fmaxf(fmaxf(fabsf(h0[0]), fabsf(h0[1])), fmaxf(fabsf(h0[2]), fabsf(h0[3]))), fmaxf(fmaxf(fabsf(h1[0]), fabsf(h1[1])), fmaxf(fabsf(h1[2]), fabsf(h1[3]))));
          am = fmaxf(am, __shfl_xor(am, 16)); am = fmaxf(am, __shfl_xor(am, 32));
          if (fq == 0) xa[((((wr * 2 + ai) * 4 + m) * 2 + bj) * 16 + fr) * 4 + wc] = am;
        }
        ss += __shfl_xor(ss, 16); ss += __shfl_xor(ss, 32);
        if (fq == 0) xs[(((wr * 2 + ai) * 4 + m) * 16 + fr) * 4 + wc] = ss;
      }
    asm volatile("s_waitcnt lgkmcnt(0)\n\ts_barrier" ::: "memory");
#pragma unroll
    for (int ai = 0; ai < 2; ++ai)
#pragma unroll
      for (int m = 0; m < 4; ++m) {
        const int row = u.pm * 256 + ai * 128 + wr * 64 + m * 16 + fr;
#pragma unroll
        for (int bj = 0; bj < 2; ++bj) {
          const f32x4 pm = *(const f32x4*)&xa[((((wr * 2 + ai) * 4 + m) * 2 + bj) * 16 + fr) * 4];
          const float M = fmaxf(fmaxf(pm.x, pm.y), fmaxf(pm.z, pm.w));
          const float inv = M > 0.f ? 127.0f / M : 0.f;
          const pg8::f32x4 h0 = acc[ai][bj][m][0], h1 = acc[ai][bj][m][1];
          u32x2 q;
          q.x = pack_i8x4(h0[0] * inv, h0[1] * inv, h0[2] * inv, h0[3] * inv);
          q.y = pack_i8x4(h1[0] * inv, h1[1] * inv, h1[2] * inv, h1[3] * inv);
          *(u32x2*)(XQ + (size_t)row * D + u.pn * 256 + bj * 128 + wc * 32 + 8 * fq) = q;
          if (wc == 0 && fq == 0) XS[(size_t)row * 8 + 2 * u.pn + bj] = M * (1.0f / 127.0f);
        }
        if (wc == 0 && fq == 0) {
          const f32x4 ps = *(const f32x4*)&xs[(((wr * 2 + ai) * 4 + m) * 16 + fr) * 4];
          SSQ[(size_t)u.pn * TREAL + row] = (ps.x + ps.y) + (ps.z + ps.w);
        }
      }
  }
};
struct EpiPQ {
  static constexpr bool PERM = true, AFTER_DRAIN = false;
  bf16_t* QP; const float* SSQ;
  DI void operator()(const pg8::f32x4 (&acc)[2][2][4][2], const pg8::Unit& u, int wr, int wc, int fr, int fq) const {
#pragma unroll
    for (int ai = 0; ai < 2; ++ai)
#pragma unroll
      for (int m = 0; m < 4; ++m) {
        const int row = u.pm * 256 + ai * 128 + wr * 64 + m * 16 + fr;
        const float r = rsqrtf(((SSQ[row] + SSQ[TREAL + row]) + (SSQ[2 * TREAL + row] + SSQ[3 * TREAL + row])) * (1.0f / D) + EPS);
        const size_t rowoff = (size_t)row * D;
#pragma unroll
        for (int bj = 0; bj < 2; ++bj) {
          const pg8::f32x4 v0 = acc[ai][bj][m][0], v1 = acc[ai][bj][m][1];
          u32x4 w; w.x = pk2(v0[0] * r, v0[1] * r); w.y = pk2(v0[2] * r, v0[3] * r); w.z = pk2(v1[0] * r, v1[1] * r); w.w = pk2(v1[2] * r, v1[3] * r);
          *(u32x4*)(QP + rowoff + u.pn * 256 + bj * 128 + wc * 32 + 8 * fq) = w;
        }
      }
  }
};

DI void ph_meta(int blk, char* smem, const float* __restrict__ meta, const float* __restrict__ g1, const float* __restrict__ w_in, const InProjOut& O) {
  float (*xmT)[16] = (float (*)[16])smem;
  float (*red)[256] = (float (*)[256])(smem + 65536);
  const int tid = fresh_tid(), lane = tid & 63, wave = tid >> 6;
  for (int rr = 0; rr < 2; ++rr) {
    const int mm = wave * 2 + rr;
    float v[16]; float ss = 0.f;
#pragma unroll
    for (int j = 0; j < 16; ++j) { v[j] = meta[(size_t)mm * D + j * 64 + lane]; ss += v[j] * v[j]; }
    ss = wave_sum(ss);
    const float r = rsqrtf(ss * (1.0f / D) + EPS);
#pragma unroll
    for (int j = 0; j < 16; ++j) xmT[j * 64 + lane][mm] = v[j] * r * g1[j * 64 + lane];
  }
  __syncthreads();
  {
    const int c = tid & 15, ks = tid >> 4, n = blk * 16 + c;
    float acc[16];
#pragma unroll
    for (int j = 0; j < 16; ++j) acc[j] = 0.f;
#pragma unroll 8
    for (int kk = 0; kk < 32; ++kk) {
      const int k = ks * 32 + kk;
      const float w = w_in[(size_t)k * NIN + n];
      const f32x4 a = *(const f32x4*)&xmT[k][0], b4 = *(const f32x4*)&xmT[k][4], c4 = *(const f32x4*)&xmT[k][8], d4 = *(const f32x4*)&xmT[k][12];
      acc[0] += a.x * w; acc[1] += a.y * w; acc[2] += a.z * w; acc[3] += a.w * w;
      acc[4] += b4.x * w; acc[5] += b4.y * w; acc[6] += b4.z * w; acc[7] += b4.w * w;
      acc[8] += c4.x * w; acc[9] += c4.y * w; acc[10] += c4.z * w; acc[11] += c4.w * w;
      acc[12] += d4.x * w; acc[13] += d4.y * w; acc[14] += d4.z * w; acc[15] += d4.w * w;
    }
#pragma unroll
    for (int mm = 0; mm < 16; ++mm) red[ks][c * 16 + mm] = acc[mm];
  }
  __syncthreads();
  if (tid < 256) {
    const int c = tid >> 4, mm = tid & 15, n = blk * 16 + c;
    float val = 0.f;
#pragma unroll 8
    for (int ks = 0; ks < 32; ++ks) val += red[ks][tid];
    const bf16_t hv = (bf16_t)f2bf(val);
    for (int bb = 0; bb < NB; ++bb) {
      if (n < 512) {}
      else if (n < 1024) { const int cc = n - 512;  O.KSB[((size_t)(bb * SBH + (cc >> 6)) * KIDX + 16 + mm) * 64 + (cc & 63)] = hv; }
      else if (n < 1536) { const int cc = n - 1024; O.VTSB[((size_t)(bb * SBH + (cc >> 6)) * 64 + (cc & 63)) * KIDX + 16 + mm] = hv; }
      else if (n < 1792) { const int cc = n - 1536; O.GQ[((size_t)(bb * GH + (cc >> 6)) * GU + 48 + mm) * 64 + (cc & 63)] = hv; }
      else if (n < 2048) { const int cc = n - 1792; O.GK[((size_t)(bb * GH + (cc >> 6)) * GU + 48 + mm) * 64 + (cc & 63)] = hv; }
      else if (n < 2560) { const int cc = n - 2048; O.GV[((size_t)(bb * GH + (cc >> 7)) * 128 + (cc & 127)) * GU + 48 + mm] = hv; }
      else if (n < 3072) {}
      else { O.GLR[((size_t)bb * GU + 48 + mm) * 16 + (n - 3072)] = val; }
    }
  }
  __syncthreads();
}


constexpr float SB_THR = 5.421010862e-20f;
DI void ph_sb_attn(int vb, const bf16_t* __restrict__ QSB, const bf16_t* __restrict__ KSB, const bf16_t* __restrict__ VTSB,
                                                 const float* __restrict__ sb_g, bf16_t* __restrict__ MIX) {
  const int tid256_ = fresh_tid() & 255;
  const int lane = TID & 63, wave = TID >> 6, r = lane & 31, h = lane >> 5;
  const int bh = vb >> 6, qb = vb & 63;
  const int b = bh >> 3, hd = bh & 7;
  const int i0 = qb * 128 + wave * 32;
  const bf16_t* Qb = QSB + ((size_t)bh * SEQ + i0) * 64;
  const bf16_t* Kb = KSB + (size_t)bh * KIDX * 64;
  const bf16_t* Vb = VTSB + (size_t)bh * 64 * KIDX;
  bf16x8 qf[4];
#pragma unroll
  for (int ks = 0; ks < 4; ++ks) qf[ks] = *(const bf16x8*)(Qb + r * 64 + ks * 16 + h * 8);
  f32x16 o[2];
#pragma unroll
  for (int e = 0; e < 16; ++e) { o[0][e] = 0.f; o[1][e] = 0.f; }
  float R = 1.f;
  const int qidx = 32 + i0 + r;
  for (int c = (i0 >> 5) + 1; c >= 0; --c) {
    const int k0 = 32 * c;
    bf16x8 kf[4];
#pragma unroll
    for (int ks = 0; ks < 4; ++ks) kf[ks] = *(const bf16x8*)(Kb + (size_t)(k0 + r) * 64 + ks * 16 + h * 8);
    bf16x8 vf[2][2];
#pragma unroll
    for (int mt = 0; mt < 2; ++mt)
#pragma unroll
      for (int s2 = 0; s2 < 2; ++s2) {
        const bf16_t* vp = Vb + (size_t)(mt * 32 + r) * KIDX + k0 + 16 * s2 + 4 * h;
        const u32x2 lo = *(const u32x2*)vp, hi = *(const u32x2*)(vp + 8);
        u32x4 t; t.x = lo.x; t.y = lo.y; t.z = hi.x; t.w = hi.y;
        vf[mt][s2] = __builtin_bit_cast(bf16x8, t);
      }
    f32x16 s;
#pragma unroll
    for (int e = 0; e < 16; ++e) s[e] = 0.f;
#pragma unroll
    for (int ks = 0; ks < 4; ++ks) s = MFMA32(kf[ks], qf[ks], s);
    float om[16], bt[16];
#pragma unroll
    for (int e = 0; e < 16; ++e) {
      const int kidx = k0 + crow(e, h);
      const bool valid = (kidx < qidx) && (kidx >= 16);
      const float z = s[e] * 0.125f;
      const float ez = __expf(-fabsf(z));
      const float big = __builtin_amdgcn_rcpf(1.f + ez), small = ez * big;
      const float beta = z >= 0.f ? big : small, onem = z >= 0.f ? small : big;
      om[e] = valid ? onem : 1.f;
      bt[e] = valid ? beta : 0.f;
    }
    float sfx[16], G[4], PG[4];
#pragma unroll
    for (int g = 0; g < 4; ++g) {
      sfx[4 * g + 3] = 1.f;
      sfx[4 * g + 2] = om[4 * g + 3];
      sfx[4 * g + 1] = sfx[4 * g + 2] * om[4 * g + 2];
      sfx[4 * g + 0] = sfx[4 * g + 1] * om[4 * g + 1];
      G[g] = sfx[4 * g + 0] * om[4 * g + 0];
      PG[g] = __shfl_xor(G[g], 32);
    }
    float HS[4];
    HS[3] = 1.f;
    HS[2] = G[3] * PG[3];
    HS[1] = HS[2] * (G[2] * PG[2]);
    HS[0] = HS[1] * (G[1] * PG[1]);
    const float total = HS[0] * (G[0] * PG[0]);
    float a[16];
#pragma unroll
    for (int e = 0; e < 16; ++e) {
      const int g = e >> 2;
      const float between = sfx[e] * (h == 0 ? PG[g] : 1.f) * (HS[g] * R);
      a[e] = bt[e] * between;
    }
    R *= total;
#pragma unroll
    for (int s2 = 0; s2 < 2; ++s2) {
      u32x4 p;
      p.x = pk2(a[8 * s2 + 0], a[8 * s2 + 1]); p.y = pk2(a[8 * s2 + 2], a[8 * s2 + 3]);
      p.z = pk2(a[8 * s2 + 4], a[8 * s2 + 5]); p.w = pk2(a[8 * s2 + 6], a[8 * s2 + 7]);
      const bf16x8 pf = __builtin_bit_cast(bf16x8, p);
      o[0] = MFMA32(vf[0][s2], pf, o[0]);
      o[1] = MFMA32(vf[1][s2], pf, o[1]);
    }
    if (__all(R < SB_THR)) break;
  }
  float ss = 0.f;
#pragma unroll
  for (int e = 0; e < 16; ++e) ss += o[0][e] * o[0][e] + o[1][e] * o[1][e];
  ss += __shfl_xor(ss, 32);
  const float sc = rsqrtf(ss * (1.0f / 64.0f) + EPS);
  bf16_t* outp = MIX + (size_t)(b * SEQ + i0 + r) * D + hd * 64;
#pragma unroll
  for (int mt = 0; mt < 2; ++mt)
#pragma unroll
    for (int g = 0; g < 4; ++g) {
      const int d = mt * 32 + 8 * g + 4 * h;
      const f32x4 gg = *(const f32x4*)(sb_g + hd * 64 + d);
      u32x2 pk;
      pk.x = pk2(o[mt][4 * g] * sc * gg.x, o[mt][4 * g + 1] * sc * gg.y);
      pk.y = pk2(o[mt][4 * g + 2] * sc * gg.z, o[mt][4 * g + 3] * sc * gg.w);
      *(u32x2*)(outp + d) = pk;
    }
}


template <bool MASK>
DI void sb_tile_step(const f32x16& s, int k0, int qidx, int h, float& R, const bf16x8 (&vf)[2][2], f32x16 (&o)[2]) {
  float om[16], bt[16];
#pragma unroll
  for (int e = 0; e < 16; ++e) {
    const float ez = __builtin_amdgcn_exp2f(s[e] * (0.125f * 1.44269504089f));
    const float onem = __builtin_amdgcn_rcpf(1.f + ez), beta = 1.f - onem;
    if (MASK) {
      const int kidx = k0 + crow(e, h);
      const bool valid = (kidx < qidx) && (kidx >= 16);
      om[e] = valid ? onem : 1.f;
      bt[e] = valid ? beta : 0.f;
    } else { om[e] = onem; bt[e] = beta; }
  }
  float sfx[16], G[4], PG[4];
#pragma unroll
  for (int g = 0; g < 4; ++g) {
    sfx[4 * g + 3] = 1.f;
    sfx[4 * g + 2] = om[4 * g + 3];
    sfx[4 * g + 1] = sfx[4 * g + 2] * om[4 * g + 2];
    sfx[4 * g + 0] = sfx[4 * g + 1] * om[4 * g + 1];
    G[g] = sfx[4 * g + 0] * om[4 * g + 0];
    PG[g] = __shfl_xor(G[g], 32);
  }
  float HS[4];
  HS[3] = 1.f; HS[2] = G[3] * PG[3]; HS[1] = HS[2] * (G[2] * PG[2]); HS[0] = HS[1] * (G[1] * PG[1]);
  const float total = HS[0] * (G[0] * PG[0]);
  float a[16];
#pragma unroll
  for (int e = 0; e < 16; ++e) { const int g = e >> 2; a[e] = bt[e] * (sfx[e] * (h == 0 ? PG[g] : 1.f) * (HS[g] * R)); }
  R *= total;
#pragma unroll
  for (int s2 = 0; s2 < 2; ++s2) {
    u32x4 p;
    p.x = pk2(a[8 * s2 + 0], a[8 * s2 + 1]); p.y = pk2(a[8 * s2 + 2], a[8 * s2 + 3]);
    p.z = pk2(a[8 * s2 + 4], a[8 * s2 + 5]); p.w = pk2(a[8 * s2 + 6], a[8 * s2 + 7]);
    const bf16x8 pf = __builtin_bit_cast(bf16x8, p);
    o[0] = MFMA32(vf[0][s2], pf, o[0]);
    o[1] = MFMA32(vf[1][s2], pf, o[1]);
  }
}
DI void sb_tile_out(const f32x16 (&o)[2], int h, const float* __restrict__ sb_gh, bf16_t* __restrict__ outp) {
  float ss = 0.f;
#pragma unroll
  for (int e = 0; e < 16; ++e) ss += o[0][e] * o[0][e] + o[1][e] * o[1][e];
  ss += __shfl_xor(ss, 32);
  const float sc = rsqrtf(ss * (1.0f / 64.0f) + EPS);
#pragma unroll
  for (int mt = 0; mt < 2; ++mt)
#pragma unroll
    for (int g = 0; g < 4; ++g) {
      const int d = mt * 32 + 8 * g + 4 * h;
      const f32x4 gg = *(const f32x4*)(sb_gh + d);
      u32x2 pk;
      pk.x = pk2(o[mt][4 * g] * sc * gg.x, o[mt][4 * g + 1] * sc * gg.y);
      pk.y = pk2(o[mt][4 * g + 2] * sc * gg.z, o[mt][4 * g + 3] * sc * gg.w);
      *(u32x2*)(outp + d) = pk;
    }
}
DI void ph_sb_attn2(int vb, const bf16_t* __restrict__ QSB, const bf16_t* __restrict__ KSB, const bf16_t* __restrict__ VTSB,
                    const float* __restrict__ sb_g, bf16_t* __restrict__ MIX) {
  const int tid256_ = fresh_tid() & 255;
  const int lane = TID & 63, wave = TID >> 6, r = lane & 31, h = lane >> 5;
  const int bh = vb >> 5, qb = vb & 31;
  const int b = bh >> 3, hd = bh & 7;
  const int i0 = qb * 256 + wave * 64;
  const bf16_t* Qb = QSB + ((size_t)bh * SEQ + i0) * 64;
  const bf16_t* Kb = KSB + (size_t)bh * KIDX * 64;
  const bf16_t* Vb = VTSB + (size_t)bh * 64 * KIDX;
  bf16x8 qfA[4], qfB[4];
#pragma unroll
  for (int ks = 0; ks < 4; ++ks) { qfA[ks] = *(const bf16x8*)(Qb + r * 64 + ks * 16 + h * 8); qfB[ks] = *(const bf16x8*)(Qb + (32 + r) * 64 + ks * 16 + h * 8); }
  f32x16 oA[2], oB[2];
#pragma unroll
  for (int e = 0; e < 16; ++e) { oA[0][e] = 0.f; oA[1][e] = 0.f; oB[0][e] = 0.f; oB[1][e] = 0.f; }
  float RA = 1.f, RB = 1.f;
  const int qidxA = 32 + i0 + r, qidxB = qidxA + 32;
  for (int c = (i0 >> 5) + 2; c >= 0; --c) {
    const int k0 = 32 * c;
    bf16x8 kf[4];
#pragma unroll
    for (int ks = 0; ks < 4; ++ks) kf[ks] = *(const bf16x8*)(Kb + (size_t)(k0 + r) * 64 + ks * 16 + h * 8);
    bf16x8 vf[2][2];
#pragma unroll
    for (int mt = 0; mt < 2; ++mt)
#pragma unroll
      for (int s2 = 0; s2 < 2; ++s2) {
        const bf16_t* vp = Vb + (size_t)(mt * 32 + r) * KIDX + k0 + 16 * s2 + 4 * h;
        const u32x2 lo = *(const u32x2*)vp, hi = *(const u32x2*)(vp + 8);
        u32x4 t; t.x = lo.x; t.y = lo.y; t.z = hi.x; t.w = hi.y;
        vf[mt][s2] = __builtin_bit_cast(bf16x8, t);
      }
    f32x16 sA, sB;
#pragma unroll
    for (int e = 0; e < 16; ++e) { sA[e] = 0.f; sB[e] = 0.f; }
#pragma unroll
    for (int ks = 0; ks < 4; ++ks) { sA = MFMA32(kf[ks], qfA[ks], sA); sB = MFMA32(kf[ks], qfB[ks], sB); }
    if (k0 >= 32 && k0 + 32 <= 64 + i0) sb_tile_step<false>(sB, k0, qidxB, h, RB, vf, oB); else sb_tile_step<true>(sB, k0, qidxB, h, RB, vf, oB);
    if (k0 >= 32 && k0 + 32 <= 32 + i0) sb_tile_step<false>(sA, k0, qidxA, h, RA, vf, oA); else sb_tile_step<true>(sA, k0, qidxA, h, RA, vf, oA);
    if (__all(RA < SB_THR && RB < SB_THR)) break;
  }
  sb_tile_out(oA, h, sb_g + hd * 64, MIX + (size_t)(b * SEQ + i0 + r) * D + hd * 64);
  sb_tile_out(oB, h, sb_g + hd * 64, MIX + (size_t)(b * SEQ + i0 + 32 + r) * D + hd * 64);
}


constexpr int RT_TOK_PER_BLOCK = 256;


#define MFMA16(a, b, c) __builtin_amdgcn_mfma_f32_16x16x32_bf16((a), (b), (c), 0, 0, 0)
constexpr int GLDS = 72;
struct GlaLds {
  bf16_t Qt[64 * GLDS];
  bf16_t Kt[64 * GLDS];
  bf16_t KT[64 * GLDS];
  bf16_t P[64 * GLDS];
  float dec[64];
  float tot[8][64];
  float ssq[8][64];
};
constexpr size_t WS_SLOC = 926 * MiB;
constexpr size_t WS_DTOT = 942 * MiB;
constexpr size_t WS_GVT = 604 * MiB;

struct GlaPtrs { const bf16_t *GQ, *GK, *GVT, *GR; const float *GLR, *wg, *bg, *gla_g; float *SLOC, *DTOT; bf16_t* MIX; };


constexpr size_t WS_GQT = 470 * MiB;
constexpr size_t WS_GKT = 502 * MiB + 512 * 1024;
constexpr size_t WS_GKTT = 861 * MiB;
constexpr size_t WS_GDEC = 894 * MiB;
constexpr size_t WS_GBL = 896 * MiB;
struct GlaPrepPtrs { const bf16_t *GQ, *GK; const float *GLR, *wg, *bg; bf16_t *QT, *KT, *KTT; float *DEC, *BL; };
DI void ph_glr(int panel, const bf16_t* __restrict__ A1, const bf16_t* __restrict__ WinT, float* __restrict__ GLR) {
  const int tid = fresh_tid(), lane = tid & 63, wave = tid >> 6, c16 = lane & 15, q = lane >> 4;
  const int row0 = panel * 256 + wave * 32;
  const bf16_t* a0 = A1 + (size_t)(row0 + c16) * D + 8 * q;
  const bf16_t* a1 = a0 + (size_t)16 * D;
  const bf16_t* bp = WinT + (size_t)(3072 + c16) * D + 8 * q;
  f32x4 acc0 = {0.f, 0.f, 0.f, 0.f}, acc1 = {0.f, 0.f, 0.f, 0.f};
#pragma unroll 8
  for (int ks = 0; ks < D / 32; ++ks) {
    const bf16x8 fa0 = *(const bf16x8*)(a0 + 32 * ks), fa1 = *(const bf16x8*)(a1 + 32 * ks), fb = *(const bf16x8*)(bp + 32 * ks);
    acc0 = MFMA16(fa0, fb, acc0); acc1 = MFMA16(fa1, fb, acc1);
  }
#pragma unroll
  for (int r = 0; r < 4; ++r) {
    const int ra = row0 + 4 * q + r, rb = ra + 16;
    GLR[((size_t)(ra >> 13) * GU + 64 + (ra & 8191)) * 16 + c16] = acc0[r];
    GLR[((size_t)(rb >> 13) * GU + 64 + (rb & 8191)) * 16 + c16] = acc1[r];
  }
}
DI void ph_gla_prep(int pair, char* smem, const GlaPrepPtrs& G) {
  const int tid = fresh_tid(), lane = tid & 63, w = tid >> 6, hb = w >> 2, w4 = w & 3;
  float (*tot)[64] = (float (*)[64])(smem + hb * 1024);
  const int item = 2 * pair + hb;
  const int bh = item / 129, c = item % 129, b = bh >> 2, hd = bh & 3, u0 = 64 * c;
  float wgr[16];
#pragma unroll
  for (int k = 0; k < 16; ++k) wgr[k] = G.wg[k * 256 + hd * 64 + lane];
  const float bgv = G.bg[hd * 64 + lane];
  float cs[16]; float run = 0.f;
  unsigned short kraw[16], qraw[16];
#pragma unroll
  for (int i = 0; i < 16; ++i) {
    const int u = u0 + 16 * w4 + i;
    kraw[i] = G.GK[((size_t)bh * GU + u) * 64 + lane];
    qraw[i] = G.GQ[((size_t)bh * GU + u) * 64 + lane];
  }
#pragma unroll
  for (int i = 0; i < 16; ++i) {
    const int u = u0 + 16 * w4 + i;
    float lgv = 0.f;
    if (u >= 48) {
      const f32x4* gp = (const f32x4*)(G.GLR + ((size_t)b * GU + u) * 16);
      const f32x4 g0 = gp[0], g1 = gp[1], g2 = gp[2], g3 = gp[3];
      float a = bgv;
      a += g0.x * wgr[0] + g0.y * wgr[1] + g0.z * wgr[2] + g0.w * wgr[3];
      a += g1.x * wgr[4] + g1.y * wgr[5] + g1.z * wgr[6] + g1.w * wgr[7];
      a += g2.x * wgr[8] + g2.y * wgr[9] + g2.z * wgr[10] + g2.w * wgr[11];
      a += g3.x * wgr[12] + g3.y * wgr[13] + g3.z * wgr[14] + g3.w * wgr[15];
      lgv = -softplus(-a) * (1.0f / 16.0f);
    }
    run += lgv; cs[i] = run;
  }
  tot[w4][lane] = run;
  __syncthreads();
  float offset = 0.f, total = 0.f;
#pragma unroll
  for (int s2 = 0; s2 < 4; ++s2) { const float tv = tot[s2][lane]; total += tv; if (s2 < w4) offset += tv; }
  const size_t cb = ((size_t)bh * 129 + c) * 4096;
  float kt[16];
#pragma unroll
  for (int i = 0; i < 16; ++i) {
    const float bc = offset + cs[i];
    kt[i] = bf2f(kraw[i]) * __expf(-bc);
    G.QT[cb + (16 * w4 + i) * 64 + lane] = (bf16_t)f2bf(bf2f(qraw[i]) * __expf(bc) * 0.125f);
    G.KT[cb + (16 * w4 + i) * 64 + lane] = (bf16_t)f2bf(kt[i]);
  }
  u32x4 kp; kp.x = pk2(kt[0], kt[1]); kp.y = pk2(kt[2], kt[3]); kp.z = pk2(kt[4], kt[5]); kp.w = pk2(kt[6], kt[7]);
  *(u32x4*)(G.KTT + cb + lane * 64 + 16 * w4) = kp;
  kp.x = pk2(kt[8], kt[9]); kp.y = pk2(kt[10], kt[11]); kp.z = pk2(kt[12], kt[13]); kp.w = pk2(kt[14], kt[15]);
  *(u32x4*)(G.KTT + cb + lane * 64 + 16 * w4 + 8) = kp;
  if (w4 == 0) { G.DEC[((size_t)bh * 129 + c) * 64 + lane] = __expf(total); G.BL[((size_t)bh * 129 + c) * 64 + lane] = total; }
  __syncthreads();
}

struct GlaBuf { bf16_t Qt[64 * GLDS]; bf16_t Kt[64 * GLDS]; bf16_t KT[64 * GLDS]; };
struct GlaLds3 { GlaBuf B[2]; bf16_t P[64 * GLDS]; float ssq[8][64]; };
struct GlaPtrs3 { const bf16_t *QT, *KT, *KTT, *GVT, *GR; const float *DEC, *BL, *gla_g; float *SLOC, *DTOT; bf16_t* MIX; };

template <int PASS>
DI void gla_item3(int bh, int sc, char* smem, const GlaPtrs3& G) {
  GlaLds3& L = *(GlaLds3*)smem;
  const int tid = fresh_tid(), lane = tid & 63, w = __builtin_amdgcn_readfirstlane(tid >> 6), c16 = lane & 15, q = lane >> 4;
  const int b = bh >> 2, hd = bh & 3;
  const int cbeg = sc == 0 ? 0 : 8 * sc + 1, cend = 8 * sc + 9;
  f32x4 X[4];
#pragma unroll
  for (int i = 0; i < 4; ++i) X[i] = (f32x4){0.f, 0.f, 0.f, 0.f};
  if (PASS == 1) {
#pragma unroll 4
    for (int j = 0; j < sc; ++j) {
      const float* dt = G.DTOT + (size_t)(bh * 16 + j) * 64;
      const float* sl = G.SLOC + ((size_t)(bh * 16 + j) * 8 + w) * 16 * 64 + lane;
#pragma unroll
      for (int i = 0; i < 4; ++i) {
        const f32x4 d4 = *(const f32x4*)(dt + 16 * i + 4 * q);
        X[i][0] = d4.x * X[i][0] + sl[(4 * i + 0) * 64]; X[i][1] = d4.y * X[i][1] + sl[(4 * i + 1) * 64];
        X[i][2] = d4.z * X[i][2] + sl[(4 * i + 2) * 64]; X[i][3] = d4.w * X[i][3] + sl[(4 * i + 3) * 64];
      }
    }
  }
  f32x4 gain = {1.f, 1.f, 1.f, 1.f};
  if (PASS == 1) gain = *(const f32x4*)(G.gla_g + hd * 128 + 16 * w + 4 * q);
  const bf16_t* gvt = G.GVT + ((size_t)bh * 128 + 16 * w + c16) * GU + 8 * q;
  const int srow = tid >> 3, sc8 = tid & 7, soff = srow * GLDS + sc8 * 8;
  const size_t cb0 = (size_t)bh * 129 * 4096 + (size_t)srow * 64 + sc8 * 8;
  u32x4 rq, rk, rkt, rq2, rk2, rkt2; bf16x8 vfr[2], vfn[2], vfn2[2]; f32x4 dec[4], decn[4], decn2[4];
  {
    const size_t cb = cb0 + (size_t)cbeg * 4096;
    rkt = *(const u32x4*)(G.KTT + cb);
    if (PASS == 1) { rq = *(const u32x4*)(G.QT + cb); rk = *(const u32x4*)(G.KT + cb); }
    vfr[0] = *(const bf16x8*)(gvt + 64 * cbeg); vfr[1] = *(const bf16x8*)(gvt + 64 * cbeg + 32);
#pragma unroll
    for (int i = 0; i < 4; ++i) dec[i] = *(const f32x4*)(G.DEC + ((size_t)bh * 129 + cbeg) * 64 + 16 * i + 4 * q);
    *(u32x4*)&L.B[0].KT[soff] = rkt;
    if (PASS == 1) { *(u32x4*)&L.B[0].Qt[soff] = rq; *(u32x4*)&L.B[0].Kt[soff] = rk; }
    const size_t cb1 = cb0 + (size_t)(cbeg + 1) * 4096;
    rkt = *(const u32x4*)(G.KTT + cb1);
    if (PASS == 1) { rq = *(const u32x4*)(G.QT + cb1); rk = *(const u32x4*)(G.KT + cb1); }
    vfn[0] = *(const bf16x8*)(gvt + 64 * (cbeg + 1)); vfn[1] = *(const bf16x8*)(gvt + 64 * (cbeg + 1) + 32);
#pragma unroll
    for (int i = 0; i < 4; ++i) decn[i] = *(const f32x4*)(G.DEC + ((size_t)bh * 129 + cbeg + 1) * 64 + 16 * i + 4 * q);
  }
  __syncthreads();
  for (int c = cbeg; c < cend; ++c) {
    const int cur = (c - cbeg) & 1;
    const GlaBuf& Bc = L.B[cur];
    const bool more = c + 1 < cend, more2 = c + 2 < cend;
    if (more2) {
      const size_t cb = cb0 + (size_t)(c + 2) * 4096;
      rkt2 = *(const u32x4*)(G.KTT + cb);
      if (PASS == 1) { rq2 = *(const u32x4*)(G.QT + cb); rk2 = *(const u32x4*)(G.KT + cb); }
      vfn2[0] = *(const bf16x8*)(gvt + 64 * (c + 2)); vfn2[1] = *(const bf16x8*)(gvt + 64 * (c + 2) + 32);
#pragma unroll
      for (int i = 0; i < 4; ++i) decn2[i] = *(const f32x4*)(G.DEC + ((size_t)bh * 129 + c + 2) * 64 + 16 * i + 4 * q);
    }
    u32x2 grv[4];
    if (PASS == 1 && c >= 1) {
#pragma unroll
      for (int n = 0; n < 4; ++n) grv[n] = *(const u32x2*)(G.GR + ((size_t)b * SEQ + 64 * (c - 1) + 16 * n + c16) * 512 + hd * 128 + 16 * w + 4 * q);
    }
    f32x4 OT[4];
    if (PASS == 1) {
      const int is = w >> 1;
#pragma unroll
      for (int z = 0; z < 2; ++z) {
        const int it = 2 * (w & 1) + z;
        f32x4 pa = {0.f, 0.f, 0.f, 0.f};
        if (is <= it) {
#pragma unroll
          for (int kk = 0; kk < 2; ++kk) {
            const bf16x8 ka = *(const bf16x8*)&Bc.Kt[(16 * is + c16) * GLDS + 32 * kk + 8 * q];
            const bf16x8 qb = *(const bf16x8*)&Bc.Qt[(16 * it + c16) * GLDS + 32 * kk + 8 * q];
            pa = MFMA16(ka, qb, pa);
          }
          if (is == it) {
#pragma unroll
            for (int r = 0; r < 4; ++r) if (4 * q + r > c16) pa[r] = 0.f;
          }
        }
        u32x2 pw; pw.x = pk2(pa[0], pa[1]); pw.y = pk2(pa[2], pa[3]);
        *(u32x2*)&L.P[(16 * it + c16) * GLDS + 16 * is + 4 * q] = pw;
      }
#pragma unroll
      for (int n = 0; n < 4; ++n) OT[n] = (f32x4){0.f, 0.f, 0.f, 0.f};
#pragma unroll
      for (int kk = 0; kk < 2; ++kk) {
        u32x4 xp; xp.x = pk2(X[2 * kk][0], X[2 * kk][1]); xp.y = pk2(X[2 * kk][2], X[2 * kk][3]);
        xp.z = pk2(X[2 * kk + 1][0], X[2 * kk + 1][1]); xp.w = pk2(X[2 * kk + 1][2], X[2 * kk + 1][3]);
        const bf16x8 xa = __builtin_bit_cast(bf16x8, xp);
#pragma unroll
        for (int n = 0; n < 4; ++n) {
          const u32x2 lo = *(const u32x2*)&Bc.Qt[(16 * n + c16) * GLDS + 32 * kk + 4 * q];
          const u32x2 hi = *(const u32x2*)&Bc.Qt[(16 * n + c16) * GLDS + 32 * kk + 16 + 4 * q];
          u32x4 qq; qq.x = lo.x; qq.y = lo.y; qq.z = hi.x; qq.w = hi.y;
          OT[n] = MFMA16(xa, __builtin_bit_cast(bf16x8, qq), OT[n]);
        }
      }
      __syncthreads();
#pragma unroll
      for (int kk = 0; kk < 2; ++kk)
#pragma unroll
        for (int n = 0; n < 4; ++n) {
          const bf16x8 pb = *(const bf16x8*)&L.P[(16 * n + c16) * GLDS + 32 * kk + 8 * q];
          OT[n] = MFMA16(vfr[kk], pb, OT[n]);
        }
    }
#pragma unroll
    for (int i = 0; i < 4; ++i) {
#pragma unroll
      for (int kk = 0; kk < 2; ++kk) {
        const bf16x8 ka = *(const bf16x8*)&Bc.KT[(16 * i + c16) * GLDS + 32 * kk + 8 * q];
        X[i] = MFMA16(ka, vfr[kk], X[i]);
      }
      X[i][0] *= dec[i].x; X[i][1] *= dec[i].y; X[i][2] *= dec[i].z; X[i][3] *= dec[i].w;
    }
    if (PASS == 1 && c >= 1) {
      float ss[4];
#pragma unroll
      for (int n = 0; n < 4; ++n) {
        float v = OT[n][0] * OT[n][0] + OT[n][1] * OT[n][1] + OT[n][2] * OT[n][2] + OT[n][3] * OT[n][3];
        v += __shfl_xor(v, 16); v += __shfl_xor(v, 32);
        ss[n] = v;
      }
      if (q == 0) {
#pragma unroll
        for (int n = 0; n < 4; ++n) L.ssq[w][16 * n + c16] = ss[n];
      }
      __syncthreads();
#pragma unroll
      for (int n = 0; n < 4; ++n) {
        float tot = 0.f;
#pragma unroll
        for (int w2 = 0; w2 < 8; ++w2) tot += L.ssq[w2][16 * n + c16];
        const float scl = rsqrtf(tot * (1.0f / 128.0f) + EPS);
        const size_t m = (size_t)b * SEQ + 64 * (c - 1) + 16 * n + c16;
        const float r0 = bflo(grv[n].x), r1 = bfhi(grv[n].x), r2 = bflo(grv[n].y), r3 = bfhi(grv[n].y);
        const float o0 = OT[n][0] * scl * gain.x * (r0 / (1.f + __expf(-r0)));
        const float o1 = OT[n][1] * scl * gain.y * (r1 / (1.f + __expf(-r1)));
        const float o2 = OT[n][2] * scl * gain.z * (r2 / (1.f + __expf(-r2)));
        const float o3 = OT[n][3] * scl * gain.w * (r3 / (1.f + __expf(-r3)));
        u32x2 ow; ow.x = pk2(o0, o1); ow.y = pk2(o2, o3);
        *(u32x2*)(G.MIX + m * D + 512 + hd * 128 + 16 * w + 4 * q) = ow;
      }
    }
    if (more) {
      GlaBuf& Bn = L.B[cur ^ 1];
      *(u32x4*)&Bn.KT[soff] = rkt;
      if (PASS == 1) { *(u32x4*)&Bn.Qt[soff] = rq; *(u32x4*)&Bn.Kt[soff] = rk; }
      vfr[0] = vfn[0]; vfr[1] = vfn[1];
#pragma unroll
      for (int i = 0; i < 4; ++i) dec[i] = decn[i];
      rkt = rkt2; rq = rq2; rk = rk2; vfn[0] = vfn2[0]; vfn[1] = vfn2[1];
#pragma unroll
      for (int i = 0; i < 4; ++i) decn[i] = decn2[i];
    }
    __syncthreads();
  }
  if (PASS == 0) {
    float* sl = G.SLOC + ((size_t)(bh * 16 + sc) * 8 + w) * 16 * 64 + lane;
#pragma unroll
    for (int i = 0; i < 4; ++i)
#pragma unroll
      for (int r = 0; r < 4; ++r) sl[(4 * i + r) * 64] = X[i][r];
    if (w == 0) {
      float bl = 0.f;
      for (int c = cbeg; c < cend; ++c) bl += G.BL[((size_t)bh * 129 + c) * 64 + lane];
      G.DTOT[(size_t)(bh * 16 + sc) * 64 + lane] = __expf(bl);
    }
  }
}


struct GlaLds4 { GlaBuf B[2]; bf16_t P[64 * GLDS]; float ssq[4][64]; };
template <int PASS>
DI void gla_item4(int bh_lo, int sc, char* smem, const GlaPtrs3& G) {
  const int tid = fresh_tid(), lane = tid & 63, w = __builtin_amdgcn_readfirstlane(tid >> 6), c16 = lane & 15, q = lane >> 4;
  const int hb = w >> 2, w4 = w & 3, tid4 = tid & 255;
  GlaLds4& L = *(GlaLds4*)(smem + hb * (int)sizeof(GlaLds4));
  const int bh = bh_lo + 16 * hb, b = bh >> 2, hd = bh & 3;
  const int cbeg = sc == 0 ? 0 : 8 * sc + 1, cend = 8 * sc + 9;
  f32x4 X[2][4];
#pragma unroll
  for (int et = 0; et < 2; ++et)
#pragma unroll
    for (int i = 0; i < 4; ++i) X[et][i] = (f32x4){0.f, 0.f, 0.f, 0.f};
  if (PASS == 1) {
#pragma unroll 2
    for (int j = 0; j < sc; ++j) {
      const float* dt = G.DTOT + (size_t)(bh * 16 + j) * 64;
#pragma unroll
      for (int et = 0; et < 2; ++et) {
        const float* sl = G.SLOC + ((size_t)(bh * 16 + j) * 8 + w4 * 2 + et) * 16 * 64 + lane;
#pragma unroll
        for (int i = 0; i < 4; ++i) {
          const f32x4 d4 = *(const f32x4*)(dt + 16 * i + 4 * q);
          X[et][i][0] = d4.x * X[et][i][0] + sl[(4 * i + 0) * 64]; X[et][i][1] = d4.y * X[et][i][1] + sl[(4 * i + 1) * 64];
          X[et][i][2] = d4.z * X[et][i][2] + sl[(4 * i + 2) * 64]; X[et][i][3] = d4.w * X[et][i][3] + sl[(4 * i + 3) * 64];
        }
      }
    }
  }
  f32x4 gain[2];
#pragma unroll
  for (int et = 0; et < 2; ++et) gain[et] = PASS == 1 ? *(const f32x4*)(G.gla_g + hd * 128 + 32 * w4 + 16 * et + 4 * q) : (f32x4){1.f, 1.f, 1.f, 1.f};
  const bf16_t* gvt0 = G.GVT + ((size_t)bh * 128 + 32 * w4 + c16) * GU + 8 * q;
  const bf16_t* gvt1 = gvt0 + (size_t)16 * GU;
  const int soffA = (tid4 >> 3) * GLDS + (tid4 & 7) * 8, soffB = soffA + 32 * GLDS;
  const size_t cb0 = (size_t)bh * 129 * 4096 + (size_t)(tid4 >> 3) * 64 + (tid4 & 7) * 8;
  u32x4 rq[2], rk[2], rkt[2], rq2[2], rk2[2], rkt2[2];
  bf16x8 vfr[2][2], vfn[2][2]; f32x4 dec[4], decn[4];
#define G4_LOADT(rq_, rk_, rkt_, c_) { const size_t cb_ = cb0 + (size_t)(c_) * 4096; \
    rkt_[0] = *(const u32x4*)(G.KTT + cb_); rkt_[1] = *(const u32x4*)(G.KTT + cb_ + 2048); \
    if (PASS == 1) { rq_[0] = *(const u32x4*)(G.QT + cb_); rq_[1] = *(const u32x4*)(G.QT + cb_ + 2048); rk_[0] = *(const u32x4*)(G.KT + cb_); rk_[1] = *(const u32x4*)(G.KT + cb_ + 2048); } }
#define G4_LOADV(vf_, dc_, c_) { vf_[0][0] = *(const bf16x8*)(gvt0 + 64 * (c_)); vf_[0][1] = *(const bf16x8*)(gvt0 + 64 * (c_) + 32); \
    vf_[1][0] = *(const bf16x8*)(gvt1 + 64 * (c_)); vf_[1][1] = *(const bf16x8*)(gvt1 + 64 * (c_) + 32); \
    _Pragma("unroll") for (int i = 0; i < 4; ++i) dc_[i] = *(const f32x4*)(G.DEC + ((size_t)bh * 129 + (c_)) * 64 + 16 * i + 4 * q); }
#define G4_STORET(Bn_, rq_, rk_, rkt_) { *(u32x4*)&Bn_.KT[soffA] = rkt_[0]; *(u32x4*)&Bn_.KT[soffB] = rkt_[1]; \
    if (PASS == 1) { *(u32x4*)&Bn_.Qt[soffA] = rq_[0]; *(u32x4*)&Bn_.Qt[soffB] = rq_[1]; *(u32x4*)&Bn_.Kt[soffA] = rk_[0]; *(u32x4*)&Bn_.Kt[soffB] = rk_[1]; } }
  G4_LOADT(rq, rk, rkt, cbeg)
  G4_LOADV(vfr, dec, cbeg)
  G4_STORET(L.B[0], rq, rk, rkt)
  G4_LOADT(rq, rk, rkt, cbeg + 1)
  G4_LOADV(vfn, decn, cbeg + 1)
  __syncthreads();
  for (int c = cbeg; c < cend; ++c) {
    const int cur = (c - cbeg) & 1;
    const GlaBuf& Bc = L.B[cur];
    const bool more = c + 1 < cend, more2 = c + 2 < cend;
    if (more2) G4_LOADT(rq2, rk2, rkt2, c + 2)
    u32x2 grv[2][4];
    if (PASS == 1 && c >= 1) {
#pragma unroll
      for (int et = 0; et < 2; ++et)
#pragma unroll
        for (int n = 0; n < 4; ++n) grv[et][n] = *(const u32x2*)(G.GR + ((size_t)b * SEQ + 64 * (c - 1) + 16 * n + c16) * 512 + hd * 128 + 32 * w4 + 16 * et + 4 * q);
    }
    f32x4 OT[2][4];
    if (PASS == 1) {
      const int is = w4;
#pragma unroll
      for (int it = 0; it < 4; ++it) {
        f32x4 pa = {0.f, 0.f, 0.f, 0.f};
        if (is <= it) {
#pragma unroll
          for (int kk = 0; kk < 2; ++kk) {
            const bf16x8 ka = *(const bf16x8*)&Bc.Kt[(16 * is + c16) * GLDS + 32 * kk + 8 * q];
            const bf16x8 qb = *(const bf16x8*)&Bc.Qt[(16 * it + c16) * GLDS + 32 * kk + 8 * q];
            pa = MFMA16(ka, qb, pa);
          }
          if (is == it) {
#pragma unroll
            for (int r = 0; r < 4; ++r) if (4 * q + r > c16) pa[r] = 0.f;
          }
        }
        u32x2 pw; pw.x = pk2(pa[0], pa[1]); pw.y = pk2(pa[2], pa[3]);
        *(u32x2*)&L.P[(16 * it + c16) * GLDS + 16 * is + 4 * q] = pw;
      }
#pragma unroll
      for (int et = 0; et < 2; ++et)
#pragma unroll
        for (int n = 0; n < 4; ++n) OT[et][n] = (f32x4){0.f, 0.f, 0.f, 0.f};
#pragma unroll
      for (int kk = 0; kk < 2; ++kk) {
        bf16x8 xa[2];
#pragma unroll
        for (int et = 0; et < 2; ++et) {
          u32x4 xp; xp.x = pk2(X[et][2 * kk][0], X[et][2 * kk][1]); xp.y = pk2(X[et][2 * kk][2], X[et][2 * kk][3]);
          xp.z = pk2(X[et][2 * kk + 1][0], X[et][2 * kk + 1][1]); xp.w = pk2(X[et][2 * kk + 1][2], X[et][2 * kk + 1][3]);
          xa[et] = __builtin_bit_cast(bf16x8, xp);
        }
#pragma unroll
        for (int n = 0; n < 4; ++n) {
          const u32x2 lo = *(const u32x2*)&Bc.Qt[(16 * n + c16) * GLDS + 32 * kk + 4 * q];
          const u32x2 hi = *(const u32x2*)&Bc.Qt[(16 * n + c16) * GLDS + 32 * kk + 16 + 4 * q];
          u32x4 qq; qq.x = lo.x; qq.y = lo.y; qq.z = hi.x; qq.w = hi.y;
          const bf16x8 qf = __builtin_bit_cast(bf16x8, qq);
          OT[0][n] = MFMA16(xa[0], qf, OT[0][n]);
          OT[1][n] = MFMA16(xa[1], qf, OT[1][n]);
        }
      }
      __syncthreads();
#pragma unroll
      for (int kk = 0; kk < 2; ++kk)
#pragma unroll
        for (int n = 0; n < 4; ++n) {
          const bf16x8 pb = *(const bf16x8*)&L.P[(16 * n + c16) * GLDS + 32 * kk + 8 * q];
          OT[0][n] = MFMA16(vfr[0][kk], pb, OT[0][n]);
          OT[1][n] = MFMA16(vfr[1][kk], pb, OT[1][n]);
        }
    }
#pragma unroll
    for (int i = 0; i < 4; ++i) {
#pragma unroll
      for (int kk = 0; kk < 2; ++kk) {
        const bf16x8 ka = *(const bf16x8*)&Bc.KT[(16 * i + c16) * GLDS + 32 * kk + 8 * q];
        X[0][i] = MFMA16(ka, vfr[0][kk], X[0][i]);
        X[1][i] = MFMA16(ka, vfr[1][kk], X[1][i]);
      }
#pragma unroll
      for (int et = 0; et < 2; ++et) { X[et][i][0] *= dec[i].x; X[et][i][1] *= dec[i].y; X[et][i][2] *= dec[i].z; X[et][i][3] *= dec[i].w; }
    }
    if (PASS == 1 && c >= 1) {
      float ss[4];
#pragma unroll
      for (int n = 0; n < 4; ++n) {
        float v = OT[0][n][0] * OT[0][n][0] + OT[0][n][1] * OT[0][n][1] + OT[0][n][2] * OT[0][n][2] + OT[0][n][3] * OT[0][n][3]
                + OT[1][n][0] * OT[1][n][0] + OT[1][n][1] * OT[1][n][1] + OT[1][n][2] * OT[1][n][2] + OT[1][n][3] * OT[1][n][3];
        v += __shfl_xor(v, 16); v += __shfl_xor(v, 32);
        ss[n] = v;
      }
      if (q == 0) {
#pragma unroll
        for (int n = 0; n < 4; ++n) L.ssq[w4][16 * n + c16] = ss[n];
      }
      __syncthreads();
#pragma unroll
      for (int n = 0; n < 4; ++n) {
        const float tot = L.ssq[0][16 * n + c16] + L.ssq[1][16 * n + c16] + L.ssq[2][16 * n + c16] + L.ssq[3][16 * n + c16];
        const float scl = rsqrtf(tot * (1.0f / 128.0f) + EPS);
        const size_t m = (size_t)b * SEQ + 64 * (c - 1) + 16 * n + c16;
#pragma unroll
        for (int et = 0; et < 2; ++et) {
          const float r0 = bflo(grv[et][n].x), r1 = bfhi(grv[et][n].x), r2 = bflo(grv[et][n].y), r3 = bfhi(grv[et][n].y);
          const float o0 = OT[et][n][0] * scl * gain[et].x * r0 * __builtin_amdgcn_rcpf(1.f + __expf(-r0));
          const float o1 = OT[et][n][1] * scl * gain[et].y * r1 * __builtin_amdgcn_rcpf(1.f + __expf(-r1));
          const float o2 = OT[et][n][2] * scl * gain[et].z * r2 * __builtin_amdgcn_rcpf(1.f + __expf(-r2));
          const float o3 = OT[et][n][3] * scl * gain[et].w * r3 * __builtin_amdgcn_rcpf(1.f + __expf(-r3));
          u32x2 ow; ow.x = pk2(o0, o1); ow.y = pk2(o2, o3);
          *(u32x2*)(G.MIX + m * D + 512 + hd * 128 + 32 * w4 + 16 * et + 4 * q) = ow;
        }
      }
    }
    if (more) {
      GlaBuf& Bn = L.B[cur ^ 1];
      G4_STORET(Bn, rq, rk, rkt)
#pragma unroll
      for (int et = 0; et < 2; ++et) { vfr[et][0] = vfn[et][0]; vfr[et][1] = vfn[et][1]; }
#pragma unroll
      for (int i = 0; i < 4; ++i) dec[i] = decn[i];
#pragma unroll
      for (int z = 0; z < 2; ++z) { rkt[z] = rkt2[z]; rq[z] = rq2[z]; rk[z] = rk2[z]; }
      if (more2) G4_LOADV(vfn, decn, c + 2)
    }
    __syncthreads();
  }
#undef G4_LOADT
#undef G4_LOADV
#undef G4_STORET
  if (PASS == 0) {
#pragma unroll
    for (int et = 0; et < 2; ++et) {
      float* sl = G.SLOC + ((size_t)(bh * 16 + sc) * 8 + w4 * 2 + et) * 16 * 64 + lane;
#pragma unroll
      for (int i = 0; i < 4; ++i)
#pragma unroll
        for (int r = 0; r < 4; ++r) sl[(4 * i + r) * 64] = X[et][i][r];
    }
    if (w4 == 0) {
      float bl = 0.f;
      for (int c = cbeg; c < cend; ++c) bl += G.BL[((size_t)bh * 129 + c) * 64 + lane];
      G.DTOT[(size_t)(bh * 16 + sc) * 64 + lane] = __expf(bl);
    }
  }
}

DI void ce_desc(float& a, float& b) {
  const float hi = __builtin_fmaxf(a, b), lo = __builtin_fminf(a, b);
  a = hi; b = lo;
}
DI float vmaxf(float a, float b) { return __builtin_fmaxf(a, b); }
template <int N> DI void bitonic_sort_desc(float (&v)[N]) {
#pragma unroll
  for (int k = 2; k <= N; k <<= 1) {
#pragma unroll
    for (int j = k >> 1; j > 0; j >>= 1) {
#pragma unroll
      for (int i = 0; i < N; ++i) {
        const int l = i ^ j;
        if (l > i) { if ((i & k) == 0) ce_desc(v[i], v[l]); else ce_desc(v[l], v[i]); }
      }
    }
  }
}
DI void sort16_desc(float (&v)[16]) {
  ce_desc(v[0], v[1]); ce_desc(v[2], v[3]); ce_desc(v[0], v[2]); ce_desc(v[1], v[3]); ce_desc(v[1], v[2]); ce_desc(v[4], v[5]); ce_desc(v[6], v[7]); ce_desc(v[4], v[6]); ce_desc(v[5], v[7]); ce_desc(v[5], v[6]); ce_desc(v[0], v[4]); ce_desc(v[2], v[6]); ce_desc(v[2], v[4]); ce_desc(v[1], v[5]); ce_desc(v[3], v[7]); ce_desc(v[3], v[5]); ce_desc(v[1], v[2]); ce_desc(v[3], v[4]); ce_desc(v[5], v[6]); ce_desc(v[8], v[9]); ce_desc(v[10], v[11]); ce_desc(v[8], v[10]); ce_desc(v[9], v[11]); ce_desc(v[9], v[10]); ce_desc(v[12], v[13]); ce_desc(v[14], v[15]); ce_desc(v[12], v[14]); ce_desc(v[13], v[15]); ce_desc(v[13], v[14]); ce_desc(v[8], v[12]); ce_desc(v[10], v[14]); ce_desc(v[10], v[12]); ce_desc(v[9], v[13]); ce_desc(v[11], v[15]); ce_desc(v[11], v[13]); ce_desc(v[9], v[10]); ce_desc(v[11], v[12]); ce_desc(v[13], v[14]); ce_desc(v[0], v[8]); ce_desc(v[4], v[12]); ce_desc(v[4], v[8]); ce_desc(v[2], v[10]); ce_desc(v[6], v[14]); ce_desc(v[6], v[10]); ce_desc(v[2], v[4]); ce_desc(v[6], v[8]); ce_desc(v[10], v[12]); ce_desc(v[1], v[9]); ce_desc(v[5], v[13]); ce_desc(v[5], v[9]); ce_desc(v[3], v[11]); ce_desc(v[7], v[15]); ce_desc(v[7], v[11]); ce_desc(v[3], v[5]); ce_desc(v[7], v[9]); ce_desc(v[11], v[13]); ce_desc(v[1], v[2]); ce_desc(v[3], v[4]); ce_desc(v[5], v[6]); ce_desc(v[7], v[8]); ce_desc(v[9], v[10]); ce_desc(v[11], v[12]); ce_desc(v[13], v[14]);
}
DI void bitonic_merge16_desc(float (&v)[16]) {
#pragma unroll
  for (int j = 8; j > 0; j >>= 1) {
#pragma unroll
    for (int i = 0; i < 16; ++i) { const int l = i ^ j; if (l > i) ce_desc(v[i], v[l]); }
  }
}
template <int NBV> DI void merge_prune16(float (&a)[16], const float (&b)[16]) {
#pragma unroll
  for (int i = 16 - NBV; i < 16; ++i) a[i] = vmaxf(a[i], b[15 - i]);
  bitonic_merge16_desc(a);
}
DI float selh(int hh, float a, float b) { asm volatile("" : "+v"(a), "+v"(b)); return hh == 0 ? a : b; }
DI float pack_idx(float v, unsigned idx, unsigned mask) { return __uint_as_float((__float_as_uint(v) & ~mask) | idx); }

DI void route_stage_keys(int hd, char* smem, const bf16_t* __restrict__ SK1b, const bf16_t* __restrict__ SK2b) {
  const int tid256_ = fresh_tid() & 255;
  bf16_t* kl = (bf16_t*)smem;
#pragma unroll
  for (int i = 0; i < 8; ++i) {
    const int pz = TID + 256 * i, L = pz >> 10, row = (pz >> 3) & 127, c8 = pz & 7;
    const bf16_t* src = (L == 0 ? SK1b : SK2b) + (size_t)(hd * 128 + row) * 64 + c8 * 8;
    *(u32x4*)&kl[(L * 128 + row) * 72 + c8 * 8] = *(const u32x4*)src;
  }
  __syncthreads();
}
DI void route_load_q(bf16x8 (&qf)[2][4], const bf16_t* __restrict__ QP, int m, int hd, int hh) {
#pragma unroll
  for (int L = 0; L < 2; ++L)
#pragma unroll
    for (int ks = 0; ks < 4; ++ks) qf[L][ks] = *(const bf16x8*)(QP + (size_t)m * D + hd * 128 + L * 64 + hh * 8 + ks * 16);
}
DI void ph_route_v2(int vb, char* smem, const bf16x8 (&qf)[2][4], unsigned short* __restrict__ EIDX, float* __restrict__ GATE) {
  const int tid256_ = fresh_tid() & 255;
  const int lane = TID & 63, wave = TID >> 6, r = lane & 31, hh = lane >> 5;
  const int hd = vb & 7, tile = vb >> 3;
  const int m = tile * 128 + wave * 32 + r;
  const bf16_t* kl = (const bf16_t*)smem;
  float loc[2][16];
#pragma unroll
  for (int L = 0; L < 2; ++L) {
    float grp[4][16];
#pragma unroll
    for (int mt = 0; mt < 4; ++mt) {
      f32x16 acc;
#pragma unroll
      for (int e = 0; e < 16; ++e) acc[e] = 0.f;
#pragma unroll
      for (int ks = 0; ks < 4; ++ks) {
        const bf16x8 kf = *(const bf16x8*)&kl[(L * 128 + mt * 32 + r) * 72 + ks * 16 + hh * 8];
        acc = MFMA32(kf, qf[L][ks], acc);
      }
#pragma unroll
      for (int e = 0; e < 16; ++e) grp[mt][e] = pack_idx(acc[e], (unsigned)(mt * 32 + crow(e, hh)), 127u);
      sort16_desc(grp[mt]);
    }
    merge_prune16<16>(grp[0], grp[1]);
    merge_prune16<16>(grp[2], grp[3]);
    merge_prune16<16>(grp[0], grp[2]);
#pragma unroll
    for (int i = 0; i < 16; ++i) loc[L][i] = grp[0][i];
  }
  float fin[16], oth[16];
#pragma unroll
  for (int i = 0; i < 16; ++i) {
    const float send = selh(hh, loc[1][i], loc[0][i]);
    oth[i] = __shfl_xor(send, 32);
    fin[i] = selh(hh, loc[0][i], loc[1][i]);
  }
  merge_prune16<16>(fin, oth);
  float v1[16], v2[16];
#pragma unroll
  for (int i = 0; i < 16; ++i) {
    const float o = __shfl_xor(fin[i], 32);
    v1[i] = selh(hh, fin[i], o);
    v2[i] = selh(hh, o, fin[i]);
  }
  unsigned* ib = (unsigned*)(smem + 36864) + (size_t)TID * 8;
#pragma unroll
  for (int q = 0; q < 4; ++q) {
    unsigned w1 = 0, w2 = 0;
#pragma unroll
    for (int j = 0; j < 4; ++j) {
      w1 |= (__float_as_uint(v1[4 * q + j]) & 127u) << (8 * j);
      w2 |= (__float_as_uint(v2[4 * q + j]) & 127u) << (8 * j);
    }
    ib[q] = w1; ib[4 + q] = w2;
  }
  float R[16], Bv[16];
#pragma unroll
  for (int j = 0; j < 16; ++j) R[j] = pack_idx(v1[0] + v2[j], (unsigned)j, 255u);
#define ROUTE_ROW(I, CNT) { _Pragma("unroll") for (int j = 0; j < 16; ++j) Bv[j] = (j < CNT) ? pack_idx(v1[I] + v2[j < CNT ? j : 0], (unsigned)(I * 16 + j), 255u) : 0.f; \
    merge_prune16<CNT>(R, Bv); }
  ROUTE_ROW(1, 8) ROUTE_ROW(2, 5) ROUTE_ROW(3, 4) ROUTE_ROW(4, 3) ROUTE_ROW(5, 2) ROUTE_ROW(6, 2) ROUTE_ROW(7, 2)
#undef ROUTE_ROW
#pragma unroll
  for (int j = 0; j < 16; ++j) Bv[j] = (j < 8) ? pack_idx(v1[8 + (j < 8 ? j : 0)] + v2[0], (unsigned)((8 + j) * 16), 255u) : 0.f;
  merge_prune16<8>(R, Bv);
  float ex[16], sum = 0.f;
#pragma unroll
  for (int i = 0; i < 16; ++i) { ex[i] = __expf(R[i] - R[0]); sum += ex[i]; }
  const float inv = 1.f / sum;
  const unsigned char* ibb = (const unsigned char*)ib;
  int eo[8]; float go[8];
#pragma unroll
  for (int w = 0; w < 8; ++w) {
    const float rv = selh(hh, R[w], R[8 + w]);
    const float ev = selh(hh, ex[w], ex[8 + w]);
    const unsigned pos = __float_as_uint(rv) & 255u;
    const unsigned i1 = ibb[pos >> 4], i2 = ibb[16 + (pos & 15u)];
    eo[w] = (int)(i1 * 128u + i2);
    go[w] = ev * inv;
  }
  unsigned short* ep = EIDX + (size_t)m * 128 + hd * 16 + hh * 8;
  float* gp = GATE + (size_t)m * 128 + hd * 16 + hh * 8;
  *(u32x4*)ep = (u32x4){(unsigned)eo[0] | ((unsigned)eo[1] << 16), (unsigned)eo[2] | ((unsigned)eo[3] << 16), (unsigned)eo[4] | ((unsigned)eo[5] << 16), (unsigned)eo[6] | ((unsigned)eo[7] << 16)};
  *(f32x4*)gp = (f32x4){go[0], go[1], go[2], go[3]};
  *(f32x4*)(gp + 4) = (f32x4){go[4], go[5], go[6], go[7]};
}


constexpr size_t WS_SCU = 14 * MiB;
constexpr size_t WS_SCV = 14 * MiB + 65536;
DI float wave_max(float v) {
#pragma unroll
  for (int o = 32; o >= 1; o >>= 1) v = fmaxf(v, __shfl_xor(v, o));
  return v;
}
DI u32x4 quant_row16(const float* __restrict__ rowp, int lane, float& sc) {
  const f32x4* rp = (const f32x4*)(rowp + lane * 16);
  const f32x4 a = rp[0], b = rp[1], c = rp[2], d = rp[3];
  float m = fmaxf(fmaxf(fmaxf(fabsf(a.x), fabsf(a.y)), fmaxf(fabsf(a.z), fabsf(a.w))), fmaxf(fmaxf(fabsf(b.x), fabsf(b.y)), fmaxf(fabsf(b.z), fabsf(b.w))));
  m = fmaxf(m, fmaxf(fmaxf(fmaxf(fabsf(c.x), fabsf(c.y)), fmaxf(fabsf(c.z), fabsf(c.w))), fmaxf(fmaxf(fabsf(d.x), fabsf(d.y)), fmaxf(fabsf(d.z), fabsf(d.w)))));
  m = wave_max(m);
  sc = m > 0.f ? m * (1.0f / 448.0f) : 1.0f;
  const float inv = 1.0f / sc;
  u32x4 o; unsigned w;
  w = 0; w = __builtin_amdgcn_cvt_pk_fp8_f32(a.x * inv, a.y * inv, w, false); w = __builtin_amdgcn_cvt_pk_fp8_f32(a.z * inv, a.w * inv, w, true); o.x = w;
  w = 0; w = __builtin_amdgcn_cvt_pk_fp8_f32(b.x * inv, b.y * inv, w, false); w = __builtin_amdgcn_cvt_pk_fp8_f32(b.z * inv, b.w * inv, w, true); o.y = w;
  w = 0; w = __builtin_amdgcn_cvt_pk_fp8_f32(c.x * inv, c.y * inv, w, false); w = __builtin_amdgcn_cvt_pk_fp8_f32(c.z * inv, c.w * inv, w, true); o.z = w;
  w = 0; w = __builtin_amdgcn_cvt_pk_fp8_f32(d.x * inv, d.y * inv, w, false); w = __builtin_amdgcn_cvt_pk_fp8_f32(d.z * inv, d.w * inv, w, true); o.w = w;
  return o;
}
DI void ph_convert_ev8(int vb, char* smem, const float* __restrict__ src, u8_t* __restrict__ EV8c, float* __restrict__ scaleV) {
  const int tid256_ = fresh_tid() & 255;
  u8_t (*t)[1040] = (u8_t (*)[1040])smem;
  const int lane = TID & 63, wave = TID >> 6, e0 = vb * 32;
  for (int rr = 0; rr < 8; ++rr) {
    const int r = wave * 8 + rr;
    float sc;
    const u32x4 o = quant_row16(src + (size_t)(e0 + r) * D, lane, sc);
    *(u32x4*)&t[r][lane * 16] = o;
    if (lane == 0) scaleV[e0 + r] = sc;
  }
  __syncthreads();
  const int r = TID & 31, cs = TID >> 5;
  for (int c0 = 0; c0 < 128; c0 += 8) {
    const int cg = c0 + cs;
    const u32x2 v = *(const u32x2*)&t[r][cg * 8];
    *(u32x2*)(EV8c + ((size_t)cg * NEXP + e0 + r) * 8) = v;
  }
  __syncthreads();
}
struct PeerUHalf { u32x4 u[8]; };
DI float gelu_as(float v) {
  const float av = fabsf(v);
  const float t = __builtin_amdgcn_rcpf(av * 0.2316418882f + 1.0f);
  float q = t * 0.5307027145f + (-0.7265760135f); q = q * t + 0.7107068705f; q = q * t + (-0.142248368f); q = q * t + 0.127414796f; q = q * t;
  const float e = __builtin_amdgcn_exp2f((v * v) * (-0.72134752044f));
  const float m = v * (q * e);
  return v < 0.f ? m : v - m;
}
DI void pc_stage_scales(char* smem, const float* __restrict__ scaleU, const float* __restrict__ scaleV) {
  unsigned* sc = (unsigned*)(smem + 34816);
  const int tid = fresh_tid();
#pragma unroll 4
  for (int i = tid; i < NEXP; i += 512) sc[i] = f2bf(scaleU[i]) | (f2bf(scaleV[i]) << 16);
  __syncthreads();
}
DI void ph_peer_c8(int unit, char* smem, const bf16_t* __restrict__ PP, const unsigned short* __restrict__ EIDX, const float* __restrict__ GATE,
                   const float* __restrict__ SSQ, unsigned* __restrict__ STREAM) {
  unsigned (*tile)[132] = (unsigned (*)[132])smem;
  const unsigned* sc = (const unsigned*)(smem + 34816);
  const int tid = fresh_tid();
  const int tl = tid >> 3, kc = tid & 7;
  const size_t rowoff = ((size_t)unit * 64 + tl) * 128 + kc * 16;
  const size_t n = (size_t)TREAL * 128;
  const int tok = unit * 64 + tl;
  const float r2 = rsqrtf(((SSQ[tok] + SSQ[TREAL + tok]) + (SSQ[2 * TREAL + tok] + SSQ[3 * TREAL + tok])) * (1.0f / D) + EPS);
  float a[16];
#pragma unroll
  for (int j = 0; j < 16; ++j) a[j] = 0.f;
#pragma unroll
  for (int s = 0; s < 8; ++s) {
    const u32x4 p0 = *(const u32x4*)(PP + (size_t)s * n + rowoff), p1 = *(const u32x4*)(PP + (size_t)s * n + rowoff + 8);
    a[0] += bflo(p0.x); a[1] += bfhi(p0.x); a[2] += bflo(p0.y); a[3] += bfhi(p0.y); a[4] += bflo(p0.z); a[5] += bfhi(p0.z); a[6] += bflo(p0.w); a[7] += bfhi(p0.w);
    a[8] += bflo(p1.x); a[9] += bfhi(p1.x); a[10] += bflo(p1.y); a[11] += bfhi(p1.y); a[12] += bflo(p1.z); a[13] += bfhi(p1.z); a[14] += bflo(p1.w); a[15] += bfhi(p1.w);
  }
  const u32x4 e0 = *(const u32x4*)(EIDX + rowoff), e1 = *(const u32x4*)(EIDX + rowoff + 8);
  unsigned ev[16] = {e0.x & 0xffffu, e0.x >> 16, e0.y & 0xffffu, e0.y >> 16, e0.z & 0xffffu, e0.z >> 16, e0.w & 0xffffu, e0.w >> 16,
                     e1.x & 0xffffu, e1.x >> 16, e1.y & 0xffffu, e1.y >> 16, e1.z & 0xffffu, e1.z >> 16, e1.w & 0xffffu, e1.w >> 16};
  float gt[16];
#pragma unroll
  for (int j = 0; j < 4; ++j) { const f32x4 g4 = *(const f32x4*)(GATE + rowoff + 4 * j); gt[4 * j] = g4.x; gt[4 * j + 1] = g4.y; gt[4 * j + 2] = g4.z; gt[4 * j + 3] = g4.w; }
#pragma unroll
  for (int j = 0; j < 16; ++j) {
    const unsigned e = ev[j];
    const unsigned sw = sc[e];
    const float av = a[j] * (r2 * bflo(sw));
    const float act = gelu_as(av);
    const float c = gt[j] * act * bfhi(sw);
    tile[tl][kc * 16 + j] = e | (f2bf(c) << 16);
  }
  __syncthreads();
  unsigned* outp = STREAM + (size_t)unit * 8192;
#pragma unroll 4
  for (int j = 0; j < 16; ++j) {
    const int o = tid + 512 * j, q = o >> 8, t2 = (o >> 2) & 63, z = o & 3;
    outp[o] = tile[t2][4 * q + z];
  }
  __syncthreads();
}
struct PVW { u32x4 a, b; };
struct PVT { u32x2 v[8]; };
DI void pv_loadw(PVW& W, const unsigned* __restrict__ STREAM, int it, int g, int lane) {
  const u32x4* sp = (const u32x4*)(STREAM + (size_t)it * 8192) + lane;
  W.a = sp[(2 * g) * 64]; W.b = sp[(2 * g + 1) * 64];
}
DI void pv_readt(PVT& T, const PVW& W, const u32x2* tabl) {
  T.v[0] = tabl[W.a.x & 0xffffu]; T.v[1] = tabl[W.a.y & 0xffffu]; T.v[2] = tabl[W.a.z & 0xffffu]; T.v[3] = tabl[W.a.w & 0xffffu];
  T.v[4] = tabl[W.b.x & 0xffffu]; T.v[5] = tabl[W.b.y & 0xffffu]; T.v[6] = tabl[W.b.z & 0xffffu]; T.v[7] = tabl[W.b.w & 0xffffu];
}
DI void pv_fma1(unsigned w, const u32x2 v, f32x2 (&y)[4]) {
  const float c = bfhi(w);
  const f32x2 cc = {c, c};
  y[0] = __builtin_elementwise_fma(__builtin_amdgcn_cvt_pk_f32_fp8(v.x, false), cc, y[0]);
  y[1] = __builtin_elementwise_fma(__builtin_amdgcn_cvt_pk_f32_fp8(v.x, true), cc, y[1]);
  y[2] = __builtin_elementwise_fma(__builtin_amdgcn_cvt_pk_f32_fp8(v.y, false), cc, y[2]);
  y[3] = __builtin_elementwise_fma(__builtin_amdgcn_cvt_pk_f32_fp8(v.y, true), cc, y[3]);
}
DI void pv_fma(const PVW& W, const PVT& T, f32x2 (&y)[4]) {
  pv_fma1(W.a.x, T.v[0], y); pv_fma1(W.a.y, T.v[1], y); pv_fma1(W.a.z, T.v[2], y); pv_fma1(W.a.w, T.v[3], y);
  pv_fma1(W.b.x, T.v[4], y); pv_fma1(W.b.y, T.v[5], y); pv_fma1(W.b.z, T.v[6], y); pv_fma1(W.b.w, T.v[7], y);
}
DI void pv_load_table(char* smem, const u8_t* __restrict__ EV8c, int cg) {
  const int tid = fresh_tid();
  const u32x4* src = (const u32x4*)(EV8c + (size_t)cg * NEXP * 8);
#pragma unroll 4
  for (int i = tid; i < NEXP * 8 / 16; i += 512) ((u32x4*)smem)[i] = src[i];
  __syncthreads();
}
DI void pv_process(const char* smem, const unsigned* __restrict__ STREAM, bf16_t* __restrict__ YT, int cg, int it0, int it_end, int step) {
  const int lane = fresh_tid() & 63;
  const u32x2* tabl = (const u32x2*)smem;
  int it = it0;
  if (it >= it_end) return;
  PVW W0, W1, W2, W3; PVT T0, T1;
  pv_loadw(W0, STREAM, it, 0, lane); pv_loadw(W1, STREAM, it, 1, lane);
  pv_readt(T0, W0, tabl);
  for (; it < it_end; it += step) {
    const int itn = (it + step < it_end) ? it + step : it;
    f32x2 y[4];
#pragma unroll
    for (int z = 0; z < 4; ++z) y[z] = (f32x2){0.f, 0.f};
#define PV_STEP(g, Wld, Wrd, Trd, Wc, Tc) \
    pv_loadw(Wld, STREAM, ((g) + 2 < 16) ? it : itn, ((g) + 2) & 15, lane); \
    pv_readt(Trd, Wrd, tabl); \
    pv_fma(Wc, Tc, y); \
    asm volatile("" ::: "memory");
    PV_STEP(0, W2, W1, T1, W0, T0)  PV_STEP(1, W3, W2, T0, W1, T1)  PV_STEP(2, W0, W3, T1, W2, T0)  PV_STEP(3, W1, W0, T0, W3, T1)
    PV_STEP(4, W2, W1, T1, W0, T0)  PV_STEP(5, W3, W2, T0, W1, T1)  PV_STEP(6, W0, W3, T1, W2, T0)  PV_STEP(7, W1, W0, T0, W3, T1)
    PV_STEP(8, W2, W1, T1, W0, T0)  PV_STEP(9, W3, W2, T0, W1, T1)  PV_STEP(10, W0, W3, T1, W2, T0) PV_STEP(11, W1, W0, T0, W3, T1)
    PV_STEP(12, W2, W1, T1, W0, T0) PV_STEP(13, W3, W2, T0, W1, T1) PV_STEP(14, W0, W3, T1, W2, T0) PV_STEP(15, W1, W0, T0, W3, T1)
#undef PV_STEP
    const int t = it * 64 + lane;
    u32x4 yw; yw.x = pk2(y[0].x, y[0].y); yw.y = pk2(y[1].x, y[1].y); yw.z = pk2(y[2].x, y[2].y); yw.w = pk2(y[3].x, y[3].y);
    *(u32x4*)(YT + ((size_t)cg * TREAL + t) * 8) = yw;
  }
}
DI void ph_peer_v8(char* smem, const unsigned* __restrict__ STREAM, const u8_t* __restrict__ EV8c, bf16_t* __restrict__ YT, int itb, int nit) {
  const int wave = __builtin_amdgcn_readfirstlane((int)(threadIdx.x >> 6));
  for (int unit = blockIdx.x; unit < 256; unit += gridDim.x) {
    const int cg = unit & 127, th = unit >> 7;
    pv_load_table(smem, EV8c, cg);
    pv_process(smem, STREAM, YT, cg, itb + th * (nit / 2) + wave, itb + (th + 1) * (nit / 2), 8);
    __syncthreads();
  }
}


DI void ph_final_lds(int unit, char* smem, const bf16_t* __restrict__ H1, const bf16_t* __restrict__ YT, const float* __restrict__ gf, float* __restrict__ out) {
  float (*h2)[1028] = (float (*)[1028])smem;
  const int tid = fresh_tid(), lane = tid & 63, wave = tid >> 6;
  const int t0 = unit * 32;
#pragma unroll
  for (int rr = 0; rr < 4; ++rr) {
    const int r = wave * 4 + rr;
    const bf16_t* hp = H1 + (size_t)(t0 + r) * D;
#pragma unroll
    for (int j = 0; j < 2; ++j) {
      const u32x4 hw = *(const u32x4*)(hp + j * 512 + lane * 8);
      *(f32x4*)&h2[r][j * 512 + lane * 8] = (f32x4){bflo(hw.x), bfhi(hw.x), bflo(hw.y), bfhi(hw.y)};
      *(f32x4*)&h2[r][j * 512 + lane * 8 + 4] = (f32x4){bflo(hw.z), bfhi(hw.z), bflo(hw.w), bfhi(hw.w)};
    }
  }
  __syncthreads();
  {
    const int tok = lane & 31;
#pragma unroll 4
    for (int cg = wave * 2 + (lane >> 5); cg < 128; cg += 16) {
      const u32x4 yw = *(const u32x4*)(YT + ((size_t)cg * TREAL + t0 + tok) * 8);
      f32x4* hp = (f32x4*)&h2[tok][cg * 8];
      f32x4 a = hp[0], b4 = hp[1];
      a.x += bflo(yw.x); a.y += bfhi(yw.x); a.z += bflo(yw.y); a.w += bfhi(yw.y);
      b4.x += bflo(yw.z); b4.y += bfhi(yw.z); b4.z += bflo(yw.w); b4.w += bfhi(yw.w);
      hp[0] = a; hp[1] = b4;
    }
  }
  __syncthreads();
#pragma unroll
  for (int rr = 0; rr < 4; ++rr) {
    const int r = wave * 4 + rr;
    f32x4 v[4]; float ss = 0.f;
#pragma unroll
    for (int j = 0; j < 4; ++j) { v[j] = *(const f32x4*)&h2[r][j * 256 + lane * 4]; ss += v[j].x * v[j].x + v[j].y * v[j].y + v[j].z * v[j].z + v[j].w * v[j].w; }
    ss = wave_sum(ss);
    const float sc = rsqrtf(ss * (1.0f / D) + EPS);
    float* op = out + (size_t)(t0 + r) * D;
#pragma unroll
    for (int j = 0; j < 4; ++j) {
      const f32x4 gg = *(const f32x4*)(gf + j * 256 + lane * 4);
      *(f32x4*)(op + j * 256 + lane * 4) = (f32x4){v[j].x * sc * gg.x, v[j].y * sc * gg.y, v[j].z * sc * gg.z, v[j].w * sc * gg.w};
    }
  }
  __syncthreads();
}

typedef int i32x4 __attribute__((ext_vector_type(4)));
constexpr size_t WS_XQ = 861 * MiB;
constexpr size_t WS_XS = 943 * MiB;
DI unsigned pack_i8x4(float a, float b, float c, float d) {
  const int ia = __float2int_rn(a), ib = __float2int_rn(b), ic = __float2int_rn(c), id = __float2int_rn(d);
  return ((unsigned)ia & 255u) | (((unsigned)ib & 255u) << 8) | (((unsigned)ic & 255u) << 16) | ((unsigned)id << 24);
}
DI u32x4 quant_row16_i8(const float* __restrict__ rowp, const f32x4 (&g)[4], int lane, float& sc) {
  const f32x4* rp = (const f32x4*)(rowp + lane * 16);
  const f32x4 a = rp[0] * g[0], b = rp[1] * g[1], c = rp[2] * g[2], d = rp[3] * g[3];
  float m = fmaxf(fmaxf(fmaxf(fabsf(a.x), fabsf(a.y)), fmaxf(fabsf(a.z), fabsf(a.w))), fmaxf(fmaxf(fabsf(b.x), fabsf(b.y)), fmaxf(fabsf(b.z), fabsf(b.w))));
  m = fmaxf(m, fmaxf(fmaxf(fmaxf(fabsf(c.x), fabsf(c.y)), fmaxf(fabsf(c.z), fabsf(c.w))), fmaxf(fmaxf(fabsf(d.x), fabsf(d.y)), fmaxf(fabsf(d.z), fabsf(d.w)))));
  m = wave_max(m);
  sc = m > 0.f ? m * (1.0f / 127.0f) : 1.0f;
  const float inv = 1.0f / sc;
  u32x4 o;
  o.x = pack_i8x4(a.x * inv, a.y * inv, a.z * inv, a.w * inv); o.y = pack_i8x4(b.x * inv, b.y * inv, b.z * inv, b.w * inv);
  o.z = pack_i8x4(c.x * inv, c.y * inv, c.z * inv, c.w * inv); o.w = pack_i8x4(d.x * inv, d.y * inv, d.z * inv, d.w * inv);
  return o;
}
DI void ph_convert_eu_i8(const float* __restrict__ src, const float* __restrict__ gain, u8_t* __restrict__ EUq, float* __restrict__ scaleU) {
  const int tid = fresh_tid(), lane = tid & 63, wave = tid >> 6;
  f32x4 g[4];
#pragma unroll
  for (int j = 0; j < 4; ++j) g[j] = *(const f32x4*)(gain + lane * 16 + 4 * j);
  for (int e = (blockIdx.x * 8 + wave) * 2; e < NEXP; e += gridDim.x * 16) {
    float sc0, sc1 = 1.f;
    const bool two = e + 1 < NEXP;
    const u32x4 o0 = quant_row16_i8(src + (size_t)e * D, g, lane, sc0);
    u32x4 o1 = o0;
    if (two) o1 = quant_row16_i8(src + (size_t)(e + 1) * D, g, lane, sc1);
    *(u32x4*)(EUq + ((size_t)(lane >> 3) * NEXP + e) * 128 + (lane & 7) * 16) = o0;
    if (two) *(u32x4*)(EUq + ((size_t)(lane >> 3) * NEXP + e + 1) * 128 + (lane & 7) * 16) = o1;
    if (lane == 0) { scaleU[e] = sc0; if (two) scaleU[e + 1] = sc1; }
  }
}
DI int dpp_i(int v, const int sel) {
  if (sel == 0) return __builtin_amdgcn_update_dpp(0, v, 0xB1, 0xF, 0xF, true);
  if (sel == 1) return __builtin_amdgcn_update_dpp(0, v, 0x4E, 0xF, 0xF, true);
  return __builtin_amdgcn_update_dpp(0, v, 0x141, 0xF, 0xF, true);
}
DI int dpp_isum8(int v) { v += dpp_i(v, 0); v += dpp_i(v, 1); v += dpp_i(v, 2); return v; }
template <int HF> DI void peer_ud4_issue(PeerUHalf& H, unsigned idxpair, int lane, const u8_t* __restrict__ tab) {
#pragma unroll
  for (int jj = 0; jj < 8; ++jj) {
    const int j = 8 * HF + jj;
    const unsigned w = (unsigned)__shfl((int)idxpair, (lane & ~7) + (j >> 1));
    const unsigned e = (j & 1) ? (w >> 16) : (w & 0xffffu);
    H.u[jj] = *(const u32x4*)(tab + (size_t)e * 128);
  }
}
template <int HF> DI void peer_ud4_compute(const PeerUHalf& H, const u32x4 xq, int sub, int& res0, int& res1) {
#pragma unroll
  for (int jj = 0; jj < 8; ++jj) {
    const int j = 8 * HF + jj;
    int acc = 0;
    acc = __builtin_amdgcn_sdot4((int)H.u[jj].x, (int)xq.x, acc, false); acc = __builtin_amdgcn_sdot4((int)H.u[jj].y, (int)xq.y, acc, false);
    acc = __builtin_amdgcn_sdot4((int)H.u[jj].z, (int)xq.z, acc, false); acc = __builtin_amdgcn_sdot4((int)H.u[jj].w, (int)xq.w, acc, false);
    acc = dpp_isum8(acc);
    if (sub == (j >> 1)) { if (j & 1) res1 = acc; else res0 = acc; }
  }
}
DI void ph_peer_u_d4(int xi, int nx, int wv, int nwv, int tbeg, int tend, const u8_t* __restrict__ XQ, const float* __restrict__ XS, const u8_t* __restrict__ EUq,
                     const unsigned short* __restrict__ EIDX, bf16_t* __restrict__ PP) {
  const int lane = fresh_tid() & 63, sub = lane & 7;
  const int ntok = (tend - tbeg - wv + nwv - 1) / nwv;
  if (ntok <= 0) return;
#define PU_TOK(i) (tbeg + wv + ((i) < ntok ? (i) : ntok - 1) * nwv)
#define PU_IDX(t) __builtin_nontemporal_load((const unsigned*)(EIDX + (size_t)(t) * 128) + lane)
#define PU_LDX(xq_, xs_, t) { xq_ = *(const u32x4*)(xbase + (size_t)(t) * D); xs_ = XS[(size_t)(t) * 8 + s]; }
#define PU_STORE(t, r0, r1, xs_) __builtin_nontemporal_store(pk2((float)(r0) * (xs_), (float)(r1) * (xs_)), (unsigned*)(pp + (size_t)(t) * 128) + lane)
  for (int s = xi; s < 8; s += nx) {
    const u8_t* tab = EUq + (size_t)s * NEXP * 128 + sub * 16;
    const u8_t* xbase = XQ + s * 128 + sub * 16;
    bf16_t* pp = PP + (size_t)s * TREAL * 128;
    PeerUHalf HA, HB, HC;
    int ta = PU_TOK(0), tb = PU_TOK(1), tc = PU_TOK(2);
    unsigned ia = PU_IDX(ta), ib = PU_IDX(tb), ic = PU_IDX(tc);
    u32x4 xqa; float xsa; PU_LDX(xqa, xsa, ta);
    peer_ud4_issue<0>(HA, ia, lane, tab);
    peer_ud4_issue<1>(HB, ia, lane, tab);
    for (int i = 0; i < ntok; i += 3) {
      const int td = PU_TOK(i + 3), te = PU_TOK(i + 4), tf = PU_TOK(i + 5);
      u32x4 xqb, xqc, xqd; float xsb, xsc, xsd;
      int r0, r1;
      peer_ud4_issue<0>(HC, ib, lane, tab); PU_LDX(xqb, xsb, tb); const unsigned id = PU_IDX(td);
      r0 = 0; r1 = 0;
      peer_ud4_compute<0>(HA, xqa, sub, r0, r1);
      peer_ud4_issue<1>(HA, ib, lane, tab);
      peer_ud4_compute<1>(HB, xqa, sub, r0, r1);
      PU_STORE(ta, r0, r1, xsa);
      peer_ud4_issue<0>(HB, ic, lane, tab); PU_LDX(xqc, xsc, tc); const unsigned ie = PU_IDX(te);
      r0 = 0; r1 = 0;
      peer_ud4_compute<0>(HC, xqb, sub, r0, r1);
      peer_ud4_issue<1>(HC, ic, lane, tab);
      peer_ud4_compute<1>(HA, xqb, sub, r0, r1);
      PU_STORE(tb, r0, r1, xsb);
      peer_ud4_issue<0>(HA, id, lane, tab); PU_LDX(xqd, xsd, td); const unsigned if_ = PU_IDX(tf);
      r0 = 0; r1 = 0;
      peer_ud4_compute<0>(HB, xqc, sub, r0, r1);
      peer_ud4_issue<1>(HB, id, lane, tab);
      peer_ud4_compute<1>(HC, xqc, sub, r0, r1);
      PU_STORE(tc, r0, r1, xsc);
      ta = td; tb = te; tc = tf; ib = ie; ic = if_; xqa = xqd; xsa = xsd;
    }
  }
#undef PU_TOK
#undef PU_IDX
#undef PU_LDX
#undef PU_STORE
}

struct PUI { i32x4 a[8]; };
struct PUE { int e[8]; };

#define XB_TMO      128
#define XB_XCNT(j)  (256  + 64 * (j))
#define XB_XSUB(j)  (1280 + 64 * (j))
#define XB_XGEN(j)  (2304 + 64 * (j))
#define XB_TOP      3328
#define XB_TOPGEN   3392
#define XCD_BAR_WORDS 3456
#define XB_SPIN_CAP (1u << 20)
#define LAS __attribute__((address_space(3)))
DI unsigned xb_ld(unsigned* p)              { return __hip_atomic_load(p, __ATOMIC_RELAXED, __HIP_MEMORY_SCOPE_AGENT); }
DI unsigned xb_add(unsigned* p, unsigned v) { return __hip_atomic_fetch_add(p, v, __ATOMIC_RELAXED, __HIP_MEMORY_SCOPE_AGENT); }
DI unsigned xb_xcc_id() { return (unsigned)__builtin_amdgcn_s_getreg((3 << 11) | 20) & 0xFu; }
#define XB_SPIN(cond, bar) do { unsigned _sp = 0; while (cond) { __builtin_amdgcn_s_sleep(1); \
    if ((++_sp & 255u) == 0u) { if (xb_ld(&(bar)[XB_TMO])) break; if (_sp > XB_SPIN_CAP) { atomicAdd(&(bar)[XB_TMO], 1u); break; } } } } while (0)
struct XcdBarrier { unsigned* bar; unsigned x; volatile unsigned* st; };
DI XcdBarrier xcd_barrier_post(unsigned* bar, volatile unsigned* st) {
  XcdBarrier b; b.bar = bar; b.x = xb_xcc_id(); b.st = st;
  if (threadIdx.x == 0) (void)xb_add(&bar[XB_XCNT(b.x)], 1u);
  return b;
}
DI void xcd_barrier_complete(unsigned* bar, unsigned x, unsigned& nloc, unsigned& nx) {
  const unsigned G = gridDim.x;
  unsigned sum, cnt, mine, sp = 0u;
  for (;;) {
    sum = 0u; cnt = 0u; mine = 0u;
#pragma unroll
    for (unsigned j = 0; j < 16; ++j) { const unsigned c = xb_ld(&bar[XB_XCNT(j)]); sum += c; cnt += (c > 0u) ? 1u : 0u; mine = (j == x) ? c : mine; }
    if (sum == G) break;
    __builtin_amdgcn_s_sleep(1);
    if ((++sp & 255u) == 0u) { if (xb_ld(&bar[XB_TMO])) break; if (sp > XB_SPIN_CAP) { atomicAdd(&bar[XB_TMO], 1u); break; } }
  }
  nloc = mine > 0u ? mine : 1u; nx = cnt > 0u ? cnt : 1u;
}
DI void xcd_barrier(const XcdBarrier& b) {
  asm volatile("s_waitcnt vmcnt(0)" ::: "memory");
  __syncthreads();
  if (threadIdx.x == 0) {
    unsigned* bar = b.bar;
    __builtin_amdgcn_s_waitcnt(0);
    unsigned nloc = b.st[0], nx = b.st[1];
    if (nloc == 0u) { xcd_barrier_complete(bar, b.x, nloc, nx); b.st[0] = nloc; b.st[1] = nx; }
    const unsigned old = xb_add(&bar[XB_XSUB(b.x)], 1u);
    const unsigned gen = old / nloc;
    if (old + 1u == (gen + 1u) * nloc) {
      __builtin_amdgcn_fence(__ATOMIC_RELEASE, "agent");
      asm volatile("s_waitcnt vmcnt(0)" ::: "memory");
      const unsigned og = xb_add(&bar[XB_TOP], 1u);
      const unsigned tg = og / nx;
      if (og + 1u == (tg + 1u) * nx) xb_add(&bar[XB_TOPGEN], 1u);
      else XB_SPIN(xb_ld(&bar[XB_TOPGEN]) == tg, bar);
      __builtin_amdgcn_fence(__ATOMIC_ACQUIRE, "agent");
      xb_add(&bar[XB_XGEN(b.x)], 1u);
      asm volatile("s_waitcnt vmcnt(0)" ::: "memory");
    } else {
      XB_SPIN(xb_ld(&bar[XB_XGEN(b.x)]) == gen, bar);
      __builtin_amdgcn_fence(__ATOMIC_ACQUIRE, "agent");
      asm volatile("s_waitcnt vmcnt(0)" ::: "memory");
    }
  }
  __syncthreads();
}

struct Params {
  const float *x, *meta, *norm1_g, *w_in, *wg, *bg, *sb_g, *gla_g, *w_out, *norm2_g, *w_pq, *sk1, *sk2, *eu, *ev, *gf;
  float* out; char* ws;
};
constexpr int PEER_SPLIT_IT = 512;
constexpr int HALF_SMEM = 73728;
constexpr int SMEM_BYTES = 2 * HALF_SMEM;
constexpr size_t WS_BAR = 0;

__global__ void __launch_bounds__(512, 2) k_fused(Params p) {
  extern __shared__ __attribute__((aligned(16))) char smem_dyn[];
  const int half = __builtin_amdgcn_readfirstlane((int)(threadIdx.x >> 8));
  char* smem = smem_dyn + half * HALF_SMEM;
  __shared__ unsigned xb_words[4];
  if (threadIdx.x < 4) xb_words[threadIdx.x] = 0u;
  __syncthreads();
  const XcdBarrier bar = xcd_barrier_post((unsigned*)(p.ws + WS_BAR), xb_words);
  if (threadIdx.x == 0) xb_words[2] = xb_add((unsigned*)(p.ws + WS_XRANK) + bar.x, 1u);
  const int G = 2 * gridDim.x, bid = 2 * blockIdx.x + half;
  char* ws = p.ws;
  bf16_t* WinT = (bf16_t*)(ws + WS_WIN);
  bf16_t* WoutT = (bf16_t*)(ws + WS_WOUT);
  bf16_t* WpqT = (bf16_t*)(ws + WS_WPQ);
  bf16_t* EU = (bf16_t*)(ws + WS_EU);
  bf16_t* EV = (bf16_t*)(ws + WS_EV);
  bf16_t* SK1b = (bf16_t*)(ws + WS_SK1);
  bf16_t* SK2b = (bf16_t*)(ws + WS_SK2);
  bf16_t* A1 = (bf16_t*)(ws + WS_A1);
  float* GO = (float*)(ws + WS_A1);
  bf16_t* A2 = (bf16_t*)(ws + WS_A1);
  InProjOut O;
  O.QSB = (bf16_t*)(ws + WS_QSB); O.KSB = (bf16_t*)(ws + WS_KSB); O.VTSB = (bf16_t*)(ws + WS_VTSB); O.VSB = (bf16_t*)(ws + WS_VSB);
  O.GQ = (bf16_t*)(ws + WS_GQ); O.GK = (bf16_t*)(ws + WS_GK); O.GV = (bf16_t*)(ws + WS_GVT); O.GR = (bf16_t*)(ws + WS_GR);
  O.GLR = (float*)(ws + WS_GLR);
  bf16_t* H1 = (bf16_t*)(ws + WS_H1);
  float* SSQ = (float*)(ws + WS_XS + 3 * MiB);
  float* R1I = (float*)(ws + WS_XS + 4 * MiB);
  bf16_t* GVT = (bf16_t*)(ws + WS_GVT);
  GlaPtrs GP;
  GP.GQ = O.GQ; GP.GK = O.GK; GP.GVT = GVT; GP.GR = O.GR; GP.GLR = O.GLR; GP.wg = p.wg; GP.bg = p.bg; GP.gla_g = p.gla_g;
  GP.SLOC = (float*)(ws + WS_SLOC); GP.DTOT = (float*)(ws + WS_DTOT); GP.MIX = (bf16_t*)(ws + WS_MIX);
  GlaPrepPtrs GPP; GPP.GQ = O.GQ; GPP.GK = O.GK; GPP.GLR = O.GLR; GPP.wg = p.wg; GPP.bg = p.bg;
  GPP.QT = (bf16_t*)(ws + WS_GQT); GPP.KT = (bf16_t*)(ws + WS_GKT); GPP.KTT = (bf16_t*)(ws + WS_GKTT); GPP.DEC = (float*)(ws + WS_GDEC); GPP.BL = (float*)(ws + WS_GBL);
  GlaPtrs3 GP3; GP3.QT = GPP.QT; GP3.KT = GPP.KT; GP3.KTT = GPP.KTT; GP3.GVT = GVT; GP3.GR = O.GR; GP3.DEC = GPP.DEC; GP3.BL = GPP.BL; GP3.gla_g = p.gla_g;
  GP3.SLOC = GP.SLOC; GP3.DTOT = GP.DTOT; GP3.MIX = GP.MIX;
  bf16_t* MIX = (bf16_t*)(ws + WS_MIX);
  bf16_t* QP = (bf16_t*)(ws + WS_MIX);
  unsigned short* EIDX = (unsigned short*)(ws + WS_EIDX);
  bf16_t* PP = (bf16_t*)(ws + WS_PP);
  bf16_t* YT = (bf16_t*)(ws + WS_A1);
  unsigned* STREAM = (unsigned*)(ws + WS_STREAM);
  float* GATE = (float*)(ws + WS_GATE);

  for (int vb = bid; vb < 832 + 256 + 256; vb += G) {
    if (vb < 832) ph_transpose_w(vb % 104, vb / 104, smem, p.w_in, p.norm1_g, WinT, D, NIN);
    else if (vb < 1088) { const int t = vb - 832; ph_transpose_w(t % 32, t / 32, smem, p.w_out, nullptr, WoutT, D, D); }
    else { const int t = vb - 1088; ph_transpose_w(t % 32, t / 32, smem, p.w_pq, p.norm2_g, WpqT, D, D); }
  }
  ph_convert_eu_i8(p.eu, p.norm2_g, (u8_t*)EU, (float*)(ws + WS_SCU));
  for (int vb = bid; vb < NEXP / 32; vb += G) ph_convert_ev8(vb, smem, p.ev, (u8_t*)EV, (float*)(ws + WS_SCV));
  ph_convert(p.sk1, SK1b, (size_t)8 * 128 * 64 / 8);
  ph_convert(p.sk2, SK2b, (size_t)8 * 128 * 64 / 8);
  ph_zero_pads(O.KSB, O.VTSB, O.GQ, O.GK, GVT);
  for (int vb = bid; vb < TREAL / 16; vb += G) ph_norm_rows<0>(vb, p.x, R1I, A1);
  __syncthreads();
  for (int mb = blockIdx.x; mb < NIN / 16; mb += gridDim.x) ph_meta(mb, smem_dyn, p.meta, p.norm1_g, p.w_in, O);
  xcd_barrier(bar);
  {
    pg8::Gemm g{A1, WinT, TREAL, 3072, D}; pg8::StaticOrder S; S.init(TREAL, 3072, (int)gridDim.x, (int)blockIdx.x);
    EpiInProj E{O, GVT, smem_dyn + 131072};
    pg8::gemm_phase<EpiInProj, pg8::StaticOrder, true, true>((PG8_LAS unsigned char*)smem_dyn, g, S, E);
  }
  for (int panel = blockIdx.x; panel < TREAL / 256; panel += gridDim.x) ph_glr(panel, A1, WinT, O.GLR);
  xcd_barrier(bar);
  for (int it = blockIdx.x; it < 16 * 129; it += gridDim.x) ph_gla_prep(it, smem_dyn, GPP);
  xcd_barrier(bar);
  for (int it = blockIdx.x; it < 16 * 15; it += gridDim.x) gla_item4<0>(it / 15, it % 15, smem_dyn, GP3);
  for (int vb = bid; vb < 64 * 32; vb += G) ph_sb_attn2(vb, O.QSB, O.KSB, O.VTSB, p.sb_g, MIX);
  xcd_barrier(bar);
  for (int it = blockIdx.x; it < 16 * 16; it += gridDim.x) gla_item4<1>(it >> 4, it & 15, smem_dyn, GP3);
  xcd_barrier(bar);
  {
    pg8::Gemm g{MIX, WoutT, TREAL, D, D}; pg8::StaticOrder S; S.init(TREAL, D, (int)gridDim.x, (int)blockIdx.x);
    EpiOut E{A1, R1I, H1, (u8_t*)(ws + WS_XQ), (float*)(ws + WS_XS), SSQ, (float*)(smem_dyn + 131072)};
    pg8::gemm_phase<EpiOut, pg8::StaticOrder, true, true>((PG8_LAS unsigned char*)smem_dyn, g, S, E);
  }
  xcd_barrier(bar);
  {
    pg8::Gemm g{H1, WpqT, TREAL, D, D}; pg8::StaticOrder S; S.init(TREAL, D, (int)gridDim.x, (int)blockIdx.x);
    EpiPQ E{QP, SSQ};
    pg8::gemm_phase<EpiPQ, pg8::StaticOrder, true, true>((PG8_LAS unsigned char*)smem_dyn, g, S, E);
  }
  xcd_barrier(bar);
  {
    const int NV = 8 * (TREAL / 128);
    route_stage_keys(bid & 7, smem, SK1b, SK2b);
    const int rlane = (int)(threadIdx.x & 63u), rwave = (int)((threadIdx.x >> 6) & 3u);
    bf16x8 qa[2][4], qb[2][4];
    if (bid < NV) route_load_q(qa, QP, (bid >> 3) * 128 + rwave * 32 + (rlane & 31), bid & 7, rlane >> 5);
    for (int vb = bid; vb < NV; vb += 2 * G) {
      const int v1 = vb + G, v2 = vb + 2 * G;
      if (v1 < NV) route_load_q(qb, QP, (v1 >> 3) * 128 + rwave * 32 + (rlane & 31), v1 & 7, rlane >> 5);
      ph_route_v2(vb, smem, qa, EIDX, GATE);
      if (v1 < NV) {
        if (v2 < NV) route_load_q(qa, QP, (v2 >> 3) * 128 + rwave * 32 + (rlane & 31), v2 & 7, rlane >> 5);
        ph_route_v2(v1, smem, qb, EIDX, GATE);
      }
    }
  }
  xcd_barrier(bar);
  {
    __shared__ int xinfo[4];
    if (threadIdx.x == 0) {
      unsigned* barw = (unsigned*)(p.ws + WS_BAR);
      unsigned cnt = 0, ord = 0, mine = 1;
      for (unsigned j = 0; j < 16; ++j) { const unsigned c = xb_ld(&barw[XB_XCNT(j)]); if (c > 0) { if (j < bar.x) ++ord; ++cnt; } if (j == bar.x) mine = c; }
      xinfo[0] = (int)ord; xinfo[1] = (int)cnt; xinfo[2] = (int)xb_words[2]; xinfo[3] = (int)mine;
    }
    __syncthreads();
    const int xi = xinfo[0], nx = xinfo[1], rank = xinfo[2], nloc = xinfo[3];
    const int wave = __builtin_amdgcn_readfirstlane((int)(threadIdx.x >> 6));
    const u8_t* XQp = (const u8_t*)(ws + WS_XQ); const float* XSp = (const float*)(ws + WS_XS);
    constexpr int ITA = PEER_SPLIT_IT, TSPLIT = ITA * 64;
    ph_peer_u_d4(xi, nx, rank * 8 + wave, nloc * 8, 0, TSPLIT, XQp, XSp, (const u8_t*)EU, EIDX, PP);
    xcd_barrier(bar);
    pc_stage_scales(smem_dyn, (const float*)(ws + WS_SCU), (const float*)(ws + WS_SCV));
    for (int unit = blockIdx.x; unit < ITA; unit += gridDim.x) ph_peer_c8(unit, smem_dyn, PP, EIDX, GATE, SSQ, STREAM);
    xcd_barrier(bar);
    if (gridDim.x >= 256) {
      const int cg = blockIdx.x & 127, th = (blockIdx.x >> 7) & 1;
      if (blockIdx.x < 256) pv_load_table(smem_dyn, (const u8_t*)EV, cg); else __syncthreads();
      if (wave < 4) { if (blockIdx.x < 256) pv_process(smem_dyn, STREAM, YT, cg, th * (ITA / 2) + wave, (th + 1) * (ITA / 2), 4); }
      else ph_peer_u_d4(xi, nx, rank * 4 + wave - 4, nloc * 4, TSPLIT, TREAL, XQp, XSp, (const u8_t*)EU, EIDX, PP);
    } else {
      ph_peer_u_d4(xi, nx, rank * 8 + wave, nloc * 8, TSPLIT, TREAL, XQp, XSp, (const u8_t*)EU, EIDX, PP);
      ph_peer_v8(smem_dyn, STREAM, (const u8_t*)EV, YT, 0, ITA);
    }
    xcd_barrier(bar);
    pc_stage_scales(smem_dyn, (const float*)(ws + WS_SCU), (const float*)(ws + WS_SCV));
    for (int unit = ITA + blockIdx.x; unit < TREAL / 64; unit += gridDim.x) ph_peer_c8(unit, smem_dyn, PP, EIDX, GATE, SSQ, STREAM);
    xcd_barrier(bar);
    ph_peer_v8(smem_dyn, STREAM, (const u8_t*)EV, YT, ITA, TREAL / 64 - ITA);
  }
  xcd_barrier(bar);
  for (int unit = blockIdx.x; unit < TREAL / 32; unit += gridDim.x) ph_final_lds(unit, smem_dyn, H1, YT, p.gf, p.out);
}

extern "C" void kernel_launch(void* const* d_in, const int* in_sizes, int n_in, void* d_out, int out_size, void* d_ws, size_t ws_size, hipStream_t stream) {
  static int grid = 0;
  if (grid == 0) {
    int dev = 0, cus = 0, per_cu = 0;
    hipGetDevice(&dev);
    hipDeviceGetAttribute(&cus, hipDeviceAttributeMultiprocessorCount, dev);
    hipFuncSetAttribute((const void*)k_fused, hipFuncAttributeMaxDynamicSharedMemorySize, SMEM_BYTES);
    hipOccupancyMaxActiveBlocksPerMultiprocessor(&per_cu, (const void*)k_fused, 512, SMEM_BYTES);
    if (per_cu > 1) per_cu = 1;
    if (per_cu < 1) per_cu = 1;
    grid = cus * per_cu;
  }
  hipMemsetAsync((char*)d_ws + WS_BAR, 0, 32768, stream);
  Params p{};
  p.x = (const float*)d_in[0]; p.meta = (const float*)d_in[1]; p.norm1_g = (const float*)d_in[2]; p.w_in = (const float*)d_in[3];
  p.wg = (const float*)d_in[4]; p.bg = (const float*)d_in[5]; p.sb_g = (const float*)d_in[6]; p.gla_g = (const float*)d_in[7];
  p.w_out = (const float*)d_in[8]; p.norm2_g = (const float*)d_in[9]; p.w_pq = (const float*)d_in[10]; p.sk1 = (const float*)d_in[11];
  p.sk2 = (const float*)d_in[12]; p.eu = (const float*)d_in[13]; p.ev = (const float*)d_in[14]; p.gf = (const float*)d_in[15];
  p.out = (float*)d_out; p.ws = (char*)d_ws;
  void* args[] = {&p};
  hipLaunchCooperativeKernel((const void*)k_fused, dim3(grid), dim3(512), args, SMEM_BYTES, stream);
}
```

```cpp
#include <hip/hip_runtime.h>
#include <stdint.h>
#include <stddef.h>

typedef unsigned short bf16_t;
typedef short bf16x8 __attribute__((ext_vector_type(8)));
typedef float f32x16 __attribute__((ext_vector_type(16)));
typedef float f32x4 __attribute__((ext_vector_type(4)));
typedef float f32x2 __attribute__((ext_vector_type(2)));
typedef unsigned u32x4 __attribute__((ext_vector_type(4)));
typedef unsigned u32x2 __attribute__((ext_vector_type(2)));
typedef __bf16 bf16x2_t __attribute__((ext_vector_type(2)));

#define DI __device__ __forceinline__
__device__ __forceinline__ int fresh_tid() { int t = (int)threadIdx.x; asm volatile("" : "+v"(t)); return t; }
#define TID tid256_
#define MFMA32(a, b, c) __builtin_amdgcn_mfma_f32_32x32x16_bf16((a), (b), (c), 0, 0, 0)

constexpr int D = 1024, NB = 8, SEQ = 8192, NMETA = 16;
constexpr int TREAL = NB * SEQ;
constexpr int MROWS = TREAL + 128;
constexpr int NIN = 3088, NINP = 3328;
constexpr int SBH = 8, SBD = 64;
constexpr int GH = 4, GDK = 64, GDV = 128;
constexpr int KIDX = SEQ + 32;
constexpr int GU = SEQ + 64;
constexpr int NEXP = 16384;
constexpr float EPS = 1e-6f;

constexpr size_t MiB = 1u << 20;
constexpr size_t WS_WIN = 1 * MiB;
constexpr size_t WS_WOUT = 8 * MiB;
constexpr size_t WS_WPQ = 10 * MiB;
constexpr size_t WS_SK1 = 12 * MiB;
constexpr size_t WS_SK2 = 13 * MiB;
constexpr size_t WS_EU = 16 * MiB;
constexpr size_t WS_EV = 48 * MiB;
constexpr size_t WS_A1 = 80 * MiB;
constexpr size_t WS_QSB = 210 * MiB;
constexpr size_t WS_KSB = 274 * MiB;
constexpr size_t WS_VTSB = 339 * MiB;
constexpr size_t WS_GQ = 404 * MiB;
constexpr size_t WS_GK = 437 * MiB;
constexpr size_t WS_H1 = 210 * MiB;
constexpr size_t WS_GV = 470 * MiB;
constexpr size_t WS_GR = 535 * MiB;
constexpr size_t WS_GLR = 599 * MiB;
constexpr size_t WS_LG = 604 * MiB;
constexpr size_t WS_MIX = 669 * MiB;
constexpr size_t WS_EIDX = 797 * MiB;
constexpr size_t WS_GATE = 829 * MiB;
constexpr size_t WS_PP = 470 * MiB;
constexpr size_t WS_STREAM = 726 * MiB;
constexpr size_t WS_XRANK = 16384;
constexpr size_t WS_VSB = 861 * MiB;
constexpr size_t WS_END = 926 * MiB;

DI unsigned f2bf(float f) { unsigned u = __float_as_uint(f); return (u + 0x7fffu + ((u >> 16) & 1u)) >> 16; }
DI float bf2f(unsigned b) { return __uint_as_float(b << 16); }
DI unsigned pk2(float lo, float hi) { f32x2 v = {lo, hi}; return __builtin_bit_cast(unsigned, __builtin_convertvector(v, bf16x2_t)); }
DI float bflo(unsigned u) { return __uint_as_float(u << 16); }
DI float bfhi(unsigned u) { return __uint_as_float(u & 0xffff0000u); }
DI int crow(int reg, int h) { return (reg & 3) + 8 * (reg >> 2) + 4 * h; }
DI float wave_sum(float v) {
#pragma unroll
  for (int o = 32; o >= 1; o >>= 1) v += __shfl_xor(v, o);
  return v;
}
DI float softplus(float z) { return fmaxf(z, 0.f) + __logf(1.f + __expf(-fabsf(z))); }

DI void ph_transpose_w(int bx, int by, char* smem, const float* __restrict__ W, const float* __restrict__ gain, bf16_t* __restrict__ WT, int K, int N) {
  const int tid256_ = fresh_tid() & 255;
  float (*t)[33] = (float (*)[33])smem;
  const int n0 = bx * 32, k0 = by * 128;
  {
    const int kr = TID >> 3, c4 = (TID & 7) * 4;
    f32x4 v[4];
#pragma unroll
    for (int j = 0; j < 4; ++j) v[j] = (n0 + c4 < N) ? *(const f32x4*)(W + (size_t)(k0 + kr + 32 * j) * N + n0 + c4) : (f32x4){0.f, 0.f, 0.f, 0.f};
#pragma unroll
    for (int j = 0; j < 4; ++j) {
      const float g = gain ? gain[k0 + kr + 32 * j] : 1.f;
      t[kr + 32 * j][c4 + 0] = v[j].x * g; t[kr + 32 * j][c4 + 1] = v[j].y * g; t[kr + 32 * j][c4 + 2] = v[j].z * g; t[kr + 32 * j][c4 + 3] = v[j].w * g;
    }
  }
  __syncthreads();
  {
    const int n = TID >> 3, ks = (TID & 7) * 16;
    unsigned w[8];
#pragma unroll
    for (int i = 0; i < 8; ++i) w[i] = pk2(t[ks + 2 * i][n], t[ks + 2 * i + 1][n]);
    bf16_t* dst = WT + (size_t)(n0 + n) * K + k0 + ks;
    *(u32x4*)dst = (u32x4){w[0], w[1], w[2], w[3]};
    *(u32x4*)(dst + 8) = (u32x4){w[4], w[5], w[6], w[7]};
  }
  __syncthreads();
}
DI void ph_convert(const float* __restrict__ src, bf16_t* __restrict__ dst, size_t n8) {
  size_t i = (size_t)blockIdx.x * blockDim.x + threadIdx.x;
  const size_t stride = (size_t)gridDim.x * blockDim.x;
  for (; i < n8; i += stride) {
    const f32x4 a = ((const f32x4*)src)[2 * i], b = ((const f32x4*)src)[2 * i + 1];
    u32x4 o; o.x = pk2(a.x, a.y); o.y = pk2(a.z, a.w); o.z = pk2(b.x, b.y); o.w = pk2(b.z, b.w);
    ((u32x4*)dst)[i] = o;
  }
}
DI void ph_zero_pads(bf16_t* KSB, bf16_t* VTSB, bf16_t* GQ, bf16_t* GK, bf16_t* GVT) {
  const int tid = blockIdx.x * blockDim.x + threadIdx.x, nth = gridDim.x * blockDim.x;
  for (int i = tid; i < 64 * 16 * 64; i += nth) { const int bh = i / 1024, r = i % 1024; KSB[(size_t)bh * KIDX * 64 + r] = 0; }
  for (int i = tid; i < 64 * 64 * 16; i += nth) { const int row = i / 16, c = i % 16; VTSB[(size_t)row * KIDX + c] = 0; }
  for (int i = tid; i < 32 * 48 * 64; i += nth) { const int bh = i / 3072, r = i % 3072; GQ[(size_t)bh * GU * 64 + r] = 0; GK[(size_t)bh * GU * 64 + r] = 0; }
  for (int i = tid; i < 32 * 128 * 48; i += nth) { const int row = i / 48, c = i % 48; GVT[(size_t)row * GU + c] = 0; }
}

template <int MODE>
DI void ph_norm_rows(int vb, const float* __restrict__ src, const float* __restrict__ meta, bf16_t* __restrict__ dst) {
  const int tid256_ = fresh_tid() & 255;
  const int row0 = vb * 16 + (TID >> 6) * 4, lane = TID & 63;
  f32x4 v[4][4];
#pragma unroll
  for (int rr = 0; rr < 4; ++rr)
#pragma unroll
    for (int j = 0; j < 4; ++j) v[rr][j] = (MODE == 0) ? __builtin_nontemporal_load((const f32x4*)(src + (size_t)(row0 + rr) * D + j * 256 + lane * 4)) : *(const f32x4*)(src + (size_t)(row0 + rr) * D + j * 256 + lane * 4);
  f32x4 gg[4];
#pragma unroll
  for (int j = 0; j < 4; ++j) { gg[j] = (f32x4){1.f, 1.f, 1.f, 1.f}; if (MODE == 1) gg[j] = *(const f32x4*)(meta + j * 256 + lane * 4); }
#pragma unroll
  for (int rr = 0; rr < 4; ++rr) {
    float ss = 0.f;
#pragma unroll
    for (int j = 0; j < 4; ++j) ss += v[rr][j].x * v[rr][j].x + v[rr][j].y * v[rr][j].y + v[rr][j].z * v[rr][j].z + v[rr][j].w * v[rr][j].w;
    ss = wave_sum(ss);
    const float r = rsqrtf(ss * (1.0f / D) + EPS);
    if (MODE == 0 && lane == 0) const_cast<float*>(meta)[row0 + rr] = sqrtf(ss * (1.0f / D) + EPS);
#pragma unroll
    for (int j = 0; j < 4; ++j) {
      u32x2 o; o.x = pk2(v[rr][j].x * r * gg[j].x, v[rr][j].y * r * gg[j].y); o.y = pk2(v[rr][j].z * r * gg[j].z, v[rr][j].w * r * gg[j].w);
      *(u32x2*)(dst + (size_t)(row0 + rr) * D + j * 256 + lane * 4) = o;
    }
  }
}

namespace pg8 {
#define PG8_LAS __attribute__((address_space(3)))
typedef unsigned short bf16_t;
typedef short bf16x8 __attribute__((ext_vector_type(8)));
typedef float f32x4 __attribute__((ext_vector_type(4)));
typedef unsigned u32x4 __attribute__((ext_vector_type(4)));
constexpr int BM = 256, BK = 64, HALF = 128, HTB = HALF * BK * 2  , STAGE_BYTES = 8 * HTB, NXCD = 8, WGM = 8;

__host__ __device__ __forceinline__ int lds_byte(int r, int c) { const int st = (r >> 4) * 2 + (c >> 5), rr = r & 15, cc = c & 31, ob = rr * 64 + cc * 2; return st * 1024 + (ob ^ (((ob >> 9) & 1) << 5)); }
__host__ __device__ __forceinline__ void stage_rc(int b, int& R, int& C) { const int st = b / 1024, sb = b % 1024, swz = sb ^ (((sb >> 9) & 1) << 5); R = (st >> 1) * 16 + swz / 64; C = (st & 1) * 32 + (swz % 64) / 2; }
__host__ __device__ __forceinline__ int perm32(int rho) { const int n = rho >> 4, i = rho & 15; return 8 * (i >> 2) + 4 * n + (i & 3); }

struct Unit { int pm, pn; };
struct Gemm { const bf16_t* A; const bf16_t* Bt; int M, N, K; };

struct StaticOrder {
    int nM, nN, nwg, G, c;
    __host__ __device__ void init(int M, int N, int G_, int c_) { nM = M / BM; nN = N / BM; nwg = nM * nN; G = G_; c = c_; }
    __host__ __device__ bool next(int i, Unit& u) const {
        const long L = (long)i * G + c; if (L >= nwg) return false;
        int wgid = (int)L; { const int q = nwg / NXCD, r = nwg % NXCD, xcd = wgid % NXCD, off = wgid / NXCD; wgid = (xcd < r ? xcd * (q + 1) : r * (q + 1) + (xcd - r) * q) + off; }
        const int nig = WGM * nN, gid = wgid / nig, fm = gid * WGM, gsz = (nM - fm) < WGM ? (nM - fm) : WGM;
        u.pm = fm + ((wgid % nig) % gsz); u.pn = (wgid % nig) / gsz; return true;
    }
    __device__ __forceinline__ void a_ready(const Unit&) const {}
    __device__ __forceinline__ void done(const Unit&) const {}
};

template <class Epi, class Sched, bool ALIGN_EPI = false, bool SP2 = false>
__device__ __forceinline__ void gemm_phase(PG8_LAS unsigned char* lds, const Gemm g, const Sched& S, const Epi& E) {
    const int tid = fresh_tid(), wid = __builtin_amdgcn_readfirstlane(tid >> 6), lane = tid & 63, wr = wid >> 2, wc = wid & 3, fr = lane & 15, fq = lane >> 4;
    const int K = g.K, nt = K / BK;
    unsigned voffA[2], voffB[2];
#pragma unroll
    for (int i = 0; i < 2; ++i) { int R, C; stage_rc(tid * 16 + i * 8192, R, C); const int Rb = Epi::PERM ? ((R & ~31) + perm32(R & 31)) : R;
        voffA[i] = (unsigned)(R * K + C) * 2u; voffB[i] = (unsigned)(Rb * K + C) * 2u; }
    const size_t kstep = (size_t)(BK * 2);
    const size_t hstep = (size_t)HALF * K * 2;
    const size_t tstep = 2 * hstep;
    const unsigned ldsw = (unsigned)wid * 1024u;
    const int aoff = lds_byte(wr * 64 + fr, fq * 8), boff = lds_byte(wc * 32 + fr, fq * 8);
#define PG8_SA(b, h) (((b) * 2 + (h)) * HTB)
#define PG8_SB(b, h) ((4 + (b) * 2 + (h)) * HTB)
#define PG8_STAGE(bufoff, gbase, voff) do { _Pragma("unroll") for (int _i = 0; _i < 2; ++_i) \
        __builtin_amdgcn_global_load_lds((const unsigned*)((const char*)(gbase) + (voff)[_i]), (PG8_LAS unsigned*)(lds + (bufoff) + ldsw + _i * 8192), 16, 0, 0); } while (0)
#define PG8_LDA(dst, b, h) do { _Pragma("unroll") for (int m = 0; m < 4; ++m) _Pragma("unroll") for (int k = 0; k < 2; ++k) dst[m][k] = *(const PG8_LAS bf16x8*)(lds + PG8_SA(b, h) + aoff + m * 2048 + k * 1024); } while (0)
#define PG8_LDB(dst, b, h) do { _Pragma("unroll") for (int n = 0; n < 2; ++n) _Pragma("unroll") for (int k = 0; k < 2; ++k) dst[n][k] = *(const PG8_LAS bf16x8*)(lds + PG8_SB(b, h) + boff + n * 2048 + k * 1024); } while (0)
#define PG8_MMA(ai, bj, At, Bt) do { __builtin_amdgcn_s_setprio(1); _Pragma("unroll") for (int m = 0; m < 4; ++m) _Pragma("unroll") for (int n = 0; n < 2; ++n) _Pragma("unroll") for (int k = 0; k < 2; ++k) \
        acc[ai][bj][m][n] = __builtin_amdgcn_mfma_f32_16x16x32_bf16(Bt[n][k], At[m][k], acc[ai][bj][m][n], 0, 0, 0); __builtin_amdgcn_s_setprio(0); } while (0)
#define PG8_WAIT_V(n) asm volatile("s_waitcnt vmcnt(" #n ")" ::: "memory")
#define PG8_WAIT_L(n) asm volatile("s_waitcnt lgkmcnt(" #n ")" ::: "memory")
#define PG8_BAR __builtin_amdgcn_s_barrier()
#define PG8_SCHED __builtin_amdgcn_sched_barrier(0)
    Unit cur, nxt; int ui = 0;
    if (!S.next(0, cur)) return;
    f32x4 acc[2][2][4][2];
#pragma unroll
    for (int a = 0; a < 2; ++a)
#pragma unroll
        for (int b = 0; b < 2; ++b)
#pragma unroll
            for (int m = 0; m < 4; ++m)
#pragma unroll
                for (int n = 0; n < 2; ++n) acc[a][b][m][n] = (f32x4){0.f, 0.f, 0.f, 0.f};
    bf16x8 At[4][2], B0[2][2], B1[2][2];
    const char* cA = (const char*)g.A + (size_t)cur.pm * tstep; const char* cB = (const char*)g.Bt + (size_t)cur.pn * tstep;
    S.a_ready(cur);
    if constexpr (SP2) {
        PG8_STAGE(PG8_SB(0, 0), cB, voffB); PG8_STAGE(PG8_SB(0, 1), cB + hstep, voffB); PG8_STAGE(PG8_SA(0, 0), cA, voffA); PG8_STAGE(PG8_SA(0, 1), cA + hstep, voffA);
        if (wr == 1) PG8_BAR;
        PG8_WAIT_V(2); PG8_BAR;
        PG8_STAGE(PG8_SB(1, 0), cB + kstep, voffB); PG8_STAGE(PG8_SA(1, 0), cA + kstep, voffA); PG8_STAGE(PG8_SB(1, 1), cB + hstep + kstep, voffB);
        PG8_WAIT_V(6); PG8_BAR;
    } else {
        PG8_STAGE(PG8_SB(0, 0), cB, voffB); PG8_STAGE(PG8_SA(0, 0), cA, voffA); PG8_STAGE(PG8_SB(0, 1), cB + hstep, voffB); PG8_STAGE(PG8_SA(0, 1), cA + hstep, voffA);
        if (wr == 1) PG8_BAR;
        PG8_WAIT_V(4); PG8_BAR;
        PG8_STAGE(PG8_SB(1, 0), cB + kstep, voffB); PG8_STAGE(PG8_SA(1, 0), cA + kstep, voffA); PG8_STAGE(PG8_SB(1, 1), cB + hstep + kstep, voffB);
        PG8_WAIT_V(6); PG8_BAR;
    }
    for (;;) {
        const bool has_next = S.next(ui + 1, nxt);
        const char* nA = has_next ? (const char*)g.A + (size_t)nxt.pm * tstep : cA; const char* nB = has_next ? (const char*)g.Bt + (size_t)nxt.pn * tstep : cB;
        for (int t = 0; t < nt; t += 2) {
            const bool last = (t == nt - 2);
            const char* a1 = cA + (size_t)(t + 1) * kstep;
            const char* a2 = last ? nA : cA + (size_t)(t + 2) * kstep; const char* b2 = last ? nB : cB + (size_t)(t + 2) * kstep;
            const char* a3 = a2 + kstep; const char* b3 = b2 + kstep;
            if (last && has_next) S.a_ready(nxt);
            if constexpr (SP2) {
            PG8_LDB(B0, 0, 0); PG8_LDB(B1, 0, 1); PG8_SCHED; PG8_LDA(At, 0, 0); PG8_STAGE(PG8_SA(1, 1), a1 + hstep, voffA);
            PG8_WAIT_V(8); PG8_WAIT_L(0); PG8_BAR; PG8_MMA(0, 0, At, B0); PG8_MMA(0, 1, At, B1); PG8_BAR; PG8_SCHED;
            PG8_LDA(At, 0, 1); PG8_STAGE(PG8_SB(0, 0), b2, voffB); PG8_STAGE(PG8_SB(0, 1), b2 + hstep, voffB); PG8_STAGE(PG8_SA(0, 0), a2, voffA);
            PG8_WAIT_V(8); PG8_WAIT_L(0); PG8_BAR; PG8_MMA(1, 0, At, B0); PG8_MMA(1, 1, At, B1); PG8_BAR; PG8_SCHED;
            PG8_LDB(B0, 1, 0); PG8_LDB(B1, 1, 1); PG8_SCHED; PG8_LDA(At, 1, 0); PG8_STAGE(PG8_SA(0, 1), a2 + hstep, voffA);
            PG8_WAIT_V(8); PG8_WAIT_L(0); PG8_BAR; PG8_MMA(0, 0, At, B0); PG8_MMA(0, 1, At, B1); PG8_BAR; PG8_SCHED;
            PG8_LDA(At, 1, 1); PG8_STAGE(PG8_SB(1, 0), b3, voffB); PG8_STAGE(PG8_SB(1, 1), b3 + hstep, voffB); PG8_STAGE(PG8_SA(1, 0), a3, voffA);
            PG8_WAIT_V(8); PG8_WAIT_L(0); PG8_BAR; PG8_MMA(1, 0, At, B0); PG8_MMA(1, 1, At, B1); PG8_BAR; PG8_SCHED;
            } else {
            PG8_LDB(B0, 0, 0); PG8_SCHED; PG8_LDA(At, 0, 0); PG8_STAGE(PG8_SA(1, 1), a1 + hstep, voffA);
            PG8_WAIT_L(8); PG8_BAR; PG8_WAIT_L(0); PG8_MMA(0, 0, At, B0); PG8_BAR; PG8_SCHED;
            PG8_LDB(B1, 0, 1); PG8_STAGE(PG8_SB(0, 0), b2, voffB);
            PG8_BAR; PG8_WAIT_L(0); PG8_MMA(0, 1, At, B1); PG8_BAR;
            PG8_LDA(At, 0, 1); PG8_STAGE(PG8_SA(0, 0), a2, voffA);
            PG8_BAR; PG8_WAIT_L(0); PG8_MMA(1, 0, At, B0); PG8_BAR; PG8_SCHED;
            PG8_STAGE(PG8_SB(0, 1), b2 + hstep, voffB);
            PG8_WAIT_V(6); PG8_BAR; PG8_MMA(1, 1, At, B1); PG8_BAR;
            PG8_LDB(B0, 1, 0); PG8_SCHED; PG8_LDA(At, 1, 0); PG8_STAGE(PG8_SA(0, 1), a2 + hstep, voffA);
            PG8_WAIT_L(8); PG8_BAR; PG8_WAIT_L(0); PG8_MMA(0, 0, At, B0); PG8_BAR; PG8_SCHED;
            PG8_LDB(B1, 1, 1); PG8_STAGE(PG8_SB(1, 0), b3, voffB);
            PG8_BAR; PG8_WAIT_L(0); PG8_MMA(0, 1, At, B1); PG8_BAR;
            PG8_LDA(At, 1, 1); PG8_STAGE(PG8_SA(1, 0), a3, voffA);
            PG8_BAR; PG8_WAIT_L(0); PG8_MMA(1, 0, At, B0); PG8_BAR; PG8_SCHED;
            PG8_STAGE(PG8_SB(1, 1), b3 + hstep, voffB);
            PG8_WAIT_V(6); PG8_BAR; PG8_MMA(1, 1, At, B1); PG8_BAR;
            }
        }
        if constexpr (ALIGN_EPI) { if (wr == 0) PG8_BAR; }
        if constexpr (!Epi::AFTER_DRAIN) { E(acc, cur, wr, wc, fr, fq); S.done(cur); }
        if (!has_next) break;
#pragma unroll
        for (int a = 0; a < 2; ++a)
#pragma unroll
            for (int b = 0; b < 2; ++b)
#pragma unroll
                for (int m = 0; m < 4; ++m)
#pragma unroll
                    for (int n = 0; n < 2; ++n) acc[a][b][m][n] = (f32x4){0.f, 0.f, 0.f, 0.f};
        cur = nxt; cA = nA; cB = nB; ++ui;
        if constexpr (ALIGN_EPI) { if (wr == 1) PG8_BAR; }
    }
    PG8_WAIT_V(0);
    if constexpr (!ALIGN_EPI) { if (wr == 0) PG8_BAR; }
    PG8_BAR;
    if constexpr (Epi::AFTER_DRAIN) { E.fused(acc, cur, wr, wc, fr, fq, lds, wid, lane); S.done(cur); }
#undef PG8_SA
#undef PG8_SB
#undef PG8_STAGE
#undef PG8_LDA
#undef PG8_LDB
#undef PG8_MMA
#undef PG8_WAIT_V
#undef PG8_WAIT_L
#undef PG8_BAR
#undef PG8_SCHED
}
}

struct InProjOut { bf16_t *QSB, *KSB, *VSB, *VTSB, *GQ, *GK, *GV, *GR; float* GLR; };

struct EpiInProj {
  static constexpr bool PERM = true, AFTER_DRAIN = false;
  InProjOut O; bf16_t* GVT; char* stage;
  DI void store_vt(const pg8::f32x4 (&acc)[2][2][4][2], const pg8::Unit& u, int wr, int wc, int fr, int fq) const {
    bf16_t* st = (bf16_t*)(stage + (wr * 4 + wc) * 1280);
    const int lane = fr + 16 * fq;
    const int rc = lane >> 2, r8 = lane & 3;
#pragma unroll
    for (int ai = 0; ai < 2; ++ai)
#pragma unroll
      for (int bj = 0; bj < 2; ++bj)
#pragma unroll
        for (int mp = 0; mp < 2; ++mp)
#pragma unroll
          for (int ch = 0; ch < 2; ++ch) {
            if ((fq >> 1) == ch) {
#pragma unroll
              for (int m2 = 0; m2 < 2; ++m2)
#pragma unroll
                for (int n = 0; n < 2; ++n) {
                  const pg8::f32x4 v = acc[ai][bj][2 * mp + m2][n];
                  const int cl = 8 * (fq & 1) + 4 * n, rl = 16 * m2 + fr;
                  st[(cl + 0) * 40 + rl] = (bf16_t)f2bf(v[0]); st[(cl + 1) * 40 + rl] = (bf16_t)f2bf(v[1]);
                  st[(cl + 2) * 40 + rl] = (bf16_t)f2bf(v[2]); st[(cl + 3) * 40 + rl] = (bf16_t)f2bf(v[3]);
                }
            }
            asm volatile("s_waitcnt lgkmcnt(0)" ::: "memory");
            const u32x4 w = *(const u32x4*)&st[rc * 40 + 8 * r8];
            asm volatile("" ::: "memory");
            const int col = u.pn * 256 + bj * 128 + wc * 32 + 16 * ch + rc;
            const int row = u.pm * 256 + ai * 128 + wr * 64 + 32 * mp + 8 * r8;
            const int b = row >> 13, i = row & 8191;
            bf16_t* dst;
            if (u.pn < 6) { const int c = col - 1024; dst = O.VTSB + ((size_t)(b * SBH + (c >> 6)) * 64 + (c & 63)) * KIDX + 32 + i; }
            else          { const int c = col - 2048; dst = GVT + ((size_t)(b * GH + (c >> 7)) * 128 + (c & 127)) * GU + 64 + i; }
            *(u32x4*)dst = w;
          }
  }
  DI void operator()(const pg8::f32x4 (&acc)[2][2][4][2], const pg8::Unit& u, int wr, int wc, int fr, int fq) const {
    const int pn = u.pn;
    if (pn == 4 || pn == 5 || pn == 8 || pn == 9) { store_vt(acc, u, wr, wc, fr, fq); return; }
#pragma unroll
    for (int ai = 0; ai < 2; ++ai)
#pragma unroll
      for (int m = 0; m < 4; ++m) {
        const int row = u.pm * 256 + ai * 128 + wr * 64 + m * 16 + fr;
        const int b = row >> 13, i = row & 8191;
#pragma unroll
        for (int bj = 0; bj < 2; ++bj) {
          const int col = pn * 256 + bj * 128 + wc * 32 + 8 * fq;
          const pg8::f32x4 v0 = acc[ai][bj][m][0], v1 = acc[ai][bj][m][1];
          if (pn < 12) {
            u32x4 w; w.x = pk2(v0[0], v0[1]); w.y = pk2(v0[2], v0[3]); w.z = pk2(v1[0], v1[1]); w.w = pk2(v1[2], v1[3]);
            bf16_t* dst;
            if (pn < 2)       { const int c = col;        dst = O.QSB + ((size_t)(b * SBH + (c >> 6)) * SEQ + i) * 64 + (c & 63); }
            else if (pn < 4)  { const int c = col - 512;  dst = O.KSB + ((size_t)(b * SBH + (c >> 6)) * KIDX + 32 + i) * 64 + (c & 63); }
            else if (pn == 6) { const int c = col - 1536; dst = O.GQ + ((size_t)(b * GH + (c >> 6)) * GU + 64 + i) * 64 + (c & 63); }
            else if (pn == 7) { const int c = col - 1792; dst = O.GK + ((size_t)(b * GH + (c >> 6)) * GU + 64 + i) * 64 + (c & 63); }
            else              { const int c = col - 2560; dst = O.GR + (size_t)row * 512 + c; }
            *(u32x4*)dst = w;
          } else if (col < NIN) {
            float* dst = O.GLR + ((size_t)b * GU + 64 + i) * 16 + (col - 3072);
            *(f32x4*)dst = (f32x4){v0[0], v0[1], v0[2], v0[3]};
            *(f32x4*)(dst + 4) = (f32x4){v1[0], v1[1], v1[2], v1[3]};
          }
        }
      }
  }
};
typedef unsigned char u8_t;
DI unsigned pack_i8x4(float a, float b, float c, float d);
struct EpiOut {
  static constexpr bool PERM = true, AFTER_DRAIN = false;
  const bf16_t* A1; const float* R1I; bf16_t* H1;
  u8_t* XQ; float* XS; float* SSQ; float* xch;
  DI void operator()(const pg8::f32x4 (&acc_)[2][2][4][2], const pg8::Unit& u, int wr, int wc, int fr, int fq) const {
    pg8::f32x4 (&acc)[2][2][4][2] = const_cast<pg8::f32x4 (&)[2][2][4][2]>(acc_);
    const int te = fresh_tid();
    float* xa = xch + ((te >> 8) * 1024 + (te & 15) * 4 + ((te >> 6) & 3));
    float* xs = xch + 2048 + ((te >> 8) * 512 + (te & 15) * 4 + ((te >> 6) & 3));
    u32x4 awb[4][2][2]; float rib[4][2];
#define EPO_LOAD(k_) { _Pragma("unroll") for (int z = 0; z < 2; ++z) { const int m_ = 2 * ((k_) & 1) + z; \
      const int row_ = u.pm * 256 + ((k_) >> 1) * 128 + wr * 64 + m_ * 16 + fr; rib[k_][z] = R1I[row_]; \
      _Pragma("unroll") for (int bj = 0; bj < 2; ++bj) awb[k_][z][bj] = *(const u32x4*)(A1 + ((unsigned)row_ * (unsigned)D + (unsigned)(u.pn * 256 + bj * 128 + wc * 32 + 8 * fq))); } }
    EPO_LOAD(0)
#pragma unroll
    for (int aim = 0; aim < 4; ++aim) {
      const int ai = aim >> 1;
      if (aim == 0) EPO_LOAD(1) else if (aim == 1) EPO_LOAD(2) else if (aim == 2) EPO_LOAD(3)
      asm volatile("" ::: "memory");
#pragma unroll
      for (int m = 2 * (aim & 1); m < 2 * (aim & 1) + 2; ++m) {
        const int row = u.pm * 256 + ai * 128 + wr * 64 + m * 16 + fr;
        const unsigned rowoff = (unsigned)row * (unsigned)D;
        const float ri = rib[aim][m & 1];
        float ss = 0.f;
#pragma unroll
        for (int bj = 0; bj < 2; ++bj) {
          const unsigned idx = rowoff + (unsigned)(u.pn * 256 + bj * 128 + wc * 32 + 8 * fq);
          const u32x4 aw = awb[aim][m & 1][bj];
          const pg8::f32x4 v0 = acc[ai][bj][m][0], v1 = acc[ai][bj][m][1];
          pg8::f32x4 h0, h1;
          h0[0] = bflo(aw.x) * ri + v0[0]; h0[1] = bfhi(aw.x) * ri + v0[1]; h0[2] = bflo(aw.y) * ri + v0[2]; h0[3] = bfhi(aw.y) * ri + v0[3];
          h1[0] = bflo(aw.z) * ri + v1[0]; h1[1] = bfhi(aw.z) * ri + v1[1]; h1[2] = bflo(aw.w) * ri + v1[2]; h1[3] = bfhi(aw.w) * ri + v1[3];
          u32x4 w; w.x = pk2(h0[0], h0[1]); w.y = pk2(h0[2], h0[3]); w.z = pk2(h1[0], h1[1]); w.w = pk2(h1[2], h1[3]);
          *(u32x4*)(H1 + idx) = w;
          acc[ai][bj][m][0] = h0; acc[ai][bj][m][1] = h1;
          ss += h0[0] * h0[0] + h0[1] * h0[1] + h0[2] * h0[2] + h0[3] * h0[3] + h1[0] * h1[0] + h1[1] * h1[1] + h1[2] * h1[2] + h1[3] * h1[3];
          float am = fmaxf(fmaxf(fmaxf(fabsf(h0[0]), fabsf(h0[1])), fmaxf(fabsf(h0[2]), fabsf(h0[3]))), fmaxf(fmaxf(fabsf(h1[0]), fabsf(h1[1])), fmaxf(fabsf(h1[2]), fabsf(h1[3]))));
          am = fmaxf(am, __shfl_xor(am, 16)); am = fmaxf(am, __shfl_xor(am, 32));
          if (fq == 0) xa[((ai * 4 + m) * 2 + bj) * 64] = am;
        }
        ss += __shfl_xor(ss, 16); ss += __shfl_xor(ss, 32);
        if (fq == 0) xs[(ai * 4 + m) * 64] = ss;
      }
    }
#undef EPO_LOAD
    asm volatile("s_waitcnt lgkmcnt(0)\n\ts_barrier" ::: "memory");
#pragma unroll
    for (int ai = 0; ai < 2; ++ai)
#pragma unroll
      for (int m = 0; m < 4; ++m) {
        const int row = u.pm * 256 + ai * 128 + wr * 64 + m * 16 + fr;
#pragma unroll
        for (int bj = 0; bj < 2; ++bj) {
          const f32x4 pm = *(const f32x4*)&xa[((ai * 4 + m) * 2 + bj) * 64 - wc];
          const float M = fmaxf(fmaxf(pm.x, pm.y), fmaxf(pm.z, pm.w));
          const float inv = M > 0.f ? 127.0f / M : 0.f;
          const pg8::f32x4 h0 = acc[ai][bj][m][0], h1 = acc[ai][bj][m][1];
          u32x2 q;
          q.x = pack_i8x4(h0[0] * inv, h0[1] * inv, h0[2] * inv, h0[3] * inv);
          q.y = pack_i8x4(h1[0] * inv, h1[1] * inv, h1[2] * inv, h1[3] * inv);
          *(u32x2*)(XQ + ((unsigned)row * (unsigned)D + (unsigned)(u.pn * 256 + bj * 128 + wc * 32 + 8 * fq))) = q;
          if (wc == 0 && fq == 0) XS[(unsigned)row * 8u + (unsigned)(2 * u.pn + bj)] = M * (1.0f / 127.0f);
        }
        if (wc == 0 && fq == 0) {
          const f32x4 ps = *(const f32x4*)&xs[(ai * 4 + m) * 64 - wc];
          SSQ[(unsigned)u.pn * (unsigned)TREAL + (unsigned)row] = (ps.x + ps.y) + (ps.z + ps.w);
        }
      }
  }
};
struct EpiPQ {
  static constexpr bool PERM = true, AFTER_DRAIN = false;
  bf16_t* QP; const float* SSQ;
  DI void operator()(const pg8::f32x4 (&acc)[2][2][4][2], const pg8::Unit& u, int wr, int wc, int fr, int fq) const {
    float rr[2][4];
#pragma unroll
    for (int ai = 0; ai < 2; ++ai)
#pragma unroll
      for (int m = 0; m < 4; ++m) {
        const int row = u.pm * 256 + ai * 128 + wr * 64 + m * 16 + fr;
        rr[ai][m] = ((SSQ[row] + SSQ[TREAL + row]) + (SSQ[2 * TREAL + row] + SSQ[3 * TREAL + row])) * (1.0f / D) + EPS;
      }
    asm volatile("" ::: "memory");
#pragma unroll
    for (int ai = 0; ai < 2; ++ai)
#pragma unroll
      for (int m = 0; m < 4; ++m) {
        const int row = u.pm * 256 + ai * 128 + wr * 64 + m * 16 + fr;
        const float r = rsqrtf(rr[ai][m]);
        const unsigned rowoff = (unsigned)row * (unsigned)D;
#pragma unroll
        for (int bj = 0; bj < 2; ++bj) {
          const pg8::f32x4 v0 = acc[ai][bj][m][0], v1 = acc[ai][bj][m][1];
          u32x4 w; w.x = pk2(v0[0] * r, v0[1] * r); w.y = pk2(v0[2] * r, v0[3] * r); w.z = pk2(v1[0] * r, v1[1] * r); w.w = pk2(v1[2] * r, v1[3] * r);
          *(u32x4*)(QP + (rowoff + (unsigned)(u.pn * 256 + bj * 128 + wc * 32 + 8 * fq))) = w;
        }
      }
  }
};

DI void ph_meta(int blk, char* smem, const float* __restrict__ meta, const float* __restrict__ g1, const float* __restrict__ w_in, const InProjOut& O) {
  float (*xmT)[16] = (float (*)[16])smem;
  float (*red)[256] = (float (*)[256])(smem + 65536);
  const int tid = fresh_tid(), lane = tid & 63, wave = tid >> 6;
  for (int rr = 0; rr < 2; ++rr) {
    const int mm = wave * 2 + rr;
    float v[16]; float ss = 0.f;
#pragma unroll
    for (int j = 0; j < 16; ++j) { v[j] = meta[(size_t)mm * D + j * 64 + lane]; ss += v[j] * v[j]; }
    ss = wave_sum(ss);
    const float r = rsqrtf(ss * (1.0f / D) + EPS);
#pragma unroll
    for (int j = 0; j < 16; ++j) xmT[j * 64 + lane][mm] = v[j] * r * g1[j * 64 + lane];
  }
  __syncthreads();
  {
    const int c = tid & 15, ks = tid >> 4, n = blk * 16 + c;
    float acc[16];
#pragma unroll
    for (int j = 0; j < 16; ++j) acc[j] = 0.f;
    float wv[32];
#pragma unroll
    for (int kk = 0; kk < 32; ++kk) wv[kk] = w_in[(size_t)(ks * 32 + kk) * NIN + n];
#pragma unroll
    for (int kk = 0; kk < 32; ++kk) {
      const int k = ks * 32 + kk;
      const float w = wv[kk];
      const f32x4 a = *(const f32x4*)&xmT[k][0], b4 = *(const f32x4*)&xmT[k][4], c4 = *(const f32x4*)&xmT[k][8], d4 = *(const f32x4*)&xmT[k][12];
      acc[0] += a.x * w; acc[1] += a.y * w; acc[2] += a.z * w; acc[3] += a.w * w;
      acc[4] += b4.x * w; acc[5] += b4.y * w; acc[6] += b4.z * w; acc[7] += b4.w * w;
      acc[8] += c4.x * w; acc[9] += c4.y * w; acc[10] += c4.z * w; acc[11] += c4.w * w;
      acc[12] += d4.x * w; acc[13] += d4.y * w; acc[14] += d4.z * w; acc[15] += d4.w * w;
    }
#pragma unroll
    for (int mm = 0; mm < 16; ++mm) red[ks][c * 16 + mm] = acc[mm];
  }
  __syncthreads();
  if (tid < 256) {
    const int c = tid >> 4, mm = tid & 15, n = blk * 16 + c;
    float val = 0.f;
#pragma unroll 8
    for (int ks = 0; ks < 32; ++ks) val += red[ks][tid];
    const bf16_t hv = (bf16_t)f2bf(val);
    for (int bb = 0; bb < NB; ++bb) {
      if (n < 512) {}
      else if (n < 1024) { const int cc = n - 512;  O.KSB[((size_t)(bb * SBH + (cc >> 6)) * KIDX + 16 + mm) * 64 + (cc & 63)] = hv; }
      else if (n < 1536) { const int cc = n - 1024; O.VTSB[((size_t)(bb * SBH + (cc >> 6)) * 64 + (cc & 63)) * KIDX + 16 + mm] = hv; }
      else if (n < 1792) { const int cc = n - 1536; O.GQ[((size_t)(bb * GH + (cc >> 6)) * GU + 48 + mm) * 64 + (cc & 63)] = hv; }
      else if (n < 2048) { const int cc = n - 1792; O.GK[((size_t)(bb * GH + (cc >> 6)) * GU + 48 + mm) * 64 + (cc & 63)] = hv; }
      else if (n < 2560) { const int cc = n - 2048; O.GV[((size_t)(bb * GH + (cc >> 7)) * 128 + (cc & 127)) * GU + 48 + mm] = hv; }
      else if (n < 3072) {}
      else { O.GLR[((size_t)bb * GU + 48 + mm) * 16 + (n - 3072)] = val; }
    }
  }
  __syncthreads();
}


constexpr float SB_THR = 5.421010862e-20f;
DI void ph_sb_attn(int vb, const bf16_t* __restrict__ QSB, const bf16_t* __restrict__ KSB, const bf16_t* __restrict__ VTSB,
                                                 const float* __restrict__ sb_g, bf16_t* __restrict__ MIX) {
  const int tid256_ = fresh_tid() & 255;
  const int lane = TID & 63, wave = TID >> 6, r = lane & 31, h = lane >> 5;
  const int bh = vb >> 6, qb = vb & 63;
  const int b = bh >> 3, hd = bh & 7;
  const int i0 = qb * 128 + wave * 32;
  const bf16_t* Qb = QSB + ((size_t)bh * SEQ + i0) * 64;
  const bf16_t* Kb = KSB + (size_t)bh * KIDX * 64;
  const bf16_t* Vb = VTSB + (size_t)bh * 64 * KIDX;
  bf16x8 qf[4];
#pragma unroll
  for (int ks = 0; ks < 4; ++ks) qf[ks] = *(const bf16x8*)(Qb + r * 64 + ks * 16 + h * 8);
  f32x16 o[2];
#pragma unroll
  for (int e = 0; e < 16; ++e) { o[0][e] = 0.f; o[1][e] = 0.f; }
  float R = 1.f;
  const int qidx = 32 + i0 + r;
  for (int c = (i0 >> 5) + 1; c >= 0; --c) {
    const int k0 = 32 * c;
    bf16x8 kf[4];
#pragma unroll
    for (int ks = 0; ks < 4; ++ks) kf[ks] = *(const bf16x8*)(Kb + (size_t)(k0 + r) * 64 + ks * 16 + h * 8);
    bf16x8 vf[2][2];
#pragma unroll
    for (int mt = 0; mt < 2; ++mt)
#pragma unroll
      for (int s2 = 0; s2 < 2; ++s2) {
        const bf16_t* vp = Vb + (size_t)(mt * 32 + r) * KIDX + k0 + 16 * s2 + 4 * h;
        const u32x2 lo = *(const u32x2*)vp, hi = *(const u32x2*)(vp + 8);
        u32x4 t; t.x = lo.x; t.y = lo.y; t.z = hi.x; t.w = hi.y;
        vf[mt][s2] = __builtin_bit_cast(bf16x8, t);
      }
    f32x16 s;
#pragma unroll
    for (int e = 0; e < 16; ++e) s[e] = 0.f;
#pragma unroll
    for (int ks = 0; ks < 4; ++ks) s = MFMA32(kf[ks], qf[ks], s);
    float om[16], bt[16];
#pragma unroll
    for (int e = 0; e < 16; ++e) {
      const int kidx = k0 + crow(e, h);
      const bool valid = (kidx < qidx) && (kidx >= 16);
      const float z = s[e] * 0.125f;
      const float ez = __expf(-fabsf(z));
      const float big = __builtin_amdgcn_rcpf(1.f + ez), small = ez * big;
      const float beta = z >= 0.f ? big : small, onem = z >= 0.f ? small : big;
      om[e] = valid ? onem : 1.f;
      bt[e] = valid ? beta : 0.f;
    }
    float sfx[16], G[4], PG[4];
#pragma unroll
    for (int g = 0; g < 4; ++g) {
      sfx[4 * g + 3] = 1.f;
      sfx[4 * g + 2] = om[4 * g + 3];
      sfx[4 * g + 1] = sfx[4 * g + 2] * om[4 * g + 2];
      sfx[4 * g + 0] = sfx[4 * g + 1] * om[4 * g + 1];
      G[g] = sfx[4 * g + 0] * om[4 * g + 0];
      PG[g] = __shfl_xor(G[g], 32);
    }
    float HS[4];
    HS[3] = 1.f;
    HS[2] = G[3] * PG[3];
    HS[1] = HS[2] * (G[2] * PG[2]);
    HS[0] = HS[1] * (G[1] * PG[1]);
    const float total = HS[0] * (G[0] * PG[0]);
    float a[16];
#pragma unroll
    for (int e = 0; e < 16; ++e) {
      const int g = e >> 2;
      const float between = sfx[e] * (h == 0 ? PG[g] : 1.f) * (HS[g] * R);
      a[e] = bt[e] * between;
    }
    R *= total;
#pragma unroll
    for (int s2 = 0; s2 < 2; ++s2) {
      u32x4 p;
      p.x = pk2(a[8 * s2 + 0], a[8 * s2 + 1]); p.y = pk2(a[8 * s2 + 2], a[8 * s2 + 3]);
      p.z = pk2(a[8 * s2 + 4], a[8 * s2 + 5]); p.w = pk2(a[8 * s2 + 6], a[8 * s2 + 7]);
      const bf16x8 pf = __builtin_bit_cast(bf16x8, p);
      o[0] = MFMA32(vf[0][s2], pf, o[0]);
      o[1] = MFMA32(vf[1][s2], pf, o[1]);
    }
    if (__all(R < SB_THR)) break;
  }
  float ss = 0.f;
#pragma unroll
  for (int e = 0; e < 16; ++e) ss += o[0][e] * o[0][e] + o[1][e] * o[1][e];
  ss += __shfl_xor(ss, 32);
  const float sc = rsqrtf(ss * (1.0f / 64.0f) + EPS);
  bf16_t* outp = MIX + (size_t)(b * SEQ + i0 + r) * D + hd * 64;
#pragma unroll
  for (int mt = 0; mt < 2; ++mt)
#pragma unroll
    for (int g = 0; g < 4; ++g) {
      const int d = mt * 32 + 8 * g + 4 * h;
      const f32x4 gg = *(const f32x4*)(sb_g + hd * 64 + d);
      u32x2 pk;
      pk.x = pk2(o[mt][4 * g] * sc * gg.x, o[mt][4 * g + 1] * sc * gg.y);
      pk.y = pk2(o[mt][4 * g + 2] * sc * gg.z, o[mt][4 * g + 3] * sc * gg.w);
      *(u32x2*)(outp + d) = pk;
    }
}


template <bool MASK>
DI void sb_tile_step(const f32x16& s, int k0, int qidx, int h, float& R, const bf16x8 (&vf)[2][2], f32x16 (&o)[2]) {
  float om[16], bt[16];
#pragma unroll
  for (int e = 0; e < 16; ++e) {
    const float ez = __builtin_amdgcn_exp2f(s[e] * (0.125f * 1.44269504089f));
    const float onem = __builtin_amdgcn_rcpf(1.f + ez), beta = 1.f - onem;
    if (MASK) {
      const int kidx = k0 + crow(e, h);
      const bool valid = (kidx < qidx) && (kidx >= 16);
      om[e] = valid ? onem : 1.f;
      bt[e] = valid ? beta : 0.f;
    } else { om[e] = onem; bt[e] = beta; }
  }
  float sfx[16], G[4], PG[4];
#pragma unroll
  for (int g = 0; g < 4; ++g) {
    sfx[4 * g + 3] = 1.f;
    sfx[4 * g + 2] = om[4 * g + 3];
    sfx[4 * g + 1] = sfx[4 * g + 2] * om[4 * g + 2];
    sfx[4 * g + 0] = sfx[4 * g + 1] * om[4 * g + 1];
    G[g] = sfx[4 * g + 0] * om[4 * g + 0];
    PG[g] = __shfl_xor(G[g], 32);
  }
  float HS[4];
  HS[3] = 1.f; HS[2] = G[3] * PG[3]; HS[1] = HS[2] * (G[2] * PG[2]); HS[0] = HS[1] * (G[1] * PG[1]);
  const float total = HS[0] * (G[0] * PG[0]);
  float a[16];
#pragma unroll
  for (int e = 0; e < 16; ++e) { const int g = e >> 2; a[e] = bt[e] * (sfx[e] * (h == 0 ? PG[g] : 1.f) * (HS[g] * R)); }
  R *= total;
#pragma unroll
  for (int s2 = 0; s2 < 2; ++s2) {
    u32x4 p;
    p.x = pk2(a[8 * s2 + 0], a[8 * s2 + 1]); p.y = pk2(a[8 * s2 + 2], a[8 * s2 + 3]);
    p.z = pk2(a[8 * s2 + 4], a[8 * s2 + 5]); p.w = pk2(a[8 * s2 + 6], a[8 * s2 + 7]);
    const bf16x8 pf = __builtin_bit_cast(bf16x8, p);
    o[0] = MFMA32(vf[0][s2], pf, o[0]);
    o[1] = MFMA32(vf[1][s2], pf, o[1]);
  }
}
DI void sb_tile_out(const f32x16 (&o)[2], int h, const float* __restrict__ sb_gh, bf16_t* __restrict__ outp) {
  float ss = 0.f;
#pragma unroll
  for (int e = 0; e < 16; ++e) ss += o[0][e] * o[0][e] + o[1][e] * o[1][e];
  ss += __shfl_xor(ss, 32);
  const float sc = rsqrtf(ss * (1.0f / 64.0f) + EPS);
#pragma unroll
  for (int mt = 0; mt < 2; ++mt)
#pragma unroll
    for (int gp = 0; gp < 2; ++gp) {
      u32x2 pk[2];
#pragma unroll
      for (int z = 0; z < 2; ++z) {
        const int g = 2 * gp + z, d = mt * 32 + 8 * g + 4 * h;
        const f32x4 gg = *(const f32x4*)(sb_gh + d);
        pk[z].x = pk2(o[mt][4 * g] * sc * gg.x, o[mt][4 * g + 1] * sc * gg.y);
        pk[z].y = pk2(o[mt][4 * g + 2] * sc * gg.z, o[mt][4 * g + 3] * sc * gg.w);
      }
      const auto rx = __builtin_amdgcn_permlane32_swap(pk[0].x, pk[1].x, false, false);
      const auto ry = __builtin_amdgcn_permlane32_swap(pk[0].y, pk[1].y, false, false);
      *(u32x4*)(outp + mt * 32 + 16 * gp + 8 * h) = (u32x4){(unsigned)rx[0], (unsigned)ry[0], (unsigned)rx[1], (unsigned)ry[1]};
    }
}
DI void ph_sb_attn2(int vb, const bf16_t* __restrict__ QSB, const bf16_t* __restrict__ KSB, const bf16_t* __restrict__ VTSB,
                    const float* __restrict__ sb_g, bf16_t* __restrict__ MIX) {
  const int tid256_ = fresh_tid() & 255;
  const int lane = TID & 63, wave = TID >> 6, r = lane & 31, h = lane >> 5;
  const int bh = vb >> 5, qb = vb & 31;
  const int b = bh >> 3, hd = bh & 7;
  const int i0 = qb * 256 + wave * 64;
  const bf16_t* Qb = QSB + ((size_t)bh * SEQ + i0) * 64;
  const bf16_t* Kb = KSB + (size_t)bh * KIDX * 64;
  const bf16_t* Vb = VTSB + (size_t)bh * 64 * KIDX;
  bf16x8 qfA[4], qfB[4];
#pragma unroll
  for (int ks = 0; ks < 4; ++ks) { qfA[ks] = *(const bf16x8*)(Qb + r * 64 + ks * 16 + h * 8); qfB[ks] = *(const bf16x8*)(Qb + (32 + r) * 64 + ks * 16 + h * 8); }
  f32x16 oA[2], oB[2];
#pragma unroll
  for (int e = 0; e < 16; ++e) { oA[0][e] = 0.f; oA[1][e] = 0.f; oB[0][e] = 0.f; oB[1][e] = 0.f; }
  float RA = 1.f, RB = 1.f;
  const int qidxA = 32 + i0 + r, qidxB = qidxA + 32;
  for (int c = (i0 >> 5) + 2; c >= 0; --c) {
    const int k0 = 32 * c;
    bf16x8 kf[4];
#pragma unroll
    for (int ks = 0; ks < 4; ++ks) kf[ks] = *(const bf16x8*)(Kb + (size_t)(k0 + r) * 64 + ks * 16 + h * 8);
    bf16x8 vf[2][2];
#pragma unroll
    for (int mt = 0; mt < 2; ++mt)
#pragma unroll
      for (int s2 = 0; s2 < 2; ++s2) {
        const bf16_t* vp = Vb + (size_t)(mt * 32 + r) * KIDX + k0 + 16 * s2 + 4 * h;
        const u32x2 lo = *(const u32x2*)vp, hi = *(const u32x2*)(vp + 8);
        u32x4 t; t.x = lo.x; t.y = lo.y; t.z = hi.x; t.w = hi.y;
        vf[mt][s2] = __builtin_bit_cast(bf16x8, t);
      }
    f32x16 sA, sB;
#pragma unroll
    for (int e = 0; e < 16; ++e) { sA[e] = 0.f; sB[e] = 0.f; }
#pragma unroll
    for (int ks = 0; ks < 4; ++ks) { sA = MFMA32(kf[ks], qfA[ks], sA); sB = MFMA32(kf[ks], qfB[ks], sB); }
    if (k0 >= 32 && k0 + 32 <= 64 + i0) sb_tile_step<false>(sB, k0, qidxB, h, RB, vf, oB); else sb_tile_step<true>(sB, k0, qidxB, h, RB, vf, oB);
    if (k0 >= 32 && k0 + 32 <= 32 + i0) sb_tile_step<false>(sA, k0, qidxA, h, RA, vf, oA); else sb_tile_step<true>(sA, k0, qidxA, h, RA, vf, oA);
    if (__all(RA < SB_THR && RB < SB_THR)) break;
  }
  sb_tile_out(oA, h, sb_g + hd * 64, MIX + (size_t)(b * SEQ + i0 + r) * D + hd * 64);
  sb_tile_out(oB, h, sb_g + hd * 64, MIX + (size_t)(b * SEQ + i0 + 32 + r) * D + hd * 64);
}


constexpr int RT_TOK_PER_BLOCK = 256;


#define MFMA16(a, b, c) __builtin_amdgcn_mfma_f32_16x16x32_bf16((a), (b), (c), 0, 0, 0)
constexpr int GLDS = 72;
struct GlaLds {
  bf16_t Qt[64 * GLDS];
  bf16_t Kt[64 * GLDS];
  bf16_t KT[64 * GLDS];
  bf16_t P[64 * GLDS];
  float dec[64];
  float tot[8][64];
  float ssq[8][64];
};
constexpr size_t WS_SLOC = 926 * MiB;
constexpr size_t WS_DTOT = 942 * MiB;
constexpr size_t WS_GVT = 604 * MiB;

struct GlaPtrs { const bf16_t *GQ, *GK, *GVT, *GR; const float *GLR, *wg, *bg, *gla_g; float *SLOC, *DTOT; bf16_t* MIX; };


constexpr size_t WS_GQT = 470 * MiB;
constexpr size_t WS_GKT = 502 * MiB + 512 * 1024;
constexpr size_t WS_GKTT = 861 * MiB;
constexpr size_t WS_GDEC = 894 * MiB;
constexpr size_t WS_GBL = 896 * MiB;
struct GlaPrepPtrs { const bf16_t *GQ, *GK; const float *GLR, *wg, *bg; bf16_t *QT, *KT, *KTT; float *DEC, *BL; };
DI void ph_glr(int panel, const bf16_t* __restrict__ A1, const bf16_t* __restrict__ WinT, float* __restrict__ GLR) {
  const int tid = fresh_tid(), lane = tid & 63, wave = tid >> 6, c16 = lane & 15, q = lane >> 4;
  const int row0 = panel * 256 + wave * 32;
  const bf16_t* a0 = A1 + (size_t)(row0 + c16) * D + 8 * q;
  const bf16_t* a1 = a0 + (size_t)16 * D;
  const bf16_t* bp = WinT + (size_t)(3072 + c16) * D + 8 * q;
  f32x4 acc0 = {0.f, 0.f, 0.f, 0.f}, acc1 = {0.f, 0.f, 0.f, 0.f};
#pragma unroll 8
  for (int ks = 0; ks < D / 32; ++ks) {
    const bf16x8 fa0 = *(const bf16x8*)(a0 + 32 * ks), fa1 = *(const bf16x8*)(a1 + 32 * ks), fb = *(const bf16x8*)(bp + 32 * ks);
    acc0 = MFMA16(fa0, fb, acc0); acc1 = MFMA16(fa1, fb, acc1);
  }
#pragma unroll
  for (int r = 0; r < 4; ++r) {
    const int ra = row0 + 4 * q + r, rb = ra + 16;
    GLR[((size_t)(ra >> 13) * GU + 64 + (ra & 8191)) * 16 + c16] = acc0[r];
    GLR[((size_t)(rb >> 13) * GU + 64 + (rb & 8191)) * 16 + c16] = acc1[r];
  }
}
DI void ph_gla_prep(int pair, char* smem, const GlaPrepPtrs& G) {
  const int tid = fresh_tid(), lane = tid & 63, w = tid >> 6, hb = w >> 2, w4 = w & 3, dq = lane & 15, tg = lane >> 4;
  float (*tot)[64] = (float (*)[64])(smem + hb * 1024);
  const int item = 2 * pair + hb;
  const int bh = item / 129, c = item % 129, b = bh >> 2, hd = bh & 3, u0 = 64 * c + 16 * w4 + 4 * tg;
  f32x4 wgr[16];
#pragma unroll
  for (int k = 0; k < 16; ++k) wgr[k] = *(const f32x4*)(G.wg + k * 256 + hd * 64 + 4 * dq);
  const f32x4 bgv = *(const f32x4*)(G.bg + hd * 64 + 4 * dq);
  u32x2 kraw[4], qraw[4];
#pragma unroll
  for (int i = 0; i < 4; ++i) {
    kraw[i] = *(const u32x2*)(G.GK + ((size_t)bh * GU + u0 + i) * 64 + 4 * dq);
    qraw[i] = *(const u32x2*)(G.GQ + ((size_t)bh * GU + u0 + i) * 64 + 4 * dq);
  }
  f32x4 cs[4]; f32x4 run = {0.f, 0.f, 0.f, 0.f};
#pragma unroll
  for (int i = 0; i < 4; ++i) {
    const int u = u0 + i;
    f32x4 lgv = {0.f, 0.f, 0.f, 0.f};
    if (u >= 48) {
      const f32x4* gp = (const f32x4*)(G.GLR + ((size_t)b * GU + u) * 16);
      const f32x4 g0 = gp[0], g1 = gp[1], g2 = gp[2], g3 = gp[3];
      f32x4 a = bgv;
      a += g0.x * wgr[0] + g0.y * wgr[1] + g0.z * wgr[2] + g0.w * wgr[3];
      a += g1.x * wgr[4] + g1.y * wgr[5] + g1.z * wgr[6] + g1.w * wgr[7];
      a += g2.x * wgr[8] + g2.y * wgr[9] + g2.z * wgr[10] + g2.w * wgr[11];
      a += g3.x * wgr[12] + g3.y * wgr[13] + g3.z * wgr[14] + g3.w * wgr[15];
      lgv = (f32x4){-softplus(-a.x), -softplus(-a.y), -softplus(-a.z), -softplus(-a.w)} * (1.0f / 16.0f);
    }
    run += lgv; cs[i] = run;
  }
  f32x4 pre = {0.f, 0.f, 0.f, 0.f}, wtot = run;
#pragma unroll
  for (int j = 0; j < 4; ++j) {
    const float t1 = __shfl_up(run[j], 16), t2 = __shfl_up(run[j], 32), t3 = __shfl_up(run[j], 48);
    pre[j] = (tg >= 1 ? t1 : 0.f) + (tg >= 2 ? t2 : 0.f) + (tg >= 3 ? t3 : 0.f);
    float t = run[j]; t += __shfl_xor(t, 16); t += __shfl_xor(t, 32); wtot[j] = t;
  }
  if (tg == 0) *(f32x4*)&tot[w4][4 * dq] = wtot;
  __syncthreads();
  f32x4 offset = pre, total = {0.f, 0.f, 0.f, 0.f};
#pragma unroll
  for (int s2 = 0; s2 < 4; ++s2) { const f32x4 tv = *(const f32x4*)&tot[s2][4 * dq]; total += tv; if (s2 < w4) offset += tv; }
  const size_t cb = ((size_t)bh * 129 + c) * 4096;
  f32x4 kt[4];
#pragma unroll
  for (int i = 0; i < 4; ++i) {
    const f32x4 bc = offset + cs[i];
    const f32x4 kf = {bflo(kraw[i].x), bfhi(kraw[i].x), bflo(kraw[i].y), bfhi(kraw[i].y)};
    const f32x4 qf = {bflo(qraw[i].x), bfhi(qraw[i].x), bflo(qraw[i].y), bfhi(qraw[i].y)};
    kt[i] = (f32x4){kf.x * __expf(-bc.x), kf.y * __expf(-bc.y), kf.z * __expf(-bc.z), kf.w * __expf(-bc.w)};
    const f32x4 qt = {qf.x * __expf(bc.x) * 0.125f, qf.y * __expf(bc.y) * 0.125f, qf.z * __expf(bc.z) * 0.125f, qf.w * __expf(bc.w) * 0.125f};
    const int tok = 16 * w4 + 4 * tg + i;
    u32x2 o; o.x = pk2(qt.x, qt.y); o.y = pk2(qt.z, qt.w);
    *(u32x2*)(G.QT + cb + tok * 64 + 4 * dq) = o;
    o.x = pk2(kt[i].x, kt[i].y); o.y = pk2(kt[i].z, kt[i].w);
    *(u32x2*)(G.KT + cb + tok * 64 + 4 * dq) = o;
  }
#pragma unroll
  for (int j = 0; j < 4; ++j) {
    u32x2 o; o.x = pk2(kt[0][j], kt[1][j]); o.y = pk2(kt[2][j], kt[3][j]);
    *(u32x2*)(G.KTT + cb + (4 * dq + j) * 64 + 16 * w4 + 4 * tg) = o;
  }
  if (w4 == 0 && tg == 0) {
    *(f32x4*)(G.DEC + ((size_t)bh * 129 + c) * 64 + 4 * dq) = (f32x4){__expf(total.x), __expf(total.y), __expf(total.z), __expf(total.w)};
    *(f32x4*)(G.BL + ((size_t)bh * 129 + c) * 64 + 4 * dq) = total;
  }
  __syncthreads();
}

struct GlaBuf { bf16_t Qt[64 * GLDS]; bf16_t Kt[64 * GLDS]; bf16_t KT[64 * GLDS]; };
struct GlaLds3 { GlaBuf B[2]; bf16_t P[64 * GLDS]; float ssq[8][64]; };
struct GlaPtrs3 { const bf16_t *QT, *KT, *KTT, *GVT, *GR; const float *DEC, *BL, *gla_g; float *SLOC, *DTOT; bf16_t* MIX; };

template <int PASS>
DI void gla_item3(int bh, int sc, char* smem, const GlaPtrs3& G) {
  GlaLds3& L = *(GlaLds3*)smem;
  const int tid = fresh_tid(), lane = tid & 63, w = __builtin_amdgcn_readfirstlane(tid >> 6), c16 = lane & 15, q = lane >> 4;
  const int b = bh >> 2, hd = bh & 3;
  const int cbeg = sc == 0 ? 0 : 8 * sc + 1, cend = 8 * sc + 9;
  f32x4 X[4];
#pragma unroll
  for (int i = 0; i < 4; ++i) X[i] = (f32x4){0.f, 0.f, 0.f, 0.f};
  if (PASS == 1) {
#pragma unroll 4
    for (int j = 0; j < sc; ++j) {
      const float* dt = G.DTOT + (size_t)(bh * 16 + j) * 64;
      const float* sl = G.SLOC + ((size_t)(bh * 16 + j) * 8 + w) * 16 * 64 + lane;
#pragma unroll
      for (int i = 0; i < 4; ++i) {
        const f32x4 d4 = *(const f32x4*)(dt + 16 * i + 4 * q);
        X[i][0] = d4.x * X[i][0] + sl[(4 * i + 0) * 64]; X[i][1] = d4.y * X[i][1] + sl[(4 * i + 1) * 64];
        X[i][2] = d4.z * X[i][2] + sl[(4 * i + 2) * 64]; X[i][3] = d4.w * X[i][3] + sl[(4 * i + 3) * 64];
      }
    }
  }
  f32x4 gain = {1.f, 1.f, 1.f, 1.f};
  if (PASS == 1) gain = *(const f32x4*)(G.gla_g + hd * 128 + 16 * w + 4 * q);
  const bf16_t* gvt = G.GVT + ((size_t)bh * 128 + 16 * w + c16) * GU + 8 * q;
  const int srow = tid >> 3, sc8 = tid & 7, soff = srow * GLDS + sc8 * 8;
  const size_t cb0 = (size_t)bh * 129 * 4096 + (size_t)srow * 64 + sc8 * 8;
  u32x4 rq, rk, rkt, rq2, rk2, rkt2; bf16x8 vfr[2], vfn[2], vfn2[2]; f32x4 dec[4], decn[4], decn2[4];
  {
    const size_t cb = cb0 + (size_t)cbeg * 4096;
    rkt = *(const u32x4*)(G.KTT + cb);
    if (PASS == 1) { rq = *(const u32x4*)(G.QT + cb); rk = *(const u32x4*)(G.KT + cb); }
    vfr[0] = *(const bf16x8*)(gvt + 64 * cbeg); vfr[1] = *(const bf16x8*)(gvt + 64 * cbeg + 32);
#pragma unroll
    for (int i = 0; i < 4; ++i) dec[i] = *(const f32x4*)(G.DEC + ((size_t)bh * 129 + cbeg) * 64 + 16 * i + 4 * q);
    *(u32x4*)&L.B[0].KT[soff] = rkt;
    if (PASS == 1) { *(u32x4*)&L.B[0].Qt[soff] = rq; *(u32x4*)&L.B[0].Kt[soff] = rk; }
    const size_t cb1 = cb0 + (size_t)(cbeg + 1) * 4096;
    rkt = *(const u32x4*)(G.KTT + cb1);
    if (PASS == 1) { rq = *(const u32x4*)(G.QT + cb1); rk = *(const u32x4*)(G.KT + cb1); }
    vfn[0] = *(const bf16x8*)(gvt + 64 * (cbeg + 1)); vfn[1] = *(const bf16x8*)(gvt + 64 * (cbeg + 1) + 32);
#pragma unroll
    for (int i = 0; i < 4; ++i) decn[i] = *(const f32x4*)(G.DEC + ((size_t)bh * 129 + cbeg + 1) * 64 + 16 * i + 4 * q);
  }
  __syncthreads();
  for (int c = cbeg; c < cend; ++c) {
    const int cur = (c - cbeg) & 1;
    const GlaBuf& Bc = L.B[cur];
    const bool more = c + 1 < cend, more2 = c + 2 < cend;
    if (more2) {
      const size_t cb = cb0 + (size_t)(c + 2) * 4096;
      rkt2 = *(const u32x4*)(G.KTT + cb);
      if (PASS == 1) { rq2 = *(const u32x4*)(G.QT + cb); rk2 = *(const u32x4*)(G.KT + cb); }
      vfn2[0] = *(const bf16x8*)(gvt + 64 * (c + 2)); vfn2[1] = *(const bf16x8*)(gvt + 64 * (c + 2) + 32);
#pragma unroll
      for (int i = 0; i < 4; ++i) decn2[i] = *(const f32x4*)(G.DEC + ((size_t)bh * 129 + c + 2) * 64 + 16 * i + 4 * q);
    }
    u32x2 grv[4];
    if (PASS == 1 && c >= 1) {
#pragma unroll
      for (int n = 0; n < 4; ++n) grv[n] = *(const u32x2*)(G.GR + ((size_t)b * SEQ + 64 * (c - 1) + 16 * n + c16) * 512 + hd * 128 + 16 * w + 4 * q);
    }
    f32x4 OT[4];
    if (PASS == 1) {
      const int is = w >> 1;
#pragma unroll
      for (int z = 0; z < 2; ++z) {
        const int it = 2 * (w & 1) + z;
        f32x4 pa = {0.f, 0.f, 0.f, 0.f};
        if (is <= it) {
#pragma unroll
          for (int kk = 0; kk < 2; ++kk) {
            const bf16x8 ka = *(const bf16x8*)&Bc.Kt[(16 * is + c16) * GLDS + 32 * kk + 8 * q];
            const bf16x8 qb = *(const bf16x8*)&Bc.Qt[(16 * it + c16) * GLDS + 32 * kk + 8 * q];
            pa = MFMA16(ka, qb, pa);
          }
          if (is == it) {
#pragma unroll
            for (int r = 0; r < 4; ++r) if (4 * q + r > c16) pa[r] = 0.f;
          }
        }
        u32x2 pw; pw.x = pk2(pa[0], pa[1]); pw.y = pk2(pa[2], pa[3]);
        *(u32x2*)&L.P[(16 * it + c16) * GLDS + 16 * is + 4 * q] = pw;
      }
#pragma unroll
      for (int n = 0; n < 4; ++n) OT[n] = (f32x4){0.f, 0.f, 0.f, 0.f};
#pragma unroll
      for (int kk = 0; kk < 2; ++kk) {
        u32x4 xp; xp.x = pk2(X[2 * kk][0], X[2 * kk][1]); xp.y = pk2(X[2 * kk][2], X[2 * kk][3]);
        xp.z = pk2(X[2 * kk + 1][0], X[2 * kk + 1][1]); xp.w = pk2(X[2 * kk + 1][2], X[2 * kk + 1][3]);
        const bf16x8 xa = __builtin_bit_cast(bf16x8, xp);
#pragma unroll
        for (int n = 0; n < 4; ++n) {
          const u32x2 lo = *(const u32x2*)&Bc.Qt[(16 * n + c16) * GLDS + 32 * kk + 4 * q];
          const u32x2 hi = *(const u32x2*)&Bc.Qt[(16 * n + c16) * GLDS + 32 * kk + 16 + 4 * q];
          u32x4 qq; qq.x = lo.x; qq.y = lo.y; qq.z = hi.x; qq.w = hi.y;
          OT[n] = MFMA16(xa, __builtin_bit_cast(bf16x8, qq), OT[n]);
        }
      }
      __syncthreads();
#pragma unroll
      for (int kk = 0; kk < 2; ++kk)
#pragma unroll
        for (int n = 0; n < 4; ++n) {
          const bf16x8 pb = *(const bf16x8*)&L.P[(16 * n + c16) * GLDS + 32 * kk + 8 * q];
          OT[n] = MFMA16(vfr[kk], pb, OT[n]);
        }
    }
#pragma unroll
    for (int i = 0; i < 4; ++i) {
#pragma unroll
      for (int kk = 0; kk < 2; ++kk) {
        const bf16x8 ka = *(const bf16x8*)&Bc.KT[(16 * i + c16) * GLDS + 32 * kk + 8 * q];
        X[i] = MFMA16(ka, vfr[kk], X[i]);
      }
      X[i][0] *= dec[i].x; X[i][1] *= dec[i].y; X[i][2] *= dec[i].z; X[i][3] *= dec[i].w;
    }
    if (PASS == 1 && c >= 1) {
      float ss[4];
#pragma unroll
      for (int n = 0; n < 4; ++n) {
        float v = OT[n][0] * OT[n][0] + OT[n][1] * OT[n][1] + OT[n][2] * OT[n][2] + OT[n][3] * OT[n][3];
        v += __shfl_xor(v, 16); v += __shfl_xor(v, 32);
        ss[n] = v;
      }
      if (q == 0) {
#pragma unroll
        for (int n = 0; n < 4; ++n) L.ssq[w][16 * n + c16] = ss[n];
      }
      __syncthreads();
#pragma unroll
      for (int n = 0; n < 4; ++n) {
        float tot = 0.f;
#pragma unroll
        for (int w2 = 0; w2 < 8; ++w2) tot += L.ssq[w2][16 * n + c16];
        const float scl = rsqrtf(tot * (1.0f / 128.0f) + EPS);
        const size_t m = (size_t)b * SEQ + 64 * (c - 1) + 16 * n + c16;
        const float r0 = bflo(grv[n].x), r1 = bfhi(grv[n].x), r2 = bflo(grv[n].y), r3 = bfhi(grv[n].y);
        const float o0 = OT[n][0] * scl * gain.x * (r0 / (1.f + __expf(-r0)));
        const float o1 = OT[n][1] * scl * gain.y * (r1 / (1.f + __expf(-r1)));
        const float o2 = OT[n][2] * scl * gain.z * (r2 / (1.f + __expf(-r2)));
        const float o3 = OT[n][3] * scl * gain.w * (r3 / (1.f + __expf(-r3)));
        u32x2 ow; ow.x = pk2(o0, o1); ow.y = pk2(o2, o3);
        *(u32x2*)(G.MIX + m * D + 512 + hd * 128 + 16 * w + 4 * q) = ow;
      }
    }
    if (more) {
      GlaBuf& Bn = L.B[cur ^ 1];
      *(u32x4*)&Bn.KT[soff] = rkt;
      if (PASS == 1) { *(u32x4*)&Bn.Qt[soff] = rq; *(u32x4*)&Bn.Kt[soff] = rk; }
      vfr[0] = vfn[0]; vfr[1] = vfn[1];
#pragma unroll
      for (int i = 0; i < 4; ++i) dec[i] = decn[i];
      rkt = rkt2; rq = rq2; rk = rk2; vfn[0] = vfn2[0]; vfn[1] = vfn2[1];
#pragma unroll
      for (int i = 0; i < 4; ++i) decn[i] = decn2[i];
    }
    __syncthreads();
  }
  if (PASS == 0) {
    float* sl = G.SLOC + ((size_t)(bh * 16 + sc) * 8 + w) * 16 * 64 + lane;
#pragma unroll
    for (int i = 0; i < 4; ++i)
#pragma unroll
      for (int r = 0; r < 4; ++r) sl[(4 * i + r) * 64] = X[i][r];
    if (w == 0) {
      float bl = 0.f;
      for (int c = cbeg; c < cend; ++c) bl += G.BL[((size_t)bh * 129 + c) * 64 + lane];
      G.DTOT[(size_t)(bh * 16 + sc) * 64 + lane] = __expf(bl);
    }
  }
}


struct GlaLds4 { GlaBuf B[2]; bf16_t P[64 * GLDS]; float ssq[4][64]; };
template <int PASS>
DI void gla_item4(int bh_lo, int sc, char* smem, const GlaPtrs3& G) {
  const int tid = fresh_tid(), lane = tid & 63, w = __builtin_amdgcn_readfirstlane(tid >> 6), c16 = lane & 15, q = lane >> 4;
  const int hb = w >> 2, w4 = w & 3, tid4 = tid & 255;
  GlaLds4& L = *(GlaLds4*)(smem + hb * (int)sizeof(GlaLds4));
  const int bh = bh_lo + 16 * hb, b = bh >> 2, hd = bh & 3;
  const int cbeg = sc == 0 ? 0 : 8 * sc + 1, cend = 8 * sc + 9;
  f32x4 X[2][4];
#pragma unroll
  for (int et = 0; et < 2; ++et)
#pragma unroll
    for (int i = 0; i < 4; ++i) X[et][i] = (f32x4){0.f, 0.f, 0.f, 0.f};
  if (PASS == 1) {
#pragma unroll 2
    for (int j = 0; j < sc; ++j) {
      const float* dt = G.DTOT + (size_t)(bh * 16 + j) * 64;
#pragma unroll
      for (int et = 0; et < 2; ++et) {
        const float* sl = G.SLOC + ((size_t)(bh * 16 + j) * 8 + w4 * 2 + et) * 16 * 64 + lane * 16;
#pragma unroll
        for (int i = 0; i < 4; ++i) {
          const f32x4 d4 = *(const f32x4*)(dt + 16 * i + 4 * q);
          const f32x4 s4 = *(const f32x4*)(sl + 4 * i);
          X[et][i][0] = d4.x * X[et][i][0] + s4.x; X[et][i][1] = d4.y * X[et][i][1] + s4.y;
          X[et][i][2] = d4.z * X[et][i][2] + s4.z; X[et][i][3] = d4.w * X[et][i][3] + s4.w;
        }
      }
    }
  }
  f32x4 gain[2];
#pragma unroll
  for (int et = 0; et < 2; ++et) gain[et] = PASS == 1 ? *(const f32x4*)(G.gla_g + hd * 128 + 32 * w4 + 16 * et + 4 * q) : (f32x4){1.f, 1.f, 1.f, 1.f};
  const bf16_t* gvt0 = G.GVT + ((size_t)bh * 128 + 32 * w4 + c16) * GU + 8 * q;
  const bf16_t* gvt1 = gvt0 + (size_t)16 * GU;
  const int soffA = (tid4 >> 3) * GLDS + (tid4 & 7) * 8, soffB = soffA + 32 * GLDS;
  const size_t cb0 = (size_t)bh * 129 * 4096 + (size_t)(tid4 >> 3) * 64 + (tid4 & 7) * 8;
  u32x4 rq[2], rk[2], rkt[2], rq2[2], rk2[2], rkt2[2];
  bf16x8 vfr[2][2], vfn[2][2]; f32x4 dec[4], decn[4];
#define G4_LOADT(rq_, rk_, rkt_, c_) { const size_t cb_ = cb0 + (size_t)(c_) * 4096; \
    rkt_[0] = *(const u32x4*)(G.KTT + cb_); rkt_[1] = *(const u32x4*)(G.KTT + cb_ + 2048); \
    if (PASS == 1) { rq_[0] = *(const u32x4*)(G.QT + cb_); rq_[1] = *(const u32x4*)(G.QT + cb_ + 2048); rk_[0] = *(const u32x4*)(G.KT + cb_); rk_[1] = *(const u32x4*)(G.KT + cb_ + 2048); } }
#define G4_LOADV(vf_, dc_, c_) { vf_[0][0] = *(const bf16x8*)(gvt0 + 64 * (c_)); vf_[0][1] = *(const bf16x8*)(gvt0 + 64 * (c_) + 32); \
    vf_[1][0] = *(const bf16x8*)(gvt1 + 64 * (c_)); vf_[1][1] = *(const bf16x8*)(gvt1 + 64 * (c_) + 32); \
    _Pragma("unroll") for (int i = 0; i < 4; ++i) dc_[i] = *(const f32x4*)(G.DEC + ((size_t)bh * 129 + (c_)) * 64 + 16 * i + 4 * q); }
#define G4_STORET(Bn_, rq_, rk_, rkt_) { *(u32x4*)&Bn_.KT[soffA] = rkt_[0]; *(u32x4*)&Bn_.KT[soffB] = rkt_[1]; \
    if (PASS == 1) { *(u32x4*)&Bn_.Qt[soffA] = rq_[0]; *(u32x4*)&Bn_.Qt[soffB] = rq_[1]; *(u32x4*)&Bn_.Kt[soffA] = rk_[0]; *(u32x4*)&Bn_.Kt[soffB] = rk_[1]; } }
  G4_LOADT(rq, rk, rkt, cbeg)
  G4_LOADV(vfr, dec, cbeg)
  G4_STORET(L.B[0], rq, rk, rkt)
  G4_LOADT(rq, rk, rkt, cbeg + 1)
  G4_LOADV(vfn, decn, cbeg + 1)
  __syncthreads();
  for (int c = cbeg; c < cend; ++c) {
    const int cur = (c - cbeg) & 1;
    const GlaBuf& Bc = L.B[cur];
    const bool more = c + 1 < cend, more2 = c + 2 < cend;
    if (more2) G4_LOADT(rq2, rk2, rkt2, c + 2)
    u32x2 grv[2][4];
    if (PASS == 1 && c >= 1) {
#pragma unroll
      for (int et = 0; et < 2; ++et)
#pragma unroll
        for (int n = 0; n < 4; ++n) grv[et][n] = *(const u32x2*)(G.GR + ((size_t)b * SEQ + 64 * (c - 1) + 16 * n + c16) * 512 + hd * 128 + 32 * w4 + 16 * et + 4 * q);
    }
    f32x4 OT[2][4];
    if (PASS == 1) {
      const int is = w4;
#pragma unroll
      for (int it = 0; it < 4; ++it) {
        f32x4 pa = {0.f, 0.f, 0.f, 0.f};
        if (is <= it) {
#pragma unroll
          for (int kk = 0; kk < 2; ++kk) {
            const bf16x8 ka = *(const bf16x8*)&Bc.Kt[(16 * is + c16) * GLDS + 32 * kk + 8 * q];
            const bf16x8 qb = *(const bf16x8*)&Bc.Qt[(16 * it + c16) * GLDS + 32 * kk + 8 * q];
            pa = MFMA16(ka, qb, pa);
          }
          if (is == it) {
#pragma unroll
            for (int r = 0; r < 4; ++r) if (4 * q + r > c16) pa[r] = 0.f;
          }
        }
        u32x2 pw; pw.x = pk2(pa[0], pa[1]); pw.y = pk2(pa[2], pa[3]);
        *(u32x2*)&L.P[(16 * it + c16) * GLDS + 16 * is + 4 * q] = pw;
      }
#pragma unroll
      for (int et = 0; et < 2; ++et)
#pragma unroll
        for (int n = 0; n < 4; ++n) OT[et][n] = (f32x4){0.f, 0.f, 0.f, 0.f};
#pragma unroll
      for (int kk = 0; kk < 2; ++kk) {
        bf16x8 xa[2];
#pragma unroll
        for (int et = 0; et < 2; ++et) {
          u32x4 xp; xp.x = pk2(X[et][2 * kk][0], X[et][2 * kk][1]); xp.y = pk2(X[et][2 * kk][2], X[et][2 * kk][3]);
          xp.z = pk2(X[et][2 * kk + 1][0], X[et][2 * kk + 1][1]); xp.w = pk2(X[et][2 * kk + 1][2], X[et][2 * kk + 1][3]);
          xa[et] = __builtin_bit_cast(bf16x8, xp);
        }
#pragma unroll
        for (int n = 0; n < 4; ++n) {
          const u32x2 lo = *(const u32x2*)&Bc.Qt[(16 * n + c16) * GLDS + 32 * kk + 4 * q];
          const u32x2 hi = *(const u32x2*)&Bc.Qt[(16 * n + c16) * GLDS + 32 * kk + 16 + 4 * q];
          u32x4 qq; qq.x = lo.x; qq.y = lo.y; qq.z = hi.x; qq.w = hi.y;
          const bf16x8 qf = __builtin_bit_cast(bf16x8, qq);
          OT[0][n] = MFMA16(xa[0], qf, OT[0][n]);
          OT[1][n] = MFMA16(xa[1], qf, OT[1][n]);
        }
      }
      __syncthreads();
#pragma unroll
      for (int kk = 0; kk < 2; ++kk)
#pragma unroll
        for (int n = 0; n < 4; ++n) {
          const bf16x8 pb = *(const bf16x8*)&L.P[(16 * n + c16) * GLDS + 32 * kk + 8 * q];
          OT[0][n] = MFMA16(vfr[0][kk], pb, OT[0][n]);
          OT[1][n] = MFMA16(vfr[1][kk], pb, OT[1][n]);
        }
    }
#pragma unroll
    for (int i = 0; i < 4; ++i) {
#pragma unroll
      for (int kk = 0; kk < 2; ++kk) {
        const bf16x8 ka = *(const bf16x8*)&Bc.KT[(16 * i + c16) * GLDS + 32 * kk + 8 * q];
        X[0][i] = MFMA16(ka, vfr[0][kk], X[0][i]);
        X[1][i] = MFMA16(ka, vfr[1][kk], X[1][i]);
      }
#pragma unroll
      for (int et = 0; et < 2; ++et) { X[et][i][0] *= dec[i].x; X[et][i][1] *= dec[i].y; X[et][i][2] *= dec[i].z; X[et][i][3] *= dec[i].w; }
    }
    if (PASS == 1 && c >= 1) {
      float ss[4];
#pragma unroll
      for (int n = 0; n < 4; ++n) {
        float v = OT[0][n][0] * OT[0][n][0] + OT[0][n][1] * OT[0][n][1] + OT[0][n][2] * OT[0][n][2] + OT[0][n][3] * OT[0][n][3]
                + OT[1][n][0] * OT[1][n][0] + OT[1][n][1] * OT[1][n][1] + OT[1][n][2] * OT[1][n][2] + OT[1][n][3] * OT[1][n][3];
        v += __shfl_xor(v, 16); v += __shfl_xor(v, 32);
        ss[n] = v;
      }
      if (q == 0) {
#pragma unroll
        for (int n = 0; n < 4; ++n) L.ssq[w4][16 * n + c16] = ss[n];
      }
      __syncthreads();
#pragma unroll
      for (int n = 0; n < 4; ++n) {
        const float tot = L.ssq[0][16 * n + c16] + L.ssq[1][16 * n + c16] + L.ssq[2][16 * n + c16] + L.ssq[3][16 * n + c16];
        const float scl = rsqrtf(tot * (1.0f / 128.0f) + EPS);
        const size_t m = (size_t)b * SEQ + 64 * (c - 1) + 16 * n + c16;
#pragma unroll
        for (int et = 0; et < 2; ++et) {
          const float r0 = bflo(grv[et][n].x), r1 = bfhi(grv[et][n].x), r2 = bflo(grv[et][n].y), r3 = bfhi(grv[et][n].y);
          const float o0 = OT[et][n][0] * scl * gain[et].x * r0 * __builtin_amdgcn_rcpf(1.f + __expf(-r0));
          const float o1 = OT[et][n][1] * scl * gain[et].y * r1 * __builtin_amdgcn_rcpf(1.f + __expf(-r1));
          const float o2 = OT[et][n][2] * scl * gain[et].z * r2 * __builtin_amdgcn_rcpf(1.f + __expf(-r2));
          const float o3 = OT[et][n][3] * scl * gain[et].w * r3 * __builtin_amdgcn_rcpf(1.f + __expf(-r3));
          u32x2 ow; ow.x = pk2(o0, o1); ow.y = pk2(o2, o3);
          *(u32x2*)(G.MIX + m * D + 512 + hd * 128 + 32 * w4 + 16 * et + 4 * q) = ow;
        }
      }
    }
    if (more) {
      GlaBuf& Bn = L.B[cur ^ 1];
      G4_STORET(Bn, rq, rk, rkt)
#pragma unroll
      for (int et = 0; et < 2; ++et) { vfr[et][0] = vfn[et][0]; vfr[et][1] = vfn[et][1]; }
#pragma unroll
      for (int i = 0; i < 4; ++i) dec[i] = decn[i];
#pragma unroll
      for (int z = 0; z < 2; ++z) { rkt[z] = rkt2[z]; rq[z] = rq2[z]; rk[z] = rk2[z]; }
      if (more2) G4_LOADV(vfn, decn, c + 2)
    }
    __syncthreads();
  }
#undef G4_LOADT
#undef G4_LOADV
#undef G4_STORET
  if (PASS == 0) {
#pragma unroll
    for (int et = 0; et < 2; ++et) {
      float* sl = G.SLOC + ((size_t)(bh * 16 + sc) * 8 + w4 * 2 + et) * 16 * 64 + lane * 16;
#pragma unroll
      for (int i = 0; i < 4; ++i) *(f32x4*)(sl + 4 * i) = (f32x4){X[et][i][0], X[et][i][1], X[et][i][2], X[et][i][3]};
    }
    if (w4 == 0) {
      float bl = 0.f;
      for (int c = cbeg; c < cend; ++c) bl += G.BL[((size_t)bh * 129 + c) * 64 + lane];
      G.DTOT[(size_t)(bh * 16 + sc) * 64 + lane] = __expf(bl);
    }
  }
}

DI void ce_desc(float& a, float& b) {
  const float hi = __builtin_fmaxf(a, b), lo = __builtin_fminf(a, b);
  a = hi; b = lo;
}
DI float vmaxf(float a, float b) { return __builtin_fmaxf(a, b); }
template <int N> DI void bitonic_sort_desc(float (&v)[N]) {
#pragma unroll
  for (int k = 2; k <= N; k <<= 1) {
#pragma unroll
    for (int j = k >> 1; j > 0; j >>= 1) {
#pragma unroll
      for (int i = 0; i < N; ++i) {
        const int l = i ^ j;
        if (l > i) { if ((i & k) == 0) ce_desc(v[i], v[l]); else ce_desc(v[l], v[i]); }
      }
    }
  }
}
DI void sort16_desc(float (&v)[16]) {
  ce_desc(v[0], v[1]); ce_desc(v[2], v[3]); ce_desc(v[0], v[2]); ce_desc(v[1], v[3]); ce_desc(v[1], v[2]); ce_desc(v[4], v[5]); ce_desc(v[6], v[7]); ce_desc(v[4], v[6]); ce_desc(v[5], v[7]); ce_desc(v[5], v[6]); ce_desc(v[0], v[4]); ce_desc(v[2], v[6]); ce_desc(v[2], v[4]); ce_desc(v[1], v[5]); ce_desc(v[3], v[7]); ce_desc(v[3], v[5]); ce_desc(v[1], v[2]); ce_desc(v[3], v[4]); ce_desc(v[5], v[6]); ce_desc(v[8], v[9]); ce_desc(v[10], v[11]); ce_desc(v[8], v[10]); ce_desc(v[9], v[11]); ce_desc(v[9], v[10]); ce_desc(v[12], v[13]); ce_desc(v[14], v[15]); ce_desc(v[12], v[14]); ce_desc(v[13], v[15]); ce_desc(v[13], v[14]); ce_desc(v[8], v[12]); ce_desc(v[10], v[14]); ce_desc(v[10], v[12]); ce_desc(v[9], v[13]); ce_desc(v[11], v[15]); ce_desc(v[11], v[13]); ce_desc(v[9], v[10]); ce_desc(v[11], v[12]); ce_desc(v[13], v[14]); ce_desc(v[0], v[8]); ce_desc(v[4], v[12]); ce_desc(v[4], v[8]); ce_desc(v[2], v[10]); ce_desc(v[6], v[14]); ce_desc(v[6], v[10]); ce_desc(v[2], v[4]); ce_desc(v[6], v[8]); ce_desc(v[10], v[12]); ce_desc(v[1], v[9]); ce_desc(v[5], v[13]); ce_desc(v[5], v[9]); ce_desc(v[3], v[11]); ce_desc(v[7], v[15]); ce_desc(v[7], v[11]); ce_desc(v[3], v[5]); ce_desc(v[7], v[9]); ce_desc(v[11], v[13]); ce_desc(v[1], v[2]); ce_desc(v[3], v[4]); ce_desc(v[5], v[6]); ce_desc(v[7], v[8]); ce_desc(v[9], v[10]); ce_desc(v[11], v[12]); ce_desc(v[13], v[14]);
}
DI void bitonic_merge16_desc(float (&v)[16]) {
#pragma unroll
  for (int j = 8; j > 0; j >>= 1) {
#pragma unroll
    for (int i = 0; i < 16; ++i) { const int l = i ^ j; if (l > i) ce_desc(v[i], v[l]); }
  }
}
template <int NBV> DI void merge_prune16(float (&a)[16], const float (&b)[16]) {
#pragma unroll
  for (int i = 16 - NBV; i < 16; ++i) a[i] = vmaxf(a[i], b[15 - i]);
  bitonic_merge16_desc(a);
}
DI float selh(int hh, float a, float b) { asm volatile("" : "+v"(a), "+v"(b)); return hh == 0 ? a : b; }
DI float pack_idx(float v, unsigned idx, unsigned mask) { return __uint_as_float((__float_as_uint(v) & ~mask) | idx); }

DI void route_stage_keys(int hd, char* smem, const bf16_t* __restrict__ SK1b, const bf16_t* __restrict__ SK2b) {
  const int tid256_ = fresh_tid() & 255;
  bf16_t* kl = (bf16_t*)smem;
#pragma unroll
  for (int i = 0; i < 8; ++i) {
    const int pz = TID + 256 * i, L = pz >> 10, row = (pz >> 3) & 127, c8 = pz & 7;
    const bf16_t* src = (L == 0 ? SK1b : SK2b) + (size_t)(hd * 128 + row) * 64 + c8 * 8;
    *(u32x4*)&kl[(L * 128 + row) * 72 + c8 * 8] = *(const u32x4*)src;
  }
  __syncthreads();
}
DI void route_load_q(bf16x8 (&qf)[2][4], const bf16_t* __restrict__ QP, int m, int hd, int hh) {
#pragma unroll
  for (int L = 0; L < 2; ++L)
#pragma unroll
    for (int ks = 0; ks < 4; ++ks) qf[L][ks] = *(const bf16x8*)(QP + (size_t)m * D + hd * 128 + L * 64 + hh * 8 + ks * 16);
}
DI void ph_route_v2(int vb, char* smem, const bf16x8 (&qf)[2][4], unsigned short* __restrict__ EIDX, float* __restrict__ GATE) {
  const int tid256_ = fresh_tid() & 255;
  const int lane = TID & 63, wave = TID >> 6, r = lane & 31, hh = lane >> 5;
  const int hd = vb & 7, tile = vb >> 3;
  const int m = tile * 128 + wave * 32 + r;
  const bf16_t* kl = (const bf16_t*)smem;
  float loc[2][16];
#pragma unroll
  for (int L = 0; L < 2; ++L) {
    float grp[4][16];
#pragma unroll
    for (int mt = 0; mt < 4; ++mt) {
      f32x16 acc;
#pragma unroll
      for (int e = 0; e < 16; ++e) acc[e] = 0.f;
#pragma unroll
      for (int ks = 0; ks < 4; ++ks) {
        const bf16x8 kf = *(const bf16x8*)&kl[(L * 128 + mt * 32 + r) * 72 + ks * 16 + hh * 8];
        acc = MFMA32(kf, qf[L][ks], acc);
      }
#pragma unroll
      for (int e = 0; e < 16; ++e) grp[mt][e] = pack_idx(acc[e], (unsigned)(mt * 32 + crow(e, hh)), 127u);
      sort16_desc(grp[mt]);
    }
    merge_prune16<16>(grp[0], grp[1]);
    merge_prune16<16>(grp[2], grp[3]);
    merge_prune16<16>(grp[0], grp[2]);
#pragma unroll
    for (int i = 0; i < 16; ++i) loc[L][i] = grp[0][i];
  }
  float fin[16], oth[16];
#pragma unroll
  for (int i = 0; i < 16; ++i) {
    const float send = selh(hh, loc[1][i], loc[0][i]);
    oth[i] = __shfl_xor(send, 32);
    fin[i] = selh(hh, loc[0][i], loc[1][i]);
  }
  merge_prune16<16>(fin, oth);
  float v1[16], v2[16];
#pragma unroll
  for (int i = 0; i < 16; ++i) {
    const float o = __shfl_xor(fin[i], 32);
    v1[i] = selh(hh, fin[i], o);
    v2[i] = selh(hh, o, fin[i]);
  }
  unsigned* ib = (unsigned*)(smem + 36864) + (size_t)TID * 8;
#pragma unroll
  for (int q = 0; q < 4; ++q) {
    unsigned w1 = 0, w2 = 0;
#pragma unroll
    for (int j = 0; j < 4; ++j) {
      w1 |= (__float_as_uint(v1[4 * q + j]) & 127u) << (8 * j);
      w2 |= (__float_as_uint(v2[4 * q + j]) & 127u) << (8 * j);
    }
    ib[q] = w1; ib[4 + q] = w2;
  }
  float R[16], Bv[16];
#pragma unroll
  for (int j = 0; j < 16; ++j) R[j] = pack_idx(v1[0] + v2[j], (unsigned)j, 255u);
#define ROUTE_ROW(I, CNT) { _Pragma("unroll") for (int j = 0; j < 16; ++j) Bv[j] = (j < CNT) ? pack_idx(v1[I] + v2[j < CNT ? j : 0], (unsigned)(I * 16 + j), 255u) : 0.f; \
    merge_prune16<CNT>(R, Bv); }
  ROUTE_ROW(1, 8) ROUTE_ROW(2, 5) ROUTE_ROW(3, 4) ROUTE_ROW(4, 3) ROUTE_ROW(5, 2) ROUTE_ROW(6, 2) ROUTE_ROW(7, 2)
#undef ROUTE_ROW
#pragma unroll
  for (int j = 0; j < 16; ++j) Bv[j] = (j < 8) ? pack_idx(v1[8 + (j < 8 ? j : 0)] + v2[0], (unsigned)((8 + j) * 16), 255u) : 0.f;
  merge_prune16<8>(R, Bv);
  float ex[16], sum = 0.f;
#pragma unroll
  for (int i = 0; i < 16; ++i) { ex[i] = __expf(R[i] - R[0]); sum += ex[i]; }
  const float inv = 1.f / sum;
  const unsigned char* ibb = (const unsigned char*)ib;
  int eo[8]; float go[8];
#pragma unroll
  for (int w = 0; w < 8; ++w) {
    const float rv = selh(hh, R[w], R[8 + w]);
    const float ev = selh(hh, ex[w], ex[8 + w]);
    const unsigned pos = __float_as_uint(rv) & 255u;
    const unsigned i1 = ibb[pos >> 4], i2 = ibb[16 + (pos & 15u)];
    eo[w] = (int)(i1 * 128u + i2);
    go[w] = ev * inv;
  }
  unsigned short* ep = EIDX + (size_t)m * 128 + hd * 16 + hh * 8;
  float* gp = GATE + (size_t)m * 128 + hd * 16 + hh * 8;
  *(u32x4*)ep = (u32x4){(unsigned)eo[0] | ((unsigned)eo[1] << 16), (unsigned)eo[2] | ((unsigned)eo[3] << 16), (unsigned)eo[4] | ((unsigned)eo[5] << 16), (unsigned)eo[6] | ((unsigned)eo[7] << 16)};
  *(f32x4*)gp = (f32x4){go[0], go[1], go[2], go[3]};
  *(f32x4*)(gp + 4) = (f32x4){go[4], go[5], go[6], go[7]};
}


constexpr size_t WS_SCU = 14 * MiB;
constexpr size_t WS_SCV = 14 * MiB + 65536;
DI float wave_max(float v) {
#pragma unroll
  for (int o = 32; o >= 1; o >>= 1) v = fmaxf(v, __shfl_xor(v, o));
  return v;
}
DI u32x4 quant_row16(const float* __restrict__ rowp, int lane, float& sc) {
  const f32x4* rp = (const f32x4*)(rowp + lane * 16);
  const f32x4 a = __builtin_nontemporal_load(rp), b = __builtin_nontemporal_load(rp + 1), c = __builtin_nontemporal_load(rp + 2), d = __builtin_nontemporal_load(rp + 3);
  float m = fmaxf(fmaxf(fmaxf(fabsf(a.x), fabsf(a.y)), fmaxf(fabsf(a.z), fabsf(a.w))), fmaxf(fmaxf(fabsf(b.x), fabsf(b.y)), fmaxf(fabsf(b.z), fabsf(b.w))));
  m = fmaxf(m, fmaxf(fmaxf(fmaxf(fabsf(c.x), fabsf(c.y)), fmaxf(fabsf(c.z), fabsf(c.w))), fmaxf(fmaxf(fabsf(d.x), fabsf(d.y)), fmaxf(fabsf(d.z), fabsf(d.w)))));
  m = wave_max(m);
  sc = m > 0.f ? m * (1.0f / 448.0f) : 1.0f;
  const float inv = 1.0f / sc;
  u32x4 o; unsigned w;
  w = 0; w = __builtin_amdgcn_cvt_pk_fp8_f32(a.x * inv, a.y * inv, w, false); w = __builtin_amdgcn_cvt_pk_fp8_f32(a.z * inv, a.w * inv, w, true); o.x = w;
  w = 0; w = __builtin_amdgcn_cvt_pk_fp8_f32(b.x * inv, b.y * inv, w, false); w = __builtin_amdgcn_cvt_pk_fp8_f32(b.z * inv, b.w * inv, w, true); o.y = w;
  w = 0; w = __builtin_amdgcn_cvt_pk_fp8_f32(c.x * inv, c.y * inv, w, false); w = __builtin_amdgcn_cvt_pk_fp8_f32(c.z * inv, c.w * inv, w, true); o.z = w;
  w = 0; w = __builtin_amdgcn_cvt_pk_fp8_f32(d.x * inv, d.y * inv, w, false); w = __builtin_amdgcn_cvt_pk_fp8_f32(d.z * inv, d.w * inv, w, true); o.w = w;
  return o;
}
DI void ph_convert_ev8(int vb, char* smem, const float* __restrict__ src, u8_t* __restrict__ EV8c, float* __restrict__ scaleV) {
  const int tid256_ = fresh_tid() & 255;
  u8_t (*t)[1040] = (u8_t (*)[1040])smem;
  const int lane = TID & 63, wave = TID >> 6, e0 = vb * 32;
  for (int rr = 0; rr < 8; ++rr) {
    const int r = wave * 8 + rr;
    float sc;
    const u32x4 o = quant_row16(src + (size_t)(e0 + r) * D, lane, sc);
    *(u32x4*)&t[r][lane * 16] = o;
    if (lane == 0) scaleV[e0 + r] = sc;
  }
  __syncthreads();
  const int r = TID & 31, cs = TID >> 5;
  for (int c0 = 0; c0 < 128; c0 += 8) {
    const int cg = c0 + cs;
    const u32x2 v = *(const u32x2*)&t[r][cg * 8];
    *(u32x2*)(EV8c + ((size_t)cg * NEXP + e0 + r) * 8) = v;
  }
  __syncthreads();
}
struct PeerUHalf { u32x4 u[8]; };
DI float gelu_as(float v) {
  const float av = fabsf(v);
  const float t = __builtin_amdgcn_rcpf(av * 0.2316418882f + 1.0f);
  float q = t * 0.5307027145f + (-0.7265760135f); q = q * t + 0.7107068705f; q = q * t + (-0.142248368f); q = q * t + 0.127414796f; q = q * t;
  const float e = __builtin_amdgcn_exp2f((v * v) * (-0.72134752044f));
  const float m = v * (q * e);
  return v < 0.f ? m : v - m;
}
DI void pc_stage_scales(char* smem, const float* __restrict__ scaleU, const float* __restrict__ scaleV) {
  unsigned* sc = (unsigned*)(smem + 34816);
  const int tid = fresh_tid();
#pragma unroll 4
  for (int i = tid; i < NEXP; i += 512) sc[i] = f2bf(scaleU[i]) | (f2bf(scaleV[i]) << 16);
  __syncthreads();
}
DI void ph_peer_c8(int unit, char* smem, const bf16_t* __restrict__ PP, const unsigned short* __restrict__ EIDX, const float* __restrict__ GATE,
                   const float* __restrict__ SSQ, unsigned* __restrict__ STREAM) {
  unsigned (*tile)[132] = (unsigned (*)[132])smem;
  const unsigned* sc = (const unsigned*)(smem + 34816);
  const int tid = fresh_tid();
  const int tl = tid >> 3, kc = tid & 7;
  const size_t rowoff = ((size_t)unit * 64 + tl) * 128 + kc * 16;
  const size_t n = (size_t)TREAL * 128;
  const int tok = unit * 64 + tl;
  const float r2 = rsqrtf(((SSQ[tok] + SSQ[TREAL + tok]) + (SSQ[2 * TREAL + tok] + SSQ[3 * TREAL + tok])) * (1.0f / D) + EPS);
  float a[16];
#pragma unroll
  for (int j = 0; j < 16; ++j) a[j] = 0.f;
#pragma unroll
  for (int s = 0; s < 8; ++s) {
    const u32x4 p0 = *(const u32x4*)(PP + (size_t)s * n + rowoff), p1 = *(const u32x4*)(PP + (size_t)s * n + rowoff + 8);
    a[0] += bflo(p0.x); a[1] += bfhi(p0.x); a[2] += bflo(p0.y); a[3] += bfhi(p0.y); a[4] += bflo(p0.z); a[5] += bfhi(p0.z); a[6] += bflo(p0.w); a[7] += bfhi(p0.w);
    a[8] += bflo(p1.x); a[9] += bfhi(p1.x); a[10] += bflo(p1.y); a[11] += bfhi(p1.y); a[12] += bflo(p1.z); a[13] += bfhi(p1.z); a[14] += bflo(p1.w); a[15] += bfhi(p1.w);
  }
  const u32x4 e0 = *(const u32x4*)(EIDX + rowoff), e1 = *(const u32x4*)(EIDX + rowoff + 8);
  unsigned ev[16] = {e0.x & 0xffffu, e0.x >> 16, e0.y & 0xffffu, e0.y >> 16, e0.z & 0xffffu, e0.z >> 16, e0.w & 0xffffu, e0.w >> 16,
                     e1.x & 0xffffu, e1.x >> 16, e1.y & 0xffffu, e1.y >> 16, e1.z & 0xffffu, e1.z >> 16, e1.w & 0xffffu, e1.w >> 16};
  float gt[16];
#pragma unroll
  for (int j = 0; j < 4; ++j) { const f32x4 g4 = *(const f32x4*)(GATE + rowoff + 4 * j); gt[4 * j] = g4.x; gt[4 * j + 1] = g4.y; gt[4 * j + 2] = g4.z; gt[4 * j + 3] = g4.w; }
#pragma unroll
  for (int j = 0; j < 16; ++j) {
    const unsigned e = ev[j];
    const unsigned sw = sc[e];
    const float av = a[j] * (r2 * bflo(sw));
    const float act = gelu_as(av);
    const float c = gt[j] * act * bfhi(sw);
    tile[tl][kc * 16 + j] = e | (f2bf(c) << 16);
  }
  __syncthreads();
  unsigned* outp = STREAM + (size_t)unit * 8192;
#pragma unroll
  for (int j = 0; j < 4; ++j) {
    const int o4 = tid + 512 * j, q = o4 >> 6, t2 = o4 & 63;
    *(u32x4*)(outp + 4 * o4) = *(const u32x4*)&tile[t2][4 * q];
  }
  __syncthreads();
}
struct PVW { u32x4 a, b; };
struct PVT { u32x2 v[8]; };
DI void pv_loadw(PVW& W, const unsigned* __restrict__ STREAM, int it, int g, int lane) {
  const u32x4* sp = (const u32x4*)(STREAM + (size_t)it * 8192) + lane;
  W.a = sp[(2 * g) * 64]; W.b = sp[(2 * g + 1) * 64];
}
DI void pv_readt(PVT& T, const PVW& W, const u32x2* tabl) {
  T.v[0] = tabl[W.a.x & 0xffffu]; T.v[1] = tabl[W.a.y & 0xffffu]; T.v[2] = tabl[W.a.z & 0xffffu]; T.v[3] = tabl[W.a.w & 0xffffu];
  T.v[4] = tabl[W.b.x & 0xffffu]; T.v[5] = tabl[W.b.y & 0xffffu]; T.v[6] = tabl[W.b.z & 0xffffu]; T.v[7] = tabl[W.b.w & 0xffffu];
}
DI void pv_fma1(unsigned w, const u32x2 v, f32x2 (&y)[4]) {
  const float c = bfhi(w);
  const f32x2 cc = {c, c};
  y[0] = __builtin_elementwise_fma(__builtin_amdgcn_cvt_pk_f32_fp8(v.x, false), cc, y[0]);
  y[1] = __builtin_elementwise_fma(__builtin_amdgcn_cvt_pk_f32_fp8(v.x, true), cc, y[1]);
  y[2] = __builtin_elementwise_fma(__builtin_amdgcn_cvt_pk_f32_fp8(v.y, false), cc, y[2]);
  y[3] = __builtin_elementwise_fma(__builtin_amdgcn_cvt_pk_f32_fp8(v.y, true), cc, y[3]);
}
DI void pv_fma(const PVW& W, const PVT& T, f32x2 (&y)[4]) {
  pv_fma1(W.a.x, T.v[0], y); pv_fma1(W.a.y, T.v[1], y); pv_fma1(W.a.z, T.v[2], y); pv_fma1(W.a.w, T.v[3], y);
  pv_fma1(W.b.x, T.v[4], y); pv_fma1(W.b.y, T.v[5], y); pv_fma1(W.b.z, T.v[6], y); pv_fma1(W.b.w, T.v[7], y);
}
DI void pv_load_table(char* smem, const u8_t* __restrict__ EV8c, int cg) {
  const int tid = fresh_tid();
  const u32x4* src = (const u32x4*)(EV8c + (size_t)cg * NEXP * 8);
#pragma unroll 4
  for (int i = tid; i < NEXP * 8 / 16; i += 512) ((u32x4*)smem)[i] = src[i];
  __syncthreads();
}
DI void pv_process(const char* smem, const unsigned* __restrict__ STREAM, bf16_t* __restrict__ YT, int cg, int it0, int it_end, int step) {
  const int lane = fresh_tid() & 63;
  const u32x2* tabl = (const u32x2*)smem;
  int it = it0;
  if (it >= it_end) return;
  PVW W0, W1, W2, W3; PVT T0, T1;
  pv_loadw(W0, STREAM, it, 0, lane); pv_loadw(W1, STREAM, it, 1, lane);
  pv_readt(T0, W0, tabl);
  for (; it < it_end; it += step) {
    const int itn = (it + step < it_end) ? it + step : it;
    f32x2 y[4];
#pragma unroll
    for (int z = 0; z < 4; ++z) y[z] = (f32x2){0.f, 0.f};
#define PV_STEP(g, Wld, Wrd, Trd, Wc, Tc) \
    pv_loadw(Wld, STREAM, ((g) + 2 < 16) ? it : itn, ((g) + 2) & 15, lane); \
    pv_readt(Trd, Wrd, tabl); \
    pv_fma(Wc, Tc, y); \
    asm volatile("" ::: "memory");
    PV_STEP(0, W2, W1, T1, W0, T0)  PV_STEP(1, W3, W2, T0, W1, T1)  PV_STEP(2, W0, W3, T1, W2, T0)  PV_STEP(3, W1, W0, T0, W3, T1)
    PV_STEP(4, W2, W1, T1, W0, T0)  PV_STEP(5, W3, W2, T0, W1, T1)  PV_STEP(6, W0, W3, T1, W2, T0)  PV_STEP(7, W1, W0, T0, W3, T1)
    PV_STEP(8, W2, W1, T1, W0, T0)  PV_STEP(9, W3, W2, T0, W1, T1)  PV_STEP(10, W0, W3, T1, W2, T0) PV_STEP(11, W1, W0, T0, W3, T1)
    PV_STEP(12, W2, W1, T1, W0, T0) PV_STEP(13, W3, W2, T0, W1, T1) PV_STEP(14, W0, W3, T1, W2, T0) PV_STEP(15, W1, W0, T0, W3, T1)
#undef PV_STEP
    const int t = it * 64 + lane;
    u32x4 yw; yw.x = pk2(y[0].x, y[0].y); yw.y = pk2(y[1].x, y[1].y); yw.z = pk2(y[2].x, y[2].y); yw.w = pk2(y[3].x, y[3].y);
    __builtin_nontemporal_store(yw, (u32x4*)(YT + ((size_t)cg * TREAL + t) * 8));
  }
}
DI void ph_peer_v8(char* smem, const unsigned* __restrict__ STREAM, const u8_t* __restrict__ EV8c, bf16_t* __restrict__ YT, int itb, int nit) {
  const int wave = __builtin_amdgcn_readfirstlane((int)(threadIdx.x >> 6));
  for (int unit = blockIdx.x; unit < 256; unit += gridDim.x) {
    const int cg = unit & 127, th = unit >> 7;
    pv_load_table(smem, EV8c, cg);
    pv_process(smem, STREAM, YT, cg, itb + th * (nit / 2) + wave, itb + (th + 1) * (nit / 2), 8);
    __syncthreads();
  }
}


DI void ph_final_lds(int unit, char* smem, const bf16_t* __restrict__ H1, const bf16_t* __restrict__ YT, const float* __restrict__ gf, float* __restrict__ out) {
  float (*h2)[1028] = (float (*)[1028])smem;
  const int tid = fresh_tid(), lane = tid & 63, wave = tid >> 6;
  const int t0 = unit * 32;
#pragma unroll
  for (int rr = 0; rr < 4; ++rr) {
    const int r = wave * 4 + rr;
    const bf16_t* hp = H1 + (size_t)(t0 + r) * D;
#pragma unroll
    for (int j = 0; j < 2; ++j) {
      const u32x4 hw = *(const u32x4*)(hp + j * 512 + lane * 8);
      *(f32x4*)&h2[r][j * 512 + lane * 8] = (f32x4){bflo(hw.x), bfhi(hw.x), bflo(hw.y), bfhi(hw.y)};
      *(f32x4*)&h2[r][j * 512 + lane * 8 + 4] = (f32x4){bflo(hw.z), bfhi(hw.z), bflo(hw.w), bfhi(hw.w)};
    }
  }
  __syncthreads();
  {
    const int tok = lane & 31;
#pragma unroll 4
    for (int cg = wave * 2 + (lane >> 5); cg < 128; cg += 16) {
      const u32x4 yw = *(const u32x4*)(YT + ((size_t)cg * TREAL + t0 + tok) * 8);
      f32x4* hp = (f32x4*)&h2[tok][cg * 8];
      f32x4 a = hp[0], b4 = hp[1];
      a.x += bflo(yw.x); a.y += bfhi(yw.x); a.z += bflo(yw.y); a.w += bfhi(yw.y);
      b4.x += bflo(yw.z); b4.y += bfhi(yw.z); b4.z += bflo(yw.w); b4.w += bfhi(yw.w);
      hp[0] = a; hp[1] = b4;
    }
  }
  __syncthreads();
#pragma unroll
  for (int rr = 0; rr < 4; ++rr) {
    const int r = wave * 4 + rr;
    f32x4 v[4]; float ss = 0.f;
#pragma unroll
    for (int j = 0; j < 4; ++j) { v[j] = *(const f32x4*)&h2[r][j * 256 + lane * 4]; ss += v[j].x * v[j].x + v[j].y * v[j].y + v[j].z * v[j].z + v[j].w * v[j].w; }
    ss = wave_sum(ss);
    const float sc = rsqrtf(ss * (1.0f / D) + EPS);
    float* op = out + (size_t)(t0 + r) * D;
#pragma unroll
    for (int j = 0; j < 4; ++j) {
      const f32x4 gg = *(const f32x4*)(gf + j * 256 + lane * 4);
      *(f32x4*)(op + j * 256 + lane * 4) = (f32x4){v[j].x * sc * gg.x, v[j].y * sc * gg.y, v[j].z * sc * gg.z, v[j].w * sc * gg.w};
    }
  }
  __syncthreads();
}

typedef int i32x4 __attribute__((ext_vector_type(4)));
constexpr size_t WS_XQ = 861 * MiB;
constexpr size_t WS_XS = 943 * MiB;
DI unsigned pack_i8x4(float a, float b, float c, float d) {
  const int ia = __float2int_rn(a), ib = __float2int_rn(b), ic = __float2int_rn(c), id = __float2int_rn(d);
  return ((unsigned)ia & 255u) | (((unsigned)ib & 255u) << 8) | (((unsigned)ic & 255u) << 16) | ((unsigned)id << 24);
}
DI u32x4 quant_row16_i8(const float* __restrict__ rowp, const f32x4 (&g)[4], int lane, float& sc) {
  const f32x4* rp = (const f32x4*)(rowp + lane * 16);
  const f32x4 a = __builtin_nontemporal_load(rp) * g[0], b = __builtin_nontemporal_load(rp + 1) * g[1], c = __builtin_nontemporal_load(rp + 2) * g[2], d = __builtin_nontemporal_load(rp + 3) * g[3];
  float m = fmaxf(fmaxf(fmaxf(fabsf(a.x), fabsf(a.y)), fmaxf(fabsf(a.z), fabsf(a.w))), fmaxf(fmaxf(fabsf(b.x), fabsf(b.y)), fmaxf(fabsf(b.z), fabsf(b.w))));
  m = fmaxf(m, fmaxf(fmaxf(fmaxf(fabsf(c.x), fabsf(c.y)), fmaxf(fabsf(c.z), fabsf(c.w))), fmaxf(fmaxf(fabsf(d.x), fabsf(d.y)), fmaxf(fabsf(d.z), fabsf(d.w)))));
  m = wave_max(m);
  sc = m > 0.f ? m * (1.0f / 127.0f) : 1.0f;
  const float inv = 1.0f / sc;
  u32x4 o;
  o.x = pack_i8x4(a.x * inv, a.y * inv, a.z * inv, a.w * inv); o.y = pack_i8x4(b.x * inv, b.y * inv, b.z * inv, b.w * inv);
  o.z = pack_i8x4(c.x * inv, c.y * inv, c.z * inv, c.w * inv); o.w = pack_i8x4(d.x * inv, d.y * inv, d.z * inv, d.w * inv);
  return o;
}
DI void ph_convert_eu_i8(const float* __restrict__ src, const float* __restrict__ gain, u8_t* __restrict__ EUq, float* __restrict__ scaleU) {
  const int tid = fresh_tid(), lane = tid & 63, wave = tid >> 6;
  f32x4 g[4];
#pragma unroll
  for (int j = 0; j < 4; ++j) g[j] = *(const f32x4*)(gain + lane * 16 + 4 * j);
  for (int e = (blockIdx.x * 8 + wave) * 2; e < NEXP; e += gridDim.x * 16) {
    float sc0, sc1 = 1.f;
    const bool two = e + 1 < NEXP;
    const u32x4 o0 = quant_row16_i8(src + (size_t)e * D, g, lane, sc0);
    u32x4 o1 = o0;
    if (two) o1 = quant_row16_i8(src + (size_t)(e + 1) * D, g, lane, sc1);
    *(u32x4*)(EUq + ((size_t)(lane >> 3) * NEXP + e) * 128 + (lane & 7) * 16) = o0;
    if (two) *(u32x4*)(EUq + ((size_t)(lane >> 3) * NEXP + e + 1) * 128 + (lane & 7) * 16) = o1;
    if (lane == 0) { scaleU[e] = sc0; if (two) scaleU[e + 1] = sc1; }
  }
}
DI int dpp_i(int v, const int sel) {
  if (sel == 0) return __builtin_amdgcn_update_dpp(0, v, 0xB1, 0xF, 0xF, true);
  if (sel == 1) return __builtin_amdgcn_update_dpp(0, v, 0x4E, 0xF, 0xF, true);
  return __builtin_amdgcn_update_dpp(0, v, 0x141, 0xF, 0xF, true);
}
DI int dpp_isum8(int v) { v += dpp_i(v, 0); v += dpp_i(v, 1); v += dpp_i(v, 2); return v; }
template <int HF> DI void peer_ud4_issue(PeerUHalf& H, unsigned idxpair, int lane, const u8_t* __restrict__ tab) {
#pragma unroll
  for (int jj = 0; jj < 8; ++jj) {
    const int j = 8 * HF + jj;
    const unsigned w = (unsigned)__shfl((int)idxpair, (lane & ~7) + (j >> 1));
    const unsigned e = (j & 1) ? (w >> 16) : (w & 0xffffu);
    H.u[jj] = *(const u32x4*)(tab + (size_t)e * 128);
  }
}
template <int HF> DI void peer_ud4_compute(const PeerUHalf& H, const u32x4 xq, int sub, int& res0, int& res1) {
#pragma unroll
  for (int jj = 0; jj < 8; ++jj) {
    const int j = 8 * HF + jj;
    int acc = 0;
    acc = __builtin_amdgcn_sdot4((int)H.u[jj].x, (int)xq.x, acc, false); acc = __builtin_amdgcn_sdot4((int)H.u[jj].y, (int)xq.y, acc, false);
    acc = __builtin_amdgcn_sdot4((int)H.u[jj].z, (int)xq.z, acc, false); acc = __builtin_amdgcn_sdot4((int)H.u[jj].w, (int)xq.w, acc, false);
    acc = dpp_isum8(acc);
    if (sub == (j >> 1)) { if (j & 1) res1 = acc; else res0 = acc; }
  }
}
DI void ph_peer_u_d4(int xi, int nx, int wv, int nwv, int tbeg, int tend, const u8_t* __restrict__ XQ, const float* __restrict__ XS, const u8_t* __restrict__ EUq,
                     const unsigned short* __restrict__ EIDX, bf16_t* __restrict__ PP) {
  const int lane = fresh_tid() & 63, sub = lane & 7;
  const int ntok = (tend - tbeg - wv + nwv - 1) / nwv;
  if (ntok <= 0) return;
#define PU_TOK(i) (tbeg + wv + ((i) < ntok ? (i) : ntok - 1) * nwv)
#define PU_IDX(t) (*((const unsigned*)(EIDX + (size_t)(t) * 128) + lane))
#define PU_LDX(xq_, xs_, t) { xq_ = *(const u32x4*)(xbase + (size_t)(t) * D); xs_ = XS[(size_t)(t) * 8 + s]; }
#define PU_STORE(t, r0, r1, xs_) *((unsigned*)(pp + (size_t)(t) * 128) + lane) = pk2((float)(r0) * (xs_), (float)(r1) * (xs_))
  for (int s = xi; s < 8; s += nx) {
    const u8_t* tab = EUq + (size_t)s * NEXP * 128 + sub * 16;
    const u8_t* xbase = XQ + s * 128 + sub * 16;
    bf16_t* pp = PP + (size_t)s * TREAL * 128;
    PeerUHalf HA, HB, HC;
    int ta = PU_TOK(0), tb = PU_TOK(1), tc = PU_TOK(2);
    unsigned ia = PU_IDX(ta), ib = PU_IDX(tb), ic = PU_IDX(tc);
    u32x4 xqa; float xsa; PU_LDX(xqa, xsa, ta);
    peer_ud4_issue<0>(HA, ia, lane, tab);
    peer_ud4_issue<1>(HB, ia, lane, tab);
    for (int i = 0; i < ntok; i += 3) {
      const int td = PU_TOK(i + 3), te = PU_TOK(i + 4), tf = PU_TOK(i + 5);
      u32x4 xqb, xqc, xqd; float xsb, xsc, xsd;
      int r0, r1;
      peer_ud4_issue<0>(HC, ib, lane, tab); PU_LDX(xqb, xsb, tb); const unsigned id = PU_IDX(td);
      r0 = 0; r1 = 0;
      peer_ud4_compute<0>(HA, xqa, sub, r0, r1);
      peer_ud4_issue<1>(HA, ib, lane, tab);
      peer_ud4_compute<1>(HB, xqa, sub, r0, r1);
      PU_STORE(ta, r0, r1, xsa);
      peer_ud4_issue<0>(HB, ic, lane, tab); PU_LDX(xqc, xsc, tc); const unsigned ie = PU_IDX(te);
      r0 = 0; r1 = 0;
      peer_ud4_compute<0>(HC, xqb, sub, r0, r1);
      peer_ud4_issue<1>(HC, ic, lane, tab);
      peer_ud4_compute<1>(HA, xqb, sub, r0, r1);
      PU_STORE(tb, r0, r1, xsb);
      peer_ud4_issue<0>(HA, id, lane, tab); PU_LDX(xqd, xsd, td); const unsigned if_ = PU_IDX(tf);
      r0 = 0; r1 = 0;
      peer_ud4_compute<0>(HB, xqc, sub, r0, r1);
      peer_ud4_issue<1>(HB, id, lane, tab);
      peer_ud4_compute<1>(HC, xqc, sub, r0, r1);
      PU_STORE(tc, r0, r1, xsc);
      ta = td; tb = te; tc = tf; ib = ie; ic = if_; xqa = xqd; xsa = xsd;
    }
  }
#undef PU_TOK
#undef PU_IDX
#undef PU_LDX
#undef PU_STORE
}

struct PUI { i32x4 a[8]; };
struct PUE { int e[8]; };

#define XB_TMO      128
#define XB_XCNT(j)  (256  + 64 * (j))
#define XB_XSUB(j)  (1280 + 64 * (j))
#define XB_XGEN(j)  (2304 + 64 * (j))
#define XB_TOP      3328
#define XB_TOPGEN   3392
#define XCD_BAR_WORDS 3456
#define XB_SPIN_CAP (1u << 20)
#define LAS __attribute__((address_space(3)))
DI unsigned xb_ld(unsigned* p)              { return __hip_atomic_load(p, __ATOMIC_RELAXED, __HIP_MEMORY_SCOPE_AGENT); }
DI unsigned xb_add(unsigned* p, unsigned v) { return __hip_atomic_fetch_add(p, v, __ATOMIC_RELAXED, __HIP_MEMORY_SCOPE_AGENT); }
DI unsigned xb_xcc_id() { return (unsigned)__builtin_amdgcn_s_getreg((3 << 11) | 20) & 0xFu; }
#define XB_SPIN(cond, bar) do { unsigned _sp = 0; while (cond) { __builtin_amdgcn_s_sleep(1); \
    if ((++_sp & 255u) == 0u) { if (xb_ld(&(bar)[XB_TMO])) break; if (_sp > XB_SPIN_CAP) { atomicAdd(&(bar)[XB_TMO], 1u); break; } } } } while (0)
struct XcdBarrier { unsigned* bar; unsigned x; volatile unsigned* st; };
DI XcdBarrier xcd_barrier_post(unsigned* bar, volatile unsigned* st) {
  XcdBarrier b; b.bar = bar; b.x = xb_xcc_id(); b.st = st;
  if (threadIdx.x == 0) (void)xb_add(&bar[XB_XCNT(b.x)], 1u);
  return b;
}
DI void xcd_barrier_complete(unsigned* bar, unsigned x, unsigned& nloc, unsigned& nx) {
  const unsigned G = gridDim.x;
  unsigned sum, cnt, mine, sp = 0u;
  for (;;) {
    sum = 0u; cnt = 0u; mine = 0u;
#pragma unroll
    for (unsigned j = 0; j < 16; ++j) { const unsigned c = xb_ld(&bar[XB_XCNT(j)]); sum += c; cnt += (c > 0u) ? 1u : 0u; mine = (j == x) ? c : mine; }
    if (sum == G) break;
    __builtin_amdgcn_s_sleep(1);
    if ((++sp & 255u) == 0u) { if (xb_ld(&bar[XB_TMO])) break; if (sp > XB_SPIN_CAP) { atomicAdd(&bar[XB_TMO], 1u); break; } }
  }
  nloc = mine > 0u ? mine : 1u; nx = cnt > 0u ? cnt : 1u;
}
DI void xcd_barrier(const XcdBarrier& b) {
  asm volatile("s_waitcnt vmcnt(0)" ::: "memory");
  __syncthreads();
  if (threadIdx.x == 0) {
    unsigned* bar = b.bar;
    __builtin_amdgcn_s_waitcnt(0);
    unsigned nloc = b.st[0], nx = b.st[1];
    if (nloc == 0u) { xcd_barrier_complete(bar, b.x, nloc, nx); b.st[0] = nloc; b.st[1] = nx; }
    const unsigned old = xb_add(&bar[XB_XSUB(b.x)], 1u);
    const unsigned gen = old / nloc;
    if (old + 1u == (gen + 1u) * nloc) {
      __builtin_amdgcn_fence(__ATOMIC_RELEASE, "agent");
      asm volatile("s_waitcnt vmcnt(0)" ::: "memory");
      const unsigned og = xb_add(&bar[XB_TOP], 1u);
      asm volatile("buffer_inv sc1" ::: "memory");
      const unsigned tg = og / nx;
      if (og + 1u == (tg + 1u) * nx) xb_add(&bar[XB_TOPGEN], 1u);
      else XB_SPIN(xb_ld(&bar[XB_TOPGEN]) == tg, bar);
      xb_add(&bar[XB_XGEN(b.x)], 1u);
      asm volatile("s_waitcnt vmcnt(0)" ::: "memory");
    } else {
      asm volatile("buffer_inv sc1" ::: "memory");
      XB_SPIN(xb_ld(&bar[XB_XGEN(b.x)]) == gen, bar);
      asm volatile("s_waitcnt vmcnt(0)" ::: "memory");
    }
  }
  __syncthreads();
}

struct Params {
  const float *x, *meta, *norm1_g, *w_in, *wg, *bg, *sb_g, *gla_g, *w_out, *norm2_g, *w_pq, *sk1, *sk2, *eu, *ev, *gf;
  float* out; char* ws;
};
constexpr int PEER_SPLIT_IT = 512;
constexpr int HALF_SMEM = 73728;
constexpr int SMEM_BYTES = 2 * HALF_SMEM;
constexpr size_t WS_BAR = 0;

__global__ void __launch_bounds__(512, 2) k_fused(Params p) {
  extern __shared__ __attribute__((aligned(16))) char smem_dyn[];
  const int half = __builtin_amdgcn_readfirstlane((int)(threadIdx.x >> 8));
  char* smem = smem_dyn + half * HALF_SMEM;
  __shared__ unsigned xb_words[4];
  if (threadIdx.x < 4) xb_words[threadIdx.x] = 0u;
  __syncthreads();
  const XcdBarrier bar = xcd_barrier_post((unsigned*)(p.ws + WS_BAR), xb_words);
  if (threadIdx.x == 0) xb_words[2] = xb_add((unsigned*)(p.ws + WS_XRANK) + bar.x, 1u);
  const int G = 2 * gridDim.x, bid = 2 * blockIdx.x + half;
  char* ws = p.ws;
  bf16_t* WinT = (bf16_t*)(ws + WS_WIN);
  bf16_t* WoutT = (bf16_t*)(ws + WS_WOUT);
  bf16_t* WpqT = (bf16_t*)(ws + WS_WPQ);
  bf16_t* EU = (bf16_t*)(ws + WS_EU);
  bf16_t* EV = (bf16_t*)(ws + WS_EV);
  bf16_t* SK1b = (bf16_t*)(ws + WS_SK1);
  bf16_t* SK2b = (bf16_t*)(ws + WS_SK2);
  bf16_t* A1 = (bf16_t*)(ws + WS_A1);
  float* GO = (float*)(ws + WS_A1);
  bf16_t* A2 = (bf16_t*)(ws + WS_A1);
  InProjOut O;
  O.QSB = (bf16_t*)(ws + WS_QSB); O.KSB = (bf16_t*)(ws + WS_KSB); O.VTSB = (bf16_t*)(ws + WS_VTSB); O.VSB = (bf16_t*)(ws + WS_VSB);
  O.GQ = (bf16_t*)(ws + WS_GQ); O.GK = (bf16_t*)(ws + WS_GK); O.GV = (bf16_t*)(ws + WS_GVT); O.GR = (bf16_t*)(ws + WS_GR);
  O.GLR = (float*)(ws + WS_GLR);
  bf16_t* H1 = (bf16_t*)(ws + WS_H1);
  float* SSQ = (float*)(ws + WS_XS + 3 * MiB);
  float* R1I = (float*)(ws + WS_XS + 4 * MiB);
  bf16_t* GVT = (bf16_t*)(ws + WS_GVT);
  GlaPtrs GP;
  GP.GQ = O.GQ; GP.GK = O.GK; GP.GVT = GVT; GP.GR = O.GR; GP.GLR = O.GLR; GP.wg = p.wg; GP.bg = p.bg; GP.gla_g = p.gla_g;
  GP.SLOC = (float*)(ws + WS_SLOC); GP.DTOT = (float*)(ws + WS_DTOT); GP.MIX = (bf16_t*)(ws + WS_MIX);
  GlaPrepPtrs GPP; GPP.GQ = O.GQ; GPP.GK = O.GK; GPP.GLR = O.GLR; GPP.wg = p.wg; GPP.bg = p.bg;
  GPP.QT = (bf16_t*)(ws + WS_GQT); GPP.KT = (bf16_t*)(ws + WS_GKT); GPP.KTT = (bf16_t*)(ws + WS_GKTT); GPP.DEC = (float*)(ws + WS_GDEC); GPP.BL = (float*)(ws + WS_GBL);
  GlaPtrs3 GP3; GP3.QT = GPP.QT; GP3.KT = GPP.KT; GP3.KTT = GPP.KTT; GP3.GVT = GVT; GP3.GR = O.GR; GP3.DEC = GPP.DEC; GP3.BL = GPP.BL; GP3.gla_g = p.gla_g;
  GP3.SLOC = GP.SLOC; GP3.DTOT = GP.DTOT; GP3.MIX = GP.MIX;
  bf16_t* MIX = (bf16_t*)(ws + WS_MIX);
  bf16_t* QP = (bf16_t*)(ws + WS_MIX);
  unsigned short* EIDX = (unsigned short*)(ws + WS_EIDX);
  bf16_t* PP = (bf16_t*)(ws + WS_PP);
  bf16_t* YT = (bf16_t*)(ws + WS_A1);
  unsigned* STREAM = (unsigned*)(ws + WS_STREAM);
  float* GATE = (float*)(ws + WS_GATE);

  for (int vb = bid; vb < 832 + 256 + 256; vb += G) {
    if (vb < 832) ph_transpose_w(vb % 104, vb / 104, smem, p.w_in, p.norm1_g, WinT, D, NIN);
    else if (vb < 1088) { const int t = vb - 832; ph_transpose_w(t % 32, t / 32, smem, p.w_out, nullptr, WoutT, D, D); }
    else { const int t = vb - 1088; ph_transpose_w(t % 32, t / 32, smem, p.w_pq, p.norm2_g, WpqT, D, D); }
  }
  ph_convert_eu_i8(p.eu, p.norm2_g, (u8_t*)EU, (float*)(ws + WS_SCU));
  for (int vb = bid; vb < NEXP / 32; vb += G) ph_convert_ev8(vb, smem, p.ev, (u8_t*)EV, (float*)(ws + WS_SCV));
  ph_convert(p.sk1, SK1b, (size_t)8 * 128 * 64 / 8);
  ph_convert(p.sk2, SK2b, (size_t)8 * 128 * 64 / 8);
  ph_zero_pads(O.KSB, O.VTSB, O.GQ, O.GK, GVT);
  for (int vb = bid; vb < TREAL / 16; vb += G) ph_norm_rows<0>(vb, p.x, R1I, A1);
  __syncthreads();
  for (int mb = blockIdx.x; mb < NIN / 16; mb += gridDim.x) ph_meta(mb, smem_dyn, p.meta, p.norm1_g, p.w_in, O);
  xcd_barrier(bar);
  {
    pg8::Gemm g{A1, WinT, TREAL, 3072, D}; pg8::StaticOrder S; S.init(TREAL, 3072, (int)gridDim.x, (int)blockIdx.x);
    EpiInProj E{O, GVT, smem_dyn + 131072};
    pg8::gemm_phase<EpiInProj, pg8::StaticOrder, true, true>((PG8_LAS unsigned char*)smem_dyn, g, S, E);
  }
  for (int panel = blockIdx.x; panel < TREAL / 256; panel += gridDim.x) ph_glr(panel, A1, WinT, O.GLR);
  xcd_barrier(bar);
  for (int it = blockIdx.x; it < 16 * 129; it += gridDim.x) ph_gla_prep(it, smem_dyn, GPP);
  xcd_barrier(bar);
  for (int it = blockIdx.x; it < 16 * 15; it += gridDim.x) gla_item4<0>(it / 15, it % 15, smem_dyn, GP3);
  for (int vb = bid; vb < 64 * 32; vb += G) ph_sb_attn2(vb, O.QSB, O.KSB, O.VTSB, p.sb_g, MIX);
  xcd_barrier(bar);
  for (int it = blockIdx.x; it < 16 * 16; it += gridDim.x) gla_item4<1>(it >> 4, it & 15, smem_dyn, GP3);
  xcd_barrier(bar);
  {
    pg8::Gemm g{MIX, WoutT, TREAL, D, D}; pg8::StaticOrder S; S.init(TREAL, D, (int)gridDim.x, (int)blockIdx.x);
    EpiOut E{A1, R1I, H1, (u8_t*)(ws + WS_XQ), (float*)(ws + WS_XS), SSQ, (float*)(smem_dyn + 131072)};
    pg8::gemm_phase<EpiOut, pg8::StaticOrder, true, true>((PG8_LAS unsigned char*)smem_dyn, g, S, E);
  }
  xcd_barrier(bar);
  {
    pg8::Gemm g{H1, WpqT, TREAL, D, D}; pg8::StaticOrder S; S.init(TREAL, D, (int)gridDim.x, (int)blockIdx.x);
    EpiPQ E{QP, SSQ};
    pg8::gemm_phase<EpiPQ, pg8::StaticOrder, true, true>((PG8_LAS unsigned char*)smem_dyn, g, S, E);
  }
  route_stage_keys(bid & 7, smem, SK1b, SK2b);
  xcd_barrier(bar);
  {
    const int NV = 8 * (TREAL / 128);
    const int rlane = (int)(threadIdx.x & 63u), rwave = (int)((threadIdx.x >> 6) & 3u);
    bf16x8 qa[2][4], qb[2][4];
    if (bid < NV) route_load_q(qa, QP, (bid >> 3) * 128 + rwave * 32 + (rlane & 31), bid & 7, rlane >> 5);
    for (int vb = bid; vb < NV; vb += 2 * G) {
      const int v1 = vb + G, v2 = vb + 2 * G;
      if (v1 < NV) route_load_q(qb, QP, (v1 >> 3) * 128 + rwave * 32 + (rlane & 31), v1 & 7, rlane >> 5);
      ph_route_v2(vb, smem, qa, EIDX, GATE);
      if (v1 < NV) {
        if (v2 < NV) route_load_q(qa, QP, (v2 >> 3) * 128 + rwave * 32 + (rlane & 31), v2 & 7, rlane >> 5);
        ph_route_v2(v1, smem, qb, EIDX, GATE);
      }
    }
  }
  __shared__ int xinfo[4];
  if (threadIdx.x == 0) {
    unsigned* barw = (unsigned*)(p.ws + WS_BAR);
    unsigned cnt = 0, ord = 0, mine = 1;
    for (unsigned j = 0; j < 16; ++j) { const unsigned c = xb_ld(&barw[XB_XCNT(j)]); if (c > 0) { if (j < bar.x) ++ord; ++cnt; } if (j == bar.x) mine = c; }
    xinfo[0] = (int)ord; xinfo[1] = (int)cnt; xinfo[2] = (int)xb_words[2]; xinfo[3] = (int)mine;
  }
  xcd_barrier(bar);
  {
    const int xi = xinfo[0], nx = xinfo[1], rank = xinfo[2], nloc = xinfo[3];
    const int wave = __builtin_amdgcn_readfirstlane((int)(threadIdx.x >> 6));
    const u8_t* XQp = (const u8_t*)(ws + WS_XQ); const float* XSp = (const float*)(ws + WS_XS);
    constexpr int ITA = PEER_SPLIT_IT, TSPLIT = ITA * 64;
    ph_peer_u_d4(xi, nx, rank * 8 + wave, nloc * 8, 0, TSPLIT, XQp, XSp, (const u8_t*)EU, EIDX, PP);
    pc_stage_scales(smem_dyn, (const float*)(ws + WS_SCU), (const float*)(ws + WS_SCV));
    xcd_barrier(bar);
    for (int unit = blockIdx.x; unit < ITA; unit += gridDim.x) ph_peer_c8(unit, smem_dyn, PP, EIDX, GATE, SSQ, STREAM);
    const bool vpre = gridDim.x >= 256 && blockIdx.x < 256;
    if (vpre) pv_load_table(smem_dyn, (const u8_t*)EV, blockIdx.x & 127);
    xcd_barrier(bar);
    if (gridDim.x >= 256) {
      const int cg = blockIdx.x & 127, th = (blockIdx.x >> 7) & 1;
      if (wave < 4) { if (blockIdx.x < 256) pv_process(smem_dyn, STREAM, YT, cg, th * (ITA / 2) + wave, (th + 1) * (ITA / 2), 4); }
      else ph_peer_u_d4(xi, nx, rank * 4 + wave - 4, nloc * 4, TSPLIT, TREAL, XQp, XSp, (const u8_t*)EU, EIDX, PP);
    } else {
      ph_peer_u_d4(xi, nx, rank * 8 + wave, nloc * 8, TSPLIT, TREAL, XQp, XSp, (const u8_t*)EU, EIDX, PP);
      ph_peer_v8(smem_dyn, STREAM, (const u8_t*)EV, YT, 0, ITA);
    }
    xcd_barrier(bar);
    pc_stage_scales(smem_dyn, (const float*)(ws + WS_SCU), (const float*)(ws + WS_SCV));
    for (int unit = ITA + blockIdx.x; unit < TREAL / 64; unit += gridDim.x) ph_peer_c8(unit, smem_dyn, PP, EIDX, GATE, SSQ, STREAM);
    if (vpre) pv_load_table(smem_dyn, (const u8_t*)EV, blockIdx.x & 127);
    xcd_barrier(bar);
    if (gridDim.x == 256) {
      const int cg = blockIdx.x & 127, th = blockIdx.x >> 7, nitb = TREAL / 64 - ITA;
      pv_process(smem_dyn, STREAM, YT, cg, ITA + th * (nitb / 2) + wave, ITA + (th + 1) * (nitb / 2), 8);
    } else ph_peer_v8(smem_dyn, STREAM, (const u8_t*)EV, YT, ITA, TREAL / 64 - ITA);
  }
  xcd_barrier(bar);
  for (int unit = blockIdx.x; unit < TREAL / 32; unit += gridDim.x) ph_final_lds(unit, smem_dyn, H1, YT, p.gf, p.out);
}

extern "C" void kernel_launch(void* const* d_in, const int* in_sizes, int n_in, void* d_out, int out_size, void* d_ws, size_t ws_size, hipStream_t stream) {
  static int grid = 0;
  if (grid == 0) {
    int dev = 0, cus = 0, per_cu = 0;
    hipGetDevice(&dev);
    hipDeviceGetAttribute(&cus, hipDeviceAttributeMultiprocessorCount, dev);
    hipFuncSetAttribute((const void*)k_fused, hipFuncAttributeMaxDynamicSharedMemorySize, SMEM_BYTES);
    hipOccupancyMaxActiveBlocksPerMultiprocessor(&per_cu, (const void*)k_fused, 512, SMEM_BYTES);
    if (per_cu > 1) per_cu = 1;
    if (per_cu < 1) per_cu = 1;
    grid = cus * per_cu;
  }
  hipMemsetAsync((char*)d_ws + WS_BAR, 0, 32768, stream);
  Params p{};
  p.x = (const float*)d_in[0]; p.meta = (const float*)d_in[1]; p.norm1_g = (const float*)d_in[2]; p.w_in = (const float*)d_in[3];
  p.wg = (const float*)d_in[4]; p.bg = (const float*)d_in[5]; p.sb_g = (const float*)d_in[6]; p.gla_g = (const float*)d_in[7];
  p.w_out = (const float*)d_in[8]; p.norm2_g = (const float*)d_in[9]; p.w_pq = (const float*)d_in[10]; p.sk1 = (const float*)d_in[11];
  p.sk2 = (const float*)d_in[12]; p.eu = (const float*)d_in[13]; p.ev = (const float*)d_in[14]; p.gf = (const float*)d_in[15];
  p.out = (float*)d_out; p.ws = (char*)d_ws;
  void* args[] = {&p};
  hipLaunchCooperativeKernel((const void*)k_fused, dim3(grid), dim3(512), args, SMEM_BYTES, stream);
}
```
